# Optimizing an MI355X kernel written in HIP

```python
import math
import jax
import jax.numpy as jnp
from jax import lax
import numpy as np

D_MODEL = 1024
BATCH = 8
SEQ = 2048
DEPTH = 2

GRID_W = 64
CTX_LEN = 256
GROUP_W = D_MODEL // 4
HEAD_DIM = 64
Q_BLOCK = 128
ROPE_THETA = 10000.0
NORM_EPS = 1e-6
DA_HEADS = GROUP_W // HEAD_DIM
DA_QK = HEAD_DIM // 2
ML_HEADS = GROUP_W // HEAD_DIM
ML_HEAD_DIM = HEAD_DIM
ML_CHUNK = 128
ML_CONV = 3
MLA_HEADS = 4
MLA_NOPE = 64
MLA_ROPE = 32
MLA_V = GROUP_W // MLA_HEADS
MLA_Q_RANK = 192
MLA_KV_RANK = 128
S5_CH = GROUP_W
S5_GROUP = 16
S5_NGROUPS = S5_CH // S5_GROUP
S5_STATE = 64
N_EXPERTS = 32
TOP_K = 4
D_FF = D_MODEL
SWIGLU_ALPHA = 1.702
SWIGLU_LIMIT = 7.0
MOE_BLOCK = 256
DA_COLS = 3 * GROUP_W
ML_COLS = 4 * GROUP_W + 4 * ML_HEADS
MLA_COLS = MLA_Q_RANK + MLA_KV_RANK + MLA_ROPE
S5_COLS = S5_CH
D_IN = DA_COLS + ML_COLS + MLA_COLS + S5_COLS

kernel_name = 'hymba_style_diffusion_hybrid_moe'


def rmsnorm(x, w):
    xf = x.astype(jnp.float32)
    y = xf * lax.rsqrt(jnp.mean(xf * xf, axis=-1, keepdims=True) + NORM_EPS)
    return (y * w.astype(jnp.float32)).astype(x.dtype)


def modulate(x, w, shift, scale):
    return rmsnorm(x, w) * (1.0 + scale) + shift


def axial_rope_tables(rows, cols, rot_dim):
    n_freq = rot_dim // 4
    inv = ROPE_THETA ** (-jnp.arange(n_freq, dtype=jnp.float32) / n_freq)
    ang = jnp.concatenate([rows[:, None] * inv, cols[:, None] * inv], axis=-1)
    return jnp.cos(ang), jnp.sin(ang)


def apply_rope(x, cos, sin):
    shp = (cos.shape[0],) + (1,) * (x.ndim - 3) + (cos.shape[1],)
    cs, sn = cos.reshape(shp), sin.reshape(shp)
    xf = x.astype(jnp.float32)
    half = x.shape[-1] // 2
    x1, x2 = xf[..., :half], xf[..., half:]
    return jnp.concatenate([x1 * cs - x2 * sn, x2 * cs + x1 * sn], axis=-1).astype(x.dtype)


def block_attn(q, k, v, scale, coef):
    b, s, m, h, dk = q.shape
    nb = s // Q_BLOCK
    qb = q.reshape(b, nb, Q_BLOCK, m, h, dk).swapaxes(0, 1)

    def one_block(q_blk):
        logits = jnp.einsum('bqmhd,bkmhd->bmhqk', q_blk, k).astype(jnp.float32) * scale
        probs = jax.nn.softmax(logits, axis=-1)
        w = jnp.einsum('m,bmhqk->bhqk', coef, probs).astype(v.dtype)
        return jnp.einsum('bhqk,bkhd->bqhd', w, v)

    out = lax.map(one_block, qb)
    return out.swapaxes(0, 1).reshape(b, s, h, v.shape[-1])


def diff_attn_mixer(p_ctx, p_lat, cos, sin, lam, subln_w, lambda_init, with_ctx):
    def qk_heads(a):
        return a.reshape(a.shape[0], a.shape[1], DA_HEADS, 2, DA_QK).swapaxes(2, 3)

    def queries(p, rotate):
        q = qk_heads(p[..., :GROUP_W])
        return apply_rope(q, cos, sin) if rotate else q

    def keys_values(p, rotate):
        k = qk_heads(p[..., GROUP_W:2 * GROUP_W])
        if rotate:
            k = apply_rope(k, cos, sin)
        v = p[..., 2 * GROUP_W:].reshape(p.shape[0], p.shape[1], DA_HEADS, 2 * DA_QK)
        return k, v

    lamf = lam.astype(jnp.float32)
    lam_full = jnp.exp(jnp.sum(lamf[0] * lamf[1])) - jnp.exp(jnp.sum(lamf[2] * lamf[3])) + lambda_init
    coef = jnp.stack([jnp.ones_like(lam_full), -lam_full])
    scale = DA_QK ** -0.5

    def finish(o):
        return (rmsnorm(o, subln_w) * (1.0 - lambda_init)).reshape(o.shape[0], o.shape[1], GROUP_W)

    k_ctx, v_ctx = keys_values(p_ctx, False)
    k_lat, v_lat = keys_values(p_lat, True)
    y_lat = finish(block_attn(queries(p_lat, True), jnp.concatenate([k_ctx, k_lat], 1),
                              jnp.concatenate([v_ctx, v_lat], 1), scale, coef))
    y_ctx = finish(block_attn(queries(p_ctx, False), k_ctx, v_ctx, scale, coef)) if with_ctx else None
    return y_ctx, y_lat


def short_conv(x, w, b):
    ch = x.shape[-1]
    y = lax.conv_general_dilated(x, w[:, None, :].astype(x.dtype), window_strides=(1,),
                                 padding=[((ML_CONV - 1) // 2, ML_CONV // 2)],
                                 dimension_numbers=('NWC', 'WIO', 'NWC'), feature_group_count=ch)
    return y + b.astype(x.dtype)


def mlstm_chunk_scan(q, k, v, log_i, log_f, state):
    b, n, h, d = q.shape
    nc = n // ML_CHUNK

    def chunks(a):
        a = a.reshape((b, nc, ML_CHUNK) + a.shape[2:])
        return jnp.moveaxis(a, (1, 3), (0, 2))

    causal = jnp.tril(jnp.ones((ML_CHUNK, ML_CHUNK), dtype=bool))

    def step(carry, inp):
        c_mat, n_vec, m = carry
        qc, kc, vc, ic, fc = inp
        bcum = jnp.cumsum(fc, axis=-1)
        log_w = jnp.where(causal, bcum[..., :, None] - bcum[..., None, :] + ic[..., None, :], -jnp.inf)
        log_inter = bcum + m[..., None]
        m_t = jnp.maximum(log_inter, jnp.max(log_w, axis=-1))
        w = jnp.einsum('bhtd,bhsd->bhts', qc, kc) * jnp.exp(log_w - m_t[..., None])
        w_inter = jnp.exp(log_inter - m_t)
        num = jnp.einsum('bhts,bhsd->bhtd', w, vc) + w_inter[..., None] * jnp.einsum('bhvk,bhtk->bhtv', c_mat, qc)
        den = jnp.sum(w, axis=-1) + w_inter * jnp.einsum('bhtk,bhk->bht', qc, n_vec)
        h_out = num / jnp.maximum(jnp.abs(den), jnp.exp(-m_t))[..., None]
        b_last = bcum[..., -1]
        log_upd = b_last[..., None] - bcum + ic
        m_new = jnp.maximum(b_last + m, jnp.max(log_upd, axis=-1))
        w_upd = jnp.exp(log_upd - m_new[..., None])
        decay = jnp.exp(b_last + m - m_new)
        c_new = decay[..., None, None] * c_mat + jnp.einsum('bhs,bhsv,bhsk->bhvk', w_upd, vc, kc)
        n_new = decay[..., None] * n_vec + jnp.einsum('bhs,bhsk->bhk', w_upd, kc)
        return (c_new, n_new, m_new), h_out

    state, hs = lax.scan(step, state, (chunks(q), chunks(k), chunks(v), chunks(log_i), chunks(log_f)))
    return state, jnp.moveaxis(hs, (0, 2), (1, 3)).reshape(b, n, h, d)


def mlstm_mixer(p_ctx, p_lat, conv_w, conv_b, gate_b, norm_w, with_ctx):
    f32 = jnp.float32

    def prep(p):
        bsz, n = p.shape[:2]
        qk, v, o, g = jnp.split(p, [2 * GROUP_W, 3 * GROUP_W, 4 * GROUP_W], axis=-1)
        qk = jax.nn.silu(short_conv(qk, conv_w, conv_b))
        q, k = jnp.split(qk, 2, axis=-1)
        heads = lambda a: a.astype(f32).reshape(bsz, n, ML_HEADS, ML_HEAD_DIM)
        g = (g + gate_b).astype(f32).reshape(bsz, n, 4, ML_HEADS)
        gates = ((g[:, :, 0], jax.nn.log_sigmoid(g[:, :, 1])), (g[:, :, 2], jax.nn.log_sigmoid(g[:, :, 3])))
        return heads(q), heads(k) * ML_HEAD_DIM ** -0.5, heads(v), o, gates

    qc, kc, vc, oc, gc = prep(p_ctx)
    ql, kl, vl, ol, gl = prep(p_lat)
    bsz = p_lat.shape[0]

    def direction(idx, reverse):
        flip = (lambda a: jnp.flip(a, axis=1)) if reverse else (lambda a: a)
        state0 = (jnp.zeros((bsz, ML_HEADS, ML_HEAD_DIM, ML_HEAD_DIM), f32),
                  jnp.zeros((bsz, ML_HEADS, ML_HEAD_DIM), f32), jnp.zeros((bsz, ML_HEADS), f32))
        (li_c, lf_c), (li_l, lf_l) = gc[idx], gl[idx]
        state, hc = mlstm_chunk_scan(flip(qc), flip(kc), flip(vc), flip(li_c), flip(lf_c), state0)
        _, hl = mlstm_chunk_scan(flip(ql), flip(kl), flip(vl), flip(li_l), flip(lf_l), state)
        return flip(hc), flip(hl)

    hc_f, hl_f = direction(0, False)
    hc_b, hl_b = direction(1, True)

    def finish(h, o):
        bsz_, n = o.shape[:2]
        h = jax.nn.sigmoid(o.astype(f32)).reshape(bsz_, n, ML_HEADS, ML_HEAD_DIM) * h
        return rmsnorm(h, norm_w.reshape(ML_HEADS, ML_HEAD_DIM)).reshape(bsz_, n, GROUP_W).astype(o.dtype)

    y_ctx = finish(hc_f + hc_b, oc) if with_ctx else None
    return y_ctx, finish(hl_f + hl_b, ol)


def mla_mixer(p_ctx, p_lat, cos, sin, q_norm, w_uq, kv_norm, w_ukv, with_ctx):
    def queries(p, rotate):
        bsz, n = p.shape[:2]
        q = (rmsnorm(p[..., :MLA_Q_RANK], q_norm) @ w_uq).reshape(bsz, n, MLA_HEADS, MLA_NOPE + MLA_ROPE)
        if rotate:
            q = jnp.concatenate([q[..., :MLA_NOPE], apply_rope(q[..., MLA_NOPE:], cos, sin)], axis=-1)
        return q[:, :, None]

    def keys_values(p, rotate):
        bsz, n = p.shape[:2]
        kv = (rmsnorm(p[..., MLA_Q_RANK:MLA_Q_RANK + MLA_KV_RANK], kv_norm) @ w_ukv).reshape(
            bsz, n, MLA_HEADS, MLA_NOPE + MLA_V)
        k_rope = p[..., MLA_Q_RANK + MLA_KV_RANK:][:, :, None, :]
        if rotate:
            k_rope = apply_rope(k_rope, cos, sin)
        k = jnp.concatenate([kv[..., :MLA_NOPE], jnp.broadcast_to(k_rope, (bsz, n, MLA_HEADS, MLA_ROPE))], axis=-1)
        return k[:, :, None], kv[..., MLA_NOPE:]

    scale = (MLA_NOPE + MLA_ROPE) ** -0.5
    coef = jnp.ones((1,), jnp.float32)
    flat = lambda o: o.reshape(o.shape[0], o.shape[1], GROUP_W)
    k_ctx, v_ctx = keys_values(p_ctx, False)
    k_lat, v_lat = keys_values(p_lat, True)
    y_lat = flat(block_attn(queries(p_lat, True), jnp.concatenate([k_ctx, k_lat], 1),
                            jnp.concatenate([v_ctx, v_lat], 1), scale, coef))
    y_ctx = flat(block_attn(queries(p_ctx, False), k_ctx, v_ctx, scale, coef)) if with_ctx else None
    return y_ctx, y_lat


def s5_discretize(a_re, a_im, log_step, b_re, b_im):
    a_re = jnp.minimum(a_re, -1e-4)
    dt = jnp.exp(log_step)[:, None]
    mag = jnp.exp(dt * a_re)
    ab_re, ab_im = mag * jnp.cos(dt * a_im), mag * jnp.sin(dt * a_im)
    inv = 1.0 / (a_re * a_re + a_im * a_im)
    f_re = ((ab_re - 1.0) * a_re + ab_im * a_im) * inv
    f_im = (ab_im * a_re - (ab_re - 1.0) * a_im) * inv
    bb_re = f_re[..., None] * b_re - f_im[..., None] * b_im
    bb_im = f_re[..., None] * b_im + f_im[..., None] * b_re
    return ab_re, ab_im, bb_re, bb_im


def complex_affine_combine(e1, e2):
    a1r, a1i, b1r, b1i = e1
    a2r, a2i, b2r, b2i = e2
    return (a1r * a2r - a1i * a2i, a1r * a2i + a1i * a2r,
            a2r * b1r - a2i * b1i + b2r, a2r * b1i + a2i * b1r + b2i)


def s5_scan(u, ab_re, ab_im, bb_re, bb_im, x0_re, x0_im):
    bu_re = jnp.einsum('bngh,gph->bngp', u, bb_re)
    bu_im = jnp.einsum('bngh,gph->bngp', u, bb_im)
    bu_re = bu_re.at[:, 0].add(ab_re * x0_re - ab_im * x0_im)
    bu_im = bu_im.at[:, 0].add(ab_re * x0_im + ab_im * x0_re)
    a_re = jnp.broadcast_to(ab_re, bu_re.shape)
    a_im = jnp.broadcast_to(ab_im, bu_im.shape)
    _, _, x_re, x_im = lax.associative_scan(complex_affine_combine, (a_re, a_im, bu_re, bu_im), axis=1)
    return x_re, x_im


def s5_mixer(p_ctx, p_lat, a_re, a_im, log_step, b_re, b_im, c_re, c_im, d_skip, w_glu, b_glu, with_ctx):
    f32 = jnp.float32
    groups = lambda p: p.astype(f32).reshape(p.shape[0], p.shape[1], S5_NGROUPS, S5_GROUP)
    u_ctx, u_lat = groups(p_ctx), groups(p_lat)
    bsz = p_lat.shape[0]
    d_g = d_skip.astype(f32).reshape(S5_NGROUPS, S5_GROUP)

    def direction(idx, reverse):
        flip = (lambda a: jnp.flip(a, axis=1)) if reverse else (lambda a: a)
        ab_re, ab_im, bb_re, bb_im = s5_discretize(a_re[idx].astype(f32), a_im[idx].astype(f32),
                                                   log_step[idx].astype(f32), b_re[idx].astype(f32),
                                                   b_im[idx].astype(f32))
        zero = jnp.zeros((bsz, S5_NGROUPS, S5_STATE), f32)
        xc_re, xc_im = s5_scan(flip(u_ctx), ab_re, ab_im, bb_re, bb_im, zero, zero)
        xl_re, xl_im = s5_scan(flip(u_lat), ab_re, ab_im, bb_re, bb_im, xc_re[:, -1], xc_im[:, -1])
        cr, ci = c_re[idx].astype(f32), c_im[idx].astype(f32)
        readout = lambda xr, xi: flip(jnp.einsum('ghp,bngp->bngh', cr, xr) - jnp.einsum('ghp,bngp->bngh', ci, xi))
        return (readout(xc_re, xc_im) if with_ctx else None), readout(xl_re, xl_im)

    yc_f, yl_f = direction(0, False)
    yc_b, yl_b = direction(1, True)

    def glu(y, dtype):
        g = jax.nn.gelu(y.reshape(y.shape[0], y.shape[1], S5_CH))
        return (g * jax.nn.sigmoid(g @ w_glu.astype(f32) + b_glu.astype(f32))).astype(dtype)

    y_lat = glu(yl_f + yl_b + u_lat * d_g, p_lat.dtype)
    y_ctx = glu(yc_f + yc_b + u_ctx * d_g, p_ctx.dtype) if with_ctx else None
    return y_ctx, y_lat


def moe_ffn(h, w_router, b_router, w_gate_up, b_gate_up, w_down, b_down):
    n_tok, d = h.shape
    n_assign = n_tok * TOP_K
    logits = (h @ w_router + b_router).astype(jnp.float32)
    top_logit, top_expert = lax.top_k(logits, TOP_K)
    top_gate = jax.nn.softmax(top_logit, axis=-1)
    flat_expert = top_expert.reshape(-1)
    flat_token = jnp.arange(n_assign) // TOP_K
    order = jnp.argsort(flat_expert)
    sorted_expert = flat_expert[order]
    counts = jnp.bincount(flat_expert, length=N_EXPERTS)
    padded = (counts + MOE_BLOCK - 1) // MOE_BLOCK * MOE_BLOCK
    group_start = jnp.cumsum(counts) - counts
    padded_end = jnp.cumsum(padded)
    dest = (padded_end - padded)[sorted_expert] + jnp.arange(n_assign) - group_start[sorted_expert]
    n_blocks = -(-(n_assign + N_EXPERTS * (MOE_BLOCK - 1)) // MOE_BLOCK)
    n_slots = n_blocks * MOE_BLOCK
    slot_token = jnp.full((n_slots,), n_tok, jnp.int32).at[dest].set(flat_token[order])
    slot_gate = jnp.zeros((n_slots,), h.dtype).at[dest].set(top_gate.reshape(-1)[order].astype(h.dtype))
    block_expert = jnp.minimum(jnp.searchsorted(padded_end, jnp.arange(n_blocks) * MOE_BLOCK, side='right'),
                               N_EXPERTS - 1)
    h_pad = jnp.concatenate([h, jnp.zeros((1, d), h.dtype)], axis=0)
    x_blocks = h_pad[slot_token].reshape(n_blocks, MOE_BLOCK, d)

    def expert_block(args):
        xb, e = args
        gu = xb @ w_gate_up[e] + b_gate_up[e]
        gate = jnp.minimum(gu[:, :D_FF], SWIGLU_LIMIT)
        up = jnp.clip(gu[:, D_FF:], -SWIGLU_LIMIT, SWIGLU_LIMIT)
        return ((up + 1.0) * gate * jax.nn.sigmoid(SWIGLU_ALPHA * gate)) @ w_down[e] + b_down[e]

    y = lax.map(expert_block, (x_blocks, block_expert)).reshape(n_slots, d)
    out = jnp.zeros((n_tok + 1, d), h.dtype).at[slot_token].add(y * slot_gate[:, None])
    return out[:n_tok]


def setup_inputs(seed: int = 0) -> dict:
    key = jax.random.key(seed)
    keys = jax.random.split(key, 64)
    counter = iter(range(64))
    f32 = jnp.float32
    L = DEPTH

    def nrm(shape, scale):
        return scale * jax.random.normal(keys[next(counter)], shape, f32)

    x = nrm((BATCH, SEQ, D_MODEL), 1.0)
    c = nrm((BATCH, D_MODEL), 1.0)
    ctx = nrm((BATCH, CTX_LEN, D_MODEL), 1.0)
    c_ctx = nrm((D_MODEL,), 1.0)
    w_mod = nrm((L, D_MODEL, 6 * D_MODEL), 0.5 * D_MODEL ** -0.5)
    b_mod = nrm((L, 6 * D_MODEL), 0.02)
    norm_w = 1.0 + nrm((L, 4, D_MODEL), 0.02)
    w_in = nrm((L, D_MODEL, D_IN), D_MODEL ** -0.5)
    w_out = nrm((L, D_MODEL, D_MODEL), D_MODEL ** -0.5)
    da_lambda = nrm((L, 4, DA_QK), 0.1)
    da_subln = 1.0 + nrm((L, 2 * DA_QK), 0.02)
    ml_conv_w = nrm((L, ML_CONV, 2 * GROUP_W), ML_CONV ** -0.5)
    ml_conv_b = nrm((L, 2 * GROUP_W), 0.02)
    f_init = jnp.linspace(3.0, 6.0, ML_HEADS, dtype=f32)
    ml_gate_b = jnp.concatenate([nrm((L, ML_HEADS), 0.1), f_init + nrm((L, ML_HEADS), 0.1),
                                 nrm((L, ML_HEADS), 0.1), f_init + nrm((L, ML_HEADS), 0.1)], axis=-1)
    ml_norm = 1.0 + nrm((L, GROUP_W), 0.02)
    mla_q_norm = 1.0 + nrm((L, MLA_Q_RANK), 0.02)
    mla_w_uq = nrm((L, MLA_Q_RANK, MLA_HEADS * (MLA_NOPE + MLA_ROPE)), MLA_Q_RANK ** -0.5)
    mla_kv_norm = 1.0 + nrm((L, MLA_KV_RANK), 0.02)
    mla_w_ukv = nrm((L, MLA_KV_RANK, MLA_HEADS * (MLA_NOPE + MLA_V)), MLA_KV_RANK ** -0.5)
    s5_a_re = -0.5 + nrm((L, 2, S5_NGROUPS, S5_STATE), 0.01)
    s5_a_im = math.pi * jnp.arange(S5_STATE, dtype=f32) + nrm((L, 2, S5_NGROUPS, S5_STATE), 0.01)
    s5_log_step = jax.random.uniform(keys[next(counter)], (L, 2, S5_NGROUPS), f32,
                                     minval=math.log(1e-3), maxval=math.log(1e-1))
    s5_b_re = nrm((L, 2, S5_NGROUPS, S5_STATE, S5_GROUP), (2 * S5_GROUP) ** -0.5)
    s5_b_im = nrm((L, 2, S5_NGROUPS, S5_STATE, S5_GROUP), (2 * S5_GROUP) ** -0.5)
    s5_c_re = nrm((L, 2, S5_NGROUPS, S5_GROUP, S5_STATE), (2 * S5_STATE) ** -0.5)
    s5_c_im = nrm((L, 2, S5_NGROUPS, S5_GROUP, S5_STATE), (2 * S5_STATE) ** -0.5)
    s5_d = nrm((L, S5_CH), 1.0)
    s5_w_glu = nrm((L, S5_CH, S5_CH), S5_CH ** -0.5)
    s5_b_glu = nrm((L, S5_CH), 0.02)
    moe_w_router = nrm((L, D_MODEL, N_EXPERTS), D_MODEL ** -0.5)
    moe_b_router = nrm((L, N_EXPERTS), 0.01)
    moe_w_gate_up = nrm((L, N_EXPERTS, D_MODEL, 2 * D_FF), D_MODEL ** -0.5)
    moe_b_gate_up = nrm((L, N_EXPERTS, 2 * D_FF), 0.02)
    moe_w_down = nrm((L, N_EXPERTS, D_FF, D_MODEL), D_FF ** -0.5)
    moe_b_down = nrm((L, N_EXPERTS, D_MODEL), 0.02)
    return {'x': x, 'c': c, 'ctx': ctx, 'c_ctx': c_ctx, 'w_mod': w_mod, 'b_mod': b_mod, 'norm_w': norm_w,
            'w_in': w_in, 'w_out': w_out, 'da_lambda': da_lambda, 'da_subln': da_subln,
            'ml_conv_w': ml_conv_w, 'ml_conv_b': ml_conv_b, 'ml_gate_b': ml_gate_b, 'ml_norm': ml_norm,
            'mla_q_norm': mla_q_norm, 'mla_w_uq': mla_w_uq, 'mla_kv_norm': mla_kv_norm, 'mla_w_ukv': mla_w_ukv,
            's5_a_re': s5_a_re, 's5_a_im': s5_a_im, 's5_log_step': s5_log_step, 's5_b_re': s5_b_re,
            's5_b_im': s5_b_im, 's5_c_re': s5_c_re, 's5_c_im': s5_c_im, 's5_d': s5_d, 's5_w_glu': s5_w_glu,
            's5_b_glu': s5_b_glu, 'moe_w_router': moe_w_router, 'moe_b_router': moe_b_router,
            'moe_w_gate_up': moe_w_gate_up, 'moe_b_gate_up': moe_b_gate_up, 'moe_w_down': moe_w_down,
            'moe_b_down': moe_b_down}


def reference(x, c, ctx, c_ctx, w_mod, b_mod, norm_w, w_in, w_out, da_lambda, da_subln,
              ml_conv_w, ml_conv_b, ml_gate_b, ml_norm, mla_q_norm, mla_w_uq, mla_kv_norm, mla_w_ukv,
              s5_a_re, s5_a_im, s5_log_step, s5_b_re, s5_b_im, s5_c_re, s5_c_im, s5_d, s5_w_glu, s5_b_glu,
              moe_w_router, moe_b_router, moe_w_gate_up, moe_b_gate_up, moe_w_down, moe_b_down):
    bsz, n_lat, d = x.shape
    n_rows = n_lat // GRID_W
    rows = jnp.repeat(jnp.arange(n_rows), GRID_W)
    cols = jnp.tile(jnp.arange(GRID_W), n_rows)
    cos_da, sin_da = axial_rope_tables(rows, cols, DA_QK)
    cos_mla, sin_mla = axial_rope_tables(rows, cols, MLA_ROPE)
    col_splits = [DA_COLS, DA_COLS + ML_COLS, DA_COLS + ML_COLS + MLA_COLS]
    split_ctx_lat = lambda a: (a[:, :CTX_LEN], a[:, CTX_LEN:])
    x_lat, x_ctx = x, ctx
    for l in range(DEPTH):
        with_ctx = l < DEPTH - 1
        lambda_init = 0.8 - 0.6 * math.exp(-0.3 * l)
        mod_lat = jnp.split((jax.nn.silu(c) @ w_mod[l] + b_mod[l])[:, None, :], 6, axis=-1)
        mod_ctx = jnp.split((jax.nn.silu(c_ctx) @ w_mod[l] + b_mod[l])[None, None, :], 6, axis=-1)

        h = jnp.concatenate([modulate(x_ctx, norm_w[l, 0], mod_ctx[0], mod_ctx[1]),
                             modulate(x_lat, norm_w[l, 0], mod_lat[0], mod_lat[1])], axis=1)
        p = h @ w_in[l]
        p_da, p_ml, p_mla, p_s5 = jnp.split(p, col_splits, axis=-1)
        ya = diff_attn_mixer(*split_ctx_lat(p_da), cos_da, sin_da, da_lambda[l], da_subln[l], lambda_init, with_ctx)
        yb = mlstm_mixer(*split_ctx_lat(p_ml), ml_conv_w[l], ml_conv_b[l], ml_gate_b[l], ml_norm[l], with_ctx)
        yc = mla_mixer(*split_ctx_lat(p_mla), cos_mla, sin_mla, mla_q_norm[l], mla_w_uq[l],
                       mla_kv_norm[l], mla_w_ukv[l], with_ctx)
        yd = s5_mixer(*split_ctx_lat(p_s5), s5_a_re[l], s5_a_im[l], s5_log_step[l], s5_b_re[l], s5_b_im[l],
                      s5_c_re[l], s5_c_im[l], s5_d[l], s5_w_glu[l], s5_b_glu[l], with_ctx)
        o_lat = jnp.concatenate([ya[1], yb[1], yc[1], yd[1]], axis=-1) @ w_out[l]
        x_lat = x_lat + mod_lat[2] * rmsnorm(o_lat, norm_w[l, 1])

        f_lat = modulate(x_lat, norm_w[l, 2], mod_lat[3], mod_lat[4])
        if with_ctx:
            o_ctx = jnp.concatenate([ya[0], yb[0], yc[0], yd[0]], axis=-1) @ w_out[l]
            x_ctx = x_ctx + mod_ctx[2] * rmsnorm(o_ctx, norm_w[l, 1])
            f_ctx = modulate(x_ctx, norm_w[l, 2], mod_ctx[3], mod_ctx[4])
            m_all = moe_ffn(jnp.concatenate([f_ctx, f_lat], axis=1).reshape(-1, d), moe_w_router[l], moe_b_router[l],
                            moe_w_gate_up[l], moe_b_gate_up[l], moe_w_down[l], moe_b_down[l])
            m_all = m_all.reshape(bsz, CTX_LEN + n_lat, d)
            x_ctx = x_ctx + mod_ctx[5] * rmsnorm(m_all[:, :CTX_LEN], norm_w[l, 3])
            m_lat = m_all[:, CTX_LEN:]
        else:
            m_lat = moe_ffn(f_lat.reshape(-1, d), moe_w_router[l], moe_b_router[l], moe_w_gate_up[l],
                            moe_b_gate_up[l], moe_w_down[l], moe_b_down[l]).reshape(bsz, n_lat, d)
        x_lat = x_lat + mod_lat[5] * rmsnorm(m_lat, norm_w[l, 3])
    return x_lat
```

```cpp
#include <hip/hip_runtime.h>
#include <cstdint>
#include <cstdio>

#define NB 8
#define NS 2048
#define NC 256
#define NT 2304
#define TT (NB * NT)
#define DM 1024
#define DIN 2416
#define NE 32
#define NASSIGN (TT * 4)
#define MAXTILES 1216

#define P_DAQ 0
#define P_DAK 256
#define P_DAV 512
#define P_MLQK 768
#define P_MLV 1280
#define P_MLO 1536
#define P_MLG 1792
#define P_CQ 1808
#define P_CKV 2000
#define P_KR 2128
#define P_S5 2160

__device__ __forceinline__ float sigmoidf_(float x) { return 1.f / (1.f + __expf(-x)); }
__device__ __forceinline__ float siluf_(float x) { return x / (1.f + __expf(-x)); }
__device__ __forceinline__ float logsigmoidf_(float x) { return fminf(x, 0.f) - log1pf(__expf(-fabsf(x))); }

__device__ __forceinline__ float block_sum_256(float v, float* red) {
    for (int o = 32; o > 0; o >>= 1) v += __shfl_xor(v, o);
    __syncthreads();
    if ((threadIdx.x & 63) == 0) red[threadIdx.x >> 6] = v;
    __syncthreads();
    float r = red[0] + red[1] + red[2] + red[3];
    return r;
}

__global__ void k_build_x(const float* __restrict__ x, const float* __restrict__ ctx, float* __restrict__ xall) {
    size_t i = (size_t)blockIdx.x * 256 + threadIdx.x;
    size_t total = (size_t)TT * DM / 4;
    if (i >= total) return;
    size_t t = i / (DM / 4); int d4 = (int)(i % (DM / 4));
    int b = (int)(t / NT), n = (int)(t % NT);
    const float4* src = (n < NC) ? (const float4*)(ctx + ((size_t)b * NC + n) * DM) : (const float4*)(x + ((size_t)b * NS + (n - NC)) * DM);
    ((float4*)xall)[i] = src[d4];
}

__global__ __launch_bounds__(256) void k_mod(const float* __restrict__ c, const float* __restrict__ c_ctx, const float* __restrict__ w_mod,
                                             const float* __restrict__ b_mod, float* __restrict__ mod) {
    __shared__ float s[9][1024];
    for (int i = threadIdx.x; i < 9 * 1024; i += 256) {
        int r = i >> 10, k = i & 1023;
        float v = (r < 8) ? c[r * 1024 + k] : c_ctx[k];
        s[r][k] = siluf_(v);
    }
    __syncthreads();
    int gj = blockIdx.x * 256 + threadIdx.x;
    int l = gj / 6144, j = gj % 6144;
    const float* w = w_mod + (size_t)l * 1024 * 6144 + j;
    float acc[9];
#pragma unroll
    for (int r = 0; r < 9; ++r) acc[r] = 0.f;
    for (int k = 0; k < 1024; ++k) {
        float wv = w[(size_t)k * 6144];
#pragma unroll
        for (int r = 0; r < 9; ++r) acc[r] += s[r][k] * wv;
    }
    float bb = b_mod[l * 6144 + j];
#pragma unroll
    for (int r = 0; r < 9; ++r) mod[((size_t)l * 9 + r) * 6144 + j] = acc[r] + bb;
}

__global__ void k_rope_table(float* __restrict__ cs) {
    int i = blockIdx.x * 256 + threadIdx.x;
    if (i >= NS * 16) return;
    int pos = i >> 4, j = i & 15;
    int row = pos / 64, col = pos % 64;
    double inv = pow(10000.0, -(double)(j & 7) / 8.0);
    double ang = (double)((j < 8) ? row : col) * inv;
    cs[i * 2] = (float)cos(ang);
    cs[i * 2 + 1] = (float)sin(ang);
}

__global__ void k_lambda(const float* __restrict__ da_lambda, float* __restrict__ lamfull) {
    int l = threadIdx.x;
    if (l >= 2) return;
    const float* lam = da_lambda + l * 128;
    double s1 = 0, s2 = 0;
    for (int i = 0; i < 32; ++i) { s1 += (double)lam[i] * lam[32 + i]; s2 += (double)lam[64 + i] * lam[96 + i]; }
    double lambda_init = 0.8 - 0.6 * exp(-0.3 * l);
    lamfull[l] = (float)(exp(s1) - exp(s2) + lambda_init);
}

__global__ void k_s5_disc(const float* __restrict__ a_re, const float* __restrict__ a_im, const float* __restrict__ log_step,
                          const float* __restrict__ b_re, const float* __restrict__ b_im,
                          float* __restrict__ abr, float* __restrict__ abi, float* __restrict__ bbr, float* __restrict__ bbi) {
    int i = blockIdx.x * 256 + threadIdx.x;
    if (i >= 2 * 2 * 16 * 64) return;
    int ldg = i >> 6;
    double ar = fmin((double)a_re[i], -1e-4), ai = (double)a_im[i];
    double dt = exp((double)log_step[ldg]);
    double mag = exp(dt * ar);
    double er = mag * cos(dt * ai), ei = mag * sin(dt * ai);
    double inv = 1.0 / (ar * ar + ai * ai);
    double fr = ((er - 1.0) * ar + ei * ai) * inv;
    double fi = (ei * ar - (er - 1.0) * ai) * inv;
    abr[i] = (float)er; abi[i] = (float)ei;
    for (int h = 0; h < 16; ++h) {
        double br = b_re[(size_t)i * 16 + h], bi = b_im[(size_t)i * 16 + h];
        bbr[(size_t)i * 16 + h] = (float)(fr * br - fi * bi);
        bbi[(size_t)i * 16 + h] = (float)(fr * bi + fi * br);
    }
}

__global__ __launch_bounds__(256) void k_norm_mod(const float* __restrict__ xall, const float* __restrict__ nw, const float* __restrict__ modl  ,
                                                  int shift_off, int scale_off, float* __restrict__ out) {
    __shared__ float red[8];
    int t = blockIdx.x; int b = t / NT, n = t % NT; int r = (n < NC) ? 8 : b;
    const float4 xv = ((const float4*)(xall + (size_t)t * DM))[threadIdx.x];
    float ss = xv.x * xv.x + xv.y * xv.y + xv.z * xv.z + xv.w * xv.w;
    ss = block_sum_256(ss, red);
    float rstd = rsqrtf(ss * (1.f / DM) + 1e-6f);
    int d = threadIdx.x * 4;
    const float4 w = *(const float4*)(nw + d);
    const float4 sc = *(const float4*)(modl + (size_t)r * 6144 + scale_off + d);
    const float4 sh = *(const float4*)(modl + (size_t)r * 6144 + shift_off + d);
    float4 o;
    o.x = xv.x * rstd * w.x * (1.f + sc.x) + sh.x;
    o.y = xv.y * rstd * w.y * (1.f + sc.y) + sh.y;
    o.z = xv.z * rstd * w.z * (1.f + sc.z) + sh.z;
    o.w = xv.w * rstd * w.w * (1.f + sc.w) + sh.w;
    ((float4*)(out + (size_t)t * DM))[threadIdx.x] = o;
}

struct GemmArgs {
    const float* A; const float* B; float* C; const float* bias;
    int M, N, K, lda, ldb, ldc;
    const int* gather;
    const int* tile_e;
    const int* tile_m0;
    const int* grp_end;
    const int* ntiles;
    long strideB, strideBias;
};

template <int MODE>
__global__ __launch_bounds__(256) void k_gemm(GemmArgs g) {
    __shared__ float As[16][68];
    __shared__ float Bs[16][64];
    __shared__ float Bs2[MODE == 1 ? 16 : 1][64];
    const float* B = g.B; const float* bias = g.bias;
    int m0, mend;
    if (g.tile_e) {
        int ty = blockIdx.y;
        if (ty >= g.ntiles[0]) return;
        int e = g.tile_e[ty];
        m0 = g.tile_m0[ty]; mend = g.grp_end[e];
        B += (size_t)e * g.strideB; if (bias) bias += (size_t)e * g.strideBias;
    } else { m0 = blockIdx.y * 64; mend = g.M; if (m0 >= mend) return; }
    int n0 = blockIdx.x * 64;
    int tx = threadIdx.x & 15, ty_ = threadIdx.x >> 4;
    float acc[4][4], acc2[4][4];
#pragma unroll
    for (int i = 0; i < 4; ++i)
#pragma unroll
        for (int j = 0; j < 4; ++j) { acc[i][j] = 0.f; acc2[i][j] = 0.f; }
    int ar = threadIdx.x >> 2, ak = (threadIdx.x & 3) * 4;
    int arow_slot = m0 + ar; bool avalid = arow_slot < mend;
    long arow = avalid ? (g.gather ? (long)g.gather[arow_slot] : (long)arow_slot) : 0;
    const float* Ap = g.A + arow * g.lda + ak;
    int bk = threadIdx.x >> 4, bn = (threadIdx.x & 15) * 4;
    for (int k0 = 0; k0 < g.K; k0 += 16) {
        float4 av = avalid ? *(const float4*)(Ap + k0) : make_float4(0.f, 0.f, 0.f, 0.f);
        As[ak + 0][ar] = av.x; As[ak + 1][ar] = av.y; As[ak + 2][ar] = av.z; As[ak + 3][ar] = av.w;
        const float* Bp = B + (size_t)(k0 + bk) * g.ldb + n0 + bn;
#pragma unroll
        for (int q = 0; q < 4; ++q) Bs[bk][bn + q] = (n0 + bn + q < g.N) ? Bp[q] : 0.f;
        if (MODE == 1) {
#pragma unroll
            for (int q = 0; q < 4; ++q) Bs2[bk][bn + q] = (n0 + bn + q < g.N) ? Bp[g.N + q] : 0.f;
        }
        __syncthreads();
#pragma unroll
        for (int kk = 0; kk < 16; ++kk) {
            float a[4], b[4];
#pragma unroll
            for (int i = 0; i < 4; ++i) a[i] = As[kk][ty_ * 4 + i];
#pragma unroll
            for (int j = 0; j < 4; ++j) b[j] = Bs[kk][tx * 4 + j];
#pragma unroll
            for (int i = 0; i < 4; ++i)
#pragma unroll
                for (int j = 0; j < 4; ++j) acc[i][j] += a[i] * b[j];
            if (MODE == 1) {
                float b2[4];
#pragma unroll
                for (int j = 0; j < 4; ++j) b2[j] = Bs2[kk][tx * 4 + j];
#pragma unroll
                for (int i = 0; i < 4; ++i)
#pragma unroll
                    for (int j = 0; j < 4; ++j) acc2[i][j] += a[i] * b2[j];
            }
        }
        __syncthreads();
    }
#pragma unroll
    for (int i = 0; i < 4; ++i) {
        int slot = m0 + ty_ * 4 + i;
        if (slot >= mend) continue;
#pragma unroll
        for (int j = 0; j < 4; ++j) {
            int n = n0 + tx * 4 + j;
            if (n >= g.N) continue;
            float v = acc[i][j] + (bias ? bias[n] : 0.f);
            if (MODE == 1) {
                float up = acc2[i][j] + (bias ? bias[g.N + n] : 0.f);
                float gate = fminf(v, 7.f);
                up = fminf(fmaxf(up, -7.f), 7.f);
                v = (up + 1.f) * gate * sigmoidf_(1.702f * gate);
            }
            g.C[(size_t)slot * g.ldc + n] = v;
        }
    }
}

__global__ __launch_bounds__(256) void k_da_prep(const float* __restrict__ p, const float* __restrict__ cs, float* __restrict__ Q, float* __restrict__ K, float* __restrict__ V) {
    int t = blockIdx.x; int b = t / NT, n = t % NT;
    int c = threadIdx.x;
    int h = c >> 6, r = c & 63, d = r & 31;
    const float* pr = p + (size_t)t * DIN;
    size_t o = (((size_t)b * 4 + h) * NT + n) * 64 + r;
    float qv = pr[P_DAQ + c], kv = pr[P_DAK + c];
    if (n >= NC) {
        int pos = n - NC; int j = d & 15;
        float co = cs[(pos * 16 + j) * 2], si = cs[(pos * 16 + j) * 2 + 1];
        int cp = (d < 16) ? c + 16 : c - 16;
        float qo = pr[P_DAQ + cp], ko = pr[P_DAK + cp];
        if (d < 16) { qv = qv * co - qo * si; kv = kv * co - ko * si; }
        else        { qv = qv * co + qo * si; kv = kv * co + ko * si; }
    }
    Q[o] = qv; K[o] = kv; V[o] = pr[P_DAV + c];
}

template <int QKD, int NMAP, int DV, bool DA>
__global__ __launch_bounds__(64) void k_attn(const float* __restrict__ Q, const float* __restrict__ K, const float* __restrict__ V,
                                             float* __restrict__ ycat, int ycat_off, const float* __restrict__ lamfull,
                                             const float* __restrict__ subln, float post_scale, float scale, int with_ctx) {
    constexpr int DK = QKD / NMAP;
    __shared__ float Ks[32][QKD];
    __shared__ float Vs[32][DV];
    int qb = blockIdx.x, h = blockIdx.y, b = blockIdx.z;
    bool isctx = qb < (NC / 64);
    if (isctx && !with_ctx) return;
    int nkeys = isctx ? NC : NT;
    int n = qb * 64 + threadIdx.x;
    size_t base = ((size_t)b * 4 + h) * NT;
    float q[QKD];
    const float* qp = Q + (base + n) * QKD;
#pragma unroll
    for (int d = 0; d < QKD; d += 4) { float4 v = *(const float4*)(qp + d); q[d] = v.x * scale; q[d + 1] = v.y * scale; q[d + 2] = v.z * scale; q[d + 3] = v.w * scale; }
    float acc[NMAP][DV]; float mx[NMAP], l[NMAP];
#pragma unroll
    for (int m = 0; m < NMAP; ++m) { mx[m] = -1e30f; l[m] = 0.f;
#pragma unroll
        for (int d = 0; d < DV; ++d) acc[m][d] = 0.f; }
    for (int k0 = 0; k0 < nkeys; k0 += 32) {
        __syncthreads();
        for (int i = threadIdx.x; i < 32 * QKD / 4; i += 64) {
            int kr = i / (QKD / 4), kc = (i % (QKD / 4)) * 4;
            *(float4*)&Ks[kr][kc] = *(const float4*)(K + (base + k0 + kr) * QKD + kc);
        }
        for (int i = threadIdx.x; i < 32 * DV / 4; i += 64) {
            int kr = i / (DV / 4), kc = (i % (DV / 4)) * 4;
            *(float4*)&Vs[kr][kc] = *(const float4*)(V + (base + k0 + kr) * DV + kc);
        }
        __syncthreads();
        for (int j = 0; j < 32; ++j) {
#pragma unroll
            for (int m = 0; m < NMAP; ++m) {
                float s = 0.f;
#pragma unroll
                for (int d = 0; d < DK; ++d) s += q[m * DK + d] * Ks[j][m * DK + d];
                float mn = fmaxf(mx[m], s);
                float alpha = __expf(mx[m] - mn);
                float pv = __expf(s - mn);
                mx[m] = mn;
                l[m] = l[m] * alpha + pv;
#pragma unroll
                for (int d = 0; d < DV; ++d) acc[m][d] = acc[m][d] * alpha + pv * Vs[j][d];
            }
        }
    }
    float o[DV];
    float c1 = 1.f;
#pragma unroll
    for (int d = 0; d < DV; ++d) o[d] = acc[0][d] / l[0];
    if (NMAP == 2) {
        c1 = -lamfull[0];
#pragma unroll
        for (int d = 0; d < DV; ++d) o[d] += c1 * acc[NMAP - 1][d] / l[NMAP - 1];
    }
    if (DA) {
        float ss = 0.f;
#pragma unroll
        for (int d = 0; d < DV; ++d) ss += o[d] * o[d];
        float rstd = rsqrtf(ss * (1.f / DV) + 1e-6f) * post_scale;
#pragma unroll
        for (int d = 0; d < DV; ++d) o[d] = o[d] * rstd * subln[d];
    }
    float* yp = ycat + ((size_t)b * NT + n) * DM + ycat_off + h * DV;
#pragma unroll
    for (int d = 0; d < DV; d += 4) *(float4*)(yp + d) = make_float4(o[d], o[d + 1], o[d + 2], o[d + 3]);
}

__global__ __launch_bounds__(64) void k_mla_norm(const float* __restrict__ p, const float* __restrict__ qn, const float* __restrict__ kvn,
                                                 float* __restrict__ cqn, float* __restrict__ ckvn) {
    int t = blockIdx.x; int lane = threadIdx.x;
    const float* pr = p + (size_t)t * DIN;
    float v0 = pr[P_CQ + lane], v1 = pr[P_CQ + 64 + lane], v2 = pr[P_CQ + 128 + lane];
    float ss = v0 * v0 + v1 * v1 + v2 * v2;
    for (int o = 32; o > 0; o >>= 1) ss += __shfl_xor(ss, o);
    float r = rsqrtf(ss * (1.f / 192.f) + 1e-6f);
    cqn[(size_t)t * 192 + lane] = v0 * r * qn[lane];
    cqn[(size_t)t * 192 + 64 + lane] = v1 * r * qn[64 + lane];
    cqn[(size_t)t * 192 + 128 + lane] = v2 * r * qn[128 + lane];
    float w0 = pr[P_CKV + lane], w1 = pr[P_CKV + 64 + lane];
    float s2 = w0 * w0 + w1 * w1;
    for (int o = 32; o > 0; o >>= 1) s2 += __shfl_xor(s2, o);
    float r2 = rsqrtf(s2 * (1.f / 128.f) + 1e-6f);
    ckvn[(size_t)t * 128 + lane] = w0 * r2 * kvn[lane];
    ckvn[(size_t)t * 128 + 64 + lane] = w1 * r2 * kvn[64 + lane];
}

__global__ __launch_bounds__(128) void k_mla_layout(const float* __restrict__ p, const float* __restrict__ qfull  , const float* __restrict__ kvfull  ,
                                                    const float* __restrict__ cs, float* __restrict__ Q, float* __restrict__ K, float* __restrict__ V) {
    int t = blockIdx.x; int b = t / NT, n = t % NT;
    const float* pr = p + (size_t)t * DIN;
    const float* qf = qfull + (size_t)t * 384;
    const float* kf = kvfull + (size_t)t * 512;
    for (int i = threadIdx.x; i < 4 * 96; i += 128) {
        int h = i / 96, j = i % 96;
        size_t o = (((size_t)b * 4 + h) * NT + n) * 96 + j;
        float qv, kv;
        if (j < 64) { qv = qf[h * 96 + j]; kv = kf[h * 128 + j]; }
        else {
            int d = j - 64;
            qv = qf[h * 96 + j]; kv = pr[P_KR + d];
            if (n >= NC) {
                int pos = n - NC; int jj = d & 15;
                float co = cs[(pos * 16 + jj) * 2], si = cs[(pos * 16 + jj) * 2 + 1];
                int dp = (d < 16) ? d + 16 : d - 16;
                float qo = qf[h * 96 + 64 + dp], ko = pr[P_KR + dp];
                if (d < 16) { qv = qv * co - qo * si; kv = kv * co - ko * si; }
                else        { qv = qv * co + qo * si; kv = kv * co + ko * si; }
            }
        }
        Q[o] = qv; K[o] = kv;
    }
    for (int i = threadIdx.x; i < 4 * 64; i += 128) {
        int h = i / 64, j = i % 64;
        V[(((size_t)b * 4 + h) * NT + n) * 64 + j] = kf[h * 128 + 64 + j];
    }
}

__global__ __launch_bounds__(256) void k_ml_prep(const float* __restrict__ p, const float* __restrict__ conv_w  , const float* __restrict__ conv_b,
                                                 const float* __restrict__ gate_b, float* __restrict__ qk  , float* __restrict__ G  ) {
    int t = blockIdx.x; int n = t % NT;
    int seg_lo = (n < NC) ? 0 : NC, seg_hi = (n < NC) ? NC - 1 : NT - 1;
    for (int c = threadIdx.x; c < 512; c += 256) {
        float y = conv_b[c];
#pragma unroll
        for (int j = 0; j < 3; ++j) {
            int nn = n + j - 1;
            if (nn >= seg_lo && nn <= seg_hi) y += p[(size_t)(t + j - 1) * DIN + P_MLQK + c] * conv_w[j * 512 + c];
        }
        y = siluf_(y);
        if (c >= 256) y *= 0.125f;
        qk[(size_t)t * 512 + c] = y;
    }
    if (threadIdx.x < 16) {
        int gi = threadIdx.x >> 2;
        float g = p[(size_t)t * DIN + P_MLG + threadIdx.x] + gate_b[threadIdx.x];
        if (gi & 1) g = logsigmoidf_(g);
        G[(size_t)t * 16 + threadIdx.x] = g;
    }
}

__device__ __forceinline__ int seq_token(int s, int dir) {
    if (dir == 0) return s;
    return (s < NC) ? (NC - 1 - s) : (NC + (NT - 1 - s));
}

__global__ __launch_bounds__(256) void k_mlstm(const float* __restrict__ qk, const float* __restrict__ p, const float* __restrict__ G, float* __restrict__ hdir  ) {
    __shared__ float sq[64][64], sk[64][64], sv[64][64], sa[64], sf[64];
    int h = blockIdx.x, b = blockIdx.y, dir = blockIdx.z;
    int tid = threadIdx.x, vrow = tid >> 2, part = tid & 3;
    float C[16], nn[16];
#pragma unroll
    for (int i = 0; i < 16; ++i) { C[i] = 0.f; nn[i] = 0.f; }
    for (int s0 = 0; s0 < NT; s0 += 64) {
        __syncthreads();
        for (int i = tid; i < 64 * 64; i += 256) {
            int j = i >> 6, d = i & 63;
            int n = seq_token(s0 + j, dir);
            size_t t = (size_t)b * NT + n;
            sq[j][d] = qk[t * 512 + h * 64 + d];
            sk[j][d] = qk[t * 512 + 256 + h * 64 + d];
            sv[j][d] = p[t * DIN + P_MLV + h * 64 + d];
        }
        if (tid < 64) {
            int n = seq_token(s0 + tid, dir);
            size_t t = (size_t)b * NT + n;
            sa[tid] = __expf(G[t * 16 + (dir * 2) * 4 + h]);
            sf[tid] = __expf(G[t * 16 + (dir * 2 + 1) * 4 + h]);
        }
        __syncthreads();
        for (int j = 0; j < 64; ++j) {
            float a = sa[j], f = sf[j], vv = sv[j][vrow];
            float av = a * vv;
            float num = 0.f, den = 0.f;
#pragma unroll
            for (int i = 0; i < 16; ++i) {
                float kk = sk[j][part * 16 + i], qq = sq[j][part * 16 + i];
                C[i] = f * C[i] + av * kk;
                nn[i] = f * nn[i] + a * kk;
                num += C[i] * qq; den += nn[i] * qq;
            }
            num += __shfl_xor(num, 1); num += __shfl_xor(num, 2);
            den += __shfl_xor(den, 1); den += __shfl_xor(den, 2);
            if (part == 0) {
                int n = seq_token(s0 + j, dir);
                hdir[((size_t)dir * TT + (size_t)b * NT + n) * 256 + h * 64 + vrow] = num / fmaxf(fabsf(den), 1.f);
            }
        }
    }
}

__global__ __launch_bounds__(256) void k_ml_finish(const float* __restrict__ p, const float* __restrict__ hdir, const float* __restrict__ ml_norm, float* __restrict__ ycat) {
    int t = blockIdx.x; int c = threadIdx.x;
    float o = p[(size_t)t * DIN + P_MLO + c];
    float hv = sigmoidf_(o) * (hdir[(size_t)t * 256 + c] + hdir[((size_t)TT + t) * 256 + c]);
    float ss = hv * hv;
    for (int off = 32; off > 0; off >>= 1) ss += __shfl_xor(ss, off);
    float r = rsqrtf(ss * (1.f / 64.f) + 1e-6f);
    ycat[(size_t)t * DM + 256 + c] = hv * r * ml_norm[c];
}

__global__ __launch_bounds__(64) void k_s5_scan(const float* __restrict__ p, const float* __restrict__ abr, const float* __restrict__ abi,
                                                const float* __restrict__ bbr, const float* __restrict__ bbi,
                                                const float* __restrict__ c_re, const float* __restrict__ c_im, float* __restrict__ ys5  ) {
    __shared__ float su[64][16];
    __shared__ float xs[64][129];
    __shared__ float cr[16][64], ci[16][64];
    int g = blockIdx.x, b = blockIdx.y, dir = blockIdx.z;
    int lane = threadIdx.x;
    int sidx = (dir * 16 + g) * 64 + lane;
    float ar = abr[sidx], ai = abi[sidx];
    float br[16], bi[16];
#pragma unroll
    for (int h = 0; h < 16; ++h) { br[h] = bbr[(size_t)sidx * 16 + h]; bi[h] = bbi[(size_t)sidx * 16 + h]; }
    for (int i = lane; i < 16 * 64; i += 64) { cr[i >> 6][i & 63] = c_re[(size_t)(dir * 16 + g) * 1024 + i]; ci[i >> 6][i & 63] = c_im[(size_t)(dir * 16 + g) * 1024 + i]; }
    float xr = 0.f, xi = 0.f;
    for (int s0 = 0; s0 < NT; s0 += 64) {
        __syncthreads();
        for (int i = lane; i < 64 * 16; i += 64) {
            int j = i >> 4, hh = i & 15;
            int n = seq_token(s0 + j, dir);
            su[j][hh] = p[((size_t)b * NT + n) * DIN + P_S5 + g * 16 + hh];
        }
        __syncthreads();
#pragma unroll 1
        for (int j = 0; j < 64; ++j) {
            float ur = 0.f, ui = 0.f;
#pragma unroll
            for (int hh = 0; hh < 16; ++hh) { float u = su[j][hh]; ur += br[hh] * u; ui += bi[hh] * u; }
            float nr = ar * xr - ai * xi + ur;
            float ni = ar * xi + ai * xr + ui;
            xr = nr; xi = ni;
            xs[j][lane] = xr; xs[j][64 + lane] = xi;
        }
        __syncthreads();
        {
            int n = seq_token(s0 + lane, dir);
            float* yp = ys5 + ((size_t)dir * TT + (size_t)b * NT + n) * 256 + g * 16;
#pragma unroll 1
            for (int hh = 0; hh < 16; ++hh) {
                float y = 0.f;
#pragma unroll 4
                for (int pp = 0; pp < 64; ++pp) y += cr[hh][pp] * xs[lane][pp] - ci[hh][pp] * xs[lane][64 + pp];
                yp[hh] = y;
            }
        }
    }
}

__device__ __forceinline__ float gelu_tanh_(float x) {
    float u = 0.7978845608028654f * (x + 0.044715f * x * x * x);
    return 0.5f * x * (1.f + tanhf(u));
}
__global__ __launch_bounds__(256) void k_s5_gelu(const float* __restrict__ p, const float* __restrict__ ys5, const float* __restrict__ dsk, float* __restrict__ gl  ) {
    int t = blockIdx.x, c = threadIdx.x;
    float y = ys5[(size_t)t * 256 + c] + ys5[((size_t)TT + t) * 256 + c] + p[(size_t)t * DIN + P_S5 + c] * dsk[c];
    gl[(size_t)t * 256 + c] = gelu_tanh_(y);
}
__global__ __launch_bounds__(256) void k_s5_glu(const float* __restrict__ gl, const float* __restrict__ z, float* __restrict__ ycat) {
    int t = blockIdx.x, c = threadIdx.x;
    ycat[(size_t)t * DM + 768 + c] = gl[(size_t)t * 256 + c] * sigmoidf_(z[(size_t)t * 256 + c]);
}

__global__ __launch_bounds__(256) void k_post1(float* __restrict__ xall, const float* __restrict__ o, const float* __restrict__ nw1, const float* __restrict__ nw2,
                                               const float* __restrict__ modl, const float* __restrict__ w_router  , const float* __restrict__ b_router,
                                               float* __restrict__ f, int* __restrict__ top_e  , float* __restrict__ top_g  , int* __restrict__ cnt,
                                               int* __restrict__ pos  , int with_ctx) {
    __shared__ float red[8];
    __shared__ float lg[4][32];
    int t = blockIdx.x; int b = t / NT, n = t % NT;
    if (n < NC && !with_ctx) return;
    int r = (n < NC) ? 8 : b;
    const float* mr = modl + (size_t)r * 6144;
    int d = threadIdx.x * 4;
    float4 ov = *(const float4*)(o + (size_t)t * DM + d);
    float ss = ov.x * ov.x + ov.y * ov.y + ov.z * ov.z + ov.w * ov.w;
    ss = block_sum_256(ss, red);
    float rstd = rsqrtf(ss * (1.f / DM) + 1e-6f);
    float4 xv = *(const float4*)(xall + (size_t)t * DM + d);
    float4 w1 = *(const float4*)(nw1 + d);
    float4 g1 = *(const float4*)(mr + 2048 + d);
    xv.x += g1.x * ov.x * rstd * w1.x; xv.y += g1.y * ov.y * rstd * w1.y; xv.z += g1.z * ov.z * rstd * w1.z; xv.w += g1.w * ov.w * rstd * w1.w;
    *(float4*)(xall + (size_t)t * DM + d) = xv;
    float s2 = xv.x * xv.x + xv.y * xv.y + xv.z * xv.z + xv.w * xv.w;
    s2 = block_sum_256(s2, red);
    float rstd2 = rsqrtf(s2 * (1.f / DM) + 1e-6f);
    float4 w2 = *(const float4*)(nw2 + d);
    float4 sh = *(const float4*)(mr + 3072 + d);
    float4 sc = *(const float4*)(mr + 4096 + d);
    float fv[4];
    fv[0] = xv.x * rstd2 * w2.x * (1.f + sc.x) + sh.x;
    fv[1] = xv.y * rstd2 * w2.y * (1.f + sc.y) + sh.y;
    fv[2] = xv.z * rstd2 * w2.z * (1.f + sc.z) + sh.z;
    fv[3] = xv.w * rstd2 * w2.w * (1.f + sc.w) + sh.w;
    *(float4*)(f + (size_t)t * DM + d) = make_float4(fv[0], fv[1], fv[2], fv[3]);
    float part[32];
#pragma unroll
    for (int e = 0; e < 32; ++e) part[e] = 0.f;
#pragma unroll
    for (int q = 0; q < 4; ++q) {
        const float* wr = w_router + (size_t)(d + q) * 32;
#pragma unroll
        for (int e = 0; e < 32; ++e) part[e] += fv[q] * wr[e];
    }
#pragma unroll
    for (int e = 0; e < 32; ++e) {
        float v = part[e];
        for (int off = 32; off > 0; off >>= 1) v += __shfl_xor(v, off);
        part[e] = v;
    }
    __syncthreads();
    if ((threadIdx.x & 63) == 0) {
#pragma unroll
        for (int e = 0; e < 32; ++e) lg[threadIdx.x >> 6][e] = part[e];
    }
    __syncthreads();
    if (threadIdx.x < 32) lg[0][threadIdx.x] = lg[0][threadIdx.x] + lg[1][threadIdx.x] + lg[2][threadIdx.x] + lg[3][threadIdx.x] + b_router[threadIdx.x];
    __syncthreads();
    if (threadIdx.x == 0) {
        unsigned used = 0;
        int s0 = 0, s1 = 0, s2_ = 0, s3 = 0; float v0 = 0.f, v1 = 0.f, v2 = 0.f, v3 = 0.f;
        for (int k = 0; k < 4; ++k) {
            int best = 0; float bv = -3.4e38f;
            for (int e = 0; e < 32; ++e) { float lv = lg[0][e]; if (!((used >> e) & 1u) && lv > bv) { bv = lv; best = e; } }
            used |= 1u << best;
            if (k == 0) { s0 = best; v0 = bv; } else if (k == 1) { s1 = best; v1 = bv; } else if (k == 2) { s2_ = best; v2 = bv; } else { s3 = best; v3 = bv; }
        }
        float e0 = 1.f, e1 = __expf(v1 - v0), e2 = __expf(v2 - v0), e3 = __expf(v3 - v0);
        float inv = 1.f / (e0 + e1 + e2 + e3);
        top_e[(size_t)t * 4 + 0] = s0; top_e[(size_t)t * 4 + 1] = s1; top_e[(size_t)t * 4 + 2] = s2_; top_e[(size_t)t * 4 + 3] = s3;
        top_g[(size_t)t * 4 + 0] = e0 * inv; top_g[(size_t)t * 4 + 1] = e1 * inv; top_g[(size_t)t * 4 + 2] = e2 * inv; top_g[(size_t)t * 4 + 3] = e3 * inv;
        pos[(size_t)t * 4 + 0] = atomicAdd(&cnt[s0], 1); pos[(size_t)t * 4 + 1] = atomicAdd(&cnt[s1], 1);
        pos[(size_t)t * 4 + 2] = atomicAdd(&cnt[s2_], 1); pos[(size_t)t * 4 + 3] = atomicAdd(&cnt[s3], 1);
    }
}

__global__ void k_moe_offsets(const int* __restrict__ cnt, int* __restrict__ off, int* __restrict__ grp_end, int* __restrict__ tile_e, int* __restrict__ tile_m0, int* __restrict__ ntiles) {
    if (threadIdx.x != 0) return;
    int o = 0, nt = 0;
    for (int e = 0; e < NE; ++e) {
        off[e] = o; int c = cnt[e];
        for (int m = 0; m < c; m += 64) { tile_e[nt] = e; tile_m0[nt] = o + m; ++nt; }
        o += c; grp_end[e] = o;
    }
    ntiles[0] = nt;
}
__global__ void k_moe_scatter(const int* __restrict__ top_e, const int* __restrict__ pos, const int* __restrict__ off, int* __restrict__ slot_token, int* __restrict__ tok_slot, int with_ctx) {
    int i = blockIdx.x * 256 + threadIdx.x;
    if (i >= NASSIGN) return;
    int t = i >> 2; int n = t % NT;
    if (n < NC && !with_ctx) return;
    int slot = off[top_e[i]] + pos[i];
    slot_token[slot] = t; tok_slot[i] = slot;
}

__global__ __launch_bounds__(256) void k_combine(float* __restrict__ xall, const float* __restrict__ yexp, const int* __restrict__ tok_slot, const float* __restrict__ top_g,
                                                 const float* __restrict__ nw3, const float* __restrict__ modl, int with_ctx) {
    __shared__ float red[8];
    int t = blockIdx.x; int b = t / NT, n = t % NT;
    if (n < NC && !with_ctx) return;
    int r = (n < NC) ? 8 : b;
    int d = threadIdx.x * 4;
    float4 m = make_float4(0.f, 0.f, 0.f, 0.f);
#pragma unroll
    for (int k = 0; k < 4; ++k) {
        int slot = tok_slot[(size_t)t * 4 + k]; float gk = top_g[(size_t)t * 4 + k];
        float4 y = *(const float4*)(yexp + (size_t)slot * DM + d);
        m.x += gk * y.x; m.y += gk * y.y; m.z += gk * y.z; m.w += gk * y.w;
    }
    float ss = m.x * m.x + m.y * m.y + m.z * m.z + m.w * m.w;
    ss = block_sum_256(ss, red);
    float rstd = rsqrtf(ss * (1.f / DM) + 1e-6f);
    float4 w3 = *(const float4*)(nw3 + d);
    float4 g2 = *(const float4*)(modl + (size_t)r * 6144 + 5120 + d);
    float4 xv = *(const float4*)(xall + (size_t)t * DM + d);
    xv.x += g2.x * m.x * rstd * w3.x; xv.y += g2.y * m.y * rstd * w3.y; xv.z += g2.z * m.z * rstd * w3.z; xv.w += g2.w * m.w * rstd * w3.w;
    *(float4*)(xall + (size_t)t * DM + d) = xv;
}

__global__ void k_out(const float* __restrict__ xall, float* __restrict__ out) {
    size_t i = (size_t)blockIdx.x * 256 + threadIdx.x;
    size_t total = (size_t)NB * NS * DM / 4;
    if (i >= total) return;
    size_t t = i / (DM / 4); int d4 = (int)(i % (DM / 4));
    int b = (int)(t / NS), n = (int)(t % NS);
    ((float4*)out)[i] = ((const float4*)(xall + ((size_t)b * NT + NC + n) * DM))[d4];
}

static void launch_gemm(hipStream_t st, const float* A, int lda, const float* B, int ldb, float* C, int ldc, const float* bias, int M, int N, int K) {
    GemmArgs g{}; g.A = A; g.B = B; g.C = C; g.bias = bias; g.M = M; g.N = N; g.K = K; g.lda = lda; g.ldb = ldb; g.ldc = ldc;
    dim3 grid((N + 63) / 64, (M + 63) / 64);
    k_gemm<0><<<grid, 256, 0, st>>>(g);
}

extern "C" void kernel_launch(void* const* d_in, const int* in_sizes, int n_in, void* d_out, int out_size, void* d_ws, size_t ws_size, hipStream_t stream) {
    const float* x = (const float*)d_in[0]; const float* c = (const float*)d_in[1]; const float* ctx = (const float*)d_in[2]; const float* c_ctx = (const float*)d_in[3];
    const float* w_mod = (const float*)d_in[4]; const float* b_mod = (const float*)d_in[5]; const float* norm_w = (const float*)d_in[6];
    const float* w_in = (const float*)d_in[7]; const float* w_out = (const float*)d_in[8]; const float* da_lambda = (const float*)d_in[9]; const float* da_subln = (const float*)d_in[10];
    const float* ml_conv_w = (const float*)d_in[11]; const float* ml_conv_b = (const float*)d_in[12]; const float* ml_gate_b = (const float*)d_in[13]; const float* ml_norm = (const float*)d_in[14];
    const float* mla_q_norm = (const float*)d_in[15]; const float* mla_w_uq = (const float*)d_in[16]; const float* mla_kv_norm = (const float*)d_in[17]; const float* mla_w_ukv = (const float*)d_in[18];
    const float* s5_a_re = (const float*)d_in[19]; const float* s5_a_im = (const float*)d_in[20]; const float* s5_log_step = (const float*)d_in[21];
    const float* s5_b_re = (const float*)d_in[22]; const float* s5_b_im = (const float*)d_in[23]; const float* s5_c_re = (const float*)d_in[24]; const float* s5_c_im = (const float*)d_in[25];
    const float* s5_d = (const float*)d_in[26]; const float* s5_w_glu = (const float*)d_in[27]; const float* s5_b_glu = (const float*)d_in[28];
    const float* moe_w_router = (const float*)d_in[29]; const float* moe_b_router = (const float*)d_in[30]; const float* moe_w_gate_up = (const float*)d_in[31];
    const float* moe_b_gate_up = (const float*)d_in[32]; const float* moe_w_down = (const float*)d_in[33]; const float* moe_b_down = (const float*)d_in[34];
    float* out = (float*)d_out;

    char* ws = (char*)d_ws; size_t off = 0;
    auto carve = [&](size_t bytes) { void* p = ws + off; off += (bytes + 255) & ~(size_t)255; return p; };
    float* xall = (float*)carve((size_t)TT * DM * 4);
    float* mod = (float*)carve((size_t)2 * 9 * 6144 * 4);
    float* ropecs = (float*)carve((size_t)NS * 16 * 2 * 4);
    float* lamfull = (float*)carve(256);
    float* abr = (float*)carve(4096 * 4); float* abi = (float*)carve(4096 * 4);
    float* bbr = (float*)carve(4096 * 16 * 4); float* bbi = (float*)carve(4096 * 16 * 4);
    float* hbuf = (float*)carve((size_t)TT * DM * 4);
    float* p = (float*)carve((size_t)TT * DIN * 4);
    float* daQ = (float*)carve((size_t)TT * 256 * 4); float* daK = (float*)carve((size_t)TT * 256 * 4); float* daV = (float*)carve((size_t)TT * 256 * 4);
    float* cqn = (float*)carve((size_t)TT * 192 * 4); float* ckvn = (float*)carve((size_t)TT * 128 * 4);
    float* qfull = (float*)carve((size_t)TT * 384 * 4); float* kvfull = (float*)carve((size_t)TT * 512 * 4);
    float* mQ = (float*)carve((size_t)TT * 384 * 4); float* mK = (float*)carve((size_t)TT * 384 * 4); float* mV = (float*)carve((size_t)TT * 256 * 4);
    float* mlqk = (float*)carve((size_t)TT * 512 * 4); float* mlG = (float*)carve((size_t)TT * 16 * 4); float* hdir = (float*)carve((size_t)2 * TT * 256 * 4);
    float* ys5 = (float*)carve((size_t)2 * TT * 256 * 4); float* gl = (float*)carve((size_t)TT * 256 * 4); float* zglu = (float*)carve((size_t)TT * 256 * 4);
    float* ycat = (float*)carve((size_t)TT * DM * 4);
    float* obuf = (float*)carve((size_t)TT * DM * 4);
    float* fbuf = (float*)carve((size_t)TT * DM * 4);
    int* top_e = (int*)carve((size_t)NASSIGN * 4); float* top_g = (float*)carve((size_t)NASSIGN * 4); int* posb = (int*)carve((size_t)NASSIGN * 4);
    int* tok_slot = (int*)carve((size_t)NASSIGN * 4); int* slot_token = (int*)carve((size_t)NASSIGN * 4);
    int* cnt = (int*)carve(256); int* offs = (int*)carve(256); int* grp_end = (int*)carve(256); int* ntiles = (int*)carve(256);
    int* tile_e = (int*)carve(MAXTILES * 4); int* tile_m0 = (int*)carve(MAXTILES * 4);
    float* act = (float*)carve((size_t)NASSIGN * DM * 4);
    float* yexp = (float*)carve((size_t)NASSIGN * DM * 4);
    if (off > ws_size) { fprintf(stderr, "workspace too small: need %zu have %zu\n", off, ws_size); return; }

    k_build_x<<<(TT * DM / 4 + 255) / 256, 256, 0, stream>>>(x, ctx, xall);
    k_mod<<<2 * 6144 / 256, 256, 0, stream>>>(c, c_ctx, w_mod, b_mod, mod);
    k_rope_table<<<NS * 16 / 256, 256, 0, stream>>>(ropecs);
    k_lambda<<<1, 64, 0, stream>>>(da_lambda, lamfull);
    k_s5_disc<<<4096 / 256, 256, 0, stream>>>(s5_a_re, s5_a_im, s5_log_step, s5_b_re, s5_b_im, abr, abi, bbr, bbi);

    for (int l = 0; l < 2; ++l) {
        int with_ctx = (l == 0);
        float lambda_init = (float)(0.8 - 0.6 * exp(-0.3 * l));
        const float* modl = mod + (size_t)l * 9 * 6144;
        const float* nw = norm_w + (size_t)l * 4 * 1024;
        k_norm_mod<<<TT, 256, 0, stream>>>(xall, nw, modl, 0, 1024, hbuf);
        launch_gemm(stream, hbuf, DM, w_in + (size_t)l * DM * DIN, DIN, p, DIN, nullptr, TT, DIN, DM);
        k_da_prep<<<TT, 256, 0, stream>>>(p, ropecs, daQ, daK, daV);
        k_attn<64, 2, 64, true><<<dim3(NT / 64, 4, NB), 64, 0, stream>>>(daQ, daK, daV, ycat, 0, lamfull + l, da_subln + l * 64, 1.f - lambda_init, 0.17677669529663687f, with_ctx);
        k_mla_norm<<<TT, 64, 0, stream>>>(p, mla_q_norm + l * 192, mla_kv_norm + l * 128, cqn, ckvn);
        launch_gemm(stream, cqn, 192, mla_w_uq + (size_t)l * 192 * 384, 384, qfull, 384, nullptr, TT, 384, 192);
        launch_gemm(stream, ckvn, 128, mla_w_ukv + (size_t)l * 128 * 512, 512, kvfull, 512, nullptr, TT, 512, 128);
        k_mla_layout<<<TT, 128, 0, stream>>>(p, qfull, kvfull, ropecs, mQ, mK, mV);
        k_attn<96, 1, 64, false><<<dim3(NT / 64, 4, NB), 64, 0, stream>>>(mQ, mK, mV, ycat, 512, lamfull, nullptr, 1.f, 0.10206207261596575f, with_ctx);
        k_ml_prep<<<TT, 256, 0, stream>>>(p, ml_conv_w + l * 3 * 512, ml_conv_b + l * 512, ml_gate_b + l * 16, mlqk, mlG);
        k_mlstm<<<dim3(4, NB, 2), 256, 0, stream>>>(mlqk, p, mlG, hdir);
        k_ml_finish<<<TT, 256, 0, stream>>>(p, hdir, ml_norm + l * 256, ycat);
        k_s5_scan<<<dim3(16, NB, 2), 64, 0, stream>>>(p, abr + l * 2048, abi + l * 2048, bbr + (size_t)l * 2048 * 16, bbi + (size_t)l * 2048 * 16,
                                                      s5_c_re + (size_t)l * 2 * 16 * 1024, s5_c_im + (size_t)l * 2 * 16 * 1024, ys5);
        k_s5_gelu<<<TT, 256, 0, stream>>>(p, ys5, s5_d + l * 256, gl);
        launch_gemm(stream, gl, 256, s5_w_glu + (size_t)l * 256 * 256, 256, zglu, 256, s5_b_glu + l * 256, TT, 256, 256);
        k_s5_glu<<<TT, 256, 0, stream>>>(gl, zglu, ycat);
        launch_gemm(stream, ycat, DM, w_out + (size_t)l * DM * DM, DM, obuf, DM, nullptr, TT, DM, DM);
        hipMemsetAsync(cnt, 0, 128, stream);
        k_post1<<<TT, 256, 0, stream>>>(xall, obuf, nw + 1024, nw + 2048, modl, moe_w_router + (size_t)l * 1024 * 32, moe_b_router + l * 32, fbuf, top_e, top_g, cnt, posb, with_ctx);
        k_moe_offsets<<<1, 64, 0, stream>>>(cnt, offs, grp_end, tile_e, tile_m0, ntiles);
        k_moe_scatter<<<NASSIGN / 256, 256, 0, stream>>>(top_e, posb, offs, slot_token, tok_slot, with_ctx);
        {
            GemmArgs g{}; g.A = fbuf; g.lda = DM; g.B = moe_w_gate_up + (size_t)l * NE * DM * 2048; g.ldb = 2048; g.C = act; g.ldc = DM;
            g.bias = moe_b_gate_up + (size_t)l * NE * 2048; g.M = 0; g.N = 1024; g.K = DM; g.gather = slot_token; g.tile_e = tile_e; g.tile_m0 = tile_m0; g.grp_end = grp_end; g.ntiles = ntiles;
            g.strideB = (long)DM * 2048; g.strideBias = 2048;
            k_gemm<1><<<dim3(1024 / 64, MAXTILES), 256, 0, stream>>>(g);
        }
        {
            GemmArgs g{}; g.A = act; g.lda = DM; g.B = moe_w_down + (size_t)l * NE * DM * DM; g.ldb = DM; g.C = yexp; g.ldc = DM;
            g.bias = moe_b_down + (size_t)l * NE * DM; g.M = 0; g.N = DM; g.K = DM; g.gather = nullptr; g.tile_e = tile_e; g.tile_m0 = tile_m0; g.grp_end = grp_end; g.ntiles = ntiles;
            g.strideB = (long)DM * DM; g.strideBias = DM;
            k_gemm<0><<<dim3(DM / 64, MAXTILES), 256, 0, stream>>>(g);
        }
        k_combine<<<TT, 256, 0, stream>>>(xall, yexp, tok_slot, top_g, nw + 3072, modl, with_ctx);
    }
    k_out<<<(NB * NS * DM / 4 + 255) / 256, 256, 0, stream>>>(xall, out);
}
```

```cpp
#include <hip/hip_runtime.h>
#include <cstdint>
#include <cstdio>

#define NB 8
#define NS 2048
#define NC 256
#define NT 2304
#define TT (NB * NT)
#define DM 1024
#define DIN 2560
#define DINC 2416
#define NE 32
#define NASSIGN (TT * 4)
#define MAXSLOTS (NASSIGN + NE * 256)

#define P_DAQ 0
#define P_DAK 256
#define P_DAV 512
#define P_MLQK 768
#define P_MLV 1280
#define P_MLO 1536
#define P_MLG 1792
#define P_CQ 1808
#define P_CKV 2000
#define P_KR 2128
#define P_S5 2160

__device__ __forceinline__ float sigmoidf_(float x) { return 1.f / (1.f + __expf(-x)); }
__device__ __forceinline__ float siluf_(float x) { return x / (1.f + __expf(-x)); }
__device__ __forceinline__ float logsigmoidf_(float x) { return fminf(x, 0.f) - log1pf(__expf(-fabsf(x))); }

__device__ __forceinline__ float block_sum_256(float v, float* red) {
    for (int o = 32; o > 0; o >>= 1) v += __shfl_xor(v, o);
    __syncthreads();
    if ((threadIdx.x & 63) == 0) red[threadIdx.x >> 6] = v;
    __syncthreads();
    float r = red[0] + red[1] + red[2] + red[3];
    return r;
}


typedef unsigned short bf16_t;
__device__ __forceinline__ bf16_t f2bf(float f) { unsigned u = __float_as_uint(f); u += 0x7FFFu + ((u >> 16) & 1u); return (bf16_t)(u >> 16); }
__device__ __forceinline__ float bf2f(bf16_t b) { return __uint_as_float(((unsigned)b) << 16); }
__device__ __forceinline__ unsigned pk2bf(float lo, float hi) { return (unsigned)f2bf(lo) | ((unsigned)f2bf(hi) << 16); }

namespace pg8 {
#define PG8_LAS __attribute__((address_space(3)))
typedef short bf16x8 __attribute__((ext_vector_type(8)));
typedef float f32x4 __attribute__((ext_vector_type(4)));
typedef unsigned u32x4 __attribute__((ext_vector_type(4)));
constexpr int BM = 256, BK = 64, HALF = 128, HTB = HALF * BK * 2, STAGE_BYTES = 8 * HTB, NXCD = 8, WGM = 8;
__host__ __device__ __forceinline__ int lds_byte(int r, int c) { const int st = (r >> 4) * 2 + (c >> 5), rr = r & 15, cc = c & 31, ob = rr * 64 + cc * 2; return st * 1024 + (ob ^ (((ob >> 9) & 1) << 5)); }
__host__ __device__ __forceinline__ void stage_rc(int b, int& R, int& C) { const int st = b / 1024, sb = b % 1024, swz = sb ^ (((sb >> 9) & 1) << 5); R = (st >> 1) * 16 + swz / 64; C = (st & 1) * 32 + (swz % 64) / 2; }
__host__ __device__ __forceinline__ int perm32(int rho) { const int n = rho >> 4, i = rho & 15; return 8 * (i >> 2) + 4 * n + (i & 3); }
struct Unit { int pm, pn; };
struct Gemm { const bf16_t* A; const bf16_t* Bt; int M, N, K, pad; };
__device__ __forceinline__ unsigned cvt_pk_bf16(float lo, float hi) { unsigned r; asm volatile("v_cvt_pk_bf16_f32 %0, %1, %2" : "=v"(r) : "v"(lo), "v"(hi)); return r; }

struct StaticOrder {
    int nM, nN, nwg, G, c;
    __device__ void init(int M, int N, int G_, int c_) { nM = M / BM; nN = N / BM; nwg = nM * nN; G = G_; c = c_; }
    __device__ bool next(int i, Unit& u) const {
        const long L = (long)i * G + c; if (L >= nwg) return false;
        int wgid = (int)L; { const int q = nwg / NXCD, r = nwg % NXCD, xcd = wgid % NXCD, off = wgid / NXCD; wgid = (xcd < r ? xcd * (q + 1) : r * (q + 1) + (xcd - r) * q) + off; }
        const int nig = WGM * nN, gid = wgid / nig, fm = gid * WGM, gsz = (nM - fm) < WGM ? (nM - fm) : WGM;
        u.pm = fm + ((wgid % nig) % gsz); u.pn = (wgid % nig) / gsz; return true;
    }
    __device__ __forceinline__ void a_ready(const Unit&) const {}
    __device__ __forceinline__ void done(const Unit&) const {}
};
struct GroupedOrder : StaticOrder {
    const int* tile_e;
    __device__ void initg(const int* ntiles_p, const int* tile_e_, int N, int G_, int c_) { nM = ntiles_p[0]; nN = N / BM; nwg = nM * nN; G = G_; c = c_; tile_e = tile_e_; }
    __device__ bool next(int i, Unit& u) const { if (!StaticOrder::next(i, u)) return false; u.pn += tile_e[u.pm] * nN; return true; }
};

struct EpiF32 {
    static constexpr bool PERM = false;
    float* C; const float* bias; int ldc, pad;
    __device__ __forceinline__ void operator()(const f32x4 (&acc)[2][2][4][2], const Unit& u, int wr, int wc, int fr, int fq) const {
        const int row0 = u.pm * BM + wr * 64 + fr, col0 = u.pn * BM + wc * 32 + 4 * fq;
        f32x4 bv[2][2];
#pragma unroll
        for (int bj = 0; bj < 2; ++bj)
#pragma unroll
            for (int n = 0; n < 2; ++n) bv[bj][n] = bias ? *(const f32x4*)(bias + col0 + bj * HALF + n * 16) : (f32x4){0.f, 0.f, 0.f, 0.f};
#pragma unroll
        for (int ai = 0; ai < 2; ++ai)
#pragma unroll
            for (int m = 0; m < 4; ++m) { float* rowp = C + (size_t)(row0 + ai * HALF + m * 16) * ldc + col0;
#pragma unroll
                for (int bj = 0; bj < 2; ++bj)
#pragma unroll
                    for (int n = 0; n < 2; ++n) *(f32x4*)(rowp + bj * HALF + n * 16) = acc[ai][bj][m][n] + bv[bj][n]; }
    }
};
struct EpiDown {
    static constexpr bool PERM = false;
    float* C; const float* bias;
    __device__ __forceinline__ void operator()(const f32x4 (&acc)[2][2][4][2], const Unit& u, int wr, int wc, int fr, int fq) const {
        const int e = u.pn >> 2, pnl = u.pn & 3;
        const int row0 = u.pm * BM + wr * 64 + fr, col0 = pnl * BM + wc * 32 + 4 * fq;
        const float* bp = bias + (size_t)e * 1024;
        f32x4 bv[2][2];
#pragma unroll
        for (int bj = 0; bj < 2; ++bj)
#pragma unroll
            for (int n = 0; n < 2; ++n) bv[bj][n] = *(const f32x4*)(bp + col0 + bj * HALF + n * 16);
#pragma unroll
        for (int ai = 0; ai < 2; ++ai)
#pragma unroll
            for (int m = 0; m < 4; ++m) { float* rowp = C + (size_t)(row0 + ai * HALF + m * 16) * 1024 + col0;
#pragma unroll
                for (int bj = 0; bj < 2; ++bj)
#pragma unroll
                    for (int n = 0; n < 2; ++n) *(f32x4*)(rowp + bj * HALF + n * 16) = acc[ai][bj][m][n] + bv[bj][n]; }
    }
};
struct EpiSwiglu {
    static constexpr bool PERM = true;
    bf16_t* O; const float* bias;
    __device__ __forceinline__ void operator()(const f32x4 (&acc)[2][2][4][2], const Unit& u, int wr, int wc, int fr, int fq) const {
        const int e = u.pn >> 3, pnl = u.pn & 7;
        const int row0 = u.pm * BM + wr * 64 + fr, col0 = pnl * HALF + wc * 32 + 8 * fq;
        const float* bp = bias + (size_t)e * 2048 + col0;
        f32x4 bg[2], bu[2];
#pragma unroll
        for (int n = 0; n < 2; ++n) { bg[n] = *(const f32x4*)(bp + 4 * n); bu[n] = *(const f32x4*)(bp + 1024 + 4 * n); }
#pragma unroll
        for (int ai = 0; ai < 2; ++ai)
#pragma unroll
            for (int m = 0; m < 4; ++m) {
                bf16_t* rowp = O + (size_t)(row0 + ai * HALF + m * 16) * 1024 + col0;
                float r[8];
#pragma unroll
                for (int n = 0; n < 2; ++n) {
                    f32x4 g = acc[ai][0][m][n] + bg[n], up = acc[ai][1][m][n] + bu[n];
#pragma unroll
                    for (int j = 0; j < 4; ++j) {
                        float gt = fminf(g[j], 7.f), uu = fminf(fmaxf(up[j], -7.f), 7.f);
                        r[n * 4 + j] = (uu + 1.f) * gt / (1.f + __expf(-1.702f * gt));
                    }
                }
                u32x4 w; w.x = cvt_pk_bf16(r[0], r[1]); w.y = cvt_pk_bf16(r[2], r[3]); w.z = cvt_pk_bf16(r[4], r[5]); w.w = cvt_pk_bf16(r[6], r[7]);
                *(u32x4*)rowp = w;
            }
    }
};

template <class Epi, class Sched>
__device__ __forceinline__ void gemm_phase(PG8_LAS unsigned char* lds, const Gemm g, const Sched& S, const Epi& E) {
    const int tid = threadIdx.x, wid = __builtin_amdgcn_readfirstlane(tid >> 6), lane = tid & 63, wr = wid >> 2, wc = wid & 3, fr = lane & 15, fq = lane >> 4;
    const int K = g.K, nt = K / BK;
    unsigned voffA[2], voffB[2];
#pragma unroll
    for (int i = 0; i < 2; ++i) { int R, C; stage_rc(tid * 16 + i * 8192, R, C); const int Rb = Epi::PERM ? ((R & ~31) + perm32(R & 31)) : R;
        voffA[i] = (unsigned)(R * K + C) * 2u; voffB[i] = (unsigned)(Rb * K + C) * 2u; }
    const size_t kstep = (size_t)(BK * 2);
    const size_t hstep = (size_t)HALF * K * 2;
    const size_t tstep = 2 * hstep;
    const unsigned ldsw = (unsigned)wid * 1024u;
    const int aoff = lds_byte(wr * 64 + fr, fq * 8), boff = lds_byte(wc * 32 + fr, fq * 8);
#define PG8_SA(b, h) (((b) * 2 + (h)) * HTB)
#define PG8_SB(b, h) ((4 + (b) * 2 + (h)) * HTB)
#define PG8_STAGE(bufoff, gbase, voff) do { _Pragma("unroll") for (int _i = 0; _i < 2; ++_i) \
        __builtin_amdgcn_global_load_lds((const unsigned*)((const char*)(gbase) + (voff)[_i]), (PG8_LAS unsigned*)(lds + (bufoff) + ldsw + _i * 8192), 16, 0, 0); } while (0)
#define PG8_LDA(dst, b, h) do { _Pragma("unroll") for (int m = 0; m < 4; ++m) _Pragma("unroll") for (int k = 0; k < 2; ++k) dst[m][k] = *(const PG8_LAS bf16x8*)(lds + PG8_SA(b, h) + aoff + m * 2048 + k * 1024); } while (0)
#define PG8_LDB(dst, b, h) do { _Pragma("unroll") for (int n = 0; n < 2; ++n) _Pragma("unroll") for (int k = 0; k < 2; ++k) dst[n][k] = *(const PG8_LAS bf16x8*)(lds + PG8_SB(b, h) + boff + n * 2048 + k * 1024); } while (0)
#define PG8_MMA(ai, bj, At, Bt) do { __builtin_amdgcn_s_setprio(1); _Pragma("unroll") for (int m = 0; m < 4; ++m) _Pragma("unroll") for (int n = 0; n < 2; ++n) _Pragma("unroll") for (int k = 0; k < 2; ++k) \
        acc[ai][bj][m][n] = __builtin_amdgcn_mfma_f32_16x16x32_bf16(Bt[n][k], At[m][k], acc[ai][bj][m][n], 0, 0, 0); __builtin_amdgcn_s_setprio(0); } while (0)
#define PG8_WAIT_V(n) asm volatile("s_waitcnt vmcnt(" #n ")" ::: "memory")
#define PG8_WAIT_L(n) asm volatile("s_waitcnt lgkmcnt(" #n ")" ::: "memory")
#define PG8_BAR __builtin_amdgcn_s_barrier()
#define PG8_SCHED __builtin_amdgcn_sched_barrier(0)
    Unit cur, nxt; int ui = 0;
    if (!S.next(0, cur)) return;
    f32x4 acc[2][2][4][2];
#pragma unroll
    for (int a = 0; a < 2; ++a)
#pragma unroll
        for (int b = 0; b < 2; ++b)
#pragma unroll
            for (int m = 0; m < 4; ++m)
#pragma unroll
                for (int n = 0; n < 2; ++n) acc[a][b][m][n] = (f32x4){0.f, 0.f, 0.f, 0.f};
    bf16x8 At[4][2], B0[2][2], B1[2][2];
    const char* cA = (const char*)g.A + (size_t)cur.pm * tstep; const char* cB = (const char*)g.Bt + (size_t)cur.pn * tstep;
    S.a_ready(cur);
    PG8_STAGE(PG8_SB(0, 0), cB, voffB); PG8_STAGE(PG8_SA(0, 0), cA, voffA); PG8_STAGE(PG8_SB(0, 1), cB + hstep, voffB); PG8_STAGE(PG8_SA(0, 1), cA + hstep, voffA);
    if (wr == 1) PG8_BAR;
    PG8_WAIT_V(4); PG8_BAR;
    PG8_STAGE(PG8_SB(1, 0), cB + kstep, voffB); PG8_STAGE(PG8_SA(1, 0), cA + kstep, voffA); PG8_STAGE(PG8_SB(1, 1), cB + hstep + kstep, voffB);
    PG8_WAIT_V(6); PG8_BAR;
    for (;;) {
        const bool has_next = S.next(ui + 1, nxt);
        const char* nA = has_next ? (const char*)g.A + (size_t)nxt.pm * tstep : cA; const char* nB = has_next ? (const char*)g.Bt + (size_t)nxt.pn * tstep : cB;
        for (int t = 0; t < nt; t += 2) {
            const bool last = (t == nt - 2);
            const char* a1 = cA + (size_t)(t + 1) * kstep;
            const char* a2 = last ? nA : cA + (size_t)(t + 2) * kstep; const char* b2 = last ? nB : cB + (size_t)(t + 2) * kstep;
            const char* a3 = a2 + kstep; const char* b3 = b2 + kstep;
            if (last && has_next) S.a_ready(nxt);
            PG8_LDB(B0, 0, 0); PG8_SCHED; PG8_LDA(At, 0, 0); PG8_STAGE(PG8_SA(1, 1), a1 + hstep, voffA);
            PG8_WAIT_L(8); PG8_BAR; PG8_WAIT_L(0); PG8_MMA(0, 0, At, B0); PG8_BAR; PG8_SCHED;
            PG8_LDB(B1, 0, 1); PG8_STAGE(PG8_SB(0, 0), b2, voffB);
            PG8_BAR; PG8_WAIT_L(0); PG8_MMA(0, 1, At, B1); PG8_BAR;
            PG8_LDA(At, 0, 1); PG8_STAGE(PG8_SA(0, 0), a2, voffA);
            PG8_BAR; PG8_WAIT_L(0); PG8_MMA(1, 0, At, B0); PG8_BAR; PG8_SCHED;
            PG8_STAGE(PG8_SB(0, 1), b2 + hstep, voffB);
            PG8_WAIT_V(6); PG8_BAR; PG8_MMA(1, 1, At, B1); PG8_BAR;
            PG8_LDB(B0, 1, 0); PG8_SCHED; PG8_LDA(At, 1, 0); PG8_STAGE(PG8_SA(0, 1), a2 + hstep, voffA);
            PG8_WAIT_L(8); PG8_BAR; PG8_WAIT_L(0); PG8_MMA(0, 0, At, B0); PG8_BAR; PG8_SCHED;
            PG8_LDB(B1, 1, 1); PG8_STAGE(PG8_SB(1, 0), b3, voffB);
            PG8_BAR; PG8_WAIT_L(0); PG8_MMA(0, 1, At, B1); PG8_BAR;
            PG8_LDA(At, 1, 1); PG8_STAGE(PG8_SA(1, 0), a3, voffA);
            PG8_BAR; PG8_WAIT_L(0); PG8_MMA(1, 0, At, B0); PG8_BAR; PG8_SCHED;
            PG8_STAGE(PG8_SB(1, 1), b3 + hstep, voffB);
            PG8_WAIT_V(6); PG8_BAR; PG8_MMA(1, 1, At, B1); PG8_BAR;
        }
        E(acc, cur, wr, wc, fr, fq); S.done(cur);
        if (!has_next) break;
#pragma unroll
        for (int a = 0; a < 2; ++a)
#pragma unroll
            for (int b = 0; b < 2; ++b)
#pragma unroll
                for (int m = 0; m < 4; ++m)
#pragma unroll
                    for (int n = 0; n < 2; ++n) acc[a][b][m][n] = (f32x4){0.f, 0.f, 0.f, 0.f};
        cur = nxt; cA = nA; cB = nB; ++ui;
    }
    PG8_WAIT_V(0);
    if (wr == 0) PG8_BAR;
    PG8_BAR;
#undef PG8_SA
#undef PG8_SB
#undef PG8_STAGE
#undef PG8_LDA
#undef PG8_LDB
#undef PG8_MMA
#undef PG8_WAIT_V
#undef PG8_WAIT_L
#undef PG8_BAR
#undef PG8_SCHED
}
}

extern __shared__ __attribute__((aligned(16))) unsigned char dyn_lds[];
template <class Epi>
__global__ __launch_bounds__(512, 2) void k_pg8_static(pg8::Gemm g, Epi E) {
    pg8::StaticOrder S; S.init(g.M, g.N, gridDim.x, blockIdx.x);
    pg8::gemm_phase<Epi, pg8::StaticOrder>((PG8_LAS unsigned char*)dyn_lds, g, S, E);
}
template <class Epi>
__global__ __launch_bounds__(512, 2) void k_pg8_grouped(pg8::Gemm g, Epi E, const int* ntiles, const int* tile_e) {
    pg8::GroupedOrder S; S.initg(ntiles, tile_e, g.N, gridDim.x, blockIdx.x);
    pg8::gemm_phase<Epi, pg8::GroupedOrder>((PG8_LAS unsigned char*)dyn_lds, g, S, E);
}

template <int MODE>
__global__ __launch_bounds__(256) void k_convT(const float* __restrict__ W, int K, int N, bf16_t* __restrict__ WT, int ldt, int roff, int koff, long strideW, long strideT) {
    __shared__ float tile[64][65];
    W += (size_t)blockIdx.z * strideW; WT += (size_t)blockIdx.z * strideT;
    int n0 = blockIdx.x * 64, k0 = blockIdx.y * 64;
    int tn = threadIdx.x & 63, tk = threadIdx.x >> 6;
#pragma unroll
    for (int i = 0; i < 16; ++i) { int k = i * 4 + tk; tile[k][tn] = (n0 + tn < N) ? W[(size_t)(k0 + k) * N + n0 + tn] : 0.f; }
    __syncthreads();
    int n = threadIdx.x >> 2, kc = (threadIdx.x & 3) * 16;
    if (n0 + n >= N) return;
    int gn = n0 + n; int dr;
    if (MODE == 0) dr = gn; else { dr = (gn < 1024) ? ((gn >> 7) * 256 + (gn & 127)) : ((((gn - 1024) >> 7) * 256) + 128 + ((gn - 1024) & 127)); }
    uint4 o0, o1;
    o0.x = pk2bf(tile[kc + 0][n], tile[kc + 1][n]); o0.y = pk2bf(tile[kc + 2][n], tile[kc + 3][n]); o0.z = pk2bf(tile[kc + 4][n], tile[kc + 5][n]); o0.w = pk2bf(tile[kc + 6][n], tile[kc + 7][n]);
    o1.x = pk2bf(tile[kc + 8][n], tile[kc + 9][n]); o1.y = pk2bf(tile[kc + 10][n], tile[kc + 11][n]); o1.z = pk2bf(tile[kc + 12][n], tile[kc + 13][n]); o1.w = pk2bf(tile[kc + 14][n], tile[kc + 15][n]);
    bf16_t* dp = WT + (size_t)(roff + dr) * ldt + koff + k0 + kc;
    *(uint4*)dp = o0; *(uint4*)(dp + 8) = o1;
}

__global__ __launch_bounds__(256) void k_to_bf16_rows(const float* __restrict__ src, bf16_t* __restrict__ dst) {
    size_t t = blockIdx.x; int d = threadIdx.x * 4;
    float4 v = *(const float4*)(src + t * DM + d);
    uint2 o; o.x = pk2bf(v.x, v.y); o.y = pk2bf(v.z, v.w);
    *(uint2*)(dst + t * DM + d) = o;
}
__global__ __launch_bounds__(256) void k_moe_gather(const float* __restrict__ f, const int* __restrict__ slot_token, const int* __restrict__ ntiles, bf16_t* __restrict__ xg) {
    int slot = blockIdx.x;
    if (slot >= ntiles[0] * 256) return;
    int t = slot_token[slot]; int d = threadIdx.x * 4;
    uint2 o = make_uint2(0u, 0u);
    if (t >= 0) { float4 v = *(const float4*)(f + (size_t)t * DM + d); o.x = pk2bf(v.x, v.y); o.y = pk2bf(v.z, v.w); }
    *(uint2*)(xg + (size_t)slot * DM + d) = o;
}

__global__ void k_build_x(const float* __restrict__ x, const float* __restrict__ ctx, float* __restrict__ xall) {
    size_t i = (size_t)blockIdx.x * 256 + threadIdx.x;
    size_t total = (size_t)TT * DM / 4;
    if (i >= total) return;
    size_t t = i / (DM / 4); int d4 = (int)(i % (DM / 4));
    int b = (int)(t / NT), n = (int)(t % NT);
    const float4* src = (n < NC) ? (const float4*)(ctx + ((size_t)b * NC + n) * DM) : (const float4*)(x + ((size_t)b * NS + (n - NC)) * DM);
    ((float4*)xall)[i] = src[d4];
}

__global__ __launch_bounds__(256) void k_mod(const float* __restrict__ c, const float* __restrict__ c_ctx, const float* __restrict__ w_mod,
                                             const float* __restrict__ b_mod, float* __restrict__ mod) {
    __shared__ float s[9][1024];
    for (int i = threadIdx.x; i < 9 * 1024; i += 256) {
        int r = i >> 10, k = i & 1023;
        float v = (r < 8) ? c[r * 1024 + k] : c_ctx[k];
        s[r][k] = siluf_(v);
    }
    __syncthreads();
    int gj = blockIdx.x * 256 + threadIdx.x;
    int l = gj / 6144, j = gj % 6144;
    const float* w = w_mod + (size_t)l * 1024 * 6144 + j;
    float acc[9];
#pragma unroll
    for (int r = 0; r < 9; ++r) acc[r] = 0.f;
    for (int k = 0; k < 1024; ++k) {
        float wv = w[(size_t)k * 6144];
#pragma unroll
        for (int r = 0; r < 9; ++r) acc[r] += s[r][k] * wv;
    }
    float bb = b_mod[l * 6144 + j];
#pragma unroll
    for (int r = 0; r < 9; ++r) mod[((size_t)l * 9 + r) * 6144 + j] = acc[r] + bb;
}

__global__ void k_rope_table(float* __restrict__ cs) {
    int i = blockIdx.x * 256 + threadIdx.x;
    if (i >= NS * 16) return;
    int pos = i >> 4, j = i & 15;
    int row = pos / 64, col = pos % 64;
    double inv = pow(10000.0, -(double)(j & 7) / 8.0);
    double ang = (double)((j < 8) ? row : col) * inv;
    cs[i * 2] = (float)cos(ang);
    cs[i * 2 + 1] = (float)sin(ang);
}

__global__ void k_lambda(const float* __restrict__ da_lambda, float* __restrict__ lamfull) {
    int l = threadIdx.x;
    if (l >= 2) return;
    const float* lam = da_lambda + l * 128;
    double s1 = 0, s2 = 0;
    for (int i = 0; i < 32; ++i) { s1 += (double)lam[i] * lam[32 + i]; s2 += (double)lam[64 + i] * lam[96 + i]; }
    double lambda_init = 0.8 - 0.6 * exp(-0.3 * l);
    lamfull[l] = (float)(exp(s1) - exp(s2) + lambda_init);
}

__global__ void k_s5_disc(const float* __restrict__ a_re, const float* __restrict__ a_im, const float* __restrict__ log_step,
                          const float* __restrict__ b_re, const float* __restrict__ b_im,
                          float* __restrict__ abr, float* __restrict__ abi, float* __restrict__ bbr, float* __restrict__ bbi) {
    int i = blockIdx.x * 256 + threadIdx.x;
    if (i >= 2 * 2 * 16 * 64) return;
    int ldg = i >> 6;
    double ar = fmin((double)a_re[i], -1e-4), ai = (double)a_im[i];
    double dt = exp((double)log_step[ldg]);
    double mag = exp(dt * ar);
    double er = mag * cos(dt * ai), ei = mag * sin(dt * ai);
    double inv = 1.0 / (ar * ar + ai * ai);
    double fr = ((er - 1.0) * ar + ei * ai) * inv;
    double fi = (ei * ar - (er - 1.0) * ai) * inv;
    abr[i] = (float)er; abi[i] = (float)ei;
    for (int h = 0; h < 16; ++h) {
        double br = b_re[(size_t)i * 16 + h], bi = b_im[(size_t)i * 16 + h];
        bbr[(size_t)i * 16 + h] = (float)(fr * br - fi * bi);
        bbi[(size_t)i * 16 + h] = (float)(fr * bi + fi * br);
    }
}

__global__ __launch_bounds__(256) void k_norm_mod(const float* __restrict__ xall, const float* __restrict__ nw, const float* __restrict__ modl  ,
                                                  int shift_off, int scale_off, bf16_t* __restrict__ out) {
    __shared__ float red[8];
    int t = blockIdx.x; int b = t / NT, n = t % NT; int r = (n < NC) ? 8 : b;
    const float4 xv = ((const float4*)(xall + (size_t)t * DM))[threadIdx.x];
    float ss = xv.x * xv.x + xv.y * xv.y + xv.z * xv.z + xv.w * xv.w;
    ss = block_sum_256(ss, red);
    float rstd = rsqrtf(ss * (1.f / DM) + 1e-6f);
    int d = threadIdx.x * 4;
    const float4 w = *(const float4*)(nw + d);
    const float4 sc = *(const float4*)(modl + (size_t)r * 6144 + scale_off + d);
    const float4 sh = *(const float4*)(modl + (size_t)r * 6144 + shift_off + d);
    float4 o;
    o.x = xv.x * rstd * w.x * (1.f + sc.x) + sh.x;
    o.y = xv.y * rstd * w.y * (1.f + sc.y) + sh.y;
    o.z = xv.z * rstd * w.z * (1.f + sc.z) + sh.z;
    o.w = xv.w * rstd * w.w * (1.f + sc.w) + sh.w;
    uint2 ob; ob.x = pk2bf(o.x, o.y); ob.y = pk2bf(o.z, o.w);
    *(uint2*)(out + (size_t)t * DM + d) = ob;
}

struct GemmArgs {
    const float* A; const float* B; float* C; const float* bias;
    int M, N, K, lda, ldb, ldc;
    const int* gather;
    const int* tile_e;
    const int* tile_m0;
    const int* grp_end;
    const int* ntiles;
    long strideB, strideBias;
};

template <int MODE>
__global__ __launch_bounds__(256) void k_gemm(GemmArgs g) {
    __shared__ float As[16][68];
    __shared__ float Bs[16][64];
    __shared__ float Bs2[MODE == 1 ? 16 : 1][64];
    const float* B = g.B; const float* bias = g.bias;
    int m0, mend;
    if (g.tile_e) {
        int ty = blockIdx.y;
        if (ty >= g.ntiles[0]) return;
        int e = g.tile_e[ty];
        m0 = g.tile_m0[ty]; mend = g.grp_end[e];
        B += (size_t)e * g.strideB; if (bias) bias += (size_t)e * g.strideBias;
    } else { m0 = blockIdx.y * 64; mend = g.M; if (m0 >= mend) return; }
    int n0 = blockIdx.x * 64;
    int tx = threadIdx.x & 15, ty_ = threadIdx.x >> 4;
    float acc[4][4], acc2[4][4];
#pragma unroll
    for (int i = 0; i < 4; ++i)
#pragma unroll
        for (int j = 0; j < 4; ++j) { acc[i][j] = 0.f; acc2[i][j] = 0.f; }
    int ar = threadIdx.x >> 2, ak = (threadIdx.x & 3) * 4;
    int arow_slot = m0 + ar; bool avalid = arow_slot < mend;
    long arow = avalid ? (g.gather ? (long)g.gather[arow_slot] : (long)arow_slot) : 0;
    const float* Ap = g.A + arow * g.lda + ak;
    int bk = threadIdx.x >> 4, bn = (threadIdx.x & 15) * 4;
    for (int k0 = 0; k0 < g.K; k0 += 16) {
        float4 av = avalid ? *(const float4*)(Ap + k0) : make_float4(0.f, 0.f, 0.f, 0.f);
        As[ak + 0][ar] = av.x; As[ak + 1][ar] = av.y; As[ak + 2][ar] = av.z; As[ak + 3][ar] = av.w;
        const float* Bp = B + (size_t)(k0 + bk) * g.ldb + n0 + bn;
#pragma unroll
        for (int q = 0; q < 4; ++q) Bs[bk][bn + q] = (n0 + bn + q < g.N) ? Bp[q] : 0.f;
        if (MODE == 1) {
#pragma unroll
            for (int q = 0; q < 4; ++q) Bs2[bk][bn + q] = (n0 + bn + q < g.N) ? Bp[g.N + q] : 0.f;
        }
        __syncthreads();
#pragma unroll
        for (int kk = 0; kk < 16; ++kk) {
            float a[4], b[4];
#pragma unroll
            for (int i = 0; i < 4; ++i) a[i] = As[kk][ty_ * 4 + i];
#pragma unroll
            for (int j = 0; j < 4; ++j) b[j] = Bs[kk][tx * 4 + j];
#pragma unroll
            for (int i = 0; i < 4; ++i)
#pragma unroll
                for (int j = 0; j < 4; ++j) acc[i][j] += a[i] * b[j];
            if (MODE == 1) {
                float b2[4];
#pragma unroll
                for (int j = 0; j < 4; ++j) b2[j] = Bs2[kk][tx * 4 + j];
#pragma unroll
                for (int i = 0; i < 4; ++i)
#pragma unroll
                    for (int j = 0; j < 4; ++j) acc2[i][j] += a[i] * b2[j];
            }
        }
        __syncthreads();
    }
#pragma unroll
    for (int i = 0; i < 4; ++i) {
        int slot = m0 + ty_ * 4 + i;
        if (slot >= mend) continue;
#pragma unroll
        for (int j = 0; j < 4; ++j) {
            int n = n0 + tx * 4 + j;
            if (n >= g.N) continue;
            float v = acc[i][j] + (bias ? bias[n] : 0.f);
            if (MODE == 1) {
                float up = acc2[i][j] + (bias ? bias[g.N + n] : 0.f);
                float gate = fminf(v, 7.f);
                up = fminf(fmaxf(up, -7.f), 7.f);
                v = (up + 1.f) * gate * sigmoidf_(1.702f * gate);
            }
            g.C[(size_t)slot * g.ldc + n] = v;
        }
    }
}

__global__ __launch_bounds__(256) void k_da_prep(const float* __restrict__ p, const float* __restrict__ cs, float* __restrict__ Q, float* __restrict__ K, float* __restrict__ V) {
    int t = blockIdx.x; int b = t / NT, n = t % NT;
    int c = threadIdx.x;
    int h = c >> 6, r = c & 63, d = r & 31;
    const float* pr = p + (size_t)t * DIN;
    size_t o = (((size_t)b * 4 + h) * NT + n) * 64 + r;
    float qv = pr[P_DAQ + c], kv = pr[P_DAK + c];
    if (n >= NC) {
        int pos = n - NC; int j = d & 15;
        float co = cs[(pos * 16 + j) * 2], si = cs[(pos * 16 + j) * 2 + 1];
        int cp = (d < 16) ? c + 16 : c - 16;
        float qo = pr[P_DAQ + cp], ko = pr[P_DAK + cp];
        if (d < 16) { qv = qv * co - qo * si; kv = kv * co - ko * si; }
        else        { qv = qv * co + qo * si; kv = kv * co + ko * si; }
    }
    Q[o] = qv; K[o] = kv; V[o] = pr[P_DAV + c];
}

template <int QKD, int NMAP, int DV, bool DA>
__global__ __launch_bounds__(64) void k_attn(const float* __restrict__ Q, const float* __restrict__ K, const float* __restrict__ V,
                                             float* __restrict__ ycat, int ycat_off, const float* __restrict__ lamfull,
                                             const float* __restrict__ subln, float post_scale, float scale, int with_ctx) {
    constexpr int DK = QKD / NMAP;
    __shared__ float Ks[32][QKD];
    __shared__ float Vs[32][DV];
    int qb = blockIdx.x, h = blockIdx.y, b = blockIdx.z;
    bool isctx = qb < (NC / 64);
    if (isctx && !with_ctx) return;
    int nkeys = isctx ? NC : NT;
    int n = qb * 64 + threadIdx.x;
    size_t base = ((size_t)b * 4 + h) * NT;
    float q[QKD];
    const float* qp = Q + (base + n) * QKD;
#pragma unroll
    for (int d = 0; d < QKD; d += 4) { float4 v = *(const float4*)(qp + d); q[d] = v.x * scale; q[d + 1] = v.y * scale; q[d + 2] = v.z * scale; q[d + 3] = v.w * scale; }
    float acc[NMAP][DV]; float mx[NMAP], l[NMAP];
#pragma unroll
    for (int m = 0; m < NMAP; ++m) { mx[m] = -1e30f; l[m] = 0.f;
#pragma unroll
        for (int d = 0; d < DV; ++d) acc[m][d] = 0.f; }
    for (int k0 = 0; k0 < nkeys; k0 += 32) {
        __syncthreads();
        for (int i = threadIdx.x; i < 32 * QKD / 4; i += 64) {
            int kr = i / (QKD / 4), kc = (i % (QKD / 4)) * 4;
            *(float4*)&Ks[kr][kc] = *(const float4*)(K + (base + k0 + kr) * QKD + kc);
        }
        for (int i = threadIdx.x; i < 32 * DV / 4; i += 64) {
            int kr = i / (DV / 4), kc = (i % (DV / 4)) * 4;
            *(float4*)&Vs[kr][kc] = *(const float4*)(V + (base + k0 + kr) * DV + kc);
        }
        __syncthreads();
        for (int j = 0; j < 32; ++j) {
#pragma unroll
            for (int m = 0; m < NMAP; ++m) {
                float s = 0.f;
#pragma unroll
                for (int d = 0; d < DK; ++d) s += q[m * DK + d] * Ks[j][m * DK + d];
                float mn = fmaxf(mx[m], s);
                float alpha = __expf(mx[m] - mn);
                float pv = __expf(s - mn);
                mx[m] = mn;
                l[m] = l[m] * alpha + pv;
#pragma unroll
                for (int d = 0; d < DV; ++d) acc[m][d] = acc[m][d] * alpha + pv * Vs[j][d];
            }
        }
    }
    float o[DV];
    float c1 = 1.f;
#pragma unroll
    for (int d = 0; d < DV; ++d) o[d] = acc[0][d] / l[0];
    if (NMAP == 2) {
        c1 = -lamfull[0];
#pragma unroll
        for (int d = 0; d < DV; ++d) o[d] += c1 * acc[NMAP - 1][d] / l[NMAP - 1];
    }
    if (DA) {
        float ss = 0.f;
#pragma unroll
        for (int d = 0; d < DV; ++d) ss += o[d] * o[d];
        float rstd = rsqrtf(ss * (1.f / DV) + 1e-6f) * post_scale;
#pragma unroll
        for (int d = 0; d < DV; ++d) o[d] = o[d] * rstd * subln[d];
    }
    float* yp = ycat + ((size_t)b * NT + n) * DM + ycat_off + h * DV;
#pragma unroll
    for (int d = 0; d < DV; d += 4) *(float4*)(yp + d) = make_float4(o[d], o[d + 1], o[d + 2], o[d + 3]);
}

__global__ __launch_bounds__(64) void k_mla_norm(const float* __restrict__ p, const float* __restrict__ qn, const float* __restrict__ kvn,
                                                 float* __restrict__ cqn, float* __restrict__ ckvn) {
    int t = blockIdx.x; int lane = threadIdx.x;
    const float* pr = p + (size_t)t * DIN;
    float v0 = pr[P_CQ + lane], v1 = pr[P_CQ + 64 + lane], v2 = pr[P_CQ + 128 + lane];
    float ss = v0 * v0 + v1 * v1 + v2 * v2;
    for (int o = 32; o > 0; o >>= 1) ss += __shfl_xor(ss, o);
    float r = rsqrtf(ss * (1.f / 192.f) + 1e-6f);
    cqn[(size_t)t * 192 + lane] = v0 * r * qn[lane];
    cqn[(size_t)t * 192 + 64 + lane] = v1 * r * qn[64 + lane];
    cqn[(size_t)t * 192 + 128 + lane] = v2 * r * qn[128 + lane];
    float w0 = pr[P_CKV + lane], w1 = pr[P_CKV + 64 + lane];
    float s2 = w0 * w0 + w1 * w1;
    for (int o = 32; o > 0; o >>= 1) s2 += __shfl_xor(s2, o);
    float r2 = rsqrtf(s2 * (1.f / 128.f) + 1e-6f);
    ckvn[(size_t)t * 128 + lane] = w0 * r2 * kvn[lane];
    ckvn[(size_t)t * 128 + 64 + lane] = w1 * r2 * kvn[64 + lane];
}

__global__ __launch_bounds__(128) void k_mla_layout(const float* __restrict__ p, const float* __restrict__ qfull  , const float* __restrict__ kvfull  ,
                                                    const float* __restrict__ cs, float* __restrict__ Q, float* __restrict__ K, float* __restrict__ V) {
    int t = blockIdx.x; int b = t / NT, n = t % NT;
    const float* pr = p + (size_t)t * DIN;
    const float* qf = qfull + (size_t)t * 384;
    const float* kf = kvfull + (size_t)t * 512;
    for (int i = threadIdx.x; i < 4 * 96; i += 128) {
        int h = i / 96, j = i % 96;
        size_t o = (((size_t)b * 4 + h) * NT + n) * 96 + j;
        float qv, kv;
        if (j < 64) { qv = qf[h * 96 + j]; kv = kf[h * 128 + j]; }
        else {
            int d = j - 64;
            qv = qf[h * 96 + j]; kv = pr[P_KR + d];
            if (n >= NC) {
                int pos = n - NC; int jj = d & 15;
                float co = cs[(pos * 16 + jj) * 2], si = cs[(pos * 16 + jj) * 2 + 1];
                int dp = (d < 16) ? d + 16 : d - 16;
                float qo = qf[h * 96 + 64 + dp], ko = pr[P_KR + dp];
                if (d < 16) { qv = qv * co - qo * si; kv = kv * co - ko * si; }
                else        { qv = qv * co + qo * si; kv = kv * co + ko * si; }
            }
        }
        Q[o] = qv; K[o] = kv;
    }
    for (int i = threadIdx.x; i < 4 * 64; i += 128) {
        int h = i / 64, j = i % 64;
        V[(((size_t)b * 4 + h) * NT + n) * 64 + j] = kf[h * 128 + 64 + j];
    }
}

__global__ __launch_bounds__(256) void k_ml_prep(const float* __restrict__ p, const float* __restrict__ conv_w  , const float* __restrict__ conv_b,
                                                 const float* __restrict__ gate_b, float* __restrict__ qk  , float* __restrict__ G  ) {
    int t = blockIdx.x; int n = t % NT;
    int seg_lo = (n < NC) ? 0 : NC, seg_hi = (n < NC) ? NC - 1 : NT - 1;
    for (int c = threadIdx.x; c < 512; c += 256) {
        float y = conv_b[c];
#pragma unroll
        for (int j = 0; j < 3; ++j) {
            int nn = n + j - 1;
            if (nn >= seg_lo && nn <= seg_hi) y += p[(size_t)(t + j - 1) * DIN + P_MLQK + c] * conv_w[j * 512 + c];
        }
        y = siluf_(y);
        if (c >= 256) y *= 0.125f;
        qk[(size_t)t * 512 + c] = y;
    }
    if (threadIdx.x < 16) {
        int gi = threadIdx.x >> 2;
        float g = p[(size_t)t * DIN + P_MLG + threadIdx.x] + gate_b[threadIdx.x];
        if (gi & 1) g = logsigmoidf_(g);
        G[(size_t)t * 16 + threadIdx.x] = g;
    }
}

__device__ __forceinline__ int seq_token(int s, int dir) {
    if (dir == 0) return s;
    return (s < NC) ? (NC - 1 - s) : (NC + (NT - 1 - s));
}

__global__ __launch_bounds__(256) void k_mlstm(const float* __restrict__ qk, const float* __restrict__ p, const float* __restrict__ G, float* __restrict__ hdir  ) {
    __shared__ float sq[64][64], sk[64][64], sv[64][64], sa[64], sf[64];
    int h = blockIdx.x, b = blockIdx.y, dir = blockIdx.z;
    int tid = threadIdx.x, vrow = tid >> 2, part = tid & 3;
    float C[16], nn[16];
#pragma unroll
    for (int i = 0; i < 16; ++i) { C[i] = 0.f; nn[i] = 0.f; }
    for (int s0 = 0; s0 < NT; s0 += 64) {
        __syncthreads();
        for (int i = tid; i < 64 * 64; i += 256) {
            int j = i >> 6, d = i & 63;
            int n = seq_token(s0 + j, dir);
            size_t t = (size_t)b * NT + n;
            sq[j][d] = qk[t * 512 + h * 64 + d];
            sk[j][d] = qk[t * 512 + 256 + h * 64 + d];
            sv[j][d] = p[t * DIN + P_MLV + h * 64 + d];
        }
        if (tid < 64) {
            int n = seq_token(s0 + tid, dir);
            size_t t = (size_t)b * NT + n;
            sa[tid] = __expf(G[t * 16 + (dir * 2) * 4 + h]);
            sf[tid] = __expf(G[t * 16 + (dir * 2 + 1) * 4 + h]);
        }
        __syncthreads();
        for (int j = 0; j < 64; ++j) {
            float a = sa[j], f = sf[j], vv = sv[j][vrow];
            float av = a * vv;
            float num = 0.f, den = 0.f;
#pragma unroll
            for (int i = 0; i < 16; ++i) {
                float kk = sk[j][part * 16 + i], qq = sq[j][part * 16 + i];
                C[i] = f * C[i] + av * kk;
                nn[i] = f * nn[i] + a * kk;
                num += C[i] * qq; den += nn[i] * qq;
            }
            num += __shfl_xor(num, 1); num += __shfl_xor(num, 2);
            den += __shfl_xor(den, 1); den += __shfl_xor(den, 2);
            if (part == 0) {
                int n = seq_token(s0 + j, dir);
                hdir[((size_t)dir * TT + (size_t)b * NT + n) * 256 + h * 64 + vrow] = num / fmaxf(fabsf(den), 1.f);
            }
        }
    }
}

__global__ __launch_bounds__(256) void k_ml_finish(const float* __restrict__ p, const float* __restrict__ hdir, const float* __restrict__ ml_norm, float* __restrict__ ycat) {
    int t = blockIdx.x; int c = threadIdx.x;
    float o = p[(size_t)t * DIN + P_MLO + c];
    float hv = sigmoidf_(o) * (hdir[(size_t)t * 256 + c] + hdir[((size_t)TT + t) * 256 + c]);
    float ss = hv * hv;
    for (int off = 32; off > 0; off >>= 1) ss += __shfl_xor(ss, off);
    float r = rsqrtf(ss * (1.f / 64.f) + 1e-6f);
    ycat[(size_t)t * DM + 256 + c] = hv * r * ml_norm[c];
}

__global__ __launch_bounds__(64) void k_s5_scan(const float* __restrict__ p, const float* __restrict__ abr, const float* __restrict__ abi,
                                                const float* __restrict__ bbr, const float* __restrict__ bbi,
                                                const float* __restrict__ c_re, const float* __restrict__ c_im, float* __restrict__ ys5  ) {
    __shared__ float su[64][16];
    __shared__ float xs[64][129];
    __shared__ float cr[16][64], ci[16][64];
    int g = blockIdx.x, b = blockIdx.y, dir = blockIdx.z;
    int lane = threadIdx.x;
    int sidx = (dir * 16 + g) * 64 + lane;
    float ar = abr[sidx], ai = abi[sidx];
    float br[16], bi[16];
#pragma unroll
    for (int h = 0; h < 16; ++h) { br[h] = bbr[(size_t)sidx * 16 + h]; bi[h] = bbi[(size_t)sidx * 16 + h]; }
    for (int i = lane; i < 16 * 64; i += 64) { cr[i >> 6][i & 63] = c_re[(size_t)(dir * 16 + g) * 1024 + i]; ci[i >> 6][i & 63] = c_im[(size_t)(dir * 16 + g) * 1024 + i]; }
    float xr = 0.f, xi = 0.f;
    for (int s0 = 0; s0 < NT; s0 += 64) {
        __syncthreads();
        for (int i = lane; i < 64 * 16; i += 64) {
            int j = i >> 4, hh = i & 15;
            int n = seq_token(s0 + j, dir);
            su[j][hh] = p[((size_t)b * NT + n) * DIN + P_S5 + g * 16 + hh];
        }
        __syncthreads();
#pragma unroll 1
        for (int j = 0; j < 64; ++j) {
            float ur = 0.f, ui = 0.f;
#pragma unroll
            for (int hh = 0; hh < 16; ++hh) { float u = su[j][hh]; ur += br[hh] * u; ui += bi[hh] * u; }
            float nr = ar * xr - ai * xi + ur;
            float ni = ar * xi + ai * xr + ui;
            xr = nr; xi = ni;
            xs[j][lane] = xr; xs[j][64 + lane] = xi;
        }
        __syncthreads();
        {
            int n = seq_token(s0 + lane, dir);
            float* yp = ys5 + ((size_t)dir * TT + (size_t)b * NT + n) * 256 + g * 16;
#pragma unroll 1
            for (int hh = 0; hh < 16; ++hh) {
                float y = 0.f;
#pragma unroll 4
                for (int pp = 0; pp < 64; ++pp) y += cr[hh][pp] * xs[lane][pp] - ci[hh][pp] * xs[lane][64 + pp];
                yp[hh] = y;
            }
        }
    }
}

__device__ __forceinline__ float gelu_tanh_(float x) {
    float u = 0.7978845608028654f * (x + 0.044715f * x * x * x);
    return 0.5f * x * (1.f + tanhf(u));
}
__global__ __launch_bounds__(256) void k_s5_gelu(const float* __restrict__ p, const float* __restrict__ ys5, const float* __restrict__ dsk, float* __restrict__ gl  ) {
    int t = blockIdx.x, c = threadIdx.x;
    float y = ys5[(size_t)t * 256 + c] + ys5[((size_t)TT + t) * 256 + c] + p[(size_t)t * DIN + P_S5 + c] * dsk[c];
    gl[(size_t)t * 256 + c] = gelu_tanh_(y);
}
__global__ __launch_bounds__(256) void k_s5_glu(const float* __restrict__ gl, const float* __restrict__ z, float* __restrict__ ycat) {
    int t = blockIdx.x, c = threadIdx.x;
    ycat[(size_t)t * DM + 768 + c] = gl[(size_t)t * 256 + c] * sigmoidf_(z[(size_t)t * 256 + c]);
}

__global__ __launch_bounds__(256) void k_post1(float* __restrict__ xall, const float* __restrict__ o, const float* __restrict__ nw1, const float* __restrict__ nw2,
                                               const float* __restrict__ modl, const float* __restrict__ w_router  , const float* __restrict__ b_router,
                                               float* __restrict__ f, int* __restrict__ top_e  , float* __restrict__ top_g  , int* __restrict__ cnt,
                                               int* __restrict__ pos  , int with_ctx) {
    __shared__ float red[8];
    __shared__ float lg[4][32];
    int t = blockIdx.x; int b = t / NT, n = t % NT;
    if (n < NC && !with_ctx) return;
    int r = (n < NC) ? 8 : b;
    const float* mr = modl + (size_t)r * 6144;
    int d = threadIdx.x * 4;
    float4 ov = *(const float4*)(o + (size_t)t * DM + d);
    float ss = ov.x * ov.x + ov.y * ov.y + ov.z * ov.z + ov.w * ov.w;
    ss = block_sum_256(ss, red);
    float rstd = rsqrtf(ss * (1.f / DM) + 1e-6f);
    float4 xv = *(const float4*)(xall + (size_t)t * DM + d);
    float4 w1 = *(const float4*)(nw1 + d);
    float4 g1 = *(const float4*)(mr + 2048 + d);
    xv.x += g1.x * ov.x * rstd * w1.x; xv.y += g1.y * ov.y * rstd * w1.y; xv.z += g1.z * ov.z * rstd * w1.z; xv.w += g1.w * ov.w * rstd * w1.w;
    *(float4*)(xall + (size_t)t * DM + d) = xv;
    float s2 = xv.x * xv.x + xv.y * xv.y + xv.z * xv.z + xv.w * xv.w;
    s2 = block_sum_256(s2, red);
    float rstd2 = rsqrtf(s2 * (1.f / DM) + 1e-6f);
    float4 w2 = *(const float4*)(nw2 + d);
    float4 sh = *(const float4*)(mr + 3072 + d);
    float4 sc = *(const float4*)(mr + 4096 + d);
    float fv[4];
    fv[0] = xv.x * rstd2 * w2.x * (1.f + sc.x) + sh.x;
    fv[1] = xv.y * rstd2 * w2.y * (1.f + sc.y) + sh.y;
    fv[2] = xv.z * rstd2 * w2.z * (1.f + sc.z) + sh.z;
    fv[3] = xv.w * rstd2 * w2.w * (1.f + sc.w) + sh.w;
    *(float4*)(f + (size_t)t * DM + d) = make_float4(fv[0], fv[1], fv[2], fv[3]);
    float part[32];
#pragma unroll
    for (int e = 0; e < 32; ++e) part[e] = 0.f;
#pragma unroll
    for (int q = 0; q < 4; ++q) {
        const float* wr = w_router + (size_t)(d + q) * 32;
#pragma unroll
        for (int e = 0; e < 32; ++e) part[e] += fv[q] * wr[e];
    }
#pragma unroll
    for (int e = 0; e < 32; ++e) {
        float v = part[e];
        for (int off = 32; off > 0; off >>= 1) v += __shfl_xor(v, off);
        part[e] = v;
    }
    __syncthreads();
    if ((threadIdx.x & 63) == 0) {
#pragma unroll
        for (int e = 0; e < 32; ++e) lg[threadIdx.x >> 6][e] = part[e];
    }
    __syncthreads();
    if (threadIdx.x < 32) lg[0][threadIdx.x] = lg[0][threadIdx.x] + lg[1][threadIdx.x] + lg[2][threadIdx.x] + lg[3][threadIdx.x] + b_router[threadIdx.x];
    __syncthreads();
    if (threadIdx.x == 0) {
        unsigned used = 0;
        int s0 = 0, s1 = 0, s2_ = 0, s3 = 0; float v0 = 0.f, v1 = 0.f, v2 = 0.f, v3 = 0.f;
        for (int k = 0; k < 4; ++k) {
            int best = 0; float bv = -3.4e38f;
            for (int e = 0; e < 32; ++e) { float lv = lg[0][e]; if (!((used >> e) & 1u) && lv > bv) { bv = lv; best = e; } }
            used |= 1u << best;
            if (k == 0) { s0 = best; v0 = bv; } else if (k == 1) { s1 = best; v1 = bv; } else if (k == 2) { s2_ = best; v2 = bv; } else { s3 = best; v3 = bv; }
        }
        float e0 = 1.f, e1 = __expf(v1 - v0), e2 = __expf(v2 - v0), e3 = __expf(v3 - v0);
        float inv = 1.f / (e0 + e1 + e2 + e3);
        top_e[(size_t)t * 4 + 0] = s0; top_e[(size_t)t * 4 + 1] = s1; top_e[(size_t)t * 4 + 2] = s2_; top_e[(size_t)t * 4 + 3] = s3;
        top_g[(size_t)t * 4 + 0] = e0 * inv; top_g[(size_t)t * 4 + 1] = e1 * inv; top_g[(size_t)t * 4 + 2] = e2 * inv; top_g[(size_t)t * 4 + 3] = e3 * inv;
        pos[(size_t)t * 4 + 0] = atomicAdd(&cnt[s0], 1); pos[(size_t)t * 4 + 1] = atomicAdd(&cnt[s1], 1);
        pos[(size_t)t * 4 + 2] = atomicAdd(&cnt[s2_], 1); pos[(size_t)t * 4 + 3] = atomicAdd(&cnt[s3], 1);
    }
}

__global__ void k_moe_offsets(const int* __restrict__ cnt, int* __restrict__ off, int* __restrict__ tile_e, int* __restrict__ ntiles) {
    if (threadIdx.x != 0) return;
    int o = 0, nt = 0;
    for (int e = 0; e < NE; ++e) {
        off[e] = o; int c = cnt[e];
        for (int m = 0; m < c; m += 256) { tile_e[nt] = e; ++nt; }
        o = nt * 256;
    }
    ntiles[0] = nt;
}
__global__ void k_moe_scatter(const int* __restrict__ top_e, const int* __restrict__ pos, const int* __restrict__ off, int* __restrict__ slot_token, int* __restrict__ tok_slot, int with_ctx) {
    int i = blockIdx.x * 256 + threadIdx.x;
    if (i >= NASSIGN) return;
    int t = i >> 2; int n = t % NT;
    if (n < NC && !with_ctx) return;
    int slot = off[top_e[i]] + pos[i];
    slot_token[slot] = t; tok_slot[i] = slot;
}

__global__ __launch_bounds__(256) void k_combine(float* __restrict__ xall, const float* __restrict__ yexp, const int* __restrict__ tok_slot, const float* __restrict__ top_g,
                                                 const float* __restrict__ nw3, const float* __restrict__ modl, int with_ctx) {
    __shared__ float red[8];
    int t = blockIdx.x; int b = t / NT, n = t % NT;
    if (n < NC && !with_ctx) return;
    int r = (n < NC) ? 8 : b;
    int d = threadIdx.x * 4;
    float4 m = make_float4(0.f, 0.f, 0.f, 0.f);
#pragma unroll
    for (int k = 0; k < 4; ++k) {
        int slot = tok_slot[(size_t)t * 4 + k]; float gk = top_g[(size_t)t * 4 + k];
        float4 y = *(const float4*)(yexp + (size_t)slot * DM + d);
        m.x += gk * y.x; m.y += gk * y.y; m.z += gk * y.z; m.w += gk * y.w;
    }
    float ss = m.x * m.x + m.y * m.y + m.z * m.z + m.w * m.w;
    ss = block_sum_256(ss, red);
    float rstd = rsqrtf(ss * (1.f / DM) + 1e-6f);
    float4 w3 = *(const float4*)(nw3 + d);
    float4 g2 = *(const float4*)(modl + (size_t)r * 6144 + 5120 + d);
    float4 xv = *(const float4*)(xall + (size_t)t * DM + d);
    xv.x += g2.x * m.x * rstd * w3.x; xv.y += g2.y * m.y * rstd * w3.y; xv.z += g2.z * m.z * rstd * w3.z; xv.w += g2.w * m.w * rstd * w3.w;
    *(float4*)(xall + (size_t)t * DM + d) = xv;
}

__global__ void k_out(const float* __restrict__ xall, float* __restrict__ out) {
    size_t i = (size_t)blockIdx.x * 256 + threadIdx.x;
    size_t total = (size_t)NB * NS * DM / 4;
    if (i >= total) return;
    size_t t = i / (DM / 4); int d4 = (int)(i % (DM / 4));
    int b = (int)(t / NS), n = (int)(t % NS);
    ((float4*)out)[i] = ((const float4*)(xall + ((size_t)b * NT + NC + n) * DM))[d4];
}

static void launch_gemm(hipStream_t st, const float* A, int lda, const float* B, int ldb, float* C, int ldc, const float* bias, int M, int N, int K) {
    GemmArgs g{}; g.A = A; g.B = B; g.C = C; g.bias = bias; g.M = M; g.N = N; g.K = K; g.lda = lda; g.ldb = ldb; g.ldc = ldc;
    dim3 grid((N + 63) / 64, (M + 63) / 64);
    k_gemm<0><<<grid, 256, 0, st>>>(g);
}

extern "C" void kernel_launch(void* const* d_in, const int* in_sizes, int n_in, void* d_out, int out_size, void* d_ws, size_t ws_size, hipStream_t stream) {
    const float* x = (const float*)d_in[0]; const float* c = (const float*)d_in[1]; const float* ctx = (const float*)d_in[2]; const float* c_ctx = (const float*)d_in[3];
    const float* w_mod = (const float*)d_in[4]; const float* b_mod = (const float*)d_in[5]; const float* norm_w = (const float*)d_in[6];
    const float* w_in = (const float*)d_in[7]; const float* w_out = (const float*)d_in[8]; const float* da_lambda = (const float*)d_in[9]; const float* da_subln = (const float*)d_in[10];
    const float* ml_conv_w = (const float*)d_in[11]; const float* ml_conv_b = (const float*)d_in[12]; const float* ml_gate_b = (const float*)d_in[13]; const float* ml_norm = (const float*)d_in[14];
    const float* mla_q_norm = (const float*)d_in[15]; const float* mla_w_uq = (const float*)d_in[16]; const float* mla_kv_norm = (const float*)d_in[17]; const float* mla_w_ukv = (const float*)d_in[18];
    const float* s5_a_re = (const float*)d_in[19]; const float* s5_a_im = (const float*)d_in[20]; const float* s5_log_step = (const float*)d_in[21];
    const float* s5_b_re = (const float*)d_in[22]; const float* s5_b_im = (const float*)d_in[23]; const float* s5_c_re = (const float*)d_in[24]; const float* s5_c_im = (const float*)d_in[25];
    const float* s5_d = (const float*)d_in[26]; const float* s5_w_glu = (const float*)d_in[27]; const float* s5_b_glu = (const float*)d_in[28];
    const float* moe_w_router = (const float*)d_in[29]; const float* moe_b_router = (const float*)d_in[30]; const float* moe_w_gate_up = (const float*)d_in[31];
    const float* moe_b_gate_up = (const float*)d_in[32]; const float* moe_w_down = (const float*)d_in[33]; const float* moe_b_down = (const float*)d_in[34];
    float* out = (float*)d_out;

    char* ws = (char*)d_ws; size_t off = 0;
    auto carve = [&](size_t bytes) { void* p = ws + off; off += (bytes + 255) & ~(size_t)255; return p; };
    float* xall = (float*)carve((size_t)TT * DM * 4);
    float* mod = (float*)carve((size_t)2 * 9 * 6144 * 4);
    float* ropecs = (float*)carve((size_t)NS * 16 * 2 * 4);
    float* lamfull = (float*)carve(256);
    float* abr = (float*)carve(4096 * 4); float* abi = (float*)carve(4096 * 4);
    float* bbr = (float*)carve(4096 * 16 * 4); float* bbi = (float*)carve(4096 * 16 * 4);
    bf16_t* w_in_t = (bf16_t*)carve((size_t)2 * 2560 * 1024 * 2);
    bf16_t* w_out_t = (bf16_t*)carve((size_t)2 * 1024 * 1024 * 2);
    bf16_t* wgu_t = (bf16_t*)carve((size_t)2 * NE * 2048 * 1024 * 2);
    bf16_t* wdn_t = (bf16_t*)carve((size_t)2 * NE * 1024 * 1024 * 2);
    bf16_t* hbuf = (bf16_t*)carve((size_t)TT * DM * 2);
    float* ycat = (float*)carve((size_t)TT * DM * 4);
    bf16_t* ycatb = (bf16_t*)carve((size_t)TT * DM * 2);
    float* obuf = (float*)carve((size_t)TT * DM * 4);
    float* fbuf = (float*)carve((size_t)TT * DM * 4);
    int* top_e = (int*)carve((size_t)NASSIGN * 4); float* top_g = (float*)carve((size_t)NASSIGN * 4); int* posb = (int*)carve((size_t)NASSIGN * 4);
    int* tok_slot = (int*)carve((size_t)NASSIGN * 4); int* slot_token = (int*)carve((size_t)MAXSLOTS * 4);
    int* cnt = (int*)carve(256); int* offs = (int*)carve(256); int* ntiles = (int*)carve(256);
    int* tile_e = (int*)carve(512 * 4);
    bf16_t* act = (bf16_t*)carve((size_t)MAXSLOTS * DM * 2);
    size_t zone0 = off;
    float* p = (float*)carve((size_t)TT * DIN * 4);
    float* daQ = (float*)carve((size_t)TT * 256 * 4); float* daK = (float*)carve((size_t)TT * 256 * 4); float* daV = (float*)carve((size_t)TT * 256 * 4);
    float* cqn = (float*)carve((size_t)TT * 192 * 4); float* ckvn = (float*)carve((size_t)TT * 128 * 4);
    float* qfull = (float*)carve((size_t)TT * 384 * 4); float* kvfull = (float*)carve((size_t)TT * 512 * 4);
    float* mQ = (float*)carve((size_t)TT * 384 * 4); float* mK = (float*)carve((size_t)TT * 384 * 4); float* mV = (float*)carve((size_t)TT * 256 * 4);
    float* mlqk = (float*)carve((size_t)TT * 512 * 4); float* mlG = (float*)carve((size_t)TT * 16 * 4); float* hdir = (float*)carve((size_t)2 * TT * 256 * 4);
    float* ys5 = (float*)carve((size_t)2 * TT * 256 * 4); float* gl = (float*)carve((size_t)TT * 256 * 4); float* zglu = (float*)carve((size_t)TT * 256 * 4);
    size_t zone1 = off;
    float* yexp = (float*)(ws + zone0);
    bf16_t* xg = (bf16_t*)(ws + zone0 + (size_t)MAXSLOTS * DM * 4);
    if (zone0 + (size_t)MAXSLOTS * DM * 6 > zone1) off = zone0 + (size_t)MAXSLOTS * DM * 6;
    if (off > ws_size) { fprintf(stderr, "workspace too small: need %zu have %zu\n", off, ws_size); return; }

    static bool attr_done = false;
    if (!attr_done) {
        (void)hipFuncSetAttribute((const void*)k_pg8_static<pg8::EpiF32>, hipFuncAttributeMaxDynamicSharedMemorySize, pg8::STAGE_BYTES);
        (void)hipFuncSetAttribute((const void*)k_pg8_grouped<pg8::EpiSwiglu>, hipFuncAttributeMaxDynamicSharedMemorySize, pg8::STAGE_BYTES);
        (void)hipFuncSetAttribute((const void*)k_pg8_grouped<pg8::EpiDown>, hipFuncAttributeMaxDynamicSharedMemorySize, pg8::STAGE_BYTES);
        attr_done = true;
    }

    k_build_x<<<(TT * DM / 4 + 255) / 256, 256, 0, stream>>>(x, ctx, xall);
    k_mod<<<2 * 6144 / 256, 256, 0, stream>>>(c, c_ctx, w_mod, b_mod, mod);
    k_rope_table<<<NS * 16 / 256, 256, 0, stream>>>(ropecs);
    k_lambda<<<1, 64, 0, stream>>>(da_lambda, lamfull);
    k_s5_disc<<<4096 / 256, 256, 0, stream>>>(s5_a_re, s5_a_im, s5_log_step, s5_b_re, s5_b_im, abr, abi, bbr, bbi);
    (void)hipMemsetAsync(w_in_t, 0, (size_t)2 * 2560 * 1024 * 2, stream);
    k_convT<0><<<dim3((DINC + 63) / 64, 16, 2), 256, 0, stream>>>(w_in, 1024, DINC, w_in_t, 1024, 0, 0, (long)1024 * DINC, (long)2560 * 1024);
    k_convT<0><<<dim3(16, 16, 2), 256, 0, stream>>>(w_out, 1024, 1024, w_out_t, 1024, 0, 0, (long)1024 * 1024, (long)1024 * 1024);
    k_convT<1><<<dim3(32, 16, 2 * NE), 256, 0, stream>>>(moe_w_gate_up, 1024, 2048, wgu_t, 1024, 0, 0, (long)1024 * 2048, (long)2048 * 1024);
    k_convT<0><<<dim3(16, 16, 2 * NE), 256, 0, stream>>>(moe_w_down, 1024, 1024, wdn_t, 1024, 0, 0, (long)1024 * 1024, (long)1024 * 1024);

    for (int l = 0; l < 2; ++l) {
        int with_ctx = (l == 0);
        float lambda_init = (float)(0.8 - 0.6 * exp(-0.3 * l));
        const float* modl = mod + (size_t)l * 9 * 6144;
        const float* nw = norm_w + (size_t)l * 4 * 1024;
        k_norm_mod<<<TT, 256, 0, stream>>>(xall, nw, modl, 0, 1024, hbuf);
        {
            pg8::Gemm g{hbuf, w_in_t + (size_t)l * 2560 * 1024, TT, 2560, 1024, 0};
            pg8::EpiF32 E{p, nullptr, DIN, 0};
            k_pg8_static<pg8::EpiF32><<<256, 512, pg8::STAGE_BYTES, stream>>>(g, E);
        }
        k_da_prep<<<TT, 256, 0, stream>>>(p, ropecs, daQ, daK, daV);
        k_attn<64, 2, 64, true><<<dim3(NT / 64, 4, NB), 64, 0, stream>>>(daQ, daK, daV, ycat, 0, lamfull + l, da_subln + l * 64, 1.f - lambda_init, 0.17677669529663687f, with_ctx);
        k_mla_norm<<<TT, 64, 0, stream>>>(p, mla_q_norm + l * 192, mla_kv_norm + l * 128, cqn, ckvn);
        launch_gemm(stream, cqn, 192, mla_w_uq + (size_t)l * 192 * 384, 384, qfull, 384, nullptr, TT, 384, 192);
        launch_gemm(stream, ckvn, 128, mla_w_ukv + (size_t)l * 128 * 512, 512, kvfull, 512, nullptr, TT, 512, 128);
        k_mla_layout<<<TT, 128, 0, stream>>>(p, qfull, kvfull, ropecs, mQ, mK, mV);
        k_attn<96, 1, 64, false><<<dim3(NT / 64, 4, NB), 64, 0, stream>>>(mQ, mK, mV, ycat, 512, lamfull, nullptr, 1.f, 0.10206207261596575f, with_ctx);
        k_ml_prep<<<TT, 256, 0, stream>>>(p, ml_conv_w + l * 3 * 512, ml_conv_b + l * 512, ml_gate_b + l * 16, mlqk, mlG);
        k_mlstm<<<dim3(4, NB, 2), 256, 0, stream>>>(mlqk, p, mlG, hdir);
        k_ml_finish<<<TT, 256, 0, stream>>>(p, hdir, ml_norm + l * 256, ycat);
        k_s5_scan<<<dim3(16, NB, 2), 64, 0, stream>>>(p, abr + l * 2048, abi + l * 2048, bbr + (size_t)l * 2048 * 16, bbi + (size_t)l * 2048 * 16,
                                                      s5_c_re + (size_t)l * 2 * 16 * 1024, s5_c_im + (size_t)l * 2 * 16 * 1024, ys5);
        k_s5_gelu<<<TT, 256, 0, stream>>>(p, ys5, s5_d + l * 256, gl);
        launch_gemm(stream, gl, 256, s5_w_glu + (size_t)l * 256 * 256, 256, zglu, 256, s5_b_glu + l * 256, TT, 256, 256);
        k_s5_glu<<<TT, 256, 0, stream>>>(gl, zglu, ycat);
        k_to_bf16_rows<<<TT, 256, 0, stream>>>(ycat, ycatb);
        {
            pg8::Gemm g{ycatb, w_out_t + (size_t)l * 1024 * 1024, TT, 1024, 1024, 0};
            pg8::EpiF32 E{obuf, nullptr, DM, 0};
            k_pg8_static<pg8::EpiF32><<<256, 512, pg8::STAGE_BYTES, stream>>>(g, E);
        }
        (void)hipMemsetAsync(cnt, 0, 128, stream);
        (void)hipMemsetAsync(slot_token, 0xFF, (size_t)MAXSLOTS * 4, stream);
        k_post1<<<TT, 256, 0, stream>>>(xall, obuf, nw + 1024, nw + 2048, modl, moe_w_router + (size_t)l * 1024 * 32, moe_b_router + l * 32, fbuf, top_e, top_g, cnt, posb, with_ctx);
        k_moe_offsets<<<1, 64, 0, stream>>>(cnt, offs, tile_e, ntiles);
        k_moe_scatter<<<NASSIGN / 256, 256, 0, stream>>>(top_e, posb, offs, slot_token, tok_slot, with_ctx);
        k_moe_gather<<<MAXSLOTS, 256, 0, stream>>>(fbuf, slot_token, ntiles, xg);
        {
            pg8::Gemm g{xg, wgu_t + (size_t)l * NE * 2048 * 1024, 0, 2048, 1024, 0};
            pg8::EpiSwiglu E{act, moe_b_gate_up + (size_t)l * NE * 2048};
            k_pg8_grouped<pg8::EpiSwiglu><<<256, 512, pg8::STAGE_BYTES, stream>>>(g, E, ntiles, tile_e);
        }
        {
            pg8::Gemm g{act, wdn_t + (size_t)l * NE * 1024 * 1024, 0, 1024, 1024, 0};
            pg8::EpiDown E{yexp, moe_b_down + (size_t)l * NE * 1024};
            k_pg8_grouped<pg8::EpiDown><<<256, 512, pg8::STAGE_BYTES, stream>>>(g, E, ntiles, tile_e);
        }
        k_combine<<<TT, 256, 0, stream>>>(xall, yexp, tok_slot, top_g, nw + 3072, modl, with_ctx);
    }
    k_out<<<(NB * NS * DM / 4 + 255) / 256, 256, 0, stream>>>(xall, out);
}
```

```cpp
#include <hip/hip_runtime.h>
#include <cstdint>
#include <cstdio>

#define NB 8
#define NS 2048
#define NC 256
#define NT 2304
#define TT (NB * NT)
#define DM 1024
#define DIN 2560
#define DINC 2416
#define NE 32
#define NASSIGN (TT * 4)
#define MAXSLOTS (NASSIGN + NE * 256)

#define P_DAQ 0
#define P_DAK 256
#define P_DAV 512
#define P_MLQK 768
#define P_MLV 1280
#define P_MLO 1536
#define P_MLG 1792
#define P_CQ 1808
#define P_CKV 2000
#define P_KR 2128
#define P_S5 2160

__device__ __forceinline__ float sigmoidf_(float x) { return 1.f / (1.f + __expf(-x)); }
__device__ __forceinline__ float siluf_(float x) { return x / (1.f + __expf(-x)); }
__device__ __forceinline__ float logsigmoidf_(float x) { return fminf(x, 0.f) - log1pf(__expf(-fabsf(x))); }

__device__ __forceinline__ float block_sum_256(float v, float* red) {
    for (int o = 32; o > 0; o >>= 1) v += __shfl_xor(v, o);
    __syncthreads();
    if ((threadIdx.x & 63) == 0) red[threadIdx.x >> 6] = v;
    __syncthreads();
    float r = red[0] + red[1] + red[2] + red[3];
    return r;
}


typedef unsigned short bf16_t;
__device__ __forceinline__ bf16_t f2bf(float f) { unsigned u = __float_as_uint(f); u += 0x7FFFu + ((u >> 16) & 1u); return (bf16_t)(u >> 16); }
__device__ __forceinline__ float bf2f(bf16_t b) { return __uint_as_float(((unsigned)b) << 16); }
__device__ __forceinline__ unsigned pk2bf(float lo, float hi) { return (unsigned)f2bf(lo) | ((unsigned)f2bf(hi) << 16); }

namespace pg8 {
#define PG8_LAS __attribute__((address_space(3)))
typedef short bf16x8 __attribute__((ext_vector_type(8)));
typedef float f32x4 __attribute__((ext_vector_type(4)));
typedef unsigned u32x4 __attribute__((ext_vector_type(4)));
constexpr int BM = 256, BK = 64, HALF = 128, HTB = HALF * BK * 2, STAGE_BYTES = 8 * HTB, NXCD = 8, WGM = 8;
__host__ __device__ __forceinline__ int lds_byte(int r, int c) { const int st = (r >> 4) * 2 + (c >> 5), rr = r & 15, cc = c & 31, ob = rr * 64 + cc * 2; return st * 1024 + (ob ^ (((ob >> 9) & 1) << 5)); }
__host__ __device__ __forceinline__ void stage_rc(int b, int& R, int& C) { const int st = b / 1024, sb = b % 1024, swz = sb ^ (((sb >> 9) & 1) << 5); R = (st >> 1) * 16 + swz / 64; C = (st & 1) * 32 + (swz % 64) / 2; }
__host__ __device__ __forceinline__ int perm32(int rho) { const int n = rho >> 4, i = rho & 15; return 8 * (i >> 2) + 4 * n + (i & 3); }
struct Unit { int pm, pn; };
struct Gemm { const bf16_t* A; const bf16_t* Bt; int M, N, K, pad; };
__device__ __forceinline__ unsigned cvt_pk_bf16(float lo, float hi) { unsigned r; asm volatile("v_cvt_pk_bf16_f32 %0, %1, %2" : "=v"(r) : "v"(lo), "v"(hi)); return r; }

struct StaticOrder {
    int nM, nN, nwg, G, c;
    __device__ void init(int M, int N, int G_, int c_) { nM = M / BM; nN = N / BM; nwg = nM * nN; G = G_; c = c_; }
    __device__ bool next(int i, Unit& u) const {
        const long L = (long)i * G + c; if (L >= nwg) return false;
        int wgid = (int)L; { const int q = nwg / NXCD, r = nwg % NXCD, xcd = wgid % NXCD, off = wgid / NXCD; wgid = (xcd < r ? xcd * (q + 1) : r * (q + 1) + (xcd - r) * q) + off; }
        const int nig = WGM * nN, gid = wgid / nig, fm = gid * WGM, gsz = (nM - fm) < WGM ? (nM - fm) : WGM;
        u.pm = fm + ((wgid % nig) % gsz); u.pn = (wgid % nig) / gsz; return true;
    }
    __device__ __forceinline__ void a_ready(const Unit&) const {}
    __device__ __forceinline__ void done(const Unit&) const {}
};
struct GroupedOrder : StaticOrder {
    const int* tile_e;
    __device__ void initg(const int* ntiles_p, const int* tile_e_, int N, int G_, int c_) { nM = ntiles_p[0]; nN = N / BM; nwg = nM * nN; G = G_; c = c_; tile_e = tile_e_; }
    __device__ bool next(int i, Unit& u) const { if (!StaticOrder::next(i, u)) return false; u.pn += tile_e[u.pm] * nN; return true; }
};

struct EpiF32 {
    static constexpr bool PERM = false;
    float* C; const float* bias; int ldc, pad;
    __device__ __forceinline__ void operator()(const f32x4 (&acc)[2][2][4][2], const Unit& u, int wr, int wc, int fr, int fq) const {
        const int row0 = u.pm * BM + wr * 64 + fr, col0 = u.pn * BM + wc * 32 + 4 * fq;
        f32x4 bv[2][2];
#pragma unroll
        for (int bj = 0; bj < 2; ++bj)
#pragma unroll
            for (int n = 0; n < 2; ++n) bv[bj][n] = bias ? *(const f32x4*)(bias + col0 + bj * HALF + n * 16) : (f32x4){0.f, 0.f, 0.f, 0.f};
#pragma unroll
        for (int ai = 0; ai < 2; ++ai)
#pragma unroll
            for (int m = 0; m < 4; ++m) { float* rowp = C + (size_t)(row0 + ai * HALF + m * 16) * ldc + col0;
#pragma unroll
                for (int bj = 0; bj < 2; ++bj)
#pragma unroll
                    for (int n = 0; n < 2; ++n) *(f32x4*)(rowp + bj * HALF + n * 16) = acc[ai][bj][m][n] + bv[bj][n]; }
    }
};
struct EpiDown {
    static constexpr bool PERM = false;
    float* C; const float* bias;
    __device__ __forceinline__ void operator()(const f32x4 (&acc)[2][2][4][2], const Unit& u, int wr, int wc, int fr, int fq) const {
        const int e = u.pn >> 2, pnl = u.pn & 3;
        const int row0 = u.pm * BM + wr * 64 + fr, col0 = pnl * BM + wc * 32 + 4 * fq;
        const float* bp = bias + (size_t)e * 1024;
        f32x4 bv[2][2];
#pragma unroll
        for (int bj = 0; bj < 2; ++bj)
#pragma unroll
            for (int n = 0; n < 2; ++n) bv[bj][n] = *(const f32x4*)(bp + col0 + bj * HALF + n * 16);
#pragma unroll
        for (int ai = 0; ai < 2; ++ai)
#pragma unroll
            for (int m = 0; m < 4; ++m) { float* rowp = C + (size_t)(row0 + ai * HALF + m * 16) * 1024 + col0;
#pragma unroll
                for (int bj = 0; bj < 2; ++bj)
#pragma unroll
                    for (int n = 0; n < 2; ++n) *(f32x4*)(rowp + bj * HALF + n * 16) = acc[ai][bj][m][n] + bv[bj][n]; }
    }
};
struct EpiSwiglu {
    static constexpr bool PERM = true;
    bf16_t* O; const float* bias;
    __device__ __forceinline__ void operator()(const f32x4 (&acc)[2][2][4][2], const Unit& u, int wr, int wc, int fr, int fq) const {
        const int e = u.pn >> 3, pnl = u.pn & 7;
        const int row0 = u.pm * BM + wr * 64 + fr, col0 = pnl * HALF + wc * 32 + 8 * fq;
        const float* bp = bias + (size_t)e * 2048 + col0;
        f32x4 bg[2], bu[2];
#pragma unroll
        for (int n = 0; n < 2; ++n) { bg[n] = *(const f32x4*)(bp + 4 * n); bu[n] = *(const f32x4*)(bp + 1024 + 4 * n); }
#pragma unroll
        for (int ai = 0; ai < 2; ++ai)
#pragma unroll
            for (int m = 0; m < 4; ++m) {
                bf16_t* rowp = O + (size_t)(row0 + ai * HALF + m * 16) * 1024 + col0;
                float r[8];
#pragma unroll
                for (int n = 0; n < 2; ++n) {
                    f32x4 g = acc[ai][0][m][n] + bg[n], up = acc[ai][1][m][n] + bu[n];
#pragma unroll
                    for (int j = 0; j < 4; ++j) {
                        float gt = fminf(g[j], 7.f), uu = fminf(fmaxf(up[j], -7.f), 7.f);
                        r[n * 4 + j] = (uu + 1.f) * gt / (1.f + __expf(-1.702f * gt));
                    }
                }
                u32x4 w; w.x = cvt_pk_bf16(r[0], r[1]); w.y = cvt_pk_bf16(r[2], r[3]); w.z = cvt_pk_bf16(r[4], r[5]); w.w = cvt_pk_bf16(r[6], r[7]);
                *(u32x4*)rowp = w;
            }
    }
};

template <class Epi, class Sched>
__device__ __forceinline__ void gemm_phase(PG8_LAS unsigned char* lds, const Gemm g, const Sched& S, const Epi& E) {
    const int tid = threadIdx.x, wid = __builtin_amdgcn_readfirstlane(tid >> 6), lane = tid & 63, wr = wid >> 2, wc = wid & 3, fr = lane & 15, fq = lane >> 4;
    const int K = g.K, nt = K / BK;
    unsigned voffA[2], voffB[2];
#pragma unroll
    for (int i = 0; i < 2; ++i) { int R, C; stage_rc(tid * 16 + i * 8192, R, C); const int Rb = Epi::PERM ? ((R & ~31) + perm32(R & 31)) : R;
        voffA[i] = (unsigned)(R * K + C) * 2u; voffB[i] = (unsigned)(Rb * K + C) * 2u; }
    const size_t kstep = (size_t)(BK * 2);
    const size_t hstep = (size_t)HALF * K * 2;
    const size_t tstep = 2 * hstep;
    const unsigned ldsw = (unsigned)wid * 1024u;
    const int aoff = lds_byte(wr * 64 + fr, fq * 8), boff = lds_byte(wc * 32 + fr, fq * 8);
#define PG8_SA(b, h) (((b) * 2 + (h)) * HTB)
#define PG8_SB(b, h) ((4 + (b) * 2 + (h)) * HTB)
#define PG8_STAGE(bufoff, gbase, voff) do { _Pragma("unroll") for (int _i = 0; _i < 2; ++_i) \
        __builtin_amdgcn_global_load_lds((const unsigned*)((const char*)(gbase) + (voff)[_i]), (PG8_LAS unsigned*)(lds + (bufoff) + ldsw + _i * 8192), 16, 0, 0); } while (0)
#define PG8_LDA(dst, b, h) do { _Pragma("unroll") for (int m = 0; m < 4; ++m) _Pragma("unroll") for (int k = 0; k < 2; ++k) dst[m][k] = *(const PG8_LAS bf16x8*)(lds + PG8_SA(b, h) + aoff + m * 2048 + k * 1024); } while (0)
#define PG8_LDB(dst, b, h) do { _Pragma("unroll") for (int n = 0; n < 2; ++n) _Pragma("unroll") for (int k = 0; k < 2; ++k) dst[n][k] = *(const PG8_LAS bf16x8*)(lds + PG8_SB(b, h) + boff + n * 2048 + k * 1024); } while (0)
#define PG8_MMA(ai, bj, At, Bt) do { __builtin_amdgcn_s_setprio(1); _Pragma("unroll") for (int m = 0; m < 4; ++m) _Pragma("unroll") for (int n = 0; n < 2; ++n) _Pragma("unroll") for (int k = 0; k < 2; ++k) \
        acc[ai][bj][m][n] = __builtin_amdgcn_mfma_f32_16x16x32_bf16(Bt[n][k], At[m][k], acc[ai][bj][m][n], 0, 0, 0); __builtin_amdgcn_s_setprio(0); } while (0)
#define PG8_WAIT_V(n) asm volatile("s_waitcnt vmcnt(" #n ")" ::: "memory")
#define PG8_WAIT_L(n) asm volatile("s_waitcnt lgkmcnt(" #n ")" ::: "memory")
#define PG8_BAR __builtin_amdgcn_s_barrier()
#define PG8_SCHED __builtin_amdgcn_sched_barrier(0)
    Unit cur, nxt; int ui = 0;
    if (!S.next(0, cur)) return;
    f32x4 acc[2][2][4][2];
#pragma unroll
    for (int a = 0; a < 2; ++a)
#pragma unroll
        for (int b = 0; b < 2; ++b)
#pragma unroll
            for (int m = 0; m < 4; ++m)
#pragma unroll
                for (int n = 0; n < 2; ++n) acc[a][b][m][n] = (f32x4){0.f, 0.f, 0.f, 0.f};
    bf16x8 At[4][2], B0[2][2], B1[2][2];
    const char* cA = (const char*)g.A + (size_t)cur.pm * tstep; const char* cB = (const char*)g.Bt + (size_t)cur.pn * tstep;
    S.a_ready(cur);
    PG8_STAGE(PG8_SB(0, 0), cB, voffB); PG8_STAGE(PG8_SA(0, 0), cA, voffA); PG8_STAGE(PG8_SB(0, 1), cB + hstep, voffB); PG8_STAGE(PG8_SA(0, 1), cA + hstep, voffA);
    if (wr == 1) PG8_BAR;
    PG8_WAIT_V(4); PG8_BAR;
    PG8_STAGE(PG8_SB(1, 0), cB + kstep, voffB); PG8_STAGE(PG8_SA(1, 0), cA + kstep, voffA); PG8_STAGE(PG8_SB(1, 1), cB + hstep + kstep, voffB);
    PG8_WAIT_V(6); PG8_BAR;
    for (;;) {
        const bool has_next = S.next(ui + 1, nxt);
        const char* nA = has_next ? (const char*)g.A + (size_t)nxt.pm * tstep : cA; const char* nB = has_next ? (const char*)g.Bt + (size_t)nxt.pn * tstep : cB;
        for (int t = 0; t < nt; t += 2) {
            const bool last = (t == nt - 2);
            const char* a1 = cA + (size_t)(t + 1) * kstep;
            const char* a2 = last ? nA : cA + (size_t)(t + 2) * kstep; const char* b2 = last ? nB : cB + (size_t)(t + 2) * kstep;
            const char* a3 = a2 + kstep; const char* b3 = b2 + kstep;
            if (last && has_next) S.a_ready(nxt);
            PG8_LDB(B0, 0, 0); PG8_SCHED; PG8_LDA(At, 0, 0); PG8_STAGE(PG8_SA(1, 1), a1 + hstep, voffA);
            PG8_WAIT_L(8); PG8_BAR; PG8_WAIT_L(0); PG8_MMA(0, 0, At, B0); PG8_BAR; PG8_SCHED;
            PG8_LDB(B1, 0, 1); PG8_STAGE(PG8_SB(0, 0), b2, voffB);
            PG8_BAR; PG8_WAIT_L(0); PG8_MMA(0, 1, At, B1); PG8_BAR;
            PG8_LDA(At, 0, 1); PG8_STAGE(PG8_SA(0, 0), a2, voffA);
            PG8_BAR; PG8_WAIT_L(0); PG8_MMA(1, 0, At, B0); PG8_BAR; PG8_SCHED;
            PG8_STAGE(PG8_SB(0, 1), b2 + hstep, voffB);
            PG8_WAIT_V(6); PG8_BAR; PG8_MMA(1, 1, At, B1); PG8_BAR;
            PG8_LDB(B0, 1, 0); PG8_SCHED; PG8_LDA(At, 1, 0); PG8_STAGE(PG8_SA(0, 1), a2 + hstep, voffA);
            PG8_WAIT_L(8); PG8_BAR; PG8_WAIT_L(0); PG8_MMA(0, 0, At, B0); PG8_BAR; PG8_SCHED;
            PG8_LDB(B1, 1, 1); PG8_STAGE(PG8_SB(1, 0), b3, voffB);
            PG8_BAR; PG8_WAIT_L(0); PG8_MMA(0, 1, At, B1); PG8_BAR;
            PG8_LDA(At, 1, 1); PG8_STAGE(PG8_SA(1, 0), a3, voffA);
            PG8_BAR; PG8_WAIT_L(0); PG8_MMA(1, 0, At, B0); PG8_BAR; PG8_SCHED;
            PG8_STAGE(PG8_SB(1, 1), b3 + hstep, voffB);
            PG8_WAIT_V(6); PG8_BAR; PG8_MMA(1, 1, At, B1); PG8_BAR;
        }
        E(acc, cur, wr, wc, fr, fq); S.done(cur);
        if (!has_next) break;
#pragma unroll
        for (int a = 0; a < 2; ++a)
#pragma unroll
            for (int b = 0; b < 2; ++b)
#pragma unroll
                for (int m = 0; m < 4; ++m)
#pragma unroll
                    for (int n = 0; n < 2; ++n) acc[a][b][m][n] = (f32x4){0.f, 0.f, 0.f, 0.f};
        cur = nxt; cA = nA; cB = nB; ++ui;
    }
    PG8_WAIT_V(0);
    if (wr == 0) PG8_BAR;
    PG8_BAR;
#undef PG8_SA
#undef PG8_SB
#undef PG8_STAGE
#undef PG8_LDA
#undef PG8_LDB
#undef PG8_MMA
#undef PG8_WAIT_V
#undef PG8_WAIT_L
#undef PG8_BAR
#undef PG8_SCHED
}
}

extern __shared__ __attribute__((aligned(16))) unsigned char dyn_lds[];
template <class Epi>
__global__ __launch_bounds__(512, 2) void k_pg8_static(pg8::Gemm g, Epi E) {
    pg8::StaticOrder S; S.init(g.M, g.N, gridDim.x, blockIdx.x);
    pg8::gemm_phase<Epi, pg8::StaticOrder>((PG8_LAS unsigned char*)dyn_lds, g, S, E);
}
template <class Epi>
__global__ __launch_bounds__(512, 2) void k_pg8_grouped(pg8::Gemm g, Epi E, const int* ntiles, const int* tile_e) {
    pg8::GroupedOrder S; S.initg(ntiles, tile_e, g.N, gridDim.x, blockIdx.x);
    pg8::gemm_phase<Epi, pg8::GroupedOrder>((PG8_LAS unsigned char*)dyn_lds, g, S, E);
}

template <int MODE>
__global__ __launch_bounds__(256) void k_convT(const float* __restrict__ W, int K, int N, bf16_t* __restrict__ WT, int ldt, int roff, int koff, long strideW, long strideT) {
    __shared__ float tile[64][65];
    W += (size_t)blockIdx.z * strideW; WT += (size_t)blockIdx.z * strideT;
    int n0 = blockIdx.x * 64, k0 = blockIdx.y * 64;
    int tn = threadIdx.x & 63, tk = threadIdx.x >> 6;
#pragma unroll
    for (int i = 0; i < 16; ++i) { int k = i * 4 + tk; tile[k][tn] = (n0 + tn < N) ? W[(size_t)(k0 + k) * N + n0 + tn] : 0.f; }
    __syncthreads();
    int n = threadIdx.x >> 2, kc = (threadIdx.x & 3) * 16;
    if (n0 + n >= N) return;
    int gn = n0 + n; int dr;
    if (MODE == 0) dr = gn; else { dr = (gn < 1024) ? ((gn >> 7) * 256 + (gn & 127)) : ((((gn - 1024) >> 7) * 256) + 128 + ((gn - 1024) & 127)); }
    uint4 o0, o1;
    o0.x = pk2bf(tile[kc + 0][n], tile[kc + 1][n]); o0.y = pk2bf(tile[kc + 2][n], tile[kc + 3][n]); o0.z = pk2bf(tile[kc + 4][n], tile[kc + 5][n]); o0.w = pk2bf(tile[kc + 6][n], tile[kc + 7][n]);
    o1.x = pk2bf(tile[kc + 8][n], tile[kc + 9][n]); o1.y = pk2bf(tile[kc + 10][n], tile[kc + 11][n]); o1.z = pk2bf(tile[kc + 12][n], tile[kc + 13][n]); o1.w = pk2bf(tile[kc + 14][n], tile[kc + 15][n]);
    bf16_t* dp = WT + (size_t)(roff + dr) * ldt + koff + k0 + kc;
    *(uint4*)dp = o0; *(uint4*)(dp + 8) = o1;
}

__global__ __launch_bounds__(256) void k_to_bf16_rows(const float* __restrict__ src, bf16_t* __restrict__ dst) {
    size_t t = blockIdx.x; int d = threadIdx.x * 4;
    float4 v = *(const float4*)(src + t * DM + d);
    uint2 o; o.x = pk2bf(v.x, v.y); o.y = pk2bf(v.z, v.w);
    *(uint2*)(dst + t * DM + d) = o;
}
__global__ __launch_bounds__(256) void k_moe_gather(const float* __restrict__ f, const int* __restrict__ slot_token, const int* __restrict__ ntiles, bf16_t* __restrict__ xg) {
    int slot = blockIdx.x;
    if (slot >= ntiles[0] * 256) return;
    int t = slot_token[slot]; int d = threadIdx.x * 4;
    uint2 o = make_uint2(0u, 0u);
    if (t >= 0) { float4 v = *(const float4*)(f + (size_t)t * DM + d); o.x = pk2bf(v.x, v.y); o.y = pk2bf(v.z, v.w); }
    *(uint2*)(xg + (size_t)slot * DM + d) = o;
}


typedef short bf16x8_t __attribute__((ext_vector_type(8)));
typedef float f32x16_t __attribute__((ext_vector_type(16)));
typedef unsigned u32x4_t __attribute__((ext_vector_type(4)));
typedef unsigned u32x2_t __attribute__((ext_vector_type(2)));
#define LAS3 __attribute__((address_space(3)))
__device__ __forceinline__ unsigned cvtpk(float lo, float hi) { unsigned r; asm volatile("v_cvt_pk_bf16_f32 %0, %1, %2" : "=v"(r) : "v"(lo), "v"(hi)); return r; }
constexpr int ATT_VROW = 68;
constexpr int ATT_LDS_BYTES = 2 * (64 * 104 * 2 + 64 * ATT_VROW * 2);

template <int QKD, int NMAP, bool DA>
__device__ __forceinline__ void attn_item(LAS3 unsigned char* lds, const bf16_t* __restrict__ Qb, const bf16_t* __restrict__ Kb, const bf16_t* __restrict__ Vt,
                                          bf16_t* __restrict__ ycatb, int ycat_off, int b, int h, int qblk, float lam, const float* __restrict__ subln, float post_scale) {
    constexpr int DK = QKD / NMAP, KS = DK / 16, KROW = QKD + 8, KCH = QKD / 8;
    constexpr int KBYTES = 64 * KROW * 2, VBYTES = 64 * ATT_VROW * 2, BUFB = KBYTES + VBYTES;
    const int tid = threadIdx.x, wid = tid >> 6, lane = tid & 63, r = lane & 31, hh = lane >> 5;
    const int q0 = qblk * 256, ntiles = (qblk == 0) ? (NC / 64) : (NT / 64);
    const size_t base = ((size_t)b * 4 + h) * NT;
    bf16x8_t qf[NMAP][KS];
#pragma unroll
    for (int m = 0; m < NMAP; ++m)
#pragma unroll
        for (int ks = 0; ks < KS; ++ks) qf[m][ks] = *(const bf16x8_t*)(Qb + (base + q0 + 32 * wid + r) * QKD + m * DK + 16 * ks + 8 * hh);
    f32x16_t O[NMAP][2]; float mrun[NMAP], lrun[NMAP];
#pragma unroll
    for (int m = 0; m < NMAP; ++m) { mrun[m] = -1e30f; lrun[m] = 0.f;
#pragma unroll
        for (int d2 = 0; d2 < 2; ++d2)
#pragma unroll
            for (int i = 0; i < 16; ++i) O[m][d2][i] = 0.f; }
    constexpr int NKC = 64 * KCH;
    const bf16_t* kg = Kb + base * QKD;
    const bf16_t* vg = Vt + ((size_t)(b * 4 + h) * 64 + (tid >> 3)) * NT + (tid & 7) * 8;
    u32x4_t rk0, rk1 = (u32x4_t){0u, 0u, 0u, 0u}, rv;
    const int kc1 = tid + 512;
    const int k0row = tid / KCH, k0col = tid % KCH, k1row = kc1 / KCH, k1col = kc1 % KCH;
#define ATT_LOAD(j) do { rk0 = *(const u32x4_t*)(kg + (size_t)(j) * 64 * QKD + tid * 8); if (NKC > 512 && kc1 < NKC) rk1 = *(const u32x4_t*)(kg + (size_t)(j) * 64 * QKD + kc1 * 8); \
        rv = *(const u32x4_t*)(vg + (size_t)(j) * 64); } while (0)
#define ATT_STORE(buf) do { LAS3 unsigned char* kb_ = lds + (buf) * BUFB; LAS3 unsigned char* vb_ = kb_ + KBYTES; \
        *(LAS3 u32x4_t*)(kb_ + (k0row * KROW + k0col * 8) * 2) = rk0; if (NKC > 512 && kc1 < NKC) *(LAS3 u32x4_t*)(kb_ + (k1row * KROW + k1col * 8) * 2) = rk1; \
        LAS3 unsigned char* vd_ = vb_ + ((tid >> 3) * ATT_VROW + (tid & 7) * 8) * 2; *(LAS3 u32x2_t*)vd_ = (u32x2_t){rv.x, rv.y}; *(LAS3 u32x2_t*)(vd_ + 8) = (u32x2_t){rv.z, rv.w}; } while (0)
    __syncthreads();
    ATT_LOAD(0); ATT_STORE(0);
    if (ntiles > 1) ATT_LOAD(1);
    __syncthreads();
    for (int j = 0; j < ntiles; ++j) {
        const LAS3 unsigned char* kb = lds + (j & 1) * BUFB; const LAS3 unsigned char* vb = kb + KBYTES;
        f32x16_t S[NMAP][2];
#pragma unroll
        for (int m = 0; m < NMAP; ++m)
#pragma unroll
            for (int kt = 0; kt < 2; ++kt) {
#pragma unroll
                for (int i = 0; i < 16; ++i) S[m][kt][i] = 0.f;
#pragma unroll
                for (int ks = 0; ks < KS; ++ks) {
                    const bf16x8_t a = *(const LAS3 bf16x8_t*)(kb + ((kt * 32 + r) * KROW + m * DK + 16 * ks + 8 * hh) * 2);
                    S[m][kt] = __builtin_amdgcn_mfma_f32_32x32x16_bf16(a, qf[m][ks], S[m][kt], 0, 0, 0);
                }
            }
        bf16x8_t pf[NMAP][2][2];
#pragma unroll
        for (int m = 0; m < NMAP; ++m) {
            float mx = S[m][0][0];
#pragma unroll
            for (int i = 1; i < 16; ++i) mx = fmaxf(mx, S[m][0][i]);
#pragma unroll
            for (int i = 0; i < 16; ++i) mx = fmaxf(mx, S[m][1][i]);
            mx = fmaxf(mx, __shfl_xor(mx, 32));
            const float mn = fmaxf(mrun[m], mx);
            const float alpha = __builtin_amdgcn_exp2f(mrun[m] - mn);
            mrun[m] = mn;
            float ps = 0.f;
#pragma unroll
            for (int kt = 0; kt < 2; ++kt) {
#pragma unroll
                for (int i = 0; i < 16; ++i) { const float pv = __builtin_amdgcn_exp2f(S[m][kt][i] - mn); S[m][kt][i] = pv; ps += pv; }
#pragma unroll
                for (int s2 = 0; s2 < 2; ++s2) {
                    union { unsigned u[4]; bf16x8_t v; } cv;
#pragma unroll
                    for (int jj = 0; jj < 4; ++jj) cv.u[jj] = cvtpk(S[m][kt][8 * s2 + 2 * jj], S[m][kt][8 * s2 + 2 * jj + 1]);
                    pf[m][kt][s2] = cv.v;
                }
            }
            lrun[m] = lrun[m] * alpha + ps;
#pragma unroll
            for (int d2 = 0; d2 < 2; ++d2)
#pragma unroll
                for (int i = 0; i < 16; ++i) O[m][d2][i] *= alpha;
        }
#pragma unroll
        for (int d2 = 0; d2 < 2; ++d2)
#pragma unroll
            for (int kt = 0; kt < 2; ++kt)
#pragma unroll
                for (int s2 = 0; s2 < 2; ++s2) {
                    const LAS3 unsigned char* vp = vb + ((d2 * 32 + r) * ATT_VROW + kt * 32 + 16 * s2 + 4 * hh) * 2;
                    union { u32x2_t u[2]; bf16x8_t v; } av;
                    av.u[0] = *(const LAS3 u32x2_t*)vp; av.u[1] = *(const LAS3 u32x2_t*)(vp + 16);
#pragma unroll
                    for (int m = 0; m < NMAP; ++m) O[m][d2] = __builtin_amdgcn_mfma_f32_32x32x16_bf16(av.v, pf[m][kt][s2], O[m][d2], 0, 0, 0);
                }
        if (j + 1 < ntiles) { ATT_STORE((j + 1) & 1); if (j + 2 < ntiles) ATT_LOAD(j + 2); }
        __syncthreads();
    }
#undef ATT_LOAD
#undef ATT_STORE
    float inv[NMAP];
#pragma unroll
    for (int m = 0; m < NMAP; ++m) { const float lt = lrun[m] + __shfl_xor(lrun[m], 32); inv[m] = 1.f / lt; }
    if (NMAP == 2) inv[NMAP - 1] *= -lam;
    float ss = 0.f;
#pragma unroll
    for (int d2 = 0; d2 < 2; ++d2)
#pragma unroll
        for (int i = 0; i < 16; ++i) {
            float o = O[0][d2][i] * inv[0];
            if (NMAP == 2) o += O[NMAP - 1][d2][i] * inv[NMAP - 1];
            O[0][d2][i] = o; ss += o * o;
        }
    float rs = 1.f;
    if (DA) { ss += __shfl_xor(ss, 32); rs = rsqrtf(ss * (1.f / 64.f) + 1e-6f) * post_scale; }
    bf16_t* yp = ycatb + ((size_t)b * NT + q0 + 32 * wid + r) * DM + ycat_off + h * 64;
#pragma unroll
    for (int d2 = 0; d2 < 2; ++d2)
#pragma unroll
        for (int g4 = 0; g4 < 4; ++g4) {
            const int dv = 32 * d2 + 8 * g4 + 4 * hh;
            float o0 = O[0][d2][4 * g4] * rs, o1 = O[0][d2][4 * g4 + 1] * rs, o2 = O[0][d2][4 * g4 + 2] * rs, o3 = O[0][d2][4 * g4 + 3] * rs;
            if (DA) { const float4 w = *(const float4*)(subln + dv); o0 *= w.x; o1 *= w.y; o2 *= w.z; o3 *= w.w; }
            *(uint2*)(yp + dv) = make_uint2(cvtpk(o0, o1), cvtpk(o2, o3));
        }
}

template <int QKD, int NMAP, bool DA>
__global__ __launch_bounds__(512, 2) void k_attn_mfma(const bf16_t* __restrict__ Qb, const bf16_t* __restrict__ Kb, const bf16_t* __restrict__ Vt, bf16_t* __restrict__ ycatb, int ycat_off,
                                                      const float* __restrict__ lamfull, const float* __restrict__ subln, float post_scale, int with_ctx) {
    int qblk = blockIdx.x, h = blockIdx.y, b = blockIdx.z;
    if (qblk == 0 && !with_ctx) return;
    attn_item<QKD, NMAP, DA>((LAS3 unsigned char*)dyn_lds, Qb, Kb, Vt, ycatb, ycat_off, b, h, qblk, DA ? lamfull[0] : 0.f, subln, post_scale);
}

__global__ __launch_bounds__(256) void k_da_prep2(const float* __restrict__ p, const float* __restrict__ cs, bf16_t* __restrict__ Qb, bf16_t* __restrict__ Kb, bf16_t* __restrict__ Vt, float qscale) {
    __shared__ bf16_t vs[256][72];
    int t0 = blockIdx.x * 64; int b = t0 / NT, n0 = t0 % NT;
    int c = threadIdx.x; int h = c >> 6, rr = c & 63, d = rr & 31;
    for (int i = 0; i < 64; ++i) {
        int n = n0 + i; const float* pr = p + (size_t)(t0 + i) * DIN;
        float qv = pr[P_DAQ + c], kv = pr[P_DAK + c];
        if (n >= NC) {
            int pos = n - NC; int j = d & 15;
            float co = cs[(pos * 16 + j) * 2], si = cs[(pos * 16 + j) * 2 + 1];
            int cp = (d < 16) ? c + 16 : c - 16;
            float qo = pr[P_DAQ + cp], ko = pr[P_DAK + cp];
            if (d < 16) { qv = qv * co - qo * si; kv = kv * co - ko * si; }
            else        { qv = qv * co + qo * si; kv = kv * co + ko * si; }
        }
        size_t o = (((size_t)b * 4 + h) * NT + n) * 64 + rr;
        Qb[o] = f2bf(qv * qscale); Kb[o] = f2bf(kv);
        vs[c][i] = f2bf(pr[P_DAV + c]);
    }
    __syncthreads();
    bf16_t* vp = Vt + (((size_t)b * 4 + h) * 64 + rr) * NT + n0;
#pragma unroll
    for (int q = 0; q < 8; ++q) *(uint4*)(vp + q * 8) = *(const uint4*)&vs[c][q * 8];
}
__global__ __launch_bounds__(256) void k_mla_layout2(const float* __restrict__ p, const float* __restrict__ qfull, const float* __restrict__ kvfull, const float* __restrict__ cs,
                                                     bf16_t* __restrict__ Qb, bf16_t* __restrict__ Kb, bf16_t* __restrict__ Vt, float qscale) {
    __shared__ bf16_t vs[256][72];
    int t0 = blockIdx.x * 64; int b = t0 / NT, n0 = t0 % NT;
    for (int i = 0; i < 64; ++i) {
        int n = n0 + i; size_t t = (size_t)t0 + i;
        const float* pr = p + t * DIN; const float* qf = qfull + t * 384; const float* kf = kvfull + t * 512;
        for (int idx = threadIdx.x; idx < 384; idx += 256) {
            int h = idx / 96, j = idx % 96;
            size_t o = (((size_t)b * 4 + h) * NT + n) * 96 + j;
            float qv, kv;
            if (j < 64) { qv = qf[h * 96 + j]; kv = kf[h * 128 + j]; }
            else {
                int d = j - 64;
                qv = qf[h * 96 + j]; kv = pr[P_KR + d];
                if (n >= NC) {
                    int pos = n - NC; int jj = d & 15;
                    float co = cs[(pos * 16 + jj) * 2], si = cs[(pos * 16 + jj) * 2 + 1];
                    int dp = (d < 16) ? d + 16 : d - 16;
                    float qo = qf[h * 96 + 64 + dp], ko = pr[P_KR + dp];
                    if (d < 16) { qv = qv * co - qo * si; kv = kv * co - ko * si; }
                    else        { qv = qv * co + qo * si; kv = kv * co + ko * si; }
                }
            }
            Qb[o] = f2bf(qv * qscale); Kb[o] = f2bf(kv);
        }
        { int c = threadIdx.x; int h = c >> 6, j = c & 63; vs[c][i] = f2bf(kf[h * 128 + 64 + j]); }
    }
    __syncthreads();
    { int c = threadIdx.x; int h = c >> 6, j = c & 63;
      bf16_t* vp = Vt + (((size_t)b * 4 + h) * 64 + j) * NT + n0;
#pragma unroll
      for (int q = 0; q < 8; ++q) *(uint4*)(vp + q * 8) = *(const uint4*)&vs[c][q * 8]; }
}

__global__ void k_build_x(const float* __restrict__ x, const float* __restrict__ ctx, float* __restrict__ xall) {
    size_t i = (size_t)blockIdx.x * 256 + threadIdx.x;
    size_t total = (size_t)TT * DM / 4;
    if (i >= total) return;
    size_t t = i / (DM / 4); int d4 = (int)(i % (DM / 4));
    int b = (int)(t / NT), n = (int)(t % NT);
    const float4* src = (n < NC) ? (const float4*)(ctx + ((size_t)b * NC + n) * DM) : (const float4*)(x + ((size_t)b * NS + (n - NC)) * DM);
    ((float4*)xall)[i] = src[d4];
}

__global__ __launch_bounds__(256) void k_mod(const float* __restrict__ c, const float* __restrict__ c_ctx, const float* __restrict__ w_mod,
                                             const float* __restrict__ b_mod, float* __restrict__ mod) {
    __shared__ float s[9][1024];
    for (int i = threadIdx.x; i < 9 * 1024; i += 256) {
        int r = i >> 10, k = i & 1023;
        float v = (r < 8) ? c[r * 1024 + k] : c_ctx[k];
        s[r][k] = siluf_(v);
    }
    __syncthreads();
    int gj = blockIdx.x * 256 + threadIdx.x;
    int l = gj / 6144, j = gj % 6144;
    const float* w = w_mod + (size_t)l * 1024 * 6144 + j;
    float acc[9];
#pragma unroll
    for (int r = 0; r < 9; ++r) acc[r] = 0.f;
    for (int k = 0; k < 1024; ++k) {
        float wv = w[(size_t)k * 6144];
#pragma unroll
        for (int r = 0; r < 9; ++r) acc[r] += s[r][k] * wv;
    }
    float bb = b_mod[l * 6144 + j];
#pragma unroll
    for (int r = 0; r < 9; ++r) mod[((size_t)l * 9 + r) * 6144 + j] = acc[r] + bb;
}

__global__ void k_rope_table(float* __restrict__ cs) {
    int i = blockIdx.x * 256 + threadIdx.x;
    if (i >= NS * 16) return;
    int pos = i >> 4, j = i & 15;
    int row = pos / 64, col = pos % 64;
    double inv = pow(10000.0, -(double)(j & 7) / 8.0);
    double ang = (double)((j < 8) ? row : col) * inv;
    cs[i * 2] = (float)cos(ang);
    cs[i * 2 + 1] = (float)sin(ang);
}

__global__ void k_lambda(const float* __restrict__ da_lambda, float* __restrict__ lamfull) {
    int l = threadIdx.x;
    if (l >= 2) return;
    const float* lam = da_lambda + l * 128;
    double s1 = 0, s2 = 0;
    for (int i = 0; i < 32; ++i) { s1 += (double)lam[i] * lam[32 + i]; s2 += (double)lam[64 + i] * lam[96 + i]; }
    double lambda_init = 0.8 - 0.6 * exp(-0.3 * l);
    lamfull[l] = (float)(exp(s1) - exp(s2) + lambda_init);
}

__global__ void k_s5_disc(const float* __restrict__ a_re, const float* __restrict__ a_im, const float* __restrict__ log_step,
                          const float* __restrict__ b_re, const float* __restrict__ b_im,
                          float* __restrict__ abr, float* __restrict__ abi, float* __restrict__ bbr, float* __restrict__ bbi) {
    int i = blockIdx.x * 256 + threadIdx.x;
    if (i >= 2 * 2 * 16 * 64) return;
    int ldg = i >> 6;
    double ar = fmin((double)a_re[i], -1e-4), ai = (double)a_im[i];
    double dt = exp((double)log_step[ldg]);
    double mag = exp(dt * ar);
    double er = mag * cos(dt * ai), ei = mag * sin(dt * ai);
    double inv = 1.0 / (ar * ar + ai * ai);
    double fr = ((er - 1.0) * ar + ei * ai) * inv;
    double fi = (ei * ar - (er - 1.0) * ai) * inv;
    abr[i] = (float)er; abi[i] = (float)ei;
    for (int h = 0; h < 16; ++h) {
        double br = b_re[(size_t)i * 16 + h], bi = b_im[(size_t)i * 16 + h];
        bbr[(size_t)i * 16 + h] = (float)(fr * br - fi * bi);
        bbi[(size_t)i * 16 + h] = (float)(fr * bi + fi * br);
    }
}

__global__ __launch_bounds__(256) void k_norm_mod(const float* __restrict__ xall, const float* __restrict__ nw, const float* __restrict__ modl  ,
                                                  int shift_off, int scale_off, bf16_t* __restrict__ out) {
    __shared__ float red[8];
    int t = blockIdx.x; int b = t / NT, n = t % NT; int r = (n < NC) ? 8 : b;
    const float4 xv = ((const float4*)(xall + (size_t)t * DM))[threadIdx.x];
    float ss = xv.x * xv.x + xv.y * xv.y + xv.z * xv.z + xv.w * xv.w;
    ss = block_sum_256(ss, red);
    float rstd = rsqrtf(ss * (1.f / DM) + 1e-6f);
    int d = threadIdx.x * 4;
    const float4 w = *(const float4*)(nw + d);
    const float4 sc = *(const float4*)(modl + (size_t)r * 6144 + scale_off + d);
    const float4 sh = *(const float4*)(modl + (size_t)r * 6144 + shift_off + d);
    float4 o;
    o.x = xv.x * rstd * w.x * (1.f + sc.x) + sh.x;
    o.y = xv.y * rstd * w.y * (1.f + sc.y) + sh.y;
    o.z = xv.z * rstd * w.z * (1.f + sc.z) + sh.z;
    o.w = xv.w * rstd * w.w * (1.f + sc.w) + sh.w;
    uint2 ob; ob.x = pk2bf(o.x, o.y); ob.y = pk2bf(o.z, o.w);
    *(uint2*)(out + (size_t)t * DM + d) = ob;
}

struct GemmArgs {
    const float* A; const float* B; float* C; const float* bias;
    int M, N, K, lda, ldb, ldc;
    const int* gather;
    const int* tile_e;
    const int* tile_m0;
    const int* grp_end;
    const int* ntiles;
    long strideB, strideBias;
};

template <int MODE>
__global__ __launch_bounds__(256) void k_gemm(GemmArgs g) {
    __shared__ float As[16][68];
    __shared__ float Bs[16][64];
    __shared__ float Bs2[MODE == 1 ? 16 : 1][64];
    const float* B = g.B; const float* bias = g.bias;
    int m0, mend;
    if (g.tile_e) {
        int ty = blockIdx.y;
        if (ty >= g.ntiles[0]) return;
        int e = g.tile_e[ty];
        m0 = g.tile_m0[ty]; mend = g.grp_end[e];
        B += (size_t)e * g.strideB; if (bias) bias += (size_t)e * g.strideBias;
    } else { m0 = blockIdx.y * 64; mend = g.M; if (m0 >= mend) return; }
    int n0 = blockIdx.x * 64;
    int tx = threadIdx.x & 15, ty_ = threadIdx.x >> 4;
    float acc[4][4], acc2[4][4];
#pragma unroll
    for (int i = 0; i < 4; ++i)
#pragma unroll
        for (int j = 0; j < 4; ++j) { acc[i][j] = 0.f; acc2[i][j] = 0.f; }
    int ar = threadIdx.x >> 2, ak = (threadIdx.x & 3) * 4;
    int arow_slot = m0 + ar; bool avalid = arow_slot < mend;
    long arow = avalid ? (g.gather ? (long)g.gather[arow_slot] : (long)arow_slot) : 0;
    const float* Ap = g.A + arow * g.lda + ak;
    int bk = threadIdx.x >> 4, bn = (threadIdx.x & 15) * 4;
    for (int k0 = 0; k0 < g.K; k0 += 16) {
        float4 av = avalid ? *(const float4*)(Ap + k0) : make_float4(0.f, 0.f, 0.f, 0.f);
        As[ak + 0][ar] = av.x; As[ak + 1][ar] = av.y; As[ak + 2][ar] = av.z; As[ak + 3][ar] = av.w;
        const float* Bp = B + (size_t)(k0 + bk) * g.ldb + n0 + bn;
#pragma unroll
        for (int q = 0; q < 4; ++q) Bs[bk][bn + q] = (n0 + bn + q < g.N) ? Bp[q] : 0.f;
        if (MODE == 1) {
#pragma unroll
            for (int q = 0; q < 4; ++q) Bs2[bk][bn + q] = (n0 + bn + q < g.N) ? Bp[g.N + q] : 0.f;
        }
        __syncthreads();
#pragma unroll
        for (int kk = 0; kk < 16; ++kk) {
            float a[4], b[4];
#pragma unroll
            for (int i = 0; i < 4; ++i) a[i] = As[kk][ty_ * 4 + i];
#pragma unroll
            for (int j = 0; j < 4; ++j) b[j] = Bs[kk][tx * 4 + j];
#pragma unroll
            for (int i = 0; i < 4; ++i)
#pragma unroll
                for (int j = 0; j < 4; ++j) acc[i][j] += a[i] * b[j];
            if (MODE == 1) {
                float b2[4];
#pragma unroll
                for (int j = 0; j < 4; ++j) b2[j] = Bs2[kk][tx * 4 + j];
#pragma unroll
                for (int i = 0; i < 4; ++i)
#pragma unroll
                    for (int j = 0; j < 4; ++j) acc2[i][j] += a[i] * b2[j];
            }
        }
        __syncthreads();
    }
#pragma unroll
    for (int i = 0; i < 4; ++i) {
        int slot = m0 + ty_ * 4 + i;
        if (slot >= mend) continue;
#pragma unroll
        for (int j = 0; j < 4; ++j) {
            int n = n0 + tx * 4 + j;
            if (n >= g.N) continue;
            float v = acc[i][j] + (bias ? bias[n] : 0.f);
            if (MODE == 1) {
                float up = acc2[i][j] + (bias ? bias[g.N + n] : 0.f);
                float gate = fminf(v, 7.f);
                up = fminf(fmaxf(up, -7.f), 7.f);
                v = (up + 1.f) * gate * sigmoidf_(1.702f * gate);
            }
            g.C[(size_t)slot * g.ldc + n] = v;
        }
    }
}

__global__ __launch_bounds__(256) void k_da_prep(const float* __restrict__ p, const float* __restrict__ cs, float* __restrict__ Q, float* __restrict__ K, float* __restrict__ V) {
    int t = blockIdx.x; int b = t / NT, n = t % NT;
    int c = threadIdx.x;
    int h = c >> 6, r = c & 63, d = r & 31;
    const float* pr = p + (size_t)t * DIN;
    size_t o = (((size_t)b * 4 + h) * NT + n) * 64 + r;
    float qv = pr[P_DAQ + c], kv = pr[P_DAK + c];
    if (n >= NC) {
        int pos = n - NC; int j = d & 15;
        float co = cs[(pos * 16 + j) * 2], si = cs[(pos * 16 + j) * 2 + 1];
        int cp = (d < 16) ? c + 16 : c - 16;
        float qo = pr[P_DAQ + cp], ko = pr[P_DAK + cp];
        if (d < 16) { qv = qv * co - qo * si; kv = kv * co - ko * si; }
        else        { qv = qv * co + qo * si; kv = kv * co + ko * si; }
    }
    Q[o] = qv; K[o] = kv; V[o] = pr[P_DAV + c];
}

template <int QKD, int NMAP, int DV, bool DA>
__global__ __launch_bounds__(64) void k_attn(const float* __restrict__ Q, const float* __restrict__ K, const float* __restrict__ V,
                                             float* __restrict__ ycat, int ycat_off, const float* __restrict__ lamfull,
                                             const float* __restrict__ subln, float post_scale, float scale, int with_ctx) {
    constexpr int DK = QKD / NMAP;
    __shared__ float Ks[32][QKD];
    __shared__ float Vs[32][DV];
    int qb = blockIdx.x, h = blockIdx.y, b = blockIdx.z;
    bool isctx = qb < (NC / 64);
    if (isctx && !with_ctx) return;
    int nkeys = isctx ? NC : NT;
    int n = qb * 64 + threadIdx.x;
    size_t base = ((size_t)b * 4 + h) * NT;
    float q[QKD];
    const float* qp = Q + (base + n) * QKD;
#pragma unroll
    for (int d = 0; d < QKD; d += 4) { float4 v = *(const float4*)(qp + d); q[d] = v.x * scale; q[d + 1] = v.y * scale; q[d + 2] = v.z * scale; q[d + 3] = v.w * scale; }
    float acc[NMAP][DV]; float mx[NMAP], l[NMAP];
#pragma unroll
    for (int m = 0; m < NMAP; ++m) { mx[m] = -1e30f; l[m] = 0.f;
#pragma unroll
        for (int d = 0; d < DV; ++d) acc[m][d] = 0.f; }
    for (int k0 = 0; k0 < nkeys; k0 += 32) {
        __syncthreads();
        for (int i = threadIdx.x; i < 32 * QKD / 4; i += 64) {
            int kr = i / (QKD / 4), kc = (i % (QKD / 4)) * 4;
            *(float4*)&Ks[kr][kc] = *(const float4*)(K + (base + k0 + kr) * QKD + kc);
        }
        for (int i = threadIdx.x; i < 32 * DV / 4; i += 64) {
            int kr = i / (DV / 4), kc = (i % (DV / 4)) * 4;
            *(float4*)&Vs[kr][kc] = *(const float4*)(V + (base + k0 + kr) * DV + kc);
        }
        __syncthreads();
        for (int j = 0; j < 32; ++j) {
#pragma unroll
            for (int m = 0; m < NMAP; ++m) {
                float s = 0.f;
#pragma unroll
                for (int d = 0; d < DK; ++d) s += q[m * DK + d] * Ks[j][m * DK + d];
                float mn = fmaxf(mx[m], s);
                float alpha = __expf(mx[m] - mn);
                float pv = __expf(s - mn);
                mx[m] = mn;
                l[m] = l[m] * alpha + pv;
#pragma unroll
                for (int d = 0; d < DV; ++d) acc[m][d] = acc[m][d] * alpha + pv * Vs[j][d];
            }
        }
    }
    float o[DV];
    float c1 = 1.f;
#pragma unroll
    for (int d = 0; d < DV; ++d) o[d] = acc[0][d] / l[0];
    if (NMAP == 2) {
        c1 = -lamfull[0];
#pragma unroll
        for (int d = 0; d < DV; ++d) o[d] += c1 * acc[NMAP - 1][d] / l[NMAP - 1];
    }
    if (DA) {
        float ss = 0.f;
#pragma unroll
        for (int d = 0; d < DV; ++d) ss += o[d] * o[d];
        float rstd = rsqrtf(ss * (1.f / DV) + 1e-6f) * post_scale;
#pragma unroll
        for (int d = 0; d < DV; ++d) o[d] = o[d] * rstd * subln[d];
    }
    float* yp = ycat + ((size_t)b * NT + n) * DM + ycat_off + h * DV;
#pragma unroll
    for (int d = 0; d < DV; d += 4) *(float4*)(yp + d) = make_float4(o[d], o[d + 1], o[d + 2], o[d + 3]);
}

__global__ __launch_bounds__(64) void k_mla_norm(const float* __restrict__ p, const float* __restrict__ qn, const float* __restrict__ kvn,
                                                 float* __restrict__ cqn, float* __restrict__ ckvn) {
    int t = blockIdx.x; int lane = threadIdx.x;
    const float* pr = p + (size_t)t * DIN;
    float v0 = pr[P_CQ + lane], v1 = pr[P_CQ + 64 + lane], v2 = pr[P_CQ + 128 + lane];
    float ss = v0 * v0 + v1 * v1 + v2 * v2;
    for (int o = 32; o > 0; o >>= 1) ss += __shfl_xor(ss, o);
    float r = rsqrtf(ss * (1.f / 192.f) + 1e-6f);
    cqn[(size_t)t * 192 + lane] = v0 * r * qn[lane];
    cqn[(size_t)t * 192 + 64 + lane] = v1 * r * qn[64 + lane];
    cqn[(size_t)t * 192 + 128 + lane] = v2 * r * qn[128 + lane];
    float w0 = pr[P_CKV + lane], w1 = pr[P_CKV + 64 + lane];
    float s2 = w0 * w0 + w1 * w1;
    for (int o = 32; o > 0; o >>= 1) s2 += __shfl_xor(s2, o);
    float r2 = rsqrtf(s2 * (1.f / 128.f) + 1e-6f);
    ckvn[(size_t)t * 128 + lane] = w0 * r2 * kvn[lane];
    ckvn[(size_t)t * 128 + 64 + lane] = w1 * r2 * kvn[64 + lane];
}

__global__ __launch_bounds__(128) void k_mla_layout(const float* __restrict__ p, const float* __restrict__ qfull  , const float* __restrict__ kvfull  ,
                                                    const float* __restrict__ cs, float* __restrict__ Q, float* __restrict__ K, float* __restrict__ V) {
    int t = blockIdx.x; int b = t / NT, n = t % NT;
    const float* pr = p + (size_t)t * DIN;
    const float* qf = qfull + (size_t)t * 384;
    const float* kf = kvfull + (size_t)t * 512;
    for (int i = threadIdx.x; i < 4 * 96; i += 128) {
        int h = i / 96, j = i % 96;
        size_t o = (((size_t)b * 4 + h) * NT + n) * 96 + j;
        float qv, kv;
        if (j < 64) { qv = qf[h * 96 + j]; kv = kf[h * 128 + j]; }
        else {
            int d = j - 64;
            qv = qf[h * 96 + j]; kv = pr[P_KR + d];
            if (n >= NC) {
                int pos = n - NC; int jj = d & 15;
                float co = cs[(pos * 16 + jj) * 2], si = cs[(pos * 16 + jj) * 2 + 1];
                int dp = (d < 16) ? d + 16 : d - 16;
                float qo = qf[h * 96 + 64 + dp], ko = pr[P_KR + dp];
                if (d < 16) { qv = qv * co - qo * si; kv = kv * co - ko * si; }
                else        { qv = qv * co + qo * si; kv = kv * co + ko * si; }
            }
        }
        Q[o] = qv; K[o] = kv;
    }
    for (int i = threadIdx.x; i < 4 * 64; i += 128) {
        int h = i / 64, j = i % 64;
        V[(((size_t)b * 4 + h) * NT + n) * 64 + j] = kf[h * 128 + 64 + j];
    }
}

__global__ __launch_bounds__(256) void k_ml_prep(const float* __restrict__ p, const float* __restrict__ conv_w  , const float* __restrict__ conv_b,
                                                 const float* __restrict__ gate_b, float* __restrict__ qk  , float* __restrict__ G  ) {
    int t = blockIdx.x; int n = t % NT;
    int seg_lo = (n < NC) ? 0 : NC, seg_hi = (n < NC) ? NC - 1 : NT - 1;
    for (int c = threadIdx.x; c < 512; c += 256) {
        float y = conv_b[c];
#pragma unroll
        for (int j = 0; j < 3; ++j) {
            int nn = n + j - 1;
            if (nn >= seg_lo && nn <= seg_hi) y += p[(size_t)(t + j - 1) * DIN + P_MLQK + c] * conv_w[j * 512 + c];
        }
        y = siluf_(y);
        if (c >= 256) y *= 0.125f;
        qk[(size_t)t * 512 + c] = y;
    }
    if (threadIdx.x < 16) {
        int gi = threadIdx.x >> 2;
        float g = p[(size_t)t * DIN + P_MLG + threadIdx.x] + gate_b[threadIdx.x];
        if (gi & 1) g = logsigmoidf_(g);
        G[(size_t)t * 16 + threadIdx.x] = g;
    }
}

__device__ __forceinline__ int seq_token(int s, int dir) {
    if (dir == 0) return s;
    return (s < NC) ? (NC - 1 - s) : (NC + (NT - 1 - s));
}

__global__ __launch_bounds__(256) void k_mlstm(const float* __restrict__ qk, const float* __restrict__ p, const float* __restrict__ G, float* __restrict__ hdir  ) {
    __shared__ float sq[64][64], sk[64][64], sv[64][64], sa[64], sf[64];
    int h = blockIdx.x, b = blockIdx.y, dir = blockIdx.z;
    int tid = threadIdx.x, vrow = tid >> 2, part = tid & 3;
    float C[16], nn[16];
#pragma unroll
    for (int i = 0; i < 16; ++i) { C[i] = 0.f; nn[i] = 0.f; }
    for (int s0 = 0; s0 < NT; s0 += 64) {
        __syncthreads();
        for (int i = tid; i < 64 * 64; i += 256) {
            int j = i >> 6, d = i & 63;
            int n = seq_token(s0 + j, dir);
            size_t t = (size_t)b * NT + n;
            sq[j][d] = qk[t * 512 + h * 64 + d];
            sk[j][d] = qk[t * 512 + 256 + h * 64 + d];
            sv[j][d] = p[t * DIN + P_MLV + h * 64 + d];
        }
        if (tid < 64) {
            int n = seq_token(s0 + tid, dir);
            size_t t = (size_t)b * NT + n;
            sa[tid] = __expf(G[t * 16 + (dir * 2) * 4 + h]);
            sf[tid] = __expf(G[t * 16 + (dir * 2 + 1) * 4 + h]);
        }
        __syncthreads();
        for (int j = 0; j < 64; ++j) {
            float a = sa[j], f = sf[j], vv = sv[j][vrow];
            float av = a * vv;
            float num = 0.f, den = 0.f;
#pragma unroll
            for (int i = 0; i < 16; ++i) {
                float kk = sk[j][part * 16 + i], qq = sq[j][part * 16 + i];
                C[i] = f * C[i] + av * kk;
                nn[i] = f * nn[i] + a * kk;
                num += C[i] * qq; den += nn[i] * qq;
            }
            num += __shfl_xor(num, 1); num += __shfl_xor(num, 2);
            den += __shfl_xor(den, 1); den += __shfl_xor(den, 2);
            if (part == 0) {
                int n = seq_token(s0 + j, dir);
                hdir[((size_t)dir * TT + (size_t)b * NT + n) * 256 + h * 64 + vrow] = num / fmaxf(fabsf(den), 1.f);
            }
        }
    }
}

__global__ __launch_bounds__(256) void k_ml_finish(const float* __restrict__ p, const float* __restrict__ hdir, const float* __restrict__ ml_norm, bf16_t* __restrict__ ycat) {
    int t = blockIdx.x; int c = threadIdx.x;
    float o = p[(size_t)t * DIN + P_MLO + c];
    float hv = sigmoidf_(o) * (hdir[(size_t)t * 256 + c] + hdir[((size_t)TT + t) * 256 + c]);
    float ss = hv * hv;
    for (int off = 32; off > 0; off >>= 1) ss += __shfl_xor(ss, off);
    float r = rsqrtf(ss * (1.f / 64.f) + 1e-6f);
    ycat[(size_t)t * DM + 256 + c] = f2bf(hv * r * ml_norm[c]);
}

__global__ __launch_bounds__(64) void k_s5_scan(const float* __restrict__ p, const float* __restrict__ abr, const float* __restrict__ abi,
                                                const float* __restrict__ bbr, const float* __restrict__ bbi,
                                                const float* __restrict__ c_re, const float* __restrict__ c_im, float* __restrict__ ys5  ) {
    __shared__ float su[64][16];
    __shared__ float xs[64][129];
    __shared__ float cr[16][64], ci[16][64];
    int g = blockIdx.x, b = blockIdx.y, dir = blockIdx.z;
    int lane = threadIdx.x;
    int sidx = (dir * 16 + g) * 64 + lane;
    float ar = abr[sidx], ai = abi[sidx];
    float br[16], bi[16];
#pragma unroll
    for (int h = 0; h < 16; ++h) { br[h] = bbr[(size_t)sidx * 16 + h]; bi[h] = bbi[(size_t)sidx * 16 + h]; }
    for (int i = lane; i < 16 * 64; i += 64) { cr[i >> 6][i & 63] = c_re[(size_t)(dir * 16 + g) * 1024 + i]; ci[i >> 6][i & 63] = c_im[(size_t)(dir * 16 + g) * 1024 + i]; }
    float xr = 0.f, xi = 0.f;
    for (int s0 = 0; s0 < NT; s0 += 64) {
        __syncthreads();
        for (int i = lane; i < 64 * 16; i += 64) {
            int j = i >> 4, hh = i & 15;
            int n = seq_token(s0 + j, dir);
            su[j][hh] = p[((size_t)b * NT + n) * DIN + P_S5 + g * 16 + hh];
        }
        __syncthreads();
#pragma unroll 1
        for (int j = 0; j < 64; ++j) {
            float ur = 0.f, ui = 0.f;
#pragma unroll
            for (int hh = 0; hh < 16; ++hh) { float u = su[j][hh]; ur += br[hh] * u; ui += bi[hh] * u; }
            float nr = ar * xr - ai * xi + ur;
            float ni = ar * xi + ai * xr + ui;
            xr = nr; xi = ni;
            xs[j][lane] = xr; xs[j][64 + lane] = xi;
        }
        __syncthreads();
        {
            int n = seq_token(s0 + lane, dir);
            float* yp = ys5 + ((size_t)dir * TT + (size_t)b * NT + n) * 256 + g * 16;
#pragma unroll 1
            for (int hh = 0; hh < 16; ++hh) {
                float y = 0.f;
#pragma unroll 4
                for (int pp = 0; pp < 64; ++pp) y += cr[hh][pp] * xs[lane][pp] - ci[hh][pp] * xs[lane][64 + pp];
                yp[hh] = y;
            }
        }
    }
}

__device__ __forceinline__ float gelu_tanh_(float x) {
    float u = 0.7978845608028654f * (x + 0.044715f * x * x * x);
    return 0.5f * x * (1.f + tanhf(u));
}
__global__ __launch_bounds__(256) void k_s5_gelu(const float* __restrict__ p, const float* __restrict__ ys5, const float* __restrict__ dsk, float* __restrict__ gl  ) {
    int t = blockIdx.x, c = threadIdx.x;
    float y = ys5[(size_t)t * 256 + c] + ys5[((size_t)TT + t) * 256 + c] + p[(size_t)t * DIN + P_S5 + c] * dsk[c];
    gl[(size_t)t * 256 + c] = gelu_tanh_(y);
}
__global__ __launch_bounds__(256) void k_s5_glu(const float* __restrict__ gl, const float* __restrict__ z, bf16_t* __restrict__ ycat) {
    int t = blockIdx.x, c = threadIdx.x;
    ycat[(size_t)t * DM + 768 + c] = f2bf(gl[(size_t)t * 256 + c] * sigmoidf_(z[(size_t)t * 256 + c]));
}

__global__ __launch_bounds__(256) void k_post1(float* __restrict__ xall, const float* __restrict__ o, const float* __restrict__ nw1, const float* __restrict__ nw2,
                                               const float* __restrict__ modl, const float* __restrict__ w_router  , const float* __restrict__ b_router,
                                               float* __restrict__ f, int* __restrict__ top_e  , float* __restrict__ top_g  , int* __restrict__ cnt,
                                               int* __restrict__ pos  , int with_ctx) {
    __shared__ float red[8];
    __shared__ float lg[4][32];
    int t = blockIdx.x; int b = t / NT, n = t % NT;
    if (n < NC && !with_ctx) return;
    int r = (n < NC) ? 8 : b;
    const float* mr = modl + (size_t)r * 6144;
    int d = threadIdx.x * 4;
    float4 ov = *(const float4*)(o + (size_t)t * DM + d);
    float ss = ov.x * ov.x + ov.y * ov.y + ov.z * ov.z + ov.w * ov.w;
    ss = block_sum_256(ss, red);
    float rstd = rsqrtf(ss * (1.f / DM) + 1e-6f);
    float4 xv = *(const float4*)(xall + (size_t)t * DM + d);
    float4 w1 = *(const float4*)(nw1 + d);
    float4 g1 = *(const float4*)(mr + 2048 + d);
    xv.x += g1.x * ov.x * rstd * w1.x; xv.y += g1.y * ov.y * rstd * w1.y; xv.z += g1.z * ov.z * rstd * w1.z; xv.w += g1.w * ov.w * rstd * w1.w;
    *(float4*)(xall + (size_t)t * DM + d) = xv;
    float s2 = xv.x * xv.x + xv.y * xv.y + xv.z * xv.z + xv.w * xv.w;
    s2 = block_sum_256(s2, red);
    float rstd2 = rsqrtf(s2 * (1.f / DM) + 1e-6f);
    float4 w2 = *(const float4*)(nw2 + d);
    float4 sh = *(const float4*)(mr + 3072 + d);
    float4 sc = *(const float4*)(mr + 4096 + d);
    float fv[4];
    fv[0] = xv.x * rstd2 * w2.x * (1.f + sc.x) + sh.x;
    fv[1] = xv.y * rstd2 * w2.y * (1.f + sc.y) + sh.y;
    fv[2] = xv.z * rstd2 * w2.z * (1.f + sc.z) + sh.z;
    fv[3] = xv.w * rstd2 * w2.w * (1.f + sc.w) + sh.w;
    *(float4*)(f + (size_t)t * DM + d) = make_float4(fv[0], fv[1], fv[2], fv[3]);
    float part[32];
#pragma unroll
    for (int e = 0; e < 32; ++e) part[e] = 0.f;
#pragma unroll
    for (int q = 0; q < 4; ++q) {
        const float* wr = w_router + (size_t)(d + q) * 32;
#pragma unroll
        for (int e = 0; e < 32; ++e) part[e] += fv[q] * wr[e];
    }
#pragma unroll
    for (int e = 0; e < 32; ++e) {
        float v = part[e];
        for (int off = 32; off > 0; off >>= 1) v += __shfl_xor(v, off);
        part[e] = v;
    }
    __syncthreads();
    if ((threadIdx.x & 63) == 0) {
#pragma unroll
        for (int e = 0; e < 32; ++e) lg[threadIdx.x >> 6][e] = part[e];
    }
    __syncthreads();
    if (threadIdx.x < 32) lg[0][threadIdx.x] = lg[0][threadIdx.x] + lg[1][threadIdx.x] + lg[2][threadIdx.x] + lg[3][threadIdx.x] + b_router[threadIdx.x];
    __syncthreads();
    if (threadIdx.x == 0) {
        unsigned used = 0;
        int s0 = 0, s1 = 0, s2_ = 0, s3 = 0; float v0 = 0.f, v1 = 0.f, v2 = 0.f, v3 = 0.f;
        for (int k = 0; k < 4; ++k) {
            int best = 0; float bv = -3.4e38f;
            for (int e = 0; e < 32; ++e) { float lv = lg[0][e]; if (!((used >> e) & 1u) && lv > bv) { bv = lv; best = e; } }
            used |= 1u << best;
            if (k == 0) { s0 = best; v0 = bv; } else if (k == 1) { s1 = best; v1 = bv; } else if (k == 2) { s2_ = best; v2 = bv; } else { s3 = best; v3 = bv; }
        }
        float e0 = 1.f, e1 = __expf(v1 - v0), e2 = __expf(v2 - v0), e3 = __expf(v3 - v0);
        float inv = 1.f / (e0 + e1 + e2 + e3);
        top_e[(size_t)t * 4 + 0] = s0; top_e[(size_t)t * 4 + 1] = s1; top_e[(size_t)t * 4 + 2] = s2_; top_e[(size_t)t * 4 + 3] = s3;
        top_g[(size_t)t * 4 + 0] = e0 * inv; top_g[(size_t)t * 4 + 1] = e1 * inv; top_g[(size_t)t * 4 + 2] = e2 * inv; top_g[(size_t)t * 4 + 3] = e3 * inv;
        pos[(size_t)t * 4 + 0] = atomicAdd(&cnt[s0], 1); pos[(size_t)t * 4 + 1] = atomicAdd(&cnt[s1], 1);
        pos[(size_t)t * 4 + 2] = atomicAdd(&cnt[s2_], 1); pos[(size_t)t * 4 + 3] = atomicAdd(&cnt[s3], 1);
    }
}

__global__ void k_moe_offsets(const int* __restrict__ cnt, int* __restrict__ off, int* __restrict__ tile_e, int* __restrict__ ntiles) {
    if (threadIdx.x != 0) return;
    int o = 0, nt = 0;
    for (int e = 0; e < NE; ++e) {
        off[e] = o; int c = cnt[e];
        for (int m = 0; m < c; m += 256) { tile_e[nt] = e; ++nt; }
        o = nt * 256;
    }
    ntiles[0] = nt;
}
__global__ void k_moe_scatter(const int* __restrict__ top_e, const int* __restrict__ pos, const int* __restrict__ off, int* __restrict__ slot_token, int* __restrict__ tok_slot, int with_ctx) {
    int i = blockIdx.x * 256 + threadIdx.x;
    if (i >= NASSIGN) return;
    int t = i >> 2; int n = t % NT;
    if (n < NC && !with_ctx) return;
    int slot = off[top_e[i]] + pos[i];
    slot_token[slot] = t; tok_slot[i] = slot;
}

__global__ __launch_bounds__(256) void k_combine(float* __restrict__ xall, const float* __restrict__ yexp, const int* __restrict__ tok_slot, const float* __restrict__ top_g,
                                                 const float* __restrict__ nw3, const float* __restrict__ modl, int with_ctx) {
    __shared__ float red[8];
    int t = blockIdx.x; int b = t / NT, n = t % NT;
    if (n < NC && !with_ctx) return;
    int r = (n < NC) ? 8 : b;
    int d = threadIdx.x * 4;
    float4 m = make_float4(0.f, 0.f, 0.f, 0.f);
#pragma unroll
    for (int k = 0; k < 4; ++k) {
        int slot = tok_slot[(size_t)t * 4 + k]; float gk = top_g[(size_t)t * 4 + k];
        float4 y = *(const float4*)(yexp + (size_t)slot * DM + d);
        m.x += gk * y.x; m.y += gk * y.y; m.z += gk * y.z; m.w += gk * y.w;
    }
    float ss = m.x * m.x + m.y * m.y + m.z * m.z + m.w * m.w;
    ss = block_sum_256(ss, red);
    float rstd = rsqrtf(ss * (1.f / DM) + 1e-6f);
    float4 w3 = *(const float4*)(nw3 + d);
    float4 g2 = *(const float4*)(modl + (size_t)r * 6144 + 5120 + d);
    float4 xv = *(const float4*)(xall + (size_t)t * DM + d);
    xv.x += g2.x * m.x * rstd * w3.x; xv.y += g2.y * m.y * rstd * w3.y; xv.z += g2.z * m.z * rstd * w3.z; xv.w += g2.w * m.w * rstd * w3.w;
    *(float4*)(xall + (size_t)t * DM + d) = xv;
}

__global__ void k_out(const float* __restrict__ xall, float* __restrict__ out) {
    size_t i = (size_t)blockIdx.x * 256 + threadIdx.x;
    size_t total = (size_t)NB * NS * DM / 4;
    if (i >= total) return;
    size_t t = i / (DM / 4); int d4 = (int)(i % (DM / 4));
    int b = (int)(t / NS), n = (int)(t % NS);
    ((float4*)out)[i] = ((const float4*)(xall + ((size_t)b * NT + NC + n) * DM))[d4];
}

static void launch_gemm(hipStream_t st, const float* A, int lda, const float* B, int ldb, float* C, int ldc, const float* bias, int M, int N, int K) {
    GemmArgs g{}; g.A = A; g.B = B; g.C = C; g.bias = bias; g.M = M; g.N = N; g.K = K; g.lda = lda; g.ldb = ldb; g.ldc = ldc;
    dim3 grid((N + 63) / 64, (M + 63) / 64);
    k_gemm<0><<<grid, 256, 0, st>>>(g);
}

extern "C" void kernel_launch(void* const* d_in, const int* in_sizes, int n_in, void* d_out, int out_size, void* d_ws, size_t ws_size, hipStream_t stream) {
    const float* x = (const float*)d_in[0]; const float* c = (const float*)d_in[1]; const float* ctx = (const float*)d_in[2]; const float* c_ctx = (const float*)d_in[3];
    const float* w_mod = (const float*)d_in[4]; const float* b_mod = (const float*)d_in[5]; const float* norm_w = (const float*)d_in[6];
    const float* w_in = (const float*)d_in[7]; const float* w_out = (const float*)d_in[8]; const float* da_lambda = (const float*)d_in[9]; const float* da_subln = (const float*)d_in[10];
    const float* ml_conv_w = (const float*)d_in[11]; const float* ml_conv_b = (const float*)d_in[12]; const float* ml_gate_b = (const float*)d_in[13]; const float* ml_norm = (const float*)d_in[14];
    const float* mla_q_norm = (const float*)d_in[15]; const float* mla_w_uq = (const float*)d_in[16]; const float* mla_kv_norm = (const float*)d_in[17]; const float* mla_w_ukv = (const float*)d_in[18];
    const float* s5_a_re = (const float*)d_in[19]; const float* s5_a_im = (const float*)d_in[20]; const float* s5_log_step = (const float*)d_in[21];
    const float* s5_b_re = (const float*)d_in[22]; const float* s5_b_im = (const float*)d_in[23]; const float* s5_c_re = (const float*)d_in[24]; const float* s5_c_im = (const float*)d_in[25];
    const float* s5_d = (const float*)d_in[26]; const float* s5_w_glu = (const float*)d_in[27]; const float* s5_b_glu = (const float*)d_in[28];
    const float* moe_w_router = (const float*)d_in[29]; const float* moe_b_router = (const float*)d_in[30]; const float* moe_w_gate_up = (const float*)d_in[31];
    const float* moe_b_gate_up = (const float*)d_in[32]; const float* moe_w_down = (const float*)d_in[33]; const float* moe_b_down = (const float*)d_in[34];
    float* out = (float*)d_out;

    char* ws = (char*)d_ws; size_t off = 0;
    auto carve = [&](size_t bytes) { void* p = ws + off; off += (bytes + 255) & ~(size_t)255; return p; };
    float* xall = (float*)carve((size_t)TT * DM * 4);
    float* mod = (float*)carve((size_t)2 * 9 * 6144 * 4);
    float* ropecs = (float*)carve((size_t)NS * 16 * 2 * 4);
    float* lamfull = (float*)carve(256);
    float* abr = (float*)carve(4096 * 4); float* abi = (float*)carve(4096 * 4);
    float* bbr = (float*)carve(4096 * 16 * 4); float* bbi = (float*)carve(4096 * 16 * 4);
    bf16_t* w_in_t = (bf16_t*)carve((size_t)2 * 2560 * 1024 * 2);
    bf16_t* w_out_t = (bf16_t*)carve((size_t)2 * 1024 * 1024 * 2);
    bf16_t* wgu_t = (bf16_t*)carve((size_t)2 * NE * 2048 * 1024 * 2);
    bf16_t* wdn_t = (bf16_t*)carve((size_t)2 * NE * 1024 * 1024 * 2);
    bf16_t* hbuf = (bf16_t*)carve((size_t)TT * DM * 2);
    bf16_t* ycatb = (bf16_t*)carve((size_t)TT * DM * 2);
    float* obuf = (float*)carve((size_t)TT * DM * 4);
    float* fbuf = (float*)carve((size_t)TT * DM * 4);
    int* top_e = (int*)carve((size_t)NASSIGN * 4); float* top_g = (float*)carve((size_t)NASSIGN * 4); int* posb = (int*)carve((size_t)NASSIGN * 4);
    int* tok_slot = (int*)carve((size_t)NASSIGN * 4); int* slot_token = (int*)carve((size_t)MAXSLOTS * 4);
    int* cnt = (int*)carve(256); int* offs = (int*)carve(256); int* ntiles = (int*)carve(256);
    int* tile_e = (int*)carve(512 * 4);
    bf16_t* act = (bf16_t*)carve((size_t)MAXSLOTS * DM * 2);
    size_t zone0 = off;
    float* p = (float*)carve((size_t)TT * DIN * 4);
    bf16_t* daQ = (bf16_t*)carve((size_t)TT * 256 * 2); bf16_t* daK = (bf16_t*)carve((size_t)TT * 256 * 2); bf16_t* daV = (bf16_t*)carve((size_t)TT * 256 * 2);
    float* cqn = (float*)carve((size_t)TT * 192 * 4); float* ckvn = (float*)carve((size_t)TT * 128 * 4);
    float* qfull = (float*)carve((size_t)TT * 384 * 4); float* kvfull = (float*)carve((size_t)TT * 512 * 4);
    bf16_t* mQ = (bf16_t*)carve((size_t)TT * 384 * 2); bf16_t* mK = (bf16_t*)carve((size_t)TT * 384 * 2); bf16_t* mV = (bf16_t*)carve((size_t)TT * 256 * 2);
    float* mlqk = (float*)carve((size_t)TT * 512 * 4); float* mlG = (float*)carve((size_t)TT * 16 * 4); float* hdir = (float*)carve((size_t)2 * TT * 256 * 4);
    float* ys5 = (float*)carve((size_t)2 * TT * 256 * 4); float* gl = (float*)carve((size_t)TT * 256 * 4); float* zglu = (float*)carve((size_t)TT * 256 * 4);
    size_t zone1 = off;
    float* yexp = (float*)(ws + zone0);
    bf16_t* xg = (bf16_t*)(ws + zone0 + (size_t)MAXSLOTS * DM * 4);
    if (zone0 + (size_t)MAXSLOTS * DM * 6 > zone1) off = zone0 + (size_t)MAXSLOTS * DM * 6;
    if (off > ws_size) { fprintf(stderr, "workspace too small: need %zu have %zu\n", off, ws_size); return; }

    static bool attr_done = false;
    if (!attr_done) {
        (void)hipFuncSetAttribute((const void*)k_pg8_static<pg8::EpiF32>, hipFuncAttributeMaxDynamicSharedMemorySize, pg8::STAGE_BYTES);
        (void)hipFuncSetAttribute((const void*)k_pg8_grouped<pg8::EpiSwiglu>, hipFuncAttributeMaxDynamicSharedMemorySize, pg8::STAGE_BYTES);
        (void)hipFuncSetAttribute((const void*)k_pg8_grouped<pg8::EpiDown>, hipFuncAttributeMaxDynamicSharedMemorySize, pg8::STAGE_BYTES);
        attr_done = true;
    }

    k_build_x<<<(TT * DM / 4 + 255) / 256, 256, 0, stream>>>(x, ctx, xall);
    k_mod<<<2 * 6144 / 256, 256, 0, stream>>>(c, c_ctx, w_mod, b_mod, mod);
    k_rope_table<<<NS * 16 / 256, 256, 0, stream>>>(ropecs);
    k_lambda<<<1, 64, 0, stream>>>(da_lambda, lamfull);
    k_s5_disc<<<4096 / 256, 256, 0, stream>>>(s5_a_re, s5_a_im, s5_log_step, s5_b_re, s5_b_im, abr, abi, bbr, bbi);
    (void)hipMemsetAsync(w_in_t, 0, (size_t)2 * 2560 * 1024 * 2, stream);
    k_convT<0><<<dim3((DINC + 63) / 64, 16, 2), 256, 0, stream>>>(w_in, 1024, DINC, w_in_t, 1024, 0, 0, (long)1024 * DINC, (long)2560 * 1024);
    k_convT<0><<<dim3(16, 16, 2), 256, 0, stream>>>(w_out, 1024, 1024, w_out_t, 1024, 0, 0, (long)1024 * 1024, (long)1024 * 1024);
    k_convT<1><<<dim3(32, 16, 2 * NE), 256, 0, stream>>>(moe_w_gate_up, 1024, 2048, wgu_t, 1024, 0, 0, (long)1024 * 2048, (long)2048 * 1024);
    k_convT<0><<<dim3(16, 16, 2 * NE), 256, 0, stream>>>(moe_w_down, 1024, 1024, wdn_t, 1024, 0, 0, (long)1024 * 1024, (long)1024 * 1024);

    for (int l = 0; l < 2; ++l) {
        int with_ctx = (l == 0);
        float lambda_init = (float)(0.8 - 0.6 * exp(-0.3 * l));
        const float* modl = mod + (size_t)l * 9 * 6144;
        const float* nw = norm_w + (size_t)l * 4 * 1024;
        k_norm_mod<<<TT, 256, 0, stream>>>(xall, nw, modl, 0, 1024, hbuf);
        {
            pg8::Gemm g{hbuf, w_in_t + (size_t)l * 2560 * 1024, TT, 2560, 1024, 0};
            pg8::EpiF32 E{p, nullptr, DIN, 0};
            k_pg8_static<pg8::EpiF32><<<256, 512, pg8::STAGE_BYTES, stream>>>(g, E);
        }
        k_da_prep2<<<TT / 64, 256, 0, stream>>>(p, ropecs, daQ, daK, daV, 0.17677669529663687f * 1.4426950408889634f);
        k_attn_mfma<64, 2, true><<<dim3(9, 4, NB), 512, ATT_LDS_BYTES, stream>>>(daQ, daK, daV, ycatb, 0, lamfull + l, da_subln + l * 64, 1.f - lambda_init, with_ctx);
        k_mla_norm<<<TT, 64, 0, stream>>>(p, mla_q_norm + l * 192, mla_kv_norm + l * 128, cqn, ckvn);
        launch_gemm(stream, cqn, 192, mla_w_uq + (size_t)l * 192 * 384, 384, qfull, 384, nullptr, TT, 384, 192);
        launch_gemm(stream, ckvn, 128, mla_w_ukv + (size_t)l * 128 * 512, 512, kvfull, 512, nullptr, TT, 512, 128);
        k_mla_layout2<<<TT / 64, 256, 0, stream>>>(p, qfull, kvfull, ropecs, mQ, mK, mV, 0.10206207261596575f * 1.4426950408889634f);
        k_attn_mfma<96, 1, false><<<dim3(9, 4, NB), 512, ATT_LDS_BYTES, stream>>>(mQ, mK, mV, ycatb, 512, lamfull, nullptr, 1.f, with_ctx);
        k_ml_prep<<<TT, 256, 0, stream>>>(p, ml_conv_w + l * 3 * 512, ml_conv_b + l * 512, ml_gate_b + l * 16, mlqk, mlG);
        k_mlstm<<<dim3(4, NB, 2), 256, 0, stream>>>(mlqk, p, mlG, hdir);
        k_ml_finish<<<TT, 256, 0, stream>>>(p, hdir, ml_norm + l * 256, ycatb);
        k_s5_scan<<<dim3(16, NB, 2), 64, 0, stream>>>(p, abr + l * 2048, abi + l * 2048, bbr + (size_t)l * 2048 * 16, bbi + (size_t)l * 2048 * 16,
                                                      s5_c_re + (size_t)l * 2 * 16 * 1024, s5_c_im + (size_t)l * 2 * 16 * 1024, ys5);
        k_s5_gelu<<<TT, 256, 0, stream>>>(p, ys5, s5_d + l * 256, gl);
        launch_gemm(stream, gl, 256, s5_w_glu + (size_t)l * 256 * 256, 256, zglu, 256, s5_b_glu + l * 256, TT, 256, 256);
        k_s5_glu<<<TT, 256, 0, stream>>>(gl, zglu, ycatb);
        {
            pg8::Gemm g{ycatb, w_out_t + (size_t)l * 1024 * 1024, TT, 1024, 1024, 0};
            pg8::EpiF32 E{obuf, nullptr, DM, 0};
            k_pg8_static<pg8::EpiF32><<<256, 512, pg8::STAGE_BYTES, stream>>>(g, E);
        }
        (void)hipMemsetAsync(cnt, 0, 128, stream);
        (void)hipMemsetAsync(slot_token, 0xFF, (size_t)MAXSLOTS * 4, stream);
        k_post1<<<TT, 256, 0, stream>>>(xall, obuf, nw + 1024, nw + 2048, modl, moe_w_router + (size_t)l * 1024 * 32, moe_b_router + l * 32, fbuf, top_e, top_g, cnt, posb, with_ctx);
        k_moe_offsets<<<1, 64, 0, stream>>>(cnt, offs, tile_e, ntiles);
        k_moe_scatter<<<NASSIGN / 256, 256, 0, stream>>>(top_e, posb, offs, slot_token, tok_slot, with_ctx);
        k_moe_gather<<<MAXSLOTS, 256, 0, stream>>>(fbuf, slot_token, ntiles, xg);
        {
            pg8::Gemm g{xg, wgu_t + (size_t)l * NE * 2048 * 1024, 0, 2048, 1024, 0};
            pg8::EpiSwiglu E{act, moe_b_gate_up + (size_t)l * NE * 2048};
            k_pg8_grouped<pg8::EpiSwiglu><<<256, 512, pg8::STAGE_BYTES, stream>>>(g, E, ntiles, tile_e);
        }
        {
            pg8::Gemm g{act, wdn_t + (size_t)l * NE * 1024 * 1024, 0, 1024, 1024, 0};
            pg8::EpiDown E{yexp, moe_b_down + (size_t)l * NE * 1024};
            k_pg8_grouped<pg8::EpiDown><<<256, 512, pg8::STAGE_BYTES, stream>>>(g, E, ntiles, tile_e);
        }
        k_combine<<<TT, 256, 0, stream>>>(xall, yexp, tok_slot, top_g, nw + 3072, modl, with_ctx);
    }
    k_out<<<(NB * NS * DM / 4 + 255) / 256, 256, 0, stream>>>(xall, out);
}
```

```cpp
#include <hip/hip_runtime.h>
#include <cstdint>
#include <cstdio>

#define NB 8
#define NS 2048
#define NC 256
#define NT 2304
#define TT (NB * NT)
#define DM 1024
#define DIN 2560
#define DINC 2416
#define NE 32
#define NASSIGN (TT * 4)
#define MAXSLOTS (NASSIGN + NE * 256)

#define P_DAQ 0
#define P_DAK 256
#define P_DAV 512
#define P_MLQK 768
#define P_MLV 1280
#define P_MLO 1536
#define P_MLG 1792
#define P_CQ 1808
#define P_CKV 2000
#define P_KR 2128
#define P_S5 2160

__device__ __forceinline__ float sigmoidf_(float x) { return 1.f / (1.f + __expf(-x)); }
__device__ __forceinline__ float siluf_(float x) { return x / (1.f + __expf(-x)); }
__device__ __forceinline__ float logsigmoidf_(float x) { return fminf(x, 0.f) - log1pf(__expf(-fabsf(x))); }

__device__ __forceinline__ float block_sum_256(float v, float* red) {
    for (int o = 32; o > 0; o >>= 1) v += __shfl_xor(v, o);
    __syncthreads();
    if ((threadIdx.x & 63) == 0) red[threadIdx.x >> 6] = v;
    __syncthreads();
    float r = red[0] + red[1] + red[2] + red[3];
    return r;
}


typedef unsigned short bf16_t;
__device__ __forceinline__ bf16_t f2bf(float f) { unsigned u = __float_as_uint(f); u += 0x7FFFu + ((u >> 16) & 1u); return (bf16_t)(u >> 16); }
__device__ __forceinline__ float bf2f(bf16_t b) { return __uint_as_float(((unsigned)b) << 16); }
__device__ __forceinline__ unsigned pk2bf(float lo, float hi) { return (unsigned)f2bf(lo) | ((unsigned)f2bf(hi) << 16); }

namespace pg8 {
#define PG8_LAS __attribute__((address_space(3)))
typedef short bf16x8 __attribute__((ext_vector_type(8)));
typedef float f32x4 __attribute__((ext_vector_type(4)));
typedef unsigned u32x4 __attribute__((ext_vector_type(4)));
constexpr int BM = 256, BK = 64, HALF = 128, HTB = HALF * BK * 2, STAGE_BYTES = 8 * HTB, NXCD = 8, WGM = 8;
__host__ __device__ __forceinline__ int lds_byte(int r, int c) { const int st = (r >> 4) * 2 + (c >> 5), rr = r & 15, cc = c & 31, ob = rr * 64 + cc * 2; return st * 1024 + (ob ^ (((ob >> 9) & 1) << 5)); }
__host__ __device__ __forceinline__ void stage_rc(int b, int& R, int& C) { const int st = b / 1024, sb = b % 1024, swz = sb ^ (((sb >> 9) & 1) << 5); R = (st >> 1) * 16 + swz / 64; C = (st & 1) * 32 + (swz % 64) / 2; }
__host__ __device__ __forceinline__ int perm32(int rho) { const int n = rho >> 4, i = rho & 15; return 8 * (i >> 2) + 4 * n + (i & 3); }
struct Unit { int pm, pn; };
struct Gemm { const bf16_t* A; const bf16_t* Bt; int M, N, K, pad; };
__device__ __forceinline__ unsigned cvt_pk_bf16(float lo, float hi) { unsigned r; asm volatile("v_cvt_pk_bf16_f32 %0, %1, %2" : "=v"(r) : "v"(lo), "v"(hi)); return r; }

struct StaticOrder {
    int nM, nN, nwg, G, c;
    __device__ void init(int M, int N, int G_, int c_) { nM = M / BM; nN = N / BM; nwg = nM * nN; G = G_; c = c_; }
    __device__ bool next(int i, Unit& u) const {
        const long L = (long)i * G + c; if (L >= nwg) return false;
        int wgid = (int)L; { const int q = nwg / NXCD, r = nwg % NXCD, xcd = wgid % NXCD, off = wgid / NXCD; wgid = (xcd < r ? xcd * (q + 1) : r * (q + 1) + (xcd - r) * q) + off; }
        const int nig = WGM * nN, gid = wgid / nig, fm = gid * WGM, gsz = (nM - fm) < WGM ? (nM - fm) : WGM;
        u.pm = fm + ((wgid % nig) % gsz); u.pn = (wgid % nig) / gsz; return true;
    }
    __device__ __forceinline__ void a_ready(const Unit&) const {}
    __device__ __forceinline__ void done(const Unit&) const {}
};
struct GroupedOrder : StaticOrder {
    const int* tile_e;
    __device__ void initg(const int* ntiles_p, const int* tile_e_, int N, int G_, int c_) { nM = ntiles_p[0]; nN = N / BM; nwg = nM * nN; G = G_; c = c_; tile_e = tile_e_; }
    __device__ bool next(int i, Unit& u) const { if (!StaticOrder::next(i, u)) return false; u.pn += tile_e[u.pm] * nN; return true; }
};

struct EpiF32 {
    static constexpr bool PERM = false;
    float* C; const float* bias; int ldc, pad;
    __device__ __forceinline__ void operator()(const f32x4 (&acc)[2][2][4][2], const Unit& u, int wr, int wc, int fr, int fq) const {
        const int row0 = u.pm * BM + wr * 64 + fr, col0 = u.pn * BM + wc * 32 + 4 * fq;
        f32x4 bv[2][2];
#pragma unroll
        for (int bj = 0; bj < 2; ++bj)
#pragma unroll
            for (int n = 0; n < 2; ++n) bv[bj][n] = bias ? *(const f32x4*)(bias + col0 + bj * HALF + n * 16) : (f32x4){0.f, 0.f, 0.f, 0.f};
#pragma unroll
        for (int ai = 0; ai < 2; ++ai)
#pragma unroll
            for (int m = 0; m < 4; ++m) { float* rowp = C + (size_t)(row0 + ai * HALF + m * 16) * ldc + col0;
#pragma unroll
                for (int bj = 0; bj < 2; ++bj)
#pragma unroll
                    for (int n = 0; n < 2; ++n) *(f32x4*)(rowp + bj * HALF + n * 16) = acc[ai][bj][m][n] + bv[bj][n]; }
    }
};
struct EpiDown {
    static constexpr bool PERM = false;
    float* C; const float* bias;
    __device__ __forceinline__ void operator()(const f32x4 (&acc)[2][2][4][2], const Unit& u, int wr, int wc, int fr, int fq) const {
        const int e = u.pn >> 2, pnl = u.pn & 3;
        const int row0 = u.pm * BM + wr * 64 + fr, col0 = pnl * BM + wc * 32 + 4 * fq;
        const float* bp = bias + (size_t)e * 1024;
        f32x4 bv[2][2];
#pragma unroll
        for (int bj = 0; bj < 2; ++bj)
#pragma unroll
            for (int n = 0; n < 2; ++n) bv[bj][n] = *(const f32x4*)(bp + col0 + bj * HALF + n * 16);
#pragma unroll
        for (int ai = 0; ai < 2; ++ai)
#pragma unroll
            for (int m = 0; m < 4; ++m) { float* rowp = C + (size_t)(row0 + ai * HALF + m * 16) * 1024 + col0;
#pragma unroll
                for (int bj = 0; bj < 2; ++bj)
#pragma unroll
                    for (int n = 0; n < 2; ++n) *(f32x4*)(rowp + bj * HALF + n * 16) = acc[ai][bj][m][n] + bv[bj][n]; }
    }
};
struct EpiSwiglu {
    static constexpr bool PERM = true;
    bf16_t* O; const float* bias;
    __device__ __forceinline__ void operator()(const f32x4 (&acc)[2][2][4][2], const Unit& u, int wr, int wc, int fr, int fq) const {
        const int e = u.pn >> 3, pnl = u.pn & 7;
        const int row0 = u.pm * BM + wr * 64 + fr, col0 = pnl * HALF + wc * 32 + 8 * fq;
        const float* bp = bias + (size_t)e * 2048 + col0;
        f32x4 bg[2], bu[2];
#pragma unroll
        for (int n = 0; n < 2; ++n) { bg[n] = *(const f32x4*)(bp + 4 * n); bu[n] = *(const f32x4*)(bp + 1024 + 4 * n); }
#pragma unroll
        for (int ai = 0; ai < 2; ++ai)
#pragma unroll
            for (int m = 0; m < 4; ++m) {
                bf16_t* rowp = O + (size_t)(row0 + ai * HALF + m * 16) * 1024 + col0;
                float r[8];
#pragma unroll
                for (int n = 0; n < 2; ++n) {
                    f32x4 g = acc[ai][0][m][n] + bg[n], up = acc[ai][1][m][n] + bu[n];
#pragma unroll
                    for (int j = 0; j < 4; ++j) {
                        float gt = fminf(g[j], 7.f), uu = fminf(fmaxf(up[j], -7.f), 7.f);
                        r[n * 4 + j] = (uu + 1.f) * gt / (1.f + __expf(-1.702f * gt));
                    }
                }
                u32x4 w; w.x = cvt_pk_bf16(r[0], r[1]); w.y = cvt_pk_bf16(r[2], r[3]); w.z = cvt_pk_bf16(r[4], r[5]); w.w = cvt_pk_bf16(r[6], r[7]);
                *(u32x4*)rowp = w;
            }
    }
};

template <class Epi, class Sched>
__device__ __forceinline__ void gemm_phase(PG8_LAS unsigned char* lds, const Gemm g, const Sched& S, const Epi& E) {
    const int tid = threadIdx.x, wid = __builtin_amdgcn_readfirstlane(tid >> 6), lane = tid & 63, wr = wid >> 2, wc = wid & 3, fr = lane & 15, fq = lane >> 4;
    const int K = g.K, nt = K / BK;
    unsigned voffA[2], voffB[2];
#pragma unroll
    for (int i = 0; i < 2; ++i) { int R, C; stage_rc(tid * 16 + i * 8192, R, C); const int Rb = Epi::PERM ? ((R & ~31) + perm32(R & 31)) : R;
        voffA[i] = (unsigned)(R * K + C) * 2u; voffB[i] = (unsigned)(Rb * K + C) * 2u; }
    const size_t kstep = (size_t)(BK * 2);
    const size_t hstep = (size_t)HALF * K * 2;
    const size_t tstep = 2 * hstep;
    const unsigned ldsw = (unsigned)wid * 1024u;
    const int aoff = lds_byte(wr * 64 + fr, fq * 8), boff = lds_byte(wc * 32 + fr, fq * 8);
#define PG8_SA(b, h) (((b) * 2 + (h)) * HTB)
#define PG8_SB(b, h) ((4 + (b) * 2 + (h)) * HTB)
#define PG8_STAGE(bufoff, gbase, voff) do { _Pragma("unroll") for (int _i = 0; _i < 2; ++_i) \
        __builtin_amdgcn_global_load_lds((const unsigned*)((const char*)(gbase) + (voff)[_i]), (PG8_LAS unsigned*)(lds + (bufoff) + ldsw + _i * 8192), 16, 0, 0); } while (0)
#define PG8_LDA(dst, b, h) do { _Pragma("unroll") for (int m = 0; m < 4; ++m) _Pragma("unroll") for (int k = 0; k < 2; ++k) dst[m][k] = *(const PG8_LAS bf16x8*)(lds + PG8_SA(b, h) + aoff + m * 2048 + k * 1024); } while (0)
#define PG8_LDB(dst, b, h) do { _Pragma("unroll") for (int n = 0; n < 2; ++n) _Pragma("unroll") for (int k = 0; k < 2; ++k) dst[n][k] = *(const PG8_LAS bf16x8*)(lds + PG8_SB(b, h) + boff + n * 2048 + k * 1024); } while (0)
#define PG8_MMA(ai, bj, At, Bt) do { __builtin_amdgcn_s_setprio(1); _Pragma("unroll") for (int m = 0; m < 4; ++m) _Pragma("unroll") for (int n = 0; n < 2; ++n) _Pragma("unroll") for (int k = 0; k < 2; ++k) \
        acc[ai][bj][m][n] = __builtin_amdgcn_mfma_f32_16x16x32_bf16(Bt[n][k], At[m][k], acc[ai][bj][m][n], 0, 0, 0); __builtin_amdgcn_s_setprio(0); } while (0)
#define PG8_WAIT_V(n) asm volatile("s_waitcnt vmcnt(" #n ")" ::: "memory")
#define PG8_WAIT_L(n) asm volatile("s_waitcnt lgkmcnt(" #n ")" ::: "memory")
#define PG8_BAR __builtin_amdgcn_s_barrier()
#define PG8_SCHED __builtin_amdgcn_sched_barrier(0)
    Unit cur, nxt; int ui = 0;
    if (!S.next(0, cur)) return;
    f32x4 acc[2][2][4][2];
#pragma unroll
    for (int a = 0; a < 2; ++a)
#pragma unroll
        for (int b = 0; b < 2; ++b)
#pragma unroll
            for (int m = 0; m < 4; ++m)
#pragma unroll
                for (int n = 0; n < 2; ++n) acc[a][b][m][n] = (f32x4){0.f, 0.f, 0.f, 0.f};
    bf16x8 At[4][2], B0[2][2], B1[2][2];
    const char* cA = (const char*)g.A + (size_t)cur.pm * tstep; const char* cB = (const char*)g.Bt + (size_t)cur.pn * tstep;
    S.a_ready(cur);
    PG8_STAGE(PG8_SB(0, 0), cB, voffB); PG8_STAGE(PG8_SA(0, 0), cA, voffA); PG8_STAGE(PG8_SB(0, 1), cB + hstep, voffB); PG8_STAGE(PG8_SA(0, 1), cA + hstep, voffA);
    if (wr == 1) PG8_BAR;
    PG8_WAIT_V(4); PG8_BAR;
    PG8_STAGE(PG8_SB(1, 0), cB + kstep, voffB); PG8_STAGE(PG8_SA(1, 0), cA + kstep, voffA); PG8_STAGE(PG8_SB(1, 1), cB + hstep + kstep, voffB);
    PG8_WAIT_V(6); PG8_BAR;
    for (;;) {
        const bool has_next = S.next(ui + 1, nxt);
        const char* nA = has_next ? (const char*)g.A + (size_t)nxt.pm * tstep : cA; const char* nB = has_next ? (const char*)g.Bt + (size_t)nxt.pn * tstep : cB;
        for (int t = 0; t < nt; t += 2) {
            const bool last = (t == nt - 2);
            const char* a1 = cA + (size_t)(t + 1) * kstep;
            const char* a2 = last ? nA : cA + (size_t)(t + 2) * kstep; const char* b2 = last ? nB : cB + (size_t)(t + 2) * kstep;
            const char* a3 = a2 + kstep; const char* b3 = b2 + kstep;
            if (last && has_next) S.a_ready(nxt);
            PG8_LDB(B0, 0, 0); PG8_SCHED; PG8_LDA(At, 0, 0); PG8_STAGE(PG8_SA(1, 1), a1 + hstep, voffA);
            PG8_WAIT_L(8); PG8_BAR; PG8_WAIT_L(0); PG8_MMA(0, 0, At, B0); PG8_BAR; PG8_SCHED;
            PG8_LDB(B1, 0, 1); PG8_STAGE(PG8_SB(0, 0), b2, voffB);
            PG8_BAR; PG8_WAIT_L(0); PG8_MMA(0, 1, At, B1); PG8_BAR;
            PG8_LDA(At, 0, 1); PG8_STAGE(PG8_SA(0, 0), a2, voffA);
            PG8_BAR; PG8_WAIT_L(0); PG8_MMA(1, 0, At, B0); PG8_BAR; PG8_SCHED;
            PG8_STAGE(PG8_SB(0, 1), b2 + hstep, voffB);
            PG8_WAIT_V(6); PG8_BAR; PG8_MMA(1, 1, At, B1); PG8_BAR;
            PG8_LDB(B0, 1, 0); PG8_SCHED; PG8_LDA(At, 1, 0); PG8_STAGE(PG8_SA(0, 1), a2 + hstep, voffA);
            PG8_WAIT_L(8); PG8_BAR; PG8_WAIT_L(0); PG8_MMA(0, 0, At, B0); PG8_BAR; PG8_SCHED;
            PG8_LDB(B1, 1, 1); PG8_STAGE(PG8_SB(1, 0), b3, voffB);
            PG8_BAR; PG8_WAIT_L(0); PG8_MMA(0, 1, At, B1); PG8_BAR;
            PG8_LDA(At, 1, 1); PG8_STAGE(PG8_SA(1, 0), a3, voffA);
            PG8_BAR; PG8_WAIT_L(0); PG8_MMA(1, 0, At, B0); PG8_BAR; PG8_SCHED;
            PG8_STAGE(PG8_SB(1, 1), b3 + hstep, voffB);
            PG8_WAIT_V(6); PG8_BAR; PG8_MMA(1, 1, At, B1); PG8_BAR;
        }
        E(acc, cur, wr, wc, fr, fq); S.done(cur);
        if (!has_next) break;
#pragma unroll
        for (int a = 0; a < 2; ++a)
#pragma unroll
            for (int b = 0; b < 2; ++b)
#pragma unroll
                for (int m = 0; m < 4; ++m)
#pragma unroll
                    for (int n = 0; n < 2; ++n) acc[a][b][m][n] = (f32x4){0.f, 0.f, 0.f, 0.f};
        cur = nxt; cA = nA; cB = nB; ++ui;
    }
    PG8_WAIT_V(0);
    if (wr == 0) PG8_BAR;
    PG8_BAR;
#undef PG8_SA
#undef PG8_SB
#undef PG8_STAGE
#undef PG8_LDA
#undef PG8_LDB
#undef PG8_MMA
#undef PG8_WAIT_V
#undef PG8_WAIT_L
#undef PG8_BAR
#undef PG8_SCHED
}
}

extern __shared__ __attribute__((aligned(16))) unsigned char dyn_lds[];
template <class Epi>
__global__ __launch_bounds__(512, 2) void k_pg8_static(pg8::Gemm g, Epi E) {
    pg8::StaticOrder S; S.init(g.M, g.N, gridDim.x, blockIdx.x);
    pg8::gemm_phase<Epi, pg8::StaticOrder>((PG8_LAS unsigned char*)dyn_lds, g, S, E);
}
template <class Epi>
__global__ __launch_bounds__(512, 2) void k_pg8_grouped(pg8::Gemm g, Epi E, const int* ntiles, const int* tile_e) {
    pg8::GroupedOrder S; S.initg(ntiles, tile_e, g.N, gridDim.x, blockIdx.x);
    pg8::gemm_phase<Epi, pg8::GroupedOrder>((PG8_LAS unsigned char*)dyn_lds, g, S, E);
}

template <int MODE>
__global__ __launch_bounds__(256) void k_convT(const float* __restrict__ W, int K, int N, bf16_t* __restrict__ WT, int ldt, int roff, int koff, long strideW, long strideT) {
    __shared__ float tile[64][65];
    W += (size_t)blockIdx.z * strideW; WT += (size_t)blockIdx.z * strideT;
    int n0 = blockIdx.x * 64, k0 = blockIdx.y * 64;
    int tn = threadIdx.x & 63, tk = threadIdx.x >> 6;
#pragma unroll
    for (int i = 0; i < 16; ++i) { int k = i * 4 + tk; tile[k][tn] = (n0 + tn < N) ? W[(size_t)(k0 + k) * N + n0 + tn] : 0.f; }
    __syncthreads();
    int n = threadIdx.x >> 2, kc = (threadIdx.x & 3) * 16;
    if (n0 + n >= N) return;
    int gn = n0 + n; int dr;
    if (MODE == 0) dr = gn; else { dr = (gn < 1024) ? ((gn >> 7) * 256 + (gn & 127)) : ((((gn - 1024) >> 7) * 256) + 128 + ((gn - 1024) & 127)); }
    uint4 o0, o1;
    o0.x = pk2bf(tile[kc + 0][n], tile[kc + 1][n]); o0.y = pk2bf(tile[kc + 2][n], tile[kc + 3][n]); o0.z = pk2bf(tile[kc + 4][n], tile[kc + 5][n]); o0.w = pk2bf(tile[kc + 6][n], tile[kc + 7][n]);
    o1.x = pk2bf(tile[kc + 8][n], tile[kc + 9][n]); o1.y = pk2bf(tile[kc + 10][n], tile[kc + 11][n]); o1.z = pk2bf(tile[kc + 12][n], tile[kc + 13][n]); o1.w = pk2bf(tile[kc + 14][n], tile[kc + 15][n]);
    bf16_t* dp = WT + (size_t)(roff + dr) * ldt + koff + k0 + kc;
    *(uint4*)dp = o0; *(uint4*)(dp + 8) = o1;
}

__global__ __launch_bounds__(256) void k_to_bf16_rows(const float* __restrict__ src, bf16_t* __restrict__ dst) {
    size_t t = blockIdx.x; int d = threadIdx.x * 4;
    float4 v = *(const float4*)(src + t * DM + d);
    uint2 o; o.x = pk2bf(v.x, v.y); o.y = pk2bf(v.z, v.w);
    *(uint2*)(dst + t * DM + d) = o;
}
__global__ __launch_bounds__(256) void k_moe_gather(const float* __restrict__ f, const int* __restrict__ slot_token, const int* __restrict__ ntiles, bf16_t* __restrict__ xg) {
    int slot = blockIdx.x;
    if (slot >= ntiles[0] * 256) return;
    int t = slot_token[slot]; int d = threadIdx.x * 4;
    uint2 o = make_uint2(0u, 0u);
    if (t >= 0) { float4 v = *(const float4*)(f + (size_t)t * DM + d); o.x = pk2bf(v.x, v.y); o.y = pk2bf(v.z, v.w); }
    *(uint2*)(xg + (size_t)slot * DM + d) = o;
}


typedef short bf16x8_t __attribute__((ext_vector_type(8)));
typedef float f32x16_t __attribute__((ext_vector_type(16)));
typedef unsigned u32x4_t __attribute__((ext_vector_type(4)));
typedef unsigned u32x2_t __attribute__((ext_vector_type(2)));
#define LAS3 __attribute__((address_space(3)))
__device__ __forceinline__ unsigned cvtpk(float lo, float hi) { unsigned r; asm volatile("v_cvt_pk_bf16_f32 %0, %1, %2" : "=v"(r) : "v"(lo), "v"(hi)); return r; }
constexpr int ATT_VROW = 68;
constexpr int ATT_LDS_BYTES = 2 * (64 * 104 * 2 + 64 * ATT_VROW * 2);

template <int QKD, int NMAP, bool DA>
__device__ __forceinline__ void attn_item(LAS3 unsigned char* lds, const bf16_t* __restrict__ Qb, const bf16_t* __restrict__ Kb, const bf16_t* __restrict__ Vt,
                                          bf16_t* __restrict__ ycatb, int ycat_off, int b, int h, int qblk, float lam, const float* __restrict__ subln, float post_scale) {
    constexpr int DK = QKD / NMAP, KS = DK / 16, KROW = QKD + 8, KCH = QKD / 8;
    constexpr int KBYTES = 64 * KROW * 2, VBYTES = 64 * ATT_VROW * 2, BUFB = KBYTES + VBYTES;
    const int tid = threadIdx.x, wid = tid >> 6, lane = tid & 63, r = lane & 31, hh = lane >> 5;
    const int q0 = qblk * 256, ntiles = (qblk == 0) ? (NC / 64) : (NT / 64);
    const size_t base = ((size_t)b * 4 + h) * NT;
    bf16x8_t qf[NMAP][KS];
#pragma unroll
    for (int m = 0; m < NMAP; ++m)
#pragma unroll
        for (int ks = 0; ks < KS; ++ks) qf[m][ks] = *(const bf16x8_t*)(Qb + (base + q0 + 32 * wid + r) * QKD + m * DK + 16 * ks + 8 * hh);
    f32x16_t O[NMAP][2]; float mrun[NMAP], lrun[NMAP];
#pragma unroll
    for (int m = 0; m < NMAP; ++m) { mrun[m] = -1e30f; lrun[m] = 0.f;
#pragma unroll
        for (int d2 = 0; d2 < 2; ++d2)
#pragma unroll
            for (int i = 0; i < 16; ++i) O[m][d2][i] = 0.f; }
    constexpr int NKC = 64 * KCH;
    const bf16_t* kg = Kb + base * QKD;
    const bf16_t* vg = Vt + ((size_t)(b * 4 + h) * 64 + (tid >> 3)) * NT + (tid & 7) * 8;
    u32x4_t rk0, rk1 = (u32x4_t){0u, 0u, 0u, 0u}, rv;
    const int kc1 = tid + 512;
    const int k0row = tid / KCH, k0col = tid % KCH, k1row = kc1 / KCH, k1col = kc1 % KCH;
#define ATT_LOAD(j) do { rk0 = *(const u32x4_t*)(kg + (size_t)(j) * 64 * QKD + tid * 8); if (NKC > 512 && kc1 < NKC) rk1 = *(const u32x4_t*)(kg + (size_t)(j) * 64 * QKD + kc1 * 8); \
        rv = *(const u32x4_t*)(vg + (size_t)(j) * 64); } while (0)
#define ATT_STORE(buf) do { LAS3 unsigned char* kb_ = lds + (buf) * BUFB; LAS3 unsigned char* vb_ = kb_ + KBYTES; \
        *(LAS3 u32x4_t*)(kb_ + (k0row * KROW + k0col * 8) * 2) = rk0; if (NKC > 512 && kc1 < NKC) *(LAS3 u32x4_t*)(kb_ + (k1row * KROW + k1col * 8) * 2) = rk1; \
        LAS3 unsigned char* vd_ = vb_ + ((tid >> 3) * ATT_VROW + (tid & 7) * 8) * 2; *(LAS3 u32x2_t*)vd_ = (u32x2_t){rv.x, rv.y}; *(LAS3 u32x2_t*)(vd_ + 8) = (u32x2_t){rv.z, rv.w}; } while (0)
    __syncthreads();
    ATT_LOAD(0); ATT_STORE(0);
    if (ntiles > 1) ATT_LOAD(1);
    __syncthreads();
    for (int j = 0; j < ntiles; ++j) {
        const LAS3 unsigned char* kb = lds + (j & 1) * BUFB; const LAS3 unsigned char* vb = kb + KBYTES;
        f32x16_t S[NMAP][2];
#pragma unroll
        for (int m = 0; m < NMAP; ++m)
#pragma unroll
            for (int kt = 0; kt < 2; ++kt) {
#pragma unroll
                for (int i = 0; i < 16; ++i) S[m][kt][i] = 0.f;
#pragma unroll
                for (int ks = 0; ks < KS; ++ks) {
                    const bf16x8_t a = *(const LAS3 bf16x8_t*)(kb + ((kt * 32 + r) * KROW + m * DK + 16 * ks + 8 * hh) * 2);
                    S[m][kt] = __builtin_amdgcn_mfma_f32_32x32x16_bf16(a, qf[m][ks], S[m][kt], 0, 0, 0);
                }
            }
        bf16x8_t pf[NMAP][2][2];
#pragma unroll
        for (int m = 0; m < NMAP; ++m) {
            float mx = S[m][0][0];
#pragma unroll
            for (int i = 1; i < 16; ++i) mx = fmaxf(mx, S[m][0][i]);
#pragma unroll
            for (int i = 0; i < 16; ++i) mx = fmaxf(mx, S[m][1][i]);
            mx = fmaxf(mx, __shfl_xor(mx, 32));
            const float mn = fmaxf(mrun[m], mx);
            const float alpha = __builtin_amdgcn_exp2f(mrun[m] - mn);
            mrun[m] = mn;
            float ps = 0.f;
#pragma unroll
            for (int kt = 0; kt < 2; ++kt) {
#pragma unroll
                for (int i = 0; i < 16; ++i) { const float pv = __builtin_amdgcn_exp2f(S[m][kt][i] - mn); S[m][kt][i] = pv; ps += pv; }
#pragma unroll
                for (int s2 = 0; s2 < 2; ++s2) {
                    union { unsigned u[4]; bf16x8_t v; } cv;
#pragma unroll
                    for (int jj = 0; jj < 4; ++jj) cv.u[jj] = cvtpk(S[m][kt][8 * s2 + 2 * jj], S[m][kt][8 * s2 + 2 * jj + 1]);
                    pf[m][kt][s2] = cv.v;
                }
            }
            lrun[m] = lrun[m] * alpha + ps;
#pragma unroll
            for (int d2 = 0; d2 < 2; ++d2)
#pragma unroll
                for (int i = 0; i < 16; ++i) O[m][d2][i] *= alpha;
        }
#pragma unroll
        for (int d2 = 0; d2 < 2; ++d2)
#pragma unroll
            for (int kt = 0; kt < 2; ++kt)
#pragma unroll
                for (int s2 = 0; s2 < 2; ++s2) {
                    const LAS3 unsigned char* vp = vb + ((d2 * 32 + r) * ATT_VROW + kt * 32 + 16 * s2 + 4 * hh) * 2;
                    union { u32x2_t u[2]; bf16x8_t v; } av;
                    av.u[0] = *(const LAS3 u32x2_t*)vp; av.u[1] = *(const LAS3 u32x2_t*)(vp + 16);
#pragma unroll
                    for (int m = 0; m < NMAP; ++m) O[m][d2] = __builtin_amdgcn_mfma_f32_32x32x16_bf16(av.v, pf[m][kt][s2], O[m][d2], 0, 0, 0);
                }
        if (j + 1 < ntiles) { ATT_STORE((j + 1) & 1); if (j + 2 < ntiles) ATT_LOAD(j + 2); }
        __syncthreads();
    }
#undef ATT_LOAD
#undef ATT_STORE
    float inv[NMAP];
#pragma unroll
    for (int m = 0; m < NMAP; ++m) { const float lt = lrun[m] + __shfl_xor(lrun[m], 32); inv[m] = 1.f / lt; }
    if (NMAP == 2) inv[NMAP - 1] *= -lam;
    float ss = 0.f;
#pragma unroll
    for (int d2 = 0; d2 < 2; ++d2)
#pragma unroll
        for (int i = 0; i < 16; ++i) {
            float o = O[0][d2][i] * inv[0];
            if (NMAP == 2) o += O[NMAP - 1][d2][i] * inv[NMAP - 1];
            O[0][d2][i] = o; ss += o * o;
        }
    float rs = 1.f;
    if (DA) { ss += __shfl_xor(ss, 32); rs = rsqrtf(ss * (1.f / 64.f) + 1e-6f) * post_scale; }
    bf16_t* yp = ycatb + ((size_t)b * NT + q0 + 32 * wid + r) * DM + ycat_off + h * 64;
#pragma unroll
    for (int d2 = 0; d2 < 2; ++d2)
#pragma unroll
        for (int g4 = 0; g4 < 4; ++g4) {
            const int dv = 32 * d2 + 8 * g4 + 4 * hh;
            float o0 = O[0][d2][4 * g4] * rs, o1 = O[0][d2][4 * g4 + 1] * rs, o2 = O[0][d2][4 * g4 + 2] * rs, o3 = O[0][d2][4 * g4 + 3] * rs;
            if (DA) { const float4 w = *(const float4*)(subln + dv); o0 *= w.x; o1 *= w.y; o2 *= w.z; o3 *= w.w; }
            *(uint2*)(yp + dv) = make_uint2(cvtpk(o0, o1), cvtpk(o2, o3));
        }
}

template <int QKD, int NMAP, bool DA>
__global__ __launch_bounds__(512, 2) void k_attn_mfma(const bf16_t* __restrict__ Qb, const bf16_t* __restrict__ Kb, const bf16_t* __restrict__ Vt, bf16_t* __restrict__ ycatb, int ycat_off,
                                                      const float* __restrict__ lamfull, const float* __restrict__ subln, float post_scale, int with_ctx) {
    int qblk = blockIdx.x, h = blockIdx.y, b = blockIdx.z;
    if (qblk == 0 && !with_ctx) return;
    attn_item<QKD, NMAP, DA>((LAS3 unsigned char*)dyn_lds, Qb, Kb, Vt, ycatb, ycat_off, b, h, qblk, DA ? lamfull[0] : 0.f, subln, post_scale);
}

__global__ __launch_bounds__(256) void k_da_prep2(const float* __restrict__ p, const float* __restrict__ cs, bf16_t* __restrict__ Qb, bf16_t* __restrict__ Kb, bf16_t* __restrict__ Vt, float qscale) {
    __shared__ bf16_t vs[256][72];
    int t0 = blockIdx.x * 64; int b = t0 / NT, n0 = t0 % NT;
    int c = threadIdx.x; int h = c >> 6, rr = c & 63, d = rr & 31;
    for (int i = 0; i < 64; ++i) {
        int n = n0 + i; const float* pr = p + (size_t)(t0 + i) * DIN;
        float qv = pr[P_DAQ + c], kv = pr[P_DAK + c];
        if (n >= NC) {
            int pos = n - NC; int j = d & 15;
            float co = cs[(pos * 16 + j) * 2], si = cs[(pos * 16 + j) * 2 + 1];
            int cp = (d < 16) ? c + 16 : c - 16;
            float qo = pr[P_DAQ + cp], ko = pr[P_DAK + cp];
            if (d < 16) { qv = qv * co - qo * si; kv = kv * co - ko * si; }
            else        { qv = qv * co + qo * si; kv = kv * co + ko * si; }
        }
        size_t o = (((size_t)b * 4 + h) * NT + n) * 64 + rr;
        Qb[o] = f2bf(qv * qscale); Kb[o] = f2bf(kv);
        vs[c][i] = f2bf(pr[P_DAV + c]);
    }
    __syncthreads();
    bf16_t* vp = Vt + (((size_t)b * 4 + h) * 64 + rr) * NT + n0;
#pragma unroll
    for (int q = 0; q < 8; ++q) *(uint4*)(vp + q * 8) = *(const uint4*)&vs[c][q * 8];
}
__global__ __launch_bounds__(256) void k_mla_layout2(const float* __restrict__ p, const float* __restrict__ qfull, const float* __restrict__ kvfull, const float* __restrict__ cs,
                                                     bf16_t* __restrict__ Qb, bf16_t* __restrict__ Kb, bf16_t* __restrict__ Vt, float qscale) {
    __shared__ bf16_t vs[256][72];
    int t0 = blockIdx.x * 64; int b = t0 / NT, n0 = t0 % NT;
    for (int i = 0; i < 64; ++i) {
        int n = n0 + i; size_t t = (size_t)t0 + i;
        const float* pr = p + t * DIN; const float* qf = qfull + t * 384; const float* kf = kvfull + t * 512;
        for (int idx = threadIdx.x; idx < 384; idx += 256) {
            int h = idx / 96, j = idx % 96;
            size_t o = (((size_t)b * 4 + h) * NT + n) * 96 + j;
            float qv, kv;
            if (j < 64) { qv = qf[h * 96 + j]; kv = kf[h * 128 + j]; }
            else {
                int d = j - 64;
                qv = qf[h * 96 + j]; kv = pr[P_KR + d];
                if (n >= NC) {
                    int pos = n - NC; int jj = d & 15;
                    float co = cs[(pos * 16 + jj) * 2], si = cs[(pos * 16 + jj) * 2 + 1];
                    int dp = (d < 16) ? d + 16 : d - 16;
                    float qo = qf[h * 96 + 64 + dp], ko = pr[P_KR + dp];
                    if (d < 16) { qv = qv * co - qo * si; kv = kv * co - ko * si; }
                    else        { qv = qv * co + qo * si; kv = kv * co + ko * si; }
                }
            }
            Qb[o] = f2bf(qv * qscale); Kb[o] = f2bf(kv);
        }
        { int c = threadIdx.x; int h = c >> 6, j = c & 63; vs[c][i] = f2bf(kf[h * 128 + 64 + j]); }
    }
    __syncthreads();
    { int c = threadIdx.x; int h = c >> 6, j = c & 63;
      bf16_t* vp = Vt + (((size_t)b * 4 + h) * 64 + j) * NT + n0;
#pragma unroll
      for (int q = 0; q < 8; ++q) *(uint4*)(vp + q * 8) = *(const uint4*)&vs[c][q * 8]; }
}


typedef float f32x4_t __attribute__((ext_vector_type(4)));
constexpr int ML_KROW = 72, ML_TROW = 136, ML_CROW = 72;
constexpr int ML_OFF_KC = 0, ML_OFF_KT = ML_OFF_KC + 128 * ML_KROW * 2, ML_OFF_VT = ML_OFF_KT + 64 * ML_TROW * 2, ML_OFF_CB = ML_OFF_VT + 80 * ML_TROW * 2,
              ML_OFF_F = ML_OFF_CB + 80 * ML_CROW * 2, ML_LDS_BYTES = ML_OFF_F + 6 * 128 * 4 + 64;
__device__ __forceinline__ void mlstm_item(LAS3 unsigned char* lds, const bf16_t* __restrict__ Qb, const bf16_t* __restrict__ Kb, const bf16_t* __restrict__ Ktg, const bf16_t* __restrict__ Vtg,
                                           const float* __restrict__ G, float* __restrict__ hdir, int b, int h, int dir) {
    const int tid = threadIdx.x, wid = tid >> 6, lane = tid & 63, lr = lane & 15, q = lane >> 4;
    LAS3 unsigned char* Kc = lds + ML_OFF_KC; LAS3 unsigned char* Kt = lds + ML_OFF_KT; LAS3 unsigned char* Vt = lds + ML_OFF_VT; LAS3 unsigned char* Cb = lds + ML_OFF_CB;
    LAS3 float* fl = (LAS3 float*)(lds + ML_OFF_F);
    LAS3 float* s_li = fl; LAS3 float* s_lf = fl + 128; LAS3 float* s_bc2 = fl + 256; LAS3 float* s_gk2 = fl + 384; LAS3 float* s_wu = fl + 512; LAS3 float* s_et = fl + 640; LAS3 float* s_misc = fl + 768;
    const size_t base = ((size_t)b * 4 + h) * NT;
    __syncthreads();
    for (int i = tid; i < 80 * ML_CROW / 2; i += 512) ((LAS3 unsigned*)Cb)[i] = 0u;
    for (int i = tid; i < 16 * ML_TROW / 2; i += 512) ((LAS3 unsigned*)(Vt + 64 * ML_TROW * 2))[i] = (i < ML_TROW / 2) ? 0x3F803F80u : 0u;
    const int ct = wid & 3, rt0 = (wid < 4) ? 0 : 3, nrt = (wid < 4) ? 3 : 2;
    f32x4_t Cacc[3];
#pragma unroll
    for (int i = 0; i < 3; ++i) Cacc[i] = (f32x4_t){0.f, 0.f, 0.f, 0.f};
    for (int c = 0; c < NT / 128; ++c) {
        int n0;
        if (dir == 0) n0 = 128 * c; else n0 = (c < 2) ? 128 * (1 - c) : NC + 128 * (17 - c);
        u32x4_t rkc[2], rkt[2], rvt[2];
#pragma unroll
        for (int i = 0; i < 2; ++i) {
            const int id = tid + 512 * i;
            rkc[i] = *(const u32x4_t*)(Kb + (base + n0 + (id >> 3)) * 64 + (id & 7) * 8);
            rkt[i] = *(const u32x4_t*)(Ktg + ((size_t)(b * 4 + h) * 64 + (id >> 4)) * NT + n0 + (id & 15) * 8);
            rvt[i] = *(const u32x4_t*)(Vtg + ((size_t)(b * 4 + h) * 64 + (id >> 4)) * NT + n0 + (id & 15) * 8);
        }
        const int tq = 16 * wid + lr;
        bf16x8_t qf[2];
#pragma unroll
        for (int ks = 0; ks < 2; ++ks) qf[ks] = *(const bf16x8_t*)(Qb + (base + n0 + tq) * 64 + 32 * ks + 8 * q);
        if (tid < 128) { const float* gp = G + ((size_t)b * NT + n0 + tid) * 16; s_li[tid] = gp[(dir * 2) * 4 + h]; s_lf[tid] = gp[(dir * 2 + 1) * 4 + h]; }
#pragma unroll
        for (int i = 0; i < 2; ++i) {
            const int id = tid + 512 * i;
            *(LAS3 u32x4_t*)(Kc + ((id >> 3) * ML_KROW + (id & 7) * 8) * 2) = rkc[i];
            *(LAS3 u32x4_t*)(Vt + ((id >> 4) * ML_TROW + (id & 15) * 8) * 2) = rvt[i];
        }
        __syncthreads();
        if (wid == 0) {
            const int ia = (dir == 0) ? 2 * lane : 127 - 2 * lane, ib = (dir == 0) ? 2 * lane + 1 : 126 - 2 * lane;
            const float xa = s_lf[ia], xb = s_lf[ib];
            float inc = xa + xb;
#pragma unroll
            for (int o = 1; o < 64; o <<= 1) { const float v = __shfl_up(inc, o); if (lane >= o) inc += v; }
            const float tot = __shfl(inc, 63);
            const float bca = inc - xb, bcb = inc;
            const float lia = s_li[ia], lib = s_li[ib];
            s_bc2[ia] = bca * 1.4426950408889634f; s_bc2[ib] = bcb * 1.4426950408889634f;
            s_gk2[ia] = (bca - lia) * 1.4426950408889634f; s_gk2[ib] = (bcb - lib) * 1.4426950408889634f;
            s_wu[ia] = __expf(tot - bca + lia); s_wu[ib] = __expf(tot - bcb + lib);
            s_et[ia] = __expf(bca); s_et[ib] = __expf(bcb);
            if (lane == 0) s_misc[0] = __expf(tot);
        }
        __syncthreads();
#pragma unroll
        for (int i = 0; i < 2; ++i) {
            const int id = tid + 512 * i; const int tk0 = (id & 15) * 8;
            unsigned w4[4] = {rkt[i].x, rkt[i].y, rkt[i].z, rkt[i].w}; u32x4_t o;
#pragma unroll
            for (int jj = 0; jj < 4; ++jj) {
                const float lo = __uint_as_float(w4[jj] << 16) * s_wu[tk0 + 2 * jj], hi = __uint_as_float(w4[jj] & 0xFFFF0000u) * s_wu[tk0 + 2 * jj + 1];
                o[jj] = cvtpk(lo, hi);
            }
            *(LAS3 u32x4_t*)(Kt + ((id >> 4) * ML_TROW + tk0) * 2) = o;
        }
        f32x4_t S[8];
#pragma unroll
        for (int kt = 0; kt < 8; ++kt) {
            S[kt] = (f32x4_t){0.f, 0.f, 0.f, 0.f};
#pragma unroll
            for (int ks = 0; ks < 2; ++ks) {
                const bf16x8_t a = *(const LAS3 bf16x8_t*)(Kc + ((16 * kt + lr) * ML_KROW + 32 * ks + 8 * q) * 2);
                S[kt] = __builtin_amdgcn_mfma_f32_16x16x32_bf16(a, qf[ks], S[kt], 0, 0, 0);
            }
        }
        const float bct = s_bc2[tq];
#pragma unroll
        for (int kt = 0; kt < 8; ++kt) {
            const f32x4_t gk = *(const LAS3 f32x4_t*)(s_gk2 + 16 * kt + 4 * q);
#pragma unroll
            for (int rg = 0; rg < 4; ++rg) {
                const int si = 16 * kt + 4 * q + rg;
                const bool valid = (dir == 0) ? (si <= tq) : (si >= tq);
                const float w = valid ? __builtin_amdgcn_exp2f(bct - gk[rg]) : 0.f;
                S[kt][rg] *= w;
            }
        }
        bf16x8_t pf[4];
#pragma unroll
        for (int k2 = 0; k2 < 4; ++k2) {
            union { unsigned u[4]; bf16x8_t v; } cv;
            cv.u[0] = cvtpk(S[2 * k2][0], S[2 * k2][1]); cv.u[1] = cvtpk(S[2 * k2][2], S[2 * k2][3]);
            cv.u[2] = cvtpk(S[2 * k2 + 1][0], S[2 * k2 + 1][1]); cv.u[3] = cvtpk(S[2 * k2 + 1][2], S[2 * k2 + 1][3]);
            pf[k2] = cv.v;
        }
        f32x4_t outv[5];
#pragma unroll
        for (int rt = 0; rt < 5; ++rt) {
            f32x4_t acc = (f32x4_t){0.f, 0.f, 0.f, 0.f}, acc2 = (f32x4_t){0.f, 0.f, 0.f, 0.f};
#pragma unroll
            for (int k2 = 0; k2 < 4; ++k2) {
                const LAS3 unsigned char* vp = Vt + ((16 * rt + lr) * ML_TROW + 32 * k2 + 4 * q) * 2;
                union { u32x2_t u[2]; bf16x8_t v; } av;
                av.u[0] = *(const LAS3 u32x2_t*)vp; av.u[1] = *(const LAS3 u32x2_t*)(vp + 32);
                acc = __builtin_amdgcn_mfma_f32_16x16x32_bf16(av.v, pf[k2], acc, 0, 0, 0);
            }
#pragma unroll
            for (int ks = 0; ks < 2; ++ks) {
                const bf16x8_t a = *(const LAS3 bf16x8_t*)(Cb + ((16 * rt + lr) * ML_CROW + 32 * ks + 8 * q) * 2);
                acc2 = __builtin_amdgcn_mfma_f32_16x16x32_bf16(a, qf[ks], acc2, 0, 0, 0);
            }
            outv[rt] = acc + acc2 * s_et[tq];
        }
        {
            const float den = __shfl(outv[4][0], lr);
            const float inv = 1.f / fmaxf(fabsf(den), 1.f);
            float* hp = hdir + ((size_t)dir * TT + (size_t)b * NT + n0 + tq) * 256 + h * 64 + 4 * q;
#pragma unroll
            for (int rt = 0; rt < 4; ++rt) *(f32x4_t*)(hp + 16 * rt) = outv[rt] * inv;
        }
        __syncthreads();
        {
            const float decay = s_misc[0];
#pragma unroll
            for (int i = 0; i < 3; ++i) Cacc[i] *= decay;
#pragma unroll
            for (int ks = 0; ks < 4; ++ks) {
                const bf16x8_t bb = *(const LAS3 bf16x8_t*)(Kt + ((16 * ct + lr) * ML_TROW + 32 * ks + 8 * q) * 2);
#pragma unroll
                for (int i = 0; i < 3; ++i) if (i < nrt) {
                    const bf16x8_t a = *(const LAS3 bf16x8_t*)(Vt + ((16 * (rt0 + i) + lr) * ML_TROW + 32 * ks + 8 * q) * 2);
                    Cacc[i] = __builtin_amdgcn_mfma_f32_16x16x32_bf16(a, bb, Cacc[i], 0, 0, 0);
                }
            }
#pragma unroll
            for (int i = 0; i < 3; ++i) if (i < nrt) {
#pragma unroll
                for (int rg = 0; rg < 4; ++rg) *(LAS3 bf16_t*)(Cb + ((16 * (rt0 + i) + 4 * q + rg) * ML_CROW + 16 * ct + lr) * 2) = f2bf(Cacc[i][rg]);
            }
        }
        __syncthreads();
    }
}
__global__ __launch_bounds__(512, 2) void k_mlstm_mfma(const bf16_t* __restrict__ Qb, const bf16_t* __restrict__ Kb, const bf16_t* __restrict__ Ktg, const bf16_t* __restrict__ Vtg,
                                                       const float* __restrict__ G, float* __restrict__ hdir) {
    mlstm_item((LAS3 unsigned char*)dyn_lds, Qb, Kb, Ktg, Vtg, G, hdir, blockIdx.y, blockIdx.x, blockIdx.z);
}
__global__ __launch_bounds__(256) void k_ml_prep2(const float* __restrict__ p, const float* __restrict__ conv_w, const float* __restrict__ conv_b, const float* __restrict__ gate_b,
                                                  bf16_t* __restrict__ Qb, bf16_t* __restrict__ Kb, bf16_t* __restrict__ Ktg, bf16_t* __restrict__ Vtg, float* __restrict__ G) {
    __shared__ bf16_t ts[256][72];
    int t0 = blockIdx.x * 64; int b = t0 / NT, n0 = t0 % NT;
    int c = threadIdx.x; int h = c >> 6, d = c & 63;
    const int seg_lo = (n0 < NC) ? 0 : NC, seg_hi = (n0 < NC) ? NC - 1 : NT - 1;
    const float wq0 = conv_w[c], wq1 = conv_w[512 + c], wq2 = conv_w[1024 + c], bq = conv_b[c];
    const float wk0 = conv_w[256 + c], wk1 = conv_w[512 + 256 + c], wk2 = conv_w[1024 + 256 + c], bk = conv_b[256 + c];
    for (int i = 0; i < 64; ++i) {
        int n = n0 + i; size_t t = (size_t)t0 + i;
        float yq = bq, yk = bk;
        if (n - 1 >= seg_lo) { yq += p[(t - 1) * DIN + P_MLQK + c] * wq0; yk += p[(t - 1) * DIN + P_MLQK + 256 + c] * wk0; }
        yq += p[t * DIN + P_MLQK + c] * wq1; yk += p[t * DIN + P_MLQK + 256 + c] * wk1;
        if (n + 1 <= seg_hi) { yq += p[(t + 1) * DIN + P_MLQK + c] * wq2; yk += p[(t + 1) * DIN + P_MLQK + 256 + c] * wk2; }
        yq = siluf_(yq); yk = siluf_(yk) * 0.125f;
        size_t o = (((size_t)b * 4 + h) * NT + n) * 64 + d;
        Qb[o] = f2bf(yq); const bf16_t kb = f2bf(yk); Kb[o] = kb; ts[c][i] = kb;
        if (c < 16) {
            float g = p[t * DIN + P_MLG + c] + gate_b[c];
            if ((c >> 2) & 1) g = logsigmoidf_(g);
            G[t * 16 + c] = g;
        }
    }
    __syncthreads();
    { bf16_t* kp = Ktg + (((size_t)b * 4 + h) * 64 + d) * NT + n0;
#pragma unroll
      for (int qq = 0; qq < 8; ++qq) *(uint4*)(kp + qq * 8) = *(const uint4*)&ts[c][qq * 8]; }
    __syncthreads();
    for (int i = 0; i < 64; ++i) ts[c][i] = f2bf(p[((size_t)t0 + i) * DIN + P_MLV + c]);
    __syncthreads();
    { bf16_t* vp = Vtg + (((size_t)b * 4 + h) * 64 + d) * NT + n0;
#pragma unroll
      for (int qq = 0; qq < 8; ++qq) *(uint4*)(vp + qq * 8) = *(const uint4*)&ts[c][qq * 8]; }
}

__global__ void k_build_x(const float* __restrict__ x, const float* __restrict__ ctx, float* __restrict__ xall) {
    size_t i = (size_t)blockIdx.x * 256 + threadIdx.x;
    size_t total = (size_t)TT * DM / 4;
    if (i >= total) return;
    size_t t = i / (DM / 4); int d4 = (int)(i % (DM / 4));
    int b = (int)(t / NT), n = (int)(t % NT);
    const float4* src = (n < NC) ? (const float4*)(ctx + ((size_t)b * NC + n) * DM) : (const float4*)(x + ((size_t)b * NS + (n - NC)) * DM);
    ((float4*)xall)[i] = src[d4];
}

__global__ __launch_bounds__(256) void k_mod(const float* __restrict__ c, const float* __restrict__ c_ctx, const float* __restrict__ w_mod,
                                             const float* __restrict__ b_mod, float* __restrict__ mod) {
    __shared__ float s[9][1024];
    for (int i = threadIdx.x; i < 9 * 1024; i += 256) {
        int r = i >> 10, k = i & 1023;
        float v = (r < 8) ? c[r * 1024 + k] : c_ctx[k];
        s[r][k] = siluf_(v);
    }
    __syncthreads();
    int gj = blockIdx.x * 256 + threadIdx.x;
    int l = gj / 6144, j = gj % 6144;
    const float* w = w_mod + (size_t)l * 1024 * 6144 + j;
    float acc[9];
#pragma unroll
    for (int r = 0; r < 9; ++r) acc[r] = 0.f;
    for (int k = 0; k < 1024; ++k) {
        float wv = w[(size_t)k * 6144];
#pragma unroll
        for (int r = 0; r < 9; ++r) acc[r] += s[r][k] * wv;
    }
    float bb = b_mod[l * 6144 + j];
#pragma unroll
    for (int r = 0; r < 9; ++r) mod[((size_t)l * 9 + r) * 6144 + j] = acc[r] + bb;
}

__global__ void k_rope_table(float* __restrict__ cs) {
    int i = blockIdx.x * 256 + threadIdx.x;
    if (i >= NS * 16) return;
    int pos = i >> 4, j = i & 15;
    int row = pos / 64, col = pos % 64;
    double inv = pow(10000.0, -(double)(j & 7) / 8.0);
    double ang = (double)((j < 8) ? row : col) * inv;
    cs[i * 2] = (float)cos(ang);
    cs[i * 2 + 1] = (float)sin(ang);
}

__global__ void k_lambda(const float* __restrict__ da_lambda, float* __restrict__ lamfull) {
    int l = threadIdx.x;
    if (l >= 2) return;
    const float* lam = da_lambda + l * 128;
    double s1 = 0, s2 = 0;
    for (int i = 0; i < 32; ++i) { s1 += (double)lam[i] * lam[32 + i]; s2 += (double)lam[64 + i] * lam[96 + i]; }
    double lambda_init = 0.8 - 0.6 * exp(-0.3 * l);
    lamfull[l] = (float)(exp(s1) - exp(s2) + lambda_init);
}

__global__ void k_s5_disc(const float* __restrict__ a_re, const float* __restrict__ a_im, const float* __restrict__ log_step,
                          const float* __restrict__ b_re, const float* __restrict__ b_im,
                          float* __restrict__ abr, float* __restrict__ abi, float* __restrict__ bbr, float* __restrict__ bbi) {
    int i = blockIdx.x * 256 + threadIdx.x;
    if (i >= 2 * 2 * 16 * 64) return;
    int ldg = i >> 6;
    double ar = fmin((double)a_re[i], -1e-4), ai = (double)a_im[i];
    double dt = exp((double)log_step[ldg]);
    double mag = exp(dt * ar);
    double er = mag * cos(dt * ai), ei = mag * sin(dt * ai);
    double inv = 1.0 / (ar * ar + ai * ai);
    double fr = ((er - 1.0) * ar + ei * ai) * inv;
    double fi = (ei * ar - (er - 1.0) * ai) * inv;
    abr[i] = (float)er; abi[i] = (float)ei;
    for (int h = 0; h < 16; ++h) {
        double br = b_re[(size_t)i * 16 + h], bi = b_im[(size_t)i * 16 + h];
        bbr[(size_t)i * 16 + h] = (float)(fr * br - fi * bi);
        bbi[(size_t)i * 16 + h] = (float)(fr * bi + fi * br);
    }
}

__global__ __launch_bounds__(256) void k_norm_mod(const float* __restrict__ xall, const float* __restrict__ nw, const float* __restrict__ modl  ,
                                                  int shift_off, int scale_off, bf16_t* __restrict__ out) {
    __shared__ float red[8];
    int t = blockIdx.x; int b = t / NT, n = t % NT; int r = (n < NC) ? 8 : b;
    const float4 xv = ((const float4*)(xall + (size_t)t * DM))[threadIdx.x];
    float ss = xv.x * xv.x + xv.y * xv.y + xv.z * xv.z + xv.w * xv.w;
    ss = block_sum_256(ss, red);
    float rstd = rsqrtf(ss * (1.f / DM) + 1e-6f);
    int d = threadIdx.x * 4;
    const float4 w = *(const float4*)(nw + d);
    const float4 sc = *(const float4*)(modl + (size_t)r * 6144 + scale_off + d);
    const float4 sh = *(const float4*)(modl + (size_t)r * 6144 + shift_off + d);
    float4 o;
    o.x = xv.x * rstd * w.x * (1.f + sc.x) + sh.x;
    o.y = xv.y * rstd * w.y * (1.f + sc.y) + sh.y;
    o.z = xv.z * rstd * w.z * (1.f + sc.z) + sh.z;
    o.w = xv.w * rstd * w.w * (1.f + sc.w) + sh.w;
    uint2 ob; ob.x = pk2bf(o.x, o.y); ob.y = pk2bf(o.z, o.w);
    *(uint2*)(out + (size_t)t * DM + d) = ob;
}

struct GemmArgs {
    const float* A; const float* B; float* C; const float* bias;
    int M, N, K, lda, ldb, ldc;
    const int* gather;
    const int* tile_e;
    const int* tile_m0;
    const int* grp_end;
    const int* ntiles;
    long strideB, strideBias;
};

template <int MODE>
__global__ __launch_bounds__(256) void k_gemm(GemmArgs g) {
    __shared__ float As[16][68];
    __shared__ float Bs[16][64];
    __shared__ float Bs2[MODE == 1 ? 16 : 1][64];
    const float* B = g.B; const float* bias = g.bias;
    int m0, mend;
    if (g.tile_e) {
        int ty = blockIdx.y;
        if (ty >= g.ntiles[0]) return;
        int e = g.tile_e[ty];
        m0 = g.tile_m0[ty]; mend = g.grp_end[e];
        B += (size_t)e * g.strideB; if (bias) bias += (size_t)e * g.strideBias;
    } else { m0 = blockIdx.y * 64; mend = g.M; if (m0 >= mend) return; }
    int n0 = blockIdx.x * 64;
    int tx = threadIdx.x & 15, ty_ = threadIdx.x >> 4;
    float acc[4][4], acc2[4][4];
#pragma unroll
    for (int i = 0; i < 4; ++i)
#pragma unroll
        for (int j = 0; j < 4; ++j) { acc[i][j] = 0.f; acc2[i][j] = 0.f; }
    int ar = threadIdx.x >> 2, ak = (threadIdx.x & 3) * 4;
    int arow_slot = m0 + ar; bool avalid = arow_slot < mend;
    long arow = avalid ? (g.gather ? (long)g.gather[arow_slot] : (long)arow_slot) : 0;
    const float* Ap = g.A + arow * g.lda + ak;
    int bk = threadIdx.x >> 4, bn = (threadIdx.x & 15) * 4;
    for (int k0 = 0; k0 < g.K; k0 += 16) {
        float4 av = avalid ? *(const float4*)(Ap + k0) : make_float4(0.f, 0.f, 0.f, 0.f);
        As[ak + 0][ar] = av.x; As[ak + 1][ar] = av.y; As[ak + 2][ar] = av.z; As[ak + 3][ar] = av.w;
        const float* Bp = B + (size_t)(k0 + bk) * g.ldb + n0 + bn;
#pragma unroll
        for (int q = 0; q < 4; ++q) Bs[bk][bn + q] = (n0 + bn + q < g.N) ? Bp[q] : 0.f;
        if (MODE == 1) {
#pragma unroll
            for (int q = 0; q < 4; ++q) Bs2[bk][bn + q] = (n0 + bn + q < g.N) ? Bp[g.N + q] : 0.f;
        }
        __syncthreads();
#pragma unroll
        for (int kk = 0; kk < 16; ++kk) {
            float a[4], b[4];
#pragma unroll
            for (int i = 0; i < 4; ++i) a[i] = As[kk][ty_ * 4 + i];
#pragma unroll
            for (int j = 0; j < 4; ++j) b[j] = Bs[kk][tx * 4 + j];
#pragma unroll
            for (int i = 0; i < 4; ++i)
#pragma unroll
                for (int j = 0; j < 4; ++j) acc[i][j] += a[i] * b[j];
            if (MODE == 1) {
                float b2[4];
#pragma unroll
                for (int j = 0; j < 4; ++j) b2[j] = Bs2[kk][tx * 4 + j];
#pragma unroll
                for (int i = 0; i < 4; ++i)
#pragma unroll
                    for (int j = 0; j < 4; ++j) acc2[i][j] += a[i] * b2[j];
            }
        }
        __syncthreads();
    }
#pragma unroll
    for (int i = 0; i < 4; ++i) {
        int slot = m0 + ty_ * 4 + i;
        if (slot >= mend) continue;
#pragma unroll
        for (int j = 0; j < 4; ++j) {
            int n = n0 + tx * 4 + j;
            if (n >= g.N) continue;
            float v = acc[i][j] + (bias ? bias[n] : 0.f);
            if (MODE == 1) {
                float up = acc2[i][j] + (bias ? bias[g.N + n] : 0.f);
                float gate = fminf(v, 7.f);
                up = fminf(fmaxf(up, -7.f), 7.f);
                v = (up + 1.f) * gate * sigmoidf_(1.702f * gate);
            }
            g.C[(size_t)slot * g.ldc + n] = v;
        }
    }
}

__global__ __launch_bounds__(256) void k_da_prep(const float* __restrict__ p, const float* __restrict__ cs, float* __restrict__ Q, float* __restrict__ K, float* __restrict__ V) {
    int t = blockIdx.x; int b = t / NT, n = t % NT;
    int c = threadIdx.x;
    int h = c >> 6, r = c & 63, d = r & 31;
    const float* pr = p + (size_t)t * DIN;
    size_t o = (((size_t)b * 4 + h) * NT + n) * 64 + r;
    float qv = pr[P_DAQ + c], kv = pr[P_DAK + c];
    if (n >= NC) {
        int pos = n - NC; int j = d & 15;
        float co = cs[(pos * 16 + j) * 2], si = cs[(pos * 16 + j) * 2 + 1];
        int cp = (d < 16) ? c + 16 : c - 16;
        float qo = pr[P_DAQ + cp], ko = pr[P_DAK + cp];
        if (d < 16) { qv = qv * co - qo * si; kv = kv * co - ko * si; }
        else        { qv = qv * co + qo * si; kv = kv * co + ko * si; }
    }
    Q[o] = qv; K[o] = kv; V[o] = pr[P_DAV + c];
}

template <int QKD, int NMAP, int DV, bool DA>
__global__ __launch_bounds__(64) void k_attn(const float* __restrict__ Q, const float* __restrict__ K, const float* __restrict__ V,
                                             float* __restrict__ ycat, int ycat_off, const float* __restrict__ lamfull,
                                             const float* __restrict__ subln, float post_scale, float scale, int with_ctx) {
    constexpr int DK = QKD / NMAP;
    __shared__ float Ks[32][QKD];
    __shared__ float Vs[32][DV];
    int qb = blockIdx.x, h = blockIdx.y, b = blockIdx.z;
    bool isctx = qb < (NC / 64);
    if (isctx && !with_ctx) return;
    int nkeys = isctx ? NC : NT;
    int n = qb * 64 + threadIdx.x;
    size_t base = ((size_t)b * 4 + h) * NT;
    float q[QKD];
    const float* qp = Q + (base + n) * QKD;
#pragma unroll
    for (int d = 0; d < QKD; d += 4) { float4 v = *(const float4*)(qp + d); q[d] = v.x * scale; q[d + 1] = v.y * scale; q[d + 2] = v.z * scale; q[d + 3] = v.w * scale; }
    float acc[NMAP][DV]; float mx[NMAP], l[NMAP];
#pragma unroll
    for (int m = 0; m < NMAP; ++m) { mx[m] = -1e30f; l[m] = 0.f;
#pragma unroll
        for (int d = 0; d < DV; ++d) acc[m][d] = 0.f; }
    for (int k0 = 0; k0 < nkeys; k0 += 32) {
        __syncthreads();
        for (int i = threadIdx.x; i < 32 * QKD / 4; i += 64) {
            int kr = i / (QKD / 4), kc = (i % (QKD / 4)) * 4;
            *(float4*)&Ks[kr][kc] = *(const float4*)(K + (base + k0 + kr) * QKD + kc);
        }
        for (int i = threadIdx.x; i < 32 * DV / 4; i += 64) {
            int kr = i / (DV / 4), kc = (i % (DV / 4)) * 4;
            *(float4*)&Vs[kr][kc] = *(const float4*)(V + (base + k0 + kr) * DV + kc);
        }
        __syncthreads();
        for (int j = 0; j < 32; ++j) {
#pragma unroll
            for (int m = 0; m < NMAP; ++m) {
                float s = 0.f;
#pragma unroll
                for (int d = 0; d < DK; ++d) s += q[m * DK + d] * Ks[j][m * DK + d];
                float mn = fmaxf(mx[m], s);
                float alpha = __expf(mx[m] - mn);
                float pv = __expf(s - mn);
                mx[m] = mn;
                l[m] = l[m] * alpha + pv;
#pragma unroll
                for (int d = 0; d < DV; ++d) acc[m][d] = acc[m][d] * alpha + pv * Vs[j][d];
            }
        }
    }
    float o[DV];
    float c1 = 1.f;
#pragma unroll
    for (int d = 0; d < DV; ++d) o[d] = acc[0][d] / l[0];
    if (NMAP == 2) {
        c1 = -lamfull[0];
#pragma unroll
        for (int d = 0; d < DV; ++d) o[d] += c1 * acc[NMAP - 1][d] / l[NMAP - 1];
    }
    if (DA) {
        float ss = 0.f;
#pragma unroll
        for (int d = 0; d < DV; ++d) ss += o[d] * o[d];
        float rstd = rsqrtf(ss * (1.f / DV) + 1e-6f) * post_scale;
#pragma unroll
        for (int d = 0; d < DV; ++d) o[d] = o[d] * rstd * subln[d];
    }
    float* yp = ycat + ((size_t)b * NT + n) * DM + ycat_off + h * DV;
#pragma unroll
    for (int d = 0; d < DV; d += 4) *(float4*)(yp + d) = make_float4(o[d], o[d + 1], o[d + 2], o[d + 3]);
}

__global__ __launch_bounds__(64) void k_mla_norm(const float* __restrict__ p, const float* __restrict__ qn, const float* __restrict__ kvn,
                                                 float* __restrict__ cqn, float* __restrict__ ckvn) {
    int t = blockIdx.x; int lane = threadIdx.x;
    const float* pr = p + (size_t)t * DIN;
    float v0 = pr[P_CQ + lane], v1 = pr[P_CQ + 64 + lane], v2 = pr[P_CQ + 128 + lane];
    float ss = v0 * v0 + v1 * v1 + v2 * v2;
    for (int o = 32; o > 0; o >>= 1) ss += __shfl_xor(ss, o);
    float r = rsqrtf(ss * (1.f / 192.f) + 1e-6f);
    cqn[(size_t)t * 192 + lane] = v0 * r * qn[lane];
    cqn[(size_t)t * 192 + 64 + lane] = v1 * r * qn[64 + lane];
    cqn[(size_t)t * 192 + 128 + lane] = v2 * r * qn[128 + lane];
    float w0 = pr[P_CKV + lane], w1 = pr[P_CKV + 64 + lane];
    float s2 = w0 * w0 + w1 * w1;
    for (int o = 32; o > 0; o >>= 1) s2 += __shfl_xor(s2, o);
    float r2 = rsqrtf(s2 * (1.f / 128.f) + 1e-6f);
    ckvn[(size_t)t * 128 + lane] = w0 * r2 * kvn[lane];
    ckvn[(size_t)t * 128 + 64 + lane] = w1 * r2 * kvn[64 + lane];
}

__global__ __launch_bounds__(128) void k_mla_layout(const float* __restrict__ p, const float* __restrict__ qfull  , const float* __restrict__ kvfull  ,
                                                    const float* __restrict__ cs, float* __restrict__ Q, float* __restrict__ K, float* __restrict__ V) {
    int t = blockIdx.x; int b = t / NT, n = t % NT;
    const float* pr = p + (size_t)t * DIN;
    const float* qf = qfull + (size_t)t * 384;
    const float* kf = kvfull + (size_t)t * 512;
    for (int i = threadIdx.x; i < 4 * 96; i += 128) {
        int h = i / 96, j = i % 96;
        size_t o = (((size_t)b * 4 + h) * NT + n) * 96 + j;
        float qv, kv;
        if (j < 64) { qv = qf[h * 96 + j]; kv = kf[h * 128 + j]; }
        else {
            int d = j - 64;
            qv = qf[h * 96 + j]; kv = pr[P_KR + d];
            if (n >= NC) {
                int pos = n - NC; int jj = d & 15;
                float co = cs[(pos * 16 + jj) * 2], si = cs[(pos * 16 + jj) * 2 + 1];
                int dp = (d < 16) ? d + 16 : d - 16;
                float qo = qf[h * 96 + 64 + dp], ko = pr[P_KR + dp];
                if (d < 16) { qv = qv * co - qo * si; kv = kv * co - ko * si; }
                else        { qv = qv * co + qo * si; kv = kv * co + ko * si; }
            }
        }
        Q[o] = qv; K[o] = kv;
    }
    for (int i = threadIdx.x; i < 4 * 64; i += 128) {
        int h = i / 64, j = i % 64;
        V[(((size_t)b * 4 + h) * NT + n) * 64 + j] = kf[h * 128 + 64 + j];
    }
}

__global__ __launch_bounds__(256) void k_ml_prep(const float* __restrict__ p, const float* __restrict__ conv_w  , const float* __restrict__ conv_b,
                                                 const float* __restrict__ gate_b, float* __restrict__ qk  , float* __restrict__ G  ) {
    int t = blockIdx.x; int n = t % NT;
    int seg_lo = (n < NC) ? 0 : NC, seg_hi = (n < NC) ? NC - 1 : NT - 1;
    for (int c = threadIdx.x; c < 512; c += 256) {
        float y = conv_b[c];
#pragma unroll
        for (int j = 0; j < 3; ++j) {
            int nn = n + j - 1;
            if (nn >= seg_lo && nn <= seg_hi) y += p[(size_t)(t + j - 1) * DIN + P_MLQK + c] * conv_w[j * 512 + c];
        }
        y = siluf_(y);
        if (c >= 256) y *= 0.125f;
        qk[(size_t)t * 512 + c] = y;
    }
    if (threadIdx.x < 16) {
        int gi = threadIdx.x >> 2;
        float g = p[(size_t)t * DIN + P_MLG + threadIdx.x] + gate_b[threadIdx.x];
        if (gi & 1) g = logsigmoidf_(g);
        G[(size_t)t * 16 + threadIdx.x] = g;
    }
}

__device__ __forceinline__ int seq_token(int s, int dir) {
    if (dir == 0) return s;
    return (s < NC) ? (NC - 1 - s) : (NC + (NT - 1 - s));
}

__global__ __launch_bounds__(256) void k_mlstm(const float* __restrict__ qk, const float* __restrict__ p, const float* __restrict__ G, float* __restrict__ hdir  ) {
    __shared__ float sq[64][64], sk[64][64], sv[64][64], sa[64], sf[64];
    int h = blockIdx.x, b = blockIdx.y, dir = blockIdx.z;
    int tid = threadIdx.x, vrow = tid >> 2, part = tid & 3;
    float C[16], nn[16];
#pragma unroll
    for (int i = 0; i < 16; ++i) { C[i] = 0.f; nn[i] = 0.f; }
    for (int s0 = 0; s0 < NT; s0 += 64) {
        __syncthreads();
        for (int i = tid; i < 64 * 64; i += 256) {
            int j = i >> 6, d = i & 63;
            int n = seq_token(s0 + j, dir);
            size_t t = (size_t)b * NT + n;
            sq[j][d] = qk[t * 512 + h * 64 + d];
            sk[j][d] = qk[t * 512 + 256 + h * 64 + d];
            sv[j][d] = p[t * DIN + P_MLV + h * 64 + d];
        }
        if (tid < 64) {
            int n = seq_token(s0 + tid, dir);
            size_t t = (size_t)b * NT + n;
            sa[tid] = __expf(G[t * 16 + (dir * 2) * 4 + h]);
            sf[tid] = __expf(G[t * 16 + (dir * 2 + 1) * 4 + h]);
        }
        __syncthreads();
        for (int j = 0; j < 64; ++j) {
            float a = sa[j], f = sf[j], vv = sv[j][vrow];
            float av = a * vv;
            float num = 0.f, den = 0.f;
#pragma unroll
            for (int i = 0; i < 16; ++i) {
                float kk = sk[j][part * 16 + i], qq = sq[j][part * 16 + i];
                C[i] = f * C[i] + av * kk;
                nn[i] = f * nn[i] + a * kk;
                num += C[i] * qq; den += nn[i] * qq;
            }
            num += __shfl_xor(num, 1); num += __shfl_xor(num, 2);
            den += __shfl_xor(den, 1); den += __shfl_xor(den, 2);
            if (part == 0) {
                int n = seq_token(s0 + j, dir);
                hdir[((size_t)dir * TT + (size_t)b * NT + n) * 256 + h * 64 + vrow] = num / fmaxf(fabsf(den), 1.f);
            }
        }
    }
}

__global__ __launch_bounds__(256) void k_ml_finish(const float* __restrict__ p, const float* __restrict__ hdir, const float* __restrict__ ml_norm, bf16_t* __restrict__ ycat) {
    int t = blockIdx.x; int c = threadIdx.x;
    float o = p[(size_t)t * DIN + P_MLO + c];
    float hv = sigmoidf_(o) * (hdir[(size_t)t * 256 + c] + hdir[((size_t)TT + t) * 256 + c]);
    float ss = hv * hv;
    for (int off = 32; off > 0; off >>= 1) ss += __shfl_xor(ss, off);
    float r = rsqrtf(ss * (1.f / 64.f) + 1e-6f);
    ycat[(size_t)t * DM + 256 + c] = f2bf(hv * r * ml_norm[c]);
}

__global__ __launch_bounds__(64) void k_s5_scan(const float* __restrict__ p, const float* __restrict__ abr, const float* __restrict__ abi,
                                                const float* __restrict__ bbr, const float* __restrict__ bbi,
                                                const float* __restrict__ c_re, const float* __restrict__ c_im, float* __restrict__ ys5  ) {
    __shared__ float su[64][16];
    __shared__ float xs[64][129];
    __shared__ float cr[16][64], ci[16][64];
    int g = blockIdx.x, b = blockIdx.y, dir = blockIdx.z;
    int lane = threadIdx.x;
    int sidx = (dir * 16 + g) * 64 + lane;
    float ar = abr[sidx], ai = abi[sidx];
    float br[16], bi[16];
#pragma unroll
    for (int h = 0; h < 16; ++h) { br[h] = bbr[(size_t)sidx * 16 + h]; bi[h] = bbi[(size_t)sidx * 16 + h]; }
    for (int i = lane; i < 16 * 64; i += 64) { cr[i >> 6][i & 63] = c_re[(size_t)(dir * 16 + g) * 1024 + i]; ci[i >> 6][i & 63] = c_im[(size_t)(dir * 16 + g) * 1024 + i]; }
    float xr = 0.f, xi = 0.f;
    for (int s0 = 0; s0 < NT; s0 += 64) {
        __syncthreads();
        for (int i = lane; i < 64 * 16; i += 64) {
            int j = i >> 4, hh = i & 15;
            int n = seq_token(s0 + j, dir);
            su[j][hh] = p[((size_t)b * NT + n) * DIN + P_S5 + g * 16 + hh];
        }
        __syncthreads();
#pragma unroll 1
        for (int j = 0; j < 64; ++j) {
            float ur = 0.f, ui = 0.f;
#pragma unroll
            for (int hh = 0; hh < 16; ++hh) { float u = su[j][hh]; ur += br[hh] * u; ui += bi[hh] * u; }
            float nr = ar * xr - ai * xi + ur;
            float ni = ar * xi + ai * xr + ui;
            xr = nr; xi = ni;
            xs[j][lane] = xr; xs[j][64 + lane] = xi;
        }
        __syncthreads();
        {
            int n = seq_token(s0 + lane, dir);
            float* yp = ys5 + ((size_t)dir * TT + (size_t)b * NT + n) * 256 + g * 16;
#pragma unroll 1
            for (int hh = 0; hh < 16; ++hh) {
                float y = 0.f;
#pragma unroll 4
                for (int pp = 0; pp < 64; ++pp) y += cr[hh][pp] * xs[lane][pp] - ci[hh][pp] * xs[lane][64 + pp];
                yp[hh] = y;
            }
        }
    }
}

__device__ __forceinline__ float gelu_tanh_(float x) {
    float u = 0.7978845608028654f * (x + 0.044715f * x * x * x);
    return 0.5f * x * (1.f + tanhf(u));
}
__global__ __launch_bounds__(256) void k_s5_gelu(const float* __restrict__ p, const float* __restrict__ ys5, const float* __restrict__ dsk, float* __restrict__ gl  ) {
    int t = blockIdx.x, c = threadIdx.x;
    float y = ys5[(size_t)t * 256 + c] + ys5[((size_t)TT + t) * 256 + c] + p[(size_t)t * DIN + P_S5 + c] * dsk[c];
    gl[(size_t)t * 256 + c] = gelu_tanh_(y);
}
__global__ __launch_bounds__(256) void k_s5_glu(const float* __restrict__ gl, const float* __restrict__ z, bf16_t* __restrict__ ycat) {
    int t = blockIdx.x, c = threadIdx.x;
    ycat[(size_t)t * DM + 768 + c] = f2bf(gl[(size_t)t * 256 + c] * sigmoidf_(z[(size_t)t * 256 + c]));
}

__global__ __launch_bounds__(256) void k_post1(float* __restrict__ xall, const float* __restrict__ o, const float* __restrict__ nw1, const float* __restrict__ nw2,
                                               const float* __restrict__ modl, const float* __restrict__ w_router  , const float* __restrict__ b_router,
                                               float* __restrict__ f, int* __restrict__ top_e  , float* __restrict__ top_g  , int* __restrict__ cnt,
                                               int* __restrict__ pos  , int with_ctx) {
    __shared__ float red[8];
    __shared__ float lg[4][32];
    int t = blockIdx.x; int b = t / NT, n = t % NT;
    if (n < NC && !with_ctx) return;
    int r = (n < NC) ? 8 : b;
    const float* mr = modl + (size_t)r * 6144;
    int d = threadIdx.x * 4;
    float4 ov = *(const float4*)(o + (size_t)t * DM + d);
    float ss = ov.x * ov.x + ov.y * ov.y + ov.z * ov.z + ov.w * ov.w;
    ss = block_sum_256(ss, red);
    float rstd = rsqrtf(ss * (1.f / DM) + 1e-6f);
    float4 xv = *(const float4*)(xall + (size_t)t * DM + d);
    float4 w1 = *(const float4*)(nw1 + d);
    float4 g1 = *(const float4*)(mr + 2048 + d);
    xv.x += g1.x * ov.x * rstd * w1.x; xv.y += g1.y * ov.y * rstd * w1.y; xv.z += g1.z * ov.z * rstd * w1.z; xv.w += g1.w * ov.w * rstd * w1.w;
    *(float4*)(xall + (size_t)t * DM + d) = xv;
    float s2 = xv.x * xv.x + xv.y * xv.y + xv.z * xv.z + xv.w * xv.w;
    s2 = block_sum_256(s2, red);
    float rstd2 = rsqrtf(s2 * (1.f / DM) + 1e-6f);
    float4 w2 = *(const float4*)(nw2 + d);
    float4 sh = *(const float4*)(mr + 3072 + d);
    float4 sc = *(const float4*)(mr + 4096 + d);
    float fv[4];
    fv[0] = xv.x * rstd2 * w2.x * (1.f + sc.x) + sh.x;
    fv[1] = xv.y * rstd2 * w2.y * (1.f + sc.y) + sh.y;
    fv[2] = xv.z * rstd2 * w2.z * (1.f + sc.z) + sh.z;
    fv[3] = xv.w * rstd2 * w2.w * (1.f + sc.w) + sh.w;
    *(float4*)(f + (size_t)t * DM + d) = make_float4(fv[0], fv[1], fv[2], fv[3]);
    float part[32];
#pragma unroll
    for (int e = 0; e < 32; ++e) part[e] = 0.f;
#pragma unroll
    for (int q = 0; q < 4; ++q) {
        const float* wr = w_router + (size_t)(d + q) * 32;
#pragma unroll
        for (int e = 0; e < 32; ++e) part[e] += fv[q] * wr[e];
    }
#pragma unroll
    for (int e = 0; e < 32; ++e) {
        float v = part[e];
        for (int off = 32; off > 0; off >>= 1) v += __shfl_xor(v, off);
        part[e] = v;
    }
    __syncthreads();
    if ((threadIdx.x & 63) == 0) {
#pragma unroll
        for (int e = 0; e < 32; ++e) lg[threadIdx.x >> 6][e] = part[e];
    }
    __syncthreads();
    if (threadIdx.x < 32) lg[0][threadIdx.x] = lg[0][threadIdx.x] + lg[1][threadIdx.x] + lg[2][threadIdx.x] + lg[3][threadIdx.x] + b_router[threadIdx.x];
    __syncthreads();
    if (threadIdx.x == 0) {
        unsigned used = 0;
        int s0 = 0, s1 = 0, s2_ = 0, s3 = 0; float v0 = 0.f, v1 = 0.f, v2 = 0.f, v3 = 0.f;
        for (int k = 0; k < 4; ++k) {
            int best = 0; float bv = -3.4e38f;
            for (int e = 0; e < 32; ++e) { float lv = lg[0][e]; if (!((used >> e) & 1u) && lv > bv) { bv = lv; best = e; } }
            used |= 1u << best;
            if (k == 0) { s0 = best; v0 = bv; } else if (k == 1) { s1 = best; v1 = bv; } else if (k == 2) { s2_ = best; v2 = bv; } else { s3 = best; v3 = bv; }
        }
        float e0 = 1.f, e1 = __expf(v1 - v0), e2 = __expf(v2 - v0), e3 = __expf(v3 - v0);
        float inv = 1.f / (e0 + e1 + e2 + e3);
        top_e[(size_t)t * 4 + 0] = s0; top_e[(size_t)t * 4 + 1] = s1; top_e[(size_t)t * 4 + 2] = s2_; top_e[(size_t)t * 4 + 3] = s3;
        top_g[(size_t)t * 4 + 0] = e0 * inv; top_g[(size_t)t * 4 + 1] = e1 * inv; top_g[(size_t)t * 4 + 2] = e2 * inv; top_g[(size_t)t * 4 + 3] = e3 * inv;
        pos[(size_t)t * 4 + 0] = atomicAdd(&cnt[s0], 1); pos[(size_t)t * 4 + 1] = atomicAdd(&cnt[s1], 1);
        pos[(size_t)t * 4 + 2] = atomicAdd(&cnt[s2_], 1); pos[(size_t)t * 4 + 3] = atomicAdd(&cnt[s3], 1);
    }
}

__global__ void k_moe_offsets(const int* __restrict__ cnt, int* __restrict__ off, int* __restrict__ tile_e, int* __restrict__ ntiles) {
    if (threadIdx.x != 0) return;
    int o = 0, nt = 0;
    for (int e = 0; e < NE; ++e) {
        off[e] = o; int c = cnt[e];
        for (int m = 0; m < c; m += 256) { tile_e[nt] = e; ++nt; }
        o = nt * 256;
    }
    ntiles[0] = nt;
}
__global__ void k_moe_scatter(const int* __restrict__ top_e, const int* __restrict__ pos, const int* __restrict__ off, int* __restrict__ slot_token, int* __restrict__ tok_slot, int with_ctx) {
    int i = blockIdx.x * 256 + threadIdx.x;
    if (i >= NASSIGN) return;
    int t = i >> 2; int n = t % NT;
    if (n < NC && !with_ctx) return;
    int slot = off[top_e[i]] + pos[i];
    slot_token[slot] = t; tok_slot[i] = slot;
}

__global__ __launch_bounds__(256) void k_combine(float* __restrict__ xall, const float* __restrict__ yexp, const int* __restrict__ tok_slot, const float* __restrict__ top_g,
                                                 const float* __restrict__ nw3, const float* __restrict__ modl, int with_ctx) {
    __shared__ float red[8];
    int t = blockIdx.x; int b = t / NT, n = t % NT;
    if (n < NC && !with_ctx) return;
    int r = (n < NC) ? 8 : b;
    int d = threadIdx.x * 4;
    float4 m = make_float4(0.f, 0.f, 0.f, 0.f);
#pragma unroll
    for (int k = 0; k < 4; ++k) {
        int slot = tok_slot[(size_t)t * 4 + k]; float gk = top_g[(size_t)t * 4 + k];
        float4 y = *(const float4*)(yexp + (size_t)slot * DM + d);
        m.x += gk * y.x; m.y += gk * y.y; m.z += gk * y.z; m.w += gk * y.w;
    }
    float ss = m.x * m.x + m.y * m.y + m.z * m.z + m.w * m.w;
    ss = block_sum_256(ss, red);
    float rstd = rsqrtf(ss * (1.f / DM) + 1e-6f);
    float4 w3 = *(const float4*)(nw3 + d);
    float4 g2 = *(const float4*)(modl + (size_t)r * 6144 + 5120 + d);
    float4 xv = *(const float4*)(xall + (size_t)t * DM + d);
    xv.x += g2.x * m.x * rstd * w3.x; xv.y += g2.y * m.y * rstd * w3.y; xv.z += g2.z * m.z * rstd * w3.z; xv.w += g2.w * m.w * rstd * w3.w;
    *(float4*)(xall + (size_t)t * DM + d) = xv;
}

__global__ void k_out(const float* __restrict__ xall, float* __restrict__ out) {
    size_t i = (size_t)blockIdx.x * 256 + threadIdx.x;
    size_t total = (size_t)NB * NS * DM / 4;
    if (i >= total) return;
    size_t t = i / (DM / 4); int d4 = (int)(i % (DM / 4));
    int b = (int)(t / NS), n = (int)(t % NS);
    ((float4*)out)[i] = ((const float4*)(xall + ((size_t)b * NT + NC + n) * DM))[d4];
}

static void launch_gemm(hipStream_t st, const float* A, int lda, const float* B, int ldb, float* C, int ldc, const float* bias, int M, int N, int K) {
    GemmArgs g{}; g.A = A; g.B = B; g.C = C; g.bias = bias; g.M = M; g.N = N; g.K = K; g.lda = lda; g.ldb = ldb; g.ldc = ldc;
    dim3 grid((N + 63) / 64, (M + 63) / 64);
    k_gemm<0><<<grid, 256, 0, st>>>(g);
}

extern "C" void kernel_launch(void* const* d_in, const int* in_sizes, int n_in, void* d_out, int out_size, void* d_ws, size_t ws_size, hipStream_t stream) {
    const float* x = (const float*)d_in[0]; const float* c = (const float*)d_in[1]; const float* ctx = (const float*)d_in[2]; const float* c_ctx = (const float*)d_in[3];
    const float* w_mod = (const float*)d_in[4]; const float* b_mod = (const float*)d_in[5]; const float* norm_w = (const float*)d_in[6];
    const float* w_in = (const float*)d_in[7]; const float* w_out = (const float*)d_in[8]; const float* da_lambda = (const float*)d_in[9]; const float* da_subln = (const float*)d_in[10];
    const float* ml_conv_w = (const float*)d_in[11]; const float* ml_conv_b = (const float*)d_in[12]; const float* ml_gate_b = (const float*)d_in[13]; const float* ml_norm = (const float*)d_in[14];
    const float* mla_q_norm = (const float*)d_in[15]; const float* mla_w_uq = (const float*)d_in[16]; const float* mla_kv_norm = (const float*)d_in[17]; const float* mla_w_ukv = (const float*)d_in[18];
    const float* s5_a_re = (const float*)d_in[19]; const float* s5_a_im = (const float*)d_in[20]; const float* s5_log_step = (const float*)d_in[21];
    const float* s5_b_re = (const float*)d_in[22]; const float* s5_b_im = (const float*)d_in[23]; const float* s5_c_re = (const float*)d_in[24]; const float* s5_c_im = (const float*)d_in[25];
    const float* s5_d = (const float*)d_in[26]; const float* s5_w_glu = (const float*)d_in[27]; const float* s5_b_glu = (const float*)d_in[28];
    const float* moe_w_router = (const float*)d_in[29]; const float* moe_b_router = (const float*)d_in[30]; const float* moe_w_gate_up = (const float*)d_in[31];
    const float* moe_b_gate_up = (const float*)d_in[32]; const float* moe_w_down = (const float*)d_in[33]; const float* moe_b_down = (const float*)d_in[34];
    float* out = (float*)d_out;

    char* ws = (char*)d_ws; size_t off = 0;
    auto carve = [&](size_t bytes) { void* p = ws + off; off += (bytes + 255) & ~(size_t)255; return p; };
    float* xall = (float*)carve((size_t)TT * DM * 4);
    float* mod = (float*)carve((size_t)2 * 9 * 6144 * 4);
    float* ropecs = (float*)carve((size_t)NS * 16 * 2 * 4);
    float* lamfull = (float*)carve(256);
    float* abr = (float*)carve(4096 * 4); float* abi = (float*)carve(4096 * 4);
    float* bbr = (float*)carve(4096 * 16 * 4); float* bbi = (float*)carve(4096 * 16 * 4);
    bf16_t* w_in_t = (bf16_t*)carve((size_t)2 * 2560 * 1024 * 2);
    bf16_t* w_out_t = (bf16_t*)carve((size_t)2 * 1024 * 1024 * 2);
    bf16_t* wgu_t = (bf16_t*)carve((size_t)2 * NE * 2048 * 1024 * 2);
    bf16_t* wdn_t = (bf16_t*)carve((size_t)2 * NE * 1024 * 1024 * 2);
    bf16_t* hbuf = (bf16_t*)carve((size_t)TT * DM * 2);
    bf16_t* ycatb = (bf16_t*)carve((size_t)TT * DM * 2);
    float* obuf = (float*)carve((size_t)TT * DM * 4);
    float* fbuf = (float*)carve((size_t)TT * DM * 4);
    int* top_e = (int*)carve((size_t)NASSIGN * 4); float* top_g = (float*)carve((size_t)NASSIGN * 4); int* posb = (int*)carve((size_t)NASSIGN * 4);
    int* tok_slot = (int*)carve((size_t)NASSIGN * 4); int* slot_token = (int*)carve((size_t)MAXSLOTS * 4);
    int* cnt = (int*)carve(256); int* offs = (int*)carve(256); int* ntiles = (int*)carve(256);
    int* tile_e = (int*)carve(512 * 4);
    bf16_t* act = (bf16_t*)carve((size_t)MAXSLOTS * DM * 2);
    size_t zone0 = off;
    float* p = (float*)carve((size_t)TT * DIN * 4);
    bf16_t* daQ = (bf16_t*)carve((size_t)TT * 256 * 2); bf16_t* daK = (bf16_t*)carve((size_t)TT * 256 * 2); bf16_t* daV = (bf16_t*)carve((size_t)TT * 256 * 2);
    float* cqn = (float*)carve((size_t)TT * 192 * 4); float* ckvn = (float*)carve((size_t)TT * 128 * 4);
    float* qfull = (float*)carve((size_t)TT * 384 * 4); float* kvfull = (float*)carve((size_t)TT * 512 * 4);
    bf16_t* mQ = (bf16_t*)carve((size_t)TT * 384 * 2); bf16_t* mK = (bf16_t*)carve((size_t)TT * 384 * 2); bf16_t* mV = (bf16_t*)carve((size_t)TT * 256 * 2);
    bf16_t* mlQ = (bf16_t*)carve((size_t)TT * 256 * 2); bf16_t* mlK = (bf16_t*)carve((size_t)TT * 256 * 2); bf16_t* mlKt = (bf16_t*)carve((size_t)TT * 256 * 2); bf16_t* mlVt = (bf16_t*)carve((size_t)TT * 256 * 2);
    float* mlG = (float*)carve((size_t)TT * 16 * 4); float* hdir = (float*)carve((size_t)2 * TT * 256 * 4);
    float* ys5 = (float*)carve((size_t)2 * TT * 256 * 4); float* gl = (float*)carve((size_t)TT * 256 * 4); float* zglu = (float*)carve((size_t)TT * 256 * 4);
    size_t zone1 = off;
    float* yexp = (float*)(ws + zone0);
    bf16_t* xg = (bf16_t*)(ws + zone0 + (size_t)MAXSLOTS * DM * 4);
    if (zone0 + (size_t)MAXSLOTS * DM * 6 > zone1) off = zone0 + (size_t)MAXSLOTS * DM * 6;
    if (off > ws_size) { fprintf(stderr, "workspace too small: need %zu have %zu\n", off, ws_size); return; }

    static bool attr_done = false;
    if (!attr_done) {
        (void)hipFuncSetAttribute((const void*)k_pg8_static<pg8::EpiF32>, hipFuncAttributeMaxDynamicSharedMemorySize, pg8::STAGE_BYTES);
        (void)hipFuncSetAttribute((const void*)k_pg8_grouped<pg8::EpiSwiglu>, hipFuncAttributeMaxDynamicSharedMemorySize, pg8::STAGE_BYTES);
        (void)hipFuncSetAttribute((const void*)k_pg8_grouped<pg8::EpiDown>, hipFuncAttributeMaxDynamicSharedMemorySize, pg8::STAGE_BYTES);
        (void)hipFuncSetAttribute((const void*)k_mlstm_mfma, hipFuncAttributeMaxDynamicSharedMemorySize, ML_LDS_BYTES);
        attr_done = true;
    }

    k_build_x<<<(TT * DM / 4 + 255) / 256, 256, 0, stream>>>(x, ctx, xall);
    k_mod<<<2 * 6144 / 256, 256, 0, stream>>>(c, c_ctx, w_mod, b_mod, mod);
    k_rope_table<<<NS * 16 / 256, 256, 0, stream>>>(ropecs);
    k_lambda<<<1, 64, 0, stream>>>(da_lambda, lamfull);
    k_s5_disc<<<4096 / 256, 256, 0, stream>>>(s5_a_re, s5_a_im, s5_log_step, s5_b_re, s5_b_im, abr, abi, bbr, bbi);
    (void)hipMemsetAsync(w_in_t, 0, (size_t)2 * 2560 * 1024 * 2, stream);
    k_convT<0><<<dim3((DINC + 63) / 64, 16, 2), 256, 0, stream>>>(w_in, 1024, DINC, w_in_t, 1024, 0, 0, (long)1024 * DINC, (long)2560 * 1024);
    k_convT<0><<<dim3(16, 16, 2), 256, 0, stream>>>(w_out, 1024, 1024, w_out_t, 1024, 0, 0, (long)1024 * 1024, (long)1024 * 1024);
    k_convT<1><<<dim3(32, 16, 2 * NE), 256, 0, stream>>>(moe_w_gate_up, 1024, 2048, wgu_t, 1024, 0, 0, (long)1024 * 2048, (long)2048 * 1024);
    k_convT<0><<<dim3(16, 16, 2 * NE), 256, 0, stream>>>(moe_w_down, 1024, 1024, wdn_t, 1024, 0, 0, (long)1024 * 1024, (long)1024 * 1024);

    for (int l = 0; l < 2; ++l) {
        int with_ctx = (l == 0);
        float lambda_init = (float)(0.8 - 0.6 * exp(-0.3 * l));
        const float* modl = mod + (size_t)l * 9 * 6144;
        const float* nw = norm_w + (size_t)l * 4 * 1024;
        k_norm_mod<<<TT, 256, 0, stream>>>(xall, nw, modl, 0, 1024, hbuf);
        {
            pg8::Gemm g{hbuf, w_in_t + (size_t)l * 2560 * 1024, TT, 2560, 1024, 0};
            pg8::EpiF32 E{p, nullptr, DIN, 0};
            k_pg8_static<pg8::EpiF32><<<256, 512, pg8::STAGE_BYTES, stream>>>(g, E);
        }
        k_da_prep2<<<TT / 64, 256, 0, stream>>>(p, ropecs, daQ, daK, daV, 0.17677669529663687f * 1.4426950408889634f);
        k_attn_mfma<64, 2, true><<<dim3(9, 4, NB), 512, ATT_LDS_BYTES, stream>>>(daQ, daK, daV, ycatb, 0, lamfull + l, da_subln + l * 64, 1.f - lambda_init, with_ctx);
        k_mla_norm<<<TT, 64, 0, stream>>>(p, mla_q_norm + l * 192, mla_kv_norm + l * 128, cqn, ckvn);
        launch_gemm(stream, cqn, 192, mla_w_uq + (size_t)l * 192 * 384, 384, qfull, 384, nullptr, TT, 384, 192);
        launch_gemm(stream, ckvn, 128, mla_w_ukv + (size_t)l * 128 * 512, 512, kvfull, 512, nullptr, TT, 512, 128);
        k_mla_layout2<<<TT / 64, 256, 0, stream>>>(p, qfull, kvfull, ropecs, mQ, mK, mV, 0.10206207261596575f * 1.4426950408889634f);
        k_attn_mfma<96, 1, false><<<dim3(9, 4, NB), 512, ATT_LDS_BYTES, stream>>>(mQ, mK, mV, ycatb, 512, lamfull, nullptr, 1.f, with_ctx);
        k_ml_prep2<<<TT / 64, 256, 0, stream>>>(p, ml_conv_w + l * 3 * 512, ml_conv_b + l * 512, ml_gate_b + l * 16, mlQ, mlK, mlKt, mlVt, mlG);
        k_mlstm_mfma<<<dim3(4, NB, 2), 512, ML_LDS_BYTES, stream>>>(mlQ, mlK, mlKt, mlVt, mlG, hdir);
        k_ml_finish<<<TT, 256, 0, stream>>>(p, hdir, ml_norm + l * 256, ycatb);
        k_s5_scan<<<dim3(16, NB, 2), 64, 0, stream>>>(p, abr + l * 2048, abi + l * 2048, bbr + (size_t)l * 2048 * 16, bbi + (size_t)l * 2048 * 16,
                                                      s5_c_re + (size_t)l * 2 * 16 * 1024, s5_c_im + (size_t)l * 2 * 16 * 1024, ys5);
        k_s5_gelu<<<TT, 256, 0, stream>>>(p, ys5, s5_d + l * 256, gl);
        launch_gemm(stream, gl, 256, s5_w_glu + (size_t)l * 256 * 256, 256, zglu, 256, s5_b_glu + l * 256, TT, 256, 256);
        k_s5_glu<<<TT, 256, 0, stream>>>(gl, zglu, ycatb);
        {
            pg8::Gemm g{ycatb, w_out_t + (size_t)l * 1024 * 1024, TT, 1024, 1024, 0};
            pg8::EpiF32 E{obuf, nullptr, DM, 0};
            k_pg8_static<pg8::EpiF32><<<256, 512, pg8::STAGE_BYTES, stream>>>(g, E);
        }
        (void)hipMemsetAsync(cnt, 0, 128, stream);
        (void)hipMemsetAsync(slot_token, 0xFF, (size_t)MAXSLOTS * 4, stream);
        k_post1<<<TT, 256, 0, stream>>>(xall, obuf, nw + 1024, nw + 2048, modl, moe_w_router + (size_t)l * 1024 * 32, moe_b_router + l * 32, fbuf, top_e, top_g, cnt, posb, with_ctx);
        k_moe_offsets<<<1, 64, 0, stream>>>(cnt, offs, tile_e, ntiles);
        k_moe_scatter<<<NASSIGN / 256, 256, 0, stream>>>(top_e, posb, offs, slot_token, tok_slot, with_ctx);
        k_moe_gather<<<MAXSLOTS, 256, 0, stream>>>(fbuf, slot_token, ntiles, xg);
        {
            pg8::Gemm g{xg, wgu_t + (size_t)l * NE * 2048 * 1024, 0, 2048, 1024, 0};
            pg8::EpiSwiglu E{act, moe_b_gate_up + (size_t)l * NE * 2048};
            k_pg8_grouped<pg8::EpiSwiglu><<<256, 512, pg8::STAGE_BYTES, stream>>>(g, E, ntiles, tile_e);
        }
        {
            pg8::Gemm g{act, wdn_t + (size_t)l * NE * 1024 * 1024, 0, 1024, 1024, 0};
            pg8::EpiDown E{yexp, moe_b_down + (size_t)l * NE * 1024};
            k_pg8_grouped<pg8::EpiDown><<<256, 512, pg8::STAGE_BYTES, stream>>>(g, E, ntiles, tile_e);
        }
        k_combine<<<TT, 256, 0, stream>>>(xall, yexp, tok_slot, top_g, nw + 3072, modl, with_ctx);
    }
    k_out<<<(NB * NS * DM / 4 + 255) / 256, 256, 0, stream>>>(xall, out);
}
```

```cpp
#include <hip/hip_runtime.h>
#include <cstdint>
#include <cstdio>

#define NB 8
#define NS 2048
#define NC 256
#define NT 2304
#define TT (NB * NT)
#define DM 1024
#define DIN 2560
#define DINC 2416
#define NE 32
#define NASSIGN (TT * 4)
#define MAXSLOTS (NASSIGN + NE * 256)

#define P_DAQ 0
#define P_DAK 256
#define P_DAV 512
#define P_MLQK 768
#define P_MLV 1280
#define P_MLO 1536
#define P_MLG 1792
#define P_CQ 1808
#define P_CKV 2000
#define P_KR 2128
#define P_S5 2160

__device__ __forceinline__ float sigmoidf_(float x) { return 1.f / (1.f + __expf(-x)); }
__device__ __forceinline__ float siluf_(float x) { return x / (1.f + __expf(-x)); }
__device__ __forceinline__ float logsigmoidf_(float x) { return fminf(x, 0.f) - log1pf(__expf(-fabsf(x))); }

__device__ __forceinline__ float block_sum_256(float v, float* red) {
    for (int o = 32; o > 0; o >>= 1) v += __shfl_xor(v, o);
    __syncthreads();
    if ((threadIdx.x & 63) == 0) red[threadIdx.x >> 6] = v;
    __syncthreads();
    float r = red[0] + red[1] + red[2] + red[3];
    return r;
}


typedef unsigned short bf16_t;
__device__ __forceinline__ bf16_t f2bf(float f) { unsigned u = __float_as_uint(f); u += 0x7FFFu + ((u >> 16) & 1u); return (bf16_t)(u >> 16); }
__device__ __forceinline__ float bf2f(bf16_t b) { return __uint_as_float(((unsigned)b) << 16); }
__device__ __forceinline__ unsigned pk2bf(float lo, float hi) { return (unsigned)f2bf(lo) | ((unsigned)f2bf(hi) << 16); }

namespace pg8 {
#define PG8_LAS __attribute__((address_space(3)))
typedef short bf16x8 __attribute__((ext_vector_type(8)));
typedef float f32x4 __attribute__((ext_vector_type(4)));
typedef unsigned u32x4 __attribute__((ext_vector_type(4)));
constexpr int BM = 256, BK = 64, HALF = 128, HTB = HALF * BK * 2, STAGE_BYTES = 8 * HTB, NXCD = 8, WGM = 8;
__host__ __device__ __forceinline__ int lds_byte(int r, int c) { const int st = (r >> 4) * 2 + (c >> 5), rr = r & 15, cc = c & 31, ob = rr * 64 + cc * 2; return st * 1024 + (ob ^ (((ob >> 9) & 1) << 5)); }
__host__ __device__ __forceinline__ void stage_rc(int b, int& R, int& C) { const int st = b / 1024, sb = b % 1024, swz = sb ^ (((sb >> 9) & 1) << 5); R = (st >> 1) * 16 + swz / 64; C = (st & 1) * 32 + (swz % 64) / 2; }
__host__ __device__ __forceinline__ int perm32(int rho) { const int n = rho >> 4, i = rho & 15; return 8 * (i >> 2) + 4 * n + (i & 3); }
struct Unit { int pm, pn; };
struct Gemm { const bf16_t* A; const bf16_t* Bt; int M, N, K, pad; };
__device__ __forceinline__ unsigned cvt_pk_bf16(float lo, float hi) { unsigned r; asm volatile("v_cvt_pk_bf16_f32 %0, %1, %2" : "=v"(r) : "v"(lo), "v"(hi)); return r; }

struct StaticOrder {
    int nM, nN, nwg, G, c;
    __device__ void init(int M, int N, int G_, int c_) { nM = M / BM; nN = N / BM; nwg = nM * nN; G = G_; c = c_; }
    __device__ bool next(int i, Unit& u) const {
        const long L = (long)i * G + c; if (L >= nwg) return false;
        int wgid = (int)L; { const int q = nwg / NXCD, r = nwg % NXCD, xcd = wgid % NXCD, off = wgid / NXCD; wgid = (xcd < r ? xcd * (q + 1) : r * (q + 1) + (xcd - r) * q) + off; }
        const int nig = WGM * nN, gid = wgid / nig, fm = gid * WGM, gsz = (nM - fm) < WGM ? (nM - fm) : WGM;
        u.pm = fm + ((wgid % nig) % gsz); u.pn = (wgid % nig) / gsz; return true;
    }
    __device__ __forceinline__ void a_ready(const Unit&) const {}
    __device__ __forceinline__ void done(const Unit&) const {}
};
struct GroupedOrder : StaticOrder {
    const int* tile_e;
    __device__ void initg(const int* ntiles_p, const int* tile_e_, int N, int G_, int c_) { nM = ntiles_p[0]; nN = N / BM; nwg = nM * nN; G = G_; c = c_; tile_e = tile_e_; }
    __device__ bool next(int i, Unit& u) const { if (!StaticOrder::next(i, u)) return false; u.pn += tile_e[u.pm] * nN; return true; }
};

struct EpiF32 {
    static constexpr bool PERM = false;
    float* C; const float* bias; int ldc, pad;
    __device__ __forceinline__ void operator()(const f32x4 (&acc)[2][2][4][2], const Unit& u, int wr, int wc, int fr, int fq) const {
        const int row0 = u.pm * BM + wr * 64 + fr, col0 = u.pn * BM + wc * 32 + 4 * fq;
        f32x4 bv[2][2];
#pragma unroll
        for (int bj = 0; bj < 2; ++bj)
#pragma unroll
            for (int n = 0; n < 2; ++n) bv[bj][n] = bias ? *(const f32x4*)(bias + col0 + bj * HALF + n * 16) : (f32x4){0.f, 0.f, 0.f, 0.f};
#pragma unroll
        for (int ai = 0; ai < 2; ++ai)
#pragma unroll
            for (int m = 0; m < 4; ++m) { float* rowp = C + (size_t)(row0 + ai * HALF + m * 16) * ldc + col0;
#pragma unroll
                for (int bj = 0; bj < 2; ++bj)
#pragma unroll
                    for (int n = 0; n < 2; ++n) *(f32x4*)(rowp + bj * HALF + n * 16) = acc[ai][bj][m][n] + bv[bj][n]; }
    }
};
struct EpiDown {
    static constexpr bool PERM = false;
    float* C; const float* bias;
    __device__ __forceinline__ void operator()(const f32x4 (&acc)[2][2][4][2], const Unit& u, int wr, int wc, int fr, int fq) const {
        const int e = u.pn >> 2, pnl = u.pn & 3;
        const int row0 = u.pm * BM + wr * 64 + fr, col0 = pnl * BM + wc * 32 + 4 * fq;
        const float* bp = bias + (size_t)e * 1024;
        f32x4 bv[2][2];
#pragma unroll
        for (int bj = 0; bj < 2; ++bj)
#pragma unroll
            for (int n = 0; n < 2; ++n) bv[bj][n] = *(const f32x4*)(bp + col0 + bj * HALF + n * 16);
#pragma unroll
        for (int ai = 0; ai < 2; ++ai)
#pragma unroll
            for (int m = 0; m < 4; ++m) { float* rowp = C + (size_t)(row0 + ai * HALF + m * 16) * 1024 + col0;
#pragma unroll
                for (int bj = 0; bj < 2; ++bj)
#pragma unroll
                    for (int n = 0; n < 2; ++n) *(f32x4*)(rowp + bj * HALF + n * 16) = acc[ai][bj][m][n] + bv[bj][n]; }
    }
};
struct EpiSwiglu {
    static constexpr bool PERM = true;
    bf16_t* O; const float* bias;
    __device__ __forceinline__ void operator()(const f32x4 (&acc)[2][2][4][2], const Unit& u, int wr, int wc, int fr, int fq) const {
        const int e = u.pn >> 3, pnl = u.pn & 7;
        const int row0 = u.pm * BM + wr * 64 + fr, col0 = pnl * HALF + wc * 32 + 8 * fq;
        const float* bp = bias + (size_t)e * 2048 + col0;
        f32x4 bg[2], bu[2];
#pragma unroll
        for (int n = 0; n < 2; ++n) { bg[n] = *(const f32x4*)(bp + 4 * n); bu[n] = *(const f32x4*)(bp + 1024 + 4 * n); }
#pragma unroll
        for (int ai = 0; ai < 2; ++ai)
#pragma unroll
            for (int m = 0; m < 4; ++m) {
                bf16_t* rowp = O + (size_t)(row0 + ai * HALF + m * 16) * 1024 + col0;
                float r[8];
#pragma unroll
                for (int n = 0; n < 2; ++n) {
                    f32x4 g = acc[ai][0][m][n] + bg[n], up = acc[ai][1][m][n] + bu[n];
#pragma unroll
                    for (int j = 0; j < 4; ++j) {
                        float gt = fminf(g[j], 7.f), uu = fminf(fmaxf(up[j], -7.f), 7.f);
                        r[n * 4 + j] = (uu + 1.f) * gt / (1.f + __expf(-1.702f * gt));
                    }
                }
                u32x4 w; w.x = cvt_pk_bf16(r[0], r[1]); w.y = cvt_pk_bf16(r[2], r[3]); w.z = cvt_pk_bf16(r[4], r[5]); w.w = cvt_pk_bf16(r[6], r[7]);
                *(u32x4*)rowp = w;
            }
    }
};

template <class Epi, class Sched>
__device__ __forceinline__ void gemm_phase(PG8_LAS unsigned char* lds, const Gemm g, const Sched& S, const Epi& E) {
    const int tid = threadIdx.x, wid = __builtin_amdgcn_readfirstlane(tid >> 6), lane = tid & 63, wr = wid >> 2, wc = wid & 3, fr = lane & 15, fq = lane >> 4;
    const int K = g.K, nt = K / BK;
    unsigned voffA[2], voffB[2];
#pragma unroll
    for (int i = 0; i < 2; ++i) { int R, C; stage_rc(tid * 16 + i * 8192, R, C); const int Rb = Epi::PERM ? ((R & ~31) + perm32(R & 31)) : R;
        voffA[i] = (unsigned)(R * K + C) * 2u; voffB[i] = (unsigned)(Rb * K + C) * 2u; }
    const size_t kstep = (size_t)(BK * 2);
    const size_t hstep = (size_t)HALF * K * 2;
    const size_t tstep = 2 * hstep;
    const unsigned ldsw = (unsigned)wid * 1024u;
    const int aoff = lds_byte(wr * 64 + fr, fq * 8), boff = lds_byte(wc * 32 + fr, fq * 8);
#define PG8_SA(b, h) (((b) * 2 + (h)) * HTB)
#define PG8_SB(b, h) ((4 + (b) * 2 + (h)) * HTB)
#define PG8_STAGE(bufoff, gbase, voff) do { _Pragma("unroll") for (int _i = 0; _i < 2; ++_i) \
        __builtin_amdgcn_global_load_lds((const unsigned*)((const char*)(gbase) + (voff)[_i]), (PG8_LAS unsigned*)(lds + (bufoff) + ldsw + _i * 8192), 16, 0, 0); } while (0)
#define PG8_LDA(dst, b, h) do { _Pragma("unroll") for (int m = 0; m < 4; ++m) _Pragma("unroll") for (int k = 0; k < 2; ++k) dst[m][k] = *(const PG8_LAS bf16x8*)(lds + PG8_SA(b, h) + aoff + m * 2048 + k * 1024); } while (0)
#define PG8_LDB(dst, b, h) do { _Pragma("unroll") for (int n = 0; n < 2; ++n) _Pragma("unroll") for (int k = 0; k < 2; ++k) dst[n][k] = *(const PG8_LAS bf16x8*)(lds + PG8_SB(b, h) + boff + n * 2048 + k * 1024); } while (0)
#define PG8_MMA(ai, bj, At, Bt) do { __builtin_amdgcn_s_setprio(1); _Pragma("unroll") for (int m = 0; m < 4; ++m) _Pragma("unroll") for (int n = 0; n < 2; ++n) _Pragma("unroll") for (int k = 0; k < 2; ++k) \
        acc[ai][bj][m][n] = __builtin_amdgcn_mfma_f32_16x16x32_bf16(Bt[n][k], At[m][k], acc[ai][bj][m][n], 0, 0, 0); __builtin_amdgcn_s_setprio(0); } while (0)
#define PG8_WAIT_V(n) asm volatile("s_waitcnt vmcnt(" #n ")" ::: "memory")
#define PG8_WAIT_L(n) asm volatile("s_waitcnt lgkmcnt(" #n ")" ::: "memory")
#define PG8_BAR __builtin_amdgcn_s_barrier()
#define PG8_SCHED __builtin_amdgcn_sched_barrier(0)
    Unit cur, nxt; int ui = 0;
    if (!S.next(0, cur)) return;
    f32x4 acc[2][2][4][2];
#pragma unroll
    for (int a = 0; a < 2; ++a)
#pragma unroll
        for (int b = 0; b < 2; ++b)
#pragma unroll
            for (int m = 0; m < 4; ++m)
#pragma unroll
                for (int n = 0; n < 2; ++n) acc[a][b][m][n] = (f32x4){0.f, 0.f, 0.f, 0.f};
    bf16x8 At[4][2], B0[2][2], B1[2][2];
    const char* cA = (const char*)g.A + (size_t)cur.pm * tstep; const char* cB = (const char*)g.Bt + (size_t)cur.pn * tstep;
    S.a_ready(cur);
    PG8_STAGE(PG8_SB(0, 0), cB, voffB); PG8_STAGE(PG8_SA(0, 0), cA, voffA); PG8_STAGE(PG8_SB(0, 1), cB + hstep, voffB); PG8_STAGE(PG8_SA(0, 1), cA + hstep, voffA);
    if (wr == 1) PG8_BAR;
    PG8_WAIT_V(4); PG8_BAR;
    PG8_STAGE(PG8_SB(1, 0), cB + kstep, voffB); PG8_STAGE(PG8_SA(1, 0), cA + kstep, voffA); PG8_STAGE(PG8_SB(1, 1), cB + hstep + kstep, voffB);
    PG8_WAIT_V(6); PG8_BAR;
    for (;;) {
        const bool has_next = S.next(ui + 1, nxt);
        const char* nA = has_next ? (const char*)g.A + (size_t)nxt.pm * tstep : cA; const char* nB = has_next ? (const char*)g.Bt + (size_t)nxt.pn * tstep : cB;
        for (int t = 0; t < nt; t += 2) {
            const bool last = (t == nt - 2);
            const char* a1 = cA + (size_t)(t + 1) * kstep;
            const char* a2 = last ? nA : cA + (size_t)(t + 2) * kstep; const char* b2 = last ? nB : cB + (size_t)(t + 2) * kstep;
            const char* a3 = a2 + kstep; const char* b3 = b2 + kstep;
            if (last && has_next) S.a_ready(nxt);
            PG8_LDB(B0, 0, 0); PG8_SCHED; PG8_LDA(At, 0, 0); PG8_STAGE(PG8_SA(1, 1), a1 + hstep, voffA);
            PG8_WAIT_L(8); PG8_BAR; PG8_WAIT_L(0); PG8_MMA(0, 0, At, B0); PG8_BAR; PG8_SCHED;
            PG8_LDB(B1, 0, 1); PG8_STAGE(PG8_SB(0, 0), b2, voffB);
            PG8_BAR; PG8_WAIT_L(0); PG8_MMA(0, 1, At, B1); PG8_BAR;
            PG8_LDA(At, 0, 1); PG8_STAGE(PG8_SA(0, 0), a2, voffA);
            PG8_BAR; PG8_WAIT_L(0); PG8_MMA(1, 0, At, B0); PG8_BAR; PG8_SCHED;
            PG8_STAGE(PG8_SB(0, 1), b2 + hstep, voffB);
            PG8_WAIT_V(6); PG8_BAR; PG8_MMA(1, 1, At, B1); PG8_BAR;
            PG8_LDB(B0, 1, 0); PG8_SCHED; PG8_LDA(At, 1, 0); PG8_STAGE(PG8_SA(0, 1), a2 + hstep, voffA);
            PG8_WAIT_L(8); PG8_BAR; PG8_WAIT_L(0); PG8_MMA(0, 0, At, B0); PG8_BAR; PG8_SCHED;
            PG8_LDB(B1, 1, 1); PG8_STAGE(PG8_SB(1, 0), b3, voffB);
            PG8_BAR; PG8_WAIT_L(0); PG8_MMA(0, 1, At, B1); PG8_BAR;
            PG8_LDA(At, 1, 1); PG8_STAGE(PG8_SA(1, 0), a3, voffA);
            PG8_BAR; PG8_WAIT_L(0); PG8_MMA(1, 0, At, B0); PG8_BAR; PG8_SCHED;
            PG8_STAGE(PG8_SB(1, 1), b3 + hstep, voffB);
            PG8_WAIT_V(6); PG8_BAR; PG8_MMA(1, 1, At, B1); PG8_BAR;
        }
        E(acc, cur, wr, wc, fr, fq); S.done(cur);
        if (!has_next) break;
#pragma unroll
        for (int a = 0; a < 2; ++a)
#pragma unroll
            for (int b = 0; b < 2; ++b)
#pragma unroll
                for (int m = 0; m < 4; ++m)
#pragma unroll
                    for (int n = 0; n < 2; ++n) acc[a][b][m][n] = (f32x4){0.f, 0.f, 0.f, 0.f};
        cur = nxt; cA = nA; cB = nB; ++ui;
    }
    PG8_WAIT_V(0);
    if (wr == 0) PG8_BAR;
    PG8_BAR;
#undef PG8_SA
#undef PG8_SB
#undef PG8_STAGE
#undef PG8_LDA
#undef PG8_LDB
#undef PG8_MMA
#undef PG8_WAIT_V
#undef PG8_WAIT_L
#undef PG8_BAR
#undef PG8_SCHED
}
}

extern __shared__ __attribute__((aligned(16))) unsigned char dyn_lds[];
template <class Epi>
__global__ __launch_bounds__(512, 2) void k_pg8_static(pg8::Gemm g, Epi E) {
    pg8::StaticOrder S; S.init(g.M, g.N, gridDim.x, blockIdx.x);
    pg8::gemm_phase<Epi, pg8::StaticOrder>((PG8_LAS unsigned char*)dyn_lds, g, S, E);
}
template <class Epi>
__global__ __launch_bounds__(512, 2) void k_pg8_grouped(pg8::Gemm g, Epi E, const int* ntiles, const int* tile_e) {
    pg8::GroupedOrder S; S.initg(ntiles, tile_e, g.N, gridDim.x, blockIdx.x);
    pg8::gemm_phase<Epi, pg8::GroupedOrder>((PG8_LAS unsigned char*)dyn_lds, g, S, E);
}

template <int MODE>
__global__ __launch_bounds__(256) void k_convT(const float* __restrict__ W, int K, int N, bf16_t* __restrict__ WT, int ldt, int roff, int koff, long strideW, long strideT) {
    __shared__ float tile[64][65];
    W += (size_t)blockIdx.z * strideW; WT += (size_t)blockIdx.z * strideT;
    int n0 = blockIdx.x * 64, k0 = blockIdx.y * 64;
    int tn = threadIdx.x & 63, tk = threadIdx.x >> 6;
#pragma unroll
    for (int i = 0; i < 16; ++i) { int k = i * 4 + tk; tile[k][tn] = (n0 + tn < N) ? W[(size_t)(k0 + k) * N + n0 + tn] : 0.f; }
    __syncthreads();
    int n = threadIdx.x >> 2, kc = (threadIdx.x & 3) * 16;
    if (n0 + n >= N) return;
    int gn = n0 + n; int dr;
    if (MODE == 0) dr = gn; else { dr = (gn < 1024) ? ((gn >> 7) * 256 + (gn & 127)) : ((((gn - 1024) >> 7) * 256) + 128 + ((gn - 1024) & 127)); }
    uint4 o0, o1;
    o0.x = pk2bf(tile[kc + 0][n], tile[kc + 1][n]); o0.y = pk2bf(tile[kc + 2][n], tile[kc + 3][n]); o0.z = pk2bf(tile[kc + 4][n], tile[kc + 5][n]); o0.w = pk2bf(tile[kc + 6][n], tile[kc + 7][n]);
    o1.x = pk2bf(tile[kc + 8][n], tile[kc + 9][n]); o1.y = pk2bf(tile[kc + 10][n], tile[kc + 11][n]); o1.z = pk2bf(tile[kc + 12][n], tile[kc + 13][n]); o1.w = pk2bf(tile[kc + 14][n], tile[kc + 15][n]);
    bf16_t* dp = WT + (size_t)(roff + dr) * ldt + koff + k0 + kc;
    *(uint4*)dp = o0; *(uint4*)(dp + 8) = o1;
}

__global__ __launch_bounds__(256) void k_to_bf16_rows(const float* __restrict__ src, bf16_t* __restrict__ dst) {
    size_t t = blockIdx.x; int d = threadIdx.x * 4;
    float4 v = *(const float4*)(src + t * DM + d);
    uint2 o; o.x = pk2bf(v.x, v.y); o.y = pk2bf(v.z, v.w);
    *(uint2*)(dst + t * DM + d) = o;
}
__global__ __launch_bounds__(256) void k_moe_gather(const float* __restrict__ f, const int* __restrict__ slot_token, const int* __restrict__ ntiles, bf16_t* __restrict__ xg) {
    int slot = blockIdx.x;
    if (slot >= ntiles[0] * 256) return;
    int t = slot_token[slot]; int d = threadIdx.x * 4;
    uint2 o = make_uint2(0u, 0u);
    if (t >= 0) { float4 v = *(const float4*)(f + (size_t)t * DM + d); o.x = pk2bf(v.x, v.y); o.y = pk2bf(v.z, v.w); }
    *(uint2*)(xg + (size_t)slot * DM + d) = o;
}


typedef short bf16x8_t __attribute__((ext_vector_type(8)));
typedef float f32x16_t __attribute__((ext_vector_type(16)));
typedef unsigned u32x4_t __attribute__((ext_vector_type(4)));
typedef unsigned u32x2_t __attribute__((ext_vector_type(2)));
#define LAS3 __attribute__((address_space(3)))
__device__ __forceinline__ unsigned cvtpk(float lo, float hi) { unsigned r; asm volatile("v_cvt_pk_bf16_f32 %0, %1, %2" : "=v"(r) : "v"(lo), "v"(hi)); return r; }
constexpr int ATT_VROW = 68;
constexpr int ATT_LDS_BYTES = 2 * (64 * 104 * 2 + 64 * ATT_VROW * 2);

template <int QKD, int NMAP, bool DA>
__device__ __forceinline__ void attn_item(LAS3 unsigned char* lds, const bf16_t* __restrict__ Qb, const bf16_t* __restrict__ Kb, const bf16_t* __restrict__ Vt,
                                          bf16_t* __restrict__ ycatb, int ycat_off, int b, int h, int qblk, float lam, const float* __restrict__ subln, float post_scale) {
    constexpr int DK = QKD / NMAP, KS = DK / 16, KROW = QKD + 8, KCH = QKD / 8;
    constexpr int KBYTES = 64 * KROW * 2, VBYTES = 64 * ATT_VROW * 2, BUFB = KBYTES + VBYTES;
    const int tid = threadIdx.x, wid = tid >> 6, lane = tid & 63, r = lane & 31, hh = lane >> 5;
    const int q0 = qblk * 256, ntiles = (qblk == 0) ? (NC / 64) : (NT / 64);
    const size_t base = ((size_t)b * 4 + h) * NT;
    bf16x8_t qf[NMAP][KS];
#pragma unroll
    for (int m = 0; m < NMAP; ++m)
#pragma unroll
        for (int ks = 0; ks < KS; ++ks) qf[m][ks] = *(const bf16x8_t*)(Qb + (base + q0 + 32 * wid + r) * QKD + m * DK + 16 * ks + 8 * hh);
    f32x16_t O[NMAP][2]; float mrun[NMAP], lrun[NMAP];
#pragma unroll
    for (int m = 0; m < NMAP; ++m) { mrun[m] = -1e30f; lrun[m] = 0.f;
#pragma unroll
        for (int d2 = 0; d2 < 2; ++d2)
#pragma unroll
            for (int i = 0; i < 16; ++i) O[m][d2][i] = 0.f; }
    constexpr int NKC = 64 * KCH;
    const bf16_t* kg = Kb + base * QKD;
    const bf16_t* vg = Vt + ((size_t)(b * 4 + h) * 64 + (tid >> 3)) * NT + (tid & 7) * 8;
    u32x4_t rk0, rk1 = (u32x4_t){0u, 0u, 0u, 0u}, rv;
    const int kc1 = tid + 512;
    const int k0row = tid / KCH, k0col = tid % KCH, k1row = kc1 / KCH, k1col = kc1 % KCH;
#define ATT_LOAD(j) do { rk0 = *(const u32x4_t*)(kg + (size_t)(j) * 64 * QKD + tid * 8); if (NKC > 512 && kc1 < NKC) rk1 = *(const u32x4_t*)(kg + (size_t)(j) * 64 * QKD + kc1 * 8); \
        rv = *(const u32x4_t*)(vg + (size_t)(j) * 64); } while (0)
#define ATT_STORE(buf) do { LAS3 unsigned char* kb_ = lds + (buf) * BUFB; LAS3 unsigned char* vb_ = kb_ + KBYTES; \
        *(LAS3 u32x4_t*)(kb_ + (k0row * KROW + k0col * 8) * 2) = rk0; if (NKC > 512 && kc1 < NKC) *(LAS3 u32x4_t*)(kb_ + (k1row * KROW + k1col * 8) * 2) = rk1; \
        LAS3 unsigned char* vd_ = vb_ + ((tid >> 3) * ATT_VROW + (tid & 7) * 8) * 2; *(LAS3 u32x2_t*)vd_ = (u32x2_t){rv.x, rv.y}; *(LAS3 u32x2_t*)(vd_ + 8) = (u32x2_t){rv.z, rv.w}; } while (0)
    __syncthreads();
    ATT_LOAD(0); ATT_STORE(0);
    if (ntiles > 1) ATT_LOAD(1);
    __syncthreads();
    for (int j = 0; j < ntiles; ++j) {
        const LAS3 unsigned char* kb = lds + (j & 1) * BUFB; const LAS3 unsigned char* vb = kb + KBYTES;
        f32x16_t S[NMAP][2];
#pragma unroll
        for (int m = 0; m < NMAP; ++m)
#pragma unroll
            for (int kt = 0; kt < 2; ++kt) {
#pragma unroll
                for (int i = 0; i < 16; ++i) S[m][kt][i] = 0.f;
#pragma unroll
                for (int ks = 0; ks < KS; ++ks) {
                    const bf16x8_t a = *(const LAS3 bf16x8_t*)(kb + ((kt * 32 + r) * KROW + m * DK + 16 * ks + 8 * hh) * 2);
                    S[m][kt] = __builtin_amdgcn_mfma_f32_32x32x16_bf16(a, qf[m][ks], S[m][kt], 0, 0, 0);
                }
            }
        bf16x8_t pf[NMAP][2][2];
#pragma unroll
        for (int m = 0; m < NMAP; ++m) {
            float mx = S[m][0][0];
#pragma unroll
            for (int i = 1; i < 16; ++i) mx = fmaxf(mx, S[m][0][i]);
#pragma unroll
            for (int i = 0; i < 16; ++i) mx = fmaxf(mx, S[m][1][i]);
            mx = fmaxf(mx, __shfl_xor(mx, 32));
            const float mn = fmaxf(mrun[m], mx);
            const float alpha = __builtin_amdgcn_exp2f(mrun[m] - mn);
            mrun[m] = mn;
            float ps = 0.f;
#pragma unroll
            for (int kt = 0; kt < 2; ++kt) {
#pragma unroll
                for (int i = 0; i < 16; ++i) { const float pv = __builtin_amdgcn_exp2f(S[m][kt][i] - mn); S[m][kt][i] = pv; ps += pv; }
#pragma unroll
                for (int s2 = 0; s2 < 2; ++s2) {
                    union { unsigned u[4]; bf16x8_t v; } cv;
#pragma unroll
                    for (int jj = 0; jj < 4; ++jj) cv.u[jj] = cvtpk(S[m][kt][8 * s2 + 2 * jj], S[m][kt][8 * s2 + 2 * jj + 1]);
                    pf[m][kt][s2] = cv.v;
                }
            }
            lrun[m] = lrun[m] * alpha + ps;
#pragma unroll
            for (int d2 = 0; d2 < 2; ++d2)
#pragma unroll
                for (int i = 0; i < 16; ++i) O[m][d2][i] *= alpha;
        }
#pragma unroll
        for (int d2 = 0; d2 < 2; ++d2)
#pragma unroll
            for (int kt = 0; kt < 2; ++kt)
#pragma unroll
                for (int s2 = 0; s2 < 2; ++s2) {
                    const LAS3 unsigned char* vp = vb + ((d2 * 32 + r) * ATT_VROW + kt * 32 + 16 * s2 + 4 * hh) * 2;
                    union { u32x2_t u[2]; bf16x8_t v; } av;
                    av.u[0] = *(const LAS3 u32x2_t*)vp; av.u[1] = *(const LAS3 u32x2_t*)(vp + 16);
#pragma unroll
                    for (int m = 0; m < NMAP; ++m) O[m][d2] = __builtin_amdgcn_mfma_f32_32x32x16_bf16(av.v, pf[m][kt][s2], O[m][d2], 0, 0, 0);
                }
        if (j + 1 < ntiles) { ATT_STORE((j + 1) & 1); if (j + 2 < ntiles) ATT_LOAD(j + 2); }
        __syncthreads();
    }
#undef ATT_LOAD
#undef ATT_STORE
    float inv[NMAP];
#pragma unroll
    for (int m = 0; m < NMAP; ++m) { const float lt = lrun[m] + __shfl_xor(lrun[m], 32); inv[m] = 1.f / lt; }
    if (NMAP == 2) inv[NMAP - 1] *= -lam;
    float ss = 0.f;
#pragma unroll
    for (int d2 = 0; d2 < 2; ++d2)
#pragma unroll
        for (int i = 0; i < 16; ++i) {
            float o = O[0][d2][i] * inv[0];
            if (NMAP == 2) o += O[NMAP - 1][d2][i] * inv[NMAP - 1];
            O[0][d2][i] = o; ss += o * o;
        }
    float rs = 1.f;
    if (DA) { ss += __shfl_xor(ss, 32); rs = rsqrtf(ss * (1.f / 64.f) + 1e-6f) * post_scale; }
    bf16_t* yp = ycatb + ((size_t)b * NT + q0 + 32 * wid + r) * DM + ycat_off + h * 64;
#pragma unroll
    for (int d2 = 0; d2 < 2; ++d2)
#pragma unroll
        for (int g4 = 0; g4 < 4; ++g4) {
            const int dv = 32 * d2 + 8 * g4 + 4 * hh;
            float o0 = O[0][d2][4 * g4] * rs, o1 = O[0][d2][4 * g4 + 1] * rs, o2 = O[0][d2][4 * g4 + 2] * rs, o3 = O[0][d2][4 * g4 + 3] * rs;
            if (DA) { const float4 w = *(const float4*)(subln + dv); o0 *= w.x; o1 *= w.y; o2 *= w.z; o3 *= w.w; }
            *(uint2*)(yp + dv) = make_uint2(cvtpk(o0, o1), cvtpk(o2, o3));
        }
}

template <int QKD, int NMAP, bool DA>
__global__ __launch_bounds__(512, 2) void k_attn_mfma(const bf16_t* __restrict__ Qb, const bf16_t* __restrict__ Kb, const bf16_t* __restrict__ Vt, bf16_t* __restrict__ ycatb, int ycat_off,
                                                      const float* __restrict__ lamfull, const float* __restrict__ subln, float post_scale, int with_ctx) {
    int qblk = blockIdx.x, h = blockIdx.y, b = blockIdx.z;
    if (qblk == 0 && !with_ctx) return;
    attn_item<QKD, NMAP, DA>((LAS3 unsigned char*)dyn_lds, Qb, Kb, Vt, ycatb, ycat_off, b, h, qblk, DA ? lamfull[0] : 0.f, subln, post_scale);
}

__global__ __launch_bounds__(256) void k_da_prep2(const float* __restrict__ p, const float* __restrict__ cs, bf16_t* __restrict__ Qb, bf16_t* __restrict__ Kb, bf16_t* __restrict__ Vt, float qscale) {
    __shared__ bf16_t vs[256][72];
    int t0 = blockIdx.x * 64; int b = t0 / NT, n0 = t0 % NT;
    int c = threadIdx.x; int h = c >> 6, rr = c & 63, d = rr & 31;
    for (int i = 0; i < 64; ++i) {
        int n = n0 + i; const float* pr = p + (size_t)(t0 + i) * DIN;
        float qv = pr[P_DAQ + c], kv = pr[P_DAK + c];
        if (n >= NC) {
            int pos = n - NC; int j = d & 15;
            float co = cs[(pos * 16 + j) * 2], si = cs[(pos * 16 + j) * 2 + 1];
            int cp = (d < 16) ? c + 16 : c - 16;
            float qo = pr[P_DAQ + cp], ko = pr[P_DAK + cp];
            if (d < 16) { qv = qv * co - qo * si; kv = kv * co - ko * si; }
            else        { qv = qv * co + qo * si; kv = kv * co + ko * si; }
        }
        size_t o = (((size_t)b * 4 + h) * NT + n) * 64 + rr;
        Qb[o] = f2bf(qv * qscale); Kb[o] = f2bf(kv);
        vs[c][i] = f2bf(pr[P_DAV + c]);
    }
    __syncthreads();
    bf16_t* vp = Vt + (((size_t)b * 4 + h) * 64 + rr) * NT + n0;
#pragma unroll
    for (int q = 0; q < 8; ++q) *(uint4*)(vp + q * 8) = *(const uint4*)&vs[c][q * 8];
}
__global__ __launch_bounds__(256) void k_mla_layout2(const float* __restrict__ p, const float* __restrict__ qfull, const float* __restrict__ kvfull, const float* __restrict__ cs,
                                                     bf16_t* __restrict__ Qb, bf16_t* __restrict__ Kb, bf16_t* __restrict__ Vt, float qscale) {
    __shared__ bf16_t vs[256][72];
    int t0 = blockIdx.x * 64; int b = t0 / NT, n0 = t0 % NT;
    for (int i = 0; i < 64; ++i) {
        int n = n0 + i; size_t t = (size_t)t0 + i;
        const float* pr = p + t * DIN; const float* qf = qfull + t * 384; const float* kf = kvfull + t * 512;
        for (int idx = threadIdx.x; idx < 384; idx += 256) {
            int h = idx / 96, j = idx % 96;
            size_t o = (((size_t)b * 4 + h) * NT + n) * 96 + j;
            float qv, kv;
            if (j < 64) { qv = qf[h * 96 + j]; kv = kf[h * 128 + j]; }
            else {
                int d = j - 64;
                qv = qf[h * 96 + j]; kv = pr[P_KR + d];
                if (n >= NC) {
                    int pos = n - NC; int jj = d & 15;
                    float co = cs[(pos * 16 + jj) * 2], si = cs[(pos * 16 + jj) * 2 + 1];
                    int dp = (d < 16) ? d + 16 : d - 16;
                    float qo = qf[h * 96 + 64 + dp], ko = pr[P_KR + dp];
                    if (d < 16) { qv = qv * co - qo * si; kv = kv * co - ko * si; }
                    else        { qv = qv * co + qo * si; kv = kv * co + ko * si; }
                }
            }
            Qb[o] = f2bf(qv * qscale); Kb[o] = f2bf(kv);
        }
        { int c = threadIdx.x; int h = c >> 6, j = c & 63; vs[c][i] = f2bf(kf[h * 128 + 64 + j]); }
    }
    __syncthreads();
    { int c = threadIdx.x; int h = c >> 6, j = c & 63;
      bf16_t* vp = Vt + (((size_t)b * 4 + h) * 64 + j) * NT + n0;
#pragma unroll
      for (int q = 0; q < 8; ++q) *(uint4*)(vp + q * 8) = *(const uint4*)&vs[c][q * 8]; }
}


typedef float f32x4_t __attribute__((ext_vector_type(4)));
constexpr int ML_KROW = 72, ML_TROW = 136, ML_CROW = 72;
constexpr int ML_OFF_KC = 0, ML_OFF_KT = ML_OFF_KC + 128 * ML_KROW * 2, ML_OFF_VT = ML_OFF_KT + 64 * ML_TROW * 2, ML_OFF_CB = ML_OFF_VT + 80 * ML_TROW * 2,
              ML_OFF_F = ML_OFF_CB + 80 * ML_CROW * 2, ML_LDS_BYTES = ML_OFF_F + 6 * 128 * 4 + 64;
__device__ __forceinline__ void mlstm_item(LAS3 unsigned char* lds, const bf16_t* __restrict__ Qb, const bf16_t* __restrict__ Kb, const bf16_t* __restrict__ Ktg, const bf16_t* __restrict__ Vtg,
                                           const float* __restrict__ G, float* __restrict__ hdir, int b, int h, int dir) {
    const int tid = threadIdx.x, wid = tid >> 6, lane = tid & 63, lr = lane & 15, q = lane >> 4;
    LAS3 unsigned char* Kc = lds + ML_OFF_KC; LAS3 unsigned char* Kt = lds + ML_OFF_KT; LAS3 unsigned char* Vt = lds + ML_OFF_VT; LAS3 unsigned char* Cb = lds + ML_OFF_CB;
    LAS3 float* fl = (LAS3 float*)(lds + ML_OFF_F);
    LAS3 float* s_li = fl; LAS3 float* s_lf = fl + 128; LAS3 float* s_bc2 = fl + 256; LAS3 float* s_gk2 = fl + 384; LAS3 float* s_wu = fl + 512; LAS3 float* s_et = fl + 640; LAS3 float* s_misc = fl + 768;
    const size_t base = ((size_t)b * 4 + h) * NT;
    __syncthreads();
    for (int i = tid; i < 80 * ML_CROW / 2; i += 512) ((LAS3 unsigned*)Cb)[i] = 0u;
    for (int i = tid; i < 16 * ML_TROW / 2; i += 512) ((LAS3 unsigned*)(Vt + 64 * ML_TROW * 2))[i] = (i < ML_TROW / 2) ? 0x3F803F80u : 0u;
    const int ct = wid & 3, rt0 = (wid < 4) ? 0 : 3, nrt = (wid < 4) ? 3 : 2;
    f32x4_t Cacc[3];
#pragma unroll
    for (int i = 0; i < 3; ++i) Cacc[i] = (f32x4_t){0.f, 0.f, 0.f, 0.f};
    for (int c = 0; c < NT / 128; ++c) {
        int n0;
        if (dir == 0) n0 = 128 * c; else n0 = (c < 2) ? 128 * (1 - c) : NC + 128 * (17 - c);
        u32x4_t rkc[2], rkt[2], rvt[2];
#pragma unroll
        for (int i = 0; i < 2; ++i) {
            const int id = tid + 512 * i;
            rkc[i] = *(const u32x4_t*)(Kb + (base + n0 + (id >> 3)) * 64 + (id & 7) * 8);
            rkt[i] = *(const u32x4_t*)(Ktg + ((size_t)(b * 4 + h) * 64 + (id >> 4)) * NT + n0 + (id & 15) * 8);
            rvt[i] = *(const u32x4_t*)(Vtg + ((size_t)(b * 4 + h) * 64 + (id >> 4)) * NT + n0 + (id & 15) * 8);
        }
        const int tq = 16 * wid + lr;
        bf16x8_t qf[2];
#pragma unroll
        for (int ks = 0; ks < 2; ++ks) qf[ks] = *(const bf16x8_t*)(Qb + (base + n0 + tq) * 64 + 32 * ks + 8 * q);
        if (tid < 128) { const float* gp = G + ((size_t)b * NT + n0 + tid) * 16; s_li[tid] = gp[(dir * 2) * 4 + h]; s_lf[tid] = gp[(dir * 2 + 1) * 4 + h]; }
#pragma unroll
        for (int i = 0; i < 2; ++i) {
            const int id = tid + 512 * i;
            *(LAS3 u32x4_t*)(Kc + ((id >> 3) * ML_KROW + (id & 7) * 8) * 2) = rkc[i];
            *(LAS3 u32x4_t*)(Vt + ((id >> 4) * ML_TROW + (id & 15) * 8) * 2) = rvt[i];
        }
        __syncthreads();
        if (wid == 0) {
            const int ia = (dir == 0) ? 2 * lane : 127 - 2 * lane, ib = (dir == 0) ? 2 * lane + 1 : 126 - 2 * lane;
            const float xa = s_lf[ia], xb = s_lf[ib];
            float inc = xa + xb;
#pragma unroll
            for (int o = 1; o < 64; o <<= 1) { const float v = __shfl_up(inc, o); if (lane >= o) inc += v; }
            const float tot = __shfl(inc, 63);
            const float bca = inc - xb, bcb = inc;
            const float lia = s_li[ia], lib = s_li[ib];
            s_bc2[ia] = bca * 1.4426950408889634f; s_bc2[ib] = bcb * 1.4426950408889634f;
            s_gk2[ia] = (bca - lia) * 1.4426950408889634f; s_gk2[ib] = (bcb - lib) * 1.4426950408889634f;
            s_wu[ia] = __expf(tot - bca + lia); s_wu[ib] = __expf(tot - bcb + lib);
            s_et[ia] = __expf(bca); s_et[ib] = __expf(bcb);
            if (lane == 0) s_misc[0] = __expf(tot);
        }
        __syncthreads();
#pragma unroll
        for (int i = 0; i < 2; ++i) {
            const int id = tid + 512 * i; const int tk0 = (id & 15) * 8;
            unsigned w4[4] = {rkt[i].x, rkt[i].y, rkt[i].z, rkt[i].w}; u32x4_t o;
#pragma unroll
            for (int jj = 0; jj < 4; ++jj) {
                const float lo = __uint_as_float(w4[jj] << 16) * s_wu[tk0 + 2 * jj], hi = __uint_as_float(w4[jj] & 0xFFFF0000u) * s_wu[tk0 + 2 * jj + 1];
                o[jj] = cvtpk(lo, hi);
            }
            *(LAS3 u32x4_t*)(Kt + ((id >> 4) * ML_TROW + tk0) * 2) = o;
        }
        f32x4_t S[8];
#pragma unroll
        for (int kt = 0; kt < 8; ++kt) {
            S[kt] = (f32x4_t){0.f, 0.f, 0.f, 0.f};
#pragma unroll
            for (int ks = 0; ks < 2; ++ks) {
                const bf16x8_t a = *(const LAS3 bf16x8_t*)(Kc + ((16 * kt + lr) * ML_KROW + 32 * ks + 8 * q) * 2);
                S[kt] = __builtin_amdgcn_mfma_f32_16x16x32_bf16(a, qf[ks], S[kt], 0, 0, 0);
            }
        }
        const float bct = s_bc2[tq];
#pragma unroll
        for (int kt = 0; kt < 8; ++kt) {
            const f32x4_t gk = *(const LAS3 f32x4_t*)(s_gk2 + 16 * kt + 4 * q);
#pragma unroll
            for (int rg = 0; rg < 4; ++rg) {
                const int si = 16 * kt + 4 * q + rg;
                const bool valid = (dir == 0) ? (si <= tq) : (si >= tq);
                const float w = valid ? __builtin_amdgcn_exp2f(bct - gk[rg]) : 0.f;
                S[kt][rg] *= w;
            }
        }
        bf16x8_t pf[4];
#pragma unroll
        for (int k2 = 0; k2 < 4; ++k2) {
            union { unsigned u[4]; bf16x8_t v; } cv;
            cv.u[0] = cvtpk(S[2 * k2][0], S[2 * k2][1]); cv.u[1] = cvtpk(S[2 * k2][2], S[2 * k2][3]);
            cv.u[2] = cvtpk(S[2 * k2 + 1][0], S[2 * k2 + 1][1]); cv.u[3] = cvtpk(S[2 * k2 + 1][2], S[2 * k2 + 1][3]);
            pf[k2] = cv.v;
        }
        f32x4_t outv[5];
#pragma unroll
        for (int rt = 0; rt < 5; ++rt) {
            f32x4_t acc = (f32x4_t){0.f, 0.f, 0.f, 0.f}, acc2 = (f32x4_t){0.f, 0.f, 0.f, 0.f};
#pragma unroll
            for (int k2 = 0; k2 < 4; ++k2) {
                const LAS3 unsigned char* vp = Vt + ((16 * rt + lr) * ML_TROW + 32 * k2 + 4 * q) * 2;
                union { u32x2_t u[2]; bf16x8_t v; } av;
                av.u[0] = *(const LAS3 u32x2_t*)vp; av.u[1] = *(const LAS3 u32x2_t*)(vp + 32);
                acc = __builtin_amdgcn_mfma_f32_16x16x32_bf16(av.v, pf[k2], acc, 0, 0, 0);
            }
#pragma unroll
            for (int ks = 0; ks < 2; ++ks) {
                const bf16x8_t a = *(const LAS3 bf16x8_t*)(Cb + ((16 * rt + lr) * ML_CROW + 32 * ks + 8 * q) * 2);
                acc2 = __builtin_amdgcn_mfma_f32_16x16x32_bf16(a, qf[ks], acc2, 0, 0, 0);
            }
            outv[rt] = acc + acc2 * s_et[tq];
        }
        {
            const float den = __shfl(outv[4][0], lr);
            const float inv = 1.f / fmaxf(fabsf(den), 1.f);
            float* hp = hdir + ((size_t)dir * TT + (size_t)b * NT + n0 + tq) * 256 + h * 64 + 4 * q;
#pragma unroll
            for (int rt = 0; rt < 4; ++rt) *(f32x4_t*)(hp + 16 * rt) = outv[rt] * inv;
        }
        __syncthreads();
        {
            const float decay = s_misc[0];
#pragma unroll
            for (int i = 0; i < 3; ++i) Cacc[i] *= decay;
#pragma unroll
            for (int ks = 0; ks < 4; ++ks) {
                const bf16x8_t bb = *(const LAS3 bf16x8_t*)(Kt + ((16 * ct + lr) * ML_TROW + 32 * ks + 8 * q) * 2);
#pragma unroll
                for (int i = 0; i < 3; ++i) if (i < nrt) {
                    const bf16x8_t a = *(const LAS3 bf16x8_t*)(Vt + ((16 * (rt0 + i) + lr) * ML_TROW + 32 * ks + 8 * q) * 2);
                    Cacc[i] = __builtin_amdgcn_mfma_f32_16x16x32_bf16(a, bb, Cacc[i], 0, 0, 0);
                }
            }
#pragma unroll
            for (int i = 0; i < 3; ++i) if (i < nrt) {
#pragma unroll
                for (int rg = 0; rg < 4; ++rg) *(LAS3 bf16_t*)(Cb + ((16 * (rt0 + i) + 4 * q + rg) * ML_CROW + 16 * ct + lr) * 2) = f2bf(Cacc[i][rg]);
            }
        }
        __syncthreads();
    }
}
__global__ __launch_bounds__(512, 2) void k_mlstm_mfma(const bf16_t* __restrict__ Qb, const bf16_t* __restrict__ Kb, const bf16_t* __restrict__ Ktg, const bf16_t* __restrict__ Vtg,
                                                       const float* __restrict__ G, float* __restrict__ hdir) {
    mlstm_item((LAS3 unsigned char*)dyn_lds, Qb, Kb, Ktg, Vtg, G, hdir, blockIdx.y, blockIdx.x, blockIdx.z);
}
__global__ __launch_bounds__(256) void k_ml_prep2(const float* __restrict__ p, const float* __restrict__ conv_w, const float* __restrict__ conv_b, const float* __restrict__ gate_b,
                                                  bf16_t* __restrict__ Qb, bf16_t* __restrict__ Kb, bf16_t* __restrict__ Ktg, bf16_t* __restrict__ Vtg, float* __restrict__ G) {
    __shared__ bf16_t ts[256][72];
    int t0 = blockIdx.x * 64; int b = t0 / NT, n0 = t0 % NT;
    int c = threadIdx.x; int h = c >> 6, d = c & 63;
    const int seg_lo = (n0 < NC) ? 0 : NC, seg_hi = (n0 < NC) ? NC - 1 : NT - 1;
    const float wq0 = conv_w[c], wq1 = conv_w[512 + c], wq2 = conv_w[1024 + c], bq = conv_b[c];
    const float wk0 = conv_w[256 + c], wk1 = conv_w[512 + 256 + c], wk2 = conv_w[1024 + 256 + c], bk = conv_b[256 + c];
    for (int i = 0; i < 64; ++i) {
        int n = n0 + i; size_t t = (size_t)t0 + i;
        float yq = bq, yk = bk;
        if (n - 1 >= seg_lo) { yq += p[(t - 1) * DIN + P_MLQK + c] * wq0; yk += p[(t - 1) * DIN + P_MLQK + 256 + c] * wk0; }
        yq += p[t * DIN + P_MLQK + c] * wq1; yk += p[t * DIN + P_MLQK + 256 + c] * wk1;
        if (n + 1 <= seg_hi) { yq += p[(t + 1) * DIN + P_MLQK + c] * wq2; yk += p[(t + 1) * DIN + P_MLQK + 256 + c] * wk2; }
        yq = siluf_(yq); yk = siluf_(yk) * 0.125f;
        size_t o = (((size_t)b * 4 + h) * NT + n) * 64 + d;
        Qb[o] = f2bf(yq); const bf16_t kb = f2bf(yk); Kb[o] = kb; ts[c][i] = kb;
        if (c < 16) {
            float g = p[t * DIN + P_MLG + c] + gate_b[c];
            if ((c >> 2) & 1) g = logsigmoidf_(g);
            G[t * 16 + c] = g;
        }
    }
    __syncthreads();
    { bf16_t* kp = Ktg + (((size_t)b * 4 + h) * 64 + d) * NT + n0;
#pragma unroll
      for (int qq = 0; qq < 8; ++qq) *(uint4*)(kp + qq * 8) = *(const uint4*)&ts[c][qq * 8]; }
    __syncthreads();
    for (int i = 0; i < 64; ++i) ts[c][i] = f2bf(p[((size_t)t0 + i) * DIN + P_MLV + c]);
    __syncthreads();
    { bf16_t* vp = Vtg + (((size_t)b * 4 + h) * 64 + d) * NT + n0;
#pragma unroll
      for (int qq = 0; qq < 8; ++qq) *(uint4*)(vp + qq * 8) = *(const uint4*)&ts[c][qq * 8]; }
}


__device__ __forceinline__ int seq_token(int s, int dir);
constexpr int S5_UROWS = NT + 64;
constexpr int S5_KROW = 1032, S5_CROW = 136, S5_ZROW = 136;
constexpr int S5_OFF_U = 0, S5_OFF_KM = S5_OFF_U + S5_UROWS * 16 * 2, S5_OFF_CM = S5_OFF_KM + 16 * S5_KROW * 2, S5_OFF_EZ = S5_OFF_CM + 16 * S5_CROW * 2,
              S5_LDS_BYTES = S5_OFF_EZ + 8 * 16 * S5_ZROW * 2;
__global__ __launch_bounds__(256) void k_s5_setup(const float* __restrict__ a_re, const float* __restrict__ a_im, const float* __restrict__ log_step,
                                                  const float* __restrict__ b_re, const float* __restrict__ b_im, const float* __restrict__ c_re, const float* __restrict__ c_im,
                                                  bf16_t* __restrict__ KmT, bf16_t* __restrict__ Smat, bf16_t* __restrict__ CmT, float* __restrict__ Aab, float* __restrict__ A64) {
    __shared__ float apw[64][64][2];
    __shared__ float bb[64][16][2];
    __shared__ float cc[16][64][2];
    const int idx = blockIdx.x, tid = threadIdx.x;
    const double dt = exp((double)log_step[idx]);
    if (tid < 64) {
        const int p = tid;
        const double ar = fmin((double)a_re[idx * 64 + p], -1e-4), ai = (double)a_im[idx * 64 + p];
        const double mag = exp(dt * ar), er = mag * cos(dt * ai), ei = mag * sin(dt * ai);
        const double inv = 1.0 / (ar * ar + ai * ai);
        const double fr = ((er - 1.0) * ar + ei * ai) * inv, fi = (ei * ar - (er - 1.0) * ai) * inv;
        Aab[(idx * 64 + p) * 2] = (float)er; Aab[(idx * 64 + p) * 2 + 1] = (float)ei;
        const double m64 = exp(64.0 * dt * ar);
        A64[(idx * 64 + p) * 2] = (float)(m64 * cos(64.0 * dt * ai)); A64[(idx * 64 + p) * 2 + 1] = (float)(m64 * sin(64.0 * dt * ai));
        for (int hh = 0; hh < 16; ++hh) {
            const double br = b_re[((size_t)idx * 64 + p) * 16 + hh], bi = b_im[((size_t)idx * 64 + p) * 16 + hh];
            bb[p][hh][0] = (float)(fr * br - fi * bi); bb[p][hh][1] = (float)(fr * bi + fi * br);
        }
    }
    for (int i = tid; i < 64 * 64; i += 256) {
        const int tau = i >> 6, p = i & 63;
        const double ar = fmin((double)a_re[idx * 64 + p], -1e-4), ai = (double)a_im[idx * 64 + p];
        const double mag = exp(tau * dt * ar);
        apw[tau][p][0] = (float)(mag * cos(tau * dt * ai)); apw[tau][p][1] = (float)(mag * sin(tau * dt * ai));
    }
    for (int i = tid; i < 16 * 64; i += 256) { const int hh = i >> 6, p = i & 63; cc[hh][p][0] = c_re[(size_t)idx * 1024 + i]; cc[hh][p][1] = c_im[(size_t)idx * 1024 + i]; }
    __syncthreads();
    for (int i = tid; i < 16 * 64; i += 256) { const int hh = i >> 6, p = i & 63;
        CmT[((size_t)idx * 16 + hh) * 128 + 2 * p] = f2bf(cc[hh][p][0]); CmT[((size_t)idx * 16 + hh) * 128 + 2 * p + 1] = f2bf(-cc[hh][p][1]); }
    for (int e = tid; e < 64 * 1024; e += 256) {
        const int p = e >> 10, k = e & 1023, i = k >> 4, hp = k & 15;
        const float pr = apw[63 - i][p][0], pi = apw[63 - i][p][1], br = bb[p][hp][0], bi = bb[p][hp][1];
        Smat[((size_t)idx * 128 + 2 * p) * 1024 + k] = f2bf(pr * br - pi * bi);
        Smat[((size_t)idx * 128 + 2 * p + 1) * 1024 + k] = f2bf(pr * bi + pi * br);
    }
    for (int e = tid; e < 16 * 1024; e += 256) {
        const int hh = e >> 10, k = e & 1023, tau = k >> 4, hp = k & 15;
        float acc = 0.f;
        for (int p = 0; p < 64; ++p) {
            const float pr = apw[tau][p][0], pi = apw[tau][p][1], br = bb[p][hp][0], bi = bb[p][hp][1];
            const float wr = pr * br - pi * bi, wi = pr * bi + pi * br;
            acc += cc[hh][p][0] * wr - cc[hh][p][1] * wi;
        }
        KmT[((size_t)idx * 16 + hh) * 1024 + k] = f2bf(acc);
    }
}

__device__ __forceinline__ void s5_item(LAS3 unsigned char* lds, const float* __restrict__ p, const bf16_t* __restrict__ KmT, const bf16_t* __restrict__ Smat, const bf16_t* __restrict__ CmT,
                                        const float* __restrict__ Aab, const float* __restrict__ A64, float* __restrict__ xs_g, float* __restrict__ ys5, int b, int g, int dir) {
    const int tid = threadIdx.x, wid = tid >> 6, lane = tid & 63, lr = lane & 15, q = lane >> 4;
    const int tix = dir * 16 + g;
    LAS3 unsigned char* U = lds + S5_OFF_U; LAS3 unsigned char* Km = lds + S5_OFF_KM; LAS3 unsigned char* Cm = lds + S5_OFF_CM; LAS3 unsigned char* EZ = lds + S5_OFF_EZ;
    float* xs = xs_g + (size_t)((b * 16 + g) * 2 + dir) * 36 * 128;
    __syncthreads();
    for (int i = tid; i < 16 * 128; i += 512) { const int hh = i >> 7, ch = i & 127;
        *(LAS3 u32x4_t*)(Km + (hh * S5_KROW + ch * 8) * 2) = *(const u32x4_t*)(KmT + ((size_t)tix * 16 + hh) * 1024 + ch * 8); }
    if (tid < 256) { const int hh = tid >> 4, ch = tid & 15;
        *(LAS3 u32x4_t*)(Cm + (hh * S5_CROW + ch * 8) * 2) = *(const u32x4_t*)(CmT + ((size_t)tix * 16 + hh) * 128 + ch * 8); }
    for (int i = tid; i < NT * 4; i += 512) {
        const int sidx = i >> 2, qd = i & 3;
        const int n = seq_token(sidx, dir);
        const float4 v = *(const float4*)(p + ((size_t)b * NT + n) * DIN + P_S5 + g * 16 + qd * 4);
        *(LAS3 u32x2_t*)(U + ((64 + sidx) * 16 + qd * 4) * 2) = (u32x2_t){cvtpk(v.x, v.y), cvtpk(v.z, v.w)};
    }
    for (int i = tid; i < 64 * 8; i += 512) *(LAS3 unsigned*)(U + i * 4) = 0u;
    __syncthreads();
    {
        f32x4_t acc[3];
#pragma unroll
        for (int i = 0; i < 3; ++i) acc[i] = (f32x4_t){0.f, 0.f, 0.f, 0.f};
        const bf16_t* sp = Smat + ((size_t)tix * 128 + 16 * wid + lr) * 1024 + 8 * q;
        int cco[3];
#pragma unroll
        for (int ctile = 0; ctile < 3; ++ctile) { int ch = 16 * ctile + lr; if (ch > 35) ch = 35; cco[ctile] = ((64 + 64 * ch + (q >> 1)) * 16 + 8 * (q & 1)) * 2; }
#pragma unroll 8
        for (int ks = 0; ks < 32; ++ks) {
            const bf16x8_t a = *(const bf16x8_t*)(sp + 32 * ks);
#pragma unroll
            for (int ctile = 0; ctile < 3; ++ctile) {
                const bf16x8_t bfr = *(const LAS3 bf16x8_t*)(U + cco[ctile] + ks * 64);
                acc[ctile] = __builtin_amdgcn_mfma_f32_16x16x32_bf16(a, bfr, acc[ctile], 0, 0, 0);
            }
        }
        LAS3 float* E = (LAS3 float*)EZ;
#pragma unroll
        for (int ctile = 0; ctile < 3; ++ctile)
#pragma unroll
            for (int rg = 0; rg < 4; ++rg) E[(16 * ctile + lr) * 128 + 16 * wid + 4 * q + rg] = acc[ctile][rg];
    }
    __syncthreads();
    const float Ar = Aab[(tix * 64 + lane) * 2], Ai = Aab[(tix * 64 + lane) * 2 + 1];
    if (wid == 0) {
        const float Br = A64[(tix * 64 + lane) * 2], Bi = A64[(tix * 64 + lane) * 2 + 1];
        const LAS3 float* E = (const LAS3 float*)EZ;
        float xr = 0.f, xi = 0.f;
        for (int c = 0; c < 36; ++c) {
            *(float2*)(xs + c * 128 + 2 * lane) = make_float2(xr, xi);
            const float er = E[c * 128 + 2 * lane], ei = E[c * 128 + 2 * lane + 1];
            const float nr = Br * xr - Bi * xi + er, ni = Br * xi + Bi * xr + ei;
            xr = nr; xi = ni;
        }
    }
    __threadfence_block();
    __syncthreads();
    LAS3 unsigned char* Zw = EZ + wid * (16 * S5_ZROW * 2);
    bf16x8_t cmf[4];
#pragma unroll
    for (int ks = 0; ks < 4; ++ks) cmf[ks] = *(const LAS3 bf16x8_t*)(Cm + (lr * S5_CROW + 32 * ks + 8 * q) * 2);
    for (int c = wid; c < 36; c += 8) {
        const float2 x0 = *(const float2*)(xs + c * 128 + 2 * lane);
        float zr = Ar * x0.x - Ai * x0.y, zi = Ar * x0.y + Ai * x0.x;
#pragma unroll
        for (int rt = 0; rt < 4; ++rt) {
#pragma unroll
            for (int ii = 0; ii < 16; ++ii) {
                *(LAS3 unsigned*)(Zw + (ii * S5_ZROW + 2 * lane) * 2) = cvtpk(zr, zi);
                const float nr = Ar * zr - Ai * zi, ni = Ar * zi + Ai * zr; zr = nr; zi = ni;
            }
            asm volatile("s_waitcnt lgkmcnt(0)" ::: "memory");
            f32x4_t acc = (f32x4_t){0.f, 0.f, 0.f, 0.f};
#pragma unroll
            for (int ks = 0; ks < 4; ++ks) {
                const bf16x8_t a = *(const LAS3 bf16x8_t*)(Zw + (lr * S5_ZROW + 32 * ks + 8 * q) * 2);
                acc = __builtin_amdgcn_mfma_f32_16x16x32_bf16(a, cmf[ks], acc, 0, 0, 0);
            }
            const int irow = 16 * rt + lr;
            const LAS3 unsigned char* up = U + ((64 + 64 * c + irow - (q >> 1)) * 16 + 8 * (q & 1)) * 2;
            const LAS3 unsigned char* kp = Km + (lr * S5_KROW + 8 * q) * 2;
#pragma unroll 4
            for (int ks = 0; ks < 8 * rt + 8; ++ks) {
                bf16x8_t a = *(const LAS3 bf16x8_t*)(up - ks * 64);
                const bool valid = (2 * ks + (q >> 1)) <= irow;
                if (!valid) a = (bf16x8_t){0, 0, 0, 0, 0, 0, 0, 0};
                const bf16x8_t kb = *(const LAS3 bf16x8_t*)(kp + ks * 64);
                acc = __builtin_amdgcn_mfma_f32_16x16x32_bf16(a, kb, acc, 0, 0, 0);
            }
#pragma unroll
            for (int rg = 0; rg < 4; ++rg) {
                const int n = seq_token(64 * c + 16 * rt + 4 * q + rg, dir);
                ys5[((size_t)dir * TT + (size_t)b * NT + n) * 256 + g * 16 + lr] = acc[rg];
            }
            asm volatile("s_waitcnt lgkmcnt(0)" ::: "memory");
        }
    }
}
__global__ __launch_bounds__(512, 2) void k_s5_mfma(const float* __restrict__ p, const bf16_t* __restrict__ KmT, const bf16_t* __restrict__ Smat, const bf16_t* __restrict__ CmT,
                                                    const float* __restrict__ Aab, const float* __restrict__ A64, float* __restrict__ xs_g, float* __restrict__ ys5) {
    s5_item((LAS3 unsigned char*)dyn_lds, p, KmT, Smat, CmT, Aab, A64, xs_g, ys5, blockIdx.y, blockIdx.x, blockIdx.z);
}

__global__ void k_build_x(const float* __restrict__ x, const float* __restrict__ ctx, float* __restrict__ xall) {
    size_t i = (size_t)blockIdx.x * 256 + threadIdx.x;
    size_t total = (size_t)TT * DM / 4;
    if (i >= total) return;
    size_t t = i / (DM / 4); int d4 = (int)(i % (DM / 4));
    int b = (int)(t / NT), n = (int)(t % NT);
    const float4* src = (n < NC) ? (const float4*)(ctx + ((size_t)b * NC + n) * DM) : (const float4*)(x + ((size_t)b * NS + (n - NC)) * DM);
    ((float4*)xall)[i] = src[d4];
}

__global__ __launch_bounds__(256) void k_mod(const float* __restrict__ c, const float* __restrict__ c_ctx, const float* __restrict__ w_mod,
                                             const float* __restrict__ b_mod, float* __restrict__ mod) {
    __shared__ float s[9][1024];
    for (int i = threadIdx.x; i < 9 * 1024; i += 256) {
        int r = i >> 10, k = i & 1023;
        float v = (r < 8) ? c[r * 1024 + k] : c_ctx[k];
        s[r][k] = siluf_(v);
    }
    __syncthreads();
    int gj = blockIdx.x * 256 + threadIdx.x;
    int l = gj / 6144, j = gj % 6144;
    const float* w = w_mod + (size_t)l * 1024 * 6144 + j;
    float acc[9];
#pragma unroll
    for (int r = 0; r < 9; ++r) acc[r] = 0.f;
    for (int k = 0; k < 1024; ++k) {
        float wv = w[(size_t)k * 6144];
#pragma unroll
        for (int r = 0; r < 9; ++r) acc[r] += s[r][k] * wv;
    }
    float bb = b_mod[l * 6144 + j];
#pragma unroll
    for (int r = 0; r < 9; ++r) mod[((size_t)l * 9 + r) * 6144 + j] = acc[r] + bb;
}

__global__ void k_rope_table(float* __restrict__ cs) {
    int i = blockIdx.x * 256 + threadIdx.x;
    if (i >= NS * 16) return;
    int pos = i >> 4, j = i & 15;
    int row = pos / 64, col = pos % 64;
    double inv = pow(10000.0, -(double)(j & 7) / 8.0);
    double ang = (double)((j < 8) ? row : col) * inv;
    cs[i * 2] = (float)cos(ang);
    cs[i * 2 + 1] = (float)sin(ang);
}

__global__ void k_lambda(const float* __restrict__ da_lambda, float* __restrict__ lamfull) {
    int l = threadIdx.x;
    if (l >= 2) return;
    const float* lam = da_lambda + l * 128;
    double s1 = 0, s2 = 0;
    for (int i = 0; i < 32; ++i) { s1 += (double)lam[i] * lam[32 + i]; s2 += (double)lam[64 + i] * lam[96 + i]; }
    double lambda_init = 0.8 - 0.6 * exp(-0.3 * l);
    lamfull[l] = (float)(exp(s1) - exp(s2) + lambda_init);
}

__global__ void k_s5_disc(const float* __restrict__ a_re, const float* __restrict__ a_im, const float* __restrict__ log_step,
                          const float* __restrict__ b_re, const float* __restrict__ b_im,
                          float* __restrict__ abr, float* __restrict__ abi, float* __restrict__ bbr, float* __restrict__ bbi) {
    int i = blockIdx.x * 256 + threadIdx.x;
    if (i >= 2 * 2 * 16 * 64) return;
    int ldg = i >> 6;
    double ar = fmin((double)a_re[i], -1e-4), ai = (double)a_im[i];
    double dt = exp((double)log_step[ldg]);
    double mag = exp(dt * ar);
    double er = mag * cos(dt * ai), ei = mag * sin(dt * ai);
    double inv = 1.0 / (ar * ar + ai * ai);
    double fr = ((er - 1.0) * ar + ei * ai) * inv;
    double fi = (ei * ar - (er - 1.0) * ai) * inv;
    abr[i] = (float)er; abi[i] = (float)ei;
    for (int h = 0; h < 16; ++h) {
        double br = b_re[(size_t)i * 16 + h], bi = b_im[(size_t)i * 16 + h];
        bbr[(size_t)i * 16 + h] = (float)(fr * br - fi * bi);
        bbi[(size_t)i * 16 + h] = (float)(fr * bi + fi * br);
    }
}

__global__ __launch_bounds__(256) void k_norm_mod(const float* __restrict__ xall, const float* __restrict__ nw, const float* __restrict__ modl  ,
                                                  int shift_off, int scale_off, bf16_t* __restrict__ out) {
    __shared__ float red[8];
    int t = blockIdx.x; int b = t / NT, n = t % NT; int r = (n < NC) ? 8 : b;
    const float4 xv = ((const float4*)(xall + (size_t)t * DM))[threadIdx.x];
    float ss = xv.x * xv.x + xv.y * xv.y + xv.z * xv.z + xv.w * xv.w;
    ss = block_sum_256(ss, red);
    float rstd = rsqrtf(ss * (1.f / DM) + 1e-6f);
    int d = threadIdx.x * 4;
    const float4 w = *(const float4*)(nw + d);
    const float4 sc = *(const float4*)(modl + (size_t)r * 6144 + scale_off + d);
    const float4 sh = *(const float4*)(modl + (size_t)r * 6144 + shift_off + d);
    float4 o;
    o.x = xv.x * rstd * w.x * (1.f + sc.x) + sh.x;
    o.y = xv.y * rstd * w.y * (1.f + sc.y) + sh.y;
    o.z = xv.z * rstd * w.z * (1.f + sc.z) + sh.z;
    o.w = xv.w * rstd * w.w * (1.f + sc.w) + sh.w;
    uint2 ob; ob.x = pk2bf(o.x, o.y); ob.y = pk2bf(o.z, o.w);
    *(uint2*)(out + (size_t)t * DM + d) = ob;
}

struct GemmArgs {
    const float* A; const float* B; float* C; const float* bias;
    int M, N, K, lda, ldb, ldc;
    const int* gather;
    const int* tile_e;
    const int* tile_m0;
    const int* grp_end;
    const int* ntiles;
    long strideB, strideBias;
};

template <int MODE>
__global__ __launch_bounds__(256) void k_gemm(GemmArgs g) {
    __shared__ float As[16][68];
    __shared__ float Bs[16][64];
    __shared__ float Bs2[MODE == 1 ? 16 : 1][64];
    const float* B = g.B; const float* bias = g.bias;
    int m0, mend;
    if (g.tile_e) {
        int ty = blockIdx.y;
        if (ty >= g.ntiles[0]) return;
        int e = g.tile_e[ty];
        m0 = g.tile_m0[ty]; mend = g.grp_end[e];
        B += (size_t)e * g.strideB; if (bias) bias += (size_t)e * g.strideBias;
    } else { m0 = blockIdx.y * 64; mend = g.M; if (m0 >= mend) return; }
    int n0 = blockIdx.x * 64;
    int tx = threadIdx.x & 15, ty_ = threadIdx.x >> 4;
    float acc[4][4], acc2[4][4];
#pragma unroll
    for (int i = 0; i < 4; ++i)
#pragma unroll
        for (int j = 0; j < 4; ++j) { acc[i][j] = 0.f; acc2[i][j] = 0.f; }
    int ar = threadIdx.x >> 2, ak = (threadIdx.x & 3) * 4;
    int arow_slot = m0 + ar; bool avalid = arow_slot < mend;
    long arow = avalid ? (g.gather ? (long)g.gather[arow_slot] : (long)arow_slot) : 0;
    const float* Ap = g.A + arow * g.lda + ak;
    int bk = threadIdx.x >> 4, bn = (threadIdx.x & 15) * 4;
    for (int k0 = 0; k0 < g.K; k0 += 16) {
        float4 av = avalid ? *(const float4*)(Ap + k0) : make_float4(0.f, 0.f, 0.f, 0.f);
        As[ak + 0][ar] = av.x; As[ak + 1][ar] = av.y; As[ak + 2][ar] = av.z; As[ak + 3][ar] = av.w;
        const float* Bp = B + (size_t)(k0 + bk) * g.ldb + n0 + bn;
#pragma unroll
        for (int q = 0; q < 4; ++q) Bs[bk][bn + q] = (n0 + bn + q < g.N) ? Bp[q] : 0.f;
        if (MODE == 1) {
#pragma unroll
            for (int q = 0; q < 4; ++q) Bs2[bk][bn + q] = (n0 + bn + q < g.N) ? Bp[g.N + q] : 0.f;
        }
        __syncthreads();
#pragma unroll
        for (int kk = 0; kk < 16; ++kk) {
            float a[4], b[4];
#pragma unroll
            for (int i = 0; i < 4; ++i) a[i] = As[kk][ty_ * 4 + i];
#pragma unroll
            for (int j = 0; j < 4; ++j) b[j] = Bs[kk][tx * 4 + j];
#pragma unroll
            for (int i = 0; i < 4; ++i)
#pragma unroll
                for (int j = 0; j < 4; ++j) acc[i][j] += a[i] * b[j];
            if (MODE == 1) {
                float b2[4];
#pragma unroll
                for (int j = 0; j < 4; ++j) b2[j] = Bs2[kk][tx * 4 + j];
#pragma unroll
                for (int i = 0; i < 4; ++i)
#pragma unroll
                    for (int j = 0; j < 4; ++j) acc2[i][j] += a[i] * b2[j];
            }
        }
        __syncthreads();
    }
#pragma unroll
    for (int i = 0; i < 4; ++i) {
        int slot = m0 + ty_ * 4 + i;
        if (slot >= mend) continue;
#pragma unroll
        for (int j = 0; j < 4; ++j) {
            int n = n0 + tx * 4 + j;
            if (n >= g.N) continue;
            float v = acc[i][j] + (bias ? bias[n] : 0.f);
            if (MODE == 1) {
                float up = acc2[i][j] + (bias ? bias[g.N + n] : 0.f);
                float gate = fminf(v, 7.f);
                up = fminf(fmaxf(up, -7.f), 7.f);
                v = (up + 1.f) * gate * sigmoidf_(1.702f * gate);
            }
            g.C[(size_t)slot * g.ldc + n] = v;
        }
    }
}

__global__ __launch_bounds__(256) void k_da_prep(const float* __restrict__ p, const float* __restrict__ cs, float* __restrict__ Q, float* __restrict__ K, float* __restrict__ V) {
    int t = blockIdx.x; int b = t / NT, n = t % NT;
    int c = threadIdx.x;
    int h = c >> 6, r = c & 63, d = r & 31;
    const float* pr = p + (size_t)t * DIN;
    size_t o = (((size_t)b * 4 + h) * NT + n) * 64 + r;
    float qv = pr[P_DAQ + c], kv = pr[P_DAK + c];
    if (n >= NC) {
        int pos = n - NC; int j = d & 15;
        float co = cs[(pos * 16 + j) * 2], si = cs[(pos * 16 + j) * 2 + 1];
        int cp = (d < 16) ? c + 16 : c - 16;
        float qo = pr[P_DAQ + cp], ko = pr[P_DAK + cp];
        if (d < 16) { qv = qv * co - qo * si; kv = kv * co - ko * si; }
        else        { qv = qv * co + qo * si; kv = kv * co + ko * si; }
    }
    Q[o] = qv; K[o] = kv; V[o] = pr[P_DAV + c];
}

template <int QKD, int NMAP, int DV, bool DA>
__global__ __launch_bounds__(64) void k_attn(const float* __restrict__ Q, const float* __restrict__ K, const float* __restrict__ V,
                                             float* __restrict__ ycat, int ycat_off, const float* __restrict__ lamfull,
                                             const float* __restrict__ subln, float post_scale, float scale, int with_ctx) {
    constexpr int DK = QKD / NMAP;
    __shared__ float Ks[32][QKD];
    __shared__ float Vs[32][DV];
    int qb = blockIdx.x, h = blockIdx.y, b = blockIdx.z;
    bool isctx = qb < (NC / 64);
    if (isctx && !with_ctx) return;
    int nkeys = isctx ? NC : NT;
    int n = qb * 64 + threadIdx.x;
    size_t base = ((size_t)b * 4 + h) * NT;
    float q[QKD];
    const float* qp = Q + (base + n) * QKD;
#pragma unroll
    for (int d = 0; d < QKD; d += 4) { float4 v = *(const float4*)(qp + d); q[d] = v.x * scale; q[d + 1] = v.y * scale; q[d + 2] = v.z * scale; q[d + 3] = v.w * scale; }
    float acc[NMAP][DV]; float mx[NMAP], l[NMAP];
#pragma unroll
    for (int m = 0; m < NMAP; ++m) { mx[m] = -1e30f; l[m] = 0.f;
#pragma unroll
        for (int d = 0; d < DV; ++d) acc[m][d] = 0.f; }
    for (int k0 = 0; k0 < nkeys; k0 += 32) {
        __syncthreads();
        for (int i = threadIdx.x; i < 32 * QKD / 4; i += 64) {
            int kr = i / (QKD / 4), kc = (i % (QKD / 4)) * 4;
            *(float4*)&Ks[kr][kc] = *(const float4*)(K + (base + k0 + kr) * QKD + kc);
        }
        for (int i = threadIdx.x; i < 32 * DV / 4; i += 64) {
            int kr = i / (DV / 4), kc = (i % (DV / 4)) * 4;
            *(float4*)&Vs[kr][kc] = *(const float4*)(V + (base + k0 + kr) * DV + kc);
        }
        __syncthreads();
        for (int j = 0; j < 32; ++j) {
#pragma unroll
            for (int m = 0; m < NMAP; ++m) {
                float s = 0.f;
#pragma unroll
                for (int d = 0; d < DK; ++d) s += q[m * DK + d] * Ks[j][m * DK + d];
                float mn = fmaxf(mx[m], s);
                float alpha = __expf(mx[m] - mn);
                float pv = __expf(s - mn);
                mx[m] = mn;
                l[m] = l[m] * alpha + pv;
#pragma unroll
                for (int d = 0; d < DV; ++d) acc[m][d] = acc[m][d] * alpha + pv * Vs[j][d];
            }
        }
    }
    float o[DV];
    float c1 = 1.f;
#pragma unroll
    for (int d = 0; d < DV; ++d) o[d] = acc[0][d] / l[0];
    if (NMAP == 2) {
        c1 = -lamfull[0];
#pragma unroll
        for (int d = 0; d < DV; ++d) o[d] += c1 * acc[NMAP - 1][d] / l[NMAP - 1];
    }
    if (DA) {
        float ss = 0.f;
#pragma unroll
        for (int d = 0; d < DV; ++d) ss += o[d] * o[d];
        float rstd = rsqrtf(ss * (1.f / DV) + 1e-6f) * post_scale;
#pragma unroll
        for (int d = 0; d < DV; ++d) o[d] = o[d] * rstd * subln[d];
    }
    float* yp = ycat + ((size_t)b * NT + n) * DM + ycat_off + h * DV;
#pragma unroll
    for (int d = 0; d < DV; d += 4) *(float4*)(yp + d) = make_float4(o[d], o[d + 1], o[d + 2], o[d + 3]);
}

__global__ __launch_bounds__(64) void k_mla_norm(const float* __restrict__ p, const float* __restrict__ qn, const float* __restrict__ kvn,
                                                 float* __restrict__ cqn, float* __restrict__ ckvn) {
    int t = blockIdx.x; int lane = threadIdx.x;
    const float* pr = p + (size_t)t * DIN;
    float v0 = pr[P_CQ + lane], v1 = pr[P_CQ + 64 + lane], v2 = pr[P_CQ + 128 + lane];
    float ss = v0 * v0 + v1 * v1 + v2 * v2;
    for (int o = 32; o > 0; o >>= 1) ss += __shfl_xor(ss, o);
    float r = rsqrtf(ss * (1.f / 192.f) + 1e-6f);
    cqn[(size_t)t * 192 + lane] = v0 * r * qn[lane];
    cqn[(size_t)t * 192 + 64 + lane] = v1 * r * qn[64 + lane];
    cqn[(size_t)t * 192 + 128 + lane] = v2 * r * qn[128 + lane];
    float w0 = pr[P_CKV + lane], w1 = pr[P_CKV + 64 + lane];
    float s2 = w0 * w0 + w1 * w1;
    for (int o = 32; o > 0; o >>= 1) s2 += __shfl_xor(s2, o);
    float r2 = rsqrtf(s2 * (1.f / 128.f) + 1e-6f);
    ckvn[(size_t)t * 128 + lane] = w0 * r2 * kvn[lane];
    ckvn[(size_t)t * 128 + 64 + lane] = w1 * r2 * kvn[64 + lane];
}

__global__ __launch_bounds__(128) void k_mla_layout(const float* __restrict__ p, const float* __restrict__ qfull  , const float* __restrict__ kvfull  ,
                                                    const float* __restrict__ cs, float* __restrict__ Q, float* __restrict__ K, float* __restrict__ V) {
    int t = blockIdx.x; int b = t / NT, n = t % NT;
    const float* pr = p + (size_t)t * DIN;
    const float* qf = qfull + (size_t)t * 384;
    const float* kf = kvfull + (size_t)t * 512;
    for (int i = threadIdx.x; i < 4 * 96; i += 128) {
        int h = i / 96, j = i % 96;
        size_t o = (((size_t)b * 4 + h) * NT + n) * 96 + j;
        float qv, kv;
        if (j < 64) { qv = qf[h * 96 + j]; kv = kf[h * 128 + j]; }
        else {
            int d = j - 64;
            qv = qf[h * 96 + j]; kv = pr[P_KR + d];
            if (n >= NC) {
                int pos = n - NC; int jj = d & 15;
                float co = cs[(pos * 16 + jj) * 2], si = cs[(pos * 16 + jj) * 2 + 1];
                int dp = (d < 16) ? d + 16 : d - 16;
                float qo = qf[h * 96 + 64 + dp], ko = pr[P_KR + dp];
                if (d < 16) { qv = qv * co - qo * si; kv = kv * co - ko * si; }
                else        { qv = qv * co + qo * si; kv = kv * co + ko * si; }
            }
        }
        Q[o] = qv; K[o] = kv;
    }
    for (int i = threadIdx.x; i < 4 * 64; i += 128) {
        int h = i / 64, j = i % 64;
        V[(((size_t)b * 4 + h) * NT + n) * 64 + j] = kf[h * 128 + 64 + j];
    }
}

__global__ __launch_bounds__(256) void k_ml_prep(const float* __restrict__ p, const float* __restrict__ conv_w  , const float* __restrict__ conv_b,
                                                 const float* __restrict__ gate_b, float* __restrict__ qk  , float* __restrict__ G  ) {
    int t = blockIdx.x; int n = t % NT;
    int seg_lo = (n < NC) ? 0 : NC, seg_hi = (n < NC) ? NC - 1 : NT - 1;
    for (int c = threadIdx.x; c < 512; c += 256) {
        float y = conv_b[c];
#pragma unroll
        for (int j = 0; j < 3; ++j) {
            int nn = n + j - 1;
            if (nn >= seg_lo && nn <= seg_hi) y += p[(size_t)(t + j - 1) * DIN + P_MLQK + c] * conv_w[j * 512 + c];
        }
        y = siluf_(y);
        if (c >= 256) y *= 0.125f;
        qk[(size_t)t * 512 + c] = y;
    }
    if (threadIdx.x < 16) {
        int gi = threadIdx.x >> 2;
        float g = p[(size_t)t * DIN + P_MLG + threadIdx.x] + gate_b[threadIdx.x];
        if (gi & 1) g = logsigmoidf_(g);
        G[(size_t)t * 16 + threadIdx.x] = g;
    }
}

__device__ __forceinline__ int seq_token(int s, int dir) {
    if (dir == 0) return s;
    return (s < NC) ? (NC - 1 - s) : (NC + (NT - 1 - s));
}

__global__ __launch_bounds__(256) void k_mlstm(const float* __restrict__ qk, const float* __restrict__ p, const float* __restrict__ G, float* __restrict__ hdir  ) {
    __shared__ float sq[64][64], sk[64][64], sv[64][64], sa[64], sf[64];
    int h = blockIdx.x, b = blockIdx.y, dir = blockIdx.z;
    int tid = threadIdx.x, vrow = tid >> 2, part = tid & 3;
    float C[16], nn[16];
#pragma unroll
    for (int i = 0; i < 16; ++i) { C[i] = 0.f; nn[i] = 0.f; }
    for (int s0 = 0; s0 < NT; s0 += 64) {
        __syncthreads();
        for (int i = tid; i < 64 * 64; i += 256) {
            int j = i >> 6, d = i & 63;
            int n = seq_token(s0 + j, dir);
            size_t t = (size_t)b * NT + n;
            sq[j][d] = qk[t * 512 + h * 64 + d];
            sk[j][d] = qk[t * 512 + 256 + h * 64 + d];
            sv[j][d] = p[t * DIN + P_MLV + h * 64 + d];
        }
        if (tid < 64) {
            int n = seq_token(s0 + tid, dir);
            size_t t = (size_t)b * NT + n;
            sa[tid] = __expf(G[t * 16 + (dir * 2) * 4 + h]);
            sf[tid] = __expf(G[t * 16 + (dir * 2 + 1) * 4 + h]);
        }
        __syncthreads();
        for (int j = 0; j < 64; ++j) {
            float a = sa[j], f = sf[j], vv = sv[j][vrow];
            float av = a * vv;
            float num = 0.f, den = 0.f;
#pragma unroll
            for (int i = 0; i < 16; ++i) {
                float kk = sk[j][part * 16 + i], qq = sq[j][part * 16 + i];
                C[i] = f * C[i] + av * kk;
                nn[i] = f * nn[i] + a * kk;
                num += C[i] * qq; den += nn[i] * qq;
            }
            num += __shfl_xor(num, 1); num += __shfl_xor(num, 2);
            den += __shfl_xor(den, 1); den += __shfl_xor(den, 2);
            if (part == 0) {
                int n = seq_token(s0 + j, dir);
                hdir[((size_t)dir * TT + (size_t)b * NT + n) * 256 + h * 64 + vrow] = num / fmaxf(fabsf(den), 1.f);
            }
        }
    }
}

__global__ __launch_bounds__(256) void k_ml_finish(const float* __restrict__ p, const float* __restrict__ hdir, const float* __restrict__ ml_norm, bf16_t* __restrict__ ycat) {
    int t = blockIdx.x; int c = threadIdx.x;
    float o = p[(size_t)t * DIN + P_MLO + c];
    float hv = sigmoidf_(o) * (hdir[(size_t)t * 256 + c] + hdir[((size_t)TT + t) * 256 + c]);
    float ss = hv * hv;
    for (int off = 32; off > 0; off >>= 1) ss += __shfl_xor(ss, off);
    float r = rsqrtf(ss * (1.f / 64.f) + 1e-6f);
    ycat[(size_t)t * DM + 256 + c] = f2bf(hv * r * ml_norm[c]);
}

__global__ __launch_bounds__(64) void k_s5_scan(const float* __restrict__ p, const float* __restrict__ abr, const float* __restrict__ abi,
                                                const float* __restrict__ bbr, const float* __restrict__ bbi,
                                                const float* __restrict__ c_re, const float* __restrict__ c_im, float* __restrict__ ys5  ) {
    __shared__ float su[64][16];
    __shared__ float xs[64][129];
    __shared__ float cr[16][64], ci[16][64];
    int g = blockIdx.x, b = blockIdx.y, dir = blockIdx.z;
    int lane = threadIdx.x;
    int sidx = (dir * 16 + g) * 64 + lane;
    float ar = abr[sidx], ai = abi[sidx];
    float br[16], bi[16];
#pragma unroll
    for (int h = 0; h < 16; ++h) { br[h] = bbr[(size_t)sidx * 16 + h]; bi[h] = bbi[(size_t)sidx * 16 + h]; }
    for (int i = lane; i < 16 * 64; i += 64) { cr[i >> 6][i & 63] = c_re[(size_t)(dir * 16 + g) * 1024 + i]; ci[i >> 6][i & 63] = c_im[(size_t)(dir * 16 + g) * 1024 + i]; }
    float xr = 0.f, xi = 0.f;
    for (int s0 = 0; s0 < NT; s0 += 64) {
        __syncthreads();
        for (int i = lane; i < 64 * 16; i += 64) {
            int j = i >> 4, hh = i & 15;
            int n = seq_token(s0 + j, dir);
            su[j][hh] = p[((size_t)b * NT + n) * DIN + P_S5 + g * 16 + hh];
        }
        __syncthreads();
#pragma unroll 1
        for (int j = 0; j < 64; ++j) {
            float ur = 0.f, ui = 0.f;
#pragma unroll
            for (int hh = 0; hh < 16; ++hh) { float u = su[j][hh]; ur += br[hh] * u; ui += bi[hh] * u; }
            float nr = ar * xr - ai * xi + ur;
            float ni = ar * xi + ai * xr + ui;
            xr = nr; xi = ni;
            xs[j][lane] = xr; xs[j][64 + lane] = xi;
        }
        __syncthreads();
        {
            int n = seq_token(s0 + lane, dir);
            float* yp = ys5 + ((size_t)dir * TT + (size_t)b * NT + n) * 256 + g * 16;
#pragma unroll 1
            for (int hh = 0; hh < 16; ++hh) {
                float y = 0.f;
#pragma unroll 4
                for (int pp = 0; pp < 64; ++pp) y += cr[hh][pp] * xs[lane][pp] - ci[hh][pp] * xs[lane][64 + pp];
                yp[hh] = y;
            }
        }
    }
}

__device__ __forceinline__ float gelu_tanh_(float x) {
    float u = 0.7978845608028654f * (x + 0.044715f * x * x * x);
    return 0.5f * x * (1.f + tanhf(u));
}
__global__ __launch_bounds__(256) void k_s5_gelu(const float* __restrict__ p, const float* __restrict__ ys5, const float* __restrict__ dsk, float* __restrict__ gl  ) {
    int t = blockIdx.x, c = threadIdx.x;
    float y = ys5[(size_t)t * 256 + c] + ys5[((size_t)TT + t) * 256 + c] + p[(size_t)t * DIN + P_S5 + c] * dsk[c];
    gl[(size_t)t * 256 + c] = gelu_tanh_(y);
}
__global__ __launch_bounds__(256) void k_s5_glu(const float* __restrict__ gl, const float* __restrict__ z, bf16_t* __restrict__ ycat) {
    int t = blockIdx.x, c = threadIdx.x;
    ycat[(size_t)t * DM + 768 + c] = f2bf(gl[(size_t)t * 256 + c] * sigmoidf_(z[(size_t)t * 256 + c]));
}

__global__ __launch_bounds__(256) void k_post1(float* __restrict__ xall, const float* __restrict__ o, const float* __restrict__ nw1, const float* __restrict__ nw2,
                                               const float* __restrict__ modl, const float* __restrict__ w_router  , const float* __restrict__ b_router,
                                               float* __restrict__ f, int* __restrict__ top_e  , float* __restrict__ top_g  , int* __restrict__ cnt,
                                               int* __restrict__ pos  , int with_ctx) {
    __shared__ float red[8];
    __shared__ float lg[4][32];
    int t = blockIdx.x; int b = t / NT, n = t % NT;
    if (n < NC && !with_ctx) return;
    int r = (n < NC) ? 8 : b;
    const float* mr = modl + (size_t)r * 6144;
    int d = threadIdx.x * 4;
    float4 ov = *(const float4*)(o + (size_t)t * DM + d);
    float ss = ov.x * ov.x + ov.y * ov.y + ov.z * ov.z + ov.w * ov.w;
    ss = block_sum_256(ss, red);
    float rstd = rsqrtf(ss * (1.f / DM) + 1e-6f);
    float4 xv = *(const float4*)(xall + (size_t)t * DM + d);
    float4 w1 = *(const float4*)(nw1 + d);
    float4 g1 = *(const float4*)(mr + 2048 + d);
    xv.x += g1.x * ov.x * rstd * w1.x; xv.y += g1.y * ov.y * rstd * w1.y; xv.z += g1.z * ov.z * rstd * w1.z; xv.w += g1.w * ov.w * rstd * w1.w;
    *(float4*)(xall + (size_t)t * DM + d) = xv;
    float s2 = xv.x * xv.x + xv.y * xv.y + xv.z * xv.z + xv.w * xv.w;
    s2 = block_sum_256(s2, red);
    float rstd2 = rsqrtf(s2 * (1.f / DM) + 1e-6f);
    float4 w2 = *(const float4*)(nw2 + d);
    float4 sh = *(const float4*)(mr + 3072 + d);
    float4 sc = *(const float4*)(mr + 4096 + d);
    float fv[4];
    fv[0] = xv.x * rstd2 * w2.x * (1.f + sc.x) + sh.x;
    fv[1] = xv.y * rstd2 * w2.y * (1.f + sc.y) + sh.y;
    fv[2] = xv.z * rstd2 * w2.z * (1.f + sc.z) + sh.z;
    fv[3] = xv.w * rstd2 * w2.w * (1.f + sc.w) + sh.w;
    *(float4*)(f + (size_t)t * DM + d) = make_float4(fv[0], fv[1], fv[2], fv[3]);
    float part[32];
#pragma unroll
    for (int e = 0; e < 32; ++e) part[e] = 0.f;
#pragma unroll
    for (int q = 0; q < 4; ++q) {
        const float* wr = w_router + (size_t)(d + q) * 32;
#pragma unroll
        for (int e = 0; e < 32; ++e) part[e] += fv[q] * wr[e];
    }
#pragma unroll
    for (int e = 0; e < 32; ++e) {
        float v = part[e];
        for (int off = 32; off > 0; off >>= 1) v += __shfl_xor(v, off);
        part[e] = v;
    }
    __syncthreads();
    if ((threadIdx.x & 63) == 0) {
#pragma unroll
        for (int e = 0; e < 32; ++e) lg[threadIdx.x >> 6][e] = part[e];
    }
    __syncthreads();
    if (threadIdx.x < 32) lg[0][threadIdx.x] = lg[0][threadIdx.x] + lg[1][threadIdx.x] + lg[2][threadIdx.x] + lg[3][threadIdx.x] + b_router[threadIdx.x];
    __syncthreads();
    if (threadIdx.x == 0) {
        unsigned used = 0;
        int s0 = 0, s1 = 0, s2_ = 0, s3 = 0; float v0 = 0.f, v1 = 0.f, v2 = 0.f, v3 = 0.f;
        for (int k = 0; k < 4; ++k) {
            int best = 0; float bv = -3.4e38f;
            for (int e = 0; e < 32; ++e) { float lv = lg[0][e]; if (!((used >> e) & 1u) && lv > bv) { bv = lv; best = e; } }
            used |= 1u << best;
            if (k == 0) { s0 = best; v0 = bv; } else if (k == 1) { s1 = best; v1 = bv; } else if (k == 2) { s2_ = best; v2 = bv; } else { s3 = best; v3 = bv; }
        }
        float e0 = 1.f, e1 = __expf(v1 - v0), e2 = __expf(v2 - v0), e3 = __expf(v3 - v0);
        float inv = 1.f / (e0 + e1 + e2 + e3);
        top_e[(size_t)t * 4 + 0] = s0; top_e[(size_t)t * 4 + 1] = s1; top_e[(size_t)t * 4 + 2] = s2_; top_e[(size_t)t * 4 + 3] = s3;
        top_g[(size_t)t * 4 + 0] = e0 * inv; top_g[(size_t)t * 4 + 1] = e1 * inv; top_g[(size_t)t * 4 + 2] = e2 * inv; top_g[(size_t)t * 4 + 3] = e3 * inv;
        pos[(size_t)t * 4 + 0] = atomicAdd(&cnt[s0], 1); pos[(size_t)t * 4 + 1] = atomicAdd(&cnt[s1], 1);
        pos[(size_t)t * 4 + 2] = atomicAdd(&cnt[s2_], 1); pos[(size_t)t * 4 + 3] = atomicAdd(&cnt[s3], 1);
    }
}

__global__ void k_moe_offsets(const int* __restrict__ cnt, int* __restrict__ off, int* __restrict__ tile_e, int* __restrict__ ntiles) {
    if (threadIdx.x != 0) return;
    int o = 0, nt = 0;
    for (int e = 0; e < NE; ++e) {
        off[e] = o; int c = cnt[e];
        for (int m = 0; m < c; m += 256) { tile_e[nt] = e; ++nt; }
        o = nt * 256;
    }
    ntiles[0] = nt;
}
__global__ void k_moe_scatter(const int* __restrict__ top_e, const int* __restrict__ pos, const int* __restrict__ off, int* __restrict__ slot_token, int* __restrict__ tok_slot, int with_ctx) {
    int i = blockIdx.x * 256 + threadIdx.x;
    if (i >= NASSIGN) return;
    int t = i >> 2; int n = t % NT;
    if (n < NC && !with_ctx) return;
    int slot = off[top_e[i]] + pos[i];
    slot_token[slot] = t; tok_slot[i] = slot;
}

__global__ __launch_bounds__(256) void k_combine(float* __restrict__ xall, const float* __restrict__ yexp, const int* __restrict__ tok_slot, const float* __restrict__ top_g,
                                                 const float* __restrict__ nw3, const float* __restrict__ modl, int with_ctx) {
    __shared__ float red[8];
    int t = blockIdx.x; int b = t / NT, n = t % NT;
    if (n < NC && !with_ctx) return;
    int r = (n < NC) ? 8 : b;
    int d = threadIdx.x * 4;
    float4 m = make_float4(0.f, 0.f, 0.f, 0.f);
#pragma unroll
    for (int k = 0; k < 4; ++k) {
        int slot = tok_slot[(size_t)t * 4 + k]; float gk = top_g[(size_t)t * 4 + k];
        float4 y = *(const float4*)(yexp + (size_t)slot * DM + d);
        m.x += gk * y.x; m.y += gk * y.y; m.z += gk * y.z; m.w += gk * y.w;
    }
    float ss = m.x * m.x + m.y * m.y + m.z * m.z + m.w * m.w;
    ss = block_sum_256(ss, red);
    float rstd = rsqrtf(ss * (1.f / DM) + 1e-6f);
    float4 w3 = *(const float4*)(nw3 + d);
    float4 g2 = *(const float4*)(modl + (size_t)r * 6144 + 5120 + d);
    float4 xv = *(const float4*)(xall + (size_t)t * DM + d);
    xv.x += g2.x * m.x * rstd * w3.x; xv.y += g2.y * m.y * rstd * w3.y; xv.z += g2.z * m.z * rstd * w3.z; xv.w += g2.w * m.w * rstd * w3.w;
    *(float4*)(xall + (size_t)t * DM + d) = xv;
}

__global__ void k_out(const float* __restrict__ xall, float* __restrict__ out) {
    size_t i = (size_t)blockIdx.x * 256 + threadIdx.x;
    size_t total = (size_t)NB * NS * DM / 4;
    if (i >= total) return;
    size_t t = i / (DM / 4); int d4 = (int)(i % (DM / 4));
    int b = (int)(t / NS), n = (int)(t % NS);
    ((float4*)out)[i] = ((const float4*)(xall + ((size_t)b * NT + NC + n) * DM))[d4];
}

static void launch_gemm(hipStream_t st, const float* A, int lda, const float* B, int ldb, float* C, int ldc, const float* bias, int M, int N, int K) {
    GemmArgs g{}; g.A = A; g.B = B; g.C = C; g.bias = bias; g.M = M; g.N = N; g.K = K; g.lda = lda; g.ldb = ldb; g.ldc = ldc;
    dim3 grid((N + 63) / 64, (M + 63) / 64);
    k_gemm<0><<<grid, 256, 0, st>>>(g);
}

extern "C" void kernel_launch(void* const* d_in, const int* in_sizes, int n_in, void* d_out, int out_size, void* d_ws, size_t ws_size, hipStream_t stream) {
    const float* x = (const float*)d_in[0]; const float* c = (const float*)d_in[1]; const float* ctx = (const float*)d_in[2]; const float* c_ctx = (const float*)d_in[3];
    const float* w_mod = (const float*)d_in[4]; const float* b_mod = (const float*)d_in[5]; const float* norm_w = (const float*)d_in[6];
    const float* w_in = (const float*)d_in[7]; const float* w_out = (const float*)d_in[8]; const float* da_lambda = (const float*)d_in[9]; const float* da_subln = (const float*)d_in[10];
    const float* ml_conv_w = (const float*)d_in[11]; const float* ml_conv_b = (const float*)d_in[12]; const float* ml_gate_b = (const float*)d_in[13]; const float* ml_norm = (const float*)d_in[14];
    const float* mla_q_norm = (const float*)d_in[15]; const float* mla_w_uq = (const float*)d_in[16]; const float* mla_kv_norm = (const float*)d_in[17]; const float* mla_w_ukv = (const float*)d_in[18];
    const float* s5_a_re = (const float*)d_in[19]; const float* s5_a_im = (const float*)d_in[20]; const float* s5_log_step = (const float*)d_in[21];
    const float* s5_b_re = (const float*)d_in[22]; const float* s5_b_im = (const float*)d_in[23]; const float* s5_c_re = (const float*)d_in[24]; const float* s5_c_im = (const float*)d_in[25];
    const float* s5_d = (const float*)d_in[26]; const float* s5_w_glu = (const float*)d_in[27]; const float* s5_b_glu = (const float*)d_in[28];
    const float* moe_w_router = (const float*)d_in[29]; const float* moe_b_router = (const float*)d_in[30]; const float* moe_w_gate_up = (const float*)d_in[31];
    const float* moe_b_gate_up = (const float*)d_in[32]; const float* moe_w_down = (const float*)d_in[33]; const float* moe_b_down = (const float*)d_in[34];
    float* out = (float*)d_out;

    char* ws = (char*)d_ws; size_t off = 0;
    auto carve = [&](size_t bytes) { void* p = ws + off; off += (bytes + 255) & ~(size_t)255; return p; };
    float* xall = (float*)carve((size_t)TT * DM * 4);
    float* mod = (float*)carve((size_t)2 * 9 * 6144 * 4);
    float* ropecs = (float*)carve((size_t)NS * 16 * 2 * 4);
    float* lamfull = (float*)carve(256);
    float* abr = (float*)carve(4096 * 4); float* abi = (float*)carve(4096 * 4);
    float* bbr = (float*)carve(4096 * 16 * 4); float* bbi = (float*)carve(4096 * 16 * 4);
    bf16_t* w_in_t = (bf16_t*)carve((size_t)2 * 2560 * 1024 * 2);
    bf16_t* w_out_t = (bf16_t*)carve((size_t)2 * 1024 * 1024 * 2);
    bf16_t* wgu_t = (bf16_t*)carve((size_t)2 * NE * 2048 * 1024 * 2);
    bf16_t* wdn_t = (bf16_t*)carve((size_t)2 * NE * 1024 * 1024 * 2);
    bf16_t* s5KmT = (bf16_t*)carve((size_t)64 * 16 * 1024 * 2); bf16_t* s5Smat = (bf16_t*)carve((size_t)64 * 128 * 1024 * 2); bf16_t* s5CmT = (bf16_t*)carve((size_t)64 * 16 * 128 * 2);
    float* s5A = (float*)carve(64 * 64 * 2 * 4); float* s5A64 = (float*)carve(64 * 64 * 2 * 4); float* s5xs = (float*)carve((size_t)256 * 36 * 128 * 4);
    bf16_t* hbuf = (bf16_t*)carve((size_t)TT * DM * 2);
    bf16_t* ycatb = (bf16_t*)carve((size_t)TT * DM * 2);
    float* obuf = (float*)carve((size_t)TT * DM * 4);
    float* fbuf = (float*)carve((size_t)TT * DM * 4);
    int* top_e = (int*)carve((size_t)NASSIGN * 4); float* top_g = (float*)carve((size_t)NASSIGN * 4); int* posb = (int*)carve((size_t)NASSIGN * 4);
    int* tok_slot = (int*)carve((size_t)NASSIGN * 4); int* slot_token = (int*)carve((size_t)MAXSLOTS * 4);
    int* cnt = (int*)carve(256); int* offs = (int*)carve(256); int* ntiles = (int*)carve(256);
    int* tile_e = (int*)carve(512 * 4);
    bf16_t* act = (bf16_t*)carve((size_t)MAXSLOTS * DM * 2);
    size_t zone0 = off;
    float* p = (float*)carve((size_t)TT * DIN * 4);
    bf16_t* daQ = (bf16_t*)carve((size_t)TT * 256 * 2); bf16_t* daK = (bf16_t*)carve((size_t)TT * 256 * 2); bf16_t* daV = (bf16_t*)carve((size_t)TT * 256 * 2);
    float* cqn = (float*)carve((size_t)TT * 192 * 4); float* ckvn = (float*)carve((size_t)TT * 128 * 4);
    float* qfull = (float*)carve((size_t)TT * 384 * 4); float* kvfull = (float*)carve((size_t)TT * 512 * 4);
    bf16_t* mQ = (bf16_t*)carve((size_t)TT * 384 * 2); bf16_t* mK = (bf16_t*)carve((size_t)TT * 384 * 2); bf16_t* mV = (bf16_t*)carve((size_t)TT * 256 * 2);
    bf16_t* mlQ = (bf16_t*)carve((size_t)TT * 256 * 2); bf16_t* mlK = (bf16_t*)carve((size_t)TT * 256 * 2); bf16_t* mlKt = (bf16_t*)carve((size_t)TT * 256 * 2); bf16_t* mlVt = (bf16_t*)carve((size_t)TT * 256 * 2);
    float* mlG = (float*)carve((size_t)TT * 16 * 4); float* hdir = (float*)carve((size_t)2 * TT * 256 * 4);
    float* ys5 = (float*)carve((size_t)2 * TT * 256 * 4); float* gl = (float*)carve((size_t)TT * 256 * 4); float* zglu = (float*)carve((size_t)TT * 256 * 4);
    size_t zone1 = off;
    float* yexp = (float*)(ws + zone0);
    bf16_t* xg = (bf16_t*)(ws + zone0 + (size_t)MAXSLOTS * DM * 4);
    if (zone0 + (size_t)MAXSLOTS * DM * 6 > zone1) off = zone0 + (size_t)MAXSLOTS * DM * 6;
    if (off > ws_size) { fprintf(stderr, "workspace too small: need %zu have %zu\n", off, ws_size); return; }

    static bool attr_done = false;
    if (!attr_done) {
        (void)hipFuncSetAttribute((const void*)k_pg8_static<pg8::EpiF32>, hipFuncAttributeMaxDynamicSharedMemorySize, pg8::STAGE_BYTES);
        (void)hipFuncSetAttribute((const void*)k_pg8_grouped<pg8::EpiSwiglu>, hipFuncAttributeMaxDynamicSharedMemorySize, pg8::STAGE_BYTES);
        (void)hipFuncSetAttribute((const void*)k_pg8_grouped<pg8::EpiDown>, hipFuncAttributeMaxDynamicSharedMemorySize, pg8::STAGE_BYTES);
        (void)hipFuncSetAttribute((const void*)k_mlstm_mfma, hipFuncAttributeMaxDynamicSharedMemorySize, ML_LDS_BYTES);
        (void)hipFuncSetAttribute((const void*)k_s5_mfma, hipFuncAttributeMaxDynamicSharedMemorySize, S5_LDS_BYTES);
        attr_done = true;
    }

    k_build_x<<<(TT * DM / 4 + 255) / 256, 256, 0, stream>>>(x, ctx, xall);
    k_mod<<<2 * 6144 / 256, 256, 0, stream>>>(c, c_ctx, w_mod, b_mod, mod);
    k_rope_table<<<NS * 16 / 256, 256, 0, stream>>>(ropecs);
    k_lambda<<<1, 64, 0, stream>>>(da_lambda, lamfull);
    k_s5_setup<<<64, 256, 0, stream>>>(s5_a_re, s5_a_im, s5_log_step, s5_b_re, s5_b_im, s5_c_re, s5_c_im, s5KmT, s5Smat, s5CmT, s5A, s5A64);
    (void)hipMemsetAsync(w_in_t, 0, (size_t)2 * 2560 * 1024 * 2, stream);
    k_convT<0><<<dim3((DINC + 63) / 64, 16, 2), 256, 0, stream>>>(w_in, 1024, DINC, w_in_t, 1024, 0, 0, (long)1024 * DINC, (long)2560 * 1024);
    k_convT<0><<<dim3(16, 16, 2), 256, 0, stream>>>(w_out, 1024, 1024, w_out_t, 1024, 0, 0, (long)1024 * 1024, (long)1024 * 1024);
    k_convT<1><<<dim3(32, 16, 2 * NE), 256, 0, stream>>>(moe_w_gate_up, 1024, 2048, wgu_t, 1024, 0, 0, (long)1024 * 2048, (long)2048 * 1024);
    k_convT<0><<<dim3(16, 16, 2 * NE), 256, 0, stream>>>(moe_w_down, 1024, 1024, wdn_t, 1024, 0, 0, (long)1024 * 1024, (long)1024 * 1024);

    for (int l = 0; l < 2; ++l) {
        int with_ctx = (l == 0);
        float lambda_init = (float)(0.8 - 0.6 * exp(-0.3 * l));
        const float* modl = mod + (size_t)l * 9 * 6144;
        const float* nw = norm_w + (size_t)l * 4 * 1024;
        k_norm_mod<<<TT, 256, 0, stream>>>(xall, nw, modl, 0, 1024, hbuf);
        {
            pg8::Gemm g{hbuf, w_in_t + (size_t)l * 2560 * 1024, TT, 2560, 1024, 0};
            pg8::EpiF32 E{p, nullptr, DIN, 0};
            k_pg8_static<pg8::EpiF32><<<256, 512, pg8::STAGE_BYTES, stream>>>(g, E);
        }
        k_da_prep2<<<TT / 64, 256, 0, stream>>>(p, ropecs, daQ, daK, daV, 0.17677669529663687f * 1.4426950408889634f);
        k_attn_mfma<64, 2, true><<<dim3(9, 4, NB), 512, ATT_LDS_BYTES, stream>>>(daQ, daK, daV, ycatb, 0, lamfull + l, da_subln + l * 64, 1.f - lambda_init, with_ctx);
        k_mla_norm<<<TT, 64, 0, stream>>>(p, mla_q_norm + l * 192, mla_kv_norm + l * 128, cqn, ckvn);
        launch_gemm(stream, cqn, 192, mla_w_uq + (size_t)l * 192 * 384, 384, qfull, 384, nullptr, TT, 384, 192);
        launch_gemm(stream, ckvn, 128, mla_w_ukv + (size_t)l * 128 * 512, 512, kvfull, 512, nullptr, TT, 512, 128);
        k_mla_layout2<<<TT / 64, 256, 0, stream>>>(p, qfull, kvfull, ropecs, mQ, mK, mV, 0.10206207261596575f * 1.4426950408889634f);
        k_attn_mfma<96, 1, false><<<dim3(9, 4, NB), 512, ATT_LDS_BYTES, stream>>>(mQ, mK, mV, ycatb, 512, lamfull, nullptr, 1.f, with_ctx);
        k_ml_prep2<<<TT / 64, 256, 0, stream>>>(p, ml_conv_w + l * 3 * 512, ml_conv_b + l * 512, ml_gate_b + l * 16, mlQ, mlK, mlKt, mlVt, mlG);
        k_mlstm_mfma<<<dim3(4, NB, 2), 512, ML_LDS_BYTES, stream>>>(mlQ, mlK, mlKt, mlVt, mlG, hdir);
        k_ml_finish<<<TT, 256, 0, stream>>>(p, hdir, ml_norm + l * 256, ycatb);
        k_s5_mfma<<<dim3(16, NB, 2), 512, S5_LDS_BYTES, stream>>>(p, s5KmT + (size_t)l * 32 * 16 * 1024, s5Smat + (size_t)l * 32 * 128 * 1024, s5CmT + (size_t)l * 32 * 16 * 128,
                                                                  s5A + l * 32 * 64 * 2, s5A64 + l * 32 * 64 * 2, s5xs, ys5);
        k_s5_gelu<<<TT, 256, 0, stream>>>(p, ys5, s5_d + l * 256, gl);
        launch_gemm(stream, gl, 256, s5_w_glu + (size_t)l * 256 * 256, 256, zglu, 256, s5_b_glu + l * 256, TT, 256, 256);
        k_s5_glu<<<TT, 256, 0, stream>>>(gl, zglu, ycatb);
        {
            pg8::Gemm g{ycatb, w_out_t + (size_t)l * 1024 * 1024, TT, 1024, 1024, 0};
            pg8::EpiF32 E{obuf, nullptr, DM, 0};
            k_pg8_static<pg8::EpiF32><<<256, 512, pg8::STAGE_BYTES, stream>>>(g, E);
        }
        (void)hipMemsetAsync(cnt, 0, 128, stream);
        (void)hipMemsetAsync(slot_token, 0xFF, (size_t)MAXSLOTS * 4, stream);
        k_post1<<<TT, 256, 0, stream>>>(xall, obuf, nw + 1024, nw + 2048, modl, moe_w_router + (size_t)l * 1024 * 32, moe_b_router + l * 32, fbuf, top_e, top_g, cnt, posb, with_ctx);
        k_moe_offsets<<<1, 64, 0, stream>>>(cnt, offs, tile_e, ntiles);
        k_moe_scatter<<<NASSIGN / 256, 256, 0, stream>>>(top_e, posb, offs, slot_token, tok_slot, with_ctx);
        k_moe_gather<<<MAXSLOTS, 256, 0, stream>>>(fbuf, slot_token, ntiles, xg);
        {
            pg8::Gemm g{xg, wgu_t + (size_t)l * NE * 2048 * 1024, 0, 2048, 1024, 0};
            pg8::EpiSwiglu E{act, moe_b_gate_up + (size_t)l * NE * 2048};
            k_pg8_grouped<pg8::EpiSwiglu><<<256, 512, pg8::STAGE_BYTES, stream>>>(g, E, ntiles, tile_e);
        }
        {
            pg8::Gemm g{act, wdn_t + (size_t)l * NE * 1024 * 1024, 0, 1024, 1024, 0};
            pg8::EpiDown E{yexp, moe_b_down + (size_t)l * NE * 1024};
            k_pg8_grouped<pg8::EpiDown><<<256, 512, pg8::STAGE_BYTES, stream>>>(g, E, ntiles, tile_e);
        }
        k_combine<<<TT, 256, 0, stream>>>(xall, yexp, tok_slot, top_g, nw + 3072, modl, with_ctx);
    }
    k_out<<<(NB * NS * DM / 4 + 255) / 256, 256, 0, stream>>>(xall, out);
}
```

```cpp
#include <hip/hip_runtime.h>
#include <cstdint>
#include <cstdio>

#define NB 8
#define NS 2048
#define NC 256
#define NT 2304
#define TT (NB * NT)
#define DM 1024
#define DIN 2560
#define DINC 2416
#define NE 32
#define NASSIGN (TT * 4)
#define MAXSLOTS (NASSIGN + NE * 256)

#define P_DAQ 0
#define P_DAK 256
#define P_DAV 512
#define P_MLQK 768
#define P_MLV 1280
#define P_MLO 1536
#define P_MLG 1792
#define P_CQ 1808
#define P_CKV 2000
#define P_KR 2128
#define P_S5 2160

#ifndef MK_ONE_LAUNCH
#define MK_ONE_LAUNCH 1
#endif

typedef unsigned short bf16_t;
__device__ __forceinline__ float sigmoidf_(float x) { return 1.f / (1.f + __expf(-x)); }
__device__ __forceinline__ float siluf_(float x) { return x / (1.f + __expf(-x)); }
__device__ __forceinline__ float logsigmoidf_(float x) { return fminf(x, 0.f) - log1pf(__expf(-fabsf(x))); }
__device__ __forceinline__ float gelu_tanh_(float x) { const float u = 0.7978845608028654f * (x + 0.044715f * x * x * x); return 0.5f * x * (1.f + tanhf(u)); }
typedef __bf16 bf16x2_nat __attribute__((ext_vector_type(2)));
typedef float f32x2_nat __attribute__((ext_vector_type(2)));
__device__ __forceinline__ unsigned cvtpk(float lo, float hi) { const f32x2_nat v = {lo, hi}; const bf16x2_nat b = __builtin_convertvector(v, bf16x2_nat); return __builtin_bit_cast(unsigned, b); }
__device__ __forceinline__ bf16_t f2bf(float f) { return (bf16_t)(cvtpk(f, 0.f) & 0xFFFFu); }
__device__ __forceinline__ float bf2f(bf16_t b) { return __uint_as_float(((unsigned)b) << 16); }
__device__ __forceinline__ unsigned pk2bf(float lo, float hi) { return cvtpk(lo, hi); }
__device__ __forceinline__ int opaque_tid() { int t = threadIdx.x; asm volatile("" : "+v"(t)); return t; }
__device__ __forceinline__ float wave_sum(float v) {
#pragma unroll
    for (int o = 32; o > 0; o >>= 1) v += __shfl_xor(v, o);
    return v;
}
__device__ __forceinline__ int seq_token(int s, int dir) {
    if (dir == 0) return s;
    return (s < NC) ? (NC - 1 - s) : (NC + (NT - 1 - s));
}

namespace pg8 {
#define PG8_LAS __attribute__((address_space(3)))
typedef short bf16x8 __attribute__((ext_vector_type(8)));
typedef float f32x4 __attribute__((ext_vector_type(4)));
typedef unsigned u32x4 __attribute__((ext_vector_type(4)));
constexpr int BM = 256, BK = 64, HALF = 128, HTB = HALF * BK * 2, STAGE_BYTES = 8 * HTB, NXCD = 8, WGM = 8;
__host__ __device__ __forceinline__ int lds_byte(int r, int c) { const int st = (r >> 4) * 2 + (c >> 5), rr = r & 15, cc = c & 31, ob = rr * 64 + cc * 2; return st * 1024 + (ob ^ (((ob >> 9) & 1) << 5)); }
__host__ __device__ __forceinline__ void stage_rc(int b, int& R, int& C) { const int st = b / 1024, sb = b % 1024, swz = sb ^ (((sb >> 9) & 1) << 5); R = (st >> 1) * 16 + swz / 64; C = (st & 1) * 32 + (swz % 64) / 2; }
__host__ __device__ __forceinline__ int perm32(int rho) { const int n = rho >> 4, i = rho & 15; return 8 * (i >> 2) + 4 * n + (i & 3); }
struct Unit { int pm, pn; };
struct Gemm { const bf16_t* A; const bf16_t* Bt; int M, N, K, pad; };
__device__ __forceinline__ unsigned cvt_pk_bf16(float lo, float hi) { return cvtpk(lo, hi); }

struct StaticOrder {
    int nM, nN, nwg, G, c;
    __device__ void init(int M, int N, int G_, int c_) { nM = M / BM; nN = N / BM; nwg = nM * nN; G = G_; c = c_; }
    __device__ bool next(int i, Unit& u) const {
        const long L = (long)i * G + c; if (L >= nwg) return false;
        int wgid = (int)L; { const int q = nwg / NXCD, r = nwg % NXCD, xcd = wgid % NXCD, off = wgid / NXCD; wgid = (xcd < r ? xcd * (q + 1) : r * (q + 1) + (xcd - r) * q) + off; }
        const int nig = WGM * nN, gid = wgid / nig, fm = gid * WGM, gsz = (nM - fm) < WGM ? (nM - fm) : WGM;
        u.pm = fm + ((wgid % nig) % gsz); u.pn = (wgid % nig) / gsz; return true;
    }
    __device__ __forceinline__ void a_ready(const Unit&) const {}
    __device__ __forceinline__ void done(const Unit&) const {}
};
struct LatOrder : StaticOrder {
    __device__ void initl(int N, int G_, int c_) { nM = 64; nN = N / BM; nwg = nM * nN; G = G_; c = c_; }
    __device__ bool next(int i, Unit& u) const { if (!StaticOrder::next(i, u)) return false; u.pm = (u.pm >> 3) * 9 + 1 + (u.pm & 7); return true; }
};
struct GroupedOrder : StaticOrder {
    const int* tile_e;
    __device__ void initg(const int* ntiles_p, const int* tile_e_, int N, int G_, int c_) { nM = ntiles_p[0]; nN = N / BM; nwg = nM * nN; G = G_; c = c_; tile_e = tile_e_; }
    __device__ bool next(int i, Unit& u) const { if (!StaticOrder::next(i, u)) return false; u.pn += tile_e[u.pm] * nN; return true; }
};

struct EpiBf16P {
    static constexpr bool PERM = true;
    bf16_t* O; int ldc, pad;
    __device__ __forceinline__ void operator()(const f32x4 (&acc)[2][2][4][2], const Unit& u, int wr, int wc, int fr, int fq) const {
        const int row0 = u.pm * BM + wr * 64 + fr, col0 = u.pn * BM + wc * 32 + 8 * fq;
#pragma unroll
        for (int ai = 0; ai < 2; ++ai)
#pragma unroll
            for (int m = 0; m < 4; ++m) { bf16_t* rowp = O + (size_t)(row0 + ai * HALF + m * 16) * ldc + col0;
#pragma unroll
                for (int bj = 0; bj < 2; ++bj) { const f32x4 v0 = acc[ai][bj][m][0], v1 = acc[ai][bj][m][1];
                    u32x4 w; w.x = cvt_pk_bf16(v0[0], v0[1]); w.y = cvt_pk_bf16(v0[2], v0[3]); w.z = cvt_pk_bf16(v1[0], v1[1]); w.w = cvt_pk_bf16(v1[2], v1[3]);
                    *(u32x4*)(rowp + bj * HALF) = w; } }
    }
};
struct EpiOut {
    static constexpr bool PERM = true;
    bf16_t* O; float* osq;
    __device__ __forceinline__ void operator()(const f32x4 (&acc)[2][2][4][2], const Unit& u, int wr, int wc, int fr, int fq) const {
        const int row0 = u.pm * BM + wr * 64 + fr, col0 = u.pn * BM + wc * 32 + 8 * fq;
#pragma unroll
        for (int ai = 0; ai < 2; ++ai)
#pragma unroll
            for (int m = 0; m < 4; ++m) { const int row = row0 + ai * HALF + m * 16; bf16_t* rowp = O + (size_t)row * 1024 + col0; float ss = 0.f;
#pragma unroll
                for (int bj = 0; bj < 2; ++bj) { const f32x4 v0 = acc[ai][bj][m][0], v1 = acc[ai][bj][m][1];
                    ss += (v0[0] * v0[0] + v0[1] * v0[1]) + (v0[2] * v0[2] + v0[3] * v0[3]) + (v1[0] * v1[0] + v1[1] * v1[1]) + (v1[2] * v1[2] + v1[3] * v1[3]);
                    u32x4 w; w.x = cvt_pk_bf16(v0[0], v0[1]); w.y = cvt_pk_bf16(v0[2], v0[3]); w.z = cvt_pk_bf16(v1[0], v1[1]); w.w = cvt_pk_bf16(v1[2], v1[3]);
                    *(u32x4*)(rowp + bj * HALF) = w; }
                ss += __shfl_xor(ss, 16); ss += __shfl_xor(ss, 32);
                if (fq == 0) osq[(size_t)row * 16 + u.pn * 4 + wc] = ss; }
    }
};
struct EpiDown {
    static constexpr bool PERM = true;
    bf16_t* C; const float* bias;
    __device__ __forceinline__ void operator()(const f32x4 (&acc)[2][2][4][2], const Unit& u, int wr, int wc, int fr, int fq) const {
        const int e = u.pn >> 2, pnl = u.pn & 3;
        const int row0 = u.pm * BM + wr * 64 + fr, col0 = pnl * BM + wc * 32 + 8 * fq;
        const float* bp = bias + (size_t)e * 1024 + col0;
        f32x4 bv[2][2];
#pragma unroll
        for (int bj = 0; bj < 2; ++bj)
#pragma unroll
            for (int n = 0; n < 2; ++n) bv[bj][n] = *(const f32x4*)(bp + bj * HALF + 4 * n);
#pragma unroll
        for (int ai = 0; ai < 2; ++ai)
#pragma unroll
            for (int m = 0; m < 4; ++m) { bf16_t* rowp = C + (size_t)(row0 + ai * HALF + m * 16) * 1024 + col0;
#pragma unroll
                for (int bj = 0; bj < 2; ++bj) { const f32x4 v0 = acc[ai][bj][m][0] + bv[bj][0], v1 = acc[ai][bj][m][1] + bv[bj][1];
                    u32x4 w; w.x = cvt_pk_bf16(v0[0], v0[1]); w.y = cvt_pk_bf16(v0[2], v0[3]); w.z = cvt_pk_bf16(v1[0], v1[1]); w.w = cvt_pk_bf16(v1[2], v1[3]);
                    *(u32x4*)(rowp + bj * HALF) = w; } }
    }
};
struct EpiSwiglu {
    static constexpr bool PERM = true;
    bf16_t* O; const float* bias;
    __device__ __forceinline__ void operator()(const f32x4 (&acc)[2][2][4][2], const Unit& u, int wr, int wc, int fr, int fq) const {
        const int e = u.pn >> 3, pnl = u.pn & 7;
        const int row0 = u.pm * BM + wr * 64 + fr, col0 = pnl * HALF + wc * 32 + 8 * fq;
        const float* bp = bias + (size_t)e * 2048 + col0;
        f32x4 bg[2], bu[2];
#pragma unroll
        for (int n = 0; n < 2; ++n) { bg[n] = *(const f32x4*)(bp + 4 * n); bu[n] = *(const f32x4*)(bp + 1024 + 4 * n); }
#pragma unroll
        for (int ai = 0; ai < 2; ++ai)
#pragma unroll
            for (int m = 0; m < 4; ++m) {
                bf16_t* rowp = O + (size_t)(row0 + ai * HALF + m * 16) * 1024 + col0;
                float r[8];
#pragma unroll
                for (int n = 0; n < 2; ++n) {
                    f32x4 g = acc[ai][0][m][n] + bg[n], up = acc[ai][1][m][n] + bu[n];
#pragma unroll
                    for (int j = 0; j < 4; ++j) {
                        float gt = fminf(g[j], 7.f), uu = fminf(fmaxf(up[j], -7.f), 7.f);
                        r[n * 4 + j] = (uu + 1.f) * gt / (1.f + __expf(-1.702f * gt));
                    }
                }
                u32x4 w; w.x = cvt_pk_bf16(r[0], r[1]); w.y = cvt_pk_bf16(r[2], r[3]); w.z = cvt_pk_bf16(r[4], r[5]); w.w = cvt_pk_bf16(r[6], r[7]);
                *(u32x4*)rowp = w;
            }
    }
};

template <class Epi, class Sched>
__device__ __forceinline__ void gemm_phase(PG8_LAS unsigned char* lds, const Gemm g, const Sched& S, const Epi& E) {
    const int tid = opaque_tid(), wid = __builtin_amdgcn_readfirstlane(tid >> 6), lane = tid & 63, wr = wid >> 2, wc = wid & 3, fr = lane & 15, fq = lane >> 4;
    const int K = g.K, nt = K / BK;
    unsigned voffA[2], voffB[2];
#pragma unroll
    for (int i = 0; i < 2; ++i) { int R, C; stage_rc(tid * 16 + i * 8192, R, C); const int Rb = Epi::PERM ? ((R & ~31) + perm32(R & 31)) : R;
        voffA[i] = (unsigned)(R * K + C) * 2u; voffB[i] = (unsigned)(Rb * K + C) * 2u; }
    const size_t kstep = (size_t)(BK * 2);
    const size_t hstep = (size_t)HALF * K * 2;
    const size_t tstep = 2 * hstep;
    const unsigned ldsw = (unsigned)wid * 1024u;
    const int aoff = lds_byte(wr * 64 + fr, fq * 8), boff = lds_byte(wc * 32 + fr, fq * 8);
#define PG8_SA(b, h) (((b) * 2 + (h)) * HTB)
#define PG8_SB(b, h) ((4 + (b) * 2 + (h)) * HTB)
#define PG8_STAGE(bufoff, gbase, voff) do { _Pragma("unroll") for (int _i = 0; _i < 2; ++_i) \
        __builtin_amdgcn_global_load_lds((const unsigned*)((const char*)(gbase) + (voff)[_i]), (PG8_LAS unsigned*)(lds + (bufoff) + ldsw + _i * 8192), 16, 0, 0); } while (0)
#define PG8_LDA(dst, b, h) do { _Pragma("unroll") for (int m = 0; m < 4; ++m) _Pragma("unroll") for (int k = 0; k < 2; ++k) dst[m][k] = *(const PG8_LAS bf16x8*)(lds + PG8_SA(b, h) + aoff + m * 2048 + k * 1024); } while (0)
#define PG8_LDB(dst, b, h) do { _Pragma("unroll") for (int n = 0; n < 2; ++n) _Pragma("unroll") for (int k = 0; k < 2; ++k) dst[n][k] = *(const PG8_LAS bf16x8*)(lds + PG8_SB(b, h) + boff + n * 2048 + k * 1024); } while (0)
#define PG8_MMA(ai, bj, At, Bt) do { __builtin_amdgcn_s_setprio(1); _Pragma("unroll") for (int m = 0; m < 4; ++m) _Pragma("unroll") for (int n = 0; n < 2; ++n) _Pragma("unroll") for (int k = 0; k < 2; ++k) \
        acc[ai][bj][m][n] = __builtin_amdgcn_mfma_f32_16x16x32_bf16(Bt[n][k], At[m][k], acc[ai][bj][m][n], 0, 0, 0); __builtin_amdgcn_s_setprio(0); } while (0)
#define PG8_WAIT_V(n) asm volatile("s_waitcnt vmcnt(" #n ")" ::: "memory")
#define PG8_WAIT_L(n) asm volatile("s_waitcnt lgkmcnt(" #n ")" ::: "memory")
#define PG8_BAR __builtin_amdgcn_s_barrier()
#define PG8_SCHED __builtin_amdgcn_sched_barrier(0)
    Unit cur, nxt; int ui = 0;
    if (!S.next(0, cur)) return;
    f32x4 acc[2][2][4][2];
#pragma unroll
    for (int a = 0; a < 2; ++a)
#pragma unroll
        for (int b = 0; b < 2; ++b)
#pragma unroll
            for (int m = 0; m < 4; ++m)
#pragma unroll
                for (int n = 0; n < 2; ++n) acc[a][b][m][n] = (f32x4){0.f, 0.f, 0.f, 0.f};
    bf16x8 At[4][2], B0[2][2], B1[2][2];
    const char* cA = (const char*)g.A + (size_t)cur.pm * tstep; const char* cB = (const char*)g.Bt + (size_t)cur.pn * tstep;
    S.a_ready(cur);
    PG8_STAGE(PG8_SB(0, 0), cB, voffB); PG8_STAGE(PG8_SA(0, 0), cA, voffA); PG8_STAGE(PG8_SB(0, 1), cB + hstep, voffB); PG8_STAGE(PG8_SA(0, 1), cA + hstep, voffA);
    if (wr == 1) PG8_BAR;
    PG8_WAIT_V(4); PG8_BAR;
    PG8_STAGE(PG8_SB(1, 0), cB + kstep, voffB); PG8_STAGE(PG8_SA(1, 0), cA + kstep, voffA); PG8_STAGE(PG8_SB(1, 1), cB + hstep + kstep, voffB);
    PG8_WAIT_V(6); PG8_BAR;
    for (;;) {
        const bool has_next = S.next(ui + 1, nxt);
        const char* nA = has_next ? (const char*)g.A + (size_t)nxt.pm * tstep : cA; const char* nB = has_next ? (const char*)g.Bt + (size_t)nxt.pn * tstep : cB;
        for (int t = 0; t < nt; t += 2) {
            const bool last = (t == nt - 2);
            const char* a1 = cA + (size_t)(t + 1) * kstep;
            const char* a2 = last ? nA : cA + (size_t)(t + 2) * kstep; const char* b2 = last ? nB : cB + (size_t)(t + 2) * kstep;
            const char* a3 = a2 + kstep; const char* b3 = b2 + kstep;
            if (last && has_next) S.a_ready(nxt);
            PG8_LDB(B0, 0, 0); PG8_SCHED; PG8_LDA(At, 0, 0); PG8_STAGE(PG8_SA(1, 1), a1 + hstep, voffA);
            PG8_WAIT_L(8); PG8_BAR; PG8_WAIT_L(0); PG8_MMA(0, 0, At, B0); PG8_BAR; PG8_SCHED;
            PG8_LDB(B1, 0, 1); PG8_STAGE(PG8_SB(0, 0), b2, voffB);
            PG8_BAR; PG8_WAIT_L(0); PG8_MMA(0, 1, At, B1); PG8_BAR;
            PG8_LDA(At, 0, 1); PG8_STAGE(PG8_SA(0, 0), a2, voffA);
            PG8_BAR; PG8_WAIT_L(0); PG8_MMA(1, 0, At, B0); PG8_BAR; PG8_SCHED;
            PG8_STAGE(PG8_SB(0, 1), b2 + hstep, voffB);
            PG8_WAIT_V(6); PG8_BAR; PG8_MMA(1, 1, At, B1); PG8_BAR;
            PG8_LDB(B0, 1, 0); PG8_SCHED; PG8_LDA(At, 1, 0); PG8_STAGE(PG8_SA(0, 1), a2 + hstep, voffA);
            PG8_WAIT_L(8); PG8_BAR; PG8_WAIT_L(0); PG8_MMA(0, 0, At, B0); PG8_BAR; PG8_SCHED;
            PG8_LDB(B1, 1, 1); PG8_STAGE(PG8_SB(1, 0), b3, voffB);
            PG8_BAR; PG8_WAIT_L(0); PG8_MMA(0, 1, At, B1); PG8_BAR;
            PG8_LDA(At, 1, 1); PG8_STAGE(PG8_SA(1, 0), a3, voffA);
            PG8_BAR; PG8_WAIT_L(0); PG8_MMA(1, 0, At, B0); PG8_BAR; PG8_SCHED;
            PG8_STAGE(PG8_SB(1, 1), b3 + hstep, voffB);
            PG8_WAIT_V(6); PG8_BAR; PG8_MMA(1, 1, At, B1); PG8_BAR;
        }
        E(acc, cur, wr, wc, fr, fq); S.done(cur);
        if (!has_next) break;
#pragma unroll
        for (int a = 0; a < 2; ++a)
#pragma unroll
            for (int b = 0; b < 2; ++b)
#pragma unroll
                for (int m = 0; m < 4; ++m)
#pragma unroll
                    for (int n = 0; n < 2; ++n) acc[a][b][m][n] = (f32x4){0.f, 0.f, 0.f, 0.f};
        cur = nxt; cA = nA; cB = nB; ++ui;
    }
    PG8_WAIT_V(0);
    if (wr == 0) PG8_BAR;
    PG8_BAR;
#undef PG8_SA
#undef PG8_SB
#undef PG8_STAGE
#undef PG8_LDA
#undef PG8_LDB
#undef PG8_MMA
#undef PG8_WAIT_V
#undef PG8_WAIT_L
#undef PG8_BAR
#undef PG8_SCHED
}
}

typedef short bf16x8_t __attribute__((ext_vector_type(8)));
typedef float f32x16_t __attribute__((ext_vector_type(16)));
typedef unsigned u32x4_t __attribute__((ext_vector_type(4)));
typedef unsigned u32x2_t __attribute__((ext_vector_type(2)));
#define LAS3 __attribute__((address_space(3)))
constexpr int ATT_VROW = 68;
constexpr int ATT_LDS_BYTES = 2 * (64 * 104 * 2 + 64 * ATT_VROW * 2);

template <int QKD, int NMAP, bool DA>
__device__ __forceinline__ void attn_item(LAS3 unsigned char* lds, const bf16_t* __restrict__ Qb, const bf16_t* __restrict__ Kb, const bf16_t* __restrict__ Vt,
                                          bf16_t* __restrict__ ycatb, int ycat_off, int b, int h, int qblk, float lam, const float* __restrict__ subln, float post_scale) {
    constexpr int DK = QKD / NMAP, KS = DK / 16, KROW = QKD + 8, KCH = QKD / 8;
    constexpr int KBYTES = 64 * KROW * 2, VBYTES = 64 * ATT_VROW * 2, BUFB = KBYTES + VBYTES;
    const int tid = opaque_tid(), wid = tid >> 6, lane = tid & 63, r = lane & 31, hh = lane >> 5;
    const int q0 = qblk * 256, ntiles = (qblk == 0) ? (NC / 64) : (NT / 64);
    const size_t base = ((size_t)b * 4 + h) * NT;
    bf16x8_t qf[NMAP][KS];
#pragma unroll
    for (int m = 0; m < NMAP; ++m)
#pragma unroll
        for (int ks = 0; ks < KS; ++ks) qf[m][ks] = *(const bf16x8_t*)(Qb + (base + q0 + 32 * wid + r) * QKD + m * DK + 16 * ks + 8 * hh);
    f32x16_t O[NMAP][2]; float mrun[NMAP], lrun[NMAP];
#pragma unroll
    for (int m = 0; m < NMAP; ++m) { mrun[m] = -1e30f; lrun[m] = 0.f;
#pragma unroll
        for (int d2 = 0; d2 < 2; ++d2)
#pragma unroll
            for (int i = 0; i < 16; ++i) O[m][d2][i] = 0.f; }
    constexpr int NKC = 64 * KCH;
    const bf16_t* kg = Kb + base * QKD;
    const bf16_t* vg = Vt + ((size_t)(b * 4 + h) * 64 + (tid >> 3)) * NT + (tid & 7) * 8;
    u32x4_t rk0, rk1 = (u32x4_t){0u, 0u, 0u, 0u}, rv;
    const int kc1 = tid + 512;
    const int k0row = tid / KCH, k0col = tid % KCH, k1row = kc1 / KCH, k1col = kc1 % KCH;
#define ATT_LOAD(j) do { rk0 = *(const u32x4_t*)(kg + (size_t)(j) * 64 * QKD + tid * 8); if (NKC > 512 && kc1 < NKC) rk1 = *(const u32x4_t*)(kg + (size_t)(j) * 64 * QKD + kc1 * 8); \
        rv = *(const u32x4_t*)(vg + (size_t)(j) * 64); } while (0)
#define ATT_STORE(buf) do { LAS3 unsigned char* kb_ = lds + (buf) * BUFB; LAS3 unsigned char* vb_ = kb_ + KBYTES; \
        *(LAS3 u32x4_t*)(kb_ + (k0row * KROW + k0col * 8) * 2) = rk0; if (NKC > 512 && kc1 < NKC) *(LAS3 u32x4_t*)(kb_ + (k1row * KROW + k1col * 8) * 2) = rk1; \
        LAS3 unsigned char* vd_ = vb_ + ((tid >> 3) * ATT_VROW + (tid & 7) * 8) * 2; *(LAS3 u32x2_t*)vd_ = (u32x2_t){rv.x, rv.y}; *(LAS3 u32x2_t*)(vd_ + 8) = (u32x2_t){rv.z, rv.w}; } while (0)
    __syncthreads();
    ATT_LOAD(0); ATT_STORE(0);
    if (ntiles > 1) ATT_LOAD(1);
    __syncthreads();
    for (int j = 0; j < ntiles; ++j) {
        const LAS3 unsigned char* kb = lds + (j & 1) * BUFB; const LAS3 unsigned char* vb = kb + KBYTES;
        bf16x8_t pf[NMAP][2][2];
#pragma unroll
        for (int m = 0; m < NMAP; ++m) {
            f32x16_t S[2];
#pragma unroll
            for (int kt = 0; kt < 2; ++kt) {
#pragma unroll
                for (int i = 0; i < 16; ++i) S[kt][i] = 0.f;
#pragma unroll
                for (int ks = 0; ks < KS; ++ks) {
                    const bf16x8_t a = *(const LAS3 bf16x8_t*)(kb + ((kt * 32 + r) * KROW + m * DK + 16 * ks + 8 * hh) * 2);
                    S[kt] = __builtin_amdgcn_mfma_f32_32x32x16_bf16(a, qf[m][ks], S[kt], 0, 0, 0);
                }
            }
            float mx = S[0][0];
#pragma unroll
            for (int i = 1; i < 16; ++i) mx = fmaxf(mx, S[0][i]);
#pragma unroll
            for (int i = 0; i < 16; ++i) mx = fmaxf(mx, S[1][i]);
            mx = fmaxf(mx, __shfl_xor(mx, 32));
            const float mn = fmaxf(mrun[m], mx);
            const float alpha = __builtin_amdgcn_exp2f(mrun[m] - mn);
            mrun[m] = mn;
            float ps = 0.f;
#pragma unroll
            for (int kt = 0; kt < 2; ++kt) {
#pragma unroll
                for (int i = 0; i < 16; ++i) { const float pv = __builtin_amdgcn_exp2f(S[kt][i] - mn); S[kt][i] = pv; ps += pv; }
#pragma unroll
                for (int s2 = 0; s2 < 2; ++s2) {
                    union { unsigned u[4]; bf16x8_t v; } cv;
#pragma unroll
                    for (int jj = 0; jj < 4; ++jj) cv.u[jj] = cvtpk(S[kt][8 * s2 + 2 * jj], S[kt][8 * s2 + 2 * jj + 1]);
                    pf[m][kt][s2] = cv.v;
                }
            }
            lrun[m] = lrun[m] * alpha + ps;
#pragma unroll
            for (int d2 = 0; d2 < 2; ++d2)
#pragma unroll
                for (int i = 0; i < 16; ++i) O[m][d2][i] *= alpha;
            asm volatile("" ::: "memory");
        }
#pragma unroll
        for (int d2 = 0; d2 < 2; ++d2)
#pragma unroll
            for (int kt = 0; kt < 2; ++kt)
#pragma unroll
                for (int s2 = 0; s2 < 2; ++s2) {
                    const LAS3 unsigned char* vp = vb + ((d2 * 32 + r) * ATT_VROW + kt * 32 + 16 * s2 + 4 * hh) * 2;
                    union { u32x2_t u[2]; bf16x8_t v; } av;
                    av.u[0] = *(const LAS3 u32x2_t*)vp; av.u[1] = *(const LAS3 u32x2_t*)(vp + 16);
#pragma unroll
                    for (int m = 0; m < NMAP; ++m) O[m][d2] = __builtin_amdgcn_mfma_f32_32x32x16_bf16(av.v, pf[m][kt][s2], O[m][d2], 0, 0, 0);
                }
        if (j + 1 < ntiles) { ATT_STORE((j + 1) & 1); if (j + 2 < ntiles) ATT_LOAD(j + 2); }
        __syncthreads();
    }
#undef ATT_LOAD
#undef ATT_STORE
    float inv[NMAP];
#pragma unroll
    for (int m = 0; m < NMAP; ++m) { const float lt = lrun[m] + __shfl_xor(lrun[m], 32); inv[m] = 1.f / lt; }
    if (NMAP == 2) inv[NMAP - 1] *= -lam;
    float ss = 0.f;
#pragma unroll
    for (int d2 = 0; d2 < 2; ++d2)
#pragma unroll
        for (int i = 0; i < 16; ++i) {
            float o = O[0][d2][i] * inv[0];
            if (NMAP == 2) o += O[NMAP - 1][d2][i] * inv[NMAP - 1];
            O[0][d2][i] = o; ss += o * o;
        }
    float rs = 1.f;
    if (DA) { ss += __shfl_xor(ss, 32); rs = rsqrtf(ss * (1.f / 64.f) + 1e-6f) * post_scale; }
    bf16_t* yp = ycatb + ((size_t)b * NT + q0 + 32 * wid + r) * DM + ycat_off + h * 64;
#pragma unroll
    for (int d2 = 0; d2 < 2; ++d2)
#pragma unroll
        for (int g4 = 0; g4 < 4; ++g4) {
            const int dv = 32 * d2 + 8 * g4 + 4 * hh;
            float o0 = O[0][d2][4 * g4] * rs, o1 = O[0][d2][4 * g4 + 1] * rs, o2 = O[0][d2][4 * g4 + 2] * rs, o3 = O[0][d2][4 * g4 + 3] * rs;
            if (DA) { const float4 w = *(const float4*)(subln + dv); o0 *= w.x; o1 *= w.y; o2 *= w.z; o3 *= w.w; }
            *(uint2*)(yp + dv) = make_uint2(cvtpk(o0, o1), cvtpk(o2, o3));
        }
}


#ifndef GDIR
#define GDIR dir
#endif
typedef float f32x4_t __attribute__((ext_vector_type(4)));
constexpr int ML_KROW = 72, ML_TROW = 136, ML_CROW = 72;
constexpr int ML_OFF_KC = 0, ML_OFF_KT = ML_OFF_KC + 128 * ML_KROW * 2, ML_OFF_VT = ML_OFF_KT + 64 * ML_TROW * 2, ML_OFF_CB = ML_OFF_VT + 80 * ML_TROW * 2,
              ML_OFF_F = ML_OFF_CB + 80 * ML_CROW * 2, ML_LDS_BYTES = ML_OFF_F + 6 * 128 * 4 + 64;
__device__ __forceinline__ void mlstm_item(LAS3 unsigned char* lds, const bf16_t* __restrict__ Qb, const bf16_t* __restrict__ Kb, const bf16_t* __restrict__ Ktg, const bf16_t* __restrict__ Vtg,
                                           const float* __restrict__ G, float* __restrict__ hdir, int b, int h, int dir) {
    const int tid = threadIdx.x, wid = tid >> 6, lane = tid & 63, lr = lane & 15, q = lane >> 4;
    LAS3 unsigned char* Kc = lds + ML_OFF_KC; LAS3 unsigned char* Kt = lds + ML_OFF_KT; LAS3 unsigned char* Vt = lds + ML_OFF_VT; LAS3 unsigned char* Cb = lds + ML_OFF_CB;
    LAS3 float* fl = (LAS3 float*)(lds + ML_OFF_F);
    LAS3 float* s_li = fl; LAS3 float* s_lf = fl + 128; LAS3 float* s_bc2 = fl + 256; LAS3 float* s_gk2 = fl + 384; LAS3 float* s_wu = fl + 512; LAS3 float* s_et = fl + 640; LAS3 float* s_misc = fl + 768;
    const size_t base = ((size_t)b * 4 + h) * NT;
    __syncthreads();
    for (int i = tid; i < 80 * ML_CROW / 2; i += 512) ((LAS3 unsigned*)Cb)[i] = 0u;
    for (int i = tid; i < 16 * ML_TROW / 2; i += 512) ((LAS3 unsigned*)(Vt + 64 * ML_TROW * 2))[i] = (i < ML_TROW / 2) ? 0x3F803F80u : 0u;
    const int ct = wid & 3, rt0 = (wid < 4) ? 0 : 3, nrt = (wid < 4) ? 3 : 2;
    f32x4_t Cacc[3];
#pragma unroll
    for (int i = 0; i < 3; ++i) Cacc[i] = (f32x4_t){0.f, 0.f, 0.f, 0.f};
    for (int c = 0; c < NT / 128; ++c) {
        int n0;
        if (dir == 0) n0 = 128 * c; else n0 = (c < 2) ? 128 * (1 - c) : NC + 128 * (17 - c);
        u32x4_t rkc[2], rkt[2], rvt[2];
#pragma unroll
        for (int i = 0; i < 2; ++i) {
            const int id = tid + 512 * i;
            rkc[i] = *(const u32x4_t*)(Kb + (base + n0 + (id >> 3)) * 64 + (id & 7) * 8);
            rkt[i] = *(const u32x4_t*)(Ktg + ((size_t)(b * 4 + h) * 64 + (id >> 4)) * NT + n0 + (id & 15) * 8);
            rvt[i] = *(const u32x4_t*)(Vtg + ((size_t)(b * 4 + h) * 64 + (id >> 4)) * NT + n0 + (id & 15) * 8);
        }
        const int tq = 16 * wid + lr;
        bf16x8_t qf[2];
#pragma unroll
        for (int ks = 0; ks < 2; ++ks) qf[ks] = *(const bf16x8_t*)(Qb + (base + n0 + tq) * 64 + 32 * ks + 8 * q);
#pragma unroll
        for (int i = 0; i < 2; ++i) {
            const int id = tid + 512 * i;
            *(LAS3 u32x4_t*)(Kc + ((id >> 3) * ML_KROW + (id & 7) * 8) * 2) = rkc[i];
            *(LAS3 u32x4_t*)(Vt + ((id >> 4) * ML_TROW + (id & 15) * 8) * 2) = rvt[i];
        }
        __syncthreads();
        if (wid == 0) {
#ifdef EXP_SCANFWD
            const int ia = 2 * lane, ib = 2 * lane + 1;
#else
            const int ia = (dir == 0) ? 2 * lane : 127 - 2 * lane, ib = (dir == 0) ? 2 * lane + 1 : 126 - 2 * lane;
#endif
            const float* gpa = G + ((size_t)b * NT + n0 + ia) * 16 + (GDIR * 2) * 4 + h; const float* gpb = G + ((size_t)b * NT + n0 + ib) * 16 + (GDIR * 2) * 4 + h;
            const float xa = gpa[4], xb = gpb[4];
            float inc = xa + xb;
#pragma unroll
            for (int o = 1; o < 64; o <<= 1) { const float v = __shfl_up(inc, o); if (lane >= o) inc += v; }
            const float tot = __shfl(inc, 63);
            const float bca = inc - xb, bcb = inc;
            const float lia = gpa[0], lib = gpb[0];
            s_bc2[ia] = bca * 1.4426950408889634f; s_bc2[ib] = bcb * 1.4426950408889634f;
            s_gk2[ia] = (bca - lia) * 1.4426950408889634f; s_gk2[ib] = (bcb - lib) * 1.4426950408889634f;
#if defined(EXP_SCANCHK) && EXP_SCANCHK == 1
            s_wu[ia] = (fabsf(lia) > 10.f || fabsf(xa) > 10.f || !(lia == lia) || !(xa == xa)) ? __builtin_nanf("") : 0.f; s_wu[ib] = (fabsf(lib) > 10.f || fabsf(xb) > 10.f || !(lib == lib) || !(xb == xb)) ? __builtin_nanf("") : 0.f;
#elif defined(EXP_SCANCHK) && EXP_SCANCHK == 2
            s_wu[ia] = (tot > 0.f || bca > 0.f || bca < tot - 0.01f || !(tot == tot) || !(bca == bca)) ? __builtin_nanf("") : 0.f; s_wu[ib] = (bcb > 0.f || bcb < tot - 0.01f || !(bcb == bcb)) ? __builtin_nanf("") : 0.f;
#elif defined(EXP_SCANCHK) && EXP_SCANCHK == 4
            { const float wa = __expf(tot - bca + lia), wb = __expf(tot - bcb + lib);
              s_wu[ia] = (wa == wa && fabsf(wa) < 1e30f) ? 0.f : __builtin_nanf(""); s_wu[ib] = (wb == wb && fabsf(wb) < 1e30f) ? 0.f : __builtin_nanf(""); }
#elif defined(EXP_SCANCHK) && EXP_SCANCHK == 3
            s_wu[ia] = (tot - bca + lia > 20.f) ? __builtin_nanf("") : 0.f; s_wu[ib] = (tot - bcb + lib > 20.f) ? __builtin_nanf("") : 0.f;
#else
            s_wu[ia] = __expf(tot - bca + lia); s_wu[ib] = __expf(tot - bcb + lib);
#endif
            s_et[ia] = __expf(bca); s_et[ib] = __expf(bcb);
            if (lane == 0) s_misc[0] = __expf(tot);
        }
        __syncthreads();
#ifdef EXP_XBAR
        __builtin_amdgcn_s_sleep(20); __syncthreads();
#endif
#pragma unroll
        for (int i = 0; i < 2; ++i) {
            const int id = tid + 512 * i; const int tk0 = (id & 15) * 8;
            unsigned w4[4] = {rkt[i].x, rkt[i].y, rkt[i].z, rkt[i].w}; u32x4_t o;
#pragma unroll
            for (int jj = 0; jj < 4; ++jj) {
                const float lo = __uint_as_float(w4[jj] << 16) * s_wu[tk0 + 2 * jj], hi = __uint_as_float(w4[jj] & 0xFFFF0000u) * s_wu[tk0 + 2 * jj + 1];
                o[jj] = cvtpk(lo, hi);
            }
            *(LAS3 u32x4_t*)(Kt + ((id >> 4) * ML_TROW + tk0) * 2) = o;
        }
        f32x4_t S[8];
#pragma unroll
        for (int kt = 0; kt < 8; ++kt) {
            S[kt] = (f32x4_t){0.f, 0.f, 0.f, 0.f};
#pragma unroll
            for (int ks = 0; ks < 2; ++ks) {
                const bf16x8_t a = *(const LAS3 bf16x8_t*)(Kc + ((16 * kt + lr) * ML_KROW + 32 * ks + 8 * q) * 2);
                S[kt] = __builtin_amdgcn_mfma_f32_16x16x32_bf16(a, qf[ks], S[kt], 0, 0, 0);
            }
        }
        const float bct = s_bc2[tq];
#pragma unroll
        for (int kt = 0; kt < 8; ++kt) {
            const f32x4_t gk = *(const LAS3 f32x4_t*)(s_gk2 + 16 * kt + 4 * q);
#pragma unroll
            for (int rg = 0; rg < 4; ++rg) {
                const int si = 16 * kt + 4 * q + rg;
#ifdef EXP_MASKFWD
                const bool valid = (si <= tq);
#else
                const bool valid = (dir == 0) ? (si <= tq) : (si >= tq);
#endif
                const float w = valid ? __builtin_amdgcn_exp2f(bct - gk[rg]) : 0.f;
                S[kt][rg] *= w;
            }
        }
        bf16x8_t pf[4];
#pragma unroll
        for (int k2 = 0; k2 < 4; ++k2) {
            union { unsigned u[4]; bf16x8_t v; } cv;
            cv.u[0] = cvtpk(S[2 * k2][0], S[2 * k2][1]); cv.u[1] = cvtpk(S[2 * k2][2], S[2 * k2][3]);
            cv.u[2] = cvtpk(S[2 * k2 + 1][0], S[2 * k2 + 1][1]); cv.u[3] = cvtpk(S[2 * k2 + 1][2], S[2 * k2 + 1][3]);
            pf[k2] = cv.v;
        }
        f32x4_t outv[5];
#pragma unroll
        for (int rt = 0; rt < 5; ++rt) {
            f32x4_t acc = (f32x4_t){0.f, 0.f, 0.f, 0.f}, acc2 = (f32x4_t){0.f, 0.f, 0.f, 0.f};
#pragma unroll
            for (int k2 = 0; k2 < 4; ++k2) {
                const LAS3 unsigned char* vp = Vt + ((16 * rt + lr) * ML_TROW + 32 * k2 + 4 * q) * 2;
                union { u32x2_t u[2]; bf16x8_t v; } av;
                av.u[0] = *(const LAS3 u32x2_t*)vp; av.u[1] = *(const LAS3 u32x2_t*)(vp + 32);
                acc = __builtin_amdgcn_mfma_f32_16x16x32_bf16(av.v, pf[k2], acc, 0, 0, 0);
            }
#pragma unroll
            for (int ks = 0; ks < 2; ++ks) {
                const bf16x8_t a = *(const LAS3 bf16x8_t*)(Cb + ((16 * rt + lr) * ML_CROW + 32 * ks + 8 * q) * 2);
                acc2 = __builtin_amdgcn_mfma_f32_16x16x32_bf16(a, qf[ks], acc2, 0, 0, 0);
            }
            outv[rt] = acc + acc2 * s_et[tq];
        }
        {
            const float den = __shfl(outv[4][0], lr);
            const float inv = 1.f / fmaxf(fabsf(den), 1.f);
            float* hp = hdir + ((size_t)dir * TT + (size_t)b * NT + n0 + tq) * 256 + h * 64 + 4 * q;
#if defined(EXP_OUT) && EXP_OUT == 4
            { const int exp_n0 = (dir == 0) ? 128 * c : ((c < 2) ? 128 * (1 - c) : NC + 128 * (17 - c));
              const float bad = (n0 == exp_n0 && (dir == 0 || dir == 1) && b >= 0 && b < 8 && h >= 0 && h < 4) ? 0.f : __builtin_nanf("");
              for (int rt = 0; rt < 4; ++rt) *(f32x4_t*)(hp + 16 * rt) = (f32x4_t){bad, bad, bad, bad}; }
#elif defined(EXP_OUT) && EXP_OUT == 5
            { float bad = 0.f;
              if (!(s_li[tq] == s_li[tq]) || !(s_lf[tq] == s_lf[tq]) || fabsf(s_li[tq]) > 10.f || fabsf(s_lf[tq]) > 10.f) bad = __builtin_nanf("");
              for (int rt = 0; rt < 4; ++rt) *(f32x4_t*)(hp + 16 * rt) = (f32x4_t){bad, bad, bad, bad}; }
#elif defined(EXP_OUT) && EXP_OUT >= 6 && EXP_OUT <= 9
            { const float val = (EXP_OUT == 6) ? bct : (EXP_OUT == 7) ? s_et[tq] : (EXP_OUT == 8) ? s_gk2[tq] : s_wu[tq];
              for (int rt = 0; rt < 4; ++rt) *(f32x4_t*)(hp + 16 * rt) = (f32x4_t){val, val, val, val}; }
#elif defined(EXP_OUT) && EXP_OUT == 11
            { const float bad = (s_et[tq] > 1.0001f || !(s_et[tq] == s_et[tq])) ? __builtin_nanf("") : 0.f;
              for (int rt = 0; rt < 4; ++rt) *(f32x4_t*)(hp + 16 * rt) = (f32x4_t){bad, bad, bad, bad}; }
#elif defined(EXP_OUT) && EXP_OUT == 12
            { const float bad = (s_misc[0] > 1.0001f || !(s_misc[0] == s_misc[0])) ? __builtin_nanf("") : 0.f;
              for (int rt = 0; rt < 4; ++rt) *(f32x4_t*)(hp + 16 * rt) = (f32x4_t){bad, bad, bad, bad}; }
#elif defined(EXP_OUT) && EXP_OUT == 1
            for (int rt = 0; rt < 4; ++rt) *(f32x4_t*)(hp + 16 * rt) = (f32x4_t){bct, s_et[tq], s_gk2[tq], s_wu[tq]};
#elif defined(EXP_OUT) && EXP_OUT == 2
            for (int rt = 0; rt < 4; ++rt) *(f32x4_t*)(hp + 16 * rt) = S[rt] + S[rt + 4];
#elif defined(EXP_OUT) && EXP_OUT == 3
            for (int rt = 0; rt < 4; ++rt) *(f32x4_t*)(hp + 16 * rt) = outv[rt];
#else
            for (int rt = 0; rt < 4; ++rt) *(f32x4_t*)(hp + 16 * rt) = outv[rt] * inv;
#endif
        }
        __syncthreads();
        {
            const float decay = s_misc[0];
#pragma unroll
            for (int i = 0; i < 3; ++i) Cacc[i] *= decay;
#pragma unroll
            for (int ks = 0; ks < 4; ++ks) {
                const bf16x8_t bb = *(const LAS3 bf16x8_t*)(Kt + ((16 * ct + lr) * ML_TROW + 32 * ks + 8 * q) * 2);
#pragma unroll
                for (int i = 0; i < 3; ++i) if (i < nrt) {
                    const bf16x8_t a = *(const LAS3 bf16x8_t*)(Vt + ((16 * (rt0 + i) + lr) * ML_TROW + 32 * ks + 8 * q) * 2);
                    Cacc[i] = __builtin_amdgcn_mfma_f32_16x16x32_bf16(a, bb, Cacc[i], 0, 0, 0);
                }
            }
#pragma unroll
            for (int i = 0; i < 3; ++i) if (i < nrt) {
#pragma unroll
                for (int rg = 0; rg < 4; ++rg) *(LAS3 bf16_t*)(Cb + ((16 * (rt0 + i) + 4 * q + rg) * ML_CROW + 16 * ct + lr) * 2) = f2bf(Cacc[i][rg]);
            }
        }
        __syncthreads();
    }
}

constexpr int S5_UROWS = NT + 64;
constexpr int S5_KROW = 1032, S5_CROW = 136, S5_ZROW = 136;
constexpr int S5_OFF_U = 0, S5_OFF_KM = S5_OFF_U + S5_UROWS * 16 * 2, S5_OFF_CM = S5_OFF_KM + 16 * S5_KROW * 2, S5_OFF_EZ = S5_OFF_CM + 16 * S5_CROW * 2,
              S5_LDS_BYTES = S5_OFF_EZ + 8 * 16 * S5_ZROW * 2;
__device__ __forceinline__ void s5_setup_item(LAS3 unsigned char* lds, int idx, const float* __restrict__ a_re, const float* __restrict__ a_im, const float* __restrict__ log_step,
                                                  const float* __restrict__ b_re, const float* __restrict__ b_im, const float* __restrict__ c_re, const float* __restrict__ c_im,
                                                  bf16_t* __restrict__ KmT, bf16_t* __restrict__ Smat, bf16_t* __restrict__ CmT, float* __restrict__ Aab, float* __restrict__ A64) {
    typedef float apw_t[64][2]; typedef float bb_t[16][2]; typedef float cc_t[64][2];
    LAS3 apw_t* apw = (LAS3 apw_t*)lds;
    LAS3 bb_t* bb = (LAS3 bb_t*)(lds + 32768);
    LAS3 cc_t* cc = (LAS3 cc_t*)(lds + 32768 + 8192);
    const int tid = opaque_tid();
    __syncthreads();
    const float dt = expf(log_step[idx]);
    if (tid < 64) {
        const int p = tid;
        const float ar = fminf(a_re[idx * 64 + p], -1e-4f), ai = a_im[idx * 64 + p];
        const float mag = expf(dt * ar), er = mag * cosf(dt * ai), ei = mag * sinf(dt * ai);
        const float inv = 1.0f / (ar * ar + ai * ai);
        const float fr = ((er - 1.0f) * ar + ei * ai) * inv, fi = (ei * ar - (er - 1.0f) * ai) * inv;
        Aab[(idx * 64 + p) * 2] = er; Aab[(idx * 64 + p) * 2 + 1] = ei;
        const float m64 = expf(64.0f * dt * ar);
        A64[(idx * 64 + p) * 2] = m64 * cosf(64.0f * dt * ai); A64[(idx * 64 + p) * 2 + 1] = m64 * sinf(64.0f * dt * ai);
        for (int hh = 0; hh < 16; ++hh) {
            const float br = b_re[((size_t)idx * 64 + p) * 16 + hh], bi = b_im[((size_t)idx * 64 + p) * 16 + hh];
            bb[p][hh][0] = fr * br - fi * bi; bb[p][hh][1] = fr * bi + fi * br;
        }
    }
    for (int i = tid; i < 64 * 64; i += 512) {
        const int tau = i >> 6, p = i & 63;
        const float ar = fminf(a_re[idx * 64 + p], -1e-4f), ai = a_im[idx * 64 + p];
        const float mag = expf((float)tau * dt * ar);
        apw[tau][p][0] = mag * cosf((float)tau * dt * ai); apw[tau][p][1] = mag * sinf((float)tau * dt * ai);
    }
    for (int i = tid; i < 16 * 64; i += 512) { const int hh = i >> 6, p = i & 63; cc[hh][p][0] = c_re[(size_t)idx * 1024 + i]; cc[hh][p][1] = c_im[(size_t)idx * 1024 + i]; }
    __syncthreads();
    for (int i = tid; i < 16 * 64; i += 512) { const int hh = i >> 6, p = i & 63;
        CmT[((size_t)idx * 16 + hh) * 128 + 2 * p] = f2bf(cc[hh][p][0]); CmT[((size_t)idx * 16 + hh) * 128 + 2 * p + 1] = f2bf(-cc[hh][p][1]); }
    for (int e = tid; e < 64 * 1024; e += 512) {
        const int p = e >> 10, k = e & 1023, i = k >> 4, hp = k & 15;
        const float pr = apw[63 - i][p][0], pi = apw[63 - i][p][1], br = bb[p][hp][0], bi = bb[p][hp][1];
        Smat[((size_t)idx * 128 + 2 * p) * 1024 + k] = f2bf(pr * br - pi * bi);
        Smat[((size_t)idx * 128 + 2 * p + 1) * 1024 + k] = f2bf(pr * bi + pi * br);
    }
    for (int e = tid; e < 16 * 1024; e += 512) {
        const int hh = e >> 10, k = e & 1023, tau = k >> 4, hp = k & 15;
        float acc = 0.f;
        for (int p = 0; p < 64; ++p) {
            const float pr = apw[tau][p][0], pi = apw[tau][p][1], br = bb[p][hp][0], bi = bb[p][hp][1];
            const float wr = pr * br - pi * bi, wi = pr * bi + pi * br;
            acc += cc[hh][p][0] * wr - cc[hh][p][1] * wi;
        }
        KmT[((size_t)idx * 16 + hh) * 1024 + k] = f2bf(acc);
    }
}


__device__ __forceinline__ void s5_item(LAS3 unsigned char* lds, const bf16_t* __restrict__ p, const bf16_t* __restrict__ KmT, const bf16_t* __restrict__ Smat, const bf16_t* __restrict__ CmT,
                                        const float* __restrict__ Aab, const float* __restrict__ A64, float* __restrict__ xs_g, float* __restrict__ ys5, int b, int g, int dir) {
    const int tid = threadIdx.x, wid = tid >> 6, lane = tid & 63, lr = lane & 15, q = lane >> 4;
    const int tix = dir * 16 + g;
    LAS3 unsigned char* U = lds + S5_OFF_U; LAS3 unsigned char* Km = lds + S5_OFF_KM; LAS3 unsigned char* Cm = lds + S5_OFF_CM; LAS3 unsigned char* EZ = lds + S5_OFF_EZ;
    float* xs = xs_g + (size_t)((b * 16 + g) * 2 + dir) * 36 * 128;
    __syncthreads();
    for (int i = tid; i < 16 * 128; i += 512) { const int hh = i >> 7, ch = i & 127;
        *(LAS3 u32x4_t*)(Km + (hh * S5_KROW + ch * 8) * 2) = *(const u32x4_t*)(KmT + ((size_t)tix * 16 + hh) * 1024 + ch * 8); }
    if (tid < 256) { const int hh = tid >> 4, ch = tid & 15;
        *(LAS3 u32x4_t*)(Cm + (hh * S5_CROW + ch * 8) * 2) = *(const u32x4_t*)(CmT + ((size_t)tix * 16 + hh) * 128 + ch * 8); }
    for (int i = tid; i < NT * 2; i += 512) {
        const int sidx = i >> 1, hf = i & 1;
        const int n = seq_token(sidx, dir);
        *(LAS3 u32x4_t*)(U + ((64 + sidx) * 16 + hf * 8) * 2) = *(const u32x4_t*)(p + ((size_t)b * NT + n) * DIN + P_S5 + g * 16 + hf * 8);
    }
    for (int i = tid; i < 64 * 8; i += 512) *(LAS3 unsigned*)(U + i * 4) = 0u;
    __syncthreads();
    {
        f32x4_t acc[3];
#pragma unroll
        for (int i = 0; i < 3; ++i) acc[i] = (f32x4_t){0.f, 0.f, 0.f, 0.f};
        const bf16_t* sp = Smat + ((size_t)tix * 128 + 16 * wid + lr) * 1024 + 8 * q;
        int cco[3];
#pragma unroll
        for (int ctile = 0; ctile < 3; ++ctile) { int ch = 16 * ctile + lr; if (ch > 35) ch = 35; cco[ctile] = ((64 + 64 * ch + (q >> 1)) * 16 + 8 * (q & 1)) * 2; }
#pragma unroll 8
        for (int ks = 0; ks < 32; ++ks) {
            const bf16x8_t a = *(const bf16x8_t*)(sp + 32 * ks);
#pragma unroll
            for (int ctile = 0; ctile < 3; ++ctile) {
                const bf16x8_t bfr = *(const LAS3 bf16x8_t*)(U + cco[ctile] + ks * 64);
                acc[ctile] = __builtin_amdgcn_mfma_f32_16x16x32_bf16(a, bfr, acc[ctile], 0, 0, 0);
            }
        }
        LAS3 float* E = (LAS3 float*)EZ;
#pragma unroll
        for (int ctile = 0; ctile < 3; ++ctile)
#pragma unroll
            for (int rg = 0; rg < 4; ++rg) E[(16 * ctile + lr) * 128 + 16 * wid + 4 * q + rg] = acc[ctile][rg];
    }
    __syncthreads();
    const float Ar = Aab[(tix * 64 + lane) * 2], Ai = Aab[(tix * 64 + lane) * 2 + 1];
    if (wid == 0) {
        const float Br = A64[(tix * 64 + lane) * 2], Bi = A64[(tix * 64 + lane) * 2 + 1];
        const LAS3 float* E = (const LAS3 float*)EZ;
        float xr = 0.f, xi = 0.f;
        for (int c = 0; c < 36; ++c) {
            *(float2*)(xs + c * 128 + 2 * lane) = make_float2(xr, xi);
            const float er = E[c * 128 + 2 * lane], ei = E[c * 128 + 2 * lane + 1];
            const float nr = Br * xr - Bi * xi + er, ni = Br * xi + Bi * xr + ei;
            xr = nr; xi = ni;
        }
    }
    __threadfence_block();
    __syncthreads();
    LAS3 unsigned char* Zw = EZ + wid * (16 * S5_ZROW * 2);
    bf16x8_t cmf[4];
#pragma unroll
    for (int ks = 0; ks < 4; ++ks) cmf[ks] = *(const LAS3 bf16x8_t*)(Cm + (lr * S5_CROW + 32 * ks + 8 * q) * 2);
    for (int c = wid; c < 36; c += 8) {
        const float2 x0 = *(const float2*)(xs + c * 128 + 2 * lane);
        float zr = Ar * x0.x - Ai * x0.y, zi = Ar * x0.y + Ai * x0.x;
#pragma unroll
        for (int rt = 0; rt < 4; ++rt) {
#pragma unroll
            for (int ii = 0; ii < 16; ++ii) {
                *(LAS3 unsigned*)(Zw + (ii * S5_ZROW + 2 * lane) * 2) = cvtpk(zr, zi);
                const float nr = Ar * zr - Ai * zi, ni = Ar * zi + Ai * zr; zr = nr; zi = ni;
            }
            asm volatile("s_waitcnt lgkmcnt(0)" ::: "memory");
            f32x4_t acc = (f32x4_t){0.f, 0.f, 0.f, 0.f};
#pragma unroll
            for (int ks = 0; ks < 4; ++ks) {
                const bf16x8_t a = *(const LAS3 bf16x8_t*)(Zw + (lr * S5_ZROW + 32 * ks + 8 * q) * 2);
                acc = __builtin_amdgcn_mfma_f32_16x16x32_bf16(a, cmf[ks], acc, 0, 0, 0);
            }
            const int irow = 16 * rt + lr;
            const LAS3 unsigned char* up = U + ((64 + 64 * c + irow - (q >> 1)) * 16 + 8 * (q & 1)) * 2;
            const LAS3 unsigned char* kp = Km + (lr * S5_KROW + 8 * q) * 2;
#pragma unroll 4
            for (int ks = 0; ks < 8 * rt + 8; ++ks) {
                bf16x8_t a = *(const LAS3 bf16x8_t*)(up - ks * 64);
                const bool valid = (2 * ks + (q >> 1)) <= irow;
                if (!valid) a = (bf16x8_t){0, 0, 0, 0, 0, 0, 0, 0};
                const bf16x8_t kb = *(const LAS3 bf16x8_t*)(kp + ks * 64);
                acc = __builtin_amdgcn_mfma_f32_16x16x32_bf16(a, kb, acc, 0, 0, 0);
            }
#pragma unroll
            for (int rg = 0; rg < 4; ++rg) {
                const int n = seq_token(64 * c + 16 * rt + 4 * q + rg, dir);
#ifdef EXP_S5GUARD
                { const size_t yi = ((size_t)dir * TT + (size_t)b * NT + n) * 256 + g * 16 + lr; if (yi < (size_t)2 * TT * 256) ys5[yi] = acc[rg]; }
#else
                ys5[((size_t)dir * TT + (size_t)b * NT + n) * 256 + g * 16 + lr] = acc[rg];
#endif
            }
            asm volatile("s_waitcnt lgkmcnt(0)" ::: "memory");
        }
    }
}

#define XB_TMO      128
#define XB_XCNT(j)  (256  + 64 * (j))
#define XB_XSUB(j)  (1280 + 64 * (j))
#define XB_XGEN(j)  (2304 + 64 * (j))
#define XB_TOP      3328
#define XB_TOPGEN   3392
#define XCD_BAR_WORDS 3456
#define XB_SPIN_CAP (1u << 22)
__device__ __forceinline__ unsigned xb_ld(unsigned* p)              { return __hip_atomic_load(p, __ATOMIC_RELAXED, __HIP_MEMORY_SCOPE_AGENT); }
__device__ __forceinline__ unsigned xb_add(unsigned* p, unsigned v) { return __hip_atomic_fetch_add(p, v, __ATOMIC_RELAXED, __HIP_MEMORY_SCOPE_AGENT); }
__device__ __forceinline__ unsigned xb_xcc_id() { return (unsigned)__builtin_amdgcn_s_getreg((3 << 11) | 20) & 0xFu; }
#define XB_SPIN(cond, bar) do { unsigned _sp = 0; while (cond) { __builtin_amdgcn_s_sleep(1); \
    if ((++_sp & 255u) == 0u) { if (xb_ld(&(bar)[XB_TMO])) break; if (_sp > XB_SPIN_CAP) { atomicAdd(&(bar)[XB_TMO], 1u); break; } } } } while (0)
struct XcdBarrier { unsigned* bar; unsigned x; volatile LAS3 unsigned* st; };
__device__ __forceinline__ XcdBarrier xcd_barrier_post(unsigned* bar, volatile LAS3 unsigned* st) {
    XcdBarrier b; b.bar = bar; b.x = xb_xcc_id(); b.st = st;
    if (threadIdx.x == 0) (void)xb_add(&bar[XB_XCNT(b.x)], 1u);
    return b;
}
__device__ __forceinline__ void xcd_barrier_complete(unsigned* bar, unsigned x, unsigned& nloc, unsigned& nx) {
    const unsigned G = gridDim.x * gridDim.y * gridDim.z;
    unsigned sum, cnt, mine, sp = 0u;
    for (;;) {
        sum = 0u; cnt = 0u; mine = 0u;
#pragma unroll
        for (unsigned j = 0; j < 16; ++j) { const unsigned c = xb_ld(&bar[XB_XCNT(j)]); sum += c; cnt += (c > 0u) ? 1u : 0u; mine = (j == x) ? c : mine; }
        if (sum == G) break;
        __builtin_amdgcn_s_sleep(1);
        if ((++sp & 255u) == 0u) { if (xb_ld(&bar[XB_TMO])) break; if (sp > XB_SPIN_CAP) { atomicAdd(&bar[XB_TMO], 1u); break; } }
    }
    nloc = mine > 0u ? mine : 1u; nx = cnt > 0u ? cnt : 1u;
}
__device__ __forceinline__ void xcd_barrier(const XcdBarrier& b) {
    asm volatile("s_waitcnt vmcnt(0)" ::: "memory");
    __syncthreads();
    if (threadIdx.x == 0) {
        unsigned* bar = b.bar;
        __builtin_amdgcn_s_waitcnt(0);
        unsigned nloc = b.st[0], nx = b.st[1];
        if (nloc == 0u) { xcd_barrier_complete(bar, b.x, nloc, nx); b.st[0] = nloc; b.st[1] = nx; }
        const unsigned old = xb_add(&bar[XB_XSUB(b.x)], 1u);
        const unsigned gen = old / nloc;
        if (old + 1u == (gen + 1u) * nloc) {
            __builtin_amdgcn_fence(__ATOMIC_RELEASE, "agent");
            asm volatile("s_waitcnt vmcnt(0)" ::: "memory");
            const unsigned og = xb_add(&bar[XB_TOP], 1u);
            const unsigned tg = og / nx;
            if (og + 1u == (tg + 1u) * nx) xb_add(&bar[XB_TOPGEN], 1u);
            else XB_SPIN(xb_ld(&bar[XB_TOPGEN]) == tg, bar);
            __builtin_amdgcn_fence(__ATOMIC_ACQUIRE, "agent");
            xb_add(&bar[XB_XGEN(b.x)], 1u);
            asm volatile("s_waitcnt vmcnt(0)" ::: "memory");
        } else {
            XB_SPIN(xb_ld(&bar[XB_XGEN(b.x)]) == gen, bar);
            __builtin_amdgcn_fence(__ATOMIC_ACQUIRE, "agent");
            asm volatile("s_waitcnt vmcnt(0)" ::: "memory");
        }
    }
    __syncthreads();
}

struct Params {
    const float *x, *c, *ctx, *c_ctx, *w_mod, *b_mod, *norm_w, *w_in, *w_out, *da_lambda, *da_subln, *ml_conv_w, *ml_conv_b, *ml_gate_b, *ml_norm,
                *mla_q_norm, *mla_w_uq, *mla_kv_norm, *mla_w_ukv, *s5_a_re, *s5_a_im, *s5_log_step, *s5_b_re, *s5_b_im, *s5_c_re, *s5_c_im, *s5_d, *s5_w_glu, *s5_b_glu,
                *moe_w_router, *moe_b_router, *moe_w_gate_up, *moe_b_gate_up, *moe_w_down, *moe_b_down;
    float* out;
    float *xall, *mod, *ropecs, *lamfull;
    bf16_t *w_in_t, *w_out_t, *wgu_t, *wdn_t, *wq_t, *wkv_t, *wglu_t;
    bf16_t *s5KmT, *s5Smat, *s5CmT; float *s5A, *s5A64, *s5xs;
    bf16_t *hbuf, *pb, *daQ, *daK, *daVt, *mQ, *mK, *mVt, *mlQ, *mlK, *mlKt, *mlVt; float *mlG, *hdir, *ys5;
    bf16_t *ycatb, *ob; float* osq; bf16_t* fb;
    int* top_e; float* top_g; int *posb, *tok_slot;
    int *cnt, *tile_e, *ntiles, *offs;
    bf16_t *xg, *act, *yexp;
    unsigned* bar; int* queue;
};

template <class T> __device__ __forceinline__ T* uni_ptr(T* p) { const unsigned long long v = (unsigned long long)p; const unsigned lo = __builtin_amdgcn_readfirstlane((unsigned)v), hi = __builtin_amdgcn_readfirstlane((unsigned)(v >> 32)); return (T*)(__attribute__((address_space(1))) T*)(((unsigned long long)hi << 32) | lo); }
__device__ __forceinline__ void store_params(LAS3 Params* PL, const Params& P) {
    PL->x = P.x;
    PL->c = P.c;
    PL->ctx = P.ctx;
    PL->c_ctx = P.c_ctx;
    PL->w_mod = P.w_mod;
    PL->b_mod = P.b_mod;
    PL->norm_w = P.norm_w;
    PL->w_in = P.w_in;
    PL->w_out = P.w_out;
    PL->da_lambda = P.da_lambda;
    PL->da_subln = P.da_subln;
    PL->ml_conv_w = P.ml_conv_w;
    PL->ml_conv_b = P.ml_conv_b;
    PL->ml_gate_b = P.ml_gate_b;
    PL->ml_norm = P.ml_norm;
    PL->mla_q_norm = P.mla_q_norm;
    PL->mla_w_uq = P.mla_w_uq;
    PL->mla_kv_norm = P.mla_kv_norm;
    PL->mla_w_ukv = P.mla_w_ukv;
    PL->s5_a_re = P.s5_a_re;
    PL->s5_a_im = P.s5_a_im;
    PL->s5_log_step = P.s5_log_step;
    PL->s5_b_re = P.s5_b_re;
    PL->s5_b_im = P.s5_b_im;
    PL->s5_c_re = P.s5_c_re;
    PL->s5_c_im = P.s5_c_im;
    PL->s5_d = P.s5_d;
    PL->s5_w_glu = P.s5_w_glu;
    PL->s5_b_glu = P.s5_b_glu;
    PL->moe_w_router = P.moe_w_router;
    PL->moe_b_router = P.moe_b_router;
    PL->moe_w_gate_up = P.moe_w_gate_up;
    PL->moe_b_gate_up = P.moe_b_gate_up;
    PL->moe_w_down = P.moe_w_down;
    PL->moe_b_down = P.moe_b_down;
    PL->out = P.out;
    PL->xall = P.xall;
    PL->mod = P.mod;
    PL->ropecs = P.ropecs;
    PL->lamfull = P.lamfull;
    PL->w_in_t = P.w_in_t;
    PL->w_out_t = P.w_out_t;
    PL->wgu_t = P.wgu_t;
    PL->wdn_t = P.wdn_t;
    PL->wq_t = P.wq_t;
    PL->wkv_t = P.wkv_t;
    PL->wglu_t = P.wglu_t;
    PL->s5KmT = P.s5KmT;
    PL->s5Smat = P.s5Smat;
    PL->s5CmT = P.s5CmT;
    PL->s5A = P.s5A;
    PL->s5A64 = P.s5A64;
    PL->s5xs = P.s5xs;
    PL->hbuf = P.hbuf;
    PL->pb = P.pb;
    PL->daQ = P.daQ;
    PL->daK = P.daK;
    PL->daVt = P.daVt;
    PL->mQ = P.mQ;
    PL->mK = P.mK;
    PL->mVt = P.mVt;
    PL->mlQ = P.mlQ;
    PL->mlK = P.mlK;
    PL->mlKt = P.mlKt;
    PL->mlVt = P.mlVt;
    PL->mlG = P.mlG;
    PL->hdir = P.hdir;
    PL->ys5 = P.ys5;
    PL->ycatb = P.ycatb;
    PL->ob = P.ob;
    PL->osq = P.osq;
    PL->fb = P.fb;
    PL->top_e = P.top_e;
    PL->top_g = P.top_g;
    PL->posb = P.posb;
    PL->tok_slot = P.tok_slot;
    PL->cnt = P.cnt;
    PL->tile_e = P.tile_e;
    PL->ntiles = P.ntiles;
    PL->offs = P.offs;
    PL->xg = P.xg;
    PL->act = P.act;
    PL->yexp = P.yexp;
    PL->bar = P.bar;
    PL->queue = P.queue;
}
__device__ __forceinline__ Params load_params(const LAS3 Params* PL) {
    Params Q;
    Q.x = uni_ptr(PL->x);
    Q.c = uni_ptr(PL->c);
    Q.ctx = uni_ptr(PL->ctx);
    Q.c_ctx = uni_ptr(PL->c_ctx);
    Q.w_mod = uni_ptr(PL->w_mod);
    Q.b_mod = uni_ptr(PL->b_mod);
    Q.norm_w = uni_ptr(PL->norm_w);
    Q.w_in = uni_ptr(PL->w_in);
    Q.w_out = uni_ptr(PL->w_out);
    Q.da_lambda = uni_ptr(PL->da_lambda);
    Q.da_subln = uni_ptr(PL->da_subln);
    Q.ml_conv_w = uni_ptr(PL->ml_conv_w);
    Q.ml_conv_b = uni_ptr(PL->ml_conv_b);
    Q.ml_gate_b = uni_ptr(PL->ml_gate_b);
    Q.ml_norm = uni_ptr(PL->ml_norm);
    Q.mla_q_norm = uni_ptr(PL->mla_q_norm);
    Q.mla_w_uq = uni_ptr(PL->mla_w_uq);
    Q.mla_kv_norm = uni_ptr(PL->mla_kv_norm);
    Q.mla_w_ukv = uni_ptr(PL->mla_w_ukv);
    Q.s5_a_re = uni_ptr(PL->s5_a_re);
    Q.s5_a_im = uni_ptr(PL->s5_a_im);
    Q.s5_log_step = uni_ptr(PL->s5_log_step);
    Q.s5_b_re = uni_ptr(PL->s5_b_re);
    Q.s5_b_im = uni_ptr(PL->s5_b_im);
    Q.s5_c_re = uni_ptr(PL->s5_c_re);
    Q.s5_c_im = uni_ptr(PL->s5_c_im);
    Q.s5_d = uni_ptr(PL->s5_d);
    Q.s5_w_glu = uni_ptr(PL->s5_w_glu);
    Q.s5_b_glu = uni_ptr(PL->s5_b_glu);
    Q.moe_w_router = uni_ptr(PL->moe_w_router);
    Q.moe_b_router = uni_ptr(PL->moe_b_router);
    Q.moe_w_gate_up = uni_ptr(PL->moe_w_gate_up);
    Q.moe_b_gate_up = uni_ptr(PL->moe_b_gate_up);
    Q.moe_w_down = uni_ptr(PL->moe_w_down);
    Q.moe_b_down = uni_ptr(PL->moe_b_down);
    Q.out = uni_ptr(PL->out);
    Q.xall = uni_ptr(PL->xall);
    Q.mod = uni_ptr(PL->mod);
    Q.ropecs = uni_ptr(PL->ropecs);
    Q.lamfull = uni_ptr(PL->lamfull);
    Q.w_in_t = uni_ptr(PL->w_in_t);
    Q.w_out_t = uni_ptr(PL->w_out_t);
    Q.wgu_t = uni_ptr(PL->wgu_t);
    Q.wdn_t = uni_ptr(PL->wdn_t);
    Q.wq_t = uni_ptr(PL->wq_t);
    Q.wkv_t = uni_ptr(PL->wkv_t);
    Q.wglu_t = uni_ptr(PL->wglu_t);
    Q.s5KmT = uni_ptr(PL->s5KmT);
    Q.s5Smat = uni_ptr(PL->s5Smat);
    Q.s5CmT = uni_ptr(PL->s5CmT);
    Q.s5A = uni_ptr(PL->s5A);
    Q.s5A64 = uni_ptr(PL->s5A64);
    Q.s5xs = uni_ptr(PL->s5xs);
    Q.hbuf = uni_ptr(PL->hbuf);
    Q.pb = uni_ptr(PL->pb);
    Q.daQ = uni_ptr(PL->daQ);
    Q.daK = uni_ptr(PL->daK);
    Q.daVt = uni_ptr(PL->daVt);
    Q.mQ = uni_ptr(PL->mQ);
    Q.mK = uni_ptr(PL->mK);
    Q.mVt = uni_ptr(PL->mVt);
    Q.mlQ = uni_ptr(PL->mlQ);
    Q.mlK = uni_ptr(PL->mlK);
    Q.mlKt = uni_ptr(PL->mlKt);
    Q.mlVt = uni_ptr(PL->mlVt);
    Q.mlG = uni_ptr(PL->mlG);
    Q.hdir = uni_ptr(PL->hdir);
    Q.ys5 = uni_ptr(PL->ys5);
    Q.ycatb = uni_ptr(PL->ycatb);
    Q.ob = uni_ptr(PL->ob);
    Q.osq = uni_ptr(PL->osq);
    Q.fb = uni_ptr(PL->fb);
    Q.top_e = uni_ptr(PL->top_e);
    Q.top_g = uni_ptr(PL->top_g);
    Q.posb = uni_ptr(PL->posb);
    Q.tok_slot = uni_ptr(PL->tok_slot);
    Q.cnt = uni_ptr(PL->cnt);
    Q.tile_e = uni_ptr(PL->tile_e);
    Q.ntiles = uni_ptr(PL->ntiles);
    Q.offs = uni_ptr(PL->offs);
    Q.xg = uni_ptr(PL->xg);
    Q.act = uni_ptr(PL->act);
    Q.yexp = uni_ptr(PL->yexp);
    Q.bar = uni_ptr(PL->bar);
    Q.queue = uni_ptr(PL->queue);
    return Q;
}
constexpr int MK_LDS_MAIN = 147968;
constexpr int MK_LDS_BYTES = MK_LDS_MAIN + 64 + 1024;
enum { PH_SETUP = 0, PH_H0 = 1, PH_LAYER0 = 2, PH_PER_LAYER = 10, PH_TOTAL = 22 };
enum { L_GEMM_IN = 0, L_PREP, L_MIX, L_FINISH, L_GEMM_OUT, L_POST, L_SCATTER, L_GEMM_GU, L_GEMM_DN, L_COMBINE };

__device__ __forceinline__ void conv_tile(LAS3 float* tile, int st, const float* __restrict__ W, int N, bf16_t* __restrict__ WT, int ldt, int tn, int tk, int mode) {
    const int n0 = tn * 64, k0 = tk * 64;
    const int a = st & 63, bq = st >> 6;
#pragma unroll
    for (int i = 0; i < 16; ++i) { const int k = i * 4 + bq; tile[k * 65 + a] = (n0 + a < N) ? W[(size_t)(k0 + k) * N + n0 + a] : 0.f; }
    __syncthreads();
    const int n = st >> 2, kc = (st & 3) * 16;
    if (n0 + n < N) {
        const int gn = n0 + n; int dr = gn;
        if (mode == 1) dr = (gn < 1024) ? ((gn >> 7) * 256 + (gn & 127)) : ((((gn - 1024) >> 7) * 256) + 128 + ((gn - 1024) & 127));
        u32x4_t o0, o1;
        o0.x = pk2bf(tile[(kc + 0) * 65 + n], tile[(kc + 1) * 65 + n]); o0.y = pk2bf(tile[(kc + 2) * 65 + n], tile[(kc + 3) * 65 + n]);
        o0.z = pk2bf(tile[(kc + 4) * 65 + n], tile[(kc + 5) * 65 + n]); o0.w = pk2bf(tile[(kc + 6) * 65 + n], tile[(kc + 7) * 65 + n]);
        o1.x = pk2bf(tile[(kc + 8) * 65 + n], tile[(kc + 9) * 65 + n]); o1.y = pk2bf(tile[(kc + 10) * 65 + n], tile[(kc + 11) * 65 + n]);
        o1.z = pk2bf(tile[(kc + 12) * 65 + n], tile[(kc + 13) * 65 + n]); o1.w = pk2bf(tile[(kc + 14) * 65 + n], tile[(kc + 15) * 65 + n]);
        bf16_t* dp = WT + (size_t)dr * ldt + k0 + kc;
        *(u32x4_t*)dp = o0; *(u32x4_t*)(dp + 8) = o1;
    }
    __syncthreads();
}
constexpr int CV_IN = 38 * 16 * 2, CV_OUT = 256 * 2, CV_GU = 512 * 64, CV_DN = 256 * 64, CV_Q = 18 * 2, CV_KV = 16 * 2, CV_GLU = 16 * 2;
constexpr int CV_TOTAL = CV_IN + CV_OUT + CV_GU + CV_DN + CV_Q + CV_KV + CV_GLU;
__device__ __forceinline__ void conv_dispatch(const Params& P, LAS3 float* tile, int st, int it) {
    const float* W = nullptr; bf16_t* WT = nullptr; int N = 64, ldt = 64, tn = 0, tk = 0, mode = 0;
    if (it < CV_TOTAL) {
        int r = it;
        if (r < CV_IN) { const int bt = r / 608, q = r % 608; W = P.w_in + (size_t)bt * 1024 * DINC; N = DINC; WT = P.w_in_t + (size_t)bt * 2560 * 1024; ldt = 1024; tn = q % 38; tk = q / 38; }
        else if ((r -= CV_IN) < CV_OUT) { const int bt = r / 256, q = r % 256; W = P.w_out + (size_t)bt * 1024 * 1024; N = 1024; WT = P.w_out_t + (size_t)bt * 1024 * 1024; ldt = 1024; tn = q % 16; tk = q / 16; }
        else if ((r -= CV_OUT) < CV_GU) { const int bt = r / 512, q = r % 512; W = P.moe_w_gate_up + (size_t)bt * 1024 * 2048; N = 2048; WT = P.wgu_t + (size_t)bt * 2048 * 1024; ldt = 1024; tn = q % 32; tk = q / 32; mode = 1; }
        else if ((r -= CV_GU) < CV_DN) { const int bt = r / 256, q = r % 256; W = P.moe_w_down + (size_t)bt * 1024 * 1024; N = 1024; WT = P.wdn_t + (size_t)bt * 1024 * 1024; ldt = 1024; tn = q % 16; tk = q / 16; }
        else if ((r -= CV_DN) < CV_Q) { const int bt = r / 18, q = r % 18; W = P.mla_w_uq + (size_t)bt * 192 * 384; N = 384; WT = P.wq_t + (size_t)bt * 384 * 192; ldt = 192; tn = q % 6; tk = q / 6; }
        else if ((r -= CV_Q) < CV_KV) { const int bt = r / 16, q = r % 16; W = P.mla_w_ukv + (size_t)bt * 128 * 512; N = 512; WT = P.wkv_t + (size_t)bt * 512 * 128; ldt = 128; tn = q % 8; tk = q / 8; }
        else { r -= CV_KV; const int bt = r / 16, q = r % 16; W = P.s5_w_glu + (size_t)bt * 256 * 256; N = 256; WT = P.wglu_t + (size_t)bt * 256 * 256; ldt = 256; tn = q % 4; tk = q / 4; }
    }
    if (W) conv_tile(tile, st, W, N, WT, ldt, tn, tk, mode);
    else { __syncthreads(); __syncthreads(); }
}
__device__ __forceinline__ void phase_setup(const Params& P, LAS3 unsigned char* lds) {
    const int tid = opaque_tid(), G = gridDim.x, bid = blockIdx.x;
    for (int it = bid; it < 192; it += G) {
        LAS3 float* sl = (LAS3 float*)lds;
        LAS3 float* red = sl + 9 * 1024;
        __syncthreads();
        for (int i = tid; i < 9 * 1024; i += 512) { const int r = i >> 10, k = i & 1023; sl[i] = siluf_((r < 8) ? P.c[r * 1024 + k] : P.c_ctx[k]); }
        __syncthreads();
        const int l = it / 96, j = (it % 96) * 64 + (tid & 63), kp = tid >> 6;
        const float* w = P.w_mod + (size_t)l * 1024 * 6144 + j;
        float acc[9];
#pragma unroll
        for (int r = 0; r < 9; ++r) acc[r] = 0.f;
        for (int k = kp * 128; k < kp * 128 + 128; ++k) {
            const float wv = w[(size_t)k * 6144];
#pragma unroll
            for (int r = 0; r < 9; ++r) acc[r] += sl[r * 1024 + k] * wv;
        }
#pragma unroll
        for (int r = 0; r < 9; ++r) red[(kp * 9 + r) * 64 + (tid & 63)] = acc[r];
        __syncthreads();
        for (int i = tid; i < 9 * 64; i += 512) {
            const int r = i >> 6, cc = i & 63; float sacc = 0.f;
#pragma unroll
            for (int k2 = 0; k2 < 8; ++k2) sacc += red[(k2 * 9 + r) * 64 + cc];
            const int jj = (it % 96) * 64 + cc;
            P.mod[((size_t)l * 9 + r) * 6144 + jj] = sacc + P.b_mod[l * 6144 + jj];
        }
    }
    for (int i = bid * 512 + tid; i < NS * 16; i += G * 512) {
        const int pos = i >> 4, j = i & 15; const int row = pos / 64, col = pos % 64;
        const float inv = exp2f(-(float)(j & 7) * 1.6609640474436813f), ang = (float)((j < 8) ? row : col) * inv;
        P.ropecs[i * 2] = cosf(ang); P.ropecs[i * 2 + 1] = sinf(ang);
    }
    if (bid == G - 1 && tid < 2) {
        const int l = tid; const float* lam = P.da_lambda + l * 128; float s1 = 0.f, s2 = 0.f;
        for (int i = 0; i < 32; ++i) { s1 += lam[i] * lam[32 + i]; s2 += lam[64 + i] * lam[96 + i]; }
        P.lamfull[l] = expf(s1) - expf(s2) + ((l == 0) ? 0.2f : 0.35550906759096927f);
    }
    for (int it = G - 1 - bid; it < 64; it += G)
        s5_setup_item(lds, it, P.s5_a_re, P.s5_a_im, P.s5_log_step, P.s5_b_re, P.s5_b_im, P.s5_c_re, P.s5_c_im, P.s5KmT, P.s5Smat, P.s5CmT, P.s5A, P.s5A64);
    for (int i = bid * 512 + tid; i < 2 * 144 * 1024 / 8; i += G * 512) {
        const int l = i / (144 * 128), r = i % (144 * 128);
        *(u32x4_t*)(P.w_in_t + ((size_t)l * 2560 + DINC) * 1024 + (size_t)r * 8) = (u32x4_t){0u, 0u, 0u, 0u};
    }
    __syncthreads();
    {
        const int sub = tid >> 8, st = tid & 255;
        LAS3 float* tile = (LAS3 float*)lds + sub * (64 * 65);
        for (int pr = bid; pr * 2 < CV_TOTAL; pr += G) conv_dispatch(P, tile, st, pr * 2 + sub);
    }
}

__device__ __forceinline__ void row_modulate_store(const float (&xv)[16], const float* __restrict__ nw, const float* __restrict__ modr, int shift_off, int scale_off, bf16_t* __restrict__ dst, int lane) {
    float ss = 0.f;
#pragma unroll
    for (int i = 0; i < 16; ++i) ss += xv[i] * xv[i];
    ss = wave_sum(ss);
    const float rstd = rsqrtf(ss * (1.f / DM) + 1e-6f);
#pragma unroll
    for (int j = 0; j < 4; ++j) {
        const int d = j * 256 + lane * 4;
        const float4 w = *(const float4*)(nw + d), sc = *(const float4*)(modr + scale_off + d), sh = *(const float4*)(modr + shift_off + d);
        const float o0 = xv[j * 4 + 0] * rstd * w.x * (1.f + sc.x) + sh.x, o1 = xv[j * 4 + 1] * rstd * w.y * (1.f + sc.y) + sh.y;
        const float o2 = xv[j * 4 + 2] * rstd * w.z * (1.f + sc.z) + sh.z, o3 = xv[j * 4 + 3] * rstd * w.w * (1.f + sc.w) + sh.w;
        *(uint2*)(dst + d) = make_uint2(cvtpk(o0, o1), cvtpk(o2, o3));
    }
}
__device__ __forceinline__ void phase_h0(const Params& P) {
    const int tid = opaque_tid(); const int lane = tid & 63, gw = blockIdx.x * 8 + (tid >> 6), NW = gridDim.x * 8;
    for (int t = gw; t < TT; t += NW) {
        const int b = t / NT, n = t % NT;
        const float* src = (n < NC) ? P.ctx + ((size_t)b * NC + n) * DM : P.x + ((size_t)b * NS + (n - NC)) * DM;
        float xv[16];
#pragma unroll
        for (int j = 0; j < 4; ++j) { const float4 v = *(const float4*)(src + j * 256 + lane * 4); xv[j * 4] = v.x; xv[j * 4 + 1] = v.y; xv[j * 4 + 2] = v.z; xv[j * 4 + 3] = v.w;
            *(float4*)(P.xall + (size_t)t * DM + j * 256 + lane * 4) = v; }
        row_modulate_store(xv, P.norm_w, P.mod + (size_t)((n < NC) ? 8 : b) * 6144, 0, 1024, P.hbuf + (size_t)t * DM, lane);
    }
}

__device__ __forceinline__ void prep_da(const Params& P, LAS3 unsigned char* lds, int tile) {
    const int tid = opaque_tid(), c = tid & 255, half = tid >> 8, h = c >> 6, rr = c & 63, d = rr & 31;
    const int t0 = tile * 64, b = t0 / NT, n0 = t0 % NT;
    LAS3 bf16_t* vs = (LAS3 bf16_t*)lds;
    const float qscale = 0.17677669529663687f * 1.4426950408889634f;
    __syncthreads();
    for (int i = half * 32; i < half * 32 + 32; ++i) {
        const int n = n0 + i; const bf16_t* pr = P.pb + (size_t)(t0 + i) * DIN;
        float qv = bf2f(pr[P_DAQ + c]), kv = bf2f(pr[P_DAK + c]);
        if (n >= NC) {
            const int pos = n - NC, j = d & 15;
            const float co = P.ropecs[(pos * 16 + j) * 2], si = P.ropecs[(pos * 16 + j) * 2 + 1];
            const int cp = (d < 16) ? c + 16 : c - 16;
            const float qo = bf2f(pr[P_DAQ + cp]), ko = bf2f(pr[P_DAK + cp]);
            if (d < 16) { qv = qv * co - qo * si; kv = kv * co - ko * si; }
            else        { qv = qv * co + qo * si; kv = kv * co + ko * si; }
        }
        const size_t o = (((size_t)b * 4 + h) * NT + n) * 64 + rr;
        P.daQ[o] = f2bf(qv * qscale); P.daK[o] = f2bf(kv);
        vs[c * 72 + i] = pr[P_DAV + c];
    }
    __syncthreads();
    { const int row = tid >> 1, hf = tid & 1;
      bf16_t* vp = P.daVt + (((size_t)b * 4 + (row >> 6)) * 64 + (row & 63)) * NT + n0 + hf * 32;
#pragma unroll
      for (int qq = 0; qq < 4; ++qq) *(u32x4_t*)(vp + qq * 8) = *(const LAS3 u32x4_t*)(vs + row * 72 + hf * 32 + qq * 8); }
}
__device__ __forceinline__ void prep_ml(const Params& P, LAS3 unsigned char* lds, int tile, int l) {
    const int tid = opaque_tid(), c = tid & 255, half = tid >> 8, h = c >> 6, d = c & 63;
    const int t0 = tile * 64, b = t0 / NT, n0 = t0 % NT;
    LAS3 bf16_t* ks = (LAS3 bf16_t*)lds; LAS3 bf16_t* vs = ks + 256 * 72;
    const int seg_lo = (n0 < NC) ? 0 : NC, seg_hi = (n0 < NC) ? NC - 1 : NT - 1;
    const float* cw = P.ml_conv_w + l * 3 * 512; const float* cb = P.ml_conv_b + l * 512; const float* gb = P.ml_gate_b + l * 16;
    const float wq0 = cw[c], wq1 = cw[512 + c], wq2 = cw[1024 + c], bq = cb[c];
    const float wk0 = cw[256 + c], wk1 = cw[512 + 256 + c], wk2 = cw[1024 + 256 + c], bk = cb[256 + c];
    __syncthreads();
    for (int i = half * 32; i < half * 32 + 32; ++i) {
        const int n = n0 + i; const size_t t = (size_t)t0 + i;
        const bf16_t* pr = P.pb + t * DIN;
        float yq = bq, yk = bk;
        if (n - 1 >= seg_lo) { yq += bf2f(pr[-DIN + P_MLQK + c]) * wq0; yk += bf2f(pr[-DIN + P_MLQK + 256 + c]) * wk0; }
        yq += bf2f(pr[P_MLQK + c]) * wq1; yk += bf2f(pr[P_MLQK + 256 + c]) * wk1;
        if (n + 1 <= seg_hi) { yq += bf2f(pr[DIN + P_MLQK + c]) * wq2; yk += bf2f(pr[DIN + P_MLQK + 256 + c]) * wk2; }
        yq = siluf_(yq); yk = siluf_(yk) * 0.125f;
        const size_t o = (((size_t)b * 4 + h) * NT + n) * 64 + d;
        P.mlQ[o] = f2bf(yq); const bf16_t kb = f2bf(yk); P.mlK[o] = kb; ks[c * 72 + i] = kb; vs[c * 72 + i] = pr[P_MLV + c];
        if (c < 16) {
            float g = bf2f(pr[P_MLG + c]) + gb[c];
            if ((c >> 2) & 1) g = logsigmoidf_(g);
            P.mlG[t * 16 + c] = g;
        }
    }
    __syncthreads();
    { const int row = tid >> 1, hf = tid & 1;
      const size_t ro = (((size_t)b * 4 + (row >> 6)) * 64 + (row & 63)) * NT + n0 + hf * 32;
#pragma unroll
      for (int qq = 0; qq < 4; ++qq) { *(u32x4_t*)(P.mlKt + ro + qq * 8) = *(const LAS3 u32x4_t*)(ks + row * 72 + hf * 32 + qq * 8);
                                       *(u32x4_t*)(P.mlVt + ro + qq * 8) = *(const LAS3 u32x4_t*)(vs + row * 72 + hf * 32 + qq * 8); } }
}
__device__ __forceinline__ void prep_mla(const Params& P, LAS3 unsigned char* lds, int tile, int l) {
    const int tid = opaque_tid(), wid = tid >> 6, lane = tid & 63, lr = lane & 15, q = lane >> 4;
    const int t0 = tile * 64, b = t0 / NT, n0 = t0 % NT;
    constexpr int AROW = 328;
    LAS3 bf16_t* As = (LAS3 bf16_t*)lds;
    const float qscale = 0.10206207261596575f * 1.4426950408889634f;
    const float* qn = P.mla_q_norm + l * 192; const float* kvn = P.mla_kv_norm + l * 128;
    __syncthreads();
    for (int i = wid * 8; i < wid * 8 + 8; ++i) {
        const bf16_t* pr = P.pb + (size_t)(t0 + i) * DIN;
        const float v0 = bf2f(pr[P_CQ + lane]), v1 = bf2f(pr[P_CQ + 64 + lane]), v2 = bf2f(pr[P_CQ + 128 + lane]);
        const float r = rsqrtf(wave_sum(v0 * v0 + v1 * v1 + v2 * v2) * (1.f / 192.f) + 1e-6f);
        As[i * AROW + lane] = f2bf(v0 * r * qn[lane]); As[i * AROW + 64 + lane] = f2bf(v1 * r * qn[64 + lane]); As[i * AROW + 128 + lane] = f2bf(v2 * r * qn[128 + lane]);
        const float w0 = bf2f(pr[P_CKV + lane]), w1 = bf2f(pr[P_CKV + 64 + lane]);
        const float r2 = rsqrtf(wave_sum(w0 * w0 + w1 * w1) * (1.f / 128.f) + 1e-6f);
        As[i * AROW + 192 + lane] = f2bf(w0 * r2 * kvn[lane]); As[i * AROW + 256 + lane] = f2bf(w1 * r2 * kvn[64 + lane]);
    }
    for (int e = tid; e < 64 * 32; e += 512) {
        const int i = e >> 5, d = e & 31, n = n0 + i;
        const bf16_t* pr = P.pb + (size_t)(t0 + i) * DIN;
        float kv = bf2f(pr[P_KR + d]);
        if (n >= NC) {
            const int pos = n - NC, jj = d & 15;
            const float co = P.ropecs[(pos * 16 + jj) * 2], si = P.ropecs[(pos * 16 + jj) * 2 + 1];
            const float ko = bf2f(pr[P_KR + ((d < 16) ? d + 16 : d - 16)]);
            kv = (d < 16) ? (kv * co - ko * si) : (kv * co + ko * si);
        }
        const bf16_t kb = f2bf(kv);
#pragma unroll
        for (int hh = 0; hh < 4; ++hh) P.mK[(((size_t)b * 4 + hh) * NT + n) * 96 + 64 + d] = kb;
    }
    __syncthreads();
    const int h = wid >> 1;
    if ((wid & 1) == 0) {
        const bf16_t* wt = P.wq_t + (size_t)l * 384 * 192;
        f32x4_t acc[4][6];
#pragma unroll
        for (int rt = 0; rt < 4; ++rt)
#pragma unroll
            for (int ct = 0; ct < 6; ++ct) acc[rt][ct] = (f32x4_t){0.f, 0.f, 0.f, 0.f};
#pragma unroll
        for (int ks = 0; ks < 6; ++ks) {
            bf16x8_t a[4];
#pragma unroll
            for (int rt = 0; rt < 4; ++rt) a[rt] = *(const LAS3 bf16x8_t*)(As + (16 * rt + lr) * AROW + 32 * ks + 8 * q);
#pragma unroll
            for (int ct = 0; ct < 6; ++ct) {
                const bf16x8_t bb = *(const bf16x8_t*)(wt + (size_t)(h * 96 + 16 * ct + lr) * 192 + 32 * ks + 8 * q);
#pragma unroll
                for (int rt = 0; rt < 4; ++rt) acc[rt][ct] = __builtin_amdgcn_mfma_f32_16x16x32_bf16(a[rt], bb, acc[rt][ct], 0, 0, 0);
            }
        }
#pragma unroll
        for (int rt = 0; rt < 4; ++rt)
#pragma unroll
            for (int rg = 0; rg < 4; ++rg) {
                const int n = n0 + 16 * rt + 4 * q + rg;
                bf16_t* qp = P.mQ + (((size_t)b * 4 + h) * NT + n) * 96;
#pragma unroll
                for (int ct = 0; ct < 4; ++ct) qp[16 * ct + lr] = f2bf(acc[rt][ct][rg] * qscale);
                float x1 = acc[rt][4][rg], x2 = acc[rt][5][rg];
                if (n >= NC) {
                    const int pos = n - NC;
                    const float co = P.ropecs[(pos * 16 + lr) * 2], si = P.ropecs[(pos * 16 + lr) * 2 + 1];
                    const float o1 = x1 * co - x2 * si, o2 = x2 * co + x1 * si; x1 = o1; x2 = o2;
                }
                qp[64 + lr] = f2bf(x1 * qscale); qp[80 + lr] = f2bf(x2 * qscale);
            }
    } else {
        const bf16_t* wt = P.wkv_t + (size_t)l * 512 * 128;
        f32x4_t acc[4][8];
#pragma unroll
        for (int rt = 0; rt < 4; ++rt)
#pragma unroll
            for (int ct = 0; ct < 8; ++ct) acc[rt][ct] = (f32x4_t){0.f, 0.f, 0.f, 0.f};
#pragma unroll
        for (int ks = 0; ks < 4; ++ks) {
            bf16x8_t a[4];
#pragma unroll
            for (int rt = 0; rt < 4; ++rt) a[rt] = *(const LAS3 bf16x8_t*)(As + (16 * rt + lr) * AROW + 192 + 32 * ks + 8 * q);
#pragma unroll
            for (int ct = 0; ct < 8; ++ct) {
                const bf16x8_t bb = *(const bf16x8_t*)(wt + (size_t)(h * 128 + 16 * ct + lr) * 128 + 32 * ks + 8 * q);
#pragma unroll
                for (int rt = 0; rt < 4; ++rt) acc[rt][ct] = __builtin_amdgcn_mfma_f32_16x16x32_bf16(a[rt], bb, acc[rt][ct], 0, 0, 0);
            }
        }
#pragma unroll
        for (int rt = 0; rt < 4; ++rt) {
#pragma unroll
            for (int rg = 0; rg < 4; ++rg) {
                const int n = n0 + 16 * rt + 4 * q + rg;
                bf16_t* kp = P.mK + (((size_t)b * 4 + h) * NT + n) * 96;
#pragma unroll
                for (int ct = 0; ct < 4; ++ct) kp[16 * ct + lr] = f2bf(acc[rt][ct][rg]);
            }
#pragma unroll
            for (int ct = 4; ct < 8; ++ct) {
                bf16_t* vp = P.mVt + (((size_t)b * 4 + h) * 64 + 16 * (ct - 4) + lr) * NT + n0 + 16 * rt + 4 * q;
                *(uint2*)vp = make_uint2(cvtpk(acc[rt][ct][0], acc[rt][ct][1]), cvtpk(acc[rt][ct][2], acc[rt][ct][3]));
            }
        }
    }
}
__device__ __forceinline__ void phase_prep(const Params& P, LAS3 unsigned char* lds, int l) {
    for (int it = blockIdx.x; it < 3 * (TT / 64); it += gridDim.x) {
        const int fn = it / (TT / 64), tile = it % (TT / 64);
        if (fn == 0) prep_mla(P, lds, tile, l); else if (fn == 1) prep_ml(P, lds, tile, l); else prep_da(P, lds, tile);
    }
}

#ifndef DIRFLIP
#define DIRFLIP 0
#endif
#ifndef DBG_SCALE
#define DBG_SCALE 1.0f
#endif
#ifndef MIXEN
#define MIXEN 63
#endif
__device__ __forceinline__ void phase_mix(const Params& P, LAS3 unsigned char* lds, int l) {
    const int bid = blockIdx.x, G = gridDim.x;
    const float lambda_init = (l == 0) ? 0.2f : 0.35550906759096927f;
    if (MIXEN & 1) for (int it = bid; it < 256; it += G)
        attn_item<64, 2, true>(lds, P.daQ, P.daK, P.daVt, P.ycatb, 0, it >> 5, (it >> 3) & 3, 1 + (it & 7), P.lamfull[l], P.da_subln + l * 64, 1.f - lambda_init);
    if (MIXEN & 2) for (int it = bid; it < 64; it += G)
        mlstm_item(lds, P.mlQ, P.mlK, P.mlKt, P.mlVt, P.mlG, P.hdir, it >> 3, (it >> 1) & 3, (it & 1) ^ DIRFLIP);
    if (MIXEN & 4) for (int it = bid; it < 256; it += G)
        attn_item<96, 1, false>(lds, P.mQ, P.mK, P.mVt, P.ycatb, 512, it >> 5, (it >> 3) & 3, 1 + (it & 7), 0.f, nullptr, 1.f);
    {
        const int s0 = (G == 256) ? ((bid >= 128) ? 2 * (bid - 128) : 256) : bid, s1 = (G == 256) ? ((bid >= 128) ? s0 + 2 : 256) : 256, sst = (G == 256) ? 1 : G;
        if (MIXEN & 8) for (int it = s0; it < s1; it += sst)
            s5_item(lds, P.pb, P.s5KmT + (size_t)l * 32 * 16 * 1024, P.s5Smat + (size_t)l * 32 * 128 * 1024, P.s5CmT + (size_t)l * 32 * 16 * 128,
                    P.s5A + l * 32 * 64 * 2, P.s5A64 + l * 32 * 64 * 2, P.s5xs, P.ys5, it >> 5, (it >> 1) & 15, it & 1);
    }
    if (l == 0 && (MIXEN & 16)) {
        for (int it = bid; it < 32; it += G)
            attn_item<64, 2, true>(lds, P.daQ, P.daK, P.daVt, P.ycatb, 0, it >> 2, it & 3, 0, P.lamfull[l], P.da_subln + l * 64, 1.f - lambda_init);
        for (int it = bid - 32; it >= 0 && it < 32; it += G)
            attn_item<96, 1, false>(lds, P.mQ, P.mK, P.mVt, P.ycatb, 512, it >> 2, it & 3, 0, 0.f, nullptr, 1.f);
    }
}

__device__ __forceinline__ void phase_finish(const Params& P, LAS3 unsigned char* lds, int l) {
    const int tid = opaque_tid(), wid = tid >> 6, lane = tid & 63, lr = lane & 15, q = lane >> 4, c = tid & 255, half = tid >> 8;
    const int ntile = (l == 0) ? TT / 64 : NB * 32;
    constexpr int GROW = 264;
    LAS3 bf16_t* Gs = (LAS3 bf16_t*)lds;
    const float* mn = P.ml_norm + l * 256; const float* dsk = P.s5_d + l * 256; const float* bgl = P.s5_b_glu + l * 256;
    const bf16_t* wg = P.wglu_t + (size_t)l * 256 * 256;
    for (int it = blockIdx.x; it < ntile; it += gridDim.x) {
        const int t0 = (l == 0) ? it * 64 : ((it >> 5) * NT + NC + (it & 31) * 64);
        __syncthreads();
        for (int i = half * 32; i < half * 32 + 32; ++i) {
            const size_t t = (size_t)t0 + i;
            const bf16_t* pr = P.pb + t * DIN;
            const float hv = sigmoidf_(bf2f(pr[P_MLO + c])) * (P.hdir[t * 256 + c] + P.hdir[((size_t)TT + t) * 256 + c]);
            const float r = rsqrtf(wave_sum(hv * hv) * (1.f / 64.f) + 1e-6f);
            P.ycatb[t * DM + 256 + c] = f2bf(hv * r * mn[c]);
            const float y = P.ys5[t * 256 + c] + P.ys5[((size_t)TT + t) * 256 + c] + bf2f(pr[P_S5 + c]) * dsk[c];
            Gs[i * GROW + c] = f2bf(gelu_tanh_(y));
        }
        __syncthreads();
        f32x4_t acc[4][2];
#pragma unroll
        for (int rt = 0; rt < 4; ++rt) { acc[rt][0] = (f32x4_t){0.f, 0.f, 0.f, 0.f}; acc[rt][1] = (f32x4_t){0.f, 0.f, 0.f, 0.f}; }
#pragma unroll
        for (int ks = 0; ks < 8; ++ks) {
            const bf16x8_t b0 = *(const bf16x8_t*)(wg + (size_t)(32 * wid + lr) * 256 + 32 * ks + 8 * q);
            const bf16x8_t b1 = *(const bf16x8_t*)(wg + (size_t)(32 * wid + 16 + lr) * 256 + 32 * ks + 8 * q);
#pragma unroll
            for (int rt = 0; rt < 4; ++rt) {
                const bf16x8_t a = *(const LAS3 bf16x8_t*)(Gs + (16 * rt + lr) * GROW + 32 * ks + 8 * q);
                acc[rt][0] = __builtin_amdgcn_mfma_f32_16x16x32_bf16(a, b0, acc[rt][0], 0, 0, 0);
                acc[rt][1] = __builtin_amdgcn_mfma_f32_16x16x32_bf16(a, b1, acc[rt][1], 0, 0, 0);
            }
        }
#pragma unroll
        for (int rt = 0; rt < 4; ++rt)
#pragma unroll
            for (int cc = 0; cc < 2; ++cc)
#pragma unroll
                for (int rg = 0; rg < 4; ++rg) {
                    const int row = 16 * rt + 4 * q + rg, col = 32 * wid + 16 * cc + lr;
                    const float gv = bf2f(Gs[row * GROW + col]);
                    P.ycatb[((size_t)t0 + row) * DM + 768 + col] = f2bf(gv * sigmoidf_(acc[rt][cc][rg] + bgl[col]));
                }
    }
}

__device__ __forceinline__ void phase_post(const Params& P, LAS3 unsigned char* lds, int l) {
    const int tid = opaque_tid(), wid = tid >> 6, lane = tid & 63, lr = lane & 15, q = lane >> 4;
    constexpr int FROW = 1028;
    LAS3 float* ft = (LAS3 float*)lds;
    LAS3 float* pl = ft + 16 * FROW;
    const float* nw1 = P.norm_w + (size_t)l * 4096 + 1024; const float* nw2 = nw1 + 1024;
    const float* wr = P.moe_w_router + (size_t)l * 1024 * 32; const float* br = P.moe_b_router + l * 32;
    int* cnt = P.cnt + l * 32;
    float breg[32][2];
#pragma unroll
    for (int ks = 0; ks < 32; ++ks) { breg[ks][0] = wr[(size_t)(128 * wid + 4 * ks + q) * 32 + lr]; breg[ks][1] = wr[(size_t)(128 * wid + 4 * ks + q) * 32 + 16 + lr]; }
    const int nitem = (l == 0) ? TT / 16 : NB * NS / 16;
    const int tr = tid >> 5, part = tid & 31;
    for (int it = blockIdx.x; it < nitem; it += gridDim.x) {
        const int t0 = (l == 0) ? it * 16 : ((it >> 7) * NT + NC + (it & 127) * 16);
        const int t = t0 + tr, b = t / NT, n = t % NT;
        const float* mr = P.mod + ((size_t)l * 9 + ((n < NC) ? 8 : b)) * 6144;
        __syncthreads();
        float x1[32];
        {
            const float* sq = P.osq + (size_t)t * 16; float so = 0.f;
#pragma unroll
            for (int i = 0; i < 16; ++i) so += sq[i];
            const float rstd = rsqrtf(so * (1.f / DM) + 1e-6f);
            float ss = 0.f;
#pragma unroll
            for (int j = 0; j < 8; ++j) {
                const int d = j * 128 + part * 4;
                const uint2 ov = *(const uint2*)(P.ob + (size_t)t * DM + d);
                const float4 xv = *(const float4*)(P.xall + (size_t)t * DM + d), w = *(const float4*)(nw1 + d), g1 = *(const float4*)(mr + 2048 + d);
                const float a0 = xv.x + g1.x * __uint_as_float(ov.x << 16) * rstd * w.x, a1 = xv.y + g1.y * __uint_as_float(ov.x & 0xFFFF0000u) * rstd * w.y;
                const float a2 = xv.z + g1.z * __uint_as_float(ov.y << 16) * rstd * w.z, a3 = xv.w + g1.w * __uint_as_float(ov.y & 0xFFFF0000u) * rstd * w.w;
                x1[j * 4] = a0; x1[j * 4 + 1] = a1; x1[j * 4 + 2] = a2; x1[j * 4 + 3] = a3;
                *(float4*)(P.xall + (size_t)t * DM + d) = make_float4(a0, a1, a2, a3);
                ss += (a0 * a0 + a1 * a1) + (a2 * a2 + a3 * a3);
            }
#pragma unroll
            for (int o = 16; o > 0; o >>= 1) ss += __shfl_xor(ss, o);
            const float rstd2 = rsqrtf(ss * (1.f / DM) + 1e-6f);
#pragma unroll
            for (int j = 0; j < 8; ++j) {
                const int d = j * 128 + part * 4;
                const float4 w = *(const float4*)(nw2 + d), sh = *(const float4*)(mr + 3072 + d), sc = *(const float4*)(mr + 4096 + d);
                const float f0 = x1[j * 4] * rstd2 * w.x * (1.f + sc.x) + sh.x, f1 = x1[j * 4 + 1] * rstd2 * w.y * (1.f + sc.y) + sh.y;
                const float f2 = x1[j * 4 + 2] * rstd2 * w.z * (1.f + sc.z) + sh.z, f3 = x1[j * 4 + 3] * rstd2 * w.w * (1.f + sc.w) + sh.w;
                *(uint2*)(P.fb + (size_t)t * DM + d) = make_uint2(cvtpk(f0, f1), cvtpk(f2, f3));
                *(LAS3 f32x4_t*)(ft + tr * FROW + d) = (f32x4_t){f0, f1, f2, f3};
            }
        }
        __syncthreads();
        {
            f32x4_t a0 = (f32x4_t){0.f, 0.f, 0.f, 0.f}, a1 = (f32x4_t){0.f, 0.f, 0.f, 0.f};
#pragma unroll
            for (int ks = 0; ks < 32; ++ks) {
                const float av = ft[lr * FROW + 128 * wid + 4 * ks + q];
                a0 = __builtin_amdgcn_mfma_f32_16x16x4f32(av, breg[ks][0], a0, 0, 0, 0);
                a1 = __builtin_amdgcn_mfma_f32_16x16x4f32(av, breg[ks][1], a1, 0, 0, 0);
            }
#pragma unroll
            for (int rg = 0; rg < 4; ++rg) { pl[(wid * 16 + 4 * q + rg) * 32 + lr] = a0[rg]; pl[(wid * 16 + 4 * q + rg) * 32 + 16 + lr] = a1[rg]; }
        }
        __syncthreads();
        {
            float lg = br[part];
#pragma unroll
            for (int w = 0; w < 8; ++w) lg += pl[(w * 16 + tr) * 32 + part];
            float v[4]; int sidx[4];
            float cur = lg;
#pragma unroll
            for (int k = 0; k < 4; ++k) {
                float bv = cur; int bi = part;
#pragma unroll
                for (int o = 16; o > 0; o >>= 1) {
                    const float ov = __shfl_xor(bv, o); const int oi = __shfl_xor(bi, o);
                    if (ov > bv || (ov == bv && oi < bi)) { bv = ov; bi = oi; }
                }
                v[k] = bv; sidx[k] = bi;
                if (part == bi) cur = -3.4e38f;
            }
            if (part < 4) {
                const float e1 = __expf(v[1] - v[0]), e2 = __expf(v[2] - v[0]), e3 = __expf(v[3] - v[0]);
                const float inv = 1.f / (1.f + e1 + e2 + e3);
                const float gk = (part == 0) ? inv : (part == 1) ? e1 * inv : (part == 2) ? e2 * inv : e3 * inv;
                const int ek = (part == 0) ? sidx[0] : (part == 1) ? sidx[1] : (part == 2) ? sidx[2] : sidx[3];
                P.top_e[(size_t)t * 4 + part] = ek; P.top_g[(size_t)t * 4 + part] = gk;
                P.posb[(size_t)t * 4 + part] = atomicAdd(&cnt[ek], 1);
            }
        }
    }
}

__device__ __forceinline__ void phase_scatter(const Params& P, LAS3 unsigned char* lds, int l) {
    const int tid = opaque_tid(), wid = tid >> 6, lane = tid & 63;
    LAS3 int* soff = (LAS3 int*)lds;
    const int* cnt = P.cnt + l * 32;
    __syncthreads();
    if (tid == 0) {
        int o = 0, nt = 0;
        for (int e = 0; e < NE; ++e) {
            soff[e] = o; const int c = cnt[e]; soff[32 + e] = c;
            const int ntl = (c + 255) >> 8;
            if (blockIdx.x == 0) { for (int m = 0; m < ntl; ++m) P.tile_e[l * 512 + nt + m] = e; P.offs[l * 32 + e] = o; }
            nt += ntl; o = nt * 256;
        }
        if (blockIdx.x == 0) P.ntiles[l * 16] = nt;
    }
    __syncthreads();
    const int gw = blockIdx.x * 8 + wid, NW = gridDim.x * 8;
    const int ntok = (l == 0) ? TT : NB * NS;
    for (int i = gw; i < ntok; i += NW) {
        const int t = (l == 0) ? i : ((i >> 11) * NT + NC + (i & 2047));
        const u32x4_t r0 = *(const u32x4_t*)(P.fb + (size_t)t * DM + lane * 8), r1 = *(const u32x4_t*)(P.fb + (size_t)t * DM + 512 + lane * 8);
#pragma unroll
        for (int k = 0; k < 4; ++k) {
            const int slot = soff[P.top_e[(size_t)t * 4 + k]] + P.posb[(size_t)t * 4 + k];
            *(u32x4_t*)(P.xg + (size_t)slot * DM + lane * 8) = r0; *(u32x4_t*)(P.xg + (size_t)slot * DM + 512 + lane * 8) = r1;
            if (lane == 0) P.tok_slot[(size_t)t * 4 + k] = slot;
        }
    }
    for (int i = gw; i < NE * 256; i += NW) {
        const int e = i >> 8, j = i & 255, c = soff[32 + e];
        const int padn = ((c + 255) & ~255) - c;
        if (j < padn) { const size_t slot = (size_t)soff[e] + c + j;
            *(u32x4_t*)(P.xg + slot * DM + lane * 8) = (u32x4_t){0u, 0u, 0u, 0u}; *(u32x4_t*)(P.xg + slot * DM + 512 + lane * 8) = (u32x4_t){0u, 0u, 0u, 0u}; }
    }
}

__device__ __forceinline__ void phase_combine(const Params& P, int l) {
    const int tid = opaque_tid(); const int lane = tid & 63, gw = blockIdx.x * 8 + (tid >> 6), NW = gridDim.x * 8;
    const float* nw3 = P.norm_w + (size_t)l * 4096 + 3072;
    const int ntok = (l == 0) ? TT : NB * NS;
    for (int i = gw; i < ntok; i += NW) {
        const int t = (l == 0) ? i : ((i >> 11) * NT + NC + (i & 2047));
        const int b = t / NT, n = t % NT;
        const float* mr = P.mod + ((size_t)l * 9 + ((n < NC) ? 8 : b)) * 6144;
        float m[16];
#pragma unroll
        for (int j = 0; j < 16; ++j) m[j] = 0.f;
#pragma unroll
        for (int k = 0; k < 4; ++k) {
            const int slot = P.tok_slot[(size_t)t * 4 + k]; const float gk = P.top_g[(size_t)t * 4 + k];
#pragma unroll
            for (int j = 0; j < 4; ++j) {
                const uint2 yv = *(const uint2*)(P.yexp + (size_t)slot * DM + j * 256 + lane * 4);
                m[j * 4] += gk * __uint_as_float(yv.x << 16); m[j * 4 + 1] += gk * __uint_as_float(yv.x & 0xFFFF0000u);
                m[j * 4 + 2] += gk * __uint_as_float(yv.y << 16); m[j * 4 + 3] += gk * __uint_as_float(yv.y & 0xFFFF0000u);
            }
        }
        float ss = 0.f;
#pragma unroll
        for (int j = 0; j < 16; ++j) ss += m[j] * m[j];
        const float rstd = rsqrtf(wave_sum(ss) * (1.f / DM) + 1e-6f);
        float xv[16];
#pragma unroll
        for (int j = 0; j < 4; ++j) {
            const int d = j * 256 + lane * 4;
            const float4 x1 = *(const float4*)(P.xall + (size_t)t * DM + d), w = *(const float4*)(nw3 + d), g2 = *(const float4*)(mr + 5120 + d);
            xv[j * 4] = x1.x + g2.x * m[j * 4] * rstd * w.x; xv[j * 4 + 1] = x1.y + g2.y * m[j * 4 + 1] * rstd * w.y;
            xv[j * 4 + 2] = x1.z + g2.z * m[j * 4 + 2] * rstd * w.z; xv[j * 4 + 3] = x1.w + g2.w * m[j * 4 + 3] * rstd * w.w;
            const float4 o = make_float4(xv[j * 4], xv[j * 4 + 1], xv[j * 4 + 2], xv[j * 4 + 3]);
            if (l == 0) *(float4*)(P.xall + (size_t)t * DM + d) = o;
            else *(float4*)(P.out + ((size_t)b * NS + (n - NC)) * DM + d) = o;
        }
        if (l == 0) row_modulate_store(xv, P.norm_w + 4096, P.mod + ((size_t)9 + ((n < NC) ? 8 : b)) * 6144, 0, 1024, P.hbuf + (size_t)t * DM, lane);
    }
}

extern __shared__ __attribute__((aligned(16))) unsigned char dyn_lds[];
__device__ __forceinline__ void run_phase(const Params& P, LAS3 unsigned char* lds, int ph) {
#ifdef ONLY_S
    if (ph == PH_SETUP) { if (ONLY_S == 100) phase_setup(P, lds); return; }
    if (ph == PH_H0) { if (ONLY_S == 101) phase_h0(P); return; }
    if ((ph - PH_LAYER0) % PH_PER_LAYER != ONLY_S) return;
#endif
    if (ph == PH_SETUP) { phase_setup(P, lds); return; }
    if (ph == PH_H0) { phase_h0(P); return; }
    const int l = (ph - PH_LAYER0) / PH_PER_LAYER, s = (ph - PH_LAYER0) % PH_PER_LAYER;
    switch (s) {
    case L_GEMM_IN: { pg8::Gemm g{P.hbuf, P.w_in_t + (size_t)l * 2560 * 1024, TT, 2560, 1024, 0}; pg8::StaticOrder S; S.init(TT, 2560, gridDim.x, blockIdx.x);
        pg8::EpiBf16P E{P.pb, DIN, 0}; pg8::gemm_phase<pg8::EpiBf16P, pg8::StaticOrder>(lds, g, S, E); } break;
    case L_PREP: phase_prep(P, lds, l); break;
    case L_MIX: phase_mix(P, lds, l); break;
    case L_FINISH: phase_finish(P, lds, l); break;
    case L_GEMM_OUT: { pg8::Gemm g{P.ycatb, P.w_out_t + (size_t)l * 1024 * 1024, TT, 1024, 1024, 0}; pg8::EpiOut E{P.ob, P.osq};
        if (l == 0) { pg8::StaticOrder S; S.init(TT, 1024, gridDim.x, blockIdx.x); pg8::gemm_phase<pg8::EpiOut, pg8::StaticOrder>(lds, g, S, E); }
        else { pg8::LatOrder S; S.initl(1024, gridDim.x, blockIdx.x); pg8::gemm_phase<pg8::EpiOut, pg8::LatOrder>(lds, g, S, E); } } break;
    case L_POST: phase_post(P, lds, l); break;
    case L_SCATTER: phase_scatter(P, lds, l); break;
    case L_GEMM_GU: { pg8::Gemm g{P.xg, P.wgu_t + (size_t)l * NE * 2048 * 1024, 0, 2048, 1024, 0}; pg8::GroupedOrder S; S.initg(P.ntiles + l * 16, P.tile_e + l * 512, 2048, gridDim.x, blockIdx.x);
        pg8::EpiSwiglu E{P.act, P.moe_b_gate_up + (size_t)l * NE * 2048}; pg8::gemm_phase<pg8::EpiSwiglu, pg8::GroupedOrder>(lds, g, S, E); } break;
    case L_GEMM_DN: { pg8::Gemm g{P.act, P.wdn_t + (size_t)l * NE * 1024 * 1024, 0, 1024, 1024, 0}; pg8::GroupedOrder S; S.initg(P.ntiles + l * 16, P.tile_e + l * 512, 1024, gridDim.x, blockIdx.x);
        pg8::EpiDown E{P.yexp, P.moe_b_down + (size_t)l * NE * 1024}; pg8::gemm_phase<pg8::EpiDown, pg8::GroupedOrder>(lds, g, S, E); } break;
    case L_COMBINE: phase_combine(P, l); break;
    }
}
__global__ void __launch_bounds__(512, 2) mk_fwd(Params Pk, int ph_lo, int ph_hi) {
    LAS3 unsigned char* lds = (LAS3 unsigned char*)dyn_lds;
    volatile LAS3 unsigned* st = (volatile LAS3 unsigned*)(lds + MK_LDS_MAIN);
    LAS3 Params* PL = (LAS3 Params*)(lds + MK_LDS_MAIN + 64);
    static_assert(sizeof(Params) <= 1024, "Params copy does not fit its LDS slot");
    if (threadIdx.x < 4) st[threadIdx.x] = 0u;
    if (threadIdx.x == 64) store_params(PL, Pk);
    unsigned* barw = Pk.bar;
    __syncthreads();
    XcdBarrier bar; bar.bar = barw; bar.x = 0; bar.st = st;
    if (ph_hi - ph_lo > 1) bar = xcd_barrier_post(barw, st);
#define MK_RUN(ph) if (ph_lo <= (ph) && (ph) < ph_hi) { { const LAS3 Params* PLo = PL; asm volatile("" : "+v"(PLo)); LAS3 unsigned char* ldsp = lds; asm volatile("" : "+s"(ldsp)); \
        const Params P = load_params(PLo); run_phase(P, ldsp, (ph)); } if ((ph) + 1 < ph_hi) xcd_barrier(bar); }
    MK_RUN(0) MK_RUN(1) MK_RUN(2) MK_RUN(3) MK_RUN(4) MK_RUN(5) MK_RUN(6) MK_RUN(7) MK_RUN(8) MK_RUN(9) MK_RUN(10) MK_RUN(11)
    MK_RUN(12) MK_RUN(13) MK_RUN(14) MK_RUN(15) MK_RUN(16) MK_RUN(17) MK_RUN(18) MK_RUN(19) MK_RUN(20) MK_RUN(21)
#undef MK_RUN
}

__global__ void k_dbg_dump(const bf16_t* __restrict__ src, float* __restrict__ out, size_t n, size_t srcn) {
    for (size_t i = (size_t)blockIdx.x * 256 + threadIdx.x; i < n; i += (size_t)gridDim.x * 256) out[i] = bf2f(src[i % srcn]);
}
__global__ void k_dbg_dumpf(const float* __restrict__ src, float* __restrict__ out, size_t n, size_t srcn) {
    for (size_t i = (size_t)blockIdx.x * 256 + threadIdx.x; i < n; i += (size_t)gridDim.x * 256) out[i] = src[i % srcn];
}
struct DbgList { const bf16_t* b[12]; size_t nb[12]; const float* f[4]; size_t nf[4]; };
__global__ void k_dbg_sum(DbgList L, float* __restrict__ out, size_t n) {
    for (size_t i = (size_t)blockIdx.x * 256 + threadIdx.x; i < n; i += (size_t)gridDim.x * 256) {
        float s = 0.f;
        for (int k = 0; k < 12; ++k) if (L.b[k]) s += bf2f(L.b[k][i % L.nb[k]]);
        for (int k = 0; k < 4; ++k) if (L.f[k]) { float v = L.f[k][i % L.nf[k]]; s += (v == v && fabsf(v) < 1e30f) ? v : 12345.f; }
        out[i] = s;
    }
}
__global__ void k_dbg_cols(const bf16_t* __restrict__ y, const float* __restrict__ ys5, float* __restrict__ out, size_t n) {
    for (size_t i = (size_t)blockIdx.x * 256 + threadIdx.x; i < n; i += (size_t)gridDim.x * 256) {
        const size_t row = (i >> 9) % TT; const int c = (int)(i & 511);
        out[i] = bf2f(y[row * DM + (c < 256 ? c : 256 + c)]) + (ys5 ? ys5[i % ((size_t)2 * TT * 256)] : 0.f);
    }
}
__global__ void k_dbg_hd(const float* __restrict__ hdir, float* __restrict__ out, size_t n, int dir, int nlo, int nhi) {
    const int span = nhi - nlo;
    for (size_t i = (size_t)blockIdx.x * 256 + threadIdx.x; i < n; i += (size_t)gridDim.x * 256) {
        const size_t e = i % ((size_t)NB * span * 256); const int b = (int)(e / ((size_t)span * 256)); const size_t r = e % ((size_t)span * 256);
        out[i] = hdir[((size_t)dir * TT + (size_t)b * NT + nlo) * 256 + r];
    }
}
__global__ void k_dbg_scale(const float* __restrict__ src, float* __restrict__ out, size_t n, size_t srcn, float sc) {
    for (size_t i = (size_t)blockIdx.x * 256 + threadIdx.x; i < n; i += (size_t)gridDim.x * 256) out[i] = src[i % srcn] * sc;
}
__global__ void k_dbg_cols2(const bf16_t* __restrict__ y, float* __restrict__ out, size_t n, int c0) {
    for (size_t i = (size_t)blockIdx.x * 256 + threadIdx.x; i < n; i += (size_t)gridDim.x * 256) {
        const size_t row = (i >> 8) % TT; const int c = (int)(i & 255);
        out[i] = bf2f(y[row * DM + c0 + c]);
    }
}
__global__ void k_dbg_rows(const bf16_t* __restrict__ y, float* __restrict__ out, size_t n, int c0, int nlo, int nhi) {
    const int span = nhi - nlo;
    for (size_t i = (size_t)blockIdx.x * 256 + threadIdx.x; i < n; i += (size_t)gridDim.x * 256) {
        const size_t e = (i >> 8) % ((size_t)NB * span); const int b = (int)(e / span), nn = nlo + (int)(e % span); const int c = (int)(i & 255);
        out[i] = bf2f(y[((size_t)b * NT + nn) * DM + c0 + c]);
    }
}
__global__ void k_dbg_rowsb(const bf16_t* __restrict__ y, float* __restrict__ out, size_t n, int c0, int nlo, int nhi, int b0, int nb) {
    const int span = nhi - nlo;
    for (size_t i = (size_t)blockIdx.x * 256 + threadIdx.x; i < n; i += (size_t)gridDim.x * 256) {
        const size_t e = (i >> 8) % ((size_t)nb * span); const int b = b0 + (int)(e / span), nn = nlo + (int)(e % span); const int c = (int)(i & 255);
        out[i] = bf2f(y[((size_t)b * NT + nn) * DM + c0 + c]) * DBG_SCALE;
    }
}
extern "C" void kernel_launch(void* const* d_in, const int* in_sizes, int n_in, void* d_out, int out_size, void* d_ws, size_t ws_size, hipStream_t stream) {
    Params P{};
    const float** pin = (const float**)&P;
    for (int i = 0; i < 35; ++i) pin[i] = (const float*)d_in[i];
    P.out = (float*)d_out;
    char* ws = (char*)d_ws; size_t off = 0;
    auto carve = [&](size_t bytes) { void* p = ws + off; off += (bytes + 255) & ~(size_t)255; return p; };
    const size_t ctl_bytes = XCD_BAR_WORDS * 4 + 256 + 256;
    P.bar = (unsigned*)carve(XCD_BAR_WORDS * 4); P.queue = (int*)carve(256); P.cnt = (int*)carve(256);
    P.tile_e = (int*)carve(2 * 512 * 4); P.ntiles = (int*)carve(2 * 16 * 4); P.offs = (int*)carve(2 * 32 * 4);
    P.xall = (float*)carve((size_t)TT * DM * 4); P.mod = (float*)carve((size_t)2 * 9 * 6144 * 4); P.ropecs = (float*)carve((size_t)NS * 16 * 2 * 4); P.lamfull = (float*)carve(256);
    P.w_in_t = (bf16_t*)carve((size_t)2 * 2560 * 1024 * 2); P.w_out_t = (bf16_t*)carve((size_t)2 * 1024 * 1024 * 2);
    P.wgu_t = (bf16_t*)carve((size_t)2 * NE * 2048 * 1024 * 2); P.wdn_t = (bf16_t*)carve((size_t)2 * NE * 1024 * 1024 * 2);
    P.wq_t = (bf16_t*)carve((size_t)2 * 384 * 192 * 2); P.wkv_t = (bf16_t*)carve((size_t)2 * 512 * 128 * 2); P.wglu_t = (bf16_t*)carve((size_t)2 * 256 * 256 * 2);
    P.s5KmT = (bf16_t*)carve((size_t)64 * 16 * 1024 * 2); P.s5Smat = (bf16_t*)carve((size_t)64 * 128 * 1024 * 2); P.s5CmT = (bf16_t*)carve((size_t)64 * 16 * 128 * 2);
    P.s5A = (float*)carve(64 * 64 * 2 * 4); P.s5A64 = (float*)carve(64 * 64 * 2 * 4); P.s5xs = (float*)carve((size_t)256 * 36 * 128 * 4);
    P.hbuf = (bf16_t*)carve((size_t)TT * DM * 2); P.pb = (bf16_t*)carve((size_t)TT * DIN * 2);
    P.daQ = (bf16_t*)carve((size_t)TT * 256 * 2); P.daK = (bf16_t*)carve((size_t)TT * 256 * 2); P.daVt = (bf16_t*)carve((size_t)TT * 256 * 2);
    P.mQ = (bf16_t*)carve((size_t)TT * 384 * 2); P.mK = (bf16_t*)carve((size_t)TT * 384 * 2); P.mVt = (bf16_t*)carve((size_t)TT * 256 * 2);
    P.mlQ = (bf16_t*)carve((size_t)TT * 256 * 2); P.mlK = (bf16_t*)carve((size_t)TT * 256 * 2); P.mlKt = (bf16_t*)carve((size_t)TT * 256 * 2); P.mlVt = (bf16_t*)carve((size_t)TT * 256 * 2);
    P.mlG = (float*)carve((size_t)TT * 16 * 4); P.hdir = (float*)carve((size_t)2 * TT * 256 * 4); P.ys5 = (float*)carve((size_t)2 * TT * 256 * 4);
    P.ycatb = (bf16_t*)carve((size_t)TT * DM * 2); P.ob = (bf16_t*)carve((size_t)TT * DM * 2); P.osq = (float*)carve((size_t)TT * 16 * 4); P.fb = (bf16_t*)carve((size_t)TT * DM * 2);
    P.top_e = (int*)carve((size_t)NASSIGN * 4); P.top_g = (float*)carve((size_t)NASSIGN * 4); P.posb = (int*)carve((size_t)NASSIGN * 4); P.tok_slot = (int*)carve((size_t)NASSIGN * 4);
    P.xg = (bf16_t*)carve((size_t)MAXSLOTS * DM * 2); P.act = (bf16_t*)carve((size_t)MAXSLOTS * DM * 2); P.yexp = (bf16_t*)carve((size_t)MAXSLOTS * DM * 2);
    if (off > ws_size) { fprintf(stderr, "kernel_launch: workspace too small: need %zu have %zu\n", off, ws_size); return; }
    static bool attr_done = false;
    if (!attr_done) {
        if (hipFuncSetAttribute((const void*)mk_fwd, hipFuncAttributeMaxDynamicSharedMemorySize, MK_LDS_BYTES) != hipSuccess) fprintf(stderr, "kernel_launch: hipFuncSetAttribute failed\n");
        attr_done = true;
    }
    (void)hipMemsetAsync(d_ws, 0, ctl_bytes, stream);
#if MK_ONE_LAUNCH
    hipLaunchKernelGGL(mk_fwd, dim3(256), dim3(512), MK_LDS_BYTES, stream, P, 0, (int)PH_TOTAL);
#else
#ifdef DBG_LAST
    for (int ph = 0; ph <= DBG_LAST; ++ph) hipLaunchKernelGGL(mk_fwd, dim3(256), dim3(512), MK_LDS_BYTES, stream, P, ph, ph + 1);
    DBG_DUMP;
#else
    for (int ph = 0; ph < PH_TOTAL; ++ph) hipLaunchKernelGGL(mk_fwd, dim3(256), dim3(512), MK_LDS_BYTES, stream, P, ph, ph + 1);
#endif
#endif
}
```

```cpp
#include <hip/hip_runtime.h>
#include <cstdint>
#include <cstdio>

#define NB 8
#define NS 2048
#define NC 256
#define NT 2304
#define TT (NB * NT)
#define DM 1024
#define DIN 2560
#define DINC 2416
#define NE 32
#define NASSIGN (TT * 4)
#define MAXSLOTS (NASSIGN + NE * 256)

#define P_DAQ 0
#define P_DAK 256
#define P_DAV 512
#define P_MLQK 768
#define P_MLV 1280
#define P_MLO 1536
#define P_MLG 1792
#define P_CQ 1808
#define P_CKV 2000
#define P_KR 2128
#define P_S5 2160

#ifndef MK_ONE_LAUNCH
#define MK_ONE_LAUNCH 1
#endif

typedef unsigned short bf16_t;
__device__ __forceinline__ float sigmoidf_(float x) { return __builtin_amdgcn_rcpf(1.f + __expf(-x)); }
__device__ __forceinline__ float siluf_(float x) { return x * __builtin_amdgcn_rcpf(1.f + __expf(-x)); }
__device__ __forceinline__ float logsigmoidf_(float x) { return fminf(x, 0.f) - log1pf(__expf(-fabsf(x))); }
__device__ __forceinline__ float gelu_tanh_(float x) { const float u = 0.7978845608028654f * (x + 0.044715f * x * x * x); return x * __builtin_amdgcn_rcpf(1.f + __expf(-2.f * u)); }
typedef __bf16 bf16x2_nat __attribute__((ext_vector_type(2)));
typedef float f32x2_nat __attribute__((ext_vector_type(2)));
__device__ __forceinline__ unsigned cvtpk(float lo, float hi) { const f32x2_nat v = {lo, hi}; const bf16x2_nat b = __builtin_convertvector(v, bf16x2_nat); return __builtin_bit_cast(unsigned, b); }
__device__ __forceinline__ bf16_t f2bf(float f) { return (bf16_t)(cvtpk(f, 0.f) & 0xFFFFu); }
__device__ __forceinline__ float bf2f(bf16_t b) { return __uint_as_float(((unsigned)b) << 16); }
__device__ __forceinline__ unsigned pk2bf(float lo, float hi) { return cvtpk(lo, hi); }
__device__ __forceinline__ int opaque_tid() { int t = threadIdx.x; asm volatile("" : "+v"(t)); return t; }
__device__ __forceinline__ float wave_sum(float v) {
#define WS_DPP(ctrl, rmask) __int_as_float(__builtin_amdgcn_update_dpp(0, __float_as_int(v), (ctrl), (rmask), 0xf, true))
    v += WS_DPP(0x111, 0xf);
    v += WS_DPP(0x112, 0xf);
    v += WS_DPP(0x114, 0xf);
    v += WS_DPP(0x118, 0xf);
    v += WS_DPP(0x142, 0xa);
    v += WS_DPP(0x143, 0xc);
#undef WS_DPP
    return __int_as_float(__builtin_amdgcn_readlane(__float_as_int(v), 63));
}
__device__ __forceinline__ int seq_token(int s, int dir) {
    if (dir == 0) return s;
    return (s < NC) ? (NC - 1 - s) : (NC + (NT - 1 - s));
}

namespace pg8 {
#define PG8_LAS __attribute__((address_space(3)))
typedef short bf16x8 __attribute__((ext_vector_type(8)));
typedef float f32x4 __attribute__((ext_vector_type(4)));
typedef unsigned u32x4 __attribute__((ext_vector_type(4)));
constexpr int BM = 256, BK = 64, HALF = 128, HTB = HALF * BK * 2, STAGE_BYTES = 8 * HTB, NXCD = 8, WGM = 8;
__host__ __device__ __forceinline__ int lds_byte(int r, int c) { const int st = (r >> 4) * 2 + (c >> 5), rr = r & 15, cc = c & 31, ob = rr * 64 + cc * 2; return st * 1024 + (ob ^ (((ob >> 9) & 1) << 5)); }
__host__ __device__ __forceinline__ void stage_rc(int b, int& R, int& C) { const int st = b / 1024, sb = b % 1024, swz = sb ^ (((sb >> 9) & 1) << 5); R = (st >> 1) * 16 + swz / 64; C = (st & 1) * 32 + (swz % 64) / 2; }
__host__ __device__ __forceinline__ int perm32(int rho) { const int n = rho >> 4, i = rho & 15; return 8 * (i >> 2) + 4 * n + (i & 3); }
struct Unit { int pm, pn; };
struct Gemm { const bf16_t* A; const bf16_t* Bt; int M, N, K, pad; };
__device__ __forceinline__ unsigned cvt_pk_bf16(float lo, float hi) { return cvtpk(lo, hi); }

struct StaticOrder {
    int nM, nN, nwg, G, c;
    __device__ void init(int M, int N, int G_, int c_) { nM = M / BM; nN = N / BM; nwg = nM * nN; G = G_; c = c_; }
    __device__ bool next(int i, Unit& u) const {
        const long L = (long)i * G + c; if (L >= nwg) return false;
        int wgid = (int)L; { const int q = nwg / NXCD, r = nwg % NXCD, xcd = wgid % NXCD, off = wgid / NXCD; wgid = (xcd < r ? xcd * (q + 1) : r * (q + 1) + (xcd - r) * q) + off; }
        const int nig = WGM * nN, gid = wgid / nig, fm = gid * WGM, gsz = (nM - fm) < WGM ? (nM - fm) : WGM;
        u.pm = fm + ((wgid % nig) % gsz); u.pn = (wgid % nig) / gsz; return true;
    }
    __device__ __forceinline__ void a_ready(const Unit&) const {}
    __device__ __forceinline__ void done(const Unit&) const {}
};
struct LatOrder : StaticOrder {
    __device__ void initl(int N, int G_, int c_) { nM = 64; nN = N / BM; nwg = nM * nN; G = G_; c = c_; }
    __device__ bool next(int i, Unit& u) const { if (!StaticOrder::next(i, u)) return false; u.pm = (u.pm >> 3) * 9 + 1 + (u.pm & 7); return true; }
};
struct GroupedOrder : StaticOrder {
    const int* tile_e;
    __device__ void initg(const int* ntiles_p, const int* tile_e_, int N, int G_, int c_) { nM = ntiles_p[0]; nN = N / BM; nwg = nM * nN; G = G_; c = c_; tile_e = tile_e_; }
    __device__ bool next(int i, Unit& u) const { if (!StaticOrder::next(i, u)) return false; u.pn += tile_e[u.pm] * nN; return true; }
};

struct EpiBf16P {
    static constexpr bool PERM = true;
    bf16_t* O; int ldc, pad;
    __device__ __forceinline__ void operator()(const f32x4 (&acc)[2][2][4][2], const Unit& u, int wr, int wc, int fr, int fq) const {
        const int row0 = u.pm * BM + wr * 64 + fr, col0 = u.pn * BM + wc * 32 + 8 * fq;
#pragma unroll
        for (int ai = 0; ai < 2; ++ai)
#pragma unroll
            for (int m = 0; m < 4; ++m) { bf16_t* rowp = O + (size_t)(row0 + ai * HALF + m * 16) * ldc + col0;
#pragma unroll
                for (int bj = 0; bj < 2; ++bj) { const f32x4 v0 = acc[ai][bj][m][0], v1 = acc[ai][bj][m][1];
                    u32x4 w; w.x = cvt_pk_bf16(v0[0], v0[1]); w.y = cvt_pk_bf16(v0[2], v0[3]); w.z = cvt_pk_bf16(v1[0], v1[1]); w.w = cvt_pk_bf16(v1[2], v1[3]);
                    *(u32x4*)(rowp + bj * HALF) = w; } }
    }
};
struct EpiOut {
    static constexpr bool PERM = true;
    bf16_t* O; float* osq;
    __device__ __forceinline__ void operator()(const f32x4 (&acc)[2][2][4][2], const Unit& u, int wr, int wc, int fr, int fq) const {
        const int row0 = u.pm * BM + wr * 64 + fr, col0 = u.pn * BM + wc * 32 + 8 * fq;
#pragma unroll
        for (int ai = 0; ai < 2; ++ai)
#pragma unroll
            for (int m = 0; m < 4; ++m) { const int row = row0 + ai * HALF + m * 16; bf16_t* rowp = O + (size_t)row * 1024 + col0; float ss = 0.f;
#pragma unroll
                for (int bj = 0; bj < 2; ++bj) { const f32x4 v0 = acc[ai][bj][m][0], v1 = acc[ai][bj][m][1];
                    ss += (v0[0] * v0[0] + v0[1] * v0[1]) + (v0[2] * v0[2] + v0[3] * v0[3]) + (v1[0] * v1[0] + v1[1] * v1[1]) + (v1[2] * v1[2] + v1[3] * v1[3]);
                    u32x4 w; w.x = cvt_pk_bf16(v0[0], v0[1]); w.y = cvt_pk_bf16(v0[2], v0[3]); w.z = cvt_pk_bf16(v1[0], v1[1]); w.w = cvt_pk_bf16(v1[2], v1[3]);
                    *(u32x4*)(rowp + bj * HALF) = w; }
                ss += __shfl_xor(ss, 16); ss += __shfl_xor(ss, 32);
                if (fq == 0) osq[(size_t)row * 16 + u.pn * 4 + wc] = ss; }
    }
};
struct EpiDown {
    static constexpr bool PERM = true;
    bf16_t* C; const float* bias;
    __device__ __forceinline__ void operator()(const f32x4 (&acc)[2][2][4][2], const Unit& u, int wr, int wc, int fr, int fq) const {
        const int e = u.pn >> 2, pnl = u.pn & 3;
        const int row0 = u.pm * BM + wr * 64 + fr, col0 = pnl * BM + wc * 32 + 8 * fq;
        const float* bp = bias + (size_t)e * 1024 + col0;
        f32x4 bv[2][2];
#pragma unroll
        for (int bj = 0; bj < 2; ++bj)
#pragma unroll
            for (int n = 0; n < 2; ++n) bv[bj][n] = *(const f32x4*)(bp + bj * HALF + 4 * n);
#pragma unroll
        for (int ai = 0; ai < 2; ++ai)
#pragma unroll
            for (int m = 0; m < 4; ++m) { bf16_t* rowp = C + (size_t)(row0 + ai * HALF + m * 16) * 1024 + col0;
#pragma unroll
                for (int bj = 0; bj < 2; ++bj) { const f32x4 v0 = acc[ai][bj][m][0] + bv[bj][0], v1 = acc[ai][bj][m][1] + bv[bj][1];
                    u32x4 w; w.x = cvt_pk_bf16(v0[0], v0[1]); w.y = cvt_pk_bf16(v0[2], v0[3]); w.z = cvt_pk_bf16(v1[0], v1[1]); w.w = cvt_pk_bf16(v1[2], v1[3]);
                    *(u32x4*)(rowp + bj * HALF) = w; } }
    }
};
struct EpiSwiglu {
    static constexpr bool PERM = true;
    bf16_t* O; const float* bias;
    __device__ __forceinline__ void operator()(const f32x4 (&acc)[2][2][4][2], const Unit& u, int wr, int wc, int fr, int fq) const {
        const int e = u.pn >> 3, pnl = u.pn & 7;
        const int row0 = u.pm * BM + wr * 64 + fr, col0 = pnl * HALF + wc * 32 + 8 * fq;
        const float* bp = bias + (size_t)e * 2048 + col0;
        f32x4 bg[2], bu[2];
#pragma unroll
        for (int n = 0; n < 2; ++n) { bg[n] = *(const f32x4*)(bp + 4 * n); bu[n] = *(const f32x4*)(bp + 1024 + 4 * n) + 1.0f; }
#pragma unroll
        for (int ai = 0; ai < 2; ++ai)
#pragma unroll
            for (int m = 0; m < 4; ++m) {
                bf16_t* rowp = O + (size_t)(row0 + ai * HALF + m * 16) * 1024 + col0;
                float r[8];
#pragma unroll
                for (int n = 0; n < 2; ++n) {
                    const f32x4 g = acc[ai][0][m][n] + bg[n], up = acc[ai][1][m][n] + bu[n];
                    const f32x4 gt = __builtin_elementwise_min(g, (f32x4){7.f, 7.f, 7.f, 7.f});
                    const f32x4 uu = __builtin_elementwise_min(__builtin_elementwise_max(up, (f32x4){-6.f, -6.f, -6.f, -6.f}), (f32x4){8.f, 8.f, 8.f, 8.f});
                    const f32x4 z = gt * (-1.702f * 1.4426950408889634f);
                    f32x4 e; e[0] = __builtin_amdgcn_exp2f(z[0]); e[1] = __builtin_amdgcn_exp2f(z[1]); e[2] = __builtin_amdgcn_exp2f(z[2]); e[3] = __builtin_amdgcn_exp2f(z[3]);
                    const f32x4 d = e + 1.0f;
                    f32x4 rc; rc[0] = __builtin_amdgcn_rcpf(d[0]); rc[1] = __builtin_amdgcn_rcpf(d[1]); rc[2] = __builtin_amdgcn_rcpf(d[2]); rc[3] = __builtin_amdgcn_rcpf(d[3]);
                    const f32x4 o = (uu * gt) * rc;
                    r[n * 4] = o[0]; r[n * 4 + 1] = o[1]; r[n * 4 + 2] = o[2]; r[n * 4 + 3] = o[3];
                }
                u32x4 w; w.x = cvt_pk_bf16(r[0], r[1]); w.y = cvt_pk_bf16(r[2], r[3]); w.z = cvt_pk_bf16(r[4], r[5]); w.w = cvt_pk_bf16(r[6], r[7]);
                *(u32x4*)rowp = w;
            }
    }
};

template <class Epi, class Sched, bool ALIGN_EPI = false, bool SP2 = false, bool GATHER = false>
__device__ __forceinline__ void gemm_phase(PG8_LAS unsigned char* lds, const Gemm g, const Sched& S, const Epi& E, const int* rowtok = nullptr) {
    static_assert(!GATHER || SP2, "gather staging is wired into the SP2 loop only");
    const int tid = opaque_tid(), wid = __builtin_amdgcn_readfirstlane(tid >> 6), lane = tid & 63, wr = wid >> 2, wc = wid & 3, fr = lane & 15, fq = lane >> 4;
    const int K = g.K, nt = K / BK;
    unsigned voffA[2], voffB[2];
#pragma unroll
    for (int i = 0; i < 2; ++i) { int R, C; stage_rc(tid * 16 + i * 8192, R, C); const int Rb = Epi::PERM ? ((R & ~31) + perm32(R & 31)) : R;
        voffA[i] = (unsigned)(R * K + C) * 2u; voffB[i] = (unsigned)(Rb * K + C) * 2u; }
    int gR[2], gC[2];
#pragma unroll
    for (int i = 0; i < 2; ++i) stage_rc(tid * 16 + i * 8192, gR[i], gC[i]);
    PG8_LAS int* rt = (PG8_LAS int*)(lds + STAGE_BYTES);
    unsigned gaC[2][2] = {{0u, 0u}, {0u, 0u}}, gaN[2][2] = {{0u, 0u}, {0u, 0u}};
    const size_t kstep = (size_t)(BK * 2);
    const size_t hstep = (size_t)HALF * K * 2;
    const size_t tstep = 2 * hstep;
    const unsigned ldsw = (unsigned)wid * 1024u;
    const int aoff = lds_byte(wr * 64 + fr, fq * 8), boff = lds_byte(wc * 32 + fr, fq * 8);
#define PG8_SA(b, h) (((b) * 2 + (h)) * HTB)
#define PG8_SB(b, h) ((4 + (b) * 2 + (h)) * HTB)
#define PG8_STAGE(bufoff, gbase, voff) do { _Pragma("unroll") for (int _i = 0; _i < 2; ++_i) \
        __builtin_amdgcn_global_load_lds((const unsigned*)((const char*)(gbase) + (voff)[_i]), (PG8_LAS unsigned*)(lds + (bufoff) + ldsw + _i * 8192), 16, 0, 0); } while (0)
#define PG8_GOFF(dst, k) do { _Pragma("unroll") for (int h_ = 0; h_ < 2; ++h_) _Pragma("unroll") for (int i_ = 0; i_ < 2; ++i_) dst[h_][i_] = (unsigned)(rt[(k) * 256 + h_ * HALF + gR[i_]] * K + gC[i_]) * 2u; } while (0)
#define PG8_STAGE_A(bufoff, ptr, un, h, kb) do { if constexpr (GATHER) { const unsigned o0_ = (un) ? gaN[h][0] : gaC[h][0], o1_ = (un) ? gaN[h][1] : gaC[h][1]; \
        __builtin_amdgcn_global_load_lds((const unsigned*)((const char*)g.A + (kb) + o0_), (PG8_LAS unsigned*)(lds + (bufoff) + ldsw), 16, 0, 0); \
        __builtin_amdgcn_global_load_lds((const unsigned*)((const char*)g.A + (kb) + o1_), (PG8_LAS unsigned*)(lds + (bufoff) + ldsw + 8192), 16, 0, 0); } else PG8_STAGE(bufoff, ptr, voffA); } while (0)
#define PG8_LDA(dst, b, h) do { _Pragma("unroll") for (int m = 0; m < 4; ++m) _Pragma("unroll") for (int k = 0; k < 2; ++k) dst[m][k] = *(const PG8_LAS bf16x8*)(lds + PG8_SA(b, h) + aoff + m * 2048 + k * 1024); } while (0)
#define PG8_LDB(dst, b, h) do { _Pragma("unroll") for (int n = 0; n < 2; ++n) _Pragma("unroll") for (int k = 0; k < 2; ++k) dst[n][k] = *(const PG8_LAS bf16x8*)(lds + PG8_SB(b, h) + boff + n * 2048 + k * 1024); } while (0)
#define PG8_MMA(ai, bj, At, Bt) do { __builtin_amdgcn_s_setprio(1); _Pragma("unroll") for (int m = 0; m < 4; ++m) _Pragma("unroll") for (int n = 0; n < 2; ++n) _Pragma("unroll") for (int k = 0; k < 2; ++k) \
        acc[ai][bj][m][n] = __builtin_amdgcn_mfma_f32_16x16x32_bf16(Bt[n][k], At[m][k], acc[ai][bj][m][n], 0, 0, 0); __builtin_amdgcn_s_setprio(0); } while (0)
#define PG8_WAIT_V(n) asm volatile("s_waitcnt vmcnt(" #n ")" ::: "memory")
#define PG8_WAIT_L(n) asm volatile("s_waitcnt lgkmcnt(" #n ")" ::: "memory")
#define PG8_BAR __builtin_amdgcn_s_barrier()
#define PG8_SCHED __builtin_amdgcn_sched_barrier(0)
    Unit cur, nxt; int ui = 0;
    if (!S.next(0, cur)) return;
    f32x4 acc[2][2][4][2];
#pragma unroll
    for (int a = 0; a < 2; ++a)
#pragma unroll
        for (int b = 0; b < 2; ++b)
#pragma unroll
            for (int m = 0; m < 4; ++m)
#pragma unroll
                for (int n = 0; n < 2; ++n) acc[a][b][m][n] = (f32x4){0.f, 0.f, 0.f, 0.f};
    bf16x8 At[4][2], B0[2][2], B1[2][2];
    const char* cA = (const char*)g.A + (size_t)cur.pm * tstep; const char* cB = (const char*)g.Bt + (size_t)cur.pn * tstep;
    S.a_ready(cur);
    if constexpr (GATHER) {
        Unit u_;
        for (int k = 0; S.next(k, u_); ++k) if (tid < 256) rt[k * 256 + tid] = rowtok[u_.pm * 256 + tid];
        __syncthreads();
        PG8_GOFF(gaC, 0);
    }
    if constexpr (SP2) {
        PG8_STAGE(PG8_SB(0, 0), cB, voffB); PG8_STAGE(PG8_SB(0, 1), cB + hstep, voffB); PG8_STAGE_A(PG8_SA(0, 0), cA, false, 0, (size_t)0); PG8_STAGE_A(PG8_SA(0, 1), cA + hstep, false, 1, (size_t)0);
        if (wr == 1) PG8_BAR;
        PG8_WAIT_V(2); PG8_BAR;
        PG8_STAGE(PG8_SB(1, 0), cB + kstep, voffB); PG8_STAGE_A(PG8_SA(1, 0), cA + kstep, false, 0, kstep); PG8_STAGE(PG8_SB(1, 1), cB + hstep + kstep, voffB);
        PG8_WAIT_V(6); PG8_BAR;
    } else {
        PG8_STAGE(PG8_SB(0, 0), cB, voffB); PG8_STAGE(PG8_SA(0, 0), cA, voffA); PG8_STAGE(PG8_SB(0, 1), cB + hstep, voffB); PG8_STAGE(PG8_SA(0, 1), cA + hstep, voffA);
        if (wr == 1) PG8_BAR;
        PG8_WAIT_V(4); PG8_BAR;
        PG8_STAGE(PG8_SB(1, 0), cB + kstep, voffB); PG8_STAGE(PG8_SA(1, 0), cA + kstep, voffA); PG8_STAGE(PG8_SB(1, 1), cB + hstep + kstep, voffB);
        PG8_WAIT_V(6); PG8_BAR;
    }
    for (;;) {
        const bool has_next = S.next(ui + 1, nxt);
        if constexpr (GATHER) { if (has_next) PG8_GOFF(gaN, ui + 1); }
        const char* nA = has_next ? (const char*)g.A + (size_t)nxt.pm * tstep : cA; const char* nB = has_next ? (const char*)g.Bt + (size_t)nxt.pn * tstep : cB;
        for (int t = 0; t < nt; t += 2) {
            const bool last = (t == nt - 2);
            const char* a1 = cA + (size_t)(t + 1) * kstep;
            const char* a2 = last ? nA : cA + (size_t)(t + 2) * kstep; const char* b2 = last ? nB : cB + (size_t)(t + 2) * kstep;
            const char* a3 = a2 + kstep; const char* b3 = b2 + kstep;
            if (last && has_next) S.a_ready(nxt);
            const bool un = last && has_next; const size_t k1 = (size_t)(t + 1) * kstep, k2 = last ? (size_t)0 : (size_t)(t + 2) * kstep;
            if constexpr (SP2) {
            PG8_LDB(B0, 0, 0); PG8_LDB(B1, 0, 1); PG8_SCHED; PG8_LDA(At, 0, 0); PG8_STAGE_A(PG8_SA(1, 1), a1 + hstep, false, 1, k1);
            PG8_WAIT_V(8); PG8_WAIT_L(0); PG8_BAR; PG8_MMA(0, 0, At, B0); PG8_MMA(0, 1, At, B1); PG8_BAR; PG8_SCHED;
            PG8_LDA(At, 0, 1); PG8_STAGE(PG8_SB(0, 0), b2, voffB); PG8_STAGE(PG8_SB(0, 1), b2 + hstep, voffB); PG8_STAGE_A(PG8_SA(0, 0), a2, un, 0, k2);
            PG8_WAIT_V(8); PG8_WAIT_L(0); PG8_BAR; PG8_MMA(1, 0, At, B0); PG8_MMA(1, 1, At, B1); PG8_BAR; PG8_SCHED;
            PG8_LDB(B0, 1, 0); PG8_LDB(B1, 1, 1); PG8_SCHED; PG8_LDA(At, 1, 0); PG8_STAGE_A(PG8_SA(0, 1), a2 + hstep, un, 1, k2);
            PG8_WAIT_V(8); PG8_WAIT_L(0); PG8_BAR; PG8_MMA(0, 0, At, B0); PG8_MMA(0, 1, At, B1); PG8_BAR; PG8_SCHED;
            PG8_LDA(At, 1, 1); PG8_STAGE(PG8_SB(1, 0), b3, voffB); PG8_STAGE(PG8_SB(1, 1), b3 + hstep, voffB); PG8_STAGE_A(PG8_SA(1, 0), a3, un, 0, k2 + kstep);
            PG8_WAIT_V(8); PG8_WAIT_L(0); PG8_BAR; PG8_MMA(1, 0, At, B0); PG8_MMA(1, 1, At, B1); PG8_BAR; PG8_SCHED;
            } else {
            PG8_LDB(B0, 0, 0); PG8_SCHED; PG8_LDA(At, 0, 0); PG8_STAGE(PG8_SA(1, 1), a1 + hstep, voffA);
            PG8_WAIT_L(8); PG8_BAR; PG8_WAIT_L(0); PG8_MMA(0, 0, At, B0); PG8_BAR; PG8_SCHED;
            PG8_LDB(B1, 0, 1); PG8_STAGE(PG8_SB(0, 0), b2, voffB);
            PG8_BAR; PG8_WAIT_L(0); PG8_MMA(0, 1, At, B1); PG8_BAR;
            PG8_LDA(At, 0, 1); PG8_STAGE(PG8_SA(0, 0), a2, voffA);
            PG8_BAR; PG8_WAIT_L(0); PG8_MMA(1, 0, At, B0); PG8_BAR; PG8_SCHED;
            PG8_STAGE(PG8_SB(0, 1), b2 + hstep, voffB);
            PG8_WAIT_V(6); PG8_BAR; PG8_MMA(1, 1, At, B1); PG8_BAR;
            PG8_LDB(B0, 1, 0); PG8_SCHED; PG8_LDA(At, 1, 0); PG8_STAGE(PG8_SA(0, 1), a2 + hstep, voffA);
            PG8_WAIT_L(8); PG8_BAR; PG8_WAIT_L(0); PG8_MMA(0, 0, At, B0); PG8_BAR; PG8_SCHED;
            PG8_LDB(B1, 1, 1); PG8_STAGE(PG8_SB(1, 0), b3, voffB);
            PG8_BAR; PG8_WAIT_L(0); PG8_MMA(0, 1, At, B1); PG8_BAR;
            PG8_LDA(At, 1, 1); PG8_STAGE(PG8_SA(1, 0), a3, voffA);
            PG8_BAR; PG8_WAIT_L(0); PG8_MMA(1, 0, At, B0); PG8_BAR; PG8_SCHED;
            PG8_STAGE(PG8_SB(1, 1), b3 + hstep, voffB);
            PG8_WAIT_V(6); PG8_BAR; PG8_MMA(1, 1, At, B1); PG8_BAR;
            }
        }
        if constexpr (ALIGN_EPI) { if (wr == 0) PG8_BAR; }
        E(acc, cur, wr, wc, fr, fq); S.done(cur);
        if (!has_next) break;
#pragma unroll
        for (int a = 0; a < 2; ++a)
#pragma unroll
            for (int b = 0; b < 2; ++b)
#pragma unroll
                for (int m = 0; m < 4; ++m)
#pragma unroll
                    for (int n = 0; n < 2; ++n) acc[a][b][m][n] = (f32x4){0.f, 0.f, 0.f, 0.f};
        cur = nxt; cA = nA; cB = nB; ++ui;
        if constexpr (GATHER) { gaC[0][0] = gaN[0][0]; gaC[0][1] = gaN[0][1]; gaC[1][0] = gaN[1][0]; gaC[1][1] = gaN[1][1]; }
        if constexpr (ALIGN_EPI) { if (wr == 1) PG8_BAR; }
    }
    PG8_WAIT_V(0);
    if constexpr (!ALIGN_EPI) { if (wr == 0) PG8_BAR; }
    PG8_BAR;
#undef PG8_SA
#undef PG8_SB
#undef PG8_STAGE
#undef PG8_LDA
#undef PG8_GOFF
#undef PG8_STAGE_A
#undef PG8_LDB
#undef PG8_MMA
#undef PG8_WAIT_V
#undef PG8_WAIT_L
#undef PG8_BAR
#undef PG8_SCHED
}
}

typedef short bf16x8_t __attribute__((ext_vector_type(8)));
typedef float f32x16_t __attribute__((ext_vector_type(16)));
typedef float f32x2_t __attribute__((ext_vector_type(2)));
typedef unsigned u32x4_t __attribute__((ext_vector_type(4)));
typedef unsigned u32x2_t __attribute__((ext_vector_type(2)));
#define LAS3 __attribute__((address_space(3)))
constexpr int ATT_VROW = 68;
constexpr int ATT_LDS_BYTES = 3 * (64 * 104 * 2 + 64 * ATT_VROW * 2);

template <int QKD, int NMAP, bool DA>
__device__ __forceinline__ void attn_item(LAS3 unsigned char* lds, const bf16_t* __restrict__ Qb, const bf16_t* __restrict__ Kb, const bf16_t* __restrict__ Vt,
                                          bf16_t* __restrict__ ycatb, int ycat_off, int b, int h, int qblk, float lam, const float* __restrict__ subln, float post_scale) {
    constexpr int DK = QKD / NMAP, KS = DK / 16, KROW = QKD + 8, KCH = QKD / 8;
    constexpr int KBYTES = 64 * KROW * 2, VBYTES = 64 * ATT_VROW * 2, BUFB = KBYTES + VBYTES;
    const int tid = opaque_tid(), wid = tid >> 6, lane = tid & 63, r = lane & 31, hh = lane >> 5;
    const int q0 = qblk * 256, ntiles = (qblk == 0) ? (NC / 64) : (NT / 64);
    const size_t base = ((size_t)b * 4 + h) * NT;
    bf16x8_t qf[NMAP][KS];
#pragma unroll
    for (int m = 0; m < NMAP; ++m)
#pragma unroll
        for (int ks = 0; ks < KS; ++ks) qf[m][ks] = *(const bf16x8_t*)(Qb + (base + q0 + 32 * wid + r) * QKD + m * DK + 16 * ks + 8 * hh);
    f32x16_t O[NMAP][2]; float mrun[NMAP], lrun[NMAP];
#pragma unroll
    for (int m = 0; m < NMAP; ++m) { mrun[m] = 0.f; lrun[m] = 0.f;
#pragma unroll
        for (int d2 = 0; d2 < 2; ++d2)
#pragma unroll
            for (int i = 0; i < 16; ++i) O[m][d2][i] = 0.f; }
    constexpr int NKC = 64 * KCH;
    const bf16_t* kg = Kb + base * QKD;
    const bf16_t* vg = Vt + ((size_t)(b * 4 + h) * 64 + (tid >> 3)) * NT + (tid & 7) * 8;
    u32x4_t rk0, rk1 = (u32x4_t){0u, 0u, 0u, 0u}, rv;
    const int kc1 = tid + 512;
    const int k0row = tid / KCH, k0col = tid % KCH, k1row = kc1 / KCH, k1col = kc1 % KCH;
#define ATT_LOAD(j) do { rk0 = *(const u32x4_t*)(kg + (size_t)(j) * 64 * QKD + tid * 8); if (NKC > 512 && kc1 < NKC) rk1 = *(const u32x4_t*)(kg + (size_t)(j) * 64 * QKD + kc1 * 8); \
        rv = *(const u32x4_t*)(vg + (size_t)(j) * 64); } while (0)
#define ATT_STORE(buf) do { LAS3 unsigned char* kb_ = lds + (buf) * BUFB; LAS3 unsigned char* vb_ = kb_ + KBYTES; \
        *(LAS3 u32x4_t*)(kb_ + (k0row * KROW + k0col * 8) * 2) = rk0; if (NKC > 512 && kc1 < NKC) *(LAS3 u32x4_t*)(kb_ + (k1row * KROW + k1col * 8) * 2) = rk1; \
        LAS3 unsigned char* vd_ = vb_ + ((tid >> 3) * ATT_VROW + (tid & 7) * 8) * 2; *(LAS3 u32x2_t*)vd_ = (u32x2_t){rv.x, rv.y}; *(LAS3 u32x2_t*)(vd_ + 8) = (u32x2_t){rv.z, rv.w}; } while (0)
    __syncthreads();
    ATT_LOAD(0); ATT_STORE(0);
    if (ntiles > 1) ATT_LOAD(1);
    __syncthreads();
    bf16x8_t pf[NMAP][2][2];
#define ATT_PV(m_, vb_) do { _Pragma("unroll") for (int d2 = 0; d2 < 2; ++d2) _Pragma("unroll") for (int kt = 0; kt < 2; ++kt) _Pragma("unroll") for (int s2 = 0; s2 < 2; ++s2) { \
        const LAS3 unsigned char* vp = (vb_) + ((d2 * 32 + r) * ATT_VROW + kt * 32 + 16 * s2 + 4 * hh) * 2; \
        union { u32x2_t u[2]; bf16x8_t v; } av; av.u[0] = *(const LAS3 u32x2_t*)vp; av.u[1] = *(const LAS3 u32x2_t*)(vp + 16); \
        O[m_][d2] = __builtin_amdgcn_mfma_f32_32x32x16_bf16(av.v, pf[m_][kt][s2], O[m_][d2], 0, 0, 0); } } while (0)
    int sl = 0;
    for (int j = 0; j < ntiles; ++j) {
        const LAS3 unsigned char* kb = lds + sl * BUFB;
        const LAS3 unsigned char* vbp = lds + ((sl == 0) ? 2 : sl - 1) * BUFB + KBYTES;
#pragma unroll
        for (int m = 0; m < NMAP; ++m) {
            f32x16_t S[2];
            const float nm = -mrun[m];
#pragma unroll
            for (int kt = 0; kt < 2; ++kt) {
#pragma unroll
                for (int i = 0; i < 16; ++i) S[kt][i] = nm;
#pragma unroll
                for (int ks = 0; ks < KS; ++ks) {
                    const bf16x8_t a = *(const LAS3 bf16x8_t*)(kb + ((kt * 32 + r) * KROW + m * DK + 16 * ks + 8 * hh) * 2);
                    S[kt] = __builtin_amdgcn_mfma_f32_32x32x16_bf16(a, qf[m][ks], S[kt], 0, 0, 0);
                }
            }
            if (j > 0) ATT_PV(m, vbp);
            float mx = S[0][0];
#pragma unroll
            for (int i = 1; i < 16; ++i) mx = fmaxf(mx, S[0][i]);
#pragma unroll
            for (int i = 0; i < 16; ++i) mx = fmaxf(mx, S[1][i]);
            mx = fmaxf(mx, __shfl_xor(mx, 32));
            if (j == 0 || !__all(mx <= 8.f)) {
                const float dl = (j == 0) ? mx : fmaxf(mx, 0.f);
                mrun[m] += dl;
#pragma unroll
                for (int kt = 0; kt < 2; ++kt)
#pragma unroll
                    for (int i = 0; i < 16; ++i) S[kt][i] -= dl;
                if (j != 0) {
                    const float alpha = __builtin_amdgcn_exp2f(-dl);
                    lrun[m] *= alpha;
#pragma unroll
                    for (int d2 = 0; d2 < 2; ++d2)
#pragma unroll
                        for (int i = 0; i < 16; ++i) O[m][d2][i] *= alpha;
                }
            }
            f32x2_t ps2 = (f32x2_t){0.f, 0.f};
#pragma unroll
            for (int kt = 0; kt < 2; ++kt) {
#pragma unroll
                for (int i = 0; i < 16; i += 2) { const float p0 = __builtin_amdgcn_exp2f(S[kt][i]), p1 = __builtin_amdgcn_exp2f(S[kt][i + 1]); S[kt][i] = p0; S[kt][i + 1] = p1; ps2 += (f32x2_t){p0, p1}; }
#pragma unroll
                for (int s2 = 0; s2 < 2; ++s2) {
                    union { unsigned u[4]; bf16x8_t v; } cv;
#pragma unroll
                    for (int jj = 0; jj < 4; ++jj) cv.u[jj] = cvtpk(S[kt][8 * s2 + 2 * jj], S[kt][8 * s2 + 2 * jj + 1]);
                    pf[m][kt][s2] = cv.v;
                }
            }
            lrun[m] += ps2[0] + ps2[1];
        }
        const int sn = (sl == 2) ? 0 : sl + 1;
        if (j + 1 < ntiles) { ATT_STORE(sn); if (j + 2 < ntiles) ATT_LOAD(j + 2); }
        __syncthreads();
        sl = sn;
    }
    {
        const LAS3 unsigned char* vbl = lds + ((sl == 0) ? 2 : sl - 1) * BUFB + KBYTES;
#pragma unroll
        for (int m = 0; m < NMAP; ++m) ATT_PV(m, vbl);
    }
#undef ATT_PV
#undef ATT_LOAD
#undef ATT_STORE
    float inv[NMAP];
#pragma unroll
    for (int m = 0; m < NMAP; ++m) { const float lt = lrun[m] + __shfl_xor(lrun[m], 32); inv[m] = __builtin_amdgcn_rcpf(lt); }
    if (NMAP == 2) inv[NMAP - 1] *= -lam;
    float ss = 0.f;
#pragma unroll
    for (int d2 = 0; d2 < 2; ++d2)
#pragma unroll
        for (int i = 0; i < 16; ++i) {
            float o = O[0][d2][i] * inv[0];
            if (NMAP == 2) o += O[NMAP - 1][d2][i] * inv[NMAP - 1];
            O[0][d2][i] = o; ss += o * o;
        }
    float rs = 1.f;
    if (DA) { ss += __shfl_xor(ss, 32); rs = rsqrtf(ss * (1.f / 64.f) + 1e-6f) * post_scale; }
    bf16_t* yp = ycatb + ((size_t)b * NT + q0 + 32 * wid + r) * DM + ycat_off + h * 64;
#pragma unroll
    for (int d2 = 0; d2 < 2; ++d2)
#pragma unroll
        for (int g4 = 0; g4 < 4; ++g4) {
            const int dv = 32 * d2 + 8 * g4 + 4 * hh;
            float o0 = O[0][d2][4 * g4] * rs, o1 = O[0][d2][4 * g4 + 1] * rs, o2 = O[0][d2][4 * g4 + 2] * rs, o3 = O[0][d2][4 * g4 + 3] * rs;
            if (DA) { const float4 w = *(const float4*)(subln + dv); o0 *= w.x; o1 *= w.y; o2 *= w.z; o3 *= w.w; }
            *(uint2*)(yp + dv) = make_uint2(cvtpk(o0, o1), cvtpk(o2, o3));
        }
}


typedef float f32x4_t __attribute__((ext_vector_type(4)));
constexpr int ML_KROW = 72, ML_TROW = 136, ML_CROW = 72;
constexpr int ML_OFF_KC = 0, ML_OFF_KT = ML_OFF_KC + 128 * ML_KROW * 2, ML_OFF_VT = ML_OFF_KT + 64 * ML_TROW * 2, ML_OFF_CB = ML_OFF_VT + 80 * ML_TROW * 2,
              ML_OFF_F = ML_OFF_CB + 80 * ML_CROW * 2, ML_LDS_BYTES = ML_OFF_F + 6 * 128 * 4 + 64;
__device__ __forceinline__ void mlstm_item(LAS3 unsigned char* lds, const bf16_t* __restrict__ Qb, const bf16_t* __restrict__ Kb, const bf16_t* __restrict__ Ktg, const bf16_t* __restrict__ Vtg,
                                           const float* __restrict__ G, float* __restrict__ hdir, int b, int h, int dir) {
    const int tid = opaque_tid(), wid = tid >> 6, lane = tid & 63, lr = lane & 15, q = lane >> 4;
    LAS3 unsigned char* Kc = lds + ML_OFF_KC; LAS3 unsigned char* Kt = lds + ML_OFF_KT; LAS3 unsigned char* Vt = lds + ML_OFF_VT; LAS3 unsigned char* Cb = lds + ML_OFF_CB;
    LAS3 float* fl = (LAS3 float*)(lds + ML_OFF_F);
    LAS3 float* s_li = fl; LAS3 float* s_lf = fl + 128; LAS3 float* s_bc2 = fl + 256; LAS3 float* s_gk2 = fl + 384; LAS3 float* s_wu = fl + 512; LAS3 float* s_et = fl + 640; LAS3 float* s_misc = fl + 768;
    const size_t base = ((size_t)b * 4 + h) * NT;
    __syncthreads();
    for (int i = tid; i < 80 * ML_CROW / 2; i += 512) ((LAS3 unsigned*)Cb)[i] = 0u;
    for (int i = tid; i < 16 * ML_TROW / 2; i += 512) ((LAS3 unsigned*)(Vt + 64 * ML_TROW * 2))[i] = (i < ML_TROW / 2) ? 0x3F803F80u : 0u;
    const int ct = wid & 3, rt0 = (wid < 4) ? 0 : 3, nrt = (wid < 4) ? 3 : 2;
    f32x4_t Cacc[3];
#pragma unroll
    for (int i = 0; i < 3; ++i) Cacc[i] = (f32x4_t){0.f, 0.f, 0.f, 0.f};
    const int tq = 16 * wid + lr;
    const int ia = (dir == 0) ? 2 * lane : 127 - 2 * lane, ib = (dir == 0) ? 2 * lane + 1 : 126 - 2 * lane;
    u32x4_t nkc[2], nkt[2], nvt[2]; bf16x8_t nqf[2]; float ngxa = 0.f, ngxb = 0.f, ngla = 0.f, nglb = 0.f;
#define ML_N0(c_) ((dir == 0) ? 128 * (c_) : (((c_) < 2) ? 128 * (1 - (c_)) : NC + 128 * (17 - (c_))))
#define ML_LOAD(c_) do { const int n0_ = ML_N0(c_); \
        _Pragma("unroll") for (int i = 0; i < 2; ++i) { const int id = tid + 512 * i; \
            nkc[i] = *(const u32x4_t*)(Kb + (base + n0_ + (id >> 3)) * 64 + (id & 7) * 8); \
            nkt[i] = *(const u32x4_t*)(Ktg + ((size_t)(b * 4 + h) * 64 + (id >> 4)) * NT + n0_ + (id & 15) * 8); \
            nvt[i] = *(const u32x4_t*)(Vtg + ((size_t)(b * 4 + h) * 64 + (id >> 4)) * NT + n0_ + (id & 15) * 8); } \
        _Pragma("unroll") for (int ks = 0; ks < 2; ++ks) nqf[ks] = *(const bf16x8_t*)(Qb + (base + n0_ + tq) * 64 + 32 * ks + 8 * q); \
        if (wid == 0) { const float* gpa = G + ((size_t)b * NT + n0_ + ia) * 16 + (dir * 2) * 4 + h; const float* gpb = G + ((size_t)b * NT + n0_ + ib) * 16 + (dir * 2) * 4 + h; \
            ngxa = gpa[4]; ngxb = gpb[4]; ngla = gpa[0]; nglb = gpb[0]; } } while (0)
    ML_LOAD(0);
    for (int c = 0; c < NT / 128; ++c) {
        const int n0 = ML_N0(c);
        u32x4_t rkc[2], rkt[2], rvt[2];
        bf16x8_t qf[2];
#pragma unroll
        for (int i = 0; i < 2; ++i) { rkc[i] = nkc[i]; rkt[i] = nkt[i]; rvt[i] = nvt[i]; qf[i] = nqf[i]; }
        const float xa = ngxa, xb = ngxb, lia = ngla, lib = nglb;
        if (c + 1 < NT / 128) ML_LOAD(c + 1);
#pragma unroll
        for (int i = 0; i < 2; ++i) {
            const int id = tid + 512 * i;
            *(LAS3 u32x4_t*)(Kc + ((id >> 3) * ML_KROW + (id & 7) * 8) * 2) = rkc[i];
            *(LAS3 u32x4_t*)(Vt + ((id >> 4) * ML_TROW + (id & 15) * 8) * 2) = rvt[i];
        }
        __syncthreads();
        if (wid == 0) {
            float inc = xa + xb;
#pragma unroll
            for (int o = 1; o < 64; o <<= 1) { const float v = __shfl_up(inc, o); if (lane >= o) inc += v; }
            const float tot = __shfl(inc, 63);
            const float bca = inc - xb, bcb = inc;
            s_bc2[ia] = bca * 1.4426950408889634f; s_bc2[ib] = bcb * 1.4426950408889634f;
            s_gk2[ia] = (bca - lia) * 1.4426950408889634f; s_gk2[ib] = (bcb - lib) * 1.4426950408889634f;
            s_wu[ia] = __expf(tot - bca + lia); s_wu[ib] = __expf(tot - bcb + lib);
            s_et[ia] = __expf(bca); s_et[ib] = __expf(bcb);
            if (lane == 0) s_misc[0] = __expf(tot);
        }
        __syncthreads();
#pragma unroll
        for (int i = 0; i < 2; ++i) {
            const int id = tid + 512 * i; const int tk0 = (id & 15) * 8;
            unsigned w4[4] = {rkt[i].x, rkt[i].y, rkt[i].z, rkt[i].w}; u32x4_t o;
#pragma unroll
            for (int jj = 0; jj < 4; ++jj) {
                const float lo = __uint_as_float(w4[jj] << 16) * s_wu[tk0 + 2 * jj], hi = __uint_as_float(w4[jj] & 0xFFFF0000u) * s_wu[tk0 + 2 * jj + 1];
                o[jj] = cvtpk(lo, hi);
            }
            *(LAS3 u32x4_t*)(Kt + ((id >> 4) * ML_TROW + tk0) * 2) = o;
        }
        f32x4_t S[8];
#pragma unroll
        for (int kt = 0; kt < 8; ++kt) {
            S[kt] = (f32x4_t){0.f, 0.f, 0.f, 0.f};
#pragma unroll
            for (int ks = 0; ks < 2; ++ks) {
                const bf16x8_t a = *(const LAS3 bf16x8_t*)(Kc + ((16 * kt + lr) * ML_KROW + 32 * ks + 8 * q) * 2);
                S[kt] = __builtin_amdgcn_mfma_f32_16x16x32_bf16(a, qf[ks], S[kt], 0, 0, 0);
            }
        }
        const float bct = s_bc2[tq];
#pragma unroll
        for (int kt = 0; kt < 8; ++kt) {
            const f32x4_t gk = *(const LAS3 f32x4_t*)(s_gk2 + 16 * kt + 4 * q);
#pragma unroll
            for (int rg = 0; rg < 4; ++rg) {
                const int si = 16 * kt + 4 * q + rg;
                const bool valid = (dir == 0) ? (si <= tq) : (si >= tq);
                const float w = valid ? __builtin_amdgcn_exp2f(bct - gk[rg]) : 0.f;
                S[kt][rg] *= w;
            }
        }
        bf16x8_t pf[4];
#pragma unroll
        for (int k2 = 0; k2 < 4; ++k2) {
            union { unsigned u[4]; bf16x8_t v; } cv;
            cv.u[0] = cvtpk(S[2 * k2][0], S[2 * k2][1]); cv.u[1] = cvtpk(S[2 * k2][2], S[2 * k2][3]);
            cv.u[2] = cvtpk(S[2 * k2 + 1][0], S[2 * k2 + 1][1]); cv.u[3] = cvtpk(S[2 * k2 + 1][2], S[2 * k2 + 1][3]);
            pf[k2] = cv.v;
        }
        f32x4_t outv[5];
#pragma unroll
        for (int rt = 0; rt < 5; ++rt) {
            f32x4_t acc = (f32x4_t){0.f, 0.f, 0.f, 0.f}, acc2 = (f32x4_t){0.f, 0.f, 0.f, 0.f};
#pragma unroll
            for (int k2 = 0; k2 < 4; ++k2) {
                const LAS3 unsigned char* vp = Vt + ((16 * rt + lr) * ML_TROW + 32 * k2 + 4 * q) * 2;
                union { u32x2_t u[2]; bf16x8_t v; } av;
                av.u[0] = *(const LAS3 u32x2_t*)vp; av.u[1] = *(const LAS3 u32x2_t*)(vp + 32);
                acc = __builtin_amdgcn_mfma_f32_16x16x32_bf16(av.v, pf[k2], acc, 0, 0, 0);
            }
#pragma unroll
            for (int ks = 0; ks < 2; ++ks) {
                const bf16x8_t a = *(const LAS3 bf16x8_t*)(Cb + ((16 * rt + lr) * ML_CROW + 32 * ks + 8 * q) * 2);
                acc2 = __builtin_amdgcn_mfma_f32_16x16x32_bf16(a, qf[ks], acc2, 0, 0, 0);
            }
            outv[rt] = acc + acc2 * s_et[tq];
        }
        {
            const float den = __shfl(outv[4][0], lr);
            const float inv = __builtin_amdgcn_rcpf(fmaxf(fabsf(den), 1.f));
            bf16_t* hp = (bf16_t*)hdir + ((size_t)dir * TT + (size_t)b * NT + n0 + tq) * 256 + h * 64 + 4 * q;
            for (int rt = 0; rt < 4; ++rt) { const f32x4_t ov = outv[rt] * inv; *(uint2*)(hp + 16 * rt) = make_uint2(cvtpk(ov[0], ov[1]), cvtpk(ov[2], ov[3])); }
        }
        __syncthreads();
        {
            const float decay = s_misc[0];
#pragma unroll
            for (int i = 0; i < 3; ++i) Cacc[i] *= decay;
#pragma unroll
            for (int ks = 0; ks < 4; ++ks) {
                const bf16x8_t bb = *(const LAS3 bf16x8_t*)(Kt + ((16 * ct + lr) * ML_TROW + 32 * ks + 8 * q) * 2);
#pragma unroll
                for (int i = 0; i < 3; ++i) if (i < nrt) {
                    const bf16x8_t a = *(const LAS3 bf16x8_t*)(Vt + ((16 * (rt0 + i) + lr) * ML_TROW + 32 * ks + 8 * q) * 2);
                    Cacc[i] = __builtin_amdgcn_mfma_f32_16x16x32_bf16(a, bb, Cacc[i], 0, 0, 0);
                }
            }
#pragma unroll
            for (int i = 0; i < 3; ++i) if (i < nrt) {
#pragma unroll
                for (int rg = 0; rg < 4; ++rg) *(LAS3 bf16_t*)(Cb + ((16 * (rt0 + i) + 4 * q + rg) * ML_CROW + 16 * ct + lr) * 2) = f2bf(Cacc[i][rg]);
            }
        }
        __syncthreads();
    }
#undef ML_LOAD
#undef ML_N0
}

constexpr int S5_UROWS = NT + 64;
constexpr int S5_KROW = 1032, S5_CROW = 136, S5_ZROW = 136;
constexpr int S5_OFF_U = 0, S5_OFF_KM = S5_OFF_U + S5_UROWS * 16 * 2, S5_OFF_CM = S5_OFF_KM + 16 * S5_KROW * 2, S5_OFF_EZ = S5_OFF_CM + 16 * S5_CROW * 2,
              S5_LDS_BYTES = S5_OFF_EZ + 8 * 16 * S5_ZROW * 2;
__device__ __forceinline__ void s5_setup_item(LAS3 unsigned char* lds, int idx, const float* __restrict__ a_re, const float* __restrict__ a_im, const float* __restrict__ log_step,
                                                  const float* __restrict__ b_re, const float* __restrict__ b_im, const float* __restrict__ c_re, const float* __restrict__ c_im,
                                                  bf16_t* __restrict__ KmT, bf16_t* __restrict__ Smat, bf16_t* __restrict__ CmT, float* __restrict__ Aab, float* __restrict__ A64) {
    typedef float apw_t[64][2]; typedef float bb_t[16][2]; typedef float cc_t[64][2];
    LAS3 apw_t* apw = (LAS3 apw_t*)lds;
    LAS3 bb_t* bb = (LAS3 bb_t*)(lds + 32768);
    LAS3 cc_t* cc = (LAS3 cc_t*)(lds + 32768 + 8192);
    const int tid = opaque_tid();
    __syncthreads();
    const float dt = expf(log_step[idx]);
    if (tid < 64) {
        const int p = tid;
        const float ar = fminf(a_re[idx * 64 + p], -1e-4f), ai = a_im[idx * 64 + p];
        const float mag = expf(dt * ar), er = mag * cosf(dt * ai), ei = mag * sinf(dt * ai);
        const float inv = 1.0f / (ar * ar + ai * ai);
        const float fr = ((er - 1.0f) * ar + ei * ai) * inv, fi = (ei * ar - (er - 1.0f) * ai) * inv;
        Aab[(idx * 64 + p) * 2] = er; Aab[(idx * 64 + p) * 2 + 1] = ei;
        const float m64 = expf(64.0f * dt * ar);
        A64[(idx * 64 + p) * 2] = m64 * cosf(64.0f * dt * ai); A64[(idx * 64 + p) * 2 + 1] = m64 * sinf(64.0f * dt * ai);
        for (int hh = 0; hh < 16; ++hh) {
            const float br = b_re[((size_t)idx * 64 + p) * 16 + hh], bi = b_im[((size_t)idx * 64 + p) * 16 + hh];
            bb[p][hh][0] = fr * br - fi * bi; bb[p][hh][1] = fr * bi + fi * br;
        }
    }
    for (int i = tid; i < 64 * 64; i += 512) {
        const int tau = i >> 6, p = i & 63;
        const float ar = fminf(a_re[idx * 64 + p], -1e-4f), ai = a_im[idx * 64 + p];
        const float mag = expf((float)tau * dt * ar);
        apw[tau][p][0] = mag * cosf((float)tau * dt * ai); apw[tau][p][1] = mag * sinf((float)tau * dt * ai);
    }
    for (int i = tid; i < 16 * 64; i += 512) { const int hh = i >> 6, p = i & 63; cc[hh][p][0] = c_re[(size_t)idx * 1024 + i]; cc[hh][p][1] = c_im[(size_t)idx * 1024 + i]; }
    __syncthreads();
    for (int i = tid; i < 16 * 64; i += 512) { const int hh = i >> 6, p = i & 63;
        CmT[((size_t)idx * 16 + hh) * 128 + 2 * p] = f2bf(cc[hh][p][0]); CmT[((size_t)idx * 16 + hh) * 128 + 2 * p + 1] = f2bf(-cc[hh][p][1]); }
    for (int e = tid; e < 64 * 1024; e += 512) {
        const int p = e >> 10, k = e & 1023, i = k >> 4, hp = k & 15;
        const float pr = apw[63 - i][p][0], pi = apw[63 - i][p][1], br = bb[p][hp][0], bi = bb[p][hp][1];
        Smat[((size_t)idx * 128 + 2 * p) * 1024 + k] = f2bf(pr * br - pi * bi);
        Smat[((size_t)idx * 128 + 2 * p + 1) * 1024 + k] = f2bf(pr * bi + pi * br);
    }
    for (int e = tid; e < 16 * 1024; e += 512) {
        const int hh = e >> 10, k = e & 1023, tau = k >> 4, hp = k & 15;
        float acc = 0.f;
        for (int p = 0; p < 64; ++p) {
            const float pr = apw[tau][p][0], pi = apw[tau][p][1], br = bb[p][hp][0], bi = bb[p][hp][1];
            const float wr = pr * br - pi * bi, wi = pr * bi + pi * br;
            acc += cc[hh][p][0] * wr - cc[hh][p][1] * wi;
        }
        KmT[((size_t)idx * 16 + hh) * 1024 + k] = f2bf(acc);
    }
}


__device__ __forceinline__ void s5_item(LAS3 unsigned char* lds, const bf16_t* __restrict__ p, const bf16_t* __restrict__ KmT, const bf16_t* __restrict__ Smat, const bf16_t* __restrict__ CmT,
                                        const float* __restrict__ Aab, const float* __restrict__ A64, float* __restrict__ xs_g, float* __restrict__ ys5, int b, int g, int dir) {
    const int tid = opaque_tid(), wid = tid >> 6, lane = tid & 63, lr = lane & 15, q = lane >> 4;
    const int tix = dir * 16 + g;
    LAS3 unsigned char* U = lds + S5_OFF_U; LAS3 unsigned char* Km = lds + S5_OFF_KM; LAS3 unsigned char* Cm = lds + S5_OFF_CM; LAS3 unsigned char* EZ = lds + S5_OFF_EZ;
    float* xs = xs_g + (size_t)((b * 16 + g) * 2 + dir) * 36 * 128;
    __syncthreads();
    for (int i = tid; i < 16 * 128; i += 512) { const int hh = i >> 7, ch = i & 127;
        *(LAS3 u32x4_t*)(Km + (hh * S5_KROW + ch * 8) * 2) = *(const u32x4_t*)(KmT + ((size_t)tix * 16 + hh) * 1024 + ch * 8); }
    if (tid < 256) { const int hh = tid >> 4, ch = tid & 15;
        *(LAS3 u32x4_t*)(Cm + (hh * S5_CROW + ch * 8) * 2) = *(const u32x4_t*)(CmT + ((size_t)tix * 16 + hh) * 128 + ch * 8); }
    for (int i = tid; i < NT * 2; i += 512) {
        const int sidx = i >> 1, hf = i & 1;
        const int n = seq_token(sidx, dir);
        *(LAS3 u32x4_t*)(U + ((64 + sidx) * 16 + hf * 8) * 2) = *(const u32x4_t*)(p + ((size_t)b * NT + n) * DIN + P_S5 + g * 16 + hf * 8);
    }
    for (int i = tid; i < 64 * 8; i += 512) *(LAS3 unsigned*)(U + i * 4) = 0u;
    __syncthreads();
    {
        f32x4_t acc[3];
#pragma unroll
        for (int i = 0; i < 3; ++i) acc[i] = (f32x4_t){0.f, 0.f, 0.f, 0.f};
        const bf16_t* sp = Smat + ((size_t)tix * 128 + 16 * wid + lr) * 1024 + 8 * q;
        int cco[3];
#pragma unroll
        for (int ctile = 0; ctile < 3; ++ctile) { int ch = 16 * ctile + lr; if (ch > 35) ch = 35; cco[ctile] = ((64 + 64 * ch + (q >> 1)) * 16 + 8 * (q & 1)) * 2; }
#pragma unroll 8
        for (int ks = 0; ks < 32; ++ks) {
            const bf16x8_t a = *(const bf16x8_t*)(sp + 32 * ks);
#pragma unroll
            for (int ctile = 0; ctile < 3; ++ctile) {
                const bf16x8_t bfr = *(const LAS3 bf16x8_t*)(U + cco[ctile] + ks * 64);
                acc[ctile] = __builtin_amdgcn_mfma_f32_16x16x32_bf16(a, bfr, acc[ctile], 0, 0, 0);
            }
        }
        LAS3 float* E = (LAS3 float*)EZ;
#pragma unroll
        for (int ctile = 0; ctile < 3; ++ctile)
#pragma unroll
            for (int rg = 0; rg < 4; ++rg) E[(16 * ctile + lr) * 128 + 16 * wid + 4 * q + rg] = acc[ctile][rg];
    }
    __syncthreads();
    const float Ar = Aab[(tix * 64 + lane) * 2], Ai = Aab[(tix * 64 + lane) * 2 + 1];
    if (wid == 0) {
        const float Br = A64[(tix * 64 + lane) * 2], Bi = A64[(tix * 64 + lane) * 2 + 1];
        const LAS3 float* E = (const LAS3 float*)EZ;
        float xr = 0.f, xi = 0.f;
        for (int c = 0; c < 36; ++c) {
            *(float2*)(xs + c * 128 + 2 * lane) = make_float2(xr, xi);
            const float er = E[c * 128 + 2 * lane], ei = E[c * 128 + 2 * lane + 1];
            const float nr = Br * xr - Bi * xi + er, ni = Br * xi + Bi * xr + ei;
            xr = nr; xi = ni;
        }
    }
    __threadfence_block();
    __syncthreads();
    LAS3 unsigned char* Zw = EZ + wid * (16 * S5_ZROW * 2);
    bf16x8_t cmf[4];
#pragma unroll
    for (int ks = 0; ks < 4; ++ks) cmf[ks] = *(const LAS3 bf16x8_t*)(Cm + (lr * S5_CROW + 32 * ks + 8 * q) * 2);
    bf16x8_t kbr[16];
#pragma unroll
    for (int ks = 0; ks < 16; ++ks) kbr[ks] = *(const LAS3 bf16x8_t*)(Km + (lr * S5_KROW + 8 * q) * 2 + ks * 64);
    float2 xnext = *(const float2*)(xs + wid * 128 + 2 * lane);
    for (int c = wid; c < 36; c += 8) {
        const float2 x0 = xnext;
        if (c + 8 < 36) xnext = *(const float2*)(xs + (c + 8) * 128 + 2 * lane);
        float zr = Ar * x0.x - Ai * x0.y, zi = Ar * x0.y + Ai * x0.x;
#pragma unroll
        for (int rt = 0; rt < 4; ++rt) {
#pragma unroll
            for (int ii = 0; ii < 16; ++ii) {
                *(LAS3 unsigned*)(Zw + (ii * S5_ZROW + 2 * lane) * 2) = cvtpk(zr, zi);
                const float nr = Ar * zr - Ai * zi, ni = Ar * zi + Ai * zr; zr = nr; zi = ni;
            }
            asm volatile("s_waitcnt lgkmcnt(0)" ::: "memory");
            f32x4_t acc = (f32x4_t){0.f, 0.f, 0.f, 0.f};
#pragma unroll
            for (int ks = 0; ks < 4; ++ks) {
                const bf16x8_t a = *(const LAS3 bf16x8_t*)(Zw + (lr * S5_ZROW + 32 * ks + 8 * q) * 2);
                acc = __builtin_amdgcn_mfma_f32_16x16x32_bf16(a, cmf[ks], acc, 0, 0, 0);
            }
            const int irow = 16 * rt + lr;
            const LAS3 unsigned char* up = U + ((64 + 64 * c + irow - (q >> 1)) * 16 + 8 * (q & 1)) * 2;
            const LAS3 unsigned char* kp = Km + (lr * S5_KROW + 8 * q) * 2;
            f32x4_t acc1 = (f32x4_t){0.f, 0.f, 0.f, 0.f};
#pragma unroll
            for (int ks0 = 0; ks0 < 8 * rt + 8; ks0 += 8) {
                bf16x8_t av[8], kv[8];
#pragma unroll
                for (int j = 0; j < 8; ++j) { av[j] = *(const LAS3 bf16x8_t*)(up - (ks0 + j) * 64); if (ks0 + j < 16) kv[j] = kbr[ks0 + j]; else kv[j] = *(const LAS3 bf16x8_t*)(kp + (ks0 + j) * 64); }
#pragma unroll
                for (int j = 0; j < 8; ++j) {
                    const int ks = ks0 + j;
                    if (ks >= 8 * rt) {
                        const bool valid = (2 * ks + (q >> 1)) <= irow;
                        if (!valid) av[j] = (bf16x8_t){0, 0, 0, 0, 0, 0, 0, 0};
                    }
                    if (j & 1) acc1 = __builtin_amdgcn_mfma_f32_16x16x32_bf16(av[j], kv[j], acc1, 0, 0, 0);
                    else acc = __builtin_amdgcn_mfma_f32_16x16x32_bf16(av[j], kv[j], acc, 0, 0, 0);
                }
            }
            acc += acc1;
#pragma unroll
            for (int rg = 0; rg < 4; ++rg) {
                const int n = seq_token(64 * c + 16 * rt + 4 * q + rg, dir);
                ((bf16_t*)ys5)[((size_t)dir * TT + (size_t)b * NT + n) * 256 + g * 16 + lr] = f2bf(acc[rg]);
            }
            asm volatile("s_waitcnt lgkmcnt(0)" ::: "memory");
        }
    }
}

#define XB_TMO      128
#define XB_XCNT(j)  (256  + 64 * (j))
#define XB_XSUB(j)  (1280 + 64 * (j))
#define XB_XGEN(j)  (2304 + 64 * (j))
#define XB_TOP      3328
#define XB_TOPGEN   3392
#define XCD_BAR_WORDS 3456
#define XB_SPIN_CAP (1u << 22)
__device__ __forceinline__ unsigned xb_ld(unsigned* p)              { return __hip_atomic_load(p, __ATOMIC_RELAXED, __HIP_MEMORY_SCOPE_AGENT); }
__device__ __forceinline__ unsigned xb_add(unsigned* p, unsigned v) { return __hip_atomic_fetch_add(p, v, __ATOMIC_RELAXED, __HIP_MEMORY_SCOPE_AGENT); }
__device__ __forceinline__ unsigned xb_xcc_id() { return (unsigned)__builtin_amdgcn_s_getreg((3 << 11) | 20) & 0xFu; }
#define XB_SPIN(cond, bar) do { unsigned _sp = 0; while (cond) { __builtin_amdgcn_s_sleep(1); \
    if ((++_sp & 255u) == 0u) { if (xb_ld(&(bar)[XB_TMO])) break; if (_sp > XB_SPIN_CAP) { atomicAdd(&(bar)[XB_TMO], 1u); break; } } } } while (0)
struct XcdBarrier { unsigned* bar; unsigned x; volatile LAS3 unsigned* st; };
__device__ __forceinline__ XcdBarrier xcd_barrier_post(unsigned* bar, volatile LAS3 unsigned* st) {
    XcdBarrier b; b.bar = bar; b.x = xb_xcc_id(); b.st = st;
    if (threadIdx.x == 0) (void)xb_add(&bar[XB_XCNT(b.x)], 1u);
    return b;
}
__device__ __forceinline__ void xcd_barrier_complete(unsigned* bar, unsigned x, unsigned& nloc, unsigned& nx) {
    const unsigned G = gridDim.x * gridDim.y * gridDim.z;
    unsigned sum, cnt, mine, sp = 0u;
    for (;;) {
        sum = 0u; cnt = 0u; mine = 0u;
#pragma unroll
        for (unsigned j = 0; j < 16; ++j) { const unsigned c = xb_ld(&bar[XB_XCNT(j)]); sum += c; cnt += (c > 0u) ? 1u : 0u; mine = (j == x) ? c : mine; }
        if (sum == G) break;
        __builtin_amdgcn_s_sleep(1);
        if ((++sp & 255u) == 0u) { if (xb_ld(&bar[XB_TMO])) break; if (sp > XB_SPIN_CAP) { atomicAdd(&bar[XB_TMO], 1u); break; } }
    }
    nloc = mine > 0u ? mine : 1u; nx = cnt > 0u ? cnt : 1u;
}
__device__ __forceinline__ void xcd_barrier(const XcdBarrier& b) {
    asm volatile("s_waitcnt vmcnt(0)" ::: "memory");
    __syncthreads();
    if (threadIdx.x == 0) {
        unsigned* bar = b.bar;
        __builtin_amdgcn_s_waitcnt(0);
        unsigned nloc = b.st[0], nx = b.st[1];
        if (nloc == 0u) { xcd_barrier_complete(bar, b.x, nloc, nx); b.st[0] = nloc; b.st[1] = nx; }
        const unsigned old = xb_add(&bar[XB_XSUB(b.x)], 1u);
        const unsigned gen = old / nloc;
        if (old + 1u == (gen + 1u) * nloc) {
            __builtin_amdgcn_fence(__ATOMIC_RELEASE, "agent");
            asm volatile("s_waitcnt vmcnt(0)" ::: "memory");
            const unsigned og = xb_add(&bar[XB_TOP], 1u);
            const unsigned tg = og / nx;
            if (og + 1u == (tg + 1u) * nx) xb_add(&bar[XB_TOPGEN], 1u);
            else XB_SPIN(xb_ld(&bar[XB_TOPGEN]) == tg, bar);
            __builtin_amdgcn_fence(__ATOMIC_ACQUIRE, "agent");
            xb_add(&bar[XB_XGEN(b.x)], 1u);
            asm volatile("s_waitcnt vmcnt(0)" ::: "memory");
        } else {
            XB_SPIN(xb_ld(&bar[XB_XGEN(b.x)]) == gen, bar);
            __builtin_amdgcn_fence(__ATOMIC_ACQUIRE, "agent");
            asm volatile("s_waitcnt vmcnt(0)" ::: "memory");
        }
    }
    __syncthreads();
}

struct Params {
    const float *x, *c, *ctx, *c_ctx, *w_mod, *b_mod, *norm_w, *w_in, *w_out, *da_lambda, *da_subln, *ml_conv_w, *ml_conv_b, *ml_gate_b, *ml_norm,
                *mla_q_norm, *mla_w_uq, *mla_kv_norm, *mla_w_ukv, *s5_a_re, *s5_a_im, *s5_log_step, *s5_b_re, *s5_b_im, *s5_c_re, *s5_c_im, *s5_d, *s5_w_glu, *s5_b_glu,
                *moe_w_router, *moe_b_router, *moe_w_gate_up, *moe_b_gate_up, *moe_w_down, *moe_b_down;
    float* out;
    float *xall, *mod, *ropecs, *lamfull;
    bf16_t *w_in_t, *w_out_t, *wgu_t, *wdn_t, *wq_t, *wkv_t, *wglu_t;
    bf16_t *s5KmT, *s5Smat, *s5CmT; float *s5A, *s5A64, *s5xs;
    bf16_t *hbuf, *pb, *daQ, *daK, *daVt, *mQ, *mK, *mVt, *mlQ, *mlK, *mlKt, *mlVt; float *mlG, *hdir, *ys5;
    bf16_t *ycatb, *ob; float* osq; bf16_t* fb;
    int* top_e; float* top_g; int *posb, *tok_slot;
    int *cnt, *tile_e, *ntiles, *offs, *blkcnt;
    bf16_t *xg, *act, *yexp;
    unsigned* bar; int* queue;
};

template <class T> __device__ __forceinline__ T* uni_ptr(T* p) { const unsigned long long v = (unsigned long long)p; const unsigned lo = __builtin_amdgcn_readfirstlane((unsigned)v), hi = __builtin_amdgcn_readfirstlane((unsigned)(v >> 32)); return (T*)(__attribute__((address_space(1))) T*)(((unsigned long long)hi << 32) | lo); }
__device__ __forceinline__ void store_params(LAS3 Params* PL, const Params& P) {
    PL->x = P.x;
    PL->c = P.c;
    PL->ctx = P.ctx;
    PL->c_ctx = P.c_ctx;
    PL->w_mod = P.w_mod;
    PL->b_mod = P.b_mod;
    PL->norm_w = P.norm_w;
    PL->w_in = P.w_in;
    PL->w_out = P.w_out;
    PL->da_lambda = P.da_lambda;
    PL->da_subln = P.da_subln;
    PL->ml_conv_w = P.ml_conv_w;
    PL->ml_conv_b = P.ml_conv_b;
    PL->ml_gate_b = P.ml_gate_b;
    PL->ml_norm = P.ml_norm;
    PL->mla_q_norm = P.mla_q_norm;
    PL->mla_w_uq = P.mla_w_uq;
    PL->mla_kv_norm = P.mla_kv_norm;
    PL->mla_w_ukv = P.mla_w_ukv;
    PL->s5_a_re = P.s5_a_re;
    PL->s5_a_im = P.s5_a_im;
    PL->s5_log_step = P.s5_log_step;
    PL->s5_b_re = P.s5_b_re;
    PL->s5_b_im = P.s5_b_im;
    PL->s5_c_re = P.s5_c_re;
    PL->s5_c_im = P.s5_c_im;
    PL->s5_d = P.s5_d;
    PL->s5_w_glu = P.s5_w_glu;
    PL->s5_b_glu = P.s5_b_glu;
    PL->moe_w_router = P.moe_w_router;
    PL->moe_b_router = P.moe_b_router;
    PL->moe_w_gate_up = P.moe_w_gate_up;
    PL->moe_b_gate_up = P.moe_b_gate_up;
    PL->moe_w_down = P.moe_w_down;
    PL->moe_b_down = P.moe_b_down;
    PL->out = P.out;
    PL->xall = P.xall;
    PL->mod = P.mod;
    PL->ropecs = P.ropecs;
    PL->lamfull = P.lamfull;
    PL->w_in_t = P.w_in_t;
    PL->w_out_t = P.w_out_t;
    PL->wgu_t = P.wgu_t;
    PL->wdn_t = P.wdn_t;
    PL->wq_t = P.wq_t;
    PL->wkv_t = P.wkv_t;
    PL->wglu_t = P.wglu_t;
    PL->s5KmT = P.s5KmT;
    PL->s5Smat = P.s5Smat;
    PL->s5CmT = P.s5CmT;
    PL->s5A = P.s5A;
    PL->s5A64 = P.s5A64;
    PL->s5xs = P.s5xs;
    PL->hbuf = P.hbuf;
    PL->pb = P.pb;
    PL->daQ = P.daQ;
    PL->daK = P.daK;
    PL->daVt = P.daVt;
    PL->mQ = P.mQ;
    PL->mK = P.mK;
    PL->mVt = P.mVt;
    PL->mlQ = P.mlQ;
    PL->mlK = P.mlK;
    PL->mlKt = P.mlKt;
    PL->mlVt = P.mlVt;
    PL->mlG = P.mlG;
    PL->hdir = P.hdir;
    PL->ys5 = P.ys5;
    PL->ycatb = P.ycatb;
    PL->ob = P.ob;
    PL->osq = P.osq;
    PL->fb = P.fb;
    PL->top_e = P.top_e;
    PL->top_g = P.top_g;
    PL->posb = P.posb;
    PL->tok_slot = P.tok_slot;
    PL->cnt = P.cnt;
    PL->tile_e = P.tile_e;
    PL->ntiles = P.ntiles;
    PL->offs = P.offs;
    PL->blkcnt = P.blkcnt;
    PL->xg = P.xg;
    PL->act = P.act;
    PL->yexp = P.yexp;
    PL->bar = P.bar;
    PL->queue = P.queue;
}
__device__ __forceinline__ Params load_params(const LAS3 Params* PL) {
    Params Q;
    Q.x = uni_ptr(PL->x);
    Q.c = uni_ptr(PL->c);
    Q.ctx = uni_ptr(PL->ctx);
    Q.c_ctx = uni_ptr(PL->c_ctx);
    Q.w_mod = uni_ptr(PL->w_mod);
    Q.b_mod = uni_ptr(PL->b_mod);
    Q.norm_w = uni_ptr(PL->norm_w);
    Q.w_in = uni_ptr(PL->w_in);
    Q.w_out = uni_ptr(PL->w_out);
    Q.da_lambda = uni_ptr(PL->da_lambda);
    Q.da_subln = uni_ptr(PL->da_subln);
    Q.ml_conv_w = uni_ptr(PL->ml_conv_w);
    Q.ml_conv_b = uni_ptr(PL->ml_conv_b);
    Q.ml_gate_b = uni_ptr(PL->ml_gate_b);
    Q.ml_norm = uni_ptr(PL->ml_norm);
    Q.mla_q_norm = uni_ptr(PL->mla_q_norm);
    Q.mla_w_uq = uni_ptr(PL->mla_w_uq);
    Q.mla_kv_norm = uni_ptr(PL->mla_kv_norm);
    Q.mla_w_ukv = uni_ptr(PL->mla_w_ukv);
    Q.s5_a_re = uni_ptr(PL->s5_a_re);
    Q.s5_a_im = uni_ptr(PL->s5_a_im);
    Q.s5_log_step = uni_ptr(PL->s5_log_step);
    Q.s5_b_re = uni_ptr(PL->s5_b_re);
    Q.s5_b_im = uni_ptr(PL->s5_b_im);
    Q.s5_c_re = uni_ptr(PL->s5_c_re);
    Q.s5_c_im = uni_ptr(PL->s5_c_im);
    Q.s5_d = uni_ptr(PL->s5_d);
    Q.s5_w_glu = uni_ptr(PL->s5_w_glu);
    Q.s5_b_glu = uni_ptr(PL->s5_b_glu);
    Q.moe_w_router = uni_ptr(PL->moe_w_router);
    Q.moe_b_router = uni_ptr(PL->moe_b_router);
    Q.moe_w_gate_up = uni_ptr(PL->moe_w_gate_up);
    Q.moe_b_gate_up = uni_ptr(PL->moe_b_gate_up);
    Q.moe_w_down = uni_ptr(PL->moe_w_down);
    Q.moe_b_down = uni_ptr(PL->moe_b_down);
    Q.out = uni_ptr(PL->out);
    Q.xall = uni_ptr(PL->xall);
    Q.mod = uni_ptr(PL->mod);
    Q.ropecs = uni_ptr(PL->ropecs);
    Q.lamfull = uni_ptr(PL->lamfull);
    Q.w_in_t = uni_ptr(PL->w_in_t);
    Q.w_out_t = uni_ptr(PL->w_out_t);
    Q.wgu_t = uni_ptr(PL->wgu_t);
    Q.wdn_t = uni_ptr(PL->wdn_t);
    Q.wq_t = uni_ptr(PL->wq_t);
    Q.wkv_t = uni_ptr(PL->wkv_t);
    Q.wglu_t = uni_ptr(PL->wglu_t);
    Q.s5KmT = uni_ptr(PL->s5KmT);
    Q.s5Smat = uni_ptr(PL->s5Smat);
    Q.s5CmT = uni_ptr(PL->s5CmT);
    Q.s5A = uni_ptr(PL->s5A);
    Q.s5A64 = uni_ptr(PL->s5A64);
    Q.s5xs = uni_ptr(PL->s5xs);
    Q.hbuf = uni_ptr(PL->hbuf);
    Q.pb = uni_ptr(PL->pb);
    Q.daQ = uni_ptr(PL->daQ);
    Q.daK = uni_ptr(PL->daK);
    Q.daVt = uni_ptr(PL->daVt);
    Q.mQ = uni_ptr(PL->mQ);
    Q.mK = uni_ptr(PL->mK);
    Q.mVt = uni_ptr(PL->mVt);
    Q.mlQ = uni_ptr(PL->mlQ);
    Q.mlK = uni_ptr(PL->mlK);
    Q.mlKt = uni_ptr(PL->mlKt);
    Q.mlVt = uni_ptr(PL->mlVt);
    Q.mlG = uni_ptr(PL->mlG);
    Q.hdir = uni_ptr(PL->hdir);
    Q.ys5 = uni_ptr(PL->ys5);
    Q.ycatb = uni_ptr(PL->ycatb);
    Q.ob = uni_ptr(PL->ob);
    Q.osq = uni_ptr(PL->osq);
    Q.fb = uni_ptr(PL->fb);
    Q.top_e = uni_ptr(PL->top_e);
    Q.top_g = uni_ptr(PL->top_g);
    Q.posb = uni_ptr(PL->posb);
    Q.tok_slot = uni_ptr(PL->tok_slot);
    Q.cnt = uni_ptr(PL->cnt);
    Q.tile_e = uni_ptr(PL->tile_e);
    Q.ntiles = uni_ptr(PL->ntiles);
    Q.offs = uni_ptr(PL->offs);
    Q.blkcnt = uni_ptr(PL->blkcnt);
    Q.xg = uni_ptr(PL->xg);
    Q.act = uni_ptr(PL->act);
    Q.yexp = uni_ptr(PL->yexp);
    Q.bar = uni_ptr(PL->bar);
    Q.queue = uni_ptr(PL->queue);
    return Q;
}
constexpr int MK_LDS_MAIN = 147968;
constexpr int MK_LDS_BYTES = MK_LDS_MAIN + 64 + 1024;
enum { PH_SETUP = 0, PH_H0 = 1, PH_LAYER0 = 2, PH_PER_LAYER = 10, PH_TOTAL = 22 };
enum { L_GEMM_IN = 0, L_PREP, L_MIX, L_FINISH, L_GEMM_OUT, L_POST, L_SCATTER, L_GEMM_GU, L_GEMM_DN, L_COMBINE };

__device__ __forceinline__ void conv_tile(LAS3 float* tile, int lane, const float* __restrict__ W, int N, bf16_t* __restrict__ WT, int ldt, int tn, int tk, int mode) {
    const int n0 = tn * 64, k0 = tk * 64;
    const int kq = lane >> 4, n4 = (lane & 15) * 4;
    const int nl = (n0 + n4 < N) ? n0 + n4 : N - 4;
    const float* wp = W + (size_t)(k0 + kq) * N + nl;
    float4 v[16];
#pragma unroll
    for (int j = 0; j < 16; ++j) v[j] = *(const float4*)(wp + (size_t)(4 * j) * N);
#pragma unroll
    for (int j = 0; j < 16; ++j) { LAS3 float* tp = tile + (4 * j + kq) * 65 + n4; tp[0] = v[j].x; tp[1] = v[j].y; tp[2] = v[j].z; tp[3] = v[j].w; }
    asm volatile("s_waitcnt lgkmcnt(0)" ::: "memory");
    {
        const int c = lane & 7;
#pragma unroll
        for (int jn = 0; jn < 8; ++jn) {
            const int n = (lane >> 3) + 8 * jn, gn = n0 + n;
            if (gn < N) {
                int dr = gn;
                if (mode == 1) dr = (gn < 1024) ? ((gn >> 7) * 256 + (gn & 127)) : ((((gn - 1024) >> 7) * 256) + 128 + ((gn - 1024) & 127));
                const LAS3 float* tp = tile + (8 * c) * 65 + n;
                u32x4_t o;
                o.x = pk2bf(tp[0 * 65], tp[1 * 65]); o.y = pk2bf(tp[2 * 65], tp[3 * 65]); o.z = pk2bf(tp[4 * 65], tp[5 * 65]); o.w = pk2bf(tp[6 * 65], tp[7 * 65]);
                *(u32x4_t*)(WT + (size_t)dr * ldt + k0 + 8 * c) = o;
            }
        }
    }
    asm volatile("s_waitcnt lgkmcnt(0)" ::: "memory");
}
constexpr int CV_IN = 38 * 16 * 2, CV_OUT = 256 * 2, CV_GU = 512 * 64, CV_DN = 256 * 64, CV_Q = 18 * 2, CV_KV = 16 * 2, CV_GLU = 16 * 2;
constexpr int CV_TOTAL = CV_IN + CV_OUT + CV_GU + CV_DN + CV_Q + CV_KV + CV_GLU;
__device__ __forceinline__ void conv_dispatch(const Params& P, LAS3 float* tile, int st, int it) {
    const float* W = nullptr; bf16_t* WT = nullptr; int N = 64, ldt = 64, tn = 0, tk = 0, mode = 0;
    if (it < CV_TOTAL) {
        int r = it;
        if (r < CV_IN) { const int bt = r / 608, q = r % 608; W = P.w_in + (size_t)bt * 1024 * DINC; N = DINC; WT = P.w_in_t + (size_t)bt * 2560 * 1024; ldt = 1024; tn = q % 38; tk = q / 38; }
        else if ((r -= CV_IN) < CV_OUT) { const int bt = r / 256, q = r % 256; W = P.w_out + (size_t)bt * 1024 * 1024; N = 1024; WT = P.w_out_t + (size_t)bt * 1024 * 1024; ldt = 1024; tn = q % 16; tk = q / 16; }
        else if ((r -= CV_OUT) < CV_GU) { const int bt = r / 512, q = r % 512; W = P.moe_w_gate_up + (size_t)bt * 1024 * 2048; N = 2048; WT = P.wgu_t + (size_t)bt * 2048 * 1024; ldt = 1024; tn = q % 32; tk = q / 32; mode = 1; }
        else if ((r -= CV_GU) < CV_DN) { const int bt = r / 256, q = r % 256; W = P.moe_w_down + (size_t)bt * 1024 * 1024; N = 1024; WT = P.wdn_t + (size_t)bt * 1024 * 1024; ldt = 1024; tn = q % 16; tk = q / 16; }
        else if ((r -= CV_DN) < CV_Q) { const int bt = r / 18, q = r % 18; W = P.mla_w_uq + (size_t)bt * 192 * 384; N = 384; WT = P.wq_t + (size_t)bt * 384 * 192; ldt = 192; tn = q % 6; tk = q / 6; }
        else if ((r -= CV_Q) < CV_KV) { const int bt = r / 16, q = r % 16; W = P.mla_w_ukv + (size_t)bt * 128 * 512; N = 512; WT = P.wkv_t + (size_t)bt * 512 * 128; ldt = 128; tn = q % 8; tk = q / 8; }
        else { r -= CV_KV; const int bt = r / 16, q = r % 16; W = P.s5_w_glu + (size_t)bt * 256 * 256; N = 256; WT = P.wglu_t + (size_t)bt * 256 * 256; ldt = 256; tn = q % 4; tk = q / 4; }
    }
    if (W) conv_tile(tile, st, W, N, WT, ldt, tn, tk, mode);
}
__device__ __forceinline__ void phase_setup(const Params& P, LAS3 unsigned char* lds) {
    const int tid = opaque_tid(), G = gridDim.x, bid = blockIdx.x;
    for (int it = bid; it < 192; it += G) {
        LAS3 float* sl = (LAS3 float*)lds;
        LAS3 float* red = sl + 9 * 1024;
        __syncthreads();
        for (int i = tid; i < 9 * 1024; i += 512) { const int r = i >> 10, k = i & 1023; sl[i] = siluf_((r < 8) ? P.c[r * 1024 + k] : P.c_ctx[k]); }
        __syncthreads();
        const int l = it / 96, j = (it % 96) * 64 + (tid & 63), kp = tid >> 6;
        const float* w = P.w_mod + (size_t)l * 1024 * 6144 + j;
        float acc[9];
#pragma unroll
        for (int r = 0; r < 9; ++r) acc[r] = 0.f;
#pragma unroll 8
        for (int k = kp * 128; k < kp * 128 + 128; ++k) {
            const float wv = w[(size_t)k * 6144];
#pragma unroll
            for (int r = 0; r < 9; ++r) acc[r] += sl[r * 1024 + k] * wv;
        }
#pragma unroll
        for (int r = 0; r < 9; ++r) red[(kp * 9 + r) * 64 + (tid & 63)] = acc[r];
        __syncthreads();
        for (int i = tid; i < 9 * 64; i += 512) {
            const int r = i >> 6, cc = i & 63; float sacc = 0.f;
#pragma unroll
            for (int k2 = 0; k2 < 8; ++k2) sacc += red[(k2 * 9 + r) * 64 + cc];
            const int jj = (it % 96) * 64 + cc;
            P.mod[((size_t)l * 9 + r) * 6144 + jj] = sacc + P.b_mod[l * 6144 + jj];
        }
    }
    for (int i = bid * 512 + tid; i < NS * 16; i += G * 512) {
        const int pos = i >> 4, j = i & 15; const int row = pos / 64, col = pos % 64;
        const float inv = exp2f(-(float)(j & 7) * 1.6609640474436813f), ang = (float)((j < 8) ? row : col) * inv;
        P.ropecs[i * 2] = cosf(ang); P.ropecs[i * 2 + 1] = sinf(ang);
    }
    if (bid == G - 1 && tid < 2) {
        const int l = tid; const float* lam = P.da_lambda + l * 128; float s1 = 0.f, s2 = 0.f;
        for (int i = 0; i < 32; ++i) { s1 += lam[i] * lam[32 + i]; s2 += lam[64 + i] * lam[96 + i]; }
        P.lamfull[l] = expf(s1) - expf(s2) + ((l == 0) ? 0.2f : 0.35550906759096927f);
    }
    for (int it = G - 1 - bid; it < 64; it += G)
        s5_setup_item(lds, it, P.s5_a_re, P.s5_a_im, P.s5_log_step, P.s5_b_re, P.s5_b_im, P.s5_c_re, P.s5_c_im, P.s5KmT, P.s5Smat, P.s5CmT, P.s5A, P.s5A64);
    for (int i = bid * 512 + tid; i < 2 * 144 * 1024 / 8; i += G * 512) {
        const int l = i / (144 * 128), r = i % (144 * 128);
        *(u32x4_t*)(P.w_in_t + ((size_t)l * 2560 + DINC) * 1024 + (size_t)r * 8) = (u32x4_t){0u, 0u, 0u, 0u};
    }
    __syncthreads();
    {
        const int wv = __builtin_amdgcn_readfirstlane(tid >> 6), lane = tid & 63;
        LAS3 float* tile = (LAS3 float*)lds + wv * (64 * 65);
        for (;;) {
            int base = 0;
            if (lane == 0) base = atomicAdd(P.queue + 2, 4);
            base = __builtin_amdgcn_readfirstlane(base);
            if (base >= CV_TOTAL) break;
            for (int it = base; it < base + 4 && it < CV_TOTAL; ++it) conv_dispatch(P, tile, lane, it);
        }
    }
}

__device__ __forceinline__ void row_modulate_store(const float (&xv)[16], const LAS3 float* nw, const LAS3 float* modr, bf16_t* __restrict__ dst, int lane) {
    float ss = 0.f;
#pragma unroll
    for (int i = 0; i < 16; ++i) ss += xv[i] * xv[i];
    ss = wave_sum(ss);
    const float rstd = rsqrtf(ss * (1.f / DM) + 1e-6f);
#pragma unroll
    for (int j = 0; j < 4; ++j) {
        const int d = j * 256 + lane * 4;
        const f32x4_t w = *(const LAS3 f32x4_t*)(nw + d), sh = *(const LAS3 f32x4_t*)(modr + d), sc = *(const LAS3 f32x4_t*)(modr + 1024 + d);
        const float o0 = xv[j * 4 + 0] * rstd * w[0] * (1.f + sc[0]) + sh[0], o1 = xv[j * 4 + 1] * rstd * w[1] * (1.f + sc[1]) + sh[1];
        const float o2 = xv[j * 4 + 2] * rstd * w[2] * (1.f + sc[2]) + sh[2], o3 = xv[j * 4 + 3] * rstd * w[3] * (1.f + sc[3]) + sh[3];
        *(uint2*)(dst + d) = make_uint2(cvtpk(o0, o1), cvtpk(o2, o3));
    }
}
__device__ __forceinline__ void phase_h0(const Params& P, LAS3 unsigned char* lds) {
    const int tid = opaque_tid(); const int lane = tid & 63, gw = blockIdx.x * 8 + (tid >> 6), NW = gridDim.x * 8;
    LAS3 float* cw = (LAS3 float*)lds;
    for (int i = tid; i < 256; i += 512) *(LAS3 f32x4_t*)(cw + i * 4) = *(const f32x4_t*)(P.norm_w + i * 4);
    for (int i = tid; i < 9 * 512; i += 512) { const int r = i >> 9, k = i & 511; *(LAS3 f32x4_t*)(cw + 1024 + r * 2048 + k * 4) = *(const f32x4_t*)(P.mod + (size_t)r * 6144 + k * 4); }
    __syncthreads();
    for (int t = gw; t < TT; t += NW) {
        const int b = t / NT, n = t % NT;
        const float* src = (n < NC) ? P.ctx + ((size_t)b * NC + n) * DM : P.x + ((size_t)b * NS + (n - NC)) * DM;
        float xv[16];
#pragma unroll
        for (int j = 0; j < 4; ++j) { const float4 v = *(const float4*)(src + j * 256 + lane * 4); xv[j * 4] = v.x; xv[j * 4 + 1] = v.y; xv[j * 4 + 2] = v.z; xv[j * 4 + 3] = v.w; }
        row_modulate_store(xv, cw, cw + 1024 + ((n < NC) ? 8 : b) * 2048, P.hbuf + (size_t)t * DM, lane);
    }
}

constexpr int TS_ROW = 264;
__device__ __forceinline__ void write_transposed(const LAS3 bf16_t* ts, bf16_t* __restrict__ dst, int b, int n0, int tid) {
    const int ch = tid & 255, hf = tid >> 8;
    bf16_t* vp = dst + (((size_t)b * 4 + (ch >> 6)) * 64 + (ch & 63)) * NT + n0 + hf * 32;
#pragma unroll
    for (int tc = 0; tc < 4; ++tc) {
        const LAS3 bf16_t* tp = ts + (hf * 32 + tc * 8) * TS_ROW + ch;
        u32x4_t o;
        o.x = (unsigned)tp[0] | ((unsigned)tp[TS_ROW] << 16); o.y = (unsigned)tp[2 * TS_ROW] | ((unsigned)tp[3 * TS_ROW] << 16);
        o.z = (unsigned)tp[4 * TS_ROW] | ((unsigned)tp[5 * TS_ROW] << 16); o.w = (unsigned)tp[6 * TS_ROW] | ((unsigned)tp[7 * TS_ROW] << 16);
        *(u32x4_t*)(vp + tc * 8) = o;
    }
}
__device__ __forceinline__ void unpack8(const u32x4_t v, float (&f)[8]) {
    f[0] = __uint_as_float(v.x << 16); f[1] = __uint_as_float(v.x & 0xFFFF0000u); f[2] = __uint_as_float(v.y << 16); f[3] = __uint_as_float(v.y & 0xFFFF0000u);
    f[4] = __uint_as_float(v.z << 16); f[5] = __uint_as_float(v.z & 0xFFFF0000u); f[6] = __uint_as_float(v.w << 16); f[7] = __uint_as_float(v.w & 0xFFFF0000u);
}
__device__ __forceinline__ u32x4_t pack8(const float (&f)[8]) { return (u32x4_t){cvtpk(f[0], f[1]), cvtpk(f[2], f[3]), cvtpk(f[4], f[5]), cvtpk(f[6], f[7])}; }

__device__ __forceinline__ void prep_da(const Params& P, LAS3 unsigned char* lds, int tile) {
    const int tid = opaque_tid();
    const int t0 = tile * 64, b = t0 / NT, n0 = t0 % NT;
    LAS3 bf16_t* vs = (LAS3 bf16_t*)lds;
    const float qscale = 0.17677669529663687f * 1.4426950408889634f;
    const bf16_t* __restrict__ pbr = P.pb; const float* __restrict__ rcs = P.ropecs;
    __syncthreads();
    {
        u32x4_t vv[4];
#pragma unroll
        for (int u = 0; u < 4; ++u) { const int id = tid + 512 * u, i = id >> 5, cg = id & 31; vv[u] = *(const u32x4_t*)(pbr + (size_t)(t0 + i) * DIN + P_DAV + cg * 8); }
#pragma unroll
        for (int u = 0; u < 4; ++u) { const int id = tid + 512 * u, i = id >> 5, cg = id & 31; *(LAS3 u32x4_t*)(vs + i * TS_ROW + cg * 8) = vv[u]; }
    }
#pragma unroll
    for (int u0 = 0; u0 < 4; u0 += 2) {
        u32x4_t lo[2], hi[2]; float4 cs[2][4];
#pragma unroll
        for (int u = 0; u < 2; ++u) {
            const int id = tid + 512 * (u0 + u), i = id >> 5, pu = id & 31, isk = pu >> 4, blk = (pu >> 1) & 7, pr = pu & 1;
            const bf16_t* src = pbr + (size_t)(t0 + i) * DIN + (isk ? P_DAK : P_DAQ) + blk * 32 + pr * 8;
            lo[u] = *(const u32x4_t*)src; hi[u] = *(const u32x4_t*)(src + 16);
            const int pos = max(n0 + i - NC, 0);
            const float4* cp = (const float4*)(rcs + (pos * 16 + pr * 8) * 2);
            cs[u][0] = cp[0]; cs[u][1] = cp[1]; cs[u][2] = cp[2]; cs[u][3] = cp[3];
        }
#pragma unroll
        for (int u = 0; u < 2; ++u) {
            const int id = tid + 512 * (u0 + u), i = id >> 5, pu = id & 31, isk = pu >> 4, blk = (pu >> 1) & 7, pr = pu & 1;
            const int n = n0 + i; const bool lat = n >= NC;
            float fl[8], fh[8], ol[8], oh[8];
            unpack8(lo[u], fl); unpack8(hi[u], fh);
            const float cc[8] = {cs[u][0].x, cs[u][0].z, cs[u][1].x, cs[u][1].z, cs[u][2].x, cs[u][2].z, cs[u][3].x, cs[u][3].z};
            const float sn[8] = {cs[u][0].y, cs[u][0].w, cs[u][1].y, cs[u][1].w, cs[u][2].y, cs[u][2].w, cs[u][3].y, cs[u][3].w};
            const float sc = isk ? 1.f : qscale;
#pragma unroll
            for (int e = 0; e < 8; ++e) {
                const float c1 = lat ? cc[e] : 1.f, s1 = lat ? sn[e] : 0.f;
                ol[e] = (fl[e] * c1 - fh[e] * s1) * sc; oh[e] = (fh[e] * c1 + fl[e] * s1) * sc;
            }
            bf16_t* dst = (isk ? P.daK : P.daQ) + (((size_t)b * 4 + (blk >> 1)) * NT + n) * 64 + (blk & 1) * 32 + pr * 8;
            *(u32x4_t*)dst = pack8(ol); *(u32x4_t*)(dst + 16) = pack8(oh);
        }
    }
    __syncthreads();
    write_transposed(vs, P.daVt, b, n0, tid);
}
__device__ __forceinline__ void prep_ml(const Params& P, LAS3 unsigned char* lds, int tile, int l) {
    const int tid = opaque_tid();
    const int t0 = tile * 64, b = t0 / NT, n0 = t0 % NT;
    LAS3 bf16_t* ks = (LAS3 bf16_t*)lds; LAS3 bf16_t* vs = ks + 64 * TS_ROW; LAS3 float* cwl = (LAS3 float*)(vs + 64 * TS_ROW);
    const int seg_lo = (n0 < NC) ? 0 : NC, seg_hi = (n0 < NC) ? NC - 1 : NT - 1;
    const bf16_t* __restrict__ pbr = P.pb;
    __syncthreads();
    for (int i = tid; i < 2048; i += 512) cwl[i] = (i < 1536) ? P.ml_conv_w[l * 1536 + i] : P.ml_conv_b[l * 512 + (i - 1536)];
    {
        u32x4_t vv[4];
#pragma unroll
        for (int u = 0; u < 4; ++u) { const int id = tid + 512 * u, i = id >> 5, cg = id & 31; vv[u] = *(const u32x4_t*)(pbr + (size_t)(t0 + i) * DIN + P_MLV + cg * 8); }
#pragma unroll
        for (int u = 0; u < 4; ++u) { const int id = tid + 512 * u, i = id >> 5, cg = id & 31; *(LAS3 u32x4_t*)(vs + i * TS_ROW + cg * 8) = vv[u]; }
        if (tid < 128) {
            const int i = tid >> 1, hf = tid & 1; float g[8];
            unpack8(*(const u32x4_t*)(pbr + (size_t)(t0 + i) * DIN + P_MLG + hf * 8), g);
#pragma unroll
            for (int e = 0; e < 8; ++e) { const int c = hf * 8 + e; g[e] += P.ml_gate_b[l * 16 + c]; if ((c >> 2) & 1) g[e] = logsigmoidf_(g[e]); }
            float* gp = P.mlG + ((size_t)t0 + i) * 16 + hf * 8;
            *(float4*)gp = make_float4(g[0], g[1], g[2], g[3]); *(float4*)(gp + 4) = make_float4(g[4], g[5], g[6], g[7]);
        }
    }
    __syncthreads();
#pragma unroll 1
    for (int u0 = 0; u0 < 8; u0 += 2) {
        u32x4_t xm[2], x0[2], xp[2];
#pragma unroll
        for (int u = 0; u < 2; ++u) {
            const int id = tid + 512 * (u0 + u), i = id >> 6, cg = id & 63, n = n0 + i;
            const int nm = max(n - 1, seg_lo), np = min(n + 1, seg_hi);
            const bf16_t* base = pbr + (size_t)b * NT * DIN + P_MLQK + cg * 8;
            xm[u] = *(const u32x4_t*)(base + (size_t)nm * DIN); x0[u] = *(const u32x4_t*)(base + (size_t)n * DIN); xp[u] = *(const u32x4_t*)(base + (size_t)np * DIN);
        }
#pragma unroll
        for (int u = 0; u < 2; ++u) {
            const int id = tid + 512 * (u0 + u), i = id >> 6, cg = id & 63, n = n0 + i;
            const float m0 = (n - 1 >= seg_lo) ? 1.f : 0.f, m2 = (n + 1 <= seg_hi) ? 1.f : 0.f;
            float a[8], c0[8], d[8], y[8];
            unpack8(xm[u], a); unpack8(x0[u], c0); unpack8(xp[u], d);
            const LAS3 float* w = cwl + cg * 8;
#pragma unroll
            for (int e = 0; e < 8; ++e) {
                float v = w[1536 + e] + a[e] * w[e] * m0 + c0[e] * w[512 + e] + d[e] * w[1024 + e] * m2;
                v = siluf_(v); if (cg >= 32) v *= 0.125f;
                y[e] = v;
            }
            const u32x4_t o = pack8(y);
            const int cc = (cg & 31) * 8;
            bf16_t* dst = ((cg < 32) ? P.mlQ : P.mlK) + (((size_t)b * 4 + (cc >> 6)) * NT + n) * 64 + (cc & 63);
            *(u32x4_t*)dst = o;
            if (cg >= 32) *(LAS3 u32x4_t*)(ks + i * TS_ROW + cc) = o;
        }
    }
    __syncthreads();
    write_transposed(ks, P.mlKt, b, n0, tid);
    write_transposed(vs, P.mlVt, b, n0, tid);
}
__device__ __forceinline__ void prep_mla(const Params& P, LAS3 unsigned char* lds, int tile, int l) {
    const int tid = opaque_tid(), wid = tid >> 6, lane = tid & 63, lr = lane & 15, q = lane >> 4;
    const int t0 = tile * 64, b = t0 / NT, n0 = t0 % NT;
    constexpr int AROW = 328;
    LAS3 bf16_t* As = (LAS3 bf16_t*)lds;
    const float qscale = 0.10206207261596575f * 1.4426950408889634f;
    const float* qn = P.mla_q_norm + l * 192; const float* kvn = P.mla_kv_norm + l * 128;
    const bf16_t* __restrict__ pbr = P.pb; bf16_t* __restrict__ oMK = P.mK; const float* __restrict__ rcs = P.ropecs;
    __syncthreads();
    {
        const int i = tid >> 3, sidx = tid & 7;
        const bf16_t* pr = pbr + (size_t)(t0 + i) * DIN;
        u32x4_t cqv[3], ckv[2];
#pragma unroll
        for (int u = 0; u < 3; ++u) cqv[u] = *(const u32x4_t*)(pr + P_CQ + (sidx + 8 * u) * 8);
#pragma unroll
        for (int u = 0; u < 2; ++u) ckv[u] = *(const u32x4_t*)(pr + P_CKV + (sidx + 8 * u) * 8);
        float fq[3][8], fk[2][8]; float sq = 0.f, sk = 0.f;
#pragma unroll
        for (int u = 0; u < 3; ++u) { unpack8(cqv[u], fq[u]);
#pragma unroll
            for (int e = 0; e < 8; ++e) sq += fq[u][e] * fq[u][e]; }
#pragma unroll
        for (int u = 0; u < 2; ++u) { unpack8(ckv[u], fk[u]);
#pragma unroll
            for (int e = 0; e < 8; ++e) sk += fk[u][e] * fk[u][e]; }
#pragma unroll
        for (int o = 1; o < 8; o <<= 1) { sq += __shfl_xor(sq, o); sk += __shfl_xor(sk, o); }
        const float rq = rsqrtf(sq * (1.f / 192.f) + 1e-6f), rk = rsqrtf(sk * (1.f / 128.f) + 1e-6f);
#pragma unroll
        for (int u = 0; u < 3; ++u) { const int c0 = (sidx + 8 * u) * 8; float o[8];
#pragma unroll
            for (int e = 0; e < 8; ++e) o[e] = fq[u][e] * rq * qn[c0 + e];
            *(LAS3 u32x4_t*)(As + i * AROW + c0) = pack8(o); }
#pragma unroll
        for (int u = 0; u < 2; ++u) { const int c0 = (sidx + 8 * u) * 8; float o[8];
#pragma unroll
            for (int e = 0; e < 8; ++e) o[e] = fk[u][e] * rk * kvn[c0 + e];
            *(LAS3 u32x4_t*)(As + i * AROW + 192 + c0) = pack8(o); }
    }
    if (tid < 256) {
        const int i = tid >> 2, c = tid & 3, n = n0 + i; const bool lat = n >= NC;
        const bf16_t* pr = pbr + (size_t)(t0 + i) * DIN + P_KR;
        const u32x4_t kav = *(const u32x4_t*)(pr + 8 * c), kbv = *(const u32x4_t*)(pr + 8 * (c ^ 2));
        const int pos = max(n - NC, 0);
        const float4* cp = (const float4*)(rcs + (pos * 16 + 8 * (c & 1)) * 2);
        const float4 c0 = cp[0], c1 = cp[1], c2 = cp[2], c3 = cp[3];
        const float sg = (c < 2) ? -1.f : 1.f;
        float ka[8], kb2[8], ko[8];
        unpack8(kav, ka); unpack8(kbv, kb2);
#define RK_(e, cc, ss) ko[e] = ka[e] * (lat ? (cc) : 1.f) + kb2[e] * (lat ? (ss) * sg : 0.f)
        RK_(0, c0.x, c0.y); RK_(1, c0.z, c0.w); RK_(2, c1.x, c1.y); RK_(3, c1.z, c1.w); RK_(4, c2.x, c2.y); RK_(5, c2.z, c2.w); RK_(6, c3.x, c3.y); RK_(7, c3.z, c3.w);
#undef RK_
        const u32x4_t ov = pack8(ko);
#pragma unroll
        for (int hh = 0; hh < 4; ++hh) *(u32x4_t*)(oMK + (((size_t)b * 4 + hh) * NT + n) * 96 + 64 + 8 * c) = ov;
    }
    __syncthreads();
    const int h = wid >> 1;
    if ((wid & 1) == 0) {
        const bf16_t* wt = P.wq_t + (size_t)l * 384 * 192;
        f32x4_t acc[4][6];
#pragma unroll
        for (int rt = 0; rt < 4; ++rt)
#pragma unroll
            for (int ct = 0; ct < 6; ++ct) acc[rt][ct] = (f32x4_t){0.f, 0.f, 0.f, 0.f};
#pragma unroll
        for (int ks = 0; ks < 6; ++ks) {
            bf16x8_t a[4];
#pragma unroll
            for (int rt = 0; rt < 4; ++rt) a[rt] = *(const LAS3 bf16x8_t*)(As + (16 * rt + lr) * AROW + 32 * ks + 8 * q);
#pragma unroll
            for (int ct = 0; ct < 6; ++ct) {
                const bf16x8_t bb = *(const bf16x8_t*)(wt + (size_t)(h * 96 + 16 * ct + lr) * 192 + 32 * ks + 8 * q);
#pragma unroll
                for (int rt = 0; rt < 4; ++rt) acc[rt][ct] = __builtin_amdgcn_mfma_f32_16x16x32_bf16(bb, a[rt], acc[rt][ct], 0, 0, 0);
            }
        }
#pragma unroll
        for (int rt = 0; rt < 4; ++rt) {
            const int n = n0 + 16 * rt + lr;
            bf16_t* qp = P.mQ + (((size_t)b * 4 + h) * NT + n) * 96;
#pragma unroll
            for (int ct = 0; ct < 4; ++ct)
                *(uint2*)(qp + 16 * ct + 4 * q) = make_uint2(cvtpk(acc[rt][ct][0] * qscale, acc[rt][ct][1] * qscale), cvtpk(acc[rt][ct][2] * qscale, acc[rt][ct][3] * qscale));
            f32x4_t x1 = acc[rt][4], x2 = acc[rt][5];
            if (n >= NC) {
                const float4* cp = (const float4*)(rcs + ((n - NC) * 16 + 4 * q) * 2);
                const float4 ca = cp[0], cb = cp[1];
                const f32x4_t co = (f32x4_t){ca.x, ca.z, cb.x, cb.z}, si = (f32x4_t){ca.y, ca.w, cb.y, cb.w};
                const f32x4_t o1 = x1 * co - x2 * si, o2 = x2 * co + x1 * si; x1 = o1; x2 = o2;
            }
            *(uint2*)(qp + 64 + 4 * q) = make_uint2(cvtpk(x1[0] * qscale, x1[1] * qscale), cvtpk(x1[2] * qscale, x1[3] * qscale));
            *(uint2*)(qp + 80 + 4 * q) = make_uint2(cvtpk(x2[0] * qscale, x2[1] * qscale), cvtpk(x2[2] * qscale, x2[3] * qscale));
        }
    } else {
        const bf16_t* wt = P.wkv_t + (size_t)l * 512 * 128;
#pragma unroll
        for (int pass = 0; pass < 2; ++pass) {
            f32x4_t acc[4][4];
#pragma unroll
            for (int rt = 0; rt < 4; ++rt)
#pragma unroll
                for (int ct = 0; ct < 4; ++ct) acc[rt][ct] = (f32x4_t){0.f, 0.f, 0.f, 0.f};
#pragma unroll
            for (int ks = 0; ks < 4; ++ks) {
                bf16x8_t a[4];
#pragma unroll
                for (int rt = 0; rt < 4; ++rt) a[rt] = *(const LAS3 bf16x8_t*)(As + (16 * rt + lr) * AROW + 192 + 32 * ks + 8 * q);
#pragma unroll
                for (int ct = 0; ct < 4; ++ct) {
                    const bf16x8_t bb = *(const bf16x8_t*)(wt + (size_t)(h * 128 + 16 * (4 * pass + ct) + lr) * 128 + 32 * ks + 8 * q);
#pragma unroll
                    for (int rt = 0; rt < 4; ++rt)
                        acc[rt][ct] = (pass == 0) ? __builtin_amdgcn_mfma_f32_16x16x32_bf16(bb, a[rt], acc[rt][ct], 0, 0, 0) : __builtin_amdgcn_mfma_f32_16x16x32_bf16(a[rt], bb, acc[rt][ct], 0, 0, 0);
                }
            }
#pragma unroll
            for (int rt = 0; rt < 4; ++rt) {
                if (pass == 0) {
                    const int n = n0 + 16 * rt + lr;
                    bf16_t* kp = P.mK + (((size_t)b * 4 + h) * NT + n) * 96;
#pragma unroll
                    for (int ct = 0; ct < 4; ++ct) *(uint2*)(kp + 16 * ct + 4 * q) = make_uint2(cvtpk(acc[rt][ct][0], acc[rt][ct][1]), cvtpk(acc[rt][ct][2], acc[rt][ct][3]));
                } else {
#pragma unroll
                    for (int ct = 0; ct < 4; ++ct) {
                        bf16_t* vp = P.mVt + (((size_t)b * 4 + h) * 64 + 16 * ct + lr) * NT + n0 + 16 * rt + 4 * q;
                        *(uint2*)vp = make_uint2(cvtpk(acc[rt][ct][0], acc[rt][ct][1]), cvtpk(acc[rt][ct][2], acc[rt][ct][3]));
                    }
                }
            }
        }
    }
}
__device__ __forceinline__ void phase_prep(const Params& P, LAS3 unsigned char* lds, int l) {
    for (int it = blockIdx.x; it < 3 * (TT / 64); it += gridDim.x) {
        const int fn = it % 3, tile = it / 3;
        if (fn == 0) prep_mla(P, lds, tile, l); else if (fn == 1) prep_ml(P, lds, tile, l); else prep_da(P, lds, tile);
    }
}

__device__ __forceinline__ void phase_mix(const Params& P, LAS3 unsigned char* lds, int l) {
    const int bid = blockIdx.x, G = gridDim.x;
    const float lambda_init = (l == 0) ? 0.2f : 0.35550906759096927f;
    for (int it = bid; it < 256; it += G)
    {
        const int pr = (it & 7) * 4 + (it >> 6), qb = (it >> 3) & 7;
        attn_item<64, 2, true>(lds, P.daQ, P.daK, P.daVt, P.ycatb, 0, pr >> 2, pr & 3, 1 + qb, P.lamfull[l], P.da_subln + l * 64, 1.f - lambda_init);
    }
    LAS3 int* slot = (LAS3 int*)(lds + MK_LDS_MAIN + 16);
    const int n_ml = 64, n_mla = 256, n_s5 = 256, n_ctx = (l == 0) ? 64 : 0;
    const int total = n_ml + n_mla + n_s5 + n_ctx;
    for (;;) {
        __syncthreads();
        if (threadIdx.x == 0) *slot = atomicAdd(P.queue + l, 1);
        __syncthreads();
        int it = __builtin_amdgcn_readfirstlane(*slot);
        if (it >= total) break;
        int kind, b, h, x3;
        if (it < n_ml) { kind = 1; b = it >> 3; h = (it >> 1) & 3; x3 = it & 1; }
        else if ((it -= n_ml) < n_mla) { kind = 2; b = it >> 5; h = (it >> 3) & 3; x3 = 1 + (it & 7); }
        else if ((it -= n_mla) < n_s5) { kind = 3; b = it >> 5; h = (it >> 1) & 15; x3 = it & 1; }
        else { it -= n_s5; kind = (it < 32) ? 0 : 2; it &= 31; b = it >> 2; h = it & 3; x3 = 0; }
        if (kind == 0) attn_item<64, 2, true>(lds, P.daQ, P.daK, P.daVt, P.ycatb, 0, b, h, x3, P.lamfull[l], P.da_subln + l * 64, 1.f - lambda_init);
        else if (kind == 1) mlstm_item(lds, P.mlQ, P.mlK, P.mlKt, P.mlVt, P.mlG, P.hdir, b, h, x3);
        else if (kind == 2) attn_item<96, 1, false>(lds, P.mQ, P.mK, P.mVt, P.ycatb, 512, b, h, x3, 0.f, nullptr, 1.f);
        else s5_item(lds, P.pb, P.s5KmT + (size_t)l * 32 * 16 * 1024, P.s5Smat + (size_t)l * 32 * 128 * 1024, P.s5CmT + (size_t)l * 32 * 16 * 128,
                     P.s5A + l * 32 * 64 * 2, P.s5A64 + l * 32 * 64 * 2, P.s5xs, P.ys5, b, h, x3);
    }
}

template <int TOK, int BATCH>
__device__ __forceinline__ void phase_finish_t(const Params& P, LAS3 unsigned char* lds, int l) {
    constexpr int RT = (TOK + 15) / 16;
    const int tid = opaque_tid(), wid = tid >> 6, lane = tid & 63, lr = lane & 15, q = lane >> 4, c = tid & 255, half = tid >> 8;
    const int ntile = (l == 0) ? TT / TOK : NB * (NS / TOK);
    constexpr int GROW = 264;
    LAS3 bf16_t* Gs = (LAS3 bf16_t*)lds;
    const float* mn = P.ml_norm + l * 256; const float* dsk = P.s5_d + l * 256; const float* bgl = P.s5_b_glu + l * 256;
    const bf16_t* wg = P.wglu_t + (size_t)l * 256 * 256;
    const bf16_t* __restrict__ pbr = P.pb; const bf16_t* __restrict__ hdr = (const bf16_t*)P.hdir; const bf16_t* __restrict__ ysr = (const bf16_t*)P.ys5; bf16_t* __restrict__ oY = P.ycatb;
    for (int it = blockIdx.x; it < ntile; it += gridDim.x) {
        const int t0 = (l == 0) ? it * TOK : ((it / (NS / TOK)) * NT + NC + (it % (NS / TOK)) * TOK);
        __syncthreads();
        {
            const int cg = tid & 31, ts = tid >> 5, c0 = 8 * cg;
            float mnv[8], dsv[8];
            { const float4 m0 = *(const float4*)(mn + c0), m1 = *(const float4*)(mn + c0 + 4), d0 = *(const float4*)(dsk + c0), d1 = *(const float4*)(dsk + c0 + 4);
              mnv[0] = m0.x; mnv[1] = m0.y; mnv[2] = m0.z; mnv[3] = m0.w; mnv[4] = m1.x; mnv[5] = m1.y; mnv[6] = m1.z; mnv[7] = m1.w;
              dsv[0] = d0.x; dsv[1] = d0.y; dsv[2] = d0.z; dsv[3] = d0.w; dsv[4] = d1.x; dsv[5] = d1.y; dsv[6] = d1.z; dsv[7] = d1.w; }
            constexpr int NP = (TOK + 15) / 16;
#pragma unroll
            for (int k0 = 0; k0 < NP; k0 += 2) {
                u32x4_t vog[2], vuu[2], vhf[2], vhb[2], vyf[2], vyb[2];
#pragma unroll
                for (int u = 0; u < 2; ++u) {
                    const int tok = ts + 16 * (k0 + u), tc = (tok < TOK) ? tok : TOK - 1;
                    const size_t t = (size_t)t0 + tc; const bf16_t* pr = pbr + t * DIN;
                    vog[u] = *(const u32x4_t*)(pr + P_MLO + c0); vuu[u] = *(const u32x4_t*)(pr + P_S5 + c0);
                    vhf[u] = *(const u32x4_t*)(hdr + t * 256 + c0); vhb[u] = *(const u32x4_t*)(hdr + ((size_t)TT + t) * 256 + c0);
                    vyf[u] = *(const u32x4_t*)(ysr + t * 256 + c0); vyb[u] = *(const u32x4_t*)(ysr + ((size_t)TT + t) * 256 + c0);
                }
#pragma unroll
                for (int u = 0; u < 2; ++u) {
                    const int tok = ts + 16 * (k0 + u);
                    float og[8], uu[8], hf[8], hb[8], yf[8], yb[8], hv[8], go[8];
                    unpack8(vog[u], og); unpack8(vuu[u], uu); unpack8(vhf[u], hf); unpack8(vhb[u], hb); unpack8(vyf[u], yf); unpack8(vyb[u], yb);
                    float ssq = 0.f;
#pragma unroll
                    for (int e = 0; e < 8; ++e) { hv[e] = sigmoidf_(og[e]) * (hf[e] + hb[e]); ssq += hv[e] * hv[e]; go[e] = gelu_tanh_(yf[e] + yb[e] + uu[e] * dsv[e]); }
                    ssq += __shfl_xor(ssq, 1); ssq += __shfl_xor(ssq, 2); ssq += __shfl_xor(ssq, 4);
                    const float r = rsqrtf(ssq * (1.f / 64.f) + 1e-6f);
#pragma unroll
                    for (int e = 0; e < 8; ++e) hv[e] = hv[e] * r * mnv[e];
                    if (NP * 16 == TOK || tok < TOK) {
                        *(u32x4_t*)(oY + ((size_t)t0 + tok) * DM + 256 + c0) = pack8(hv);
                        *(LAS3 u32x4_t*)(Gs + tok * GROW + c0) = pack8(go);
                    }
                }
            }
        }
        __syncthreads();
        f32x4_t acc[RT][2];
#pragma unroll
        for (int rt = 0; rt < RT; ++rt) { acc[rt][0] = (f32x4_t){0.f, 0.f, 0.f, 0.f}; acc[rt][1] = (f32x4_t){0.f, 0.f, 0.f, 0.f}; }
#pragma unroll
        for (int ks = 0; ks < 8; ++ks) {
            const bf16x8_t b0 = *(const bf16x8_t*)(wg + (size_t)(32 * wid + lr) * 256 + 32 * ks + 8 * q);
            const bf16x8_t b1 = *(const bf16x8_t*)(wg + (size_t)(32 * wid + 16 + lr) * 256 + 32 * ks + 8 * q);
#pragma unroll
            for (int rt = 0; rt < RT; ++rt) {
                const bf16x8_t a = *(const LAS3 bf16x8_t*)(Gs + (16 * rt + lr) * GROW + 32 * ks + 8 * q);
                acc[rt][0] = __builtin_amdgcn_mfma_f32_16x16x32_bf16(a, b0, acc[rt][0], 0, 0, 0);
                acc[rt][1] = __builtin_amdgcn_mfma_f32_16x16x32_bf16(a, b1, acc[rt][1], 0, 0, 0);
            }
        }
#pragma unroll
        for (int rt = 0; rt < RT; ++rt)
#pragma unroll
            for (int cc = 0; cc < 2; ++cc)
#pragma unroll
                for (int rg = 0; rg < 4; ++rg) {
                    const int row = 16 * rt + 4 * q + rg, col = 32 * wid + 16 * cc + lr;
                    const float gv = bf2f(Gs[row * GROW + col]);
                    if (TOK % 16 == 0 || row < TOK) P.ycatb[((size_t)t0 + row) * DM + 768 + col] = f2bf(gv * sigmoidf_(acc[rt][cc][rg] + bgl[col]));
                }
    }
}
__device__ __forceinline__ void phase_finish(const Params& P, LAS3 unsigned char* lds, int l) {
    if (l == 0) phase_finish_t<72, 12>(P, lds, l); else phase_finish_t<64, 8>(P, lds, l);
}

__device__ __forceinline__ void phase_post(const Params& P, LAS3 unsigned char* lds, int l) {
    const int tid = opaque_tid(), wid = tid >> 6, lane = tid & 63, lr = lane & 15, q = lane >> 4;
    constexpr int FROW = 1028, HROW = 1032;
    LAS3 float* ft = (LAS3 float*)lds;
    LAS3 bf16_t* fhi = (LAS3 bf16_t*)lds; LAS3 bf16_t* flo = fhi + 16 * HROW;
    static_assert(2 * 16 * HROW * 2 <= 16 * FROW * 4 + 1024, "hi/lo images");
    LAS3 float* pl = ft + 16 * FROW + 256;
    const float* nw1 = P.norm_w + (size_t)l * 4096 + 1024; const float* nw2 = nw1 + 1024;
    const float* wr = P.moe_w_router + (size_t)l * 1024 * 32; const float* br = P.moe_b_router + l * 32;
    LAS3 int* lcnt = (LAS3 int*)(pl + 8 * 16 * 32);
    if (tid < 32) lcnt[tid] = 0;
    bf16x8_t whi[4][2], wlo[4][2];
#pragma unroll
    for (int kb = 0; kb < 4; ++kb)
#pragma unroll
        for (int hx = 0; hx < 2; ++hx) {
            union { unsigned u[4]; bf16x8_t v; } uh, ul;
#pragma unroll
            for (int jj = 0; jj < 4; ++jj) {
                const float w0 = wr[(size_t)(128 * wid + 32 * kb + 8 * q + 2 * jj) * 32 + 16 * hx + lr], w1 = wr[(size_t)(128 * wid + 32 * kb + 8 * q + 2 * jj + 1) * 32 + 16 * hx + lr];
                const unsigned hb = cvtpk(w0, w1);
                uh.u[jj] = hb; ul.u[jj] = cvtpk(w0 - __uint_as_float(hb << 16), w1 - __uint_as_float(hb & 0xFFFF0000u));
            }
            whi[kb][hx] = uh.v; wlo[kb][hx] = ul.v;
        }
    const int nitem = (l == 0) ? TT / 16 : NB * NS / 16;
    const int tr = tid >> 5, part = tid & 31;
    LAS3 float* wl = (LAS3 float*)(lcnt + 32) + 16 * 32 + 16 * 4 + 16 * 4;
    float4 nm0 = make_float4(0.f, 0.f, 0.f, 0.f), nm1 = nm0;
#define POST_MODROW(it_) (P.mod + ((size_t)l * 9 + (((((l == 0) ? (it_) * 16 : (((it_) >> 7) * NT + NC + ((it_) & 127) * 16)) % NT) < NC) ? 8 : (((l == 0) ? (it_) * 16 : (((it_) >> 7) * NT + NC + ((it_) & 127) * 16)) / NT))) * 6144 + 2048)
    *(LAS3 f32x4_t*)(wl + tid * 4) = *(const f32x4_t*)(nw1 + tid * 4);
    if ((int)blockIdx.x < nitem) { const float* mrn = POST_MODROW((int)blockIdx.x); nm0 = *(const float4*)(mrn + tid * 4); if (tid < 256) nm1 = *(const float4*)(mrn + 2048 + tid * 4);
        *(LAS3 f32x4_t*)(wl + 2048 + tid * 4) = (f32x4_t){nm0.x, nm0.y, nm0.z, nm0.w}; if (tid < 256) *(LAS3 f32x4_t*)(wl + 4096 + tid * 4) = (f32x4_t){nm1.x, nm1.y, nm1.z, nm1.w}; }
    for (int it = blockIdx.x; it < nitem; it += gridDim.x) {
        const int t0 = (l == 0) ? it * 16 : ((it >> 7) * NT + NC + (it & 127) * 16);
        const int t = t0 + tr, b = t / NT, n = t % NT;
        const float* xin = (n < NC) ? P.ctx + ((size_t)b * NC + n) * DM : P.x + ((size_t)b * NS + (n - NC)) * DM;
        bf16_t* x1b = (bf16_t*)P.xall; const bf16_t* x2b = x1b + (size_t)TT * DM;
        __syncthreads();
        float x1[32];
        {
            float so = P.osq[(size_t)t * 16 + (part & 15)];
#pragma unroll
            for (int o = 8; o > 0; o >>= 1) so += __shfl_xor(so, o);
            const float rstd = rsqrtf(so * (1.f / DM) + 1e-6f);
            float ss = 0.f;
#pragma unroll
            for (int j = 0; j < 8; ++j) {
                const int d = j * 128 + part * 4;
                const uint2 ov = *(const uint2*)(P.ob + (size_t)t * DM + d);
                float4 xv;
                if (l == 0) xv = *(const float4*)(xin + d);
                else { const uint2 xb = *(const uint2*)(x2b + (size_t)t * DM + d); xv = make_float4(__uint_as_float(xb.x << 16), __uint_as_float(xb.x & 0xFFFF0000u), __uint_as_float(xb.y << 16), __uint_as_float(xb.y & 0xFFFF0000u)); }
                const f32x4_t wv_ = *(const LAS3 f32x4_t*)(wl + d), gv_ = *(const LAS3 f32x4_t*)(wl + 2048 + d);
                const float4 w = make_float4(wv_[0], wv_[1], wv_[2], wv_[3]), g1 = make_float4(gv_[0], gv_[1], gv_[2], gv_[3]);
                const float a0 = xv.x + g1.x * __uint_as_float(ov.x << 16) * rstd * w.x, a1 = xv.y + g1.y * __uint_as_float(ov.x & 0xFFFF0000u) * rstd * w.y;
                const float a2 = xv.z + g1.z * __uint_as_float(ov.y << 16) * rstd * w.z, a3 = xv.w + g1.w * __uint_as_float(ov.y & 0xFFFF0000u) * rstd * w.w;
                x1[j * 4] = a0; x1[j * 4 + 1] = a1; x1[j * 4 + 2] = a2; x1[j * 4 + 3] = a3;
                *(uint2*)(x1b + (size_t)t * DM + d) = make_uint2(cvtpk(a0, a1), cvtpk(a2, a3));
                ss += (a0 * a0 + a1 * a1) + (a2 * a2 + a3 * a3);
            }
#pragma unroll
            for (int o = 16; o > 0; o >>= 1) ss += __shfl_xor(ss, o);
            const float rstd2 = rsqrtf(ss * (1.f / DM) + 1e-6f);
#pragma unroll
            for (int j = 0; j < 8; ++j) {
                const int d = j * 128 + part * 4;
                const f32x4_t wv_ = *(const LAS3 f32x4_t*)(wl + 1024 + d), sv_ = *(const LAS3 f32x4_t*)(wl + 3072 + d), cv_ = *(const LAS3 f32x4_t*)(wl + 4096 + d);
                const float4 w = make_float4(wv_[0], wv_[1], wv_[2], wv_[3]), sh = make_float4(sv_[0], sv_[1], sv_[2], sv_[3]), sc = make_float4(cv_[0], cv_[1], cv_[2], cv_[3]);
                const float f0 = x1[j * 4] * rstd2 * w.x * (1.f + sc.x) + sh.x, f1 = x1[j * 4 + 1] * rstd2 * w.y * (1.f + sc.y) + sh.y;
                const float f2 = x1[j * 4 + 2] * rstd2 * w.z * (1.f + sc.z) + sh.z, f3 = x1[j * 4 + 3] * rstd2 * w.w * (1.f + sc.w) + sh.w;
                *(uint2*)(P.fb + (size_t)t * DM + d) = make_uint2(cvtpk(f0, f1), cvtpk(f2, f3));
                {
                    const unsigned h01 = cvtpk(f0, f1), h23 = cvtpk(f2, f3);
                    *(LAS3 u32x2_t*)(fhi + tr * HROW + d) = (u32x2_t){h01, h23};
                    *(LAS3 u32x2_t*)(flo + tr * HROW + d) = (u32x2_t){cvtpk(f0 - __uint_as_float(h01 << 16), f1 - __uint_as_float(h01 & 0xFFFF0000u)), cvtpk(f2 - __uint_as_float(h23 << 16), f3 - __uint_as_float(h23 & 0xFFFF0000u))};
                }
            }
        }
        __syncthreads();
        const bool hasn = it + (int)gridDim.x < nitem;
        if (hasn) { const float* mrn = POST_MODROW(it + (int)gridDim.x); nm0 = *(const float4*)(mrn + tid * 4); if (tid < 256) nm1 = *(const float4*)(mrn + 2048 + tid * 4); }
        {
            f32x4_t a0 = (f32x4_t){0.f, 0.f, 0.f, 0.f}, a1 = (f32x4_t){0.f, 0.f, 0.f, 0.f};
            bf16x8_t ah[4], al[4];
#pragma unroll
            for (int kb = 0; kb < 4; ++kb) { ah[kb] = *(const LAS3 bf16x8_t*)(fhi + lr * HROW + 128 * wid + 32 * kb + 8 * q); al[kb] = *(const LAS3 bf16x8_t*)(flo + lr * HROW + 128 * wid + 32 * kb + 8 * q); }
#pragma unroll
            for (int kb = 0; kb < 4; ++kb) {
                a0 = __builtin_amdgcn_mfma_f32_16x16x32_bf16(ah[kb], whi[kb][0], a0, 0, 0, 0); a1 = __builtin_amdgcn_mfma_f32_16x16x32_bf16(ah[kb], whi[kb][1], a1, 0, 0, 0);
                a0 = __builtin_amdgcn_mfma_f32_16x16x32_bf16(ah[kb], wlo[kb][0], a0, 0, 0, 0); a1 = __builtin_amdgcn_mfma_f32_16x16x32_bf16(ah[kb], wlo[kb][1], a1, 0, 0, 0);
                a0 = __builtin_amdgcn_mfma_f32_16x16x32_bf16(al[kb], whi[kb][0], a0, 0, 0, 0); a1 = __builtin_amdgcn_mfma_f32_16x16x32_bf16(al[kb], whi[kb][1], a1, 0, 0, 0);
            }
#pragma unroll
            for (int rg = 0; rg < 4; ++rg) { pl[(wid * 16 + 4 * q + rg) * 32 + lr] = a0[rg]; pl[(wid * 16 + 4 * q + rg) * 32 + 16 + lr] = a1[rg]; }
        }
        __syncthreads();
        {
            float lg = br[part];
#pragma unroll
            for (int w = 0; w < 8; ++w) lg += pl[(w * 16 + tr) * 32 + part];
            LAS3 float* lgs = (LAS3 float*)(lcnt + 32);
            LAS3 float* topv = lgs + 16 * 32;
            LAS3 int* topi = (LAS3 int*)(topv + 16 * 4);
            lgs[tr * 32 + part] = lg;
            asm volatile("s_waitcnt lgkmcnt(0)" ::: "memory");
            int rank = 0;
#pragma unroll
            for (int c4 = 0; c4 < 8; ++c4) {
                const f32x4_t lv = *(const LAS3 f32x4_t*)(lgs + tr * 32 + 4 * c4);
#pragma unroll
                for (int e = 0; e < 4; ++e) rank += (lv[e] > lg || (lv[e] == lg && (4 * c4 + e) < part)) ? 1 : 0;
            }
            if (rank < 4) { topv[tr * 4 + rank] = lg; topi[tr * 4 + rank] = part; }
            asm volatile("s_waitcnt lgkmcnt(0)" ::: "memory");
            if (part < 4) {
                const f32x4_t v = *(const LAS3 f32x4_t*)(topv + tr * 4);
                const int ek = topi[tr * 4 + part];
                const float e1 = __expf(v[1] - v[0]), e2 = __expf(v[2] - v[0]), e3 = __expf(v[3] - v[0]);
                const float inv = 1.f / (1.f + e1 + e2 + e3);
                const float gk = (part == 0) ? inv : (part == 1) ? e1 * inv : (part == 2) ? e2 * inv : e3 * inv;
                P.top_e[(size_t)t * 4 + part] = ek; P.top_g[(size_t)t * 4 + part] = gk;
                P.posb[(size_t)t * 4 + part] = __hip_atomic_fetch_add(&lcnt[ek], 1, __ATOMIC_RELAXED, __HIP_MEMORY_SCOPE_WORKGROUP);
            }
        }
        if (hasn) { *(LAS3 f32x4_t*)(wl + 2048 + tid * 4) = (f32x4_t){nm0.x, nm0.y, nm0.z, nm0.w}; if (tid < 256) *(LAS3 f32x4_t*)(wl + 4096 + tid * 4) = (f32x4_t){nm1.x, nm1.y, nm1.z, nm1.w}; }
    }
#undef POST_MODROW
    __syncthreads();
    if (tid < 32) P.blkcnt[((size_t)l * gridDim.x + blockIdx.x) * 32 + tid] = lcnt[tid];
}

__device__ __forceinline__ void phase_scatter(const Params& P, LAS3 unsigned char* lds, int l) {
    const int tid = opaque_tid(), wid = tid >> 6, lane = tid & 63;
    LAS3 int* soff = (LAS3 int*)lds;
    LAS3 int* part = soff + 64;
    LAS3 int* pre = soff + 1024;
    const int G = gridDim.x;
    const int* bc = P.blkcnt + (size_t)l * G * 32;
    __syncthreads();
    {
        const int e = tid & 31, pt = tid >> 5, per = (G + 15) / 16;
        int sum = 0;
        for (int b2 = pt * per; b2 < (pt + 1) * per && b2 < G; ++b2) sum += bc[b2 * 32 + e];
        part[pt * 32 + e] = sum;
        __syncthreads();
        int run = 0;
        for (int p2 = 0; p2 < pt; ++p2) run += part[p2 * 32 + e];
        for (int b2 = pt * per; b2 < (pt + 1) * per && b2 < G; ++b2) { pre[b2 * 32 + e] = run; run += bc[b2 * 32 + e]; }
        if (pt == 15) soff[32 + e] = run;
    }
    __syncthreads();
    if (tid == 0) {
        int o = 0, nt = 0;
        for (int e = 0; e < NE; ++e) {
            soff[e] = o; const int c = soff[32 + e];
            const int ntl = (c + 255) >> 8;
            if (blockIdx.x == 0) { for (int m = 0; m < ntl; ++m) P.tile_e[l * 512 + nt + m] = e; P.offs[l * 32 + e] = o; }
            nt += ntl; o = nt * 256;
        }
        if (blockIdx.x == 0) P.ntiles[l * 16] = nt;
    }
    __syncthreads();
    const int gt = blockIdx.x * 512 + tid, NTH = gridDim.x * 512;
    const int ntok = (l == 0) ? TT : NB * NS;
    int* __restrict__ stk = (int*)P.xg;
    for (int a = gt; a < ntok * 4; a += NTH) {
        const int i = a >> 2;
        const int t = (l == 0) ? i : ((i >> 11) * NT + NC + (i & 2047));
        const int ek = P.top_e[(size_t)t * 4 + (a & 3)];
        const int slot = soff[ek] + pre[((i >> 4) % G) * 32 + ek] + P.posb[(size_t)t * 4 + (a & 3)];
        stk[slot] = t; P.tok_slot[(size_t)t * 4 + (a & 3)] = slot;
    }
    for (int i = gt; i < NE * 256; i += NTH) {
        const int e = i >> 8, j = i & 255, c = soff[32 + e];
        const int padn = ((c + 255) & ~255) - c;
        if (j < padn) stk[soff[e] + c + j] = NC;
    }
}

__device__ __forceinline__ void phase_combine(const Params& P, LAS3 unsigned char* lds, int l) {
    const int tid = opaque_tid(); const int lane = tid & 63, gw = blockIdx.x * 8 + (tid >> 6), NW = gridDim.x * 8;
    const float* __restrict__ nw3 = P.norm_w + (size_t)l * 4096 + 3072;
    const float* __restrict__ nwn = P.norm_w + 4096;
    const int* __restrict__ tsl = P.tok_slot; const float* __restrict__ tg = P.top_g; const bf16_t* __restrict__ ye = P.yexp; const float* __restrict__ modp = P.mod;
    const int ntok = (l == 0) ? TT : NB * NS;
    LAS3 float* cw = (LAS3 float*)lds;
    for (int i = tid; i < 256; i += 512) { *(LAS3 f32x4_t*)(cw + i * 4) = *(const f32x4_t*)(nw3 + i * 4); if (l == 0) *(LAS3 f32x4_t*)(cw + 1024 + i * 4) = *(const f32x4_t*)(nwn + i * 4); }
    for (int i = tid; i < 9 * 256; i += 512) { const int r = i >> 8, k = i & 255; *(LAS3 f32x4_t*)(cw + 2048 + r * 1024 + k * 4) = *(const f32x4_t*)(modp + ((size_t)l * 9 + r) * 6144 + 5120 + k * 4); }
    if (l == 0) for (int i = tid; i < 9 * 512; i += 512) { const int r = i >> 9, k = i & 511; *(LAS3 f32x4_t*)(cw + 11264 + r * 2048 + k * 4) = *(const f32x4_t*)(modp + ((size_t)9 + r) * 6144 + k * 4); }
    __syncthreads();
    const bf16_t* __restrict__ x1b = (const bf16_t*)P.xall; bf16_t* __restrict__ x2b = (bf16_t*)P.xall + (size_t)TT * DM;
    int i = gw;
    int4 sl = make_int4(0, 0, 0, 0); float4 gt = make_float4(0.f, 0.f, 0.f, 0.f);
    if (i < ntok) { const int t = (l == 0) ? i : ((i >> 11) * NT + NC + (i & 2047)); sl = *(const int4*)(tsl + (size_t)t * 4); gt = *(const float4*)(tg + (size_t)t * 4); }
    for (; i < ntok; i += NW) {
        const int t = (l == 0) ? i : ((i >> 11) * NT + NC + (i & 2047));
        const int b = t / NT, n = t % NT, r = (n < NC) ? 8 : b;
        const int4 slc = sl; const float4 gtc = gt;
        uint2 yv[4][4];
        const int slots[4] = {slc.x, slc.y, slc.z, slc.w};
#pragma unroll
        for (int k = 0; k < 4; ++k)
#pragma unroll
            for (int j = 0; j < 4; ++j) yv[k][j] = *(const uint2*)(ye + (size_t)slots[k] * DM + j * 256 + lane * 4);
        float4 x1[4], w3[4], g2[4], wn[4], scn[4], shn[4];
#define CW4(p_) ({ const f32x4_t v_ = *(const LAS3 f32x4_t*)(p_); make_float4(v_[0], v_[1], v_[2], v_[3]); })
#pragma unroll
        for (int j = 0; j < 4; ++j) {
            const int d = j * 256 + lane * 4;
            { const uint2 xb = *(const uint2*)(x1b + (size_t)t * DM + d); x1[j] = make_float4(__uint_as_float(xb.x << 16), __uint_as_float(xb.x & 0xFFFF0000u), __uint_as_float(xb.y << 16), __uint_as_float(xb.y & 0xFFFF0000u)); }
            w3[j] = CW4(cw + d); g2[j] = CW4(cw + 2048 + r * 1024 + d);
            if (l == 0) { wn[j] = CW4(cw + 1024 + d); scn[j] = CW4(cw + 11264 + r * 2048 + 1024 + d); shn[j] = CW4(cw + 11264 + r * 2048 + d); }
        }
        { const int in = i + NW; if (in < ntok) { const int tn = (l == 0) ? in : ((in >> 11) * NT + NC + (in & 2047)); sl = *(const int4*)(tsl + (size_t)tn * 4); gt = *(const float4*)(tg + (size_t)tn * 4); } }
        const float gk[4] = {gtc.x, gtc.y, gtc.z, gtc.w};
        float m[16];
#pragma unroll
        for (int j = 0; j < 16; ++j) m[j] = 0.f;
#pragma unroll
        for (int k = 0; k < 4; ++k)
#pragma unroll
            for (int j = 0; j < 4; ++j) {
                m[j * 4] += gk[k] * __uint_as_float(yv[k][j].x << 16); m[j * 4 + 1] += gk[k] * __uint_as_float(yv[k][j].x & 0xFFFF0000u);
                m[j * 4 + 2] += gk[k] * __uint_as_float(yv[k][j].y << 16); m[j * 4 + 3] += gk[k] * __uint_as_float(yv[k][j].y & 0xFFFF0000u);
            }
        float ss = 0.f;
#pragma unroll
        for (int j = 0; j < 16; ++j) ss += m[j] * m[j];
        const float rstd = rsqrtf(wave_sum(ss) * (1.f / DM) + 1e-6f);
        float xv[16]; float s2 = 0.f;
#pragma unroll
        for (int j = 0; j < 4; ++j) {
            const int d = j * 256 + lane * 4;
            xv[j * 4] = x1[j].x + g2[j].x * m[j * 4] * rstd * w3[j].x; xv[j * 4 + 1] = x1[j].y + g2[j].y * m[j * 4 + 1] * rstd * w3[j].y;
            xv[j * 4 + 2] = x1[j].z + g2[j].z * m[j * 4 + 2] * rstd * w3[j].z; xv[j * 4 + 3] = x1[j].w + g2[j].w * m[j * 4 + 3] * rstd * w3[j].w;
            s2 += (xv[j * 4] * xv[j * 4] + xv[j * 4 + 1] * xv[j * 4 + 1]) + (xv[j * 4 + 2] * xv[j * 4 + 2] + xv[j * 4 + 3] * xv[j * 4 + 3]);
            const float4 o = make_float4(xv[j * 4], xv[j * 4 + 1], xv[j * 4 + 2], xv[j * 4 + 3]);
            if (l == 0) *(uint2*)(x2b + (size_t)t * DM + d) = make_uint2(cvtpk(o.x, o.y), cvtpk(o.z, o.w));
            else *(float4*)(P.out + ((size_t)b * NS + (n - NC)) * DM + d) = o;
        }
        if (l == 0) {
            const float rs2 = rsqrtf(wave_sum(s2) * (1.f / DM) + 1e-6f);
#pragma unroll
            for (int j = 0; j < 4; ++j) {
                const int d = j * 256 + lane * 4;
                const float o0 = xv[j * 4] * rs2 * wn[j].x * (1.f + scn[j].x) + shn[j].x, o1 = xv[j * 4 + 1] * rs2 * wn[j].y * (1.f + scn[j].y) + shn[j].y;
                const float o2 = xv[j * 4 + 2] * rs2 * wn[j].z * (1.f + scn[j].z) + shn[j].z, o3 = xv[j * 4 + 3] * rs2 * wn[j].w * (1.f + scn[j].w) + shn[j].w;
                *(uint2*)(P.hbuf + (size_t)t * DM + d) = make_uint2(cvtpk(o0, o1), cvtpk(o2, o3));
            }
        }
    }
}

extern __shared__ __attribute__((aligned(16))) unsigned char dyn_lds[];
__device__ __forceinline__ void run_phase(const Params& P, LAS3 unsigned char* lds, int ph) {
    if (ph == PH_SETUP) { phase_setup(P, lds); return; }
    if (ph == PH_H0) { phase_h0(P, lds); return; }
    const int l = (ph - PH_LAYER0) / PH_PER_LAYER, s = (ph - PH_LAYER0) % PH_PER_LAYER;
    switch (s) {
    case L_GEMM_IN: { pg8::Gemm g{P.hbuf, P.w_in_t + (size_t)l * 2560 * 1024, TT, 2560, 1024, 0}; pg8::StaticOrder S; S.init(TT, 2560, gridDim.x, blockIdx.x);
        pg8::EpiBf16P E{P.pb, DIN, 0}; pg8::gemm_phase<pg8::EpiBf16P, pg8::StaticOrder, true, true>(lds, g, S, E); } break;
    case L_PREP: phase_prep(P, lds, l); break;
    case L_MIX: phase_mix(P, lds, l); break;
    case L_FINISH: phase_finish(P, lds, l); break;
    case L_GEMM_OUT: { pg8::Gemm g{P.ycatb, P.w_out_t + (size_t)l * 1024 * 1024, TT, 1024, 1024, 0}; pg8::EpiOut E{P.ob, P.osq};
        if (l == 0) { pg8::StaticOrder S; S.init(TT, 1024, gridDim.x, blockIdx.x); pg8::gemm_phase<pg8::EpiOut, pg8::StaticOrder, true, true>(lds, g, S, E); }
        else { pg8::LatOrder S; S.initl(1024, gridDim.x, blockIdx.x); pg8::gemm_phase<pg8::EpiOut, pg8::LatOrder, true, true>(lds, g, S, E); } } break;
    case L_POST: phase_post(P, lds, l); break;
    case L_SCATTER: phase_scatter(P, lds, l); break;
    case L_GEMM_GU: { pg8::Gemm g{P.fb, P.wgu_t + (size_t)l * NE * 2048 * 1024, 0, 2048, 1024, 0}; pg8::GroupedOrder S; S.initg(P.ntiles + l * 16, P.tile_e + l * 512, 2048, gridDim.x, blockIdx.x);
        pg8::EpiSwiglu E{P.act, P.moe_b_gate_up + (size_t)l * NE * 2048}; pg8::gemm_phase<pg8::EpiSwiglu, pg8::GroupedOrder, true, true, true>(lds, g, S, E, (const int*)P.xg); } break;
    case L_GEMM_DN: { pg8::Gemm g{P.act, P.wdn_t + (size_t)l * NE * 1024 * 1024, 0, 1024, 1024, 0}; pg8::GroupedOrder S; S.initg(P.ntiles + l * 16, P.tile_e + l * 512, 1024, gridDim.x, blockIdx.x);
        pg8::EpiDown E{P.yexp, P.moe_b_down + (size_t)l * NE * 1024}; pg8::gemm_phase<pg8::EpiDown, pg8::GroupedOrder, true, true>(lds, g, S, E); } break;
    case L_COMBINE: phase_combine(P, lds, l); break;
    }
}
__global__ void __launch_bounds__(512, 2) mk_fwd(Params Pk, int ph_lo, int ph_hi) {
    LAS3 unsigned char* lds = (LAS3 unsigned char*)dyn_lds;
    volatile LAS3 unsigned* st = (volatile LAS3 unsigned*)(lds + MK_LDS_MAIN);
    LAS3 Params* PL = (LAS3 Params*)(lds + MK_LDS_MAIN + 64);
    static_assert(sizeof(Params) <= 1024, "Params copy does not fit its LDS slot");
    if (threadIdx.x < 4) st[threadIdx.x] = 0u;
    if (threadIdx.x == 64) store_params(PL, Pk);
    unsigned* barw = Pk.bar;
    __syncthreads();
    XcdBarrier bar; bar.bar = barw; bar.x = 0; bar.st = st;
    if (ph_hi - ph_lo > 1) bar = xcd_barrier_post(barw, st);
#define MK_RUN(ph) if (ph_lo <= (ph) && (ph) < ph_hi) { { const LAS3 Params* PLo = PL; asm volatile("" : "+v"(PLo)); LAS3 unsigned char* ldsp = lds; asm volatile("" : "+s"(ldsp)); \
        const Params P = load_params(PLo); run_phase(P, ldsp, (ph)); } if ((ph) + 1 < ph_hi) xcd_barrier(bar); }
    MK_RUN(0) MK_RUN(1) MK_RUN(2) MK_RUN(3) MK_RUN(4) MK_RUN(5) MK_RUN(6) MK_RUN(7) MK_RUN(8) MK_RUN(9) MK_RUN(10) MK_RUN(11)
    MK_RUN(12) MK_RUN(13) MK_RUN(14) MK_RUN(15) MK_RUN(16) MK_RUN(17) MK_RUN(18) MK_RUN(19) MK_RUN(20) MK_RUN(21)
#undef MK_RUN
}

extern "C" void kernel_launch(void* const* d_in, const int* in_sizes, int n_in, void* d_out, int out_size, void* d_ws, size_t ws_size, hipStream_t stream) {
    Params P{};
    const float** pin = (const float**)&P;
    for (int i = 0; i < 35; ++i) pin[i] = (const float*)d_in[i];
    P.out = (float*)d_out;
    char* ws = (char*)d_ws; size_t off = 0;
    auto carve = [&](size_t bytes) { void* p = ws + off; off += (bytes + 255) & ~(size_t)255; return p; };
    const size_t ctl_bytes = XCD_BAR_WORDS * 4 + 256 + 256;
    P.bar = (unsigned*)carve(XCD_BAR_WORDS * 4); P.queue = (int*)carve(256); P.cnt = (int*)carve(256);
    P.tile_e = (int*)carve(2 * 512 * 4); P.ntiles = (int*)carve(2 * 16 * 4); P.offs = (int*)carve(2 * 32 * 4); P.blkcnt = (int*)carve(2 * 256 * 32 * 4);
    P.xall = (float*)carve((size_t)TT * DM * 4); P.mod = (float*)carve((size_t)2 * 9 * 6144 * 4); P.ropecs = (float*)carve((size_t)NS * 16 * 2 * 4); P.lamfull = (float*)carve(256);
    P.w_in_t = (bf16_t*)carve((size_t)2 * 2560 * 1024 * 2); P.w_out_t = (bf16_t*)carve((size_t)2 * 1024 * 1024 * 2);
    P.wgu_t = (bf16_t*)carve((size_t)2 * NE * 2048 * 1024 * 2); P.wdn_t = (bf16_t*)carve((size_t)2 * NE * 1024 * 1024 * 2);
    P.wq_t = (bf16_t*)carve((size_t)2 * 384 * 192 * 2); P.wkv_t = (bf16_t*)carve((size_t)2 * 512 * 128 * 2); P.wglu_t = (bf16_t*)carve((size_t)2 * 256 * 256 * 2);
    P.s5KmT = (bf16_t*)carve((size_t)64 * 16 * 1024 * 2); P.s5Smat = (bf16_t*)carve((size_t)64 * 128 * 1024 * 2); P.s5CmT = (bf16_t*)carve((size_t)64 * 16 * 128 * 2);
    P.s5A = (float*)carve(64 * 64 * 2 * 4); P.s5A64 = (float*)carve(64 * 64 * 2 * 4); P.s5xs = (float*)carve((size_t)256 * 36 * 128 * 4);
    P.hbuf = (bf16_t*)carve((size_t)TT * DM * 2); P.pb = (bf16_t*)carve((size_t)TT * DIN * 2);
    P.daQ = (bf16_t*)carve((size_t)TT * 256 * 2); P.daK = (bf16_t*)carve((size_t)TT * 256 * 2); P.daVt = (bf16_t*)carve((size_t)TT * 256 * 2);
    P.mQ = (bf16_t*)carve((size_t)TT * 384 * 2); P.mK = (bf16_t*)carve((size_t)TT * 384 * 2); P.mVt = (bf16_t*)carve((size_t)TT * 256 * 2);
    P.mlQ = (bf16_t*)carve((size_t)TT * 256 * 2); P.mlK = (bf16_t*)carve((size_t)TT * 256 * 2); P.mlKt = (bf16_t*)carve((size_t)TT * 256 * 2); P.mlVt = (bf16_t*)carve((size_t)TT * 256 * 2);
    P.mlG = (float*)carve((size_t)TT * 16 * 4); P.hdir = (float*)carve((size_t)2 * TT * 256 * 4); P.ys5 = (float*)carve((size_t)2 * TT * 256 * 4);
    P.ycatb = (bf16_t*)carve((size_t)TT * DM * 2); P.ob = (bf16_t*)carve((size_t)TT * DM * 2); P.osq = (float*)carve((size_t)TT * 16 * 4); P.fb = (bf16_t*)carve((size_t)TT * DM * 2);
    P.top_e = (int*)carve((size_t)NASSIGN * 4); P.top_g = (float*)carve((size_t)NASSIGN * 4); P.posb = (int*)carve((size_t)NASSIGN * 4); P.tok_slot = (int*)carve((size_t)NASSIGN * 4);
    P.xg = (bf16_t*)carve((size_t)MAXSLOTS * DM * 2); P.act = (bf16_t*)carve((size_t)MAXSLOTS * DM * 2); P.yexp = (bf16_t*)carve((size_t)MAXSLOTS * DM * 2);
    if (off > ws_size) { fprintf(stderr, "kernel_launch: workspace too small: need %zu have %zu\n", off, ws_size); return; }
    static bool attr_done = false;
    if (!attr_done) {
        if (hipFuncSetAttribute((const void*)mk_fwd, hipFuncAttributeMaxDynamicSharedMemorySize, MK_LDS_BYTES) != hipSuccess) fprintf(stderr, "kernel_launch: hipFuncSetAttribute failed\n");
        attr_done = true;
    }
    (void)hipMemsetAsync(d_ws, 0, ctl_bytes, stream);
#if MK_ONE_LAUNCH
    hipLaunchKernelGGL(mk_fwd, dim3(256), dim3(512), MK_LDS_BYTES, stream, P, 0, (int)PH_TOTAL);
#else
    for (int ph = 0; ph < PH_TOTAL; ++ph) hipLaunchKernelGGL(mk_fwd, dim3(256), dim3(512), MK_LDS_BYTES, stream, P, ph, ph + 1);
#endif
}
```

```cpp
#include <hip/hip_runtime.h>
#include <cstdint>
#include <cstdio>

#define NB 8
#define NS 2048
#define NC 256
#define NT 2304
#define TT (NB * NT)
#define DM 1024
#define DIN 2560
#define DINC 2416
#define NE 32
#define NASSIGN (TT * 4)
#define MAXSLOTS (NASSIGN + NE * 256)

#define P_DAQ 0
#define P_DAK 256
#define P_DAV 512
#define P_MLQK 768
#define P_MLV 1280
#define P_MLO 1536
#define P_MLG 1792
#define P_CQ 1808
#define P_CKV 2000
#define P_KR 2128
#define P_S5 2160

#ifndef MK_ONE_LAUNCH
#define MK_ONE_LAUNCH 1
#endif

typedef unsigned short bf16_t;
__device__ __forceinline__ float sigmoidf_(float x) { return __builtin_amdgcn_rcpf(1.f + __expf(-x)); }
__device__ __forceinline__ float siluf_(float x) { return x * __builtin_amdgcn_rcpf(1.f + __expf(-x)); }
__device__ __forceinline__ float logsigmoidf_(float x) { return fminf(x, 0.f) - log1pf(__expf(-fabsf(x))); }
__device__ __forceinline__ float gelu_tanh_(float x) { const float u = 0.7978845608028654f * (x + 0.044715f * x * x * x); return x * __builtin_amdgcn_rcpf(1.f + __expf(-2.f * u)); }
typedef __bf16 bf16x2_nat __attribute__((ext_vector_type(2)));
typedef float f32x2_nat __attribute__((ext_vector_type(2)));
__device__ __forceinline__ unsigned cvtpk(float lo, float hi) { const f32x2_nat v = {lo, hi}; const bf16x2_nat b = __builtin_convertvector(v, bf16x2_nat); return __builtin_bit_cast(unsigned, b); }
__device__ __forceinline__ bf16_t f2bf(float f) { return (bf16_t)(cvtpk(f, 0.f) & 0xFFFFu); }
__device__ __forceinline__ float bf2f(bf16_t b) { return __uint_as_float(((unsigned)b) << 16); }
__device__ __forceinline__ unsigned pk2bf(float lo, float hi) { return cvtpk(lo, hi); }
__device__ __forceinline__ int opaque_tid() { int t = threadIdx.x; asm volatile("" : "+v"(t)); return t; }
__device__ __forceinline__ float wave_sum(float v) {
#pragma unroll
    for (int o = 32; o > 0; o >>= 1) v += __shfl_xor(v, o);
    return v;
}
__device__ __forceinline__ int seq_token(int s, int dir) {
    if (dir == 0) return s;
    return (s < NC) ? (NC - 1 - s) : (NC + (NT - 1 - s));
}

namespace pg8 {
#define PG8_LAS __attribute__((address_space(3)))
typedef short bf16x8 __attribute__((ext_vector_type(8)));
typedef float f32x4 __attribute__((ext_vector_type(4)));
typedef unsigned u32x4 __attribute__((ext_vector_type(4)));
constexpr int BM = 256, BK = 64, HALF = 128, HTB = HALF * BK * 2, STAGE_BYTES = 8 * HTB, NXCD = 8, WGM = 8;
__host__ __device__ __forceinline__ int lds_byte(int r, int c) { const int st = (r >> 4) * 2 + (c >> 5), rr = r & 15, cc = c & 31, ob = rr * 64 + cc * 2; return st * 1024 + (ob ^ (((ob >> 9) & 1) << 5)); }
__host__ __device__ __forceinline__ void stage_rc(int b, int& R, int& C) { const int st = b / 1024, sb = b % 1024, swz = sb ^ (((sb >> 9) & 1) << 5); R = (st >> 1) * 16 + swz / 64; C = (st & 1) * 32 + (swz % 64) / 2; }
__host__ __device__ __forceinline__ int perm32(int rho) { const int n = rho >> 4, i = rho & 15; return 8 * (i >> 2) + 4 * n + (i & 3); }
struct Unit { int pm, pn; };
struct Gemm { const bf16_t* A; const bf16_t* Bt; int M, N, K, pad; };
__device__ __forceinline__ unsigned cvt_pk_bf16(float lo, float hi) { return cvtpk(lo, hi); }

struct StaticOrder {
    int nM, nN, nwg, G, c;
    __device__ void init(int M, int N, int G_, int c_) { nM = M / BM; nN = N / BM; nwg = nM * nN; G = G_; c = c_; }
    __device__ bool next(int i, Unit& u) const {
        const long L = (long)i * G + c; if (L >= nwg) return false;
        int wgid = (int)L; { const int q = nwg / NXCD, r = nwg % NXCD, xcd = wgid % NXCD, off = wgid / NXCD; wgid = (xcd < r ? xcd * (q + 1) : r * (q + 1) + (xcd - r) * q) + off; }
        const int nig = WGM * nN, gid = wgid / nig, fm = gid * WGM, gsz = (nM - fm) < WGM ? (nM - fm) : WGM;
        u.pm = fm + ((wgid % nig) % gsz); u.pn = (wgid % nig) / gsz; return true;
    }
    __device__ __forceinline__ void a_ready(const Unit&) const {}
    __device__ __forceinline__ void done(const Unit&) const {}
};
struct LatOrder : StaticOrder {
    __device__ void initl(int N, int G_, int c_) { nM = 64; nN = N / BM; nwg = nM * nN; G = G_; c = c_; }
    __device__ bool next(int i, Unit& u) const { if (!StaticOrder::next(i, u)) return false; u.pm = (u.pm >> 3) * 9 + 1 + (u.pm & 7); return true; }
};
struct GroupedOrder : StaticOrder {
    const int* tile_e;
    __device__ void initg(const int* ntiles_p, const int* tile_e_, int N, int G_, int c_) { nM = ntiles_p[0]; nN = N / BM; nwg = nM * nN; G = G_; c = c_; tile_e = tile_e_; }
    __device__ bool next(int i, Unit& u) const { if (!StaticOrder::next(i, u)) return false; u.pn += tile_e[u.pm] * nN; return true; }
};

struct EpiBf16P {
    static constexpr bool PERM = true;
    bf16_t* O; int ldc, pad;
    __device__ __forceinline__ void operator()(const f32x4 (&acc)[2][2][4][2], const Unit& u, int wr, int wc, int fr, int fq) const {
        const int row0 = u.pm * BM + wr * 64 + fr, col0 = u.pn * BM + wc * 32 + 8 * fq;
#pragma unroll
        for (int ai = 0; ai < 2; ++ai)
#pragma unroll
            for (int m = 0; m < 4; ++m) { bf16_t* rowp = O + (size_t)(row0 + ai * HALF + m * 16) * ldc + col0;
#pragma unroll
                for (int bj = 0; bj < 2; ++bj) { const f32x4 v0 = acc[ai][bj][m][0], v1 = acc[ai][bj][m][1];
                    u32x4 w; w.x = cvt_pk_bf16(v0[0], v0[1]); w.y = cvt_pk_bf16(v0[2], v0[3]); w.z = cvt_pk_bf16(v1[0], v1[1]); w.w = cvt_pk_bf16(v1[2], v1[3]);
                    *(u32x4*)(rowp + bj * HALF) = w; } }
    }
};
struct EpiOut {
    static constexpr bool PERM = true;
    bf16_t* O; float* osq;
    __device__ __forceinline__ void operator()(const f32x4 (&acc)[2][2][4][2], const Unit& u, int wr, int wc, int fr, int fq) const {
        const int row0 = u.pm * BM + wr * 64 + fr, col0 = u.pn * BM + wc * 32 + 8 * fq;
#pragma unroll
        for (int ai = 0; ai < 2; ++ai)
#pragma unroll
            for (int m = 0; m < 4; ++m) { const int row = row0 + ai * HALF + m * 16; bf16_t* rowp = O + (size_t)row * 1024 + col0; float ss = 0.f;
#pragma unroll
                for (int bj = 0; bj < 2; ++bj) { const f32x4 v0 = acc[ai][bj][m][0], v1 = acc[ai][bj][m][1];
                    ss += (v0[0] * v0[0] + v0[1] * v0[1]) + (v0[2] * v0[2] + v0[3] * v0[3]) + (v1[0] * v1[0] + v1[1] * v1[1]) + (v1[2] * v1[2] + v1[3] * v1[3]);
                    u32x4 w; w.x = cvt_pk_bf16(v0[0], v0[1]); w.y = cvt_pk_bf16(v0[2], v0[3]); w.z = cvt_pk_bf16(v1[0], v1[1]); w.w = cvt_pk_bf16(v1[2], v1[3]);
                    *(u32x4*)(rowp + bj * HALF) = w; }
                ss += __shfl_xor(ss, 16); ss += __shfl_xor(ss, 32);
                if (fq == 0) osq[(size_t)row * 16 + u.pn * 4 + wc] = ss; }
    }
};
struct EpiDown {
    static constexpr bool PERM = true;
    bf16_t* C; const float* bias;
    __device__ __forceinline__ void operator()(const f32x4 (&acc)[2][2][4][2], const Unit& u, int wr, int wc, int fr, int fq) const {
        const int e = u.pn >> 2, pnl = u.pn & 3;
        const int row0 = u.pm * BM + wr * 64 + fr, col0 = pnl * BM + wc * 32 + 8 * fq;
        const float* bp = bias + (size_t)e * 1024 + col0;
        f32x4 bv[2][2];
#pragma unroll
        for (int bj = 0; bj < 2; ++bj)
#pragma unroll
            for (int n = 0; n < 2; ++n) bv[bj][n] = *(const f32x4*)(bp + bj * HALF + 4 * n);
#pragma unroll
        for (int ai = 0; ai < 2; ++ai)
#pragma unroll
            for (int m = 0; m < 4; ++m) { bf16_t* rowp = C + (size_t)(row0 + ai * HALF + m * 16) * 1024 + col0;
#pragma unroll
                for (int bj = 0; bj < 2; ++bj) { const f32x4 v0 = acc[ai][bj][m][0] + bv[bj][0], v1 = acc[ai][bj][m][1] + bv[bj][1];
                    u32x4 w; w.x = cvt_pk_bf16(v0[0], v0[1]); w.y = cvt_pk_bf16(v0[2], v0[3]); w.z = cvt_pk_bf16(v1[0], v1[1]); w.w = cvt_pk_bf16(v1[2], v1[3]);
                    *(u32x4*)(rowp + bj * HALF) = w; } }
    }
};
struct EpiSwiglu {
    static constexpr bool PERM = true;
    bf16_t* O; const float* bias;
    __device__ __forceinline__ void operator()(const f32x4 (&acc)[2][2][4][2], const Unit& u, int wr, int wc, int fr, int fq) const {
        const int e = u.pn >> 3, pnl = u.pn & 7;
        const int row0 = u.pm * BM + wr * 64 + fr, col0 = pnl * HALF + wc * 32 + 8 * fq;
        const float* bp = bias + (size_t)e * 2048 + col0;
        f32x4 bg[2], bu[2];
#pragma unroll
        for (int n = 0; n < 2; ++n) { bg[n] = *(const f32x4*)(bp + 4 * n); bu[n] = *(const f32x4*)(bp + 1024 + 4 * n) + 1.0f; }
#pragma unroll
        for (int ai = 0; ai < 2; ++ai)
#pragma unroll
            for (int m = 0; m < 4; ++m) {
                bf16_t* rowp = O + (size_t)(row0 + ai * HALF + m * 16) * 1024 + col0;
                float r[8];
#pragma unroll
                for (int n = 0; n < 2; ++n) {
                    const f32x4 g = acc[ai][0][m][n] + bg[n], up = acc[ai][1][m][n] + bu[n];
                    const f32x4 gt = __builtin_elementwise_min(g, (f32x4){7.f, 7.f, 7.f, 7.f});
                    const f32x4 uu = __builtin_elementwise_min(__builtin_elementwise_max(up, (f32x4){-6.f, -6.f, -6.f, -6.f}), (f32x4){8.f, 8.f, 8.f, 8.f});
                    const f32x4 z = gt * (-1.702f * 1.4426950408889634f);
                    f32x4 e; e[0] = __builtin_amdgcn_exp2f(z[0]); e[1] = __builtin_amdgcn_exp2f(z[1]); e[2] = __builtin_amdgcn_exp2f(z[2]); e[3] = __builtin_amdgcn_exp2f(z[3]);
                    const f32x4 d = e + 1.0f;
                    f32x4 rc; rc[0] = __builtin_amdgcn_rcpf(d[0]); rc[1] = __builtin_amdgcn_rcpf(d[1]); rc[2] = __builtin_amdgcn_rcpf(d[2]); rc[3] = __builtin_amdgcn_rcpf(d[3]);
                    const f32x4 o = (uu * gt) * rc;
                    r[n * 4] = o[0]; r[n * 4 + 1] = o[1]; r[n * 4 + 2] = o[2]; r[n * 4 + 3] = o[3];
                }
                u32x4 w; w.x = cvt_pk_bf16(r[0], r[1]); w.y = cvt_pk_bf16(r[2], r[3]); w.z = cvt_pk_bf16(r[4], r[5]); w.w = cvt_pk_bf16(r[6], r[7]);
                *(u32x4*)rowp = w;
            }
    }
};

template <class Epi, class Sched, bool ALIGN_EPI = false, bool SP2 = false, bool GATHER = false>
__device__ __forceinline__ void gemm_phase(PG8_LAS unsigned char* lds, const Gemm g, const Sched& S, const Epi& E, const int* rowtok = nullptr) {
    static_assert(!GATHER || SP2, "gather staging is wired into the SP2 loop only");
    const int tid = opaque_tid(), wid = __builtin_amdgcn_readfirstlane(tid >> 6), lane = tid & 63, wr = wid >> 2, wc = wid & 3, fr = lane & 15, fq = lane >> 4;
    const int K = g.K, nt = K / BK;
    unsigned voffA[2], voffB[2];
#pragma unroll
    for (int i = 0; i < 2; ++i) { int R, C; stage_rc(tid * 16 + i * 8192, R, C); const int Rb = Epi::PERM ? ((R & ~31) + perm32(R & 31)) : R;
        voffA[i] = (unsigned)(R * K + C) * 2u; voffB[i] = (unsigned)(Rb * K + C) * 2u; }
    int gR[2], gC[2];
#pragma unroll
    for (int i = 0; i < 2; ++i) stage_rc(tid * 16 + i * 8192, gR[i], gC[i]);
    PG8_LAS int* rt = (PG8_LAS int*)(lds + STAGE_BYTES);
    unsigned gaC[2][2] = {{0u, 0u}, {0u, 0u}}, gaN[2][2] = {{0u, 0u}, {0u, 0u}};
    const size_t kstep = (size_t)(BK * 2);
    const size_t hstep = (size_t)HALF * K * 2;
    const size_t tstep = 2 * hstep;
    const unsigned ldsw = (unsigned)wid * 1024u;
    const int aoff = lds_byte(wr * 64 + fr, fq * 8), boff = lds_byte(wc * 32 + fr, fq * 8);
#define PG8_SA(b, h) (((b) * 2 + (h)) * HTB)
#define PG8_SB(b, h) ((4 + (b) * 2 + (h)) * HTB)
#define PG8_STAGE(bufoff, gbase, voff) do { _Pragma("unroll") for (int _i = 0; _i < 2; ++_i) \
        __builtin_amdgcn_global_load_lds((const unsigned*)((const char*)(gbase) + (voff)[_i]), (PG8_LAS unsigned*)(lds + (bufoff) + ldsw + _i * 8192), 16, 0, 0); } while (0)
#define PG8_GOFF(dst, k) do { _Pragma("unroll") for (int h_ = 0; h_ < 2; ++h_) _Pragma("unroll") for (int i_ = 0; i_ < 2; ++i_) dst[h_][i_] = (unsigned)(rt[(k) * 256 + h_ * HALF + gR[i_]] * K + gC[i_]) * 2u; } while (0)
#define PG8_STAGE_A(bufoff, ptr, un, h, kb) do { if constexpr (GATHER) { const unsigned o0_ = (un) ? gaN[h][0] : gaC[h][0], o1_ = (un) ? gaN[h][1] : gaC[h][1]; \
        __builtin_amdgcn_global_load_lds((const unsigned*)((const char*)g.A + (kb) + o0_), (PG8_LAS unsigned*)(lds + (bufoff) + ldsw), 16, 0, 0); \
        __builtin_amdgcn_global_load_lds((const unsigned*)((const char*)g.A + (kb) + o1_), (PG8_LAS unsigned*)(lds + (bufoff) + ldsw + 8192), 16, 0, 0); } else PG8_STAGE(bufoff, ptr, voffA); } while (0)
#define PG8_LDA(dst, b, h) do { _Pragma("unroll") for (int m = 0; m < 4; ++m) _Pragma("unroll") for (int k = 0; k < 2; ++k) dst[m][k] = *(const PG8_LAS bf16x8*)(lds + PG8_SA(b, h) + aoff + m * 2048 + k * 1024); } while (0)
#define PG8_LDB(dst, b, h) do { _Pragma("unroll") for (int n = 0; n < 2; ++n) _Pragma("unroll") for (int k = 0; k < 2; ++k) dst[n][k] = *(const PG8_LAS bf16x8*)(lds + PG8_SB(b, h) + boff + n * 2048 + k * 1024); } while (0)
#define PG8_MMA(ai, bj, At, Bt) do { __builtin_amdgcn_s_setprio(1); _Pragma("unroll") for (int m = 0; m < 4; ++m) _Pragma("unroll") for (int n = 0; n < 2; ++n) _Pragma("unroll") for (int k = 0; k < 2; ++k) \
        acc[ai][bj][m][n] = __builtin_amdgcn_mfma_f32_16x16x32_bf16(Bt[n][k], At[m][k], acc[ai][bj][m][n], 0, 0, 0); __builtin_amdgcn_s_setprio(0); } while (0)
#define PG8_WAIT_V(n) asm volatile("s_waitcnt vmcnt(" #n ")" ::: "memory")
#define PG8_WAIT_L(n) asm volatile("s_waitcnt lgkmcnt(" #n ")" ::: "memory")
#define PG8_BAR __builtin_amdgcn_s_barrier()
#define PG8_SCHED __builtin_amdgcn_sched_barrier(0)
    Unit cur, nxt; int ui = 0;
    if (!S.next(0, cur)) return;
    f32x4 acc[2][2][4][2];
#pragma unroll
    for (int a = 0; a < 2; ++a)
#pragma unroll
        for (int b = 0; b < 2; ++b)
#pragma unroll
            for (int m = 0; m < 4; ++m)
#pragma unroll
                for (int n = 0; n < 2; ++n) acc[a][b][m][n] = (f32x4){0.f, 0.f, 0.f, 0.f};
    bf16x8 At[4][2], B0[2][2], B1[2][2];
    const char* cA = (const char*)g.A + (size_t)cur.pm * tstep; const char* cB = (const char*)g.Bt + (size_t)cur.pn * tstep;
    S.a_ready(cur);
    if constexpr (GATHER) {
        Unit u_;
        for (int k = 0; S.next(k, u_); ++k) if (tid < 256) rt[k * 256 + tid] = rowtok[u_.pm * 256 + tid];
        __syncthreads();
        PG8_GOFF(gaC, 0);
    }
    if constexpr (SP2) {
        PG8_STAGE(PG8_SB(0, 0), cB, voffB); PG8_STAGE(PG8_SB(0, 1), cB + hstep, voffB); PG8_STAGE_A(PG8_SA(0, 0), cA, false, 0, (size_t)0); PG8_STAGE_A(PG8_SA(0, 1), cA + hstep, false, 1, (size_t)0);
        if (wr == 1) PG8_BAR;
        PG8_WAIT_V(2); PG8_BAR;
        PG8_STAGE(PG8_SB(1, 0), cB + kstep, voffB); PG8_STAGE_A(PG8_SA(1, 0), cA + kstep, false, 0, kstep); PG8_STAGE(PG8_SB(1, 1), cB + hstep + kstep, voffB);
        PG8_WAIT_V(6); PG8_BAR;
    } else {
        PG8_STAGE(PG8_SB(0, 0), cB, voffB); PG8_STAGE(PG8_SA(0, 0), cA, voffA); PG8_STAGE(PG8_SB(0, 1), cB + hstep, voffB); PG8_STAGE(PG8_SA(0, 1), cA + hstep, voffA);
        if (wr == 1) PG8_BAR;
        PG8_WAIT_V(4); PG8_BAR;
        PG8_STAGE(PG8_SB(1, 0), cB + kstep, voffB); PG8_STAGE(PG8_SA(1, 0), cA + kstep, voffA); PG8_STAGE(PG8_SB(1, 1), cB + hstep + kstep, voffB);
        PG8_WAIT_V(6); PG8_BAR;
    }
    for (;;) {
        const bool has_next = S.next(ui + 1, nxt);
        if constexpr (GATHER) { if (has_next) PG8_GOFF(gaN, ui + 1); }
        const char* nA = has_next ? (const char*)g.A + (size_t)nxt.pm * tstep : cA; const char* nB = has_next ? (const char*)g.Bt + (size_t)nxt.pn * tstep : cB;
        for (int t = 0; t < nt; t += 2) {
            const bool last = (t == nt - 2);
            const char* a1 = cA + (size_t)(t + 1) * kstep;
            const char* a2 = last ? nA : cA + (size_t)(t + 2) * kstep; const char* b2 = last ? nB : cB + (size_t)(t + 2) * kstep;
            const char* a3 = a2 + kstep; const char* b3 = b2 + kstep;
            if (last && has_next) S.a_ready(nxt);
            const bool un = last && has_next; const size_t k1 = (size_t)(t + 1) * kstep, k2 = last ? (size_t)0 : (size_t)(t + 2) * kstep;
            if constexpr (SP2) {
            PG8_LDB(B0, 0, 0); PG8_LDB(B1, 0, 1); PG8_SCHED; PG8_LDA(At, 0, 0); PG8_STAGE_A(PG8_SA(1, 1), a1 + hstep, false, 1, k1);
            PG8_WAIT_V(8); PG8_WAIT_L(0); PG8_BAR; PG8_MMA(0, 0, At, B0); PG8_MMA(0, 1, At, B1); PG8_BAR; PG8_SCHED;
            PG8_LDA(At, 0, 1); PG8_STAGE(PG8_SB(0, 0), b2, voffB); PG8_STAGE(PG8_SB(0, 1), b2 + hstep, voffB); PG8_STAGE_A(PG8_SA(0, 0), a2, un, 0, k2);
            PG8_WAIT_V(8); PG8_WAIT_L(0); PG8_BAR; PG8_MMA(1, 0, At, B0); PG8_MMA(1, 1, At, B1); PG8_BAR; PG8_SCHED;
            PG8_LDB(B0, 1, 0); PG8_LDB(B1, 1, 1); PG8_SCHED; PG8_LDA(At, 1, 0); PG8_STAGE_A(PG8_SA(0, 1), a2 + hstep, un, 1, k2);
            PG8_WAIT_V(8); PG8_WAIT_L(0); PG8_BAR; PG8_MMA(0, 0, At, B0); PG8_MMA(0, 1, At, B1); PG8_BAR; PG8_SCHED;
            PG8_LDA(At, 1, 1); PG8_STAGE(PG8_SB(1, 0), b3, voffB); PG8_STAGE(PG8_SB(1, 1), b3 + hstep, voffB); PG8_STAGE_A(PG8_SA(1, 0), a3, un, 0, k2 + kstep);
            PG8_WAIT_V(8); PG8_WAIT_L(0); PG8_BAR; PG8_MMA(1, 0, At, B0); PG8_MMA(1, 1, At, B1); PG8_BAR; PG8_SCHED;
            } else {
            PG8_LDB(B0, 0, 0); PG8_SCHED; PG8_LDA(At, 0, 0); PG8_STAGE(PG8_SA(1, 1), a1 + hstep, voffA);
            PG8_WAIT_L(8); PG8_BAR; PG8_WAIT_L(0); PG8_MMA(0, 0, At, B0); PG8_BAR; PG8_SCHED;
            PG8_LDB(B1, 0, 1); PG8_STAGE(PG8_SB(0, 0), b2, voffB);
            PG8_BAR; PG8_WAIT_L(0); PG8_MMA(0, 1, At, B1); PG8_BAR;
            PG8_LDA(At, 0, 1); PG8_STAGE(PG8_SA(0, 0), a2, voffA);
            PG8_BAR; PG8_WAIT_L(0); PG8_MMA(1, 0, At, B0); PG8_BAR; PG8_SCHED;
            PG8_STAGE(PG8_SB(0, 1), b2 + hstep, voffB);
            PG8_WAIT_V(6); PG8_BAR; PG8_MMA(1, 1, At, B1); PG8_BAR;
            PG8_LDB(B0, 1, 0); PG8_SCHED; PG8_LDA(At, 1, 0); PG8_STAGE(PG8_SA(0, 1), a2 + hstep, voffA);
            PG8_WAIT_L(8); PG8_BAR; PG8_WAIT_L(0); PG8_MMA(0, 0, At, B0); PG8_BAR; PG8_SCHED;
            PG8_LDB(B1, 1, 1); PG8_STAGE(PG8_SB(1, 0), b3, voffB);
            PG8_BAR; PG8_WAIT_L(0); PG8_MMA(0, 1, At, B1); PG8_BAR;
            PG8_LDA(At, 1, 1); PG8_STAGE(PG8_SA(1, 0), a3, voffA);
            PG8_BAR; PG8_WAIT_L(0); PG8_MMA(1, 0, At, B0); PG8_BAR; PG8_SCHED;
            PG8_STAGE(PG8_SB(1, 1), b3 + hstep, voffB);
            PG8_WAIT_V(6); PG8_BAR; PG8_MMA(1, 1, At, B1); PG8_BAR;
            }
        }
        if constexpr (ALIGN_EPI) { if (wr == 0) PG8_BAR; }
        E(acc, cur, wr, wc, fr, fq); S.done(cur);
        if (!has_next) break;
#pragma unroll
        for (int a = 0; a < 2; ++a)
#pragma unroll
            for (int b = 0; b < 2; ++b)
#pragma unroll
                for (int m = 0; m < 4; ++m)
#pragma unroll
                    for (int n = 0; n < 2; ++n) acc[a][b][m][n] = (f32x4){0.f, 0.f, 0.f, 0.f};
        cur = nxt; cA = nA; cB = nB; ++ui;
        if constexpr (GATHER) { gaC[0][0] = gaN[0][0]; gaC[0][1] = gaN[0][1]; gaC[1][0] = gaN[1][0]; gaC[1][1] = gaN[1][1]; }
        if constexpr (ALIGN_EPI) { if (wr == 1) PG8_BAR; }
    }
    PG8_WAIT_V(0);
    if constexpr (!ALIGN_EPI) { if (wr == 0) PG8_BAR; }
    PG8_BAR;
#undef PG8_SA
#undef PG8_SB
#undef PG8_STAGE
#undef PG8_LDA
#undef PG8_GOFF
#undef PG8_STAGE_A
#undef PG8_LDB
#undef PG8_MMA
#undef PG8_WAIT_V
#undef PG8_WAIT_L
#undef PG8_BAR
#undef PG8_SCHED
}
}

typedef short bf16x8_t __attribute__((ext_vector_type(8)));
typedef float f32x16_t __attribute__((ext_vector_type(16)));
typedef float f32x2_t __attribute__((ext_vector_type(2)));
typedef unsigned u32x4_t __attribute__((ext_vector_type(4)));
typedef unsigned u32x2_t __attribute__((ext_vector_type(2)));
#define LAS3 __attribute__((address_space(3)))
constexpr int ATT_VROW = 68;
constexpr int ATT_LDS_BYTES = 3 * (64 * 104 * 2 + 64 * ATT_VROW * 2);

template <int QKD, int NMAP, bool DA>
__device__ __forceinline__ void attn_item(LAS3 unsigned char* lds, const bf16_t* __restrict__ Qb, const bf16_t* __restrict__ Kb, const bf16_t* __restrict__ Vt,
                                          bf16_t* __restrict__ ycatb, int ycat_off, int b, int h, int qblk, float lam, const float* __restrict__ subln, float post_scale) {
    constexpr int DK = QKD / NMAP, KS = DK / 16, KROW = QKD + 8, KCH = QKD / 8;
    constexpr int KBYTES = 64 * KROW * 2, VBYTES = 64 * ATT_VROW * 2, BUFB = KBYTES + VBYTES;
    const int tid = opaque_tid(), wid = tid >> 6, lane = tid & 63, r = lane & 31, hh = lane >> 5;
    const int q0 = qblk * 256, ntiles = (qblk == 0) ? (NC / 64) : (NT / 64);
    const size_t base = ((size_t)b * 4 + h) * NT;
    bf16x8_t qf[NMAP][KS];
#pragma unroll
    for (int m = 0; m < NMAP; ++m)
#pragma unroll
        for (int ks = 0; ks < KS; ++ks) qf[m][ks] = *(const bf16x8_t*)(Qb + (base + q0 + 32 * wid + r) * QKD + m * DK + 16 * ks + 8 * hh);
    f32x16_t O[NMAP][2]; float mrun[NMAP], lrun[NMAP];
#pragma unroll
    for (int m = 0; m < NMAP; ++m) { mrun[m] = 0.f; lrun[m] = 0.f;
#pragma unroll
        for (int d2 = 0; d2 < 2; ++d2)
#pragma unroll
            for (int i = 0; i < 16; ++i) O[m][d2][i] = 0.f; }
    constexpr int NKC = 64 * KCH;
    const bf16_t* kg = Kb + base * QKD;
    const bf16_t* vg = Vt + ((size_t)(b * 4 + h) * 64 + (tid >> 3)) * NT + (tid & 7) * 8;
    u32x4_t rk0, rk1 = (u32x4_t){0u, 0u, 0u, 0u}, rv;
    const int kc1 = tid + 512;
    const int k0row = tid / KCH, k0col = tid % KCH, k1row = kc1 / KCH, k1col = kc1 % KCH;
#define ATT_LOAD(j) do { rk0 = *(const u32x4_t*)(kg + (size_t)(j) * 64 * QKD + tid * 8); if (NKC > 512 && kc1 < NKC) rk1 = *(const u32x4_t*)(kg + (size_t)(j) * 64 * QKD + kc1 * 8); \
        rv = *(const u32x4_t*)(vg + (size_t)(j) * 64); } while (0)
#define ATT_STORE(buf) do { LAS3 unsigned char* kb_ = lds + (buf) * BUFB; LAS3 unsigned char* vb_ = kb_ + KBYTES; \
        *(LAS3 u32x4_t*)(kb_ + (k0row * KROW + k0col * 8) * 2) = rk0; if (NKC > 512 && kc1 < NKC) *(LAS3 u32x4_t*)(kb_ + (k1row * KROW + k1col * 8) * 2) = rk1; \
        LAS3 unsigned char* vd_ = vb_ + ((tid >> 3) * ATT_VROW + (tid & 7) * 8) * 2; *(LAS3 u32x2_t*)vd_ = (u32x2_t){rv.x, rv.y}; *(LAS3 u32x2_t*)(vd_ + 8) = (u32x2_t){rv.z, rv.w}; } while (0)
    __syncthreads();
    ATT_LOAD(0); ATT_STORE(0);
    if (ntiles > 1) ATT_LOAD(1);
    __syncthreads();
    bf16x8_t pf[NMAP][2][2];
#define ATT_PV(m_, vb_) do { _Pragma("unroll") for (int d2 = 0; d2 < 2; ++d2) _Pragma("unroll") for (int kt = 0; kt < 2; ++kt) _Pragma("unroll") for (int s2 = 0; s2 < 2; ++s2) { \
        const LAS3 unsigned char* vp = (vb_) + ((d2 * 32 + r) * ATT_VROW + kt * 32 + 16 * s2 + 4 * hh) * 2; \
        union { u32x2_t u[2]; bf16x8_t v; } av; av.u[0] = *(const LAS3 u32x2_t*)vp; av.u[1] = *(const LAS3 u32x2_t*)(vp + 16); \
        O[m_][d2] = __builtin_amdgcn_mfma_f32_32x32x16_bf16(av.v, pf[m_][kt][s2], O[m_][d2], 0, 0, 0); } } while (0)
    int sl = 0;
    for (int j = 0; j < ntiles; ++j) {
        const LAS3 unsigned char* kb = lds + sl * BUFB;
        const LAS3 unsigned char* vbp = lds + ((sl == 0) ? 2 : sl - 1) * BUFB + KBYTES;
#pragma unroll
        for (int m = 0; m < NMAP; ++m) {
            f32x16_t S[2];
            const float nm = -mrun[m];
#pragma unroll
            for (int kt = 0; kt < 2; ++kt) {
#pragma unroll
                for (int i = 0; i < 16; ++i) S[kt][i] = nm;
#pragma unroll
                for (int ks = 0; ks < KS; ++ks) {
                    const bf16x8_t a = *(const LAS3 bf16x8_t*)(kb + ((kt * 32 + r) * KROW + m * DK + 16 * ks + 8 * hh) * 2);
                    S[kt] = __builtin_amdgcn_mfma_f32_32x32x16_bf16(a, qf[m][ks], S[kt], 0, 0, 0);
                }
            }
            if (j > 0) ATT_PV(m, vbp);
            float mx = S[0][0];
#pragma unroll
            for (int i = 1; i < 16; ++i) mx = fmaxf(mx, S[0][i]);
#pragma unroll
            for (int i = 0; i < 16; ++i) mx = fmaxf(mx, S[1][i]);
            mx = fmaxf(mx, __shfl_xor(mx, 32));
            if (j == 0 || !__all(mx <= 8.f)) {
                const float dl = (j == 0) ? mx : fmaxf(mx, 0.f);
                mrun[m] += dl;
#pragma unroll
                for (int kt = 0; kt < 2; ++kt)
#pragma unroll
                    for (int i = 0; i < 16; ++i) S[kt][i] -= dl;
                if (j != 0) {
                    const float alpha = __builtin_amdgcn_exp2f(-dl);
                    lrun[m] *= alpha;
#pragma unroll
                    for (int d2 = 0; d2 < 2; ++d2)
#pragma unroll
                        for (int i = 0; i < 16; ++i) O[m][d2][i] *= alpha;
                }
            }
            f32x2_t ps2 = (f32x2_t){0.f, 0.f};
#pragma unroll
            for (int kt = 0; kt < 2; ++kt) {
#pragma unroll
                for (int i = 0; i < 16; i += 2) { const float p0 = __builtin_amdgcn_exp2f(S[kt][i]), p1 = __builtin_amdgcn_exp2f(S[kt][i + 1]); S[kt][i] = p0; S[kt][i + 1] = p1; ps2 += (f32x2_t){p0, p1}; }
#pragma unroll
                for (int s2 = 0; s2 < 2; ++s2) {
                    union { unsigned u[4]; bf16x8_t v; } cv;
#pragma unroll
                    for (int jj = 0; jj < 4; ++jj) cv.u[jj] = cvtpk(S[kt][8 * s2 + 2 * jj], S[kt][8 * s2 + 2 * jj + 1]);
                    pf[m][kt][s2] = cv.v;
                }
            }
            lrun[m] += ps2[0] + ps2[1];
        }
        const int sn = (sl == 2) ? 0 : sl + 1;
        if (j + 1 < ntiles) { ATT_STORE(sn); if (j + 2 < ntiles) ATT_LOAD(j + 2); }
        __syncthreads();
        sl = sn;
    }
    {
        const LAS3 unsigned char* vbl = lds + ((sl == 0) ? 2 : sl - 1) * BUFB + KBYTES;
#pragma unroll
        for (int m = 0; m < NMAP; ++m) ATT_PV(m, vbl);
    }
#undef ATT_PV
#undef ATT_LOAD
#undef ATT_STORE
    float inv[NMAP];
#pragma unroll
    for (int m = 0; m < NMAP; ++m) { const float lt = lrun[m] + __shfl_xor(lrun[m], 32); inv[m] = __builtin_amdgcn_rcpf(lt); }
    if (NMAP == 2) inv[NMAP - 1] *= -lam;
    float ss = 0.f;
#pragma unroll
    for (int d2 = 0; d2 < 2; ++d2)
#pragma unroll
        for (int i = 0; i < 16; ++i) {
            float o = O[0][d2][i] * inv[0];
            if (NMAP == 2) o += O[NMAP - 1][d2][i] * inv[NMAP - 1];
            O[0][d2][i] = o; ss += o * o;
        }
    float rs = 1.f;
    if (DA) { ss += __shfl_xor(ss, 32); rs = rsqrtf(ss * (1.f / 64.f) + 1e-6f) * post_scale; }
    bf16_t* yp = ycatb + ((size_t)b * NT + q0 + 32 * wid + r) * DM + ycat_off + h * 64;
#pragma unroll
    for (int d2 = 0; d2 < 2; ++d2)
#pragma unroll
        for (int g4 = 0; g4 < 4; ++g4) {
            const int dv = 32 * d2 + 8 * g4 + 4 * hh;
            float o0 = O[0][d2][4 * g4] * rs, o1 = O[0][d2][4 * g4 + 1] * rs, o2 = O[0][d2][4 * g4 + 2] * rs, o3 = O[0][d2][4 * g4 + 3] * rs;
            if (DA) { const float4 w = *(const float4*)(subln + dv); o0 *= w.x; o1 *= w.y; o2 *= w.z; o3 *= w.w; }
            *(uint2*)(yp + dv) = make_uint2(cvtpk(o0, o1), cvtpk(o2, o3));
        }
}


typedef float f32x4_t __attribute__((ext_vector_type(4)));
constexpr int ML_KROW = 72, ML_TROW = 136, ML_CROW = 72;
constexpr int ML_OFF_KC = 0, ML_OFF_KT = ML_OFF_KC + 128 * ML_KROW * 2, ML_OFF_VT = ML_OFF_KT + 64 * ML_TROW * 2, ML_OFF_CB = ML_OFF_VT + 80 * ML_TROW * 2,
              ML_OFF_F = ML_OFF_CB + 80 * ML_CROW * 2, ML_LDS_BYTES = ML_OFF_F + 6 * 128 * 4 + 64;
__device__ __forceinline__ void mlstm_item(LAS3 unsigned char* lds, const bf16_t* __restrict__ Qb, const bf16_t* __restrict__ Kb, const bf16_t* __restrict__ Ktg, const bf16_t* __restrict__ Vtg,
                                           const float* __restrict__ G, float* __restrict__ hdir, int b, int h, int dir) {
    const int tid = opaque_tid(), wid = tid >> 6, lane = tid & 63, lr = lane & 15, q = lane >> 4;
    LAS3 unsigned char* Kc = lds + ML_OFF_KC; LAS3 unsigned char* Kt = lds + ML_OFF_KT; LAS3 unsigned char* Vt = lds + ML_OFF_VT; LAS3 unsigned char* Cb = lds + ML_OFF_CB;
    LAS3 float* fl = (LAS3 float*)(lds + ML_OFF_F);
    LAS3 float* s_li = fl; LAS3 float* s_lf = fl + 128; LAS3 float* s_bc2 = fl + 256; LAS3 float* s_gk2 = fl + 384; LAS3 float* s_wu = fl + 512; LAS3 float* s_et = fl + 640; LAS3 float* s_misc = fl + 768;
    const size_t base = ((size_t)b * 4 + h) * NT;
    __syncthreads();
    for (int i = tid; i < 80 * ML_CROW / 2; i += 512) ((LAS3 unsigned*)Cb)[i] = 0u;
    for (int i = tid; i < 16 * ML_TROW / 2; i += 512) ((LAS3 unsigned*)(Vt + 64 * ML_TROW * 2))[i] = (i < ML_TROW / 2) ? 0x3F803F80u : 0u;
    const int ct = wid & 3, rt0 = (wid < 4) ? 0 : 3, nrt = (wid < 4) ? 3 : 2;
    f32x4_t Cacc[3];
#pragma unroll
    for (int i = 0; i < 3; ++i) Cacc[i] = (f32x4_t){0.f, 0.f, 0.f, 0.f};
    const int tq = 16 * wid + lr;
    const int ia = (dir == 0) ? 2 * lane : 127 - 2 * lane, ib = (dir == 0) ? 2 * lane + 1 : 126 - 2 * lane;
    u32x4_t nkc[2], nkt[2], nvt[2]; bf16x8_t nqf[2]; float ngxa = 0.f, ngxb = 0.f, ngla = 0.f, nglb = 0.f;
#define ML_N0(c_) ((dir == 0) ? 128 * (c_) : (((c_) < 2) ? 128 * (1 - (c_)) : NC + 128 * (17 - (c_))))
#define ML_LOAD(c_) do { const int n0_ = ML_N0(c_); \
        _Pragma("unroll") for (int i = 0; i < 2; ++i) { const int id = tid + 512 * i; \
            nkc[i] = *(const u32x4_t*)(Kb + (base + n0_ + (id >> 3)) * 64 + (id & 7) * 8); \
            nkt[i] = *(const u32x4_t*)(Ktg + ((size_t)(b * 4 + h) * 64 + (id >> 4)) * NT + n0_ + (id & 15) * 8); \
            nvt[i] = *(const u32x4_t*)(Vtg + ((size_t)(b * 4 + h) * 64 + (id >> 4)) * NT + n0_ + (id & 15) * 8); } \
        _Pragma("unroll") for (int ks = 0; ks < 2; ++ks) nqf[ks] = *(const bf16x8_t*)(Qb + (base + n0_ + tq) * 64 + 32 * ks + 8 * q); \
        if (wid == 0) { const float* gpa = G + ((size_t)b * NT + n0_ + ia) * 16 + (dir * 2) * 4 + h; const float* gpb = G + ((size_t)b * NT + n0_ + ib) * 16 + (dir * 2) * 4 + h; \
            ngxa = gpa[4]; ngxb = gpb[4]; ngla = gpa[0]; nglb = gpb[0]; } } while (0)
    ML_LOAD(0);
    for (int c = 0; c < NT / 128; ++c) {
        const int n0 = ML_N0(c);
        u32x4_t rkc[2], rkt[2], rvt[2];
        bf16x8_t qf[2];
#pragma unroll
        for (int i = 0; i < 2; ++i) { rkc[i] = nkc[i]; rkt[i] = nkt[i]; rvt[i] = nvt[i]; qf[i] = nqf[i]; }
        const float xa = ngxa, xb = ngxb, lia = ngla, lib = nglb;
        if (c + 1 < NT / 128) ML_LOAD(c + 1);
#pragma unroll
        for (int i = 0; i < 2; ++i) {
            const int id = tid + 512 * i;
            *(LAS3 u32x4_t*)(Kc + ((id >> 3) * ML_KROW + (id & 7) * 8) * 2) = rkc[i];
            *(LAS3 u32x4_t*)(Vt + ((id >> 4) * ML_TROW + (id & 15) * 8) * 2) = rvt[i];
        }
        __syncthreads();
        if (wid == 0) {
            float inc = xa + xb;
#pragma unroll
            for (int o = 1; o < 64; o <<= 1) { const float v = __shfl_up(inc, o); if (lane >= o) inc += v; }
            const float tot = __shfl(inc, 63);
            const float bca = inc - xb, bcb = inc;
            s_bc2[ia] = bca * 1.4426950408889634f; s_bc2[ib] = bcb * 1.4426950408889634f;
            s_gk2[ia] = (bca - lia) * 1.4426950408889634f; s_gk2[ib] = (bcb - lib) * 1.4426950408889634f;
            s_wu[ia] = __expf(tot - bca + lia); s_wu[ib] = __expf(tot - bcb + lib);
            s_et[ia] = __expf(bca); s_et[ib] = __expf(bcb);
            if (lane == 0) s_misc[0] = __expf(tot);
        }
        __syncthreads();
#pragma unroll
        for (int i = 0; i < 2; ++i) {
            const int id = tid + 512 * i; const int tk0 = (id & 15) * 8;
            unsigned w4[4] = {rkt[i].x, rkt[i].y, rkt[i].z, rkt[i].w}; u32x4_t o;
#pragma unroll
            for (int jj = 0; jj < 4; ++jj) {
                const float lo = __uint_as_float(w4[jj] << 16) * s_wu[tk0 + 2 * jj], hi = __uint_as_float(w4[jj] & 0xFFFF0000u) * s_wu[tk0 + 2 * jj + 1];
                o[jj] = cvtpk(lo, hi);
            }
            *(LAS3 u32x4_t*)(Kt + ((id >> 4) * ML_TROW + tk0) * 2) = o;
        }
        f32x4_t S[8];
#pragma unroll
        for (int kt = 0; kt < 8; ++kt) {
            S[kt] = (f32x4_t){0.f, 0.f, 0.f, 0.f};
#pragma unroll
            for (int ks = 0; ks < 2; ++ks) {
                const bf16x8_t a = *(const LAS3 bf16x8_t*)(Kc + ((16 * kt + lr) * ML_KROW + 32 * ks + 8 * q) * 2);
                S[kt] = __builtin_amdgcn_mfma_f32_16x16x32_bf16(a, qf[ks], S[kt], 0, 0, 0);
            }
        }
        const float bct = s_bc2[tq];
#pragma unroll
        for (int kt = 0; kt < 8; ++kt) {
            const f32x4_t gk = *(const LAS3 f32x4_t*)(s_gk2 + 16 * kt + 4 * q);
#pragma unroll
            for (int rg = 0; rg < 4; ++rg) {
                const int si = 16 * kt + 4 * q + rg;
                const bool valid = (dir == 0) ? (si <= tq) : (si >= tq);
                const float w = valid ? __builtin_amdgcn_exp2f(bct - gk[rg]) : 0.f;
                S[kt][rg] *= w;
            }
        }
        bf16x8_t pf[4];
#pragma unroll
        for (int k2 = 0; k2 < 4; ++k2) {
            union { unsigned u[4]; bf16x8_t v; } cv;
            cv.u[0] = cvtpk(S[2 * k2][0], S[2 * k2][1]); cv.u[1] = cvtpk(S[2 * k2][2], S[2 * k2][3]);
            cv.u[2] = cvtpk(S[2 * k2 + 1][0], S[2 * k2 + 1][1]); cv.u[3] = cvtpk(S[2 * k2 + 1][2], S[2 * k2 + 1][3]);
            pf[k2] = cv.v;
        }
        f32x4_t outv[5];
#pragma unroll
        for (int rt = 0; rt < 5; ++rt) {
            f32x4_t acc = (f32x4_t){0.f, 0.f, 0.f, 0.f}, acc2 = (f32x4_t){0.f, 0.f, 0.f, 0.f};
#pragma unroll
            for (int k2 = 0; k2 < 4; ++k2) {
                const LAS3 unsigned char* vp = Vt + ((16 * rt + lr) * ML_TROW + 32 * k2 + 4 * q) * 2;
                union { u32x2_t u[2]; bf16x8_t v; } av;
                av.u[0] = *(const LAS3 u32x2_t*)vp; av.u[1] = *(const LAS3 u32x2_t*)(vp + 32);
                acc = __builtin_amdgcn_mfma_f32_16x16x32_bf16(av.v, pf[k2], acc, 0, 0, 0);
            }
#pragma unroll
            for (int ks = 0; ks < 2; ++ks) {
                const bf16x8_t a = *(const LAS3 bf16x8_t*)(Cb + ((16 * rt + lr) * ML_CROW + 32 * ks + 8 * q) * 2);
                acc2 = __builtin_amdgcn_mfma_f32_16x16x32_bf16(a, qf[ks], acc2, 0, 0, 0);
            }
            outv[rt] = acc + acc2 * s_et[tq];
        }
        {
            const float den = __shfl(outv[4][0], lr);
            const float inv = __builtin_amdgcn_rcpf(fmaxf(fabsf(den), 1.f));
            bf16_t* hp = (bf16_t*)hdir + ((size_t)dir * TT + (size_t)b * NT + n0 + tq) * 256 + h * 64 + 4 * q;
            for (int rt = 0; rt < 4; ++rt) { const f32x4_t ov = outv[rt] * inv; *(uint2*)(hp + 16 * rt) = make_uint2(cvtpk(ov[0], ov[1]), cvtpk(ov[2], ov[3])); }
        }
        __syncthreads();
        {
            const float decay = s_misc[0];
#pragma unroll
            for (int i = 0; i < 3; ++i) Cacc[i] *= decay;
#pragma unroll
            for (int ks = 0; ks < 4; ++ks) {
                const bf16x8_t bb = *(const LAS3 bf16x8_t*)(Kt + ((16 * ct + lr) * ML_TROW + 32 * ks + 8 * q) * 2);
#pragma unroll
                for (int i = 0; i < 3; ++i) if (i < nrt) {
                    const bf16x8_t a = *(const LAS3 bf16x8_t*)(Vt + ((16 * (rt0 + i) + lr) * ML_TROW + 32 * ks + 8 * q) * 2);
                    Cacc[i] = __builtin_amdgcn_mfma_f32_16x16x32_bf16(a, bb, Cacc[i], 0, 0, 0);
                }
            }
#pragma unroll
            for (int i = 0; i < 3; ++i) if (i < nrt) {
#pragma unroll
                for (int rg = 0; rg < 4; ++rg) *(LAS3 bf16_t*)(Cb + ((16 * (rt0 + i) + 4 * q + rg) * ML_CROW + 16 * ct + lr) * 2) = f2bf(Cacc[i][rg]);
            }
        }
        __syncthreads();
    }
#undef ML_LOAD
#undef ML_N0
}

constexpr int S5_UROWS = NT + 64;
constexpr int S5_KROW = 1032, S5_CROW = 136, S5_ZROW = 136;
constexpr int S5_OFF_U = 0, S5_OFF_KM = S5_OFF_U + S5_UROWS * 16 * 2, S5_OFF_CM = S5_OFF_KM + 16 * S5_KROW * 2, S5_OFF_EZ = S5_OFF_CM + 16 * S5_CROW * 2,
              S5_LDS_BYTES = S5_OFF_EZ + 8 * 16 * S5_ZROW * 2;
__device__ __forceinline__ void s5_setup_item(LAS3 unsigned char* lds, int idx, const float* __restrict__ a_re, const float* __restrict__ a_im, const float* __restrict__ log_step,
                                                  const float* __restrict__ b_re, const float* __restrict__ b_im, const float* __restrict__ c_re, const float* __restrict__ c_im,
                                                  bf16_t* __restrict__ KmT, bf16_t* __restrict__ Smat, bf16_t* __restrict__ CmT, float* __restrict__ Aab, float* __restrict__ A64) {
    typedef float apw_t[64][2]; typedef float bb_t[16][2]; typedef float cc_t[64][2];
    LAS3 apw_t* apw = (LAS3 apw_t*)lds;
    LAS3 bb_t* bb = (LAS3 bb_t*)(lds + 32768);
    LAS3 cc_t* cc = (LAS3 cc_t*)(lds + 32768 + 8192);
    const int tid = opaque_tid();
    __syncthreads();
    const float dt = expf(log_step[idx]);
    if (tid < 64) {
        const int p = tid;
        const float ar = fminf(a_re[idx * 64 + p], -1e-4f), ai = a_im[idx * 64 + p];
        const float mag = expf(dt * ar), er = mag * cosf(dt * ai), ei = mag * sinf(dt * ai);
        const float inv = 1.0f / (ar * ar + ai * ai);
        const float fr = ((er - 1.0f) * ar + ei * ai) * inv, fi = (ei * ar - (er - 1.0f) * ai) * inv;
        Aab[(idx * 64 + p) * 2] = er; Aab[(idx * 64 + p) * 2 + 1] = ei;
        const float m64 = expf(64.0f * dt * ar);
        A64[(idx * 64 + p) * 2] = m64 * cosf(64.0f * dt * ai); A64[(idx * 64 + p) * 2 + 1] = m64 * sinf(64.0f * dt * ai);
        for (int hh = 0; hh < 16; ++hh) {
            const float br = b_re[((size_t)idx * 64 + p) * 16 + hh], bi = b_im[((size_t)idx * 64 + p) * 16 + hh];
            bb[p][hh][0] = fr * br - fi * bi; bb[p][hh][1] = fr * bi + fi * br;
        }
    }
    for (int i = tid; i < 64 * 64; i += 512) {
        const int tau = i >> 6, p = i & 63;
        const float ar = fminf(a_re[idx * 64 + p], -1e-4f), ai = a_im[idx * 64 + p];
        const float mag = expf((float)tau * dt * ar);
        apw[tau][p][0] = mag * cosf((float)tau * dt * ai); apw[tau][p][1] = mag * sinf((float)tau * dt * ai);
    }
    for (int i = tid; i < 16 * 64; i += 512) { const int hh = i >> 6, p = i & 63; cc[hh][p][0] = c_re[(size_t)idx * 1024 + i]; cc[hh][p][1] = c_im[(size_t)idx * 1024 + i]; }
    __syncthreads();
    for (int i = tid; i < 16 * 64; i += 512) { const int hh = i >> 6, p = i & 63;
        CmT[((size_t)idx * 16 + hh) * 128 + 2 * p] = f2bf(cc[hh][p][0]); CmT[((size_t)idx * 16 + hh) * 128 + 2 * p + 1] = f2bf(-cc[hh][p][1]); }
    for (int e = tid; e < 64 * 1024; e += 512) {
        const int p = e >> 10, k = e & 1023, i = k >> 4, hp = k & 15;
        const float pr = apw[63 - i][p][0], pi = apw[63 - i][p][1], br = bb[p][hp][0], bi = bb[p][hp][1];
        Smat[((size_t)idx * 128 + 2 * p) * 1024 + k] = f2bf(pr * br - pi * bi);
        Smat[((size_t)idx * 128 + 2 * p + 1) * 1024 + k] = f2bf(pr * bi + pi * br);
    }
    for (int e = tid; e < 16 * 1024; e += 512) {
        const int hh = e >> 10, k = e & 1023, tau = k >> 4, hp = k & 15;
        float acc = 0.f;
        for (int p = 0; p < 64; ++p) {
            const float pr = apw[tau][p][0], pi = apw[tau][p][1], br = bb[p][hp][0], bi = bb[p][hp][1];
            const float wr = pr * br - pi * bi, wi = pr * bi + pi * br;
            acc += cc[hh][p][0] * wr - cc[hh][p][1] * wi;
        }
        KmT[((size_t)idx * 16 + hh) * 1024 + k] = f2bf(acc);
    }
}


__device__ __forceinline__ void s5_item(LAS3 unsigned char* lds, const bf16_t* __restrict__ p, const bf16_t* __restrict__ KmT, const bf16_t* __restrict__ Smat, const bf16_t* __restrict__ CmT,
                                        const float* __restrict__ Aab, const float* __restrict__ A64, float* __restrict__ xs_g, float* __restrict__ ys5, int b, int g, int dir) {
    const int tid = opaque_tid(), wid = tid >> 6, lane = tid & 63, lr = lane & 15, q = lane >> 4;
    const int tix = dir * 16 + g;
    LAS3 unsigned char* U = lds + S5_OFF_U; LAS3 unsigned char* Km = lds + S5_OFF_KM; LAS3 unsigned char* Cm = lds + S5_OFF_CM; LAS3 unsigned char* EZ = lds + S5_OFF_EZ;
    float* xs = xs_g + (size_t)((b * 16 + g) * 2 + dir) * 36 * 128;
    __syncthreads();
    for (int i = tid; i < 16 * 128; i += 512) { const int hh = i >> 7, ch = i & 127;
        *(LAS3 u32x4_t*)(Km + (hh * S5_KROW + ch * 8) * 2) = *(const u32x4_t*)(KmT + ((size_t)tix * 16 + hh) * 1024 + ch * 8); }
    if (tid < 256) { const int hh = tid >> 4, ch = tid & 15;
        *(LAS3 u32x4_t*)(Cm + (hh * S5_CROW + ch * 8) * 2) = *(const u32x4_t*)(CmT + ((size_t)tix * 16 + hh) * 128 + ch * 8); }
    for (int i = tid; i < NT * 2; i += 512) {
        const int sidx = i >> 1, hf = i & 1;
        const int n = seq_token(sidx, dir);
        *(LAS3 u32x4_t*)(U + ((64 + sidx) * 16 + hf * 8) * 2) = *(const u32x4_t*)(p + ((size_t)b * NT + n) * DIN + P_S5 + g * 16 + hf * 8);
    }
    for (int i = tid; i < 64 * 8; i += 512) *(LAS3 unsigned*)(U + i * 4) = 0u;
    __syncthreads();
    {
        f32x4_t acc[3];
#pragma unroll
        for (int i = 0; i < 3; ++i) acc[i] = (f32x4_t){0.f, 0.f, 0.f, 0.f};
        const bf16_t* sp = Smat + ((size_t)tix * 128 + 16 * wid + lr) * 1024 + 8 * q;
        int cco[3];
#pragma unroll
        for (int ctile = 0; ctile < 3; ++ctile) { int ch = 16 * ctile + lr; if (ch > 35) ch = 35; cco[ctile] = ((64 + 64 * ch + (q >> 1)) * 16 + 8 * (q & 1)) * 2; }
#pragma unroll 8
        for (int ks = 0; ks < 32; ++ks) {
            const bf16x8_t a = *(const bf16x8_t*)(sp + 32 * ks);
#pragma unroll
            for (int ctile = 0; ctile < 3; ++ctile) {
                const bf16x8_t bfr = *(const LAS3 bf16x8_t*)(U + cco[ctile] + ks * 64);
                acc[ctile] = __builtin_amdgcn_mfma_f32_16x16x32_bf16(a, bfr, acc[ctile], 0, 0, 0);
            }
        }
        LAS3 float* E = (LAS3 float*)EZ;
#pragma unroll
        for (int ctile = 0; ctile < 3; ++ctile)
#pragma unroll
            for (int rg = 0; rg < 4; ++rg) E[(16 * ctile + lr) * 128 + 16 * wid + 4 * q + rg] = acc[ctile][rg];
    }
    __syncthreads();
    const float Ar = Aab[(tix * 64 + lane) * 2], Ai = Aab[(tix * 64 + lane) * 2 + 1];
    if (wid == 0) {
        const float Br = A64[(tix * 64 + lane) * 2], Bi = A64[(tix * 64 + lane) * 2 + 1];
        const LAS3 float* E = (const LAS3 float*)EZ;
        float xr = 0.f, xi = 0.f;
        for (int c = 0; c < 36; ++c) {
            *(float2*)(xs + c * 128 + 2 * lane) = make_float2(xr, xi);
            const float er = E[c * 128 + 2 * lane], ei = E[c * 128 + 2 * lane + 1];
            const float nr = Br * xr - Bi * xi + er, ni = Br * xi + Bi * xr + ei;
            xr = nr; xi = ni;
        }
    }
    __threadfence_block();
    __syncthreads();
    LAS3 unsigned char* Zw = EZ + wid * (16 * S5_ZROW * 2);
    bf16x8_t cmf[4];
#pragma unroll
    for (int ks = 0; ks < 4; ++ks) cmf[ks] = *(const LAS3 bf16x8_t*)(Cm + (lr * S5_CROW + 32 * ks + 8 * q) * 2);
    bf16x8_t kbr[16];
#pragma unroll
    for (int ks = 0; ks < 16; ++ks) kbr[ks] = *(const LAS3 bf16x8_t*)(Km + (lr * S5_KROW + 8 * q) * 2 + ks * 64);
    float2 xnext = *(const float2*)(xs + wid * 128 + 2 * lane);
    for (int c = wid; c < 36; c += 8) {
        const float2 x0 = xnext;
        if (c + 8 < 36) xnext = *(const float2*)(xs + (c + 8) * 128 + 2 * lane);
        float zr = Ar * x0.x - Ai * x0.y, zi = Ar * x0.y + Ai * x0.x;
#pragma unroll
        for (int rt = 0; rt < 4; ++rt) {
#pragma unroll
            for (int ii = 0; ii < 16; ++ii) {
                *(LAS3 unsigned*)(Zw + (ii * S5_ZROW + 2 * lane) * 2) = cvtpk(zr, zi);
                const float nr = Ar * zr - Ai * zi, ni = Ar * zi + Ai * zr; zr = nr; zi = ni;
            }
            asm volatile("s_waitcnt lgkmcnt(0)" ::: "memory");
            f32x4_t acc = (f32x4_t){0.f, 0.f, 0.f, 0.f};
#pragma unroll
            for (int ks = 0; ks < 4; ++ks) {
                const bf16x8_t a = *(const LAS3 bf16x8_t*)(Zw + (lr * S5_ZROW + 32 * ks + 8 * q) * 2);
                acc = __builtin_amdgcn_mfma_f32_16x16x32_bf16(a, cmf[ks], acc, 0, 0, 0);
            }
            const int irow = 16 * rt + lr;
            const LAS3 unsigned char* up = U + ((64 + 64 * c + irow - (q >> 1)) * 16 + 8 * (q & 1)) * 2;
            const LAS3 unsigned char* kp = Km + (lr * S5_KROW + 8 * q) * 2;
            f32x4_t acc1 = (f32x4_t){0.f, 0.f, 0.f, 0.f};
#pragma unroll
            for (int ks0 = 0; ks0 < 8 * rt + 8; ks0 += 8) {
                bf16x8_t av[8], kv[8];
#pragma unroll
                for (int j = 0; j < 8; ++j) { av[j] = *(const LAS3 bf16x8_t*)(up - (ks0 + j) * 64); if (ks0 + j < 16) kv[j] = kbr[ks0 + j]; else kv[j] = *(const LAS3 bf16x8_t*)(kp + (ks0 + j) * 64); }
#pragma unroll
                for (int j = 0; j < 8; ++j) {
                    const int ks = ks0 + j;
                    if (ks >= 8 * rt) {
                        const bool valid = (2 * ks + (q >> 1)) <= irow;
                        if (!valid) av[j] = (bf16x8_t){0, 0, 0, 0, 0, 0, 0, 0};
                    }
                    if (j & 1) acc1 = __builtin_amdgcn_mfma_f32_16x16x32_bf16(av[j], kv[j], acc1, 0, 0, 0);
                    else acc = __builtin_amdgcn_mfma_f32_16x16x32_bf16(av[j], kv[j], acc, 0, 0, 0);
                }
            }
            acc += acc1;
#pragma unroll
            for (int rg = 0; rg < 4; ++rg) {
                const int n = seq_token(64 * c + 16 * rt + 4 * q + rg, dir);
                ((bf16_t*)ys5)[((size_t)dir * TT + (size_t)b * NT + n) * 256 + g * 16 + lr] = f2bf(acc[rg]);
            }
            asm volatile("s_waitcnt lgkmcnt(0)" ::: "memory");
        }
    }
}

#define XB_TMO      128
#define XB_XCNT(j)  (256  + 64 * (j))
#define XB_XSUB(j)  (1280 + 64 * (j))
#define XB_XGEN(j)  (2304 + 64 * (j))
#define XB_TOP      3328
#define XB_TOPGEN   3392
#define XCD_BAR_WORDS 3456
#define XB_SPIN_CAP (1u << 22)
__device__ __forceinline__ unsigned xb_ld(unsigned* p)              { return __hip_atomic_load(p, __ATOMIC_RELAXED, __HIP_MEMORY_SCOPE_AGENT); }
__device__ __forceinline__ unsigned xb_add(unsigned* p, unsigned v) { return __hip_atomic_fetch_add(p, v, __ATOMIC_RELAXED, __HIP_MEMORY_SCOPE_AGENT); }
__device__ __forceinline__ unsigned xb_xcc_id() { return (unsigned)__builtin_amdgcn_s_getreg((3 << 11) | 20) & 0xFu; }
#define XB_SPIN(cond, bar) do { unsigned _sp = 0; while (cond) { __builtin_amdgcn_s_sleep(1); \
    if ((++_sp & 255u) == 0u) { if (xb_ld(&(bar)[XB_TMO])) break; if (_sp > XB_SPIN_CAP) { atomicAdd(&(bar)[XB_TMO], 1u); break; } } } } while (0)
struct XcdBarrier { unsigned* bar; unsigned x; volatile LAS3 unsigned* st; };
__device__ __forceinline__ XcdBarrier xcd_barrier_post(unsigned* bar, volatile LAS3 unsigned* st) {
    XcdBarrier b; b.bar = bar; b.x = xb_xcc_id(); b.st = st;
    if (threadIdx.x == 0) (void)xb_add(&bar[XB_XCNT(b.x)], 1u);
    return b;
}
__device__ __forceinline__ void xcd_barrier_complete(unsigned* bar, unsigned x, unsigned& nloc, unsigned& nx) {
    const unsigned G = gridDim.x * gridDim.y * gridDim.z;
    unsigned sum, cnt, mine, sp = 0u;
    for (;;) {
        sum = 0u; cnt = 0u; mine = 0u;
#pragma unroll
        for (unsigned j = 0; j < 16; ++j) { const unsigned c = xb_ld(&bar[XB_XCNT(j)]); sum += c; cnt += (c > 0u) ? 1u : 0u; mine = (j == x) ? c : mine; }
        if (sum == G) break;
        __builtin_amdgcn_s_sleep(1);
        if ((++sp & 255u) == 0u) { if (xb_ld(&bar[XB_TMO])) break; if (sp > XB_SPIN_CAP) { atomicAdd(&bar[XB_TMO], 1u); break; } }
    }
    nloc = mine > 0u ? mine : 1u; nx = cnt > 0u ? cnt : 1u;
}
__device__ __forceinline__ void xcd_barrier(const XcdBarrier& b) {
    asm volatile("s_waitcnt vmcnt(0)" ::: "memory");
    __syncthreads();
    if (threadIdx.x == 0) {
        unsigned* bar = b.bar;
        __builtin_amdgcn_s_waitcnt(0);
        unsigned nloc = b.st[0], nx = b.st[1];
        if (nloc == 0u) { xcd_barrier_complete(bar, b.x, nloc, nx); b.st[0] = nloc; b.st[1] = nx; }
        const unsigned old = xb_add(&bar[XB_XSUB(b.x)], 1u);
        const unsigned gen = old / nloc;
        if (old + 1u == (gen + 1u) * nloc) {
            __builtin_amdgcn_fence(__ATOMIC_RELEASE, "agent");
            asm volatile("s_waitcnt vmcnt(0)" ::: "memory");
            const unsigned og = xb_add(&bar[XB_TOP], 1u);
            const unsigned tg = og / nx;
            if (og + 1u == (tg + 1u) * nx) xb_add(&bar[XB_TOPGEN], 1u);
            else XB_SPIN(xb_ld(&bar[XB_TOPGEN]) == tg, bar);
            __builtin_amdgcn_fence(__ATOMIC_ACQUIRE, "agent");
            xb_add(&bar[XB_XGEN(b.x)], 1u);
            asm volatile("s_waitcnt vmcnt(0)" ::: "memory");
        } else {
            XB_SPIN(xb_ld(&bar[XB_XGEN(b.x)]) == gen, bar);
            __builtin_amdgcn_fence(__ATOMIC_ACQUIRE, "agent");
            asm volatile("s_waitcnt vmcnt(0)" ::: "memory");
        }
    }
    __syncthreads();
}

struct Params {
    const float *x, *c, *ctx, *c_ctx, *w_mod, *b_mod, *norm_w, *w_in, *w_out, *da_lambda, *da_subln, *ml_conv_w, *ml_conv_b, *ml_gate_b, *ml_norm,
                *mla_q_norm, *mla_w_uq, *mla_kv_norm, *mla_w_ukv, *s5_a_re, *s5_a_im, *s5_log_step, *s5_b_re, *s5_b_im, *s5_c_re, *s5_c_im, *s5_d, *s5_w_glu, *s5_b_glu,
                *moe_w_router, *moe_b_router, *moe_w_gate_up, *moe_b_gate_up, *moe_w_down, *moe_b_down;
    float* out;
    float *xall, *mod, *ropecs, *lamfull;
    bf16_t *w_in_t, *w_out_t, *wgu_t, *wdn_t, *wq_t, *wkv_t, *wglu_t;
    bf16_t *s5KmT, *s5Smat, *s5CmT; float *s5A, *s5A64, *s5xs;
    bf16_t *hbuf, *pb, *daQ, *daK, *daVt, *mQ, *mK, *mVt, *mlQ, *mlK, *mlKt, *mlVt; float *mlG, *hdir, *ys5;
    bf16_t *ycatb, *ob; float* osq; bf16_t* fb;
    int* top_e; float* top_g; int *posb, *tok_slot;
    int *cnt, *tile_e, *ntiles, *offs, *blkcnt;
    bf16_t *xg, *act, *yexp;
    unsigned* bar; int* queue;
};

template <class T> __device__ __forceinline__ T* uni_ptr(T* p) { const unsigned long long v = (unsigned long long)p; const unsigned lo = __builtin_amdgcn_readfirstlane((unsigned)v), hi = __builtin_amdgcn_readfirstlane((unsigned)(v >> 32)); return (T*)(__attribute__((address_space(1))) T*)(((unsigned long long)hi << 32) | lo); }
__device__ __forceinline__ void store_params(LAS3 Params* PL, const Params& P) {
    PL->x = P.x;
    PL->c = P.c;
    PL->ctx = P.ctx;
    PL->c_ctx = P.c_ctx;
    PL->w_mod = P.w_mod;
    PL->b_mod = P.b_mod;
    PL->norm_w = P.norm_w;
    PL->w_in = P.w_in;
    PL->w_out = P.w_out;
    PL->da_lambda = P.da_lambda;
    PL->da_subln = P.da_subln;
    PL->ml_conv_w = P.ml_conv_w;
    PL->ml_conv_b = P.ml_conv_b;
    PL->ml_gate_b = P.ml_gate_b;
    PL->ml_norm = P.ml_norm;
    PL->mla_q_norm = P.mla_q_norm;
    PL->mla_w_uq = P.mla_w_uq;
    PL->mla_kv_norm = P.mla_kv_norm;
    PL->mla_w_ukv = P.mla_w_ukv;
    PL->s5_a_re = P.s5_a_re;
    PL->s5_a_im = P.s5_a_im;
    PL->s5_log_step = P.s5_log_step;
    PL->s5_b_re = P.s5_b_re;
    PL->s5_b_im = P.s5_b_im;
    PL->s5_c_re = P.s5_c_re;
    PL->s5_c_im = P.s5_c_im;
    PL->s5_d = P.s5_d;
    PL->s5_w_glu = P.s5_w_glu;
    PL->s5_b_glu = P.s5_b_glu;
    PL->moe_w_router = P.moe_w_router;
    PL->moe_b_router = P.moe_b_router;
    PL->moe_w_gate_up = P.moe_w_gate_up;
    PL->moe_b_gate_up = P.moe_b_gate_up;
    PL->moe_w_down = P.moe_w_down;
    PL->moe_b_down = P.moe_b_down;
    PL->out = P.out;
    PL->xall = P.xall;
    PL->mod = P.mod;
    PL->ropecs = P.ropecs;
    PL->lamfull = P.lamfull;
    PL->w_in_t = P.w_in_t;
    PL->w_out_t = P.w_out_t;
    PL->wgu_t = P.wgu_t;
    PL->wdn_t = P.wdn_t;
    PL->wq_t = P.wq_t;
    PL->wkv_t = P.wkv_t;
    PL->wglu_t = P.wglu_t;
    PL->s5KmT = P.s5KmT;
    PL->s5Smat = P.s5Smat;
    PL->s5CmT = P.s5CmT;
    PL->s5A = P.s5A;
    PL->s5A64 = P.s5A64;
    PL->s5xs = P.s5xs;
    PL->hbuf = P.hbuf;
    PL->pb = P.pb;
    PL->daQ = P.daQ;
    PL->daK = P.daK;
    PL->daVt = P.daVt;
    PL->mQ = P.mQ;
    PL->mK = P.mK;
    PL->mVt = P.mVt;
    PL->mlQ = P.mlQ;
    PL->mlK = P.mlK;
    PL->mlKt = P.mlKt;
    PL->mlVt = P.mlVt;
    PL->mlG = P.mlG;
    PL->hdir = P.hdir;
    PL->ys5 = P.ys5;
    PL->ycatb = P.ycatb;
    PL->ob = P.ob;
    PL->osq = P.osq;
    PL->fb = P.fb;
    PL->top_e = P.top_e;
    PL->top_g = P.top_g;
    PL->posb = P.posb;
    PL->tok_slot = P.tok_slot;
    PL->cnt = P.cnt;
    PL->tile_e = P.tile_e;
    PL->ntiles = P.ntiles;
    PL->offs = P.offs;
    PL->blkcnt = P.blkcnt;
    PL->xg = P.xg;
    PL->act = P.act;
    PL->yexp = P.yexp;
    PL->bar = P.bar;
    PL->queue = P.queue;
}
__device__ __forceinline__ Params load_params(const LAS3 Params* PL) {
    Params Q;
    Q.x = uni_ptr(PL->x);
    Q.c = uni_ptr(PL->c);
    Q.ctx = uni_ptr(PL->ctx);
    Q.c_ctx = uni_ptr(PL->c_ctx);
    Q.w_mod = uni_ptr(PL->w_mod);
    Q.b_mod = uni_ptr(PL->b_mod);
    Q.norm_w = uni_ptr(PL->norm_w);
    Q.w_in = uni_ptr(PL->w_in);
    Q.w_out = uni_ptr(PL->w_out);
    Q.da_lambda = uni_ptr(PL->da_lambda);
    Q.da_subln = uni_ptr(PL->da_subln);
    Q.ml_conv_w = uni_ptr(PL->ml_conv_w);
    Q.ml_conv_b = uni_ptr(PL->ml_conv_b);
    Q.ml_gate_b = uni_ptr(PL->ml_gate_b);
    Q.ml_norm = uni_ptr(PL->ml_norm);
    Q.mla_q_norm = uni_ptr(PL->mla_q_norm);
    Q.mla_w_uq = uni_ptr(PL->mla_w_uq);
    Q.mla_kv_norm = uni_ptr(PL->mla_kv_norm);
    Q.mla_w_ukv = uni_ptr(PL->mla_w_ukv);
    Q.s5_a_re = uni_ptr(PL->s5_a_re);
    Q.s5_a_im = uni_ptr(PL->s5_a_im);
    Q.s5_log_step = uni_ptr(PL->s5_log_step);
    Q.s5_b_re = uni_ptr(PL->s5_b_re);
    Q.s5_b_im = uni_ptr(PL->s5_b_im);
    Q.s5_c_re = uni_ptr(PL->s5_c_re);
    Q.s5_c_im = uni_ptr(PL->s5_c_im);
    Q.s5_d = uni_ptr(PL->s5_d);
    Q.s5_w_glu = uni_ptr(PL->s5_w_glu);
    Q.s5_b_glu = uni_ptr(PL->s5_b_glu);
    Q.moe_w_router = uni_ptr(PL->moe_w_router);
    Q.moe_b_router = uni_ptr(PL->moe_b_router);
    Q.moe_w_gate_up = uni_ptr(PL->moe_w_gate_up);
    Q.moe_b_gate_up = uni_ptr(PL->moe_b_gate_up);
    Q.moe_w_down = uni_ptr(PL->moe_w_down);
    Q.moe_b_down = uni_ptr(PL->moe_b_down);
    Q.out = uni_ptr(PL->out);
    Q.xall = uni_ptr(PL->xall);
    Q.mod = uni_ptr(PL->mod);
    Q.ropecs = uni_ptr(PL->ropecs);
    Q.lamfull = uni_ptr(PL->lamfull);
    Q.w_in_t = uni_ptr(PL->w_in_t);
    Q.w_out_t = uni_ptr(PL->w_out_t);
    Q.wgu_t = uni_ptr(PL->wgu_t);
    Q.wdn_t = uni_ptr(PL->wdn_t);
    Q.wq_t = uni_ptr(PL->wq_t);
    Q.wkv_t = uni_ptr(PL->wkv_t);
    Q.wglu_t = uni_ptr(PL->wglu_t);
    Q.s5KmT = uni_ptr(PL->s5KmT);
    Q.s5Smat = uni_ptr(PL->s5Smat);
    Q.s5CmT = uni_ptr(PL->s5CmT);
    Q.s5A = uni_ptr(PL->s5A);
    Q.s5A64 = uni_ptr(PL->s5A64);
    Q.s5xs = uni_ptr(PL->s5xs);
    Q.hbuf = uni_ptr(PL->hbuf);
    Q.pb = uni_ptr(PL->pb);
    Q.daQ = uni_ptr(PL->daQ);
    Q.daK = uni_ptr(PL->daK);
    Q.daVt = uni_ptr(PL->daVt);
    Q.mQ = uni_ptr(PL->mQ);
    Q.mK = uni_ptr(PL->mK);
    Q.mVt = uni_ptr(PL->mVt);
    Q.mlQ = uni_ptr(PL->mlQ);
    Q.mlK = uni_ptr(PL->mlK);
    Q.mlKt = uni_ptr(PL->mlKt);
    Q.mlVt = uni_ptr(PL->mlVt);
    Q.mlG = uni_ptr(PL->mlG);
    Q.hdir = uni_ptr(PL->hdir);
    Q.ys5 = uni_ptr(PL->ys5);
    Q.ycatb = uni_ptr(PL->ycatb);
    Q.ob = uni_ptr(PL->ob);
    Q.osq = uni_ptr(PL->osq);
    Q.fb = uni_ptr(PL->fb);
    Q.top_e = uni_ptr(PL->top_e);
    Q.top_g = uni_ptr(PL->top_g);
    Q.posb = uni_ptr(PL->posb);
    Q.tok_slot = uni_ptr(PL->tok_slot);
    Q.cnt = uni_ptr(PL->cnt);
    Q.tile_e = uni_ptr(PL->tile_e);
    Q.ntiles = uni_ptr(PL->ntiles);
    Q.offs = uni_ptr(PL->offs);
    Q.blkcnt = uni_ptr(PL->blkcnt);
    Q.xg = uni_ptr(PL->xg);
    Q.act = uni_ptr(PL->act);
    Q.yexp = uni_ptr(PL->yexp);
    Q.bar = uni_ptr(PL->bar);
    Q.queue = uni_ptr(PL->queue);
    return Q;
}
constexpr int MK_LDS_MAIN = 147968;
constexpr int MK_LDS_BYTES = MK_LDS_MAIN + 64 + 1024;
enum { PH_SETUP = 0, PH_H0 = 1, PH_LAYER0 = 2, PH_PER_LAYER = 10, PH_TOTAL = 22 };
enum { L_GEMM_IN = 0, L_PREP, L_MIX, L_FINISH, L_GEMM_OUT, L_POST, L_SCATTER, L_GEMM_GU, L_GEMM_DN, L_COMBINE };

__device__ __forceinline__ void conv_tile(LAS3 float* tile, int lane, const float* __restrict__ W, int N, bf16_t* __restrict__ WT, int ldt, int tn, int tk, int mode) {
    const int n0 = tn * 64, k0 = tk * 64;
    const int kq = lane >> 4, n4 = (lane & 15) * 4;
    const int nl = (n0 + n4 < N) ? n0 + n4 : N - 4;
    const float* wp = W + (size_t)(k0 + kq) * N + nl;
    float4 v[16];
#pragma unroll
    for (int j = 0; j < 16; ++j) v[j] = *(const float4*)(wp + (size_t)(4 * j) * N);
#pragma unroll
    for (int j = 0; j < 16; ++j) { LAS3 float* tp = tile + (4 * j + kq) * 65 + n4; tp[0] = v[j].x; tp[1] = v[j].y; tp[2] = v[j].z; tp[3] = v[j].w; }
    asm volatile("s_waitcnt lgkmcnt(0)" ::: "memory");
    {
        const int c = lane & 7;
#pragma unroll
        for (int jn = 0; jn < 8; ++jn) {
            const int n = (lane >> 3) + 8 * jn, gn = n0 + n;
            if (gn < N) {
                int dr = gn;
                if (mode == 1) dr = (gn < 1024) ? ((gn >> 7) * 256 + (gn & 127)) : ((((gn - 1024) >> 7) * 256) + 128 + ((gn - 1024) & 127));
                const LAS3 float* tp = tile + (8 * c) * 65 + n;
                u32x4_t o;
                o.x = pk2bf(tp[0 * 65], tp[1 * 65]); o.y = pk2bf(tp[2 * 65], tp[3 * 65]); o.z = pk2bf(tp[4 * 65], tp[5 * 65]); o.w = pk2bf(tp[6 * 65], tp[7 * 65]);
                *(u32x4_t*)(WT + (size_t)dr * ldt + k0 + 8 * c) = o;
            }
        }
    }
    asm volatile("s_waitcnt lgkmcnt(0)" ::: "memory");
}
constexpr int CV_IN = 38 * 16 * 2, CV_OUT = 256 * 2, CV_GU = 512 * 64, CV_DN = 256 * 64, CV_Q = 18 * 2, CV_KV = 16 * 2, CV_GLU = 16 * 2;
constexpr int CV_TOTAL = CV_IN + CV_OUT + CV_GU + CV_DN + CV_Q + CV_KV + CV_GLU;
__device__ __forceinline__ void conv_dispatch(const Params& P, LAS3 float* tile, int st, int it) {
    const float* W = nullptr; bf16_t* WT = nullptr; int N = 64, ldt = 64, tn = 0, tk = 0, mode = 0;
    if (it < CV_TOTAL) {
        int r = it;
        if (r < CV_IN) { const int bt = r / 608, q = r % 608; W = P.w_in + (size_t)bt * 1024 * DINC; N = DINC; WT = P.w_in_t + (size_t)bt * 2560 * 1024; ldt = 1024; tn = q % 38; tk = q / 38; }
        else if ((r -= CV_IN) < CV_OUT) { const int bt = r / 256, q = r % 256; W = P.w_out + (size_t)bt * 1024 * 1024; N = 1024; WT = P.w_out_t + (size_t)bt * 1024 * 1024; ldt = 1024; tn = q % 16; tk = q / 16; }
        else if ((r -= CV_OUT) < CV_GU) { const int bt = r / 512, q = r % 512; W = P.moe_w_gate_up + (size_t)bt * 1024 * 2048; N = 2048; WT = P.wgu_t + (size_t)bt * 2048 * 1024; ldt = 1024; tn = q % 32; tk = q / 32; mode = 1; }
        else if ((r -= CV_GU) < CV_DN) { const int bt = r / 256, q = r % 256; W = P.moe_w_down + (size_t)bt * 1024 * 1024; N = 1024; WT = P.wdn_t + (size_t)bt * 1024 * 1024; ldt = 1024; tn = q % 16; tk = q / 16; }
        else if ((r -= CV_DN) < CV_Q) { const int bt = r / 18, q = r % 18; W = P.mla_w_uq + (size_t)bt * 192 * 384; N = 384; WT = P.wq_t + (size_t)bt * 384 * 192; ldt = 192; tn = q % 6; tk = q / 6; }
        else if ((r -= CV_Q) < CV_KV) { const int bt = r / 16, q = r % 16; W = P.mla_w_ukv + (size_t)bt * 128 * 512; N = 512; WT = P.wkv_t + (size_t)bt * 512 * 128; ldt = 128; tn = q % 8; tk = q / 8; }
        else { r -= CV_KV; const int bt = r / 16, q = r % 16; W = P.s5_w_glu + (size_t)bt * 256 * 256; N = 256; WT = P.wglu_t + (size_t)bt * 256 * 256; ldt = 256; tn = q % 4; tk = q / 4; }
    }
    if (W) conv_tile(tile, st, W, N, WT, ldt, tn, tk, mode);
}
__device__ __forceinline__ void phase_setup(const Params& P, LAS3 unsigned char* lds) {
    const int tid = opaque_tid(), G = gridDim.x, bid = blockIdx.x;
    for (int it = bid; it < 192; it += G) {
        LAS3 float* sl = (LAS3 float*)lds;
        LAS3 float* red = sl + 9 * 1024;
        __syncthreads();
        for (int i = tid; i < 9 * 1024; i += 512) { const int r = i >> 10, k = i & 1023; sl[i] = siluf_((r < 8) ? P.c[r * 1024 + k] : P.c_ctx[k]); }
        __syncthreads();
        const int l = it / 96, j = (it % 96) * 64 + (tid & 63), kp = tid >> 6;
        const float* w = P.w_mod + (size_t)l * 1024 * 6144 + j;
        float acc[9];
#pragma unroll
        for (int r = 0; r < 9; ++r) acc[r] = 0.f;
#pragma unroll 8
        for (int k = kp * 128; k < kp * 128 + 128; ++k) {
            const float wv = w[(size_t)k * 6144];
#pragma unroll
            for (int r = 0; r < 9; ++r) acc[r] += sl[r * 1024 + k] * wv;
        }
#pragma unroll
        for (int r = 0; r < 9; ++r) red[(kp * 9 + r) * 64 + (tid & 63)] = acc[r];
        __syncthreads();
        for (int i = tid; i < 9 * 64; i += 512) {
            const int r = i >> 6, cc = i & 63; float sacc = 0.f;
#pragma unroll
            for (int k2 = 0; k2 < 8; ++k2) sacc += red[(k2 * 9 + r) * 64 + cc];
            const int jj = (it % 96) * 64 + cc;
            P.mod[((size_t)l * 9 + r) * 6144 + jj] = sacc + P.b_mod[l * 6144 + jj];
        }
    }
    for (int i = bid * 512 + tid; i < NS * 16; i += G * 512) {
        const int pos = i >> 4, j = i & 15; const int row = pos / 64, col = pos % 64;
        const float inv = exp2f(-(float)(j & 7) * 1.6609640474436813f), ang = (float)((j < 8) ? row : col) * inv;
        P.ropecs[i * 2] = cosf(ang); P.ropecs[i * 2 + 1] = sinf(ang);
    }
    if (bid == G - 1 && tid < 2) {
        const int l = tid; const float* lam = P.da_lambda + l * 128; float s1 = 0.f, s2 = 0.f;
        for (int i = 0; i < 32; ++i) { s1 += lam[i] * lam[32 + i]; s2 += lam[64 + i] * lam[96 + i]; }
        P.lamfull[l] = expf(s1) - expf(s2) + ((l == 0) ? 0.2f : 0.35550906759096927f);
    }
    for (int it = G - 1 - bid; it < 64; it += G)
        s5_setup_item(lds, it, P.s5_a_re, P.s5_a_im, P.s5_log_step, P.s5_b_re, P.s5_b_im, P.s5_c_re, P.s5_c_im, P.s5KmT, P.s5Smat, P.s5CmT, P.s5A, P.s5A64);
    for (int i = bid * 512 + tid; i < 2 * 144 * 1024 / 8; i += G * 512) {
        const int l = i / (144 * 128), r = i % (144 * 128);
        *(u32x4_t*)(P.w_in_t + ((size_t)l * 2560 + DINC) * 1024 + (size_t)r * 8) = (u32x4_t){0u, 0u, 0u, 0u};
    }
    __syncthreads();
    {
        const int wv = __builtin_amdgcn_readfirstlane(tid >> 6), lane = tid & 63;
        LAS3 float* tile = (LAS3 float*)lds + wv * (64 * 65);
        for (;;) {
            int base = 0;
            if (lane == 0) base = atomicAdd(P.queue + 2, 4);
            base = __builtin_amdgcn_readfirstlane(base);
            if (base >= CV_TOTAL) break;
            for (int it = base; it < base + 4 && it < CV_TOTAL; ++it) conv_dispatch(P, tile, lane, it);
        }
    }
}

__device__ __forceinline__ void row_modulate_store(const float (&xv)[16], const LAS3 float* nw, const LAS3 float* modr, bf16_t* __restrict__ dst, int lane) {
    float ss = 0.f;
#pragma unroll
    for (int i = 0; i < 16; ++i) ss += xv[i] * xv[i];
    ss = wave_sum(ss);
    const float rstd = rsqrtf(ss * (1.f / DM) + 1e-6f);
#pragma unroll
    for (int j = 0; j < 4; ++j) {
        const int d = j * 256 + lane * 4;
        const f32x4_t w = *(const LAS3 f32x4_t*)(nw + d), sh = *(const LAS3 f32x4_t*)(modr + d), sc = *(const LAS3 f32x4_t*)(modr + 1024 + d);
        const float o0 = xv[j * 4 + 0] * rstd * w[0] * (1.f + sc[0]) + sh[0], o1 = xv[j * 4 + 1] * rstd * w[1] * (1.f + sc[1]) + sh[1];
        const float o2 = xv[j * 4 + 2] * rstd * w[2] * (1.f + sc[2]) + sh[2], o3 = xv[j * 4 + 3] * rstd * w[3] * (1.f + sc[3]) + sh[3];
        *(uint2*)(dst + d) = make_uint2(cvtpk(o0, o1), cvtpk(o2, o3));
    }
}
__device__ __forceinline__ void phase_h0(const Params& P, LAS3 unsigned char* lds) {
    const int tid = opaque_tid(); const int lane = tid & 63, gw = blockIdx.x * 8 + (tid >> 6), NW = gridDim.x * 8;
    LAS3 float* cw = (LAS3 float*)lds;
    for (int i = tid; i < 256; i += 512) *(LAS3 f32x4_t*)(cw + i * 4) = *(const f32x4_t*)(P.norm_w + i * 4);
    for (int i = tid; i < 9 * 512; i += 512) { const int r = i >> 9, k = i & 511; *(LAS3 f32x4_t*)(cw + 1024 + r * 2048 + k * 4) = *(const f32x4_t*)(P.mod + (size_t)r * 6144 + k * 4); }
    __syncthreads();
    for (int t = gw; t < TT; t += NW) {
        const int b = t / NT, n = t % NT;
        const float* src = (n < NC) ? P.ctx + ((size_t)b * NC + n) * DM : P.x + ((size_t)b * NS + (n - NC)) * DM;
        float xv[16];
#pragma unroll
        for (int j = 0; j < 4; ++j) { const float4 v = *(const float4*)(src + j * 256 + lane * 4); xv[j * 4] = v.x; xv[j * 4 + 1] = v.y; xv[j * 4 + 2] = v.z; xv[j * 4 + 3] = v.w; }
        row_modulate_store(xv, cw, cw + 1024 + ((n < NC) ? 8 : b) * 2048, P.hbuf + (size_t)t * DM, lane);
    }
}

constexpr int TS_ROW = 264;
__device__ __forceinline__ void write_transposed(const LAS3 bf16_t* ts, bf16_t* __restrict__ dst, int b, int n0, int tid) {
    const int ch = tid & 255, hf = tid >> 8;
    bf16_t* vp = dst + (((size_t)b * 4 + (ch >> 6)) * 64 + (ch & 63)) * NT + n0 + hf * 32;
#pragma unroll
    for (int tc = 0; tc < 4; ++tc) {
        const LAS3 bf16_t* tp = ts + (hf * 32 + tc * 8) * TS_ROW + ch;
        u32x4_t o;
        o.x = (unsigned)tp[0] | ((unsigned)tp[TS_ROW] << 16); o.y = (unsigned)tp[2 * TS_ROW] | ((unsigned)tp[3 * TS_ROW] << 16);
        o.z = (unsigned)tp[4 * TS_ROW] | ((unsigned)tp[5 * TS_ROW] << 16); o.w = (unsigned)tp[6 * TS_ROW] | ((unsigned)tp[7 * TS_ROW] << 16);
        *(u32x4_t*)(vp + tc * 8) = o;
    }
}
__device__ __forceinline__ void unpack8(const u32x4_t v, float (&f)[8]) {
    f[0] = __uint_as_float(v.x << 16); f[1] = __uint_as_float(v.x & 0xFFFF0000u); f[2] = __uint_as_float(v.y << 16); f[3] = __uint_as_float(v.y & 0xFFFF0000u);
    f[4] = __uint_as_float(v.z << 16); f[5] = __uint_as_float(v.z & 0xFFFF0000u); f[6] = __uint_as_float(v.w << 16); f[7] = __uint_as_float(v.w & 0xFFFF0000u);
}
__device__ __forceinline__ u32x4_t pack8(const float (&f)[8]) { return (u32x4_t){cvtpk(f[0], f[1]), cvtpk(f[2], f[3]), cvtpk(f[4], f[5]), cvtpk(f[6], f[7])}; }

__device__ __forceinline__ void prep_da(const Params& P, LAS3 unsigned char* lds, int tile) {
    const int tid = opaque_tid();
    const int t0 = tile * 64, b = t0 / NT, n0 = t0 % NT;
    LAS3 bf16_t* vs = (LAS3 bf16_t*)lds;
    const float qscale = 0.17677669529663687f * 1.4426950408889634f;
    const bf16_t* __restrict__ pbr = P.pb; const float* __restrict__ rcs = P.ropecs;
    __syncthreads();
    {
        u32x4_t vv[4];
#pragma unroll
        for (int u = 0; u < 4; ++u) { const int id = tid + 512 * u, i = id >> 5, cg = id & 31; vv[u] = *(const u32x4_t*)(pbr + (size_t)(t0 + i) * DIN + P_DAV + cg * 8); }
#pragma unroll
        for (int u = 0; u < 4; ++u) { const int id = tid + 512 * u, i = id >> 5, cg = id & 31; *(LAS3 u32x4_t*)(vs + i * TS_ROW + cg * 8) = vv[u]; }
    }
#pragma unroll
    for (int u0 = 0; u0 < 4; u0 += 2) {
        u32x4_t lo[2], hi[2]; float4 cs[2][4];
#pragma unroll
        for (int u = 0; u < 2; ++u) {
            const int id = tid + 512 * (u0 + u), i = id >> 5, pu = id & 31, isk = pu >> 4, blk = (pu >> 1) & 7, pr = pu & 1;
            const bf16_t* src = pbr + (size_t)(t0 + i) * DIN + (isk ? P_DAK : P_DAQ) + blk * 32 + pr * 8;
            lo[u] = *(const u32x4_t*)src; hi[u] = *(const u32x4_t*)(src + 16);
            const int pos = max(n0 + i - NC, 0);
            const float4* cp = (const float4*)(rcs + (pos * 16 + pr * 8) * 2);
            cs[u][0] = cp[0]; cs[u][1] = cp[1]; cs[u][2] = cp[2]; cs[u][3] = cp[3];
        }
#pragma unroll
        for (int u = 0; u < 2; ++u) {
            const int id = tid + 512 * (u0 + u), i = id >> 5, pu = id & 31, isk = pu >> 4, blk = (pu >> 1) & 7, pr = pu & 1;
            const int n = n0 + i; const bool lat = n >= NC;
            float fl[8], fh[8], ol[8], oh[8];
            unpack8(lo[u], fl); unpack8(hi[u], fh);
            const float cc[8] = {cs[u][0].x, cs[u][0].z, cs[u][1].x, cs[u][1].z, cs[u][2].x, cs[u][2].z, cs[u][3].x, cs[u][3].z};
            const float sn[8] = {cs[u][0].y, cs[u][0].w, cs[u][1].y, cs[u][1].w, cs[u][2].y, cs[u][2].w, cs[u][3].y, cs[u][3].w};
            const float sc = isk ? 1.f : qscale;
#pragma unroll
            for (int e = 0; e < 8; ++e) {
                const float c1 = lat ? cc[e] : 1.f, s1 = lat ? sn[e] : 0.f;
                ol[e] = (fl[e] * c1 - fh[e] * s1) * sc; oh[e] = (fh[e] * c1 + fl[e] * s1) * sc;
            }
            bf16_t* dst = (isk ? P.daK : P.daQ) + (((size_t)b * 4 + (blk >> 1)) * NT + n) * 64 + (blk & 1) * 32 + pr * 8;
            *(u32x4_t*)dst = pack8(ol); *(u32x4_t*)(dst + 16) = pack8(oh);
        }
    }
    __syncthreads();
    write_transposed(vs, P.daVt, b, n0, tid);
}
__device__ __forceinline__ void prep_ml(const Params& P, LAS3 unsigned char* lds, int tile, int l) {
    const int tid = opaque_tid();
    const int t0 = tile * 64, b = t0 / NT, n0 = t0 % NT;
    LAS3 bf16_t* ks = (LAS3 bf16_t*)lds; LAS3 bf16_t* vs = ks + 64 * TS_ROW; LAS3 float* cwl = (LAS3 float*)(vs + 64 * TS_ROW);
    const int seg_lo = (n0 < NC) ? 0 : NC, seg_hi = (n0 < NC) ? NC - 1 : NT - 1;
    const bf16_t* __restrict__ pbr = P.pb;
    __syncthreads();
    for (int i = tid; i < 2048; i += 512) cwl[i] = (i < 1536) ? P.ml_conv_w[l * 1536 + i] : P.ml_conv_b[l * 512 + (i - 1536)];
    {
        u32x4_t vv[4];
#pragma unroll
        for (int u = 0; u < 4; ++u) { const int id = tid + 512 * u, i = id >> 5, cg = id & 31; vv[u] = *(const u32x4_t*)(pbr + (size_t)(t0 + i) * DIN + P_MLV + cg * 8); }
#pragma unroll
        for (int u = 0; u < 4; ++u) { const int id = tid + 512 * u, i = id >> 5, cg = id & 31; *(LAS3 u32x4_t*)(vs + i * TS_ROW + cg * 8) = vv[u]; }
        if (tid < 128) {
            const int i = tid >> 1, hf = tid & 1; float g[8];
            unpack8(*(const u32x4_t*)(pbr + (size_t)(t0 + i) * DIN + P_MLG + hf * 8), g);
#pragma unroll
            for (int e = 0; e < 8; ++e) { const int c = hf * 8 + e; g[e] += P.ml_gate_b[l * 16 + c]; if ((c >> 2) & 1) g[e] = logsigmoidf_(g[e]); }
            float* gp = P.mlG + ((size_t)t0 + i) * 16 + hf * 8;
            *(float4*)gp = make_float4(g[0], g[1], g[2], g[3]); *(float4*)(gp + 4) = make_float4(g[4], g[5], g[6], g[7]);
        }
    }
    __syncthreads();
#pragma unroll 1
    for (int u0 = 0; u0 < 8; u0 += 2) {
        u32x4_t xm[2], x0[2], xp[2];
#pragma unroll
        for (int u = 0; u < 2; ++u) {
            const int id = tid + 512 * (u0 + u), i = id >> 6, cg = id & 63, n = n0 + i;
            const int nm = max(n - 1, seg_lo), np = min(n + 1, seg_hi);
            const bf16_t* base = pbr + (size_t)b * NT * DIN + P_MLQK + cg * 8;
            xm[u] = *(const u32x4_t*)(base + (size_t)nm * DIN); x0[u] = *(const u32x4_t*)(base + (size_t)n * DIN); xp[u] = *(const u32x4_t*)(base + (size_t)np * DIN);
        }
#pragma unroll
        for (int u = 0; u < 2; ++u) {
            const int id = tid + 512 * (u0 + u), i = id >> 6, cg = id & 63, n = n0 + i;
            const float m0 = (n - 1 >= seg_lo) ? 1.f : 0.f, m2 = (n + 1 <= seg_hi) ? 1.f : 0.f;
            float a[8], c0[8], d[8], y[8];
            unpack8(xm[u], a); unpack8(x0[u], c0); unpack8(xp[u], d);
            const LAS3 float* w = cwl + cg * 8;
#pragma unroll
            for (int e = 0; e < 8; ++e) {
                float v = w[1536 + e] + a[e] * w[e] * m0 + c0[e] * w[512 + e] + d[e] * w[1024 + e] * m2;
                v = siluf_(v); if (cg >= 32) v *= 0.125f;
                y[e] = v;
            }
            const u32x4_t o = pack8(y);
            const int cc = (cg & 31) * 8;
            bf16_t* dst = ((cg < 32) ? P.mlQ : P.mlK) + (((size_t)b * 4 + (cc >> 6)) * NT + n) * 64 + (cc & 63);
            *(u32x4_t*)dst = o;
            if (cg >= 32) *(LAS3 u32x4_t*)(ks + i * TS_ROW + cc) = o;
        }
    }
    __syncthreads();
    write_transposed(ks, P.mlKt, b, n0, tid);
    write_transposed(vs, P.mlVt, b, n0, tid);
}
__device__ __forceinline__ void prep_mla(const Params& P, LAS3 unsigned char* lds, int tile, int l) {
    const int tid = opaque_tid(), wid = tid >> 6, lane = tid & 63, lr = lane & 15, q = lane >> 4;
    const int t0 = tile * 64, b = t0 / NT, n0 = t0 % NT;
    constexpr int AROW = 328;
    LAS3 bf16_t* As = (LAS3 bf16_t*)lds;
    const float qscale = 0.10206207261596575f * 1.4426950408889634f;
    const float* qn = P.mla_q_norm + l * 192; const float* kvn = P.mla_kv_norm + l * 128;
    const bf16_t* __restrict__ pbr = P.pb; bf16_t* __restrict__ oMK = P.mK; const float* __restrict__ rcs = P.ropecs;
    __syncthreads();
    {
        const int i = tid >> 3, sidx = tid & 7;
        const bf16_t* pr = pbr + (size_t)(t0 + i) * DIN;
        u32x4_t cqv[3], ckv[2];
#pragma unroll
        for (int u = 0; u < 3; ++u) cqv[u] = *(const u32x4_t*)(pr + P_CQ + (sidx + 8 * u) * 8);
#pragma unroll
        for (int u = 0; u < 2; ++u) ckv[u] = *(const u32x4_t*)(pr + P_CKV + (sidx + 8 * u) * 8);
        float fq[3][8], fk[2][8]; float sq = 0.f, sk = 0.f;
#pragma unroll
        for (int u = 0; u < 3; ++u) { unpack8(cqv[u], fq[u]);
#pragma unroll
            for (int e = 0; e < 8; ++e) sq += fq[u][e] * fq[u][e]; }
#pragma unroll
        for (int u = 0; u < 2; ++u) { unpack8(ckv[u], fk[u]);
#pragma unroll
            for (int e = 0; e < 8; ++e) sk += fk[u][e] * fk[u][e]; }
#pragma unroll
        for (int o = 1; o < 8; o <<= 1) { sq += __shfl_xor(sq, o); sk += __shfl_xor(sk, o); }
        const float rq = rsqrtf(sq * (1.f / 192.f) + 1e-6f), rk = rsqrtf(sk * (1.f / 128.f) + 1e-6f);
#pragma unroll
        for (int u = 0; u < 3; ++u) { const int c0 = (sidx + 8 * u) * 8; float o[8];
#pragma unroll
            for (int e = 0; e < 8; ++e) o[e] = fq[u][e] * rq * qn[c0 + e];
            *(LAS3 u32x4_t*)(As + i * AROW + c0) = pack8(o); }
#pragma unroll
        for (int u = 0; u < 2; ++u) { const int c0 = (sidx + 8 * u) * 8; float o[8];
#pragma unroll
            for (int e = 0; e < 8; ++e) o[e] = fk[u][e] * rk * kvn[c0 + e];
            *(LAS3 u32x4_t*)(As + i * AROW + 192 + c0) = pack8(o); }
    }
    if (tid < 256) {
        const int i = tid >> 2, c = tid & 3, n = n0 + i; const bool lat = n >= NC;
        const bf16_t* pr = pbr + (size_t)(t0 + i) * DIN + P_KR;
        const u32x4_t kav = *(const u32x4_t*)(pr + 8 * c), kbv = *(const u32x4_t*)(pr + 8 * (c ^ 2));
        const int pos = max(n - NC, 0);
        const float4* cp = (const float4*)(rcs + (pos * 16 + 8 * (c & 1)) * 2);
        const float4 c0 = cp[0], c1 = cp[1], c2 = cp[2], c3 = cp[3];
        const float sg = (c < 2) ? -1.f : 1.f;
        float ka[8], kb2[8], ko[8];
        unpack8(kav, ka); unpack8(kbv, kb2);
#define RK_(e, cc, ss) ko[e] = ka[e] * (lat ? (cc) : 1.f) + kb2[e] * (lat ? (ss) * sg : 0.f)
        RK_(0, c0.x, c0.y); RK_(1, c0.z, c0.w); RK_(2, c1.x, c1.y); RK_(3, c1.z, c1.w); RK_(4, c2.x, c2.y); RK_(5, c2.z, c2.w); RK_(6, c3.x, c3.y); RK_(7, c3.z, c3.w);
#undef RK_
        const u32x4_t ov = pack8(ko);
#pragma unroll
        for (int hh = 0; hh < 4; ++hh) *(u32x4_t*)(oMK + (((size_t)b * 4 + hh) * NT + n) * 96 + 64 + 8 * c) = ov;
    }
    __syncthreads();
    const int h = wid >> 1;
    if ((wid & 1) == 0) {
        const bf16_t* wt = P.wq_t + (size_t)l * 384 * 192;
        f32x4_t acc[4][6];
#pragma unroll
        for (int rt = 0; rt < 4; ++rt)
#pragma unroll
            for (int ct = 0; ct < 6; ++ct) acc[rt][ct] = (f32x4_t){0.f, 0.f, 0.f, 0.f};
#pragma unroll
        for (int ks = 0; ks < 6; ++ks) {
            bf16x8_t a[4];
#pragma unroll
            for (int rt = 0; rt < 4; ++rt) a[rt] = *(const LAS3 bf16x8_t*)(As + (16 * rt + lr) * AROW + 32 * ks + 8 * q);
#pragma unroll
            for (int ct = 0; ct < 6; ++ct) {
                const bf16x8_t bb = *(const bf16x8_t*)(wt + (size_t)(h * 96 + 16 * ct + lr) * 192 + 32 * ks + 8 * q);
#pragma unroll
                for (int rt = 0; rt < 4; ++rt) acc[rt][ct] = __builtin_amdgcn_mfma_f32_16x16x32_bf16(bb, a[rt], acc[rt][ct], 0, 0, 0);
            }
        }
#pragma unroll
        for (int rt = 0; rt < 4; ++rt) {
            const int n = n0 + 16 * rt + lr;
            bf16_t* qp = P.mQ + (((size_t)b * 4 + h) * NT + n) * 96;
#pragma unroll
            for (int ct = 0; ct < 4; ++ct)
                *(uint2*)(qp + 16 * ct + 4 * q) = make_uint2(cvtpk(acc[rt][ct][0] * qscale, acc[rt][ct][1] * qscale), cvtpk(acc[rt][ct][2] * qscale, acc[rt][ct][3] * qscale));
            f32x4_t x1 = acc[rt][4], x2 = acc[rt][5];
            if (n >= NC) {
                const float4* cp = (const float4*)(rcs + ((n - NC) * 16 + 4 * q) * 2);
                const float4 ca = cp[0], cb = cp[1];
                const f32x4_t co = (f32x4_t){ca.x, ca.z, cb.x, cb.z}, si = (f32x4_t){ca.y, ca.w, cb.y, cb.w};
                const f32x4_t o1 = x1 * co - x2 * si, o2 = x2 * co + x1 * si; x1 = o1; x2 = o2;
            }
            *(uint2*)(qp + 64 + 4 * q) = make_uint2(cvtpk(x1[0] * qscale, x1[1] * qscale), cvtpk(x1[2] * qscale, x1[3] * qscale));
            *(uint2*)(qp + 80 + 4 * q) = make_uint2(cvtpk(x2[0] * qscale, x2[1] * qscale), cvtpk(x2[2] * qscale, x2[3] * qscale));
        }
    } else {
        const bf16_t* wt = P.wkv_t + (size_t)l * 512 * 128;
#pragma unroll
        for (int pass = 0; pass < 2; ++pass) {
            f32x4_t acc[4][4];
#pragma unroll
            for (int rt = 0; rt < 4; ++rt)
#pragma unroll
                for (int ct = 0; ct < 4; ++ct) acc[rt][ct] = (f32x4_t){0.f, 0.f, 0.f, 0.f};
#pragma unroll
            for (int ks = 0; ks < 4; ++ks) {
                bf16x8_t a[4];
#pragma unroll
                for (int rt = 0; rt < 4; ++rt) a[rt] = *(const LAS3 bf16x8_t*)(As + (16 * rt + lr) * AROW + 192 + 32 * ks + 8 * q);
#pragma unroll
                for (int ct = 0; ct < 4; ++ct) {
                    const bf16x8_t bb = *(const bf16x8_t*)(wt + (size_t)(h * 128 + 16 * (4 * pass + ct) + lr) * 128 + 32 * ks + 8 * q);
#pragma unroll
                    for (int rt = 0; rt < 4; ++rt)
                        acc[rt][ct] = (pass == 0) ? __builtin_amdgcn_mfma_f32_16x16x32_bf16(bb, a[rt], acc[rt][ct], 0, 0, 0) : __builtin_amdgcn_mfma_f32_16x16x32_bf16(a[rt], bb, acc[rt][ct], 0, 0, 0);
                }
            }
#pragma unroll
            for (int rt = 0; rt < 4; ++rt) {
                if (pass == 0) {
                    const int n = n0 + 16 * rt + lr;
                    bf16_t* kp = P.mK + (((size_t)b * 4 + h) * NT + n) * 96;
#pragma unroll
                    for (int ct = 0; ct < 4; ++ct) *(uint2*)(kp + 16 * ct + 4 * q) = make_uint2(cvtpk(acc[rt][ct][0], acc[rt][ct][1]), cvtpk(acc[rt][ct][2], acc[rt][ct][3]));
                } else {
#pragma unroll
                    for (int ct = 0; ct < 4; ++ct) {
                        bf16_t* vp = P.mVt + (((size_t)b * 4 + h) * 64 + 16 * ct + lr) * NT + n0 + 16 * rt + 4 * q;
                        *(uint2*)vp = make_uint2(cvtpk(acc[rt][ct][0], acc[rt][ct][1]), cvtpk(acc[rt][ct][2], acc[rt][ct][3]));
                    }
                }
            }
        }
    }
}
__device__ __forceinline__ void phase_prep(const Params& P, LAS3 unsigned char* lds, int l) {
    for (int it = blockIdx.x; it < 3 * (TT / 64); it += gridDim.x) {
        const int fn = it % 3, tile = it / 3;
        if (fn == 0) prep_mla(P, lds, tile, l); else if (fn == 1) prep_ml(P, lds, tile, l); else prep_da(P, lds, tile);
    }
}

__device__ __forceinline__ void phase_mix(const Params& P, LAS3 unsigned char* lds, int l) {
    const int bid = blockIdx.x, G = gridDim.x;
    const float lambda_init = (l == 0) ? 0.2f : 0.35550906759096927f;
    for (int it = bid; it < 256; it += G)
    {
        const int pr = (it & 7) * 4 + (it >> 6), qb = (it >> 3) & 7;
        attn_item<64, 2, true>(lds, P.daQ, P.daK, P.daVt, P.ycatb, 0, pr >> 2, pr & 3, 1 + qb, P.lamfull[l], P.da_subln + l * 64, 1.f - lambda_init);
    }
    LAS3 int* slot = (LAS3 int*)(lds + MK_LDS_MAIN + 16);
    const int n_ml = 64, n_mla = 256, n_s5 = 256, n_ctx = (l == 0) ? 64 : 0;
    const int total = n_ml + n_mla + n_s5 + n_ctx;
    for (;;) {
        __syncthreads();
        if (threadIdx.x == 0) *slot = atomicAdd(P.queue + l, 1);
        __syncthreads();
        int it = __builtin_amdgcn_readfirstlane(*slot);
        if (it >= total) break;
        int kind, b, h, x3;
        if (it < n_ml) { kind = 1; b = it >> 3; h = (it >> 1) & 3; x3 = it & 1; }
        else if ((it -= n_ml) < n_mla) { kind = 2; b = it >> 5; h = (it >> 3) & 3; x3 = 1 + (it & 7); }
        else if ((it -= n_mla) < n_s5) { kind = 3; b = it >> 5; h = (it >> 1) & 15; x3 = it & 1; }
        else { it -= n_s5; kind = (it < 32) ? 0 : 2; it &= 31; b = it >> 2; h = it & 3; x3 = 0; }
        if (kind == 0) attn_item<64, 2, true>(lds, P.daQ, P.daK, P.daVt, P.ycatb, 0, b, h, x3, P.lamfull[l], P.da_subln + l * 64, 1.f - lambda_init);
        else if (kind == 1) mlstm_item(lds, P.mlQ, P.mlK, P.mlKt, P.mlVt, P.mlG, P.hdir, b, h, x3);
        else if (kind == 2) attn_item<96, 1, false>(lds, P.mQ, P.mK, P.mVt, P.ycatb, 512, b, h, x3, 0.f, nullptr, 1.f);
        else s5_item(lds, P.pb, P.s5KmT + (size_t)l * 32 * 16 * 1024, P.s5Smat + (size_t)l * 32 * 128 * 1024, P.s5CmT + (size_t)l * 32 * 16 * 128,
                     P.s5A + l * 32 * 64 * 2, P.s5A64 + l * 32 * 64 * 2, P.s5xs, P.ys5, b, h, x3);
    }
}

template <int TOK, int BATCH>
__device__ __forceinline__ void phase_finish_t(const Params& P, LAS3 unsigned char* lds, int l) {
    constexpr int RT = (TOK + 15) / 16;
    const int tid = opaque_tid(), wid = tid >> 6, lane = tid & 63, lr = lane & 15, q = lane >> 4, c = tid & 255, half = tid >> 8;
    const int ntile = (l == 0) ? TT / TOK : NB * (NS / TOK);
    constexpr int GROW = 264;
    LAS3 bf16_t* Gs = (LAS3 bf16_t*)lds;
    const float* mn = P.ml_norm + l * 256; const float* dsk = P.s5_d + l * 256; const float* bgl = P.s5_b_glu + l * 256;
    const bf16_t* wg = P.wglu_t + (size_t)l * 256 * 256;
    const bf16_t* __restrict__ pbr = P.pb; const bf16_t* __restrict__ hdr = (const bf16_t*)P.hdir; const bf16_t* __restrict__ ysr = (const bf16_t*)P.ys5; bf16_t* __restrict__ oY = P.ycatb;
    for (int it = blockIdx.x; it < ntile; it += gridDim.x) {
        const int t0 = (l == 0) ? it * TOK : ((it / (NS / TOK)) * NT + NC + (it % (NS / TOK)) * TOK);
        __syncthreads();
        {
            const int cg = tid & 31, ts = tid >> 5, c0 = 8 * cg;
            float mnv[8], dsv[8];
            { const float4 m0 = *(const float4*)(mn + c0), m1 = *(const float4*)(mn + c0 + 4), d0 = *(const float4*)(dsk + c0), d1 = *(const float4*)(dsk + c0 + 4);
              mnv[0] = m0.x; mnv[1] = m0.y; mnv[2] = m0.z; mnv[3] = m0.w; mnv[4] = m1.x; mnv[5] = m1.y; mnv[6] = m1.z; mnv[7] = m1.w;
              dsv[0] = d0.x; dsv[1] = d0.y; dsv[2] = d0.z; dsv[3] = d0.w; dsv[4] = d1.x; dsv[5] = d1.y; dsv[6] = d1.z; dsv[7] = d1.w; }
            constexpr int NP = (TOK + 15) / 16;
#pragma unroll
            for (int k0 = 0; k0 < NP; k0 += 2) {
                u32x4_t vog[2], vuu[2], vhf[2], vhb[2], vyf[2], vyb[2];
#pragma unroll
                for (int u = 0; u < 2; ++u) {
                    const int tok = ts + 16 * (k0 + u), tc = (tok < TOK) ? tok : TOK - 1;
                    const size_t t = (size_t)t0 + tc; const bf16_t* pr = pbr + t * DIN;
                    vog[u] = *(const u32x4_t*)(pr + P_MLO + c0); vuu[u] = *(const u32x4_t*)(pr + P_S5 + c0);
                    vhf[u] = *(const u32x4_t*)(hdr + t * 256 + c0); vhb[u] = *(const u32x4_t*)(hdr + ((size_t)TT + t) * 256 + c0);
                    vyf[u] = *(const u32x4_t*)(ysr + t * 256 + c0); vyb[u] = *(const u32x4_t*)(ysr + ((size_t)TT + t) * 256 + c0);
                }
#pragma unroll
                for (int u = 0; u < 2; ++u) {
                    const int tok = ts + 16 * (k0 + u);
                    float og[8], uu[8], hf[8], hb[8], yf[8], yb[8], hv[8], go[8];
                    unpack8(vog[u], og); unpack8(vuu[u], uu); unpack8(vhf[u], hf); unpack8(vhb[u], hb); unpack8(vyf[u], yf); unpack8(vyb[u], yb);
                    float ssq = 0.f;
#pragma unroll
                    for (int e = 0; e < 8; ++e) { hv[e] = sigmoidf_(og[e]) * (hf[e] + hb[e]); ssq += hv[e] * hv[e]; go[e] = gelu_tanh_(yf[e] + yb[e] + uu[e] * dsv[e]); }
                    ssq += __shfl_xor(ssq, 1); ssq += __shfl_xor(ssq, 2); ssq += __shfl_xor(ssq, 4);
                    const float r = rsqrtf(ssq * (1.f / 64.f) + 1e-6f);
#pragma unroll
                    for (int e = 0; e < 8; ++e) hv[e] = hv[e] * r * mnv[e];
                    if (NP * 16 == TOK || tok < TOK) {
                        *(u32x4_t*)(oY + ((size_t)t0 + tok) * DM + 256 + c0) = pack8(hv);
                        *(LAS3 u32x4_t*)(Gs + tok * GROW + c0) = pack8(go);
                    }
                }
            }
        }
        __syncthreads();
        f32x4_t acc[RT][2];
#pragma unroll
        for (int rt = 0; rt < RT; ++rt) { acc[rt][0] = (f32x4_t){0.f, 0.f, 0.f, 0.f}; acc[rt][1] = (f32x4_t){0.f, 0.f, 0.f, 0.f}; }
#pragma unroll
        for (int ks = 0; ks < 8; ++ks) {
            const bf16x8_t b0 = *(const bf16x8_t*)(wg + (size_t)(32 * wid + lr) * 256 + 32 * ks + 8 * q);
            const bf16x8_t b1 = *(const bf16x8_t*)(wg + (size_t)(32 * wid + 16 + lr) * 256 + 32 * ks + 8 * q);
#pragma unroll
            for (int rt = 0; rt < RT; ++rt) {
                const bf16x8_t a = *(const LAS3 bf16x8_t*)(Gs + (16 * rt + lr) * GROW + 32 * ks + 8 * q);
                acc[rt][0] = __builtin_amdgcn_mfma_f32_16x16x32_bf16(a, b0, acc[rt][0], 0, 0, 0);
                acc[rt][1] = __builtin_amdgcn_mfma_f32_16x16x32_bf16(a, b1, acc[rt][1], 0, 0, 0);
            }
        }
#pragma unroll
        for (int rt = 0; rt < RT; ++rt)
#pragma unroll
            for (int cc = 0; cc < 2; ++cc)
#pragma unroll
                for (int rg = 0; rg < 4; ++rg) {
                    const int row = 16 * rt + 4 * q + rg, col = 32 * wid + 16 * cc + lr;
                    const float gv = bf2f(Gs[row * GROW + col]);
                    if (TOK % 16 == 0 || row < TOK) P.ycatb[((size_t)t0 + row) * DM + 768 + col] = f2bf(gv * sigmoidf_(acc[rt][cc][rg] + bgl[col]));
                }
    }
}
__device__ __forceinline__ void phase_finish(const Params& P, LAS3 unsigned char* lds, int l) {
    if (l == 0) phase_finish_t<72, 12>(P, lds, l); else phase_finish_t<64, 8>(P, lds, l);
}

__device__ __forceinline__ void phase_post(const Params& P, LAS3 unsigned char* lds, int l) {
    const int tid = opaque_tid(), wid = tid >> 6, lane = tid & 63, lr = lane & 15, q = lane >> 4;
    constexpr int FROW = 1028, HROW = 1032;
    LAS3 float* ft = (LAS3 float*)lds;
    LAS3 bf16_t* fhi = (LAS3 bf16_t*)lds; LAS3 bf16_t* flo = fhi + 16 * HROW;
    static_assert(2 * 16 * HROW * 2 <= 16 * FROW * 4 + 1024, "hi/lo images");
    LAS3 float* pl = ft + 16 * FROW + 256;
    const float* nw1 = P.norm_w + (size_t)l * 4096 + 1024; const float* nw2 = nw1 + 1024;
    const float* wr = P.moe_w_router + (size_t)l * 1024 * 32; const float* br = P.moe_b_router + l * 32;
    LAS3 int* lcnt = (LAS3 int*)(pl + 8 * 16 * 32);
    if (tid < 32) lcnt[tid] = 0;
    bf16x8_t whi[4][2], wlo[4][2];
#pragma unroll
    for (int kb = 0; kb < 4; ++kb)
#pragma unroll
        for (int hx = 0; hx < 2; ++hx) {
            union { unsigned u[4]; bf16x8_t v; } uh, ul;
#pragma unroll
            for (int jj = 0; jj < 4; ++jj) {
                const float w0 = wr[(size_t)(128 * wid + 32 * kb + 8 * q + 2 * jj) * 32 + 16 * hx + lr], w1 = wr[(size_t)(128 * wid + 32 * kb + 8 * q + 2 * jj + 1) * 32 + 16 * hx + lr];
                const unsigned hb = cvtpk(w0, w1);
                uh.u[jj] = hb; ul.u[jj] = cvtpk(w0 - __uint_as_float(hb << 16), w1 - __uint_as_float(hb & 0xFFFF0000u));
            }
            whi[kb][hx] = uh.v; wlo[kb][hx] = ul.v;
        }
    const int nitem = (l == 0) ? TT / 16 : NB * NS / 16;
    const int tr = tid >> 5, part = tid & 31;
    LAS3 float* wl = (LAS3 float*)(lcnt + 32) + 16 * 32 + 16 * 4 + 16 * 4;
    float4 nm0 = make_float4(0.f, 0.f, 0.f, 0.f), nm1 = nm0;
#define POST_MODROW(it_) (P.mod + ((size_t)l * 9 + (((((l == 0) ? (it_) * 16 : (((it_) >> 7) * NT + NC + ((it_) & 127) * 16)) % NT) < NC) ? 8 : (((l == 0) ? (it_) * 16 : (((it_) >> 7) * NT + NC + ((it_) & 127) * 16)) / NT))) * 6144 + 2048)
    *(LAS3 f32x4_t*)(wl + tid * 4) = *(const f32x4_t*)(nw1 + tid * 4);
    if ((int)blockIdx.x < nitem) { const float* mrn = POST_MODROW((int)blockIdx.x); nm0 = *(const float4*)(mrn + tid * 4); if (tid < 256) nm1 = *(const float4*)(mrn + 2048 + tid * 4);
        *(LAS3 f32x4_t*)(wl + 2048 + tid * 4) = (f32x4_t){nm0.x, nm0.y, nm0.z, nm0.w}; if (tid < 256) *(LAS3 f32x4_t*)(wl + 4096 + tid * 4) = (f32x4_t){nm1.x, nm1.y, nm1.z, nm1.w}; }
    for (int it = blockIdx.x; it < nitem; it += gridDim.x) {
        const int t0 = (l == 0) ? it * 16 : ((it >> 7) * NT + NC + (it & 127) * 16);
        const int t = t0 + tr, b = t / NT, n = t % NT;
        const float* xin = (n < NC) ? P.ctx + ((size_t)b * NC + n) * DM : P.x + ((size_t)b * NS + (n - NC)) * DM;
        bf16_t* x1b = (bf16_t*)P.xall; const bf16_t* x2b = x1b + (size_t)TT * DM;
        __syncthreads();
        float x1[32];
        {
            float so = P.osq[(size_t)t * 16 + (part & 15)];
#pragma unroll
            for (int o = 8; o > 0; o >>= 1) so += __shfl_xor(so, o);
            const float rstd = rsqrtf(so * (1.f / DM) + 1e-6f);
            float ss = 0.f;
#pragma unroll
            for (int j = 0; j < 8; ++j) {
                const int d = j * 128 + part * 4;
                const uint2 ov = *(const uint2*)(P.ob + (size_t)t * DM + d);
                float4 xv;
                if (l == 0) xv = *(const float4*)(xin + d);
                else { const uint2 xb = *(const uint2*)(x2b + (size_t)t * DM + d); xv = make_float4(__uint_as_float(xb.x << 16), __uint_as_float(xb.x & 0xFFFF0000u), __uint_as_float(xb.y << 16), __uint_as_float(xb.y & 0xFFFF0000u)); }
                const f32x4_t wv_ = *(const LAS3 f32x4_t*)(wl + d), gv_ = *(const LAS3 f32x4_t*)(wl + 2048 + d);
                const float4 w = make_float4(wv_[0], wv_[1], wv_[2], wv_[3]), g1 = make_float4(gv_[0], gv_[1], gv_[2], gv_[3]);
                const float a0 = xv.x + g1.x * __uint_as_float(ov.x << 16) * rstd * w.x, a1 = xv.y + g1.y * __uint_as_float(ov.x & 0xFFFF0000u) * rstd * w.y;
                const float a2 = xv.z + g1.z * __uint_as_float(ov.y << 16) * rstd * w.z, a3 = xv.w + g1.w * __uint_as_float(ov.y & 0xFFFF0000u) * rstd * w.w;
                x1[j * 4] = a0; x1[j * 4 + 1] = a1; x1[j * 4 + 2] = a2; x1[j * 4 + 3] = a3;
                *(uint2*)(x1b + (size_t)t * DM + d) = make_uint2(cvtpk(a0, a1), cvtpk(a2, a3));
                ss += (a0 * a0 + a1 * a1) + (a2 * a2 + a3 * a3);
            }
#pragma unroll
            for (int o = 16; o > 0; o >>= 1) ss += __shfl_xor(ss, o);
            const float rstd2 = rsqrtf(ss * (1.f / DM) + 1e-6f);
#pragma unroll
            for (int j = 0; j < 8; ++j) {
                const int d = j * 128 + part * 4;
                const f32x4_t wv_ = *(const LAS3 f32x4_t*)(wl + 1024 + d), sv_ = *(const LAS3 f32x4_t*)(wl + 3072 + d), cv_ = *(const LAS3 f32x4_t*)(wl + 4096 + d);
                const float4 w = make_float4(wv_[0], wv_[1], wv_[2], wv_[3]), sh = make_float4(sv_[0], sv_[1], sv_[2], sv_[3]), sc = make_float4(cv_[0], cv_[1], cv_[2], cv_[3]);
                const float f0 = x1[j * 4] * rstd2 * w.x * (1.f + sc.x) + sh.x, f1 = x1[j * 4 + 1] * rstd2 * w.y * (1.f + sc.y) + sh.y;
                const float f2 = x1[j * 4 + 2] * rstd2 * w.z * (1.f + sc.z) + sh.z, f3 = x1[j * 4 + 3] * rstd2 * w.w * (1.f + sc.w) + sh.w;
                *(uint2*)(P.fb + (size_t)t * DM + d) = make_uint2(cvtpk(f0, f1), cvtpk(f2, f3));
                {
                    const unsigned h01 = cvtpk(f0, f1), h23 = cvtpk(f2, f3);
                    *(LAS3 u32x2_t*)(fhi + tr * HROW + d) = (u32x2_t){h01, h23};
                    *(LAS3 u32x2_t*)(flo + tr * HROW + d) = (u32x2_t){cvtpk(f0 - __uint_as_float(h01 << 16), f1 - __uint_as_float(h01 & 0xFFFF0000u)), cvtpk(f2 - __uint_as_float(h23 << 16), f3 - __uint_as_float(h23 & 0xFFFF0000u))};
                }
            }
        }
        __syncthreads();
        const bool hasn = it + (int)gridDim.x < nitem;
        if (hasn) { const float* mrn = POST_MODROW(it + (int)gridDim.x); nm0 = *(const float4*)(mrn + tid * 4); if (tid < 256) nm1 = *(const float4*)(mrn + 2048 + tid * 4); }
        {
            f32x4_t a0 = (f32x4_t){0.f, 0.f, 0.f, 0.f}, a1 = (f32x4_t){0.f, 0.f, 0.f, 0.f};
            bf16x8_t ah[4], al[4];
#pragma unroll
            for (int kb = 0; kb < 4; ++kb) { ah[kb] = *(const LAS3 bf16x8_t*)(fhi + lr * HROW + 128 * wid + 32 * kb + 8 * q); al[kb] = *(const LAS3 bf16x8_t*)(flo + lr * HROW + 128 * wid + 32 * kb + 8 * q); }
#pragma unroll
            for (int kb = 0; kb < 4; ++kb) {
                a0 = __builtin_amdgcn_mfma_f32_16x16x32_bf16(ah[kb], whi[kb][0], a0, 0, 0, 0); a1 = __builtin_amdgcn_mfma_f32_16x16x32_bf16(ah[kb], whi[kb][1], a1, 0, 0, 0);
                a0 = __builtin_amdgcn_mfma_f32_16x16x32_bf16(ah[kb], wlo[kb][0], a0, 0, 0, 0); a1 = __builtin_amdgcn_mfma_f32_16x16x32_bf16(ah[kb], wlo[kb][1], a1, 0, 0, 0);
                a0 = __builtin_amdgcn_mfma_f32_16x16x32_bf16(al[kb], whi[kb][0], a0, 0, 0, 0); a1 = __builtin_amdgcn_mfma_f32_16x16x32_bf16(al[kb], whi[kb][1], a1, 0, 0, 0);
            }
#pragma unroll
            for (int rg = 0; rg < 4; ++rg) { pl[(wid * 16 + 4 * q + rg) * 32 + lr] = a0[rg]; pl[(wid * 16 + 4 * q + rg) * 32 + 16 + lr] = a1[rg]; }
        }
        __syncthreads();
        {
            float lg = br[part];
#pragma unroll
            for (int w = 0; w < 8; ++w) lg += pl[(w * 16 + tr) * 32 + part];
            LAS3 float* lgs = (LAS3 float*)(lcnt + 32);
            LAS3 float* topv = lgs + 16 * 32;
            LAS3 int* topi = (LAS3 int*)(topv + 16 * 4);
            lgs[tr * 32 + part] = lg;
            asm volatile("s_waitcnt lgkmcnt(0)" ::: "memory");
            int rank = 0;
#pragma unroll
            for (int c4 = 0; c4 < 8; ++c4) {
                const f32x4_t lv = *(const LAS3 f32x4_t*)(lgs + tr * 32 + 4 * c4);
#pragma unroll
                for (int e = 0; e < 4; ++e) rank += (lv[e] > lg || (lv[e] == lg && (4 * c4 + e) < part)) ? 1 : 0;
            }
            if (rank < 4) { topv[tr * 4 + rank] = lg; topi[tr * 4 + rank] = part; }
            asm volatile("s_waitcnt lgkmcnt(0)" ::: "memory");
            if (part < 4) {
                const f32x4_t v = *(const LAS3 f32x4_t*)(topv + tr * 4);
                const int ek = topi[tr * 4 + part];
                const float e1 = __expf(v[1] - v[0]), e2 = __expf(v[2] - v[0]), e3 = __expf(v[3] - v[0]);
                const float inv = 1.f / (1.f + e1 + e2 + e3);
                const float gk = (part == 0) ? inv : (part == 1) ? e1 * inv : (part == 2) ? e2 * inv : e3 * inv;
                P.top_e[(size_t)t * 4 + part] = ek; P.top_g[(size_t)t * 4 + part] = gk;
                P.posb[(size_t)t * 4 + part] = __hip_atomic_fetch_add(&lcnt[ek], 1, __ATOMIC_RELAXED, __HIP_MEMORY_SCOPE_WORKGROUP);
            }
        }
        if (hasn) { *(LAS3 f32x4_t*)(wl + 2048 + tid * 4) = (f32x4_t){nm0.x, nm0.y, nm0.z, nm0.w}; if (tid < 256) *(LAS3 f32x4_t*)(wl + 4096 + tid * 4) = (f32x4_t){nm1.x, nm1.y, nm1.z, nm1.w}; }
    }
#undef POST_MODROW
    __syncthreads();
    if (tid < 32) P.blkcnt[((size_t)l * gridDim.x + blockIdx.x) * 32 + tid] = lcnt[tid];
}

__device__ __forceinline__ void phase_scatter(const Params& P, LAS3 unsigned char* lds, int l) {
    const int tid = opaque_tid(), wid = tid >> 6, lane = tid & 63;
    LAS3 int* soff = (LAS3 int*)lds;
    LAS3 int* part = soff + 64;
    LAS3 int* pre = soff + 1024;
    const int G = gridDim.x;
    const int* bc = P.blkcnt + (size_t)l * G * 32;
    __syncthreads();
    {
        const int e = tid & 31, pt = tid >> 5, per = (G + 15) / 16;
        int sum = 0;
        for (int b2 = pt * per; b2 < (pt + 1) * per && b2 < G; ++b2) sum += bc[b2 * 32 + e];
        part[pt * 32 + e] = sum;
        __syncthreads();
        int run = 0;
        for (int p2 = 0; p2 < pt; ++p2) run += part[p2 * 32 + e];
        for (int b2 = pt * per; b2 < (pt + 1) * per && b2 < G; ++b2) { pre[b2 * 32 + e] = run; run += bc[b2 * 32 + e]; }
        if (pt == 15) soff[32 + e] = run;
    }
    __syncthreads();
    if (tid == 0) {
        int o = 0, nt = 0;
        for (int e = 0; e < NE; ++e) {
            soff[e] = o; const int c = soff[32 + e];
            const int ntl = (c + 255) >> 8;
            if (blockIdx.x == 0) { for (int m = 0; m < ntl; ++m) P.tile_e[l * 512 + nt + m] = e; P.offs[l * 32 + e] = o; }
            nt += ntl; o = nt * 256;
        }
        if (blockIdx.x == 0) P.ntiles[l * 16] = nt;
    }
    __syncthreads();
    const int gt = blockIdx.x * 512 + tid, NTH = gridDim.x * 512;
    const int ntok = (l == 0) ? TT : NB * NS;
    int* __restrict__ stk = (int*)P.xg;
    for (int a = gt; a < ntok * 4; a += NTH) {
        const int i = a >> 2;
        const int t = (l == 0) ? i : ((i >> 11) * NT + NC + (i & 2047));
        const int ek = P.top_e[(size_t)t * 4 + (a & 3)];
        const int slot = soff[ek] + pre[((i >> 4) % G) * 32 + ek] + P.posb[(size_t)t * 4 + (a & 3)];
        stk[slot] = t; P.tok_slot[(size_t)t * 4 + (a & 3)] = slot;
    }
    for (int i = gt; i < NE * 256; i += NTH) {
        const int e = i >> 8, j = i & 255, c = soff[32 + e];
        const int padn = ((c + 255) & ~255) - c;
        if (j < padn) stk[soff[e] + c + j] = NC;
    }
}

__device__ __forceinline__ void phase_combine(const Params& P, LAS3 unsigned char* lds, int l) {
    const int tid = opaque_tid(); const int lane = tid & 63, gw = blockIdx.x * 8 + (tid >> 6), NW = gridDim.x * 8;
    const float* __restrict__ nw3 = P.norm_w + (size_t)l * 4096 + 3072;
    const float* __restrict__ nwn = P.norm_w + 4096;
    const int* __restrict__ tsl = P.tok_slot; const float* __restrict__ tg = P.top_g; const bf16_t* __restrict__ ye = P.yexp; const float* __restrict__ modp = P.mod;
    const int ntok = (l == 0) ? TT : NB * NS;
    LAS3 float* cw = (LAS3 float*)lds;
    for (int i = tid; i < 256; i += 512) { *(LAS3 f32x4_t*)(cw + i * 4) = *(const f32x4_t*)(nw3 + i * 4); if (l == 0) *(LAS3 f32x4_t*)(cw + 1024 + i * 4) = *(const f32x4_t*)(nwn + i * 4); }
    for (int i = tid; i < 9 * 256; i += 512) { const int r = i >> 8, k = i & 255; *(LAS3 f32x4_t*)(cw + 2048 + r * 1024 + k * 4) = *(const f32x4_t*)(modp + ((size_t)l * 9 + r) * 6144 + 5120 + k * 4); }
    if (l == 0) for (int i = tid; i < 9 * 512; i += 512) { const int r = i >> 9, k = i & 511; *(LAS3 f32x4_t*)(cw + 11264 + r * 2048 + k * 4) = *(const f32x4_t*)(modp + ((size_t)9 + r) * 6144 + k * 4); }
    __syncthreads();
    const bf16_t* __restrict__ x1b = (const bf16_t*)P.xall; bf16_t* __restrict__ x2b = (bf16_t*)P.xall + (size_t)TT * DM;
    int i = gw;
    int4 sl = make_int4(0, 0, 0, 0); float4 gt = make_float4(0.f, 0.f, 0.f, 0.f);
    if (i < ntok) { const int t = (l == 0) ? i : ((i >> 11) * NT + NC + (i & 2047)); sl = *(const int4*)(tsl + (size_t)t * 4); gt = *(const float4*)(tg + (size_t)t * 4); }
    for (; i < ntok; i += NW) {
        const int t = (l == 0) ? i : ((i >> 11) * NT + NC + (i & 2047));
        const int b = t / NT, n = t % NT, r = (n < NC) ? 8 : b;
        const int4 slc = sl; const float4 gtc = gt;
        uint2 yv[4][4];
        const int slots[4] = {slc.x, slc.y, slc.z, slc.w};
#pragma unroll
        for (int k = 0; k < 4; ++k)
#pragma unroll
            for (int j2 = 0; j2 < 2; ++j2) { const u32x4_t v16 = *(const u32x4_t*)(ye + (size_t)slots[k] * DM + j2 * 512 + lane * 8);
                yv[k][2 * j2] = make_uint2(v16.x, v16.y); yv[k][2 * j2 + 1] = make_uint2(v16.z, v16.w); }
        float4 x1[4], w3[4], g2[4], wn[4], scn[4], shn[4];
#define CW4(p_) ({ const f32x4_t v_ = *(const LAS3 f32x4_t*)(p_); make_float4(v_[0], v_[1], v_[2], v_[3]); })
#pragma unroll
        for (int j = 0; j < 4; ++j) {
            const int d = (j >> 1) * 512 + lane * 8 + (j & 1) * 4;
            { const uint2 xb = *(const uint2*)(x1b + (size_t)t * DM + d); x1[j] = make_float4(__uint_as_float(xb.x << 16), __uint_as_float(xb.x & 0xFFFF0000u), __uint_as_float(xb.y << 16), __uint_as_float(xb.y & 0xFFFF0000u)); }
            w3[j] = CW4(cw + d); g2[j] = CW4(cw + 2048 + r * 1024 + d);
            if (l == 0) { wn[j] = CW4(cw + 1024 + d); scn[j] = CW4(cw + 11264 + r * 2048 + 1024 + d); shn[j] = CW4(cw + 11264 + r * 2048 + d); }
        }
        { const int in = i + NW; if (in < ntok) { const int tn = (l == 0) ? in : ((in >> 11) * NT + NC + (in & 2047)); sl = *(const int4*)(tsl + (size_t)tn * 4); gt = *(const float4*)(tg + (size_t)tn * 4); } }
        const float gk[4] = {gtc.x, gtc.y, gtc.z, gtc.w};
        float m[16];
#pragma unroll
        for (int j = 0; j < 16; ++j) m[j] = 0.f;
#pragma unroll
        for (int k = 0; k < 4; ++k)
#pragma unroll
            for (int j = 0; j < 4; ++j) {
                m[j * 4] += gk[k] * __uint_as_float(yv[k][j].x << 16); m[j * 4 + 1] += gk[k] * __uint_as_float(yv[k][j].x & 0xFFFF0000u);
                m[j * 4 + 2] += gk[k] * __uint_as_float(yv[k][j].y << 16); m[j * 4 + 3] += gk[k] * __uint_as_float(yv[k][j].y & 0xFFFF0000u);
            }
        float ss = 0.f;
#pragma unroll
        for (int j = 0; j < 16; ++j) ss += m[j] * m[j];
        const float rstd = rsqrtf(wave_sum(ss) * (1.f / DM) + 1e-6f);
        float xv[16]; float s2 = 0.f;
#pragma unroll
        for (int j = 0; j < 4; ++j) {
            const int d = (j >> 1) * 512 + lane * 8 + (j & 1) * 4;
            xv[j * 4] = x1[j].x + g2[j].x * m[j * 4] * rstd * w3[j].x; xv[j * 4 + 1] = x1[j].y + g2[j].y * m[j * 4 + 1] * rstd * w3[j].y;
            xv[j * 4 + 2] = x1[j].z + g2[j].z * m[j * 4 + 2] * rstd * w3[j].z; xv[j * 4 + 3] = x1[j].w + g2[j].w * m[j * 4 + 3] * rstd * w3[j].w;
            s2 += (xv[j * 4] * xv[j * 4] + xv[j * 4 + 1] * xv[j * 4 + 1]) + (xv[j * 4 + 2] * xv[j * 4 + 2] + xv[j * 4 + 3] * xv[j * 4 + 3]);
            const float4 o = make_float4(xv[j * 4], xv[j * 4 + 1], xv[j * 4 + 2], xv[j * 4 + 3]);
            if (l == 0) *(uint2*)(x2b + (size_t)t * DM + d) = make_uint2(cvtpk(o.x, o.y), cvtpk(o.z, o.w));
            else *(float4*)(P.out + ((size_t)b * NS + (n - NC)) * DM + d) = o;
        }
        if (l == 0) {
            const float rs2 = rsqrtf(wave_sum(s2) * (1.f / DM) + 1e-6f);
#pragma unroll
            for (int j = 0; j < 4; ++j) {
                const int d = (j >> 1) * 512 + lane * 8 + (j & 1) * 4;
                const float o0 = xv[j * 4] * rs2 * wn[j].x * (1.f + scn[j].x) + shn[j].x, o1 = xv[j * 4 + 1] * rs2 * wn[j].y * (1.f + scn[j].y) + shn[j].y;
                const float o2 = xv[j * 4 + 2] * rs2 * wn[j].z * (1.f + scn[j].z) + shn[j].z, o3 = xv[j * 4 + 3] * rs2 * wn[j].w * (1.f + scn[j].w) + shn[j].w;
                *(uint2*)(P.hbuf + (size_t)t * DM + d) = make_uint2(cvtpk(o0, o1), cvtpk(o2, o3));
            }
        }
    }
}

extern __shared__ __attribute__((aligned(16))) unsigned char dyn_lds[];
__device__ __forceinline__ void run_phase(const Params& P, LAS3 unsigned char* lds, int ph) {
    if (ph == PH_SETUP) { phase_setup(P, lds); return; }
    if (ph == PH_H0) { phase_h0(P, lds); return; }
    const int l = (ph - PH_LAYER0) / PH_PER_LAYER, s = (ph - PH_LAYER0) % PH_PER_LAYER;
    switch (s) {
    case L_GEMM_IN: { pg8::Gemm g{P.hbuf, P.w_in_t + (size_t)l * 2560 * 1024, TT, 2560, 1024, 0}; pg8::StaticOrder S; S.init(TT, 2560, gridDim.x, blockIdx.x);
        pg8::EpiBf16P E{P.pb, DIN, 0}; pg8::gemm_phase<pg8::EpiBf16P, pg8::StaticOrder, true, true>(lds, g, S, E); } break;
    case L_PREP: phase_prep(P, lds, l); break;
    case L_MIX: phase_mix(P, lds, l); break;
    case L_FINISH: phase_finish(P, lds, l); break;
    case L_GEMM_OUT: { pg8::Gemm g{P.ycatb, P.w_out_t + (size_t)l * 1024 * 1024, TT, 1024, 1024, 0}; pg8::EpiOut E{P.ob, P.osq};
        if (l == 0) { pg8::StaticOrder S; S.init(TT, 1024, gridDim.x, blockIdx.x); pg8::gemm_phase<pg8::EpiOut, pg8::StaticOrder, true, true>(lds, g, S, E); }
        else { pg8::LatOrder S; S.initl(1024, gridDim.x, blockIdx.x); pg8::gemm_phase<pg8::EpiOut, pg8::LatOrder, true, true>(lds, g, S, E); } } break;
    case L_POST: phase_post(P, lds, l); break;
    case L_SCATTER: phase_scatter(P, lds, l); break;
    case L_GEMM_GU: { pg8::Gemm g{P.fb, P.wgu_t + (size_t)l * NE * 2048 * 1024, 0, 2048, 1024, 0}; pg8::GroupedOrder S; S.initg(P.ntiles + l * 16, P.tile_e + l * 512, 2048, gridDim.x, blockIdx.x);
        pg8::EpiSwiglu E{P.act, P.moe_b_gate_up + (size_t)l * NE * 2048}; pg8::gemm_phase<pg8::EpiSwiglu, pg8::GroupedOrder, true, true, true>(lds, g, S, E, (const int*)P.xg); } break;
    case L_GEMM_DN: { pg8::Gemm g{P.act, P.wdn_t + (size_t)l * NE * 1024 * 1024, 0, 1024, 1024, 0}; pg8::GroupedOrder S; S.initg(P.ntiles + l * 16, P.tile_e + l * 512, 1024, gridDim.x, blockIdx.x);
        pg8::EpiDown E{P.yexp, P.moe_b_down + (size_t)l * NE * 1024}; pg8::gemm_phase<pg8::EpiDown, pg8::GroupedOrder, true, true>(lds, g, S, E); } break;
    case L_COMBINE: phase_combine(P, lds, l); break;
    }
}
__global__ void __launch_bounds__(512, 2) mk_fwd(Params Pk, int ph_lo, int ph_hi) {
    LAS3 unsigned char* lds = (LAS3 unsigned char*)dyn_lds;
    volatile LAS3 unsigned* st = (volatile LAS3 unsigned*)(lds + MK_LDS_MAIN);
    LAS3 Params* PL = (LAS3 Params*)(lds + MK_LDS_MAIN + 64);
    static_assert(sizeof(Params) <= 1024, "Params copy does not fit its LDS slot");
    if (threadIdx.x < 4) st[threadIdx.x] = 0u;
    if (threadIdx.x == 64) store_params(PL, Pk);
    unsigned* barw = Pk.bar;
    __syncthreads();
    XcdBarrier bar; bar.bar = barw; bar.x = 0; bar.st = st;
    if (ph_hi - ph_lo > 1) bar = xcd_barrier_post(barw, st);
#define MK_RUN(ph) if (ph_lo <= (ph) && (ph) < ph_hi) { { const LAS3 Params* PLo = PL; asm volatile("" : "+v"(PLo)); LAS3 unsigned char* ldsp = lds; asm volatile("" : "+s"(ldsp)); \
        const Params P = load_params(PLo); run_phase(P, ldsp, (ph)); } if ((ph) + 1 < ph_hi) xcd_barrier(bar); }
    MK_RUN(0) MK_RUN(1) MK_RUN(2) MK_RUN(3) MK_RUN(4) MK_RUN(5) MK_RUN(6) MK_RUN(7) MK_RUN(8) MK_RUN(9) MK_RUN(10) MK_RUN(11)
    MK_RUN(12) MK_RUN(13) MK_RUN(14) MK_RUN(15) MK_RUN(16) MK_RUN(17) MK_RUN(18) MK_RUN(19) MK_RUN(20) MK_RUN(21)
#undef MK_RUN
}

extern "C" void kernel_launch(void* const* d_in, const int* in_sizes, int n_in, void* d_out, int out_size, void* d_ws, size_t ws_size, hipStream_t stream) {
    Params P{};
    const float** pin = (const float**)&P;
    for (int i = 0; i < 35; ++i) pin[i] = (const float*)d_in[i];
    P.out = (float*)d_out;
    char* ws = (char*)d_ws; size_t off = 0;
    auto carve = [&](size_t bytes) { void* p = ws + off; off += (bytes + 255) & ~(size_t)255; return p; };
    const size_t ctl_bytes = XCD_BAR_WORDS * 4 + 256 + 256;
    P.bar = (unsigned*)carve(XCD_BAR_WORDS * 4); P.queue = (int*)carve(256); P.cnt = (int*)carve(256);
    P.tile_e = (int*)carve(2 * 512 * 4); P.ntiles = (int*)carve(2 * 16 * 4); P.offs = (int*)carve(2 * 32 * 4); P.blkcnt = (int*)carve(2 * 256 * 32 * 4);
    P.xall = (float*)carve((size_t)TT * DM * 4); P.mod = (float*)carve((size_t)2 * 9 * 6144 * 4); P.ropecs = (float*)carve((size_t)NS * 16 * 2 * 4); P.lamfull = (float*)carve(256);
    P.w_in_t = (bf16_t*)carve((size_t)2 * 2560 * 1024 * 2); P.w_out_t = (bf16_t*)carve((size_t)2 * 1024 * 1024 * 2);
    P.wgu_t = (bf16_t*)carve((size_t)2 * NE * 2048 * 1024 * 2); P.wdn_t = (bf16_t*)carve((size_t)2 * NE * 1024 * 1024 * 2);
    P.wq_t = (bf16_t*)carve((size_t)2 * 384 * 192 * 2); P.wkv_t = (bf16_t*)carve((size_t)2 * 512 * 128 * 2); P.wglu_t = (bf16_t*)carve((size_t)2 * 256 * 256 * 2);
    P.s5KmT = (bf16_t*)carve((size_t)64 * 16 * 1024 * 2); P.s5Smat = (bf16_t*)carve((size_t)64 * 128 * 1024 * 2); P.s5CmT = (bf16_t*)carve((size_t)64 * 16 * 128 * 2);
    P.s5A = (float*)carve(64 * 64 * 2 * 4); P.s5A64 = (float*)carve(64 * 64 * 2 * 4); P.s5xs = (float*)carve((size_t)256 * 36 * 128 * 4);
    P.hbuf = (bf16_t*)carve((size_t)TT * DM * 2); P.pb = (bf16_t*)carve((size_t)TT * DIN * 2);
    P.daQ = (bf16_t*)carve((size_t)TT * 256 * 2); P.daK = (bf16_t*)carve((size_t)TT * 256 * 2); P.daVt = (bf16_t*)carve((size_t)TT * 256 * 2);
    P.mQ = (bf16_t*)carve((size_t)TT * 384 * 2); P.mK = (bf16_t*)carve((size_t)TT * 384 * 2); P.mVt = (bf16_t*)carve((size_t)TT * 256 * 2);
    P.mlQ = (bf16_t*)carve((size_t)TT * 256 * 2); P.mlK = (bf16_t*)carve((size_t)TT * 256 * 2); P.mlKt = (bf16_t*)carve((size_t)TT * 256 * 2); P.mlVt = (bf16_t*)carve((size_t)TT * 256 * 2);
    P.mlG = (float*)carve((size_t)TT * 16 * 4); P.hdir = (float*)carve((size_t)2 * TT * 256 * 4); P.ys5 = (float*)carve((size_t)2 * TT * 256 * 4);
    P.ycatb = (bf16_t*)carve((size_t)TT * DM * 2); P.ob = (bf16_t*)carve((size_t)TT * DM * 2); P.osq = (float*)carve((size_t)TT * 16 * 4); P.fb = (bf16_t*)carve((size_t)TT * DM * 2);
    P.top_e = (int*)carve((size_t)NASSIGN * 4); P.top_g = (float*)carve((size_t)NASSIGN * 4); P.posb = (int*)carve((size_t)NASSIGN * 4); P.tok_slot = (int*)carve((size_t)NASSIGN * 4);
    P.xg = (bf16_t*)carve((size_t)MAXSLOTS * DM * 2); P.act = (bf16_t*)carve((size_t)MAXSLOTS * DM * 2); P.yexp = (bf16_t*)carve((size_t)MAXSLOTS * DM * 2);
    if (off > ws_size) { fprintf(stderr, "kernel_launch: workspace too small: need %zu have %zu\n", off, ws_size); return; }
    static bool attr_done = false;
    if (!attr_done) {
        if (hipFuncSetAttribute((const void*)mk_fwd, hipFuncAttributeMaxDynamicSharedMemorySize, MK_LDS_BYTES) != hipSuccess) fprintf(stderr, "kernel_launch: hipFuncSetAttribute failed\n");
        attr_done = true;
    }
    (void)hipMemsetAsync(d_ws, 0, ctl_bytes, stream);
#if MK_ONE_LAUNCH
    hipLaunchKernelGGL(mk_fwd, dim3(256), dim3(512), MK_LDS_BYTES, stream, P, 0, (int)PH_TOTAL);
#else
    for (int ph = 0; ph < PH_TOTAL; ++ph) hipLaunchKernelGGL(mk_fwd, dim3(256), dim3(512), MK_LDS_BYTES, stream, P, ph, ph + 1);
#endif
}
```

```cpp
#include <hip/hip_runtime.h>
#include <cstdint>
#include <cstdio>

#define NB 8
#define NS 2048
#define NC 256
#define NT 2304
#define TT (NB * NT)
#define DM 1024
#define DIN 2560
#define DINC 2416
#define NE 32
#define NASSIGN (TT * 4)
#define MAXSLOTS (NASSIGN + NE * 256)

#define P_DAQ 0
#define P_DAK 256
#define P_DAV 512
#define P_MLQK 768
#define P_MLV 1280
#define P_MLO 1536
#define P_MLG 1792
#define P_CQ 1808
#define P_CKV 2000
#define P_KR 2128
#define P_S5 2160

#ifndef MK_ONE_LAUNCH
#define MK_ONE_LAUNCH 1
#endif

typedef unsigned short bf16_t;
__device__ __forceinline__ float sigmoidf_(float x) { return __builtin_amdgcn_rcpf(1.f + __expf(-x)); }
__device__ __forceinline__ float siluf_(float x) { return x * __builtin_amdgcn_rcpf(1.f + __expf(-x)); }
__device__ __forceinline__ float logsigmoidf_(float x) { return fminf(x, 0.f) - log1pf(__expf(-fabsf(x))); }
__device__ __forceinline__ float gelu_tanh_(float x) { const float u = 0.7978845608028654f * (x + 0.044715f * x * x * x); return x * __builtin_amdgcn_rcpf(1.f + __expf(-2.f * u)); }
typedef __bf16 bf16x2_nat __attribute__((ext_vector_type(2)));
typedef float f32x2_nat __attribute__((ext_vector_type(2)));
__device__ __forceinline__ unsigned cvtpk(float lo, float hi) { const f32x2_nat v = {lo, hi}; const bf16x2_nat b = __builtin_convertvector(v, bf16x2_nat); return __builtin_bit_cast(unsigned, b); }
__device__ __forceinline__ bf16_t f2bf(float f) { return (bf16_t)(cvtpk(f, 0.f) & 0xFFFFu); }
__device__ __forceinline__ float bf2f(bf16_t b) { return __uint_as_float(((unsigned)b) << 16); }
__device__ __forceinline__ unsigned pk2bf(float lo, float hi) { return cvtpk(lo, hi); }
__device__ __forceinline__ int opaque_tid() { int t = threadIdx.x; asm volatile("" : "+v"(t)); return t; }
__device__ __forceinline__ float wave_sum(float v) {
#pragma unroll
    for (int o = 32; o > 0; o >>= 1) v += __shfl_xor(v, o);
    return v;
}
__device__ __forceinline__ int seq_token(int s, int dir) {
    if (dir == 0) return s;
    return (s < NC) ? (NC - 1 - s) : (NC + (NT - 1 - s));
}

namespace pg8 {
#define PG8_LAS __attribute__((address_space(3)))
typedef short bf16x8 __attribute__((ext_vector_type(8)));
typedef float f32x4 __attribute__((ext_vector_type(4)));
typedef unsigned u32x4 __attribute__((ext_vector_type(4)));
constexpr int BM = 256, BK = 64, HALF = 128, HTB = HALF * BK * 2, STAGE_BYTES = 8 * HTB, NXCD = 8, WGM = 8;
__host__ __device__ __forceinline__ int lds_byte(int r, int c) { const int st = (r >> 4) * 2 + (c >> 5), rr = r & 15, cc = c & 31, ob = rr * 64 + cc * 2; return st * 1024 + (ob ^ (((ob >> 9) & 1) << 5)); }
__host__ __device__ __forceinline__ void stage_rc(int b, int& R, int& C) { const int st = b / 1024, sb = b % 1024, swz = sb ^ (((sb >> 9) & 1) << 5); R = (st >> 1) * 16 + swz / 64; C = (st & 1) * 32 + (swz % 64) / 2; }
__host__ __device__ __forceinline__ int perm32(int rho) { const int n = rho >> 4, i = rho & 15; return 8 * (i >> 2) + 4 * n + (i & 3); }
struct Unit { int pm, pn; };
struct Gemm { const bf16_t* A; const bf16_t* Bt; int M, N, K, pad; };
__device__ __forceinline__ unsigned cvt_pk_bf16(float lo, float hi) { return cvtpk(lo, hi); }

struct StaticOrder {
    int nM, nN, nwg, G, c;
    __device__ void init(int M, int N, int G_, int c_) { nM = M / BM; nN = N / BM; nwg = nM * nN; G = G_; c = c_; }
    __device__ bool next(int i, Unit& u) const {
        const long L = (long)i * G + c; if (L >= nwg) return false;
        int wgid = (int)L; { const int q = nwg / NXCD, r = nwg % NXCD, xcd = wgid % NXCD, off = wgid / NXCD; wgid = (xcd < r ? xcd * (q + 1) : r * (q + 1) + (xcd - r) * q) + off; }
        const int nig = WGM * nN, gid = wgid / nig, fm = gid * WGM, gsz = (nM - fm) < WGM ? (nM - fm) : WGM;
        u.pm = fm + ((wgid % nig) % gsz); u.pn = (wgid % nig) / gsz; return true;
    }
    __device__ __forceinline__ void a_ready(const Unit&) const {}
    __device__ __forceinline__ void done(const Unit&) const {}
};
struct LatOrder : StaticOrder {
    __device__ void initl(int N, int G_, int c_) { nM = 64; nN = N / BM; nwg = nM * nN; G = G_; c = c_; }
    __device__ bool next(int i, Unit& u) const { if (!StaticOrder::next(i, u)) return false; u.pm = (u.pm >> 3) * 9 + 1 + (u.pm & 7); return true; }
};
struct GroupedOrder : StaticOrder {
    const int* tile_e;
    __device__ void initg(const int* ntiles_p, const int* tile_e_, int N, int G_, int c_) { nM = ntiles_p[0]; nN = N / BM; nwg = nM * nN; G = G_; c = c_; tile_e = tile_e_; }
    __device__ bool next(int i, Unit& u) const { if (!StaticOrder::next(i, u)) return false; u.pn += tile_e[u.pm] * nN; return true; }
};

struct EpiBf16P {
    static constexpr bool PERM = true;
    bf16_t* O; int ldc, pad;
    __device__ __forceinline__ void operator()(const f32x4 (&acc)[2][2][4][2], const Unit& u, int wr, int wc, int fr, int fq) const {
        const int row0 = u.pm * BM + wr * 64 + fr, col0 = u.pn * BM + wc * 32 + 8 * fq;
#pragma unroll
        for (int ai = 0; ai < 2; ++ai)
#pragma unroll
            for (int m = 0; m < 4; ++m) { bf16_t* rowp = O + (size_t)(row0 + ai * HALF + m * 16) * ldc + col0;
#pragma unroll
                for (int bj = 0; bj < 2; ++bj) { const f32x4 v0 = acc[ai][bj][m][0], v1 = acc[ai][bj][m][1];
                    u32x4 w; w.x = cvt_pk_bf16(v0[0], v0[1]); w.y = cvt_pk_bf16(v0[2], v0[3]); w.z = cvt_pk_bf16(v1[0], v1[1]); w.w = cvt_pk_bf16(v1[2], v1[3]);
                    *(u32x4*)(rowp + bj * HALF) = w; } }
    }
};
struct EpiOut {
    static constexpr bool PERM = true;
    bf16_t* O; float* osq;
    __device__ __forceinline__ void operator()(const f32x4 (&acc)[2][2][4][2], const Unit& u, int wr, int wc, int fr, int fq) const {
        const int row0 = u.pm * BM + wr * 64 + fr, col0 = u.pn * BM + wc * 32 + 8 * fq;
#pragma unroll
        for (int ai = 0; ai < 2; ++ai)
#pragma unroll
            for (int m = 0; m < 4; ++m) { const int row = row0 + ai * HALF + m * 16; bf16_t* rowp = O + (size_t)row * 1024 + col0; float ss = 0.f;
#pragma unroll
                for (int bj = 0; bj < 2; ++bj) { const f32x4 v0 = acc[ai][bj][m][0], v1 = acc[ai][bj][m][1];
                    ss += (v0[0] * v0[0] + v0[1] * v0[1]) + (v0[2] * v0[2] + v0[3] * v0[3]) + (v1[0] * v1[0] + v1[1] * v1[1]) + (v1[2] * v1[2] + v1[3] * v1[3]);
                    u32x4 w; w.x = cvt_pk_bf16(v0[0], v0[1]); w.y = cvt_pk_bf16(v0[2], v0[3]); w.z = cvt_pk_bf16(v1[0], v1[1]); w.w = cvt_pk_bf16(v1[2], v1[3]);
                    *(u32x4*)(rowp + bj * HALF) = w; }
                ss += __shfl_xor(ss, 16); ss += __shfl_xor(ss, 32);
                if (fq == 0) osq[(size_t)row * 16 + u.pn * 4 + wc] = ss; }
    }
};
struct EpiDown {
    static constexpr bool PERM = true;
    bf16_t* C; const float* bias;
    __device__ __forceinline__ void operator()(const f32x4 (&acc)[2][2][4][2], const Unit& u, int wr, int wc, int fr, int fq) const {
        const int e = u.pn >> 2, pnl = u.pn & 3;
        const int row0 = u.pm * BM + wr * 64 + fr, col0 = pnl * BM + wc * 32 + 8 * fq;
        const float* bp = bias + (size_t)e * 1024 + col0;
        f32x4 bv[2][2];
#pragma unroll
        for (int bj = 0; bj < 2; ++bj)
#pragma unroll
            for (int n = 0; n < 2; ++n) bv[bj][n] = *(const f32x4*)(bp + bj * HALF + 4 * n);
#pragma unroll
        for (int ai = 0; ai < 2; ++ai)
#pragma unroll
            for (int m = 0; m < 4; ++m) { bf16_t* rowp = C + (size_t)(row0 + ai * HALF + m * 16) * 1024 + col0;
#pragma unroll
                for (int bj = 0; bj < 2; ++bj) { const f32x4 v0 = acc[ai][bj][m][0] + bv[bj][0], v1 = acc[ai][bj][m][1] + bv[bj][1];
                    u32x4 w; w.x = cvt_pk_bf16(v0[0], v0[1]); w.y = cvt_pk_bf16(v0[2], v0[3]); w.z = cvt_pk_bf16(v1[0], v1[1]); w.w = cvt_pk_bf16(v1[2], v1[3]);
                    *(u32x4*)(rowp + bj * HALF) = w; } }
    }
};
struct EpiSwiglu {
    static constexpr bool PERM = true;
    bf16_t* O; const float* bias;
    __device__ __forceinline__ void operator()(const f32x4 (&acc)[2][2][4][2], const Unit& u, int wr, int wc, int fr, int fq) const {
        const int e = u.pn >> 3, pnl = u.pn & 7;
        const int row0 = u.pm * BM + wr * 64 + fr, col0 = pnl * HALF + wc * 32 + 8 * fq;
        const float* bp = bias + (size_t)e * 2048 + col0;
        f32x4 bg[2], bu[2];
#pragma unroll
        for (int n = 0; n < 2; ++n) { bg[n] = *(const f32x4*)(bp + 4 * n); bu[n] = *(const f32x4*)(bp + 1024 + 4 * n) + 1.0f; }
#pragma unroll
        for (int ai = 0; ai < 2; ++ai)
#pragma unroll
            for (int m = 0; m < 4; ++m) {
                bf16_t* rowp = O + (size_t)(row0 + ai * HALF + m * 16) * 1024 + col0;
                float r[8];
#pragma unroll
                for (int n = 0; n < 2; ++n) {
                    const f32x4 g = acc[ai][0][m][n] + bg[n], up = acc[ai][1][m][n] + bu[n];
                    const f32x4 gt = __builtin_elementwise_min(g, (f32x4){7.f, 7.f, 7.f, 7.f});
                    const f32x4 uu = __builtin_elementwise_min(__builtin_elementwise_max(up, (f32x4){-6.f, -6.f, -6.f, -6.f}), (f32x4){8.f, 8.f, 8.f, 8.f});
                    const f32x4 z = gt * (-1.702f * 1.4426950408889634f);
                    f32x4 e; e[0] = __builtin_amdgcn_exp2f(z[0]); e[1] = __builtin_amdgcn_exp2f(z[1]); e[2] = __builtin_amdgcn_exp2f(z[2]); e[3] = __builtin_amdgcn_exp2f(z[3]);
                    const f32x4 d = e + 1.0f;
                    f32x4 rc; rc[0] = __builtin_amdgcn_rcpf(d[0]); rc[1] = __builtin_amdgcn_rcpf(d[1]); rc[2] = __builtin_amdgcn_rcpf(d[2]); rc[3] = __builtin_amdgcn_rcpf(d[3]);
                    const f32x4 o = (uu * gt) * rc;
                    r[n * 4] = o[0]; r[n * 4 + 1] = o[1]; r[n * 4 + 2] = o[2]; r[n * 4 + 3] = o[3];
                }
                u32x4 w; w.x = cvt_pk_bf16(r[0], r[1]); w.y = cvt_pk_bf16(r[2], r[3]); w.z = cvt_pk_bf16(r[4], r[5]); w.w = cvt_pk_bf16(r[6], r[7]);
                *(u32x4*)rowp = w;
            }
    }
};

template <class Epi, class Sched, bool ALIGN_EPI = false, bool SP2 = false, bool GATHER = false>
__device__ __forceinline__ void gemm_phase(PG8_LAS unsigned char* lds, const Gemm g, const Sched& S, const Epi& E, const int* rowtok = nullptr) {
    static_assert(!GATHER || SP2, "gather staging is wired into the SP2 loop only");
    const int tid = opaque_tid(), wid = __builtin_amdgcn_readfirstlane(tid >> 6), lane = tid & 63, wr = wid >> 2, wc = wid & 3, fr = lane & 15, fq = lane >> 4;
    const int K = g.K, nt = K / BK;
    unsigned voffA[2], voffB[2];
#pragma unroll
    for (int i = 0; i < 2; ++i) { int R, C; stage_rc(tid * 16 + i * 8192, R, C); const int Rb = Epi::PERM ? ((R & ~31) + perm32(R & 31)) : R;
        voffA[i] = (unsigned)(R * K + C) * 2u; voffB[i] = (unsigned)(Rb * K + C) * 2u; }
    int gR[2], gC[2];
#pragma unroll
    for (int i = 0; i < 2; ++i) stage_rc(tid * 16 + i * 8192, gR[i], gC[i]);
    PG8_LAS int* rt = (PG8_LAS int*)(lds + STAGE_BYTES);
    unsigned gaC[2][2] = {{0u, 0u}, {0u, 0u}}, gaN[2][2] = {{0u, 0u}, {0u, 0u}};
    const size_t kstep = (size_t)(BK * 2);
    const size_t hstep = (size_t)HALF * K * 2;
    const size_t tstep = 2 * hstep;
    const unsigned ldsw = (unsigned)wid * 1024u;
    const int aoff = lds_byte(wr * 64 + fr, fq * 8), boff = lds_byte(wc * 32 + fr, fq * 8);
#define PG8_SA(b, h) (((b) * 2 + (h)) * HTB)
#define PG8_SB(b, h) ((4 + (b) * 2 + (h)) * HTB)
#define PG8_STAGE(bufoff, gbase, voff) do { _Pragma("unroll") for (int _i = 0; _i < 2; ++_i) \
        __builtin_amdgcn_global_load_lds((const unsigned*)((const char*)(gbase) + (voff)[_i]), (PG8_LAS unsigned*)(lds + (bufoff) + ldsw + _i * 8192), 16, 0, 0); } while (0)
#define PG8_GOFF(dst, k) do { _Pragma("unroll") for (int h_ = 0; h_ < 2; ++h_) _Pragma("unroll") for (int i_ = 0; i_ < 2; ++i_) dst[h_][i_] = (unsigned)(rt[(k) * 256 + h_ * HALF + gR[i_]] * K + gC[i_]) * 2u; } while (0)
#define PG8_STAGE_A(bufoff, ptr, un, h, kb) do { if constexpr (GATHER) { const unsigned o0_ = (un) ? gaN[h][0] : gaC[h][0], o1_ = (un) ? gaN[h][1] : gaC[h][1]; \
        __builtin_amdgcn_global_load_lds((const unsigned*)((const char*)g.A + (kb) + o0_), (PG8_LAS unsigned*)(lds + (bufoff) + ldsw), 16, 0, 0); \
        __builtin_amdgcn_global_load_lds((const unsigned*)((const char*)g.A + (kb) + o1_), (PG8_LAS unsigned*)(lds + (bufoff) + ldsw + 8192), 16, 0, 0); } else PG8_STAGE(bufoff, ptr, voffA); } while (0)
#define PG8_LDA(dst, b, h) do { _Pragma("unroll") for (int m = 0; m < 4; ++m) _Pragma("unroll") for (int k = 0; k < 2; ++k) dst[m][k] = *(const PG8_LAS bf16x8*)(lds + PG8_SA(b, h) + aoff + m * 2048 + k * 1024); } while (0)
#define PG8_LDB(dst, b, h) do { _Pragma("unroll") for (int n = 0; n < 2; ++n) _Pragma("unroll") for (int k = 0; k < 2; ++k) dst[n][k] = *(const PG8_LAS bf16x8*)(lds + PG8_SB(b, h) + boff + n * 2048 + k * 1024); } while (0)
#define PG8_MMA(ai, bj, At, Bt) do { __builtin_amdgcn_s_setprio(1); _Pragma("unroll") for (int m = 0; m < 4; ++m) _Pragma("unroll") for (int n = 0; n < 2; ++n) _Pragma("unroll") for (int k = 0; k < 2; ++k) \
        acc[ai][bj][m][n] = __builtin_amdgcn_mfma_f32_16x16x32_bf16(Bt[n][k], At[m][k], acc[ai][bj][m][n], 0, 0, 0); __builtin_amdgcn_s_setprio(0); } while (0)
#define PG8_WAIT_V(n) asm volatile("s_waitcnt vmcnt(" #n ")" ::: "memory")
#define PG8_WAIT_L(n) asm volatile("s_waitcnt lgkmcnt(" #n ")" ::: "memory")
#define PG8_BAR __builtin_amdgcn_s_barrier()
#define PG8_SCHED __builtin_amdgcn_sched_barrier(0)
    Unit cur, nxt; int ui = 0;
    if (!S.next(0, cur)) return;
    f32x4 acc[2][2][4][2];
#pragma unroll
    for (int a = 0; a < 2; ++a)
#pragma unroll
        for (int b = 0; b < 2; ++b)
#pragma unroll
            for (int m = 0; m < 4; ++m)
#pragma unroll
                for (int n = 0; n < 2; ++n) acc[a][b][m][n] = (f32x4){0.f, 0.f, 0.f, 0.f};
    bf16x8 At[4][2], B0[2][2], B1[2][2];
    const char* cA = (const char*)g.A + (size_t)cur.pm * tstep; const char* cB = (const char*)g.Bt + (size_t)cur.pn * tstep;
    S.a_ready(cur);
    if constexpr (GATHER) {
        PG8_LAS int* pms = rt + 16 * 256;
        if (tid < 16) { Unit u_; pms[tid] = S.next(tid, u_) ? u_.pm : -1; }
        __syncthreads();
        {
            int tok[8];
#pragma unroll
            for (int j = 0; j < 8; ++j) { const int k = 2 * j + (tid >> 8), pm = pms[k]; tok[j] = (pm >= 0) ? rowtok[pm * 256 + (tid & 255)] : 0; }
#pragma unroll
            for (int j = 0; j < 8; ++j) rt[(2 * j + (tid >> 8)) * 256 + (tid & 255)] = tok[j];
        }
        __syncthreads();
        PG8_GOFF(gaC, 0);
    }
    if constexpr (SP2) {
        PG8_STAGE(PG8_SB(0, 0), cB, voffB); PG8_STAGE(PG8_SB(0, 1), cB + hstep, voffB); PG8_STAGE_A(PG8_SA(0, 0), cA, false, 0, (size_t)0); PG8_STAGE_A(PG8_SA(0, 1), cA + hstep, false, 1, (size_t)0);
        if (wr == 1) PG8_BAR;
        PG8_WAIT_V(2); PG8_BAR;
        PG8_STAGE(PG8_SB(1, 0), cB + kstep, voffB); PG8_STAGE_A(PG8_SA(1, 0), cA + kstep, false, 0, kstep); PG8_STAGE(PG8_SB(1, 1), cB + hstep + kstep, voffB);
        PG8_WAIT_V(6); PG8_BAR;
    } else {
        PG8_STAGE(PG8_SB(0, 0), cB, voffB); PG8_STAGE(PG8_SA(0, 0), cA, voffA); PG8_STAGE(PG8_SB(0, 1), cB + hstep, voffB); PG8_STAGE(PG8_SA(0, 1), cA + hstep, voffA);
        if (wr == 1) PG8_BAR;
        PG8_WAIT_V(4); PG8_BAR;
        PG8_STAGE(PG8_SB(1, 0), cB + kstep, voffB); PG8_STAGE(PG8_SA(1, 0), cA + kstep, voffA); PG8_STAGE(PG8_SB(1, 1), cB + hstep + kstep, voffB);
        PG8_WAIT_V(6); PG8_BAR;
    }
    for (;;) {
        const bool has_next = S.next(ui + 1, nxt);
        if constexpr (GATHER) { if (has_next) PG8_GOFF(gaN, ui + 1); }
        const char* nA = has_next ? (const char*)g.A + (size_t)nxt.pm * tstep : cA; const char* nB = has_next ? (const char*)g.Bt + (size_t)nxt.pn * tstep : cB;
        for (int t = 0; t < nt; t += 2) {
            const bool last = (t == nt - 2);
            const char* a1 = cA + (size_t)(t + 1) * kstep;
            const char* a2 = last ? nA : cA + (size_t)(t + 2) * kstep; const char* b2 = last ? nB : cB + (size_t)(t + 2) * kstep;
            const char* a3 = a2 + kstep; const char* b3 = b2 + kstep;
            if (last && has_next) S.a_ready(nxt);
            const bool un = last && has_next; const size_t k1 = (size_t)(t + 1) * kstep, k2 = last ? (size_t)0 : (size_t)(t + 2) * kstep;
            if constexpr (SP2) {
            PG8_LDB(B0, 0, 0); PG8_LDB(B1, 0, 1); PG8_SCHED; PG8_LDA(At, 0, 0); PG8_STAGE_A(PG8_SA(1, 1), a1 + hstep, false, 1, k1);
            PG8_WAIT_V(8); PG8_WAIT_L(0); PG8_BAR; PG8_MMA(0, 0, At, B0); PG8_MMA(0, 1, At, B1); PG8_BAR; PG8_SCHED;
            PG8_LDA(At, 0, 1); PG8_STAGE(PG8_SB(0, 0), b2, voffB); PG8_STAGE(PG8_SB(0, 1), b2 + hstep, voffB); PG8_STAGE_A(PG8_SA(0, 0), a2, un, 0, k2);
            PG8_WAIT_V(8); PG8_WAIT_L(0); PG8_BAR; PG8_MMA(1, 0, At, B0); PG8_MMA(1, 1, At, B1); PG8_BAR; PG8_SCHED;
            PG8_LDB(B0, 1, 0); PG8_LDB(B1, 1, 1); PG8_SCHED; PG8_LDA(At, 1, 0); PG8_STAGE_A(PG8_SA(0, 1), a2 + hstep, un, 1, k2);
            PG8_WAIT_V(8); PG8_WAIT_L(0); PG8_BAR; PG8_MMA(0, 0, At, B0); PG8_MMA(0, 1, At, B1); PG8_BAR; PG8_SCHED;
            PG8_LDA(At, 1, 1); PG8_STAGE(PG8_SB(1, 0), b3, voffB); PG8_STAGE(PG8_SB(1, 1), b3 + hstep, voffB); PG8_STAGE_A(PG8_SA(1, 0), a3, un, 0, k2 + kstep);
            PG8_WAIT_V(8); PG8_WAIT_L(0); PG8_BAR; PG8_MMA(1, 0, At, B0); PG8_MMA(1, 1, At, B1); PG8_BAR; PG8_SCHED;
            } else {
            PG8_LDB(B0, 0, 0); PG8_SCHED; PG8_LDA(At, 0, 0); PG8_STAGE(PG8_SA(1, 1), a1 + hstep, voffA);
            PG8_WAIT_L(8); PG8_BAR; PG8_WAIT_L(0); PG8_MMA(0, 0, At, B0); PG8_BAR; PG8_SCHED;
            PG8_LDB(B1, 0, 1); PG8_STAGE(PG8_SB(0, 0), b2, voffB);
            PG8_BAR; PG8_WAIT_L(0); PG8_MMA(0, 1, At, B1); PG8_BAR;
            PG8_LDA(At, 0, 1); PG8_STAGE(PG8_SA(0, 0), a2, voffA);
            PG8_BAR; PG8_WAIT_L(0); PG8_MMA(1, 0, At, B0); PG8_BAR; PG8_SCHED;
            PG8_STAGE(PG8_SB(0, 1), b2 + hstep, voffB);
            PG8_WAIT_V(6); PG8_BAR; PG8_MMA(1, 1, At, B1); PG8_BAR;
            PG8_LDB(B0, 1, 0); PG8_SCHED; PG8_LDA(At, 1, 0); PG8_STAGE(PG8_SA(0, 1), a2 + hstep, voffA);
            PG8_WAIT_L(8); PG8_BAR; PG8_WAIT_L(0); PG8_MMA(0, 0, At, B0); PG8_BAR; PG8_SCHED;
            PG8_LDB(B1, 1, 1); PG8_STAGE(PG8_SB(1, 0), b3, voffB);
            PG8_BAR; PG8_WAIT_L(0); PG8_MMA(0, 1, At, B1); PG8_BAR;
            PG8_LDA(At, 1, 1); PG8_STAGE(PG8_SA(1, 0), a3, voffA);
            PG8_BAR; PG8_WAIT_L(0); PG8_MMA(1, 0, At, B0); PG8_BAR; PG8_SCHED;
            PG8_STAGE(PG8_SB(1, 1), b3 + hstep, voffB);
            PG8_WAIT_V(6); PG8_BAR; PG8_MMA(1, 1, At, B1); PG8_BAR;
            }
        }
        if constexpr (ALIGN_EPI) { if (wr == 0) PG8_BAR; }
        E(acc, cur, wr, wc, fr, fq); S.done(cur);
        if (!has_next) break;
#pragma unroll
        for (int a = 0; a < 2; ++a)
#pragma unroll
            for (int b = 0; b < 2; ++b)
#pragma unroll
                for (int m = 0; m < 4; ++m)
#pragma unroll
                    for (int n = 0; n < 2; ++n) acc[a][b][m][n] = (f32x4){0.f, 0.f, 0.f, 0.f};
        cur = nxt; cA = nA; cB = nB; ++ui;
        if constexpr (GATHER) { gaC[0][0] = gaN[0][0]; gaC[0][1] = gaN[0][1]; gaC[1][0] = gaN[1][0]; gaC[1][1] = gaN[1][1]; }
        if constexpr (ALIGN_EPI) { if (wr == 1) PG8_BAR; }
    }
    PG8_WAIT_V(0);
    if constexpr (!ALIGN_EPI) { if (wr == 0) PG8_BAR; }
    PG8_BAR;
#undef PG8_SA
#undef PG8_SB
#undef PG8_STAGE
#undef PG8_LDA
#undef PG8_GOFF
#undef PG8_STAGE_A
#undef PG8_LDB
#undef PG8_MMA
#undef PG8_WAIT_V
#undef PG8_WAIT_L
#undef PG8_BAR
#undef PG8_SCHED
}
}

typedef short bf16x8_t __attribute__((ext_vector_type(8)));
typedef float f32x16_t __attribute__((ext_vector_type(16)));
typedef float f32x2_t __attribute__((ext_vector_type(2)));
typedef unsigned u32x4_t __attribute__((ext_vector_type(4)));
typedef unsigned u32x2_t __attribute__((ext_vector_type(2)));
#define LAS3 __attribute__((address_space(3)))
constexpr int ATT_VROW = 68;
constexpr int ATT_LDS_BYTES = 3 * (64 * 104 * 2 + 64 * ATT_VROW * 2);

template <int QKD, int NMAP, bool DA>
__device__ __forceinline__ void attn_item(LAS3 unsigned char* lds, const bf16_t* __restrict__ Qb, const bf16_t* __restrict__ Kb, const bf16_t* __restrict__ Vt,
                                          bf16_t* __restrict__ ycatb, int ycat_off, int b, int h, int qblk, float lam, const float* __restrict__ subln, float post_scale) {
    constexpr int DK = QKD / NMAP, KS = DK / 16, KROW = QKD + 8, KCH = QKD / 8;
    constexpr int KBYTES = 64 * KROW * 2, VBYTES = 64 * ATT_VROW * 2, BUFB = KBYTES + VBYTES;
    const int tid = opaque_tid(), wid = tid >> 6, lane = tid & 63, r = lane & 31, hh = lane >> 5;
    const int q0 = qblk * 256, ntiles = (qblk == 0) ? (NC / 64) : (NT / 64);
    const size_t base = ((size_t)b * 4 + h) * NT;
    bf16x8_t qf[NMAP][KS];
#pragma unroll
    for (int m = 0; m < NMAP; ++m)
#pragma unroll
        for (int ks = 0; ks < KS; ++ks) qf[m][ks] = *(const bf16x8_t*)(Qb + (base + q0 + 32 * wid + r) * QKD + m * DK + 16 * ks + 8 * hh);
    f32x16_t O[NMAP][2]; float mrun[NMAP], lrun[NMAP];
#pragma unroll
    for (int m = 0; m < NMAP; ++m) { mrun[m] = 0.f; lrun[m] = 0.f;
#pragma unroll
        for (int d2 = 0; d2 < 2; ++d2)
#pragma unroll
            for (int i = 0; i < 16; ++i) O[m][d2][i] = 0.f; }
    constexpr int NKC = 64 * KCH;
    const bf16_t* kg = Kb + base * QKD;
    const bf16_t* vg = Vt + ((size_t)(b * 4 + h) * 64 + (tid >> 3)) * NT + (tid & 7) * 8;
    u32x4_t rk0, rk1 = (u32x4_t){0u, 0u, 0u, 0u}, rv;
    const int kc1 = tid + 512;
    const int k0row = tid / KCH, k0col = tid % KCH, k1row = kc1 / KCH, k1col = kc1 % KCH;
#define ATT_LOAD(j) do { rk0 = *(const u32x4_t*)(kg + (size_t)(j) * 64 * QKD + tid * 8); if (NKC > 512 && kc1 < NKC) rk1 = *(const u32x4_t*)(kg + (size_t)(j) * 64 * QKD + kc1 * 8); \
        rv = *(const u32x4_t*)(vg + (size_t)(j) * 64); } while (0)
#define ATT_STORE(buf) do { LAS3 unsigned char* kb_ = lds + (buf) * BUFB; LAS3 unsigned char* vb_ = kb_ + KBYTES; \
        *(LAS3 u32x4_t*)(kb_ + (k0row * KROW + k0col * 8) * 2) = rk0; if (NKC > 512 && kc1 < NKC) *(LAS3 u32x4_t*)(kb_ + (k1row * KROW + k1col * 8) * 2) = rk1; \
        LAS3 unsigned char* vd_ = vb_ + ((tid >> 3) * ATT_VROW + (tid & 7) * 8) * 2; *(LAS3 u32x2_t*)vd_ = (u32x2_t){rv.x, rv.y}; *(LAS3 u32x2_t*)(vd_ + 8) = (u32x2_t){rv.z, rv.w}; } while (0)
    __syncthreads();
    ATT_LOAD(0); ATT_STORE(0);
    if (ntiles > 1) ATT_LOAD(1);
    __syncthreads();
    bf16x8_t pf[NMAP][2][2];
#define ATT_PV(m_, vb_) do { _Pragma("unroll") for (int d2 = 0; d2 < 2; ++d2) _Pragma("unroll") for (int kt = 0; kt < 2; ++kt) _Pragma("unroll") for (int s2 = 0; s2 < 2; ++s2) { \
        const LAS3 unsigned char* vp = (vb_) + ((d2 * 32 + r) * ATT_VROW + kt * 32 + 16 * s2 + 4 * hh) * 2; \
        union { u32x2_t u[2]; bf16x8_t v; } av; av.u[0] = *(const LAS3 u32x2_t*)vp; av.u[1] = *(const LAS3 u32x2_t*)(vp + 16); \
        O[m_][d2] = __builtin_amdgcn_mfma_f32_32x32x16_bf16(av.v, pf[m_][kt][s2], O[m_][d2], 0, 0, 0); } } while (0)
    int sl = 0;
    for (int j = 0; j < ntiles; ++j) {
        const LAS3 unsigned char* kb = lds + sl * BUFB;
        const LAS3 unsigned char* vbp = lds + ((sl == 0) ? 2 : sl - 1) * BUFB + KBYTES;
#pragma unroll
        for (int m = 0; m < NMAP; ++m) {
            f32x16_t S[2];
            const float nm = -mrun[m];
#pragma unroll
            for (int kt = 0; kt < 2; ++kt) {
#pragma unroll
                for (int i = 0; i < 16; ++i) S[kt][i] = nm;
#pragma unroll
                for (int ks = 0; ks < KS; ++ks) {
                    const bf16x8_t a = *(const LAS3 bf16x8_t*)(kb + ((kt * 32 + r) * KROW + m * DK + 16 * ks + 8 * hh) * 2);
                    S[kt] = __builtin_amdgcn_mfma_f32_32x32x16_bf16(a, qf[m][ks], S[kt], 0, 0, 0);
                }
            }
            if (j > 0) ATT_PV(m, vbp);
            float mx = S[0][0];
#pragma unroll
            for (int i = 1; i < 16; ++i) mx = fmaxf(mx, S[0][i]);
#pragma unroll
            for (int i = 0; i < 16; ++i) mx = fmaxf(mx, S[1][i]);
            mx = fmaxf(mx, __shfl_xor(mx, 32));
            if (j == 0 || !__all(mx <= 8.f)) {
                const float dl = (j == 0) ? mx : fmaxf(mx, 0.f);
                mrun[m] += dl;
#pragma unroll
                for (int kt = 0; kt < 2; ++kt)
#pragma unroll
                    for (int i = 0; i < 16; ++i) S[kt][i] -= dl;
                if (j != 0) {
                    const float alpha = __builtin_amdgcn_exp2f(-dl);
                    lrun[m] *= alpha;
#pragma unroll
                    for (int d2 = 0; d2 < 2; ++d2)
#pragma unroll
                        for (int i = 0; i < 16; ++i) O[m][d2][i] *= alpha;
                }
            }
            f32x2_t ps2 = (f32x2_t){0.f, 0.f};
#pragma unroll
            for (int kt = 0; kt < 2; ++kt) {
#pragma unroll
                for (int i = 0; i < 16; i += 2) { const float p0 = __builtin_amdgcn_exp2f(S[kt][i]), p1 = __builtin_amdgcn_exp2f(S[kt][i + 1]); S[kt][i] = p0; S[kt][i + 1] = p1; ps2 += (f32x2_t){p0, p1}; }
#pragma unroll
                for (int s2 = 0; s2 < 2; ++s2) {
                    union { unsigned u[4]; bf16x8_t v; } cv;
#pragma unroll
                    for (int jj = 0; jj < 4; ++jj) cv.u[jj] = cvtpk(S[kt][8 * s2 + 2 * jj], S[kt][8 * s2 + 2 * jj + 1]);
                    pf[m][kt][s2] = cv.v;
                }
            }
            lrun[m] += ps2[0] + ps2[1];
        }
        const int sn = (sl == 2) ? 0 : sl + 1;
        if (j + 1 < ntiles) { ATT_STORE(sn); if (j + 2 < ntiles) ATT_LOAD(j + 2); }
        __syncthreads();
        sl = sn;
    }
    {
        const LAS3 unsigned char* vbl = lds + ((sl == 0) ? 2 : sl - 1) * BUFB + KBYTES;
#pragma unroll
        for (int m = 0; m < NMAP; ++m) ATT_PV(m, vbl);
    }
#undef ATT_PV
#undef ATT_LOAD
#undef ATT_STORE
    float inv[NMAP];
#pragma unroll
    for (int m = 0; m < NMAP; ++m) { const float lt = lrun[m] + __shfl_xor(lrun[m], 32); inv[m] = __builtin_amdgcn_rcpf(lt); }
    if (NMAP == 2) inv[NMAP - 1] *= -lam;
    float ss = 0.f;
#pragma unroll
    for (int d2 = 0; d2 < 2; ++d2)
#pragma unroll
        for (int i = 0; i < 16; ++i) {
            float o = O[0][d2][i] * inv[0];
            if (NMAP == 2) o += O[NMAP - 1][d2][i] * inv[NMAP - 1];
            O[0][d2][i] = o; ss += o * o;
        }
    float rs = 1.f;
    if (DA) { ss += __shfl_xor(ss, 32); rs = rsqrtf(ss * (1.f / 64.f) + 1e-6f) * post_scale; }
    bf16_t* yp = ycatb + ((size_t)b * NT + q0 + 32 * wid + r) * DM + ycat_off + h * 64;
#pragma unroll
    for (int d2 = 0; d2 < 2; ++d2)
#pragma unroll
        for (int g4 = 0; g4 < 4; ++g4) {
            const int dv = 32 * d2 + 8 * g4 + 4 * hh;
            float o0 = O[0][d2][4 * g4] * rs, o1 = O[0][d2][4 * g4 + 1] * rs, o2 = O[0][d2][4 * g4 + 2] * rs, o3 = O[0][d2][4 * g4 + 3] * rs;
            if (DA) { const float4 w = *(const float4*)(subln + dv); o0 *= w.x; o1 *= w.y; o2 *= w.z; o3 *= w.w; }
            *(uint2*)(yp + dv) = make_uint2(cvtpk(o0, o1), cvtpk(o2, o3));
        }
}


typedef float f32x4_t __attribute__((ext_vector_type(4)));
constexpr int ML_KROW = 72, ML_TROW = 136, ML_CROW = 72;
constexpr int ML_OFF_KC = 0, ML_OFF_KT = ML_OFF_KC + 128 * ML_KROW * 2, ML_OFF_VT = ML_OFF_KT + 64 * ML_TROW * 2, ML_OFF_CB = ML_OFF_VT + 80 * ML_TROW * 2,
              ML_OFF_F = ML_OFF_CB + 80 * ML_CROW * 2, ML_LDS_BYTES = ML_OFF_F + 6 * 128 * 4 + 64;
__device__ __forceinline__ void mlstm_item(LAS3 unsigned char* lds, const bf16_t* __restrict__ Qb, const bf16_t* __restrict__ Kb, const bf16_t* __restrict__ Ktg, const bf16_t* __restrict__ Vtg,
                                           const float* __restrict__ G, float* __restrict__ hdir, int b, int h, int dir) {
    const int tid = opaque_tid(), wid = tid >> 6, lane = tid & 63, lr = lane & 15, q = lane >> 4;
    LAS3 unsigned char* Kc = lds + ML_OFF_KC; LAS3 unsigned char* Kt = lds + ML_OFF_KT; LAS3 unsigned char* Vt = lds + ML_OFF_VT; LAS3 unsigned char* Cb = lds + ML_OFF_CB;
    LAS3 float* fl = (LAS3 float*)(lds + ML_OFF_F);
    LAS3 float* s_li = fl; LAS3 float* s_lf = fl + 128; LAS3 float* s_bc2 = fl + 256; LAS3 float* s_gk2 = fl + 384; LAS3 float* s_wu = fl + 512; LAS3 float* s_et = fl + 640; LAS3 float* s_misc = fl + 768;
    const size_t base = ((size_t)b * 4 + h) * NT;
    __syncthreads();
    for (int i = tid; i < 80 * ML_CROW / 2; i += 512) ((LAS3 unsigned*)Cb)[i] = 0u;
    for (int i = tid; i < 16 * ML_TROW / 2; i += 512) ((LAS3 unsigned*)(Vt + 64 * ML_TROW * 2))[i] = (i < ML_TROW / 2) ? 0x3F803F80u : 0u;
    const int ct = wid & 3, rt0 = (wid < 4) ? 0 : 3, nrt = (wid < 4) ? 3 : 2;
    f32x4_t Cacc[3];
#pragma unroll
    for (int i = 0; i < 3; ++i) Cacc[i] = (f32x4_t){0.f, 0.f, 0.f, 0.f};
    const int tq = 16 * wid + lr;
    const int ia = (dir == 0) ? 2 * lane : 127 - 2 * lane, ib = (dir == 0) ? 2 * lane + 1 : 126 - 2 * lane;
    u32x4_t nkc[2], nkt[2], nvt[2]; bf16x8_t nqf[2]; float ngxa = 0.f, ngxb = 0.f, ngla = 0.f, nglb = 0.f;
#define ML_N0(c_) ((dir == 0) ? 128 * (c_) : (((c_) < 2) ? 128 * (1 - (c_)) : NC + 128 * (17 - (c_))))
#define ML_LOAD(c_) do { const int n0_ = ML_N0(c_); \
        _Pragma("unroll") for (int i = 0; i < 2; ++i) { const int id = tid + 512 * i; \
            nkc[i] = *(const u32x4_t*)(Kb + (base + n0_ + (id >> 3)) * 64 + (id & 7) * 8); \
            nkt[i] = *(const u32x4_t*)(Ktg + ((size_t)(b * 4 + h) * 64 + (id >> 4)) * NT + n0_ + (id & 15) * 8); \
            nvt[i] = *(const u32x4_t*)(Vtg + ((size_t)(b * 4 + h) * 64 + (id >> 4)) * NT + n0_ + (id & 15) * 8); } \
        _Pragma("unroll") for (int ks = 0; ks < 2; ++ks) nqf[ks] = *(const bf16x8_t*)(Qb + (base + n0_ + tq) * 64 + 32 * ks + 8 * q); \
        if (wid == 0) { const float* gpa = G + ((size_t)b * NT + n0_ + ia) * 16 + (dir * 2) * 4 + h; const float* gpb = G + ((size_t)b * NT + n0_ + ib) * 16 + (dir * 2) * 4 + h; \
            ngxa = gpa[4]; ngxb = gpb[4]; ngla = gpa[0]; nglb = gpb[0]; } } while (0)
    ML_LOAD(0);
    for (int c = 0; c < NT / 128; ++c) {
        const int n0 = ML_N0(c);
        u32x4_t rkc[2], rkt[2], rvt[2];
        bf16x8_t qf[2];
#pragma unroll
        for (int i = 0; i < 2; ++i) { rkc[i] = nkc[i]; rkt[i] = nkt[i]; rvt[i] = nvt[i]; qf[i] = nqf[i]; }
        const float xa = ngxa, xb = ngxb, lia = ngla, lib = nglb;
        if (c + 1 < NT / 128) ML_LOAD(c + 1);
#pragma unroll
        for (int i = 0; i < 2; ++i) {
            const int id = tid + 512 * i;
            *(LAS3 u32x4_t*)(Kc + ((id >> 3) * ML_KROW + (id & 7) * 8) * 2) = rkc[i];
            *(LAS3 u32x4_t*)(Vt + ((id >> 4) * ML_TROW + (id & 15) * 8) * 2) = rvt[i];
        }
        __syncthreads();
        if (wid == 0) {
            float inc = xa + xb;
#pragma unroll
            for (int o = 1; o < 64; o <<= 1) { const float v = __shfl_up(inc, o); if (lane >= o) inc += v; }
            const float tot = __shfl(inc, 63);
            const float bca = inc - xb, bcb = inc;
            s_bc2[ia] = bca * 1.4426950408889634f; s_bc2[ib] = bcb * 1.4426950408889634f;
            s_gk2[ia] = (bca - lia) * 1.4426950408889634f; s_gk2[ib] = (bcb - lib) * 1.4426950408889634f;
            s_wu[ia] = __expf(tot - bca + lia); s_wu[ib] = __expf(tot - bcb + lib);
            s_et[ia] = __expf(bca); s_et[ib] = __expf(bcb);
            if (lane == 0) s_misc[0] = __expf(tot);
        }
        __syncthreads();
#pragma unroll
        for (int i = 0; i < 2; ++i) {
            const int id = tid + 512 * i; const int tk0 = (id & 15) * 8;
            unsigned w4[4] = {rkt[i].x, rkt[i].y, rkt[i].z, rkt[i].w}; u32x4_t o;
#pragma unroll
            for (int jj = 0; jj < 4; ++jj) {
                const float lo = __uint_as_float(w4[jj] << 16) * s_wu[tk0 + 2 * jj], hi = __uint_as_float(w4[jj] & 0xFFFF0000u) * s_wu[tk0 + 2 * jj + 1];
                o[jj] = cvtpk(lo, hi);
            }
            *(LAS3 u32x4_t*)(Kt + ((id >> 4) * ML_TROW + tk0) * 2) = o;
        }
        f32x4_t S[8];
#pragma unroll
        for (int kt = 0; kt < 8; ++kt) {
            S[kt] = (f32x4_t){0.f, 0.f, 0.f, 0.f};
#pragma unroll
            for (int ks = 0; ks < 2; ++ks) {
                const bf16x8_t a = *(const LAS3 bf16x8_t*)(Kc + ((16 * kt + lr) * ML_KROW + 32 * ks + 8 * q) * 2);
                S[kt] = __builtin_amdgcn_mfma_f32_16x16x32_bf16(a, qf[ks], S[kt], 0, 0, 0);
            }
        }
        const float bct = s_bc2[tq];
#pragma unroll
        for (int kt = 0; kt < 8; ++kt) {
            const f32x4_t gk = *(const LAS3 f32x4_t*)(s_gk2 + 16 * kt + 4 * q);
#pragma unroll
            for (int rg = 0; rg < 4; ++rg) {
                const int si = 16 * kt + 4 * q + rg;
                const bool valid = (dir == 0) ? (si <= tq) : (si >= tq);
                const float w = valid ? __builtin_amdgcn_exp2f(bct - gk[rg]) : 0.f;
                S[kt][rg] *= w;
            }
        }
        bf16x8_t pf[4];
#pragma unroll
        for (int k2 = 0; k2 < 4; ++k2) {
            union { unsigned u[4]; bf16x8_t v; } cv;
            cv.u[0] = cvtpk(S[2 * k2][0], S[2 * k2][1]); cv.u[1] = cvtpk(S[2 * k2][2], S[2 * k2][3]);
            cv.u[2] = cvtpk(S[2 * k2 + 1][0], S[2 * k2 + 1][1]); cv.u[3] = cvtpk(S[2 * k2 + 1][2], S[2 * k2 + 1][3]);
            pf[k2] = cv.v;
        }
        f32x4_t outv[5];
#pragma unroll
        for (int rt = 0; rt < 5; ++rt) {
            f32x4_t acc = (f32x4_t){0.f, 0.f, 0.f, 0.f}, acc2 = (f32x4_t){0.f, 0.f, 0.f, 0.f};
#pragma unroll
            for (int k2 = 0; k2 < 4; ++k2) {
                const LAS3 unsigned char* vp = Vt + ((16 * rt + lr) * ML_TROW + 32 * k2 + 4 * q) * 2;
                union { u32x2_t u[2]; bf16x8_t v; } av;
                av.u[0] = *(const LAS3 u32x2_t*)vp; av.u[1] = *(const LAS3 u32x2_t*)(vp + 32);
                acc = __builtin_amdgcn_mfma_f32_16x16x32_bf16(av.v, pf[k2], acc, 0, 0, 0);
            }
#pragma unroll
            for (int ks = 0; ks < 2; ++ks) {
                const bf16x8_t a = *(const LAS3 bf16x8_t*)(Cb + ((16 * rt + lr) * ML_CROW + 32 * ks + 8 * q) * 2);
                acc2 = __builtin_amdgcn_mfma_f32_16x16x32_bf16(a, qf[ks], acc2, 0, 0, 0);
            }
            outv[rt] = acc + acc2 * s_et[tq];
        }
        {
            const float den = __shfl(outv[4][0], lr);
            const float inv = __builtin_amdgcn_rcpf(fmaxf(fabsf(den), 1.f));
            bf16_t* hp = (bf16_t*)hdir + ((size_t)dir * TT + (size_t)b * NT + n0 + tq) * 256 + h * 64 + 4 * q;
            for (int rt = 0; rt < 4; ++rt) { const f32x4_t ov = outv[rt] * inv; *(uint2*)(hp + 16 * rt) = make_uint2(cvtpk(ov[0], ov[1]), cvtpk(ov[2], ov[3])); }
        }
        __syncthreads();
        {
            const float decay = s_misc[0];
#pragma unroll
            for (int i = 0; i < 3; ++i) Cacc[i] *= decay;
#pragma unroll
            for (int ks = 0; ks < 4; ++ks) {
                const bf16x8_t bb = *(const LAS3 bf16x8_t*)(Kt + ((16 * ct + lr) * ML_TROW + 32 * ks + 8 * q) * 2);
#pragma unroll
                for (int i = 0; i < 3; ++i) if (i < nrt) {
                    const bf16x8_t a = *(const LAS3 bf16x8_t*)(Vt + ((16 * (rt0 + i) + lr) * ML_TROW + 32 * ks + 8 * q) * 2);
                    Cacc[i] = __builtin_amdgcn_mfma_f32_16x16x32_bf16(a, bb, Cacc[i], 0, 0, 0);
                }
            }
#pragma unroll
            for (int i = 0; i < 3; ++i) if (i < nrt) {
#pragma unroll
                for (int rg = 0; rg < 4; ++rg) *(LAS3 bf16_t*)(Cb + ((16 * (rt0 + i) + 4 * q + rg) * ML_CROW + 16 * ct + lr) * 2) = f2bf(Cacc[i][rg]);
            }
        }
        __syncthreads();
    }
#undef ML_LOAD
#undef ML_N0
}

constexpr int S5_UROWS = NT + 64;
constexpr int S5_KROW = 1032, S5_CROW = 136, S5_ZROW = 136;
constexpr int S5_OFF_U = 0, S5_OFF_KM = S5_OFF_U + S5_UROWS * 16 * 2, S5_OFF_CM = S5_OFF_KM + 16 * S5_KROW * 2, S5_OFF_EZ = S5_OFF_CM + 16 * S5_CROW * 2,
              S5_LDS_BYTES = S5_OFF_EZ + 8 * 16 * S5_ZROW * 2;
__device__ __forceinline__ void s5_setup_item(LAS3 unsigned char* lds, int idx, const float* __restrict__ a_re, const float* __restrict__ a_im, const float* __restrict__ log_step,
                                                  const float* __restrict__ b_re, const float* __restrict__ b_im, const float* __restrict__ c_re, const float* __restrict__ c_im,
                                                  bf16_t* __restrict__ KmT, bf16_t* __restrict__ Smat, bf16_t* __restrict__ CmT, float* __restrict__ Aab, float* __restrict__ A64) {
    typedef float apw_t[64][2]; typedef float bb_t[16][2]; typedef float cc_t[64][2];
    LAS3 apw_t* apw = (LAS3 apw_t*)lds;
    LAS3 bb_t* bb = (LAS3 bb_t*)(lds + 32768);
    LAS3 cc_t* cc = (LAS3 cc_t*)(lds + 32768 + 8192);
    const int tid = opaque_tid();
    __syncthreads();
    const float dt = expf(log_step[idx]);
    if (tid < 64) {
        const int p = tid;
        const float ar = fminf(a_re[idx * 64 + p], -1e-4f), ai = a_im[idx * 64 + p];
        const float mag = expf(dt * ar), er = mag * cosf(dt * ai), ei = mag * sinf(dt * ai);
        const float inv = 1.0f / (ar * ar + ai * ai);
        const float fr = ((er - 1.0f) * ar + ei * ai) * inv, fi = (ei * ar - (er - 1.0f) * ai) * inv;
        Aab[(idx * 64 + p) * 2] = er; Aab[(idx * 64 + p) * 2 + 1] = ei;
        const float m64 = expf(64.0f * dt * ar);
        A64[(idx * 64 + p) * 2] = m64 * cosf(64.0f * dt * ai); A64[(idx * 64 + p) * 2 + 1] = m64 * sinf(64.0f * dt * ai);
        for (int hh = 0; hh < 16; ++hh) {
            const float br = b_re[((size_t)idx * 64 + p) * 16 + hh], bi = b_im[((size_t)idx * 64 + p) * 16 + hh];
            bb[p][hh][0] = fr * br - fi * bi; bb[p][hh][1] = fr * bi + fi * br;
        }
    }
    for (int i = tid; i < 64 * 64; i += 512) {
        const int tau = i >> 6, p = i & 63;
        const float ar = fminf(a_re[idx * 64 + p], -1e-4f), ai = a_im[idx * 64 + p];
        const float mag = expf((float)tau * dt * ar);
        apw[tau][p][0] = mag * cosf((float)tau * dt * ai); apw[tau][p][1] = mag * sinf((float)tau * dt * ai);
    }
    for (int i = tid; i < 16 * 64; i += 512) { const int hh = i >> 6, p = i & 63; cc[hh][p][0] = c_re[(size_t)idx * 1024 + i]; cc[hh][p][1] = c_im[(size_t)idx * 1024 + i]; }
    __syncthreads();
    for (int i = tid; i < 16 * 64; i += 512) { const int hh = i >> 6, p = i & 63;
        CmT[((size_t)idx * 16 + hh) * 128 + 2 * p] = f2bf(cc[hh][p][0]); CmT[((size_t)idx * 16 + hh) * 128 + 2 * p + 1] = f2bf(-cc[hh][p][1]); }
    for (int e = tid; e < 64 * 1024; e += 512) {
        const int p = e >> 10, k = e & 1023, i = k >> 4, hp = k & 15;
        const float pr = apw[63 - i][p][0], pi = apw[63 - i][p][1], br = bb[p][hp][0], bi = bb[p][hp][1];
        Smat[((size_t)idx * 128 + 2 * p) * 1024 + k] = f2bf(pr * br - pi * bi);
        Smat[((size_t)idx * 128 + 2 * p + 1) * 1024 + k] = f2bf(pr * bi + pi * br);
    }
    for (int e = tid; e < 16 * 1024; e += 512) {
        const int hh = e >> 10, k = e & 1023, tau = k >> 4, hp = k & 15;
        float acc = 0.f;
        for (int p = 0; p < 64; ++p) {
            const float pr = apw[tau][p][0], pi = apw[tau][p][1], br = bb[p][hp][0], bi = bb[p][hp][1];
            const float wr = pr * br - pi * bi, wi = pr * bi + pi * br;
            acc += cc[hh][p][0] * wr - cc[hh][p][1] * wi;
        }
        KmT[((size_t)idx * 16 + hh) * 1024 + k] = f2bf(acc);
    }
}


__device__ __forceinline__ void s5_item(LAS3 unsigned char* lds, const bf16_t* __restrict__ p, const bf16_t* __restrict__ KmT, const bf16_t* __restrict__ Smat, const bf16_t* __restrict__ CmT,
                                        const float* __restrict__ Aab, const float* __restrict__ A64, float* __restrict__ xs_g, float* __restrict__ ys5, int b, int g, int dir) {
    const int tid = opaque_tid(), wid = tid >> 6, lane = tid & 63, lr = lane & 15, q = lane >> 4;
    const int tix = dir * 16 + g;
    LAS3 unsigned char* U = lds + S5_OFF_U; LAS3 unsigned char* Km = lds + S5_OFF_KM; LAS3 unsigned char* Cm = lds + S5_OFF_CM; LAS3 unsigned char* EZ = lds + S5_OFF_EZ;
    float* xs = xs_g + (size_t)((b * 16 + g) * 2 + dir) * 36 * 128;
    __syncthreads();
    for (int i = tid; i < 16 * 128; i += 512) { const int hh = i >> 7, ch = i & 127;
        *(LAS3 u32x4_t*)(Km + (hh * S5_KROW + ch * 8) * 2) = *(const u32x4_t*)(KmT + ((size_t)tix * 16 + hh) * 1024 + ch * 8); }
    if (tid < 256) { const int hh = tid >> 4, ch = tid & 15;
        *(LAS3 u32x4_t*)(Cm + (hh * S5_CROW + ch * 8) * 2) = *(const u32x4_t*)(CmT + ((size_t)tix * 16 + hh) * 128 + ch * 8); }
    for (int i = tid; i < NT * 2; i += 512) {
        const int sidx = i >> 1, hf = i & 1;
        const int n = seq_token(sidx, dir);
        *(LAS3 u32x4_t*)(U + ((64 + sidx) * 16 + hf * 8) * 2) = *(const u32x4_t*)(p + ((size_t)b * NT + n) * DIN + P_S5 + g * 16 + hf * 8);
    }
    for (int i = tid; i < 64 * 8; i += 512) *(LAS3 unsigned*)(U + i * 4) = 0u;
    __syncthreads();
    {
        f32x4_t acc[3];
#pragma unroll
        for (int i = 0; i < 3; ++i) acc[i] = (f32x4_t){0.f, 0.f, 0.f, 0.f};
        const bf16_t* sp = Smat + ((size_t)tix * 128 + 16 * wid + lr) * 1024 + 8 * q;
        int cco[3];
#pragma unroll
        for (int ctile = 0; ctile < 3; ++ctile) { int ch = 16 * ctile + lr; if (ch > 35) ch = 35; cco[ctile] = ((64 + 64 * ch + (q >> 1)) * 16 + 8 * (q & 1)) * 2; }
#pragma unroll 8
        for (int ks = 0; ks < 32; ++ks) {
            const bf16x8_t a = *(const bf16x8_t*)(sp + 32 * ks);
#pragma unroll
            for (int ctile = 0; ctile < 3; ++ctile) {
                const bf16x8_t bfr = *(const LAS3 bf16x8_t*)(U + cco[ctile] + ks * 64);
                acc[ctile] = __builtin_amdgcn_mfma_f32_16x16x32_bf16(a, bfr, acc[ctile], 0, 0, 0);
            }
        }
        LAS3 float* E = (LAS3 float*)EZ;
#pragma unroll
        for (int ctile = 0; ctile < 3; ++ctile)
#pragma unroll
            for (int rg = 0; rg < 4; ++rg) E[(16 * ctile + lr) * 128 + 16 * wid + 4 * q + rg] = acc[ctile][rg];
    }
    __syncthreads();
    const float Ar = Aab[(tix * 64 + lane) * 2], Ai = Aab[(tix * 64 + lane) * 2 + 1];
    if (wid == 0) {
        const float Br = A64[(tix * 64 + lane) * 2], Bi = A64[(tix * 64 + lane) * 2 + 1];
        const LAS3 float* E = (const LAS3 float*)EZ;
        float xr = 0.f, xi = 0.f;
        for (int c = 0; c < 36; ++c) {
            *(float2*)(xs + c * 128 + 2 * lane) = make_float2(xr, xi);
            const float er = E[c * 128 + 2 * lane], ei = E[c * 128 + 2 * lane + 1];
            const float nr = Br * xr - Bi * xi + er, ni = Br * xi + Bi * xr + ei;
            xr = nr; xi = ni;
        }
    }
    __threadfence_block();
    __syncthreads();
    LAS3 unsigned char* Zw = EZ + wid * (16 * S5_ZROW * 2);
    bf16x8_t cmf[4];
#pragma unroll
    for (int ks = 0; ks < 4; ++ks) cmf[ks] = *(const LAS3 bf16x8_t*)(Cm + (lr * S5_CROW + 32 * ks + 8 * q) * 2);
    bf16x8_t kbr[16];
#pragma unroll
    for (int ks = 0; ks < 16; ++ks) kbr[ks] = *(const LAS3 bf16x8_t*)(Km + (lr * S5_KROW + 8 * q) * 2 + ks * 64);
    float2 xnext = *(const float2*)(xs + wid * 128 + 2 * lane);
    for (int c = wid; c < 36; c += 8) {
        const float2 x0 = xnext;
        if (c + 8 < 36) xnext = *(const float2*)(xs + (c + 8) * 128 + 2 * lane);
        float zr = Ar * x0.x - Ai * x0.y, zi = Ar * x0.y + Ai * x0.x;
#pragma unroll
        for (int rt = 0; rt < 4; ++rt) {
#pragma unroll
            for (int ii = 0; ii < 16; ++ii) {
                *(LAS3 unsigned*)(Zw + (ii * S5_ZROW + 2 * lane) * 2) = cvtpk(zr, zi);
                const float nr = Ar * zr - Ai * zi, ni = Ar * zi + Ai * zr; zr = nr; zi = ni;
            }
            asm volatile("s_waitcnt lgkmcnt(0)" ::: "memory");
            f32x4_t acc = (f32x4_t){0.f, 0.f, 0.f, 0.f};
#pragma unroll
            for (int ks = 0; ks < 4; ++ks) {
                const bf16x8_t a = *(const LAS3 bf16x8_t*)(Zw + (lr * S5_ZROW + 32 * ks + 8 * q) * 2);
                acc = __builtin_amdgcn_mfma_f32_16x16x32_bf16(a, cmf[ks], acc, 0, 0, 0);
            }
            const int irow = 16 * rt + lr;
            const LAS3 unsigned char* up = U + ((64 + 64 * c + irow - (q >> 1)) * 16 + 8 * (q & 1)) * 2;
            const LAS3 unsigned char* kp = Km + (lr * S5_KROW + 8 * q) * 2;
            f32x4_t acc1 = (f32x4_t){0.f, 0.f, 0.f, 0.f};
#pragma unroll
            for (int ks0 = 0; ks0 < 8 * rt + 8; ks0 += 8) {
                bf16x8_t av[8], kv[8];
#pragma unroll
                for (int j = 0; j < 8; ++j) { av[j] = *(const LAS3 bf16x8_t*)(up - (ks0 + j) * 64); if (ks0 + j < 16) kv[j] = kbr[ks0 + j]; else kv[j] = *(const LAS3 bf16x8_t*)(kp + (ks0 + j) * 64); }
#pragma unroll
                for (int j = 0; j < 8; ++j) {
                    const int ks = ks0 + j;
                    if (ks >= 8 * rt) {
                        const bool valid = (2 * ks + (q >> 1)) <= irow;
                        if (!valid) av[j] = (bf16x8_t){0, 0, 0, 0, 0, 0, 0, 0};
                    }
                    if (j & 1) acc1 = __builtin_amdgcn_mfma_f32_16x16x32_bf16(av[j], kv[j], acc1, 0, 0, 0);
                    else acc = __builtin_amdgcn_mfma_f32_16x16x32_bf16(av[j], kv[j], acc, 0, 0, 0);
                }
            }
            acc += acc1;
#pragma unroll
            for (int rg = 0; rg < 4; ++rg) {
                const int n = seq_token(64 * c + 16 * rt + 4 * q + rg, dir);
                ((bf16_t*)ys5)[((size_t)dir * TT + (size_t)b * NT + n) * 256 + g * 16 + lr] = f2bf(acc[rg]);
            }
            asm volatile("s_waitcnt lgkmcnt(0)" ::: "memory");
        }
    }
}

#define XB_TMO      128
#define XB_XCNT(j)  (256  + 64 * (j))
#define XB_XSUB(j)  (1280 + 64 * (j))
#define XB_XGEN(j)  (2304 + 64 * (j))
#define XB_TOP      3328
#define XB_TOPGEN   3392
#define XCD_BAR_WORDS 3456
#define XB_SPIN_CAP (1u << 22)
__device__ __forceinline__ unsigned xb_ld(unsigned* p)              { return __hip_atomic_load(p, __ATOMIC_RELAXED, __HIP_MEMORY_SCOPE_AGENT); }
__device__ __forceinline__ unsigned xb_add(unsigned* p, unsigned v) { return __hip_atomic_fetch_add(p, v, __ATOMIC_RELAXED, __HIP_MEMORY_SCOPE_AGENT); }
__device__ __forceinline__ unsigned xb_xcc_id() { return (unsigned)__builtin_amdgcn_s_getreg((3 << 11) | 20) & 0xFu; }
#define XB_SPIN(cond, bar) do { unsigned _sp = 0; while (cond) { __builtin_amdgcn_s_sleep(1); \
    if ((++_sp & 255u) == 0u) { if (xb_ld(&(bar)[XB_TMO])) break; if (_sp > XB_SPIN_CAP) { atomicAdd(&(bar)[XB_TMO], 1u); break; } } } } while (0)
struct XcdBarrier { unsigned* bar; unsigned x; volatile LAS3 unsigned* st; };
__device__ __forceinline__ XcdBarrier xcd_barrier_post(unsigned* bar, volatile LAS3 unsigned* st) {
    XcdBarrier b; b.bar = bar; b.x = xb_xcc_id(); b.st = st;
    if (threadIdx.x == 0) (void)xb_add(&bar[XB_XCNT(b.x)], 1u);
    return b;
}
__device__ __forceinline__ void xcd_barrier_complete(unsigned* bar, unsigned x, unsigned& nloc, unsigned& nx) {
    const unsigned G = gridDim.x * gridDim.y * gridDim.z;
    unsigned sum, cnt, mine, sp = 0u;
    for (;;) {
        sum = 0u; cnt = 0u; mine = 0u;
#pragma unroll
        for (unsigned j = 0; j < 16; ++j) { const unsigned c = xb_ld(&bar[XB_XCNT(j)]); sum += c; cnt += (c > 0u) ? 1u : 0u; mine = (j == x) ? c : mine; }
        if (sum == G) break;
        __builtin_amdgcn_s_sleep(1);
        if ((++sp & 255u) == 0u) { if (xb_ld(&bar[XB_TMO])) break; if (sp > XB_SPIN_CAP) { atomicAdd(&bar[XB_TMO], 1u); break; } }
    }
    nloc = mine > 0u ? mine : 1u; nx = cnt > 0u ? cnt : 1u;
}
__device__ __forceinline__ void xcd_barrier(const XcdBarrier& b) {
    asm volatile("s_waitcnt vmcnt(0)" ::: "memory");
    __syncthreads();
    if (threadIdx.x == 0) {
        unsigned* bar = b.bar;
        __builtin_amdgcn_s_waitcnt(0);
        unsigned nloc = b.st[0], nx = b.st[1];
        if (nloc == 0u) { xcd_barrier_complete(bar, b.x, nloc, nx); b.st[0] = nloc; b.st[1] = nx; }
        const unsigned old = xb_add(&bar[XB_XSUB(b.x)], 1u);
        const unsigned gen = old / nloc;
        if (old + 1u == (gen + 1u) * nloc) {
            __builtin_amdgcn_fence(__ATOMIC_RELEASE, "agent");
            asm volatile("s_waitcnt vmcnt(0)" ::: "memory");
            const unsigned og = xb_add(&bar[XB_TOP], 1u);
            const unsigned tg = og / nx;
            if (og + 1u == (tg + 1u) * nx) xb_add(&bar[XB_TOPGEN], 1u);
            else XB_SPIN(xb_ld(&bar[XB_TOPGEN]) == tg, bar);
            __builtin_amdgcn_fence(__ATOMIC_ACQUIRE, "agent");
            xb_add(&bar[XB_XGEN(b.x)], 1u);
            asm volatile("s_waitcnt vmcnt(0)" ::: "memory");
        } else {
            XB_SPIN(xb_ld(&bar[XB_XGEN(b.x)]) == gen, bar);
            __builtin_amdgcn_fence(__ATOMIC_ACQUIRE, "agent");
            asm volatile("s_waitcnt vmcnt(0)" ::: "memory");
        }
    }
    __syncthreads();
}

struct Params {
    const float *x, *c, *ctx, *c_ctx, *w_mod, *b_mod, *norm_w, *w_in, *w_out, *da_lambda, *da_subln, *ml_conv_w, *ml_conv_b, *ml_gate_b, *ml_norm,
                *mla_q_norm, *mla_w_uq, *mla_kv_norm, *mla_w_ukv, *s5_a_re, *s5_a_im, *s5_log_step, *s5_b_re, *s5_b_im, *s5_c_re, *s5_c_im, *s5_d, *s5_w_glu, *s5_b_glu,
                *moe_w_router, *moe_b_router, *moe_w_gate_up, *moe_b_gate_up, *moe_w_down, *moe_b_down;
    float* out;
    float *xall, *mod, *ropecs, *lamfull;
    bf16_t *w_in_t, *w_out_t, *wgu_t, *wdn_t, *wq_t, *wkv_t, *wglu_t;
    bf16_t *s5KmT, *s5Smat, *s5CmT; float *s5A, *s5A64, *s5xs;
    bf16_t *hbuf, *pb, *daQ, *daK, *daVt, *mQ, *mK, *mVt, *mlQ, *mlK, *mlKt, *mlVt; float *mlG, *hdir, *ys5;
    bf16_t *ycatb, *ob; float* osq; bf16_t* fb;
    int* top_e; float* top_g; int *posb, *tok_slot;
    int *cnt, *tile_e, *ntiles, *offs, *blkcnt;
    bf16_t *xg, *act, *yexp;
    unsigned* bar; int* queue;
};

template <class T> __device__ __forceinline__ T* uni_ptr(T* p) { const unsigned long long v = (unsigned long long)p; const unsigned lo = __builtin_amdgcn_readfirstlane((unsigned)v), hi = __builtin_amdgcn_readfirstlane((unsigned)(v >> 32)); return (T*)(__attribute__((address_space(1))) T*)(((unsigned long long)hi << 32) | lo); }
__device__ __forceinline__ void store_params(LAS3 Params* PL, const Params& P) {
    PL->x = P.x;
    PL->c = P.c;
    PL->ctx = P.ctx;
    PL->c_ctx = P.c_ctx;
    PL->w_mod = P.w_mod;
    PL->b_mod = P.b_mod;
    PL->norm_w = P.norm_w;
    PL->w_in = P.w_in;
    PL->w_out = P.w_out;
    PL->da_lambda = P.da_lambda;
    PL->da_subln = P.da_subln;
    PL->ml_conv_w = P.ml_conv_w;
    PL->ml_conv_b = P.ml_conv_b;
    PL->ml_gate_b = P.ml_gate_b;
    PL->ml_norm = P.ml_norm;
    PL->mla_q_norm = P.mla_q_norm;
    PL->mla_w_uq = P.mla_w_uq;
    PL->mla_kv_norm = P.mla_kv_norm;
    PL->mla_w_ukv = P.mla_w_ukv;
    PL->s5_a_re = P.s5_a_re;
    PL->s5_a_im = P.s5_a_im;
    PL->s5_log_step = P.s5_log_step;
    PL->s5_b_re = P.s5_b_re;
    PL->s5_b_im = P.s5_b_im;
    PL->s5_c_re = P.s5_c_re;
    PL->s5_c_im = P.s5_c_im;
    PL->s5_d = P.s5_d;
    PL->s5_w_glu = P.s5_w_glu;
    PL->s5_b_glu = P.s5_b_glu;
    PL->moe_w_router = P.moe_w_router;
    PL->moe_b_router = P.moe_b_router;
    PL->moe_w_gate_up = P.moe_w_gate_up;
    PL->moe_b_gate_up = P.moe_b_gate_up;
    PL->moe_w_down = P.moe_w_down;
    PL->moe_b_down = P.moe_b_down;
    PL->out = P.out;
    PL->xall = P.xall;
    PL->mod = P.mod;
    PL->ropecs = P.ropecs;
    PL->lamfull = P.lamfull;
    PL->w_in_t = P.w_in_t;
    PL->w_out_t = P.w_out_t;
    PL->wgu_t = P.wgu_t;
    PL->wdn_t = P.wdn_t;
    PL->wq_t = P.wq_t;
    PL->wkv_t = P.wkv_t;
    PL->wglu_t = P.wglu_t;
    PL->s5KmT = P.s5KmT;
    PL->s5Smat = P.s5Smat;
    PL->s5CmT = P.s5CmT;
    PL->s5A = P.s5A;
    PL->s5A64 = P.s5A64;
    PL->s5xs = P.s5xs;
    PL->hbuf = P.hbuf;
    PL->pb = P.pb;
    PL->daQ = P.daQ;
    PL->daK = P.daK;
    PL->daVt = P.daVt;
    PL->mQ = P.mQ;
    PL->mK = P.mK;
    PL->mVt = P.mVt;
    PL->mlQ = P.mlQ;
    PL->mlK = P.mlK;
    PL->mlKt = P.mlKt;
    PL->mlVt = P.mlVt;
    PL->mlG = P.mlG;
    PL->hdir = P.hdir;
    PL->ys5 = P.ys5;
    PL->ycatb = P.ycatb;
    PL->ob = P.ob;
    PL->osq = P.osq;
    PL->fb = P.fb;
    PL->top_e = P.top_e;
    PL->top_g = P.top_g;
    PL->posb = P.posb;
    PL->tok_slot = P.tok_slot;
    PL->cnt = P.cnt;
    PL->tile_e = P.tile_e;
    PL->ntiles = P.ntiles;
    PL->offs = P.offs;
    PL->blkcnt = P.blkcnt;
    PL->xg = P.xg;
    PL->act = P.act;
    PL->yexp = P.yexp;
    PL->bar = P.bar;
    PL->queue = P.queue;
}
__device__ __forceinline__ Params load_params(const LAS3 Params* PL) {
    Params Q;
    Q.x = uni_ptr(PL->x);
    Q.c = uni_ptr(PL->c);
    Q.ctx = uni_ptr(PL->ctx);
    Q.c_ctx = uni_ptr(PL->c_ctx);
    Q.w_mod = uni_ptr(PL->w_mod);
    Q.b_mod = uni_ptr(PL->b_mod);
    Q.norm_w = uni_ptr(PL->norm_w);
    Q.w_in = uni_ptr(PL->w_in);
    Q.w_out = uni_ptr(PL->w_out);
    Q.da_lambda = uni_ptr(PL->da_lambda);
    Q.da_subln = uni_ptr(PL->da_subln);
    Q.ml_conv_w = uni_ptr(PL->ml_conv_w);
    Q.ml_conv_b = uni_ptr(PL->ml_conv_b);
    Q.ml_gate_b = uni_ptr(PL->ml_gate_b);
    Q.ml_norm = uni_ptr(PL->ml_norm);
    Q.mla_q_norm = uni_ptr(PL->mla_q_norm);
    Q.mla_w_uq = uni_ptr(PL->mla_w_uq);
    Q.mla_kv_norm = uni_ptr(PL->mla_kv_norm);
    Q.mla_w_ukv = uni_ptr(PL->mla_w_ukv);
    Q.s5_a_re = uni_ptr(PL->s5_a_re);
    Q.s5_a_im = uni_ptr(PL->s5_a_im);
    Q.s5_log_step = uni_ptr(PL->s5_log_step);
    Q.s5_b_re = uni_ptr(PL->s5_b_re);
    Q.s5_b_im = uni_ptr(PL->s5_b_im);
    Q.s5_c_re = uni_ptr(PL->s5_c_re);
    Q.s5_c_im = uni_ptr(PL->s5_c_im);
    Q.s5_d = uni_ptr(PL->s5_d);
    Q.s5_w_glu = uni_ptr(PL->s5_w_glu);
    Q.s5_b_glu = uni_ptr(PL->s5_b_glu);
    Q.moe_w_router = uni_ptr(PL->moe_w_router);
    Q.moe_b_router = uni_ptr(PL->moe_b_router);
    Q.moe_w_gate_up = uni_ptr(PL->moe_w_gate_up);
    Q.moe_b_gate_up = uni_ptr(PL->moe_b_gate_up);
    Q.moe_w_down = uni_ptr(PL->moe_w_down);
    Q.moe_b_down = uni_ptr(PL->moe_b_down);
    Q.out = uni_ptr(PL->out);
    Q.xall = uni_ptr(PL->xall);
    Q.mod = uni_ptr(PL->mod);
    Q.ropecs = uni_ptr(PL->ropecs);
    Q.lamfull = uni_ptr(PL->lamfull);
    Q.w_in_t = uni_ptr(PL->w_in_t);
    Q.w_out_t = uni_ptr(PL->w_out_t);
    Q.wgu_t = uni_ptr(PL->wgu_t);
    Q.wdn_t = uni_ptr(PL->wdn_t);
    Q.wq_t = uni_ptr(PL->wq_t);
    Q.wkv_t = uni_ptr(PL->wkv_t);
    Q.wglu_t = uni_ptr(PL->wglu_t);
    Q.s5KmT = uni_ptr(PL->s5KmT);
    Q.s5Smat = uni_ptr(PL->s5Smat);
    Q.s5CmT = uni_ptr(PL->s5CmT);
    Q.s5A = uni_ptr(PL->s5A);
    Q.s5A64 = uni_ptr(PL->s5A64);
    Q.s5xs = uni_ptr(PL->s5xs);
    Q.hbuf = uni_ptr(PL->hbuf);
    Q.pb = uni_ptr(PL->pb);
    Q.daQ = uni_ptr(PL->daQ);
    Q.daK = uni_ptr(PL->daK);
    Q.daVt = uni_ptr(PL->daVt);
    Q.mQ = uni_ptr(PL->mQ);
    Q.mK = uni_ptr(PL->mK);
    Q.mVt = uni_ptr(PL->mVt);
    Q.mlQ = uni_ptr(PL->mlQ);
    Q.mlK = uni_ptr(PL->mlK);
    Q.mlKt = uni_ptr(PL->mlKt);
    Q.mlVt = uni_ptr(PL->mlVt);
    Q.mlG = uni_ptr(PL->mlG);
    Q.hdir = uni_ptr(PL->hdir);
    Q.ys5 = uni_ptr(PL->ys5);
    Q.ycatb = uni_ptr(PL->ycatb);
    Q.ob = uni_ptr(PL->ob);
    Q.osq = uni_ptr(PL->osq);
    Q.fb = uni_ptr(PL->fb);
    Q.top_e = uni_ptr(PL->top_e);
    Q.top_g = uni_ptr(PL->top_g);
    Q.posb = uni_ptr(PL->posb);
    Q.tok_slot = uni_ptr(PL->tok_slot);
    Q.cnt = uni_ptr(PL->cnt);
    Q.tile_e = uni_ptr(PL->tile_e);
    Q.ntiles = uni_ptr(PL->ntiles);
    Q.offs = uni_ptr(PL->offs);
    Q.blkcnt = uni_ptr(PL->blkcnt);
    Q.xg = uni_ptr(PL->xg);
    Q.act = uni_ptr(PL->act);
    Q.yexp = uni_ptr(PL->yexp);
    Q.bar = uni_ptr(PL->bar);
    Q.queue = uni_ptr(PL->queue);
    return Q;
}
constexpr int MK_LDS_MAIN = 147968;
constexpr int MK_LDS_BYTES = MK_LDS_MAIN + 64 + 1024;
enum { PH_SETUP = 0, PH_H0 = 1, PH_LAYER0 = 2, PH_PER_LAYER = 10, PH_TOTAL = 22 };
enum { L_GEMM_IN = 0, L_PREP, L_MIX, L_FINISH, L_GEMM_OUT, L_POST, L_SCATTER, L_GEMM_GU, L_GEMM_DN, L_COMBINE };

__device__ __forceinline__ void conv_tile(LAS3 float* tile, int lane, const float* __restrict__ W, int N, bf16_t* __restrict__ WT, int ldt, int tn, int tk, int mode) {
    const int n0 = tn * 64, k0 = tk * 64;
    const int kq = lane >> 4, n4 = (lane & 15) * 4;
    const int nl = (n0 + n4 < N) ? n0 + n4 : N - 4;
    const float* wp = W + (size_t)(k0 + kq) * N + nl;
    float4 v[16];
#pragma unroll
    for (int j = 0; j < 16; ++j) v[j] = *(const float4*)(wp + (size_t)(4 * j) * N);
#pragma unroll
    for (int j = 0; j < 16; ++j) { LAS3 float* tp = tile + (4 * j + kq) * 65 + n4; tp[0] = v[j].x; tp[1] = v[j].y; tp[2] = v[j].z; tp[3] = v[j].w; }
    asm volatile("s_waitcnt lgkmcnt(0)" ::: "memory");
    {
        const int c = lane & 7;
#pragma unroll
        for (int jn = 0; jn < 8; ++jn) {
            const int n = (lane >> 3) + 8 * jn, gn = n0 + n;
            if (gn < N) {
                int dr = gn;
                if (mode == 1) dr = (gn < 1024) ? ((gn >> 7) * 256 + (gn & 127)) : ((((gn - 1024) >> 7) * 256) + 128 + ((gn - 1024) & 127));
                const LAS3 float* tp = tile + (8 * c) * 65 + n;
                u32x4_t o;
                o.x = pk2bf(tp[0 * 65], tp[1 * 65]); o.y = pk2bf(tp[2 * 65], tp[3 * 65]); o.z = pk2bf(tp[4 * 65], tp[5 * 65]); o.w = pk2bf(tp[6 * 65], tp[7 * 65]);
                *(u32x4_t*)(WT + (size_t)dr * ldt + k0 + 8 * c) = o;
            }
        }
    }
    asm volatile("s_waitcnt lgkmcnt(0)" ::: "memory");
}
constexpr int CV_IN = 38 * 16 * 2, CV_OUT = 256 * 2, CV_GU = 512 * 64, CV_DN = 256 * 64, CV_Q = 18 * 2, CV_KV = 16 * 2, CV_GLU = 16 * 2;
constexpr int CV_TOTAL = CV_IN + CV_OUT + CV_GU + CV_DN + CV_Q + CV_KV + CV_GLU;
__device__ __forceinline__ void conv_dispatch(const Params& P, LAS3 float* tile, int st, int it) {
    const float* W = nullptr; bf16_t* WT = nullptr; int N = 64, ldt = 64, tn = 0, tk = 0, mode = 0;
    if (it < CV_TOTAL) {
        int r = it;
        if (r < CV_IN) { const int bt = r / 608, q = r % 608; W = P.w_in + (size_t)bt * 1024 * DINC; N = DINC; WT = P.w_in_t + (size_t)bt * 2560 * 1024; ldt = 1024; tn = q % 38; tk = q / 38; }
        else if ((r -= CV_IN) < CV_OUT) { const int bt = r / 256, q = r % 256; W = P.w_out + (size_t)bt * 1024 * 1024; N = 1024; WT = P.w_out_t + (size_t)bt * 1024 * 1024; ldt = 1024; tn = q % 16; tk = q / 16; }
        else if ((r -= CV_OUT) < CV_GU) { const int bt = r / 512, q = r % 512; W = P.moe_w_gate_up + (size_t)bt * 1024 * 2048; N = 2048; WT = P.wgu_t + (size_t)bt * 2048 * 1024; ldt = 1024; tn = q % 32; tk = q / 32; mode = 1; }
        else if ((r -= CV_GU) < CV_DN) { const int bt = r / 256, q = r % 256; W = P.moe_w_down + (size_t)bt * 1024 * 1024; N = 1024; WT = P.wdn_t + (size_t)bt * 1024 * 1024; ldt = 1024; tn = q % 16; tk = q / 16; }
        else if ((r -= CV_DN) < CV_Q) { const int bt = r / 18, q = r % 18; W = P.mla_w_uq + (size_t)bt * 192 * 384; N = 384; WT = P.wq_t + (size_t)bt * 384 * 192; ldt = 192; tn = q % 6; tk = q / 6; }
        else if ((r -= CV_Q) < CV_KV) { const int bt = r / 16, q = r % 16; W = P.mla_w_ukv + (size_t)bt * 128 * 512; N = 512; WT = P.wkv_t + (size_t)bt * 512 * 128; ldt = 128; tn = q % 8; tk = q / 8; }
        else { r -= CV_KV; const int bt = r / 16, q = r % 16; W = P.s5_w_glu + (size_t)bt * 256 * 256; N = 256; WT = P.wglu_t + (size_t)bt * 256 * 256; ldt = 256; tn = q % 4; tk = q / 4; }
    }
    if (W) conv_tile(tile, st, W, N, WT, ldt, tn, tk, mode);
}
__device__ __forceinline__ void phase_setup(const Params& P, LAS3 unsigned char* lds) {
    const int tid = opaque_tid(), G = gridDim.x, bid = blockIdx.x;
    for (int it = bid; it < 192; it += G) {
        LAS3 float* sl = (LAS3 float*)lds;
        LAS3 float* red = sl + 9 * 1024;
        __syncthreads();
        for (int i = tid; i < 9 * 1024; i += 512) { const int r = i >> 10, k = i & 1023; sl[i] = siluf_((r < 8) ? P.c[r * 1024 + k] : P.c_ctx[k]); }
        __syncthreads();
        const int l = it / 96, j = (it % 96) * 64 + (tid & 63), kp = tid >> 6;
        const float* w = P.w_mod + (size_t)l * 1024 * 6144 + j;
        float acc[9];
#pragma unroll
        for (int r = 0; r < 9; ++r) acc[r] = 0.f;
#pragma unroll 8
        for (int k = kp * 128; k < kp * 128 + 128; ++k) {
            const float wv = w[(size_t)k * 6144];
#pragma unroll
            for (int r = 0; r < 9; ++r) acc[r] += sl[r * 1024 + k] * wv;
        }
#pragma unroll
        for (int r = 0; r < 9; ++r) red[(kp * 9 + r) * 64 + (tid & 63)] = acc[r];
        __syncthreads();
        for (int i = tid; i < 9 * 64; i += 512) {
            const int r = i >> 6, cc = i & 63; float sacc = 0.f;
#pragma unroll
            for (int k2 = 0; k2 < 8; ++k2) sacc += red[(k2 * 9 + r) * 64 + cc];
            const int jj = (it % 96) * 64 + cc;
            P.mod[((size_t)l * 9 + r) * 6144 + jj] = sacc + P.b_mod[l * 6144 + jj];
        }
    }
    for (int i = bid * 512 + tid; i < NS * 16; i += G * 512) {
        const int pos = i >> 4, j = i & 15; const int row = pos / 64, col = pos % 64;
        const float inv = exp2f(-(float)(j & 7) * 1.6609640474436813f), ang = (float)((j < 8) ? row : col) * inv;
        P.ropecs[i * 2] = cosf(ang); P.ropecs[i * 2 + 1] = sinf(ang);
    }
    if (bid == G - 1 && tid < 2) {
        const int l = tid; const float* lam = P.da_lambda + l * 128; float s1 = 0.f, s2 = 0.f;
        for (int i = 0; i < 32; ++i) { s1 += lam[i] * lam[32 + i]; s2 += lam[64 + i] * lam[96 + i]; }
        P.lamfull[l] = expf(s1) - expf(s2) + ((l == 0) ? 0.2f : 0.35550906759096927f);
    }
    for (int it = G - 1 - bid; it < 64; it += G)
        s5_setup_item(lds, it, P.s5_a_re, P.s5_a_im, P.s5_log_step, P.s5_b_re, P.s5_b_im, P.s5_c_re, P.s5_c_im, P.s5KmT, P.s5Smat, P.s5CmT, P.s5A, P.s5A64);
    for (int i = bid * 512 + tid; i < 2 * 144 * 1024 / 8; i += G * 512) {
        const int l = i / (144 * 128), r = i % (144 * 128);
        *(u32x4_t*)(P.w_in_t + ((size_t)l * 2560 + DINC) * 1024 + (size_t)r * 8) = (u32x4_t){0u, 0u, 0u, 0u};
    }
    __syncthreads();
    {
        const int wv = __builtin_amdgcn_readfirstlane(tid >> 6), lane = tid & 63;
        LAS3 float* tile = (LAS3 float*)lds + wv * (64 * 65);
        for (;;) {
            int base = 0;
            if (lane == 0) base = atomicAdd(P.queue + 2, 4);
            base = __builtin_amdgcn_readfirstlane(base);
            if (base >= CV_TOTAL) break;
            for (int it = base; it < base + 4 && it < CV_TOTAL; ++it) conv_dispatch(P, tile, lane, it);
        }
    }
}

__device__ __forceinline__ void row_modulate_store(const float (&xv)[16], const LAS3 float* nw, const LAS3 float* modr, bf16_t* __restrict__ dst, int lane) {
    float ss = 0.f;
#pragma unroll
    for (int i = 0; i < 16; ++i) ss += xv[i] * xv[i];
    ss = wave_sum(ss);
    const float rstd = rsqrtf(ss * (1.f / DM) + 1e-6f);
#pragma unroll
    for (int j = 0; j < 4; ++j) {
        const int d = j * 256 + lane * 4;
        const f32x4_t w = *(const LAS3 f32x4_t*)(nw + d), sh = *(const LAS3 f32x4_t*)(modr + d), sc = *(const LAS3 f32x4_t*)(modr + 1024 + d);
        const float o0 = xv[j * 4 + 0] * rstd * w[0] * (1.f + sc[0]) + sh[0], o1 = xv[j * 4 + 1] * rstd * w[1] * (1.f + sc[1]) + sh[1];
        const float o2 = xv[j * 4 + 2] * rstd * w[2] * (1.f + sc[2]) + sh[2], o3 = xv[j * 4 + 3] * rstd * w[3] * (1.f + sc[3]) + sh[3];
        *(uint2*)(dst + d) = make_uint2(cvtpk(o0, o1), cvtpk(o2, o3));
    }
}
__device__ __forceinline__ void phase_h0(const Params& P, LAS3 unsigned char* lds) {
    const int tid = opaque_tid(); const int lane = tid & 63, gw = blockIdx.x * 8 + (tid >> 6), NW = gridDim.x * 8;
    LAS3 float* cw = (LAS3 float*)lds;
    for (int i = tid; i < 256; i += 512) *(LAS3 f32x4_t*)(cw + i * 4) = *(const f32x4_t*)(P.norm_w + i * 4);
    for (int i = tid; i < 9 * 512; i += 512) { const int r = i >> 9, k = i & 511; *(LAS3 f32x4_t*)(cw + 1024 + r * 2048 + k * 4) = *(const f32x4_t*)(P.mod + (size_t)r * 6144 + k * 4); }
    __syncthreads();
    for (int t = gw; t < TT; t += NW) {
        const int b = t / NT, n = t % NT;
        const float* src = (n < NC) ? P.ctx + ((size_t)b * NC + n) * DM : P.x + ((size_t)b * NS + (n - NC)) * DM;
        float xv[16];
#pragma unroll
        for (int j = 0; j < 4; ++j) { const float4 v = *(const float4*)(src + j * 256 + lane * 4); xv[j * 4] = v.x; xv[j * 4 + 1] = v.y; xv[j * 4 + 2] = v.z; xv[j * 4 + 3] = v.w; }
        row_modulate_store(xv, cw, cw + 1024 + ((n < NC) ? 8 : b) * 2048, P.hbuf + (size_t)t * DM, lane);
    }
}

constexpr int TS_ROW = 264;
__device__ __forceinline__ void write_transposed(const LAS3 bf16_t* ts, bf16_t* __restrict__ dst, int b, int n0, int tid) {
    const int ch = tid & 255, hf = tid >> 8;
    bf16_t* vp = dst + (((size_t)b * 4 + (ch >> 6)) * 64 + (ch & 63)) * NT + n0 + hf * 32;
#pragma unroll
    for (int tc = 0; tc < 4; ++tc) {
        const LAS3 bf16_t* tp = ts + (hf * 32 + tc * 8) * TS_ROW + ch;
        u32x4_t o;
        o.x = (unsigned)tp[0] | ((unsigned)tp[TS_ROW] << 16); o.y = (unsigned)tp[2 * TS_ROW] | ((unsigned)tp[3 * TS_ROW] << 16);
        o.z = (unsigned)tp[4 * TS_ROW] | ((unsigned)tp[5 * TS_ROW] << 16); o.w = (unsigned)tp[6 * TS_ROW] | ((unsigned)tp[7 * TS_ROW] << 16);
        *(u32x4_t*)(vp + tc * 8) = o;
    }
}
__device__ __forceinline__ void unpack8(const u32x4_t v, float (&f)[8]) {
    f[0] = __uint_as_float(v.x << 16); f[1] = __uint_as_float(v.x & 0xFFFF0000u); f[2] = __uint_as_float(v.y << 16); f[3] = __uint_as_float(v.y & 0xFFFF0000u);
    f[4] = __uint_as_float(v.z << 16); f[5] = __uint_as_float(v.z & 0xFFFF0000u); f[6] = __uint_as_float(v.w << 16); f[7] = __uint_as_float(v.w & 0xFFFF0000u);
}
__device__ __forceinline__ u32x4_t pack8(const float (&f)[8]) { return (u32x4_t){cvtpk(f[0], f[1]), cvtpk(f[2], f[3]), cvtpk(f[4], f[5]), cvtpk(f[6], f[7])}; }

__device__ __forceinline__ void prep_da(const Params& P, LAS3 unsigned char* lds, int tile) {
    const int tid = opaque_tid();
    const int t0 = tile * 64, b = t0 / NT, n0 = t0 % NT;
    LAS3 bf16_t* vs = (LAS3 bf16_t*)lds;
    const float qscale = 0.17677669529663687f * 1.4426950408889634f;
    const bf16_t* __restrict__ pbr = P.pb; const float* __restrict__ rcs = P.ropecs;
    __syncthreads();
    {
        u32x4_t vv[4];
#pragma unroll
        for (int u = 0; u < 4; ++u) { const int id = tid + 512 * u, i = id >> 5, cg = id & 31; vv[u] = *(const u32x4_t*)(pbr + (size_t)(t0 + i) * DIN + P_DAV + cg * 8); }
#pragma unroll
        for (int u = 0; u < 4; ++u) { const int id = tid + 512 * u, i = id >> 5, cg = id & 31; *(LAS3 u32x4_t*)(vs + i * TS_ROW + cg * 8) = vv[u]; }
    }
#pragma unroll
    for (int u0 = 0; u0 < 4; u0 += 2) {
        u32x4_t lo[2], hi[2]; float4 cs[2][4];
#pragma unroll
        for (int u = 0; u < 2; ++u) {
            const int id = tid + 512 * (u0 + u), i = id >> 5, pu = id & 31, isk = pu >> 4, blk = (pu >> 1) & 7, pr = pu & 1;
            const bf16_t* src = pbr + (size_t)(t0 + i) * DIN + (isk ? P_DAK : P_DAQ) + blk * 32 + pr * 8;
            lo[u] = *(const u32x4_t*)src; hi[u] = *(const u32x4_t*)(src + 16);
            const int pos = max(n0 + i - NC, 0);
            const float4* cp = (const float4*)(rcs + (pos * 16 + pr * 8) * 2);
            cs[u][0] = cp[0]; cs[u][1] = cp[1]; cs[u][2] = cp[2]; cs[u][3] = cp[3];
        }
#pragma unroll
        for (int u = 0; u < 2; ++u) {
            const int id = tid + 512 * (u0 + u), i = id >> 5, pu = id & 31, isk = pu >> 4, blk = (pu >> 1) & 7, pr = pu & 1;
            const int n = n0 + i; const bool lat = n >= NC;
            float fl[8], fh[8], ol[8], oh[8];
            unpack8(lo[u], fl); unpack8(hi[u], fh);
            const float cc[8] = {cs[u][0].x, cs[u][0].z, cs[u][1].x, cs[u][1].z, cs[u][2].x, cs[u][2].z, cs[u][3].x, cs[u][3].z};
            const float sn[8] = {cs[u][0].y, cs[u][0].w, cs[u][1].y, cs[u][1].w, cs[u][2].y, cs[u][2].w, cs[u][3].y, cs[u][3].w};
            const float sc = isk ? 1.f : qscale;
#pragma unroll
            for (int e = 0; e < 8; ++e) {
                const float c1 = lat ? cc[e] : 1.f, s1 = lat ? sn[e] : 0.f;
                ol[e] = (fl[e] * c1 - fh[e] * s1) * sc; oh[e] = (fh[e] * c1 + fl[e] * s1) * sc;
            }
            bf16_t* dst = (isk ? P.daK : P.daQ) + (((size_t)b * 4 + (blk >> 1)) * NT + n) * 64 + (blk & 1) * 32 + pr * 8;
            *(u32x4_t*)dst = pack8(ol); *(u32x4_t*)(dst + 16) = pack8(oh);
        }
    }
    __syncthreads();
    write_transposed(vs, P.daVt, b, n0, tid);
}
__device__ __forceinline__ void prep_ml(const Params& P, LAS3 unsigned char* lds, int tile, int l) {
    const int tid = opaque_tid();
    const int t0 = tile * 64, b = t0 / NT, n0 = t0 % NT;
    LAS3 bf16_t* ks = (LAS3 bf16_t*)lds; LAS3 bf16_t* vs = ks + 64 * TS_ROW; LAS3 float* cwl = (LAS3 float*)(vs + 64 * TS_ROW);
    const int seg_lo = (n0 < NC) ? 0 : NC, seg_hi = (n0 < NC) ? NC - 1 : NT - 1;
    const bf16_t* __restrict__ pbr = P.pb;
    __syncthreads();
    for (int i = tid; i < 2048; i += 512) cwl[i] = (i < 1536) ? P.ml_conv_w[l * 1536 + i] : P.ml_conv_b[l * 512 + (i - 1536)];
    {
        u32x4_t vv[4];
#pragma unroll
        for (int u = 0; u < 4; ++u) { const int id = tid + 512 * u, i = id >> 5, cg = id & 31; vv[u] = *(const u32x4_t*)(pbr + (size_t)(t0 + i) * DIN + P_MLV + cg * 8); }
#pragma unroll
        for (int u = 0; u < 4; ++u) { const int id = tid + 512 * u, i = id >> 5, cg = id & 31; *(LAS3 u32x4_t*)(vs + i * TS_ROW + cg * 8) = vv[u]; }
        if (tid < 128) {
            const int i = tid >> 1, hf = tid & 1; float g[8];
            unpack8(*(const u32x4_t*)(pbr + (size_t)(t0 + i) * DIN + P_MLG + hf * 8), g);
#pragma unroll
            for (int e = 0; e < 8; ++e) { const int c = hf * 8 + e; g[e] += P.ml_gate_b[l * 16 + c]; if ((c >> 2) & 1) g[e] = logsigmoidf_(g[e]); }
            float* gp = P.mlG + ((size_t)t0 + i) * 16 + hf * 8;
            *(float4*)gp = make_float4(g[0], g[1], g[2], g[3]); *(float4*)(gp + 4) = make_float4(g[4], g[5], g[6], g[7]);
        }
    }
    __syncthreads();
#pragma unroll 1
    for (int u0 = 0; u0 < 8; u0 += 2) {
        u32x4_t xm[2], x0[2], xp[2];
#pragma unroll
        for (int u = 0; u < 2; ++u) {
            const int id = tid + 512 * (u0 + u), i = id >> 6, cg = id & 63, n = n0 + i;
            const int nm = max(n - 1, seg_lo), np = min(n + 1, seg_hi);
            const bf16_t* base = pbr + (size_t)b * NT * DIN + P_MLQK + cg * 8;
            xm[u] = *(const u32x4_t*)(base + (size_t)nm * DIN); x0[u] = *(const u32x4_t*)(base + (size_t)n * DIN); xp[u] = *(const u32x4_t*)(base + (size_t)np * DIN);
        }
#pragma unroll
        for (int u = 0; u < 2; ++u) {
            const int id = tid + 512 * (u0 + u), i = id >> 6, cg = id & 63, n = n0 + i;
            const float m0 = (n - 1 >= seg_lo) ? 1.f : 0.f, m2 = (n + 1 <= seg_hi) ? 1.f : 0.f;
            float a[8], c0[8], d[8], y[8];
            unpack8(xm[u], a); unpack8(x0[u], c0); unpack8(xp[u], d);
            const LAS3 float* w = cwl + cg * 8;
#pragma unroll
            for (int e = 0; e < 8; ++e) {
                float v = w[1536 + e] + a[e] * w[e] * m0 + c0[e] * w[512 + e] + d[e] * w[1024 + e] * m2;
                v = siluf_(v); if (cg >= 32) v *= 0.125f;
                y[e] = v;
            }
            const u32x4_t o = pack8(y);
            const int cc = (cg & 31) * 8;
            bf16_t* dst = ((cg < 32) ? P.mlQ : P.mlK) + (((size_t)b * 4 + (cc >> 6)) * NT + n) * 64 + (cc & 63);
            *(u32x4_t*)dst = o;
            if (cg >= 32) *(LAS3 u32x4_t*)(ks + i * TS_ROW + cc) = o;
        }
    }
    __syncthreads();
    write_transposed(ks, P.mlKt, b, n0, tid);
    write_transposed(vs, P.mlVt, b, n0, tid);
}
__device__ __forceinline__ void prep_mla(const Params& P, LAS3 unsigned char* lds, int tile, int l) {
    const int tid = opaque_tid(), wid = tid >> 6, lane = tid & 63, lr = lane & 15, q = lane >> 4;
    const int t0 = tile * 64, b = t0 / NT, n0 = t0 % NT;
    constexpr int AROW = 328;
    LAS3 bf16_t* As = (LAS3 bf16_t*)lds;
    const float qscale = 0.10206207261596575f * 1.4426950408889634f;
    const float* qn = P.mla_q_norm + l * 192; const float* kvn = P.mla_kv_norm + l * 128;
    const bf16_t* __restrict__ pbr = P.pb; bf16_t* __restrict__ oMK = P.mK; const float* __restrict__ rcs = P.ropecs;
    __syncthreads();
    {
        const int i = tid >> 3, sidx = tid & 7;
        const bf16_t* pr = pbr + (size_t)(t0 + i) * DIN;
        u32x4_t cqv[3], ckv[2];
#pragma unroll
        for (int u = 0; u < 3; ++u) cqv[u] = *(const u32x4_t*)(pr + P_CQ + (sidx + 8 * u) * 8);
#pragma unroll
        for (int u = 0; u < 2; ++u) ckv[u] = *(const u32x4_t*)(pr + P_CKV + (sidx + 8 * u) * 8);
        float fq[3][8], fk[2][8]; float sq = 0.f, sk = 0.f;
#pragma unroll
        for (int u = 0; u < 3; ++u) { unpack8(cqv[u], fq[u]);
#pragma unroll
            for (int e = 0; e < 8; ++e) sq += fq[u][e] * fq[u][e]; }
#pragma unroll
        for (int u = 0; u < 2; ++u) { unpack8(ckv[u], fk[u]);
#pragma unroll
            for (int e = 0; e < 8; ++e) sk += fk[u][e] * fk[u][e]; }
#pragma unroll
        for (int o = 1; o < 8; o <<= 1) { sq += __shfl_xor(sq, o); sk += __shfl_xor(sk, o); }
        const float rq = rsqrtf(sq * (1.f / 192.f) + 1e-6f), rk = rsqrtf(sk * (1.f / 128.f) + 1e-6f);
#pragma unroll
        for (int u = 0; u < 3; ++u) { const int c0 = (sidx + 8 * u) * 8; float o[8];
#pragma unroll
            for (int e = 0; e < 8; ++e) o[e] = fq[u][e] * rq * qn[c0 + e];
            *(LAS3 u32x4_t*)(As + i * AROW + c0) = pack8(o); }
#pragma unroll
        for (int u = 0; u < 2; ++u) { const int c0 = (sidx + 8 * u) * 8; float o[8];
#pragma unroll
            for (int e = 0; e < 8; ++e) o[e] = fk[u][e] * rk * kvn[c0 + e];
            *(LAS3 u32x4_t*)(As + i * AROW + 192 + c0) = pack8(o); }
    }
    if (tid < 256) {
        const int i = tid >> 2, c = tid & 3, n = n0 + i; const bool lat = n >= NC;
        const bf16_t* pr = pbr + (size_t)(t0 + i) * DIN + P_KR;
        const u32x4_t kav = *(const u32x4_t*)(pr + 8 * c), kbv = *(const u32x4_t*)(pr + 8 * (c ^ 2));
        const int pos = max(n - NC, 0);
        const float4* cp = (const float4*)(rcs + (pos * 16 + 8 * (c & 1)) * 2);
        const float4 c0 = cp[0], c1 = cp[1], c2 = cp[2], c3 = cp[3];
        const float sg = (c < 2) ? -1.f : 1.f;
        float ka[8], kb2[8], ko[8];
        unpack8(kav, ka); unpack8(kbv, kb2);
#define RK_(e, cc, ss) ko[e] = ka[e] * (lat ? (cc) : 1.f) + kb2[e] * (lat ? (ss) * sg : 0.f)
        RK_(0, c0.x, c0.y); RK_(1, c0.z, c0.w); RK_(2, c1.x, c1.y); RK_(3, c1.z, c1.w); RK_(4, c2.x, c2.y); RK_(5, c2.z, c2.w); RK_(6, c3.x, c3.y); RK_(7, c3.z, c3.w);
#undef RK_
        const u32x4_t ov = pack8(ko);
#pragma unroll
        for (int hh = 0; hh < 4; ++hh) *(u32x4_t*)(oMK + (((size_t)b * 4 + hh) * NT + n) * 96 + 64 + 8 * c) = ov;
    }
    __syncthreads();
    const int h = wid >> 1;
    if ((wid & 1) == 0) {
        const bf16_t* wt = P.wq_t + (size_t)l * 384 * 192;
        f32x4_t acc[4][6];
#pragma unroll
        for (int rt = 0; rt < 4; ++rt)
#pragma unroll
            for (int ct = 0; ct < 6; ++ct) acc[rt][ct] = (f32x4_t){0.f, 0.f, 0.f, 0.f};
#pragma unroll
        for (int ks = 0; ks < 6; ++ks) {
            bf16x8_t a[4];
#pragma unroll
            for (int rt = 0; rt < 4; ++rt) a[rt] = *(const LAS3 bf16x8_t*)(As + (16 * rt + lr) * AROW + 32 * ks + 8 * q);
#pragma unroll
            for (int ct = 0; ct < 6; ++ct) {
                const bf16x8_t bb = *(const bf16x8_t*)(wt + (size_t)(h * 96 + 16 * ct + lr) * 192 + 32 * ks + 8 * q);
#pragma unroll
                for (int rt = 0; rt < 4; ++rt) acc[rt][ct] = __builtin_amdgcn_mfma_f32_16x16x32_bf16(bb, a[rt], acc[rt][ct], 0, 0, 0);
            }
        }
#pragma unroll
        for (int rt = 0; rt < 4; ++rt) {
            const int n = n0 + 16 * rt + lr;
            bf16_t* qp = P.mQ + (((size_t)b * 4 + h) * NT + n) * 96;
#pragma unroll
            for (int ct = 0; ct < 4; ++ct)
                *(uint2*)(qp + 16 * ct + 4 * q) = make_uint2(cvtpk(acc[rt][ct][0] * qscale, acc[rt][ct][1] * qscale), cvtpk(acc[rt][ct][2] * qscale, acc[rt][ct][3] * qscale));
            f32x4_t x1 = acc[rt][4], x2 = acc[rt][5];
            if (n >= NC) {
                const float4* cp = (const float4*)(rcs + ((n - NC) * 16 + 4 * q) * 2);
                const float4 ca = cp[0], cb = cp[1];
                const f32x4_t co = (f32x4_t){ca.x, ca.z, cb.x, cb.z}, si = (f32x4_t){ca.y, ca.w, cb.y, cb.w};
                const f32x4_t o1 = x1 * co - x2 * si, o2 = x2 * co + x1 * si; x1 = o1; x2 = o2;
            }
            *(uint2*)(qp + 64 + 4 * q) = make_uint2(cvtpk(x1[0] * qscale, x1[1] * qscale), cvtpk(x1[2] * qscale, x1[3] * qscale));
            *(uint2*)(qp + 80 + 4 * q) = make_uint2(cvtpk(x2[0] * qscale, x2[1] * qscale), cvtpk(x2[2] * qscale, x2[3] * qscale));
        }
    } else {
        const bf16_t* wt = P.wkv_t + (size_t)l * 512 * 128;
#pragma unroll
        for (int pass = 0; pass < 2; ++pass) {
            f32x4_t acc[4][4];
#pragma unroll
            for (int rt = 0; rt < 4; ++rt)
#pragma unroll
                for (int ct = 0; ct < 4; ++ct) acc[rt][ct] = (f32x4_t){0.f, 0.f, 0.f, 0.f};
#pragma unroll
            for (int ks = 0; ks < 4; ++ks) {
                bf16x8_t a[4];
#pragma unroll
                for (int rt = 0; rt < 4; ++rt) a[rt] = *(const LAS3 bf16x8_t*)(As + (16 * rt + lr) * AROW + 192 + 32 * ks + 8 * q);
#pragma unroll
                for (int ct = 0; ct < 4; ++ct) {
                    const bf16x8_t bb = *(const bf16x8_t*)(wt + (size_t)(h * 128 + 16 * (4 * pass + ct) + lr) * 128 + 32 * ks + 8 * q);
#pragma unroll
                    for (int rt = 0; rt < 4; ++rt)
                        acc[rt][ct] = (pass == 0) ? __builtin_amdgcn_mfma_f32_16x16x32_bf16(bb, a[rt], acc[rt][ct], 0, 0, 0) : __builtin_amdgcn_mfma_f32_16x16x32_bf16(a[rt], bb, acc[rt][ct], 0, 0, 0);
                }
            }
#pragma unroll
            for (int rt = 0; rt < 4; ++rt) {
                if (pass == 0) {
                    const int n = n0 + 16 * rt + lr;
                    bf16_t* kp = P.mK + (((size_t)b * 4 + h) * NT + n) * 96;
#pragma unroll
                    for (int ct = 0; ct < 4; ++ct) *(uint2*)(kp + 16 * ct + 4 * q) = make_uint2(cvtpk(acc[rt][ct][0], acc[rt][ct][1]), cvtpk(acc[rt][ct][2], acc[rt][ct][3]));
                } else {
#pragma unroll
                    for (int ct = 0; ct < 4; ++ct) {
                        bf16_t* vp = P.mVt + (((size_t)b * 4 + h) * 64 + 16 * ct + lr) * NT + n0 + 16 * rt + 4 * q;
                        *(uint2*)vp = make_uint2(cvtpk(acc[rt][ct][0], acc[rt][ct][1]), cvtpk(acc[rt][ct][2], acc[rt][ct][3]));
                    }
                }
            }
        }
    }
}
__device__ __forceinline__ void phase_prep(const Params& P, LAS3 unsigned char* lds, int l) {
    for (int it = blockIdx.x; it < 3 * (TT / 64); it += gridDim.x) {
        const int fn = it % 3, tile = it / 3;
        if (fn == 0) prep_mla(P, lds, tile, l); else if (fn == 1) prep_ml(P, lds, tile, l); else prep_da(P, lds, tile);
    }
}

__device__ __forceinline__ void phase_mix(const Params& P, LAS3 unsigned char* lds, int l) {
    const int bid = blockIdx.x, G = gridDim.x;
    const float lambda_init = (l == 0) ? 0.2f : 0.35550906759096927f;
    for (int it = bid; it < 256; it += G)
    {
        const int pr = (it & 7) * 4 + (it >> 6), qb = (it >> 3) & 7;
        attn_item<64, 2, true>(lds, P.daQ, P.daK, P.daVt, P.ycatb, 0, pr >> 2, pr & 3, 1 + qb, P.lamfull[l], P.da_subln + l * 64, 1.f - lambda_init);
    }
    LAS3 int* slot = (LAS3 int*)(lds + MK_LDS_MAIN + 16);
    const int n_ml = 64, n_mla = 256, n_s5 = 256, n_ctx = (l == 0) ? 64 : 0;
    const int total = n_ml + n_mla + n_s5 + n_ctx;
    for (;;) {
        __syncthreads();
        if (threadIdx.x == 0) *slot = atomicAdd(P.queue + l, 1);
        __syncthreads();
        int it = __builtin_amdgcn_readfirstlane(*slot);
        if (it >= total) break;
        int kind, b, h, x3;
        if (it < n_ml) { kind = 1; b = it >> 3; h = (it >> 1) & 3; x3 = it & 1; }
        else if ((it -= n_ml) < n_mla) { kind = 2; b = it >> 5; h = (it >> 3) & 3; x3 = 1 + (it & 7); }
        else if ((it -= n_mla) < n_s5) { kind = 3; b = it >> 5; h = (it >> 1) & 15; x3 = it & 1; }
        else { it -= n_s5; kind = (it < 32) ? 0 : 2; it &= 31; b = it >> 2; h = it & 3; x3 = 0; }
        if (kind == 0) attn_item<64, 2, true>(lds, P.daQ, P.daK, P.daVt, P.ycatb, 0, b, h, x3, P.lamfull[l], P.da_subln + l * 64, 1.f - lambda_init);
        else if (kind == 1) mlstm_item(lds, P.mlQ, P.mlK, P.mlKt, P.mlVt, P.mlG, P.hdir, b, h, x3);
        else if (kind == 2) attn_item<96, 1, false>(lds, P.mQ, P.mK, P.mVt, P.ycatb, 512, b, h, x3, 0.f, nullptr, 1.f);
        else s5_item(lds, P.pb, P.s5KmT + (size_t)l * 32 * 16 * 1024, P.s5Smat + (size_t)l * 32 * 128 * 1024, P.s5CmT + (size_t)l * 32 * 16 * 128,
                     P.s5A + l * 32 * 64 * 2, P.s5A64 + l * 32 * 64 * 2, P.s5xs, P.ys5, b, h, x3);
    }
}

template <int TOK, int BATCH>
__device__ __forceinline__ void phase_finish_t(const Params& P, LAS3 unsigned char* lds, int l) {
    constexpr int RT = (TOK + 15) / 16;
    const int tid = opaque_tid(), wid = tid >> 6, lane = tid & 63, lr = lane & 15, q = lane >> 4, c = tid & 255, half = tid >> 8;
    const int ntile = (l == 0) ? TT / TOK : NB * (NS / TOK);
    constexpr int GROW = 264;
    LAS3 bf16_t* Gs = (LAS3 bf16_t*)lds;
    const float* mn = P.ml_norm + l * 256; const float* dsk = P.s5_d + l * 256; const float* bgl = P.s5_b_glu + l * 256;
    const bf16_t* wg = P.wglu_t + (size_t)l * 256 * 256;
    const bf16_t* __restrict__ pbr = P.pb; const bf16_t* __restrict__ hdr = (const bf16_t*)P.hdir; const bf16_t* __restrict__ ysr = (const bf16_t*)P.ys5; bf16_t* __restrict__ oY = P.ycatb;
    for (int it = blockIdx.x; it < ntile; it += gridDim.x) {
        const int t0 = (l == 0) ? it * TOK : ((it / (NS / TOK)) * NT + NC + (it % (NS / TOK)) * TOK);
        __syncthreads();
        {
            const int cg = tid & 31, ts = tid >> 5, c0 = 8 * cg;
            float mnv[8], dsv[8];
            { const float4 m0 = *(const float4*)(mn + c0), m1 = *(const float4*)(mn + c0 + 4), d0 = *(const float4*)(dsk + c0), d1 = *(const float4*)(dsk + c0 + 4);
              mnv[0] = m0.x; mnv[1] = m0.y; mnv[2] = m0.z; mnv[3] = m0.w; mnv[4] = m1.x; mnv[5] = m1.y; mnv[6] = m1.z; mnv[7] = m1.w;
              dsv[0] = d0.x; dsv[1] = d0.y; dsv[2] = d0.z; dsv[3] = d0.w; dsv[4] = d1.x; dsv[5] = d1.y; dsv[6] = d1.z; dsv[7] = d1.w; }
            constexpr int NP = (TOK + 15) / 16;
#pragma unroll
            for (int k0 = 0; k0 < NP; k0 += 2) {
                u32x4_t vog[2], vuu[2], vhf[2], vhb[2], vyf[2], vyb[2];
#pragma unroll
                for (int u = 0; u < 2; ++u) {
                    const int tok = ts + 16 * (k0 + u), tc = (tok < TOK) ? tok : TOK - 1;
                    const size_t t = (size_t)t0 + tc; const bf16_t* pr = pbr + t * DIN;
                    vog[u] = *(const u32x4_t*)(pr + P_MLO + c0); vuu[u] = *(const u32x4_t*)(pr + P_S5 + c0);
                    vhf[u] = *(const u32x4_t*)(hdr + t * 256 + c0); vhb[u] = *(const u32x4_t*)(hdr + ((size_t)TT + t) * 256 + c0);
                    vyf[u] = *(const u32x4_t*)(ysr + t * 256 + c0); vyb[u] = *(const u32x4_t*)(ysr + ((size_t)TT + t) * 256 + c0);
                }
#pragma unroll
                for (int u = 0; u < 2; ++u) {
                    const int tok = ts + 16 * (k0 + u);
                    float og[8], uu[8], hf[8], hb[8], yf[8], yb[8], hv[8], go[8];
                    unpack8(vog[u], og); unpack8(vuu[u], uu); unpack8(vhf[u], hf); unpack8(vhb[u], hb); unpack8(vyf[u], yf); unpack8(vyb[u], yb);
                    float ssq = 0.f;
#pragma unroll
                    for (int e = 0; e < 8; ++e) { hv[e] = sigmoidf_(og[e]) * (hf[e] + hb[e]); ssq += hv[e] * hv[e]; go[e] = gelu_tanh_(yf[e] + yb[e] + uu[e] * dsv[e]); }
                    ssq += __shfl_xor(ssq, 1); ssq += __shfl_xor(ssq, 2); ssq += __shfl_xor(ssq, 4);
                    const float r = rsqrtf(ssq * (1.f / 64.f) + 1e-6f);
#pragma unroll
                    for (int e = 0; e < 8; ++e) hv[e] = hv[e] * r * mnv[e];
                    if (NP * 16 == TOK || tok < TOK) {
                        *(u32x4_t*)(oY + ((size_t)t0 + tok) * DM + 256 + c0) = pack8(hv);
                        *(LAS3 u32x4_t*)(Gs + tok * GROW + c0) = pack8(go);
                    }
                }
            }
        }
        __syncthreads();
        f32x4_t acc[RT][2];
#pragma unroll
        for (int rt = 0; rt < RT; ++rt) { acc[rt][0] = (f32x4_t){0.f, 0.f, 0.f, 0.f}; acc[rt][1] = (f32x4_t){0.f, 0.f, 0.f, 0.f}; }
#pragma unroll
        for (int ks = 0; ks < 8; ++ks) {
            const bf16x8_t b0 = *(const bf16x8_t*)(wg + (size_t)(32 * wid + lr) * 256 + 32 * ks + 8 * q);
            const bf16x8_t b1 = *(const bf16x8_t*)(wg + (size_t)(32 * wid + 16 + lr) * 256 + 32 * ks + 8 * q);
#pragma unroll
            for (int rt = 0; rt < RT; ++rt) {
                const bf16x8_t a = *(const LAS3 bf16x8_t*)(Gs + (16 * rt + lr) * GROW + 32 * ks + 8 * q);
                acc[rt][0] = __builtin_amdgcn_mfma_f32_16x16x32_bf16(a, b0, acc[rt][0], 0, 0, 0);
                acc[rt][1] = __builtin_amdgcn_mfma_f32_16x16x32_bf16(a, b1, acc[rt][1], 0, 0, 0);
            }
        }
#pragma unroll
        for (int rt = 0; rt < RT; ++rt)
#pragma unroll
            for (int cc = 0; cc < 2; ++cc)
#pragma unroll
                for (int rg = 0; rg < 4; ++rg) {
                    const int row = 16 * rt + 4 * q + rg, col = 32 * wid + 16 * cc + lr;
                    const float gv = bf2f(Gs[row * GROW + col]);
                    if (TOK % 16 == 0 || row < TOK) P.ycatb[((size_t)t0 + row) * DM + 768 + col] = f2bf(gv * sigmoidf_(acc[rt][cc][rg] + bgl[col]));
                }
    }
}
__device__ __forceinline__ void phase_finish(const Params& P, LAS3 unsigned char* lds, int l) {
    if (l == 0) phase_finish_t<72, 12>(P, lds, l); else phase_finish_t<64, 8>(P, lds, l);
}

__device__ __forceinline__ void phase_post(const Params& P, LAS3 unsigned char* lds, int l) {
    const int tid = opaque_tid(), wid = tid >> 6, lane = tid & 63, lr = lane & 15, q = lane >> 4;
    constexpr int FROW = 1028, HROW = 1032;
    LAS3 float* ft = (LAS3 float*)lds;
    LAS3 bf16_t* fhi = (LAS3 bf16_t*)lds; LAS3 bf16_t* flo = fhi + 16 * HROW;
    static_assert(2 * 16 * HROW * 2 <= 16 * FROW * 4 + 1024, "hi/lo images");
    LAS3 float* pl = ft + 16 * FROW + 256;
    const float* nw1 = P.norm_w + (size_t)l * 4096 + 1024; const float* nw2 = nw1 + 1024;
    const float* wr = P.moe_w_router + (size_t)l * 1024 * 32; const float* br = P.moe_b_router + l * 32;
    LAS3 int* lcnt = (LAS3 int*)(pl + 8 * 16 * 32);
    if (tid < 32) lcnt[tid] = 0;
    bf16x8_t whi[4][2], wlo[4][2];
#pragma unroll
    for (int kb = 0; kb < 4; ++kb)
#pragma unroll
        for (int hx = 0; hx < 2; ++hx) {
            union { unsigned u[4]; bf16x8_t v; } uh, ul;
#pragma unroll
            for (int jj = 0; jj < 4; ++jj) {
                const float w0 = wr[(size_t)(128 * wid + 32 * kb + 8 * q + 2 * jj) * 32 + 16 * hx + lr], w1 = wr[(size_t)(128 * wid + 32 * kb + 8 * q + 2 * jj + 1) * 32 + 16 * hx + lr];
                const unsigned hb = cvtpk(w0, w1);
                uh.u[jj] = hb; ul.u[jj] = cvtpk(w0 - __uint_as_float(hb << 16), w1 - __uint_as_float(hb & 0xFFFF0000u));
            }
            whi[kb][hx] = uh.v; wlo[kb][hx] = ul.v;
        }
    const int nitem = (l == 0) ? TT / 16 : NB * NS / 16;
    const int tr = tid >> 5, part = tid & 31;
    LAS3 float* wl = (LAS3 float*)(lcnt + 32) + 16 * 32 + 16 * 4 + 16 * 4;
    float4 nm0 = make_float4(0.f, 0.f, 0.f, 0.f), nm1 = nm0;
#define POST_MODROW(it_) (P.mod + ((size_t)l * 9 + (((((l == 0) ? (it_) * 16 : (((it_) >> 7) * NT + NC + ((it_) & 127) * 16)) % NT) < NC) ? 8 : (((l == 0) ? (it_) * 16 : (((it_) >> 7) * NT + NC + ((it_) & 127) * 16)) / NT))) * 6144 + 2048)
    *(LAS3 f32x4_t*)(wl + tid * 4) = *(const f32x4_t*)(nw1 + tid * 4);
    if ((int)blockIdx.x < nitem) { const float* mrn = POST_MODROW((int)blockIdx.x); nm0 = *(const float4*)(mrn + tid * 4); if (tid < 256) nm1 = *(const float4*)(mrn + 2048 + tid * 4);
        *(LAS3 f32x4_t*)(wl + 2048 + tid * 4) = (f32x4_t){nm0.x, nm0.y, nm0.z, nm0.w}; if (tid < 256) *(LAS3 f32x4_t*)(wl + 4096 + tid * 4) = (f32x4_t){nm1.x, nm1.y, nm1.z, nm1.w}; }
    for (int it = blockIdx.x; it < nitem; it += gridDim.x) {
        const int t0 = (l == 0) ? it * 16 : ((it >> 7) * NT + NC + (it & 127) * 16);
        const int t = t0 + tr, b = t / NT, n = t % NT;
        const float* xin = (n < NC) ? P.ctx + ((size_t)b * NC + n) * DM : P.x + ((size_t)b * NS + (n - NC)) * DM;
        bf16_t* x1b = (bf16_t*)P.xall; const bf16_t* x2b = x1b + (size_t)TT * DM;
        __syncthreads();
        float x1[32];
        {
            float so = P.osq[(size_t)t * 16 + (part & 15)];
#pragma unroll
            for (int o = 8; o > 0; o >>= 1) so += __shfl_xor(so, o);
            const float rstd = rsqrtf(so * (1.f / DM) + 1e-6f);
            float ss = 0.f;
#pragma unroll
            for (int j = 0; j < 8; ++j) {
                const int d = j * 128 + part * 4;
                const uint2 ov = *(const uint2*)(P.ob + (size_t)t * DM + d);
                float4 xv;
                if (l == 0) xv = *(const float4*)(xin + d);
                else { const uint2 xb = *(const uint2*)(x2b + (size_t)t * DM + d); xv = make_float4(__uint_as_float(xb.x << 16), __uint_as_float(xb.x & 0xFFFF0000u), __uint_as_float(xb.y << 16), __uint_as_float(xb.y & 0xFFFF0000u)); }
                const f32x4_t wv_ = *(const LAS3 f32x4_t*)(wl + d), gv_ = *(const LAS3 f32x4_t*)(wl + 2048 + d);
                const float4 w = make_float4(wv_[0], wv_[1], wv_[2], wv_[3]), g1 = make_float4(gv_[0], gv_[1], gv_[2], gv_[3]);
                const float a0 = xv.x + g1.x * __uint_as_float(ov.x << 16) * rstd * w.x, a1 = xv.y + g1.y * __uint_as_float(ov.x & 0xFFFF0000u) * rstd * w.y;
                const float a2 = xv.z + g1.z * __uint_as_float(ov.y << 16) * rstd * w.z, a3 = xv.w + g1.w * __uint_as_float(ov.y & 0xFFFF0000u) * rstd * w.w;
                x1[j * 4] = a0; x1[j * 4 + 1] = a1; x1[j * 4 + 2] = a2; x1[j * 4 + 3] = a3;
                *(uint2*)(x1b + (size_t)t * DM + d) = make_uint2(cvtpk(a0, a1), cvtpk(a2, a3));
                ss += (a0 * a0 + a1 * a1) + (a2 * a2 + a3 * a3);
            }
#pragma unroll
            for (int o = 16; o > 0; o >>= 1) ss += __shfl_xor(ss, o);
            const float rstd2 = rsqrtf(ss * (1.f / DM) + 1e-6f);
#pragma unroll
            for (int j = 0; j < 8; ++j) {
                const int d = j * 128 + part * 4;
                const f32x4_t wv_ = *(const LAS3 f32x4_t*)(wl + 1024 + d), sv_ = *(const LAS3 f32x4_t*)(wl + 3072 + d), cv_ = *(const LAS3 f32x4_t*)(wl + 4096 + d);
                const float4 w = make_float4(wv_[0], wv_[1], wv_[2], wv_[3]), sh = make_float4(sv_[0], sv_[1], sv_[2], sv_[3]), sc = make_float4(cv_[0], cv_[1], cv_[2], cv_[3]);
                const float f0 = x1[j * 4] * rstd2 * w.x * (1.f + sc.x) + sh.x, f1 = x1[j * 4 + 1] * rstd2 * w.y * (1.f + sc.y) + sh.y;
                const float f2 = x1[j * 4 + 2] * rstd2 * w.z * (1.f + sc.z) + sh.z, f3 = x1[j * 4 + 3] * rstd2 * w.w * (1.f + sc.w) + sh.w;
                *(uint2*)(P.fb + (size_t)t * DM + d) = make_uint2(cvtpk(f0, f1), cvtpk(f2, f3));
                {
                    const unsigned h01 = cvtpk(f0, f1), h23 = cvtpk(f2, f3);
                    *(LAS3 u32x2_t*)(fhi + tr * HROW + d) = (u32x2_t){h01, h23};
                    *(LAS3 u32x2_t*)(flo + tr * HROW + d) = (u32x2_t){cvtpk(f0 - __uint_as_float(h01 << 16), f1 - __uint_as_float(h01 & 0xFFFF0000u)), cvtpk(f2 - __uint_as_float(h23 << 16), f3 - __uint_as_float(h23 & 0xFFFF0000u))};
                }
            }
        }
        __syncthreads();
        const bool hasn = it + (int)gridDim.x < nitem;
        if (hasn) { const float* mrn = POST_MODROW(it + (int)gridDim.x); nm0 = *(const float4*)(mrn + tid * 4); if (tid < 256) nm1 = *(const float4*)(mrn + 2048 + tid * 4); }
        {
            f32x4_t a0 = (f32x4_t){0.f, 0.f, 0.f, 0.f}, a1 = (f32x4_t){0.f, 0.f, 0.f, 0.f};
            bf16x8_t ah[4], al[4];
#pragma unroll
            for (int kb = 0; kb < 4; ++kb) { ah[kb] = *(const LAS3 bf16x8_t*)(fhi + lr * HROW + 128 * wid + 32 * kb + 8 * q); al[kb] = *(const LAS3 bf16x8_t*)(flo + lr * HROW + 128 * wid + 32 * kb + 8 * q); }
#pragma unroll
            for (int kb = 0; kb < 4; ++kb) {
                a0 = __builtin_amdgcn_mfma_f32_16x16x32_bf16(ah[kb], whi[kb][0], a0, 0, 0, 0); a1 = __builtin_amdgcn_mfma_f32_16x16x32_bf16(ah[kb], whi[kb][1], a1, 0, 0, 0);
                a0 = __builtin_amdgcn_mfma_f32_16x16x32_bf16(ah[kb], wlo[kb][0], a0, 0, 0, 0); a1 = __builtin_amdgcn_mfma_f32_16x16x32_bf16(ah[kb], wlo[kb][1], a1, 0, 0, 0);
                a0 = __builtin_amdgcn_mfma_f32_16x16x32_bf16(al[kb], whi[kb][0], a0, 0, 0, 0); a1 = __builtin_amdgcn_mfma_f32_16x16x32_bf16(al[kb], whi[kb][1], a1, 0, 0, 0);
            }
#pragma unroll
            for (int rg = 0; rg < 4; ++rg) { pl[(wid * 16 + 4 * q + rg) * 32 + lr] = a0[rg]; pl[(wid * 16 + 4 * q + rg) * 32 + 16 + lr] = a1[rg]; }
        }
        __syncthreads();
        {
            float lg = br[part];
#pragma unroll
            for (int w = 0; w < 8; ++w) lg += pl[(w * 16 + tr) * 32 + part];
            LAS3 float* lgs = (LAS3 float*)(lcnt + 32);
            LAS3 float* topv = lgs + 16 * 32;
            LAS3 int* topi = (LAS3 int*)(topv + 16 * 4);
            lgs[tr * 32 + part] = lg;
            asm volatile("s_waitcnt lgkmcnt(0)" ::: "memory");
            int rank = 0;
#pragma unroll
            for (int c4 = 0; c4 < 8; ++c4) {
                const f32x4_t lv = *(const LAS3 f32x4_t*)(lgs + tr * 32 + 4 * c4);
#pragma unroll
                for (int e = 0; e < 4; ++e) rank += (lv[e] > lg || (lv[e] == lg && (4 * c4 + e) < part)) ? 1 : 0;
            }
            if (rank < 4) { topv[tr * 4 + rank] = lg; topi[tr * 4 + rank] = part; }
            asm volatile("s_waitcnt lgkmcnt(0)" ::: "memory");
            if (part < 4) {
                const f32x4_t v = *(const LAS3 f32x4_t*)(topv + tr * 4);
                const int ek = topi[tr * 4 + part];
                const float e1 = __expf(v[1] - v[0]), e2 = __expf(v[2] - v[0]), e3 = __expf(v[3] - v[0]);
                const float inv = 1.f / (1.f + e1 + e2 + e3);
                const float gk = (part == 0) ? inv : (part == 1) ? e1 * inv : (part == 2) ? e2 * inv : e3 * inv;
                P.top_e[(size_t)t * 4 + part] = ek; P.top_g[(size_t)t * 4 + part] = gk;
                P.posb[(size_t)t * 4 + part] = __hip_atomic_fetch_add(&lcnt[ek], 1, __ATOMIC_RELAXED, __HIP_MEMORY_SCOPE_WORKGROUP);
            }
        }
        if (hasn) { *(LAS3 f32x4_t*)(wl + 2048 + tid * 4) = (f32x4_t){nm0.x, nm0.y, nm0.z, nm0.w}; if (tid < 256) *(LAS3 f32x4_t*)(wl + 4096 + tid * 4) = (f32x4_t){nm1.x, nm1.y, nm1.z, nm1.w}; }
    }
#undef POST_MODROW
    __syncthreads();
    if (tid < 32) P.blkcnt[((size_t)l * gridDim.x + blockIdx.x) * 32 + tid] = lcnt[tid];
}

__device__ __forceinline__ void phase_scatter(const Params& P, LAS3 unsigned char* lds, int l) {
    const int tid = opaque_tid(), wid = tid >> 6, lane = tid & 63;
    LAS3 int* soff = (LAS3 int*)lds;
    LAS3 int* part = soff + 64;
    LAS3 int* pre = soff + 1024;
    const int G = gridDim.x;
    const int* bc = P.blkcnt + (size_t)l * G * 32;
    __syncthreads();
    {
        const int e = tid & 31, pt = tid >> 5, per = (G + 15) / 16;
        int sum = 0;
        for (int b2 = pt * per; b2 < (pt + 1) * per && b2 < G; ++b2) sum += bc[b2 * 32 + e];
        part[pt * 32 + e] = sum;
        __syncthreads();
        int run = 0;
        for (int p2 = 0; p2 < pt; ++p2) run += part[p2 * 32 + e];
        for (int b2 = pt * per; b2 < (pt + 1) * per && b2 < G; ++b2) { pre[b2 * 32 + e] = run; run += bc[b2 * 32 + e]; }
        if (pt == 15) soff[32 + e] = run;
    }
    __syncthreads();
    if (tid == 0) {
        int o = 0, nt = 0;
        for (int e = 0; e < NE; ++e) {
            soff[e] = o; const int c = soff[32 + e];
            const int ntl = (c + 255) >> 8;
            if (blockIdx.x == 0) { for (int m = 0; m < ntl; ++m) P.tile_e[l * 512 + nt + m] = e; P.offs[l * 32 + e] = o; }
            nt += ntl; o = nt * 256;
        }
        if (blockIdx.x == 0) P.ntiles[l * 16] = nt;
    }
    __syncthreads();
    const int gt = blockIdx.x * 512 + tid, NTH = gridDim.x * 512;
    const int ntok = (l == 0) ? TT : NB * NS;
    int* __restrict__ stk = (int*)P.xg;
    for (int a = gt; a < ntok * 4; a += NTH) {
        const int i = a >> 2;
        const int t = (l == 0) ? i : ((i >> 11) * NT + NC + (i & 2047));
        const int ek = P.top_e[(size_t)t * 4 + (a & 3)];
        const int slot = soff[ek] + pre[((i >> 4) % G) * 32 + ek] + P.posb[(size_t)t * 4 + (a & 3)];
        stk[slot] = t; P.tok_slot[(size_t)t * 4 + (a & 3)] = slot;
    }
    for (int i = gt; i < NE * 256; i += NTH) {
        const int e = i >> 8, j = i & 255, c = soff[32 + e];
        const int padn = ((c + 255) & ~255) - c;
        if (j < padn) stk[soff[e] + c + j] = NC;
    }
}

__device__ __forceinline__ void phase_combine(const Params& P, LAS3 unsigned char* lds, int l) {
    const int tid = opaque_tid(); const int lane = tid & 63, gw = blockIdx.x * 8 + (tid >> 6), NW = gridDim.x * 8;
    const float* __restrict__ nw3 = P.norm_w + (size_t)l * 4096 + 3072;
    const float* __restrict__ nwn = P.norm_w + 4096;
    const int* __restrict__ tsl = P.tok_slot; const float* __restrict__ tg = P.top_g; const bf16_t* __restrict__ ye = P.yexp; const float* __restrict__ modp = P.mod;
    const int ntok = (l == 0) ? TT : NB * NS;
    LAS3 float* cw = (LAS3 float*)lds;
    for (int i = tid; i < 256; i += 512) { *(LAS3 f32x4_t*)(cw + i * 4) = *(const f32x4_t*)(nw3 + i * 4); if (l == 0) *(LAS3 f32x4_t*)(cw + 1024 + i * 4) = *(const f32x4_t*)(nwn + i * 4); }
    for (int i = tid; i < 9 * 256; i += 512) { const int r = i >> 8, k = i & 255; *(LAS3 f32x4_t*)(cw + 2048 + r * 1024 + k * 4) = *(const f32x4_t*)(modp + ((size_t)l * 9 + r) * 6144 + 5120 + k * 4); }
    if (l == 0) for (int i = tid; i < 9 * 512; i += 512) { const int r = i >> 9, k = i & 511; *(LAS3 f32x4_t*)(cw + 11264 + r * 2048 + k * 4) = *(const f32x4_t*)(modp + ((size_t)9 + r) * 6144 + k * 4); }
    __syncthreads();
    const bf16_t* __restrict__ x1b = (const bf16_t*)P.xall; bf16_t* __restrict__ x2b = (bf16_t*)P.xall + (size_t)TT * DM;
    int i = gw;
    int4 sl = make_int4(0, 0, 0, 0); float4 gt = make_float4(0.f, 0.f, 0.f, 0.f);
    if (i < ntok) { const int t = (l == 0) ? i : ((i >> 11) * NT + NC + (i & 2047)); sl = *(const int4*)(tsl + (size_t)t * 4); gt = *(const float4*)(tg + (size_t)t * 4); }
    for (; i < ntok; i += NW) {
        const int t = (l == 0) ? i : ((i >> 11) * NT + NC + (i & 2047));
        const int b = t / NT, n = t % NT, r = (n < NC) ? 8 : b;
        const int4 slc = sl; const float4 gtc = gt;
        uint2 yv[4][4];
        const int slots[4] = {slc.x, slc.y, slc.z, slc.w};
#pragma unroll
        for (int k = 0; k < 4; ++k)
#pragma unroll
            for (int j = 0; j < 4; ++j) yv[k][j] = *(const uint2*)(ye + (size_t)slots[k] * DM + j * 256 + lane * 4);
        float4 x1[4], w3[4], g2[4], wn[4], scn[4], shn[4];
#define CW4(p_) ({ const f32x4_t v_ = *(const LAS3 f32x4_t*)(p_); make_float4(v_[0], v_[1], v_[2], v_[3]); })
#pragma unroll
        for (int j = 0; j < 4; ++j) {
            const int d = j * 256 + lane * 4;
            { const uint2 xb = *(const uint2*)(x1b + (size_t)t * DM + d); x1[j] = make_float4(__uint_as_float(xb.x << 16), __uint_as_float(xb.x & 0xFFFF0000u), __uint_as_float(xb.y << 16), __uint_as_float(xb.y & 0xFFFF0000u)); }
            w3[j] = CW4(cw + d); g2[j] = CW4(cw + 2048 + r * 1024 + d);
            if (l == 0) { wn[j] = CW4(cw + 1024 + d); scn[j] = CW4(cw + 11264 + r * 2048 + 1024 + d); shn[j] = CW4(cw + 11264 + r * 2048 + d); }
        }
        { const int in = i + NW; if (in < ntok) { const int tn = (l == 0) ? in : ((in >> 11) * NT + NC + (in & 2047)); sl = *(const int4*)(tsl + (size_t)tn * 4); gt = *(const float4*)(tg + (size_t)tn * 4); } }
        const float gk[4] = {gtc.x, gtc.y, gtc.z, gtc.w};
        float m[16];
#pragma unroll
        for (int j = 0; j < 16; ++j) m[j] = 0.f;
#pragma unroll
        for (int k = 0; k < 4; ++k)
#pragma unroll
            for (int j = 0; j < 4; ++j) {
                m[j * 4] += gk[k] * __uint_as_float(yv[k][j].x << 16); m[j * 4 + 1] += gk[k] * __uint_as_float(yv[k][j].x & 0xFFFF0000u);
                m[j * 4 + 2] += gk[k] * __uint_as_float(yv[k][j].y << 16); m[j * 4 + 3] += gk[k] * __uint_as_float(yv[k][j].y & 0xFFFF0000u);
            }
        float ss = 0.f;
#pragma unroll
        for (int j = 0; j < 16; ++j) ss += m[j] * m[j];
        const float rstd = rsqrtf(wave_sum(ss) * (1.f / DM) + 1e-6f);
        float xv[16]; float s2 = 0.f;
#pragma unroll
        for (int j = 0; j < 4; ++j) {
            const int d = j * 256 + lane * 4;
            xv[j * 4] = x1[j].x + g2[j].x * m[j * 4] * rstd * w3[j].x; xv[j * 4 + 1] = x1[j].y + g2[j].y * m[j * 4 + 1] * rstd * w3[j].y;
            xv[j * 4 + 2] = x1[j].z + g2[j].z * m[j * 4 + 2] * rstd * w3[j].z; xv[j * 4 + 3] = x1[j].w + g2[j].w * m[j * 4 + 3] * rstd * w3[j].w;
            s2 += (xv[j * 4] * xv[j * 4] + xv[j * 4 + 1] * xv[j * 4 + 1]) + (xv[j * 4 + 2] * xv[j * 4 + 2] + xv[j * 4 + 3] * xv[j * 4 + 3]);
            const float4 o = make_float4(xv[j * 4], xv[j * 4 + 1], xv[j * 4 + 2], xv[j * 4 + 3]);
            if (l == 0) *(uint2*)(x2b + (size_t)t * DM + d) = make_uint2(cvtpk(o.x, o.y), cvtpk(o.z, o.w));
            else *(float4*)(P.out + ((size_t)b * NS + (n - NC)) * DM + d) = o;
        }
        if (l == 0) {
            const float rs2 = rsqrtf(wave_sum(s2) * (1.f / DM) + 1e-6f);
#pragma unroll
            for (int j = 0; j < 4; ++j) {
                const int d = j * 256 + lane * 4;
                const float o0 = xv[j * 4] * rs2 * wn[j].x * (1.f + scn[j].x) + shn[j].x, o1 = xv[j * 4 + 1] * rs2 * wn[j].y * (1.f + scn[j].y) + shn[j].y;
                const float o2 = xv[j * 4 + 2] * rs2 * wn[j].z * (1.f + scn[j].z) + shn[j].z, o3 = xv[j * 4 + 3] * rs2 * wn[j].w * (1.f + scn[j].w) + shn[j].w;
                *(uint2*)(P.hbuf + (size_t)t * DM + d) = make_uint2(cvtpk(o0, o1), cvtpk(o2, o3));
            }
        }
    }
}

extern __shared__ __attribute__((aligned(16))) unsigned char dyn_lds[];
__device__ __forceinline__ void run_phase(const Params& P, LAS3 unsigned char* lds, int ph) {
    if (ph == PH_SETUP) { phase_setup(P, lds); return; }
    if (ph == PH_H0) { phase_h0(P, lds); return; }
    const int l = (ph - PH_LAYER0) / PH_PER_LAYER, s = (ph - PH_LAYER0) % PH_PER_LAYER;
    switch (s) {
    case L_GEMM_IN: { pg8::Gemm g{P.hbuf, P.w_in_t + (size_t)l * 2560 * 1024, TT, 2560, 1024, 0}; pg8::StaticOrder S; S.init(TT, 2560, gridDim.x, blockIdx.x);
        pg8::EpiBf16P E{P.pb, DIN, 0}; pg8::gemm_phase<pg8::EpiBf16P, pg8::StaticOrder, true, true>(lds, g, S, E); } break;
    case L_PREP: phase_prep(P, lds, l); break;
    case L_MIX: phase_mix(P, lds, l); break;
    case L_FINISH: phase_finish(P, lds, l); break;
    case L_GEMM_OUT: { pg8::Gemm g{P.ycatb, P.w_out_t + (size_t)l * 1024 * 1024, TT, 1024, 1024, 0}; pg8::EpiOut E{P.ob, P.osq};
        if (l == 0) { pg8::StaticOrder S; S.init(TT, 1024, gridDim.x, blockIdx.x); pg8::gemm_phase<pg8::EpiOut, pg8::StaticOrder, true, true>(lds, g, S, E); }
        else { pg8::LatOrder S; S.initl(1024, gridDim.x, blockIdx.x); pg8::gemm_phase<pg8::EpiOut, pg8::LatOrder, true, true>(lds, g, S, E); } } break;
    case L_POST: phase_post(P, lds, l); break;
    case L_SCATTER: phase_scatter(P, lds, l); break;
    case L_GEMM_GU: { pg8::Gemm g{P.fb, P.wgu_t + (size_t)l * NE * 2048 * 1024, 0, 2048, 1024, 0}; pg8::GroupedOrder S; S.initg(P.ntiles + l * 16, P.tile_e + l * 512, 2048, gridDim.x, blockIdx.x);
        pg8::EpiSwiglu E{P.act, P.moe_b_gate_up + (size_t)l * NE * 2048}; pg8::gemm_phase<pg8::EpiSwiglu, pg8::GroupedOrder, true, true, true>(lds, g, S, E, (const int*)P.xg); } break;
    case L_GEMM_DN: { pg8::Gemm g{P.act, P.wdn_t + (size_t)l * NE * 1024 * 1024, 0, 1024, 1024, 0}; pg8::GroupedOrder S; S.initg(P.ntiles + l * 16, P.tile_e + l * 512, 1024, gridDim.x, blockIdx.x);
        pg8::EpiDown E{P.yexp, P.moe_b_down + (size_t)l * NE * 1024}; pg8::gemm_phase<pg8::EpiDown, pg8::GroupedOrder, true, true>(lds, g, S, E); } break;
    case L_COMBINE: phase_combine(P, lds, l); break;
    }
}
__global__ void __launch_bounds__(512, 2) mk_fwd(Params Pk, int ph_lo, int ph_hi) {
    LAS3 unsigned char* lds = (LAS3 unsigned char*)dyn_lds;
    volatile LAS3 unsigned* st = (volatile LAS3 unsigned*)(lds + MK_LDS_MAIN);
    LAS3 Params* PL = (LAS3 Params*)(lds + MK_LDS_MAIN + 64);
    static_assert(sizeof(Params) <= 1024, "Params copy does not fit its LDS slot");
    if (threadIdx.x < 4) st[threadIdx.x] = 0u;
    if (threadIdx.x == 64) store_params(PL, Pk);
    unsigned* barw = Pk.bar;
    __syncthreads();
    XcdBarrier bar; bar.bar = barw; bar.x = 0; bar.st = st;
    if (ph_hi - ph_lo > 1) bar = xcd_barrier_post(barw, st);
#define MK_RUN(ph) if (ph_lo <= (ph) && (ph) < ph_hi) { { const LAS3 Params* PLo = PL; asm volatile("" : "+v"(PLo)); LAS3 unsigned char* ldsp = lds; asm volatile("" : "+s"(ldsp)); \
        const Params P = load_params(PLo); run_phase(P, ldsp, (ph)); } if ((ph) + 1 < ph_hi) xcd_barrier(bar); }
    MK_RUN(0) MK_RUN(1) MK_RUN(2) MK_RUN(3) MK_RUN(4) MK_RUN(5) MK_RUN(6) MK_RUN(7) MK_RUN(8) MK_RUN(9) MK_RUN(10) MK_RUN(11)
    MK_RUN(12) MK_RUN(13) MK_RUN(14) MK_RUN(15) MK_RUN(16) MK_RUN(17) MK_RUN(18) MK_RUN(19) MK_RUN(20) MK_RUN(21)
#undef MK_RUN
}

extern "C" void kernel_launch(void* const* d_in, const int* in_sizes, int n_in, void* d_out, int out_size, void* d_ws, size_t ws_size, hipStream_t stream) {
    Params P{};
    const float** pin = (const float**)&P;
    for (int i = 0; i < 35; ++i) pin[i] = (const float*)d_in[i];
    P.out = (float*)d_out;
    char* ws = (char*)d_ws; size_t off = 0;
    auto carve = [&](size_t bytes) { void* p = ws + off; off += (bytes + 255) & ~(size_t)255; return p; };
    const size_t ctl_bytes = XCD_BAR_WORDS * 4 + 256 + 256;
    P.bar = (unsigned*)carve(XCD_BAR_WORDS * 4); P.queue = (int*)carve(256); P.cnt = (int*)carve(256);
    P.tile_e = (int*)carve(2 * 512 * 4); P.ntiles = (int*)carve(2 * 16 * 4); P.offs = (int*)carve(2 * 32 * 4); P.blkcnt = (int*)carve(2 * 256 * 32 * 4);
    P.xall = (float*)carve((size_t)TT * DM * 4); P.mod = (float*)carve((size_t)2 * 9 * 6144 * 4); P.ropecs = (float*)carve((size_t)NS * 16 * 2 * 4); P.lamfull = (float*)carve(256);
    P.w_in_t = (bf16_t*)carve((size_t)2 * 2560 * 1024 * 2); P.w_out_t = (bf16_t*)carve((size_t)2 * 1024 * 1024 * 2);
    P.wgu_t = (bf16_t*)carve((size_t)2 * NE * 2048 * 1024 * 2); P.wdn_t = (bf16_t*)carve((size_t)2 * NE * 1024 * 1024 * 2);
    P.wq_t = (bf16_t*)carve((size_t)2 * 384 * 192 * 2); P.wkv_t = (bf16_t*)carve((size_t)2 * 512 * 128 * 2); P.wglu_t = (bf16_t*)carve((size_t)2 * 256 * 256 * 2);
    P.s5KmT = (bf16_t*)carve((size_t)64 * 16 * 1024 * 2); P.s5Smat = (bf16_t*)carve((size_t)64 * 128 * 1024 * 2); P.s5CmT = (bf16_t*)carve((size_t)64 * 16 * 128 * 2);
    P.s5A = (float*)carve(64 * 64 * 2 * 4); P.s5A64 = (float*)carve(64 * 64 * 2 * 4); P.s5xs = (float*)carve((size_t)256 * 36 * 128 * 4);
    P.hbuf = (bf16_t*)carve((size_t)TT * DM * 2); P.pb = (bf16_t*)carve((size_t)TT * DIN * 2);
    P.daQ = (bf16_t*)carve((size_t)TT * 256 * 2); P.daK = (bf16_t*)carve((size_t)TT * 256 * 2); P.daVt = (bf16_t*)carve((size_t)TT * 256 * 2);
    P.mQ = (bf16_t*)carve((size_t)TT * 384 * 2); P.mK = (bf16_t*)carve((size_t)TT * 384 * 2); P.mVt = (bf16_t*)carve((size_t)TT * 256 * 2);
    P.mlQ = (bf16_t*)carve((size_t)TT * 256 * 2); P.mlK = (bf16_t*)carve((size_t)TT * 256 * 2); P.mlKt = (bf16_t*)carve((size_t)TT * 256 * 2); P.mlVt = (bf16_t*)carve((size_t)TT * 256 * 2);
    P.mlG = (float*)carve((size_t)TT * 16 * 4); P.hdir = (float*)carve((size_t)2 * TT * 256 * 4); P.ys5 = (float*)carve((size_t)2 * TT * 256 * 4);
    P.ycatb = (bf16_t*)carve((size_t)TT * DM * 2); P.ob = (bf16_t*)carve((size_t)TT * DM * 2); P.osq = (float*)carve((size_t)TT * 16 * 4); P.fb = (bf16_t*)carve((size_t)TT * DM * 2);
    P.top_e = (int*)carve((size_t)NASSIGN * 4); P.top_g = (float*)carve((size_t)NASSIGN * 4); P.posb = (int*)carve((size_t)NASSIGN * 4); P.tok_slot = (int*)carve((size_t)NASSIGN * 4);
    P.xg = (bf16_t*)carve((size_t)MAXSLOTS * DM * 2); P.act = (bf16_t*)carve((size_t)MAXSLOTS * DM * 2); P.yexp = (bf16_t*)carve((size_t)MAXSLOTS * DM * 2);
    if (off > ws_size) { fprintf(stderr, "kernel_launch: workspace too small: need %zu have %zu\n", off, ws_size); return; }
    static bool attr_done = false;
    if (!attr_done) {
        if (hipFuncSetAttribute((const void*)mk_fwd, hipFuncAttributeMaxDynamicSharedMemorySize, MK_LDS_BYTES) != hipSuccess) fprintf(stderr, "kernel_launch: hipFuncSetAttribute failed\n");
        attr_done = true;
    }
    (void)hipMemsetAsync(d_ws, 0, ctl_bytes, stream);
#if MK_ONE_LAUNCH
    hipLaunchKernelGGL(mk_fwd, dim3(256), dim3(512), MK_LDS_BYTES, stream, P, 0, (int)PH_TOTAL);
#else
    for (int ph = 0; ph < PH_TOTAL; ++ph) hipLaunchKernelGGL(mk_fwd, dim3(256), dim3(512), MK_LDS_BYTES, stream, P, ph, ph + 1);
#endif
}
```

```cpp
#include <hip/hip_runtime.h>
#include <cstdint>
#include <cstdio>

#define NB 8
#define NS 2048
#define NC 256
#define NT 2304
#define TT (NB * NT)
#define DM 1024
#define DIN 2560
#define DINC 2416
#define NE 32
#define NASSIGN (TT * 4)
#define MAXSLOTS (NASSIGN + NE * 256)

#define P_DAQ 0
#define P_DAK 256
#define P_DAV 512
#define P_MLQK 768
#define P_MLV 1280
#define P_MLO 1536
#define P_MLG 1792
#define P_CQ 1808
#define P_CKV 2000
#define P_KR 2128
#define P_S5 2160

#ifndef MK_ONE_LAUNCH
#define MK_ONE_LAUNCH 1
#endif

typedef unsigned short bf16_t;
__device__ __forceinline__ float sigmoidf_(float x) { return __builtin_amdgcn_rcpf(1.f + __expf(-x)); }
__device__ __forceinline__ float siluf_(float x) { return x * __builtin_amdgcn_rcpf(1.f + __expf(-x)); }
__device__ __forceinline__ float logsigmoidf_(float x) { return fminf(x, 0.f) - log1pf(__expf(-fabsf(x))); }
__device__ __forceinline__ float gelu_tanh_(float x) { const float u = 0.7978845608028654f * (x + 0.044715f * x * x * x); return x * __builtin_amdgcn_rcpf(1.f + __expf(-2.f * u)); }
typedef __bf16 bf16x2_nat __attribute__((ext_vector_type(2)));
typedef float f32x2_nat __attribute__((ext_vector_type(2)));
__device__ __forceinline__ unsigned cvtpk(float lo, float hi) { const f32x2_nat v = {lo, hi}; const bf16x2_nat b = __builtin_convertvector(v, bf16x2_nat); return __builtin_bit_cast(unsigned, b); }
__device__ __forceinline__ bf16_t f2bf(float f) { return (bf16_t)(cvtpk(f, 0.f) & 0xFFFFu); }
__device__ __forceinline__ float bf2f(bf16_t b) { return __uint_as_float(((unsigned)b) << 16); }
__device__ __forceinline__ unsigned pk2bf(float lo, float hi) { return cvtpk(lo, hi); }
__device__ __forceinline__ int opaque_tid() { int t = threadIdx.x; asm volatile("" : "+v"(t)); return t; }
__device__ __forceinline__ float wave_sum(float v) {
#pragma unroll
    for (int o = 32; o > 0; o >>= 1) v += __shfl_xor(v, o);
    return v;
}
__device__ __forceinline__ int seq_token(int s, int dir) {
    if (dir == 0) return s;
    return (s < NC) ? (NC - 1 - s) : (NC + (NT - 1 - s));
}

namespace pg8 {
#define PG8_LAS __attribute__((address_space(3)))
typedef short bf16x8 __attribute__((ext_vector_type(8)));
typedef float f32x4 __attribute__((ext_vector_type(4)));
typedef unsigned u32x4 __attribute__((ext_vector_type(4)));
constexpr int BM = 256, BK = 64, HALF = 128, HTB = HALF * BK * 2, STAGE_BYTES = 8 * HTB, NXCD = 8, WGM = 8;
__host__ __device__ __forceinline__ int lds_byte(int r, int c) { const int st = (r >> 4) * 2 + (c >> 5), rr = r & 15, cc = c & 31, ob = rr * 64 + cc * 2; return st * 1024 + (ob ^ (((ob >> 9) & 1) << 5)); }
__host__ __device__ __forceinline__ void stage_rc(int b, int& R, int& C) { const int st = b / 1024, sb = b % 1024, swz = sb ^ (((sb >> 9) & 1) << 5); R = (st >> 1) * 16 + swz / 64; C = (st & 1) * 32 + (swz % 64) / 2; }
__host__ __device__ __forceinline__ int perm32(int rho) { const int n = rho >> 4, i = rho & 15; return 8 * (i >> 2) + 4 * n + (i & 3); }
struct Unit { int pm, pn; };
struct Gemm { const bf16_t* A; const bf16_t* Bt; int M, N, K, pad; };
__device__ __forceinline__ unsigned cvt_pk_bf16(float lo, float hi) { return cvtpk(lo, hi); }

struct StaticOrder {
    int nM, nN, nwg, G, c;
    __device__ void init(int M, int N, int G_, int c_) { nM = M / BM; nN = N / BM; nwg = nM * nN; G = G_; c = c_; }
    __device__ bool next(int i, Unit& u) const {
        const long L = (long)i * G + c; if (L >= nwg) return false;
        int wgid = (int)L; { const int q = nwg / NXCD, r = nwg % NXCD, xcd = wgid % NXCD, off = wgid / NXCD; wgid = (xcd < r ? xcd * (q + 1) : r * (q + 1) + (xcd - r) * q) + off; }
        const int nig = WGM * nN, gid = wgid / nig, fm = gid * WGM, gsz = (nM - fm) < WGM ? (nM - fm) : WGM;
        u.pm = fm + ((wgid % nig) % gsz); u.pn = (wgid % nig) / gsz; return true;
    }
    __device__ __forceinline__ void a_ready(const Unit&) const {}
    __device__ __forceinline__ void done(const Unit&) const {}
};
struct LatOrder : StaticOrder {
    __device__ void initl(int N, int G_, int c_) { nM = 64; nN = N / BM; nwg = nM * nN; G = G_; c = c_; }
    __device__ bool next(int i, Unit& u) const { if (!StaticOrder::next(i, u)) return false; u.pm = (u.pm >> 3) * 9 + 1 + (u.pm & 7); return true; }
};
struct GroupedOrder : StaticOrder {
    const int* tile_e;
    __device__ void initg(const int* ntiles_p, const int* tile_e_, int N, int G_, int c_) { nM = ntiles_p[0]; nN = N / BM; nwg = nM * nN; G = G_; c = c_; tile_e = tile_e_; }
    __device__ bool next(int i, Unit& u) const { if (!StaticOrder::next(i, u)) return false; u.pn += tile_e[u.pm] * nN; return true; }
};

struct EpiBf16P {
    static constexpr bool PERM = true;
    bf16_t* O; int ldc, pad;
    __device__ __forceinline__ void operator()(const f32x4 (&acc)[2][2][4][2], const Unit& u, int wr, int wc, int fr, int fq) const {
        const int row0 = u.pm * BM + wr * 64 + fr, col0 = u.pn * BM + wc * 32 + 8 * fq;
#pragma unroll
        for (int ai = 0; ai < 2; ++ai)
#pragma unroll
            for (int m = 0; m < 4; ++m) { bf16_t* rowp = O + (size_t)(row0 + ai * HALF + m * 16) * ldc + col0;
#pragma unroll
                for (int bj = 0; bj < 2; ++bj) { const f32x4 v0 = acc[ai][bj][m][0], v1 = acc[ai][bj][m][1];
                    u32x4 w; w.x = cvt_pk_bf16(v0[0], v0[1]); w.y = cvt_pk_bf16(v0[2], v0[3]); w.z = cvt_pk_bf16(v1[0], v1[1]); w.w = cvt_pk_bf16(v1[2], v1[3]);
                    *(u32x4*)(rowp + bj * HALF) = w; } }
    }
};
struct EpiOut {
    static constexpr bool PERM = true;
    bf16_t* O; float* osq;
    __device__ __forceinline__ void operator()(const f32x4 (&acc)[2][2][4][2], const Unit& u, int wr, int wc, int fr, int fq) const {
        const int row0 = u.pm * BM + wr * 64 + fr, col0 = u.pn * BM + wc * 32 + 8 * fq;
#pragma unroll
        for (int ai = 0; ai < 2; ++ai)
#pragma unroll
            for (int m = 0; m < 4; ++m) { const int row = row0 + ai * HALF + m * 16; bf16_t* rowp = O + (size_t)row * 1024 + col0; float ss = 0.f;
#pragma unroll
                for (int bj = 0; bj < 2; ++bj) { const f32x4 v0 = acc[ai][bj][m][0], v1 = acc[ai][bj][m][1];
                    ss += (v0[0] * v0[0] + v0[1] * v0[1]) + (v0[2] * v0[2] + v0[3] * v0[3]) + (v1[0] * v1[0] + v1[1] * v1[1]) + (v1[2] * v1[2] + v1[3] * v1[3]);
                    u32x4 w; w.x = cvt_pk_bf16(v0[0], v0[1]); w.y = cvt_pk_bf16(v0[2], v0[3]); w.z = cvt_pk_bf16(v1[0], v1[1]); w.w = cvt_pk_bf16(v1[2], v1[3]);
                    *(u32x4*)(rowp + bj * HALF) = w; }
                ss += __shfl_xor(ss, 16); ss += __shfl_xor(ss, 32);
                if (fq == 0) osq[(size_t)row * 16 + u.pn * 4 + wc] = ss; }
    }
};
struct EpiDown {
    static constexpr bool PERM = true;
    bf16_t* C; const float* bias;
    __device__ __forceinline__ void operator()(const f32x4 (&acc)[2][2][4][2], const Unit& u, int wr, int wc, int fr, int fq) const {
        const int e = u.pn >> 2, pnl = u.pn & 3;
        const int row0 = u.pm * BM + wr * 64 + fr, col0 = pnl * BM + wc * 32 + 8 * fq;
        const float* bp = bias + (size_t)e * 1024 + col0;
        f32x4 bv[2][2];
#pragma unroll
        for (int bj = 0; bj < 2; ++bj)
#pragma unroll
            for (int n = 0; n < 2; ++n) bv[bj][n] = *(const f32x4*)(bp + bj * HALF + 4 * n);
#pragma unroll
        for (int ai = 0; ai < 2; ++ai)
#pragma unroll
            for (int m = 0; m < 4; ++m) { bf16_t* rowp = C + (size_t)(row0 + ai * HALF + m * 16) * 1024 + col0;
#pragma unroll
                for (int bj = 0; bj < 2; ++bj) { const f32x4 v0 = acc[ai][bj][m][0] + bv[bj][0], v1 = acc[ai][bj][m][1] + bv[bj][1];
                    u32x4 w; w.x = cvt_pk_bf16(v0[0], v0[1]); w.y = cvt_pk_bf16(v0[2], v0[3]); w.z = cvt_pk_bf16(v1[0], v1[1]); w.w = cvt_pk_bf16(v1[2], v1[3]);
                    *(u32x4*)(rowp + bj * HALF) = w; } }
    }
};
struct EpiSwiglu {
    static constexpr bool PERM = true;
    bf16_t* O; const float* bias;
    __device__ __forceinline__ void operator()(const f32x4 (&acc)[2][2][4][2], const Unit& u, int wr, int wc, int fr, int fq) const {
        const int e = u.pn >> 3, pnl = u.pn & 7;
        const int row0 = u.pm * BM + wr * 64 + fr, col0 = pnl * HALF + wc * 32 + 8 * fq;
        const float* bp = bias + (size_t)e * 2048 + col0;
        f32x4 bg[2], bu[2];
#pragma unroll
        for (int n = 0; n < 2; ++n) { bg[n] = *(const f32x4*)(bp + 4 * n); bu[n] = *(const f32x4*)(bp + 1024 + 4 * n) + 1.0f; }
#pragma unroll
        for (int ai = 0; ai < 2; ++ai)
#pragma unroll
            for (int m = 0; m < 4; ++m) {
                bf16_t* rowp = O + (size_t)(row0 + ai * HALF + m * 16) * 1024 + col0;
                float r[8];
#pragma unroll
                for (int n = 0; n < 2; ++n) {
                    const f32x4 g = acc[ai][0][m][n] + bg[n], up = acc[ai][1][m][n] + bu[n];
                    const f32x4 gt = __builtin_elementwise_min(g, (f32x4){7.f, 7.f, 7.f, 7.f});
                    const f32x4 uu = __builtin_elementwise_min(__builtin_elementwise_max(up, (f32x4){-6.f, -6.f, -6.f, -6.f}), (f32x4){8.f, 8.f, 8.f, 8.f});
                    const f32x4 z = gt * (-1.702f * 1.4426950408889634f);
                    f32x4 e; e[0] = __builtin_amdgcn_exp2f(z[0]); e[1] = __builtin_amdgcn_exp2f(z[1]); e[2] = __builtin_amdgcn_exp2f(z[2]); e[3] = __builtin_amdgcn_exp2f(z[3]);
                    const f32x4 d = e + 1.0f;
                    f32x4 rc; rc[0] = __builtin_amdgcn_rcpf(d[0]); rc[1] = __builtin_amdgcn_rcpf(d[1]); rc[2] = __builtin_amdgcn_rcpf(d[2]); rc[3] = __builtin_amdgcn_rcpf(d[3]);
                    const f32x4 o = (uu * gt) * rc;
                    r[n * 4] = o[0]; r[n * 4 + 1] = o[1]; r[n * 4 + 2] = o[2]; r[n * 4 + 3] = o[3];
                }
                u32x4 w; w.x = cvt_pk_bf16(r[0], r[1]); w.y = cvt_pk_bf16(r[2], r[3]); w.z = cvt_pk_bf16(r[4], r[5]); w.w = cvt_pk_bf16(r[6], r[7]);
                *(u32x4*)rowp = w;
            }
    }
};

template <class Epi, class Sched, bool ALIGN_EPI = false, bool SP2 = false, bool GATHER = false>
__device__ __forceinline__ void gemm_phase(PG8_LAS unsigned char* lds, const Gemm g, const Sched& S, const Epi& E, const int* rowtok = nullptr) {
    static_assert(!GATHER || SP2, "gather staging is wired into the SP2 loop only");
    const int tid = opaque_tid(), wid = __builtin_amdgcn_readfirstlane(tid >> 6), lane = tid & 63, wr = wid >> 2, wc = wid & 3, fr = lane & 15, fq = lane >> 4;
    const int K = g.K, nt = K / BK;
    unsigned voffA[2], voffB[2];
#pragma unroll
    for (int i = 0; i < 2; ++i) { int R, C; stage_rc(tid * 16 + i * 8192, R, C); const int Rb = Epi::PERM ? ((R & ~31) + perm32(R & 31)) : R;
        voffA[i] = (unsigned)(R * K + C) * 2u; voffB[i] = (unsigned)(Rb * K + C) * 2u; }
    int gR[2], gC[2];
#pragma unroll
    for (int i = 0; i < 2; ++i) stage_rc(tid * 16 + i * 8192, gR[i], gC[i]);
    PG8_LAS int* rt = (PG8_LAS int*)(lds + STAGE_BYTES);
    unsigned gaC[2][2] = {{0u, 0u}, {0u, 0u}}, gaN[2][2] = {{0u, 0u}, {0u, 0u}};
    const size_t kstep = (size_t)(BK * 2);
    const size_t hstep = (size_t)HALF * K * 2;
    const size_t tstep = 2 * hstep;
    const unsigned ldsw = (unsigned)wid * 1024u;
    const int aoff = lds_byte(wr * 64 + fr, fq * 8), boff = lds_byte(wc * 32 + fr, fq * 8);
#define PG8_SA(b, h) (((b) * 2 + (h)) * HTB)
#define PG8_SB(b, h) ((4 + (b) * 2 + (h)) * HTB)
#define PG8_STAGE(bufoff, gbase, voff) do { _Pragma("unroll") for (int _i = 0; _i < 2; ++_i) \
        __builtin_amdgcn_global_load_lds((const unsigned*)((const char*)(gbase) + (voff)[_i]), (PG8_LAS unsigned*)(lds + (bufoff) + ldsw + _i * 8192), 16, 0, 0); } while (0)
#define PG8_GOFF(dst, k) do { _Pragma("unroll") for (int h_ = 0; h_ < 2; ++h_) _Pragma("unroll") for (int i_ = 0; i_ < 2; ++i_) dst[h_][i_] = (unsigned)(rt[(k) * 256 + h_ * HALF + gR[i_]] * K + gC[i_]) * 2u; } while (0)
#define PG8_STAGE_A(bufoff, ptr, un, h, kb) do { if constexpr (GATHER) { const unsigned o0_ = (un) ? gaN[h][0] : gaC[h][0], o1_ = (un) ? gaN[h][1] : gaC[h][1]; \
        __builtin_amdgcn_global_load_lds((const unsigned*)((const char*)g.A + (kb) + o0_), (PG8_LAS unsigned*)(lds + (bufoff) + ldsw), 16, 0, 0); \
        __builtin_amdgcn_global_load_lds((const unsigned*)((const char*)g.A + (kb) + o1_), (PG8_LAS unsigned*)(lds + (bufoff) + ldsw + 8192), 16, 0, 0); } else PG8_STAGE(bufoff, ptr, voffA); } while (0)
#define PG8_LDA(dst, b, h) do { _Pragma("unroll") for (int m = 0; m < 4; ++m) _Pragma("unroll") for (int k = 0; k < 2; ++k) dst[m][k] = *(const PG8_LAS bf16x8*)(lds + PG8_SA(b, h) + aoff + m * 2048 + k * 1024); } while (0)
#define PG8_LDB(dst, b, h) do { _Pragma("unroll") for (int n = 0; n < 2; ++n) _Pragma("unroll") for (int k = 0; k < 2; ++k) dst[n][k] = *(const PG8_LAS bf16x8*)(lds + PG8_SB(b, h) + boff + n * 2048 + k * 1024); } while (0)
#define PG8_MMA(ai, bj, At, Bt) do { __builtin_amdgcn_s_setprio(1); _Pragma("unroll") for (int m = 0; m < 4; ++m) _Pragma("unroll") for (int n = 0; n < 2; ++n) _Pragma("unroll") for (int k = 0; k < 2; ++k) \
        acc[ai][bj][m][n] = __builtin_amdgcn_mfma_f32_16x16x32_bf16(Bt[n][k], At[m][k], acc[ai][bj][m][n], 0, 0, 0); __builtin_amdgcn_s_setprio(0); } while (0)
#define PG8_WAIT_V(n) asm volatile("s_waitcnt vmcnt(" #n ")" ::: "memory")
#define PG8_WAIT_L(n) asm volatile("s_waitcnt lgkmcnt(" #n ")" ::: "memory")
#define PG8_BAR __builtin_amdgcn_s_barrier()
#define PG8_SCHED __builtin_amdgcn_sched_barrier(0)
    Unit cur, nxt; int ui = 0;
    if (!S.next(0, cur)) return;
    f32x4 acc[2][2][4][2];
#pragma unroll
    for (int a = 0; a < 2; ++a)
#pragma unroll
        for (int b = 0; b < 2; ++b)
#pragma unroll
            for (int m = 0; m < 4; ++m)
#pragma unroll
                for (int n = 0; n < 2; ++n) acc[a][b][m][n] = (f32x4){0.f, 0.f, 0.f, 0.f};
    bf16x8 At[4][2], B0[2][2], B1[2][2];
    const char* cA = (const char*)g.A + (size_t)cur.pm * tstep; const char* cB = (const char*)g.Bt + (size_t)cur.pn * tstep;
    S.a_ready(cur);
    if constexpr (GATHER) {
        PG8_LAS int* pms = rt + 16 * 256;
        if (tid < 16) { Unit u_; pms[tid] = S.next(tid, u_) ? u_.pm : -1; }
        __syncthreads();
        {
            int tok[8];
#pragma unroll
            for (int j = 0; j < 8; ++j) { const int k = 2 * j + (tid >> 8), pm = pms[k]; tok[j] = (pm >= 0) ? rowtok[pm * 256 + (tid & 255)] : 0; }
#pragma unroll
            for (int j = 0; j < 8; ++j) rt[(2 * j + (tid >> 8)) * 256 + (tid & 255)] = tok[j];
        }
        __syncthreads();
        PG8_GOFF(gaC, 0);
    }
    if constexpr (SP2) {
        PG8_STAGE(PG8_SB(0, 0), cB, voffB); PG8_STAGE(PG8_SB(0, 1), cB + hstep, voffB); PG8_STAGE_A(PG8_SA(0, 0), cA, false, 0, (size_t)0); PG8_STAGE_A(PG8_SA(0, 1), cA + hstep, false, 1, (size_t)0);
        if (wr == 1) PG8_BAR;
        PG8_WAIT_V(2); PG8_BAR;
        PG8_STAGE(PG8_SB(1, 0), cB + kstep, voffB); PG8_STAGE_A(PG8_SA(1, 0), cA + kstep, false, 0, kstep); PG8_STAGE(PG8_SB(1, 1), cB + hstep + kstep, voffB);
        PG8_WAIT_V(6); PG8_BAR;
    } else {
        PG8_STAGE(PG8_SB(0, 0), cB, voffB); PG8_STAGE(PG8_SA(0, 0), cA, voffA); PG8_STAGE(PG8_SB(0, 1), cB + hstep, voffB); PG8_STAGE(PG8_SA(0, 1), cA + hstep, voffA);
        if (wr == 1) PG8_BAR;
        PG8_WAIT_V(4); PG8_BAR;
        PG8_STAGE(PG8_SB(1, 0), cB + kstep, voffB); PG8_STAGE(PG8_SA(1, 0), cA + kstep, voffA); PG8_STAGE(PG8_SB(1, 1), cB + hstep + kstep, voffB);
        PG8_WAIT_V(6); PG8_BAR;
    }
    for (;;) {
        const bool has_next = S.next(ui + 1, nxt);
        if constexpr (GATHER) { if (has_next) PG8_GOFF(gaN, ui + 1); }
        const char* nA = has_next ? (const char*)g.A + (size_t)nxt.pm * tstep : cA; const char* nB = has_next ? (const char*)g.Bt + (size_t)nxt.pn * tstep : cB;
        for (int t = 0; t < nt; t += 2) {
            const bool last = (t == nt - 2);
            const char* a1 = cA + (size_t)(t + 1) * kstep;
            const char* a2 = last ? nA : cA + (size_t)(t + 2) * kstep; const char* b2 = last ? nB : cB + (size_t)(t + 2) * kstep;
            const char* a3 = a2 + kstep; const char* b3 = b2 + kstep;
            if (last && has_next) S.a_ready(nxt);
            const bool un = last && has_next; const size_t k1 = (size_t)(t + 1) * kstep, k2 = last ? (size_t)0 : (size_t)(t + 2) * kstep;
            if constexpr (SP2) {
            PG8_LDB(B0, 0, 0); PG8_LDB(B1, 0, 1); PG8_SCHED; PG8_LDA(At, 0, 0); PG8_STAGE_A(PG8_SA(1, 1), a1 + hstep, false, 1, k1);
            PG8_WAIT_V(8); PG8_WAIT_L(0); PG8_BAR; PG8_MMA(0, 0, At, B0); PG8_MMA(0, 1, At, B1); PG8_BAR; PG8_SCHED;
            PG8_LDA(At, 0, 1); PG8_STAGE(PG8_SB(0, 0), b2, voffB); PG8_STAGE(PG8_SB(0, 1), b2 + hstep, voffB); PG8_STAGE_A(PG8_SA(0, 0), a2, un, 0, k2);
            PG8_WAIT_V(8); PG8_WAIT_L(0); PG8_BAR; PG8_MMA(1, 0, At, B0); PG8_MMA(1, 1, At, B1); PG8_BAR; PG8_SCHED;
            PG8_LDB(B0, 1, 0); PG8_LDB(B1, 1, 1); PG8_SCHED; PG8_LDA(At, 1, 0); PG8_STAGE_A(PG8_SA(0, 1), a2 + hstep, un, 1, k2);
            PG8_WAIT_V(8); PG8_WAIT_L(0); PG8_BAR; PG8_MMA(0, 0, At, B0); PG8_MMA(0, 1, At, B1); PG8_BAR; PG8_SCHED;
            PG8_LDA(At, 1, 1); PG8_STAGE(PG8_SB(1, 0), b3, voffB); PG8_STAGE(PG8_SB(1, 1), b3 + hstep, voffB); PG8_STAGE_A(PG8_SA(1, 0), a3, un, 0, k2 + kstep);
            PG8_WAIT_V(8); PG8_WAIT_L(0); PG8_BAR; PG8_MMA(1, 0, At, B0); PG8_MMA(1, 1, At, B1); PG8_BAR; PG8_SCHED;
            } else {
            PG8_LDB(B0, 0, 0); PG8_SCHED; PG8_LDA(At, 0, 0); PG8_STAGE(PG8_SA(1, 1), a1 + hstep, voffA);
            PG8_WAIT_L(8); PG8_BAR; PG8_WAIT_L(0); PG8_MMA(0, 0, At, B0); PG8_BAR; PG8_SCHED;
            PG8_LDB(B1, 0, 1); PG8_STAGE(PG8_SB(0, 0), b2, voffB);
            PG8_BAR; PG8_WAIT_L(0); PG8_MMA(0, 1, At, B1); PG8_BAR;
            PG8_LDA(At, 0, 1); PG8_STAGE(PG8_SA(0, 0), a2, voffA);
            PG8_BAR; PG8_WAIT_L(0); PG8_MMA(1, 0, At, B0); PG8_BAR; PG8_SCHED;
            PG8_STAGE(PG8_SB(0, 1), b2 + hstep, voffB);
            PG8_WAIT_V(6); PG8_BAR; PG8_MMA(1, 1, At, B1); PG8_BAR;
            PG8_LDB(B0, 1, 0); PG8_SCHED; PG8_LDA(At, 1, 0); PG8_STAGE(PG8_SA(0, 1), a2 + hstep, voffA);
            PG8_WAIT_L(8); PG8_BAR; PG8_WAIT_L(0); PG8_MMA(0, 0, At, B0); PG8_BAR; PG8_SCHED;
            PG8_LDB(B1, 1, 1); PG8_STAGE(PG8_SB(1, 0), b3, voffB);
            PG8_BAR; PG8_WAIT_L(0); PG8_MMA(0, 1, At, B1); PG8_BAR;
            PG8_LDA(At, 1, 1); PG8_STAGE(PG8_SA(1, 0), a3, voffA);
            PG8_BAR; PG8_WAIT_L(0); PG8_MMA(1, 0, At, B0); PG8_BAR; PG8_SCHED;
            PG8_STAGE(PG8_SB(1, 1), b3 + hstep, voffB);
            PG8_WAIT_V(6); PG8_BAR; PG8_MMA(1, 1, At, B1); PG8_BAR;
            }
        }
        if constexpr (ALIGN_EPI) { if (wr == 0) PG8_BAR; }
        E(acc, cur, wr, wc, fr, fq); S.done(cur);
        if (!has_next) break;
#pragma unroll
        for (int a = 0; a < 2; ++a)
#pragma unroll
            for (int b = 0; b < 2; ++b)
#pragma unroll
                for (int m = 0; m < 4; ++m)
#pragma unroll
                    for (int n = 0; n < 2; ++n) acc[a][b][m][n] = (f32x4){0.f, 0.f, 0.f, 0.f};
        cur = nxt; cA = nA; cB = nB; ++ui;
        if constexpr (GATHER) { gaC[0][0] = gaN[0][0]; gaC[0][1] = gaN[0][1]; gaC[1][0] = gaN[1][0]; gaC[1][1] = gaN[1][1]; }
        if constexpr (ALIGN_EPI) { if (wr == 1) PG8_BAR; }
    }
    PG8_WAIT_V(0);
    if constexpr (!ALIGN_EPI) { if (wr == 0) PG8_BAR; }
    PG8_BAR;
#undef PG8_SA
#undef PG8_SB
#undef PG8_STAGE
#undef PG8_LDA
#undef PG8_GOFF
#undef PG8_STAGE_A
#undef PG8_LDB
#undef PG8_MMA
#undef PG8_WAIT_V
#undef PG8_WAIT_L
#undef PG8_BAR
#undef PG8_SCHED
}
}

typedef short bf16x8_t __attribute__((ext_vector_type(8)));
typedef float f32x16_t __attribute__((ext_vector_type(16)));
typedef float f32x2_t __attribute__((ext_vector_type(2)));
typedef unsigned u32x4_t __attribute__((ext_vector_type(4)));
typedef unsigned u32x2_t __attribute__((ext_vector_type(2)));
#define LAS3 __attribute__((address_space(3)))
constexpr int ATT_VROW = 68;
constexpr int ATT_LDS_BYTES = 3 * (64 * 104 * 2 + 64 * ATT_VROW * 2);

template <int QKD, int NMAP, bool DA>
__device__ __forceinline__ void attn_item(LAS3 unsigned char* lds, const bf16_t* __restrict__ Qb, const bf16_t* __restrict__ Kb, const bf16_t* __restrict__ Vt,
                                          bf16_t* __restrict__ ycatb, int ycat_off, int b, int h, int qblk, float lam, const float* __restrict__ subln, float post_scale) {
    constexpr int DK = QKD / NMAP, KS = DK / 16, KROW = QKD + 8, KCH = QKD / 8;
    constexpr int KBYTES = 64 * KROW * 2, VBYTES = 64 * ATT_VROW * 2, BUFB = KBYTES + VBYTES;
    const int tid = opaque_tid(), wid = tid >> 6, lane = tid & 63, r = lane & 31, hh = lane >> 5;
    const int q0 = qblk * 256, ntiles = (qblk == 0) ? (NC / 64) : (NT / 64);
    const size_t base = ((size_t)b * 4 + h) * NT;
    bf16x8_t qf[NMAP][KS];
#pragma unroll
    for (int m = 0; m < NMAP; ++m)
#pragma unroll
        for (int ks = 0; ks < KS; ++ks) qf[m][ks] = *(const bf16x8_t*)(Qb + (base + q0 + 32 * wid + r) * QKD + m * DK + 16 * ks + 8 * hh);
    f32x16_t O[NMAP][2]; float mrun[NMAP], lrun[NMAP];
#pragma unroll
    for (int m = 0; m < NMAP; ++m) { mrun[m] = 0.f; lrun[m] = 0.f;
#pragma unroll
        for (int d2 = 0; d2 < 2; ++d2)
#pragma unroll
            for (int i = 0; i < 16; ++i) O[m][d2][i] = 0.f; }
    constexpr int NKC = 64 * KCH;
    const bf16_t* kg = Kb + base * QKD;
    const bf16_t* vg = Vt + ((size_t)(b * 4 + h) * 64 + (tid >> 3)) * NT + (tid & 7) * 8;
    u32x4_t rk0, rk1 = (u32x4_t){0u, 0u, 0u, 0u}, rv;
    const int kc1 = tid + 512;
    const int k0row = tid / KCH, k0col = tid % KCH, k1row = kc1 / KCH, k1col = kc1 % KCH;
#define ATT_LOAD(j) do { rk0 = *(const u32x4_t*)(kg + (size_t)(j) * 64 * QKD + tid * 8); if (NKC > 512 && kc1 < NKC) rk1 = *(const u32x4_t*)(kg + (size_t)(j) * 64 * QKD + kc1 * 8); \
        rv = *(const u32x4_t*)(vg + (size_t)(j) * 64); } while (0)
#define ATT_STORE(buf) do { LAS3 unsigned char* kb_ = lds + (buf) * BUFB; LAS3 unsigned char* vb_ = kb_ + KBYTES; \
        *(LAS3 u32x4_t*)(kb_ + (k0row * KROW + k0col * 8) * 2) = rk0; if (NKC > 512 && kc1 < NKC) *(LAS3 u32x4_t*)(kb_ + (k1row * KROW + k1col * 8) * 2) = rk1; \
        LAS3 unsigned char* vd_ = vb_ + ((tid >> 3) * ATT_VROW + (tid & 7) * 8) * 2; *(LAS3 u32x2_t*)vd_ = (u32x2_t){rv.x, rv.y}; *(LAS3 u32x2_t*)(vd_ + 8) = (u32x2_t){rv.z, rv.w}; } while (0)
    __syncthreads();
    ATT_LOAD(0); ATT_STORE(0);
    if (ntiles > 1) ATT_LOAD(1);
    __syncthreads();
    bf16x8_t pf[NMAP][2][2];
#define ATT_PV(m_, vb_) do { _Pragma("unroll") for (int d2 = 0; d2 < 2; ++d2) _Pragma("unroll") for (int kt = 0; kt < 2; ++kt) _Pragma("unroll") for (int s2 = 0; s2 < 2; ++s2) { \
        const LAS3 unsigned char* vp = (vb_) + ((d2 * 32 + r) * ATT_VROW + kt * 32 + 16 * s2 + 4 * hh) * 2; \
        union { u32x2_t u[2]; bf16x8_t v; } av; av.u[0] = *(const LAS3 u32x2_t*)vp; av.u[1] = *(const LAS3 u32x2_t*)(vp + 16); \
        O[m_][d2] = __builtin_amdgcn_mfma_f32_32x32x16_bf16(av.v, pf[m_][kt][s2], O[m_][d2], 0, 0, 0); } } while (0)
    int sl = 0;
    for (int j = 0; j < ntiles; ++j) {
        const LAS3 unsigned char* kb = lds + sl * BUFB;
        const LAS3 unsigned char* vbp = lds + ((sl == 0) ? 2 : sl - 1) * BUFB + KBYTES;
#pragma unroll
        for (int m = 0; m < NMAP; ++m) {
            f32x16_t S[2];
            const float nm = -mrun[m];
#pragma unroll
            for (int kt = 0; kt < 2; ++kt) {
#pragma unroll
                for (int i = 0; i < 16; ++i) S[kt][i] = nm;
#pragma unroll
                for (int ks = 0; ks < KS; ++ks) {
                    const bf16x8_t a = *(const LAS3 bf16x8_t*)(kb + ((kt * 32 + r) * KROW + m * DK + 16 * ks + 8 * hh) * 2);
                    S[kt] = __builtin_amdgcn_mfma_f32_32x32x16_bf16(a, qf[m][ks], S[kt], 0, 0, 0);
                }
            }
            if (j > 0) ATT_PV(m, vbp);
            float mx = S[0][0];
#pragma unroll
            for (int i = 1; i < 16; ++i) mx = fmaxf(mx, S[0][i]);
#pragma unroll
            for (int i = 0; i < 16; ++i) mx = fmaxf(mx, S[1][i]);
            mx = fmaxf(mx, __shfl_xor(mx, 32));
            if (j == 0 || !__all(mx <= 8.f)) {
                const float dl = (j == 0) ? mx : fmaxf(mx, 0.f);
                mrun[m] += dl;
#pragma unroll
                for (int kt = 0; kt < 2; ++kt)
#pragma unroll
                    for (int i = 0; i < 16; ++i) S[kt][i] -= dl;
                if (j != 0) {
                    const float alpha = __builtin_amdgcn_exp2f(-dl);
                    lrun[m] *= alpha;
#pragma unroll
                    for (int d2 = 0; d2 < 2; ++d2)
#pragma unroll
                        for (int i = 0; i < 16; ++i) O[m][d2][i] *= alpha;
                }
            }
            f32x2_t ps2 = (f32x2_t){0.f, 0.f};
#pragma unroll
            for (int kt = 0; kt < 2; ++kt) {
#pragma unroll
                for (int i = 0; i < 16; i += 2) { const float p0 = __builtin_amdgcn_exp2f(S[kt][i]), p1 = __builtin_amdgcn_exp2f(S[kt][i + 1]); S[kt][i] = p0; S[kt][i + 1] = p1; ps2 += (f32x2_t){p0, p1}; }
#pragma unroll
                for (int s2 = 0; s2 < 2; ++s2) {
                    union { unsigned u[4]; bf16x8_t v; } cv;
#pragma unroll
                    for (int jj = 0; jj < 4; ++jj) cv.u[jj] = cvtpk(S[kt][8 * s2 + 2 * jj], S[kt][8 * s2 + 2 * jj + 1]);
                    pf[m][kt][s2] = cv.v;
                }
            }
            lrun[m] += ps2[0] + ps2[1];
        }
        const int sn = (sl == 2) ? 0 : sl + 1;
        if (j + 1 < ntiles) { ATT_STORE(sn); if (j + 2 < ntiles) ATT_LOAD(j + 2); }
        __syncthreads();
        sl = sn;
    }
    {
        const LAS3 unsigned char* vbl = lds + ((sl == 0) ? 2 : sl - 1) * BUFB + KBYTES;
#pragma unroll
        for (int m = 0; m < NMAP; ++m) ATT_PV(m, vbl);
    }
#undef ATT_PV
#undef ATT_LOAD
#undef ATT_STORE
    float inv[NMAP];
#pragma unroll
    for (int m = 0; m < NMAP; ++m) { const float lt = lrun[m] + __shfl_xor(lrun[m], 32); inv[m] = __builtin_amdgcn_rcpf(lt); }
    if (NMAP == 2) inv[NMAP - 1] *= -lam;
    float ss = 0.f;
#pragma unroll
    for (int d2 = 0; d2 < 2; ++d2)
#pragma unroll
        for (int i = 0; i < 16; ++i) {
            float o = O[0][d2][i] * inv[0];
            if (NMAP == 2) o += O[NMAP - 1][d2][i] * inv[NMAP - 1];
            O[0][d2][i] = o; ss += o * o;
        }
    float rs = 1.f;
    if (DA) { ss += __shfl_xor(ss, 32); rs = rsqrtf(ss * (1.f / 64.f) + 1e-6f) * post_scale; }
    bf16_t* yp = ycatb + ((size_t)b * NT + q0 + 32 * wid + r) * DM + ycat_off + h * 64;
#pragma unroll
    for (int d2 = 0; d2 < 2; ++d2)
#pragma unroll
        for (int g4 = 0; g4 < 4; ++g4) {
            const int dv = 32 * d2 + 8 * g4 + 4 * hh;
            float o0 = O[0][d2][4 * g4] * rs, o1 = O[0][d2][4 * g4 + 1] * rs, o2 = O[0][d2][4 * g4 + 2] * rs, o3 = O[0][d2][4 * g4 + 3] * rs;
            if (DA) { const float4 w = *(const float4*)(subln + dv); o0 *= w.x; o1 *= w.y; o2 *= w.z; o3 *= w.w; }
            *(uint2*)(yp + dv) = make_uint2(cvtpk(o0, o1), cvtpk(o2, o3));
        }
}


typedef float f32x4_t __attribute__((ext_vector_type(4)));
constexpr int ML_KROW = 72, ML_TROW = 136, ML_CROW = 72;
constexpr int ML_OFF_KC = 0, ML_OFF_KT = ML_OFF_KC + 128 * ML_KROW * 2, ML_OFF_VT = ML_OFF_KT + 64 * ML_TROW * 2, ML_OFF_CB = ML_OFF_VT + 80 * ML_TROW * 2,
              ML_OFF_F = ML_OFF_CB + 80 * ML_CROW * 2, ML_LDS_BYTES = ML_OFF_F + 6 * 128 * 4 + 64;
__device__ __forceinline__ void mlstm_item(LAS3 unsigned char* lds, const bf16_t* __restrict__ Qb, const bf16_t* __restrict__ Kb, const bf16_t* __restrict__ Ktg, const bf16_t* __restrict__ Vtg,
                                           const float* __restrict__ G, float* __restrict__ hdir, int b, int h, int dir) {
    const int tid = opaque_tid(), wid = tid >> 6, lane = tid & 63, lr = lane & 15, q = lane >> 4;
    LAS3 unsigned char* Kc = lds + ML_OFF_KC; LAS3 unsigned char* Kt = lds + ML_OFF_KT; LAS3 unsigned char* Vt = lds + ML_OFF_VT; LAS3 unsigned char* Cb = lds + ML_OFF_CB;
    LAS3 float* fl = (LAS3 float*)(lds + ML_OFF_F);
    LAS3 float* s_li = fl; LAS3 float* s_lf = fl + 128; LAS3 float* s_bc2 = fl + 256; LAS3 float* s_gk2 = fl + 384; LAS3 float* s_wu = fl + 512; LAS3 float* s_et = fl + 640; LAS3 float* s_misc = fl + 768;
    const size_t base = ((size_t)b * 4 + h) * NT;
    __syncthreads();
    for (int i = tid; i < 80 * ML_CROW / 2; i += 512) ((LAS3 unsigned*)Cb)[i] = 0u;
    for (int i = tid; i < 16 * ML_TROW / 2; i += 512) ((LAS3 unsigned*)(Vt + 64 * ML_TROW * 2))[i] = (i < ML_TROW / 2) ? 0x3F803F80u : 0u;
    const int ct = wid & 3, rt0 = (wid < 4) ? 0 : 3, nrt = (wid < 4) ? 3 : 2;
    f32x4_t Cacc[3];
#pragma unroll
    for (int i = 0; i < 3; ++i) Cacc[i] = (f32x4_t){0.f, 0.f, 0.f, 0.f};
    const int tq = 16 * wid + lr;
    const int ia = (dir == 0) ? 2 * lane : 127 - 2 * lane, ib = (dir == 0) ? 2 * lane + 1 : 126 - 2 * lane;
    u32x4_t nkc[2], nkt[2], nvt[2]; bf16x8_t nqf[2]; float ngxa = 0.f, ngxb = 0.f, ngla = 0.f, nglb = 0.f;
#define ML_N0(c_) ((dir == 0) ? 128 * (c_) : (((c_) < 2) ? 128 * (1 - (c_)) : NC + 128 * (17 - (c_))))
#define ML_LOAD(c_) do { const int n0_ = ML_N0(c_); \
        _Pragma("unroll") for (int i = 0; i < 2; ++i) { const int id = tid + 512 * i; \
            nkc[i] = *(const u32x4_t*)(Kb + (base + n0_ + (id >> 3)) * 64 + (id & 7) * 8); \
            nkt[i] = *(const u32x4_t*)(Ktg + ((size_t)(b * 4 + h) * 64 + (id >> 4)) * NT + n0_ + (id & 15) * 8); \
            nvt[i] = *(const u32x4_t*)(Vtg + ((size_t)(b * 4 + h) * 64 + (id >> 4)) * NT + n0_ + (id & 15) * 8); } \
        _Pragma("unroll") for (int ks = 0; ks < 2; ++ks) nqf[ks] = *(const bf16x8_t*)(Qb + (base + n0_ + tq) * 64 + 32 * ks + 8 * q); \
        if (wid == 0) { const float* gpa = G + ((size_t)b * NT + n0_ + ia) * 16 + (dir * 2) * 4 + h; const float* gpb = G + ((size_t)b * NT + n0_ + ib) * 16 + (dir * 2) * 4 + h; \
            ngxa = gpa[4]; ngxb = gpb[4]; ngla = gpa[0]; nglb = gpb[0]; } } while (0)
    ML_LOAD(0);
    for (int c = 0; c < NT / 128; ++c) {
        const int n0 = ML_N0(c);
        u32x4_t rkc[2], rkt[2], rvt[2];
        bf16x8_t qf[2];
#pragma unroll
        for (int i = 0; i < 2; ++i) { rkc[i] = nkc[i]; rkt[i] = nkt[i]; rvt[i] = nvt[i]; qf[i] = nqf[i]; }
        const float xa = ngxa, xb = ngxb, lia = ngla, lib = nglb;
        if (c + 1 < NT / 128) ML_LOAD(c + 1);
#pragma unroll
        for (int i = 0; i < 2; ++i) {
            const int id = tid + 512 * i;
            *(LAS3 u32x4_t*)(Kc + ((id >> 3) * ML_KROW + (id & 7) * 8) * 2) = rkc[i];
            *(LAS3 u32x4_t*)(Vt + ((id >> 4) * ML_TROW + (id & 15) * 8) * 2) = rvt[i];
        }
        __syncthreads();
        if (wid == 0) {
            float inc = xa + xb;
#pragma unroll
            for (int o = 1; o < 64; o <<= 1) { const float v = __shfl_up(inc, o); if (lane >= o) inc += v; }
            const float tot = __shfl(inc, 63);
            const float bca = inc - xb, bcb = inc;
            s_bc2[ia] = bca * 1.4426950408889634f; s_bc2[ib] = bcb * 1.4426950408889634f;
            s_gk2[ia] = (bca - lia) * 1.4426950408889634f; s_gk2[ib] = (bcb - lib) * 1.4426950408889634f;
            s_wu[ia] = __expf(tot - bca + lia); s_wu[ib] = __expf(tot - bcb + lib);
            s_et[ia] = __expf(bca); s_et[ib] = __expf(bcb);
            if (lane == 0) s_misc[0] = __expf(tot);
        }
        __syncthreads();
#pragma unroll
        for (int i = 0; i < 2; ++i) {
            const int id = tid + 512 * i; const int tk0 = (id & 15) * 8;
            unsigned w4[4] = {rkt[i].x, rkt[i].y, rkt[i].z, rkt[i].w}; u32x4_t o;
#pragma unroll
            for (int jj = 0; jj < 4; ++jj) {
                const float lo = __uint_as_float(w4[jj] << 16) * s_wu[tk0 + 2 * jj], hi = __uint_as_float(w4[jj] & 0xFFFF0000u) * s_wu[tk0 + 2 * jj + 1];
                o[jj] = cvtpk(lo, hi);
            }
            *(LAS3 u32x4_t*)(Kt + ((id >> 4) * ML_TROW + tk0) * 2) = o;
        }
        f32x4_t S[8];
#pragma unroll
        for (int kt = 0; kt < 8; ++kt) {
            S[kt] = (f32x4_t){0.f, 0.f, 0.f, 0.f};
#pragma unroll
            for (int ks = 0; ks < 2; ++ks) {
                const bf16x8_t a = *(const LAS3 bf16x8_t*)(Kc + ((16 * kt + lr) * ML_KROW + 32 * ks + 8 * q) * 2);
                S[kt] = __builtin_amdgcn_mfma_f32_16x16x32_bf16(a, qf[ks], S[kt], 0, 0, 0);
            }
        }
        const float bct = s_bc2[tq];
#pragma unroll
        for (int kt = 0; kt < 8; ++kt) {
            const f32x4_t gk = *(const LAS3 f32x4_t*)(s_gk2 + 16 * kt + 4 * q);
#pragma unroll
            for (int rg = 0; rg < 4; ++rg) {
                const int si = 16 * kt + 4 * q + rg;
                const bool valid = (dir == 0) ? (si <= tq) : (si >= tq);
                const float w = valid ? __builtin_amdgcn_exp2f(bct - gk[rg]) : 0.f;
                S[kt][rg] *= w;
            }
        }
        bf16x8_t pf[4];
#pragma unroll
        for (int k2 = 0; k2 < 4; ++k2) {
            union { unsigned u[4]; bf16x8_t v; } cv;
            cv.u[0] = cvtpk(S[2 * k2][0], S[2 * k2][1]); cv.u[1] = cvtpk(S[2 * k2][2], S[2 * k2][3]);
            cv.u[2] = cvtpk(S[2 * k2 + 1][0], S[2 * k2 + 1][1]); cv.u[3] = cvtpk(S[2 * k2 + 1][2], S[2 * k2 + 1][3]);
            pf[k2] = cv.v;
        }
        f32x4_t outv[5];
#pragma unroll
        for (int rt = 0; rt < 5; ++rt) {
            f32x4_t acc = (f32x4_t){0.f, 0.f, 0.f, 0.f}, acc2 = (f32x4_t){0.f, 0.f, 0.f, 0.f};
#pragma unroll
            for (int k2 = 0; k2 < 4; ++k2) {
                const LAS3 unsigned char* vp = Vt + ((16 * rt + lr) * ML_TROW + 32 * k2 + 4 * q) * 2;
                union { u32x2_t u[2]; bf16x8_t v; } av;
                av.u[0] = *(const LAS3 u32x2_t*)vp; av.u[1] = *(const LAS3 u32x2_t*)(vp + 32);
                acc = __builtin_amdgcn_mfma_f32_16x16x32_bf16(av.v, pf[k2], acc, 0, 0, 0);
            }
#pragma unroll
            for (int ks = 0; ks < 2; ++ks) {
                const bf16x8_t a = *(const LAS3 bf16x8_t*)(Cb + ((16 * rt + lr) * ML_CROW + 32 * ks + 8 * q) * 2);
                acc2 = __builtin_amdgcn_mfma_f32_16x16x32_bf16(a, qf[ks], acc2, 0, 0, 0);
            }
            outv[rt] = acc + acc2 * s_et[tq];
        }
        {
            const float den = __shfl(outv[4][0], lr);
            const float inv = __builtin_amdgcn_rcpf(fmaxf(fabsf(den), 1.f));
            bf16_t* hp = (bf16_t*)hdir + ((size_t)dir * TT + (size_t)b * NT + n0 + tq) * 256 + h * 64 + 4 * q;
            for (int rt = 0; rt < 4; ++rt) { const f32x4_t ov = outv[rt] * inv; *(uint2*)(hp + 16 * rt) = make_uint2(cvtpk(ov[0], ov[1]), cvtpk(ov[2], ov[3])); }
        }
        __syncthreads();
        {
            const float decay = s_misc[0];
#pragma unroll
            for (int i = 0; i < 3; ++i) Cacc[i] *= decay;
#pragma unroll
            for (int ks = 0; ks < 4; ++ks) {
                const bf16x8_t bb = *(const LAS3 bf16x8_t*)(Kt + ((16 * ct + lr) * ML_TROW + 32 * ks + 8 * q) * 2);
#pragma unroll
                for (int i = 0; i < 3; ++i) if (i < nrt) {
                    const bf16x8_t a = *(const LAS3 bf16x8_t*)(Vt + ((16 * (rt0 + i) + lr) * ML_TROW + 32 * ks + 8 * q) * 2);
                    Cacc[i] = __builtin_amdgcn_mfma_f32_16x16x32_bf16(a, bb, Cacc[i], 0, 0, 0);
                }
            }
#pragma unroll
            for (int i = 0; i < 3; ++i) if (i < nrt) {
#pragma unroll
                for (int rg = 0; rg < 4; ++rg) *(LAS3 bf16_t*)(Cb + ((16 * (rt0 + i) + 4 * q + rg) * ML_CROW + 16 * ct + lr) * 2) = f2bf(Cacc[i][rg]);
            }
        }
        __syncthreads();
    }
#undef ML_LOAD
#undef ML_N0
}

constexpr int S5_UROWS = NT + 64;
constexpr int S5_KROW = 1032, S5_CROW = 136, S5_ZROW = 136;
constexpr int S5_OFF_U = 0, S5_OFF_KM = S5_OFF_U + S5_UROWS * 16 * 2, S5_OFF_CM = S5_OFF_KM + 16 * S5_KROW * 2, S5_OFF_EZ = S5_OFF_CM + 16 * S5_CROW * 2,
              S5_LDS_BYTES = S5_OFF_EZ + 8 * 16 * S5_ZROW * 2;
__device__ __forceinline__ void s5_setup_item(LAS3 unsigned char* lds, int idx, const float* __restrict__ a_re, const float* __restrict__ a_im, const float* __restrict__ log_step,
                                                  const float* __restrict__ b_re, const float* __restrict__ b_im, const float* __restrict__ c_re, const float* __restrict__ c_im,
                                                  bf16_t* __restrict__ KmT, bf16_t* __restrict__ Smat, bf16_t* __restrict__ CmT, float* __restrict__ Aab, float* __restrict__ A64) {
    typedef float apw_t[64][2]; typedef float bb_t[16][2]; typedef float cc_t[64][2];
    LAS3 apw_t* apw = (LAS3 apw_t*)lds;
    LAS3 bb_t* bb = (LAS3 bb_t*)(lds + 32768);
    LAS3 cc_t* cc = (LAS3 cc_t*)(lds + 32768 + 8192);
    const int tid = opaque_tid();
    __syncthreads();
    const float dt = expf(log_step[idx]);
    if (tid < 64) {
        const int p = tid;
        const float ar = fminf(a_re[idx * 64 + p], -1e-4f), ai = a_im[idx * 64 + p];
        const float mag = expf(dt * ar), er = mag * cosf(dt * ai), ei = mag * sinf(dt * ai);
        const float inv = 1.0f / (ar * ar + ai * ai);
        const float fr = ((er - 1.0f) * ar + ei * ai) * inv, fi = (ei * ar - (er - 1.0f) * ai) * inv;
        Aab[(idx * 64 + p) * 2] = er; Aab[(idx * 64 + p) * 2 + 1] = ei;
        const float m64 = expf(64.0f * dt * ar);
        A64[(idx * 64 + p) * 2] = m64 * cosf(64.0f * dt * ai); A64[(idx * 64 + p) * 2 + 1] = m64 * sinf(64.0f * dt * ai);
        for (int hh = 0; hh < 16; ++hh) {
            const float br = b_re[((size_t)idx * 64 + p) * 16 + hh], bi = b_im[((size_t)idx * 64 + p) * 16 + hh];
            bb[p][hh][0] = fr * br - fi * bi; bb[p][hh][1] = fr * bi + fi * br;
        }
    }
    for (int i = tid; i < 64 * 64; i += 512) {
        const int tau = i >> 6, p = i & 63;
        const float ar = fminf(a_re[idx * 64 + p], -1e-4f), ai = a_im[idx * 64 + p];
        const float mag = expf((float)tau * dt * ar);
        apw[tau][p][0] = mag * cosf((float)tau * dt * ai); apw[tau][p][1] = mag * sinf((float)tau * dt * ai);
    }
    for (int i = tid; i < 16 * 64; i += 512) { const int hh = i >> 6, p = i & 63; cc[hh][p][0] = c_re[(size_t)idx * 1024 + i]; cc[hh][p][1] = c_im[(size_t)idx * 1024 + i]; }
    __syncthreads();
    for (int i = tid; i < 16 * 64; i += 512) { const int hh = i >> 6, p = i & 63;
        CmT[((size_t)idx * 16 + hh) * 128 + 2 * p] = f2bf(cc[hh][p][0]); CmT[((size_t)idx * 16 + hh) * 128 + 2 * p + 1] = f2bf(-cc[hh][p][1]); }
    for (int e = tid; e < 64 * 1024; e += 512) {
        const int p = e >> 10, k = e & 1023, i = k >> 4, hp = k & 15;
        const float pr = apw[63 - i][p][0], pi = apw[63 - i][p][1], br = bb[p][hp][0], bi = bb[p][hp][1];
        Smat[((size_t)idx * 128 + 2 * p) * 1024 + k] = f2bf(pr * br - pi * bi);
        Smat[((size_t)idx * 128 + 2 * p + 1) * 1024 + k] = f2bf(pr * bi + pi * br);
    }
    for (int e = tid; e < 16 * 1024; e += 512) {
        const int hh = e >> 10, k = e & 1023, tau = k >> 4, hp = k & 15;
        float acc = 0.f;
        for (int p = 0; p < 64; ++p) {
            const float pr = apw[tau][p][0], pi = apw[tau][p][1], br = bb[p][hp][0], bi = bb[p][hp][1];
            const float wr = pr * br - pi * bi, wi = pr * bi + pi * br;
            acc += cc[hh][p][0] * wr - cc[hh][p][1] * wi;
        }
        KmT[((size_t)idx * 16 + hh) * 1024 + k] = f2bf(acc);
    }
}


__device__ __forceinline__ void s5_item(LAS3 unsigned char* lds, const bf16_t* __restrict__ p, const bf16_t* __restrict__ KmT, const bf16_t* __restrict__ Smat, const bf16_t* __restrict__ CmT,
                                        const float* __restrict__ Aab, const float* __restrict__ A64, float* __restrict__ xs_g, float* __restrict__ ys5, int b, int g, int dir) {
    const int tid = opaque_tid(), wid = tid >> 6, lane = tid & 63, lr = lane & 15, q = lane >> 4;
    const int tix = dir * 16 + g;
    LAS3 unsigned char* U = lds + S5_OFF_U; LAS3 unsigned char* Km = lds + S5_OFF_KM; LAS3 unsigned char* Cm = lds + S5_OFF_CM; LAS3 unsigned char* EZ = lds + S5_OFF_EZ;
    float* xs = xs_g + (size_t)((b * 16 + g) * 2 + dir) * 36 * 128;
    __syncthreads();
    for (int i = tid; i < 16 * 128; i += 512) { const int hh = i >> 7, ch = i & 127;
        *(LAS3 u32x4_t*)(Km + (hh * S5_KROW + ch * 8) * 2) = *(const u32x4_t*)(KmT + ((size_t)tix * 16 + hh) * 1024 + ch * 8); }
    if (tid < 256) { const int hh = tid >> 4, ch = tid & 15;
        *(LAS3 u32x4_t*)(Cm + (hh * S5_CROW + ch * 8) * 2) = *(const u32x4_t*)(CmT + ((size_t)tix * 16 + hh) * 128 + ch * 8); }
    for (int i = tid; i < NT * 2; i += 512) {
        const int sidx = i >> 1, hf = i & 1;
        const int n = seq_token(sidx, dir);
        *(LAS3 u32x4_t*)(U + ((64 + sidx) * 16 + hf * 8) * 2) = *(const u32x4_t*)(p + ((size_t)b * NT + n) * DIN + P_S5 + g * 16 + hf * 8);
    }
    for (int i = tid; i < 64 * 8; i += 512) *(LAS3 unsigned*)(U + i * 4) = 0u;
    __syncthreads();
    {
        f32x4_t acc[3];
#pragma unroll
        for (int i = 0; i < 3; ++i) acc[i] = (f32x4_t){0.f, 0.f, 0.f, 0.f};
        const bf16_t* sp = Smat + ((size_t)tix * 128 + 16 * wid + lr) * 1024 + 8 * q;
        int cco[3];
#pragma unroll
        for (int ctile = 0; ctile < 3; ++ctile) { int ch = 16 * ctile + lr; if (ch > 35) ch = 35; cco[ctile] = ((64 + 64 * ch + (q >> 1)) * 16 + 8 * (q & 1)) * 2; }
#pragma unroll 8
        for (int ks = 0; ks < 32; ++ks) {
            const bf16x8_t a = *(const bf16x8_t*)(sp + 32 * ks);
#pragma unroll
            for (int ctile = 0; ctile < 3; ++ctile) {
                const bf16x8_t bfr = *(const LAS3 bf16x8_t*)(U + cco[ctile] + ks * 64);
                acc[ctile] = __builtin_amdgcn_mfma_f32_16x16x32_bf16(a, bfr, acc[ctile], 0, 0, 0);
            }
        }
        LAS3 float* E = (LAS3 float*)EZ;
#pragma unroll
        for (int ctile = 0; ctile < 3; ++ctile)
#pragma unroll
            for (int rg = 0; rg < 4; ++rg) E[(16 * ctile + lr) * 128 + 16 * wid + 4 * q + rg] = acc[ctile][rg];
    }
    __syncthreads();
    const float Ar = Aab[(tix * 64 + lane) * 2], Ai = Aab[(tix * 64 + lane) * 2 + 1];
    if (wid == 0) {
        const float Br = A64[(tix * 64 + lane) * 2], Bi = A64[(tix * 64 + lane) * 2 + 1];
        const LAS3 float* E = (const LAS3 float*)EZ;
        float xr = 0.f, xi = 0.f;
        for (int c = 0; c < 36; ++c) {
            *(float2*)(xs + c * 128 + 2 * lane) = make_float2(xr, xi);
            const float er = E[c * 128 + 2 * lane], ei = E[c * 128 + 2 * lane + 1];
            const float nr = Br * xr - Bi * xi + er, ni = Br * xi + Bi * xr + ei;
            xr = nr; xi = ni;
        }
    }
    __threadfence_block();
    __syncthreads();
    LAS3 unsigned char* Zw = EZ + wid * (16 * S5_ZROW * 2);
    bf16x8_t cmf[4];
#pragma unroll
    for (int ks = 0; ks < 4; ++ks) cmf[ks] = *(const LAS3 bf16x8_t*)(Cm + (lr * S5_CROW + 32 * ks + 8 * q) * 2);
    bf16x8_t kbr[16];
#pragma unroll
    for (int ks = 0; ks < 16; ++ks) kbr[ks] = *(const LAS3 bf16x8_t*)(Km + (lr * S5_KROW + 8 * q) * 2 + ks * 64);
    float2 xnext = *(const float2*)(xs + wid * 128 + 2 * lane);
    for (int c = wid; c < 36; c += 8) {
        const float2 x0 = xnext;
        if (c + 8 < 36) xnext = *(const float2*)(xs + (c + 8) * 128 + 2 * lane);
        float zr = Ar * x0.x - Ai * x0.y, zi = Ar * x0.y + Ai * x0.x;
#pragma unroll
        for (int rt = 0; rt < 4; ++rt) {
#pragma unroll
            for (int ii = 0; ii < 16; ++ii) {
                *(LAS3 unsigned*)(Zw + (ii * S5_ZROW + 2 * lane) * 2) = cvtpk(zr, zi);
                const float nr = Ar * zr - Ai * zi, ni = Ar * zi + Ai * zr; zr = nr; zi = ni;
            }
            asm volatile("s_waitcnt lgkmcnt(0)" ::: "memory");
            f32x4_t acc = (f32x4_t){0.f, 0.f, 0.f, 0.f};
#pragma unroll
            for (int ks = 0; ks < 4; ++ks) {
                const bf16x8_t a = *(const LAS3 bf16x8_t*)(Zw + (lr * S5_ZROW + 32 * ks + 8 * q) * 2);
                acc = __builtin_amdgcn_mfma_f32_16x16x32_bf16(a, cmf[ks], acc, 0, 0, 0);
            }
            const int irow = 16 * rt + lr;
            const LAS3 unsigned char* up = U + ((64 + 64 * c + irow - (q >> 1)) * 16 + 8 * (q & 1)) * 2;
            const LAS3 unsigned char* kp = Km + (lr * S5_KROW + 8 * q) * 2;
            f32x4_t acc1 = (f32x4_t){0.f, 0.f, 0.f, 0.f};
#pragma unroll
            for (int ks0 = 0; ks0 < 8 * rt + 8; ks0 += 8) {
                bf16x8_t av[8], kv[8];
#pragma unroll
                for (int j = 0; j < 8; ++j) { av[j] = *(const LAS3 bf16x8_t*)(up - (ks0 + j) * 64); if (ks0 + j < 16) kv[j] = kbr[ks0 + j]; else kv[j] = *(const LAS3 bf16x8_t*)(kp + (ks0 + j) * 64); }
#pragma unroll
                for (int j = 0; j < 8; ++j) {
                    const int ks = ks0 + j;
                    if (ks >= 8 * rt) {
                        const bool valid = (2 * ks + (q >> 1)) <= irow;
                        if (!valid) av[j] = (bf16x8_t){0, 0, 0, 0, 0, 0, 0, 0};
                    }
                    if (j & 1) acc1 = __builtin_amdgcn_mfma_f32_16x16x32_bf16(av[j], kv[j], acc1, 0, 0, 0);
                    else acc = __builtin_amdgcn_mfma_f32_16x16x32_bf16(av[j], kv[j], acc, 0, 0, 0);
                }
            }
            acc += acc1;
#pragma unroll
            for (int rg = 0; rg < 4; ++rg) {
                const int n = seq_token(64 * c + 16 * rt + 4 * q + rg, dir);
                ((bf16_t*)ys5)[((size_t)dir * TT + (size_t)b * NT + n) * 256 + g * 16 + lr] = f2bf(acc[rg]);
            }
            asm volatile("s_waitcnt lgkmcnt(0)" ::: "memory");
        }
    }
}

#define XB_TMO      128
#define XB_XCNT(j)  (256  + 64 * (j))
#define XB_XSUB(j)  (1280 + 64 * (j))
#define XB_XGEN(j)  (2304 + 64 * (j))
#define XB_TOP      3328
#define XB_TOPGEN   3392
#define XCD_BAR_WORDS 3456
#define XB_SPIN_CAP (1u << 22)
__device__ __forceinline__ unsigned xb_ld(unsigned* p)              { return __hip_atomic_load(p, __ATOMIC_RELAXED, __HIP_MEMORY_SCOPE_AGENT); }
__device__ __forceinline__ unsigned xb_add(unsigned* p, unsigned v) { return __hip_atomic_fetch_add(p, v, __ATOMIC_RELAXED, __HIP_MEMORY_SCOPE_AGENT); }
__device__ __forceinline__ unsigned xb_xcc_id() { return (unsigned)__builtin_amdgcn_s_getreg((3 << 11) | 20) & 0xFu; }
#define XB_SPIN(cond, bar) do { unsigned _sp = 0; while (cond) { __builtin_amdgcn_s_sleep(1); \
    if ((++_sp & 255u) == 0u) { if (xb_ld(&(bar)[XB_TMO])) break; if (_sp > XB_SPIN_CAP) { atomicAdd(&(bar)[XB_TMO], 1u); break; } } } } while (0)
struct XcdBarrier { unsigned* bar; unsigned x; volatile LAS3 unsigned* st; };
__device__ __forceinline__ XcdBarrier xcd_barrier_post(unsigned* bar, volatile LAS3 unsigned* st) {
    XcdBarrier b; b.bar = bar; b.x = xb_xcc_id(); b.st = st;
    if (threadIdx.x == 0) (void)xb_add(&bar[XB_XCNT(b.x)], 1u);
    return b;
}
__device__ __forceinline__ void xcd_barrier_complete(unsigned* bar, unsigned x, unsigned& nloc, unsigned& nx) {
    const unsigned G = gridDim.x * gridDim.y * gridDim.z;
    unsigned sum, cnt, mine, sp = 0u;
    for (;;) {
        sum = 0u; cnt = 0u; mine = 0u;
#pragma unroll
        for (unsigned j = 0; j < 16; ++j) { const unsigned c = xb_ld(&bar[XB_XCNT(j)]); sum += c; cnt += (c > 0u) ? 1u : 0u; mine = (j == x) ? c : mine; }
        if (sum == G) break;
        __builtin_amdgcn_s_sleep(1);
        if ((++sp & 255u) == 0u) { if (xb_ld(&bar[XB_TMO])) break; if (sp > XB_SPIN_CAP) { atomicAdd(&bar[XB_TMO], 1u); break; } }
    }
    nloc = mine > 0u ? mine : 1u; nx = cnt > 0u ? cnt : 1u;
}
__device__ __forceinline__ void xcd_barrier(const XcdBarrier& b) {
    asm volatile("s_waitcnt vmcnt(0)" ::: "memory");
    __syncthreads();
    if (threadIdx.x == 0) {
        unsigned* bar = b.bar;
        __builtin_amdgcn_s_waitcnt(0);
        unsigned nloc = b.st[0], nx = b.st[1];
        if (nloc == 0u) { xcd_barrier_complete(bar, b.x, nloc, nx); b.st[0] = nloc; b.st[1] = nx; }
        const unsigned old = xb_add(&bar[XB_XSUB(b.x)], 1u);
        const unsigned gen = old / nloc;
        if (old + 1u == (gen + 1u) * nloc) {
            __builtin_amdgcn_fence(__ATOMIC_RELEASE, "agent");
            asm volatile("s_waitcnt vmcnt(0)" ::: "memory");
            const unsigned og = xb_add(&bar[XB_TOP], 1u);
            const unsigned tg = og / nx;
            if (og + 1u == (tg + 1u) * nx) xb_add(&bar[XB_TOPGEN], 1u);
            else XB_SPIN(xb_ld(&bar[XB_TOPGEN]) == tg, bar);
            __builtin_amdgcn_fence(__ATOMIC_ACQUIRE, "agent");
            xb_add(&bar[XB_XGEN(b.x)], 1u);
            asm volatile("s_waitcnt vmcnt(0)" ::: "memory");
        } else {
            XB_SPIN(xb_ld(&bar[XB_XGEN(b.x)]) == gen, bar);
            __builtin_amdgcn_fence(__ATOMIC_ACQUIRE, "agent");
            asm volatile("s_waitcnt vmcnt(0)" ::: "memory");
        }
    }
    __syncthreads();
}

struct Params {
    const float *x, *c, *ctx, *c_ctx, *w_mod, *b_mod, *norm_w, *w_in, *w_out, *da_lambda, *da_subln, *ml_conv_w, *ml_conv_b, *ml_gate_b, *ml_norm,
                *mla_q_norm, *mla_w_uq, *mla_kv_norm, *mla_w_ukv, *s5_a_re, *s5_a_im, *s5_log_step, *s5_b_re, *s5_b_im, *s5_c_re, *s5_c_im, *s5_d, *s5_w_glu, *s5_b_glu,
                *moe_w_router, *moe_b_router, *moe_w_gate_up, *moe_b_gate_up, *moe_w_down, *moe_b_down;
    float* out;
    float *xall, *mod, *ropecs, *lamfull;
    bf16_t *w_in_t, *w_out_t, *wgu_t, *wdn_t, *wq_t, *wkv_t, *wglu_t;
    bf16_t *s5KmT, *s5Smat, *s5CmT; float *s5A, *s5A64, *s5xs;
    bf16_t *hbuf, *pb, *daQ, *daK, *daVt, *mQ, *mK, *mVt, *mlQ, *mlK, *mlKt, *mlVt; float *mlG, *hdir, *ys5;
    bf16_t *ycatb, *ob; float* osq; bf16_t* fb;
    int* top_e; float* top_g; int *posb, *tok_slot;
    int *cnt, *tile_e, *ntiles, *offs, *blkcnt;
    bf16_t *xg, *act, *yexp;
    unsigned* bar; int* queue;
};

template <class T> __device__ __forceinline__ T* uni_ptr(T* p) { const unsigned long long v = (unsigned long long)p; const unsigned lo = __builtin_amdgcn_readfirstlane((unsigned)v), hi = __builtin_amdgcn_readfirstlane((unsigned)(v >> 32)); return (T*)(__attribute__((address_space(1))) T*)(((unsigned long long)hi << 32) | lo); }
__device__ __forceinline__ void store_params(LAS3 Params* PL, const Params& P) {
    PL->x = P.x;
    PL->c = P.c;
    PL->ctx = P.ctx;
    PL->c_ctx = P.c_ctx;
    PL->w_mod = P.w_mod;
    PL->b_mod = P.b_mod;
    PL->norm_w = P.norm_w;
    PL->w_in = P.w_in;
    PL->w_out = P.w_out;
    PL->da_lambda = P.da_lambda;
    PL->da_subln = P.da_subln;
    PL->ml_conv_w = P.ml_conv_w;
    PL->ml_conv_b = P.ml_conv_b;
    PL->ml_gate_b = P.ml_gate_b;
    PL->ml_norm = P.ml_norm;
    PL->mla_q_norm = P.mla_q_norm;
    PL->mla_w_uq = P.mla_w_uq;
    PL->mla_kv_norm = P.mla_kv_norm;
    PL->mla_w_ukv = P.mla_w_ukv;
    PL->s5_a_re = P.s5_a_re;
    PL->s5_a_im = P.s5_a_im;
    PL->s5_log_step = P.s5_log_step;
    PL->s5_b_re = P.s5_b_re;
    PL->s5_b_im = P.s5_b_im;
    PL->s5_c_re = P.s5_c_re;
    PL->s5_c_im = P.s5_c_im;
    PL->s5_d = P.s5_d;
    PL->s5_w_glu = P.s5_w_glu;
    PL->s5_b_glu = P.s5_b_glu;
    PL->moe_w_router = P.moe_w_router;
    PL->moe_b_router = P.moe_b_router;
    PL->moe_w_gate_up = P.moe_w_gate_up;
    PL->moe_b_gate_up = P.moe_b_gate_up;
    PL->moe_w_down = P.moe_w_down;
    PL->moe_b_down = P.moe_b_down;
    PL->out = P.out;
    PL->xall = P.xall;
    PL->mod = P.mod;
    PL->ropecs = P.ropecs;
    PL->lamfull = P.lamfull;
    PL->w_in_t = P.w_in_t;
    PL->w_out_t = P.w_out_t;
    PL->wgu_t = P.wgu_t;
    PL->wdn_t = P.wdn_t;
    PL->wq_t = P.wq_t;
    PL->wkv_t = P.wkv_t;
    PL->wglu_t = P.wglu_t;
    PL->s5KmT = P.s5KmT;
    PL->s5Smat = P.s5Smat;
    PL->s5CmT = P.s5CmT;
    PL->s5A = P.s5A;
    PL->s5A64 = P.s5A64;
    PL->s5xs = P.s5xs;
    PL->hbuf = P.hbuf;
    PL->pb = P.pb;
    PL->daQ = P.daQ;
    PL->daK = P.daK;
    PL->daVt = P.daVt;
    PL->mQ = P.mQ;
    PL->mK = P.mK;
    PL->mVt = P.mVt;
    PL->mlQ = P.mlQ;
    PL->mlK = P.mlK;
    PL->mlKt = P.mlKt;
    PL->mlVt = P.mlVt;
    PL->mlG = P.mlG;
    PL->hdir = P.hdir;
    PL->ys5 = P.ys5;
    PL->ycatb = P.ycatb;
    PL->ob = P.ob;
    PL->osq = P.osq;
    PL->fb = P.fb;
    PL->top_e = P.top_e;
    PL->top_g = P.top_g;
    PL->posb = P.posb;
    PL->tok_slot = P.tok_slot;
    PL->cnt = P.cnt;
    PL->tile_e = P.tile_e;
    PL->ntiles = P.ntiles;
    PL->offs = P.offs;
    PL->blkcnt = P.blkcnt;
    PL->xg = P.xg;
    PL->act = P.act;
    PL->yexp = P.yexp;
    PL->bar = P.bar;
    PL->queue = P.queue;
}
__device__ __forceinline__ Params load_params(const LAS3 Params* PL) {
    Params Q;
    Q.x = uni_ptr(PL->x);
    Q.c = uni_ptr(PL->c);
    Q.ctx = uni_ptr(PL->ctx);
    Q.c_ctx = uni_ptr(PL->c_ctx);
    Q.w_mod = uni_ptr(PL->w_mod);
    Q.b_mod = uni_ptr(PL->b_mod);
    Q.norm_w = uni_ptr(PL->norm_w);
    Q.w_in = uni_ptr(PL->w_in);
    Q.w_out = uni_ptr(PL->w_out);
    Q.da_lambda = uni_ptr(PL->da_lambda);
    Q.da_subln = uni_ptr(PL->da_subln);
    Q.ml_conv_w = uni_ptr(PL->ml_conv_w);
    Q.ml_conv_b = uni_ptr(PL->ml_conv_b);
    Q.ml_gate_b = uni_ptr(PL->ml_gate_b);
    Q.ml_norm = uni_ptr(PL->ml_norm);
    Q.mla_q_norm = uni_ptr(PL->mla_q_norm);
    Q.mla_w_uq = uni_ptr(PL->mla_w_uq);
    Q.mla_kv_norm = uni_ptr(PL->mla_kv_norm);
    Q.mla_w_ukv = uni_ptr(PL->mla_w_ukv);
    Q.s5_a_re = uni_ptr(PL->s5_a_re);
    Q.s5_a_im = uni_ptr(PL->s5_a_im);
    Q.s5_log_step = uni_ptr(PL->s5_log_step);
    Q.s5_b_re = uni_ptr(PL->s5_b_re);
    Q.s5_b_im = uni_ptr(PL->s5_b_im);
    Q.s5_c_re = uni_ptr(PL->s5_c_re);
    Q.s5_c_im = uni_ptr(PL->s5_c_im);
    Q.s5_d = uni_ptr(PL->s5_d);
    Q.s5_w_glu = uni_ptr(PL->s5_w_glu);
    Q.s5_b_glu = uni_ptr(PL->s5_b_glu);
    Q.moe_w_router = uni_ptr(PL->moe_w_router);
    Q.moe_b_router = uni_ptr(PL->moe_b_router);
    Q.moe_w_gate_up = uni_ptr(PL->moe_w_gate_up);
    Q.moe_b_gate_up = uni_ptr(PL->moe_b_gate_up);
    Q.moe_w_down = uni_ptr(PL->moe_w_down);
    Q.moe_b_down = uni_ptr(PL->moe_b_down);
    Q.out = uni_ptr(PL->out);
    Q.xall = uni_ptr(PL->xall);
    Q.mod = uni_ptr(PL->mod);
    Q.ropecs = uni_ptr(PL->ropecs);
    Q.lamfull = uni_ptr(PL->lamfull);
    Q.w_in_t = uni_ptr(PL->w_in_t);
    Q.w_out_t = uni_ptr(PL->w_out_t);
    Q.wgu_t = uni_ptr(PL->wgu_t);
    Q.wdn_t = uni_ptr(PL->wdn_t);
    Q.wq_t = uni_ptr(PL->wq_t);
    Q.wkv_t = uni_ptr(PL->wkv_t);
    Q.wglu_t = uni_ptr(PL->wglu_t);
    Q.s5KmT = uni_ptr(PL->s5KmT);
    Q.s5Smat = uni_ptr(PL->s5Smat);
    Q.s5CmT = uni_ptr(PL->s5CmT);
    Q.s5A = uni_ptr(PL->s5A);
    Q.s5A64 = uni_ptr(PL->s5A64);
    Q.s5xs = uni_ptr(PL->s5xs);
    Q.hbuf = uni_ptr(PL->hbuf);
    Q.pb = uni_ptr(PL->pb);
    Q.daQ = uni_ptr(PL->daQ);
    Q.daK = uni_ptr(PL->daK);
    Q.daVt = uni_ptr(PL->daVt);
    Q.mQ = uni_ptr(PL->mQ);
    Q.mK = uni_ptr(PL->mK);
    Q.mVt = uni_ptr(PL->mVt);
    Q.mlQ = uni_ptr(PL->mlQ);
    Q.mlK = uni_ptr(PL->mlK);
    Q.mlKt = uni_ptr(PL->mlKt);
    Q.mlVt = uni_ptr(PL->mlVt);
    Q.mlG = uni_ptr(PL->mlG);
    Q.hdir = uni_ptr(PL->hdir);
    Q.ys5 = uni_ptr(PL->ys5);
    Q.ycatb = uni_ptr(PL->ycatb);
    Q.ob = uni_ptr(PL->ob);
    Q.osq = uni_ptr(PL->osq);
    Q.fb = uni_ptr(PL->fb);
    Q.top_e = uni_ptr(PL->top_e);
    Q.top_g = uni_ptr(PL->top_g);
    Q.posb = uni_ptr(PL->posb);
    Q.tok_slot = uni_ptr(PL->tok_slot);
    Q.cnt = uni_ptr(PL->cnt);
    Q.tile_e = uni_ptr(PL->tile_e);
    Q.ntiles = uni_ptr(PL->ntiles);
    Q.offs = uni_ptr(PL->offs);
    Q.blkcnt = uni_ptr(PL->blkcnt);
    Q.xg = uni_ptr(PL->xg);
    Q.act = uni_ptr(PL->act);
    Q.yexp = uni_ptr(PL->yexp);
    Q.bar = uni_ptr(PL->bar);
    Q.queue = uni_ptr(PL->queue);
    return Q;
}
constexpr int MK_LDS_MAIN = 147968;
constexpr int MK_LDS_BYTES = MK_LDS_MAIN + 64 + 1024;
enum { PH_SETUP = 0, PH_H0 = 1, PH_LAYER0 = 2, PH_PER_LAYER = 10, PH_TOTAL = 22 };
enum { L_GEMM_IN = 0, L_PREP, L_MIX, L_FINISH, L_GEMM_OUT, L_POST, L_SCATTER, L_GEMM_GU, L_GEMM_DN, L_COMBINE };

__device__ __forceinline__ void conv_tile(LAS3 float* tile, int lane, const float* __restrict__ W, int N, bf16_t* __restrict__ WT, int ldt, int tn, int tk, int mode) {
    const int n0 = tn * 64, k0 = tk * 64;
    const int kq = lane >> 4, n4 = (lane & 15) * 4;
    const int nl = (n0 + n4 < N) ? n0 + n4 : N - 4;
    const float* wp = W + (size_t)(k0 + kq) * N + nl;
    float4 v[16];
#pragma unroll
    for (int j = 0; j < 16; ++j) v[j] = *(const float4*)(wp + (size_t)(4 * j) * N);
#pragma unroll
    for (int j = 0; j < 16; ++j) { LAS3 float* tp = tile + (4 * j + kq) * 65 + n4; tp[0] = v[j].x; tp[1] = v[j].y; tp[2] = v[j].z; tp[3] = v[j].w; }
    asm volatile("s_waitcnt lgkmcnt(0)" ::: "memory");
    {
        const int c = lane & 7;
#pragma unroll
        for (int jn = 0; jn < 8; ++jn) {
            const int n = (lane >> 3) + 8 * jn, gn = n0 + n;
            if (gn < N) {
                int dr = gn;
                if (mode == 1) dr = (gn < 1024) ? ((gn >> 7) * 256 + (gn & 127)) : ((((gn - 1024) >> 7) * 256) + 128 + ((gn - 1024) & 127));
                const LAS3 float* tp = tile + (8 * c) * 65 + n;
                u32x4_t o;
                o.x = pk2bf(tp[0 * 65], tp[1 * 65]); o.y = pk2bf(tp[2 * 65], tp[3 * 65]); o.z = pk2bf(tp[4 * 65], tp[5 * 65]); o.w = pk2bf(tp[6 * 65], tp[7 * 65]);
                *(u32x4_t*)(WT + (size_t)dr * ldt + k0 + 8 * c) = o;
            }
        }
    }
    asm volatile("s_waitcnt lgkmcnt(0)" ::: "memory");
}
constexpr int CV_IN = 38 * 16 * 2, CV_OUT = 256 * 2, CV_GU = 512 * 64, CV_DN = 256 * 64, CV_Q = 18 * 2, CV_KV = 16 * 2, CV_GLU = 16 * 2;
constexpr int CV_TOTAL = CV_IN + CV_OUT + CV_GU + CV_DN + CV_Q + CV_KV + CV_GLU;
__device__ __forceinline__ void conv_dispatch(const Params& P, LAS3 float* tile, int st, int it) {
    const float* W = nullptr; bf16_t* WT = nullptr; int N = 64, ldt = 64, tn = 0, tk = 0, mode = 0;
    if (it < CV_TOTAL) {
        int r = it;
        if (r < CV_IN) { const int bt = r / 608, q = r % 608; W = P.w_in + (size_t)bt * 1024 * DINC; N = DINC; WT = P.w_in_t + (size_t)bt * 2560 * 1024; ldt = 1024; tn = q % 38; tk = q / 38; }
        else if ((r -= CV_IN) < CV_OUT) { const int bt = r / 256, q = r % 256; W = P.w_out + (size_t)bt * 1024 * 1024; N = 1024; WT = P.w_out_t + (size_t)bt * 1024 * 1024; ldt = 1024; tn = q % 16; tk = q / 16; }
        else if ((r -= CV_OUT) < CV_GU) { const int bt = r / 512, q = r % 512; W = P.moe_w_gate_up + (size_t)bt * 1024 * 2048; N = 2048; WT = P.wgu_t + (size_t)bt * 2048 * 1024; ldt = 1024; tn = q % 32; tk = q / 32; mode = 1; }
        else if ((r -= CV_GU) < CV_DN) { const int bt = r / 256, q = r % 256; W = P.moe_w_down + (size_t)bt * 1024 * 1024; N = 1024; WT = P.wdn_t + (size_t)bt * 1024 * 1024; ldt = 1024; tn = q % 16; tk = q / 16; }
        else if ((r -= CV_DN) < CV_Q) { const int bt = r / 18, q = r % 18; W = P.mla_w_uq + (size_t)bt * 192 * 384; N = 384; WT = P.wq_t + (size_t)bt * 384 * 192; ldt = 192; tn = q % 6; tk = q / 6; }
        else if ((r -= CV_Q) < CV_KV) { const int bt = r / 16, q = r % 16; W = P.mla_w_ukv + (size_t)bt * 128 * 512; N = 512; WT = P.wkv_t + (size_t)bt * 512 * 128; ldt = 128; tn = q % 8; tk = q / 8; }
        else { r -= CV_KV; const int bt = r / 16, q = r % 16; W = P.s5_w_glu + (size_t)bt * 256 * 256; N = 256; WT = P.wglu_t + (size_t)bt * 256 * 256; ldt = 256; tn = q % 4; tk = q / 4; }
    }
    if (W) conv_tile(tile, st, W, N, WT, ldt, tn, tk, mode);
}
__device__ __forceinline__ void phase_setup(const Params& P, LAS3 unsigned char* lds) {
    const int tid = opaque_tid(), G = gridDim.x, bid = blockIdx.x;
    for (int it = bid; it < 192; it += G) {
        LAS3 float* sl = (LAS3 float*)lds;
        LAS3 float* red = sl + 9 * 1024;
        __syncthreads();
        for (int i = tid; i < 9 * 1024; i += 512) { const int r = i >> 10, k = i & 1023; sl[i] = siluf_((r < 8) ? P.c[r * 1024 + k] : P.c_ctx[k]); }
        __syncthreads();
        const int l = it / 96, j = (it % 96) * 64 + (tid & 63), kp = tid >> 6;
        const float* w = P.w_mod + (size_t)l * 1024 * 6144 + j;
        float acc[9];
#pragma unroll
        for (int r = 0; r < 9; ++r) acc[r] = 0.f;
#pragma unroll 8
        for (int k = kp * 128; k < kp * 128 + 128; ++k) {
            const float wv = w[(size_t)k * 6144];
#pragma unroll
            for (int r = 0; r < 9; ++r) acc[r] += sl[r * 1024 + k] * wv;
        }
#pragma unroll
        for (int r = 0; r < 9; ++r) red[(kp * 9 + r) * 64 + (tid & 63)] = acc[r];
        __syncthreads();
        for (int i = tid; i < 9 * 64; i += 512) {
            const int r = i >> 6, cc = i & 63; float sacc = 0.f;
#pragma unroll
            for (int k2 = 0; k2 < 8; ++k2) sacc += red[(k2 * 9 + r) * 64 + cc];
            const int jj = (it % 96) * 64 + cc;
            P.mod[((size_t)l * 9 + r) * 6144 + jj] = sacc + P.b_mod[l * 6144 + jj];
        }
    }
    for (int i = bid * 512 + tid; i < NS * 16; i += G * 512) {
        const int pos = i >> 4, j = i & 15; const int row = pos / 64, col = pos % 64;
        const float inv = exp2f(-(float)(j & 7) * 1.6609640474436813f), ang = (float)((j < 8) ? row : col) * inv;
        P.ropecs[i * 2] = cosf(ang); P.ropecs[i * 2 + 1] = sinf(ang);
    }
    if (bid == G - 1 && tid < 2) {
        const int l = tid; const float* lam = P.da_lambda + l * 128; float s1 = 0.f, s2 = 0.f;
        for (int i = 0; i < 32; ++i) { s1 += lam[i] * lam[32 + i]; s2 += lam[64 + i] * lam[96 + i]; }
        P.lamfull[l] = expf(s1) - expf(s2) + ((l == 0) ? 0.2f : 0.35550906759096927f);
    }
    for (int it = G - 1 - bid; it < 64; it += G)
        s5_setup_item(lds, it, P.s5_a_re, P.s5_a_im, P.s5_log_step, P.s5_b_re, P.s5_b_im, P.s5_c_re, P.s5_c_im, P.s5KmT, P.s5Smat, P.s5CmT, P.s5A, P.s5A64);
    for (int i = bid * 512 + tid; i < 2 * 144 * 1024 / 8; i += G * 512) {
        const int l = i / (144 * 128), r = i % (144 * 128);
        *(u32x4_t*)(P.w_in_t + ((size_t)l * 2560 + DINC) * 1024 + (size_t)r * 8) = (u32x4_t){0u, 0u, 0u, 0u};
    }
    __syncthreads();
    {
        const int wv = __builtin_amdgcn_readfirstlane(tid >> 6), lane = tid & 63;
        LAS3 float* tile = (LAS3 float*)lds + wv * (64 * 65);
        for (;;) {
            int base = 0;
            if (lane == 0) base = atomicAdd(P.queue + 2, 4);
            base = __builtin_amdgcn_readfirstlane(base);
            if (base >= CV_TOTAL) break;
            for (int it = base; it < base + 4 && it < CV_TOTAL; ++it) conv_dispatch(P, tile, lane, it);
        }
    }
}

__device__ __forceinline__ void row_modulate_store(const float (&xv)[16], const LAS3 float* nw, const LAS3 float* modr, bf16_t* __restrict__ dst, int lane) {
    float ss = 0.f;
#pragma unroll
    for (int i = 0; i < 16; ++i) ss += xv[i] * xv[i];
    ss = wave_sum(ss);
    const float rstd = rsqrtf(ss * (1.f / DM) + 1e-6f);
#pragma unroll
    for (int j = 0; j < 4; ++j) {
        const int d = j * 256 + lane * 4;
        const f32x4_t w = *(const LAS3 f32x4_t*)(nw + d), sh = *(const LAS3 f32x4_t*)(modr + d), sc = *(const LAS3 f32x4_t*)(modr + 1024 + d);
        const float o0 = xv[j * 4 + 0] * rstd * w[0] * (1.f + sc[0]) + sh[0], o1 = xv[j * 4 + 1] * rstd * w[1] * (1.f + sc[1]) + sh[1];
        const float o2 = xv[j * 4 + 2] * rstd * w[2] * (1.f + sc[2]) + sh[2], o3 = xv[j * 4 + 3] * rstd * w[3] * (1.f + sc[3]) + sh[3];
        *(uint2*)(dst + d) = make_uint2(cvtpk(o0, o1), cvtpk(o2, o3));
    }
}
__device__ __forceinline__ void phase_h0(const Params& P, LAS3 unsigned char* lds) {
    const int tid = opaque_tid(); const int lane = tid & 63, gw = blockIdx.x * 8 + (tid >> 6), NW = gridDim.x * 8;
    LAS3 float* cw = (LAS3 float*)lds;
    for (int i = tid; i < 256; i += 512) *(LAS3 f32x4_t*)(cw + i * 4) = *(const f32x4_t*)(P.norm_w + i * 4);
    for (int i = tid; i < 9 * 512; i += 512) { const int r = i >> 9, k = i & 511; *(LAS3 f32x4_t*)(cw + 1024 + r * 2048 + k * 4) = *(const f32x4_t*)(P.mod + (size_t)r * 6144 + k * 4); }
    __syncthreads();
    for (int t = gw; t < TT; t += NW) {
        const int b = t / NT, n = t % NT;
        const float* src = (n < NC) ? P.ctx + ((size_t)b * NC + n) * DM : P.x + ((size_t)b * NS + (n - NC)) * DM;
        float xv[16];
#pragma unroll
        for (int j = 0; j < 4; ++j) { const float4 v = *(const float4*)(src + j * 256 + lane * 4); xv[j * 4] = v.x; xv[j * 4 + 1] = v.y; xv[j * 4 + 2] = v.z; xv[j * 4 + 3] = v.w; }
        row_modulate_store(xv, cw, cw + 1024 + ((n < NC) ? 8 : b) * 2048, P.hbuf + (size_t)t * DM, lane);
    }
}

constexpr int TS_ROW = 264;
__device__ __forceinline__ void write_transposed(const LAS3 bf16_t* ts, bf16_t* __restrict__ dst, int b, int n0, int tid) {
    const int ch = tid & 255, hf = tid >> 8;
    bf16_t* vp = dst + (((size_t)b * 4 + (ch >> 6)) * 64 + (ch & 63)) * NT + n0 + hf * 32;
#pragma unroll
    for (int tc = 0; tc < 4; ++tc) {
        const LAS3 bf16_t* tp = ts + (hf * 32 + tc * 8) * TS_ROW + ch;
        u32x4_t o;
        o.x = (unsigned)tp[0] | ((unsigned)tp[TS_ROW] << 16); o.y = (unsigned)tp[2 * TS_ROW] | ((unsigned)tp[3 * TS_ROW] << 16);
        o.z = (unsigned)tp[4 * TS_ROW] | ((unsigned)tp[5 * TS_ROW] << 16); o.w = (unsigned)tp[6 * TS_ROW] | ((unsigned)tp[7 * TS_ROW] << 16);
        *(u32x4_t*)(vp + tc * 8) = o;
    }
}
__device__ __forceinline__ void unpack8(const u32x4_t v, float (&f)[8]) {
    f[0] = __uint_as_float(v.x << 16); f[1] = __uint_as_float(v.x & 0xFFFF0000u); f[2] = __uint_as_float(v.y << 16); f[3] = __uint_as_float(v.y & 0xFFFF0000u);
    f[4] = __uint_as_float(v.z << 16); f[5] = __uint_as_float(v.z & 0xFFFF0000u); f[6] = __uint_as_float(v.w << 16); f[7] = __uint_as_float(v.w & 0xFFFF0000u);
}
__device__ __forceinline__ u32x4_t pack8(const float (&f)[8]) { return (u32x4_t){cvtpk(f[0], f[1]), cvtpk(f[2], f[3]), cvtpk(f[4], f[5]), cvtpk(f[6], f[7])}; }

__device__ __forceinline__ void prep_da(const Params& P, LAS3 unsigned char* lds, int tile) {
    const int tid = opaque_tid();
    const int t0 = tile * 64, b = t0 / NT, n0 = t0 % NT;
    LAS3 bf16_t* vs = (LAS3 bf16_t*)lds;
    const float qscale = 0.17677669529663687f * 1.4426950408889634f;
    const bf16_t* __restrict__ pbr = P.pb; const float* __restrict__ rcs = P.ropecs;
    __syncthreads();
    {
        u32x4_t vv[4];
#pragma unroll
        for (int u = 0; u < 4; ++u) { const int id = tid + 512 * u, i = id >> 5, cg = id & 31; vv[u] = *(const u32x4_t*)(pbr + (size_t)(t0 + i) * DIN + P_DAV + cg * 8); }
#pragma unroll
        for (int u = 0; u < 4; ++u) { const int id = tid + 512 * u, i = id >> 5, cg = id & 31; *(LAS3 u32x4_t*)(vs + i * TS_ROW + cg * 8) = vv[u]; }
    }
#pragma unroll
    for (int u0 = 0; u0 < 4; u0 += 2) {
        u32x4_t lo[2], hi[2]; float4 cs[2][4];
#pragma unroll
        for (int u = 0; u < 2; ++u) {
            const int id = tid + 512 * (u0 + u), i = id >> 5, pu = id & 31, isk = pu >> 4, blk = (pu >> 1) & 7, pr = pu & 1;
            const bf16_t* src = pbr + (size_t)(t0 + i) * DIN + (isk ? P_DAK : P_DAQ) + blk * 32 + pr * 8;
            lo[u] = *(const u32x4_t*)src; hi[u] = *(const u32x4_t*)(src + 16);
            const int pos = max(n0 + i - NC, 0);
            const float4* cp = (const float4*)(rcs + (pos * 16 + pr * 8) * 2);
            cs[u][0] = cp[0]; cs[u][1] = cp[1]; cs[u][2] = cp[2]; cs[u][3] = cp[3];
        }
#pragma unroll
        for (int u = 0; u < 2; ++u) {
            const int id = tid + 512 * (u0 + u), i = id >> 5, pu = id & 31, isk = pu >> 4, blk = (pu >> 1) & 7, pr = pu & 1;
            const int n = n0 + i; const bool lat = n >= NC;
            float fl[8], fh[8], ol[8], oh[8];
            unpack8(lo[u], fl); unpack8(hi[u], fh);
            const float cc[8] = {cs[u][0].x, cs[u][0].z, cs[u][1].x, cs[u][1].z, cs[u][2].x, cs[u][2].z, cs[u][3].x, cs[u][3].z};
            const float sn[8] = {cs[u][0].y, cs[u][0].w, cs[u][1].y, cs[u][1].w, cs[u][2].y, cs[u][2].w, cs[u][3].y, cs[u][3].w};
            const float sc = isk ? 1.f : qscale;
#pragma unroll
            for (int e = 0; e < 8; ++e) {
                const float c1 = lat ? cc[e] : 1.f, s1 = lat ? sn[e] : 0.f;
                ol[e] = (fl[e] * c1 - fh[e] * s1) * sc; oh[e] = (fh[e] * c1 + fl[e] * s1) * sc;
            }
            bf16_t* dst = (isk ? P.daK : P.daQ) + (((size_t)b * 4 + (blk >> 1)) * NT + n) * 64 + (blk & 1) * 32 + pr * 8;
            *(u32x4_t*)dst = pack8(ol); *(u32x4_t*)(dst + 16) = pack8(oh);
        }
    }
    __syncthreads();
    write_transposed(vs, P.daVt, b, n0, tid);
}
__device__ __forceinline__ void prep_ml(const Params& P, LAS3 unsigned char* lds, int tile, int l) {
    const int tid = opaque_tid();
    const int t0 = tile * 64, b = t0 / NT, n0 = t0 % NT;
    LAS3 bf16_t* ks = (LAS3 bf16_t*)lds; LAS3 bf16_t* vs = ks + 64 * TS_ROW; LAS3 float* cwl = (LAS3 float*)(vs + 64 * TS_ROW);
    const int seg_lo = (n0 < NC) ? 0 : NC, seg_hi = (n0 < NC) ? NC - 1 : NT - 1;
    const bf16_t* __restrict__ pbr = P.pb;
    __syncthreads();
    for (int i = tid; i < 2048; i += 512) cwl[i] = (i < 1536) ? P.ml_conv_w[l * 1536 + i] : P.ml_conv_b[l * 512 + (i - 1536)];
    {
        u32x4_t vv[4];
#pragma unroll
        for (int u = 0; u < 4; ++u) { const int id = tid + 512 * u, i = id >> 5, cg = id & 31; vv[u] = *(const u32x4_t*)(pbr + (size_t)(t0 + i) * DIN + P_MLV + cg * 8); }
#pragma unroll
        for (int u = 0; u < 4; ++u) { const int id = tid + 512 * u, i = id >> 5, cg = id & 31; *(LAS3 u32x4_t*)(vs + i * TS_ROW + cg * 8) = vv[u]; }
        if (tid < 128) {
            const int i = tid >> 1, hf = tid & 1; float g[8];
            unpack8(*(const u32x4_t*)(pbr + (size_t)(t0 + i) * DIN + P_MLG + hf * 8), g);
#pragma unroll
            for (int e = 0; e < 8; ++e) { const int c = hf * 8 + e; g[e] += P.ml_gate_b[l * 16 + c]; if ((c >> 2) & 1) g[e] = logsigmoidf_(g[e]); }
            float* gp = P.mlG + ((size_t)t0 + i) * 16 + hf * 8;
            *(float4*)gp = make_float4(g[0], g[1], g[2], g[3]); *(float4*)(gp + 4) = make_float4(g[4], g[5], g[6], g[7]);
        }
    }
    __syncthreads();
#pragma unroll 1
    for (int u0 = 0; u0 < 8; u0 += 2) {
        u32x4_t xm[2], x0[2], xp[2];
#pragma unroll
        for (int u = 0; u < 2; ++u) {
            const int id = tid + 512 * (u0 + u), i = id >> 6, cg = id & 63, n = n0 + i;
            const int nm = max(n - 1, seg_lo), np = min(n + 1, seg_hi);
            const bf16_t* base = pbr + (size_t)b * NT * DIN + P_MLQK + cg * 8;
            xm[u] = *(const u32x4_t*)(base + (size_t)nm * DIN); x0[u] = *(const u32x4_t*)(base + (size_t)n * DIN); xp[u] = *(const u32x4_t*)(base + (size_t)np * DIN);
        }
#pragma unroll
        for (int u = 0; u < 2; ++u) {
            const int id = tid + 512 * (u0 + u), i = id >> 6, cg = id & 63, n = n0 + i;
            const float m0 = (n - 1 >= seg_lo) ? 1.f : 0.f, m2 = (n + 1 <= seg_hi) ? 1.f : 0.f;
            float a[8], c0[8], d[8], y[8];
            unpack8(xm[u], a); unpack8(x0[u], c0); unpack8(xp[u], d);
            const LAS3 float* w = cwl + cg * 8;
#pragma unroll
            for (int e = 0; e < 8; ++e) {
                float v = w[1536 + e] + a[e] * w[e] * m0 + c0[e] * w[512 + e] + d[e] * w[1024 + e] * m2;
                v = siluf_(v); if (cg >= 32) v *= 0.125f;
                y[e] = v;
            }
            const u32x4_t o = pack8(y);
            const int cc = (cg & 31) * 8;
            bf16_t* dst = ((cg < 32) ? P.mlQ : P.mlK) + (((size_t)b * 4 + (cc >> 6)) * NT + n) * 64 + (cc & 63);
            *(u32x4_t*)dst = o;
            if (cg >= 32) *(LAS3 u32x4_t*)(ks + i * TS_ROW + cc) = o;
        }
    }
    __syncthreads();
    write_transposed(ks, P.mlKt, b, n0, tid);
    write_transposed(vs, P.mlVt, b, n0, tid);
}
__device__ __forceinline__ void prep_mla(const Params& P, LAS3 unsigned char* lds, int tile, int l) {
    const int tid = opaque_tid(), wid = tid >> 6, lane = tid & 63, lr = lane & 15, q = lane >> 4;
    const int t0 = tile * 64, b = t0 / NT, n0 = t0 % NT;
    constexpr int AROW = 328;
    LAS3 bf16_t* As = (LAS3 bf16_t*)lds;
    const float qscale = 0.10206207261596575f * 1.4426950408889634f;
    const float* qn = P.mla_q_norm + l * 192; const float* kvn = P.mla_kv_norm + l * 128;
    const bf16_t* __restrict__ pbr = P.pb; bf16_t* __restrict__ oMK = P.mK; const float* __restrict__ rcs = P.ropecs;
    __syncthreads();
    {
        const int i = tid >> 3, sidx = tid & 7;
        const bf16_t* pr = pbr + (size_t)(t0 + i) * DIN;
        u32x4_t cqv[3], ckv[2];
#pragma unroll
        for (int u = 0; u < 3; ++u) cqv[u] = *(const u32x4_t*)(pr + P_CQ + (sidx + 8 * u) * 8);
#pragma unroll
        for (int u = 0; u < 2; ++u) ckv[u] = *(const u32x4_t*)(pr + P_CKV + (sidx + 8 * u) * 8);
        float fq[3][8], fk[2][8]; float sq = 0.f, sk = 0.f;
#pragma unroll
        for (int u = 0; u < 3; ++u) { unpack8(cqv[u], fq[u]);
#pragma unroll
            for (int e = 0; e < 8; ++e) sq += fq[u][e] * fq[u][e]; }
#pragma unroll
        for (int u = 0; u < 2; ++u) { unpack8(ckv[u], fk[u]);
#pragma unroll
            for (int e = 0; e < 8; ++e) sk += fk[u][e] * fk[u][e]; }
#pragma unroll
        for (int o = 1; o < 8; o <<= 1) { sq += __shfl_xor(sq, o); sk += __shfl_xor(sk, o); }
        const float rq = rsqrtf(sq * (1.f / 192.f) + 1e-6f), rk = rsqrtf(sk * (1.f / 128.f) + 1e-6f);
#pragma unroll
        for (int u = 0; u < 3; ++u) { const int c0 = (sidx + 8 * u) * 8; float o[8];
#pragma unroll
            for (int e = 0; e < 8; ++e) o[e] = fq[u][e] * rq * qn[c0 + e];
            *(LAS3 u32x4_t*)(As + i * AROW + c0) = pack8(o); }
#pragma unroll
        for (int u = 0; u < 2; ++u) { const int c0 = (sidx + 8 * u) * 8; float o[8];
#pragma unroll
            for (int e = 0; e < 8; ++e) o[e] = fk[u][e] * rk * kvn[c0 + e];
            *(LAS3 u32x4_t*)(As + i * AROW + 192 + c0) = pack8(o); }
    }
    if (tid < 256) {
        const int i = tid >> 2, c = tid & 3, n = n0 + i; const bool lat = n >= NC;
        const bf16_t* pr = pbr + (size_t)(t0 + i) * DIN + P_KR;
        const u32x4_t kav = *(const u32x4_t*)(pr + 8 * c), kbv = *(const u32x4_t*)(pr + 8 * (c ^ 2));
        const int pos = max(n - NC, 0);
        const float4* cp = (const float4*)(rcs + (pos * 16 + 8 * (c & 1)) * 2);
        const float4 c0 = cp[0], c1 = cp[1], c2 = cp[2], c3 = cp[3];
        const float sg = (c < 2) ? -1.f : 1.f;
        float ka[8], kb2[8], ko[8];
        unpack8(kav, ka); unpack8(kbv, kb2);
#define RK_(e, cc, ss) ko[e] = ka[e] * (lat ? (cc) : 1.f) + kb2[e] * (lat ? (ss) * sg : 0.f)
        RK_(0, c0.x, c0.y); RK_(1, c0.z, c0.w); RK_(2, c1.x, c1.y); RK_(3, c1.z, c1.w); RK_(4, c2.x, c2.y); RK_(5, c2.z, c2.w); RK_(6, c3.x, c3.y); RK_(7, c3.z, c3.w);
#undef RK_
        const u32x4_t ov = pack8(ko);
#pragma unroll
        for (int hh = 0; hh < 4; ++hh) *(u32x4_t*)(oMK + (((size_t)b * 4 + hh) * NT + n) * 96 + 64 + 8 * c) = ov;
    }
    __syncthreads();
    const int h = wid >> 1;
    if ((wid & 1) == 0) {
        const bf16_t* wt = P.wq_t + (size_t)l * 384 * 192;
        f32x4_t acc[4][6];
#pragma unroll
        for (int rt = 0; rt < 4; ++rt)
#pragma unroll
            for (int ct = 0; ct < 6; ++ct) acc[rt][ct] = (f32x4_t){0.f, 0.f, 0.f, 0.f};
#pragma unroll
        for (int ks = 0; ks < 6; ++ks) {
            bf16x8_t a[4];
#pragma unroll
            for (int rt = 0; rt < 4; ++rt) a[rt] = *(const LAS3 bf16x8_t*)(As + (16 * rt + lr) * AROW + 32 * ks + 8 * q);
#pragma unroll
            for (int ct = 0; ct < 6; ++ct) {
                const bf16x8_t bb = *(const bf16x8_t*)(wt + (size_t)(h * 96 + 16 * ct + lr) * 192 + 32 * ks + 8 * q);
#pragma unroll
                for (int rt = 0; rt < 4; ++rt) acc[rt][ct] = __builtin_amdgcn_mfma_f32_16x16x32_bf16(bb, a[rt], acc[rt][ct], 0, 0, 0);
            }
        }
#pragma unroll
        for (int rt = 0; rt < 4; ++rt) {
            const int n = n0 + 16 * rt + lr;
            bf16_t* qp = P.mQ + (((size_t)b * 4 + h) * NT + n) * 96;
#pragma unroll
            for (int ct = 0; ct < 4; ++ct)
                *(uint2*)(qp + 16 * ct + 4 * q) = make_uint2(cvtpk(acc[rt][ct][0] * qscale, acc[rt][ct][1] * qscale), cvtpk(acc[rt][ct][2] * qscale, acc[rt][ct][3] * qscale));
            f32x4_t x1 = acc[rt][4], x2 = acc[rt][5];
            if (n >= NC) {
                const float4* cp = (const float4*)(rcs + ((n - NC) * 16 + 4 * q) * 2);
                const float4 ca = cp[0], cb = cp[1];
                const f32x4_t co = (f32x4_t){ca.x, ca.z, cb.x, cb.z}, si = (f32x4_t){ca.y, ca.w, cb.y, cb.w};
                const f32x4_t o1 = x1 * co - x2 * si, o2 = x2 * co + x1 * si; x1 = o1; x2 = o2;
            }
            *(uint2*)(qp + 64 + 4 * q) = make_uint2(cvtpk(x1[0] * qscale, x1[1] * qscale), cvtpk(x1[2] * qscale, x1[3] * qscale));
            *(uint2*)(qp + 80 + 4 * q) = make_uint2(cvtpk(x2[0] * qscale, x2[1] * qscale), cvtpk(x2[2] * qscale, x2[3] * qscale));
        }
    } else {
        const bf16_t* wt = P.wkv_t + (size_t)l * 512 * 128;
#pragma unroll
        for (int pass = 0; pass < 2; ++pass) {
            f32x4_t acc[4][4];
#pragma unroll
            for (int rt = 0; rt < 4; ++rt)
#pragma unroll
                for (int ct = 0; ct < 4; ++ct) acc[rt][ct] = (f32x4_t){0.f, 0.f, 0.f, 0.f};
#pragma unroll
            for (int ks = 0; ks < 4; ++ks) {
                bf16x8_t a[4];
#pragma unroll
                for (int rt = 0; rt < 4; ++rt) a[rt] = *(const LAS3 bf16x8_t*)(As + (16 * rt + lr) * AROW + 192 + 32 * ks + 8 * q);
#pragma unroll
                for (int ct = 0; ct < 4; ++ct) {
                    const bf16x8_t bb = *(const bf16x8_t*)(wt + (size_t)(h * 128 + 16 * (4 * pass + ct) + lr) * 128 + 32 * ks + 8 * q);
#pragma unroll
                    for (int rt = 0; rt < 4; ++rt)
                        acc[rt][ct] = (pass == 0) ? __builtin_amdgcn_mfma_f32_16x16x32_bf16(bb, a[rt], acc[rt][ct], 0, 0, 0) : __builtin_amdgcn_mfma_f32_16x16x32_bf16(a[rt], bb, acc[rt][ct], 0, 0, 0);
                }
            }
#pragma unroll
            for (int rt = 0; rt < 4; ++rt) {
                if (pass == 0) {
                    const int n = n0 + 16 * rt + lr;
                    bf16_t* kp = P.mK + (((size_t)b * 4 + h) * NT + n) * 96;
#pragma unroll
                    for (int ct = 0; ct < 4; ++ct) *(uint2*)(kp + 16 * ct + 4 * q) = make_uint2(cvtpk(acc[rt][ct][0], acc[rt][ct][1]), cvtpk(acc[rt][ct][2], acc[rt][ct][3]));
                } else {
#pragma unroll
                    for (int ct = 0; ct < 4; ++ct) {
                        bf16_t* vp = P.mVt + (((size_t)b * 4 + h) * 64 + 16 * ct + lr) * NT + n0 + 16 * rt + 4 * q;
                        *(uint2*)vp = make_uint2(cvtpk(acc[rt][ct][0], acc[rt][ct][1]), cvtpk(acc[rt][ct][2], acc[rt][ct][3]));
                    }
                }
            }
        }
    }
}
__device__ __forceinline__ void phase_prep(const Params& P, LAS3 unsigned char* lds, int l) {
    for (int it = blockIdx.x; it < 3 * (TT / 64); it += gridDim.x) {
        const int fn = it % 3, tile = it / 3;
        if (fn == 0) prep_mla(P, lds, tile, l); else if (fn == 1) prep_ml(P, lds, tile, l); else prep_da(P, lds, tile);
    }
}

__device__ __forceinline__ void phase_mix(const Params& P, LAS3 unsigned char* lds, int l) {
    const int bid = blockIdx.x, G = gridDim.x;
    const float lambda_init = (l == 0) ? 0.2f : 0.35550906759096927f;
    for (int it = bid; it < 256; it += G)
    {
        const int pr = (it & 7) * 4 + (it >> 6), qb = (it >> 3) & 7;
        attn_item<64, 2, true>(lds, P.daQ, P.daK, P.daVt, P.ycatb, 0, pr >> 2, pr & 3, 1 + qb, P.lamfull[l], P.da_subln + l * 64, 1.f - lambda_init);
    }
    LAS3 int* slot = (LAS3 int*)(lds + MK_LDS_MAIN + 16);
    const int n_ml = 64, n_mla = 256, n_s5 = 256, n_ctx = (l == 0) ? 64 : 0;
    const int total = n_ml + n_mla + n_s5 + n_ctx;
    for (;;) {
        __syncthreads();
        if (threadIdx.x == 0) *slot = atomicAdd(P.queue + l, 1);
        __syncthreads();
        int it = __builtin_amdgcn_readfirstlane(*slot);
        if (it >= total) break;
        int kind, b, h, x3;
        if (it < n_ml) { kind = 1; b = it >> 3; h = (it >> 1) & 3; x3 = it & 1; }
        else if ((it -= n_ml) < n_mla) { kind = 2; b = it >> 5; h = (it >> 3) & 3; x3 = 1 + (it & 7); }
        else if ((it -= n_mla) < n_s5) { kind = 3; b = it >> 5; h = (it >> 1) & 15; x3 = it & 1; }
        else { it -= n_s5; kind = (it < 32) ? 0 : 2; it &= 31; b = it >> 2; h = it & 3; x3 = 0; }
        if (kind == 0) attn_item<64, 2, true>(lds, P.daQ, P.daK, P.daVt, P.ycatb, 0, b, h, x3, P.lamfull[l], P.da_subln + l * 64, 1.f - lambda_init);
        else if (kind == 1) mlstm_item(lds, P.mlQ, P.mlK, P.mlKt, P.mlVt, P.mlG, P.hdir, b, h, x3);
        else if (kind == 2) attn_item<96, 1, false>(lds, P.mQ, P.mK, P.mVt, P.ycatb, 512, b, h, x3, 0.f, nullptr, 1.f);
        else s5_item(lds, P.pb, P.s5KmT + (size_t)l * 32 * 16 * 1024, P.s5Smat + (size_t)l * 32 * 128 * 1024, P.s5CmT + (size_t)l * 32 * 16 * 128,
                     P.s5A + l * 32 * 64 * 2, P.s5A64 + l * 32 * 64 * 2, P.s5xs, P.ys5, b, h, x3);
    }
}

template <int TOK, int BATCH>
__device__ __forceinline__ void phase_finish_t(const Params& P, LAS3 unsigned char* lds, int l) {
    constexpr int RT = (TOK + 15) / 16;
    const int tid = opaque_tid(), wid = tid >> 6, lane = tid & 63, lr = lane & 15, q = lane >> 4, c = tid & 255, half = tid >> 8;
    const int ntile = (l == 0) ? TT / TOK : NB * (NS / TOK);
    constexpr int GROW = 264;
    LAS3 bf16_t* Gs = (LAS3 bf16_t*)lds;
    const float* mn = P.ml_norm + l * 256; const float* dsk = P.s5_d + l * 256; const float* bgl = P.s5_b_glu + l * 256;
    const bf16_t* wg = P.wglu_t + (size_t)l * 256 * 256;
    const bf16_t* __restrict__ pbr = P.pb; const bf16_t* __restrict__ hdr = (const bf16_t*)P.hdir; const bf16_t* __restrict__ ysr = (const bf16_t*)P.ys5; bf16_t* __restrict__ oY = P.ycatb;
    for (int it = blockIdx.x; it < ntile; it += gridDim.x) {
        const int t0 = (l == 0) ? it * TOK : ((it / (NS / TOK)) * NT + NC + (it % (NS / TOK)) * TOK);
        __syncthreads();
        {
            const int cg = tid & 31, ts = tid >> 5, c0 = 8 * cg;
            float mnv[8], dsv[8];
            { const float4 m0 = *(const float4*)(mn + c0), m1 = *(const float4*)(mn + c0 + 4), d0 = *(const float4*)(dsk + c0), d1 = *(const float4*)(dsk + c0 + 4);
              mnv[0] = m0.x; mnv[1] = m0.y; mnv[2] = m0.z; mnv[3] = m0.w; mnv[4] = m1.x; mnv[5] = m1.y; mnv[6] = m1.z; mnv[7] = m1.w;
              dsv[0] = d0.x; dsv[1] = d0.y; dsv[2] = d0.z; dsv[3] = d0.w; dsv[4] = d1.x; dsv[5] = d1.y; dsv[6] = d1.z; dsv[7] = d1.w; }
            constexpr int NP = (TOK + 15) / 16;
#pragma unroll
            for (int k0 = 0; k0 < NP; k0 += 2) {
                u32x4_t vog[2], vuu[2], vhf[2], vhb[2], vyf[2], vyb[2];
#pragma unroll
                for (int u = 0; u < 2; ++u) {
                    const int tok = ts + 16 * (k0 + u), tc = (tok < TOK) ? tok : TOK - 1;
                    const size_t t = (size_t)t0 + tc; const bf16_t* pr = pbr + t * DIN;
                    vog[u] = *(const u32x4_t*)(pr + P_MLO + c0); vuu[u] = *(const u32x4_t*)(pr + P_S5 + c0);
                    vhf[u] = *(const u32x4_t*)(hdr + t * 256 + c0); vhb[u] = *(const u32x4_t*)(hdr + ((size_t)TT + t) * 256 + c0);
                    vyf[u] = *(const u32x4_t*)(ysr + t * 256 + c0); vyb[u] = *(const u32x4_t*)(ysr + ((size_t)TT + t) * 256 + c0);
                }
#pragma unroll
                for (int u = 0; u < 2; ++u) {
                    const int tok = ts + 16 * (k0 + u);
                    float og[8], uu[8], hf[8], hb[8], yf[8], yb[8], hv[8], go[8];
                    unpack8(vog[u], og); unpack8(vuu[u], uu); unpack8(vhf[u], hf); unpack8(vhb[u], hb); unpack8(vyf[u], yf); unpack8(vyb[u], yb);
                    float ssq = 0.f;
#pragma unroll
                    for (int e = 0; e < 8; ++e) { hv[e] = sigmoidf_(og[e]) * (hf[e] + hb[e]); ssq += hv[e] * hv[e]; go[e] = gelu_tanh_(yf[e] + yb[e] + uu[e] * dsv[e]); }
                    ssq += __shfl_xor(ssq, 1); ssq += __shfl_xor(ssq, 2); ssq += __shfl_xor(ssq, 4);
                    const float r = rsqrtf(ssq * (1.f / 64.f) + 1e-6f);
#pragma unroll
                    for (int e = 0; e < 8; ++e) hv[e] = hv[e] * r * mnv[e];
                    if (NP * 16 == TOK || tok < TOK) {
                        *(u32x4_t*)(oY + ((size_t)t0 + tok) * DM + 256 + c0) = pack8(hv);
                        *(LAS3 u32x4_t*)(Gs + tok * GROW + c0) = pack8(go);
                    }
                }
            }
        }
        __syncthreads();
        f32x4_t acc[RT][2];
#pragma unroll
        for (int rt = 0; rt < RT; ++rt) { acc[rt][0] = (f32x4_t){0.f, 0.f, 0.f, 0.f}; acc[rt][1] = (f32x4_t){0.f, 0.f, 0.f, 0.f}; }
#pragma unroll
        for (int ks = 0; ks < 8; ++ks) {
            const bf16x8_t b0 = *(const bf16x8_t*)(wg + (size_t)(32 * wid + lr) * 256 + 32 * ks + 8 * q);
            const bf16x8_t b1 = *(const bf16x8_t*)(wg + (size_t)(32 * wid + 16 + lr) * 256 + 32 * ks + 8 * q);
#pragma unroll
            for (int rt = 0; rt < RT; ++rt) {
                const bf16x8_t a = *(const LAS3 bf16x8_t*)(Gs + (16 * rt + lr) * GROW + 32 * ks + 8 * q);
                acc[rt][0] = __builtin_amdgcn_mfma_f32_16x16x32_bf16(a, b0, acc[rt][0], 0, 0, 0);
                acc[rt][1] = __builtin_amdgcn_mfma_f32_16x16x32_bf16(a, b1, acc[rt][1], 0, 0, 0);
            }
        }
#pragma unroll
        for (int rt = 0; rt < RT; ++rt)
#pragma unroll
            for (int cc = 0; cc < 2; ++cc)
#pragma unroll
                for (int rg = 0; rg < 4; ++rg) {
                    const int row = 16 * rt + 4 * q + rg, col = 32 * wid + 16 * cc + lr;
                    const float gv = bf2f(Gs[row * GROW + col]);
                    if (TOK % 16 == 0 || row < TOK) P.ycatb[((size_t)t0 + row) * DM + 768 + col] = f2bf(gv * sigmoidf_(acc[rt][cc][rg] + bgl[col]));
                }
    }
}
__device__ __forceinline__ void phase_finish(const Params& P, LAS3 unsigned char* lds, int l) {
    if (l == 0) phase_finish_t<72, 12>(P, lds, l); else phase_finish_t<64, 8>(P, lds, l);
}

__device__ __forceinline__ void phase_post(const Params& P, LAS3 unsigned char* lds, int l) {
    const int tid = opaque_tid(), wid = tid >> 6, lane = tid & 63, lr = lane & 15, q = lane >> 4;
    constexpr int FROW = 1028, HROW = 1032;
    LAS3 float* ft = (LAS3 float*)lds;
    LAS3 bf16_t* fhi = (LAS3 bf16_t*)lds; LAS3 bf16_t* flo = fhi + 16 * HROW;
    static_assert(2 * 16 * HROW * 2 <= 16 * FROW * 4 + 1024, "hi/lo images");
    LAS3 float* pl = ft + 16 * FROW + 256;
    const float* nw1 = P.norm_w + (size_t)l * 4096 + 1024; const float* nw2 = nw1 + 1024;
    const float* wr = P.moe_w_router + (size_t)l * 1024 * 32; const float* br = P.moe_b_router + l * 32;
    LAS3 int* lcnt = (LAS3 int*)(pl + 8 * 16 * 32);
    if (tid < 32) lcnt[tid] = 0;
    bf16x8_t whi[4][2], wlo[4][2];
#pragma unroll
    for (int kb = 0; kb < 4; ++kb)
#pragma unroll
        for (int hx = 0; hx < 2; ++hx) {
            union { unsigned u[4]; bf16x8_t v; } uh, ul;
#pragma unroll
            for (int jj = 0; jj < 4; ++jj) {
                const float w0 = wr[(size_t)(128 * wid + 32 * kb + 8 * q + 2 * jj) * 32 + 16 * hx + lr], w1 = wr[(size_t)(128 * wid + 32 * kb + 8 * q + 2 * jj + 1) * 32 + 16 * hx + lr];
                const unsigned hb = cvtpk(w0, w1);
                uh.u[jj] = hb; ul.u[jj] = cvtpk(w0 - __uint_as_float(hb << 16), w1 - __uint_as_float(hb & 0xFFFF0000u));
            }
            whi[kb][hx] = uh.v; wlo[kb][hx] = ul.v;
        }
    const int nitem = (l == 0) ? TT / 16 : NB * NS / 16;
    const int tr = tid >> 5, part = tid & 31;
    LAS3 float* wl = (LAS3 float*)(lcnt + 32) + 16 * 32 + 16 * 4 + 16 * 4;
    float4 nm0 = make_float4(0.f, 0.f, 0.f, 0.f), nm1 = nm0;
#define POST_MODROW(it_) (P.mod + ((size_t)l * 9 + (((((l == 0) ? (it_) * 16 : (((it_) >> 7) * NT + NC + ((it_) & 127) * 16)) % NT) < NC) ? 8 : (((l == 0) ? (it_) * 16 : (((it_) >> 7) * NT + NC + ((it_) & 127) * 16)) / NT))) * 6144 + 2048)
    *(LAS3 f32x4_t*)(wl + tid * 4) = *(const f32x4_t*)(nw1 + tid * 4);
    if ((int)blockIdx.x < nitem) { const float* mrn = POST_MODROW((int)blockIdx.x); nm0 = *(const float4*)(mrn + tid * 4); if (tid < 256) nm1 = *(const float4*)(mrn + 2048 + tid * 4);
        *(LAS3 f32x4_t*)(wl + 2048 + tid * 4) = (f32x4_t){nm0.x, nm0.y, nm0.z, nm0.w}; if (tid < 256) *(LAS3 f32x4_t*)(wl + 4096 + tid * 4) = (f32x4_t){nm1.x, nm1.y, nm1.z, nm1.w}; }
    for (int it = blockIdx.x; it < nitem; it += gridDim.x) {
        const int t0 = (l == 0) ? it * 16 : ((it >> 7) * NT + NC + (it & 127) * 16);
        const int t = t0 + tr, b = t / NT, n = t % NT;
        const float* xin = (n < NC) ? P.ctx + ((size_t)b * NC + n) * DM : P.x + ((size_t)b * NS + (n - NC)) * DM;
        bf16_t* x1b = (bf16_t*)P.xall; const bf16_t* x2b = x1b + (size_t)TT * DM;
        __syncthreads();
        float x1[32];
        {
            float so = P.osq[(size_t)t * 16 + (part & 15)];
#pragma unroll
            for (int o = 8; o > 0; o >>= 1) so += __shfl_xor(so, o);
            const float rstd = rsqrtf(so * (1.f / DM) + 1e-6f);
            float ss = 0.f;
#pragma unroll
            for (int j = 0; j < 8; ++j) {
                const int d = j * 128 + part * 4;
                const uint2 ov = *(const uint2*)(P.ob + (size_t)t * DM + d);
                float4 xv;
                if (l == 0) xv = *(const float4*)(xin + d);
                else { const uint2 xb = *(const uint2*)(x2b + (size_t)t * DM + d); xv = make_float4(__uint_as_float(xb.x << 16), __uint_as_float(xb.x & 0xFFFF0000u), __uint_as_float(xb.y << 16), __uint_as_float(xb.y & 0xFFFF0000u)); }
                const f32x4_t wv_ = *(const LAS3 f32x4_t*)(wl + d), gv_ = *(const LAS3 f32x4_t*)(wl + 2048 + d);
                const float4 w = make_float4(wv_[0], wv_[1], wv_[2], wv_[3]), g1 = make_float4(gv_[0], gv_[1], gv_[2], gv_[3]);
                const float a0 = xv.x + g1.x * __uint_as_float(ov.x << 16) * rstd * w.x, a1 = xv.y + g1.y * __uint_as_float(ov.x & 0xFFFF0000u) * rstd * w.y;
                const float a2 = xv.z + g1.z * __uint_as_float(ov.y << 16) * rstd * w.z, a3 = xv.w + g1.w * __uint_as_float(ov.y & 0xFFFF0000u) * rstd * w.w;
                x1[j * 4] = a0; x1[j * 4 + 1] = a1; x1[j * 4 + 2] = a2; x1[j * 4 + 3] = a3;
                *(uint2*)(x1b + (size_t)t * DM + d) = make_uint2(cvtpk(a0, a1), cvtpk(a2, a3));
                ss += (a0 * a0 + a1 * a1) + (a2 * a2 + a3 * a3);
            }
#pragma unroll
            for (int o = 16; o > 0; o >>= 1) ss += __shfl_xor(ss, o);
            const float rstd2 = rsqrtf(ss * (1.f / DM) + 1e-6f);
#pragma unroll
            for (int j = 0; j < 8; ++j) {
                const int d = j * 128 + part * 4;
                const f32x4_t wv_ = *(const LAS3 f32x4_t*)(wl + 1024 + d), sv_ = *(const LAS3 f32x4_t*)(wl + 3072 + d), cv_ = *(const LAS3 f32x4_t*)(wl + 4096 + d);
                const float4 w = make_float4(wv_[0], wv_[1], wv_[2], wv_[3]), sh = make_float4(sv_[0], sv_[1], sv_[2], sv_[3]), sc = make_float4(cv_[0], cv_[1], cv_[2], cv_[3]);
                const float f0 = x1[j * 4] * rstd2 * w.x * (1.f + sc.x) + sh.x, f1 = x1[j * 4 + 1] * rstd2 * w.y * (1.f + sc.y) + sh.y;
                const float f2 = x1[j * 4 + 2] * rstd2 * w.z * (1.f + sc.z) + sh.z, f3 = x1[j * 4 + 3] * rstd2 * w.w * (1.f + sc.w) + sh.w;
                *(uint2*)(P.fb + (size_t)t * DM + d) = make_uint2(cvtpk(f0, f1), cvtpk(f2, f3));
                {
                    const unsigned h01 = cvtpk(f0, f1), h23 = cvtpk(f2, f3);
                    *(LAS3 u32x2_t*)(fhi + tr * HROW + d) = (u32x2_t){h01, h23};
                    *(LAS3 u32x2_t*)(flo + tr * HROW + d) = (u32x2_t){cvtpk(f0 - __uint_as_float(h01 << 16), f1 - __uint_as_float(h01 & 0xFFFF0000u)), cvtpk(f2 - __uint_as_float(h23 << 16), f3 - __uint_as_float(h23 & 0xFFFF0000u))};
                }
            }
        }
        __syncthreads();
        const bool hasn = it + (int)gridDim.x < nitem;
        if (hasn) { const float* mrn = POST_MODROW(it + (int)gridDim.x); nm0 = *(const float4*)(mrn + tid * 4); if (tid < 256) nm1 = *(const float4*)(mrn + 2048 + tid * 4); }
        {
            f32x4_t a0 = (f32x4_t){0.f, 0.f, 0.f, 0.f}, a1 = (f32x4_t){0.f, 0.f, 0.f, 0.f};
            bf16x8_t ah[4], al[4];
#pragma unroll
            for (int kb = 0; kb < 4; ++kb) { ah[kb] = *(const LAS3 bf16x8_t*)(fhi + lr * HROW + 128 * wid + 32 * kb + 8 * q); al[kb] = *(const LAS3 bf16x8_t*)(flo + lr * HROW + 128 * wid + 32 * kb + 8 * q); }
#pragma unroll
            for (int kb = 0; kb < 4; ++kb) {
                a0 = __builtin_amdgcn_mfma_f32_16x16x32_bf16(ah[kb], whi[kb][0], a0, 0, 0, 0); a1 = __builtin_amdgcn_mfma_f32_16x16x32_bf16(ah[kb], whi[kb][1], a1, 0, 0, 0);
                a0 = __builtin_amdgcn_mfma_f32_16x16x32_bf16(ah[kb], wlo[kb][0], a0, 0, 0, 0); a1 = __builtin_amdgcn_mfma_f32_16x16x32_bf16(ah[kb], wlo[kb][1], a1, 0, 0, 0);
                a0 = __builtin_amdgcn_mfma_f32_16x16x32_bf16(al[kb], whi[kb][0], a0, 0, 0, 0); a1 = __builtin_amdgcn_mfma_f32_16x16x32_bf16(al[kb], whi[kb][1], a1, 0, 0, 0);
            }
#pragma unroll
            for (int rg = 0; rg < 4; ++rg) { pl[(wid * 16 + 4 * q + rg) * 32 + lr] = a0[rg]; pl[(wid * 16 + 4 * q + rg) * 32 + 16 + lr] = a1[rg]; }
        }
        __syncthreads();
        {
            float lg = br[part];
#pragma unroll
            for (int w = 0; w < 8; ++w) lg += pl[(w * 16 + tr) * 32 + part];
            LAS3 float* lgs = (LAS3 float*)(lcnt + 32);
            LAS3 float* topv = lgs + 16 * 32;
            LAS3 int* topi = (LAS3 int*)(topv + 16 * 4);
            lgs[tr * 32 + part] = lg;
            asm volatile("s_waitcnt lgkmcnt(0)" ::: "memory");
            int rank = 0;
#pragma unroll
            for (int c4 = 0; c4 < 8; ++c4) {
                const f32x4_t lv = *(const LAS3 f32x4_t*)(lgs + tr * 32 + 4 * c4);
#pragma unroll
                for (int e = 0; e < 4; ++e) rank += (lv[e] > lg || (lv[e] == lg && (4 * c4 + e) < part)) ? 1 : 0;
            }
            if (rank < 4) { topv[tr * 4 + rank] = lg; topi[tr * 4 + rank] = part; }
            asm volatile("s_waitcnt lgkmcnt(0)" ::: "memory");
            if (part < 4) {
                const f32x4_t v = *(const LAS3 f32x4_t*)(topv + tr * 4);
                const int ek = topi[tr * 4 + part];
                const float e1 = __expf(v[1] - v[0]), e2 = __expf(v[2] - v[0]), e3 = __expf(v[3] - v[0]);
                const float inv = 1.f / (1.f + e1 + e2 + e3);
                const float gk = (part == 0) ? inv : (part == 1) ? e1 * inv : (part == 2) ? e2 * inv : e3 * inv;
                P.top_e[(size_t)t * 4 + part] = ek; P.top_g[(size_t)t * 4 + part] = gk;
                P.posb[(size_t)t * 4 + part] = __hip_atomic_fetch_add(&lcnt[ek], 1, __ATOMIC_RELAXED, __HIP_MEMORY_SCOPE_WORKGROUP);
            }
        }
        if (hasn) { *(LAS3 f32x4_t*)(wl + 2048 + tid * 4) = (f32x4_t){nm0.x, nm0.y, nm0.z, nm0.w}; if (tid < 256) *(LAS3 f32x4_t*)(wl + 4096 + tid * 4) = (f32x4_t){nm1.x, nm1.y, nm1.z, nm1.w}; }
    }
#undef POST_MODROW
    __syncthreads();
    if (tid < 32) P.blkcnt[((size_t)l * gridDim.x + blockIdx.x) * 32 + tid] = lcnt[tid];
}

__device__ __forceinline__ void phase_scatter(const Params& P, LAS3 unsigned char* lds, int l) {
    const int tid = opaque_tid(), wid = tid >> 6, lane = tid & 63;
    LAS3 int* soff = (LAS3 int*)lds;
    LAS3 int* part = soff + 64;
    LAS3 int* pre = soff + 1024;
    const int G = gridDim.x;
    const int* bc = P.blkcnt + (size_t)l * G * 32;
    __syncthreads();
    {
        const int e = tid & 31, pt = tid >> 5, per = (G + 15) / 16;
        int sum = 0;
        for (int b2 = pt * per; b2 < (pt + 1) * per && b2 < G; ++b2) sum += bc[b2 * 32 + e];
        part[pt * 32 + e] = sum;
        __syncthreads();
        int run = 0;
        for (int p2 = 0; p2 < pt; ++p2) run += part[p2 * 32 + e];
        for (int b2 = pt * per; b2 < (pt + 1) * per && b2 < G; ++b2) { pre[b2 * 32 + e] = run; run += bc[b2 * 32 + e]; }
        if (pt == 15) soff[32 + e] = run;
    }
    __syncthreads();
    if (tid < 64) {
        const int e = tid & 31;
        const int ntl = (soff[32 + e] + 255) >> 8;
        int inc = ntl;
#pragma unroll
        for (int o = 1; o < 32; o <<= 1) { const int v = __shfl_up(inc, o, 32); if (e >= o) inc += v; }
        const int nt0 = inc - ntl;
        if (tid < 32) {
            soff[e] = nt0 * 256;
            if (blockIdx.x == 0) { for (int m = 0; m < ntl; ++m) P.tile_e[l * 512 + nt0 + m] = e; P.offs[l * 32 + e] = nt0 * 256; if (e == 31) P.ntiles[l * 16] = inc; }
        }
    }
    __syncthreads();
    const int gt = blockIdx.x * 512 + tid, NTH = gridDim.x * 512;
    const int ntok = (l == 0) ? TT : NB * NS;
    int* __restrict__ stk = (int*)P.xg;
    for (int a = gt; a < ntok * 4; a += NTH) {
        const int i = a >> 2;
        const int t = (l == 0) ? i : ((i >> 11) * NT + NC + (i & 2047));
        const int ek = P.top_e[(size_t)t * 4 + (a & 3)];
        const int slot = soff[ek] + pre[((i >> 4) % G) * 32 + ek] + P.posb[(size_t)t * 4 + (a & 3)];
        stk[slot] = t; P.tok_slot[(size_t)t * 4 + (a & 3)] = slot;
    }
    for (int i = gt; i < NE * 256; i += NTH) {
        const int e = i >> 8, j = i & 255, c = soff[32 + e];
        const int padn = ((c + 255) & ~255) - c;
        if (j < padn) stk[soff[e] + c + j] = NC;
    }
}

__device__ __forceinline__ void phase_combine(const Params& P, LAS3 unsigned char* lds, int l) {
    const int tid = opaque_tid(); const int lane = tid & 63, gw = blockIdx.x * 8 + (tid >> 6), NW = gridDim.x * 8;
    const float* __restrict__ nw3 = P.norm_w + (size_t)l * 4096 + 3072;
    const float* __restrict__ nwn = P.norm_w + 4096;
    const int* __restrict__ tsl = P.tok_slot; const float* __restrict__ tg = P.top_g; const bf16_t* __restrict__ ye = P.yexp; const float* __restrict__ modp = P.mod;
    const int ntok = (l == 0) ? TT : NB * NS;
    LAS3 float* cw = (LAS3 float*)lds;
    for (int i = tid; i < 256; i += 512) { *(LAS3 f32x4_t*)(cw + i * 4) = *(const f32x4_t*)(nw3 + i * 4); if (l == 0) *(LAS3 f32x4_t*)(cw + 1024 + i * 4) = *(const f32x4_t*)(nwn + i * 4); }
    for (int i = tid; i < 9 * 256; i += 512) { const int r = i >> 8, k = i & 255; *(LAS3 f32x4_t*)(cw + 2048 + r * 1024 + k * 4) = *(const f32x4_t*)(modp + ((size_t)l * 9 + r) * 6144 + 5120 + k * 4); }
    if (l == 0) for (int i = tid; i < 9 * 512; i += 512) { const int r = i >> 9, k = i & 511; *(LAS3 f32x4_t*)(cw + 11264 + r * 2048 + k * 4) = *(const f32x4_t*)(modp + ((size_t)9 + r) * 6144 + k * 4); }
    __syncthreads();
    const bf16_t* __restrict__ x1b = (const bf16_t*)P.xall; bf16_t* __restrict__ x2b = (bf16_t*)P.xall + (size_t)TT * DM;
    int i = gw;
    int4 sl = make_int4(0, 0, 0, 0); float4 gt = make_float4(0.f, 0.f, 0.f, 0.f);
    if (i < ntok) { const int t = (l == 0) ? i : ((i >> 11) * NT + NC + (i & 2047)); sl = *(const int4*)(tsl + (size_t)t * 4); gt = *(const float4*)(tg + (size_t)t * 4); }
    for (; i < ntok; i += NW) {
        const int t = (l == 0) ? i : ((i >> 11) * NT + NC + (i & 2047));
        const int b = t / NT, n = t % NT, r = (n < NC) ? 8 : b;
        const int4 slc = sl; const float4 gtc = gt;
        uint2 yv[4][4];
        const int slots[4] = {slc.x, slc.y, slc.z, slc.w};
#pragma unroll
        for (int k = 0; k < 4; ++k)
#pragma unroll
            for (int j = 0; j < 4; ++j) yv[k][j] = *(const uint2*)(ye + (size_t)slots[k] * DM + j * 256 + lane * 4);
        float4 x1[4], w3[4], g2[4], wn[4], scn[4], shn[4];
#define CW4(p_) ({ const f32x4_t v_ = *(const LAS3 f32x4_t*)(p_); make_float4(v_[0], v_[1], v_[2], v_[3]); })
#pragma unroll
        for (int j = 0; j < 4; ++j) {
            const int d = j * 256 + lane * 4;
            { const uint2 xb = *(const uint2*)(x1b + (size_t)t * DM + d); x1[j] = make_float4(__uint_as_float(xb.x << 16), __uint_as_float(xb.x & 0xFFFF0000u), __uint_as_float(xb.y << 16), __uint_as_float(xb.y & 0xFFFF0000u)); }
            w3[j] = CW4(cw + d); g2[j] = CW4(cw + 2048 + r * 1024 + d);
            if (l == 0) { wn[j] = CW4(cw + 1024 + d); scn[j] = CW4(cw + 11264 + r * 2048 + 1024 + d); shn[j] = CW4(cw + 11264 + r * 2048 + d); }
        }
        { const int in = i + NW; if (in < ntok) { const int tn = (l == 0) ? in : ((in >> 11) * NT + NC + (in & 2047)); sl = *(const int4*)(tsl + (size_t)tn * 4); gt = *(const float4*)(tg + (size_t)tn * 4); } }
        const float gk[4] = {gtc.x, gtc.y, gtc.z, gtc.w};
        float m[16];
#pragma unroll
        for (int j = 0; j < 16; ++j) m[j] = 0.f;
#pragma unroll
        for (int k = 0; k < 4; ++k)
#pragma unroll
            for (int j = 0; j < 4; ++j) {
                m[j * 4] += gk[k] * __uint_as_float(yv[k][j].x << 16); m[j * 4 + 1] += gk[k] * __uint_as_float(yv[k][j].x & 0xFFFF0000u);
                m[j * 4 + 2] += gk[k] * __uint_as_float(yv[k][j].y << 16); m[j * 4 + 3] += gk[k] * __uint_as_float(yv[k][j].y & 0xFFFF0000u);
            }
        float ss = 0.f;
#pragma unroll
        for (int j = 0; j < 16; ++j) ss += m[j] * m[j];
        const float rstd = rsqrtf(wave_sum(ss) * (1.f / DM) + 1e-6f);
        float xv[16]; float s2 = 0.f;
#pragma unroll
        for (int j = 0; j < 4; ++j) {
            const int d = j * 256 + lane * 4;
            xv[j * 4] = x1[j].x + g2[j].x * m[j * 4] * rstd * w3[j].x; xv[j * 4 + 1] = x1[j].y + g2[j].y * m[j * 4 + 1] * rstd * w3[j].y;
            xv[j * 4 + 2] = x1[j].z + g2[j].z * m[j * 4 + 2] * rstd * w3[j].z; xv[j * 4 + 3] = x1[j].w + g2[j].w * m[j * 4 + 3] * rstd * w3[j].w;
            s2 += (xv[j * 4] * xv[j * 4] + xv[j * 4 + 1] * xv[j * 4 + 1]) + (xv[j * 4 + 2] * xv[j * 4 + 2] + xv[j * 4 + 3] * xv[j * 4 + 3]);
            const float4 o = make_float4(xv[j * 4], xv[j * 4 + 1], xv[j * 4 + 2], xv[j * 4 + 3]);
            if (l == 0) *(uint2*)(x2b + (size_t)t * DM + d) = make_uint2(cvtpk(o.x, o.y), cvtpk(o.z, o.w));
            else *(float4*)(P.out + ((size_t)b * NS + (n - NC)) * DM + d) = o;
        }
        if (l == 0) {
            const float rs2 = rsqrtf(wave_sum(s2) * (1.f / DM) + 1e-6f);
#pragma unroll
            for (int j = 0; j < 4; ++j) {
                const int d = j * 256 + lane * 4;
                const float o0 = xv[j * 4] * rs2 * wn[j].x * (1.f + scn[j].x) + shn[j].x, o1 = xv[j * 4 + 1] * rs2 * wn[j].y * (1.f + scn[j].y) + shn[j].y;
                const float o2 = xv[j * 4 + 2] * rs2 * wn[j].z * (1.f + scn[j].z) + shn[j].z, o3 = xv[j * 4 + 3] * rs2 * wn[j].w * (1.f + scn[j].w) + shn[j].w;
                *(uint2*)(P.hbuf + (size_t)t * DM + d) = make_uint2(cvtpk(o0, o1), cvtpk(o2, o3));
            }
        }
    }
}

extern __shared__ __attribute__((aligned(16))) unsigned char dyn_lds[];
__device__ __forceinline__ void run_phase(const Params& P, LAS3 unsigned char* lds, int ph) {
    if (ph == PH_SETUP) { phase_setup(P, lds); return; }
    if (ph == PH_H0) { phase_h0(P, lds); return; }
    const int l = (ph - PH_LAYER0) / PH_PER_LAYER, s = (ph - PH_LAYER0) % PH_PER_LAYER;
    switch (s) {
    case L_GEMM_IN: { pg8::Gemm g{P.hbuf, P.w_in_t + (size_t)l * 2560 * 1024, TT, 2560, 1024, 0}; pg8::StaticOrder S; S.init(TT, 2560, gridDim.x, blockIdx.x);
        pg8::EpiBf16P E{P.pb, DIN, 0}; pg8::gemm_phase<pg8::EpiBf16P, pg8::StaticOrder, true, true>(lds, g, S, E); } break;
    case L_PREP: phase_prep(P, lds, l); break;
    case L_MIX: phase_mix(P, lds, l); break;
    case L_FINISH: phase_finish(P, lds, l); break;
    case L_GEMM_OUT: { pg8::Gemm g{P.ycatb, P.w_out_t + (size_t)l * 1024 * 1024, TT, 1024, 1024, 0}; pg8::EpiOut E{P.ob, P.osq};
        if (l == 0) { pg8::StaticOrder S; S.init(TT, 1024, gridDim.x, blockIdx.x); pg8::gemm_phase<pg8::EpiOut, pg8::StaticOrder, true, true>(lds, g, S, E); }
        else { pg8::LatOrder S; S.initl(1024, gridDim.x, blockIdx.x); pg8::gemm_phase<pg8::EpiOut, pg8::LatOrder, true, true>(lds, g, S, E); } } break;
    case L_POST: phase_post(P, lds, l); break;
    case L_SCATTER: phase_scatter(P, lds, l); break;
    case L_GEMM_GU: { pg8::Gemm g{P.fb, P.wgu_t + (size_t)l * NE * 2048 * 1024, 0, 2048, 1024, 0}; pg8::GroupedOrder S; S.initg(P.ntiles + l * 16, P.tile_e + l * 512, 2048, gridDim.x, blockIdx.x);
        pg8::EpiSwiglu E{P.act, P.moe_b_gate_up + (size_t)l * NE * 2048}; pg8::gemm_phase<pg8::EpiSwiglu, pg8::GroupedOrder, true, true, true>(lds, g, S, E, (const int*)P.xg); } break;
    case L_GEMM_DN: { pg8::Gemm g{P.act, P.wdn_t + (size_t)l * NE * 1024 * 1024, 0, 1024, 1024, 0}; pg8::GroupedOrder S; S.initg(P.ntiles + l * 16, P.tile_e + l * 512, 1024, gridDim.x, blockIdx.x);
        pg8::EpiDown E{P.yexp, P.moe_b_down + (size_t)l * NE * 1024}; pg8::gemm_phase<pg8::EpiDown, pg8::GroupedOrder, true, true>(lds, g, S, E); } break;
    case L_COMBINE: phase_combine(P, lds, l); break;
    }
}
__global__ void __launch_bounds__(512, 2) mk_fwd(Params Pk, int ph_lo, int ph_hi) {
    LAS3 unsigned char* lds = (LAS3 unsigned char*)dyn_lds;
    volatile LAS3 unsigned* st = (volatile LAS3 unsigned*)(lds + MK_LDS_MAIN);
    LAS3 Params* PL = (LAS3 Params*)(lds + MK_LDS_MAIN + 64);
    static_assert(sizeof(Params) <= 1024, "Params copy does not fit its LDS slot");
    if (threadIdx.x < 4) st[threadIdx.x] = 0u;
    if (threadIdx.x == 64) store_params(PL, Pk);
    unsigned* barw = Pk.bar;
    __syncthreads();
    XcdBarrier bar; bar.bar = barw; bar.x = 0; bar.st = st;
    if (ph_hi - ph_lo > 1) bar = xcd_barrier_post(barw, st);
#define MK_RUN(ph) if (ph_lo <= (ph) && (ph) < ph_hi) { { const LAS3 Params* PLo = PL; asm volatile("" : "+v"(PLo)); LAS3 unsigned char* ldsp = lds; asm volatile("" : "+s"(ldsp)); \
        const Params P = load_params(PLo); run_phase(P, ldsp, (ph)); } if ((ph) + 1 < ph_hi) xcd_barrier(bar); }
    MK_RUN(0) MK_RUN(1) MK_RUN(2) MK_RUN(3) MK_RUN(4) MK_RUN(5) MK_RUN(6) MK_RUN(7) MK_RUN(8) MK_RUN(9) MK_RUN(10) MK_RUN(11)
    MK_RUN(12) MK_RUN(13) MK_RUN(14) MK_RUN(15) MK_RUN(16) MK_RUN(17) MK_RUN(18) MK_RUN(19) MK_RUN(20) MK_RUN(21)
#undef MK_RUN
}

extern "C" void kernel_launch(void* const* d_in, const int* in_sizes, int n_in, void* d_out, int out_size, void* d_ws, size_t ws_size, hipStream_t stream) {
    Params P{};
    const float** pin = (const float**)&P;
    for (int i = 0; i < 35; ++i) pin[i] = (const float*)d_in[i];
    P.out = (float*)d_out;
    char* ws = (char*)d_ws; size_t off = 0;
    auto carve = [&](size_t bytes) { void* p = ws + off; off += (bytes + 255) & ~(size_t)255; return p; };
    const size_t ctl_bytes = XCD_BAR_WORDS * 4 + 256 + 256;
    P.bar = (unsigned*)carve(XCD_BAR_WORDS * 4); P.queue = (int*)carve(256); P.cnt = (int*)carve(256);
    P.tile_e = (int*)carve(2 * 512 * 4); P.ntiles = (int*)carve(2 * 16 * 4); P.offs = (int*)carve(2 * 32 * 4); P.blkcnt = (int*)carve(2 * 256 * 32 * 4);
    P.xall = (float*)carve((size_t)TT * DM * 4); P.mod = (float*)carve((size_t)2 * 9 * 6144 * 4); P.ropecs = (float*)carve((size_t)NS * 16 * 2 * 4); P.lamfull = (float*)carve(256);
    P.w_in_t = (bf16_t*)carve((size_t)2 * 2560 * 1024 * 2); P.w_out_t = (bf16_t*)carve((size_t)2 * 1024 * 1024 * 2);
    P.wgu_t = (bf16_t*)carve((size_t)2 * NE * 2048 * 1024 * 2); P.wdn_t = (bf16_t*)carve((size_t)2 * NE * 1024 * 1024 * 2);
    P.wq_t = (bf16_t*)carve((size_t)2 * 384 * 192 * 2); P.wkv_t = (bf16_t*)carve((size_t)2 * 512 * 128 * 2); P.wglu_t = (bf16_t*)carve((size_t)2 * 256 * 256 * 2);
    P.s5KmT = (bf16_t*)carve((size_t)64 * 16 * 1024 * 2); P.s5Smat = (bf16_t*)carve((size_t)64 * 128 * 1024 * 2); P.s5CmT = (bf16_t*)carve((size_t)64 * 16 * 128 * 2);
    P.s5A = (float*)carve(64 * 64 * 2 * 4); P.s5A64 = (float*)carve(64 * 64 * 2 * 4); P.s5xs = (float*)carve((size_t)256 * 36 * 128 * 4);
    P.hbuf = (bf16_t*)carve((size_t)TT * DM * 2); P.pb = (bf16_t*)carve((size_t)TT * DIN * 2);
    P.daQ = (bf16_t*)carve((size_t)TT * 256 * 2); P.daK = (bf16_t*)carve((size_t)TT * 256 * 2); P.daVt = (bf16_t*)carve((size_t)TT * 256 * 2);
    P.mQ = (bf16_t*)carve((size_t)TT * 384 * 2); P.mK = (bf16_t*)carve((size_t)TT * 384 * 2); P.mVt = (bf16_t*)carve((size_t)TT * 256 * 2);
    P.mlQ = (bf16_t*)carve((size_t)TT * 256 * 2); P.mlK = (bf16_t*)carve((size_t)TT * 256 * 2); P.mlKt = (bf16_t*)carve((size_t)TT * 256 * 2); P.mlVt = (bf16_t*)carve((size_t)TT * 256 * 2);
    P.mlG = (float*)carve((size_t)TT * 16 * 4); P.hdir = (float*)carve((size_t)2 * TT * 256 * 4); P.ys5 = (float*)carve((size_t)2 * TT * 256 * 4);
    P.ycatb = (bf16_t*)carve((size_t)TT * DM * 2); P.ob = (bf16_t*)carve((size_t)TT * DM * 2); P.osq = (float*)carve((size_t)TT * 16 * 4); P.fb = (bf16_t*)carve((size_t)TT * DM * 2);
    P.top_e = (int*)carve((size_t)NASSIGN * 4); P.top_g = (float*)carve((size_t)NASSIGN * 4); P.posb = (int*)carve((size_t)NASSIGN * 4); P.tok_slot = (int*)carve((size_t)NASSIGN * 4);
    P.xg = (bf16_t*)carve((size_t)MAXSLOTS * DM * 2); P.act = (bf16_t*)carve((size_t)MAXSLOTS * DM * 2); P.yexp = (bf16_t*)carve((size_t)MAXSLOTS * DM * 2);
    if (off > ws_size) { fprintf(stderr, "kernel_launch: workspace too small: need %zu have %zu\n", off, ws_size); return; }
    static bool attr_done = false;
    if (!attr_done) {
        if (hipFuncSetAttribute((const void*)mk_fwd, hipFuncAttributeMaxDynamicSharedMemorySize, MK_LDS_BYTES) != hipSuccess) fprintf(stderr, "kernel_launch: hipFuncSetAttribute failed\n");
        attr_done = true;
    }
    (void)hipMemsetAsync(d_ws, 0, ctl_bytes, stream);
#if MK_ONE_LAUNCH
    hipLaunchKernelGGL(mk_fwd, dim3(256), dim3(512), MK_LDS_BYTES, stream, P, 0, (int)PH_TOTAL);
#else
    for (int ph = 0; ph < PH_TOTAL; ++ph) hipLaunchKernelGGL(mk_fwd, dim3(256), dim3(512), MK_LDS_BYTES, stream, P, ph, ph + 1);
#endif
}
```

```cpp
#include <hip/hip_runtime.h>
#include <cstdint>
#include <cstdio>

#define NB 8
#define NS 2048
#define NC 256
#define NT 2304
#define TT (NB * NT)
#define DM 1024
#define DIN 2560
#define DINC 2416
#define NE 32
#define NASSIGN (TT * 4)
#define MAXSLOTS (NASSIGN + NE * 256)

#define P_DAQ 0
#define P_DAK 256
#define P_DAV 512
#define P_MLQK 768
#define P_MLV 1280
#define P_MLO 1536
#define P_MLG 1792
#define P_CQ 1808
#define P_CKV 2000
#define P_KR 2128
#define P_S5 2160

#ifndef MK_ONE_LAUNCH
#define MK_ONE_LAUNCH 1
#endif

typedef unsigned short bf16_t;
__device__ __forceinline__ float sigmoidf_(float x) { return __builtin_amdgcn_rcpf(1.f + __expf(-x)); }
__device__ __forceinline__ float siluf_(float x) { return x * __builtin_amdgcn_rcpf(1.f + __expf(-x)); }
__device__ __forceinline__ float logsigmoidf_(float x) { return fminf(x, 0.f) - log1pf(__expf(-fabsf(x))); }
__device__ __forceinline__ float gelu_tanh_(float x) { const float u = 0.7978845608028654f * (x + 0.044715f * x * x * x); return x * __builtin_amdgcn_rcpf(1.f + __expf(-2.f * u)); }
typedef __bf16 bf16x2_nat __attribute__((ext_vector_type(2)));
typedef float f32x2_nat __attribute__((ext_vector_type(2)));
__device__ __forceinline__ unsigned cvtpk(float lo, float hi) { const f32x2_nat v = {lo, hi}; const bf16x2_nat b = __builtin_convertvector(v, bf16x2_nat); return __builtin_bit_cast(unsigned, b); }
__device__ __forceinline__ bf16_t f2bf(float f) { return (bf16_t)(cvtpk(f, 0.f) & 0xFFFFu); }
__device__ __forceinline__ float bf2f(bf16_t b) { return __uint_as_float(((unsigned)b) << 16); }
__device__ __forceinline__ unsigned pk2bf(float lo, float hi) { return cvtpk(lo, hi); }
__device__ __forceinline__ int opaque_tid() { int t = threadIdx.x; asm volatile("" : "+v"(t)); return t; }
__device__ __forceinline__ float wave_sum(float v) {
#pragma unroll
    for (int o = 32; o > 0; o >>= 1) v += __shfl_xor(v, o);
    return v;
}
__device__ __forceinline__ int seq_token(int s, int dir) {
    if (dir == 0) return s;
    return (s < NC) ? (NC - 1 - s) : (NC + (NT - 1 - s));
}

namespace pg8 {
#define PG8_LAS __attribute__((address_space(3)))
typedef short bf16x8 __attribute__((ext_vector_type(8)));
typedef float f32x4 __attribute__((ext_vector_type(4)));
typedef unsigned u32x4 __attribute__((ext_vector_type(4)));
constexpr int BM = 256, BK = 64, HALF = 128, HTB = HALF * BK * 2, STAGE_BYTES = 8 * HTB, NXCD = 8, WGM = 8;
__host__ __device__ __forceinline__ int lds_byte(int r, int c) { const int st = (r >> 4) * 2 + (c >> 5), rr = r & 15, cc = c & 31, ob = rr * 64 + cc * 2; return st * 1024 + (ob ^ (((ob >> 9) & 1) << 5)); }
__host__ __device__ __forceinline__ void stage_rc(int b, int& R, int& C) { const int st = b / 1024, sb = b % 1024, swz = sb ^ (((sb >> 9) & 1) << 5); R = (st >> 1) * 16 + swz / 64; C = (st & 1) * 32 + (swz % 64) / 2; }
__host__ __device__ __forceinline__ int perm32(int rho) { const int n = rho >> 4, i = rho & 15; return 8 * (i >> 2) + 4 * n + (i & 3); }
struct Unit { int pm, pn; };
struct Gemm { const bf16_t* A; const bf16_t* Bt; int M, N, K, pad; };
__device__ __forceinline__ unsigned cvt_pk_bf16(float lo, float hi) { return cvtpk(lo, hi); }

struct StaticOrder {
    int nM, nN, nwg, G, c;
    __device__ void init(int M, int N, int G_, int c_) { nM = M / BM; nN = N / BM; nwg = nM * nN; G = G_; c = c_; }
    __device__ bool next(int i, Unit& u) const {
        const long L = (long)i * G + c; if (L >= nwg) return false;
        int wgid = (int)L; { const int q = nwg / NXCD, r = nwg % NXCD, xcd = wgid % NXCD, off = wgid / NXCD; wgid = (xcd < r ? xcd * (q + 1) : r * (q + 1) + (xcd - r) * q) + off; }
        const int nig = WGM * nN, gid = wgid / nig, fm = gid * WGM, gsz = (nM - fm) < WGM ? (nM - fm) : WGM;
        u.pm = fm + ((wgid % nig) % gsz); u.pn = (wgid % nig) / gsz; return true;
    }
    __device__ __forceinline__ void a_ready(const Unit&) const {}
    __device__ __forceinline__ void done(const Unit&) const {}
};
struct LatOrder : StaticOrder {
    __device__ void initl(int N, int G_, int c_) { nM = 64; nN = N / BM; nwg = nM * nN; G = G_; c = c_; }
    __device__ bool next(int i, Unit& u) const { if (!StaticOrder::next(i, u)) return false; u.pm = (u.pm >> 3) * 9 + 1 + (u.pm & 7); return true; }
};
struct GroupedOrder : StaticOrder {
    const int* tile_e;
    __device__ void initg(const int* ntiles_p, const int* tile_e_, int N, int G_, int c_) { nM = ntiles_p[0]; nN = N / BM; nwg = nM * nN; G = G_; c = c_; tile_e = tile_e_; }
    __device__ bool next(int i, Unit& u) const { if (!StaticOrder::next(i, u)) return false; u.pn += tile_e[u.pm] * nN; return true; }
};

struct EpiBf16P {
    static constexpr bool PERM = true;
    bf16_t* O; int ldc, pad;
    __device__ __forceinline__ void operator()(const f32x4 (&acc)[2][2][4][2], const Unit& u, int wr, int wc, int fr, int fq) const {
        const int row0 = u.pm * BM + wr * 64 + fr, col0 = u.pn * BM + wc * 32 + 8 * fq;
#pragma unroll
        for (int ai = 0; ai < 2; ++ai)
#pragma unroll
            for (int m = 0; m < 4; ++m) { bf16_t* rowp = O + (size_t)(row0 + ai * HALF + m * 16) * ldc + col0;
#pragma unroll
                for (int bj = 0; bj < 2; ++bj) { const f32x4 v0 = acc[ai][bj][m][0], v1 = acc[ai][bj][m][1];
                    u32x4 w; w.x = cvt_pk_bf16(v0[0], v0[1]); w.y = cvt_pk_bf16(v0[2], v0[3]); w.z = cvt_pk_bf16(v1[0], v1[1]); w.w = cvt_pk_bf16(v1[2], v1[3]);
                    *(u32x4*)(rowp + bj * HALF) = w; } }
    }
};
struct EpiOut {
    static constexpr bool PERM = true;
    bf16_t* O; float* osq;
    __device__ __forceinline__ void operator()(const f32x4 (&acc)[2][2][4][2], const Unit& u, int wr, int wc, int fr, int fq) const {
        const int row0 = u.pm * BM + wr * 64 + fr, col0 = u.pn * BM + wc * 32 + 8 * fq;
#pragma unroll
        for (int ai = 0; ai < 2; ++ai)
#pragma unroll
            for (int m = 0; m < 4; ++m) { const int row = row0 + ai * HALF + m * 16; bf16_t* rowp = O + (size_t)row * 1024 + col0; float ss = 0.f;
#pragma unroll
                for (int bj = 0; bj < 2; ++bj) { const f32x4 v0 = acc[ai][bj][m][0], v1 = acc[ai][bj][m][1];
                    ss += (v0[0] * v0[0] + v0[1] * v0[1]) + (v0[2] * v0[2] + v0[3] * v0[3]) + (v1[0] * v1[0] + v1[1] * v1[1]) + (v1[2] * v1[2] + v1[3] * v1[3]);
                    u32x4 w; w.x = cvt_pk_bf16(v0[0], v0[1]); w.y = cvt_pk_bf16(v0[2], v0[3]); w.z = cvt_pk_bf16(v1[0], v1[1]); w.w = cvt_pk_bf16(v1[2], v1[3]);
                    *(u32x4*)(rowp + bj * HALF) = w; }
                ss += __shfl_xor(ss, 16); ss += __shfl_xor(ss, 32);
                if (fq == 0) osq[(size_t)row * 16 + u.pn * 4 + wc] = ss; }
    }
};
struct EpiDown {
    static constexpr bool PERM = true;
    bf16_t* C; const float* bias;
    __device__ __forceinline__ void operator()(const f32x4 (&acc)[2][2][4][2], const Unit& u, int wr, int wc, int fr, int fq) const {
        const int e = u.pn >> 2, pnl = u.pn & 3;
        const int row0 = u.pm * BM + wr * 64 + fr, col0 = pnl * BM + wc * 32 + 8 * fq;
        const float* bp = bias + (size_t)e * 1024 + col0;
        f32x4 bv[2][2];
#pragma unroll
        for (int bj = 0; bj < 2; ++bj)
#pragma unroll
            for (int n = 0; n < 2; ++n) bv[bj][n] = *(const f32x4*)(bp + bj * HALF + 4 * n);
#pragma unroll
        for (int ai = 0; ai < 2; ++ai)
#pragma unroll
            for (int m = 0; m < 4; ++m) { bf16_t* rowp = C + (size_t)(row0 + ai * HALF + m * 16) * 1024 + col0;
#pragma unroll
                for (int bj = 0; bj < 2; ++bj) { const f32x4 v0 = acc[ai][bj][m][0] + bv[bj][0], v1 = acc[ai][bj][m][1] + bv[bj][1];
                    u32x4 w; w.x = cvt_pk_bf16(v0[0], v0[1]); w.y = cvt_pk_bf16(v0[2], v0[3]); w.z = cvt_pk_bf16(v1[0], v1[1]); w.w = cvt_pk_bf16(v1[2], v1[3]);
                    *(u32x4*)(rowp + bj * HALF) = w; } }
    }
};
struct EpiSwiglu {
    static constexpr bool PERM = true;
    bf16_t* O; const float* bias;
    __device__ __forceinline__ void operator()(const f32x4 (&acc)[2][2][4][2], const Unit& u, int wr, int wc, int fr, int fq) const {
        const int e = u.pn >> 3, pnl = u.pn & 7;
        const int row0 = u.pm * BM + wr * 64 + fr, col0 = pnl * HALF + wc * 32 + 8 * fq;
        const float* bp = bias + (size_t)e * 2048 + col0;
        f32x4 bg[2], bu[2];
#pragma unroll
        for (int n = 0; n < 2; ++n) { bg[n] = *(const f32x4*)(bp + 4 * n); bu[n] = *(const f32x4*)(bp + 1024 + 4 * n) + 1.0f; }
#pragma unroll
        for (int ai = 0; ai < 2; ++ai)
#pragma unroll
            for (int m = 0; m < 4; ++m) {
                bf16_t* rowp = O + (size_t)(row0 + ai * HALF + m * 16) * 1024 + col0;
                float r[8];
#pragma unroll
                for (int n = 0; n < 2; ++n) {
                    const f32x4 g = acc[ai][0][m][n] + bg[n], up = acc[ai][1][m][n] + bu[n];
                    const f32x4 gt = __builtin_elementwise_min(g, (f32x4){7.f, 7.f, 7.f, 7.f});
                    const f32x4 uu = __builtin_elementwise_min(__builtin_elementwise_max(up, (f32x4){-6.f, -6.f, -6.f, -6.f}), (f32x4){8.f, 8.f, 8.f, 8.f});
                    const f32x4 z = gt * (-1.702f * 1.4426950408889634f);
                    f32x4 e; e[0] = __builtin_amdgcn_exp2f(z[0]); e[1] = __builtin_amdgcn_exp2f(z[1]); e[2] = __builtin_amdgcn_exp2f(z[2]); e[3] = __builtin_amdgcn_exp2f(z[3]);
                    const f32x4 d = e + 1.0f;
                    f32x4 rc; rc[0] = __builtin_amdgcn_rcpf(d[0]); rc[1] = __builtin_amdgcn_rcpf(d[1]); rc[2] = __builtin_amdgcn_rcpf(d[2]); rc[3] = __builtin_amdgcn_rcpf(d[3]);
                    const f32x4 o = (uu * gt) * rc;
                    r[n * 4] = o[0]; r[n * 4 + 1] = o[1]; r[n * 4 + 2] = o[2]; r[n * 4 + 3] = o[3];
                }
                u32x4 w; w.x = cvt_pk_bf16(r[0], r[1]); w.y = cvt_pk_bf16(r[2], r[3]); w.z = cvt_pk_bf16(r[4], r[5]); w.w = cvt_pk_bf16(r[6], r[7]);
                *(u32x4*)rowp = w;
            }
    }
};

template <class Epi, class Sched, bool ALIGN_EPI = false, bool SP2 = false, bool GATHER = false>
__device__ __forceinline__ void gemm_phase(PG8_LAS unsigned char* lds, const Gemm g, const Sched& S, const Epi& E, const int* rowtok = nullptr) {
    static_assert(!GATHER || SP2, "gather staging is wired into the SP2 loop only");
    const int tid = opaque_tid(), wid = __builtin_amdgcn_readfirstlane(tid >> 6), lane = tid & 63, wr = wid >> 2, wc = wid & 3, fr = lane & 15, fq = lane >> 4;
    const int K = g.K, nt = K / BK;
    unsigned voffA[2], voffB[2];
#pragma unroll
    for (int i = 0; i < 2; ++i) { int R, C; stage_rc(tid * 16 + i * 8192, R, C); const int Rb = Epi::PERM ? ((R & ~31) + perm32(R & 31)) : R;
        voffA[i] = (unsigned)(R * K + C) * 2u; voffB[i] = (unsigned)(Rb * K + C) * 2u; }
    int gR[2], gC[2];
#pragma unroll
    for (int i = 0; i < 2; ++i) stage_rc(tid * 16 + i * 8192, gR[i], gC[i]);
    PG8_LAS int* rt = (PG8_LAS int*)(lds + STAGE_BYTES);
    unsigned gaC[2][2] = {{0u, 0u}, {0u, 0u}}, gaN[2][2] = {{0u, 0u}, {0u, 0u}};
    const size_t kstep = (size_t)(BK * 2);
    const size_t hstep = (size_t)HALF * K * 2;
    const size_t tstep = 2 * hstep;
    const unsigned ldsw = (unsigned)wid * 1024u;
    const int aoff = lds_byte(wr * 64 + fr, fq * 8), boff = lds_byte(wc * 32 + fr, fq * 8);
#define PG8_SA(b, h) (((b) * 2 + (h)) * HTB)
#define PG8_SB(b, h) ((4 + (b) * 2 + (h)) * HTB)
#define PG8_STAGE(bufoff, gbase, voff) do { _Pragma("unroll") for (int _i = 0; _i < 2; ++_i) \
        __builtin_amdgcn_global_load_lds((const unsigned*)((const char*)(gbase) + (voff)[_i]), (PG8_LAS unsigned*)(lds + (bufoff) + ldsw + _i * 8192), 16, 0, 0); } while (0)
#define PG8_GOFF(dst, k) do { _Pragma("unroll") for (int h_ = 0; h_ < 2; ++h_) _Pragma("unroll") for (int i_ = 0; i_ < 2; ++i_) dst[h_][i_] = (unsigned)(rt[(k) * 256 + h_ * HALF + gR[i_]] * K + gC[i_]) * 2u; } while (0)
#define PG8_STAGE_A(bufoff, ptr, un, h, kb) do { if constexpr (GATHER) { const unsigned o0_ = (un) ? gaN[h][0] : gaC[h][0], o1_ = (un) ? gaN[h][1] : gaC[h][1]; \
        __builtin_amdgcn_global_load_lds((const unsigned*)((const char*)g.A + (kb) + o0_), (PG8_LAS unsigned*)(lds + (bufoff) + ldsw), 16, 0, 0); \
        __builtin_amdgcn_global_load_lds((const unsigned*)((const char*)g.A + (kb) + o1_), (PG8_LAS unsigned*)(lds + (bufoff) + ldsw + 8192), 16, 0, 0); } else PG8_STAGE(bufoff, ptr, voffA); } while (0)
#define PG8_LDA(dst, b, h) do { _Pragma("unroll") for (int m = 0; m < 4; ++m) _Pragma("unroll") for (int k = 0; k < 2; ++k) dst[m][k] = *(const PG8_LAS bf16x8*)(lds + PG8_SA(b, h) + aoff + m * 2048 + k * 1024); } while (0)
#define PG8_LDB(dst, b, h) do { _Pragma("unroll") for (int n = 0; n < 2; ++n) _Pragma("unroll") for (int k = 0; k < 2; ++k) dst[n][k] = *(const PG8_LAS bf16x8*)(lds + PG8_SB(b, h) + boff + n * 2048 + k * 1024); } while (0)
#define PG8_MMA(ai, bj, At, Bt) do { __builtin_amdgcn_s_setprio(1); _Pragma("unroll") for (int m = 0; m < 4; ++m) _Pragma("unroll") for (int n = 0; n < 2; ++n) _Pragma("unroll") for (int k = 0; k < 2; ++k) \
        acc[ai][bj][m][n] = __builtin_amdgcn_mfma_f32_16x16x32_bf16(Bt[n][k], At[m][k], acc[ai][bj][m][n], 0, 0, 0); __builtin_amdgcn_s_setprio(0); } while (0)
#define PG8_WAIT_V(n) asm volatile("s_waitcnt vmcnt(" #n ")" ::: "memory")
#define PG8_WAIT_L(n) asm volatile("s_waitcnt lgkmcnt(" #n ")" ::: "memory")
#define PG8_BAR __builtin_amdgcn_s_barrier()
#define PG8_SCHED __builtin_amdgcn_sched_barrier(0)
    Unit cur, nxt; int ui = 0;
    if (!S.next(0, cur)) return;
    f32x4 acc[2][2][4][2];
#pragma unroll
    for (int a = 0; a < 2; ++a)
#pragma unroll
        for (int b = 0; b < 2; ++b)
#pragma unroll
            for (int m = 0; m < 4; ++m)
#pragma unroll
                for (int n = 0; n < 2; ++n) acc[a][b][m][n] = (f32x4){0.f, 0.f, 0.f, 0.f};
    bf16x8 At[4][2], B0[2][2], B1[2][2];
    const char* cA = (const char*)g.A + (size_t)cur.pm * tstep; const char* cB = (const char*)g.Bt + (size_t)cur.pn * tstep;
    S.a_ready(cur);
    if constexpr (GATHER) {
        PG8_LAS int* pms = rt + 16 * 256;
        if (tid < 16) { Unit u_; pms[tid] = S.next(tid, u_) ? u_.pm : -1; }
        __syncthreads();
        {
            int tok[8];
#pragma unroll
            for (int j = 0; j < 8; ++j) { const int k = 2 * j + (tid >> 8), pm = pms[k]; tok[j] = (pm >= 0) ? rowtok[pm * 256 + (tid & 255)] : 0; }
#pragma unroll
            for (int j = 0; j < 8; ++j) rt[(2 * j + (tid >> 8)) * 256 + (tid & 255)] = tok[j];
        }
        __syncthreads();
        PG8_GOFF(gaC, 0);
    }
    if constexpr (SP2) {
        PG8_STAGE(PG8_SB(0, 0), cB, voffB); PG8_STAGE(PG8_SB(0, 1), cB + hstep, voffB); PG8_STAGE_A(PG8_SA(0, 0), cA, false, 0, (size_t)0); PG8_STAGE_A(PG8_SA(0, 1), cA + hstep, false, 1, (size_t)0);
        if (wr == 1) PG8_BAR;
        PG8_WAIT_V(2); PG8_BAR;
        PG8_STAGE(PG8_SB(1, 0), cB + kstep, voffB); PG8_STAGE_A(PG8_SA(1, 0), cA + kstep, false, 0, kstep); PG8_STAGE(PG8_SB(1, 1), cB + hstep + kstep, voffB);
        PG8_WAIT_V(6); PG8_BAR;
    } else {
        PG8_STAGE(PG8_SB(0, 0), cB, voffB); PG8_STAGE(PG8_SA(0, 0), cA, voffA); PG8_STAGE(PG8_SB(0, 1), cB + hstep, voffB); PG8_STAGE(PG8_SA(0, 1), cA + hstep, voffA);
        if (wr == 1) PG8_BAR;
        PG8_WAIT_V(4); PG8_BAR;
        PG8_STAGE(PG8_SB(1, 0), cB + kstep, voffB); PG8_STAGE(PG8_SA(1, 0), cA + kstep, voffA); PG8_STAGE(PG8_SB(1, 1), cB + hstep + kstep, voffB);
        PG8_WAIT_V(6); PG8_BAR;
    }
    for (;;) {
        const bool has_next = S.next(ui + 1, nxt);
        if constexpr (GATHER) { if (has_next) PG8_GOFF(gaN, ui + 1); }
        const char* nA = has_next ? (const char*)g.A + (size_t)nxt.pm * tstep : cA; const char* nB = has_next ? (const char*)g.Bt + (size_t)nxt.pn * tstep : cB;
        for (int t = 0; t < nt; t += 2) {
            const bool last = (t == nt - 2);
            const char* a1 = cA + (size_t)(t + 1) * kstep;
            const char* a2 = last ? nA : cA + (size_t)(t + 2) * kstep; const char* b2 = last ? nB : cB + (size_t)(t + 2) * kstep;
            const char* a3 = a2 + kstep; const char* b3 = b2 + kstep;
            if (last && has_next) S.a_ready(nxt);
            const bool un = last && has_next; const size_t k1 = (size_t)(t + 1) * kstep, k2 = last ? (size_t)0 : (size_t)(t + 2) * kstep;
            if constexpr (SP2) {
            PG8_LDB(B0, 0, 0); PG8_LDB(B1, 0, 1); PG8_SCHED; PG8_LDA(At, 0, 0); PG8_STAGE_A(PG8_SA(1, 1), a1 + hstep, false, 1, k1);
            PG8_WAIT_V(8); PG8_WAIT_L(0); PG8_BAR; PG8_MMA(0, 0, At, B0); PG8_MMA(0, 1, At, B1); PG8_BAR; PG8_SCHED;
            PG8_LDA(At, 0, 1); PG8_STAGE(PG8_SB(0, 0), b2, voffB); PG8_STAGE(PG8_SB(0, 1), b2 + hstep, voffB); PG8_STAGE_A(PG8_SA(0, 0), a2, un, 0, k2);
            PG8_WAIT_V(8); PG8_WAIT_L(0); PG8_BAR; PG8_MMA(1, 0, At, B0); PG8_MMA(1, 1, At, B1); PG8_BAR; PG8_SCHED;
            PG8_LDB(B0, 1, 0); PG8_LDB(B1, 1, 1); PG8_SCHED; PG8_LDA(At, 1, 0); PG8_STAGE_A(PG8_SA(0, 1), a2 + hstep, un, 1, k2);
            PG8_WAIT_V(8); PG8_WAIT_L(0); PG8_BAR; PG8_MMA(0, 0, At, B0); PG8_MMA(0, 1, At, B1); PG8_BAR; PG8_SCHED;
            PG8_LDA(At, 1, 1); PG8_STAGE(PG8_SB(1, 0), b3, voffB); PG8_STAGE(PG8_SB(1, 1), b3 + hstep, voffB); PG8_STAGE_A(PG8_SA(1, 0), a3, un, 0, k2 + kstep);
            PG8_WAIT_V(8); PG8_WAIT_L(0); PG8_BAR; PG8_MMA(1, 0, At, B0); PG8_MMA(1, 1, At, B1); PG8_BAR; PG8_SCHED;
            } else {
            PG8_LDB(B0, 0, 0); PG8_SCHED; PG8_LDA(At, 0, 0); PG8_STAGE(PG8_SA(1, 1), a1 + hstep, voffA);
            PG8_WAIT_L(8); PG8_BAR; PG8_WAIT_L(0); PG8_MMA(0, 0, At, B0); PG8_BAR; PG8_SCHED;
            PG8_LDB(B1, 0, 1); PG8_STAGE(PG8_SB(0, 0), b2, voffB);
            PG8_BAR; PG8_WAIT_L(0); PG8_MMA(0, 1, At, B1); PG8_BAR;
            PG8_LDA(At, 0, 1); PG8_STAGE(PG8_SA(0, 0), a2, voffA);
            PG8_BAR; PG8_WAIT_L(0); PG8_MMA(1, 0, At, B0); PG8_BAR; PG8_SCHED;
            PG8_STAGE(PG8_SB(0, 1), b2 + hstep, voffB);
            PG8_WAIT_V(6); PG8_BAR; PG8_MMA(1, 1, At, B1); PG8_BAR;
            PG8_LDB(B0, 1, 0); PG8_SCHED; PG8_LDA(At, 1, 0); PG8_STAGE(PG8_SA(0, 1), a2 + hstep, voffA);
            PG8_WAIT_L(8); PG8_BAR; PG8_WAIT_L(0); PG8_MMA(0, 0, At, B0); PG8_BAR; PG8_SCHED;
            PG8_LDB(B1, 1, 1); PG8_STAGE(PG8_SB(1, 0), b3, voffB);
            PG8_BAR; PG8_WAIT_L(0); PG8_MMA(0, 1, At, B1); PG8_BAR;
            PG8_LDA(At, 1, 1); PG8_STAGE(PG8_SA(1, 0), a3, voffA);
            PG8_BAR; PG8_WAIT_L(0); PG8_MMA(1, 0, At, B0); PG8_BAR; PG8_SCHED;
            PG8_STAGE(PG8_SB(1, 1), b3 + hstep, voffB);
            PG8_WAIT_V(6); PG8_BAR; PG8_MMA(1, 1, At, B1); PG8_BAR;
            }
        }
        if constexpr (ALIGN_EPI) { if (wr == 0) PG8_BAR; }
        E(acc, cur, wr, wc, fr, fq); S.done(cur);
        if (!has_next) break;
#pragma unroll
        for (int a = 0; a < 2; ++a)
#pragma unroll
            for (int b = 0; b < 2; ++b)
#pragma unroll
                for (int m = 0; m < 4; ++m)
#pragma unroll
                    for (int n = 0; n < 2; ++n) acc[a][b][m][n] = (f32x4){0.f, 0.f, 0.f, 0.f};
        cur = nxt; cA = nA; cB = nB; ++ui;
        if constexpr (GATHER) { gaC[0][0] = gaN[0][0]; gaC[0][1] = gaN[0][1]; gaC[1][0] = gaN[1][0]; gaC[1][1] = gaN[1][1]; }
        if constexpr (ALIGN_EPI) { if (wr == 1) PG8_BAR; }
    }
    PG8_WAIT_V(0);
    if constexpr (!ALIGN_EPI) { if (wr == 0) PG8_BAR; }
    PG8_BAR;
#undef PG8_SA
#undef PG8_SB
#undef PG8_STAGE
#undef PG8_LDA
#undef PG8_GOFF
#undef PG8_STAGE_A
#undef PG8_LDB
#undef PG8_MMA
#undef PG8_WAIT_V
#undef PG8_WAIT_L
#undef PG8_BAR
#undef PG8_SCHED
}
}

typedef short bf16x8_t __attribute__((ext_vector_type(8)));
typedef float f32x16_t __attribute__((ext_vector_type(16)));
typedef float f32x2_t __attribute__((ext_vector_type(2)));
typedef unsigned u32x4_t __attribute__((ext_vector_type(4)));
typedef unsigned u32x2_t __attribute__((ext_vector_type(2)));
#define LAS3 __attribute__((address_space(3)))
constexpr int ATT_VROW = 68;
constexpr int ATT_LDS_BYTES = 3 * (64 * 104 * 2 + 64 * ATT_VROW * 2);

template <int QKD, int NMAP, bool DA>
__device__ __forceinline__ void attn_item(LAS3 unsigned char* lds, const bf16_t* __restrict__ Qb, const bf16_t* __restrict__ Kb, const bf16_t* __restrict__ Vt,
                                          bf16_t* __restrict__ ycatb, int ycat_off, int b, int h, int qblk, float lam, const float* __restrict__ subln, float post_scale) {
    constexpr int DK = QKD / NMAP, KS = DK / 16, KROW = QKD + 8, KCH = QKD / 8;
    constexpr int KBYTES = 64 * KROW * 2, VBYTES = 64 * ATT_VROW * 2, BUFB = KBYTES + VBYTES;
    const int tid = opaque_tid(), wid = tid >> 6, lane = tid & 63, r = lane & 31, hh = lane >> 5;
    const int q0 = qblk * 256, ntiles = (qblk == 0) ? (NC / 64) : (NT / 64);
    const size_t base = ((size_t)b * 4 + h) * NT;
    bf16x8_t qf[NMAP][KS];
#pragma unroll
    for (int m = 0; m < NMAP; ++m)
#pragma unroll
        for (int ks = 0; ks < KS; ++ks) qf[m][ks] = *(const bf16x8_t*)(Qb + (base + q0 + 32 * wid + r) * QKD + m * DK + 16 * ks + 8 * hh);
    f32x16_t O[NMAP][2]; float mrun[NMAP], lrun[NMAP];
#pragma unroll
    for (int m = 0; m < NMAP; ++m) { mrun[m] = 0.f; lrun[m] = 0.f;
#pragma unroll
        for (int d2 = 0; d2 < 2; ++d2)
#pragma unroll
            for (int i = 0; i < 16; ++i) O[m][d2][i] = 0.f; }
    constexpr int NKC = 64 * KCH;
    const bf16_t* kg = Kb + base * QKD;
    const bf16_t* vg = Vt + ((size_t)(b * 4 + h) * 64 + (tid >> 3)) * NT + (tid & 7) * 8;
    u32x4_t rk0, rk1 = (u32x4_t){0u, 0u, 0u, 0u}, rv;
    const int kc1 = tid + 512;
    const int k0row = tid / KCH, k0col = tid % KCH, k1row = kc1 / KCH, k1col = kc1 % KCH;
#define ATT_LOAD(j) do { rk0 = *(const u32x4_t*)(kg + (size_t)(j) * 64 * QKD + tid * 8); if (NKC > 512 && kc1 < NKC) rk1 = *(const u32x4_t*)(kg + (size_t)(j) * 64 * QKD + kc1 * 8); \
        rv = *(const u32x4_t*)(vg + (size_t)(j) * 64); } while (0)
#define ATT_STORE(buf) do { LAS3 unsigned char* kb_ = lds + (buf) * BUFB; LAS3 unsigned char* vb_ = kb_ + KBYTES; \
        *(LAS3 u32x4_t*)(kb_ + (k0row * KROW + k0col * 8) * 2) = rk0; if (NKC > 512 && kc1 < NKC) *(LAS3 u32x4_t*)(kb_ + (k1row * KROW + k1col * 8) * 2) = rk1; \
        LAS3 unsigned char* vd_ = vb_ + ((tid >> 3) * ATT_VROW + (tid & 7) * 8) * 2; *(LAS3 u32x2_t*)vd_ = (u32x2_t){rv.x, rv.y}; *(LAS3 u32x2_t*)(vd_ + 8) = (u32x2_t){rv.z, rv.w}; } while (0)
    __syncthreads();
    ATT_LOAD(0); ATT_STORE(0);
    if (ntiles > 1) ATT_LOAD(1);
    __syncthreads();
    bf16x8_t pf[NMAP][2][2];
#define ATT_PV(m_, vb_) do { _Pragma("unroll") for (int d2 = 0; d2 < 2; ++d2) _Pragma("unroll") for (int kt = 0; kt < 2; ++kt) _Pragma("unroll") for (int s2 = 0; s2 < 2; ++s2) { \
        const LAS3 unsigned char* vp = (vb_) + ((d2 * 32 + r) * ATT_VROW + kt * 32 + 16 * s2 + 4 * hh) * 2; \
        union { u32x2_t u[2]; bf16x8_t v; } av; av.u[0] = *(const LAS3 u32x2_t*)vp; av.u[1] = *(const LAS3 u32x2_t*)(vp + 16); \
        O[m_][d2] = __builtin_amdgcn_mfma_f32_32x32x16_bf16(av.v, pf[m_][kt][s2], O[m_][d2], 0, 0, 0); } } while (0)
    int sl = 0;
    for (int j = 0; j < ntiles; ++j) {
        const LAS3 unsigned char* kb = lds + sl * BUFB;
        const LAS3 unsigned char* vbp = lds + ((sl == 0) ? 2 : sl - 1) * BUFB + KBYTES;
#pragma unroll
        for (int m = 0; m < NMAP; ++m) {
            f32x16_t S[2];
            const float nm = -mrun[m];
#pragma unroll
            for (int kt = 0; kt < 2; ++kt) {
#pragma unroll
                for (int i = 0; i < 16; ++i) S[kt][i] = nm;
#pragma unroll
                for (int ks = 0; ks < KS; ++ks) {
                    const bf16x8_t a = *(const LAS3 bf16x8_t*)(kb + ((kt * 32 + r) * KROW + m * DK + 16 * ks + 8 * hh) * 2);
                    S[kt] = __builtin_amdgcn_mfma_f32_32x32x16_bf16(a, qf[m][ks], S[kt], 0, 0, 0);
                }
            }
            if (j > 0) ATT_PV(m, vbp);
            float mx = S[0][0];
#pragma unroll
            for (int i = 1; i < 16; ++i) mx = fmaxf(mx, S[0][i]);
#pragma unroll
            for (int i = 0; i < 16; ++i) mx = fmaxf(mx, S[1][i]);
            mx = fmaxf(mx, __shfl_xor(mx, 32));
            if (j == 0 || !__all(mx <= 8.f)) {
                const float dl = (j == 0) ? mx : fmaxf(mx, 0.f);
                mrun[m] += dl;
#pragma unroll
                for (int kt = 0; kt < 2; ++kt)
#pragma unroll
                    for (int i = 0; i < 16; ++i) S[kt][i] -= dl;
                if (j != 0) {
                    const float alpha = __builtin_amdgcn_exp2f(-dl);
                    lrun[m] *= alpha;
#pragma unroll
                    for (int d2 = 0; d2 < 2; ++d2)
#pragma unroll
                        for (int i = 0; i < 16; ++i) O[m][d2][i] *= alpha;
                }
            }
            f32x2_t ps2 = (f32x2_t){0.f, 0.f};
#pragma unroll
            for (int kt = 0; kt < 2; ++kt) {
#pragma unroll
                for (int i = 0; i < 16; i += 2) { const float p0 = __builtin_amdgcn_exp2f(S[kt][i]), p1 = __builtin_amdgcn_exp2f(S[kt][i + 1]); S[kt][i] = p0; S[kt][i + 1] = p1; ps2 += (f32x2_t){p0, p1}; }
#pragma unroll
                for (int s2 = 0; s2 < 2; ++s2) {
                    union { unsigned u[4]; bf16x8_t v; } cv;
#pragma unroll
                    for (int jj = 0; jj < 4; ++jj) cv.u[jj] = cvtpk(S[kt][8 * s2 + 2 * jj], S[kt][8 * s2 + 2 * jj + 1]);
                    pf[m][kt][s2] = cv.v;
                }
            }
            lrun[m] += ps2[0] + ps2[1];
        }
        const int sn = (sl == 2) ? 0 : sl + 1;
        if (j + 1 < ntiles) { ATT_STORE(sn); if (j + 2 < ntiles) ATT_LOAD(j + 2); }
        __syncthreads();
        sl = sn;
    }
    {
        const LAS3 unsigned char* vbl = lds + ((sl == 0) ? 2 : sl - 1) * BUFB + KBYTES;
#pragma unroll
        for (int m = 0; m < NMAP; ++m) ATT_PV(m, vbl);
    }
#undef ATT_PV
#undef ATT_LOAD
#undef ATT_STORE
    float inv[NMAP];
#pragma unroll
    for (int m = 0; m < NMAP; ++m) { const float lt = lrun[m] + __shfl_xor(lrun[m], 32); inv[m] = __builtin_amdgcn_rcpf(lt); }
    if (NMAP == 2) inv[NMAP - 1] *= -lam;
    float ss = 0.f;
#pragma unroll
    for (int d2 = 0; d2 < 2; ++d2)
#pragma unroll
        for (int i = 0; i < 16; ++i) {
            float o = O[0][d2][i] * inv[0];
            if (NMAP == 2) o += O[NMAP - 1][d2][i] * inv[NMAP - 1];
            O[0][d2][i] = o; ss += o * o;
        }
    float rs = 1.f;
    if (DA) { ss += __shfl_xor(ss, 32); rs = rsqrtf(ss * (1.f / 64.f) + 1e-6f) * post_scale; }
    bf16_t* yp = ycatb + ((size_t)b * NT + q0 + 32 * wid + r) * DM + ycat_off + h * 64;
#pragma unroll
    for (int d2 = 0; d2 < 2; ++d2)
#pragma unroll
        for (int g4 = 0; g4 < 4; ++g4) {
            const int dv = 32 * d2 + 8 * g4 + 4 * hh;
            float o0 = O[0][d2][4 * g4] * rs, o1 = O[0][d2][4 * g4 + 1] * rs, o2 = O[0][d2][4 * g4 + 2] * rs, o3 = O[0][d2][4 * g4 + 3] * rs;
            if (DA) { const float4 w = *(const float4*)(subln + dv); o0 *= w.x; o1 *= w.y; o2 *= w.z; o3 *= w.w; }
            *(uint2*)(yp + dv) = make_uint2(cvtpk(o0, o1), cvtpk(o2, o3));
        }
}


typedef float f32x4_t __attribute__((ext_vector_type(4)));
constexpr int ML_KROW = 72, ML_TROW = 136, ML_CROW = 72;
constexpr int ML_OFF_KC = 0, ML_OFF_KT = ML_OFF_KC + 128 * ML_KROW * 2, ML_OFF_VT = ML_OFF_KT + 64 * ML_TROW * 2, ML_OFF_CB = ML_OFF_VT + 80 * ML_TROW * 2,
              ML_OFF_F = ML_OFF_CB + 80 * ML_CROW * 2, ML_LDS_BYTES = ML_OFF_F + 6 * 128 * 4 + 64;
__device__ __forceinline__ void mlstm_item(LAS3 unsigned char* lds, const bf16_t* __restrict__ Qb, const bf16_t* __restrict__ Kb, const bf16_t* __restrict__ Ktg, const bf16_t* __restrict__ Vtg,
                                           const float* __restrict__ G, float* __restrict__ hdir, int b, int h, int dir) {
    const int tid = opaque_tid(), wid = tid >> 6, lane = tid & 63, lr = lane & 15, q = lane >> 4;
    LAS3 unsigned char* Kc = lds + ML_OFF_KC; LAS3 unsigned char* Kt = lds + ML_OFF_KT; LAS3 unsigned char* Vt = lds + ML_OFF_VT; LAS3 unsigned char* Cb = lds + ML_OFF_CB;
    LAS3 float* fl = (LAS3 float*)(lds + ML_OFF_F);
    LAS3 float* s_li = fl; LAS3 float* s_lf = fl + 128; LAS3 float* s_bc2 = fl + 256; LAS3 float* s_gk2 = fl + 384; LAS3 float* s_wu = fl + 512; LAS3 float* s_et = fl + 640; LAS3 float* s_misc = fl + 768;
    const size_t base = ((size_t)b * 4 + h) * NT;
    __syncthreads();
    for (int i = tid; i < 80 * ML_CROW / 2; i += 512) ((LAS3 unsigned*)Cb)[i] = 0u;
    for (int i = tid; i < 16 * ML_TROW / 2; i += 512) ((LAS3 unsigned*)(Vt + 64 * ML_TROW * 2))[i] = (i < ML_TROW / 2) ? 0x3F803F80u : 0u;
    const int ct = wid & 3, rt0 = (wid < 4) ? 0 : 3, nrt = (wid < 4) ? 3 : 2;
    f32x4_t Cacc[3];
#pragma unroll
    for (int i = 0; i < 3; ++i) Cacc[i] = (f32x4_t){0.f, 0.f, 0.f, 0.f};
    const int tq = 16 * wid + lr;
    const int ia = (dir == 0) ? 2 * lane : 127 - 2 * lane, ib = (dir == 0) ? 2 * lane + 1 : 126 - 2 * lane;
    u32x4_t nkc[2], nkt[2], nvt[2]; bf16x8_t nqf[2]; float ngxa = 0.f, ngxb = 0.f, ngla = 0.f, nglb = 0.f;
#define ML_N0(c_) ((dir == 0) ? 128 * (c_) : (((c_) < 2) ? 128 * (1 - (c_)) : NC + 128 * (17 - (c_))))
#define ML_LOAD(c_) do { const int n0_ = ML_N0(c_); \
        _Pragma("unroll") for (int i = 0; i < 2; ++i) { const int id = tid + 512 * i; \
            nkc[i] = *(const u32x4_t*)(Kb + (base + n0_ + (id >> 3)) * 64 + (id & 7) * 8); \
            nkt[i] = *(const u32x4_t*)(Ktg + ((size_t)(b * 4 + h) * 64 + (id >> 4)) * NT + n0_ + (id & 15) * 8); \
            nvt[i] = *(const u32x4_t*)(Vtg + ((size_t)(b * 4 + h) * 64 + (id >> 4)) * NT + n0_ + (id & 15) * 8); } \
        _Pragma("unroll") for (int ks = 0; ks < 2; ++ks) nqf[ks] = *(const bf16x8_t*)(Qb + (base + n0_ + tq) * 64 + 32 * ks + 8 * q); \
        if (wid == 0) { const float* gpa = G + ((size_t)b * NT + n0_ + ia) * 16 + (dir * 2) * 4 + h; const float* gpb = G + ((size_t)b * NT + n0_ + ib) * 16 + (dir * 2) * 4 + h; \
            ngxa = gpa[4]; ngxb = gpb[4]; ngla = gpa[0]; nglb = gpb[0]; } } while (0)
    ML_LOAD(0);
    for (int c = 0; c < NT / 128; ++c) {
        const int n0 = ML_N0(c);
        u32x4_t rkc[2], rkt[2], rvt[2];
        bf16x8_t qf[2];
#pragma unroll
        for (int i = 0; i < 2; ++i) { rkc[i] = nkc[i]; rkt[i] = nkt[i]; rvt[i] = nvt[i]; qf[i] = nqf[i]; }
        const float xa = ngxa, xb = ngxb, lia = ngla, lib = nglb;
        if (c + 1 < NT / 128) ML_LOAD(c + 1);
#pragma unroll
        for (int i = 0; i < 2; ++i) {
            const int id = tid + 512 * i;
            *(LAS3 u32x4_t*)(Kc + ((id >> 3) * ML_KROW + (id & 7) * 8) * 2) = rkc[i];
            *(LAS3 u32x4_t*)(Vt + ((id >> 4) * ML_TROW + (id & 15) * 8) * 2) = rvt[i];
        }
        __syncthreads();
        if (wid == 0) {
            float inc = xa + xb;
#pragma unroll
            for (int o = 1; o < 64; o <<= 1) { const float v = __shfl_up(inc, o); if (lane >= o) inc += v; }
            const float tot = __shfl(inc, 63);
            const float bca = inc - xb, bcb = inc;
            s_bc2[ia] = bca * 1.4426950408889634f; s_bc2[ib] = bcb * 1.4426950408889634f;
            s_gk2[ia] = (bca - lia) * 1.4426950408889634f; s_gk2[ib] = (bcb - lib) * 1.4426950408889634f;
            s_wu[ia] = __expf(tot - bca + lia); s_wu[ib] = __expf(tot - bcb + lib);
            s_et[ia] = __expf(bca); s_et[ib] = __expf(bcb);
            if (lane == 0) s_misc[0] = __expf(tot);
        }
        __syncthreads();
#pragma unroll
        for (int i = 0; i < 2; ++i) {
            const int id = tid + 512 * i; const int tk0 = (id & 15) * 8;
            unsigned w4[4] = {rkt[i].x, rkt[i].y, rkt[i].z, rkt[i].w}; u32x4_t o;
#pragma unroll
            for (int jj = 0; jj < 4; ++jj) {
                const float lo = __uint_as_float(w4[jj] << 16) * s_wu[tk0 + 2 * jj], hi = __uint_as_float(w4[jj] & 0xFFFF0000u) * s_wu[tk0 + 2 * jj + 1];
                o[jj] = cvtpk(lo, hi);
            }
            *(LAS3 u32x4_t*)(Kt + ((id >> 4) * ML_TROW + tk0) * 2) = o;
        }
        f32x4_t S[8];
#pragma unroll
        for (int kt = 0; kt < 8; ++kt) {
            S[kt] = (f32x4_t){0.f, 0.f, 0.f, 0.f};
#pragma unroll
            for (int ks = 0; ks < 2; ++ks) {
                const bf16x8_t a = *(const LAS3 bf16x8_t*)(Kc + ((16 * kt + lr) * ML_KROW + 32 * ks + 8 * q) * 2);
                S[kt] = __builtin_amdgcn_mfma_f32_16x16x32_bf16(a, qf[ks], S[kt], 0, 0, 0);
            }
        }
        const float bct = s_bc2[tq];
#pragma unroll
        for (int kt = 0; kt < 8; ++kt) {
            const f32x4_t gk = *(const LAS3 f32x4_t*)(s_gk2 + 16 * kt + 4 * q);
#pragma unroll
            for (int rg = 0; rg < 4; ++rg) {
                const int si = 16 * kt + 4 * q + rg;
                const bool valid = (dir == 0) ? (si <= tq) : (si >= tq);
                const float w = valid ? __builtin_amdgcn_exp2f(bct - gk[rg]) : 0.f;
                S[kt][rg] *= w;
            }
        }
        bf16x8_t pf[4];
#pragma unroll
        for (int k2 = 0; k2 < 4; ++k2) {
            union { unsigned u[4]; bf16x8_t v; } cv;
            cv.u[0] = cvtpk(S[2 * k2][0], S[2 * k2][1]); cv.u[1] = cvtpk(S[2 * k2][2], S[2 * k2][3]);
            cv.u[2] = cvtpk(S[2 * k2 + 1][0], S[2 * k2 + 1][1]); cv.u[3] = cvtpk(S[2 * k2 + 1][2], S[2 * k2 + 1][3]);
            pf[k2] = cv.v;
        }
        f32x4_t outv[5];
#pragma unroll
        for (int rt = 0; rt < 5; ++rt) {
            f32x4_t acc = (f32x4_t){0.f, 0.f, 0.f, 0.f}, acc2 = (f32x4_t){0.f, 0.f, 0.f, 0.f};
#pragma unroll
            for (int k2 = 0; k2 < 4; ++k2) {
                const LAS3 unsigned char* vp = Vt + ((16 * rt + lr) * ML_TROW + 32 * k2 + 4 * q) * 2;
                union { u32x2_t u[2]; bf16x8_t v; } av;
                av.u[0] = *(const LAS3 u32x2_t*)vp; av.u[1] = *(const LAS3 u32x2_t*)(vp + 32);
                acc = __builtin_amdgcn_mfma_f32_16x16x32_bf16(av.v, pf[k2], acc, 0, 0, 0);
            }
#pragma unroll
            for (int ks = 0; ks < 2; ++ks) {
                const bf16x8_t a = *(const LAS3 bf16x8_t*)(Cb + ((16 * rt + lr) * ML_CROW + 32 * ks + 8 * q) * 2);
                acc2 = __builtin_amdgcn_mfma_f32_16x16x32_bf16(a, qf[ks], acc2, 0, 0, 0);
            }
            outv[rt] = acc + acc2 * s_et[tq];
        }
        {
            const float den = __shfl(outv[4][0], lr);
            const float inv = __builtin_amdgcn_rcpf(fmaxf(fabsf(den), 1.f));
            bf16_t* hp = (bf16_t*)hdir + ((size_t)dir * TT + (size_t)b * NT + n0 + tq) * 256 + h * 64 + 4 * q;
            for (int rt = 0; rt < 4; ++rt) { const f32x4_t ov = outv[rt] * inv; *(uint2*)(hp + 16 * rt) = make_uint2(cvtpk(ov[0], ov[1]), cvtpk(ov[2], ov[3])); }
        }
        __syncthreads();
        {
            const float decay = s_misc[0];
#pragma unroll
            for (int i = 0; i < 3; ++i) Cacc[i] *= decay;
#pragma unroll
            for (int ks = 0; ks < 4; ++ks) {
                const bf16x8_t bb = *(const LAS3 bf16x8_t*)(Kt + ((16 * ct + lr) * ML_TROW + 32 * ks + 8 * q) * 2);
#pragma unroll
                for (int i = 0; i < 3; ++i) if (i < nrt) {
                    const bf16x8_t a = *(const LAS3 bf16x8_t*)(Vt + ((16 * (rt0 + i) + lr) * ML_TROW + 32 * ks + 8 * q) * 2);
                    Cacc[i] = __builtin_amdgcn_mfma_f32_16x16x32_bf16(a, bb, Cacc[i], 0, 0, 0);
                }
            }
#pragma unroll
            for (int i = 0; i < 3; ++i) if (i < nrt) {
#pragma unroll
                for (int rg = 0; rg < 4; ++rg) *(LAS3 bf16_t*)(Cb + ((16 * (rt0 + i) + 4 * q + rg) * ML_CROW + 16 * ct + lr) * 2) = f2bf(Cacc[i][rg]);
            }
        }
        __syncthreads();
    }
#undef ML_LOAD
#undef ML_N0
}

constexpr int S5_UROWS = NT + 64;
constexpr int S5_KROW = 1032, S5_CROW = 136, S5_ZROW = 136;
constexpr int S5_OFF_U = 0, S5_OFF_KM = S5_OFF_U + S5_UROWS * 16 * 2, S5_OFF_CM = S5_OFF_KM + 16 * S5_KROW * 2, S5_OFF_EZ = S5_OFF_CM + 16 * S5_CROW * 2,
              S5_LDS_BYTES = S5_OFF_EZ + 8 * 16 * S5_ZROW * 2;
__device__ __forceinline__ void s5_setup_item(LAS3 unsigned char* lds, int idx, const float* __restrict__ a_re, const float* __restrict__ a_im, const float* __restrict__ log_step,
                                                  const float* __restrict__ b_re, const float* __restrict__ b_im, const float* __restrict__ c_re, const float* __restrict__ c_im,
                                                  bf16_t* __restrict__ KmT, bf16_t* __restrict__ Smat, bf16_t* __restrict__ CmT, float* __restrict__ Aab, float* __restrict__ A64) {
    typedef float apw_t[64][2]; typedef float bb_t[16][2]; typedef float cc_t[64][2];
    LAS3 apw_t* apw = (LAS3 apw_t*)lds;
    LAS3 bb_t* bb = (LAS3 bb_t*)(lds + 32768);
    LAS3 cc_t* cc = (LAS3 cc_t*)(lds + 32768 + 8192);
    const int tid = opaque_tid();
    __syncthreads();
    const float dt = expf(log_step[idx]);
    if (tid < 64) {
        const int p = tid;
        const float ar = fminf(a_re[idx * 64 + p], -1e-4f), ai = a_im[idx * 64 + p];
        const float mag = expf(dt * ar), er = mag * cosf(dt * ai), ei = mag * sinf(dt * ai);
        const float inv = 1.0f / (ar * ar + ai * ai);
        const float fr = ((er - 1.0f) * ar + ei * ai) * inv, fi = (ei * ar - (er - 1.0f) * ai) * inv;
        Aab[(idx * 64 + p) * 2] = er; Aab[(idx * 64 + p) * 2 + 1] = ei;
        const float m64 = expf(64.0f * dt * ar);
        A64[(idx * 64 + p) * 2] = m64 * cosf(64.0f * dt * ai); A64[(idx * 64 + p) * 2 + 1] = m64 * sinf(64.0f * dt * ai);
        for (int hh = 0; hh < 16; ++hh) {
            const float br = b_re[((size_t)idx * 64 + p) * 16 + hh], bi = b_im[((size_t)idx * 64 + p) * 16 + hh];
            bb[p][hh][0] = fr * br - fi * bi; bb[p][hh][1] = fr * bi + fi * br;
        }
    }
    for (int i = tid; i < 64 * 64; i += 512) {
        const int tau = i >> 6, p = i & 63;
        const float ar = fminf(a_re[idx * 64 + p], -1e-4f), ai = a_im[idx * 64 + p];
        const float mag = expf((float)tau * dt * ar);
        apw[tau][p][0] = mag * cosf((float)tau * dt * ai); apw[tau][p][1] = mag * sinf((float)tau * dt * ai);
    }
    for (int i = tid; i < 16 * 64; i += 512) { const int hh = i >> 6, p = i & 63; cc[hh][p][0] = c_re[(size_t)idx * 1024 + i]; cc[hh][p][1] = c_im[(size_t)idx * 1024 + i]; }
    __syncthreads();
    for (int i = tid; i < 16 * 64; i += 512) { const int hh = i >> 6, p = i & 63;
        CmT[((size_t)idx * 16 + hh) * 128 + 2 * p] = f2bf(cc[hh][p][0]); CmT[((size_t)idx * 16 + hh) * 128 + 2 * p + 1] = f2bf(-cc[hh][p][1]); }
    for (int e = tid; e < 64 * 1024; e += 512) {
        const int p = e >> 10, k = e & 1023, i = k >> 4, hp = k & 15;
        const float pr = apw[63 - i][p][0], pi = apw[63 - i][p][1], br = bb[p][hp][0], bi = bb[p][hp][1];
        Smat[((size_t)idx * 128 + 2 * p) * 1024 + k] = f2bf(pr * br - pi * bi);
        Smat[((size_t)idx * 128 + 2 * p + 1) * 1024 + k] = f2bf(pr * bi + pi * br);
    }
    for (int e = tid; e < 16 * 1024; e += 512) {
        const int hh = e >> 10, k = e & 1023, tau = k >> 4, hp = k & 15;
        float acc = 0.f;
        for (int p = 0; p < 64; ++p) {
            const float pr = apw[tau][p][0], pi = apw[tau][p][1], br = bb[p][hp][0], bi = bb[p][hp][1];
            const float wr = pr * br - pi * bi, wi = pr * bi + pi * br;
            acc += cc[hh][p][0] * wr - cc[hh][p][1] * wi;
        }
        KmT[((size_t)idx * 16 + hh) * 1024 + k] = f2bf(acc);
    }
}


__device__ __forceinline__ void s5_item(LAS3 unsigned char* lds, const bf16_t* __restrict__ p, const bf16_t* __restrict__ KmT, const bf16_t* __restrict__ Smat, const bf16_t* __restrict__ CmT,
                                        const float* __restrict__ Aab, const float* __restrict__ A64, float* __restrict__ xs_g, float* __restrict__ ys5, int b, int g, int dir) {
    const int tid = opaque_tid(), wid = tid >> 6, lane = tid & 63, lr = lane & 15, q = lane >> 4;
    const int tix = dir * 16 + g;
    LAS3 unsigned char* U = lds + S5_OFF_U; LAS3 unsigned char* Km = lds + S5_OFF_KM; LAS3 unsigned char* Cm = lds + S5_OFF_CM; LAS3 unsigned char* EZ = lds + S5_OFF_EZ;
    float* xs = xs_g + (size_t)((b * 16 + g) * 2 + dir) * 36 * 128;
    __syncthreads();
    for (int i = tid; i < 16 * 128; i += 512) { const int hh = i >> 7, ch = i & 127;
        *(LAS3 u32x4_t*)(Km + (hh * S5_KROW + ch * 8) * 2) = *(const u32x4_t*)(KmT + ((size_t)tix * 16 + hh) * 1024 + ch * 8); }
    if (tid < 256) { const int hh = tid >> 4, ch = tid & 15;
        *(LAS3 u32x4_t*)(Cm + (hh * S5_CROW + ch * 8) * 2) = *(const u32x4_t*)(CmT + ((size_t)tix * 16 + hh) * 128 + ch * 8); }
    for (int i = tid; i < NT * 2; i += 512) {
        const int sidx = i >> 1, hf = i & 1;
        const int n = seq_token(sidx, dir);
        *(LAS3 u32x4_t*)(U + ((64 + sidx) * 16 + hf * 8) * 2) = *(const u32x4_t*)(p + ((size_t)b * NT + n) * DIN + P_S5 + g * 16 + hf * 8);
    }
    for (int i = tid; i < 64 * 8; i += 512) *(LAS3 unsigned*)(U + i * 4) = 0u;
    __syncthreads();
    {
        f32x4_t acc[3];
#pragma unroll
        for (int i = 0; i < 3; ++i) acc[i] = (f32x4_t){0.f, 0.f, 0.f, 0.f};
        const bf16_t* sp = Smat + ((size_t)tix * 128 + 16 * wid + lr) * 1024 + 8 * q;
        int cco[3];
#pragma unroll
        for (int ctile = 0; ctile < 3; ++ctile) { int ch = 16 * ctile + lr; if (ch > 35) ch = 35; cco[ctile] = ((64 + 64 * ch + (q >> 1)) * 16 + 8 * (q & 1)) * 2; }
#pragma unroll 8
        for (int ks = 0; ks < 32; ++ks) {
            const bf16x8_t a = *(const bf16x8_t*)(sp + 32 * ks);
#pragma unroll
            for (int ctile = 0; ctile < 3; ++ctile) {
                const bf16x8_t bfr = *(const LAS3 bf16x8_t*)(U + cco[ctile] + ks * 64);
                acc[ctile] = __builtin_amdgcn_mfma_f32_16x16x32_bf16(a, bfr, acc[ctile], 0, 0, 0);
            }
        }
        LAS3 float* E = (LAS3 float*)EZ;
#pragma unroll
        for (int ctile = 0; ctile < 3; ++ctile)
#pragma unroll
            for (int rg = 0; rg < 4; ++rg) E[(16 * ctile + lr) * 128 + 16 * wid + 4 * q + rg] = acc[ctile][rg];
    }
    __syncthreads();
    const float Ar = Aab[(tix * 64 + lane) * 2], Ai = Aab[(tix * 64 + lane) * 2 + 1];
    if (wid == 0) {
        const float Br = A64[(tix * 64 + lane) * 2], Bi = A64[(tix * 64 + lane) * 2 + 1];
        const LAS3 float* E = (const LAS3 float*)EZ;
        float xr = 0.f, xi = 0.f;
        for (int c = 0; c < 36; ++c) {
            *(float2*)(xs + c * 128 + 2 * lane) = make_float2(xr, xi);
            const float er = E[c * 128 + 2 * lane], ei = E[c * 128 + 2 * lane + 1];
            const float nr = Br * xr - Bi * xi + er, ni = Br * xi + Bi * xr + ei;
            xr = nr; xi = ni;
        }
    }
    __threadfence_block();
    __syncthreads();
    LAS3 unsigned char* Zw = EZ + wid * (16 * S5_ZROW * 2);
    bf16x8_t cmf[4];
#pragma unroll
    for (int ks = 0; ks < 4; ++ks) cmf[ks] = *(const LAS3 bf16x8_t*)(Cm + (lr * S5_CROW + 32 * ks + 8 * q) * 2);
    bf16x8_t kbr[16];
#pragma unroll
    for (int ks = 0; ks < 16; ++ks) kbr[ks] = *(const LAS3 bf16x8_t*)(Km + (lr * S5_KROW + 8 * q) * 2 + ks * 64);
    float2 xnext = *(const float2*)(xs + wid * 128 + 2 * lane);
    for (int c = wid; c < 36; c += 8) {
        const float2 x0 = xnext;
        if (c + 8 < 36) xnext = *(const float2*)(xs + (c + 8) * 128 + 2 * lane);
        float zr = Ar * x0.x - Ai * x0.y, zi = Ar * x0.y + Ai * x0.x;
#pragma unroll
        for (int rt = 0; rt < 4; ++rt) {
#pragma unroll
            for (int ii = 0; ii < 16; ++ii) {
                *(LAS3 unsigned*)(Zw + (ii * S5_ZROW + 2 * lane) * 2) = cvtpk(zr, zi);
                const float nr = Ar * zr - Ai * zi, ni = Ar * zi + Ai * zr; zr = nr; zi = ni;
            }
            asm volatile("s_waitcnt lgkmcnt(0)" ::: "memory");
            f32x4_t acc = (f32x4_t){0.f, 0.f, 0.f, 0.f};
#pragma unroll
            for (int ks = 0; ks < 4; ++ks) {
                const bf16x8_t a = *(const LAS3 bf16x8_t*)(Zw + (lr * S5_ZROW + 32 * ks + 8 * q) * 2);
                acc = __builtin_amdgcn_mfma_f32_16x16x32_bf16(a, cmf[ks], acc, 0, 0, 0);
            }
            const int irow = 16 * rt + lr;
            const LAS3 unsigned char* up = U + ((64 + 64 * c + irow - (q >> 1)) * 16 + 8 * (q & 1)) * 2;
            const LAS3 unsigned char* kp = Km + (lr * S5_KROW + 8 * q) * 2;
            f32x4_t acc1 = (f32x4_t){0.f, 0.f, 0.f, 0.f};
#pragma unroll
            for (int ks0 = 0; ks0 < 8 * rt + 8; ks0 += 8) {
                bf16x8_t av[8], kv[8];
#pragma unroll
                for (int j = 0; j < 8; ++j) { av[j] = *(const LAS3 bf16x8_t*)(up - (ks0 + j) * 64); if (ks0 + j < 16) kv[j] = kbr[ks0 + j]; else kv[j] = *(const LAS3 bf16x8_t*)(kp + (ks0 + j) * 64); }
#pragma unroll
                for (int j = 0; j < 8; ++j) {
                    const int ks = ks0 + j;
                    if (ks >= 8 * rt) {
                        const bool valid = (2 * ks + (q >> 1)) <= irow;
                        if (!valid) av[j] = (bf16x8_t){0, 0, 0, 0, 0, 0, 0, 0};
                    }
                    if (j & 1) acc1 = __builtin_amdgcn_mfma_f32_16x16x32_bf16(av[j], kv[j], acc1, 0, 0, 0);
                    else acc = __builtin_amdgcn_mfma_f32_16x16x32_bf16(av[j], kv[j], acc, 0, 0, 0);
                }
            }
            acc += acc1;
#pragma unroll
            for (int rg = 0; rg < 4; ++rg) {
                const int n = seq_token(64 * c + 16 * rt + 4 * q + rg, dir);
                ((bf16_t*)ys5)[((size_t)dir * TT + (size_t)b * NT + n) * 256 + g * 16 + lr] = f2bf(acc[rg]);
            }
            asm volatile("s_waitcnt lgkmcnt(0)" ::: "memory");
        }
    }
}

#define XB_TMO      128
#define XB_XCNT(j)  (256  + 64 * (j))
#define XB_XSUB(j)  (1280 + 64 * (j))
#define XB_XGEN(j)  (2304 + 64 * (j))
#define XB_TOP      3328
#define XB_TOPGEN   3392
#define XCD_BAR_WORDS 3456
#define XB_SPIN_CAP (1u << 22)
__device__ __forceinline__ unsigned xb_ld(unsigned* p)              { return __hip_atomic_load(p, __ATOMIC_RELAXED, __HIP_MEMORY_SCOPE_AGENT); }
__device__ __forceinline__ unsigned xb_add(unsigned* p, unsigned v) { return __hip_atomic_fetch_add(p, v, __ATOMIC_RELAXED, __HIP_MEMORY_SCOPE_AGENT); }
__device__ __forceinline__ unsigned xb_xcc_id() { return (unsigned)__builtin_amdgcn_s_getreg((3 << 11) | 20) & 0xFu; }
#define XB_SPIN(cond, bar) do { unsigned _sp = 0; while (cond) { __builtin_amdgcn_s_sleep(1); \
    if ((++_sp & 255u) == 0u) { if (xb_ld(&(bar)[XB_TMO])) break; if (_sp > XB_SPIN_CAP) { atomicAdd(&(bar)[XB_TMO], 1u); break; } } } } while (0)
struct XcdBarrier { unsigned* bar; unsigned x; volatile LAS3 unsigned* st; };
__device__ __forceinline__ XcdBarrier xcd_barrier_post(unsigned* bar, volatile LAS3 unsigned* st) {
    XcdBarrier b; b.bar = bar; b.x = xb_xcc_id(); b.st = st;
    if (threadIdx.x == 0) (void)xb_add(&bar[XB_XCNT(b.x)], 1u);
    return b;
}
__device__ __forceinline__ void xcd_barrier_complete(unsigned* bar, unsigned x, unsigned& nloc, unsigned& nx) {
    const unsigned G = gridDim.x * gridDim.y * gridDim.z;
    unsigned sum, cnt, mine, sp = 0u;
    for (;;) {
        sum = 0u; cnt = 0u; mine = 0u;
#pragma unroll
        for (unsigned j = 0; j < 16; ++j) { const unsigned c = xb_ld(&bar[XB_XCNT(j)]); sum += c; cnt += (c > 0u) ? 1u : 0u; mine = (j == x) ? c : mine; }
        if (sum == G) break;
        __builtin_amdgcn_s_sleep(1);
        if ((++sp & 255u) == 0u) { if (xb_ld(&bar[XB_TMO])) break; if (sp > XB_SPIN_CAP) { atomicAdd(&bar[XB_TMO], 1u); break; } }
    }
    nloc = mine > 0u ? mine : 1u; nx = cnt > 0u ? cnt : 1u;
}
__device__ __forceinline__ void xcd_barrier(const XcdBarrier& b) {
    asm volatile("s_waitcnt vmcnt(0)" ::: "memory");
    __syncthreads();
    if (threadIdx.x == 0) {
        unsigned* bar = b.bar;
        __builtin_amdgcn_s_waitcnt(0);
        unsigned nloc = b.st[0], nx = b.st[1];
        if (nloc == 0u) { xcd_barrier_complete(bar, b.x, nloc, nx); b.st[0] = nloc; b.st[1] = nx; }
        const unsigned old = xb_add(&bar[XB_XSUB(b.x)], 1u);
        const unsigned gen = old / nloc;
        if (old + 1u == (gen + 1u) * nloc) {
            __builtin_amdgcn_fence(__ATOMIC_RELEASE, "agent");
            asm volatile("s_waitcnt vmcnt(0)" ::: "memory");
            const unsigned og = xb_add(&bar[XB_TOP], 1u);
            const unsigned tg = og / nx;
            if (og + 1u == (tg + 1u) * nx) xb_add(&bar[XB_TOPGEN], 1u);
            else XB_SPIN(xb_ld(&bar[XB_TOPGEN]) == tg, bar);
            __builtin_amdgcn_fence(__ATOMIC_ACQUIRE, "agent");
            xb_add(&bar[XB_XGEN(b.x)], 1u);
            asm volatile("s_waitcnt vmcnt(0)" ::: "memory");
        } else {
            XB_SPIN(xb_ld(&bar[XB_XGEN(b.x)]) == gen, bar);
            __builtin_amdgcn_fence(__ATOMIC_ACQUIRE, "agent");
            asm volatile("s_waitcnt vmcnt(0)" ::: "memory");
        }
    }
    __syncthreads();
}

struct Params {
    const float *x, *c, *ctx, *c_ctx, *w_mod, *b_mod, *norm_w, *w_in, *w_out, *da_lambda, *da_subln, *ml_conv_w, *ml_conv_b, *ml_gate_b, *ml_norm,
                *mla_q_norm, *mla_w_uq, *mla_kv_norm, *mla_w_ukv, *s5_a_re, *s5_a_im, *s5_log_step, *s5_b_re, *s5_b_im, *s5_c_re, *s5_c_im, *s5_d, *s5_w_glu, *s5_b_glu,
                *moe_w_router, *moe_b_router, *moe_w_gate_up, *moe_b_gate_up, *moe_w_down, *moe_b_down;
    float* out;
    float *xall, *mod, *ropecs, *lamfull;
    bf16_t *w_in_t, *w_out_t, *wgu_t, *wdn_t, *wq_t, *wkv_t, *wglu_t;
    bf16_t *s5KmT, *s5Smat, *s5CmT; float *s5A, *s5A64, *s5xs;
    bf16_t *hbuf, *pb, *daQ, *daK, *daVt, *mQ, *mK, *mVt, *mlQ, *mlK, *mlKt, *mlVt; float *mlG, *hdir, *ys5;
    bf16_t *ycatb, *ob; float* osq; bf16_t* fb;
    int* top_e; float* top_g; int *posb, *tok_slot;
    int *cnt, *tile_e, *ntiles, *offs, *blkcnt;
    bf16_t *xg, *act, *yexp;
    unsigned* bar; int* queue;
};

template <class T> __device__ __forceinline__ T* uni_ptr(T* p) { const unsigned long long v = (unsigned long long)p; const unsigned lo = __builtin_amdgcn_readfirstlane((unsigned)v), hi = __builtin_amdgcn_readfirstlane((unsigned)(v >> 32)); return (T*)(__attribute__((address_space(1))) T*)(((unsigned long long)hi << 32) | lo); }
__device__ __forceinline__ void store_params(LAS3 Params* PL, const Params& P) {
    PL->x = P.x;
    PL->c = P.c;
    PL->ctx = P.ctx;
    PL->c_ctx = P.c_ctx;
    PL->w_mod = P.w_mod;
    PL->b_mod = P.b_mod;
    PL->norm_w = P.norm_w;
    PL->w_in = P.w_in;
    PL->w_out = P.w_out;
    PL->da_lambda = P.da_lambda;
    PL->da_subln = P.da_subln;
    PL->ml_conv_w = P.ml_conv_w;
    PL->ml_conv_b = P.ml_conv_b;
    PL->ml_gate_b = P.ml_gate_b;
    PL->ml_norm = P.ml_norm;
    PL->mla_q_norm = P.mla_q_norm;
    PL->mla_w_uq = P.mla_w_uq;
    PL->mla_kv_norm = P.mla_kv_norm;
    PL->mla_w_ukv = P.mla_w_ukv;
    PL->s5_a_re = P.s5_a_re;
    PL->s5_a_im = P.s5_a_im;
    PL->s5_log_step = P.s5_log_step;
    PL->s5_b_re = P.s5_b_re;
    PL->s5_b_im = P.s5_b_im;
    PL->s5_c_re = P.s5_c_re;
    PL->s5_c_im = P.s5_c_im;
    PL->s5_d = P.s5_d;
    PL->s5_w_glu = P.s5_w_glu;
    PL->s5_b_glu = P.s5_b_glu;
    PL->moe_w_router = P.moe_w_router;
    PL->moe_b_router = P.moe_b_router;
    PL->moe_w_gate_up = P.moe_w_gate_up;
    PL->moe_b_gate_up = P.moe_b_gate_up;
    PL->moe_w_down = P.moe_w_down;
    PL->moe_b_down = P.moe_b_down;
    PL->out = P.out;
    PL->xall = P.xall;
    PL->mod = P.mod;
    PL->ropecs = P.ropecs;
    PL->lamfull = P.lamfull;
    PL->w_in_t = P.w_in_t;
    PL->w_out_t = P.w_out_t;
    PL->wgu_t = P.wgu_t;
    PL->wdn_t = P.wdn_t;
    PL->wq_t = P.wq_t;
    PL->wkv_t = P.wkv_t;
    PL->wglu_t = P.wglu_t;
    PL->s5KmT = P.s5KmT;
    PL->s5Smat = P.s5Smat;
    PL->s5CmT = P.s5CmT;
    PL->s5A = P.s5A;
    PL->s5A64 = P.s5A64;
    PL->s5xs = P.s5xs;
    PL->hbuf = P.hbuf;
    PL->pb = P.pb;
    PL->daQ = P.daQ;
    PL->daK = P.daK;
    PL->daVt = P.daVt;
    PL->mQ = P.mQ;
    PL->mK = P.mK;
    PL->mVt = P.mVt;
    PL->mlQ = P.mlQ;
    PL->mlK = P.mlK;
    PL->mlKt = P.mlKt;
    PL->mlVt = P.mlVt;
    PL->mlG = P.mlG;
    PL->hdir = P.hdir;
    PL->ys5 = P.ys5;
    PL->ycatb = P.ycatb;
    PL->ob = P.ob;
    PL->osq = P.osq;
    PL->fb = P.fb;
    PL->top_e = P.top_e;
    PL->top_g = P.top_g;
    PL->posb = P.posb;
    PL->tok_slot = P.tok_slot;
    PL->cnt = P.cnt;
    PL->tile_e = P.tile_e;
    PL->ntiles = P.ntiles;
    PL->offs = P.offs;
    PL->blkcnt = P.blkcnt;
    PL->xg = P.xg;
    PL->act = P.act;
    PL->yexp = P.yexp;
    PL->bar = P.bar;
    PL->queue = P.queue;
}
__device__ __forceinline__ Params load_params(const LAS3 Params* PL) {
    Params Q;
    Q.x = uni_ptr(PL->x);
    Q.c = uni_ptr(PL->c);
    Q.ctx = uni_ptr(PL->ctx);
    Q.c_ctx = uni_ptr(PL->c_ctx);
    Q.w_mod = uni_ptr(PL->w_mod);
    Q.b_mod = uni_ptr(PL->b_mod);
    Q.norm_w = uni_ptr(PL->norm_w);
    Q.w_in = uni_ptr(PL->w_in);
    Q.w_out = uni_ptr(PL->w_out);
    Q.da_lambda = uni_ptr(PL->da_lambda);
    Q.da_subln = uni_ptr(PL->da_subln);
    Q.ml_conv_w = uni_ptr(PL->ml_conv_w);
    Q.ml_conv_b = uni_ptr(PL->ml_conv_b);
    Q.ml_gate_b = uni_ptr(PL->ml_gate_b);
    Q.ml_norm = uni_ptr(PL->ml_norm);
    Q.mla_q_norm = uni_ptr(PL->mla_q_norm);
    Q.mla_w_uq = uni_ptr(PL->mla_w_uq);
    Q.mla_kv_norm = uni_ptr(PL->mla_kv_norm);
    Q.mla_w_ukv = uni_ptr(PL->mla_w_ukv);
    Q.s5_a_re = uni_ptr(PL->s5_a_re);
    Q.s5_a_im = uni_ptr(PL->s5_a_im);
    Q.s5_log_step = uni_ptr(PL->s5_log_step);
    Q.s5_b_re = uni_ptr(PL->s5_b_re);
    Q.s5_b_im = uni_ptr(PL->s5_b_im);
    Q.s5_c_re = uni_ptr(PL->s5_c_re);
    Q.s5_c_im = uni_ptr(PL->s5_c_im);
    Q.s5_d = uni_ptr(PL->s5_d);
    Q.s5_w_glu = uni_ptr(PL->s5_w_glu);
    Q.s5_b_glu = uni_ptr(PL->s5_b_glu);
    Q.moe_w_router = uni_ptr(PL->moe_w_router);
    Q.moe_b_router = uni_ptr(PL->moe_b_router);
    Q.moe_w_gate_up = uni_ptr(PL->moe_w_gate_up);
    Q.moe_b_gate_up = uni_ptr(PL->moe_b_gate_up);
    Q.moe_w_down = uni_ptr(PL->moe_w_down);
    Q.moe_b_down = uni_ptr(PL->moe_b_down);
    Q.out = uni_ptr(PL->out);
    Q.xall = uni_ptr(PL->xall);
    Q.mod = uni_ptr(PL->mod);
    Q.ropecs = uni_ptr(PL->ropecs);
    Q.lamfull = uni_ptr(PL->lamfull);
    Q.w_in_t = uni_ptr(PL->w_in_t);
    Q.w_out_t = uni_ptr(PL->w_out_t);
    Q.wgu_t = uni_ptr(PL->wgu_t);
    Q.wdn_t = uni_ptr(PL->wdn_t);
    Q.wq_t = uni_ptr(PL->wq_t);
    Q.wkv_t = uni_ptr(PL->wkv_t);
    Q.wglu_t = uni_ptr(PL->wglu_t);
    Q.s5KmT = uni_ptr(PL->s5KmT);
    Q.s5Smat = uni_ptr(PL->s5Smat);
    Q.s5CmT = uni_ptr(PL->s5CmT);
    Q.s5A = uni_ptr(PL->s5A);
    Q.s5A64 = uni_ptr(PL->s5A64);
    Q.s5xs = uni_ptr(PL->s5xs);
    Q.hbuf = uni_ptr(PL->hbuf);
    Q.pb = uni_ptr(PL->pb);
    Q.daQ = uni_ptr(PL->daQ);
    Q.daK = uni_ptr(PL->daK);
    Q.daVt = uni_ptr(PL->daVt);
    Q.mQ = uni_ptr(PL->mQ);
    Q.mK = uni_ptr(PL->mK);
    Q.mVt = uni_ptr(PL->mVt);
    Q.mlQ = uni_ptr(PL->mlQ);
    Q.mlK = uni_ptr(PL->mlK);
    Q.mlKt = uni_ptr(PL->mlKt);
    Q.mlVt = uni_ptr(PL->mlVt);
    Q.mlG = uni_ptr(PL->mlG);
    Q.hdir = uni_ptr(PL->hdir);
    Q.ys5 = uni_ptr(PL->ys5);
    Q.ycatb = uni_ptr(PL->ycatb);
    Q.ob = uni_ptr(PL->ob);
    Q.osq = uni_ptr(PL->osq);
    Q.fb = uni_ptr(PL->fb);
    Q.top_e = uni_ptr(PL->top_e);
    Q.top_g = uni_ptr(PL->top_g);
    Q.posb = uni_ptr(PL->posb);
    Q.tok_slot = uni_ptr(PL->tok_slot);
    Q.cnt = uni_ptr(PL->cnt);
    Q.tile_e = uni_ptr(PL->tile_e);
    Q.ntiles = uni_ptr(PL->ntiles);
    Q.offs = uni_ptr(PL->offs);
    Q.blkcnt = uni_ptr(PL->blkcnt);
    Q.xg = uni_ptr(PL->xg);
    Q.act = uni_ptr(PL->act);
    Q.yexp = uni_ptr(PL->yexp);
    Q.bar = uni_ptr(PL->bar);
    Q.queue = uni_ptr(PL->queue);
    return Q;
}
constexpr int MK_LDS_MAIN = 147968;
constexpr int MK_LDS_BYTES = MK_LDS_MAIN + 64 + 1024;
enum { PH_SETUP = 0, PH_H0 = 1, PH_LAYER0 = 2, PH_PER_LAYER = 10, PH_TOTAL = 22 };
enum { L_GEMM_IN = 0, L_PREP, L_MIX, L_FINISH, L_GEMM_OUT, L_POST, L_SCATTER, L_GEMM_GU, L_GEMM_DN, L_COMBINE };

__device__ __forceinline__ void conv_tile(LAS3 float* tile, int lane, const float* __restrict__ W, int N, bf16_t* __restrict__ WT, int ldt, int tn, int tk, int mode) {
    const int n0 = tn * 64, k0 = tk * 64;
    const int kq = lane >> 4, n4 = (lane & 15) * 4;
    const int nl = (n0 + n4 < N) ? n0 + n4 : N - 4;
    const float* wp = W + (size_t)(k0 + kq) * N + nl;
    float4 v[16];
#pragma unroll
    for (int j = 0; j < 16; ++j) v[j] = *(const float4*)(wp + (size_t)(4 * j) * N);
#pragma unroll
    for (int j = 0; j < 16; ++j) { LAS3 float* tp = tile + (4 * j + kq) * 65 + n4; tp[0] = v[j].x; tp[1] = v[j].y; tp[2] = v[j].z; tp[3] = v[j].w; }
    asm volatile("s_waitcnt lgkmcnt(0)" ::: "memory");
    {
        const int c = lane & 7;
#pragma unroll
        for (int jn = 0; jn < 8; ++jn) {
            const int n = (lane >> 3) + 8 * jn, gn = n0 + n;
            if (gn < N) {
                int dr = gn;
                if (mode == 1) dr = (gn < 1024) ? ((gn >> 7) * 256 + (gn & 127)) : ((((gn - 1024) >> 7) * 256) + 128 + ((gn - 1024) & 127));
                const LAS3 float* tp = tile + (8 * c) * 65 + n;
                u32x4_t o;
                o.x = pk2bf(tp[0 * 65], tp[1 * 65]); o.y = pk2bf(tp[2 * 65], tp[3 * 65]); o.z = pk2bf(tp[4 * 65], tp[5 * 65]); o.w = pk2bf(tp[6 * 65], tp[7 * 65]);
                *(u32x4_t*)(WT + (size_t)dr * ldt + k0 + 8 * c) = o;
            }
        }
    }
    asm volatile("s_waitcnt lgkmcnt(0)" ::: "memory");
}
constexpr int CV_IN = 38 * 16 * 2, CV_OUT = 256 * 2, CV_GU = 512 * 64, CV_DN = 256 * 64, CV_Q = 18 * 2, CV_KV = 16 * 2, CV_GLU = 16 * 2;
constexpr int CV_TOTAL = CV_IN + CV_OUT + CV_GU + CV_DN + CV_Q + CV_KV + CV_GLU;
__device__ __forceinline__ void conv_dispatch(const Params& P, LAS3 float* tile, int st, int it) {
    const float* W = nullptr; bf16_t* WT = nullptr; int N = 64, ldt = 64, tn = 0, tk = 0, mode = 0;
    if (it < CV_TOTAL) {
        int r = it;
        if (r < CV_IN) { const int bt = r / 608, q = r % 608; W = P.w_in + (size_t)bt * 1024 * DINC; N = DINC; WT = P.w_in_t + (size_t)bt * 2560 * 1024; ldt = 1024; tn = q % 38; tk = q / 38; }
        else if ((r -= CV_IN) < CV_OUT) { const int bt = r / 256, q = r % 256; W = P.w_out + (size_t)bt * 1024 * 1024; N = 1024; WT = P.w_out_t + (size_t)bt * 1024 * 1024; ldt = 1024; tn = q % 16; tk = q / 16; }
        else if ((r -= CV_OUT) < CV_GU) { const int bt = r / 512, q = r % 512; W = P.moe_w_gate_up + (size_t)bt * 1024 * 2048; N = 2048; WT = P.wgu_t + (size_t)bt * 2048 * 1024; ldt = 1024; tn = q % 32; tk = q / 32; mode = 1; }
        else if ((r -= CV_GU) < CV_DN) { const int bt = r / 256, q = r % 256; W = P.moe_w_down + (size_t)bt * 1024 * 1024; N = 1024; WT = P.wdn_t + (size_t)bt * 1024 * 1024; ldt = 1024; tn = q % 16; tk = q / 16; }
        else if ((r -= CV_DN) < CV_Q) { const int bt = r / 18, q = r % 18; W = P.mla_w_uq + (size_t)bt * 192 * 384; N = 384; WT = P.wq_t + (size_t)bt * 384 * 192; ldt = 192; tn = q % 6; tk = q / 6; }
        else if ((r -= CV_Q) < CV_KV) { const int bt = r / 16, q = r % 16; W = P.mla_w_ukv + (size_t)bt * 128 * 512; N = 512; WT = P.wkv_t + (size_t)bt * 512 * 128; ldt = 128; tn = q % 8; tk = q / 8; }
        else { r -= CV_KV; const int bt = r / 16, q = r % 16; W = P.s5_w_glu + (size_t)bt * 256 * 256; N = 256; WT = P.wglu_t + (size_t)bt * 256 * 256; ldt = 256; tn = q % 4; tk = q / 4; }
    }
    if (W) conv_tile(tile, st, W, N, WT, ldt, tn, tk, mode);
}
__device__ __forceinline__ void phase_setup(const Params& P, LAS3 unsigned char* lds) {
    const int tid = opaque_tid(), G = gridDim.x, bid = blockIdx.x;
    for (int it = bid; it < 192; it += G) {
        LAS3 float* sl = (LAS3 float*)lds;
        LAS3 float* red = sl + 9 * 1024;
        __syncthreads();
        for (int i = tid; i < 9 * 1024; i += 512) { const int r = i >> 10, k = i & 1023; sl[i] = siluf_((r < 8) ? P.c[r * 1024 + k] : P.c_ctx[k]); }
        __syncthreads();
        const int l = it / 96, j = (it % 96) * 64 + (tid & 63), kp = tid >> 6;
        const float* w = P.w_mod + (size_t)l * 1024 * 6144 + j;
        float acc[9];
#pragma unroll
        for (int r = 0; r < 9; ++r) acc[r] = 0.f;
#pragma unroll 8
        for (int k = kp * 128; k < kp * 128 + 128; ++k) {
            const float wv = w[(size_t)k * 6144];
#pragma unroll
            for (int r = 0; r < 9; ++r) acc[r] += sl[r * 1024 + k] * wv;
        }
#pragma unroll
        for (int r = 0; r < 9; ++r) red[(kp * 9 + r) * 64 + (tid & 63)] = acc[r];
        __syncthreads();
        for (int i = tid; i < 9 * 64; i += 512) {
            const int r = i >> 6, cc = i & 63; float sacc = 0.f;
#pragma unroll
            for (int k2 = 0; k2 < 8; ++k2) sacc += red[(k2 * 9 + r) * 64 + cc];
            const int jj = (it % 96) * 64 + cc;
            P.mod[((size_t)l * 9 + r) * 6144 + jj] = sacc + P.b_mod[l * 6144 + jj];
        }
    }
    for (int i = bid * 512 + tid; i < NS * 16; i += G * 512) {
        const int pos = i >> 4, j = i & 15; const int row = pos / 64, col = pos % 64;
        const float inv = exp2f(-(float)(j & 7) * 1.6609640474436813f), ang = (float)((j < 8) ? row : col) * inv;
        P.ropecs[i * 2] = cosf(ang); P.ropecs[i * 2 + 1] = sinf(ang);
    }
    if (bid == G - 1 && tid < 2) {
        const int l = tid; const float* lam = P.da_lambda + l * 128; float s1 = 0.f, s2 = 0.f;
        for (int i = 0; i < 32; ++i) { s1 += lam[i] * lam[32 + i]; s2 += lam[64 + i] * lam[96 + i]; }
        P.lamfull[l] = expf(s1) - expf(s2) + ((l == 0) ? 0.2f : 0.35550906759096927f);
    }
    for (int it = G - 1 - bid; it < 64; it += G)
        s5_setup_item(lds, it, P.s5_a_re, P.s5_a_im, P.s5_log_step, P.s5_b_re, P.s5_b_im, P.s5_c_re, P.s5_c_im, P.s5KmT, P.s5Smat, P.s5CmT, P.s5A, P.s5A64);
    for (int i = bid * 512 + tid; i < 2 * 144 * 1024 / 8; i += G * 512) {
        const int l = i / (144 * 128), r = i % (144 * 128);
        *(u32x4_t*)(P.w_in_t + ((size_t)l * 2560 + DINC) * 1024 + (size_t)r * 8) = (u32x4_t){0u, 0u, 0u, 0u};
    }
    __syncthreads();
    {
        const int wv = __builtin_amdgcn_readfirstlane(tid >> 6), lane = tid & 63;
        LAS3 float* tile = (LAS3 float*)lds + wv * (64 * 65);
        for (;;) {
            int base = 0;
            if (lane == 0) base = atomicAdd(P.queue + 2, 4);
            base = __builtin_amdgcn_readfirstlane(base);
            if (base >= CV_TOTAL) break;
            for (int it = base; it < base + 4 && it < CV_TOTAL; ++it) conv_dispatch(P, tile, lane, it);
        }
    }
}

__device__ __forceinline__ void row_modulate_store(const float (&xv)[16], const LAS3 float* nw, const LAS3 float* modr, bf16_t* __restrict__ dst, int lane) {
    float ss = 0.f;
#pragma unroll
    for (int i = 0; i < 16; ++i) ss += xv[i] * xv[i];
    ss = wave_sum(ss);
    const float rstd = rsqrtf(ss * (1.f / DM) + 1e-6f);
#pragma unroll
    for (int j = 0; j < 4; ++j) {
        const int d = j * 256 + lane * 4;
        const f32x4_t w = *(const LAS3 f32x4_t*)(nw + d), sh = *(const LAS3 f32x4_t*)(modr + d), sc = *(const LAS3 f32x4_t*)(modr + 1024 + d);
        const float o0 = xv[j * 4 + 0] * rstd * w[0] * (1.f + sc[0]) + sh[0], o1 = xv[j * 4 + 1] * rstd * w[1] * (1.f + sc[1]) + sh[1];
        const float o2 = xv[j * 4 + 2] * rstd * w[2] * (1.f + sc[2]) + sh[2], o3 = xv[j * 4 + 3] * rstd * w[3] * (1.f + sc[3]) + sh[3];
        *(uint2*)(dst + d) = make_uint2(cvtpk(o0, o1), cvtpk(o2, o3));
    }
}
__device__ __forceinline__ void phase_h0(const Params& P, LAS3 unsigned char* lds) {
    const int tid = opaque_tid(); const int lane = tid & 63, gw = blockIdx.x * 8 + (tid >> 6), NW = gridDim.x * 8;
    LAS3 float* cw = (LAS3 float*)lds;
    for (int i = tid; i < 256; i += 512) *(LAS3 f32x4_t*)(cw + i * 4) = *(const f32x4_t*)(P.norm_w + i * 4);
    for (int i = tid; i < 9 * 512; i += 512) { const int r = i >> 9, k = i & 511; *(LAS3 f32x4_t*)(cw + 1024 + r * 2048 + k * 4) = *(const f32x4_t*)(P.mod + (size_t)r * 6144 + k * 4); }
    __syncthreads();
    for (int t = gw; t < TT; t += NW) {
        const int b = t / NT, n = t % NT;
        const float* src = (n < NC) ? P.ctx + ((size_t)b * NC + n) * DM : P.x + ((size_t)b * NS + (n - NC)) * DM;
        float xv[16];
#pragma unroll
        for (int j = 0; j < 4; ++j) { const float4 v = *(const float4*)(src + j * 256 + lane * 4); xv[j * 4] = v.x; xv[j * 4 + 1] = v.y; xv[j * 4 + 2] = v.z; xv[j * 4 + 3] = v.w; }
        row_modulate_store(xv, cw, cw + 1024 + ((n < NC) ? 8 : b) * 2048, P.hbuf + (size_t)t * DM, lane);
    }
}

constexpr int TS_ROW = 264;
__device__ __forceinline__ void write_transposed(const LAS3 bf16_t* ts, bf16_t* __restrict__ dst, int b, int n0, int tid) {
    const int ch = tid & 255, hf = tid >> 8;
    bf16_t* vp = dst + (((size_t)b * 4 + (ch >> 6)) * 64 + (ch & 63)) * NT + n0 + hf * 32;
#pragma unroll
    for (int tc = 0; tc < 4; ++tc) {
        const LAS3 bf16_t* tp = ts + (hf * 32 + tc * 8) * TS_ROW + ch;
        u32x4_t o;
        o.x = (unsigned)tp[0] | ((unsigned)tp[TS_ROW] << 16); o.y = (unsigned)tp[2 * TS_ROW] | ((unsigned)tp[3 * TS_ROW] << 16);
        o.z = (unsigned)tp[4 * TS_ROW] | ((unsigned)tp[5 * TS_ROW] << 16); o.w = (unsigned)tp[6 * TS_ROW] | ((unsigned)tp[7 * TS_ROW] << 16);
        *(u32x4_t*)(vp + tc * 8) = o;
    }
}
__device__ __forceinline__ void unpack8(const u32x4_t v, float (&f)[8]) {
    f[0] = __uint_as_float(v.x << 16); f[1] = __uint_as_float(v.x & 0xFFFF0000u); f[2] = __uint_as_float(v.y << 16); f[3] = __uint_as_float(v.y & 0xFFFF0000u);
    f[4] = __uint_as_float(v.z << 16); f[5] = __uint_as_float(v.z & 0xFFFF0000u); f[6] = __uint_as_float(v.w << 16); f[7] = __uint_as_float(v.w & 0xFFFF0000u);
}
__device__ __forceinline__ u32x4_t pack8(const float (&f)[8]) { return (u32x4_t){cvtpk(f[0], f[1]), cvtpk(f[2], f[3]), cvtpk(f[4], f[5]), cvtpk(f[6], f[7])}; }

__device__ __forceinline__ void prep_da(const Params& P, LAS3 unsigned char* lds, int tile) {
    const int tid = opaque_tid();
    const int t0 = tile * 64, b = t0 / NT, n0 = t0 % NT;
    LAS3 bf16_t* vs = (LAS3 bf16_t*)lds;
    const float qscale = 0.17677669529663687f * 1.4426950408889634f;
    const bf16_t* __restrict__ pbr = P.pb; const float* __restrict__ rcs = P.ropecs;
    __syncthreads();
    {
        u32x4_t vv[4];
#pragma unroll
        for (int u = 0; u < 4; ++u) { const int id = tid + 512 * u, i = id >> 5, cg = id & 31; vv[u] = *(const u32x4_t*)(pbr + (size_t)(t0 + i) * DIN + P_DAV + cg * 8); }
#pragma unroll
        for (int u = 0; u < 4; ++u) { const int id = tid + 512 * u, i = id >> 5, cg = id & 31; *(LAS3 u32x4_t*)(vs + i * TS_ROW + cg * 8) = vv[u]; }
    }
#pragma unroll
    for (int u0 = 0; u0 < 4; u0 += 2) {
        u32x4_t lo[2], hi[2]; float4 cs[2][4];
#pragma unroll
        for (int u = 0; u < 2; ++u) {
            const int id = tid + 512 * (u0 + u), i = id >> 5, pu = id & 31, isk = pu >> 4, blk = (pu >> 1) & 7, pr = pu & 1;
            const bf16_t* src = pbr + (size_t)(t0 + i) * DIN + (isk ? P_DAK : P_DAQ) + blk * 32 + pr * 8;
            lo[u] = *(const u32x4_t*)src; hi[u] = *(const u32x4_t*)(src + 16);
            const int pos = max(n0 + i - NC, 0);
            const float4* cp = (const float4*)(rcs + (pos * 16 + pr * 8) * 2);
            cs[u][0] = cp[0]; cs[u][1] = cp[1]; cs[u][2] = cp[2]; cs[u][3] = cp[3];
        }
#pragma unroll
        for (int u = 0; u < 2; ++u) {
            const int id = tid + 512 * (u0 + u), i = id >> 5, pu = id & 31, isk = pu >> 4, blk = (pu >> 1) & 7, pr = pu & 1;
            const int n = n0 + i; const bool lat = n >= NC;
            float fl[8], fh[8], ol[8], oh[8];
            unpack8(lo[u], fl); unpack8(hi[u], fh);
            const float cc[8] = {cs[u][0].x, cs[u][0].z, cs[u][1].x, cs[u][1].z, cs[u][2].x, cs[u][2].z, cs[u][3].x, cs[u][3].z};
            const float sn[8] = {cs[u][0].y, cs[u][0].w, cs[u][1].y, cs[u][1].w, cs[u][2].y, cs[u][2].w, cs[u][3].y, cs[u][3].w};
            const float sc = isk ? 1.f : qscale;
#pragma unroll
            for (int e = 0; e < 8; ++e) {
                const float c1 = lat ? cc[e] : 1.f, s1 = lat ? sn[e] : 0.f;
                ol[e] = (fl[e] * c1 - fh[e] * s1) * sc; oh[e] = (fh[e] * c1 + fl[e] * s1) * sc;
            }
            bf16_t* dst = (isk ? P.daK : P.daQ) + (((size_t)b * 4 + (blk >> 1)) * NT + n) * 64 + (blk & 1) * 32 + pr * 8;
            *(u32x4_t*)dst = pack8(ol); *(u32x4_t*)(dst + 16) = pack8(oh);
        }
    }
    __syncthreads();
    write_transposed(vs, P.daVt, b, n0, tid);
}
__device__ __forceinline__ void prep_ml(const Params& P, LAS3 unsigned char* lds, int tile, int l) {
    const int tid = opaque_tid();
    const int t0 = tile * 64, b = t0 / NT, n0 = t0 % NT;
    LAS3 bf16_t* ks = (LAS3 bf16_t*)lds; LAS3 bf16_t* vs = ks + 64 * TS_ROW; LAS3 float* cwl = (LAS3 float*)(vs + 64 * TS_ROW);
    const int seg_lo = (n0 < NC) ? 0 : NC, seg_hi = (n0 < NC) ? NC - 1 : NT - 1;
    const bf16_t* __restrict__ pbr = P.pb;
    __syncthreads();
    for (int i = tid; i < 2048; i += 512) cwl[i] = (i < 1536) ? P.ml_conv_w[l * 1536 + i] : P.ml_conv_b[l * 512 + (i - 1536)];
    {
        u32x4_t vv[4];
#pragma unroll
        for (int u = 0; u < 4; ++u) { const int id = tid + 512 * u, i = id >> 5, cg = id & 31; vv[u] = *(const u32x4_t*)(pbr + (size_t)(t0 + i) * DIN + P_MLV + cg * 8); }
#pragma unroll
        for (int u = 0; u < 4; ++u) { const int id = tid + 512 * u, i = id >> 5, cg = id & 31; *(LAS3 u32x4_t*)(vs + i * TS_ROW + cg * 8) = vv[u]; }
        if (tid < 128) {
            const int i = tid >> 1, hf = tid & 1; float g[8];
            unpack8(*(const u32x4_t*)(pbr + (size_t)(t0 + i) * DIN + P_MLG + hf * 8), g);
#pragma unroll
            for (int e = 0; e < 8; ++e) { const int c = hf * 8 + e; g[e] += P.ml_gate_b[l * 16 + c]; if ((c >> 2) & 1) g[e] = logsigmoidf_(g[e]); }
            float* gp = P.mlG + ((size_t)t0 + i) * 16 + hf * 8;
            *(float4*)gp = make_float4(g[0], g[1], g[2], g[3]); *(float4*)(gp + 4) = make_float4(g[4], g[5], g[6], g[7]);
        }
    }
    __syncthreads();
#pragma unroll 1
    for (int u0 = 0; u0 < 8; u0 += 2) {
        u32x4_t xm[2], x0[2], xp[2];
#pragma unroll
        for (int u = 0; u < 2; ++u) {
            const int id = tid + 512 * (u0 + u), i = id >> 6, cg = id & 63, n = n0 + i;
            const int nm = max(n - 1, seg_lo), np = min(n + 1, seg_hi);
            const bf16_t* base = pbr + (size_t)b * NT * DIN + P_MLQK + cg * 8;
            xm[u] = *(const u32x4_t*)(base + (size_t)nm * DIN); x0[u] = *(const u32x4_t*)(base + (size_t)n * DIN); xp[u] = *(const u32x4_t*)(base + (size_t)np * DIN);
        }
#pragma unroll
        for (int u = 0; u < 2; ++u) {
            const int id = tid + 512 * (u0 + u), i = id >> 6, cg = id & 63, n = n0 + i;
            const float m0 = (n - 1 >= seg_lo) ? 1.f : 0.f, m2 = (n + 1 <= seg_hi) ? 1.f : 0.f;
            float a[8], c0[8], d[8], y[8];
            unpack8(xm[u], a); unpack8(x0[u], c0); unpack8(xp[u], d);
            const LAS3 float* w = cwl + cg * 8;
#pragma unroll
            for (int e = 0; e < 8; ++e) {
                float v = w[1536 + e] + a[e] * w[e] * m0 + c0[e] * w[512 + e] + d[e] * w[1024 + e] * m2;
                v = siluf_(v); if (cg >= 32) v *= 0.125f;
                y[e] = v;
            }
            const u32x4_t o = pack8(y);
            const int cc = (cg & 31) * 8;
            bf16_t* dst = ((cg < 32) ? P.mlQ : P.mlK) + (((size_t)b * 4 + (cc >> 6)) * NT + n) * 64 + (cc & 63);
            *(u32x4_t*)dst = o;
            if (cg >= 32) *(LAS3 u32x4_t*)(ks + i * TS_ROW + cc) = o;
        }
    }
    __syncthreads();
    write_transposed(ks, P.mlKt, b, n0, tid);
    write_transposed(vs, P.mlVt, b, n0, tid);
}
__device__ __forceinline__ void prep_mla(const Params& P, LAS3 unsigned char* lds, int tile, int l) {
    const int tid = opaque_tid(), wid = tid >> 6, lane = tid & 63, lr = lane & 15, q = lane >> 4;
    const int t0 = tile * 64, b = t0 / NT, n0 = t0 % NT;
    constexpr int AROW = 328;
    LAS3 bf16_t* As = (LAS3 bf16_t*)lds;
    const float qscale = 0.10206207261596575f * 1.4426950408889634f;
    const float* qn = P.mla_q_norm + l * 192; const float* kvn = P.mla_kv_norm + l * 128;
    const bf16_t* __restrict__ pbr = P.pb; bf16_t* __restrict__ oMK = P.mK; const float* __restrict__ rcs = P.ropecs;
    __syncthreads();
    {
        const int i = tid >> 3, sidx = tid & 7;
        const bf16_t* pr = pbr + (size_t)(t0 + i) * DIN;
        u32x4_t cqv[3], ckv[2];
#pragma unroll
        for (int u = 0; u < 3; ++u) cqv[u] = *(const u32x4_t*)(pr + P_CQ + (sidx + 8 * u) * 8);
#pragma unroll
        for (int u = 0; u < 2; ++u) ckv[u] = *(const u32x4_t*)(pr + P_CKV + (sidx + 8 * u) * 8);
        float fq[3][8], fk[2][8]; float sq = 0.f, sk = 0.f;
#pragma unroll
        for (int u = 0; u < 3; ++u) { unpack8(cqv[u], fq[u]);
#pragma unroll
            for (int e = 0; e < 8; ++e) sq += fq[u][e] * fq[u][e]; }
#pragma unroll
        for (int u = 0; u < 2; ++u) { unpack8(ckv[u], fk[u]);
#pragma unroll
            for (int e = 0; e < 8; ++e) sk += fk[u][e] * fk[u][e]; }
#pragma unroll
        for (int o = 1; o < 8; o <<= 1) { sq += __shfl_xor(sq, o); sk += __shfl_xor(sk, o); }
        const float rq = rsqrtf(sq * (1.f / 192.f) + 1e-6f), rk = rsqrtf(sk * (1.f / 128.f) + 1e-6f);
#pragma unroll
        for (int u = 0; u < 3; ++u) { const int c0 = (sidx + 8 * u) * 8; float o[8];
#pragma unroll
            for (int e = 0; e < 8; ++e) o[e] = fq[u][e] * rq * qn[c0 + e];
            *(LAS3 u32x4_t*)(As + i * AROW + c0) = pack8(o); }
#pragma unroll
        for (int u = 0; u < 2; ++u) { const int c0 = (sidx + 8 * u) * 8; float o[8];
#pragma unroll
            for (int e = 0; e < 8; ++e) o[e] = fk[u][e] * rk * kvn[c0 + e];
            *(LAS3 u32x4_t*)(As + i * AROW + 192 + c0) = pack8(o); }
    }
    if (tid < 256) {
        const int i = tid >> 2, c = tid & 3, n = n0 + i; const bool lat = n >= NC;
        const bf16_t* pr = pbr + (size_t)(t0 + i) * DIN + P_KR;
        const u32x4_t kav = *(const u32x4_t*)(pr + 8 * c), kbv = *(const u32x4_t*)(pr + 8 * (c ^ 2));
        const int pos = max(n - NC, 0);
        const float4* cp = (const float4*)(rcs + (pos * 16 + 8 * (c & 1)) * 2);
        const float4 c0 = cp[0], c1 = cp[1], c2 = cp[2], c3 = cp[3];
        const float sg = (c < 2) ? -1.f : 1.f;
        float ka[8], kb2[8], ko[8];
        unpack8(kav, ka); unpack8(kbv, kb2);
#define RK_(e, cc, ss) ko[e] = ka[e] * (lat ? (cc) : 1.f) + kb2[e] * (lat ? (ss) * sg : 0.f)
        RK_(0, c0.x, c0.y); RK_(1, c0.z, c0.w); RK_(2, c1.x, c1.y); RK_(3, c1.z, c1.w); RK_(4, c2.x, c2.y); RK_(5, c2.z, c2.w); RK_(6, c3.x, c3.y); RK_(7, c3.z, c3.w);
#undef RK_
        const u32x4_t ov = pack8(ko);
#pragma unroll
        for (int hh = 0; hh < 4; ++hh) *(u32x4_t*)(oMK + (((size_t)b * 4 + hh) * NT + n) * 96 + 64 + 8 * c) = ov;
    }
    __syncthreads();
    const int h = wid >> 1;
    if ((wid & 1) == 0) {
        const bf16_t* wt = P.wq_t + (size_t)l * 384 * 192;
        f32x4_t acc[4][6];
#pragma unroll
        for (int rt = 0; rt < 4; ++rt)
#pragma unroll
            for (int ct = 0; ct < 6; ++ct) acc[rt][ct] = (f32x4_t){0.f, 0.f, 0.f, 0.f};
#pragma unroll
        for (int ks = 0; ks < 6; ++ks) {
            bf16x8_t a[4];
#pragma unroll
            for (int rt = 0; rt < 4; ++rt) a[rt] = *(const LAS3 bf16x8_t*)(As + (16 * rt + lr) * AROW + 32 * ks + 8 * q);
#pragma unroll
            for (int ct = 0; ct < 6; ++ct) {
                const bf16x8_t bb = *(const bf16x8_t*)(wt + (size_t)(h * 96 + 16 * ct + lr) * 192 + 32 * ks + 8 * q);
#pragma unroll
                for (int rt = 0; rt < 4; ++rt) acc[rt][ct] = __builtin_amdgcn_mfma_f32_16x16x32_bf16(bb, a[rt], acc[rt][ct], 0, 0, 0);
            }
        }
#pragma unroll
        for (int rt = 0; rt < 4; ++rt) {
            const int n = n0 + 16 * rt + lr;
            bf16_t* qp = P.mQ + (((size_t)b * 4 + h) * NT + n) * 96;
#pragma unroll
            for (int ct = 0; ct < 4; ++ct)
                *(uint2*)(qp + 16 * ct + 4 * q) = make_uint2(cvtpk(acc[rt][ct][0] * qscale, acc[rt][ct][1] * qscale), cvtpk(acc[rt][ct][2] * qscale, acc[rt][ct][3] * qscale));
            f32x4_t x1 = acc[rt][4], x2 = acc[rt][5];
            if (n >= NC) {
                const float4* cp = (const float4*)(rcs + ((n - NC) * 16 + 4 * q) * 2);
                const float4 ca = cp[0], cb = cp[1];
                const f32x4_t co = (f32x4_t){ca.x, ca.z, cb.x, cb.z}, si = (f32x4_t){ca.y, ca.w, cb.y, cb.w};
                const f32x4_t o1 = x1 * co - x2 * si, o2 = x2 * co + x1 * si; x1 = o1; x2 = o2;
            }
            *(uint2*)(qp + 64 + 4 * q) = make_uint2(cvtpk(x1[0] * qscale, x1[1] * qscale), cvtpk(x1[2] * qscale, x1[3] * qscale));
            *(uint2*)(qp + 80 + 4 * q) = make_uint2(cvtpk(x2[0] * qscale, x2[1] * qscale), cvtpk(x2[2] * qscale, x2[3] * qscale));
        }
    } else {
        const bf16_t* wt = P.wkv_t + (size_t)l * 512 * 128;
#pragma unroll
        for (int pass = 0; pass < 2; ++pass) {
            f32x4_t acc[4][4];
#pragma unroll
            for (int rt = 0; rt < 4; ++rt)
#pragma unroll
                for (int ct = 0; ct < 4; ++ct) acc[rt][ct] = (f32x4_t){0.f, 0.f, 0.f, 0.f};
#pragma unroll
            for (int ks = 0; ks < 4; ++ks) {
                bf16x8_t a[4];
#pragma unroll
                for (int rt = 0; rt < 4; ++rt) a[rt] = *(const LAS3 bf16x8_t*)(As + (16 * rt + lr) * AROW + 192 + 32 * ks + 8 * q);
#pragma unroll
                for (int ct = 0; ct < 4; ++ct) {
                    const bf16x8_t bb = *(const bf16x8_t*)(wt + (size_t)(h * 128 + 16 * (4 * pass + ct) + lr) * 128 + 32 * ks + 8 * q);
#pragma unroll
                    for (int rt = 0; rt < 4; ++rt)
                        acc[rt][ct] = (pass == 0) ? __builtin_amdgcn_mfma_f32_16x16x32_bf16(bb, a[rt], acc[rt][ct], 0, 0, 0) : __builtin_amdgcn_mfma_f32_16x16x32_bf16(a[rt], bb, acc[rt][ct], 0, 0, 0);
                }
            }
#pragma unroll
            for (int rt = 0; rt < 4; ++rt) {
                if (pass == 0) {
                    const int n = n0 + 16 * rt + lr;
                    bf16_t* kp = P.mK + (((size_t)b * 4 + h) * NT + n) * 96;
#pragma unroll
                    for (int ct = 0; ct < 4; ++ct) *(uint2*)(kp + 16 * ct + 4 * q) = make_uint2(cvtpk(acc[rt][ct][0], acc[rt][ct][1]), cvtpk(acc[rt][ct][2], acc[rt][ct][3]));
                } else {
#pragma unroll
                    for (int ct = 0; ct < 4; ++ct) {
                        bf16_t* vp = P.mVt + (((size_t)b * 4 + h) * 64 + 16 * ct + lr) * NT + n0 + 16 * rt + 4 * q;
                        *(uint2*)vp = make_uint2(cvtpk(acc[rt][ct][0], acc[rt][ct][1]), cvtpk(acc[rt][ct][2], acc[rt][ct][3]));
                    }
                }
            }
        }
    }
}
__device__ __forceinline__ void phase_prep(const Params& P, LAS3 unsigned char* lds, int l) {
    for (int it = blockIdx.x; it < 3 * (TT / 64); it += gridDim.x) {
        const int fn = it % 3, tile = it / 3;
        if (fn == 0) prep_mla(P, lds, tile, l); else if (fn == 1) prep_ml(P, lds, tile, l); else prep_da(P, lds, tile);
    }
}

__device__ __forceinline__ void phase_mix(const Params& P, LAS3 unsigned char* lds, int l) {
    const int bid = blockIdx.x, G = gridDim.x;
    const float lambda_init = (l == 0) ? 0.2f : 0.35550906759096927f;
    for (int it = bid; it < 256; it += G)
    {
        const int pr = (it & 7) * 4 + (it >> 6), qb = (it >> 3) & 7;
        attn_item<64, 2, true>(lds, P.daQ, P.daK, P.daVt, P.ycatb, 0, pr >> 2, pr & 3, 1 + qb, P.lamfull[l], P.da_subln + l * 64, 1.f - lambda_init);
    }
    LAS3 int* slot = (LAS3 int*)(lds + MK_LDS_MAIN + 16);
    const int n_ml = 64, n_mla = 256, n_s5 = 256, n_ctx = (l == 0) ? 64 : 0;
    const int total = n_ml + n_mla + n_s5 + n_ctx;
    for (;;) {
        __syncthreads();
        if (threadIdx.x == 0) *slot = atomicAdd(P.queue + l, 1);
        __syncthreads();
        int it = __builtin_amdgcn_readfirstlane(*slot);
        if (it >= total) break;
        int kind, b, h, x3;
        if (it < n_ml) { kind = 1; b = it >> 3; h = (it >> 1) & 3; x3 = it & 1; }
        else if ((it -= n_ml) < n_mla) { kind = 2; b = it >> 5; h = (it >> 3) & 3; x3 = 1 + (it & 7); }
        else if ((it -= n_mla) < n_s5) { kind = 3; b = it >> 5; h = (it >> 1) & 15; x3 = it & 1; }
        else { it -= n_s5; kind = (it < 32) ? 0 : 2; it &= 31; b = it >> 2; h = it & 3; x3 = 0; }
        if (kind == 0) attn_item<64, 2, true>(lds, P.daQ, P.daK, P.daVt, P.ycatb, 0, b, h, x3, P.lamfull[l], P.da_subln + l * 64, 1.f - lambda_init);
        else if (kind == 1) mlstm_item(lds, P.mlQ, P.mlK, P.mlKt, P.mlVt, P.mlG, P.hdir, b, h, x3);
        else if (kind == 2) attn_item<96, 1, false>(lds, P.mQ, P.mK, P.mVt, P.ycatb, 512, b, h, x3, 0.f, nullptr, 1.f);
        else s5_item(lds, P.pb, P.s5KmT + (size_t)l * 32 * 16 * 1024, P.s5Smat + (size_t)l * 32 * 128 * 1024, P.s5CmT + (size_t)l * 32 * 16 * 128,
                     P.s5A + l * 32 * 64 * 2, P.s5A64 + l * 32 * 64 * 2, P.s5xs, P.ys5, b, h, x3);
    }
}

template <int TOK, int BATCH>
__device__ __forceinline__ void phase_finish_t(const Params& P, LAS3 unsigned char* lds, int l) {
    constexpr int RT = (TOK + 15) / 16;
    const int tid = opaque_tid(), wid = tid >> 6, lane = tid & 63, lr = lane & 15, q = lane >> 4, c = tid & 255, half = tid >> 8;
    const int ntile = (l == 0) ? TT / TOK : NB * (NS / TOK);
    constexpr int GROW = 264;
    LAS3 bf16_t* Gs = (LAS3 bf16_t*)lds;
    const float* mn = P.ml_norm + l * 256; const float* dsk = P.s5_d + l * 256; const float* bgl = P.s5_b_glu + l * 256;
    const bf16_t* wg = P.wglu_t + (size_t)l * 256 * 256;
    const bf16_t* __restrict__ pbr = P.pb; const bf16_t* __restrict__ hdr = (const bf16_t*)P.hdir; const bf16_t* __restrict__ ysr = (const bf16_t*)P.ys5; bf16_t* __restrict__ oY = P.ycatb;
    bf16x8_t wb[8][2];
#pragma unroll
    for (int ks = 0; ks < 8; ++ks) { wb[ks][0] = *(const bf16x8_t*)(wg + (size_t)(32 * wid + lr) * 256 + 32 * ks + 8 * q); wb[ks][1] = *(const bf16x8_t*)(wg + (size_t)(32 * wid + 16 + lr) * 256 + 32 * ks + 8 * q); }
    for (int it = blockIdx.x; it < ntile; it += gridDim.x) {
        const int t0 = (l == 0) ? it * TOK : ((it / (NS / TOK)) * NT + NC + (it % (NS / TOK)) * TOK);
        __syncthreads();
        {
            const int cg = tid & 31, ts = tid >> 5, c0 = 8 * cg;
            float mnv[8], dsv[8];
            { const float4 m0 = *(const float4*)(mn + c0), m1 = *(const float4*)(mn + c0 + 4), d0 = *(const float4*)(dsk + c0), d1 = *(const float4*)(dsk + c0 + 4);
              mnv[0] = m0.x; mnv[1] = m0.y; mnv[2] = m0.z; mnv[3] = m0.w; mnv[4] = m1.x; mnv[5] = m1.y; mnv[6] = m1.z; mnv[7] = m1.w;
              dsv[0] = d0.x; dsv[1] = d0.y; dsv[2] = d0.z; dsv[3] = d0.w; dsv[4] = d1.x; dsv[5] = d1.y; dsv[6] = d1.z; dsv[7] = d1.w; }
            constexpr int NP = (TOK + 15) / 16;
#pragma unroll
            for (int k0 = 0; k0 < NP; k0 += 2) {
                u32x4_t vog[2], vuu[2], vhf[2], vhb[2], vyf[2], vyb[2];
#pragma unroll
                for (int u = 0; u < 2; ++u) {
                    const int tok = ts + 16 * (k0 + u), tc = (tok < TOK) ? tok : TOK - 1;
                    const size_t t = (size_t)t0 + tc; const bf16_t* pr = pbr + t * DIN;
                    vog[u] = *(const u32x4_t*)(pr + P_MLO + c0); vuu[u] = *(const u32x4_t*)(pr + P_S5 + c0);
                    vhf[u] = *(const u32x4_t*)(hdr + t * 256 + c0); vhb[u] = *(const u32x4_t*)(hdr + ((size_t)TT + t) * 256 + c0);
                    vyf[u] = *(const u32x4_t*)(ysr + t * 256 + c0); vyb[u] = *(const u32x4_t*)(ysr + ((size_t)TT + t) * 256 + c0);
                }
#pragma unroll
                for (int u = 0; u < 2; ++u) {
                    const int tok = ts + 16 * (k0 + u);
                    float og[8], uu[8], hf[8], hb[8], yf[8], yb[8], hv[8], go[8];
                    unpack8(vog[u], og); unpack8(vuu[u], uu); unpack8(vhf[u], hf); unpack8(vhb[u], hb); unpack8(vyf[u], yf); unpack8(vyb[u], yb);
                    float ssq = 0.f;
#pragma unroll
                    for (int e = 0; e < 8; ++e) { hv[e] = sigmoidf_(og[e]) * (hf[e] + hb[e]); ssq += hv[e] * hv[e]; go[e] = gelu_tanh_(yf[e] + yb[e] + uu[e] * dsv[e]); }
                    ssq += __shfl_xor(ssq, 1); ssq += __shfl_xor(ssq, 2); ssq += __shfl_xor(ssq, 4);
                    const float r = rsqrtf(ssq * (1.f / 64.f) + 1e-6f);
#pragma unroll
                    for (int e = 0; e < 8; ++e) hv[e] = hv[e] * r * mnv[e];
                    if (NP * 16 == TOK || tok < TOK) {
                        *(u32x4_t*)(oY + ((size_t)t0 + tok) * DM + 256 + c0) = pack8(hv);
                        *(LAS3 u32x4_t*)(Gs + tok * GROW + c0) = pack8(go);
                    }
                }
            }
        }
        __syncthreads();
        f32x4_t acc[RT][2];
#pragma unroll
        for (int rt = 0; rt < RT; ++rt) { acc[rt][0] = (f32x4_t){0.f, 0.f, 0.f, 0.f}; acc[rt][1] = (f32x4_t){0.f, 0.f, 0.f, 0.f}; }
#pragma unroll
        for (int ks = 0; ks < 8; ++ks) {
#pragma unroll
            for (int rt = 0; rt < RT; ++rt) {
                const bf16x8_t a = *(const LAS3 bf16x8_t*)(Gs + (16 * rt + lr) * GROW + 32 * ks + 8 * q);
                acc[rt][0] = __builtin_amdgcn_mfma_f32_16x16x32_bf16(a, wb[ks][0], acc[rt][0], 0, 0, 0);
                acc[rt][1] = __builtin_amdgcn_mfma_f32_16x16x32_bf16(a, wb[ks][1], acc[rt][1], 0, 0, 0);
            }
        }
#pragma unroll
        for (int rt = 0; rt < RT; ++rt)
#pragma unroll
            for (int cc = 0; cc < 2; ++cc)
#pragma unroll
                for (int rg = 0; rg < 4; ++rg) {
                    const int row = 16 * rt + 4 * q + rg, col = 32 * wid + 16 * cc + lr;
                    const float gv = bf2f(Gs[row * GROW + col]);
                    if (TOK % 16 == 0 || row < TOK) P.ycatb[((size_t)t0 + row) * DM + 768 + col] = f2bf(gv * sigmoidf_(acc[rt][cc][rg] + bgl[col]));
                }
    }
}
__device__ __forceinline__ void phase_finish(const Params& P, LAS3 unsigned char* lds, int l) {
    if (l == 0) phase_finish_t<72, 12>(P, lds, l); else phase_finish_t<64, 8>(P, lds, l);
}

__device__ __forceinline__ void phase_post(const Params& P, LAS3 unsigned char* lds, int l) {
    const int tid = opaque_tid(), wid = tid >> 6, lane = tid & 63, lr = lane & 15, q = lane >> 4;
    constexpr int FROW = 1028, HROW = 1032;
    LAS3 float* ft = (LAS3 float*)lds;
    LAS3 bf16_t* fhi = (LAS3 bf16_t*)lds; LAS3 bf16_t* flo = fhi + 16 * HROW;
    static_assert(2 * 16 * HROW * 2 <= 16 * FROW * 4 + 1024, "hi/lo images");
    LAS3 float* pl = ft + 16 * FROW + 256;
    const float* nw1 = P.norm_w + (size_t)l * 4096 + 1024; const float* nw2 = nw1 + 1024;
    const float* wr = P.moe_w_router + (size_t)l * 1024 * 32; const float* br = P.moe_b_router + l * 32;
    LAS3 int* lcnt = (LAS3 int*)(pl + 8 * 16 * 32);
    if (tid < 32) lcnt[tid] = 0;
    bf16x8_t whi[4][2], wlo[4][2];
#pragma unroll
    for (int kb = 0; kb < 4; ++kb)
#pragma unroll
        for (int hx = 0; hx < 2; ++hx) {
            union { unsigned u[4]; bf16x8_t v; } uh, ul;
#pragma unroll
            for (int jj = 0; jj < 4; ++jj) {
                const float w0 = wr[(size_t)(128 * wid + 32 * kb + 8 * q + 2 * jj) * 32 + 16 * hx + lr], w1 = wr[(size_t)(128 * wid + 32 * kb + 8 * q + 2 * jj + 1) * 32 + 16 * hx + lr];
                const unsigned hb = cvtpk(w0, w1);
                uh.u[jj] = hb; ul.u[jj] = cvtpk(w0 - __uint_as_float(hb << 16), w1 - __uint_as_float(hb & 0xFFFF0000u));
            }
            whi[kb][hx] = uh.v; wlo[kb][hx] = ul.v;
        }
    const int nitem = (l == 0) ? TT / 16 : NB * NS / 16;
    const int tr = tid >> 5, part = tid & 31;
    LAS3 float* wl = (LAS3 float*)(lcnt + 32) + 16 * 32 + 16 * 4 + 16 * 4;
    float4 nm0 = make_float4(0.f, 0.f, 0.f, 0.f), nm1 = nm0;
#define POST_MODROW(it_) (P.mod + ((size_t)l * 9 + (((((l == 0) ? (it_) * 16 : (((it_) >> 7) * NT + NC + ((it_) & 127) * 16)) % NT) < NC) ? 8 : (((l == 0) ? (it_) * 16 : (((it_) >> 7) * NT + NC + ((it_) & 127) * 16)) / NT))) * 6144 + 2048)
    *(LAS3 f32x4_t*)(wl + tid * 4) = *(const f32x4_t*)(nw1 + tid * 4);
    if ((int)blockIdx.x < nitem) { const float* mrn = POST_MODROW((int)blockIdx.x); nm0 = *(const float4*)(mrn + tid * 4); if (tid < 256) nm1 = *(const float4*)(mrn + 2048 + tid * 4);
        *(LAS3 f32x4_t*)(wl + 2048 + tid * 4) = (f32x4_t){nm0.x, nm0.y, nm0.z, nm0.w}; if (tid < 256) *(LAS3 f32x4_t*)(wl + 4096 + tid * 4) = (f32x4_t){nm1.x, nm1.y, nm1.z, nm1.w}; }
    for (int it = blockIdx.x; it < nitem; it += gridDim.x) {
        const int t0 = (l == 0) ? it * 16 : ((it >> 7) * NT + NC + (it & 127) * 16);
        const int t = t0 + tr, b = t / NT, n = t % NT;
        const float* xin = (n < NC) ? P.ctx + ((size_t)b * NC + n) * DM : P.x + ((size_t)b * NS + (n - NC)) * DM;
        bf16_t* x1b = (bf16_t*)P.xall; const bf16_t* x2b = x1b + (size_t)TT * DM;
        __syncthreads();
        float x1[32];
        {
            float so = P.osq[(size_t)t * 16 + (part & 15)];
#pragma unroll
            for (int o = 8; o > 0; o >>= 1) so += __shfl_xor(so, o);
            const float rstd = rsqrtf(so * (1.f / DM) + 1e-6f);
            float ss = 0.f;
#pragma unroll
            for (int j = 0; j < 8; ++j) {
                const int d = j * 128 + part * 4;
                const uint2 ov = *(const uint2*)(P.ob + (size_t)t * DM + d);
                float4 xv;
                if (l == 0) xv = *(const float4*)(xin + d);
                else { const uint2 xb = *(const uint2*)(x2b + (size_t)t * DM + d); xv = make_float4(__uint_as_float(xb.x << 16), __uint_as_float(xb.x & 0xFFFF0000u), __uint_as_float(xb.y << 16), __uint_as_float(xb.y & 0xFFFF0000u)); }
                const f32x4_t wv_ = *(const LAS3 f32x4_t*)(wl + d), gv_ = *(const LAS3 f32x4_t*)(wl + 2048 + d);
                const float4 w = make_float4(wv_[0], wv_[1], wv_[2], wv_[3]), g1 = make_float4(gv_[0], gv_[1], gv_[2], gv_[3]);
                const float a0 = xv.x + g1.x * __uint_as_float(ov.x << 16) * rstd * w.x, a1 = xv.y + g1.y * __uint_as_float(ov.x & 0xFFFF0000u) * rstd * w.y;
                const float a2 = xv.z + g1.z * __uint_as_float(ov.y << 16) * rstd * w.z, a3 = xv.w + g1.w * __uint_as_float(ov.y & 0xFFFF0000u) * rstd * w.w;
                x1[j * 4] = a0; x1[j * 4 + 1] = a1; x1[j * 4 + 2] = a2; x1[j * 4 + 3] = a3;
                *(uint2*)(x1b + (size_t)t * DM + d) = make_uint2(cvtpk(a0, a1), cvtpk(a2, a3));
                ss += (a0 * a0 + a1 * a1) + (a2 * a2 + a3 * a3);
            }
#pragma unroll
            for (int o = 16; o > 0; o >>= 1) ss += __shfl_xor(ss, o);
            const float rstd2 = rsqrtf(ss * (1.f / DM) + 1e-6f);
#pragma unroll
            for (int j = 0; j < 8; ++j) {
                const int d = j * 128 + part * 4;
                const f32x4_t wv_ = *(const LAS3 f32x4_t*)(wl + 1024 + d), sv_ = *(const LAS3 f32x4_t*)(wl + 3072 + d), cv_ = *(const LAS3 f32x4_t*)(wl + 4096 + d);
                const float4 w = make_float4(wv_[0], wv_[1], wv_[2], wv_[3]), sh = make_float4(sv_[0], sv_[1], sv_[2], sv_[3]), sc = make_float4(cv_[0], cv_[1], cv_[2], cv_[3]);
                const float f0 = x1[j * 4] * rstd2 * w.x * (1.f + sc.x) + sh.x, f1 = x1[j * 4 + 1] * rstd2 * w.y * (1.f + sc.y) + sh.y;
                const float f2 = x1[j * 4 + 2] * rstd2 * w.z * (1.f + sc.z) + sh.z, f3 = x1[j * 4 + 3] * rstd2 * w.w * (1.f + sc.w) + sh.w;
                *(uint2*)(P.fb + (size_t)t * DM + d) = make_uint2(cvtpk(f0, f1), cvtpk(f2, f3));
                {
                    const unsigned h01 = cvtpk(f0, f1), h23 = cvtpk(f2, f3);
                    *(LAS3 u32x2_t*)(fhi + tr * HROW + d) = (u32x2_t){h01, h23};
                    *(LAS3 u32x2_t*)(flo + tr * HROW + d) = (u32x2_t){cvtpk(f0 - __uint_as_float(h01 << 16), f1 - __uint_as_float(h01 & 0xFFFF0000u)), cvtpk(f2 - __uint_as_float(h23 << 16), f3 - __uint_as_float(h23 & 0xFFFF0000u))};
                }
            }
        }
        __syncthreads();
        const bool hasn = it + (int)gridDim.x < nitem;
        if (hasn) { const float* mrn = POST_MODROW(it + (int)gridDim.x); nm0 = *(const float4*)(mrn + tid * 4); if (tid < 256) nm1 = *(const float4*)(mrn + 2048 + tid * 4); }
        {
            f32x4_t a0 = (f32x4_t){0.f, 0.f, 0.f, 0.f}, a1 = (f32x4_t){0.f, 0.f, 0.f, 0.f};
            bf16x8_t ah[4], al[4];
#pragma unroll
            for (int kb = 0; kb < 4; ++kb) { ah[kb] = *(const LAS3 bf16x8_t*)(fhi + lr * HROW + 128 * wid + 32 * kb + 8 * q); al[kb] = *(const LAS3 bf16x8_t*)(flo + lr * HROW + 128 * wid + 32 * kb + 8 * q); }
#pragma unroll
            for (int kb = 0; kb < 4; ++kb) {
                a0 = __builtin_amdgcn_mfma_f32_16x16x32_bf16(ah[kb], whi[kb][0], a0, 0, 0, 0); a1 = __builtin_amdgcn_mfma_f32_16x16x32_bf16(ah[kb], whi[kb][1], a1, 0, 0, 0);
                a0 = __builtin_amdgcn_mfma_f32_16x16x32_bf16(ah[kb], wlo[kb][0], a0, 0, 0, 0); a1 = __builtin_amdgcn_mfma_f32_16x16x32_bf16(ah[kb], wlo[kb][1], a1, 0, 0, 0);
                a0 = __builtin_amdgcn_mfma_f32_16x16x32_bf16(al[kb], whi[kb][0], a0, 0, 0, 0); a1 = __builtin_amdgcn_mfma_f32_16x16x32_bf16(al[kb], whi[kb][1], a1, 0, 0, 0);
            }
#pragma unroll
            for (int rg = 0; rg < 4; ++rg) { pl[(wid * 16 + 4 * q + rg) * 32 + lr] = a0[rg]; pl[(wid * 16 + 4 * q + rg) * 32 + 16 + lr] = a1[rg]; }
        }
        __syncthreads();
        {
            float lg = br[part];
#pragma unroll
            for (int w = 0; w < 8; ++w) lg += pl[(w * 16 + tr) * 32 + part];
            LAS3 float* lgs = (LAS3 float*)(lcnt + 32);
            LAS3 float* topv = lgs + 16 * 32;
            LAS3 int* topi = (LAS3 int*)(topv + 16 * 4);
            lgs[tr * 32 + part] = lg;
            asm volatile("s_waitcnt lgkmcnt(0)" ::: "memory");
            int rank = 0;
#pragma unroll
            for (int c4 = 0; c4 < 8; ++c4) {
                const f32x4_t lv = *(const LAS3 f32x4_t*)(lgs + tr * 32 + 4 * c4);
#pragma unroll
                for (int e = 0; e < 4; ++e) rank += (lv[e] > lg || (lv[e] == lg && (4 * c4 + e) < part)) ? 1 : 0;
            }
            if (rank < 4) { topv[tr * 4 + rank] = lg; topi[tr * 4 + rank] = part; }
            asm volatile("s_waitcnt lgkmcnt(0)" ::: "memory");
            if (part < 4) {
                const f32x4_t v = *(const LAS3 f32x4_t*)(topv + tr * 4);
                const int ek = topi[tr * 4 + part];
                const float e1 = __expf(v[1] - v[0]), e2 = __expf(v[2] - v[0]), e3 = __expf(v[3] - v[0]);
                const float inv = 1.f / (1.f + e1 + e2 + e3);
                const float gk = (part == 0) ? inv : (part == 1) ? e1 * inv : (part == 2) ? e2 * inv : e3 * inv;
                P.top_e[(size_t)t * 4 + part] = ek; P.top_g[(size_t)t * 4 + part] = gk;
                P.posb[(size_t)t * 4 + part] = __hip_atomic_fetch_add(&lcnt[ek], 1, __ATOMIC_RELAXED, __HIP_MEMORY_SCOPE_WORKGROUP);
            }
        }
        if (hasn) { *(LAS3 f32x4_t*)(wl + 2048 + tid * 4) = (f32x4_t){nm0.x, nm0.y, nm0.z, nm0.w}; if (tid < 256) *(LAS3 f32x4_t*)(wl + 4096 + tid * 4) = (f32x4_t){nm1.x, nm1.y, nm1.z, nm1.w}; }
    }
#undef POST_MODROW
    __syncthreads();
    if (tid < 32) P.blkcnt[((size_t)l * gridDim.x + blockIdx.x) * 32 + tid] = lcnt[tid];
}

__device__ __forceinline__ void phase_scatter(const Params& P, LAS3 unsigned char* lds, int l) {
    const int tid = opaque_tid(), wid = tid >> 6, lane = tid & 63;
    LAS3 int* soff = (LAS3 int*)lds;
    LAS3 int* part = soff + 64;
    LAS3 int* pre = soff + 1024;
    const int G = gridDim.x;
    const int* bc = P.blkcnt + (size_t)l * G * 32;
    __syncthreads();
    {
        const int e = tid & 31, pt = tid >> 5, per = (G + 15) / 16;
        int sum = 0;
        for (int b2 = pt * per; b2 < (pt + 1) * per && b2 < G; ++b2) sum += bc[b2 * 32 + e];
        part[pt * 32 + e] = sum;
        __syncthreads();
        int run = 0;
        for (int p2 = 0; p2 < pt; ++p2) run += part[p2 * 32 + e];
        for (int b2 = pt * per; b2 < (pt + 1) * per && b2 < G; ++b2) { pre[b2 * 32 + e] = run; run += bc[b2 * 32 + e]; }
        if (pt == 15) soff[32 + e] = run;
    }
    __syncthreads();
    if (tid < 64) {
        const int e = tid & 31;
        const int ntl = (soff[32 + e] + 255) >> 8;
        int inc = ntl;
#pragma unroll
        for (int o = 1; o < 32; o <<= 1) { const int v = __shfl_up(inc, o, 32); if (e >= o) inc += v; }
        const int nt0 = inc - ntl;
        if (tid < 32) {
            soff[e] = nt0 * 256;
            if (blockIdx.x == 0) { for (int m = 0; m < ntl; ++m) P.tile_e[l * 512 + nt0 + m] = e; P.offs[l * 32 + e] = nt0 * 256; if (e == 31) P.ntiles[l * 16] = inc; }
        }
    }
    __syncthreads();
    const int gt = blockIdx.x * 512 + tid, NTH = gridDim.x * 512;
    const int ntok = (l == 0) ? TT : NB * NS;
    int* __restrict__ stk = (int*)P.xg;
    for (int a = gt; a < ntok * 4; a += NTH) {
        const int i = a >> 2;
        const int t = (l == 0) ? i : ((i >> 11) * NT + NC + (i & 2047));
        const int ek = P.top_e[(size_t)t * 4 + (a & 3)];
        const int slot = soff[ek] + pre[((i >> 4) % G) * 32 + ek] + P.posb[(size_t)t * 4 + (a & 3)];
        stk[slot] = t; P.tok_slot[(size_t)t * 4 + (a & 3)] = slot;
    }
    for (int i = gt; i < NE * 256; i += NTH) {
        const int e = i >> 8, j = i & 255, c = soff[32 + e];
        const int padn = ((c + 255) & ~255) - c;
        if (j < padn) stk[soff[e] + c + j] = NC;
    }
}

__device__ __forceinline__ void phase_combine(const Params& P, LAS3 unsigned char* lds, int l) {
    const int tid = opaque_tid(); const int lane = tid & 63, gw = blockIdx.x * 8 + (tid >> 6), NW = gridDim.x * 8;
    const float* __restrict__ nw3 = P.norm_w + (size_t)l * 4096 + 3072;
    const float* __restrict__ nwn = P.norm_w + 4096;
    const int* __restrict__ tsl = P.tok_slot; const float* __restrict__ tg = P.top_g; const bf16_t* __restrict__ ye = P.yexp; const float* __restrict__ modp = P.mod;
    const int ntok = (l == 0) ? TT : NB * NS;
    LAS3 float* cw = (LAS3 float*)lds;
    for (int i = tid; i < 256; i += 512) { *(LAS3 f32x4_t*)(cw + i * 4) = *(const f32x4_t*)(nw3 + i * 4); if (l == 0) *(LAS3 f32x4_t*)(cw + 1024 + i * 4) = *(const f32x4_t*)(nwn + i * 4); }
    for (int i = tid; i < 9 * 256; i += 512) { const int r = i >> 8, k = i & 255; *(LAS3 f32x4_t*)(cw + 2048 + r * 1024 + k * 4) = *(const f32x4_t*)(modp + ((size_t)l * 9 + r) * 6144 + 5120 + k * 4); }
    if (l == 0) for (int i = tid; i < 9 * 512; i += 512) { const int r = i >> 9, k = i & 511; *(LAS3 f32x4_t*)(cw + 11264 + r * 2048 + k * 4) = *(const f32x4_t*)(modp + ((size_t)9 + r) * 6144 + k * 4); }
    __syncthreads();
    const bf16_t* __restrict__ x1b = (const bf16_t*)P.xall; bf16_t* __restrict__ x2b = (bf16_t*)P.xall + (size_t)TT * DM;
    int i = gw;
    int4 sl = make_int4(0, 0, 0, 0); float4 gt = make_float4(0.f, 0.f, 0.f, 0.f);
    if (i < ntok) { const int t = (l == 0) ? i : ((i >> 11) * NT + NC + (i & 2047)); sl = *(const int4*)(tsl + (size_t)t * 4); gt = *(const float4*)(tg + (size_t)t * 4); }
    for (; i < ntok; i += NW) {
        const int t = (l == 0) ? i : ((i >> 11) * NT + NC + (i & 2047));
        const int b = t / NT, n = t % NT, r = (n < NC) ? 8 : b;
        const int4 slc = sl; const float4 gtc = gt;
        uint2 yv[4][4];
        const int slots[4] = {slc.x, slc.y, slc.z, slc.w};
#pragma unroll
        for (int k = 0; k < 4; ++k)
#pragma unroll
            for (int j = 0; j < 4; ++j) yv[k][j] = *(const uint2*)(ye + (size_t)slots[k] * DM + j * 256 + lane * 4);
        float4 x1[4], w3[4], g2[4], wn[4], scn[4], shn[4];
#define CW4(p_) ({ const f32x4_t v_ = *(const LAS3 f32x4_t*)(p_); make_float4(v_[0], v_[1], v_[2], v_[3]); })
#pragma unroll
        for (int j = 0; j < 4; ++j) {
            const int d = j * 256 + lane * 4;
            { const uint2 xb = *(const uint2*)(x1b + (size_t)t * DM + d); x1[j] = make_float4(__uint_as_float(xb.x << 16), __uint_as_float(xb.x & 0xFFFF0000u), __uint_as_float(xb.y << 16), __uint_as_float(xb.y & 0xFFFF0000u)); }
            w3[j] = CW4(cw + d); g2[j] = CW4(cw + 2048 + r * 1024 + d);
            if (l == 0) { wn[j] = CW4(cw + 1024 + d); scn[j] = CW4(cw + 11264 + r * 2048 + 1024 + d); shn[j] = CW4(cw + 11264 + r * 2048 + d); }
        }
        { const int in = i + NW; if (in < ntok) { const int tn = (l == 0) ? in : ((in >> 11) * NT + NC + (in & 2047)); sl = *(const int4*)(tsl + (size_t)tn * 4); gt = *(const float4*)(tg + (size_t)tn * 4); } }
        const float gk[4] = {gtc.x, gtc.y, gtc.z, gtc.w};
        float m[16];
#pragma unroll
        for (int j = 0; j < 16; ++j) m[j] = 0.f;
#pragma unroll
        for (int k = 0; k < 4; ++k)
#pragma unroll
            for (int j = 0; j < 4; ++j) {
                m[j * 4] += gk[k] * __uint_as_float(yv[k][j].x << 16); m[j * 4 + 1] += gk[k] * __uint_as_float(yv[k][j].x & 0xFFFF0000u);
                m[j * 4 + 2] += gk[k] * __uint_as_float(yv[k][j].y << 16); m[j * 4 + 3] += gk[k] * __uint_as_float(yv[k][j].y & 0xFFFF0000u);
            }
        float ss = 0.f;
#pragma unroll
        for (int j = 0; j < 16; ++j) ss += m[j] * m[j];
        const float rstd = rsqrtf(wave_sum(ss) * (1.f / DM) + 1e-6f);
        float xv[16]; float s2 = 0.f;
#pragma unroll
        for (int j = 0; j < 4; ++j) {
            const int d = j * 256 + lane * 4;
            xv[j * 4] = x1[j].x + g2[j].x * m[j * 4] * rstd * w3[j].x; xv[j * 4 + 1] = x1[j].y + g2[j].y * m[j * 4 + 1] * rstd * w3[j].y;
            xv[j * 4 + 2] = x1[j].z + g2[j].z * m[j * 4 + 2] * rstd * w3[j].z; xv[j * 4 + 3] = x1[j].w + g2[j].w * m[j * 4 + 3] * rstd * w3[j].w;
            s2 += (xv[j * 4] * xv[j * 4] + xv[j * 4 + 1] * xv[j * 4 + 1]) + (xv[j * 4 + 2] * xv[j * 4 + 2] + xv[j * 4 + 3] * xv[j * 4 + 3]);
            const float4 o = make_float4(xv[j * 4], xv[j * 4 + 1], xv[j * 4 + 2], xv[j * 4 + 3]);
            if (l == 0) *(uint2*)(x2b + (size_t)t * DM + d) = make_uint2(cvtpk(o.x, o.y), cvtpk(o.z, o.w));
            else *(float4*)(P.out + ((size_t)b * NS + (n - NC)) * DM + d) = o;
        }
        if (l == 0) {
            const float rs2 = rsqrtf(wave_sum(s2) * (1.f / DM) + 1e-6f);
#pragma unroll
            for (int j = 0; j < 4; ++j) {
                const int d = j * 256 + lane * 4;
                const float o0 = xv[j * 4] * rs2 * wn[j].x * (1.f + scn[j].x) + shn[j].x, o1 = xv[j * 4 + 1] * rs2 * wn[j].y * (1.f + scn[j].y) + shn[j].y;
                const float o2 = xv[j * 4 + 2] * rs2 * wn[j].z * (1.f + scn[j].z) + shn[j].z, o3 = xv[j * 4 + 3] * rs2 * wn[j].w * (1.f + scn[j].w) + shn[j].w;
                *(uint2*)(P.hbuf + (size_t)t * DM + d) = make_uint2(cvtpk(o0, o1), cvtpk(o2, o3));
            }
        }
    }
}

extern __shared__ __attribute__((aligned(16))) unsigned char dyn_lds[];
__device__ __forceinline__ void run_phase(const Params& P, LAS3 unsigned char* lds, int ph) {
    if (ph == PH_SETUP) { phase_setup(P, lds); return; }
    if (ph == PH_H0) { phase_h0(P, lds); return; }
    const int l = (ph - PH_LAYER0) / PH_PER_LAYER, s = (ph - PH_LAYER0) % PH_PER_LAYER;
    switch (s) {
    case L_GEMM_IN: { pg8::Gemm g{P.hbuf, P.w_in_t + (size_t)l * 2560 * 1024, TT, 2560, 1024, 0}; pg8::StaticOrder S; S.init(TT, 2560, gridDim.x, blockIdx.x);
        pg8::EpiBf16P E{P.pb, DIN, 0}; pg8::gemm_phase<pg8::EpiBf16P, pg8::StaticOrder, true, true>(lds, g, S, E); } break;
    case L_PREP: phase_prep(P, lds, l); break;
    case L_MIX: phase_mix(P, lds, l); break;
    case L_FINISH: phase_finish(P, lds, l); break;
    case L_GEMM_OUT: { pg8::Gemm g{P.ycatb, P.w_out_t + (size_t)l * 1024 * 1024, TT, 1024, 1024, 0}; pg8::EpiOut E{P.ob, P.osq};
        if (l == 0) { pg8::StaticOrder S; S.init(TT, 1024, gridDim.x, blockIdx.x); pg8::gemm_phase<pg8::EpiOut, pg8::StaticOrder, true, true>(lds, g, S, E); }
        else { pg8::LatOrder S; S.initl(1024, gridDim.x, blockIdx.x); pg8::gemm_phase<pg8::EpiOut, pg8::LatOrder, true, true>(lds, g, S, E); } } break;
    case L_POST: phase_post(P, lds, l); break;
    case L_SCATTER: phase_scatter(P, lds, l); break;
    case L_GEMM_GU: { pg8::Gemm g{P.fb, P.wgu_t + (size_t)l * NE * 2048 * 1024, 0, 2048, 1024, 0}; pg8::GroupedOrder S; S.initg(P.ntiles + l * 16, P.tile_e + l * 512, 2048, gridDim.x, blockIdx.x);
        pg8::EpiSwiglu E{P.act, P.moe_b_gate_up + (size_t)l * NE * 2048}; pg8::gemm_phase<pg8::EpiSwiglu, pg8::GroupedOrder, true, true, true>(lds, g, S, E, (const int*)P.xg); } break;
    case L_GEMM_DN: { pg8::Gemm g{P.act, P.wdn_t + (size_t)l * NE * 1024 * 1024, 0, 1024, 1024, 0}; pg8::GroupedOrder S; S.initg(P.ntiles + l * 16, P.tile_e + l * 512, 1024, gridDim.x, blockIdx.x);
        pg8::EpiDown E{P.yexp, P.moe_b_down + (size_t)l * NE * 1024}; pg8::gemm_phase<pg8::EpiDown, pg8::GroupedOrder, true, true>(lds, g, S, E); } break;
    case L_COMBINE: phase_combine(P, lds, l); break;
    }
}
__global__ void __launch_bounds__(512, 2) mk_fwd(Params Pk, int ph_lo, int ph_hi) {
    LAS3 unsigned char* lds = (LAS3 unsigned char*)dyn_lds;
    volatile LAS3 unsigned* st = (volatile LAS3 unsigned*)(lds + MK_LDS_MAIN);
    LAS3 Params* PL = (LAS3 Params*)(lds + MK_LDS_MAIN + 64);
    static_assert(sizeof(Params) <= 1024, "Params copy does not fit its LDS slot");
    if (threadIdx.x < 4) st[threadIdx.x] = 0u;
    if (threadIdx.x == 64) store_params(PL, Pk);
    unsigned* barw = Pk.bar;
    __syncthreads();
    XcdBarrier bar; bar.bar = barw; bar.x = 0; bar.st = st;
    if (ph_hi - ph_lo > 1) bar = xcd_barrier_post(barw, st);
#define MK_RUN(ph) if (ph_lo <= (ph) && (ph) < ph_hi) { { const LAS3 Params* PLo = PL; asm volatile("" : "+v"(PLo)); LAS3 unsigned char* ldsp = lds; asm volatile("" : "+s"(ldsp)); \
        const Params P = load_params(PLo); run_phase(P, ldsp, (ph)); } if ((ph) + 1 < ph_hi) xcd_barrier(bar); }
    MK_RUN(0) MK_RUN(1) MK_RUN(2) MK_RUN(3) MK_RUN(4) MK_RUN(5) MK_RUN(6) MK_RUN(7) MK_RUN(8) MK_RUN(9) MK_RUN(10) MK_RUN(11)
    MK_RUN(12) MK_RUN(13) MK_RUN(14) MK_RUN(15) MK_RUN(16) MK_RUN(17) MK_RUN(18) MK_RUN(19) MK_RUN(20) MK_RUN(21)
#undef MK_RUN
}

extern "C" void kernel_launch(void* const* d_in, const int* in_sizes, int n_in, void* d_out, int out_size, void* d_ws, size_t ws_size, hipStream_t stream) {
    Params P{};
    const float** pin = (const float**)&P;
    for (int i = 0; i < 35; ++i) pin[i] = (const float*)d_in[i];
    P.out = (float*)d_out;
    char* ws = (char*)d_ws; size_t off = 0;
    auto carve = [&](size_t bytes) { void* p = ws + off; off += (bytes + 255) & ~(size_t)255; return p; };
    const size_t ctl_bytes = XCD_BAR_WORDS * 4 + 256 + 256;
    P.bar = (unsigned*)carve(XCD_BAR_WORDS * 4); P.queue = (int*)carve(256); P.cnt = (int*)carve(256);
    P.tile_e = (int*)carve(2 * 512 * 4); P.ntiles = (int*)carve(2 * 16 * 4); P.offs = (int*)carve(2 * 32 * 4); P.blkcnt = (int*)carve(2 * 256 * 32 * 4);
    P.xall = (float*)carve((size_t)TT * DM * 4); P.mod = (float*)carve((size_t)2 * 9 * 6144 * 4); P.ropecs = (float*)carve((size_t)NS * 16 * 2 * 4); P.lamfull = (float*)carve(256);
    P.w_in_t = (bf16_t*)carve((size_t)2 * 2560 * 1024 * 2); P.w_out_t = (bf16_t*)carve((size_t)2 * 1024 * 1024 * 2);
    P.wgu_t = (bf16_t*)carve((size_t)2 * NE * 2048 * 1024 * 2); P.wdn_t = (bf16_t*)carve((size_t)2 * NE * 1024 * 1024 * 2);
    P.wq_t = (bf16_t*)carve((size_t)2 * 384 * 192 * 2); P.wkv_t = (bf16_t*)carve((size_t)2 * 512 * 128 * 2); P.wglu_t = (bf16_t*)carve((size_t)2 * 256 * 256 * 2);
    P.s5KmT = (bf16_t*)carve((size_t)64 * 16 * 1024 * 2); P.s5Smat = (bf16_t*)carve((size_t)64 * 128 * 1024 * 2); P.s5CmT = (bf16_t*)carve((size_t)64 * 16 * 128 * 2);
    P.s5A = (float*)carve(64 * 64 * 2 * 4); P.s5A64 = (float*)carve(64 * 64 * 2 * 4); P.s5xs = (float*)carve((size_t)256 * 36 * 128 * 4);
    P.hbuf = (bf16_t*)carve((size_t)TT * DM * 2); P.pb = (bf16_t*)carve((size_t)TT * DIN * 2);
    P.daQ = (bf16_t*)carve((size_t)TT * 256 * 2); P.daK = (bf16_t*)carve((size_t)TT * 256 * 2); P.daVt = (bf16_t*)carve((size_t)TT * 256 * 2);
    P.mQ = (bf16_t*)carve((size_t)TT * 384 * 2); P.mK = (bf16_t*)carve((size_t)TT * 384 * 2); P.mVt = (bf16_t*)carve((size_t)TT * 256 * 2);
    P.mlQ = (bf16_t*)carve((size_t)TT * 256 * 2); P.mlK = (bf16_t*)carve((size_t)TT * 256 * 2); P.mlKt = (bf16_t*)carve((size_t)TT * 256 * 2); P.mlVt = (bf16_t*)carve((size_t)TT * 256 * 2);
    P.mlG = (float*)carve((size_t)TT * 16 * 4); P.hdir = (float*)carve((size_t)2 * TT * 256 * 4); P.ys5 = (float*)carve((size_t)2 * TT * 256 * 4);
    P.ycatb = (bf16_t*)carve((size_t)TT * DM * 2); P.ob = (bf16_t*)carve((size_t)TT * DM * 2); P.osq = (float*)carve((size_t)TT * 16 * 4); P.fb = (bf16_t*)carve((size_t)TT * DM * 2);
    P.top_e = (int*)carve((size_t)NASSIGN * 4); P.top_g = (float*)carve((size_t)NASSIGN * 4); P.posb = (int*)carve((size_t)NASSIGN * 4); P.tok_slot = (int*)carve((size_t)NASSIGN * 4);
    P.xg = (bf16_t*)carve((size_t)MAXSLOTS * DM * 2); P.act = (bf16_t*)carve((size_t)MAXSLOTS * DM * 2); P.yexp = (bf16_t*)carve((size_t)MAXSLOTS * DM * 2);
    if (off > ws_size) { fprintf(stderr, "kernel_launch: workspace too small: need %zu have %zu\n", off, ws_size); return; }
    static bool attr_done = false;
    if (!attr_done) {
        if (hipFuncSetAttribute((const void*)mk_fwd, hipFuncAttributeMaxDynamicSharedMemorySize, MK_LDS_BYTES) != hipSuccess) fprintf(stderr, "kernel_launch: hipFuncSetAttribute failed\n");
        attr_done = true;
    }
    (void)hipMemsetAsync(d_ws, 0, ctl_bytes, stream);
#if MK_ONE_LAUNCH
    hipLaunchKernelGGL(mk_fwd, dim3(256), dim3(512), MK_LDS_BYTES, stream, P, 0, (int)PH_TOTAL);
#else
    for (int ph = 0; ph < PH_TOTAL; ++ph) hipLaunchKernelGGL(mk_fwd, dim3(256), dim3(512), MK_LDS_BYTES, stream, P, ph, ph + 1);
#endif
}
```

```cpp
#include <hip/hip_runtime.h>
#include <cstdint>
#include <cstdio>

#define NB 8
#define NS 2048
#define NC 256
#define NT 2304
#define TT (NB * NT)
#define DM 1024
#define DIN 2560
#define DINC 2416
#define NE 32
#define NASSIGN (TT * 4)
#define MAXSLOTS (NASSIGN + NE * 256)

#define P_DAQ 0
#define P_DAK 256
#define P_DAV 512
#define P_MLQK 768
#define P_MLV 1280
#define P_MLO 1536
#define P_MLG 1792
#define P_CQ 1808
#define P_CKV 2000
#define P_KR 2128
#define P_S5 2160

#ifndef MK_ONE_LAUNCH
#define MK_ONE_LAUNCH 1
#endif

typedef unsigned short bf16_t;
__device__ __forceinline__ float sigmoidf_(float x) { return __builtin_amdgcn_rcpf(1.f + __expf(-x)); }
__device__ __forceinline__ float siluf_(float x) { return x * __builtin_amdgcn_rcpf(1.f + __expf(-x)); }
__device__ __forceinline__ float logsigmoidf_(float x) { return fminf(x, 0.f) - log1pf(__expf(-fabsf(x))); }
__device__ __forceinline__ float gelu_tanh_(float x) { const float u = 0.7978845608028654f * (x + 0.044715f * x * x * x); return x * __builtin_amdgcn_rcpf(1.f + __expf(-2.f * u)); }
typedef __bf16 bf16x2_nat __attribute__((ext_vector_type(2)));
typedef float f32x2_nat __attribute__((ext_vector_type(2)));
__device__ __forceinline__ unsigned cvtpk(float lo, float hi) { const f32x2_nat v = {lo, hi}; const bf16x2_nat b = __builtin_convertvector(v, bf16x2_nat); return __builtin_bit_cast(unsigned, b); }
__device__ __forceinline__ bf16_t f2bf(float f) { return (bf16_t)(cvtpk(f, 0.f) & 0xFFFFu); }
__device__ __forceinline__ float bf2f(bf16_t b) { return __uint_as_float(((unsigned)b) << 16); }
__device__ __forceinline__ unsigned pk2bf(float lo, float hi) { return cvtpk(lo, hi); }
__device__ __forceinline__ int opaque_tid() { int t = threadIdx.x; asm volatile("" : "+v"(t)); return t; }
__device__ __forceinline__ float wave_sum(float v) {
#pragma unroll
    for (int o = 32; o > 0; o >>= 1) v += __shfl_xor(v, o);
    return v;
}
__device__ __forceinline__ int seq_token(int s, int dir) {
    if (dir == 0) return s;
    return (s < NC) ? (NC - 1 - s) : (NC + (NT - 1 - s));
}

namespace pg8 {
#define PG8_LAS __attribute__((address_space(3)))
typedef short bf16x8 __attribute__((ext_vector_type(8)));
typedef float f32x4 __attribute__((ext_vector_type(4)));
typedef unsigned u32x4 __attribute__((ext_vector_type(4)));
constexpr int BM = 256, BK = 64, HALF = 128, HTB = HALF * BK * 2, STAGE_BYTES = 8 * HTB, NXCD = 8, WGM = 8;
__host__ __device__ __forceinline__ int lds_byte(int r, int c) { const int st = (r >> 4) * 2 + (c >> 5), rr = r & 15, cc = c & 31, ob = rr * 64 + cc * 2; return st * 1024 + (ob ^ (((ob >> 9) & 1) << 5)); }
__host__ __device__ __forceinline__ void stage_rc(int b, int& R, int& C) { const int st = b / 1024, sb = b % 1024, swz = sb ^ (((sb >> 9) & 1) << 5); R = (st >> 1) * 16 + swz / 64; C = (st & 1) * 32 + (swz % 64) / 2; }
__host__ __device__ __forceinline__ int perm32(int rho) { const int n = rho >> 4, i = rho & 15; return 8 * (i >> 2) + 4 * n + (i & 3); }
struct Unit { int pm, pn; };
struct Gemm { const bf16_t* A; const bf16_t* Bt; int M, N, K, pad; };
__device__ __forceinline__ unsigned cvt_pk_bf16(float lo, float hi) { return cvtpk(lo, hi); }

struct StaticOrder {
    int nM, nN, nwg, G, c;
    __device__ void init(int M, int N, int G_, int c_) { nM = M / BM; nN = N / BM; nwg = nM * nN; G = G_; c = c_; }
    __device__ bool next(int i, Unit& u) const {
        const long L = (long)i * G + c; if (L >= nwg) return false;
        int wgid = (int)L; { const int q = nwg / NXCD, r = nwg % NXCD, xcd = wgid % NXCD, off = wgid / NXCD; wgid = (xcd < r ? xcd * (q + 1) : r * (q + 1) + (xcd - r) * q) + off; }
        const int nig = WGM * nN, gid = wgid / nig, fm = gid * WGM, gsz = (nM - fm) < WGM ? (nM - fm) : WGM;
        u.pm = fm + ((wgid % nig) % gsz); u.pn = (wgid % nig) / gsz; return true;
    }
    __device__ __forceinline__ void a_ready(const Unit&) const {}
    __device__ __forceinline__ void done(const Unit&) const {}
};
struct LatOrder : StaticOrder {
    __device__ void initl(int N, int G_, int c_) { nM = 64; nN = N / BM; nwg = nM * nN; G = G_; c = c_; }
    __device__ bool next(int i, Unit& u) const { if (!StaticOrder::next(i, u)) return false; u.pm = (u.pm >> 3) * 9 + 1 + (u.pm & 7); return true; }
};
struct GroupedOrder : StaticOrder {
    const int* tile_e;
    __device__ void initg(const int* ntiles_p, const int* tile_e_, int N, int G_, int c_) { nM = ntiles_p[0]; nN = N / BM; nwg = nM * nN; G = G_; c = c_; tile_e = tile_e_; }
    __device__ bool next(int i, Unit& u) const { if (!StaticOrder::next(i, u)) return false; u.pn += tile_e[u.pm] * nN; return true; }
};

struct EpiBf16P {
    static constexpr bool PERM = true;
    bf16_t* O; int ldc, pad;
    __device__ __forceinline__ void operator()(const f32x4 (&acc)[2][2][4][2], const Unit& u, int wr, int wc, int fr, int fq) const {
        const int row0 = u.pm * BM + wr * 64 + fr, col0 = u.pn * BM + wc * 32 + 8 * fq;
#pragma unroll
        for (int ai = 0; ai < 2; ++ai)
#pragma unroll
            for (int m = 0; m < 4; ++m) { bf16_t* rowp = O + (size_t)(row0 + ai * HALF + m * 16) * ldc + col0;
#pragma unroll
                for (int bj = 0; bj < 2; ++bj) { const f32x4 v0 = acc[ai][bj][m][0], v1 = acc[ai][bj][m][1];
                    u32x4 w; w.x = cvt_pk_bf16(v0[0], v0[1]); w.y = cvt_pk_bf16(v0[2], v0[3]); w.z = cvt_pk_bf16(v1[0], v1[1]); w.w = cvt_pk_bf16(v1[2], v1[3]);
                    *(u32x4*)(rowp + bj * HALF) = w; } }
    }
};
struct EpiOut {
    static constexpr bool PERM = true;
    bf16_t* O; float* osq;
    __device__ __forceinline__ void operator()(const f32x4 (&acc)[2][2][4][2], const Unit& u, int wr, int wc, int fr, int fq) const {
        const int row0 = u.pm * BM + wr * 64 + fr, col0 = u.pn * BM + wc * 32 + 8 * fq;
#pragma unroll
        for (int ai = 0; ai < 2; ++ai)
#pragma unroll
            for (int m = 0; m < 4; ++m) { const int row = row0 + ai * HALF + m * 16; bf16_t* rowp = O + (size_t)row * 1024 + col0; float ss = 0.f;
#pragma unroll
                for (int bj = 0; bj < 2; ++bj) { const f32x4 v0 = acc[ai][bj][m][0], v1 = acc[ai][bj][m][1];
                    ss += (v0[0] * v0[0] + v0[1] * v0[1]) + (v0[2] * v0[2] + v0[3] * v0[3]) + (v1[0] * v1[0] + v1[1] * v1[1]) + (v1[2] * v1[2] + v1[3] * v1[3]);
                    u32x4 w; w.x = cvt_pk_bf16(v0[0], v0[1]); w.y = cvt_pk_bf16(v0[2], v0[3]); w.z = cvt_pk_bf16(v1[0], v1[1]); w.w = cvt_pk_bf16(v1[2], v1[3]);
                    *(u32x4*)(rowp + bj * HALF) = w; }
                ss += __shfl_xor(ss, 16); ss += __shfl_xor(ss, 32);
                if (fq == 0) osq[(size_t)row * 16 + u.pn * 4 + wc] = ss; }
    }
};
struct EpiDown {
    static constexpr bool PERM = true;
    bf16_t* C; const float* bias;
    __device__ __forceinline__ void operator()(const f32x4 (&acc)[2][2][4][2], const Unit& u, int wr, int wc, int fr, int fq) const {
        const int e = u.pn >> 2, pnl = u.pn & 3;
        const int row0 = u.pm * BM + wr * 64 + fr, col0 = pnl * BM + wc * 32 + 8 * fq;
        const float* bp = bias + (size_t)e * 1024 + col0;
        f32x4 bv[2][2];
#pragma unroll
        for (int bj = 0; bj < 2; ++bj)
#pragma unroll
            for (int n = 0; n < 2; ++n) bv[bj][n] = *(const f32x4*)(bp + bj * HALF + 4 * n);
#pragma unroll
        for (int ai = 0; ai < 2; ++ai)
#pragma unroll
            for (int m = 0; m < 4; ++m) { bf16_t* rowp = C + (size_t)(row0 + ai * HALF + m * 16) * 1024 + col0;
#pragma unroll
                for (int bj = 0; bj < 2; ++bj) { const f32x4 v0 = acc[ai][bj][m][0] + bv[bj][0], v1 = acc[ai][bj][m][1] + bv[bj][1];
                    u32x4 w; w.x = cvt_pk_bf16(v0[0], v0[1]); w.y = cvt_pk_bf16(v0[2], v0[3]); w.z = cvt_pk_bf16(v1[0], v1[1]); w.w = cvt_pk_bf16(v1[2], v1[3]);
                    *(u32x4*)(rowp + bj * HALF) = w; } }
    }
};
struct EpiSwiglu {
    static constexpr bool PERM = true;
    bf16_t* O; const float* bias;
    __device__ __forceinline__ void operator()(const f32x4 (&acc)[2][2][4][2], const Unit& u, int wr, int wc, int fr, int fq) const {
        const int e = u.pn >> 3, pnl = u.pn & 7;
        const int row0 = u.pm * BM + wr * 64 + fr, col0 = pnl * HALF + wc * 32 + 8 * fq;
        const float* bp = bias + (size_t)e * 2048 + col0;
        f32x4 bg[2], bu[2];
#pragma unroll
        for (int n = 0; n < 2; ++n) { bg[n] = *(const f32x4*)(bp + 4 * n); bu[n] = *(const f32x4*)(bp + 1024 + 4 * n) + 1.0f; }
#pragma unroll
        for (int ai = 0; ai < 2; ++ai)
#pragma unroll
            for (int m = 0; m < 4; ++m) {
                bf16_t* rowp = O + (size_t)(row0 + ai * HALF + m * 16) * 1024 + col0;
                float r[8];
#pragma unroll
                for (int n = 0; n < 2; ++n) {
                    const f32x4 g = acc[ai][0][m][n] + bg[n], up = acc[ai][1][m][n] + bu[n];
                    const f32x4 gt = __builtin_elementwise_min(g, (f32x4){7.f, 7.f, 7.f, 7.f});
                    const f32x4 uu = __builtin_elementwise_min(__builtin_elementwise_max(up, (f32x4){-6.f, -6.f, -6.f, -6.f}), (f32x4){8.f, 8.f, 8.f, 8.f});
                    const f32x4 z = gt * (-1.702f * 1.4426950408889634f);
                    f32x4 e; e[0] = __builtin_amdgcn_exp2f(z[0]); e[1] = __builtin_amdgcn_exp2f(z[1]); e[2] = __builtin_amdgcn_exp2f(z[2]); e[3] = __builtin_amdgcn_exp2f(z[3]);
                    const f32x4 d = e + 1.0f;
                    f32x4 rc; rc[0] = __builtin_amdgcn_rcpf(d[0]); rc[1] = __builtin_amdgcn_rcpf(d[1]); rc[2] = __builtin_amdgcn_rcpf(d[2]); rc[3] = __builtin_amdgcn_rcpf(d[3]);
                    const f32x4 o = (uu * gt) * rc;
                    r[n * 4] = o[0]; r[n * 4 + 1] = o[1]; r[n * 4 + 2] = o[2]; r[n * 4 + 3] = o[3];
                }
                u32x4 w; w.x = cvt_pk_bf16(r[0], r[1]); w.y = cvt_pk_bf16(r[2], r[3]); w.z = cvt_pk_bf16(r[4], r[5]); w.w = cvt_pk_bf16(r[6], r[7]);
                *(u32x4*)rowp = w;
            }
    }
};

template <class Epi, class Sched, bool ALIGN_EPI = false, bool SP2 = false, bool GATHER = false>
__device__ __forceinline__ void gemm_phase(PG8_LAS unsigned char* lds, const Gemm g, const Sched& S, const Epi& E, const int* rowtok = nullptr) {
    static_assert(!GATHER || SP2, "gather staging is wired into the SP2 loop only");
    const int tid = opaque_tid(), wid = __builtin_amdgcn_readfirstlane(tid >> 6), lane = tid & 63, wr = wid >> 2, wc = wid & 3, fr = lane & 15, fq = lane >> 4;
    const int K = g.K, nt = K / BK;
    unsigned voffA[2], voffB[2];
#pragma unroll
    for (int i = 0; i < 2; ++i) { int R, C; stage_rc(tid * 16 + i * 8192, R, C); const int Rb = Epi::PERM ? ((R & ~31) + perm32(R & 31)) : R;
        voffA[i] = (unsigned)(R * K + C) * 2u; voffB[i] = (unsigned)(Rb * K + C) * 2u; }
    int gR[2], gC[2];
#pragma unroll
    for (int i = 0; i < 2; ++i) stage_rc(tid * 16 + i * 8192, gR[i], gC[i]);
    PG8_LAS int* rt = (PG8_LAS int*)(lds + STAGE_BYTES);
    unsigned gaC[2][2] = {{0u, 0u}, {0u, 0u}}, gaN[2][2] = {{0u, 0u}, {0u, 0u}};
    const size_t kstep = (size_t)(BK * 2);
    const size_t hstep = (size_t)HALF * K * 2;
    const size_t tstep = 2 * hstep;
    const unsigned ldsw = (unsigned)wid * 1024u;
    const int aoff = lds_byte(wr * 64 + fr, fq * 8), boff = lds_byte(wc * 32 + fr, fq * 8);
#define PG8_SA(b, h) (((b) * 2 + (h)) * HTB)
#define PG8_SB(b, h) ((4 + (b) * 2 + (h)) * HTB)
#define PG8_STAGE(bufoff, gbase, voff) do { _Pragma("unroll") for (int _i = 0; _i < 2; ++_i) \
        __builtin_amdgcn_global_load_lds((const unsigned*)((const char*)(gbase) + (voff)[_i]), (PG8_LAS unsigned*)(lds + (bufoff) + ldsw + _i * 8192), 16, 0, 0); } while (0)
#define PG8_GOFF(dst, k) do { _Pragma("unroll") for (int h_ = 0; h_ < 2; ++h_) _Pragma("unroll") for (int i_ = 0; i_ < 2; ++i_) dst[h_][i_] = (unsigned)(rt[(k) * 256 + h_ * HALF + gR[i_]] * K + gC[i_]) * 2u; } while (0)
#define PG8_STAGE_A(bufoff, ptr, un, h, kb) do { if constexpr (GATHER) { const unsigned o0_ = (un) ? gaN[h][0] : gaC[h][0], o1_ = (un) ? gaN[h][1] : gaC[h][1]; \
        __builtin_amdgcn_global_load_lds((const unsigned*)((const char*)g.A + (kb) + o0_), (PG8_LAS unsigned*)(lds + (bufoff) + ldsw), 16, 0, 0); \
        __builtin_amdgcn_global_load_lds((const unsigned*)((const char*)g.A + (kb) + o1_), (PG8_LAS unsigned*)(lds + (bufoff) + ldsw + 8192), 16, 0, 0); } else PG8_STAGE(bufoff, ptr, voffA); } while (0)
#define PG8_LDA(dst, b, h) do { _Pragma("unroll") for (int m = 0; m < 4; ++m) _Pragma("unroll") for (int k = 0; k < 2; ++k) dst[m][k] = *(const PG8_LAS bf16x8*)(lds + PG8_SA(b, h) + aoff + m * 2048 + k * 1024); } while (0)
#define PG8_LDB(dst, b, h) do { _Pragma("unroll") for (int n = 0; n < 2; ++n) _Pragma("unroll") for (int k = 0; k < 2; ++k) dst[n][k] = *(const PG8_LAS bf16x8*)(lds + PG8_SB(b, h) + boff + n * 2048 + k * 1024); } while (0)
#define PG8_MMA(ai, bj, At, Bt) do { __builtin_amdgcn_s_setprio(1); _Pragma("unroll") for (int m = 0; m < 4; ++m) _Pragma("unroll") for (int n = 0; n < 2; ++n) _Pragma("unroll") for (int k = 0; k < 2; ++k) \
        acc[ai][bj][m][n] = __builtin_amdgcn_mfma_f32_16x16x32_bf16(Bt[n][k], At[m][k], acc[ai][bj][m][n], 0, 0, 0); __builtin_amdgcn_s_setprio(0); } while (0)
#define PG8_WAIT_V(n) asm volatile("s_waitcnt vmcnt(" #n ")" ::: "memory")
#define PG8_WAIT_L(n) asm volatile("s_waitcnt lgkmcnt(" #n ")" ::: "memory")
#define PG8_BAR __builtin_amdgcn_s_barrier()
#define PG8_SCHED __builtin_amdgcn_sched_barrier(0)
    Unit cur, nxt; int ui = 0;
    if (!S.next(0, cur)) return;
    f32x4 acc[2][2][4][2];
#pragma unroll
    for (int a = 0; a < 2; ++a)
#pragma unroll
        for (int b = 0; b < 2; ++b)
#pragma unroll
            for (int m = 0; m < 4; ++m)
#pragma unroll
                for (int n = 0; n < 2; ++n) acc[a][b][m][n] = (f32x4){0.f, 0.f, 0.f, 0.f};
    bf16x8 At[4][2], B0[2][2], B1[2][2];
    const char* cA = (const char*)g.A + (size_t)cur.pm * tstep; const char* cB = (const char*)g.Bt + (size_t)cur.pn * tstep;
    S.a_ready(cur);
    if constexpr (GATHER) {
        PG8_LAS int* pms = rt + 16 * 256;
        if (tid < 16) { Unit u_; pms[tid] = S.next(tid, u_) ? u_.pm : -1; }
        __syncthreads();
        {
            int tok[8];
#pragma unroll
            for (int j = 0; j < 8; ++j) { const int k = 2 * j + (tid >> 8), pm = pms[k]; tok[j] = (pm >= 0) ? rowtok[pm * 256 + (tid & 255)] : 0; }
#pragma unroll
            for (int j = 0; j < 8; ++j) rt[(2 * j + (tid >> 8)) * 256 + (tid & 255)] = tok[j];
        }
        __syncthreads();
        PG8_GOFF(gaC, 0);
    }
    if constexpr (SP2) {
        PG8_STAGE(PG8_SB(0, 0), cB, voffB); PG8_STAGE(PG8_SB(0, 1), cB + hstep, voffB); PG8_STAGE_A(PG8_SA(0, 0), cA, false, 0, (size_t)0); PG8_STAGE_A(PG8_SA(0, 1), cA + hstep, false, 1, (size_t)0);
        if (wr == 1) PG8_BAR;
        PG8_WAIT_V(2); PG8_BAR;
        PG8_STAGE(PG8_SB(1, 0), cB + kstep, voffB); PG8_STAGE_A(PG8_SA(1, 0), cA + kstep, false, 0, kstep); PG8_STAGE(PG8_SB(1, 1), cB + hstep + kstep, voffB);
        PG8_WAIT_V(6); PG8_BAR;
    } else {
        PG8_STAGE(PG8_SB(0, 0), cB, voffB); PG8_STAGE(PG8_SA(0, 0), cA, voffA); PG8_STAGE(PG8_SB(0, 1), cB + hstep, voffB); PG8_STAGE(PG8_SA(0, 1), cA + hstep, voffA);
        if (wr == 1) PG8_BAR;
        PG8_WAIT_V(4); PG8_BAR;
        PG8_STAGE(PG8_SB(1, 0), cB + kstep, voffB); PG8_STAGE(PG8_SA(1, 0), cA + kstep, voffA); PG8_STAGE(PG8_SB(1, 1), cB + hstep + kstep, voffB);
        PG8_WAIT_V(6); PG8_BAR;
    }
    for (;;) {
        const bool has_next = S.next(ui + 1, nxt);
        if constexpr (GATHER) { if (has_next) PG8_GOFF(gaN, ui + 1); }
        const char* nA = has_next ? (const char*)g.A + (size_t)nxt.pm * tstep : cA; const char* nB = has_next ? (const char*)g.Bt + (size_t)nxt.pn * tstep : cB;
        for (int t = 0; t < nt; t += 2) {
            const bool last = (t == nt - 2);
            const char* a1 = cA + (size_t)(t + 1) * kstep;
            const char* a2 = last ? nA : cA + (size_t)(t + 2) * kstep; const char* b2 = last ? nB : cB + (size_t)(t + 2) * kstep;
            const char* a3 = a2 + kstep; const char* b3 = b2 + kstep;
            if (last && has_next) S.a_ready(nxt);
            const bool un = last && has_next; const size_t k1 = (size_t)(t + 1) * kstep, k2 = last ? (size_t)0 : (size_t)(t + 2) * kstep;
            if constexpr (SP2) {
            PG8_LDB(B0, 0, 0); PG8_LDB(B1, 0, 1); PG8_SCHED; PG8_LDA(At, 0, 0); PG8_STAGE_A(PG8_SA(1, 1), a1 + hstep, false, 1, k1);
            PG8_WAIT_V(8); PG8_WAIT_L(0); PG8_BAR; PG8_MMA(0, 0, At, B0); PG8_MMA(0, 1, At, B1); PG8_BAR; PG8_SCHED;
            PG8_LDA(At, 0, 1); PG8_STAGE(PG8_SB(0, 0), b2, voffB); PG8_STAGE(PG8_SB(0, 1), b2 + hstep, voffB); PG8_STAGE_A(PG8_SA(0, 0), a2, un, 0, k2);
            PG8_WAIT_V(8); PG8_WAIT_L(0); PG8_BAR; PG8_MMA(1, 0, At, B0); PG8_MMA(1, 1, At, B1); PG8_BAR; PG8_SCHED;
            PG8_LDB(B0, 1, 0); PG8_LDB(B1, 1, 1); PG8_SCHED; PG8_LDA(At, 1, 0); PG8_STAGE_A(PG8_SA(0, 1), a2 + hstep, un, 1, k2);
            PG8_WAIT_V(8); PG8_WAIT_L(0); PG8_BAR; PG8_MMA(0, 0, At, B0); PG8_MMA(0, 1, At, B1); PG8_BAR; PG8_SCHED;
            PG8_LDA(At, 1, 1); PG8_STAGE(PG8_SB(1, 0), b3, voffB); PG8_STAGE(PG8_SB(1, 1), b3 + hstep, voffB); PG8_STAGE_A(PG8_SA(1, 0), a3, un, 0, k2 + kstep);
            PG8_WAIT_V(8); PG8_WAIT_L(0); PG8_BAR; PG8_MMA(1, 0, At, B0); PG8_MMA(1, 1, At, B1); PG8_BAR; PG8_SCHED;
            } else {
            PG8_LDB(B0, 0, 0); PG8_SCHED; PG8_LDA(At, 0, 0); PG8_STAGE(PG8_SA(1, 1), a1 + hstep, voffA);
            PG8_WAIT_L(8); PG8_BAR; PG8_WAIT_L(0); PG8_MMA(0, 0, At, B0); PG8_BAR; PG8_SCHED;
            PG8_LDB(B1, 0, 1); PG8_STAGE(PG8_SB(0, 0), b2, voffB);
            PG8_BAR; PG8_WAIT_L(0); PG8_MMA(0, 1, At, B1); PG8_BAR;
            PG8_LDA(At, 0, 1); PG8_STAGE(PG8_SA(0, 0), a2, voffA);
            PG8_BAR; PG8_WAIT_L(0); PG8_MMA(1, 0, At, B0); PG8_BAR; PG8_SCHED;
            PG8_STAGE(PG8_SB(0, 1), b2 + hstep, voffB);
            PG8_WAIT_V(6); PG8_BAR; PG8_MMA(1, 1, At, B1); PG8_BAR;
            PG8_LDB(B0, 1, 0); PG8_SCHED; PG8_LDA(At, 1, 0); PG8_STAGE(PG8_SA(0, 1), a2 + hstep, voffA);
            PG8_WAIT_L(8); PG8_BAR; PG8_WAIT_L(0); PG8_MMA(0, 0, At, B0); PG8_BAR; PG8_SCHED;
            PG8_LDB(B1, 1, 1); PG8_STAGE(PG8_SB(1, 0), b3, voffB);
            PG8_BAR; PG8_WAIT_L(0); PG8_MMA(0, 1, At, B1); PG8_BAR;
            PG8_LDA(At, 1, 1); PG8_STAGE(PG8_SA(1, 0), a3, voffA);
            PG8_BAR; PG8_WAIT_L(0); PG8_MMA(1, 0, At, B0); PG8_BAR; PG8_SCHED;
            PG8_STAGE(PG8_SB(1, 1), b3 + hstep, voffB);
            PG8_WAIT_V(6); PG8_BAR; PG8_MMA(1, 1, At, B1); PG8_BAR;
            }
        }
        if constexpr (ALIGN_EPI) { if (wr == 0) PG8_BAR; }
        E(acc, cur, wr, wc, fr, fq); S.done(cur);
        if (!has_next) break;
#pragma unroll
        for (int a = 0; a < 2; ++a)
#pragma unroll
            for (int b = 0; b < 2; ++b)
#pragma unroll
                for (int m = 0; m < 4; ++m)
#pragma unroll
                    for (int n = 0; n < 2; ++n) acc[a][b][m][n] = (f32x4){0.f, 0.f, 0.f, 0.f};
        cur = nxt; cA = nA; cB = nB; ++ui;
        if constexpr (GATHER) { gaC[0][0] = gaN[0][0]; gaC[0][1] = gaN[0][1]; gaC[1][0] = gaN[1][0]; gaC[1][1] = gaN[1][1]; }
        if constexpr (ALIGN_EPI) { if (wr == 1) PG8_BAR; }
    }
    PG8_WAIT_V(0);
    if constexpr (!ALIGN_EPI) { if (wr == 0) PG8_BAR; }
    PG8_BAR;
#undef PG8_SA
#undef PG8_SB
#undef PG8_STAGE
#undef PG8_LDA
#undef PG8_GOFF
#undef PG8_STAGE_A
#undef PG8_LDB
#undef PG8_MMA
#undef PG8_WAIT_V
#undef PG8_WAIT_L
#undef PG8_BAR
#undef PG8_SCHED
}
}

typedef short bf16x8_t __attribute__((ext_vector_type(8)));
typedef float f32x16_t __attribute__((ext_vector_type(16)));
typedef float f32x2_t __attribute__((ext_vector_type(2)));
typedef unsigned u32x4_t __attribute__((ext_vector_type(4)));
typedef unsigned u32x2_t __attribute__((ext_vector_type(2)));
#define LAS3 __attribute__((address_space(3)))
constexpr int ATT_VROW = 68;
constexpr int ATT_LDS_BYTES = 3 * (64 * 104 * 2 + 64 * ATT_VROW * 2);

template <int QKD, int NMAP, bool DA>
__device__ __forceinline__ void attn_item(LAS3 unsigned char* lds, const bf16_t* __restrict__ Qb, const bf16_t* __restrict__ Kb, const bf16_t* __restrict__ Vt,
                                          bf16_t* __restrict__ ycatb, int ycat_off, int b, int h, int qblk, float lam, const float* __restrict__ subln, float post_scale) {
    constexpr int DK = QKD / NMAP, KS = DK / 16, KROW = QKD + 8, KCH = QKD / 8;
    constexpr int KBYTES = 64 * KROW * 2, VBYTES = 64 * ATT_VROW * 2, BUFB = KBYTES + VBYTES;
    const int tid = opaque_tid(), wid = tid >> 6, lane = tid & 63, r = lane & 31, hh = lane >> 5;
    const int q0 = qblk * 256, ntiles = (qblk == 0) ? (NC / 64) : (NT / 64);
    const size_t base = ((size_t)b * 4 + h) * NT;
    bf16x8_t qf[NMAP][KS];
#pragma unroll
    for (int m = 0; m < NMAP; ++m)
#pragma unroll
        for (int ks = 0; ks < KS; ++ks) qf[m][ks] = *(const bf16x8_t*)(Qb + (base + q0 + 32 * wid + r) * QKD + m * DK + 16 * ks + 8 * hh);
    f32x16_t O[NMAP][2]; float mrun[NMAP], lrun[NMAP];
#pragma unroll
    for (int m = 0; m < NMAP; ++m) { mrun[m] = 0.f; lrun[m] = 0.f;
#pragma unroll
        for (int d2 = 0; d2 < 2; ++d2)
#pragma unroll
            for (int i = 0; i < 16; ++i) O[m][d2][i] = 0.f; }
    constexpr int NKC = 64 * KCH;
    const bf16_t* kg = Kb + base * QKD;
    const bf16_t* vg = Vt + ((size_t)(b * 4 + h) * 64 + (tid >> 3)) * NT + (tid & 7) * 8;
    u32x4_t rk0, rk1 = (u32x4_t){0u, 0u, 0u, 0u}, rv;
    const int kc1 = tid + 512;
    const int k0row = tid / KCH, k0col = tid % KCH, k1row = kc1 / KCH, k1col = kc1 % KCH;
#define ATT_LOAD(j) do { rk0 = *(const u32x4_t*)(kg + (size_t)(j) * 64 * QKD + tid * 8); if (NKC > 512 && kc1 < NKC) rk1 = *(const u32x4_t*)(kg + (size_t)(j) * 64 * QKD + kc1 * 8); \
        rv = *(const u32x4_t*)(vg + (size_t)(j) * 64); } while (0)
#define ATT_STORE(buf) do { LAS3 unsigned char* kb_ = lds + (buf) * BUFB; LAS3 unsigned char* vb_ = kb_ + KBYTES; \
        *(LAS3 u32x4_t*)(kb_ + (k0row * KROW + k0col * 8) * 2) = rk0; if (NKC > 512 && kc1 < NKC) *(LAS3 u32x4_t*)(kb_ + (k1row * KROW + k1col * 8) * 2) = rk1; \
        LAS3 unsigned char* vd_ = vb_ + ((tid >> 3) * ATT_VROW + (tid & 7) * 8) * 2; *(LAS3 u32x2_t*)vd_ = (u32x2_t){rv.x, rv.y}; *(LAS3 u32x2_t*)(vd_ + 8) = (u32x2_t){rv.z, rv.w}; } while (0)
    __syncthreads();
    ATT_LOAD(0); ATT_STORE(0);
    if (ntiles > 1) ATT_LOAD(1);
    __syncthreads();
    bf16x8_t pf[NMAP][2][2];
#define ATT_PV(m_, vb_) do { _Pragma("unroll") for (int d2 = 0; d2 < 2; ++d2) _Pragma("unroll") for (int kt = 0; kt < 2; ++kt) _Pragma("unroll") for (int s2 = 0; s2 < 2; ++s2) { \
        const LAS3 unsigned char* vp = (vb_) + ((d2 * 32 + r) * ATT_VROW + kt * 32 + 16 * s2 + 4 * hh) * 2; \
        union { u32x2_t u[2]; bf16x8_t v; } av; av.u[0] = *(const LAS3 u32x2_t*)vp; av.u[1] = *(const LAS3 u32x2_t*)(vp + 16); \
        O[m_][d2] = __builtin_amdgcn_mfma_f32_32x32x16_bf16(av.v, pf[m_][kt][s2], O[m_][d2], 0, 0, 0); } } while (0)
    int sl = 0;
    for (int j = 0; j < ntiles; ++j) {
        const LAS3 unsigned char* kb = lds + sl * BUFB;
        const LAS3 unsigned char* vbp = lds + ((sl == 0) ? 2 : sl - 1) * BUFB + KBYTES;
#pragma unroll
        for (int m = 0; m < NMAP; ++m) {
            f32x16_t S[2];
            const float nm = -mrun[m];
#pragma unroll
            for (int kt = 0; kt < 2; ++kt) {
#pragma unroll
                for (int i = 0; i < 16; ++i) S[kt][i] = nm;
#pragma unroll
                for (int ks = 0; ks < KS; ++ks) {
                    const bf16x8_t a = *(const LAS3 bf16x8_t*)(kb + ((kt * 32 + r) * KROW + m * DK + 16 * ks + 8 * hh) * 2);
                    S[kt] = __builtin_amdgcn_mfma_f32_32x32x16_bf16(a, qf[m][ks], S[kt], 0, 0, 0);
                }
            }
            if (j > 0) ATT_PV(m, vbp);
            float mx = S[0][0];
#pragma unroll
            for (int i = 1; i < 16; ++i) mx = fmaxf(mx, S[0][i]);
#pragma unroll
            for (int i = 0; i < 16; ++i) mx = fmaxf(mx, S[1][i]);
            mx = fmaxf(mx, __shfl_xor(mx, 32));
            if (j == 0 || !__all(mx <= 8.f)) {
                const float dl = (j == 0) ? mx : fmaxf(mx, 0.f);
                mrun[m] += dl;
#pragma unroll
                for (int kt = 0; kt < 2; ++kt)
#pragma unroll
                    for (int i = 0; i < 16; ++i) S[kt][i] -= dl;
                if (j != 0) {
                    const float alpha = __builtin_amdgcn_exp2f(-dl);
                    lrun[m] *= alpha;
#pragma unroll
                    for (int d2 = 0; d2 < 2; ++d2)
#pragma unroll
                        for (int i = 0; i < 16; ++i) O[m][d2][i] *= alpha;
                }
            }
            f32x2_t ps2 = (f32x2_t){0.f, 0.f};
#pragma unroll
            for (int kt = 0; kt < 2; ++kt) {
#pragma unroll
                for (int i = 0; i < 16; i += 2) { const float p0 = __builtin_amdgcn_exp2f(S[kt][i]), p1 = __builtin_amdgcn_exp2f(S[kt][i + 1]); S[kt][i] = p0; S[kt][i + 1] = p1; ps2 += (f32x2_t){p0, p1}; }
#pragma unroll
                for (int s2 = 0; s2 < 2; ++s2) {
                    union { unsigned u[4]; bf16x8_t v; } cv;
#pragma unroll
                    for (int jj = 0; jj < 4; ++jj) cv.u[jj] = cvtpk(S[kt][8 * s2 + 2 * jj], S[kt][8 * s2 + 2 * jj + 1]);
                    pf[m][kt][s2] = cv.v;
                }
            }
            lrun[m] += ps2[0] + ps2[1];
        }
        const int sn = (sl == 2) ? 0 : sl + 1;
        if (j + 1 < ntiles) { ATT_STORE(sn); if (j + 2 < ntiles) ATT_LOAD(j + 2); }
        __syncthreads();
        sl = sn;
    }
    {
        const LAS3 unsigned char* vbl = lds + ((sl == 0) ? 2 : sl - 1) * BUFB + KBYTES;
#pragma unroll
        for (int m = 0; m < NMAP; ++m) ATT_PV(m, vbl);
    }
#undef ATT_PV
#undef ATT_LOAD
#undef ATT_STORE
    float inv[NMAP];
#pragma unroll
    for (int m = 0; m < NMAP; ++m) { const float lt = lrun[m] + __shfl_xor(lrun[m], 32); inv[m] = __builtin_amdgcn_rcpf(lt); }
    if (NMAP == 2) inv[NMAP - 1] *= -lam;
    float ss = 0.f;
#pragma unroll
    for (int d2 = 0; d2 < 2; ++d2)
#pragma unroll
        for (int i = 0; i < 16; ++i) {
            float o = O[0][d2][i] * inv[0];
            if (NMAP == 2) o += O[NMAP - 1][d2][i] * inv[NMAP - 1];
            O[0][d2][i] = o; ss += o * o;
        }
    float rs = 1.f;
    if (DA) { ss += __shfl_xor(ss, 32); rs = rsqrtf(ss * (1.f / 64.f) + 1e-6f) * post_scale; }
    bf16_t* yp = ycatb + ((size_t)b * NT + q0 + 32 * wid + r) * DM + ycat_off + h * 64;
#pragma unroll
    for (int d2 = 0; d2 < 2; ++d2)
#pragma unroll
        for (int g4 = 0; g4 < 4; ++g4) {
            const int dv = 32 * d2 + 8 * g4 + 4 * hh;
            float o0 = O[0][d2][4 * g4] * rs, o1 = O[0][d2][4 * g4 + 1] * rs, o2 = O[0][d2][4 * g4 + 2] * rs, o3 = O[0][d2][4 * g4 + 3] * rs;
            if (DA) { const float4 w = *(const float4*)(subln + dv); o0 *= w.x; o1 *= w.y; o2 *= w.z; o3 *= w.w; }
            *(uint2*)(yp + dv) = make_uint2(cvtpk(o0, o1), cvtpk(o2, o3));
        }
}


typedef float f32x4_t __attribute__((ext_vector_type(4)));
constexpr int ML_KROW = 72, ML_TROW = 136, ML_CROW = 72;
constexpr int ML_OFF_KC = 0, ML_OFF_KT = ML_OFF_KC + 128 * ML_KROW * 2, ML_OFF_VT = ML_OFF_KT + 64 * ML_TROW * 2, ML_OFF_CB = ML_OFF_VT + 80 * ML_TROW * 2,
              ML_OFF_F = ML_OFF_CB + 80 * ML_CROW * 2, ML_LDS_BYTES = ML_OFF_F + 6 * 128 * 4 + 64;
__device__ __forceinline__ void mlstm_item(LAS3 unsigned char* lds, const bf16_t* __restrict__ Qb, const bf16_t* __restrict__ Kb, const bf16_t* __restrict__ Ktg, const bf16_t* __restrict__ Vtg,
                                           const float* __restrict__ G, float* __restrict__ hdir, int b, int h, int dir) {
    const int tid = opaque_tid(), wid = tid >> 6, lane = tid & 63, lr = lane & 15, q = lane >> 4;
    LAS3 unsigned char* Kc = lds + ML_OFF_KC; LAS3 unsigned char* Kt = lds + ML_OFF_KT; LAS3 unsigned char* Vt = lds + ML_OFF_VT; LAS3 unsigned char* Cb = lds + ML_OFF_CB;
    LAS3 float* fl = (LAS3 float*)(lds + ML_OFF_F);
    LAS3 float* s_li = fl; LAS3 float* s_lf = fl + 128; LAS3 float* s_bc2 = fl + 256; LAS3 float* s_gk2 = fl + 384; LAS3 float* s_wu = fl + 512; LAS3 float* s_et = fl + 640; LAS3 float* s_misc = fl + 768;
    const size_t base = ((size_t)b * 4 + h) * NT;
    __syncthreads();
    for (int i = tid; i < 80 * ML_CROW / 2; i += 512) ((LAS3 unsigned*)Cb)[i] = 0u;
    for (int i = tid; i < 16 * ML_TROW / 2; i += 512) ((LAS3 unsigned*)(Vt + 64 * ML_TROW * 2))[i] = (i < ML_TROW / 2) ? 0x3F803F80u : 0u;
    const int ct = wid & 3, rt0 = (wid < 4) ? 0 : 3, nrt = (wid < 4) ? 3 : 2;
    f32x4_t Cacc[3];
#pragma unroll
    for (int i = 0; i < 3; ++i) Cacc[i] = (f32x4_t){0.f, 0.f, 0.f, 0.f};
    const int tq = 16 * wid + lr;
    const int ia = (dir == 0) ? 2 * lane : 127 - 2 * lane, ib = (dir == 0) ? 2 * lane + 1 : 126 - 2 * lane;
    u32x4_t nkc[2], nkt[2], nvt[2]; bf16x8_t nqf[2]; float ngxa = 0.f, ngxb = 0.f, ngla = 0.f, nglb = 0.f;
#define ML_N0(c_) ((dir == 0) ? 128 * (c_) : (((c_) < 2) ? 128 * (1 - (c_)) : NC + 128 * (17 - (c_))))
#define ML_LOAD(c_) do { const int n0_ = ML_N0(c_); \
        _Pragma("unroll") for (int i = 0; i < 2; ++i) { const int id = tid + 512 * i; \
            nkc[i] = *(const u32x4_t*)(Kb + (base + n0_ + (id >> 3)) * 64 + (id & 7) * 8); \
            nkt[i] = *(const u32x4_t*)(Ktg + ((size_t)(b * 4 + h) * 64 + (id >> 4)) * NT + n0_ + (id & 15) * 8); \
            nvt[i] = *(const u32x4_t*)(Vtg + ((size_t)(b * 4 + h) * 64 + (id >> 4)) * NT + n0_ + (id & 15) * 8); } \
        _Pragma("unroll") for (int ks = 0; ks < 2; ++ks) nqf[ks] = *(const bf16x8_t*)(Qb + (base + n0_ + tq) * 64 + 32 * ks + 8 * q); \
        if (wid == 0) { const float* gpa = G + ((size_t)b * NT + n0_ + ia) * 16 + (dir * 2) * 4 + h; const float* gpb = G + ((size_t)b * NT + n0_ + ib) * 16 + (dir * 2) * 4 + h; \
            ngxa = gpa[4]; ngxb = gpb[4]; ngla = gpa[0]; nglb = gpb[0]; } } while (0)
    ML_LOAD(0);
    for (int c = 0; c < NT / 128; ++c) {
        const int n0 = ML_N0(c);
        u32x4_t rkc[2], rkt[2], rvt[2];
        bf16x8_t qf[2];
#pragma unroll
        for (int i = 0; i < 2; ++i) { rkc[i] = nkc[i]; rkt[i] = nkt[i]; rvt[i] = nvt[i]; qf[i] = nqf[i]; }
        const float xa = ngxa, xb = ngxb, lia = ngla, lib = nglb;
        if (c + 1 < NT / 128) ML_LOAD(c + 1);
#pragma unroll
        for (int i = 0; i < 2; ++i) {
            const int id = tid + 512 * i;
            *(LAS3 u32x4_t*)(Kc + ((id >> 3) * ML_KROW + (id & 7) * 8) * 2) = rkc[i];
            *(LAS3 u32x4_t*)(Vt + ((id >> 4) * ML_TROW + (id & 15) * 8) * 2) = rvt[i];
        }
        __syncthreads();
        if (wid == 0) {
            float inc = xa + xb;
#pragma unroll
            for (int o = 1; o < 64; o <<= 1) { const float v = __shfl_up(inc, o); if (lane >= o) inc += v; }
            const float tot = __shfl(inc, 63);
            const float bca = inc - xb, bcb = inc;
            s_bc2[ia] = bca * 1.4426950408889634f; s_bc2[ib] = bcb * 1.4426950408889634f;
            s_gk2[ia] = (bca - lia) * 1.4426950408889634f; s_gk2[ib] = (bcb - lib) * 1.4426950408889634f;
            s_wu[ia] = __expf(tot - bca + lia); s_wu[ib] = __expf(tot - bcb + lib);
            s_et[ia] = __expf(bca); s_et[ib] = __expf(bcb);
            if (lane == 0) s_misc[0] = __expf(tot);
        }
        __syncthreads();
#pragma unroll
        for (int i = 0; i < 2; ++i) {
            const int id = tid + 512 * i; const int tk0 = (id & 15) * 8;
            unsigned w4[4] = {rkt[i].x, rkt[i].y, rkt[i].z, rkt[i].w}; u32x4_t o;
#pragma unroll
            for (int jj = 0; jj < 4; ++jj) {
                const float lo = __uint_as_float(w4[jj] << 16) * s_wu[tk0 + 2 * jj], hi = __uint_as_float(w4[jj] & 0xFFFF0000u) * s_wu[tk0 + 2 * jj + 1];
                o[jj] = cvtpk(lo, hi);
            }
            *(LAS3 u32x4_t*)(Kt + ((id >> 4) * ML_TROW + tk0) * 2) = o;
        }
        f32x4_t S[8];
#pragma unroll
        for (int kt = 0; kt < 8; ++kt) {
            S[kt] = (f32x4_t){0.f, 0.f, 0.f, 0.f};
#pragma unroll
            for (int ks = 0; ks < 2; ++ks) {
                const bf16x8_t a = *(const LAS3 bf16x8_t*)(Kc + ((16 * kt + lr) * ML_KROW + 32 * ks + 8 * q) * 2);
                S[kt] = __builtin_amdgcn_mfma_f32_16x16x32_bf16(a, qf[ks], S[kt], 0, 0, 0);
            }
        }
        const float bct = s_bc2[tq];
#pragma unroll
        for (int kt = 0; kt < 8; ++kt) {
            const f32x4_t gk = *(const LAS3 f32x4_t*)(s_gk2 + 16 * kt + 4 * q);
#pragma unroll
            for (int rg = 0; rg < 4; ++rg) {
                const int si = 16 * kt + 4 * q + rg;
                const bool valid = (dir == 0) ? (si <= tq) : (si >= tq);
                const float w = valid ? __builtin_amdgcn_exp2f(bct - gk[rg]) : 0.f;
                S[kt][rg] *= w;
            }
        }
        bf16x8_t pf[4];
#pragma unroll
        for (int k2 = 0; k2 < 4; ++k2) {
            union { unsigned u[4]; bf16x8_t v; } cv;
            cv.u[0] = cvtpk(S[2 * k2][0], S[2 * k2][1]); cv.u[1] = cvtpk(S[2 * k2][2], S[2 * k2][3]);
            cv.u[2] = cvtpk(S[2 * k2 + 1][0], S[2 * k2 + 1][1]); cv.u[3] = cvtpk(S[2 * k2 + 1][2], S[2 * k2 + 1][3]);
            pf[k2] = cv.v;
        }
        f32x4_t outv[5];
#pragma unroll
        for (int rt = 0; rt < 5; ++rt) {
            f32x4_t acc = (f32x4_t){0.f, 0.f, 0.f, 0.f}, acc2 = (f32x4_t){0.f, 0.f, 0.f, 0.f};
#pragma unroll
            for (int k2 = 0; k2 < 4; ++k2) {
                const LAS3 unsigned char* vp = Vt + ((16 * rt + lr) * ML_TROW + 32 * k2 + 4 * q) * 2;
                union { u32x2_t u[2]; bf16x8_t v; } av;
                av.u[0] = *(const LAS3 u32x2_t*)vp; av.u[1] = *(const LAS3 u32x2_t*)(vp + 32);
                acc = __builtin_amdgcn_mfma_f32_16x16x32_bf16(av.v, pf[k2], acc, 0, 0, 0);
            }
#pragma unroll
            for (int ks = 0; ks < 2; ++ks) {
                const bf16x8_t a = *(const LAS3 bf16x8_t*)(Cb + ((16 * rt + lr) * ML_CROW + 32 * ks + 8 * q) * 2);
                acc2 = __builtin_amdgcn_mfma_f32_16x16x32_bf16(a, qf[ks], acc2, 0, 0, 0);
            }
            outv[rt] = acc + acc2 * s_et[tq];
        }
        {
            const float den = __shfl(outv[4][0], lr);
            const float inv = __builtin_amdgcn_rcpf(fmaxf(fabsf(den), 1.f));
            bf16_t* hp = (bf16_t*)hdir + ((size_t)dir * TT + (size_t)b * NT + n0 + tq) * 256 + h * 64 + 4 * q;
            for (int rt = 0; rt < 4; ++rt) { const f32x4_t ov = outv[rt] * inv; *(uint2*)(hp + 16 * rt) = make_uint2(cvtpk(ov[0], ov[1]), cvtpk(ov[2], ov[3])); }
        }
        __syncthreads();
        {
            const float decay = s_misc[0];
#pragma unroll
            for (int i = 0; i < 3; ++i) Cacc[i] *= decay;
#pragma unroll
            for (int ks = 0; ks < 4; ++ks) {
                const bf16x8_t bb = *(const LAS3 bf16x8_t*)(Kt + ((16 * ct + lr) * ML_TROW + 32 * ks + 8 * q) * 2);
#pragma unroll
                for (int i = 0; i < 3; ++i) if (i < nrt) {
                    const bf16x8_t a = *(const LAS3 bf16x8_t*)(Vt + ((16 * (rt0 + i) + lr) * ML_TROW + 32 * ks + 8 * q) * 2);
                    Cacc[i] = __builtin_amdgcn_mfma_f32_16x16x32_bf16(a, bb, Cacc[i], 0, 0, 0);
                }
            }
#pragma unroll
            for (int i = 0; i < 3; ++i) if (i < nrt) {
#pragma unroll
                for (int rg = 0; rg < 4; ++rg) *(LAS3 bf16_t*)(Cb + ((16 * (rt0 + i) + 4 * q + rg) * ML_CROW + 16 * ct + lr) * 2) = f2bf(Cacc[i][rg]);
            }
        }
        __syncthreads();
    }
#undef ML_LOAD
#undef ML_N0
}

constexpr int S5_UROWS = NT + 64;
constexpr int S5_KROW = 1032, S5_CROW = 136, S5_ZROW = 136;
constexpr int S5_OFF_U = 0, S5_OFF_KM = S5_OFF_U + S5_UROWS * 16 * 2, S5_OFF_CM = S5_OFF_KM + 16 * S5_KROW * 2, S5_OFF_EZ = S5_OFF_CM + 16 * S5_CROW * 2,
              S5_LDS_BYTES = S5_OFF_EZ + 8 * 16 * S5_ZROW * 2;
__device__ __forceinline__ void s5_setup_item(LAS3 unsigned char* lds, int idx, const float* __restrict__ a_re, const float* __restrict__ a_im, const float* __restrict__ log_step,
                                                  const float* __restrict__ b_re, const float* __restrict__ b_im, const float* __restrict__ c_re, const float* __restrict__ c_im,
                                                  bf16_t* __restrict__ KmT, bf16_t* __restrict__ Smat, bf16_t* __restrict__ CmT, float* __restrict__ Aab, float* __restrict__ A64) {
    typedef float apw_t[64][2]; typedef float bb_t[16][2]; typedef float cc_t[64][2];
    LAS3 apw_t* apw = (LAS3 apw_t*)lds;
    LAS3 bb_t* bb = (LAS3 bb_t*)(lds + 32768);
    LAS3 cc_t* cc = (LAS3 cc_t*)(lds + 32768 + 8192);
    const int tid = opaque_tid();
    __syncthreads();
    const float dt = expf(log_step[idx]);
    if (tid < 64) {
        const int p = tid;
        const float ar = fminf(a_re[idx * 64 + p], -1e-4f), ai = a_im[idx * 64 + p];
        const float mag = expf(dt * ar), er = mag * cosf(dt * ai), ei = mag * sinf(dt * ai);
        const float inv = 1.0f / (ar * ar + ai * ai);
        const float fr = ((er - 1.0f) * ar + ei * ai) * inv, fi = (ei * ar - (er - 1.0f) * ai) * inv;
        Aab[(idx * 64 + p) * 2] = er; Aab[(idx * 64 + p) * 2 + 1] = ei;
        const float m64 = expf(64.0f * dt * ar);
        A64[(idx * 64 + p) * 2] = m64 * cosf(64.0f * dt * ai); A64[(idx * 64 + p) * 2 + 1] = m64 * sinf(64.0f * dt * ai);
        for (int hh = 0; hh < 16; ++hh) {
            const float br = b_re[((size_t)idx * 64 + p) * 16 + hh], bi = b_im[((size_t)idx * 64 + p) * 16 + hh];
            bb[p][hh][0] = fr * br - fi * bi; bb[p][hh][1] = fr * bi + fi * br;
        }
    }
    for (int i = tid; i < 64 * 64; i += 512) {
        const int tau = i >> 6, p = i & 63;
        const float ar = fminf(a_re[idx * 64 + p], -1e-4f), ai = a_im[idx * 64 + p];
        const float mag = expf((float)tau * dt * ar);
        apw[tau][p][0] = mag * cosf((float)tau * dt * ai); apw[tau][p][1] = mag * sinf((float)tau * dt * ai);
    }
    for (int i = tid; i < 16 * 64; i += 512) { const int hh = i >> 6, p = i & 63; cc[hh][p][0] = c_re[(size_t)idx * 1024 + i]; cc[hh][p][1] = c_im[(size_t)idx * 1024 + i]; }
    __syncthreads();
    for (int i = tid; i < 16 * 64; i += 512) { const int hh = i >> 6, p = i & 63;
        CmT[((size_t)idx * 16 + hh) * 128 + 2 * p] = f2bf(cc[hh][p][0]); CmT[((size_t)idx * 16 + hh) * 128 + 2 * p + 1] = f2bf(-cc[hh][p][1]); }
    for (int e = tid; e < 64 * 1024; e += 512) {
        const int p = e >> 10, k = e & 1023, i = k >> 4, hp = k & 15;
        const float pr = apw[63 - i][p][0], pi = apw[63 - i][p][1], br = bb[p][hp][0], bi = bb[p][hp][1];
        Smat[((size_t)idx * 128 + 2 * p) * 1024 + k] = f2bf(pr * br - pi * bi);
        Smat[((size_t)idx * 128 + 2 * p + 1) * 1024 + k] = f2bf(pr * bi + pi * br);
    }
    for (int e = tid; e < 16 * 1024; e += 512) {
        const int hh = e >> 10, k = e & 1023, tau = k >> 4, hp = k & 15;
        float acc = 0.f;
        for (int p = 0; p < 64; ++p) {
            const float pr = apw[tau][p][0], pi = apw[tau][p][1], br = bb[p][hp][0], bi = bb[p][hp][1];
            const float wr = pr * br - pi * bi, wi = pr * bi + pi * br;
            acc += cc[hh][p][0] * wr - cc[hh][p][1] * wi;
        }
        KmT[((size_t)idx * 16 + hh) * 1024 + k] = f2bf(acc);
    }
}


__device__ __forceinline__ void s5_item(LAS3 unsigned char* lds, const bf16_t* __restrict__ p, const bf16_t* __restrict__ KmT, const bf16_t* __restrict__ Smat, const bf16_t* __restrict__ CmT,
                                        const float* __restrict__ Aab, const float* __restrict__ A64, float* __restrict__ xs_g, float* __restrict__ ys5, int b, int g, int dir) {
    const int tid = opaque_tid(), wid = tid >> 6, lane = tid & 63, lr = lane & 15, q = lane >> 4;
    const int tix = dir * 16 + g;
    LAS3 unsigned char* U = lds + S5_OFF_U; LAS3 unsigned char* Km = lds + S5_OFF_KM; LAS3 unsigned char* Cm = lds + S5_OFF_CM; LAS3 unsigned char* EZ = lds + S5_OFF_EZ;
    float* xs = xs_g + (size_t)((b * 16 + g) * 2 + dir) * 36 * 128;
    __syncthreads();
    for (int i = tid; i < 16 * 128; i += 512) { const int hh = i >> 7, ch = i & 127;
        *(LAS3 u32x4_t*)(Km + (hh * S5_KROW + ch * 8) * 2) = *(const u32x4_t*)(KmT + ((size_t)tix * 16 + hh) * 1024 + ch * 8); }
    if (tid < 256) { const int hh = tid >> 4, ch = tid & 15;
        *(LAS3 u32x4_t*)(Cm + (hh * S5_CROW + ch * 8) * 2) = *(const u32x4_t*)(CmT + ((size_t)tix * 16 + hh) * 128 + ch * 8); }
    for (int i = tid; i < NT * 2; i += 512) {
        const int sidx = i >> 1, hf = i & 1;
        const int n = seq_token(sidx, dir);
        *(LAS3 u32x4_t*)(U + ((64 + sidx) * 16 + hf * 8) * 2) = *(const u32x4_t*)(p + ((size_t)b * NT + n) * DIN + P_S5 + g * 16 + hf * 8);
    }
    for (int i = tid; i < 64 * 8; i += 512) *(LAS3 unsigned*)(U + i * 4) = 0u;
    __syncthreads();
    {
        f32x4_t acc[3];
#pragma unroll
        for (int i = 0; i < 3; ++i) acc[i] = (f32x4_t){0.f, 0.f, 0.f, 0.f};
        const bf16_t* sp = Smat + ((size_t)tix * 128 + 16 * wid + lr) * 1024 + 8 * q;
        int cco[3];
#pragma unroll
        for (int ctile = 0; ctile < 3; ++ctile) { int ch = 16 * ctile + lr; if (ch > 35) ch = 35; cco[ctile] = ((64 + 64 * ch + (q >> 1)) * 16 + 8 * (q & 1)) * 2; }
#pragma unroll 8
        for (int ks = 0; ks < 32; ++ks) {
            const bf16x8_t a = *(const bf16x8_t*)(sp + 32 * ks);
#pragma unroll
            for (int ctile = 0; ctile < 3; ++ctile) {
                const bf16x8_t bfr = *(const LAS3 bf16x8_t*)(U + cco[ctile] + ks * 64);
                acc[ctile] = __builtin_amdgcn_mfma_f32_16x16x32_bf16(a, bfr, acc[ctile], 0, 0, 0);
            }
        }
        LAS3 float* E = (LAS3 float*)EZ;
#pragma unroll
        for (int ctile = 0; ctile < 3; ++ctile)
#pragma unroll
            for (int rg = 0; rg < 4; ++rg) E[(16 * ctile + lr) * 128 + 16 * wid + 4 * q + rg] = acc[ctile][rg];
    }
    __syncthreads();
    const float Ar = Aab[(tix * 64 + lane) * 2], Ai = Aab[(tix * 64 + lane) * 2 + 1];
    if (wid == 0) {
        const float Br = A64[(tix * 64 + lane) * 2], Bi = A64[(tix * 64 + lane) * 2 + 1];
        const LAS3 float* E = (const LAS3 float*)EZ;
        float xr = 0.f, xi = 0.f;
        for (int c = 0; c < 36; ++c) {
            *(float2*)(xs + c * 128 + 2 * lane) = make_float2(xr, xi);
            const float er = E[c * 128 + 2 * lane], ei = E[c * 128 + 2 * lane + 1];
            const float nr = Br * xr - Bi * xi + er, ni = Br * xi + Bi * xr + ei;
            xr = nr; xi = ni;
        }
    }
    __threadfence_block();
    __syncthreads();
    LAS3 unsigned char* Zw = EZ + wid * (16 * S5_ZROW * 2);
    bf16x8_t cmf[4];
#pragma unroll
    for (int ks = 0; ks < 4; ++ks) cmf[ks] = *(const LAS3 bf16x8_t*)(Cm + (lr * S5_CROW + 32 * ks + 8 * q) * 2);
    bf16x8_t kbr[16];
#pragma unroll
    for (int ks = 0; ks < 16; ++ks) kbr[ks] = *(const LAS3 bf16x8_t*)(Km + (lr * S5_KROW + 8 * q) * 2 + ks * 64);
    float2 xnext = *(const float2*)(xs + wid * 128 + 2 * lane);
    for (int c = wid; c < 36; c += 8) {
        const float2 x0 = xnext;
        if (c + 8 < 36) xnext = *(const float2*)(xs + (c + 8) * 128 + 2 * lane);
        float zr = Ar * x0.x - Ai * x0.y, zi = Ar * x0.y + Ai * x0.x;
#pragma unroll
        for (int rt = 0; rt < 4; ++rt) {
#pragma unroll
            for (int ii = 0; ii < 16; ++ii) {
                *(LAS3 unsigned*)(Zw + (ii * S5_ZROW + 2 * lane) * 2) = cvtpk(zr, zi);
                const float nr = Ar * zr - Ai * zi, ni = Ar * zi + Ai * zr; zr = nr; zi = ni;
            }
            asm volatile("s_waitcnt lgkmcnt(0)" ::: "memory");
            f32x4_t acc = (f32x4_t){0.f, 0.f, 0.f, 0.f};
#pragma unroll
            for (int ks = 0; ks < 4; ++ks) {
                const bf16x8_t a = *(const LAS3 bf16x8_t*)(Zw + (lr * S5_ZROW + 32 * ks + 8 * q) * 2);
                acc = __builtin_amdgcn_mfma_f32_16x16x32_bf16(a, cmf[ks], acc, 0, 0, 0);
            }
            const int irow = 16 * rt + lr;
            const LAS3 unsigned char* up = U + ((64 + 64 * c + irow - (q >> 1)) * 16 + 8 * (q & 1)) * 2;
            const LAS3 unsigned char* kp = Km + (lr * S5_KROW + 8 * q) * 2;
            f32x4_t acc1 = (f32x4_t){0.f, 0.f, 0.f, 0.f};
#pragma unroll
            for (int ks0 = 0; ks0 < 8 * rt + 8; ks0 += 8) {
                bf16x8_t av[8], kv[8];
#pragma unroll
                for (int j = 0; j < 8; ++j) { av[j] = *(const LAS3 bf16x8_t*)(up - (ks0 + j) * 64); if (ks0 + j < 16) kv[j] = kbr[ks0 + j]; else kv[j] = *(const LAS3 bf16x8_t*)(kp + (ks0 + j) * 64); }
#pragma unroll
                for (int j = 0; j < 8; ++j) {
                    const int ks = ks0 + j;
                    if (ks >= 8 * rt) {
                        const bool valid = (2 * ks + (q >> 1)) <= irow;
                        if (!valid) av[j] = (bf16x8_t){0, 0, 0, 0, 0, 0, 0, 0};
                    }
                    if (j & 1) acc1 = __builtin_amdgcn_mfma_f32_16x16x32_bf16(av[j], kv[j], acc1, 0, 0, 0);
                    else acc = __builtin_amdgcn_mfma_f32_16x16x32_bf16(av[j], kv[j], acc, 0, 0, 0);
                }
            }
            acc += acc1;
#pragma unroll
            for (int rg = 0; rg < 4; ++rg) {
                const int n = seq_token(64 * c + 16 * rt + 4 * q + rg, dir);
                ((bf16_t*)ys5)[((size_t)dir * TT + (size_t)b * NT + n) * 256 + g * 16 + lr] = f2bf(acc[rg]);
            }
            asm volatile("s_waitcnt lgkmcnt(0)" ::: "memory");
        }
    }
}

#define XB_TMO      128
#define XB_XCNT(j)  (256  + 64 * (j))
#define XB_XSUB(j)  (1280 + 64 * (j))
#define XB_XGEN(j)  (2304 + 64 * (j))
#define XB_TOP      3328
#define XB_TOPGEN   3392
#define XCD_BAR_WORDS 3456
#define XB_SPIN_CAP (1u << 22)
__device__ __forceinline__ unsigned xb_ld(unsigned* p)              { return __hip_atomic_load(p, __ATOMIC_RELAXED, __HIP_MEMORY_SCOPE_AGENT); }
__device__ __forceinline__ unsigned xb_add(unsigned* p, unsigned v) { return __hip_atomic_fetch_add(p, v, __ATOMIC_RELAXED, __HIP_MEMORY_SCOPE_AGENT); }
__device__ __forceinline__ unsigned xb_xcc_id() { return (unsigned)__builtin_amdgcn_s_getreg((3 << 11) | 20) & 0xFu; }
#define XB_SPIN(cond, bar) do { unsigned _sp = 0; while (cond) { __builtin_amdgcn_s_sleep(1); \
    if ((++_sp & 255u) == 0u) { if (xb_ld(&(bar)[XB_TMO])) break; if (_sp > XB_SPIN_CAP) { atomicAdd(&(bar)[XB_TMO], 1u); break; } } } } while (0)
struct XcdBarrier { unsigned* bar; unsigned x; volatile LAS3 unsigned* st; };
__device__ __forceinline__ XcdBarrier xcd_barrier_post(unsigned* bar, volatile LAS3 unsigned* st) {
    XcdBarrier b; b.bar = bar; b.x = xb_xcc_id(); b.st = st;
    if (threadIdx.x == 0) (void)xb_add(&bar[XB_XCNT(b.x)], 1u);
    return b;
}
__device__ __forceinline__ void xcd_barrier_complete(unsigned* bar, unsigned x, unsigned& nloc, unsigned& nx) {
    const unsigned G = gridDim.x * gridDim.y * gridDim.z;
    unsigned sum, cnt, mine, sp = 0u;
    for (;;) {
        sum = 0u; cnt = 0u; mine = 0u;
#pragma unroll
        for (unsigned j = 0; j < 16; ++j) { const unsigned c = xb_ld(&bar[XB_XCNT(j)]); sum += c; cnt += (c > 0u) ? 1u : 0u; mine = (j == x) ? c : mine; }
        if (sum == G) break;
        __builtin_amdgcn_s_sleep(1);
        if ((++sp & 255u) == 0u) { if (xb_ld(&bar[XB_TMO])) break; if (sp > XB_SPIN_CAP) { atomicAdd(&bar[XB_TMO], 1u); break; } }
    }
    nloc = mine > 0u ? mine : 1u; nx = cnt > 0u ? cnt : 1u;
}
__device__ __forceinline__ void xcd_barrier(const XcdBarrier& b) {
    asm volatile("s_waitcnt vmcnt(0)" ::: "memory");
    __syncthreads();
    if (threadIdx.x == 0) {
        unsigned* bar = b.bar;
        __builtin_amdgcn_s_waitcnt(0);
        unsigned nloc = b.st[0], nx = b.st[1];
        if (nloc == 0u) { xcd_barrier_complete(bar, b.x, nloc, nx); b.st[0] = nloc; b.st[1] = nx; }
        const unsigned old = xb_add(&bar[XB_XSUB(b.x)], 1u);
        const unsigned gen = old / nloc;
        if (old + 1u == (gen + 1u) * nloc) {
            __builtin_amdgcn_fence(__ATOMIC_RELEASE, "agent");
            asm volatile("s_waitcnt vmcnt(0)" ::: "memory");
            const unsigned og = xb_add(&bar[XB_TOP], 1u);
            const unsigned tg = og / nx;
            if (og + 1u == (tg + 1u) * nx) xb_add(&bar[XB_TOPGEN], 1u);
            else XB_SPIN(xb_ld(&bar[XB_TOPGEN]) == tg, bar);
            __builtin_amdgcn_fence(__ATOMIC_ACQUIRE, "agent");
            xb_add(&bar[XB_XGEN(b.x)], 1u);
            asm volatile("s_waitcnt vmcnt(0)" ::: "memory");
        } else {
            XB_SPIN(xb_ld(&bar[XB_XGEN(b.x)]) == gen, bar);
            __builtin_amdgcn_fence(__ATOMIC_ACQUIRE, "agent");
            asm volatile("s_waitcnt vmcnt(0)" ::: "memory");
        }
    }
    __syncthreads();
}

struct Params {
    const float *x, *c, *ctx, *c_ctx, *w_mod, *b_mod, *norm_w, *w_in, *w_out, *da_lambda, *da_subln, *ml_conv_w, *ml_conv_b, *ml_gate_b, *ml_norm,
                *mla_q_norm, *mla_w_uq, *mla_kv_norm, *mla_w_ukv, *s5_a_re, *s5_a_im, *s5_log_step, *s5_b_re, *s5_b_im, *s5_c_re, *s5_c_im, *s5_d, *s5_w_glu, *s5_b_glu,
                *moe_w_router, *moe_b_router, *moe_w_gate_up, *moe_b_gate_up, *moe_w_down, *moe_b_down;
    float* out;
    float *xall, *mod, *ropecs, *lamfull;
    bf16_t *w_in_t, *w_out_t, *wgu_t, *wdn_t, *wq_t, *wkv_t, *wglu_t;
    bf16_t *s5KmT, *s5Smat, *s5CmT; float *s5A, *s5A64, *s5xs;
    bf16_t *hbuf, *pb, *daQ, *daK, *daVt, *mQ, *mK, *mVt, *mlQ, *mlK, *mlKt, *mlVt; float *mlG, *hdir, *ys5;
    bf16_t *ycatb, *ob; float* osq; bf16_t* fb;
    int* top_e; float* top_g; int *posb, *tok_slot;
    int *cnt, *tile_e, *ntiles, *offs, *blkcnt;
    bf16_t *xg, *act, *yexp;
    unsigned* bar; int* queue;
};

template <class T> __device__ __forceinline__ T* uni_ptr(T* p) { const unsigned long long v = (unsigned long long)p; const unsigned lo = __builtin_amdgcn_readfirstlane((unsigned)v), hi = __builtin_amdgcn_readfirstlane((unsigned)(v >> 32)); return (T*)(__attribute__((address_space(1))) T*)(((unsigned long long)hi << 32) | lo); }
__device__ __forceinline__ void store_params(LAS3 Params* PL, const Params& P) {
    PL->x = P.x;
    PL->c = P.c;
    PL->ctx = P.ctx;
    PL->c_ctx = P.c_ctx;
    PL->w_mod = P.w_mod;
    PL->b_mod = P.b_mod;
    PL->norm_w = P.norm_w;
    PL->w_in = P.w_in;
    PL->w_out = P.w_out;
    PL->da_lambda = P.da_lambda;
    PL->da_subln = P.da_subln;
    PL->ml_conv_w = P.ml_conv_w;
    PL->ml_conv_b = P.ml_conv_b;
    PL->ml_gate_b = P.ml_gate_b;
    PL->ml_norm = P.ml_norm;
    PL->mla_q_norm = P.mla_q_norm;
    PL->mla_w_uq = P.mla_w_uq;
    PL->mla_kv_norm = P.mla_kv_norm;
    PL->mla_w_ukv = P.mla_w_ukv;
    PL->s5_a_re = P.s5_a_re;
    PL->s5_a_im = P.s5_a_im;
    PL->s5_log_step = P.s5_log_step;
    PL->s5_b_re = P.s5_b_re;
    PL->s5_b_im = P.s5_b_im;
    PL->s5_c_re = P.s5_c_re;
    PL->s5_c_im = P.s5_c_im;
    PL->s5_d = P.s5_d;
    PL->s5_w_glu = P.s5_w_glu;
    PL->s5_b_glu = P.s5_b_glu;
    PL->moe_w_router = P.moe_w_router;
    PL->moe_b_router = P.moe_b_router;
    PL->moe_w_gate_up = P.moe_w_gate_up;
    PL->moe_b_gate_up = P.moe_b_gate_up;
    PL->moe_w_down = P.moe_w_down;
    PL->moe_b_down = P.moe_b_down;
    PL->out = P.out;
    PL->xall = P.xall;
    PL->mod = P.mod;
    PL->ropecs = P.ropecs;
    PL->lamfull = P.lamfull;
    PL->w_in_t = P.w_in_t;
    PL->w_out_t = P.w_out_t;
    PL->wgu_t = P.wgu_t;
    PL->wdn_t = P.wdn_t;
    PL->wq_t = P.wq_t;
    PL->wkv_t = P.wkv_t;
    PL->wglu_t = P.wglu_t;
    PL->s5KmT = P.s5KmT;
    PL->s5Smat = P.s5Smat;
    PL->s5CmT = P.s5CmT;
    PL->s5A = P.s5A;
    PL->s5A64 = P.s5A64;
    PL->s5xs = P.s5xs;
    PL->hbuf = P.hbuf;
    PL->pb = P.pb;
    PL->daQ = P.daQ;
    PL->daK = P.daK;
    PL->daVt = P.daVt;
    PL->mQ = P.mQ;
    PL->mK = P.mK;
    PL->mVt = P.mVt;
    PL->mlQ = P.mlQ;
    PL->mlK = P.mlK;
    PL->mlKt = P.mlKt;
    PL->mlVt = P.mlVt;
    PL->mlG = P.mlG;
    PL->hdir = P.hdir;
    PL->ys5 = P.ys5;
    PL->ycatb = P.ycatb;
    PL->ob = P.ob;
    PL->osq = P.osq;
    PL->fb = P.fb;
    PL->top_e = P.top_e;
    PL->top_g = P.top_g;
    PL->posb = P.posb;
    PL->tok_slot = P.tok_slot;
    PL->cnt = P.cnt;
    PL->tile_e = P.tile_e;
    PL->ntiles = P.ntiles;
    PL->offs = P.offs;
    PL->blkcnt = P.blkcnt;
    PL->xg = P.xg;
    PL->act = P.act;
    PL->yexp = P.yexp;
    PL->bar = P.bar;
    PL->queue = P.queue;
}
__device__ __forceinline__ Params load_params(const LAS3 Params* PL) {
    Params Q;
    Q.x = uni_ptr(PL->x);
    Q.c = uni_ptr(PL->c);
    Q.ctx = uni_ptr(PL->ctx);
    Q.c_ctx = uni_ptr(PL->c_ctx);
    Q.w_mod = uni_ptr(PL->w_mod);
    Q.b_mod = uni_ptr(PL->b_mod);
    Q.norm_w = uni_ptr(PL->norm_w);
    Q.w_in = uni_ptr(PL->w_in);
    Q.w_out = uni_ptr(PL->w_out);
    Q.da_lambda = uni_ptr(PL->da_lambda);
    Q.da_subln = uni_ptr(PL->da_subln);
    Q.ml_conv_w = uni_ptr(PL->ml_conv_w);
    Q.ml_conv_b = uni_ptr(PL->ml_conv_b);
    Q.ml_gate_b = uni_ptr(PL->ml_gate_b);
    Q.ml_norm = uni_ptr(PL->ml_norm);
    Q.mla_q_norm = uni_ptr(PL->mla_q_norm);
    Q.mla_w_uq = uni_ptr(PL->mla_w_uq);
    Q.mla_kv_norm = uni_ptr(PL->mla_kv_norm);
    Q.mla_w_ukv = uni_ptr(PL->mla_w_ukv);
    Q.s5_a_re = uni_ptr(PL->s5_a_re);
    Q.s5_a_im = uni_ptr(PL->s5_a_im);
    Q.s5_log_step = uni_ptr(PL->s5_log_step);
    Q.s5_b_re = uni_ptr(PL->s5_b_re);
    Q.s5_b_im = uni_ptr(PL->s5_b_im);
    Q.s5_c_re = uni_ptr(PL->s5_c_re);
    Q.s5_c_im = uni_ptr(PL->s5_c_im);
    Q.s5_d = uni_ptr(PL->s5_d);
    Q.s5_w_glu = uni_ptr(PL->s5_w_glu);
    Q.s5_b_glu = uni_ptr(PL->s5_b_glu);
    Q.moe_w_router = uni_ptr(PL->moe_w_router);
    Q.moe_b_router = uni_ptr(PL->moe_b_router);
    Q.moe_w_gate_up = uni_ptr(PL->moe_w_gate_up);
    Q.moe_b_gate_up = uni_ptr(PL->moe_b_gate_up);
    Q.moe_w_down = uni_ptr(PL->moe_w_down);
    Q.moe_b_down = uni_ptr(PL->moe_b_down);
    Q.out = uni_ptr(PL->out);
    Q.xall = uni_ptr(PL->xall);
    Q.mod = uni_ptr(PL->mod);
    Q.ropecs = uni_ptr(PL->ropecs);
    Q.lamfull = uni_ptr(PL->lamfull);
    Q.w_in_t = uni_ptr(PL->w_in_t);
    Q.w_out_t = uni_ptr(PL->w_out_t);
    Q.wgu_t = uni_ptr(PL->wgu_t);
    Q.wdn_t = uni_ptr(PL->wdn_t);
    Q.wq_t = uni_ptr(PL->wq_t);
    Q.wkv_t = uni_ptr(PL->wkv_t);
    Q.wglu_t = uni_ptr(PL->wglu_t);
    Q.s5KmT = uni_ptr(PL->s5KmT);
    Q.s5Smat = uni_ptr(PL->s5Smat);
    Q.s5CmT = uni_ptr(PL->s5CmT);
    Q.s5A = uni_ptr(PL->s5A);
    Q.s5A64 = uni_ptr(PL->s5A64);
    Q.s5xs = uni_ptr(PL->s5xs);
    Q.hbuf = uni_ptr(PL->hbuf);
    Q.pb = uni_ptr(PL->pb);
    Q.daQ = uni_ptr(PL->daQ);
    Q.daK = uni_ptr(PL->daK);
    Q.daVt = uni_ptr(PL->daVt);
    Q.mQ = uni_ptr(PL->mQ);
    Q.mK = uni_ptr(PL->mK);
    Q.mVt = uni_ptr(PL->mVt);
    Q.mlQ = uni_ptr(PL->mlQ);
    Q.mlK = uni_ptr(PL->mlK);
    Q.mlKt = uni_ptr(PL->mlKt);
    Q.mlVt = uni_ptr(PL->mlVt);
    Q.mlG = uni_ptr(PL->mlG);
    Q.hdir = uni_ptr(PL->hdir);
    Q.ys5 = uni_ptr(PL->ys5);
    Q.ycatb = uni_ptr(PL->ycatb);
    Q.ob = uni_ptr(PL->ob);
    Q.osq = uni_ptr(PL->osq);
    Q.fb = uni_ptr(PL->fb);
    Q.top_e = uni_ptr(PL->top_e);
    Q.top_g = uni_ptr(PL->top_g);
    Q.posb = uni_ptr(PL->posb);
    Q.tok_slot = uni_ptr(PL->tok_slot);
    Q.cnt = uni_ptr(PL->cnt);
    Q.tile_e = uni_ptr(PL->tile_e);
    Q.ntiles = uni_ptr(PL->ntiles);
    Q.offs = uni_ptr(PL->offs);
    Q.blkcnt = uni_ptr(PL->blkcnt);
    Q.xg = uni_ptr(PL->xg);
    Q.act = uni_ptr(PL->act);
    Q.yexp = uni_ptr(PL->yexp);
    Q.bar = uni_ptr(PL->bar);
    Q.queue = uni_ptr(PL->queue);
    return Q;
}
constexpr int MK_LDS_MAIN = 147968;
constexpr int MK_LDS_BYTES = MK_LDS_MAIN + 64 + 1024;
enum { PH_SETUP = 0, PH_H0 = 1, PH_LAYER0 = 2, PH_PER_LAYER = 10, PH_TOTAL = 22 };
enum { L_GEMM_IN = 0, L_PREP, L_MIX, L_FINISH, L_GEMM_OUT, L_POST, L_SCATTER, L_GEMM_GU, L_GEMM_DN, L_COMBINE };

__device__ __forceinline__ void conv_tile(LAS3 float* tile, int lane, const float* __restrict__ W, int N, bf16_t* __restrict__ WT, int ldt, int tn, int tk, int mode) {
    const int n0 = tn * 64, k0 = tk * 64;
    const int kq = lane >> 4, n4 = (lane & 15) * 4;
    const int nl = (n0 + n4 < N) ? n0 + n4 : N - 4;
    const float* wp = W + (size_t)(k0 + kq) * N + nl;
    float4 v[16];
#pragma unroll
    for (int j = 0; j < 16; ++j) v[j] = *(const float4*)(wp + (size_t)(4 * j) * N);
#pragma unroll
    for (int j = 0; j < 16; ++j) { LAS3 float* tp = tile + (4 * j + kq) * 65 + n4; tp[0] = v[j].x; tp[1] = v[j].y; tp[2] = v[j].z; tp[3] = v[j].w; }
    asm volatile("s_waitcnt lgkmcnt(0)" ::: "memory");
    {
        const int c = lane & 7;
#pragma unroll
        for (int jn = 0; jn < 8; ++jn) {
            const int n = (lane >> 3) + 8 * jn, gn = n0 + n;
            if (gn < N) {
                int dr = gn;
                if (mode == 1) dr = (gn < 1024) ? ((gn >> 7) * 256 + (gn & 127)) : ((((gn - 1024) >> 7) * 256) + 128 + ((gn - 1024) & 127));
                const LAS3 float* tp = tile + (8 * c) * 65 + n;
                u32x4_t o;
                o.x = pk2bf(tp[0 * 65], tp[1 * 65]); o.y = pk2bf(tp[2 * 65], tp[3 * 65]); o.z = pk2bf(tp[4 * 65], tp[5 * 65]); o.w = pk2bf(tp[6 * 65], tp[7 * 65]);
                *(u32x4_t*)(WT + (size_t)dr * ldt + k0 + 8 * c) = o;
            }
        }
    }
    asm volatile("s_waitcnt lgkmcnt(0)" ::: "memory");
}
constexpr int CV_IN = 38 * 16 * 2, CV_OUT = 256 * 2, CV_GU = 512 * 64, CV_DN = 256 * 64, CV_Q = 18 * 2, CV_KV = 16 * 2, CV_GLU = 16 * 2;
constexpr int CV_TOTAL = CV_IN + CV_OUT + CV_GU + CV_DN + CV_Q + CV_KV + CV_GLU;
__device__ __forceinline__ void conv_dispatch(const Params& P, LAS3 float* tile, int st, int it) {
    const float* W = nullptr; bf16_t* WT = nullptr; int N = 64, ldt = 64, tn = 0, tk = 0, mode = 0;
    if (it < CV_TOTAL) {
        int r = it;
        if (r < CV_IN) { const int bt = r / 608, q = r % 608; W = P.w_in + (size_t)bt * 1024 * DINC; N = DINC; WT = P.w_in_t + (size_t)bt * 2560 * 1024; ldt = 1024; tn = q % 38; tk = q / 38; }
        else if ((r -= CV_IN) < CV_OUT) { const int bt = r / 256, q = r % 256; W = P.w_out + (size_t)bt * 1024 * 1024; N = 1024; WT = P.w_out_t + (size_t)bt * 1024 * 1024; ldt = 1024; tn = q % 16; tk = q / 16; }
        else if ((r -= CV_OUT) < CV_GU) { const int bt = r / 512, q = r % 512; W = P.moe_w_gate_up + (size_t)bt * 1024 * 2048; N = 2048; WT = P.wgu_t + (size_t)bt * 2048 * 1024; ldt = 1024; tn = q % 32; tk = q / 32; mode = 1; }
        else if ((r -= CV_GU) < CV_DN) { const int bt = r / 256, q = r % 256; W = P.moe_w_down + (size_t)bt * 1024 * 1024; N = 1024; WT = P.wdn_t + (size_t)bt * 1024 * 1024; ldt = 1024; tn = q % 16; tk = q / 16; }
        else if ((r -= CV_DN) < CV_Q) { const int bt = r / 18, q = r % 18; W = P.mla_w_uq + (size_t)bt * 192 * 384; N = 384; WT = P.wq_t + (size_t)bt * 384 * 192; ldt = 192; tn = q % 6; tk = q / 6; }
        else if ((r -= CV_Q) < CV_KV) { const int bt = r / 16, q = r % 16; W = P.mla_w_ukv + (size_t)bt * 128 * 512; N = 512; WT = P.wkv_t + (size_t)bt * 512 * 128; ldt = 128; tn = q % 8; tk = q / 8; }
        else { r -= CV_KV; const int bt = r / 16, q = r % 16; W = P.s5_w_glu + (size_t)bt * 256 * 256; N = 256; WT = P.wglu_t + (size_t)bt * 256 * 256; ldt = 256; tn = q % 4; tk = q / 4; }
    }
    if (W) conv_tile(tile, st, W, N, WT, ldt, tn, tk, mode);
}
__device__ __forceinline__ void phase_setup(const Params& P, LAS3 unsigned char* lds) {
    const int tid = opaque_tid(), G = gridDim.x, bid = blockIdx.x;
    for (int it = bid; it < 192; it += G) {
        LAS3 float* sl = (LAS3 float*)lds;
        LAS3 float* red = sl + 9 * 1024;
        __syncthreads();
        for (int i = tid; i < 9 * 1024; i += 512) { const int r = i >> 10, k = i & 1023; sl[i] = siluf_((r < 8) ? P.c[r * 1024 + k] : P.c_ctx[k]); }
        __syncthreads();
        const int l = it / 96, j = (it % 96) * 64 + (tid & 63), kp = tid >> 6;
        const float* w = P.w_mod + (size_t)l * 1024 * 6144 + j;
        float acc[9];
#pragma unroll
        for (int r = 0; r < 9; ++r) acc[r] = 0.f;
#pragma unroll 8
        for (int k = kp * 128; k < kp * 128 + 128; ++k) {
            const float wv = w[(size_t)k * 6144];
#pragma unroll
            for (int r = 0; r < 9; ++r) acc[r] += sl[r * 1024 + k] * wv;
        }
#pragma unroll
        for (int r = 0; r < 9; ++r) red[(kp * 9 + r) * 64 + (tid & 63)] = acc[r];
        __syncthreads();
        for (int i = tid; i < 9 * 64; i += 512) {
            const int r = i >> 6, cc = i & 63; float sacc = 0.f;
#pragma unroll
            for (int k2 = 0; k2 < 8; ++k2) sacc += red[(k2 * 9 + r) * 64 + cc];
            const int jj = (it % 96) * 64 + cc;
            P.mod[((size_t)l * 9 + r) * 6144 + jj] = sacc + P.b_mod[l * 6144 + jj];
        }
    }
    for (int i = bid * 512 + tid; i < NS * 16; i += G * 512) {
        const int pos = i >> 4, j = i & 15; const int row = pos / 64, col = pos % 64;
        const float inv = exp2f(-(float)(j & 7) * 1.6609640474436813f), ang = (float)((j < 8) ? row : col) * inv;
        P.ropecs[i * 2] = cosf(ang); P.ropecs[i * 2 + 1] = sinf(ang);
    }
    if (bid == G - 1 && tid < 2) {
        const int l = tid; const float* lam = P.da_lambda + l * 128; float s1 = 0.f, s2 = 0.f;
        for (int i = 0; i < 32; ++i) { s1 += lam[i] * lam[32 + i]; s2 += lam[64 + i] * lam[96 + i]; }
        P.lamfull[l] = expf(s1) - expf(s2) + ((l == 0) ? 0.2f : 0.35550906759096927f);
    }
    for (int it = G - 1 - bid; it < 64; it += G)
        s5_setup_item(lds, it, P.s5_a_re, P.s5_a_im, P.s5_log_step, P.s5_b_re, P.s5_b_im, P.s5_c_re, P.s5_c_im, P.s5KmT, P.s5Smat, P.s5CmT, P.s5A, P.s5A64);
    for (int i = bid * 512 + tid; i < 2 * 144 * 1024 / 8; i += G * 512) {
        const int l = i / (144 * 128), r = i % (144 * 128);
        *(u32x4_t*)(P.w_in_t + ((size_t)l * 2560 + DINC) * 1024 + (size_t)r * 8) = (u32x4_t){0u, 0u, 0u, 0u};
    }
    __syncthreads();
    {
        const int wv = __builtin_amdgcn_readfirstlane(tid >> 6), lane = tid & 63;
        LAS3 float* tile = (LAS3 float*)lds + wv * (64 * 65);
        for (;;) {
            int base = 0;
            if (lane == 0) base = atomicAdd(P.queue + 2, 4);
            base = __builtin_amdgcn_readfirstlane(base);
            if (base >= CV_TOTAL) break;
            for (int it = base; it < base + 4 && it < CV_TOTAL; ++it) conv_dispatch(P, tile, lane, it);
        }
    }
}

__device__ __forceinline__ void row_modulate_store(const float (&xv)[16], const LAS3 float* nw, const LAS3 float* modr, bf16_t* __restrict__ dst, int lane) {
    float ss = 0.f;
#pragma unroll
    for (int i = 0; i < 16; ++i) ss += xv[i] * xv[i];
    ss = wave_sum(ss);
    const float rstd = rsqrtf(ss * (1.f / DM) + 1e-6f);
#pragma unroll
    for (int j = 0; j < 4; ++j) {
        const int d = j * 256 + lane * 4;
        const f32x4_t w = *(const LAS3 f32x4_t*)(nw + d), sh = *(const LAS3 f32x4_t*)(modr + d), sc = *(const LAS3 f32x4_t*)(modr + 1024 + d);
        const float o0 = xv[j * 4 + 0] * rstd * w[0] * (1.f + sc[0]) + sh[0], o1 = xv[j * 4 + 1] * rstd * w[1] * (1.f + sc[1]) + sh[1];
        const float o2 = xv[j * 4 + 2] * rstd * w[2] * (1.f + sc[2]) + sh[2], o3 = xv[j * 4 + 3] * rstd * w[3] * (1.f + sc[3]) + sh[3];
        *(uint2*)(dst + d) = make_uint2(cvtpk(o0, o1), cvtpk(o2, o3));
    }
}
__device__ __forceinline__ void phase_h0(const Params& P, LAS3 unsigned char* lds) {
    const int tid = opaque_tid(); const int lane = tid & 63, gw = blockIdx.x * 8 + (tid >> 6), NW = gridDim.x * 8;
    LAS3 float* cw = (LAS3 float*)lds;
    for (int i = tid; i < 256; i += 512) *(LAS3 f32x4_t*)(cw + i * 4) = *(const f32x4_t*)(P.norm_w + i * 4);
    for (int i = tid; i < 9 * 512; i += 512) { const int r = i >> 9, k = i & 511; *(LAS3 f32x4_t*)(cw + 1024 + r * 2048 + k * 4) = *(const f32x4_t*)(P.mod + (size_t)r * 6144 + k * 4); }
    __syncthreads();
    for (int t = gw; t < TT; t += NW) {
        const int b = t / NT, n = t % NT;
        const float* src = (n < NC) ? P.ctx + ((size_t)b * NC + n) * DM : P.x + ((size_t)b * NS + (n - NC)) * DM;
        float xv[16];
#pragma unroll
        for (int j = 0; j < 4; ++j) { const float4 v = *(const float4*)(src + j * 256 + lane * 4); xv[j * 4] = v.x; xv[j * 4 + 1] = v.y; xv[j * 4 + 2] = v.z; xv[j * 4 + 3] = v.w; }
        row_modulate_store(xv, cw, cw + 1024 + ((n < NC) ? 8 : b) * 2048, P.hbuf + (size_t)t * DM, lane);
    }
}

constexpr int TS_ROW = 264;
__device__ __forceinline__ void write_transposed(const LAS3 bf16_t* ts, bf16_t* __restrict__ dst, int b, int n0, int tid) {
    const int ch = tid & 255, hf = tid >> 8;
    bf16_t* vp = dst + (((size_t)b * 4 + (ch >> 6)) * 64 + (ch & 63)) * NT + n0 + hf * 32;
#pragma unroll
    for (int tc = 0; tc < 4; ++tc) {
        const LAS3 bf16_t* tp = ts + (hf * 32 + tc * 8) * TS_ROW + ch;
        u32x4_t o;
        o.x = (unsigned)tp[0] | ((unsigned)tp[TS_ROW] << 16); o.y = (unsigned)tp[2 * TS_ROW] | ((unsigned)tp[3 * TS_ROW] << 16);
        o.z = (unsigned)tp[4 * TS_ROW] | ((unsigned)tp[5 * TS_ROW] << 16); o.w = (unsigned)tp[6 * TS_ROW] | ((unsigned)tp[7 * TS_ROW] << 16);
        *(u32x4_t*)(vp + tc * 8) = o;
    }
}
__device__ __forceinline__ void unpack8(const u32x4_t v, float (&f)[8]) {
    f[0] = __uint_as_float(v.x << 16); f[1] = __uint_as_float(v.x & 0xFFFF0000u); f[2] = __uint_as_float(v.y << 16); f[3] = __uint_as_float(v.y & 0xFFFF0000u);
    f[4] = __uint_as_float(v.z << 16); f[5] = __uint_as_float(v.z & 0xFFFF0000u); f[6] = __uint_as_float(v.w << 16); f[7] = __uint_as_float(v.w & 0xFFFF0000u);
}
__device__ __forceinline__ u32x4_t pack8(const float (&f)[8]) { return (u32x4_t){cvtpk(f[0], f[1]), cvtpk(f[2], f[3]), cvtpk(f[4], f[5]), cvtpk(f[6], f[7])}; }

__device__ __forceinline__ void prep_da(const Params& P, LAS3 unsigned char* lds, int tile) {
    const int tid = opaque_tid();
    const int t0 = tile * 64, b = t0 / NT, n0 = t0 % NT;
    LAS3 bf16_t* vs = (LAS3 bf16_t*)lds;
    const float qscale = 0.17677669529663687f * 1.4426950408889634f;
    const bf16_t* __restrict__ pbr = P.pb; const float* __restrict__ rcs = P.ropecs;
    __syncthreads();
    {
        u32x4_t vv[4];
#pragma unroll
        for (int u = 0; u < 4; ++u) { const int id = tid + 512 * u, i = id >> 5, cg = id & 31; vv[u] = *(const u32x4_t*)(pbr + (size_t)(t0 + i) * DIN + P_DAV + cg * 8); }
#pragma unroll
        for (int u = 0; u < 4; ++u) { const int id = tid + 512 * u, i = id >> 5, cg = id & 31; *(LAS3 u32x4_t*)(vs + i * TS_ROW + cg * 8) = vv[u]; }
    }
#pragma unroll
    for (int u0 = 0; u0 < 4; u0 += 2) {
        u32x4_t lo[2], hi[2]; float4 cs[2][4];
#pragma unroll
        for (int u = 0; u < 2; ++u) {
            const int id = tid + 512 * (u0 + u), i = id >> 5, pu = id & 31, isk = pu >> 4, blk = (pu >> 1) & 7, pr = pu & 1;
            const bf16_t* src = pbr + (size_t)(t0 + i) * DIN + (isk ? P_DAK : P_DAQ) + blk * 32 + pr * 8;
            lo[u] = *(const u32x4_t*)src; hi[u] = *(const u32x4_t*)(src + 16);
            const int pos = max(n0 + i - NC, 0);
            const float4* cp = (const float4*)(rcs + (pos * 16 + pr * 8) * 2);
            cs[u][0] = cp[0]; cs[u][1] = cp[1]; cs[u][2] = cp[2]; cs[u][3] = cp[3];
        }
#pragma unroll
        for (int u = 0; u < 2; ++u) {
            const int id = tid + 512 * (u0 + u), i = id >> 5, pu = id & 31, isk = pu >> 4, blk = (pu >> 1) & 7, pr = pu & 1;
            const int n = n0 + i; const bool lat = n >= NC;
            float fl[8], fh[8], ol[8], oh[8];
            unpack8(lo[u], fl); unpack8(hi[u], fh);
            const float cc[8] = {cs[u][0].x, cs[u][0].z, cs[u][1].x, cs[u][1].z, cs[u][2].x, cs[u][2].z, cs[u][3].x, cs[u][3].z};
            const float sn[8] = {cs[u][0].y, cs[u][0].w, cs[u][1].y, cs[u][1].w, cs[u][2].y, cs[u][2].w, cs[u][3].y, cs[u][3].w};
            const float sc = isk ? 1.f : qscale;
#pragma unroll
            for (int e = 0; e < 8; ++e) {
                const float c1 = lat ? cc[e] : 1.f, s1 = lat ? sn[e] : 0.f;
                ol[e] = (fl[e] * c1 - fh[e] * s1) * sc; oh[e] = (fh[e] * c1 + fl[e] * s1) * sc;
            }
            bf16_t* dst = (isk ? P.daK : P.daQ) + (((size_t)b * 4 + (blk >> 1)) * NT + n) * 64 + (blk & 1) * 32 + pr * 8;
            *(u32x4_t*)dst = pack8(ol); *(u32x4_t*)(dst + 16) = pack8(oh);
        }
    }
    __syncthreads();
    write_transposed(vs, P.daVt, b, n0, tid);
}
__device__ __forceinline__ void prep_ml(const Params& P, LAS3 unsigned char* lds, int tile, int l) {
    const int tid = opaque_tid();
    const int t0 = tile * 64, b = t0 / NT, n0 = t0 % NT;
    LAS3 bf16_t* ks = (LAS3 bf16_t*)lds; LAS3 bf16_t* vs = ks + 64 * TS_ROW; LAS3 float* cwl = (LAS3 float*)(vs + 64 * TS_ROW);
    const int seg_lo = (n0 < NC) ? 0 : NC, seg_hi = (n0 < NC) ? NC - 1 : NT - 1;
    const bf16_t* __restrict__ pbr = P.pb;
    __syncthreads();
    for (int i = tid; i < 2048; i += 512) cwl[i] = (i < 1536) ? P.ml_conv_w[l * 1536 + i] : P.ml_conv_b[l * 512 + (i - 1536)];
    {
        u32x4_t vv[4];
#pragma unroll
        for (int u = 0; u < 4; ++u) { const int id = tid + 512 * u, i = id >> 5, cg = id & 31; vv[u] = *(const u32x4_t*)(pbr + (size_t)(t0 + i) * DIN + P_MLV + cg * 8); }
#pragma unroll
        for (int u = 0; u < 4; ++u) { const int id = tid + 512 * u, i = id >> 5, cg = id & 31; *(LAS3 u32x4_t*)(vs + i * TS_ROW + cg * 8) = vv[u]; }
        if (tid < 128) {
            const int i = tid >> 1, hf = tid & 1; float g[8];
            unpack8(*(const u32x4_t*)(pbr + (size_t)(t0 + i) * DIN + P_MLG + hf * 8), g);
#pragma unroll
            for (int e = 0; e < 8; ++e) { const int c = hf * 8 + e; g[e] += P.ml_gate_b[l * 16 + c]; if ((c >> 2) & 1) g[e] = logsigmoidf_(g[e]); }
            float* gp = P.mlG + ((size_t)t0 + i) * 16 + hf * 8;
            *(float4*)gp = make_float4(g[0], g[1], g[2], g[3]); *(float4*)(gp + 4) = make_float4(g[4], g[5], g[6], g[7]);
        }
    }
    __syncthreads();
#pragma unroll 1
    for (int u0 = 0; u0 < 8; u0 += 2) {
        u32x4_t xm[2], x0[2], xp[2];
#pragma unroll
        for (int u = 0; u < 2; ++u) {
            const int id = tid + 512 * (u0 + u), i = id >> 6, cg = id & 63, n = n0 + i;
            const int nm = max(n - 1, seg_lo), np = min(n + 1, seg_hi);
            const bf16_t* base = pbr + (size_t)b * NT * DIN + P_MLQK + cg * 8;
            xm[u] = *(const u32x4_t*)(base + (size_t)nm * DIN); x0[u] = *(const u32x4_t*)(base + (size_t)n * DIN); xp[u] = *(const u32x4_t*)(base + (size_t)np * DIN);
        }
#pragma unroll
        for (int u = 0; u < 2; ++u) {
            const int id = tid + 512 * (u0 + u), i = id >> 6, cg = id & 63, n = n0 + i;
            const float m0 = (n - 1 >= seg_lo) ? 1.f : 0.f, m2 = (n + 1 <= seg_hi) ? 1.f : 0.f;
            float a[8], c0[8], d[8], y[8];
            unpack8(xm[u], a); unpack8(x0[u], c0); unpack8(xp[u], d);
            const LAS3 float* w = cwl + cg * 8;
#pragma unroll
            for (int e = 0; e < 8; ++e) {
                float v = w[1536 + e] + a[e] * w[e] * m0 + c0[e] * w[512 + e] + d[e] * w[1024 + e] * m2;
                v = siluf_(v); if (cg >= 32) v *= 0.125f;
                y[e] = v;
            }
            const u32x4_t o = pack8(y);
            const int cc = (cg & 31) * 8;
            bf16_t* dst = ((cg < 32) ? P.mlQ : P.mlK) + (((size_t)b * 4 + (cc >> 6)) * NT + n) * 64 + (cc & 63);
            *(u32x4_t*)dst = o;
            if (cg >= 32) *(LAS3 u32x4_t*)(ks + i * TS_ROW + cc) = o;
        }
    }
    __syncthreads();
    write_transposed(ks, P.mlKt, b, n0, tid);
    write_transposed(vs, P.mlVt, b, n0, tid);
}
__device__ __forceinline__ void prep_mla(const Params& P, LAS3 unsigned char* lds, int tile, int l) {
    const int tid = opaque_tid(), wid = tid >> 6, lane = tid & 63, lr = lane & 15, q = lane >> 4;
    const int t0 = tile * 64, b = t0 / NT, n0 = t0 % NT;
    constexpr int AROW = 328;
    LAS3 bf16_t* As = (LAS3 bf16_t*)lds;
    const float qscale = 0.10206207261596575f * 1.4426950408889634f;
    const float* qn = P.mla_q_norm + l * 192; const float* kvn = P.mla_kv_norm + l * 128;
    const bf16_t* __restrict__ pbr = P.pb; bf16_t* __restrict__ oMK = P.mK; const float* __restrict__ rcs = P.ropecs;
    __syncthreads();
    {
        const int i = tid >> 3, sidx = tid & 7;
        const bf16_t* pr = pbr + (size_t)(t0 + i) * DIN;
        u32x4_t cqv[3], ckv[2];
#pragma unroll
        for (int u = 0; u < 3; ++u) cqv[u] = *(const u32x4_t*)(pr + P_CQ + (sidx + 8 * u) * 8);
#pragma unroll
        for (int u = 0; u < 2; ++u) ckv[u] = *(const u32x4_t*)(pr + P_CKV + (sidx + 8 * u) * 8);
        float fq[3][8], fk[2][8]; float sq = 0.f, sk = 0.f;
#pragma unroll
        for (int u = 0; u < 3; ++u) { unpack8(cqv[u], fq[u]);
#pragma unroll
            for (int e = 0; e < 8; ++e) sq += fq[u][e] * fq[u][e]; }
#pragma unroll
        for (int u = 0; u < 2; ++u) { unpack8(ckv[u], fk[u]);
#pragma unroll
            for (int e = 0; e < 8; ++e) sk += fk[u][e] * fk[u][e]; }
#pragma unroll
        for (int o = 1; o < 8; o <<= 1) { sq += __shfl_xor(sq, o); sk += __shfl_xor(sk, o); }
        const float rq = rsqrtf(sq * (1.f / 192.f) + 1e-6f), rk = rsqrtf(sk * (1.f / 128.f) + 1e-6f);
#pragma unroll
        for (int u = 0; u < 3; ++u) { const int c0 = (sidx + 8 * u) * 8; float o[8];
#pragma unroll
            for (int e = 0; e < 8; ++e) o[e] = fq[u][e] * rq * qn[c0 + e];
            *(LAS3 u32x4_t*)(As + i * AROW + c0) = pack8(o); }
#pragma unroll
        for (int u = 0; u < 2; ++u) { const int c0 = (sidx + 8 * u) * 8; float o[8];
#pragma unroll
            for (int e = 0; e < 8; ++e) o[e] = fk[u][e] * rk * kvn[c0 + e];
            *(LAS3 u32x4_t*)(As + i * AROW + 192 + c0) = pack8(o); }
    }
    if (tid < 256) {
        const int i = tid >> 2, c = tid & 3, n = n0 + i; const bool lat = n >= NC;
        const bf16_t* pr = pbr + (size_t)(t0 + i) * DIN + P_KR;
        const u32x4_t kav = *(const u32x4_t*)(pr + 8 * c), kbv = *(const u32x4_t*)(pr + 8 * (c ^ 2));
        const int pos = max(n - NC, 0);
        const float4* cp = (const float4*)(rcs + (pos * 16 + 8 * (c & 1)) * 2);
        const float4 c0 = cp[0], c1 = cp[1], c2 = cp[2], c3 = cp[3];
        const float sg = (c < 2) ? -1.f : 1.f;
        float ka[8], kb2[8], ko[8];
        unpack8(kav, ka); unpack8(kbv, kb2);
#define RK_(e, cc, ss) ko[e] = ka[e] * (lat ? (cc) : 1.f) + kb2[e] * (lat ? (ss) * sg : 0.f)
        RK_(0, c0.x, c0.y); RK_(1, c0.z, c0.w); RK_(2, c1.x, c1.y); RK_(3, c1.z, c1.w); RK_(4, c2.x, c2.y); RK_(5, c2.z, c2.w); RK_(6, c3.x, c3.y); RK_(7, c3.z, c3.w);
#undef RK_
        const u32x4_t ov = pack8(ko);
#pragma unroll
        for (int hh = 0; hh < 4; ++hh) *(u32x4_t*)(oMK + (((size_t)b * 4 + hh) * NT + n) * 96 + 64 + 8 * c) = ov;
    }
    __syncthreads();
    const int h = wid >> 1;
    if ((wid & 1) == 0) {
        const bf16_t* wt = P.wq_t + (size_t)l * 384 * 192;
        f32x4_t acc[4][6];
#pragma unroll
        for (int rt = 0; rt < 4; ++rt)
#pragma unroll
            for (int ct = 0; ct < 6; ++ct) acc[rt][ct] = (f32x4_t){0.f, 0.f, 0.f, 0.f};
#pragma unroll
        for (int ks = 0; ks < 6; ++ks) {
            bf16x8_t a[4];
#pragma unroll
            for (int rt = 0; rt < 4; ++rt) a[rt] = *(const LAS3 bf16x8_t*)(As + (16 * rt + lr) * AROW + 32 * ks + 8 * q);
#pragma unroll
            for (int ct = 0; ct < 6; ++ct) {
                const bf16x8_t bb = *(const bf16x8_t*)(wt + (size_t)(h * 96 + 16 * ct + lr) * 192 + 32 * ks + 8 * q);
#pragma unroll
                for (int rt = 0; rt < 4; ++rt) acc[rt][ct] = __builtin_amdgcn_mfma_f32_16x16x32_bf16(bb, a[rt], acc[rt][ct], 0, 0, 0);
            }
        }
#pragma unroll
        for (int rt = 0; rt < 4; ++rt) {
            const int n = n0 + 16 * rt + lr;
            bf16_t* qp = P.mQ + (((size_t)b * 4 + h) * NT + n) * 96;
#pragma unroll
            for (int ct = 0; ct < 4; ++ct)
                *(uint2*)(qp + 16 * ct + 4 * q) = make_uint2(cvtpk(acc[rt][ct][0] * qscale, acc[rt][ct][1] * qscale), cvtpk(acc[rt][ct][2] * qscale, acc[rt][ct][3] * qscale));
            f32x4_t x1 = acc[rt][4], x2 = acc[rt][5];
            if (n >= NC) {
                const float4* cp = (const float4*)(rcs + ((n - NC) * 16 + 4 * q) * 2);
                const float4 ca = cp[0], cb = cp[1];
                const f32x4_t co = (f32x4_t){ca.x, ca.z, cb.x, cb.z}, si = (f32x4_t){ca.y, ca.w, cb.y, cb.w};
                const f32x4_t o1 = x1 * co - x2 * si, o2 = x2 * co + x1 * si; x1 = o1; x2 = o2;
            }
            *(uint2*)(qp + 64 + 4 * q) = make_uint2(cvtpk(x1[0] * qscale, x1[1] * qscale), cvtpk(x1[2] * qscale, x1[3] * qscale));
            *(uint2*)(qp + 80 + 4 * q) = make_uint2(cvtpk(x2[0] * qscale, x2[1] * qscale), cvtpk(x2[2] * qscale, x2[3] * qscale));
        }
    } else {
        const bf16_t* wt = P.wkv_t + (size_t)l * 512 * 128;
#pragma unroll
        for (int pass = 0; pass < 2; ++pass) {
            f32x4_t acc[4][4];
#pragma unroll
            for (int rt = 0; rt < 4; ++rt)
#pragma unroll
                for (int ct = 0; ct < 4; ++ct) acc[rt][ct] = (f32x4_t){0.f, 0.f, 0.f, 0.f};
#pragma unroll
            for (int ks = 0; ks < 4; ++ks) {
                bf16x8_t a[4];
#pragma unroll
                for (int rt = 0; rt < 4; ++rt) a[rt] = *(const LAS3 bf16x8_t*)(As + (16 * rt + lr) * AROW + 192 + 32 * ks + 8 * q);
#pragma unroll
                for (int ct = 0; ct < 4; ++ct) {
                    const bf16x8_t bb = *(const bf16x8_t*)(wt + (size_t)(h * 128 + 16 * (4 * pass + ct) + lr) * 128 + 32 * ks + 8 * q);
#pragma unroll
                    for (int rt = 0; rt < 4; ++rt)
                        acc[rt][ct] = (pass == 0) ? __builtin_amdgcn_mfma_f32_16x16x32_bf16(bb, a[rt], acc[rt][ct], 0, 0, 0) : __builtin_amdgcn_mfma_f32_16x16x32_bf16(a[rt], bb, acc[rt][ct], 0, 0, 0);
                }
            }
#pragma unroll
            for (int rt = 0; rt < 4; ++rt) {
                if (pass == 0) {
                    const int n = n0 + 16 * rt + lr;
                    bf16_t* kp = P.mK + (((size_t)b * 4 + h) * NT + n) * 96;
#pragma unroll
                    for (int ct = 0; ct < 4; ++ct) *(uint2*)(kp + 16 * ct + 4 * q) = make_uint2(cvtpk(acc[rt][ct][0], acc[rt][ct][1]), cvtpk(acc[rt][ct][2], acc[rt][ct][3]));
                } else {
#pragma unroll
                    for (int ct = 0; ct < 4; ++ct) {
                        bf16_t* vp = P.mVt + (((size_t)b * 4 + h) * 64 + 16 * ct + lr) * NT + n0 + 16 * rt + 4 * q;
                        *(uint2*)vp = make_uint2(cvtpk(acc[rt][ct][0], acc[rt][ct][1]), cvtpk(acc[rt][ct][2], acc[rt][ct][3]));
                    }
                }
            }
        }
    }
}
__device__ __forceinline__ void phase_prep(const Params& P, LAS3 unsigned char* lds, int l) {
    if (gridDim.x == 256) {
        const int w = blockIdx.x, nr = (w >= 128 && w < 224) ? 4 : 3;
        for (int r = 0; r < nr; ++r) {
            int q = -1, tile = 0;
            if (w < 128) { if (r < 2) tile = 2 * w + r; else q = w; }
            else if (w < 224) q = 128 + 4 * (w - 128) + r;
            else { if (r == 0) tile = 256 + (w - 224); else q = 512 + 2 * (w - 224) + (r - 1); }
            if (q < 0) prep_mla(P, lds, tile, l); else if ((q & 1) == 0) prep_ml(P, lds, q >> 1, l); else prep_da(P, lds, q >> 1);
        }
    } else
    for (int it = blockIdx.x; it < 3 * (TT / 64); it += gridDim.x) {
        const int fn = it % 3, tile = it / 3;
        if (fn == 0) prep_mla(P, lds, tile, l); else if (fn == 1) prep_ml(P, lds, tile, l); else prep_da(P, lds, tile);
    }
}

__device__ __forceinline__ void phase_mix(const Params& P, LAS3 unsigned char* lds, int l) {
    const int bid = blockIdx.x, G = gridDim.x;
    const float lambda_init = (l == 0) ? 0.2f : 0.35550906759096927f;
    for (int it = bid; it < 256; it += G)
    {
        const int pr = (it & 7) * 4 + (it >> 6), qb = (it >> 3) & 7;
        attn_item<64, 2, true>(lds, P.daQ, P.daK, P.daVt, P.ycatb, 0, pr >> 2, pr & 3, 1 + qb, P.lamfull[l], P.da_subln + l * 64, 1.f - lambda_init);
    }
    LAS3 int* slot = (LAS3 int*)(lds + MK_LDS_MAIN + 16);
    const int n_ml = 64, n_mla = 256, n_s5 = 256, n_ctx = (l == 0) ? 64 : 0;
    const int total = n_ml + n_mla + n_s5 + n_ctx;
    for (;;) {
        __syncthreads();
        if (threadIdx.x == 0) *slot = atomicAdd(P.queue + l, 1);
        __syncthreads();
        int it = __builtin_amdgcn_readfirstlane(*slot);
        if (it >= total) break;
        int kind, b, h, x3;
        if (it < n_ml) { kind = 1; b = it >> 3; h = (it >> 1) & 3; x3 = it & 1; }
        else if ((it -= n_ml) < n_mla) { kind = 2; b = it >> 5; h = (it >> 3) & 3; x3 = 1 + (it & 7); }
        else if ((it -= n_mla) < n_s5) { kind = 3; b = it >> 5; h = (it >> 1) & 15; x3 = it & 1; }
        else { it -= n_s5; kind = (it < 32) ? 0 : 2; it &= 31; b = it >> 2; h = it & 3; x3 = 0; }
        if (kind == 0) attn_item<64, 2, true>(lds, P.daQ, P.daK, P.daVt, P.ycatb, 0, b, h, x3, P.lamfull[l], P.da_subln + l * 64, 1.f - lambda_init);
        else if (kind == 1) mlstm_item(lds, P.mlQ, P.mlK, P.mlKt, P.mlVt, P.mlG, P.hdir, b, h, x3);
        else if (kind == 2) attn_item<96, 1, false>(lds, P.mQ, P.mK, P.mVt, P.ycatb, 512, b, h, x3, 0.f, nullptr, 1.f);
        else s5_item(lds, P.pb, P.s5KmT + (size_t)l * 32 * 16 * 1024, P.s5Smat + (size_t)l * 32 * 128 * 1024, P.s5CmT + (size_t)l * 32 * 16 * 128,
                     P.s5A + l * 32 * 64 * 2, P.s5A64 + l * 32 * 64 * 2, P.s5xs, P.ys5, b, h, x3);
    }
}

template <int TOK, int BATCH>
__device__ __forceinline__ void phase_finish_t(const Params& P, LAS3 unsigned char* lds, int l) {
    constexpr int RT = (TOK + 15) / 16;
    const int tid = opaque_tid(), wid = tid >> 6, lane = tid & 63, lr = lane & 15, q = lane >> 4, c = tid & 255, half = tid >> 8;
    const int ntile = (l == 0) ? TT / TOK : NB * (NS / TOK);
    constexpr int GROW = 264;
    LAS3 bf16_t* Gs = (LAS3 bf16_t*)lds;
    const float* mn = P.ml_norm + l * 256; const float* dsk = P.s5_d + l * 256; const float* bgl = P.s5_b_glu + l * 256;
    const bf16_t* wg = P.wglu_t + (size_t)l * 256 * 256;
    const bf16_t* __restrict__ pbr = P.pb; const bf16_t* __restrict__ hdr = (const bf16_t*)P.hdir; const bf16_t* __restrict__ ysr = (const bf16_t*)P.ys5; bf16_t* __restrict__ oY = P.ycatb;
    bf16x8_t wb[8][2];
#pragma unroll
    for (int ks = 0; ks < 8; ++ks) { wb[ks][0] = *(const bf16x8_t*)(wg + (size_t)(32 * wid + lr) * 256 + 32 * ks + 8 * q); wb[ks][1] = *(const bf16x8_t*)(wg + (size_t)(32 * wid + 16 + lr) * 256 + 32 * ks + 8 * q); }
    for (int it = blockIdx.x; it < ntile; it += gridDim.x) {
        const int t0 = (l == 0) ? it * TOK : ((it / (NS / TOK)) * NT + NC + (it % (NS / TOK)) * TOK);
        __syncthreads();
        {
            const int cg = tid & 31, ts = tid >> 5, c0 = 8 * cg;
            float mnv[8], dsv[8];
            { const float4 m0 = *(const float4*)(mn + c0), m1 = *(const float4*)(mn + c0 + 4), d0 = *(const float4*)(dsk + c0), d1 = *(const float4*)(dsk + c0 + 4);
              mnv[0] = m0.x; mnv[1] = m0.y; mnv[2] = m0.z; mnv[3] = m0.w; mnv[4] = m1.x; mnv[5] = m1.y; mnv[6] = m1.z; mnv[7] = m1.w;
              dsv[0] = d0.x; dsv[1] = d0.y; dsv[2] = d0.z; dsv[3] = d0.w; dsv[4] = d1.x; dsv[5] = d1.y; dsv[6] = d1.z; dsv[7] = d1.w; }
            constexpr int NP = (TOK + 15) / 16;
#pragma unroll
            for (int k0 = 0; k0 < NP; k0 += 2) {
                u32x4_t vog[2], vuu[2], vhf[2], vhb[2], vyf[2], vyb[2];
#pragma unroll
                for (int u = 0; u < 2; ++u) {
                    const int tok = ts + 16 * (k0 + u), tc = (tok < TOK) ? tok : TOK - 1;
                    const size_t t = (size_t)t0 + tc; const bf16_t* pr = pbr + t * DIN;
                    vog[u] = *(const u32x4_t*)(pr + P_MLO + c0); vuu[u] = *(const u32x4_t*)(pr + P_S5 + c0);
                    vhf[u] = *(const u32x4_t*)(hdr + t * 256 + c0); vhb[u] = *(const u32x4_t*)(hdr + ((size_t)TT + t) * 256 + c0);
                    vyf[u] = *(const u32x4_t*)(ysr + t * 256 + c0); vyb[u] = *(const u32x4_t*)(ysr + ((size_t)TT + t) * 256 + c0);
                }
#pragma unroll
                for (int u = 0; u < 2; ++u) {
                    const int tok = ts + 16 * (k0 + u);
                    float og[8], uu[8], hf[8], hb[8], yf[8], yb[8], hv[8], go[8];
                    unpack8(vog[u], og); unpack8(vuu[u], uu); unpack8(vhf[u], hf); unpack8(vhb[u], hb); unpack8(vyf[u], yf); unpack8(vyb[u], yb);
                    float ssq = 0.f;
#pragma unroll
                    for (int e = 0; e < 8; ++e) { hv[e] = sigmoidf_(og[e]) * (hf[e] + hb[e]); ssq += hv[e] * hv[e]; go[e] = gelu_tanh_(yf[e] + yb[e] + uu[e] * dsv[e]); }
                    ssq += __shfl_xor(ssq, 1); ssq += __shfl_xor(ssq, 2); ssq += __shfl_xor(ssq, 4);
                    const float r = rsqrtf(ssq * (1.f / 64.f) + 1e-6f);
#pragma unroll
                    for (int e = 0; e < 8; ++e) hv[e] = hv[e] * r * mnv[e];
                    if (NP * 16 == TOK || tok < TOK) {
                        *(u32x4_t*)(oY + ((size_t)t0 + tok) * DM + 256 + c0) = pack8(hv);
                        *(LAS3 u32x4_t*)(Gs + tok * GROW + c0) = pack8(go);
                    }
                }
            }
        }
        __syncthreads();
        f32x4_t acc[RT][2];
#pragma unroll
        for (int rt = 0; rt < RT; ++rt) { acc[rt][0] = (f32x4_t){0.f, 0.f, 0.f, 0.f}; acc[rt][1] = (f32x4_t){0.f, 0.f, 0.f, 0.f}; }
#pragma unroll
        for (int ks = 0; ks < 8; ++ks) {
#pragma unroll
            for (int rt = 0; rt < RT; ++rt) {
                const bf16x8_t a = *(const LAS3 bf16x8_t*)(Gs + (16 * rt + lr) * GROW + 32 * ks + 8 * q);
                acc[rt][0] = __builtin_amdgcn_mfma_f32_16x16x32_bf16(a, wb[ks][0], acc[rt][0], 0, 0, 0);
                acc[rt][1] = __builtin_amdgcn_mfma_f32_16x16x32_bf16(a, wb[ks][1], acc[rt][1], 0, 0, 0);
            }
        }
#pragma unroll
        for (int rt = 0; rt < RT; ++rt)
#pragma unroll
            for (int cc = 0; cc < 2; ++cc)
#pragma unroll
                for (int rg = 0; rg < 4; ++rg) {
                    const int row = 16 * rt + 4 * q + rg, col = 32 * wid + 16 * cc + lr;
                    const float gv = bf2f(Gs[row * GROW + col]);
                    if (TOK % 16 == 0 || row < TOK) P.ycatb[((size_t)t0 + row) * DM + 768 + col] = f2bf(gv * sigmoidf_(acc[rt][cc][rg] + bgl[col]));
                }
    }
}
__device__ __forceinline__ void phase_finish(const Params& P, LAS3 unsigned char* lds, int l) {
    if (l == 0) phase_finish_t<72, 12>(P, lds, l); else phase_finish_t<64, 8>(P, lds, l);
}

__device__ __forceinline__ void phase_post(const Params& P, LAS3 unsigned char* lds, int l) {
    const int tid = opaque_tid(), wid = tid >> 6, lane = tid & 63, lr = lane & 15, q = lane >> 4;
    constexpr int FROW = 1028, HROW = 1032;
    LAS3 float* ft = (LAS3 float*)lds;
    LAS3 bf16_t* fhi = (LAS3 bf16_t*)lds; LAS3 bf16_t* flo = fhi + 16 * HROW;
    static_assert(2 * 16 * HROW * 2 <= 16 * FROW * 4 + 1024, "hi/lo images");
    LAS3 float* pl = ft + 16 * FROW + 256;
    const float* nw1 = P.norm_w + (size_t)l * 4096 + 1024; const float* nw2 = nw1 + 1024;
    const float* wr = P.moe_w_router + (size_t)l * 1024 * 32; const float* br = P.moe_b_router + l * 32;
    LAS3 int* lcnt = (LAS3 int*)(pl + 8 * 16 * 32);
    if (tid < 32) lcnt[tid] = 0;
    bf16x8_t whi[4][2], wlo[4][2];
#pragma unroll
    for (int kb = 0; kb < 4; ++kb)
#pragma unroll
        for (int hx = 0; hx < 2; ++hx) {
            union { unsigned u[4]; bf16x8_t v; } uh, ul;
#pragma unroll
            for (int jj = 0; jj < 4; ++jj) {
                const float w0 = wr[(size_t)(128 * wid + 32 * kb + 8 * q + 2 * jj) * 32 + 16 * hx + lr], w1 = wr[(size_t)(128 * wid + 32 * kb + 8 * q + 2 * jj + 1) * 32 + 16 * hx + lr];
                const unsigned hb = cvtpk(w0, w1);
                uh.u[jj] = hb; ul.u[jj] = cvtpk(w0 - __uint_as_float(hb << 16), w1 - __uint_as_float(hb & 0xFFFF0000u));
            }
            whi[kb][hx] = uh.v; wlo[kb][hx] = ul.v;
        }
    const int nitem = (l == 0) ? TT / 16 : NB * NS / 16;
    const int tr = tid >> 5, part = tid & 31;
    LAS3 float* wl = (LAS3 float*)(lcnt + 32) + 16 * 32 + 16 * 4 + 16 * 4;
    float4 nm0 = make_float4(0.f, 0.f, 0.f, 0.f), nm1 = nm0;
#define POST_MODROW(it_) (P.mod + ((size_t)l * 9 + (((((l == 0) ? (it_) * 16 : (((it_) >> 7) * NT + NC + ((it_) & 127) * 16)) % NT) < NC) ? 8 : (((l == 0) ? (it_) * 16 : (((it_) >> 7) * NT + NC + ((it_) & 127) * 16)) / NT))) * 6144 + 2048)
    *(LAS3 f32x4_t*)(wl + tid * 4) = *(const f32x4_t*)(nw1 + tid * 4);
    if ((int)blockIdx.x < nitem) { const float* mrn = POST_MODROW((int)blockIdx.x); nm0 = *(const float4*)(mrn + tid * 4); if (tid < 256) nm1 = *(const float4*)(mrn + 2048 + tid * 4);
        *(LAS3 f32x4_t*)(wl + 2048 + tid * 4) = (f32x4_t){nm0.x, nm0.y, nm0.z, nm0.w}; if (tid < 256) *(LAS3 f32x4_t*)(wl + 4096 + tid * 4) = (f32x4_t){nm1.x, nm1.y, nm1.z, nm1.w}; }
    for (int it = blockIdx.x; it < nitem; it += gridDim.x) {
        const int t0 = (l == 0) ? it * 16 : ((it >> 7) * NT + NC + (it & 127) * 16);
        const int t = t0 + tr, b = t / NT, n = t % NT;
        const float* xin = (n < NC) ? P.ctx + ((size_t)b * NC + n) * DM : P.x + ((size_t)b * NS + (n - NC)) * DM;
        bf16_t* x1b = (bf16_t*)P.xall; const bf16_t* x2b = x1b + (size_t)TT * DM;
        __syncthreads();
        float x1[32];
        {
            float so = P.osq[(size_t)t * 16 + (part & 15)];
#pragma unroll
            for (int o = 8; o > 0; o >>= 1) so += __shfl_xor(so, o);
            const float rstd = rsqrtf(so * (1.f / DM) + 1e-6f);
            float ss = 0.f;
#pragma unroll
            for (int j = 0; j < 8; ++j) {
                const int d = j * 128 + part * 4;
                const uint2 ov = *(const uint2*)(P.ob + (size_t)t * DM + d);
                float4 xv;
                if (l == 0) xv = *(const float4*)(xin + d);
                else { const uint2 xb = *(const uint2*)(x2b + (size_t)t * DM + d); xv = make_float4(__uint_as_float(xb.x << 16), __uint_as_float(xb.x & 0xFFFF0000u), __uint_as_float(xb.y << 16), __uint_as_float(xb.y & 0xFFFF0000u)); }
                const f32x4_t wv_ = *(const LAS3 f32x4_t*)(wl + d), gv_ = *(const LAS3 f32x4_t*)(wl + 2048 + d);
                const float4 w = make_float4(wv_[0], wv_[1], wv_[2], wv_[3]), g1 = make_float4(gv_[0], gv_[1], gv_[2], gv_[3]);
                const float a0 = xv.x + g1.x * __uint_as_float(ov.x << 16) * rstd * w.x, a1 = xv.y + g1.y * __uint_as_float(ov.x & 0xFFFF0000u) * rstd * w.y;
                const float a2 = xv.z + g1.z * __uint_as_float(ov.y << 16) * rstd * w.z, a3 = xv.w + g1.w * __uint_as_float(ov.y & 0xFFFF0000u) * rstd * w.w;
                x1[j * 4] = a0; x1[j * 4 + 1] = a1; x1[j * 4 + 2] = a2; x1[j * 4 + 3] = a3;
                *(uint2*)(x1b + (size_t)t * DM + d) = make_uint2(cvtpk(a0, a1), cvtpk(a2, a3));
                ss += (a0 * a0 + a1 * a1) + (a2 * a2 + a3 * a3);
            }
#pragma unroll
            for (int o = 16; o > 0; o >>= 1) ss += __shfl_xor(ss, o);
            const float rstd2 = rsqrtf(ss * (1.f / DM) + 1e-6f);
#pragma unroll
            for (int j = 0; j < 8; ++j) {
                const int d = j * 128 + part * 4;
                const f32x4_t wv_ = *(const LAS3 f32x4_t*)(wl + 1024 + d), sv_ = *(const LAS3 f32x4_t*)(wl + 3072 + d), cv_ = *(const LAS3 f32x4_t*)(wl + 4096 + d);
                const float4 w = make_float4(wv_[0], wv_[1], wv_[2], wv_[3]), sh = make_float4(sv_[0], sv_[1], sv_[2], sv_[3]), sc = make_float4(cv_[0], cv_[1], cv_[2], cv_[3]);
                const float f0 = x1[j * 4] * rstd2 * w.x * (1.f + sc.x) + sh.x, f1 = x1[j * 4 + 1] * rstd2 * w.y * (1.f + sc.y) + sh.y;
                const float f2 = x1[j * 4 + 2] * rstd2 * w.z * (1.f + sc.z) + sh.z, f3 = x1[j * 4 + 3] * rstd2 * w.w * (1.f + sc.w) + sh.w;
                *(uint2*)(P.fb + (size_t)t * DM + d) = make_uint2(cvtpk(f0, f1), cvtpk(f2, f3));
                {
                    const unsigned h01 = cvtpk(f0, f1), h23 = cvtpk(f2, f3);
                    *(LAS3 u32x2_t*)(fhi + tr * HROW + d) = (u32x2_t){h01, h23};
                    *(LAS3 u32x2_t*)(flo + tr * HROW + d) = (u32x2_t){cvtpk(f0 - __uint_as_float(h01 << 16), f1 - __uint_as_float(h01 & 0xFFFF0000u)), cvtpk(f2 - __uint_as_float(h23 << 16), f3 - __uint_as_float(h23 & 0xFFFF0000u))};
                }
            }
        }
        __syncthreads();
        const bool hasn = it + (int)gridDim.x < nitem;
        if (hasn) { const float* mrn = POST_MODROW(it + (int)gridDim.x); nm0 = *(const float4*)(mrn + tid * 4); if (tid < 256) nm1 = *(const float4*)(mrn + 2048 + tid * 4); }
        {
            f32x4_t a0 = (f32x4_t){0.f, 0.f, 0.f, 0.f}, a1 = (f32x4_t){0.f, 0.f, 0.f, 0.f};
            bf16x8_t ah[4], al[4];
#pragma unroll
            for (int kb = 0; kb < 4; ++kb) { ah[kb] = *(const LAS3 bf16x8_t*)(fhi + lr * HROW + 128 * wid + 32 * kb + 8 * q); al[kb] = *(const LAS3 bf16x8_t*)(flo + lr * HROW + 128 * wid + 32 * kb + 8 * q); }
#pragma unroll
            for (int kb = 0; kb < 4; ++kb) {
                a0 = __builtin_amdgcn_mfma_f32_16x16x32_bf16(ah[kb], whi[kb][0], a0, 0, 0, 0); a1 = __builtin_amdgcn_mfma_f32_16x16x32_bf16(ah[kb], whi[kb][1], a1, 0, 0, 0);
                a0 = __builtin_amdgcn_mfma_f32_16x16x32_bf16(ah[kb], wlo[kb][0], a0, 0, 0, 0); a1 = __builtin_amdgcn_mfma_f32_16x16x32_bf16(ah[kb], wlo[kb][1], a1, 0, 0, 0);
                a0 = __builtin_amdgcn_mfma_f32_16x16x32_bf16(al[kb], whi[kb][0], a0, 0, 0, 0); a1 = __builtin_amdgcn_mfma_f32_16x16x32_bf16(al[kb], whi[kb][1], a1, 0, 0, 0);
            }
#pragma unroll
            for (int rg = 0; rg < 4; ++rg) { pl[(wid * 16 + 4 * q + rg) * 32 + lr] = a0[rg]; pl[(wid * 16 + 4 * q + rg) * 32 + 16 + lr] = a1[rg]; }
        }
        __syncthreads();
        {
            float lg = br[part];
#pragma unroll
            for (int w = 0; w < 8; ++w) lg += pl[(w * 16 + tr) * 32 + part];
            LAS3 float* lgs = (LAS3 float*)(lcnt + 32);
            LAS3 float* topv = lgs + 16 * 32;
            LAS3 int* topi = (LAS3 int*)(topv + 16 * 4);
            lgs[tr * 32 + part] = lg;
            asm volatile("s_waitcnt lgkmcnt(0)" ::: "memory");
            int rank = 0;
#pragma unroll
            for (int c4 = 0; c4 < 8; ++c4) {
                const f32x4_t lv = *(const LAS3 f32x4_t*)(lgs + tr * 32 + 4 * c4);
#pragma unroll
                for (int e = 0; e < 4; ++e) rank += (lv[e] > lg || (lv[e] == lg && (4 * c4 + e) < part)) ? 1 : 0;
            }
            if (rank < 4) { topv[tr * 4 + rank] = lg; topi[tr * 4 + rank] = part; }
            asm volatile("s_waitcnt lgkmcnt(0)" ::: "memory");
            if (part < 4) {
                const f32x4_t v = *(const LAS3 f32x4_t*)(topv + tr * 4);
                const int ek = topi[tr * 4 + part];
                const float e1 = __expf(v[1] - v[0]), e2 = __expf(v[2] - v[0]), e3 = __expf(v[3] - v[0]);
                const float inv = 1.f / (1.f + e1 + e2 + e3);
                const float gk = (part == 0) ? inv : (part == 1) ? e1 * inv : (part == 2) ? e2 * inv : e3 * inv;
                P.top_e[(size_t)t * 4 + part] = ek; P.top_g[(size_t)t * 4 + part] = gk;
                P.posb[(size_t)t * 4 + part] = __hip_atomic_fetch_add(&lcnt[ek], 1, __ATOMIC_RELAXED, __HIP_MEMORY_SCOPE_WORKGROUP);
            }
        }
        if (hasn) { *(LAS3 f32x4_t*)(wl + 2048 + tid * 4) = (f32x4_t){nm0.x, nm0.y, nm0.z, nm0.w}; if (tid < 256) *(LAS3 f32x4_t*)(wl + 4096 + tid * 4) = (f32x4_t){nm1.x, nm1.y, nm1.z, nm1.w}; }
    }
#undef POST_MODROW
    __syncthreads();
    if (tid < 32) P.blkcnt[((size_t)l * gridDim.x + blockIdx.x) * 32 + tid] = lcnt[tid];
}

__device__ __forceinline__ void phase_scatter(const Params& P, LAS3 unsigned char* lds, int l) {
    const int tid = opaque_tid(), wid = tid >> 6, lane = tid & 63;
    LAS3 int* soff = (LAS3 int*)lds;
    LAS3 int* part = soff + 64;
    LAS3 int* pre = soff + 1024;
    const int G = gridDim.x;
    const int* bc = P.blkcnt + (size_t)l * G * 32;
    __syncthreads();
    {
        const int e = tid & 31, pt = tid >> 5, per = (G + 15) / 16;
        int sum = 0;
        for (int b2 = pt * per; b2 < (pt + 1) * per && b2 < G; ++b2) sum += bc[b2 * 32 + e];
        part[pt * 32 + e] = sum;
        __syncthreads();
        int run = 0;
        for (int p2 = 0; p2 < pt; ++p2) run += part[p2 * 32 + e];
        for (int b2 = pt * per; b2 < (pt + 1) * per && b2 < G; ++b2) { pre[b2 * 32 + e] = run; run += bc[b2 * 32 + e]; }
        if (pt == 15) soff[32 + e] = run;
    }
    __syncthreads();
    if (tid < 64) {
        const int e = tid & 31;
        const int ntl = (soff[32 + e] + 255) >> 8;
        int inc = ntl;
#pragma unroll
        for (int o = 1; o < 32; o <<= 1) { const int v = __shfl_up(inc, o, 32); if (e >= o) inc += v; }
        const int nt0 = inc - ntl;
        if (tid < 32) {
            soff[e] = nt0 * 256;
            if (blockIdx.x == 0) { for (int m = 0; m < ntl; ++m) P.tile_e[l * 512 + nt0 + m] = e; P.offs[l * 32 + e] = nt0 * 256; if (e == 31) P.ntiles[l * 16] = inc; }
        }
    }
    __syncthreads();
    const int gt = blockIdx.x * 512 + tid, NTH = gridDim.x * 512;
    const int ntok = (l == 0) ? TT : NB * NS;
    int* __restrict__ stk = (int*)P.xg;
    for (int a = gt; a < ntok * 4; a += NTH) {
        const int i = a >> 2;
        const int t = (l == 0) ? i : ((i >> 11) * NT + NC + (i & 2047));
        const int ek = P.top_e[(size_t)t * 4 + (a & 3)];
        const int slot = soff[ek] + pre[((i >> 4) % G) * 32 + ek] + P.posb[(size_t)t * 4 + (a & 3)];
        stk[slot] = t; P.tok_slot[(size_t)t * 4 + (a & 3)] = slot;
    }
    for (int i = gt; i < NE * 256; i += NTH) {
        const int e = i >> 8, j = i & 255, c = soff[32 + e];
        const int padn = ((c + 255) & ~255) - c;
        if (j < padn) stk[soff[e] + c + j] = NC;
    }
}

__device__ __forceinline__ void phase_combine(const Params& P, LAS3 unsigned char* lds, int l) {
    const int tid = opaque_tid(); const int lane = tid & 63, gw = blockIdx.x * 8 + (tid >> 6), NW = gridDim.x * 8;
    const float* __restrict__ nw3 = P.norm_w + (size_t)l * 4096 + 3072;
    const float* __restrict__ nwn = P.norm_w + 4096;
    const int* __restrict__ tsl = P.tok_slot; const float* __restrict__ tg = P.top_g; const bf16_t* __restrict__ ye = P.yexp; const float* __restrict__ modp = P.mod;
    const int ntok = (l == 0) ? TT : NB * NS;
    LAS3 float* cw = (LAS3 float*)lds;
    for (int i = tid; i < 256; i += 512) { *(LAS3 f32x4_t*)(cw + i * 4) = *(const f32x4_t*)(nw3 + i * 4); if (l == 0) *(LAS3 f32x4_t*)(cw + 1024 + i * 4) = *(const f32x4_t*)(nwn + i * 4); }
    for (int i = tid; i < 9 * 256; i += 512) { const int r = i >> 8, k = i & 255; *(LAS3 f32x4_t*)(cw + 2048 + r * 1024 + k * 4) = *(const f32x4_t*)(modp + ((size_t)l * 9 + r) * 6144 + 5120 + k * 4); }
    if (l == 0) for (int i = tid; i < 9 * 512; i += 512) { const int r = i >> 9, k = i & 511; *(LAS3 f32x4_t*)(cw + 11264 + r * 2048 + k * 4) = *(const f32x4_t*)(modp + ((size_t)9 + r) * 6144 + k * 4); }
    __syncthreads();
    const bf16_t* __restrict__ x1b = (const bf16_t*)P.xall; bf16_t* __restrict__ x2b = (bf16_t*)P.xall + (size_t)TT * DM;
    int i = gw;
    int4 sl = make_int4(0, 0, 0, 0); float4 gt = make_float4(0.f, 0.f, 0.f, 0.f);
    if (i < ntok) { const int t = (l == 0) ? i : ((i >> 11) * NT + NC + (i & 2047)); sl = *(const int4*)(tsl + (size_t)t * 4); gt = *(const float4*)(tg + (size_t)t * 4); }
    for (; i < ntok; i += NW) {
        const int t = (l == 0) ? i : ((i >> 11) * NT + NC + (i & 2047));
        const int b = t / NT, n = t % NT, r = (n < NC) ? 8 : b;
        const int4 slc = sl; const float4 gtc = gt;
        uint2 yv[4][4];
        const int slots[4] = {slc.x, slc.y, slc.z, slc.w};
#pragma unroll
        for (int k = 0; k < 4; ++k)
#pragma unroll
            for (int j = 0; j < 4; ++j) yv[k][j] = *(const uint2*)(ye + (size_t)slots[k] * DM + j * 256 + lane * 4);
        float4 x1[4], w3[4], g2[4], wn[4], scn[4], shn[4];
#define CW4(p_) ({ const f32x4_t v_ = *(const LAS3 f32x4_t*)(p_); make_float4(v_[0], v_[1], v_[2], v_[3]); })
#pragma unroll
        for (int j = 0; j < 4; ++j) {
            const int d = j * 256 + lane * 4;
            { const uint2 xb = *(const uint2*)(x1b + (size_t)t * DM + d); x1[j] = make_float4(__uint_as_float(xb.x << 16), __uint_as_float(xb.x & 0xFFFF0000u), __uint_as_float(xb.y << 16), __uint_as_float(xb.y & 0xFFFF0000u)); }
            w3[j] = CW4(cw + d); g2[j] = CW4(cw + 2048 + r * 1024 + d);
            if (l == 0) { wn[j] = CW4(cw + 1024 + d); scn[j] = CW4(cw + 11264 + r * 2048 + 1024 + d); shn[j] = CW4(cw + 11264 + r * 2048 + d); }
        }
        { const int in = i + NW; if (in < ntok) { const int tn = (l == 0) ? in : ((in >> 11) * NT + NC + (in & 2047)); sl = *(const int4*)(tsl + (size_t)tn * 4); gt = *(const float4*)(tg + (size_t)tn * 4); } }
        const float gk[4] = {gtc.x, gtc.y, gtc.z, gtc.w};
        float m[16];
#pragma unroll
        for (int j = 0; j < 16; ++j) m[j] = 0.f;
#pragma unroll
        for (int k = 0; k < 4; ++k)
#pragma unroll
            for (int j = 0; j < 4; ++j) {
                m[j * 4] += gk[k] * __uint_as_float(yv[k][j].x << 16); m[j * 4 + 1] += gk[k] * __uint_as_float(yv[k][j].x & 0xFFFF0000u);
                m[j * 4 + 2] += gk[k] * __uint_as_float(yv[k][j].y << 16); m[j * 4 + 3] += gk[k] * __uint_as_float(yv[k][j].y & 0xFFFF0000u);
            }
        float ss = 0.f;
#pragma unroll
        for (int j = 0; j < 16; ++j) ss += m[j] * m[j];
        const float rstd = rsqrtf(wave_sum(ss) * (1.f / DM) + 1e-6f);
        float xv[16]; float s2 = 0.f;
#pragma unroll
        for (int j = 0; j < 4; ++j) {
            const int d = j * 256 + lane * 4;
            xv[j * 4] = x1[j].x + g2[j].x * m[j * 4] * rstd * w3[j].x; xv[j * 4 + 1] = x1[j].y + g2[j].y * m[j * 4 + 1] * rstd * w3[j].y;
            xv[j * 4 + 2] = x1[j].z + g2[j].z * m[j * 4 + 2] * rstd * w3[j].z; xv[j * 4 + 3] = x1[j].w + g2[j].w * m[j * 4 + 3] * rstd * w3[j].w;
            s2 += (xv[j * 4] * xv[j * 4] + xv[j * 4 + 1] * xv[j * 4 + 1]) + (xv[j * 4 + 2] * xv[j * 4 + 2] + xv[j * 4 + 3] * xv[j * 4 + 3]);
            const float4 o = make_float4(xv[j * 4], xv[j * 4 + 1], xv[j * 4 + 2], xv[j * 4 + 3]);
            if (l == 0) *(uint2*)(x2b + (size_t)t * DM + d) = make_uint2(cvtpk(o.x, o.y), cvtpk(o.z, o.w));
            else *(float4*)(P.out + ((size_t)b * NS + (n - NC)) * DM + d) = o;
        }
        if (l == 0) {
            const float rs2 = rsqrtf(wave_sum(s2) * (1.f / DM) + 1e-6f);
#pragma unroll
            for (int j = 0; j < 4; ++j) {
                const int d = j * 256 + lane * 4;
                const float o0 = xv[j * 4] * rs2 * wn[j].x * (1.f + scn[j].x) + shn[j].x, o1 = xv[j * 4 + 1] * rs2 * wn[j].y * (1.f + scn[j].y) + shn[j].y;
                const float o2 = xv[j * 4 + 2] * rs2 * wn[j].z * (1.f + scn[j].z) + shn[j].z, o3 = xv[j * 4 + 3] * rs2 * wn[j].w * (1.f + scn[j].w) + shn[j].w;
                *(uint2*)(P.hbuf + (size_t)t * DM + d) = make_uint2(cvtpk(o0, o1), cvtpk(o2, o3));
            }
        }
    }
}

extern __shared__ __attribute__((aligned(16))) unsigned char dyn_lds[];
__device__ __forceinline__ void run_phase(const Params& P, LAS3 unsigned char* lds, int ph) {
    if (ph == PH_SETUP) { phase_setup(P, lds); return; }
    if (ph == PH_H0) { phase_h0(P, lds); return; }
    const int l = (ph - PH_LAYER0) / PH_PER_LAYER, s = (ph - PH_LAYER0) % PH_PER_LAYER;
    switch (s) {
    case L_GEMM_IN: { pg8::Gemm g{P.hbuf, P.w_in_t + (size_t)l * 2560 * 1024, TT, 2560, 1024, 0}; pg8::StaticOrder S; S.init(TT, 2560, gridDim.x, blockIdx.x);
        pg8::EpiBf16P E{P.pb, DIN, 0}; pg8::gemm_phase<pg8::EpiBf16P, pg8::StaticOrder, true, true>(lds, g, S, E); } break;
    case L_PREP: phase_prep(P, lds, l); break;
    case L_MIX: phase_mix(P, lds, l); break;
    case L_FINISH: phase_finish(P, lds, l); break;
    case L_GEMM_OUT: { pg8::Gemm g{P.ycatb, P.w_out_t + (size_t)l * 1024 * 1024, TT, 1024, 1024, 0}; pg8::EpiOut E{P.ob, P.osq};
        if (l == 0) { pg8::StaticOrder S; S.init(TT, 1024, gridDim.x, blockIdx.x); pg8::gemm_phase<pg8::EpiOut, pg8::StaticOrder, true, true>(lds, g, S, E); }
        else { pg8::LatOrder S; S.initl(1024, gridDim.x, blockIdx.x); pg8::gemm_phase<pg8::EpiOut, pg8::LatOrder, true, true>(lds, g, S, E); } } break;
    case L_POST: phase_post(P, lds, l); break;
    case L_SCATTER: phase_scatter(P, lds, l); break;
    case L_GEMM_GU: { pg8::Gemm g{P.fb, P.wgu_t + (size_t)l * NE * 2048 * 1024, 0, 2048, 1024, 0}; pg8::GroupedOrder S; S.initg(P.ntiles + l * 16, P.tile_e + l * 512, 2048, gridDim.x, blockIdx.x);
        pg8::EpiSwiglu E{P.act, P.moe_b_gate_up + (size_t)l * NE * 2048}; pg8::gemm_phase<pg8::EpiSwiglu, pg8::GroupedOrder, true, true, true>(lds, g, S, E, (const int*)P.xg); } break;
    case L_GEMM_DN: { pg8::Gemm g{P.act, P.wdn_t + (size_t)l * NE * 1024 * 1024, 0, 1024, 1024, 0}; pg8::GroupedOrder S; S.initg(P.ntiles + l * 16, P.tile_e + l * 512, 1024, gridDim.x, blockIdx.x);
        pg8::EpiDown E{P.yexp, P.moe_b_down + (size_t)l * NE * 1024}; pg8::gemm_phase<pg8::EpiDown, pg8::GroupedOrder, true, true>(lds, g, S, E); } break;
    case L_COMBINE: phase_combine(P, lds, l); break;
    }
}
__global__ void __launch_bounds__(512, 2) mk_fwd(Params Pk, int ph_lo, int ph_hi) {
    LAS3 unsigned char* lds = (LAS3 unsigned char*)dyn_lds;
    volatile LAS3 unsigned* st = (volatile LAS3 unsigned*)(lds + MK_LDS_MAIN);
    LAS3 Params* PL = (LAS3 Params*)(lds + MK_LDS_MAIN + 64);
    static_assert(sizeof(Params) <= 1024, "Params copy does not fit its LDS slot");
    if (threadIdx.x < 4) st[threadIdx.x] = 0u;
    if (threadIdx.x == 64) store_params(PL, Pk);
    unsigned* barw = Pk.bar;
    __syncthreads();
    XcdBarrier bar; bar.bar = barw; bar.x = 0; bar.st = st;
    if (ph_hi - ph_lo > 1) bar = xcd_barrier_post(barw, st);
#define MK_RUN(ph) if (ph_lo <= (ph) && (ph) < ph_hi) { { const LAS3 Params* PLo = PL; asm volatile("" : "+v"(PLo)); LAS3 unsigned char* ldsp = lds; asm volatile("" : "+s"(ldsp)); \
        const Params P = load_params(PLo); run_phase(P, ldsp, (ph)); } if ((ph) + 1 < ph_hi) xcd_barrier(bar); }
    MK_RUN(0) MK_RUN(1) MK_RUN(2) MK_RUN(3) MK_RUN(4) MK_RUN(5) MK_RUN(6) MK_RUN(7) MK_RUN(8) MK_RUN(9) MK_RUN(10) MK_RUN(11)
    MK_RUN(12) MK_RUN(13) MK_RUN(14) MK_RUN(15) MK_RUN(16) MK_RUN(17) MK_RUN(18) MK_RUN(19) MK_RUN(20) MK_RUN(21)
#undef MK_RUN
}

extern "C" void kernel_launch(void* const* d_in, const int* in_sizes, int n_in, void* d_out, int out_size, void* d_ws, size_t ws_size, hipStream_t stream) {
    Params P{};
    const float** pin = (const float**)&P;
    for (int i = 0; i < 35; ++i) pin[i] = (const float*)d_in[i];
    P.out = (float*)d_out;
    char* ws = (char*)d_ws; size_t off = 0;
    auto carve = [&](size_t bytes) { void* p = ws + off; off += (bytes + 255) & ~(size_t)255; return p; };
    const size_t ctl_bytes = XCD_BAR_WORDS * 4 + 256 + 256;
    P.bar = (unsigned*)carve(XCD_BAR_WORDS * 4); P.queue = (int*)carve(256); P.cnt = (int*)carve(256);
    P.tile_e = (int*)carve(2 * 512 * 4); P.ntiles = (int*)carve(2 * 16 * 4); P.offs = (int*)carve(2 * 32 * 4); P.blkcnt = (int*)carve(2 * 256 * 32 * 4);
    P.xall = (float*)carve((size_t)TT * DM * 4); P.mod = (float*)carve((size_t)2 * 9 * 6144 * 4); P.ropecs = (float*)carve((size_t)NS * 16 * 2 * 4); P.lamfull = (float*)carve(256);
    P.w_in_t = (bf16_t*)carve((size_t)2 * 2560 * 1024 * 2); P.w_out_t = (bf16_t*)carve((size_t)2 * 1024 * 1024 * 2);
    P.wgu_t = (bf16_t*)carve((size_t)2 * NE * 2048 * 1024 * 2); P.wdn_t = (bf16_t*)carve((size_t)2 * NE * 1024 * 1024 * 2);
    P.wq_t = (bf16_t*)carve((size_t)2 * 384 * 192 * 2); P.wkv_t = (bf16_t*)carve((size_t)2 * 512 * 128 * 2); P.wglu_t = (bf16_t*)carve((size_t)2 * 256 * 256 * 2);
    P.s5KmT = (bf16_t*)carve((size_t)64 * 16 * 1024 * 2); P.s5Smat = (bf16_t*)carve((size_t)64 * 128 * 1024 * 2); P.s5CmT = (bf16_t*)carve((size_t)64 * 16 * 128 * 2);
    P.s5A = (float*)carve(64 * 64 * 2 * 4); P.s5A64 = (float*)carve(64 * 64 * 2 * 4); P.s5xs = (float*)carve((size_t)256 * 36 * 128 * 4);
    P.hbuf = (bf16_t*)carve((size_t)TT * DM * 2); P.pb = (bf16_t*)carve((size_t)TT * DIN * 2);
    P.daQ = (bf16_t*)carve((size_t)TT * 256 * 2); P.daK = (bf16_t*)carve((size_t)TT * 256 * 2); P.daVt = (bf16_t*)carve((size_t)TT * 256 * 2);
    P.mQ = (bf16_t*)carve((size_t)TT * 384 * 2); P.mK = (bf16_t*)carve((size_t)TT * 384 * 2); P.mVt = (bf16_t*)carve((size_t)TT * 256 * 2);
    P.mlQ = (bf16_t*)carve((size_t)TT * 256 * 2); P.mlK = (bf16_t*)carve((size_t)TT * 256 * 2); P.mlKt = (bf16_t*)carve((size_t)TT * 256 * 2); P.mlVt = (bf16_t*)carve((size_t)TT * 256 * 2);
    P.mlG = (float*)carve((size_t)TT * 16 * 4); P.hdir = (float*)carve((size_t)2 * TT * 256 * 4); P.ys5 = (float*)carve((size_t)2 * TT * 256 * 4);
    P.ycatb = (bf16_t*)carve((size_t)TT * DM * 2); P.ob = (bf16_t*)carve((size_t)TT * DM * 2); P.osq = (float*)carve((size_t)TT * 16 * 4); P.fb = (bf16_t*)carve((size_t)TT * DM * 2);
    P.top_e = (int*)carve((size_t)NASSIGN * 4); P.top_g = (float*)carve((size_t)NASSIGN * 4); P.posb = (int*)carve((size_t)NASSIGN * 4); P.tok_slot = (int*)carve((size_t)NASSIGN * 4);
    P.xg = (bf16_t*)carve((size_t)MAXSLOTS * DM * 2); P.act = (bf16_t*)carve((size_t)MAXSLOTS * DM * 2); P.yexp = (bf16_t*)carve((size_t)MAXSLOTS * DM * 2);
    if (off > ws_size) { fprintf(stderr, "kernel_launch: workspace too small: need %zu have %zu\n", off, ws_size); return; }
    static bool attr_done = false;
    if (!attr_done) {
        if (hipFuncSetAttribute((const void*)mk_fwd, hipFuncAttributeMaxDynamicSharedMemorySize, MK_LDS_BYTES) != hipSuccess) fprintf(stderr, "kernel_launch: hipFuncSetAttribute failed\n");
        attr_done = true;
    }
    (void)hipMemsetAsync(d_ws, 0, ctl_bytes, stream);
#if MK_ONE_LAUNCH
    hipLaunchKernelGGL(mk_fwd, dim3(256), dim3(512), MK_LDS_BYTES, stream, P, 0, (int)PH_TOTAL);
#else
    for (int ph = 0; ph < PH_TOTAL; ++ph) hipLaunchKernelGGL(mk_fwd, dim3(256), dim3(512), MK_LDS_BYTES, stream, P, ph, ph + 1);
#endif
}
```

```cpp
#include <hip/hip_runtime.h>
#include <cstdint>
#include <cstdio>

#define NB 8
#define NS 2048
#define NC 256
#define NT 2304
#define TT (NB * NT)
#define DM 1024
#define DIN 2560
#define DINC 2416
#define NE 32
#define NASSIGN (TT * 4)
#define MAXSLOTS (NASSIGN + NE * 256)

#define P_DAQ 0
#define P_DAK 256
#define P_DAV 512
#define P_MLQK 768
#define P_MLV 1280
#define P_MLO 1536
#define P_MLG 1792
#define P_CQ 1808
#define P_CKV 2000
#define P_KR 2128
#define P_S5 2160

#ifndef MK_ONE_LAUNCH
#define MK_ONE_LAUNCH 1
#endif

typedef unsigned short bf16_t;
__device__ __forceinline__ float sigmoidf_(float x) { return __builtin_amdgcn_rcpf(1.f + __expf(-x)); }
__device__ __forceinline__ float siluf_(float x) { return x * __builtin_amdgcn_rcpf(1.f + __expf(-x)); }
__device__ __forceinline__ float logsigmoidf_(float x) { return fminf(x, 0.f) - log1pf(__expf(-fabsf(x))); }
__device__ __forceinline__ float gelu_tanh_(float x) { const float u = 0.7978845608028654f * (x + 0.044715f * x * x * x); return x * __builtin_amdgcn_rcpf(1.f + __expf(-2.f * u)); }
typedef __bf16 bf16x2_nat __attribute__((ext_vector_type(2)));
typedef float f32x2_nat __attribute__((ext_vector_type(2)));
__device__ __forceinline__ unsigned cvtpk(float lo, float hi) { const f32x2_nat v = {lo, hi}; const bf16x2_nat b = __builtin_convertvector(v, bf16x2_nat); return __builtin_bit_cast(unsigned, b); }
__device__ __forceinline__ bf16_t f2bf(float f) { return (bf16_t)(cvtpk(f, 0.f) & 0xFFFFu); }
__device__ __forceinline__ float bf2f(bf16_t b) { return __uint_as_float(((unsigned)b) << 16); }
__device__ __forceinline__ unsigned pk2bf(float lo, float hi) { return cvtpk(lo, hi); }
__device__ __forceinline__ int opaque_tid() { int t = threadIdx.x; asm volatile("" : "+v"(t)); return t; }
__device__ __forceinline__ float wave_sum(float v) {
#pragma unroll
    for (int o = 32; o > 0; o >>= 1) v += __shfl_xor(v, o);
    return v;
}
__device__ __forceinline__ int seq_token(int s, int dir) {
    if (dir == 0) return s;
    return (s < NC) ? (NC - 1 - s) : (NC + (NT - 1 - s));
}

namespace pg8 {
#define PG8_LAS __attribute__((address_space(3)))
typedef short bf16x8 __attribute__((ext_vector_type(8)));
typedef float f32x4 __attribute__((ext_vector_type(4)));
typedef unsigned u32x4 __attribute__((ext_vector_type(4)));
constexpr int BM = 256, BK = 64, HALF = 128, HTB = HALF * BK * 2, STAGE_BYTES = 8 * HTB, NXCD = 8, WGM = 8;
__host__ __device__ __forceinline__ int lds_byte(int r, int c) { const int st = (r >> 4) * 2 + (c >> 5), rr = r & 15, cc = c & 31, ob = rr * 64 + cc * 2; return st * 1024 + (ob ^ (((ob >> 9) & 1) << 5)); }
__host__ __device__ __forceinline__ void stage_rc(int b, int& R, int& C) { const int st = b / 1024, sb = b % 1024, swz = sb ^ (((sb >> 9) & 1) << 5); R = (st >> 1) * 16 + swz / 64; C = (st & 1) * 32 + (swz % 64) / 2; }
__host__ __device__ __forceinline__ int perm32(int rho) { const int n = rho >> 4, i = rho & 15; return 8 * (i >> 2) + 4 * n + (i & 3); }
struct Unit { int pm, pn; };
struct Gemm { const bf16_t* A; const bf16_t* Bt; int M, N, K, pad; };
__device__ __forceinline__ unsigned cvt_pk_bf16(float lo, float hi) { return cvtpk(lo, hi); }

struct StaticOrder {
    int nM, nN, nwg, G, c;
    __device__ void init(int M, int N, int G_, int c_) { nM = M / BM; nN = N / BM; nwg = nM * nN; G = G_; c = c_; }
    __device__ bool next(int i, Unit& u) const {
        const long L = (long)i * G + c; if (L >= nwg) return false;
        int wgid = (int)L; { const int q = nwg / NXCD, r = nwg % NXCD, xcd = wgid % NXCD, off = wgid / NXCD; wgid = (xcd < r ? xcd * (q + 1) : r * (q + 1) + (xcd - r) * q) + off; }
        const int nig = WGM * nN, gid = wgid / nig, fm = gid * WGM, gsz = (nM - fm) < WGM ? (nM - fm) : WGM;
        u.pm = fm + ((wgid % nig) % gsz); u.pn = (wgid % nig) / gsz; return true;
    }
    __device__ __forceinline__ void a_ready(const Unit&) const {}
    __device__ __forceinline__ void done(const Unit&) const {}
};
struct LatOrder : StaticOrder {
    __device__ void initl(int N, int G_, int c_) { nM = 64; nN = N / BM; nwg = nM * nN; G = G_; c = c_; }
    __device__ bool next(int i, Unit& u) const { if (!StaticOrder::next(i, u)) return false; u.pm = (u.pm >> 3) * 9 + 1 + (u.pm & 7); return true; }
};
struct GroupedOrder : StaticOrder {
    const int* tile_e;
    __device__ void initg(const int* ntiles_p, const int* tile_e_, int N, int G_, int c_) { nM = ntiles_p[0]; nN = N / BM; nwg = nM * nN; G = G_; c = c_; tile_e = tile_e_; }
    __device__ bool next(int i, Unit& u) const { if (!StaticOrder::next(i, u)) return false; u.pn += tile_e[u.pm] * nN; return true; }
};

struct EpiBf16P {
    static constexpr bool PERM = true;
    bf16_t* O; int ldc, pad;
    __device__ __forceinline__ void operator()(const f32x4 (&acc)[2][2][4][2], const Unit& u, int wr, int wc, int fr, int fq) const {
        const int row0 = u.pm * BM + wr * 64 + fr, col0 = u.pn * BM + wc * 32 + 8 * fq;
#pragma unroll
        for (int ai = 0; ai < 2; ++ai)
#pragma unroll
            for (int m = 0; m < 4; ++m) { bf16_t* rowp = O + (size_t)(row0 + ai * HALF + m * 16) * ldc + col0;
#pragma unroll
                for (int bj = 0; bj < 2; ++bj) { const f32x4 v0 = acc[ai][bj][m][0], v1 = acc[ai][bj][m][1];
                    u32x4 w; w.x = cvt_pk_bf16(v0[0], v0[1]); w.y = cvt_pk_bf16(v0[2], v0[3]); w.z = cvt_pk_bf16(v1[0], v1[1]); w.w = cvt_pk_bf16(v1[2], v1[3]);
                    *(u32x4*)(rowp + bj * HALF) = w; } }
    }
};
struct EpiOut {
    static constexpr bool PERM = true;
    bf16_t* O; float* osq;
    __device__ __forceinline__ void operator()(const f32x4 (&acc)[2][2][4][2], const Unit& u, int wr, int wc, int fr, int fq) const {
        const int row0 = u.pm * BM + wr * 64 + fr, col0 = u.pn * BM + wc * 32 + 8 * fq;
#pragma unroll
        for (int ai = 0; ai < 2; ++ai)
#pragma unroll
            for (int m = 0; m < 4; ++m) { const int row = row0 + ai * HALF + m * 16; bf16_t* rowp = O + (size_t)row * 1024 + col0; float ss = 0.f;
#pragma unroll
                for (int bj = 0; bj < 2; ++bj) { const f32x4 v0 = acc[ai][bj][m][0], v1 = acc[ai][bj][m][1];
                    ss += (v0[0] * v0[0] + v0[1] * v0[1]) + (v0[2] * v0[2] + v0[3] * v0[3]) + (v1[0] * v1[0] + v1[1] * v1[1]) + (v1[2] * v1[2] + v1[3] * v1[3]);
                    u32x4 w; w.x = cvt_pk_bf16(v0[0], v0[1]); w.y = cvt_pk_bf16(v0[2], v0[3]); w.z = cvt_pk_bf16(v1[0], v1[1]); w.w = cvt_pk_bf16(v1[2], v1[3]);
                    *(u32x4*)(rowp + bj * HALF) = w; }
                ss += __shfl_xor(ss, 16); ss += __shfl_xor(ss, 32);
                if (fq == 0) osq[(size_t)row * 16 + u.pn * 4 + wc] = ss; }
    }
};
struct EpiDown {
    static constexpr bool PERM = true;
    bf16_t* C; const float* bias;
    __device__ __forceinline__ void operator()(const f32x4 (&acc)[2][2][4][2], const Unit& u, int wr, int wc, int fr, int fq) const {
        const int e = u.pn >> 2, pnl = u.pn & 3;
        const int row0 = u.pm * BM + wr * 64 + fr, col0 = pnl * BM + wc * 32 + 8 * fq;
        const float* bp = bias + (size_t)e * 1024 + col0;
        f32x4 bv[2][2];
#pragma unroll
        for (int bj = 0; bj < 2; ++bj)
#pragma unroll
            for (int n = 0; n < 2; ++n) bv[bj][n] = *(const f32x4*)(bp + bj * HALF + 4 * n);
#pragma unroll
        for (int ai = 0; ai < 2; ++ai)
#pragma unroll
            for (int m = 0; m < 4; ++m) { bf16_t* rowp = C + (size_t)(row0 + ai * HALF + m * 16) * 1024 + col0;
#pragma unroll
                for (int bj = 0; bj < 2; ++bj) { const f32x4 v0 = acc[ai][bj][m][0] + bv[bj][0], v1 = acc[ai][bj][m][1] + bv[bj][1];
                    u32x4 w; w.x = cvt_pk_bf16(v0[0], v0[1]); w.y = cvt_pk_bf16(v0[2], v0[3]); w.z = cvt_pk_bf16(v1[0], v1[1]); w.w = cvt_pk_bf16(v1[2], v1[3]);
                    *(u32x4*)(rowp + bj * HALF) = w; } }
    }
};
struct EpiSwiglu {
    static constexpr bool PERM = true;
    bf16_t* O; const float* bias;
    __device__ __forceinline__ void operator()(const f32x4 (&acc)[2][2][4][2], const Unit& u, int wr, int wc, int fr, int fq) const {
        const int e = u.pn >> 3, pnl = u.pn & 7;
        const int row0 = u.pm * BM + wr * 64 + fr, col0 = pnl * HALF + wc * 32 + 8 * fq;
        const float* bp = bias + (size_t)e * 2048 + col0;
        f32x4 bg[2], bu[2];
#pragma unroll
        for (int n = 0; n < 2; ++n) { bg[n] = *(const f32x4*)(bp + 4 * n); bu[n] = *(const f32x4*)(bp + 1024 + 4 * n) + 1.0f; }
#pragma unroll
        for (int ai = 0; ai < 2; ++ai)
#pragma unroll
            for (int m = 0; m < 4; ++m) {
                bf16_t* rowp = O + (size_t)(row0 + ai * HALF + m * 16) * 1024 + col0;
                float r[8];
#pragma unroll
                for (int n = 0; n < 2; ++n) {
                    const f32x4 g = acc[ai][0][m][n] + bg[n], up = acc[ai][1][m][n] + bu[n];
                    const f32x4 gt = __builtin_elementwise_min(g, (f32x4){7.f, 7.f, 7.f, 7.f});
                    const f32x4 uu = __builtin_elementwise_min(__builtin_elementwise_max(up, (f32x4){-6.f, -6.f, -6.f, -6.f}), (f32x4){8.f, 8.f, 8.f, 8.f});
                    const f32x4 z = gt * (-1.702f * 1.4426950408889634f);
                    f32x4 e; e[0] = __builtin_amdgcn_exp2f(z[0]); e[1] = __builtin_amdgcn_exp2f(z[1]); e[2] = __builtin_amdgcn_exp2f(z[2]); e[3] = __builtin_amdgcn_exp2f(z[3]);
                    const f32x4 d = e + 1.0f;
                    f32x4 rc; rc[0] = __builtin_amdgcn_rcpf(d[0]); rc[1] = __builtin_amdgcn_rcpf(d[1]); rc[2] = __builtin_amdgcn_rcpf(d[2]); rc[3] = __builtin_amdgcn_rcpf(d[3]);
                    const f32x4 o = (uu * gt) * rc;
                    r[n * 4] = o[0]; r[n * 4 + 1] = o[1]; r[n * 4 + 2] = o[2]; r[n * 4 + 3] = o[3];
                }
                u32x4 w; w.x = cvt_pk_bf16(r[0], r[1]); w.y = cvt_pk_bf16(r[2], r[3]); w.z = cvt_pk_bf16(r[4], r[5]); w.w = cvt_pk_bf16(r[6], r[7]);
                *(u32x4*)rowp = w;
            }
    }
};

template <class Epi, class Sched, bool ALIGN_EPI = false, bool SP2 = false, bool GATHER = false>
__device__ __forceinline__ void gemm_phase(PG8_LAS unsigned char* lds, const Gemm g, const Sched& S, const Epi& E, const int* rowtok = nullptr) {
    static_assert(!GATHER || SP2, "gather staging is wired into the SP2 loop only");
    const int tid = opaque_tid(), wid = __builtin_amdgcn_readfirstlane(tid >> 6), lane = tid & 63, wr = wid >> 2, wc = wid & 3, fr = lane & 15, fq = lane >> 4;
    const int K = g.K, nt = K / BK;
    unsigned voffA[2], voffB[2];
#pragma unroll
    for (int i = 0; i < 2; ++i) { int R, C; stage_rc(tid * 16 + i * 8192, R, C); const int Rb = Epi::PERM ? ((R & ~31) + perm32(R & 31)) : R;
        voffA[i] = (unsigned)(R * K + C) * 2u; voffB[i] = (unsigned)(Rb * K + C) * 2u; }
    int gR[2], gC[2];
#pragma unroll
    for (int i = 0; i < 2; ++i) stage_rc(tid * 16 + i * 8192, gR[i], gC[i]);
    PG8_LAS int* rt = (PG8_LAS int*)(lds + STAGE_BYTES);
    unsigned gaC[2][2] = {{0u, 0u}, {0u, 0u}}, gaN[2][2] = {{0u, 0u}, {0u, 0u}};
    const size_t kstep = (size_t)(BK * 2);
    const size_t hstep = (size_t)HALF * K * 2;
    const size_t tstep = 2 * hstep;
    const unsigned ldsw = (unsigned)wid * 1024u;
    const int aoff = lds_byte(wr * 64 + fr, fq * 8), boff = lds_byte(wc * 32 + fr, fq * 8);
#define PG8_SA(b, h) (((b) * 2 + (h)) * HTB)
#define PG8_SB(b, h) ((4 + (b) * 2 + (h)) * HTB)
#define PG8_STAGE(bufoff, gbase, voff) do { _Pragma("unroll") for (int _i = 0; _i < 2; ++_i) \
        __builtin_amdgcn_global_load_lds((const unsigned*)((const char*)(gbase) + (voff)[_i]), (PG8_LAS unsigned*)(lds + (bufoff) + ldsw + _i * 8192), 16, 0, 0); } while (0)
#define PG8_GOFF(dst, k) do { _Pragma("unroll") for (int h_ = 0; h_ < 2; ++h_) _Pragma("unroll") for (int i_ = 0; i_ < 2; ++i_) dst[h_][i_] = (unsigned)(rt[(k) * 256 + h_ * HALF + gR[i_]] * K + gC[i_]) * 2u; } while (0)
#define PG8_STAGE_A(bufoff, ptr, un, h, kb) do { if constexpr (GATHER) { const unsigned o0_ = (un) ? gaN[h][0] : gaC[h][0], o1_ = (un) ? gaN[h][1] : gaC[h][1]; \
        __builtin_amdgcn_global_load_lds((const unsigned*)((const char*)g.A + (kb) + o0_), (PG8_LAS unsigned*)(lds + (bufoff) + ldsw), 16, 0, 0); \
        __builtin_amdgcn_global_load_lds((const unsigned*)((const char*)g.A + (kb) + o1_), (PG8_LAS unsigned*)(lds + (bufoff) + ldsw + 8192), 16, 0, 0); } else PG8_STAGE(bufoff, ptr, voffA); } while (0)
#define PG8_LDA(dst, b, h) do { _Pragma("unroll") for (int m = 0; m < 4; ++m) _Pragma("unroll") for (int k = 0; k < 2; ++k) dst[m][k] = *(const PG8_LAS bf16x8*)(lds + PG8_SA(b, h) + aoff + m * 2048 + k * 1024); } while (0)
#define PG8_LDB(dst, b, h) do { _Pragma("unroll") for (int n = 0; n < 2; ++n) _Pragma("unroll") for (int k = 0; k < 2; ++k) dst[n][k] = *(const PG8_LAS bf16x8*)(lds + PG8_SB(b, h) + boff + n * 2048 + k * 1024); } while (0)
#define PG8_MMA(ai, bj, At, Bt) do { __builtin_amdgcn_s_setprio(1); _Pragma("unroll") for (int m = 0; m < 4; ++m) _Pragma("unroll") for (int n = 0; n < 2; ++n) _Pragma("unroll") for (int k = 0; k < 2; ++k) \
        acc[ai][bj][m][n] = __builtin_amdgcn_mfma_f32_16x16x32_bf16(Bt[n][k], At[m][k], acc[ai][bj][m][n], 0, 0, 0); __builtin_amdgcn_s_setprio(0); } while (0)
#define PG8_WAIT_V(n) asm volatile("s_waitcnt vmcnt(" #n ")" ::: "memory")
#define PG8_WAIT_L(n) asm volatile("s_waitcnt lgkmcnt(" #n ")" ::: "memory")
#define PG8_BAR __builtin_amdgcn_s_barrier()
#define PG8_SCHED __builtin_amdgcn_sched_barrier(0)
    Unit cur, nxt; int ui = 0;
    if (!S.next(0, cur)) return;
    f32x4 acc[2][2][4][2];
#pragma unroll
    for (int a = 0; a < 2; ++a)
#pragma unroll
        for (int b = 0; b < 2; ++b)
#pragma unroll
            for (int m = 0; m < 4; ++m)
#pragma unroll
                for (int n = 0; n < 2; ++n) acc[a][b][m][n] = (f32x4){0.f, 0.f, 0.f, 0.f};
    bf16x8 At[4][2], B0[2][2], B1[2][2];
    const char* cA = (const char*)g.A + (size_t)cur.pm * tstep; const char* cB = (const char*)g.Bt + (size_t)cur.pn * tstep;
    S.a_ready(cur);
    if constexpr (GATHER) {
        PG8_LAS int* pms = rt + 16 * 256;
        if (tid < 16) { Unit u_; pms[tid] = S.next(tid, u_) ? u_.pm : -1; }
        __syncthreads();
        {
            int tok[8];
#pragma unroll
            for (int j = 0; j < 8; ++j) { const int k = 2 * j + (tid >> 8), pm = pms[k]; tok[j] = (pm >= 0) ? rowtok[pm * 256 + (tid & 255)] : 0; }
#pragma unroll
            for (int j = 0; j < 8; ++j) rt[(2 * j + (tid >> 8)) * 256 + (tid & 255)] = tok[j];
        }
        __syncthreads();
        PG8_GOFF(gaC, 0);
    }
    if constexpr (SP2) {
        PG8_STAGE(PG8_SB(0, 0), cB, voffB); PG8_STAGE(PG8_SB(0, 1), cB + hstep, voffB); PG8_STAGE_A(PG8_SA(0, 0), cA, false, 0, (size_t)0); PG8_STAGE_A(PG8_SA(0, 1), cA + hstep, false, 1, (size_t)0);
        if (wr == 1) PG8_BAR;
        PG8_WAIT_V(2); PG8_BAR;
        PG8_STAGE(PG8_SB(1, 0), cB + kstep, voffB); PG8_STAGE_A(PG8_SA(1, 0), cA + kstep, false, 0, kstep); PG8_STAGE(PG8_SB(1, 1), cB + hstep + kstep, voffB);
        PG8_WAIT_V(6); PG8_BAR;
    } else {
        PG8_STAGE(PG8_SB(0, 0), cB, voffB); PG8_STAGE(PG8_SA(0, 0), cA, voffA); PG8_STAGE(PG8_SB(0, 1), cB + hstep, voffB); PG8_STAGE(PG8_SA(0, 1), cA + hstep, voffA);
        if (wr == 1) PG8_BAR;
        PG8_WAIT_V(4); PG8_BAR;
        PG8_STAGE(PG8_SB(1, 0), cB + kstep, voffB); PG8_STAGE(PG8_SA(1, 0), cA + kstep, voffA); PG8_STAGE(PG8_SB(1, 1), cB + hstep + kstep, voffB);
        PG8_WAIT_V(6); PG8_BAR;
    }
    for (;;) {
        const bool has_next = S.next(ui + 1, nxt);
        if constexpr (GATHER) { if (has_next) PG8_GOFF(gaN, ui + 1); }
        const char* nA = has_next ? (const char*)g.A + (size_t)nxt.pm * tstep : cA; const char* nB = has_next ? (const char*)g.Bt + (size_t)nxt.pn * tstep : cB;
        for (int t = 0; t < nt; t += 2) {
            const bool last = (t == nt - 2);
            const char* a1 = cA + (size_t)(t + 1) * kstep;
            const char* a2 = last ? nA : cA + (size_t)(t + 2) * kstep; const char* b2 = last ? nB : cB + (size_t)(t + 2) * kstep;
            const char* a3 = a2 + kstep; const char* b3 = b2 + kstep;
            if (last && has_next) S.a_ready(nxt);
            const bool un = last && has_next; const size_t k1 = (size_t)(t + 1) * kstep, k2 = last ? (size_t)0 : (size_t)(t + 2) * kstep;
            if constexpr (SP2) {
            PG8_LDB(B0, 0, 0); PG8_LDB(B1, 0, 1); PG8_SCHED; PG8_LDA(At, 0, 0); PG8_STAGE_A(PG8_SA(1, 1), a1 + hstep, false, 1, k1);
            PG8_WAIT_V(8); PG8_WAIT_L(0); PG8_BAR; PG8_MMA(0, 0, At, B0); PG8_MMA(0, 1, At, B1); PG8_BAR; PG8_SCHED;
            PG8_LDA(At, 0, 1); PG8_STAGE(PG8_SB(0, 0), b2, voffB); PG8_STAGE(PG8_SB(0, 1), b2 + hstep, voffB); PG8_STAGE_A(PG8_SA(0, 0), a2, un, 0, k2);
            PG8_WAIT_V(8); PG8_WAIT_L(0); PG8_BAR; PG8_MMA(1, 0, At, B0); PG8_MMA(1, 1, At, B1); PG8_BAR; PG8_SCHED;
            PG8_LDB(B0, 1, 0); PG8_LDB(B1, 1, 1); PG8_SCHED; PG8_LDA(At, 1, 0); PG8_STAGE_A(PG8_SA(0, 1), a2 + hstep, un, 1, k2);
            PG8_WAIT_V(8); PG8_WAIT_L(0); PG8_BAR; PG8_MMA(0, 0, At, B0); PG8_MMA(0, 1, At, B1); PG8_BAR; PG8_SCHED;
            PG8_LDA(At, 1, 1); PG8_STAGE(PG8_SB(1, 0), b3, voffB); PG8_STAGE(PG8_SB(1, 1), b3 + hstep, voffB); PG8_STAGE_A(PG8_SA(1, 0), a3, un, 0, k2 + kstep);
            PG8_WAIT_V(8); PG8_WAIT_L(0); PG8_BAR; PG8_MMA(1, 0, At, B0); PG8_MMA(1, 1, At, B1); PG8_BAR; PG8_SCHED;
            } else {
            PG8_LDB(B0, 0, 0); PG8_SCHED; PG8_LDA(At, 0, 0); PG8_STAGE(PG8_SA(1, 1), a1 + hstep, voffA);
            PG8_WAIT_L(8); PG8_BAR; PG8_WAIT_L(0); PG8_MMA(0, 0, At, B0); PG8_BAR; PG8_SCHED;
            PG8_LDB(B1, 0, 1); PG8_STAGE(PG8_SB(0, 0), b2, voffB);
            PG8_BAR; PG8_WAIT_L(0); PG8_MMA(0, 1, At, B1); PG8_BAR;
            PG8_LDA(At, 0, 1); PG8_STAGE(PG8_SA(0, 0), a2, voffA);
            PG8_BAR; PG8_WAIT_L(0); PG8_MMA(1, 0, At, B0); PG8_BAR; PG8_SCHED;
            PG8_STAGE(PG8_SB(0, 1), b2 + hstep, voffB);
            PG8_WAIT_V(6); PG8_BAR; PG8_MMA(1, 1, At, B1); PG8_BAR;
            PG8_LDB(B0, 1, 0); PG8_SCHED; PG8_LDA(At, 1, 0); PG8_STAGE(PG8_SA(0, 1), a2 + hstep, voffA);
            PG8_WAIT_L(8); PG8_BAR; PG8_WAIT_L(0); PG8_MMA(0, 0, At, B0); PG8_BAR; PG8_SCHED;
            PG8_LDB(B1, 1, 1); PG8_STAGE(PG8_SB(1, 0), b3, voffB);
            PG8_BAR; PG8_WAIT_L(0); PG8_MMA(0, 1, At, B1); PG8_BAR;
            PG8_LDA(At, 1, 1); PG8_STAGE(PG8_SA(1, 0), a3, voffA);
            PG8_BAR; PG8_WAIT_L(0); PG8_MMA(1, 0, At, B0); PG8_BAR; PG8_SCHED;
            PG8_STAGE(PG8_SB(1, 1), b3 + hstep, voffB);
            PG8_WAIT_V(6); PG8_BAR; PG8_MMA(1, 1, At, B1); PG8_BAR;
            }
        }
        if constexpr (ALIGN_EPI) { if (wr == 0) PG8_BAR; }
        E(acc, cur, wr, wc, fr, fq); S.done(cur);
        if (!has_next) break;
#pragma unroll
        for (int a = 0; a < 2; ++a)
#pragma unroll
            for (int b = 0; b < 2; ++b)
#pragma unroll
                for (int m = 0; m < 4; ++m)
#pragma unroll
                    for (int n = 0; n < 2; ++n) acc[a][b][m][n] = (f32x4){0.f, 0.f, 0.f, 0.f};
        cur = nxt; cA = nA; cB = nB; ++ui;
        if constexpr (GATHER) { gaC[0][0] = gaN[0][0]; gaC[0][1] = gaN[0][1]; gaC[1][0] = gaN[1][0]; gaC[1][1] = gaN[1][1]; }
        if constexpr (ALIGN_EPI) { if (wr == 1) PG8_BAR; }
    }
    PG8_WAIT_V(0);
    if constexpr (!ALIGN_EPI) { if (wr == 0) PG8_BAR; }
    PG8_BAR;
#undef PG8_SA
#undef PG8_SB
#undef PG8_STAGE
#undef PG8_LDA
#undef PG8_GOFF
#undef PG8_STAGE_A
#undef PG8_LDB
#undef PG8_MMA
#undef PG8_WAIT_V
#undef PG8_WAIT_L
#undef PG8_BAR
#undef PG8_SCHED
}
}

typedef short bf16x8_t __attribute__((ext_vector_type(8)));
typedef float f32x16_t __attribute__((ext_vector_type(16)));
typedef float f32x2_t __attribute__((ext_vector_type(2)));
typedef unsigned u32x4_t __attribute__((ext_vector_type(4)));
typedef unsigned u32x2_t __attribute__((ext_vector_type(2)));
#define LAS3 __attribute__((address_space(3)))
constexpr int ATT_VROW = 68;
constexpr int ATT_LDS_BYTES = 3 * (64 * 104 * 2 + 64 * ATT_VROW * 2);

template <int QKD, int NMAP, bool DA>
__device__ __forceinline__ void attn_item(LAS3 unsigned char* lds, const bf16_t* __restrict__ Qb, const bf16_t* __restrict__ Kb, const bf16_t* __restrict__ Vt,
                                          bf16_t* __restrict__ ycatb, int ycat_off, int b, int h, int qblk, float lam, const float* __restrict__ subln, float post_scale) {
    constexpr int DK = QKD / NMAP, KS = DK / 16, KROW = QKD + 8, KCH = QKD / 8;
    constexpr int KBYTES = 64 * KROW * 2, VBYTES = 64 * ATT_VROW * 2, BUFB = KBYTES + VBYTES;
    const int tid = opaque_tid(), wid = tid >> 6, lane = tid & 63, r = lane & 31, hh = lane >> 5;
    const int q0 = qblk * 256, ntiles = (qblk == 0) ? (NC / 64) : (NT / 64);
    const size_t base = ((size_t)b * 4 + h) * NT;
    bf16x8_t qf[NMAP][KS];
#pragma unroll
    for (int m = 0; m < NMAP; ++m)
#pragma unroll
        for (int ks = 0; ks < KS; ++ks) qf[m][ks] = *(const bf16x8_t*)(Qb + (base + q0 + 32 * wid + r) * QKD + m * DK + 16 * ks + 8 * hh);
    f32x16_t O[NMAP][2]; float mrun[NMAP], lrun[NMAP];
#pragma unroll
    for (int m = 0; m < NMAP; ++m) { mrun[m] = 0.f; lrun[m] = 0.f;
#pragma unroll
        for (int d2 = 0; d2 < 2; ++d2)
#pragma unroll
            for (int i = 0; i < 16; ++i) O[m][d2][i] = 0.f; }
    constexpr int NKC = 64 * KCH;
    const bf16_t* kg = Kb + base * QKD;
    const bf16_t* vg = Vt + ((size_t)(b * 4 + h) * 64 + (tid >> 3)) * NT + (tid & 7) * 8;
    u32x4_t rk0, rk1 = (u32x4_t){0u, 0u, 0u, 0u}, rv;
    const int kc1 = tid + 512;
    const int k0row = tid / KCH, k0col = tid % KCH, k1row = kc1 / KCH, k1col = kc1 % KCH;
#define ATT_LOAD(j) do { rk0 = *(const u32x4_t*)(kg + (size_t)(j) * 64 * QKD + tid * 8); if (NKC > 512 && kc1 < NKC) rk1 = *(const u32x4_t*)(kg + (size_t)(j) * 64 * QKD + kc1 * 8); \
        rv = *(const u32x4_t*)(vg + (size_t)(j) * 64); } while (0)
#define ATT_STORE(buf) do { LAS3 unsigned char* kb_ = lds + (buf) * BUFB; LAS3 unsigned char* vb_ = kb_ + KBYTES; \
        *(LAS3 u32x4_t*)(kb_ + (k0row * KROW + k0col * 8) * 2) = rk0; if (NKC > 512 && kc1 < NKC) *(LAS3 u32x4_t*)(kb_ + (k1row * KROW + k1col * 8) * 2) = rk1; \
        LAS3 unsigned char* vd_ = vb_ + ((tid >> 3) * ATT_VROW + (tid & 7) * 8) * 2; *(LAS3 u32x2_t*)vd_ = (u32x2_t){rv.x, rv.y}; *(LAS3 u32x2_t*)(vd_ + 8) = (u32x2_t){rv.z, rv.w}; } while (0)
    __syncthreads();
    ATT_LOAD(0); ATT_STORE(0);
    if (ntiles > 1) ATT_LOAD(1);
    __syncthreads();
    bf16x8_t pf[NMAP][2][2];
#define ATT_PV(m_, vb_) do { _Pragma("unroll") for (int d2 = 0; d2 < 2; ++d2) _Pragma("unroll") for (int kt = 0; kt < 2; ++kt) _Pragma("unroll") for (int s2 = 0; s2 < 2; ++s2) { \
        const LAS3 unsigned char* vp = (vb_) + ((d2 * 32 + r) * ATT_VROW + kt * 32 + 16 * s2 + 4 * hh) * 2; \
        union { u32x2_t u[2]; bf16x8_t v; } av; av.u[0] = *(const LAS3 u32x2_t*)vp; av.u[1] = *(const LAS3 u32x2_t*)(vp + 16); \
        O[m_][d2] = __builtin_amdgcn_mfma_f32_32x32x16_bf16(av.v, pf[m_][kt][s2], O[m_][d2], 0, 0, 0); } } while (0)
    int sl = 0;
    for (int j = 0; j < ntiles; ++j) {
        const LAS3 unsigned char* kb = lds + sl * BUFB;
        const LAS3 unsigned char* vbp = lds + ((sl == 0) ? 2 : sl - 1) * BUFB + KBYTES;
#pragma unroll
        for (int m = 0; m < NMAP; ++m) {
            f32x16_t S[2];
            const float nm = -mrun[m];
#pragma unroll
            for (int kt = 0; kt < 2; ++kt) {
#pragma unroll
                for (int i = 0; i < 16; ++i) S[kt][i] = nm;
#pragma unroll
                for (int ks = 0; ks < KS; ++ks) {
                    const bf16x8_t a = *(const LAS3 bf16x8_t*)(kb + ((kt * 32 + r) * KROW + m * DK + 16 * ks + 8 * hh) * 2);
                    S[kt] = __builtin_amdgcn_mfma_f32_32x32x16_bf16(a, qf[m][ks], S[kt], 0, 0, 0);
                }
            }
            if (j > 0) ATT_PV(m, vbp);
            float mx = S[0][0];
#pragma unroll
            for (int i = 1; i < 16; ++i) mx = fmaxf(mx, S[0][i]);
#pragma unroll
            for (int i = 0; i < 16; ++i) mx = fmaxf(mx, S[1][i]);
            mx = fmaxf(mx, __shfl_xor(mx, 32));
            if (j == 0 || !__all(mx <= 8.f)) {
                const float dl = (j == 0) ? mx : fmaxf(mx, 0.f);
                mrun[m] += dl;
#pragma unroll
                for (int kt = 0; kt < 2; ++kt)
#pragma unroll
                    for (int i = 0; i < 16; ++i) S[kt][i] -= dl;
                if (j != 0) {
                    const float alpha = __builtin_amdgcn_exp2f(-dl);
                    lrun[m] *= alpha;
#pragma unroll
                    for (int d2 = 0; d2 < 2; ++d2)
#pragma unroll
                        for (int i = 0; i < 16; ++i) O[m][d2][i] *= alpha;
                }
            }
            f32x2_t ps2 = (f32x2_t){0.f, 0.f};
#pragma unroll
            for (int kt = 0; kt < 2; ++kt) {
#pragma unroll
                for (int i = 0; i < 16; i += 2) { const float p0 = __builtin_amdgcn_exp2f(S[kt][i]), p1 = __builtin_amdgcn_exp2f(S[kt][i + 1]); S[kt][i] = p0; S[kt][i + 1] = p1; ps2 += (f32x2_t){p0, p1}; }
#pragma unroll
                for (int s2 = 0; s2 < 2; ++s2) {
                    union { unsigned u[4]; bf16x8_t v; } cv;
#pragma unroll
                    for (int jj = 0; jj < 4; ++jj) cv.u[jj] = cvtpk(S[kt][8 * s2 + 2 * jj], S[kt][8 * s2 + 2 * jj + 1]);
                    pf[m][kt][s2] = cv.v;
                }
            }
            lrun[m] += ps2[0] + ps2[1];
        }
        const int sn = (sl == 2) ? 0 : sl + 1;
        if (j + 1 < ntiles) { ATT_STORE(sn); if (j + 2 < ntiles) ATT_LOAD(j + 2); }
        __syncthreads();
        sl = sn;
    }
    {
        const LAS3 unsigned char* vbl = lds + ((sl == 0) ? 2 : sl - 1) * BUFB + KBYTES;
#pragma unroll
        for (int m = 0; m < NMAP; ++m) ATT_PV(m, vbl);
    }
#undef ATT_PV
#undef ATT_LOAD
#undef ATT_STORE
    float inv[NMAP];
#pragma unroll
    for (int m = 0; m < NMAP; ++m) { const float lt = lrun[m] + __shfl_xor(lrun[m], 32); inv[m] = __builtin_amdgcn_rcpf(lt); }
    if (NMAP == 2) inv[NMAP - 1] *= -lam;
    float ss = 0.f;
#pragma unroll
    for (int d2 = 0; d2 < 2; ++d2)
#pragma unroll
        for (int i = 0; i < 16; ++i) {
            float o = O[0][d2][i] * inv[0];
            if (NMAP == 2) o += O[NMAP - 1][d2][i] * inv[NMAP - 1];
            O[0][d2][i] = o; ss += o * o;
        }
    float rs = 1.f;
    if (DA) { ss += __shfl_xor(ss, 32); rs = rsqrtf(ss * (1.f / 64.f) + 1e-6f) * post_scale; }
    bf16_t* yp = ycatb + ((size_t)b * NT + q0 + 32 * wid + r) * DM + ycat_off + h * 64;
#pragma unroll
    for (int d2 = 0; d2 < 2; ++d2)
#pragma unroll
        for (int g4 = 0; g4 < 4; ++g4) {
            const int dv = 32 * d2 + 8 * g4 + 4 * hh;
            float o0 = O[0][d2][4 * g4] * rs, o1 = O[0][d2][4 * g4 + 1] * rs, o2 = O[0][d2][4 * g4 + 2] * rs, o3 = O[0][d2][4 * g4 + 3] * rs;
            if (DA) { const float4 w = *(const float4*)(subln + dv); o0 *= w.x; o1 *= w.y; o2 *= w.z; o3 *= w.w; }
            *(uint2*)(yp + dv) = make_uint2(cvtpk(o0, o1), cvtpk(o2, o3));
        }
}


typedef float f32x4_t __attribute__((ext_vector_type(4)));
constexpr int ML_KROW = 72, ML_TROW = 136, ML_CROW = 72;
constexpr int ML_OFF_KC = 0, ML_OFF_KT = ML_OFF_KC + 128 * ML_KROW * 2, ML_OFF_VT = ML_OFF_KT + 64 * ML_TROW * 2, ML_OFF_CB = ML_OFF_VT + 80 * ML_TROW * 2,
              ML_OFF_F = ML_OFF_CB + 80 * ML_CROW * 2, ML_LDS_BYTES = ML_OFF_F + 6 * 128 * 4 + 64;
__device__ __forceinline__ void mlstm_item(LAS3 unsigned char* lds, const bf16_t* __restrict__ Qb, const bf16_t* __restrict__ Kb, const bf16_t* __restrict__ Ktg, const bf16_t* __restrict__ Vtg,
                                           const float* __restrict__ G, float* __restrict__ hdir, int b, int h, int dir) {
    const int tid = opaque_tid(), wid = tid >> 6, lane = tid & 63, lr = lane & 15, q = lane >> 4;
    LAS3 unsigned char* Kc = lds + ML_OFF_KC; LAS3 unsigned char* Kt = lds + ML_OFF_KT; LAS3 unsigned char* Vt = lds + ML_OFF_VT; LAS3 unsigned char* Cb = lds + ML_OFF_CB;
    LAS3 float* fl = (LAS3 float*)(lds + ML_OFF_F);
    LAS3 float* s_li = fl; LAS3 float* s_lf = fl + 128; LAS3 float* s_bc2 = fl + 256; LAS3 float* s_gk2 = fl + 384; LAS3 float* s_wu = fl + 512; LAS3 float* s_et = fl + 640; LAS3 float* s_misc = fl + 768;
    const size_t base = ((size_t)b * 4 + h) * NT;
    __syncthreads();
    for (int i = tid; i < 80 * ML_CROW / 2; i += 512) ((LAS3 unsigned*)Cb)[i] = 0u;
    for (int i = tid; i < 16 * ML_TROW / 2; i += 512) ((LAS3 unsigned*)(Vt + 64 * ML_TROW * 2))[i] = (i < ML_TROW / 2) ? 0x3F803F80u : 0u;
    const int ct = wid & 3, rt0 = (wid < 4) ? 0 : 3, nrt = (wid < 4) ? 3 : 2;
    f32x4_t Cacc[3];
#pragma unroll
    for (int i = 0; i < 3; ++i) Cacc[i] = (f32x4_t){0.f, 0.f, 0.f, 0.f};
    const int tq = 16 * wid + lr;
    const int ia = (dir == 0) ? 2 * lane : 127 - 2 * lane, ib = (dir == 0) ? 2 * lane + 1 : 126 - 2 * lane;
    u32x4_t nkc[2], nkt[2], nvt[2]; bf16x8_t nqf[2]; float ngxa = 0.f, ngxb = 0.f, ngla = 0.f, nglb = 0.f;
#define ML_N0(c_) ((dir == 0) ? 128 * (c_) : (((c_) < 2) ? 128 * (1 - (c_)) : NC + 128 * (17 - (c_))))
#define ML_LOAD(c_) do { const int n0_ = ML_N0(c_); \
        _Pragma("unroll") for (int i = 0; i < 2; ++i) { const int id = tid + 512 * i; \
            nkc[i] = *(const u32x4_t*)(Kb + (base + n0_ + (id >> 3)) * 64 + (id & 7) * 8); \
            nkt[i] = *(const u32x4_t*)(Ktg + ((size_t)(b * 4 + h) * 64 + (id >> 4)) * NT + n0_ + (id & 15) * 8); \
            nvt[i] = *(const u32x4_t*)(Vtg + ((size_t)(b * 4 + h) * 64 + (id >> 4)) * NT + n0_ + (id & 15) * 8); } \
        _Pragma("unroll") for (int ks = 0; ks < 2; ++ks) nqf[ks] = *(const bf16x8_t*)(Qb + (base + n0_ + tq) * 64 + 32 * ks + 8 * q); \
        if (wid == 0) { const float* gpa = G + ((size_t)b * NT + n0_ + ia) * 16 + (dir * 2) * 4 + h; const float* gpb = G + ((size_t)b * NT + n0_ + ib) * 16 + (dir * 2) * 4 + h; \
            ngxa = gpa[4]; ngxb = gpb[4]; ngla = gpa[0]; nglb = gpb[0]; } } while (0)
    ML_LOAD(0);
    for (int c = 0; c < NT / 128; ++c) {
        const int n0 = ML_N0(c);
        u32x4_t rkc[2], rkt[2], rvt[2];
        bf16x8_t qf[2];
#pragma unroll
        for (int i = 0; i < 2; ++i) { rkc[i] = nkc[i]; rkt[i] = nkt[i]; rvt[i] = nvt[i]; qf[i] = nqf[i]; }
        const float xa = ngxa, xb = ngxb, lia = ngla, lib = nglb;
        if (c + 1 < NT / 128) ML_LOAD(c + 1);
#pragma unroll
        for (int i = 0; i < 2; ++i) {
            const int id = tid + 512 * i;
            *(LAS3 u32x4_t*)(Kc + ((id >> 3) * ML_KROW + (id & 7) * 8) * 2) = rkc[i];
            *(LAS3 u32x4_t*)(Vt + ((id >> 4) * ML_TROW + (id & 15) * 8) * 2) = rvt[i];
        }
        __syncthreads();
        if (wid == 0) {
            float inc = xa + xb;
#pragma unroll
            for (int o = 1; o < 64; o <<= 1) { const float v = __shfl_up(inc, o); if (lane >= o) inc += v; }
            const float tot = __shfl(inc, 63);
            const float bca = inc - xb, bcb = inc;
            s_bc2[ia] = bca * 1.4426950408889634f; s_bc2[ib] = bcb * 1.4426950408889634f;
            s_gk2[ia] = (bca - lia) * 1.4426950408889634f; s_gk2[ib] = (bcb - lib) * 1.4426950408889634f;
            s_wu[ia] = __expf(tot - bca + lia); s_wu[ib] = __expf(tot - bcb + lib);
            s_et[ia] = __expf(bca); s_et[ib] = __expf(bcb);
            if (lane == 0) s_misc[0] = __expf(tot);
        }
        __syncthreads();
#pragma unroll
        for (int i = 0; i < 2; ++i) {
            const int id = tid + 512 * i; const int tk0 = (id & 15) * 8;
            unsigned w4[4] = {rkt[i].x, rkt[i].y, rkt[i].z, rkt[i].w}; u32x4_t o;
#pragma unroll
            for (int jj = 0; jj < 4; ++jj) {
                const float lo = __uint_as_float(w4[jj] << 16) * s_wu[tk0 + 2 * jj], hi = __uint_as_float(w4[jj] & 0xFFFF0000u) * s_wu[tk0 + 2 * jj + 1];
                o[jj] = cvtpk(lo, hi);
            }
            *(LAS3 u32x4_t*)(Kt + ((id >> 4) * ML_TROW + tk0) * 2) = o;
        }
        f32x4_t S[8];
#pragma unroll
        for (int kt = 0; kt < 8; ++kt) {
            S[kt] = (f32x4_t){0.f, 0.f, 0.f, 0.f};
#pragma unroll
            for (int ks = 0; ks < 2; ++ks) {
                const bf16x8_t a = *(const LAS3 bf16x8_t*)(Kc + ((16 * kt + lr) * ML_KROW + 32 * ks + 8 * q) * 2);
                S[kt] = __builtin_amdgcn_mfma_f32_16x16x32_bf16(a, qf[ks], S[kt], 0, 0, 0);
            }
        }
        const float bct = s_bc2[tq];
#pragma unroll
        for (int kt = 0; kt < 8; ++kt) {
            const f32x4_t gk = *(const LAS3 f32x4_t*)(s_gk2 + 16 * kt + 4 * q);
#pragma unroll
            for (int rg = 0; rg < 4; ++rg) {
                const int si = 16 * kt + 4 * q + rg;
                const bool valid = (dir == 0) ? (si <= tq) : (si >= tq);
                const float w = valid ? __builtin_amdgcn_exp2f(bct - gk[rg]) : 0.f;
                S[kt][rg] *= w;
            }
        }
        bf16x8_t pf[4];
#pragma unroll
        for (int k2 = 0; k2 < 4; ++k2) {
            union { unsigned u[4]; bf16x8_t v; } cv;
            cv.u[0] = cvtpk(S[2 * k2][0], S[2 * k2][1]); cv.u[1] = cvtpk(S[2 * k2][2], S[2 * k2][3]);
            cv.u[2] = cvtpk(S[2 * k2 + 1][0], S[2 * k2 + 1][1]); cv.u[3] = cvtpk(S[2 * k2 + 1][2], S[2 * k2 + 1][3]);
            pf[k2] = cv.v;
        }
        f32x4_t outv[5];
#pragma unroll
        for (int rt = 0; rt < 5; ++rt) {
            f32x4_t acc = (f32x4_t){0.f, 0.f, 0.f, 0.f}, acc2 = (f32x4_t){0.f, 0.f, 0.f, 0.f};
#pragma unroll
            for (int k2 = 0; k2 < 4; ++k2) {
                const LAS3 unsigned char* vp = Vt + ((16 * rt + lr) * ML_TROW + 32 * k2 + 4 * q) * 2;
                union { u32x2_t u[2]; bf16x8_t v; } av;
                av.u[0] = *(const LAS3 u32x2_t*)vp; av.u[1] = *(const LAS3 u32x2_t*)(vp + 32);
                acc = __builtin_amdgcn_mfma_f32_16x16x32_bf16(av.v, pf[k2], acc, 0, 0, 0);
            }
#pragma unroll
            for (int ks = 0; ks < 2; ++ks) {
                const bf16x8_t a = *(const LAS3 bf16x8_t*)(Cb + ((16 * rt + lr) * ML_CROW + 32 * ks + 8 * q) * 2);
                acc2 = __builtin_amdgcn_mfma_f32_16x16x32_bf16(a, qf[ks], acc2, 0, 0, 0);
            }
            outv[rt] = acc + acc2 * s_et[tq];
        }
        {
            const float den = __shfl(outv[4][0], lr);
            const float inv = __builtin_amdgcn_rcpf(fmaxf(fabsf(den), 1.f));
            bf16_t* hp = (bf16_t*)hdir + ((size_t)dir * TT + (size_t)b * NT + n0 + tq) * 256 + h * 64 + 4 * q;
            for (int rt = 0; rt < 4; ++rt) { const f32x4_t ov = outv[rt] * inv; *(uint2*)(hp + 16 * rt) = make_uint2(cvtpk(ov[0], ov[1]), cvtpk(ov[2], ov[3])); }
        }
        __syncthreads();
        {
            const float decay = s_misc[0];
#pragma unroll
            for (int i = 0; i < 3; ++i) Cacc[i] *= decay;
#pragma unroll
            for (int ks = 0; ks < 4; ++ks) {
                const bf16x8_t bb = *(const LAS3 bf16x8_t*)(Kt + ((16 * ct + lr) * ML_TROW + 32 * ks + 8 * q) * 2);
#pragma unroll
                for (int i = 0; i < 3; ++i) if (i < nrt) {
                    const bf16x8_t a = *(const LAS3 bf16x8_t*)(Vt + ((16 * (rt0 + i) + lr) * ML_TROW + 32 * ks + 8 * q) * 2);
                    Cacc[i] = __builtin_amdgcn_mfma_f32_16x16x32_bf16(a, bb, Cacc[i], 0, 0, 0);
                }
            }
#pragma unroll
            for (int i = 0; i < 3; ++i) if (i < nrt) {
#pragma unroll
                for (int rg = 0; rg < 4; ++rg) *(LAS3 bf16_t*)(Cb + ((16 * (rt0 + i) + 4 * q + rg) * ML_CROW + 16 * ct + lr) * 2) = f2bf(Cacc[i][rg]);
            }
        }
        __syncthreads();
    }
#undef ML_LOAD
#undef ML_N0
}

constexpr int S5_UROWS = NT + 64;
constexpr int S5_KROW = 1032, S5_CROW = 136, S5_ZROW = 136;
constexpr int S5_OFF_U = 0, S5_OFF_KM = S5_OFF_U + S5_UROWS * 16 * 2, S5_OFF_CM = S5_OFF_KM + 16 * S5_KROW * 2, S5_OFF_EZ = S5_OFF_CM + 16 * S5_CROW * 2,
              S5_LDS_BYTES = S5_OFF_EZ + 8 * 16 * S5_ZROW * 2;
__device__ __forceinline__ void s5_setup_item(LAS3 unsigned char* lds, int idx, const float* __restrict__ a_re, const float* __restrict__ a_im, const float* __restrict__ log_step,
                                                  const float* __restrict__ b_re, const float* __restrict__ b_im, const float* __restrict__ c_re, const float* __restrict__ c_im,
                                                  bf16_t* __restrict__ KmT, bf16_t* __restrict__ Smat, bf16_t* __restrict__ CmT, float* __restrict__ Aab, float* __restrict__ A64) {
    typedef float apw_t[64][2]; typedef float bb_t[16][2]; typedef float cc_t[64][2];
    LAS3 apw_t* apw = (LAS3 apw_t*)lds;
    LAS3 bb_t* bb = (LAS3 bb_t*)(lds + 32768);
    LAS3 cc_t* cc = (LAS3 cc_t*)(lds + 32768 + 8192);
    const int tid = opaque_tid();
    __syncthreads();
    const float dt = expf(log_step[idx]);
    if (tid < 64) {
        const int p = tid;
        const float ar = fminf(a_re[idx * 64 + p], -1e-4f), ai = a_im[idx * 64 + p];
        const float mag = expf(dt * ar), er = mag * cosf(dt * ai), ei = mag * sinf(dt * ai);
        const float inv = 1.0f / (ar * ar + ai * ai);
        const float fr = ((er - 1.0f) * ar + ei * ai) * inv, fi = (ei * ar - (er - 1.0f) * ai) * inv;
        Aab[(idx * 64 + p) * 2] = er; Aab[(idx * 64 + p) * 2 + 1] = ei;
        const float m64 = expf(64.0f * dt * ar);
        A64[(idx * 64 + p) * 2] = m64 * cosf(64.0f * dt * ai); A64[(idx * 64 + p) * 2 + 1] = m64 * sinf(64.0f * dt * ai);
        for (int hh = 0; hh < 16; ++hh) {
            const float br = b_re[((size_t)idx * 64 + p) * 16 + hh], bi = b_im[((size_t)idx * 64 + p) * 16 + hh];
            bb[p][hh][0] = fr * br - fi * bi; bb[p][hh][1] = fr * bi + fi * br;
        }
    }
    for (int i = tid; i < 64 * 64; i += 512) {
        const int tau = i >> 6, p = i & 63;
        const float ar = fminf(a_re[idx * 64 + p], -1e-4f), ai = a_im[idx * 64 + p];
        const float mag = expf((float)tau * dt * ar);
        apw[tau][p][0] = mag * cosf((float)tau * dt * ai); apw[tau][p][1] = mag * sinf((float)tau * dt * ai);
    }
    for (int i = tid; i < 16 * 64; i += 512) { const int hh = i >> 6, p = i & 63; cc[hh][p][0] = c_re[(size_t)idx * 1024 + i]; cc[hh][p][1] = c_im[(size_t)idx * 1024 + i]; }
    __syncthreads();
    for (int i = tid; i < 16 * 64; i += 512) { const int hh = i >> 6, p = i & 63;
        CmT[((size_t)idx * 16 + hh) * 128 + 2 * p] = f2bf(cc[hh][p][0]); CmT[((size_t)idx * 16 + hh) * 128 + 2 * p + 1] = f2bf(-cc[hh][p][1]); }
    for (int e = tid; e < 64 * 1024; e += 512) {
        const int p = e >> 10, k = e & 1023, i = k >> 4, hp = k & 15;
        const float pr = apw[63 - i][p][0], pi = apw[63 - i][p][1], br = bb[p][hp][0], bi = bb[p][hp][1];
        Smat[((size_t)idx * 128 + 2 * p) * 1024 + k] = f2bf(pr * br - pi * bi);
        Smat[((size_t)idx * 128 + 2 * p + 1) * 1024 + k] = f2bf(pr * bi + pi * br);
    }
    for (int e = tid; e < 16 * 1024; e += 512) {
        const int hh = e >> 10, k = e & 1023, tau = k >> 4, hp = k & 15;
        float acc = 0.f;
        for (int p = 0; p < 64; ++p) {
            const float pr = apw[tau][p][0], pi = apw[tau][p][1], br = bb[p][hp][0], bi = bb[p][hp][1];
            const float wr = pr * br - pi * bi, wi = pr * bi + pi * br;
            acc += cc[hh][p][0] * wr - cc[hh][p][1] * wi;
        }
        KmT[((size_t)idx * 16 + hh) * 1024 + k] = f2bf(acc);
    }
}


__device__ __forceinline__ void s5_item(LAS3 unsigned char* lds, const bf16_t* __restrict__ p, const bf16_t* __restrict__ KmT, const bf16_t* __restrict__ Smat, const bf16_t* __restrict__ CmT,
                                        const float* __restrict__ Aab, const float* __restrict__ A64, float* __restrict__ xs_g, float* __restrict__ ys5, int b, int g, int dir) {
    const int tid = opaque_tid(), wid = tid >> 6, lane = tid & 63, lr = lane & 15, q = lane >> 4;
    const int tix = dir * 16 + g;
    LAS3 unsigned char* U = lds + S5_OFF_U; LAS3 unsigned char* Km = lds + S5_OFF_KM; LAS3 unsigned char* Cm = lds + S5_OFF_CM; LAS3 unsigned char* EZ = lds + S5_OFF_EZ;
    float* xs = xs_g + (size_t)((b * 16 + g) * 2 + dir) * 36 * 128;
    __syncthreads();
    for (int i = tid; i < 16 * 128; i += 512) { const int hh = i >> 7, ch = i & 127;
        *(LAS3 u32x4_t*)(Km + (hh * S5_KROW + ch * 8) * 2) = *(const u32x4_t*)(KmT + ((size_t)tix * 16 + hh) * 1024 + ch * 8); }
    if (tid < 256) { const int hh = tid >> 4, ch = tid & 15;
        *(LAS3 u32x4_t*)(Cm + (hh * S5_CROW + ch * 8) * 2) = *(const u32x4_t*)(CmT + ((size_t)tix * 16 + hh) * 128 + ch * 8); }
    for (int i = tid; i < NT * 2; i += 512) {
        const int sidx = i >> 1, hf = i & 1;
        const int n = seq_token(sidx, dir);
        *(LAS3 u32x4_t*)(U + ((64 + sidx) * 16 + hf * 8) * 2) = *(const u32x4_t*)(p + ((size_t)b * NT + n) * DIN + P_S5 + g * 16 + hf * 8);
    }
    for (int i = tid; i < 64 * 8; i += 512) *(LAS3 unsigned*)(U + i * 4) = 0u;
    __syncthreads();
    {
        f32x4_t acc[3];
#pragma unroll
        for (int i = 0; i < 3; ++i) acc[i] = (f32x4_t){0.f, 0.f, 0.f, 0.f};
        const bf16_t* sp = Smat + ((size_t)tix * 128 + 16 * wid + lr) * 1024 + 8 * q;
        int cco[3];
#pragma unroll
        for (int ctile = 0; ctile < 3; ++ctile) { int ch = 16 * ctile + lr; if (ch > 35) ch = 35; cco[ctile] = ((64 + 64 * ch + (q >> 1)) * 16 + 8 * (q & 1)) * 2; }
#pragma unroll 8
        for (int ks = 0; ks < 32; ++ks) {
            const bf16x8_t a = *(const bf16x8_t*)(sp + 32 * ks);
#pragma unroll
            for (int ctile = 0; ctile < 3; ++ctile) {
                const bf16x8_t bfr = *(const LAS3 bf16x8_t*)(U + cco[ctile] + ks * 64);
                acc[ctile] = __builtin_amdgcn_mfma_f32_16x16x32_bf16(a, bfr, acc[ctile], 0, 0, 0);
            }
        }
        LAS3 float* E = (LAS3 float*)EZ;
#pragma unroll
        for (int ctile = 0; ctile < 3; ++ctile)
#pragma unroll
            for (int rg = 0; rg < 4; ++rg) E[(16 * ctile + lr) * 128 + 16 * wid + 4 * q + rg] = acc[ctile][rg];
    }
    __syncthreads();
    const float Ar = Aab[(tix * 64 + lane) * 2], Ai = Aab[(tix * 64 + lane) * 2 + 1];
    if (wid == 0) {
        const float Br = A64[(tix * 64 + lane) * 2], Bi = A64[(tix * 64 + lane) * 2 + 1];
        const LAS3 float* E = (const LAS3 float*)EZ;
        float xr = 0.f, xi = 0.f;
        for (int c = 0; c < 36; ++c) {
            *(float2*)(xs + c * 128 + 2 * lane) = make_float2(xr, xi);
            const float er = E[c * 128 + 2 * lane], ei = E[c * 128 + 2 * lane + 1];
            const float nr = Br * xr - Bi * xi + er, ni = Br * xi + Bi * xr + ei;
            xr = nr; xi = ni;
        }
    }
    __threadfence_block();
    __syncthreads();
    LAS3 unsigned char* Zw = EZ + wid * (16 * S5_ZROW * 2);
    bf16x8_t cmf[4];
#pragma unroll
    for (int ks = 0; ks < 4; ++ks) cmf[ks] = *(const LAS3 bf16x8_t*)(Cm + (lr * S5_CROW + 32 * ks + 8 * q) * 2);
    bf16x8_t kbr[16];
#pragma unroll
    for (int ks = 0; ks < 16; ++ks) kbr[ks] = *(const LAS3 bf16x8_t*)(Km + (lr * S5_KROW + 8 * q) * 2 + ks * 64);
    float2 xnext = *(const float2*)(xs + wid * 128 + 2 * lane);
    for (int c = wid; c < 36; c += 8) {
        const float2 x0 = xnext;
        if (c + 8 < 36) xnext = *(const float2*)(xs + (c + 8) * 128 + 2 * lane);
        float zr = Ar * x0.x - Ai * x0.y, zi = Ar * x0.y + Ai * x0.x;
#pragma unroll
        for (int rt = 0; rt < 4; ++rt) {
#pragma unroll
            for (int ii = 0; ii < 16; ++ii) {
                *(LAS3 unsigned*)(Zw + (ii * S5_ZROW + 2 * lane) * 2) = cvtpk(zr, zi);
                const float nr = Ar * zr - Ai * zi, ni = Ar * zi + Ai * zr; zr = nr; zi = ni;
            }
            asm volatile("s_waitcnt lgkmcnt(0)" ::: "memory");
            f32x4_t acc = (f32x4_t){0.f, 0.f, 0.f, 0.f};
#pragma unroll
            for (int ks = 0; ks < 4; ++ks) {
                const bf16x8_t a = *(const LAS3 bf16x8_t*)(Zw + (lr * S5_ZROW + 32 * ks + 8 * q) * 2);
                acc = __builtin_amdgcn_mfma_f32_16x16x32_bf16(a, cmf[ks], acc, 0, 0, 0);
            }
            const int irow = 16 * rt + lr;
            const LAS3 unsigned char* up = U + ((64 + 64 * c + irow - (q >> 1)) * 16 + 8 * (q & 1)) * 2;
            const LAS3 unsigned char* kp = Km + (lr * S5_KROW + 8 * q) * 2;
            f32x4_t acc1 = (f32x4_t){0.f, 0.f, 0.f, 0.f};
#pragma unroll
            for (int ks0 = 0; ks0 < 8 * rt + 8; ks0 += 8) {
                bf16x8_t av[8], kv[8];
#pragma unroll
                for (int j = 0; j < 8; ++j) { av[j] = *(const LAS3 bf16x8_t*)(up - (ks0 + j) * 64); if (ks0 + j < 16) kv[j] = kbr[ks0 + j]; else kv[j] = *(const LAS3 bf16x8_t*)(kp + (ks0 + j) * 64); }
#pragma unroll
                for (int j = 0; j < 8; ++j) {
                    const int ks = ks0 + j;
                    if (ks >= 8 * rt) {
                        const bool valid = (2 * ks + (q >> 1)) <= irow;
                        if (!valid) av[j] = (bf16x8_t){0, 0, 0, 0, 0, 0, 0, 0};
                    }
                    if (j & 1) acc1 = __builtin_amdgcn_mfma_f32_16x16x32_bf16(av[j], kv[j], acc1, 0, 0, 0);
                    else acc = __builtin_amdgcn_mfma_f32_16x16x32_bf16(av[j], kv[j], acc, 0, 0, 0);
                }
            }
            acc += acc1;
#pragma unroll
            for (int rg = 0; rg < 4; ++rg) {
                const int n = seq_token(64 * c + 16 * rt + 4 * q + rg, dir);
                ((bf16_t*)ys5)[((size_t)dir * TT + (size_t)b * NT + n) * 256 + g * 16 + lr] = f2bf(acc[rg]);
            }
            asm volatile("s_waitcnt lgkmcnt(0)" ::: "memory");
        }
    }
}

#define XB_TMO      128
#define XB_XCNT(j)  (256  + 64 * (j))
#define XB_XSUB(j)  (1280 + 64 * (j))
#define XB_XGEN(j)  (2304 + 64 * (j))
#define XB_TOP      3328
#define XB_TOPGEN   3392
#define XCD_BAR_WORDS 3456
#define XB_SPIN_CAP (1u << 22)
__device__ __forceinline__ unsigned xb_ld(unsigned* p)              { return __hip_atomic_load(p, __ATOMIC_RELAXED, __HIP_MEMORY_SCOPE_AGENT); }
__device__ __forceinline__ unsigned xb_add(unsigned* p, unsigned v) { return __hip_atomic_fetch_add(p, v, __ATOMIC_RELAXED, __HIP_MEMORY_SCOPE_AGENT); }
__device__ __forceinline__ unsigned xb_xcc_id() { return (unsigned)__builtin_amdgcn_s_getreg((3 << 11) | 20) & 0xFu; }
#define XB_SPIN(cond, bar) do { unsigned _sp = 0; while (cond) { __builtin_amdgcn_s_sleep(1); \
    if ((++_sp & 255u) == 0u) { if (xb_ld(&(bar)[XB_TMO])) break; if (_sp > XB_SPIN_CAP) { atomicAdd(&(bar)[XB_TMO], 1u); break; } } } } while (0)
struct XcdBarrier { unsigned* bar; unsigned x; volatile LAS3 unsigned* st; };
__device__ __forceinline__ XcdBarrier xcd_barrier_post(unsigned* bar, volatile LAS3 unsigned* st) {
    XcdBarrier b; b.bar = bar; b.x = xb_xcc_id(); b.st = st;
    if (threadIdx.x == 0) (void)xb_add(&bar[XB_XCNT(b.x)], 1u);
    return b;
}
__device__ __forceinline__ void xcd_barrier_complete(unsigned* bar, unsigned x, unsigned& nloc, unsigned& nx) {
    const unsigned G = gridDim.x * gridDim.y * gridDim.z;
    unsigned sum, cnt, mine, sp = 0u;
    for (;;) {
        sum = 0u; cnt = 0u; mine = 0u;
#pragma unroll
        for (unsigned j = 0; j < 16; ++j) { const unsigned c = xb_ld(&bar[XB_XCNT(j)]); sum += c; cnt += (c > 0u) ? 1u : 0u; mine = (j == x) ? c : mine; }
        if (sum == G) break;
        __builtin_amdgcn_s_sleep(1);
        if ((++sp & 255u) == 0u) { if (xb_ld(&bar[XB_TMO])) break; if (sp > XB_SPIN_CAP) { atomicAdd(&bar[XB_TMO], 1u); break; } }
    }
    nloc = mine > 0u ? mine : 1u; nx = cnt > 0u ? cnt : 1u;
}
__device__ __forceinline__ void xcd_barrier(const XcdBarrier& b) {
    asm volatile("s_waitcnt vmcnt(0)" ::: "memory");
    __syncthreads();
    if (threadIdx.x == 0) {
        unsigned* bar = b.bar;
        __builtin_amdgcn_s_waitcnt(0);
        unsigned nloc = b.st[0], nx = b.st[1];
        if (nloc == 0u) { xcd_barrier_complete(bar, b.x, nloc, nx); b.st[0] = nloc; b.st[1] = nx; }
        const unsigned old = xb_add(&bar[XB_XSUB(b.x)], 1u);
        const unsigned gen = old / nloc;
        if (old + 1u == (gen + 1u) * nloc) {
            __builtin_amdgcn_fence(__ATOMIC_RELEASE, "agent");
            asm volatile("s_waitcnt vmcnt(0)" ::: "memory");
            const unsigned og = xb_add(&bar[XB_TOP], 1u);
            const unsigned tg = og / nx;
            if (og + 1u == (tg + 1u) * nx) xb_add(&bar[XB_TOPGEN], 1u);
            else XB_SPIN(xb_ld(&bar[XB_TOPGEN]) == tg, bar);
            __builtin_amdgcn_fence(__ATOMIC_ACQUIRE, "agent");
            xb_add(&bar[XB_XGEN(b.x)], 1u);
            asm volatile("s_waitcnt vmcnt(0)" ::: "memory");
        } else {
            XB_SPIN(xb_ld(&bar[XB_XGEN(b.x)]) == gen, bar);
            __builtin_amdgcn_fence(__ATOMIC_ACQUIRE, "agent");
            asm volatile("s_waitcnt vmcnt(0)" ::: "memory");
        }
    }
    __syncthreads();
}

struct Params {
    const float *x, *c, *ctx, *c_ctx, *w_mod, *b_mod, *norm_w, *w_in, *w_out, *da_lambda, *da_subln, *ml_conv_w, *ml_conv_b, *ml_gate_b, *ml_norm,
                *mla_q_norm, *mla_w_uq, *mla_kv_norm, *mla_w_ukv, *s5_a_re, *s5_a_im, *s5_log_step, *s5_b_re, *s5_b_im, *s5_c_re, *s5_c_im, *s5_d, *s5_w_glu, *s5_b_glu,
                *moe_w_router, *moe_b_router, *moe_w_gate_up, *moe_b_gate_up, *moe_w_down, *moe_b_down;
    float* out;
    float *xall, *mod, *ropecs, *lamfull;
    bf16_t *w_in_t, *w_out_t, *wgu_t, *wdn_t, *wq_t, *wkv_t, *wglu_t;
    bf16_t *s5KmT, *s5Smat, *s5CmT; float *s5A, *s5A64, *s5xs;
    bf16_t *hbuf, *pb, *daQ, *daK, *daVt, *mQ, *mK, *mVt, *mlQ, *mlK, *mlKt, *mlVt; float *mlG, *hdir, *ys5;
    bf16_t *ycatb, *ob; float* osq; bf16_t* fb;
    int* top_e; float* top_g; int *posb, *tok_slot;
    int *cnt, *tile_e, *ntiles, *offs, *blkcnt;
    bf16_t *xg, *act, *yexp;
    unsigned* bar; int* queue;
};

template <class T> __device__ __forceinline__ T* uni_ptr(T* p) { const unsigned long long v = (unsigned long long)p; const unsigned lo = __builtin_amdgcn_readfirstlane((unsigned)v), hi = __builtin_amdgcn_readfirstlane((unsigned)(v >> 32)); return (T*)(__attribute__((address_space(1))) T*)(((unsigned long long)hi << 32) | lo); }
__device__ __forceinline__ void store_params(LAS3 Params* PL, const Params& P) {
    PL->x = P.x;
    PL->c = P.c;
    PL->ctx = P.ctx;
    PL->c_ctx = P.c_ctx;
    PL->w_mod = P.w_mod;
    PL->b_mod = P.b_mod;
    PL->norm_w = P.norm_w;
    PL->w_in = P.w_in;
    PL->w_out = P.w_out;
    PL->da_lambda = P.da_lambda;
    PL->da_subln = P.da_subln;
    PL->ml_conv_w = P.ml_conv_w;
    PL->ml_conv_b = P.ml_conv_b;
    PL->ml_gate_b = P.ml_gate_b;
    PL->ml_norm = P.ml_norm;
    PL->mla_q_norm = P.mla_q_norm;
    PL->mla_w_uq = P.mla_w_uq;
    PL->mla_kv_norm = P.mla_kv_norm;
    PL->mla_w_ukv = P.mla_w_ukv;
    PL->s5_a_re = P.s5_a_re;
    PL->s5_a_im = P.s5_a_im;
    PL->s5_log_step = P.s5_log_step;
    PL->s5_b_re = P.s5_b_re;
    PL->s5_b_im = P.s5_b_im;
    PL->s5_c_re = P.s5_c_re;
    PL->s5_c_im = P.s5_c_im;
    PL->s5_d = P.s5_d;
    PL->s5_w_glu = P.s5_w_glu;
    PL->s5_b_glu = P.s5_b_glu;
    PL->moe_w_router = P.moe_w_router;
    PL->moe_b_router = P.moe_b_router;
    PL->moe_w_gate_up = P.moe_w_gate_up;
    PL->moe_b_gate_up = P.moe_b_gate_up;
    PL->moe_w_down = P.moe_w_down;
    PL->moe_b_down = P.moe_b_down;
    PL->out = P.out;
    PL->xall = P.xall;
    PL->mod = P.mod;
    PL->ropecs = P.ropecs;
    PL->lamfull = P.lamfull;
    PL->w_in_t = P.w_in_t;
    PL->w_out_t = P.w_out_t;
    PL->wgu_t = P.wgu_t;
    PL->wdn_t = P.wdn_t;
    PL->wq_t = P.wq_t;
    PL->wkv_t = P.wkv_t;
    PL->wglu_t = P.wglu_t;
    PL->s5KmT = P.s5KmT;
    PL->s5Smat = P.s5Smat;
    PL->s5CmT = P.s5CmT;
    PL->s5A = P.s5A;
    PL->s5A64 = P.s5A64;
    PL->s5xs = P.s5xs;
    PL->hbuf = P.hbuf;
    PL->pb = P.pb;
    PL->daQ = P.daQ;
    PL->daK = P.daK;
    PL->daVt = P.daVt;
    PL->mQ = P.mQ;
    PL->mK = P.mK;
    PL->mVt = P.mVt;
    PL->mlQ = P.mlQ;
    PL->mlK = P.mlK;
    PL->mlKt = P.mlKt;
    PL->mlVt = P.mlVt;
    PL->mlG = P.mlG;
    PL->hdir = P.hdir;
    PL->ys5 = P.ys5;
    PL->ycatb = P.ycatb;
    PL->ob = P.ob;
    PL->osq = P.osq;
    PL->fb = P.fb;
    PL->top_e = P.top_e;
    PL->top_g = P.top_g;
    PL->posb = P.posb;
    PL->tok_slot = P.tok_slot;
    PL->cnt = P.cnt;
    PL->tile_e = P.tile_e;
    PL->ntiles = P.ntiles;
    PL->offs = P.offs;
    PL->blkcnt = P.blkcnt;
    PL->xg = P.xg;
    PL->act = P.act;
    PL->yexp = P.yexp;
    PL->bar = P.bar;
    PL->queue = P.queue;
}
__device__ __forceinline__ Params load_params(const LAS3 Params* PL) {
    Params Q;
    Q.x = uni_ptr(PL->x);
    Q.c = uni_ptr(PL->c);
    Q.ctx = uni_ptr(PL->ctx);
    Q.c_ctx = uni_ptr(PL->c_ctx);
    Q.w_mod = uni_ptr(PL->w_mod);
    Q.b_mod = uni_ptr(PL->b_mod);
    Q.norm_w = uni_ptr(PL->norm_w);
    Q.w_in = uni_ptr(PL->w_in);
    Q.w_out = uni_ptr(PL->w_out);
    Q.da_lambda = uni_ptr(PL->da_lambda);
    Q.da_subln = uni_ptr(PL->da_subln);
    Q.ml_conv_w = uni_ptr(PL->ml_conv_w);
    Q.ml_conv_b = uni_ptr(PL->ml_conv_b);
    Q.ml_gate_b = uni_ptr(PL->ml_gate_b);
    Q.ml_norm = uni_ptr(PL->ml_norm);
    Q.mla_q_norm = uni_ptr(PL->mla_q_norm);
    Q.mla_w_uq = uni_ptr(PL->mla_w_uq);
    Q.mla_kv_norm = uni_ptr(PL->mla_kv_norm);
    Q.mla_w_ukv = uni_ptr(PL->mla_w_ukv);
    Q.s5_a_re = uni_ptr(PL->s5_a_re);
    Q.s5_a_im = uni_ptr(PL->s5_a_im);
    Q.s5_log_step = uni_ptr(PL->s5_log_step);
    Q.s5_b_re = uni_ptr(PL->s5_b_re);
    Q.s5_b_im = uni_ptr(PL->s5_b_im);
    Q.s5_c_re = uni_ptr(PL->s5_c_re);
    Q.s5_c_im = uni_ptr(PL->s5_c_im);
    Q.s5_d = uni_ptr(PL->s5_d);
    Q.s5_w_glu = uni_ptr(PL->s5_w_glu);
    Q.s5_b_glu = uni_ptr(PL->s5_b_glu);
    Q.moe_w_router = uni_ptr(PL->moe_w_router);
    Q.moe_b_router = uni_ptr(PL->moe_b_router);
    Q.moe_w_gate_up = uni_ptr(PL->moe_w_gate_up);
    Q.moe_b_gate_up = uni_ptr(PL->moe_b_gate_up);
    Q.moe_w_down = uni_ptr(PL->moe_w_down);
    Q.moe_b_down = uni_ptr(PL->moe_b_down);
    Q.out = uni_ptr(PL->out);
    Q.xall = uni_ptr(PL->xall);
    Q.mod = uni_ptr(PL->mod);
    Q.ropecs = uni_ptr(PL->ropecs);
    Q.lamfull = uni_ptr(PL->lamfull);
    Q.w_in_t = uni_ptr(PL->w_in_t);
    Q.w_out_t = uni_ptr(PL->w_out_t);
    Q.wgu_t = uni_ptr(PL->wgu_t);
    Q.wdn_t = uni_ptr(PL->wdn_t);
    Q.wq_t = uni_ptr(PL->wq_t);
    Q.wkv_t = uni_ptr(PL->wkv_t);
    Q.wglu_t = uni_ptr(PL->wglu_t);
    Q.s5KmT = uni_ptr(PL->s5KmT);
    Q.s5Smat = uni_ptr(PL->s5Smat);
    Q.s5CmT = uni_ptr(PL->s5CmT);
    Q.s5A = uni_ptr(PL->s5A);
    Q.s5A64 = uni_ptr(PL->s5A64);
    Q.s5xs = uni_ptr(PL->s5xs);
    Q.hbuf = uni_ptr(PL->hbuf);
    Q.pb = uni_ptr(PL->pb);
    Q.daQ = uni_ptr(PL->daQ);
    Q.daK = uni_ptr(PL->daK);
    Q.daVt = uni_ptr(PL->daVt);
    Q.mQ = uni_ptr(PL->mQ);
    Q.mK = uni_ptr(PL->mK);
    Q.mVt = uni_ptr(PL->mVt);
    Q.mlQ = uni_ptr(PL->mlQ);
    Q.mlK = uni_ptr(PL->mlK);
    Q.mlKt = uni_ptr(PL->mlKt);
    Q.mlVt = uni_ptr(PL->mlVt);
    Q.mlG = uni_ptr(PL->mlG);
    Q.hdir = uni_ptr(PL->hdir);
    Q.ys5 = uni_ptr(PL->ys5);
    Q.ycatb = uni_ptr(PL->ycatb);
    Q.ob = uni_ptr(PL->ob);
    Q.osq = uni_ptr(PL->osq);
    Q.fb = uni_ptr(PL->fb);
    Q.top_e = uni_ptr(PL->top_e);
    Q.top_g = uni_ptr(PL->top_g);
    Q.posb = uni_ptr(PL->posb);
    Q.tok_slot = uni_ptr(PL->tok_slot);
    Q.cnt = uni_ptr(PL->cnt);
    Q.tile_e = uni_ptr(PL->tile_e);
    Q.ntiles = uni_ptr(PL->ntiles);
    Q.offs = uni_ptr(PL->offs);
    Q.blkcnt = uni_ptr(PL->blkcnt);
    Q.xg = uni_ptr(PL->xg);
    Q.act = uni_ptr(PL->act);
    Q.yexp = uni_ptr(PL->yexp);
    Q.bar = uni_ptr(PL->bar);
    Q.queue = uni_ptr(PL->queue);
    return Q;
}
constexpr int MK_LDS_MAIN = 147968;
constexpr int MK_LDS_BYTES = MK_LDS_MAIN + 64 + 1024;
enum { PH_SETUP = 0, PH_H0 = 1, PH_LAYER0 = 2, PH_PER_LAYER = 10, PH_TOTAL = 22 };
enum { L_GEMM_IN = 0, L_PREP, L_MIX, L_FINISH, L_GEMM_OUT, L_POST, L_SCATTER, L_GEMM_GU, L_GEMM_DN, L_COMBINE };

__device__ __forceinline__ void conv_tile(LAS3 float* tile, int lane, const float* __restrict__ W, int N, bf16_t* __restrict__ WT, int ldt, int tn, int tk, int mode) {
    const int n0 = tn * 64, k0 = tk * 64;
    const int kq = lane >> 4, n4 = (lane & 15) * 4;
    const int nl = (n0 + n4 < N) ? n0 + n4 : N - 4;
    const float* wp = W + (size_t)(k0 + kq) * N + nl;
    float4 v[16];
#pragma unroll
    for (int j = 0; j < 16; ++j) v[j] = *(const float4*)(wp + (size_t)(4 * j) * N);
#pragma unroll
    for (int j = 0; j < 16; ++j) { LAS3 float* tp = tile + (4 * j + kq) * 65 + n4; tp[0] = v[j].x; tp[1] = v[j].y; tp[2] = v[j].z; tp[3] = v[j].w; }
    asm volatile("s_waitcnt lgkmcnt(0)" ::: "memory");
    {
        const int c = lane & 7;
#pragma unroll
        for (int jn = 0; jn < 8; ++jn) {
            const int n = (lane >> 3) + 8 * jn, gn = n0 + n;
            if (gn < N) {
                int dr = gn;
                if (mode == 1) dr = (gn < 1024) ? ((gn >> 7) * 256 + (gn & 127)) : ((((gn - 1024) >> 7) * 256) + 128 + ((gn - 1024) & 127));
                const LAS3 float* tp = tile + (8 * c) * 65 + n;
                u32x4_t o;
                o.x = pk2bf(tp[0 * 65], tp[1 * 65]); o.y = pk2bf(tp[2 * 65], tp[3 * 65]); o.z = pk2bf(tp[4 * 65], tp[5 * 65]); o.w = pk2bf(tp[6 * 65], tp[7 * 65]);
                *(u32x4_t*)(WT + (size_t)dr * ldt + k0 + 8 * c) = o;
            }
        }
    }
    asm volatile("s_waitcnt lgkmcnt(0)" ::: "memory");
}
constexpr int CV_IN = 38 * 16 * 2, CV_OUT = 256 * 2, CV_GU = 512 * 64, CV_DN = 256 * 64, CV_Q = 18 * 2, CV_KV = 16 * 2, CV_GLU = 16 * 2;
constexpr int CV_TOTAL = CV_IN + CV_OUT + CV_GU + CV_DN + CV_Q + CV_KV + CV_GLU;
__device__ __forceinline__ void conv_dispatch(const Params& P, LAS3 float* tile, int st, int it) {
    const float* W = nullptr; bf16_t* WT = nullptr; int N = 64, ldt = 64, tn = 0, tk = 0, mode = 0;
    if (it < CV_TOTAL) {
        int r = it;
        if (r < CV_IN) { const int bt = r / 608, q = r % 608; W = P.w_in + (size_t)bt * 1024 * DINC; N = DINC; WT = P.w_in_t + (size_t)bt * 2560 * 1024; ldt = 1024; tn = q % 38; tk = q / 38; }
        else if ((r -= CV_IN) < CV_OUT) { const int bt = r / 256, q = r % 256; W = P.w_out + (size_t)bt * 1024 * 1024; N = 1024; WT = P.w_out_t + (size_t)bt * 1024 * 1024; ldt = 1024; tn = q % 16; tk = q / 16; }
        else if ((r -= CV_OUT) < CV_GU) { const int bt = r / 512, q = r % 512; W = P.moe_w_gate_up + (size_t)bt * 1024 * 2048; N = 2048; WT = P.wgu_t + (size_t)bt * 2048 * 1024; ldt = 1024; tn = q % 32; tk = q / 32; mode = 1; }
        else if ((r -= CV_GU) < CV_DN) { const int bt = r / 256, q = r % 256; W = P.moe_w_down + (size_t)bt * 1024 * 1024; N = 1024; WT = P.wdn_t + (size_t)bt * 1024 * 1024; ldt = 1024; tn = q % 16; tk = q / 16; }
        else if ((r -= CV_DN) < CV_Q) { const int bt = r / 18, q = r % 18; W = P.mla_w_uq + (size_t)bt * 192 * 384; N = 384; WT = P.wq_t + (size_t)bt * 384 * 192; ldt = 192; tn = q % 6; tk = q / 6; }
        else if ((r -= CV_Q) < CV_KV) { const int bt = r / 16, q = r % 16; W = P.mla_w_ukv + (size_t)bt * 128 * 512; N = 512; WT = P.wkv_t + (size_t)bt * 512 * 128; ldt = 128; tn = q % 8; tk = q / 8; }
        else { r -= CV_KV; const int bt = r / 16, q = r % 16; W = P.s5_w_glu + (size_t)bt * 256 * 256; N = 256; WT = P.wglu_t + (size_t)bt * 256 * 256; ldt = 256; tn = q % 4; tk = q / 4; }
    }
    if (W) conv_tile(tile, st, W, N, WT, ldt, tn, tk, mode);
}
__device__ __forceinline__ void phase_setup(const Params& P, LAS3 unsigned char* lds) {
    const int tid = opaque_tid(), G = gridDim.x, bid = blockIdx.x;
    for (int it = bid; it < 192; it += G) {
        LAS3 float* sl = (LAS3 float*)lds;
        LAS3 float* red = sl + 9 * 1024;
        __syncthreads();
        for (int i = tid; i < 9 * 1024; i += 512) { const int r = i >> 10, k = i & 1023; sl[i] = siluf_((r < 8) ? P.c[r * 1024 + k] : P.c_ctx[k]); }
        __syncthreads();
        const int l = it / 96, j = (it % 96) * 64 + (tid & 63), kp = tid >> 6;
        const float* w = P.w_mod + (size_t)l * 1024 * 6144 + j;
        float acc[9];
#pragma unroll
        for (int r = 0; r < 9; ++r) acc[r] = 0.f;
#pragma unroll 8
        for (int k = kp * 128; k < kp * 128 + 128; ++k) {
            const float wv = w[(size_t)k * 6144];
#pragma unroll
            for (int r = 0; r < 9; ++r) acc[r] += sl[r * 1024 + k] * wv;
        }
#pragma unroll
        for (int r = 0; r < 9; ++r) red[(kp * 9 + r) * 64 + (tid & 63)] = acc[r];
        __syncthreads();
        for (int i = tid; i < 9 * 64; i += 512) {
            const int r = i >> 6, cc = i & 63; float sacc = 0.f;
#pragma unroll
            for (int k2 = 0; k2 < 8; ++k2) sacc += red[(k2 * 9 + r) * 64 + cc];
            const int jj = (it % 96) * 64 + cc;
            P.mod[((size_t)l * 9 + r) * 6144 + jj] = sacc + P.b_mod[l * 6144 + jj];
        }
    }
    for (int i = bid * 512 + tid; i < NS * 16; i += G * 512) {
        const int pos = i >> 4, j = i & 15; const int row = pos / 64, col = pos % 64;
        const float inv = exp2f(-(float)(j & 7) * 1.6609640474436813f), ang = (float)((j < 8) ? row : col) * inv;
        P.ropecs[i * 2] = cosf(ang); P.ropecs[i * 2 + 1] = sinf(ang);
    }
    if (bid == G - 1 && tid < 2) {
        const int l = tid; const float* lam = P.da_lambda + l * 128; float s1 = 0.f, s2 = 0.f;
        for (int i = 0; i < 32; ++i) { s1 += lam[i] * lam[32 + i]; s2 += lam[64 + i] * lam[96 + i]; }
        P.lamfull[l] = expf(s1) - expf(s2) + ((l == 0) ? 0.2f : 0.35550906759096927f);
    }
    for (int it = G - 1 - bid; it < 64; it += G)
        s5_setup_item(lds, it, P.s5_a_re, P.s5_a_im, P.s5_log_step, P.s5_b_re, P.s5_b_im, P.s5_c_re, P.s5_c_im, P.s5KmT, P.s5Smat, P.s5CmT, P.s5A, P.s5A64);
    for (int i = bid * 512 + tid; i < 2 * 144 * 1024 / 8; i += G * 512) {
        const int l = i / (144 * 128), r = i % (144 * 128);
        *(u32x4_t*)(P.w_in_t + ((size_t)l * 2560 + DINC) * 1024 + (size_t)r * 8) = (u32x4_t){0u, 0u, 0u, 0u};
    }
    __syncthreads();
    {
        const int wv = __builtin_amdgcn_readfirstlane(tid >> 6), lane = tid & 63;
        LAS3 float* tile = (LAS3 float*)lds + wv * (64 * 65);
        for (;;) {
            int base = 0;
            if (lane == 0) base = atomicAdd(P.queue + 2, 4);
            base = __builtin_amdgcn_readfirstlane(base);
            if (base >= CV_TOTAL) break;
            for (int it = base; it < base + 4 && it < CV_TOTAL; ++it) conv_dispatch(P, tile, lane, it);
        }
    }
}

__device__ __forceinline__ void row_modulate_store(const float (&xv)[16], const LAS3 float* nw, const LAS3 float* modr, bf16_t* __restrict__ dst, int lane) {
    float ss = 0.f;
#pragma unroll
    for (int i = 0; i < 16; ++i) ss += xv[i] * xv[i];
    ss = wave_sum(ss);
    const float rstd = rsqrtf(ss * (1.f / DM) + 1e-6f);
#pragma unroll
    for (int j = 0; j < 4; ++j) {
        const int d = j * 256 + lane * 4;
        const f32x4_t w = *(const LAS3 f32x4_t*)(nw + d), sh = *(const LAS3 f32x4_t*)(modr + d), sc = *(const LAS3 f32x4_t*)(modr + 1024 + d);
        const float o0 = xv[j * 4 + 0] * rstd * w[0] * (1.f + sc[0]) + sh[0], o1 = xv[j * 4 + 1] * rstd * w[1] * (1.f + sc[1]) + sh[1];
        const float o2 = xv[j * 4 + 2] * rstd * w[2] * (1.f + sc[2]) + sh[2], o3 = xv[j * 4 + 3] * rstd * w[3] * (1.f + sc[3]) + sh[3];
        *(uint2*)(dst + d) = make_uint2(cvtpk(o0, o1), cvtpk(o2, o3));
    }
}
__device__ __forceinline__ void phase_h0(const Params& P, LAS3 unsigned char* lds) {
    const int tid = opaque_tid(); const int lane = tid & 63, gw = blockIdx.x * 8 + (tid >> 6), NW = gridDim.x * 8;
    LAS3 float* cw = (LAS3 float*)lds;
    for (int i = tid; i < 256; i += 512) *(LAS3 f32x4_t*)(cw + i * 4) = *(const f32x4_t*)(P.norm_w + i * 4);
    for (int i = tid; i < 9 * 512; i += 512) { const int r = i >> 9, k = i & 511; *(LAS3 f32x4_t*)(cw + 1024 + r * 2048 + k * 4) = *(const f32x4_t*)(P.mod + (size_t)r * 6144 + k * 4); }
    __syncthreads();
    for (int t = gw; t < TT; t += NW) {
        const int b = t / NT, n = t % NT;
        const float* src = (n < NC) ? P.ctx + ((size_t)b * NC + n) * DM : P.x + ((size_t)b * NS + (n - NC)) * DM;
        float xv[16];
#pragma unroll
        for (int j = 0; j < 4; ++j) { const float4 v = *(const float4*)(src + j * 256 + lane * 4); xv[j * 4] = v.x; xv[j * 4 + 1] = v.y; xv[j * 4 + 2] = v.z; xv[j * 4 + 3] = v.w; }
        row_modulate_store(xv, cw, cw + 1024 + ((n < NC) ? 8 : b) * 2048, P.hbuf + (size_t)t * DM, lane);
    }
}

constexpr int TS_ROW = 264;
__device__ __forceinline__ void write_transposed(const LAS3 bf16_t* ts, bf16_t* __restrict__ dst, int b, int n0, int tid) {
    const int ch = tid & 255, hf = tid >> 8;
    bf16_t* vp = dst + (((size_t)b * 4 + (ch >> 6)) * 64 + (ch & 63)) * NT + n0 + hf * 32;
#pragma unroll
    for (int tc = 0; tc < 4; ++tc) {
        const LAS3 bf16_t* tp = ts + (hf * 32 + tc * 8) * TS_ROW + ch;
        u32x4_t o;
        o.x = (unsigned)tp[0] | ((unsigned)tp[TS_ROW] << 16); o.y = (unsigned)tp[2 * TS_ROW] | ((unsigned)tp[3 * TS_ROW] << 16);
        o.z = (unsigned)tp[4 * TS_ROW] | ((unsigned)tp[5 * TS_ROW] << 16); o.w = (unsigned)tp[6 * TS_ROW] | ((unsigned)tp[7 * TS_ROW] << 16);
        *(u32x4_t*)(vp + tc * 8) = o;
    }
}
__device__ __forceinline__ void unpack8(const u32x4_t v, float (&f)[8]) {
    f[0] = __uint_as_float(v.x << 16); f[1] = __uint_as_float(v.x & 0xFFFF0000u); f[2] = __uint_as_float(v.y << 16); f[3] = __uint_as_float(v.y & 0xFFFF0000u);
    f[4] = __uint_as_float(v.z << 16); f[5] = __uint_as_float(v.z & 0xFFFF0000u); f[6] = __uint_as_float(v.w << 16); f[7] = __uint_as_float(v.w & 0xFFFF0000u);
}
__device__ __forceinline__ u32x4_t pack8(const float (&f)[8]) { return (u32x4_t){cvtpk(f[0], f[1]), cvtpk(f[2], f[3]), cvtpk(f[4], f[5]), cvtpk(f[6], f[7])}; }

__device__ __forceinline__ void prep_da(const Params& P, LAS3 unsigned char* lds, int tile) {
    const int tid = opaque_tid();
    const int t0 = tile * 64, b = t0 / NT, n0 = t0 % NT;
    LAS3 bf16_t* vs = (LAS3 bf16_t*)lds;
    const float qscale = 0.17677669529663687f * 1.4426950408889634f;
    const bf16_t* __restrict__ pbr = P.pb; const float* __restrict__ rcs = P.ropecs;
    __syncthreads();
    {
        u32x4_t vv[4];
#pragma unroll
        for (int u = 0; u < 4; ++u) { const int id = tid + 512 * u, i = id >> 5, cg = id & 31; vv[u] = *(const u32x4_t*)(pbr + (size_t)(t0 + i) * DIN + P_DAV + cg * 8); }
#pragma unroll
        for (int u = 0; u < 4; ++u) { const int id = tid + 512 * u, i = id >> 5, cg = id & 31; *(LAS3 u32x4_t*)(vs + i * TS_ROW + cg * 8) = vv[u]; }
    }
#pragma unroll
    for (int u0 = 0; u0 < 4; u0 += 2) {
        u32x4_t lo[2], hi[2]; float4 cs[2][4];
#pragma unroll
        for (int u = 0; u < 2; ++u) {
            const int id = tid + 512 * (u0 + u), i = id >> 5, pu = id & 31, isk = pu >> 4, blk = (pu >> 1) & 7, pr = pu & 1;
            const bf16_t* src = pbr + (size_t)(t0 + i) * DIN + (isk ? P_DAK : P_DAQ) + blk * 32 + pr * 8;
            lo[u] = *(const u32x4_t*)src; hi[u] = *(const u32x4_t*)(src + 16);
            const int pos = max(n0 + i - NC, 0);
            const float4* cp = (const float4*)(rcs + (pos * 16 + pr * 8) * 2);
            cs[u][0] = cp[0]; cs[u][1] = cp[1]; cs[u][2] = cp[2]; cs[u][3] = cp[3];
        }
#pragma unroll
        for (int u = 0; u < 2; ++u) {
            const int id = tid + 512 * (u0 + u), i = id >> 5, pu = id & 31, isk = pu >> 4, blk = (pu >> 1) & 7, pr = pu & 1;
            const int n = n0 + i; const bool lat = n >= NC;
            float fl[8], fh[8], ol[8], oh[8];
            unpack8(lo[u], fl); unpack8(hi[u], fh);
            const float cc[8] = {cs[u][0].x, cs[u][0].z, cs[u][1].x, cs[u][1].z, cs[u][2].x, cs[u][2].z, cs[u][3].x, cs[u][3].z};
            const float sn[8] = {cs[u][0].y, cs[u][0].w, cs[u][1].y, cs[u][1].w, cs[u][2].y, cs[u][2].w, cs[u][3].y, cs[u][3].w};
            const float sc = isk ? 1.f : qscale;
#pragma unroll
            for (int e = 0; e < 8; ++e) {
                const float c1 = lat ? cc[e] : 1.f, s1 = lat ? sn[e] : 0.f;
                ol[e] = (fl[e] * c1 - fh[e] * s1) * sc; oh[e] = (fh[e] * c1 + fl[e] * s1) * sc;
            }
            bf16_t* dst = (isk ? P.daK : P.daQ) + (((size_t)b * 4 + (blk >> 1)) * NT + n) * 64 + (blk & 1) * 32 + pr * 8;
            *(u32x4_t*)dst = pack8(ol); *(u32x4_t*)(dst + 16) = pack8(oh);
        }
    }
    __syncthreads();
    write_transposed(vs, P.daVt, b, n0, tid);
}
__device__ __forceinline__ void prep_ml(const Params& P, LAS3 unsigned char* lds, int tile, int l) {
    const int tid = opaque_tid();
    const int t0 = tile * 64, b = t0 / NT, n0 = t0 % NT;
    LAS3 bf16_t* ks = (LAS3 bf16_t*)lds; LAS3 bf16_t* vs = ks + 64 * TS_ROW; LAS3 float* cwl = (LAS3 float*)(vs + 64 * TS_ROW);
    const int seg_lo = (n0 < NC) ? 0 : NC, seg_hi = (n0 < NC) ? NC - 1 : NT - 1;
    const bf16_t* __restrict__ pbr = P.pb;
    __syncthreads();
    for (int i = tid; i < 2048; i += 512) cwl[i] = (i < 1536) ? P.ml_conv_w[l * 1536 + i] : P.ml_conv_b[l * 512 + (i - 1536)];
    {
        u32x4_t vv[4];
#pragma unroll
        for (int u = 0; u < 4; ++u) { const int id = tid + 512 * u, i = id >> 5, cg = id & 31; vv[u] = *(const u32x4_t*)(pbr + (size_t)(t0 + i) * DIN + P_MLV + cg * 8); }
#pragma unroll
        for (int u = 0; u < 4; ++u) { const int id = tid + 512 * u, i = id >> 5, cg = id & 31; *(LAS3 u32x4_t*)(vs + i * TS_ROW + cg * 8) = vv[u]; }
        if (tid < 128) {
            const int i = tid >> 1, hf = tid & 1; float g[8];
            unpack8(*(const u32x4_t*)(pbr + (size_t)(t0 + i) * DIN + P_MLG + hf * 8), g);
#pragma unroll
            for (int e = 0; e < 8; ++e) { const int c = hf * 8 + e; g[e] += P.ml_gate_b[l * 16 + c]; if ((c >> 2) & 1) g[e] = logsigmoidf_(g[e]); }
            float* gp = P.mlG + ((size_t)t0 + i) * 16 + hf * 8;
            *(float4*)gp = make_float4(g[0], g[1], g[2], g[3]); *(float4*)(gp + 4) = make_float4(g[4], g[5], g[6], g[7]);
        }
    }
    __syncthreads();
#pragma unroll 1
    for (int u0 = 0; u0 < 8; u0 += 2) {
        u32x4_t xm[2], x0[2], xp[2];
#pragma unroll
        for (int u = 0; u < 2; ++u) {
            const int id = tid + 512 * (u0 + u), i = id >> 6, cg = id & 63, n = n0 + i;
            const int nm = max(n - 1, seg_lo), np = min(n + 1, seg_hi);
            const bf16_t* base = pbr + (size_t)b * NT * DIN + P_MLQK + cg * 8;
            xm[u] = *(const u32x4_t*)(base + (size_t)nm * DIN); x0[u] = *(const u32x4_t*)(base + (size_t)n * DIN); xp[u] = *(const u32x4_t*)(base + (size_t)np * DIN);
        }
#pragma unroll
        for (int u = 0; u < 2; ++u) {
            const int id = tid + 512 * (u0 + u), i = id >> 6, cg = id & 63, n = n0 + i;
            const float m0 = (n - 1 >= seg_lo) ? 1.f : 0.f, m2 = (n + 1 <= seg_hi) ? 1.f : 0.f;
            float a[8], c0[8], d[8], y[8];
            unpack8(xm[u], a); unpack8(x0[u], c0); unpack8(xp[u], d);
            const LAS3 float* w = cwl + cg * 8;
#pragma unroll
            for (int e = 0; e < 8; ++e) {
                float v = w[1536 + e] + a[e] * w[e] * m0 + c0[e] * w[512 + e] + d[e] * w[1024 + e] * m2;
                v = siluf_(v); if (cg >= 32) v *= 0.125f;
                y[e] = v;
            }
            const u32x4_t o = pack8(y);
            const int cc = (cg & 31) * 8;
            bf16_t* dst = ((cg < 32) ? P.mlQ : P.mlK) + (((size_t)b * 4 + (cc >> 6)) * NT + n) * 64 + (cc & 63);
            *(u32x4_t*)dst = o;
            if (cg >= 32) *(LAS3 u32x4_t*)(ks + i * TS_ROW + cc) = o;
        }
    }
    __syncthreads();
    write_transposed(ks, P.mlKt, b, n0, tid);
    write_transposed(vs, P.mlVt, b, n0, tid);
}
__device__ __forceinline__ void prep_mla(const Params& P, LAS3 unsigned char* lds, int tile, int l) {
    const int tid = opaque_tid(), wid = tid >> 6, lane = tid & 63, lr = lane & 15, q = lane >> 4;
    const int t0 = tile * 64, b = t0 / NT, n0 = t0 % NT;
    constexpr int AROW = 328;
    LAS3 bf16_t* As = (LAS3 bf16_t*)lds;
    const float qscale = 0.10206207261596575f * 1.4426950408889634f;
    const float* qn = P.mla_q_norm + l * 192; const float* kvn = P.mla_kv_norm + l * 128;
    const bf16_t* __restrict__ pbr = P.pb; bf16_t* __restrict__ oMK = P.mK; const float* __restrict__ rcs = P.ropecs;
    __syncthreads();
    {
        const int i = tid >> 3, sidx = tid & 7;
        const bf16_t* pr = pbr + (size_t)(t0 + i) * DIN;
        u32x4_t cqv[3], ckv[2];
#pragma unroll
        for (int u = 0; u < 3; ++u) cqv[u] = *(const u32x4_t*)(pr + P_CQ + (sidx + 8 * u) * 8);
#pragma unroll
        for (int u = 0; u < 2; ++u) ckv[u] = *(const u32x4_t*)(pr + P_CKV + (sidx + 8 * u) * 8);
        float fq[3][8], fk[2][8]; float sq = 0.f, sk = 0.f;
#pragma unroll
        for (int u = 0; u < 3; ++u) { unpack8(cqv[u], fq[u]);
#pragma unroll
            for (int e = 0; e < 8; ++e) sq += fq[u][e] * fq[u][e]; }
#pragma unroll
        for (int u = 0; u < 2; ++u) { unpack8(ckv[u], fk[u]);
#pragma unroll
            for (int e = 0; e < 8; ++e) sk += fk[u][e] * fk[u][e]; }
#pragma unroll
        for (int o = 1; o < 8; o <<= 1) { sq += __shfl_xor(sq, o); sk += __shfl_xor(sk, o); }
        const float rq = rsqrtf(sq * (1.f / 192.f) + 1e-6f), rk = rsqrtf(sk * (1.f / 128.f) + 1e-6f);
#pragma unroll
        for (int u = 0; u < 3; ++u) { const int c0 = (sidx + 8 * u) * 8; float o[8];
#pragma unroll
            for (int e = 0; e < 8; ++e) o[e] = fq[u][e] * rq * qn[c0 + e];
            *(LAS3 u32x4_t*)(As + i * AROW + c0) = pack8(o); }
#pragma unroll
        for (int u = 0; u < 2; ++u) { const int c0 = (sidx + 8 * u) * 8; float o[8];
#pragma unroll
            for (int e = 0; e < 8; ++e) o[e] = fk[u][e] * rk * kvn[c0 + e];
            *(LAS3 u32x4_t*)(As + i * AROW + 192 + c0) = pack8(o); }
    }
    if (tid < 256) {
        const int i = tid >> 2, c = tid & 3, n = n0 + i; const bool lat = n >= NC;
        const bf16_t* pr = pbr + (size_t)(t0 + i) * DIN + P_KR;
        const u32x4_t kav = *(const u32x4_t*)(pr + 8 * c), kbv = *(const u32x4_t*)(pr + 8 * (c ^ 2));
        const int pos = max(n - NC, 0);
        const float4* cp = (const float4*)(rcs + (pos * 16 + 8 * (c & 1)) * 2);
        const float4 c0 = cp[0], c1 = cp[1], c2 = cp[2], c3 = cp[3];
        const float sg = (c < 2) ? -1.f : 1.f;
        float ka[8], kb2[8], ko[8];
        unpack8(kav, ka); unpack8(kbv, kb2);
#define RK_(e, cc, ss) ko[e] = ka[e] * (lat ? (cc) : 1.f) + kb2[e] * (lat ? (ss) * sg : 0.f)
        RK_(0, c0.x, c0.y); RK_(1, c0.z, c0.w); RK_(2, c1.x, c1.y); RK_(3, c1.z, c1.w); RK_(4, c2.x, c2.y); RK_(5, c2.z, c2.w); RK_(6, c3.x, c3.y); RK_(7, c3.z, c3.w);
#undef RK_
        const u32x4_t ov = pack8(ko);
#pragma unroll
        for (int hh = 0; hh < 4; ++hh) *(u32x4_t*)(oMK + (((size_t)b * 4 + hh) * NT + n) * 96 + 64 + 8 * c) = ov;
    }
    __syncthreads();
    const int h = wid >> 1;
    if ((wid & 1) == 0) {
        const bf16_t* wt = P.wq_t + (size_t)l * 384 * 192;
        f32x4_t acc[4][6];
#pragma unroll
        for (int rt = 0; rt < 4; ++rt)
#pragma unroll
            for (int ct = 0; ct < 6; ++ct) acc[rt][ct] = (f32x4_t){0.f, 0.f, 0.f, 0.f};
#pragma unroll
        for (int ks = 0; ks < 6; ++ks) {
            bf16x8_t a[4];
#pragma unroll
            for (int rt = 0; rt < 4; ++rt) a[rt] = *(const LAS3 bf16x8_t*)(As + (16 * rt + lr) * AROW + 32 * ks + 8 * q);
#pragma unroll
            for (int ct = 0; ct < 6; ++ct) {
                const bf16x8_t bb = *(const bf16x8_t*)(wt + (size_t)(h * 96 + 16 * ct + lr) * 192 + 32 * ks + 8 * q);
#pragma unroll
                for (int rt = 0; rt < 4; ++rt) acc[rt][ct] = __builtin_amdgcn_mfma_f32_16x16x32_bf16(bb, a[rt], acc[rt][ct], 0, 0, 0);
            }
        }
#pragma unroll
        for (int rt = 0; rt < 4; ++rt) {
            const int n = n0 + 16 * rt + lr;
            bf16_t* qp = P.mQ + (((size_t)b * 4 + h) * NT + n) * 96;
#pragma unroll
            for (int ct = 0; ct < 4; ++ct)
                *(uint2*)(qp + 16 * ct + 4 * q) = make_uint2(cvtpk(acc[rt][ct][0] * qscale, acc[rt][ct][1] * qscale), cvtpk(acc[rt][ct][2] * qscale, acc[rt][ct][3] * qscale));
            f32x4_t x1 = acc[rt][4], x2 = acc[rt][5];
            if (n >= NC) {
                const float4* cp = (const float4*)(rcs + ((n - NC) * 16 + 4 * q) * 2);
                const float4 ca = cp[0], cb = cp[1];
                const f32x4_t co = (f32x4_t){ca.x, ca.z, cb.x, cb.z}, si = (f32x4_t){ca.y, ca.w, cb.y, cb.w};
                const f32x4_t o1 = x1 * co - x2 * si, o2 = x2 * co + x1 * si; x1 = o1; x2 = o2;
            }
            *(uint2*)(qp + 64 + 4 * q) = make_uint2(cvtpk(x1[0] * qscale, x1[1] * qscale), cvtpk(x1[2] * qscale, x1[3] * qscale));
            *(uint2*)(qp + 80 + 4 * q) = make_uint2(cvtpk(x2[0] * qscale, x2[1] * qscale), cvtpk(x2[2] * qscale, x2[3] * qscale));
        }
    } else {
        const bf16_t* wt = P.wkv_t + (size_t)l * 512 * 128;
#pragma unroll
        for (int pass = 0; pass < 2; ++pass) {
            f32x4_t acc[4][4];
#pragma unroll
            for (int rt = 0; rt < 4; ++rt)
#pragma unroll
                for (int ct = 0; ct < 4; ++ct) acc[rt][ct] = (f32x4_t){0.f, 0.f, 0.f, 0.f};
#pragma unroll
            for (int ks = 0; ks < 4; ++ks) {
                bf16x8_t a[4];
#pragma unroll
                for (int rt = 0; rt < 4; ++rt) a[rt] = *(const LAS3 bf16x8_t*)(As + (16 * rt + lr) * AROW + 192 + 32 * ks + 8 * q);
#pragma unroll
                for (int ct = 0; ct < 4; ++ct) {
                    const bf16x8_t bb = *(const bf16x8_t*)(wt + (size_t)(h * 128 + 16 * (4 * pass + ct) + lr) * 128 + 32 * ks + 8 * q);
#pragma unroll
                    for (int rt = 0; rt < 4; ++rt)
                        acc[rt][ct] = (pass == 0) ? __builtin_amdgcn_mfma_f32_16x16x32_bf16(bb, a[rt], acc[rt][ct], 0, 0, 0) : __builtin_amdgcn_mfma_f32_16x16x32_bf16(a[rt], bb, acc[rt][ct], 0, 0, 0);
                }
            }
#pragma unroll
            for (int rt = 0; rt < 4; ++rt) {
                if (pass == 0) {
                    const int n = n0 + 16 * rt + lr;
                    bf16_t* kp = P.mK + (((size_t)b * 4 + h) * NT + n) * 96;
#pragma unroll
                    for (int ct = 0; ct < 4; ++ct) *(uint2*)(kp + 16 * ct + 4 * q) = make_uint2(cvtpk(acc[rt][ct][0], acc[rt][ct][1]), cvtpk(acc[rt][ct][2], acc[rt][ct][3]));
                } else {
#pragma unroll
                    for (int ct = 0; ct < 4; ++ct) {
                        bf16_t* vp = P.mVt + (((size_t)b * 4 + h) * 64 + 16 * ct + lr) * NT + n0 + 16 * rt + 4 * q;
                        *(uint2*)vp = make_uint2(cvtpk(acc[rt][ct][0], acc[rt][ct][1]), cvtpk(acc[rt][ct][2], acc[rt][ct][3]));
                    }
                }
            }
        }
    }
}
__device__ __forceinline__ void phase_prep(const Params& P, LAS3 unsigned char* lds, int l) {
    if (gridDim.x == 256) {
        const int w = blockIdx.x, nr = (w >= 128 && w < 224) ? 4 : 3;
        for (int r = 0; r < nr; ++r) {
            int q = -1, tile = 0;
            if (w < 128) { if (r < 2) tile = 2 * w + r; else q = w; }
            else if (w < 224) q = 128 + 4 * (w - 128) + r;
            else { if (r == 0) tile = 256 + (w - 224); else q = 512 + 2 * (w - 224) + (r - 1); }
            if (q < 0) prep_mla(P, lds, tile, l); else if ((q & 1) == 0) prep_ml(P, lds, q >> 1, l); else prep_da(P, lds, q >> 1);
        }
    } else
    for (int it = blockIdx.x; it < 3 * (TT / 64); it += gridDim.x) {
        const int fn = it % 3, tile = it / 3;
        if (fn == 0) prep_mla(P, lds, tile, l); else if (fn == 1) prep_ml(P, lds, tile, l); else prep_da(P, lds, tile);
    }
}

__device__ __forceinline__ void phase_mix(const Params& P, LAS3 unsigned char* lds, int l) {
    const int bid = blockIdx.x, G = gridDim.x;
    const float lambda_init = (l == 0) ? 0.2f : 0.35550906759096927f;
    for (int it = bid; it < 256; it += G)
    {
        const int pr = (it & 7) * 4 + (it >> 6), qb = (it >> 3) & 7;
        attn_item<64, 2, true>(lds, P.daQ, P.daK, P.daVt, P.ycatb, 0, pr >> 2, pr & 3, 1 + qb, P.lamfull[l], P.da_subln + l * 64, 1.f - lambda_init);
    }
    LAS3 int* slot = (LAS3 int*)(lds + MK_LDS_MAIN + 16);
    const int n_ml = 64, n_mla = 256, n_s5 = 256, n_ctx = (l == 0) ? 64 : 0;
    const int total = n_ml + n_mla + n_s5 + n_ctx;
    (void)total;
    for (int step = 0;; ++step) {
        int it;
        const int nst = (bid < 128) ? 1 : (bid < 192) ? 2 : 1;
        if (G == 256 && step < nst) it = (bid < 128) ? 64 + bid : (bid < 192) ? 320 + 2 * (bid - 128) + step : bid - 192;
        else {
            __syncthreads();
            if (threadIdx.x == 0) *slot = atomicAdd(P.queue + l, 1);
            __syncthreads();
            const int d = __builtin_amdgcn_readfirstlane(*slot);
            if (G == 256) { if (d < 128) it = 192 + d; else if (d < 256) it = 320 + d; else if (d - 256 < n_ctx) it = 576 + (d - 256); else break; }
            else { if (d >= total) break; it = d; }
        }
        int kind, b, h, x3;
        if (it < n_ml) { kind = 1; b = it >> 3; h = (it >> 1) & 3; x3 = it & 1; }
        else if ((it -= n_ml) < n_mla) { kind = 2; b = it >> 5; h = (it >> 3) & 3; x3 = 1 + (it & 7); }
        else if ((it -= n_mla) < n_s5) { kind = 3; b = it >> 5; h = (it >> 1) & 15; x3 = it & 1; }
        else { it -= n_s5; kind = (it < 32) ? 0 : 2; it &= 31; b = it >> 2; h = it & 3; x3 = 0; }
        if (kind == 0) attn_item<64, 2, true>(lds, P.daQ, P.daK, P.daVt, P.ycatb, 0, b, h, x3, P.lamfull[l], P.da_subln + l * 64, 1.f - lambda_init);
        else if (kind == 1) mlstm_item(lds, P.mlQ, P.mlK, P.mlKt, P.mlVt, P.mlG, P.hdir, b, h, x3);
        else if (kind == 2) attn_item<96, 1, false>(lds, P.mQ, P.mK, P.mVt, P.ycatb, 512, b, h, x3, 0.f, nullptr, 1.f);
        else s5_item(lds, P.pb, P.s5KmT + (size_t)l * 32 * 16 * 1024, P.s5Smat + (size_t)l * 32 * 128 * 1024, P.s5CmT + (size_t)l * 32 * 16 * 128,
                     P.s5A + l * 32 * 64 * 2, P.s5A64 + l * 32 * 64 * 2, P.s5xs, P.ys5, b, h, x3);
    }
}

template <int TOK, int BATCH>
__device__ __forceinline__ void phase_finish_t(const Params& P, LAS3 unsigned char* lds, int l) {
    constexpr int RT = (TOK + 15) / 16;
    const int tid = opaque_tid(), wid = tid >> 6, lane = tid & 63, lr = lane & 15, q = lane >> 4, c = tid & 255, half = tid >> 8;
    const int ntile = (l == 0) ? TT / TOK : NB * (NS / TOK);
    constexpr int GROW = 264;
    LAS3 bf16_t* Gs = (LAS3 bf16_t*)lds;
    const float* mn = P.ml_norm + l * 256; const float* dsk = P.s5_d + l * 256; const float* bgl = P.s5_b_glu + l * 256;
    const bf16_t* wg = P.wglu_t + (size_t)l * 256 * 256;
    const bf16_t* __restrict__ pbr = P.pb; const bf16_t* __restrict__ hdr = (const bf16_t*)P.hdir; const bf16_t* __restrict__ ysr = (const bf16_t*)P.ys5; bf16_t* __restrict__ oY = P.ycatb;
    bf16x8_t wb[8][2];
#pragma unroll
    for (int ks = 0; ks < 8; ++ks) { wb[ks][0] = *(const bf16x8_t*)(wg + (size_t)(32 * wid + lr) * 256 + 32 * ks + 8 * q); wb[ks][1] = *(const bf16x8_t*)(wg + (size_t)(32 * wid + 16 + lr) * 256 + 32 * ks + 8 * q); }
    for (int it = blockIdx.x; it < ntile; it += gridDim.x) {
        const int t0 = (l == 0) ? it * TOK : ((it / (NS / TOK)) * NT + NC + (it % (NS / TOK)) * TOK);
        __syncthreads();
        {
            const int cg = tid & 31, ts = tid >> 5, c0 = 8 * cg;
            float mnv[8], dsv[8];
            { const float4 m0 = *(const float4*)(mn + c0), m1 = *(const float4*)(mn + c0 + 4), d0 = *(const float4*)(dsk + c0), d1 = *(const float4*)(dsk + c0 + 4);
              mnv[0] = m0.x; mnv[1] = m0.y; mnv[2] = m0.z; mnv[3] = m0.w; mnv[4] = m1.x; mnv[5] = m1.y; mnv[6] = m1.z; mnv[7] = m1.w;
              dsv[0] = d0.x; dsv[1] = d0.y; dsv[2] = d0.z; dsv[3] = d0.w; dsv[4] = d1.x; dsv[5] = d1.y; dsv[6] = d1.z; dsv[7] = d1.w; }
            constexpr int NP = (TOK + 15) / 16;
#pragma unroll
            for (int k0 = 0; k0 < NP; k0 += 2) {
                u32x4_t vog[2], vuu[2], vhf[2], vhb[2], vyf[2], vyb[2];
#pragma unroll
                for (int u = 0; u < 2; ++u) {
                    const int tok = ts + 16 * (k0 + u), tc = (tok < TOK) ? tok : TOK - 1;
                    const size_t t = (size_t)t0 + tc; const bf16_t* pr = pbr + t * DIN;
                    vog[u] = *(const u32x4_t*)(pr + P_MLO + c0); vuu[u] = *(const u32x4_t*)(pr + P_S5 + c0);
                    vhf[u] = *(const u32x4_t*)(hdr + t * 256 + c0); vhb[u] = *(const u32x4_t*)(hdr + ((size_t)TT + t) * 256 + c0);
                    vyf[u] = *(const u32x4_t*)(ysr + t * 256 + c0); vyb[u] = *(const u32x4_t*)(ysr + ((size_t)TT + t) * 256 + c0);
                }
#pragma unroll
                for (int u = 0; u < 2; ++u) {
                    const int tok = ts + 16 * (k0 + u);
                    float og[8], uu[8], hf[8], hb[8], yf[8], yb[8], hv[8], go[8];
                    unpack8(vog[u], og); unpack8(vuu[u], uu); unpack8(vhf[u], hf); unpack8(vhb[u], hb); unpack8(vyf[u], yf); unpack8(vyb[u], yb);
                    float ssq = 0.f;
#pragma unroll
                    for (int e = 0; e < 8; ++e) { hv[e] = sigmoidf_(og[e]) * (hf[e] + hb[e]); ssq += hv[e] * hv[e]; go[e] = gelu_tanh_(yf[e] + yb[e] + uu[e] * dsv[e]); }
                    ssq += __shfl_xor(ssq, 1); ssq += __shfl_xor(ssq, 2); ssq += __shfl_xor(ssq, 4);
                    const float r = rsqrtf(ssq * (1.f / 64.f) + 1e-6f);
#pragma unroll
                    for (int e = 0; e < 8; ++e) hv[e] = hv[e] * r * mnv[e];
                    if (NP * 16 == TOK || tok < TOK) {
                        *(u32x4_t*)(oY + ((size_t)t0 + tok) * DM + 256 + c0) = pack8(hv);
                        *(LAS3 u32x4_t*)(Gs + tok * GROW + c0) = pack8(go);
                    }
                }
            }
        }
        __syncthreads();
        f32x4_t acc[RT][2];
#pragma unroll
        for (int rt = 0; rt < RT; ++rt) { acc[rt][0] = (f32x4_t){0.f, 0.f, 0.f, 0.f}; acc[rt][1] = (f32x4_t){0.f, 0.f, 0.f, 0.f}; }
#pragma unroll
        for (int ks = 0; ks < 8; ++ks) {
#pragma unroll
            for (int rt = 0; rt < RT; ++rt) {
                const bf16x8_t a = *(const LAS3 bf16x8_t*)(Gs + (16 * rt + lr) * GROW + 32 * ks + 8 * q);
                acc[rt][0] = __builtin_amdgcn_mfma_f32_16x16x32_bf16(a, wb[ks][0], acc[rt][0], 0, 0, 0);
                acc[rt][1] = __builtin_amdgcn_mfma_f32_16x16x32_bf16(a, wb[ks][1], acc[rt][1], 0, 0, 0);
            }
        }
#pragma unroll
        for (int rt = 0; rt < RT; ++rt)
#pragma unroll
            for (int cc = 0; cc < 2; ++cc)
#pragma unroll
                for (int rg = 0; rg < 4; ++rg) {
                    const int row = 16 * rt + 4 * q + rg, col = 32 * wid + 16 * cc + lr;
                    const float gv = bf2f(Gs[row * GROW + col]);
                    if (TOK % 16 == 0 || row < TOK) P.ycatb[((size_t)t0 + row) * DM + 768 + col] = f2bf(gv * sigmoidf_(acc[rt][cc][rg] + bgl[col]));
                }
    }
}
__device__ __forceinline__ void phase_finish(const Params& P, LAS3 unsigned char* lds, int l) {
    if (l == 0) phase_finish_t<72, 12>(P, lds, l); else phase_finish_t<64, 8>(P, lds, l);
}

__device__ __forceinline__ void phase_post(const Params& P, LAS3 unsigned char* lds, int l) {
    const int tid = opaque_tid(), wid = tid >> 6, lane = tid & 63, lr = lane & 15, q = lane >> 4;
    constexpr int FROW = 1028, HROW = 1032;
    LAS3 float* ft = (LAS3 float*)lds;
    LAS3 bf16_t* fhi = (LAS3 bf16_t*)lds; LAS3 bf16_t* flo = fhi + 16 * HROW;
    static_assert(2 * 16 * HROW * 2 <= 16 * FROW * 4 + 1024, "hi/lo images");
    LAS3 float* pl = ft + 16 * FROW + 256;
    const float* nw1 = P.norm_w + (size_t)l * 4096 + 1024; const float* nw2 = nw1 + 1024;
    const float* wr = P.moe_w_router + (size_t)l * 1024 * 32; const float* br = P.moe_b_router + l * 32;
    LAS3 int* lcnt = (LAS3 int*)(pl + 8 * 16 * 32);
    if (tid < 32) lcnt[tid] = 0;
    bf16x8_t whi[4][2], wlo[4][2];
#pragma unroll
    for (int kb = 0; kb < 4; ++kb)
#pragma unroll
        for (int hx = 0; hx < 2; ++hx) {
            union { unsigned u[4]; bf16x8_t v; } uh, ul;
#pragma unroll
            for (int jj = 0; jj < 4; ++jj) {
                const float w0 = wr[(size_t)(128 * wid + 32 * kb + 8 * q + 2 * jj) * 32 + 16 * hx + lr], w1 = wr[(size_t)(128 * wid + 32 * kb + 8 * q + 2 * jj + 1) * 32 + 16 * hx + lr];
                const unsigned hb = cvtpk(w0, w1);
                uh.u[jj] = hb; ul.u[jj] = cvtpk(w0 - __uint_as_float(hb << 16), w1 - __uint_as_float(hb & 0xFFFF0000u));
            }
            whi[kb][hx] = uh.v; wlo[kb][hx] = ul.v;
        }
    const int nitem = (l == 0) ? TT / 16 : NB * NS / 16;
    const int tr = tid >> 5, part = tid & 31;
    LAS3 float* wl = (LAS3 float*)(lcnt + 32) + 16 * 32 + 16 * 4 + 16 * 4;
    float4 nm0 = make_float4(0.f, 0.f, 0.f, 0.f), nm1 = nm0;
#define POST_MODROW(it_) (P.mod + ((size_t)l * 9 + (((((l == 0) ? (it_) * 16 : (((it_) >> 7) * NT + NC + ((it_) & 127) * 16)) % NT) < NC) ? 8 : (((l == 0) ? (it_) * 16 : (((it_) >> 7) * NT + NC + ((it_) & 127) * 16)) / NT))) * 6144 + 2048)
    *(LAS3 f32x4_t*)(wl + tid * 4) = *(const f32x4_t*)(nw1 + tid * 4);
    if ((int)blockIdx.x < nitem) { const float* mrn = POST_MODROW((int)blockIdx.x); nm0 = *(const float4*)(mrn + tid * 4); if (tid < 256) nm1 = *(const float4*)(mrn + 2048 + tid * 4);
        *(LAS3 f32x4_t*)(wl + 2048 + tid * 4) = (f32x4_t){nm0.x, nm0.y, nm0.z, nm0.w}; if (tid < 256) *(LAS3 f32x4_t*)(wl + 4096 + tid * 4) = (f32x4_t){nm1.x, nm1.y, nm1.z, nm1.w}; }
    for (int it = blockIdx.x; it < nitem; it += gridDim.x) {
        const int t0 = (l == 0) ? it * 16 : ((it >> 7) * NT + NC + (it & 127) * 16);
        const int t = t0 + tr, b = t / NT, n = t % NT;
        const float* xin = (n < NC) ? P.ctx + ((size_t)b * NC + n) * DM : P.x + ((size_t)b * NS + (n - NC)) * DM;
        bf16_t* x1b = (bf16_t*)P.xall; const bf16_t* x2b = x1b + (size_t)TT * DM;
        __syncthreads();
        float x1[32];
        {
            float so = P.osq[(size_t)t * 16 + (part & 15)];
#pragma unroll
            for (int o = 8; o > 0; o >>= 1) so += __shfl_xor(so, o);
            const float rstd = rsqrtf(so * (1.f / DM) + 1e-6f);
            float ss = 0.f;
#pragma unroll
            for (int j = 0; j < 8; ++j) {
                const int d = j * 128 + part * 4;
                const uint2 ov = *(const uint2*)(P.ob + (size_t)t * DM + d);
                float4 xv;
                if (l == 0) xv = *(const float4*)(xin + d);
                else { const uint2 xb = *(const uint2*)(x2b + (size_t)t * DM + d); xv = make_float4(__uint_as_float(xb.x << 16), __uint_as_float(xb.x & 0xFFFF0000u), __uint_as_float(xb.y << 16), __uint_as_float(xb.y & 0xFFFF0000u)); }
                const f32x4_t wv_ = *(const LAS3 f32x4_t*)(wl + d), gv_ = *(const LAS3 f32x4_t*)(wl + 2048 + d);
                const float4 w = make_float4(wv_[0], wv_[1], wv_[2], wv_[3]), g1 = make_float4(gv_[0], gv_[1], gv_[2], gv_[3]);
                const float a0 = xv.x + g1.x * __uint_as_float(ov.x << 16) * rstd * w.x, a1 = xv.y + g1.y * __uint_as_float(ov.x & 0xFFFF0000u) * rstd * w.y;
                const float a2 = xv.z + g1.z * __uint_as_float(ov.y << 16) * rstd * w.z, a3 = xv.w + g1.w * __uint_as_float(ov.y & 0xFFFF0000u) * rstd * w.w;
                x1[j * 4] = a0; x1[j * 4 + 1] = a1; x1[j * 4 + 2] = a2; x1[j * 4 + 3] = a3;
                *(uint2*)(x1b + (size_t)t * DM + d) = make_uint2(cvtpk(a0, a1), cvtpk(a2, a3));
                ss += (a0 * a0 + a1 * a1) + (a2 * a2 + a3 * a3);
            }
#pragma unroll
            for (int o = 16; o > 0; o >>= 1) ss += __shfl_xor(ss, o);
            const float rstd2 = rsqrtf(ss * (1.f / DM) + 1e-6f);
#pragma unroll
            for (int j = 0; j < 8; ++j) {
                const int d = j * 128 + part * 4;
                const f32x4_t wv_ = *(const LAS3 f32x4_t*)(wl + 1024 + d), sv_ = *(const LAS3 f32x4_t*)(wl + 3072 + d), cv_ = *(const LAS3 f32x4_t*)(wl + 4096 + d);
                const float4 w = make_float4(wv_[0], wv_[1], wv_[2], wv_[3]), sh = make_float4(sv_[0], sv_[1], sv_[2], sv_[3]), sc = make_float4(cv_[0], cv_[1], cv_[2], cv_[3]);
                const float f0 = x1[j * 4] * rstd2 * w.x * (1.f + sc.x) + sh.x, f1 = x1[j * 4 + 1] * rstd2 * w.y * (1.f + sc.y) + sh.y;
                const float f2 = x1[j * 4 + 2] * rstd2 * w.z * (1.f + sc.z) + sh.z, f3 = x1[j * 4 + 3] * rstd2 * w.w * (1.f + sc.w) + sh.w;
                *(uint2*)(P.fb + (size_t)t * DM + d) = make_uint2(cvtpk(f0, f1), cvtpk(f2, f3));
                {
                    const unsigned h01 = cvtpk(f0, f1), h23 = cvtpk(f2, f3);
                    *(LAS3 u32x2_t*)(fhi + tr * HROW + d) = (u32x2_t){h01, h23};
                    *(LAS3 u32x2_t*)(flo + tr * HROW + d) = (u32x2_t){cvtpk(f0 - __uint_as_float(h01 << 16), f1 - __uint_as_float(h01 & 0xFFFF0000u)), cvtpk(f2 - __uint_as_float(h23 << 16), f3 - __uint_as_float(h23 & 0xFFFF0000u))};
                }
            }
        }
        __syncthreads();
        const bool hasn = it + (int)gridDim.x < nitem;
        if (hasn) { const float* mrn = POST_MODROW(it + (int)gridDim.x); nm0 = *(const float4*)(mrn + tid * 4); if (tid < 256) nm1 = *(const float4*)(mrn + 2048 + tid * 4); }
        {
            f32x4_t a0 = (f32x4_t){0.f, 0.f, 0.f, 0.f}, a1 = (f32x4_t){0.f, 0.f, 0.f, 0.f};
            bf16x8_t ah[4], al[4];
#pragma unroll
            for (int kb = 0; kb < 4; ++kb) { ah[kb] = *(const LAS3 bf16x8_t*)(fhi + lr * HROW + 128 * wid + 32 * kb + 8 * q); al[kb] = *(const LAS3 bf16x8_t*)(flo + lr * HROW + 128 * wid + 32 * kb + 8 * q); }
#pragma unroll
            for (int kb = 0; kb < 4; ++kb) {
                a0 = __builtin_amdgcn_mfma_f32_16x16x32_bf16(ah[kb], whi[kb][0], a0, 0, 0, 0); a1 = __builtin_amdgcn_mfma_f32_16x16x32_bf16(ah[kb], whi[kb][1], a1, 0, 0, 0);
                a0 = __builtin_amdgcn_mfma_f32_16x16x32_bf16(ah[kb], wlo[kb][0], a0, 0, 0, 0); a1 = __builtin_amdgcn_mfma_f32_16x16x32_bf16(ah[kb], wlo[kb][1], a1, 0, 0, 0);
                a0 = __builtin_amdgcn_mfma_f32_16x16x32_bf16(al[kb], whi[kb][0], a0, 0, 0, 0); a1 = __builtin_amdgcn_mfma_f32_16x16x32_bf16(al[kb], whi[kb][1], a1, 0, 0, 0);
            }
#pragma unroll
            for (int rg = 0; rg < 4; ++rg) { pl[(wid * 16 + 4 * q + rg) * 32 + lr] = a0[rg]; pl[(wid * 16 + 4 * q + rg) * 32 + 16 + lr] = a1[rg]; }
        }
        __syncthreads();
        {
            float lg = br[part];
#pragma unroll
            for (int w = 0; w < 8; ++w) lg += pl[(w * 16 + tr) * 32 + part];
            LAS3 float* lgs = (LAS3 float*)(lcnt + 32);
            LAS3 float* topv = lgs + 16 * 32;
            LAS3 int* topi = (LAS3 int*)(topv + 16 * 4);
            lgs[tr * 32 + part] = lg;
            asm volatile("s_waitcnt lgkmcnt(0)" ::: "memory");
            int rank = 0;
#pragma unroll
            for (int c4 = 0; c4 < 8; ++c4) {
                const f32x4_t lv = *(const LAS3 f32x4_t*)(lgs + tr * 32 + 4 * c4);
#pragma unroll
                for (int e = 0; e < 4; ++e) rank += (lv[e] > lg || (lv[e] == lg && (4 * c4 + e) < part)) ? 1 : 0;
            }
            if (rank < 4) { topv[tr * 4 + rank] = lg; topi[tr * 4 + rank] = part; }
            asm volatile("s_waitcnt lgkmcnt(0)" ::: "memory");
            if (part < 4) {
                const f32x4_t v = *(const LAS3 f32x4_t*)(topv + tr * 4);
                const int ek = topi[tr * 4 + part];
                const float e1 = __expf(v[1] - v[0]), e2 = __expf(v[2] - v[0]), e3 = __expf(v[3] - v[0]);
                const float inv = 1.f / (1.f + e1 + e2 + e3);
                const float gk = (part == 0) ? inv : (part == 1) ? e1 * inv : (part == 2) ? e2 * inv : e3 * inv;
                P.top_e[(size_t)t * 4 + part] = ek; P.top_g[(size_t)t * 4 + part] = gk;
                P.posb[(size_t)t * 4 + part] = __hip_atomic_fetch_add(&lcnt[ek], 1, __ATOMIC_RELAXED, __HIP_MEMORY_SCOPE_WORKGROUP);
            }
        }
        if (hasn) { *(LAS3 f32x4_t*)(wl + 2048 + tid * 4) = (f32x4_t){nm0.x, nm0.y, nm0.z, nm0.w}; if (tid < 256) *(LAS3 f32x4_t*)(wl + 4096 + tid * 4) = (f32x4_t){nm1.x, nm1.y, nm1.z, nm1.w}; }
    }
#undef POST_MODROW
    __syncthreads();
    if (tid < 32) P.blkcnt[((size_t)l * gridDim.x + blockIdx.x) * 32 + tid] = lcnt[tid];
}

__device__ __forceinline__ void phase_scatter(const Params& P, LAS3 unsigned char* lds, int l) {
    const int tid = opaque_tid(), wid = tid >> 6, lane = tid & 63;
    LAS3 int* soff = (LAS3 int*)lds;
    LAS3 int* part = soff + 64;
    LAS3 int* pre = soff + 1024;
    const int G = gridDim.x;
    const int* bc = P.blkcnt + (size_t)l * G * 32;
    __syncthreads();
    {
        const int e = tid & 31, pt = tid >> 5, per = (G + 15) / 16;
        int sum = 0;
        for (int b2 = pt * per; b2 < (pt + 1) * per && b2 < G; ++b2) sum += bc[b2 * 32 + e];
        part[pt * 32 + e] = sum;
        __syncthreads();
        int run = 0;
        for (int p2 = 0; p2 < pt; ++p2) run += part[p2 * 32 + e];
        for (int b2 = pt * per; b2 < (pt + 1) * per && b2 < G; ++b2) { pre[b2 * 32 + e] = run; run += bc[b2 * 32 + e]; }
        if (pt == 15) soff[32 + e] = run;
    }
    __syncthreads();
    if (tid < 64) {
        const int e = tid & 31;
        const int ntl = (soff[32 + e] + 255) >> 8;
        int inc = ntl;
#pragma unroll
        for (int o = 1; o < 32; o <<= 1) { const int v = __shfl_up(inc, o, 32); if (e >= o) inc += v; }
        const int nt0 = inc - ntl;
        if (tid < 32) {
            soff[e] = nt0 * 256;
            if (blockIdx.x == 0) { for (int m = 0; m < ntl; ++m) P.tile_e[l * 512 + nt0 + m] = e; P.offs[l * 32 + e] = nt0 * 256; if (e == 31) P.ntiles[l * 16] = inc; }
        }
    }
    __syncthreads();
    const int gt = blockIdx.x * 512 + tid, NTH = gridDim.x * 512;
    const int ntok = (l == 0) ? TT : NB * NS;
    int* __restrict__ stk = (int*)P.xg;
    for (int a = gt; a < ntok * 4; a += NTH) {
        const int i = a >> 2;
        const int t = (l == 0) ? i : ((i >> 11) * NT + NC + (i & 2047));
        const int ek = P.top_e[(size_t)t * 4 + (a & 3)];
        const int slot = soff[ek] + pre[((i >> 4) % G) * 32 + ek] + P.posb[(size_t)t * 4 + (a & 3)];
        stk[slot] = t; P.tok_slot[(size_t)t * 4 + (a & 3)] = slot;
    }
    for (int i = gt; i < NE * 256; i += NTH) {
        const int e = i >> 8, j = i & 255, c = soff[32 + e];
        const int padn = ((c + 255) & ~255) - c;
        if (j < padn) stk[soff[e] + c + j] = NC;
    }
}

__device__ __forceinline__ void phase_combine(const Params& P, LAS3 unsigned char* lds, int l) {
    const int tid = opaque_tid(); const int lane = tid & 63, gw = blockIdx.x * 8 + (tid >> 6), NW = gridDim.x * 8;
    const float* __restrict__ nw3 = P.norm_w + (size_t)l * 4096 + 3072;
    const float* __restrict__ nwn = P.norm_w + 4096;
    const int* __restrict__ tsl = P.tok_slot; const float* __restrict__ tg = P.top_g; const bf16_t* __restrict__ ye = P.yexp; const float* __restrict__ modp = P.mod;
    const int ntok = (l == 0) ? TT : NB * NS;
    LAS3 float* cw = (LAS3 float*)lds;
    for (int i = tid; i < 256; i += 512) { *(LAS3 f32x4_t*)(cw + i * 4) = *(const f32x4_t*)(nw3 + i * 4); if (l == 0) *(LAS3 f32x4_t*)(cw + 1024 + i * 4) = *(const f32x4_t*)(nwn + i * 4); }
    for (int i = tid; i < 9 * 256; i += 512) { const int r = i >> 8, k = i & 255; *(LAS3 f32x4_t*)(cw + 2048 + r * 1024 + k * 4) = *(const f32x4_t*)(modp + ((size_t)l * 9 + r) * 6144 + 5120 + k * 4); }
    if (l == 0) for (int i = tid; i < 9 * 512; i += 512) { const int r = i >> 9, k = i & 511; *(LAS3 f32x4_t*)(cw + 11264 + r * 2048 + k * 4) = *(const f32x4_t*)(modp + ((size_t)9 + r) * 6144 + k * 4); }
    __syncthreads();
    const bf16_t* __restrict__ x1b = (const bf16_t*)P.xall; bf16_t* __restrict__ x2b = (bf16_t*)P.xall + (size_t)TT * DM;
    int i = gw;
    int4 sl = make_int4(0, 0, 0, 0); float4 gt = make_float4(0.f, 0.f, 0.f, 0.f);
    if (i < ntok) { const int t = (l == 0) ? i : ((i >> 11) * NT + NC + (i & 2047)); sl = *(const int4*)(tsl + (size_t)t * 4); gt = *(const float4*)(tg + (size_t)t * 4); }
    for (; i < ntok; i += NW) {
        const int t = (l == 0) ? i : ((i >> 11) * NT + NC + (i & 2047));
        const int b = t / NT, n = t % NT, r = (n < NC) ? 8 : b;
        const int4 slc = sl; const float4 gtc = gt;
        uint2 yv[4][4];
        const int slots[4] = {slc.x, slc.y, slc.z, slc.w};
#pragma unroll
        for (int k = 0; k < 4; ++k)
#pragma unroll
            for (int j = 0; j < 4; ++j) yv[k][j] = *(const uint2*)(ye + (size_t)slots[k] * DM + j * 256 + lane * 4);
        float4 x1[4], w3[4], g2[4], wn[4], scn[4], shn[4];
#define CW4(p_) ({ const f32x4_t v_ = *(const LAS3 f32x4_t*)(p_); make_float4(v_[0], v_[1], v_[2], v_[3]); })
#pragma unroll
        for (int j = 0; j < 4; ++j) {
            const int d = j * 256 + lane * 4;
            { const uint2 xb = *(const uint2*)(x1b + (size_t)t * DM + d); x1[j] = make_float4(__uint_as_float(xb.x << 16), __uint_as_float(xb.x & 0xFFFF0000u), __uint_as_float(xb.y << 16), __uint_as_float(xb.y & 0xFFFF0000u)); }
            w3[j] = CW4(cw + d); g2[j] = CW4(cw + 2048 + r * 1024 + d);
            if (l == 0) { wn[j] = CW4(cw + 1024 + d); scn[j] = CW4(cw + 11264 + r * 2048 + 1024 + d); shn[j] = CW4(cw + 11264 + r * 2048 + d); }
        }
        { const int in = i + NW; if (in < ntok) { const int tn = (l == 0) ? in : ((in >> 11) * NT + NC + (in & 2047)); sl = *(const int4*)(tsl + (size_t)tn * 4); gt = *(const float4*)(tg + (size_t)tn * 4); } }
        const float gk[4] = {gtc.x, gtc.y, gtc.z, gtc.w};
        float m[16];
#pragma unroll
        for (int j = 0; j < 16; ++j) m[j] = 0.f;
#pragma unroll
        for (int k = 0; k < 4; ++k)
#pragma unroll
            for (int j = 0; j < 4; ++j) {
                m[j * 4] += gk[k] * __uint_as_float(yv[k][j].x << 16); m[j * 4 + 1] += gk[k] * __uint_as_float(yv[k][j].x & 0xFFFF0000u);
                m[j * 4 + 2] += gk[k] * __uint_as_float(yv[k][j].y << 16); m[j * 4 + 3] += gk[k] * __uint_as_float(yv[k][j].y & 0xFFFF0000u);
            }
        float ss = 0.f;
#pragma unroll
        for (int j = 0; j < 16; ++j) ss += m[j] * m[j];
        const float rstd = rsqrtf(wave_sum(ss) * (1.f / DM) + 1e-6f);
        float xv[16]; float s2 = 0.f;
#pragma unroll
        for (int j = 0; j < 4; ++j) {
            const int d = j * 256 + lane * 4;
            xv[j * 4] = x1[j].x + g2[j].x * m[j * 4] * rstd * w3[j].x; xv[j * 4 + 1] = x1[j].y + g2[j].y * m[j * 4 + 1] * rstd * w3[j].y;
            xv[j * 4 + 2] = x1[j].z + g2[j].z * m[j * 4 + 2] * rstd * w3[j].z; xv[j * 4 + 3] = x1[j].w + g2[j].w * m[j * 4 + 3] * rstd * w3[j].w;
            s2 += (xv[j * 4] * xv[j * 4] + xv[j * 4 + 1] * xv[j * 4 + 1]) + (xv[j * 4 + 2] * xv[j * 4 + 2] + xv[j * 4 + 3] * xv[j * 4 + 3]);
            const float4 o = make_float4(xv[j * 4], xv[j * 4 + 1], xv[j * 4 + 2], xv[j * 4 + 3]);
            if (l == 0) *(uint2*)(x2b + (size_t)t * DM + d) = make_uint2(cvtpk(o.x, o.y), cvtpk(o.z, o.w));
            else *(float4*)(P.out + ((size_t)b * NS + (n - NC)) * DM + d) = o;
        }
        if (l == 0) {
            const float rs2 = rsqrtf(wave_sum(s2) * (1.f / DM) + 1e-6f);
#pragma unroll
            for (int j = 0; j < 4; ++j) {
                const int d = j * 256 + lane * 4;
                const float o0 = xv[j * 4] * rs2 * wn[j].x * (1.f + scn[j].x) + shn[j].x, o1 = xv[j * 4 + 1] * rs2 * wn[j].y * (1.f + scn[j].y) + shn[j].y;
                const float o2 = xv[j * 4 + 2] * rs2 * wn[j].z * (1.f + scn[j].z) + shn[j].z, o3 = xv[j * 4 + 3] * rs2 * wn[j].w * (1.f + scn[j].w) + shn[j].w;
                *(uint2*)(P.hbuf + (size_t)t * DM + d) = make_uint2(cvtpk(o0, o1), cvtpk(o2, o3));
            }
        }
    }
}

extern __shared__ __attribute__((aligned(16))) unsigned char dyn_lds[];
__device__ __forceinline__ void run_phase(const Params& P, LAS3 unsigned char* lds, int ph) {
    if (ph == PH_SETUP) { phase_setup(P, lds); return; }
    if (ph == PH_H0) { phase_h0(P, lds); return; }
    const int l = (ph - PH_LAYER0) / PH_PER_LAYER, s = (ph - PH_LAYER0) % PH_PER_LAYER;
    switch (s) {
    case L_GEMM_IN: { pg8::Gemm g{P.hbuf, P.w_in_t + (size_t)l * 2560 * 1024, TT, 2560, 1024, 0}; pg8::StaticOrder S; S.init(TT, 2560, gridDim.x, blockIdx.x);
        pg8::EpiBf16P E{P.pb, DIN, 0}; pg8::gemm_phase<pg8::EpiBf16P, pg8::StaticOrder, true, true>(lds, g, S, E); } break;
    case L_PREP: phase_prep(P, lds, l); break;
    case L_MIX: phase_mix(P, lds, l); break;
    case L_FINISH: phase_finish(P, lds, l); break;
    case L_GEMM_OUT: { pg8::Gemm g{P.ycatb, P.w_out_t + (size_t)l * 1024 * 1024, TT, 1024, 1024, 0}; pg8::EpiOut E{P.ob, P.osq};
        if (l == 0) { pg8::StaticOrder S; S.init(TT, 1024, gridDim.x, blockIdx.x); pg8::gemm_phase<pg8::EpiOut, pg8::StaticOrder, true, true>(lds, g, S, E); }
        else { pg8::LatOrder S; S.initl(1024, gridDim.x, blockIdx.x); pg8::gemm_phase<pg8::EpiOut, pg8::LatOrder, true, true>(lds, g, S, E); } } break;
    case L_POST: phase_post(P, lds, l); break;
    case L_SCATTER: phase_scatter(P, lds, l); break;
    case L_GEMM_GU: { pg8::Gemm g{P.fb, P.wgu_t + (size_t)l * NE * 2048 * 1024, 0, 2048, 1024, 0}; pg8::GroupedOrder S; S.initg(P.ntiles + l * 16, P.tile_e + l * 512, 2048, gridDim.x, blockIdx.x);
        pg8::EpiSwiglu E{P.act, P.moe_b_gate_up + (size_t)l * NE * 2048}; pg8::gemm_phase<pg8::EpiSwiglu, pg8::GroupedOrder, true, true, true>(lds, g, S, E, (const int*)P.xg); } break;
    case L_GEMM_DN: { pg8::Gemm g{P.act, P.wdn_t + (size_t)l * NE * 1024 * 1024, 0, 1024, 1024, 0}; pg8::GroupedOrder S; S.initg(P.ntiles + l * 16, P.tile_e + l * 512, 1024, gridDim.x, blockIdx.x);
        pg8::EpiDown E{P.yexp, P.moe_b_down + (size_t)l * NE * 1024}; pg8::gemm_phase<pg8::EpiDown, pg8::GroupedOrder, true, true>(lds, g, S, E); } break;
    case L_COMBINE: phase_combine(P, lds, l); break;
    }
}
__global__ void __launch_bounds__(512, 2) mk_fwd(Params Pk, int ph_lo, int ph_hi) {
    LAS3 unsigned char* lds = (LAS3 unsigned char*)dyn_lds;
    volatile LAS3 unsigned* st = (volatile LAS3 unsigned*)(lds + MK_LDS_MAIN);
    LAS3 Params* PL = (LAS3 Params*)(lds + MK_LDS_MAIN + 64);
    static_assert(sizeof(Params) <= 1024, "Params copy does not fit its LDS slot");
    if (threadIdx.x < 4) st[threadIdx.x] = 0u;
    if (threadIdx.x == 64) store_params(PL, Pk);
    unsigned* barw = Pk.bar;
    __syncthreads();
    XcdBarrier bar; bar.bar = barw; bar.x = 0; bar.st = st;
    if (ph_hi - ph_lo > 1) bar = xcd_barrier_post(barw, st);
#define MK_RUN(ph) if (ph_lo <= (ph) && (ph) < ph_hi) { { const LAS3 Params* PLo = PL; asm volatile("" : "+v"(PLo)); LAS3 unsigned char* ldsp = lds; asm volatile("" : "+s"(ldsp)); \
        const Params P = load_params(PLo); run_phase(P, ldsp, (ph)); } if ((ph) + 1 < ph_hi) xcd_barrier(bar); }
    MK_RUN(0) MK_RUN(1) MK_RUN(2) MK_RUN(3) MK_RUN(4) MK_RUN(5) MK_RUN(6) MK_RUN(7) MK_RUN(8) MK_RUN(9) MK_RUN(10) MK_RUN(11)
    MK_RUN(12) MK_RUN(13) MK_RUN(14) MK_RUN(15) MK_RUN(16) MK_RUN(17) MK_RUN(18) MK_RUN(19) MK_RUN(20) MK_RUN(21)
#undef MK_RUN
}

extern "C" void kernel_launch(void* const* d_in, const int* in_sizes, int n_in, void* d_out, int out_size, void* d_ws, size_t ws_size, hipStream_t stream) {
    Params P{};
    const float** pin = (const float**)&P;
    for (int i = 0; i < 35; ++i) pin[i] = (const float*)d_in[i];
    P.out = (float*)d_out;
    char* ws = (char*)d_ws; size_t off = 0;
    auto carve = [&](size_t bytes) { void* p = ws + off; off += (bytes + 255) & ~(size_t)255; return p; };
    const size_t ctl_bytes = XCD_BAR_WORDS * 4 + 256 + 256;
    P.bar = (unsigned*)carve(XCD_BAR_WORDS * 4); P.queue = (int*)carve(256); P.cnt = (int*)carve(256);
    P.tile_e = (int*)carve(2 * 512 * 4); P.ntiles = (int*)carve(2 * 16 * 4); P.offs = (int*)carve(2 * 32 * 4); P.blkcnt = (int*)carve(2 * 256 * 32 * 4);
    P.xall = (float*)carve((size_t)TT * DM * 4); P.mod = (float*)carve((size_t)2 * 9 * 6144 * 4); P.ropecs = (float*)carve((size_t)NS * 16 * 2 * 4); P.lamfull = (float*)carve(256);
    P.w_in_t = (bf16_t*)carve((size_t)2 * 2560 * 1024 * 2); P.w_out_t = (bf16_t*)carve((size_t)2 * 1024 * 1024 * 2);
    P.wgu_t = (bf16_t*)carve((size_t)2 * NE * 2048 * 1024 * 2); P.wdn_t = (bf16_t*)carve((size_t)2 * NE * 1024 * 1024 * 2);
    P.wq_t = (bf16_t*)carve((size_t)2 * 384 * 192 * 2); P.wkv_t = (bf16_t*)carve((size_t)2 * 512 * 128 * 2); P.wglu_t = (bf16_t*)carve((size_t)2 * 256 * 256 * 2);
    P.s5KmT = (bf16_t*)carve((size_t)64 * 16 * 1024 * 2); P.s5Smat = (bf16_t*)carve((size_t)64 * 128 * 1024 * 2); P.s5CmT = (bf16_t*)carve((size_t)64 * 16 * 128 * 2);
    P.s5A = (float*)carve(64 * 64 * 2 * 4); P.s5A64 = (float*)carve(64 * 64 * 2 * 4); P.s5xs = (float*)carve((size_t)256 * 36 * 128 * 4);
    P.hbuf = (bf16_t*)carve((size_t)TT * DM * 2); P.pb = (bf16_t*)carve((size_t)TT * DIN * 2);
    P.daQ = (bf16_t*)carve((size_t)TT * 256 * 2); P.daK = (bf16_t*)carve((size_t)TT * 256 * 2); P.daVt = (bf16_t*)carve((size_t)TT * 256 * 2);
    P.mQ = (bf16_t*)carve((size_t)TT * 384 * 2); P.mK = (bf16_t*)carve((size_t)TT * 384 * 2); P.mVt = (bf16_t*)carve((size_t)TT * 256 * 2);
    P.mlQ = (bf16_t*)carve((size_t)TT * 256 * 2); P.mlK = (bf16_t*)carve((size_t)TT * 256 * 2); P.mlKt = (bf16_t*)carve((size_t)TT * 256 * 2); P.mlVt = (bf16_t*)carve((size_t)TT * 256 * 2);
    P.mlG = (float*)carve((size_t)TT * 16 * 4); P.hdir = (float*)carve((size_t)2 * TT * 256 * 4); P.ys5 = (float*)carve((size_t)2 * TT * 256 * 4);
    P.ycatb = (bf16_t*)carve((size_t)TT * DM * 2); P.ob = (bf16_t*)carve((size_t)TT * DM * 2); P.osq = (float*)carve((size_t)TT * 16 * 4); P.fb = (bf16_t*)carve((size_t)TT * DM * 2);
    P.top_e = (int*)carve((size_t)NASSIGN * 4); P.top_g = (float*)carve((size_t)NASSIGN * 4); P.posb = (int*)carve((size_t)NASSIGN * 4); P.tok_slot = (int*)carve((size_t)NASSIGN * 4);
    P.xg = (bf16_t*)carve((size_t)MAXSLOTS * DM * 2); P.act = (bf16_t*)carve((size_t)MAXSLOTS * DM * 2); P.yexp = (bf16_t*)carve((size_t)MAXSLOTS * DM * 2);
    if (off > ws_size) { fprintf(stderr, "kernel_launch: workspace too small: need %zu have %zu\n", off, ws_size); return; }
    static bool attr_done = false;
    if (!attr_done) {
        if (hipFuncSetAttribute((const void*)mk_fwd, hipFuncAttributeMaxDynamicSharedMemorySize, MK_LDS_BYTES) != hipSuccess) fprintf(stderr, "kernel_launch: hipFuncSetAttribute failed\n");
        attr_done = true;
    }
    (void)hipMemsetAsync(d_ws, 0, ctl_bytes, stream);
#if MK_ONE_LAUNCH
    hipLaunchKernelGGL(mk_fwd, dim3(256), dim3(512), MK_LDS_BYTES, stream, P, 0, (int)PH_TOTAL);
#else
    for (int ph = 0; ph < PH_TOTAL; ++ph) hipLaunchKernelGGL(mk_fwd, dim3(256), dim3(512), MK_LDS_BYTES, stream, P, ph, ph + 1);
#endif
}
```
